# Optimizing an MI355X kernel written in HIP

```python
import jax, jax.numpy as jnp
from jax import lax
import numpy as np

D_MODEL = 2048
BATCH = 1
SEQ = 8192
DEPTH = 1

MIX_WIDTH = D_MODEL
MLSTM_HEADS = 4
MLSTM_WIDTH = MIX_WIDTH // 2
MLSTM_DV = MLSTM_WIDTH // MLSTM_HEADS
MLSTM_DQK = MLSTM_DV // 2
MLSTM_CHUNK = 64
GATE_SOFTCAP = 15.0
FOX_HEAD_DIM = 128
FOX_WIDTH = MIX_WIDTH - MLSTM_WIDTH
FOX_HEADS = FOX_WIDTH // FOX_HEAD_DIM
FOX_BLOCK = 128
D_IN_PROJ = 2 * MLSTM_HEADS * MLSTM_DQK + 2 * MLSTM_WIDTH + 2 * MLSTM_HEADS + 3 * FOX_WIDTH + FOX_HEADS
N_EXPERTS = 32
TOP_K = 4
D_FF = D_MODEL
SWIGLU_LIMIT = 7.0
SWIGLU_ALPHA = 1.702
MOE_BLOCK = 128
ADA_SCALE = 0.5
EPS = 1e-6

kernel_name = 'hymba_mlstm_fox_moe_adaln_block'


def rms_last(a, g):
    a = a.astype(jnp.float32)
    return a * lax.rsqrt(jnp.mean(a * a, axis=-1, keepdims=True) + EPS) * g.astype(jnp.float32)


def modulate(x, g, shift, scale):
    return rms_last(x, g) * (1.0 + scale[:, None, :]) + shift[:, None, :]


def soft_cap(a):
    return GATE_SOFTCAP * jnp.tanh(a / GATE_SOFTCAP)


def split_heads(a, n_heads):
    b, s, _ = a.shape
    return a.reshape(b, s, n_heads, -1).transpose(0, 2, 1, 3)


def merge_heads(a):
    b, h, s, d = a.shape
    return a.transpose(0, 2, 1, 3).reshape(b, s, h * d)


def mlstm_chunkwise(q, k, v, i_pre, f_pre):
    b, h, s, _ = q.shape
    L = MLSTM_CHUNK
    nc = s // L
    q = q * (MLSTM_DQK ** -0.5)
    log_f = jax.nn.log_sigmoid(f_pre)

    def to_chunks(a):
        return jnp.moveaxis(a.reshape(b, h, nc, L, *a.shape[3:]), 2, 0)

    causal = jnp.tril(jnp.ones((L, L), dtype=bool))

    def step(carry, inp):
        C, n, m = carry
        qc, kc, vc, ic, fc = inp
        g = jnp.cumsum(fc, axis=-1)
        dmat = jnp.where(causal, g[..., :, None] - g[..., None, :] + ic[..., None, :], -jnp.inf)
        m_inter = g + m[..., None]
        m_t = jnp.maximum(m_inter, jnp.max(dmat, axis=-1))
        scores = jnp.einsum('bhtd,bhsd->bhts', qc, kc) * jnp.exp(dmat - m_t[..., None])
        inter = jnp.exp(m_inter - m_t)
        num = jnp.einsum('bhts,bhsv->bhtv', scores, vc) + inter[..., None] * jnp.einsum('bhtd,bhdv->bhtv', qc, C)
        den = jnp.sum(scores, axis=-1) + inter * jnp.einsum('bhtd,bhd->bht', qc, n)
        h_out = num / jnp.maximum(jnp.abs(den), jnp.exp(-m_t))[..., None]
        g_last = g[..., -1]
        log_w = g_last[..., None] - g + ic
        m_new = jnp.maximum(g_last + m, jnp.max(log_w, axis=-1))
        w = jnp.exp(log_w - m_new[..., None])
        decay = jnp.exp(g_last + m - m_new)
        C = decay[..., None, None] * C + jnp.einsum('bhs,bhsd,bhsv->bhdv', w, kc, vc)
        n = decay[..., None] * n + jnp.einsum('bhs,bhsd->bhd', w, kc)
        return (C, n, m_new), h_out

    init = (jnp.zeros((b, h, MLSTM_DQK, MLSTM_DV), jnp.float32),
            jnp.zeros((b, h, MLSTM_DQK), jnp.float32),
            jnp.zeros((b, h), jnp.float32))
    _, hs = lax.scan(step, init, (to_chunks(q), to_chunks(k), to_chunks(v), to_chunks(i_pre), to_chunks(log_f)))
    return jnp.moveaxis(hs, 0, 2).reshape(b, h, s, MLSTM_DV)


def forgetting_attention(q, k, v, f_pre):
    b, h, s, d = q.shape
    nb = s // FOX_BLOCK
    F = jnp.cumsum(jax.nn.log_sigmoid(f_pre), axis=-1)
    qb = jnp.moveaxis(q.reshape(b, h, nb, FOX_BLOCK, d), 2, 0)
    Fb = jnp.moveaxis(F.reshape(b, h, nb, FOX_BLOCK), 2, 0)
    kpos = jnp.arange(s)
    scale = FOX_HEAD_DIM ** -0.5

    def block(args):
        qi, Fi, bi = args
        qpos = bi * FOX_BLOCK + jnp.arange(FOX_BLOCK)
        logits = jnp.einsum('bhtd,bhsd->bhts', qi, k) * scale + Fi[..., :, None] - F[..., None, :]
        logits = jnp.where(kpos[None, :] <= qpos[:, None], logits, -jnp.inf)
        p = jax.nn.softmax(logits, axis=-1)
        return jnp.einsum('bhts,bhsd->bhtd', p, v)

    out = lax.map(block, (qb, Fb, jnp.arange(nb)))
    return jnp.moveaxis(out, 0, 2).reshape(b, h, s, d)


def moe_ffn(xt, w_router, b_router, w_up_gate, b_up_gate, w_down, b_down):
    t, d = xt.shape
    logits = (xt @ w_router + b_router).astype(jnp.float32)
    top_logits, top_idx = lax.top_k(logits, TOP_K)
    top_w = jax.nn.softmax(top_logits, axis=-1)
    a = t * TOP_K
    flat_e = top_idx.reshape(a)
    flat_tok = jnp.repeat(jnp.arange(t, dtype=jnp.int32), TOP_K)
    flat_w = top_w.reshape(a)
    order = jnp.argsort(flat_e)
    sorted_e = flat_e[order]
    counts = jnp.zeros((N_EXPERTS,), jnp.int32).at[flat_e].add(1)
    n_blocks_e = (counts + MOE_BLOCK - 1) // MOE_BLOCK
    blk_end = jnp.cumsum(n_blocks_e)
    blk_start = blk_end - n_blocks_e
    tok_start = jnp.cumsum(counts) - counts
    rank = jnp.arange(a, dtype=jnp.int32) - tok_start[sorted_e]
    dest = blk_start[sorted_e] * MOE_BLOCK + rank
    nb = -(-a // MOE_BLOCK) + N_EXPERTS
    rows = nb * MOE_BLOCK
    row_tok = jnp.full((rows,), t, jnp.int32).at[dest].set(flat_tok[order])
    row_w = jnp.zeros((rows,), jnp.float32).at[dest].set(flat_w[order])
    block_e = jnp.minimum(jnp.searchsorted(blk_end, jnp.arange(nb), side='right'), N_EXPERTS - 1)
    x_pad = jnp.concatenate([xt, jnp.zeros((1, d), xt.dtype)], axis=0)
    xb = x_pad[row_tok].reshape(nb, MOE_BLOCK, d)

    def expert_block(args):
        xi, e = args
        gu = xi @ w_up_gate[e] + b_up_gate[e]
        gate = jnp.minimum(gu[:, :D_FF], SWIGLU_LIMIT)
        up = jnp.clip(gu[:, D_FF:], -SWIGLU_LIMIT, SWIGLU_LIMIT)
        act = (up + 1.0) * gate * jax.nn.sigmoid(SWIGLU_ALPHA * gate)
        return act @ w_down[e] + b_down[e]

    yb = lax.map(expert_block, (xb, block_e)).reshape(rows, d).astype(jnp.float32)
    out = jnp.zeros((t + 1, d), jnp.float32).at[row_tok].add(yb * row_w[:, None])
    return out[:t]


def setup_inputs(seed: int = 0) -> dict:
    key = jax.random.key(seed)
    ks = jax.random.split(key, 24)
    f32 = jnp.float32
    L, D, E, F = DEPTH, D_MODEL, N_EXPERTS, D_FF

    def nrm(k, shape, scale):
        return jax.random.normal(k, shape, f32) * scale

    return {
        'x': nrm(ks[0], (BATCH, SEQ, D), 1.0),
        'c': nrm(ks[1], (BATCH, D), 1.0),
        'w_ada': nrm(ks[2], (L, D, 6 * D), ADA_SCALE * D ** -0.5),
        'b_ada': nrm(ks[3], (L, 6 * D), 0.02),
        'norm_mix': 1.0 + nrm(ks[4], (L, D), 0.02),
        'w_in': nrm(ks[5], (L, D, D_IN_PROJ), D ** -0.5),
        'b_i': nrm(ks[6], (L, MLSTM_HEADS), 0.1),
        'b_f': jnp.linspace(3.0, 6.0, MLSTM_HEADS, dtype=f32)[None, :] + nrm(ks[7], (L, MLSTM_HEADS), 0.1),
        'fox_b_f': jnp.linspace(1.0, 5.0, FOX_HEADS, dtype=f32)[None, :] + nrm(ks[8], (L, FOX_HEADS), 0.1),
        'fox_q_norm': 1.0 + nrm(ks[9], (L, FOX_HEAD_DIM), 0.02),
        'fox_k_norm': 1.0 + nrm(ks[10], (L, FOX_HEAD_DIM), 0.02),
        'mlstm_out_norm': 1.0 + nrm(ks[11], (L, MLSTM_HEADS, MLSTM_DV), 0.02),
        'fox_out_norm': 1.0 + nrm(ks[12], (L, FOX_HEADS, FOX_HEAD_DIM), 0.02),
        'w_out': nrm(ks[13], (L, MIX_WIDTH, D), MIX_WIDTH ** -0.5),
        'norm_ffn': 1.0 + nrm(ks[14], (L, D), 0.02),
        'w_router': nrm(ks[15], (L, D, E), D ** -0.5),
        'b_router': nrm(ks[16], (L, E), 0.01),
        'w_up_gate': nrm(ks[17], (L, E, D, 2 * F), D ** -0.5),
        'b_up_gate': nrm(ks[18], (L, E, 2 * F), 0.02),
        'w_down': nrm(ks[19], (L, E, F, D), F ** -0.5),
        'b_down': nrm(ks[20], (L, E, D), 0.02),
        'w_ada_final': nrm(ks[21], (D, 2 * D), ADA_SCALE * D ** -0.5),
        'b_ada_final': nrm(ks[22], (2 * D,), 0.02),
        'norm_final': 1.0 + nrm(ks[23], (D,), 0.02),
    }


def reference(x, c, w_ada, b_ada, norm_mix, w_in, b_i, b_f, fox_b_f, fox_q_norm, fox_k_norm,
              mlstm_out_norm, fox_out_norm, w_out, norm_ffn, w_router, b_router, w_up_gate,
              b_up_gate, w_down, b_down, w_ada_final, b_ada_final, norm_final):
    b, s, d = x.shape
    c_act = jax.nn.silu(c.astype(jnp.float32))
    sizes = [MLSTM_HEADS * MLSTM_DQK, MLSTM_HEADS * MLSTM_DQK, MLSTM_WIDTH, MLSTM_WIDTH,
             MLSTM_HEADS, MLSTM_HEADS, FOX_WIDTH, FOX_WIDTH, FOX_WIDTH, FOX_HEADS]
    offsets = []
    acc = 0
    for sz in sizes[:-1]:
        acc += sz
        offsets.append(acc)
    h_res = x.astype(jnp.float32)
    for l in range(DEPTH):
        mod = c_act @ w_ada[l] + b_ada[l]
        sh1, sc1, g1, sh2, sc2, g2 = jnp.split(mod, 6, axis=-1)
        hn = modulate(h_res, norm_mix[l], sh1, sc1)
        proj = (hn @ w_in[l]).astype(jnp.float32)
        mq, mk, mv, mo, mi, mf, fq, fk, fv, ff = jnp.split(proj, offsets, axis=-1)
        i_pre = soft_cap(mi + b_i[l]).transpose(0, 2, 1)
        f_pre = soft_cap(mf + b_f[l]).transpose(0, 2, 1)
        hm = mlstm_chunkwise(split_heads(mq, MLSTM_HEADS), split_heads(mk, MLSTM_HEADS),
                             split_heads(mv, MLSTM_HEADS), i_pre, f_pre)
        hm = merge_heads(rms_last(hm, mlstm_out_norm[l][:, None, :])) * jax.nn.sigmoid(mo)
        qf = rms_last(split_heads(fq, FOX_HEADS), fox_q_norm[l])
        kf = rms_last(split_heads(fk, FOX_HEADS), fox_k_norm[l])
        fox_f = (ff + fox_b_f[l]).transpose(0, 2, 1)
        hf = forgetting_attention(qf, kf, split_heads(fv, FOX_HEADS), fox_f)
        hf = merge_heads(rms_last(hf, fox_out_norm[l][:, None, :]))
        y = jnp.concatenate([hm, hf], axis=-1) @ w_out[l]
        h_res = h_res + g1[:, None, :] * y
        h2 = modulate(h_res, norm_ffn[l], sh2, sc2)
        ffn = moe_ffn(h2.reshape(b * s, d), w_router[l], b_router[l], w_up_gate[l],
                      b_up_gate[l], w_down[l], b_down[l]).reshape(b, s, d)
        h_res = h_res + g2[:, None, :] * ffn
    modf = c_act @ w_ada_final + b_ada_final
    shf, scf = jnp.split(modf, 2, axis=-1)
    out = modulate(h_res, norm_final, shf, scf)
    return out.astype(x.dtype)
```

```cpp
#include <hip/hip_runtime.h>
#include <cstdio>
#include <cstdint>
namespace nv {
constexpr int S = 8192, D = 2048, NPROJ = 6160, E = 32, FF = 2048;
constexpr int O_MQ = 0, O_MK = 512, O_MV = 1024, O_MO = 2048, O_MI = 3072, O_MF = 3076, O_FQ = 3080, O_FK = 4104, O_FV = 5128, O_FF = 6152;

__device__ __forceinline__ float sigmoidf_(float v) { return 1.f / (1.f + __expf(-v)); }
__device__ __forceinline__ float log_sigmoid_(float v) { return fminf(v, 0.f) - log1pf(__expf(-fabsf(v))); }
__device__ __forceinline__ float softcap_(float v) { return 15.f * tanhf(v * (1.f / 15.f)); }
__device__ __forceinline__ float wave_sum_(float v) {
#pragma unroll
    for (int o = 1; o < 64; o <<= 1) v += __shfl_xor(v, o);
    return v;
}
__device__ __forceinline__ float block_sum_256(float v, float* red) {
    v = wave_sum_(v);
    __syncthreads();
    if ((threadIdx.x & 63) == 0) red[threadIdx.x >> 6] = v;
    __syncthreads();
    return red[0] + red[1] + red[2] + red[3];
}

__global__ void __launch_bounds__(256) k_ada(const float* c, const float* w_ada, const float* b_ada, const float* w_f, const float* b_f, float* mod) {
    const int j = blockIdx.x * 256 + threadIdx.x;
    const float* w; int ld, col; float acc;
    if (j < 6 * D) { w = w_ada; ld = 6 * D; col = j; acc = b_ada[j]; } else { w = w_f; ld = 2 * D; col = j - 6 * D; acc = b_f[col]; }
    for (int i = 0; i < D; ++i) { const float cv = c[i]; const float s = cv * sigmoidf_(cv); acc += s * w[(size_t)i * ld + col]; }
    mod[j] = acc;
}
__global__ void __launch_bounds__(256) k_modulate(const float* x, const float* g, const float* shift, const float* scale, float* out) {
    __shared__ float red[4];
    const int row = blockIdx.x; const float* xr = x + (size_t)row * D; float v[8]; float ss = 0.f;
#pragma unroll
    for (int i = 0; i < 8; ++i) { v[i] = xr[threadIdx.x + 256 * i]; ss += v[i] * v[i]; }
    ss = block_sum_256(ss, red);
    const float r = rsqrtf(ss * (1.f / D) + 1e-6f);
#pragma unroll
    for (int i = 0; i < 8; ++i) { const int cidx = threadIdx.x + 256 * i; out[(size_t)row * D + cidx] = v[i] * r * g[cidx] * (1.f + scale[cidx]) + shift[cidx]; }
}
template <bool TRANSB>
__global__ void __launch_bounds__(256) k_sgemm(const float* A, int lda, const float* B, int ldb, float* C, int ldc, int M, int N, int K,
                                               const int* arow, const int* tile_e, size_t bstride, size_t sa, size_t sb, size_t sc) {
    __shared__ float As[16][68];
    __shared__ float Bs[16][68];
    A += (size_t)blockIdx.z * sa; B += (size_t)blockIdx.z * sb; C += (size_t)blockIdx.z * sc;
    const int tid = threadIdx.x, m0 = blockIdx.y * 64, n0 = blockIdx.x * 64;
    if (tile_e) { const int e = tile_e[blockIdx.y]; if (e < 0) return; B += (size_t)e * bstride; }
    const int ar = tid >> 2, ak = (tid & 3) * 4;
    int arow_i = m0 + ar; if (arow) arow_i = arow[m0 + ar];
    const float* Ap = A + (size_t)(arow_i < 0 ? 0 : arow_i) * lda + ak;
    const int ty = tid >> 4, tx = tid & 15;
    float acc[4][4];
#pragma unroll
    for (int i = 0; i < 4; ++i)
#pragma unroll
        for (int j = 0; j < 4; ++j) acc[i][j] = 0.f;
    for (int k0 = 0; k0 < K; k0 += 16) {
        float4 av = (arow_i < 0) ? make_float4(0.f, 0.f, 0.f, 0.f) : *(const float4*)(Ap + k0);
        As[ak + 0][ar] = av.x; As[ak + 1][ar] = av.y; As[ak + 2][ar] = av.z; As[ak + 3][ar] = av.w;
        if (TRANSB) {
            const int bn = tid >> 2, bk = (tid & 3) * 4; float4 bv = make_float4(0.f, 0.f, 0.f, 0.f);
            if (n0 + bn < N) bv = *(const float4*)(B + (size_t)(n0 + bn) * ldb + k0 + bk);
            Bs[bk + 0][bn] = bv.x; Bs[bk + 1][bn] = bv.y; Bs[bk + 2][bn] = bv.z; Bs[bk + 3][bn] = bv.w;
        } else {
            const int bk = tid >> 4, bn = (tid & 15) * 4; float4 bv = make_float4(0.f, 0.f, 0.f, 0.f);
            if (n0 + bn < N) bv = *(const float4*)(B + (size_t)(k0 + bk) * ldb + n0 + bn);
            Bs[bk][bn + 0] = bv.x; Bs[bk][bn + 1] = bv.y; Bs[bk][bn + 2] = bv.z; Bs[bk][bn + 3] = bv.w;
        }
        __syncthreads();
#pragma unroll
        for (int k = 0; k < 16; ++k) {
            const float4 a4 = *(const float4*)&As[k][ty * 4]; const float4 b4 = *(const float4*)&Bs[k][tx * 4];
            const float a[4] = {a4.x, a4.y, a4.z, a4.w}, b[4] = {b4.x, b4.y, b4.z, b4.w};
#pragma unroll
            for (int i = 0; i < 4; ++i)
#pragma unroll
                for (int j = 0; j < 4; ++j) acc[i][j] += a[i] * b[j];
        }
        __syncthreads();
    }
#pragma unroll
    for (int i = 0; i < 4; ++i) { const int r = m0 + ty * 4 + i;
#pragma unroll
        for (int j = 0; j < 4; ++j) { const int cc = n0 + tx * 4 + j; if (cc < N) C[(size_t)r * ldc + cc] = acc[i][j]; } }
}
__global__ void __launch_bounds__(256) k_mlstm_rec(const float* proj, const float* b_i, const float* b_f, float* hraw) {
    __shared__ float red[4][9];
    const int h = blockIdx.x >> 4, vs = blockIdx.x & 15, tid = threadIdx.x, d = tid & 127, vh = tid >> 7, w = tid >> 6;
    const int v0 = vs * 16 + vh * 8;
    float C[8]; float n = 0.f, m = 0.f;
#pragma unroll
    for (int j = 0; j < 8; ++j) C[j] = 0.f;
    const float bi = b_i[h], bf = b_f[h];
    for (int t = 0; t < S; ++t) {
        const float* pr = proj + (size_t)t * NPROJ;
        const float q = pr[O_MQ + h * 128 + d] * 0.08838834764831845f, k = pr[O_MK + h * 128 + d];
        const float ip = softcap_(pr[O_MI + h] + bi), fp = softcap_(pr[O_MF + h] + bf);
        const float lf = log_sigmoid_(fp);
        const float mn = fmaxf(lf + m, ip), fpr = __expf(lf + m - mn), ipr = __expf(ip - mn); m = mn;
        const float ik = ipr * k;
        n = fpr * n + ik;
        float part[9];
#pragma unroll
        for (int j = 0; j < 8; ++j) { C[j] = fpr * C[j] + ik * pr[O_MV + h * 256 + v0 + j]; part[j] = C[j] * q; }
        part[8] = n * q;
#pragma unroll
        for (int j = 0; j < 9; ++j) part[j] = wave_sum_(part[j]);
        __syncthreads();
        if ((tid & 63) == 0) {
#pragma unroll
            for (int j = 0; j < 9; ++j) red[w][j] = part[j]; }
        __syncthreads();
        if (d < 8) {
            const int wb = vh * 2; const float num = red[wb][d] + red[wb + 1][d], den = red[wb][8] + red[wb + 1][8];
            hraw[(size_t)t * 1024 + h * 256 + v0 + d] = num / fmaxf(fabsf(den), __expf(-m));
        }
    }
}
__global__ void __launch_bounds__(256) k_mlstm_post(const float* hraw, const float* proj, const float* gain, float* concat) {
    __shared__ float red[4];
    const int t = blockIdx.x >> 2, h = blockIdx.x & 3, v = threadIdx.x;
    const float x = hraw[(size_t)t * 1024 + h * 256 + v];
    const float ss = block_sum_256(x * x, red);
    const float r = rsqrtf(ss * (1.f / 256.f) + 1e-6f);
    concat[(size_t)t * D + h * 256 + v] = x * r * gain[h * 256 + v] * sigmoidf_(proj[(size_t)t * NPROJ + O_MO + h * 256 + v]);
}
__global__ void __launch_bounds__(128) k_fox_prep(const float* proj, const float* gq, const float* gk, float* qn, float* kn, float* vv) {
    __shared__ float red[2][2];
    const int t = blockIdx.x >> 3, h = blockIdx.x & 7, d = threadIdx.x;
    const float* pr = proj + (size_t)t * NPROJ;
    const float q = pr[O_FQ + h * 128 + d], k = pr[O_FK + h * 128 + d];
    float sq = wave_sum_(q * q), sk = wave_sum_(k * k);
    if ((d & 63) == 0) { red[d >> 6][0] = sq; red[d >> 6][1] = sk; }
    __syncthreads();
    sq = red[0][0] + red[1][0]; sk = red[0][1] + red[1][1];
    const size_t o = ((size_t)h * S + t) * 128 + d;
    qn[o] = q * rsqrtf(sq * (1.f / 128.f) + 1e-6f) * gq[d];
    kn[o] = k * rsqrtf(sk * (1.f / 128.f) + 1e-6f) * gk[d];
    vv[o] = pr[O_FV + h * 128 + d];
}
__global__ void __launch_bounds__(64) k_fox_scan(const float* proj, const float* fb, float* F) {
    const int h = blockIdx.x;
    if (threadIdx.x == 0) { double acc = 0.0; const float b = fb[h];
        for (int t = 0; t < S; ++t) { acc += (double)log_sigmoid_(proj[(size_t)t * NPROJ + O_FF + h] + b); F[h * S + t] = (float)acc; } }
}
__global__ void __launch_bounds__(256) k_fox_softmax(float* Sm, const float* F) {
    __shared__ float red[4];
    const int t = blockIdx.x; float* row = Sm + (size_t)t * S; const float Ft = F[t]; const float sc = 0.08838834764831845f;
    float mx = -3.0e38f;
    for (int s = threadIdx.x; s <= t; s += 256) { const float l = row[s] * sc + Ft - F[s]; row[s] = l; mx = fmaxf(mx, l); }
#pragma unroll
    for (int o = 1; o < 64; o <<= 1) mx = fmaxf(mx, __shfl_xor(mx, o));
    __syncthreads();
    if ((threadIdx.x & 63) == 0) red[threadIdx.x >> 6] = mx;
    __syncthreads();
    mx = fmaxf(fmaxf(red[0], red[1]), fmaxf(red[2], red[3]));
    float sum = 0.f;
    for (int s = threadIdx.x; s <= t; s += 256) { const float p = __expf(row[s] - mx); row[s] = p; sum += p; }
    sum = block_sum_256(sum, red);
    const float inv = 1.f / sum;
    for (int s = threadIdx.x; s < S; s += 256) row[s] = (s <= t) ? row[s] * inv : 0.f;
}
__global__ void __launch_bounds__(128) k_fox_post(const float* o, const float* gain, float* concat) {
    __shared__ float red[2];
    const int t = blockIdx.x >> 3, h = blockIdx.x & 7, d = threadIdx.x;
    const float x = o[((size_t)h * S + t) * 128 + d];
    float ss = wave_sum_(x * x);
    if ((d & 63) == 0) red[d >> 6] = ss;
    __syncthreads();
    ss = red[0] + red[1];
    concat[(size_t)t * D + 1024 + h * 128 + d] = x * rsqrtf(ss * (1.f / 128.f) + 1e-6f) * gain[h * 128 + d];
}
__global__ void __launch_bounds__(256) k_resid(const float* x, const float* g, const float* y, float* h1) {
    const size_t i = (size_t)blockIdx.x * 256 + threadIdx.x; h1[i] = x[i] + g[i & (D - 1)] * y[i];
}
__global__ void __launch_bounds__(256) k_router(const float* h2, const float* wr, const float* br, int* top_i, float* top_w) {
    const int t = blockIdx.x * 4 + (threadIdx.x >> 6), lane = threadIdx.x & 63, e = lane & 31;
    const float* hr = h2 + (size_t)t * D; float acc = 0.f;
    const int kb = (lane >> 5) * (D / 2);
    for (int k = 0; k < D / 2; ++k) acc += hr[kb + k] * wr[(size_t)(kb + k) * E + e];
    acc += __shfl_xor(acc, 32);
    acc += br[e];
    float sel[4]; int seli[4]; float cur = acc;
#pragma unroll
    for (int r = 0; r < 4; ++r) {
        float best = cur; int bi = e;
#pragma unroll
        for (int o = 1; o < 32; o <<= 1) { const float ob = __shfl_xor(best, o); const int oi = __shfl_xor(bi, o); if (ob > best || (ob == best && oi < bi)) { best = ob; bi = oi; } }
        sel[r] = best; seli[r] = bi; if (e == bi) cur = -3.0e38f;
    }
    const float mx = sel[0]; float ex[4], sum = 0.f;
#pragma unroll
    for (int r = 0; r < 4; ++r) { ex[r] = __expf(sel[r] - mx); sum += ex[r]; }
    if (lane < 4) { float w = ex[0]; int i = seli[0];
        if (lane == 1) { w = ex[1]; i = seli[1]; } if (lane == 2) { w = ex[2]; i = seli[2]; } if (lane == 3) { w = ex[3]; i = seli[3]; }
        top_i[t * 4 + lane] = i; top_w[t * 4 + lane] = w / sum; }
}
template <int PAD>
__global__ void __launch_bounds__(1024) k_sort(const int* top_i, const float* top_w, int* pos, int* row_tok, float* row_w, int* tile_e, int* meta, int max_rows) {
    __shared__ unsigned char eid[S * 4];
    __shared__ int cnt[E], start[E];
    const int tid = threadIdx.x;
    for (int i = tid; i < S * 4; i += 1024) eid[i] = (unsigned char)top_i[i];
    for (int i = tid; i < max_rows; i += 1024) { row_tok[i] = -1; row_w[i] = 0.f; }
    for (int i = tid; i < max_rows / PAD; i += 1024) tile_e[i] = -1;
    __syncthreads();
    if (tid < E) { int c = 0; for (int i = 0; i < S * 4; ++i) c += (eid[i] == tid) ? 1 : 0; cnt[tid] = c; }
    __syncthreads();
    if (tid == 0) { int acc = 0; for (int e = 0; e < E; ++e) { start[e] = acc; const int nt = (cnt[e] + PAD - 1) / PAD; for (int j = 0; j < nt; ++j) tile_e[acc / PAD + j] = e; acc += nt * PAD; } meta[0] = acc / PAD; }
    __syncthreads();
    if (tid < E) { int r = start[tid]; for (int i = 0; i < S * 4; ++i) if (eid[i] == tid) { pos[i] = r; row_tok[r] = i >> 2; row_w[r] = top_w[i]; ++r; } }
}
__global__ void __launch_bounds__(256) k_swiglu(const float* gu, const float* bug, const int* tile_e, int pad, float* act) {
    const int r = blockIdx.x; const int e = tile_e[r / pad]; if (e < 0) return;
    for (int f = threadIdx.x; f < FF; f += 256) {
        const float g = fminf(gu[(size_t)r * 2 * FF + f] + bug[(size_t)e * 2 * FF + f], 7.f);
        const float u = fminf(fmaxf(gu[(size_t)r * 2 * FF + FF + f] + bug[(size_t)e * 2 * FF + FF + f], -7.f), 7.f);
        act[(size_t)r * FF + f] = (u + 1.f) * g * sigmoidf_(1.702f * g);
    }
}
__global__ void __launch_bounds__(256) k_final(const float* h1, const float* g2, const float* y, const int* pos, const int* top_i, const float* top_w, const float* bd,
                                               const float* gf, const float* shf, const float* scf, float* out) {
    __shared__ float red[4];
    const int t = blockIdx.x; float v[8]; float ss = 0.f;
#pragma unroll
    for (int i = 0; i < 8; ++i) { const int c = threadIdx.x + 256 * i; float f = 0.f;
#pragma unroll
        for (int k = 0; k < 4; ++k) f += top_w[t * 4 + k] * (y[(size_t)pos[t * 4 + k] * D + c] + bd[(size_t)top_i[t * 4 + k] * D + c]);
        v[i] = h1[(size_t)t * D + c] + g2[c] * f; ss += v[i] * v[i]; }
    ss = block_sum_256(ss, red);
    const float r = rsqrtf(ss * (1.f / D) + 1e-6f);
#pragma unroll
    for (int i = 0; i < 8; ++i) { const int c = threadIdx.x + 256 * i; out[(size_t)t * D + c] = v[i] * r * gf[c] * (1.f + scf[c]) + shf[c]; }
}

struct NaiveWs {
    float *mod, *hn, *proj, *hraw, *concat, *qn, *kn, *vv, *F, *Sm, *o, *y, *h1, *h2, *top_w, *row_w, *gu, *act, *yy;
    int *top_i, *pos, *row_tok, *tile_e, *meta;
};
constexpr int NV_PAD = 64, NV_MAXROWS = S * 4 + E * NV_PAD;
inline NaiveWs carve(char* base) {
    NaiveWs w; size_t o = 0;
    auto take = [&](size_t bytes) { char* p = base + o; o += (bytes + 255) & ~(size_t)255; return p; };
    w.mod = (float*)take(16384 * 4); w.hn = (float*)take((size_t)S * D * 4); w.proj = (float*)take((size_t)S * NPROJ * 4); w.hraw = (float*)take((size_t)S * 1024 * 4);
    w.concat = (float*)take((size_t)S * D * 4); w.qn = (float*)take((size_t)8 * S * 128 * 4); w.kn = (float*)take((size_t)8 * S * 128 * 4); w.vv = (float*)take((size_t)8 * S * 128 * 4);
    w.F = (float*)take(8 * S * 4); w.Sm = (float*)take((size_t)S * S * 4); w.o = (float*)take((size_t)8 * S * 128 * 4); w.y = (float*)take((size_t)S * D * 4);
    w.h1 = (float*)take((size_t)S * D * 4); w.h2 = (float*)take((size_t)S * D * 4); w.top_w = (float*)take(S * 4 * 4); w.row_w = (float*)take(NV_MAXROWS * 4);
    w.gu = (float*)take((size_t)NV_MAXROWS * 2 * FF * 4); w.act = (float*)take((size_t)NV_MAXROWS * FF * 4); w.yy = (float*)take((size_t)NV_MAXROWS * D * 4);
    w.top_i = (int*)take(S * 4 * 4); w.pos = (int*)take(S * 4 * 4); w.row_tok = (int*)take(NV_MAXROWS * 4); w.tile_e = (int*)take((NV_MAXROWS / NV_PAD) * 4); w.meta = (int*)take(256);
    return w;
}
inline void naive_forward(void* const* d_in, float* out, char* wsbase, hipStream_t st) {
    const float* x = (const float*)d_in[0]; const float* c = (const float*)d_in[1]; const float* w_ada = (const float*)d_in[2]; const float* b_ada = (const float*)d_in[3];
    const float* norm_mix = (const float*)d_in[4]; const float* w_in = (const float*)d_in[5]; const float* b_i = (const float*)d_in[6]; const float* b_f = (const float*)d_in[7];
    const float* fox_b_f = (const float*)d_in[8]; const float* fox_q_norm = (const float*)d_in[9]; const float* fox_k_norm = (const float*)d_in[10];
    const float* mlstm_out_norm = (const float*)d_in[11]; const float* fox_out_norm = (const float*)d_in[12]; const float* w_out = (const float*)d_in[13];
    const float* norm_ffn = (const float*)d_in[14]; const float* w_router = (const float*)d_in[15]; const float* b_router = (const float*)d_in[16];
    const float* w_ug = (const float*)d_in[17]; const float* b_ug = (const float*)d_in[18]; const float* w_dn = (const float*)d_in[19]; const float* b_dn = (const float*)d_in[20];
    const float* w_af = (const float*)d_in[21]; const float* b_af = (const float*)d_in[22]; const float* norm_final = (const float*)d_in[23];
    NaiveWs w = carve(wsbase);
    const float *sh1 = w.mod, *sc1 = w.mod + D, *g1 = w.mod + 2 * D, *sh2 = w.mod + 3 * D, *sc2 = w.mod + 4 * D, *g2 = w.mod + 5 * D, *shf = w.mod + 6 * D, *scf = w.mod + 7 * D;
    k_ada<<<16384 / 256, 256, 0, st>>>(c, w_ada, b_ada, w_af, b_af, w.mod);
    k_modulate<<<S, 256, 0, st>>>(x, norm_mix, sh1, sc1, w.hn);
    k_sgemm<false><<<dim3((NPROJ + 63) / 64, S / 64, 1), 256, 0, st>>>(w.hn, D, w_in, NPROJ, w.proj, NPROJ, S, NPROJ, D, nullptr, nullptr, 0, 0, 0, 0);
    k_mlstm_rec<<<64, 256, 0, st>>>(w.proj, b_i, b_f, w.hraw);
    k_mlstm_post<<<S * 4, 256, 0, st>>>(w.hraw, w.proj, mlstm_out_norm, w.concat);
    k_fox_prep<<<S * 8, 128, 0, st>>>(w.proj, fox_q_norm, fox_k_norm, w.qn, w.kn, w.vv);
    k_fox_scan<<<8, 64, 0, st>>>(w.proj, fox_b_f, w.F);
    for (int h = 0; h < 8; ++h) {
        const size_t ho = (size_t)h * S * 128;
        k_sgemm<true><<<dim3(S / 64, S / 64, 1), 256, 0, st>>>(w.qn + ho, 128, w.kn + ho, 128, w.Sm, S, S, S, 128, nullptr, nullptr, 0, 0, 0, 0);
        k_fox_softmax<<<S, 256, 0, st>>>(w.Sm, w.F + h * S);
        k_sgemm<false><<<dim3(2, S / 64, 1), 256, 0, st>>>(w.Sm, S, w.vv + ho, 128, w.o + ho, 128, S, 128, S, nullptr, nullptr, 0, 0, 0, 0);
    }
    k_fox_post<<<S * 8, 128, 0, st>>>(w.o, fox_out_norm, w.concat);
    k_sgemm<false><<<dim3(D / 64, S / 64, 1), 256, 0, st>>>(w.concat, D, w_out, D, w.y, D, S, D, D, nullptr, nullptr, 0, 0, 0, 0);
    k_resid<<<S * D / 256, 256, 0, st>>>(x, g1, w.y, w.h1);
    k_modulate<<<S, 256, 0, st>>>(w.h1, norm_ffn, sh2, sc2, w.h2);
    k_router<<<S / 4, 256, 0, st>>>(w.h2, w_router, b_router, w.top_i, w.top_w);
    k_sort<NV_PAD><<<1, 1024, 0, st>>>(w.top_i, w.top_w, w.pos, w.row_tok, w.row_w, w.tile_e, w.meta, NV_MAXROWS);
    k_sgemm<false><<<dim3(2 * FF / 64, NV_MAXROWS / 64, 1), 256, 0, st>>>(w.h2, D, w_ug, 2 * FF, w.gu, 2 * FF, NV_MAXROWS, 2 * FF, D, w.row_tok, w.tile_e, (size_t)D * 2 * FF, 0, 0, 0);
    k_swiglu<<<NV_MAXROWS, 256, 0, st>>>(w.gu, b_ug, w.tile_e, NV_PAD, w.act);
    k_sgemm<false><<<dim3(D / 64, NV_MAXROWS / 64, 1), 256, 0, st>>>(w.act, FF, w_dn, D, w.yy, D, NV_MAXROWS, D, FF, nullptr, w.tile_e, (size_t)FF * D, 0, 0, 0);
    k_final<<<S, 256, 0, st>>>(w.h1, g2, w.yy, w.pos, w.top_i, w.top_w, b_dn, norm_final, shf, scf, out);
}
}
extern "C" void kernel_launch(void* const* d_in, const int* in_sizes, int n_in, void* d_out, int out_size, void* d_ws, size_t ws_size, hipStream_t stream) {
    (void)in_sizes; (void)n_in; (void)out_size; (void)ws_size;
    nv::naive_forward(d_in, (float*)d_out, (char*)d_ws, stream);
}
```

```cpp
#include <hip/hip_runtime.h>
#include <hip/hip_bf16.h>
#include <cstdio>
#include <cstdint>
namespace pg8 {
#define PG8_LAS __attribute__((address_space(3)))
typedef unsigned short bf16_t;
typedef short bf16x8 __attribute__((ext_vector_type(8)));
typedef float f32x4 __attribute__((ext_vector_type(4)));
typedef unsigned u32x4 __attribute__((ext_vector_type(4)));
constexpr int BM = 256, BK = 64, HALF = 128, HTB = HALF * BK * 2  , STAGE_BYTES = 8 * HTB, NXCD = 8, WGM = 8;

__host__ __device__ __forceinline__ int lds_byte(int r, int c) { const int st = (r >> 4) * 2 + (c >> 5), rr = r & 15, cc = c & 31, ob = rr * 64 + cc * 2; return st * 1024 + (ob ^ (((ob >> 9) & 1) << 5)); }
__host__ __device__ __forceinline__ void stage_rc(int b, int& R, int& C) { const int st = b / 1024, sb = b % 1024, swz = sb ^ (((sb >> 9) & 1) << 5); R = (st >> 1) * 16 + swz / 64; C = (st & 1) * 32 + (swz % 64) / 2; }
__host__ __device__ __forceinline__ int perm32(int rho) { const int n = rho >> 4, i = rho & 15; return 8 * (i >> 2) + 4 * n + (i & 3); }

struct Unit { int pm, pn, pb, e; };
struct Gemm { const bf16_t* A; const bf16_t* Bt; int M, N, K; };

struct StaticOrder {
    int nM, nN, nwg, G, c;
    __host__ __device__ void init(int M, int N, int G_, int c_) { nM = M / BM; nN = N / BM; nwg = nM * nN; G = G_; c = c_; }
    __host__ __device__ bool next(int i, Unit& u) const {
        const long L = (long)i * G + c; if (L >= nwg) return false;
        int wgid = (int)L; { const int q = nwg / NXCD, r = nwg % NXCD, xcd = wgid % NXCD, off = wgid / NXCD; wgid = (xcd < r ? xcd * (q + 1) : r * (q + 1) + (xcd - r) * q) + off; }
        const int nig = WGM * nN, gid = wgid / nig, fm = gid * WGM, gsz = (nM - fm) < WGM ? (nM - fm) : WGM;
        u.pm = fm + ((wgid % nig) % gsz); u.pn = (wgid % nig) / gsz; u.pb = u.pn; u.e = 0; return true;
    }
    __device__ __forceinline__ void a_ready(const Unit&) const {}
    __device__ __forceinline__ void done(const Unit&) const {}
};

__device__ __forceinline__ unsigned cvt_pk_bf16(float lo, float hi) { unsigned r; asm volatile("v_cvt_pk_bf16_f32 %0, %1, %2" : "=v"(r) : "v"(lo), "v"(hi)); return r; }
template <class Epi, class Sched, bool ALIGN_EPI = false, bool SP2 = false>
__device__ __forceinline__ void gemm_phase(PG8_LAS unsigned char* lds, const Gemm g, const Sched& S, const Epi& E) {
    const int tid = threadIdx.x, wid = __builtin_amdgcn_readfirstlane(tid >> 6), lane = tid & 63, wr = wid >> 2, wc = wid & 3, fr = lane & 15, fq = lane >> 4;
    const int K = g.K, nt = K / BK;
    unsigned voffA[2], voffB[2];
#pragma unroll
    for (int i = 0; i < 2; ++i) { int R, C; stage_rc(tid * 16 + i * 8192, R, C); const int Rb = Epi::PERM ? ((R & ~31) + perm32(R & 31)) : R;
        voffA[i] = (unsigned)(R * K + C) * 2u; voffB[i] = (unsigned)(Rb * K + C) * 2u; }
    const size_t kstep = (size_t)(BK * 2);
    const size_t hstep = (size_t)HALF * K * 2;
    const size_t tstep = 2 * hstep;
    const unsigned ldsw = (unsigned)wid * 1024u;
    const int aoff = lds_byte(wr * 64 + fr, fq * 8), boff = lds_byte(wc * 32 + fr, fq * 8);
#define PG8_SA(b, h) (((b) * 2 + (h)) * HTB)
#define PG8_SB(b, h) ((4 + (b) * 2 + (h)) * HTB)
#define PG8_STAGE(bufoff, gbase, voff) do { _Pragma("unroll") for (int _i = 0; _i < 2; ++_i) \
        __builtin_amdgcn_global_load_lds((const unsigned*)((const char*)(gbase) + (voff)[_i]), (PG8_LAS unsigned*)(lds + (bufoff) + ldsw + _i * 8192), 16, 0, 0); } while (0)
#define PG8_LDA(dst, b, h) do { _Pragma("unroll") for (int m = 0; m < 4; ++m) _Pragma("unroll") for (int k = 0; k < 2; ++k) dst[m][k] = *(const PG8_LAS bf16x8*)(lds + PG8_SA(b, h) + aoff + m * 2048 + k * 1024); } while (0)
#define PG8_LDB(dst, b, h) do { _Pragma("unroll") for (int n = 0; n < 2; ++n) _Pragma("unroll") for (int k = 0; k < 2; ++k) dst[n][k] = *(const PG8_LAS bf16x8*)(lds + PG8_SB(b, h) + boff + n * 2048 + k * 1024); } while (0)
#define PG8_MMA(ai, bj, At, Bt) do { __builtin_amdgcn_s_setprio(1); _Pragma("unroll") for (int m = 0; m < 4; ++m) _Pragma("unroll") for (int n = 0; n < 2; ++n) _Pragma("unroll") for (int k = 0; k < 2; ++k) \
        acc[ai][bj][m][n] = __builtin_amdgcn_mfma_f32_16x16x32_bf16(Bt[n][k], At[m][k], acc[ai][bj][m][n], 0, 0, 0); __builtin_amdgcn_s_setprio(0); } while (0)
#define PG8_WAIT_V(n) asm volatile("s_waitcnt vmcnt(" #n ")" ::: "memory")
#define PG8_WAIT_L(n) asm volatile("s_waitcnt lgkmcnt(" #n ")" ::: "memory")
#define PG8_BAR __builtin_amdgcn_s_barrier()
#define PG8_SCHED __builtin_amdgcn_sched_barrier(0)
    Unit cur, nxt; int ui = 0;
    if (!S.next(0, cur)) return;
    f32x4 acc[2][2][4][2];
#pragma unroll
    for (int a = 0; a < 2; ++a)
#pragma unroll
        for (int b = 0; b < 2; ++b)
#pragma unroll
            for (int m = 0; m < 4; ++m)
#pragma unroll
                for (int n = 0; n < 2; ++n) acc[a][b][m][n] = (f32x4){0.f, 0.f, 0.f, 0.f};
    bf16x8 At[4][2], B0[2][2], B1[2][2];
    const char* cA = (const char*)g.A + (size_t)cur.pm * tstep; const char* cB = (const char*)g.Bt + (size_t)cur.pb * tstep;
    S.a_ready(cur);
    if constexpr (SP2) {
        PG8_STAGE(PG8_SB(0, 0), cB, voffB); PG8_STAGE(PG8_SB(0, 1), cB + hstep, voffB); PG8_STAGE(PG8_SA(0, 0), cA, voffA); PG8_STAGE(PG8_SA(0, 1), cA + hstep, voffA);
        if (wr == 1) PG8_BAR;
        PG8_WAIT_V(2); PG8_BAR;
        PG8_STAGE(PG8_SB(1, 0), cB + kstep, voffB); PG8_STAGE(PG8_SA(1, 0), cA + kstep, voffA); PG8_STAGE(PG8_SB(1, 1), cB + hstep + kstep, voffB);
        PG8_WAIT_V(6); PG8_BAR;
    } else {
        PG8_STAGE(PG8_SB(0, 0), cB, voffB); PG8_STAGE(PG8_SA(0, 0), cA, voffA); PG8_STAGE(PG8_SB(0, 1), cB + hstep, voffB); PG8_STAGE(PG8_SA(0, 1), cA + hstep, voffA);
        if (wr == 1) PG8_BAR;
        PG8_WAIT_V(4); PG8_BAR;
        PG8_STAGE(PG8_SB(1, 0), cB + kstep, voffB); PG8_STAGE(PG8_SA(1, 0), cA + kstep, voffA); PG8_STAGE(PG8_SB(1, 1), cB + hstep + kstep, voffB);
        PG8_WAIT_V(6); PG8_BAR;
    }
    for (;;) {
        const bool has_next = S.next(ui + 1, nxt);
        const char* nA = has_next ? (const char*)g.A + (size_t)nxt.pm * tstep : cA; const char* nB = has_next ? (const char*)g.Bt + (size_t)nxt.pb * tstep : cB;
        for (int t = 0; t < nt; t += 2) {
            const bool last = (t == nt - 2);
            const char* a1 = cA + (size_t)(t + 1) * kstep;
            const char* a2 = last ? nA : cA + (size_t)(t + 2) * kstep; const char* b2 = last ? nB : cB + (size_t)(t + 2) * kstep;
            const char* a3 = a2 + kstep; const char* b3 = b2 + kstep;
            if (last && has_next) S.a_ready(nxt);
            if constexpr (SP2) {
            PG8_LDB(B0, 0, 0); PG8_LDB(B1, 0, 1); PG8_SCHED; PG8_LDA(At, 0, 0); PG8_STAGE(PG8_SA(1, 1), a1 + hstep, voffA);
            PG8_WAIT_V(8); PG8_WAIT_L(0); PG8_BAR; PG8_MMA(0, 0, At, B0); PG8_MMA(0, 1, At, B1); PG8_BAR; PG8_SCHED;
            PG8_LDA(At, 0, 1); PG8_STAGE(PG8_SB(0, 0), b2, voffB); PG8_STAGE(PG8_SB(0, 1), b2 + hstep, voffB); PG8_STAGE(PG8_SA(0, 0), a2, voffA);
            PG8_WAIT_V(8); PG8_WAIT_L(0); PG8_BAR; PG8_MMA(1, 0, At, B0); PG8_MMA(1, 1, At, B1); PG8_BAR; PG8_SCHED;
            PG8_LDB(B0, 1, 0); PG8_LDB(B1, 1, 1); PG8_SCHED; PG8_LDA(At, 1, 0); PG8_STAGE(PG8_SA(0, 1), a2 + hstep, voffA);
            PG8_WAIT_V(8); PG8_WAIT_L(0); PG8_BAR; PG8_MMA(0, 0, At, B0); PG8_MMA(0, 1, At, B1); PG8_BAR; PG8_SCHED;
            PG8_LDA(At, 1, 1); PG8_STAGE(PG8_SB(1, 0), b3, voffB); PG8_STAGE(PG8_SB(1, 1), b3 + hstep, voffB); PG8_STAGE(PG8_SA(1, 0), a3, voffA);
            PG8_WAIT_V(8); PG8_WAIT_L(0); PG8_BAR; PG8_MMA(1, 0, At, B0); PG8_MMA(1, 1, At, B1); PG8_BAR; PG8_SCHED;
            } else {
            PG8_LDB(B0, 0, 0); PG8_SCHED; PG8_LDA(At, 0, 0); PG8_STAGE(PG8_SA(1, 1), a1 + hstep, voffA);
            PG8_WAIT_L(8); PG8_BAR; PG8_WAIT_L(0); PG8_MMA(0, 0, At, B0); PG8_BAR; PG8_SCHED;
            PG8_LDB(B1, 0, 1); PG8_STAGE(PG8_SB(0, 0), b2, voffB);
            PG8_BAR; PG8_WAIT_L(0); PG8_MMA(0, 1, At, B1); PG8_BAR;
            PG8_LDA(At, 0, 1); PG8_STAGE(PG8_SA(0, 0), a2, voffA);
            PG8_BAR; PG8_WAIT_L(0); PG8_MMA(1, 0, At, B0); PG8_BAR; PG8_SCHED;
            PG8_STAGE(PG8_SB(0, 1), b2 + hstep, voffB);
            PG8_WAIT_V(6); PG8_BAR; PG8_MMA(1, 1, At, B1); PG8_BAR;
            PG8_LDB(B0, 1, 0); PG8_SCHED; PG8_LDA(At, 1, 0); PG8_STAGE(PG8_SA(0, 1), a2 + hstep, voffA);
            PG8_WAIT_L(8); PG8_BAR; PG8_WAIT_L(0); PG8_MMA(0, 0, At, B0); PG8_BAR; PG8_SCHED;
            PG8_LDB(B1, 1, 1); PG8_STAGE(PG8_SB(1, 0), b3, voffB);
            PG8_BAR; PG8_WAIT_L(0); PG8_MMA(0, 1, At, B1); PG8_BAR;
            PG8_LDA(At, 1, 1); PG8_STAGE(PG8_SA(1, 0), a3, voffA);
            PG8_BAR; PG8_WAIT_L(0); PG8_MMA(1, 0, At, B0); PG8_BAR; PG8_SCHED;
            PG8_STAGE(PG8_SB(1, 1), b3 + hstep, voffB);
            PG8_WAIT_V(6); PG8_BAR; PG8_MMA(1, 1, At, B1); PG8_BAR;
            }
        }
        if constexpr (ALIGN_EPI) { if (wr == 0) PG8_BAR; }
        if constexpr (!Epi::AFTER_DRAIN) { E(acc, cur, wr, wc, fr, fq); S.done(cur); }
        if (!has_next) break;
#pragma unroll
        for (int a = 0; a < 2; ++a)
#pragma unroll
            for (int b = 0; b < 2; ++b)
#pragma unroll
                for (int m = 0; m < 4; ++m)
#pragma unroll
                    for (int n = 0; n < 2; ++n) acc[a][b][m][n] = (f32x4){0.f, 0.f, 0.f, 0.f};
        cur = nxt; cA = nA; cB = nB; ++ui;
        if constexpr (ALIGN_EPI) { if (wr == 1) PG8_BAR; }
    }
    PG8_WAIT_V(0);
    if constexpr (!ALIGN_EPI) { if (wr == 0) PG8_BAR; }
    PG8_BAR;
    if constexpr (Epi::AFTER_DRAIN) { E.fused(acc, cur, wr, wc, fr, fq, lds, wid, lane); S.done(cur); }
#undef PG8_SA
#undef PG8_SB
#undef PG8_STAGE
#undef PG8_LDA
#undef PG8_LDB
#undef PG8_MMA
#undef PG8_WAIT_V
#undef PG8_WAIT_L
#undef PG8_BAR
#undef PG8_SCHED
}
}
#define GAS __attribute__((address_space(1)))
#define LAS __attribute__((address_space(3)))
typedef unsigned short bf16;
typedef unsigned v4u __attribute__((ext_vector_type(4)));
typedef float f32x4 __attribute__((ext_vector_type(4)));
typedef short bf16x8 __attribute__((ext_vector_type(8)));
typedef GAS unsigned gu32;
typedef GAS unsigned long long gu64;
#define RLX_AGENT __ATOMIC_RELAXED, __HIP_MEMORY_SCOPE_AGENT
#define LDS_WAIT() asm volatile("s_waitcnt lgkmcnt(0)" ::: "memory")
#define VM_WAIT() asm volatile("s_waitcnt vmcnt(0)" ::: "memory")
__device__ __forceinline__ unsigned long long rt() { return __builtin_amdgcn_s_memrealtime(); }
__device__ __forceinline__ unsigned f2bf(float f) { unsigned u = __builtin_bit_cast(unsigned, f); return (u + 0x7fffu + ((u >> 16) & 1u)) >> 16; }
__device__ __forceinline__ unsigned pk2(float lo, float hi) { return f2bf(lo) | (f2bf(hi) << 16); }

#define XB_TMO      128
#define XB_XCNT(j)  (256  + 64 * (j))
#define XB_XSUB(j)  (1280 + 64 * (j))
#define XB_XGEN(j)  (2304 + 64 * (j))
#define XB_TOP      3328
#define XB_TOPGEN   3392
#define XCD_BAR_WORDS 3456
#define XB_SPIN_CAP (1u << 18)

__device__ __forceinline__ unsigned xb_ld(unsigned* p)              { return __hip_atomic_load(p, __ATOMIC_RELAXED, __HIP_MEMORY_SCOPE_AGENT); }
__device__ __forceinline__ unsigned xb_add(unsigned* p, unsigned v) { return __hip_atomic_fetch_add(p, v, __ATOMIC_RELAXED, __HIP_MEMORY_SCOPE_AGENT); }
__device__ __forceinline__ unsigned xb_xcc_id() { return (unsigned)__builtin_amdgcn_s_getreg((3 << 11) | 20) & 0xFu; }
#define XB_SPIN(cond, bar) do { unsigned _sp = 0; while (cond) { __builtin_amdgcn_s_sleep(1); \
    if ((++_sp & 255u) == 0u) { if (xb_ld(&(bar)[XB_TMO])) break; if (_sp > XB_SPIN_CAP) { atomicAdd(&(bar)[XB_TMO], 1u); break; } } } } while (0)

struct XcdBarrier {
    unsigned* bar; unsigned x;
    volatile LAS unsigned* st;
};

__device__ __forceinline__ XcdBarrier xcd_barrier_post(unsigned* bar, volatile LAS unsigned* st) {
    XcdBarrier b; b.bar = bar; b.x = xb_xcc_id(); b.st = st;
    if (threadIdx.x == 0) (void)xb_add(&bar[XB_XCNT(b.x)], 1u);
    return b;
}
__device__ __forceinline__ void xcd_barrier_complete(unsigned* bar, unsigned x, unsigned& nloc, unsigned& nx) {
    const unsigned G = gridDim.x * gridDim.y * gridDim.z;
    unsigned sum, cnt, mine, sp = 0u;
    for (;;) {
        sum = 0u; cnt = 0u; mine = 0u;
#pragma unroll
        for (unsigned j = 0; j < 16; ++j) { const unsigned c = xb_ld(&bar[XB_XCNT(j)]); sum += c; cnt += (c > 0u) ? 1u : 0u; mine = (j == x) ? c : mine; }
        if (sum == G) break;
        __builtin_amdgcn_s_sleep(1);
        if ((++sp & 255u) == 0u) { if (xb_ld(&bar[XB_TMO])) break; if (sp > XB_SPIN_CAP) { atomicAdd(&bar[XB_TMO], 1u); break; } }
    }
    nloc = mine > 0u ? mine : 1u; nx = cnt > 0u ? cnt : 1u;
}

__device__ __forceinline__ void xcd_barrier(const XcdBarrier& b) {
    asm volatile("s_waitcnt vmcnt(0)" ::: "memory");
    __syncthreads();
    if (threadIdx.x == 0) {
        unsigned* bar = b.bar;
        __builtin_amdgcn_s_waitcnt(0);
        unsigned nloc = b.st[0], nx = b.st[1];
        if (nloc == 0u) { xcd_barrier_complete(bar, b.x, nloc, nx); b.st[0] = nloc; b.st[1] = nx; }
        const unsigned old = xb_add(&bar[XB_XSUB(b.x)], 1u);
        const unsigned gen = old / nloc;
        if (old + 1u == (gen + 1u) * nloc) {
            __builtin_amdgcn_fence(__ATOMIC_RELEASE, "agent");
            asm volatile("s_waitcnt vmcnt(0)" ::: "memory");
            const unsigned og = xb_add(&bar[XB_TOP], 1u);
            const unsigned tg = og / nx;
            if (og + 1u == (tg + 1u) * nx) xb_add(&bar[XB_TOPGEN], 1u);
            else XB_SPIN(xb_ld(&bar[XB_TOPGEN]) == tg, bar);
            __builtin_amdgcn_fence(__ATOMIC_ACQUIRE, "agent");
            xb_add(&bar[XB_XGEN(b.x)], 1u);
            asm volatile("s_waitcnt vmcnt(0)" ::: "memory");
        } else {
            XB_SPIN(xb_ld(&bar[XB_XGEN(b.x)]) == gen, bar);
            __builtin_amdgcn_fence(__ATOMIC_ACQUIRE, "agent");
            asm volatile("s_waitcnt vmcnt(0)" ::: "memory");
        }
    }
    __syncthreads();
}
namespace mk {
constexpr int S = 8192, D = 2048, NPROJ = 6160, NPP = 6144, NPAD = 6400, NE = 32, FF = 2048, NWAVES = 8, NTHR = 512;
constexpr int C_MQ = 0, C_MK = 512, C_MV = 1024, C_MO = 2048, C_FQ = 3072, C_FK = 4096, C_FV = 5120;
constexpr int MAXROWS = S * 4 + NE * 256;
constexpr int NCH = 128, LCH = 64;
constexpr size_t MiB = 1u << 20;
constexpr size_t WS_CTL = 0, CTL_ZERO_BYTES = 1 * MiB;
constexpr size_t WS_MODP = 1 * MiB;
constexpr size_t WS_MOD = 2 * MiB;
constexpr size_t WS_GATES = 3 * MiB;
constexpr size_t WS_F = 4 * MiB;
constexpr size_t WS_NL = 5 * MiB;
constexpr size_t WS_NS = 6 * MiB;
constexpr size_t WS_GLAL = 7 * MiB;
constexpr size_t WS_MS = 7 * MiB + 65536;
constexpr size_t WS_TOPI = 8 * MiB;
constexpr size_t WS_TOPW = 9 * MiB;
constexpr size_t WS_HIST = 10 * MiB;
constexpr size_t WS_LRANK = 11 * MiB;
constexpr size_t WS_POS = 12 * MiB;
constexpr size_t WS_ROWW = 13 * MiB;
constexpr size_t WS_WIN = 16 * MiB;
constexpr size_t WS_WOUT = 42 * MiB;
constexpr size_t WS_HN = 50 * MiB;
constexpr size_t WS_PROJ = 82 * MiB;
constexpr size_t WS_UL = 178 * MiB;
constexpr size_t WS_CS = 242 * MiB;
constexpr size_t WS_CONCAT = 274 * MiB;
constexpr size_t WS_H1 = 306 * MiB;
constexpr size_t WS_XG = 370 * MiB;
constexpr size_t WS_ACT = 530 * MiB;
constexpr size_t WS_Y = 690 * MiB;
constexpr size_t WS_WUG = 850 * MiB;
constexpr size_t WS_WD = 1362 * MiB;
constexpr size_t WS_END = 1618 * MiB;
constexpr size_t WS_NAIVE = 1620 * MiB;
constexpr int CW_TMO = 0, CW_CODE = 1, CW_BAR = 4096;
constexpr int RING_OFF = 0, RING_BYTES = 131072;
constexpr int LDSCTL_OFF = RING_BYTES, MISC_OFF = LDSCTL_OFF + 320;
constexpr int TAB_OFF = LDSCTL_OFF + 1024;
constexpr int LDS_BYTES = 147456;
}
namespace mk {
typedef float f32x2 __attribute__((ext_vector_type(2)));
typedef unsigned u32x2 __attribute__((ext_vector_type(2)));
typedef float f32x16 __attribute__((ext_vector_type(16)));
struct Frame {
    LAS unsigned char* lds;
    volatile LAS unsigned* MISC;
    gu32* ctl;
    int tid, lane, wave, vcu, G;
    const float* in[24];
    float* out; unsigned char* ws;
};
#define IN_X 0
#define IN_C 1
#define IN_WADA 2
#define IN_BADA 3
#define IN_NMIX 4
#define IN_WIN 5
#define IN_BI 6
#define IN_BF 7
#define IN_FOXBF 8
#define IN_FOXQN 9
#define IN_FOXKN 10
#define IN_MOUTN 11
#define IN_FOUTN 12
#define IN_WOUT 13
#define IN_NFFN 14
#define IN_WR 15
#define IN_BR 16
#define IN_WUG 17
#define IN_BUG 18
#define IN_WD 19
#define IN_BD 20
#define IN_WAF 21
#define IN_BAF 22
#define IN_NFIN 23
template <class T> __device__ __forceinline__ T* wsp(const Frame& F, size_t off) { return (T*)(F.ws + off); }
__device__ __forceinline__ float wave_sum(float v) {
#pragma unroll
    for (int o = 1; o < 64; o <<= 1) v += __shfl_xor(v, o);
    return v;
}
__device__ __forceinline__ float sigmoid_f(float v) { return 1.f / (1.f + __expf(-v)); }
__device__ __forceinline__ float log_sigmoid_f(float v) { return fminf(v, 0.f) - log1pf(__expf(-fabsf(v))); }
__device__ __forceinline__ float softcap_f(float v) { return 15.f * tanhf(v * (1.f / 15.f)); }
__device__ __forceinline__ float bf2f(unsigned short b) { return __uint_as_float(((unsigned)b) << 16); }

__device__ __forceinline__ void p0_transpose_item(const float* W, int ldw, int K, bf16* WT, int drow0, int scol0, int k0, LAS float* scr, int lane) {
#pragma unroll 8
    for (int i = 0; i < 32; ++i) { const int kk = 2 * i + (lane >> 5); scr[kk * 33 + (lane & 31)] = W[(size_t)(k0 + kk) * ldw + scol0 + (lane & 31)]; }
    LDS_WAIT(); asm volatile("" ::: "memory");
    const int c = lane & 7;
#pragma unroll
    for (int j = 0; j < 4; ++j) { const int n = (lane >> 3) + 8 * j; const LAS float* s = scr + (8 * c) * 33 + n;
        v4u o; o.x = pk2(s[0 * 33], s[1 * 33]); o.y = pk2(s[2 * 33], s[3 * 33]); o.z = pk2(s[4 * 33], s[5 * 33]); o.w = pk2(s[6 * 33], s[7 * 33]);
        *(GAS v4u*)(WT + (size_t)(drow0 + n) * K + k0 + 8 * c) = o; }
    LDS_WAIT(); asm volatile("" ::: "memory");
}
__device__ __forceinline__ void p0_prologue(Frame& F) {
    LAS float* scr = (LAS float*)(F.lds + RING_OFF + F.wave * 16384);
    const int gw = F.vcu * NWAVES + F.wave, NGW = F.G * NWAVES, lane = F.lane;
    {
        const float* c = F.in[IN_C]; float* modp = wsp<float>(F, WS_MODP);
        for (int task = gw; task < 4096; task += NGW) {
            const int cg = task & 255, ks = task >> 8, j = cg * 64 + lane;
            const float* w; int ld, col;
            if (j < 6 * D) { w = F.in[IN_WADA]; ld = 6 * D; col = j; } else { w = F.in[IN_WAF]; ld = 2 * D; col = j - 6 * D; }
            const float c0 = c[ks * 128 + lane], c1 = c[ks * 128 + 64 + lane];
            const float s0 = c0 * sigmoid_f(c0), s1 = c1 * sigmoid_f(c1);
            const float* wp = w + (size_t)(ks * 128) * ld + col; float acc = 0.f;
#pragma unroll 16
            for (int i = 0; i < 64; ++i) acc += __builtin_bit_cast(float, __builtin_amdgcn_readlane(__builtin_bit_cast(int, s0), i)) * wp[(size_t)i * ld];
#pragma unroll 16
            for (int i = 0; i < 64; ++i) acc += __builtin_bit_cast(float, __builtin_amdgcn_readlane(__builtin_bit_cast(int, s1), i)) * wp[(size_t)(64 + i) * ld];
            modp[ks * 16384 + j] = acc;
        }
    }
    bf16* win_t = wsp<bf16>(F, WS_WIN); bf16* wout_t = wsp<bf16>(F, WS_WOUT); bf16* wug_t = wsp<bf16>(F, WS_WUG); bf16* wd_t = wsp<bf16>(F, WS_WD);
    {
        constexpr int NB = NPP / 32, NIT = (D / 64) * NB;
        for (int it = gw; it < NIT; it += NGW) { const int kb = it / NB, nb = it % NB, n0 = nb * 32;
            p0_transpose_item(F.in[IN_WIN], NPROJ, D, win_t, n0, n0 < 3072 ? n0 : n0 + 8, kb * 64, scr, lane); }
        for (int it = gw; it < D / 4; it += NGW) {
            const int col = lane & 15, k = 4 * it + (lane >> 4), sc = col < 8 ? 3072 + col : 6152 + (col - 8);
            win_t[(size_t)(NPP + col) * D + k] = (bf16)f2bf(F.in[IN_WIN][(size_t)k * NPROJ + sc]); }
        const v4u z = {0u, 0u, 0u, 0u};
        for (int i = gw * 64 + lane; i < (NPAD - NPROJ) * D / 8; i += NGW * 64) *(GAS v4u*)(win_t + (size_t)NPROJ * D + (size_t)i * 8) = z;
    }
    {   constexpr int NB = D / 32, NIT = (D / 64) * NB;
        for (int it = gw; it < NIT; it += NGW) { const int kb = it / NB, nb = it % NB; p0_transpose_item(F.in[IN_WOUT], D, D, wout_t, nb * 32, nb * 32, kb * 64, scr, lane); } }
    {
        constexpr int NB = 4096 / 32, PER_E = (D / 64) * NB;
        for (int it = gw; it < NE * PER_E; it += NGW) { const int e = it / PER_E, r = it % PER_E, kb = r / NB, nb = r % NB, d0 = nb * 32, j = d0 >> 8, wv = d0 & 255;
            const int sc = wv < 128 ? 128 * j + wv : 2048 + 128 * j + (wv - 128);
            p0_transpose_item(F.in[IN_WUG] + (size_t)e * D * 4096, 4096, D, wug_t + (size_t)e * 4096 * D, d0, sc, kb * 64, scr, lane); } }
    {   constexpr int NB = D / 32, PER_E = (FF / 64) * NB;
        for (int it = gw; it < NE * PER_E; it += NGW) { const int e = it / PER_E, r = it % PER_E, kb = r / NB, nb = r % NB;
            p0_transpose_item(F.in[IN_WD] + (size_t)e * FF * D, D, FF, wd_t + (size_t)e * D * FF, nb * 32, nb * 32, kb * 64, scr, lane); } }
}
__device__ __forceinline__ void mod_reduce_lds(Frame& F, int j0, int n, LAS float* dst) {
    const float* modp = wsp<float>(F, WS_MODP);
    for (int i = F.tid; i < n; i += NTHR) { const int j = j0 + i; float a = j < 6 * D ? F.in[IN_BADA][j] : F.in[IN_BAF][j - 6 * D];
#pragma unroll
        for (int ks = 0; ks < 16; ++ks) a += modp[ks * 16384 + j];
        dst[i] = a; }
}
__device__ __forceinline__ void modulate_row_bf16(const float* xrow, const float* g, const LAS float* sh, const LAS float* sc, bf16* orow, int lane) {
    const GAS f32x4* xr = (const GAS f32x4*)xrow + lane; f32x4 v[8]; float s2 = 0.f;
#pragma unroll
    for (int j = 0; j < 8; ++j) { v[j] = xr[64 * j]; s2 += (v[j].x * v[j].x + v[j].y * v[j].y) + (v[j].z * v[j].z + v[j].w * v[j].w); }
    const float r = rsqrtf(wave_sum(s2) * (1.f / D) + 1e-6f);
    GAS u32x2* o8 = (GAS u32x2*)orow + lane;
#pragma unroll
    for (int j = 0; j < 8; ++j) { const int c0 = 4 * lane + 256 * j; const f32x4 gg = *(const GAS f32x4*)(g + c0); const f32x4 a = *(const LAS f32x4*)(sc + c0), b = *(const LAS f32x4*)(sh + c0);
        const f32x4 y = v[j] * r * gg * (a + 1.f) + b; u32x2 w; w.x = pk2(y.x, y.y); w.y = pk2(y.z, y.w); o8[64 * j] = w; }
}
__device__ __forceinline__ void p1_modulate(Frame& F) {
    LAS float* shs = (LAS float*)(F.lds + RING_OFF);
    mod_reduce_lds(F, 0, 2 * D, shs);
    if (blockIdx.x == 0) {
        const float* modp = wsp<float>(F, WS_MODP); float* mod = wsp<float>(F, WS_MOD);
        for (int j = F.tid; j < 16384; j += NTHR) { float a = j < 6 * D ? F.in[IN_BADA][j] : F.in[IN_BAF][j - 6 * D];
#pragma unroll
            for (int ks = 0; ks < 16; ++ks) a += modp[ks * 16384 + j];
            mod[j] = a; }
    }
    __syncthreads();
    const int gw = F.vcu * NWAVES + F.wave, NGW = F.G * NWAVES; bf16* hn = wsp<bf16>(F, WS_HN);
    for (int m = gw; m < S; m += NGW) modulate_row_bf16(F.in[IN_X] + (size_t)m * D, F.in[IN_NMIX], shs, shs + D, hn + (size_t)m * D, F.lane);
    __syncthreads();
}
using pg8::Unit; using pg8::cvt_pk_bf16;
struct EpiProj {
    static constexpr bool PERM = true, AFTER_DRAIN = false;
    bf16* O; float* gates;
    __device__ __forceinline__ void operator()(const pg8::f32x4 (&acc)[2][2][4][2], const Unit& u, int wr, int wc, int fr, int fq) const {
        const int row0 = u.pm * 256 + wr * 64 + fr;
        if (u.pn < 24) {
            const int col0 = u.pn * 256 + wc * 32 + 8 * fq;
#pragma unroll
            for (int ai = 0; ai < 2; ++ai)
#pragma unroll
                for (int m = 0; m < 4; ++m) { bf16* rowp = O + (size_t)(row0 + ai * 128 + m * 16) * NPP + col0;
#pragma unroll
                    for (int bj = 0; bj < 2; ++bj) { const pg8::f32x4 v0 = acc[ai][bj][m][0], v1 = acc[ai][bj][m][1];
                        pg8::u32x4 w; w.x = cvt_pk_bf16(v0[0], v0[1]); w.y = cvt_pk_bf16(v0[2], v0[3]); w.z = cvt_pk_bf16(v1[0], v1[1]); w.w = cvt_pk_bf16(v1[2], v1[3]);
                        *(pg8::u32x4*)(rowp + bj * 128) = w; } }
        } else if (wc == 0 && fq < 2) {
#pragma unroll
            for (int ai = 0; ai < 2; ++ai)
#pragma unroll
                for (int m = 0; m < 4; ++m) { float* gp = gates + (size_t)(row0 + ai * 128 + m * 16) * 16 + 8 * fq;
                    *(pg8::f32x4*)gp = acc[ai][0][m][0]; *(pg8::f32x4*)(gp + 4) = acc[ai][0][m][1]; }
        }
    }
};
struct EpiOut {
    static constexpr bool PERM = false, AFTER_DRAIN = false;
    const float* x; const float* g1; float* h1;
    __device__ __forceinline__ void operator()(const pg8::f32x4 (&acc)[2][2][4][2], const Unit& u, int wr, int wc, int fr, int fq) const {
        const int row0 = u.pm * 256 + wr * 64 + fr, col0 = u.pn * 256 + wc * 32 + 4 * fq;
        pg8::f32x4 gv[2][2];
#pragma unroll
        for (int bj = 0; bj < 2; ++bj)
#pragma unroll
            for (int n = 0; n < 2; ++n) gv[bj][n] = *(const pg8::f32x4*)(g1 + col0 + bj * 128 + n * 16);
#pragma unroll
        for (int ai = 0; ai < 2; ++ai)
#pragma unroll
            for (int m = 0; m < 4; ++m) { const size_t off = (size_t)(row0 + ai * 128 + m * 16) * D + col0;
#pragma unroll
                for (int bj = 0; bj < 2; ++bj)
#pragma unroll
                    for (int n = 0; n < 2; ++n) { const pg8::f32x4 xv = *(const pg8::f32x4*)(x + off + bj * 128 + n * 16);
                        *(pg8::f32x4*)(h1 + off + bj * 128 + n * 16) = xv + gv[bj][n] * acc[ai][bj][m][n]; } }
    }
};
}
namespace fox {
constexpr int D = 128, SQ = 8192, SKV = 8192; constexpr float THR = 8.f; constexpr bool WSKIP = false;
constexpr int PITCH = 6144;
constexpr int OPITCH = 2048;
constexpr float SCALE = 0.08838834764831845f;
constexpr int NW = 8, QBLK = 32, KVBLK = 64, QB = NW * QBLK;
constexpr int SHM_V = KVBLK * D * 2, SHM_K = KVBLK * D * 2;
constexpr int LDS_BIAS = 2 * SHM_V + 2 * SHM_K + NW * 64 * 4;
constexpr int LDS_BYTES = LDS_BIAS + 512;

using bf16 = __hip_bfloat16;
typedef short bf16x8 __attribute__((ext_vector_type(8)));
typedef short s16x4 __attribute__((ext_vector_type(4)));
typedef float f32x16 __attribute__((ext_vector_type(16)));
typedef float f32x4 __attribute__((ext_vector_type(4)));
typedef unsigned u32x4 __attribute__((ext_vector_type(4)));
template <class A, class Bt> struct same_t { static constexpr bool v = false; };
template <class A> struct same_t<A, A> { static constexpr bool v = true; };

#define KSWZ(row, colB) ((row) * 256 + ((colB) ^ (((row) & 7) << 4)))
#define SBAR() __builtin_amdgcn_sched_barrier(0)
__device__ __forceinline__ int v_st(int k, int c) { const int kk = (k & ~0xC) | ((k & 4) << 1) | ((k & 8) >> 1); return ((kk >> 3) * 4 + (c >> 5)) * 512 + ((kk & 7) * 32 + (c & 31)) * 2; }
__device__ __forceinline__ int v_rd_base(int lane) { return ((lane & 3) << 3) | (((lane >> 2) & 3) << 6) | (((lane >> 4) & 1) << 5) | (((lane >> 5) & 1) << 8); }
constexpr int v_rd_off(int d0, int ks, int half) { return d0 * 512 + ks * 4096 + half * 2048; }
__device__ __forceinline__ int crow(int r, int hi) { return (r & 3) + 8 * (r >> 2) + 4 * hi; }
__device__ __forceinline__ int bias_slot(int kk) { return ((kk >> 2) & 1) * 32 + (kk >> 5) * 16 + (kk & 3) + 4 * ((kk & 31) >> 3); }
__device__ __forceinline__ unsigned cvtpk(float lo, float hi) {
    unsigned r; asm volatile("v_cvt_pk_bf16_f32 %0, %1, %2" : "=v"(r) : "v"(lo), "v"(hi)); return r;
}
__device__ __forceinline__ bf16x8 pack8(f32x4 a, f32x4 b) {
    u32x4 w = {cvtpk(a[0], a[1]), cvtpk(a[2], a[3]), cvtpk(b[0], b[1]), cvtpk(b[2], b[3])};
    return *reinterpret_cast<bf16x8*>(&w);
}
template <class T> __device__ __forceinline__ bf16x8 load8(const T* p) {
    if constexpr (same_t<T, float>::v) { return pack8(*(const f32x4*)p, *(const f32x4*)(p + 4)); }
    else { return *reinterpret_cast<const bf16x8*>(p); }
}
__device__ __forceinline__ void mask_tile(f32x16& p0, f32x16& p1, int dq, unsigned W) {
    const float NEG = -__builtin_inff();
#pragma unroll
    for (int r = 0; r < 16; ++r) {
        const int c = (r & 3) + 8 * (r >> 2);
        if ((unsigned)(dq - c) >= W) p0[r] = NEG;
        if ((unsigned)(dq - c - 32) >= W) p1[r] = NEG;
    }
}
__device__ __forceinline__ void partialSM(f32x16& p0, f32x16& p1, float& m_reg, float& mn, float& alpha) {
    float pmax = p0[0]; for (int r = 1; r < 16; ++r) pmax = fmaxf(pmax, p0[r]); for (int r = 0; r < 16; ++r) pmax = fmaxf(pmax, p1[r]);
    { auto rr = __builtin_amdgcn_permlane32_swap(__float_as_uint(pmax), __float_as_uint(pmax), false, false);
      pmax = fmaxf(__uint_as_float(rr[0]), __uint_as_float(rr[1])); }
    constexpr float C2 = 1.4426950408889634f * SCALE;
    if (__builtin_expect(__all((pmax - m_reg) * SCALE <= THR), 1)) { mn = m_reg; alpha = 1.f; }
    else { mn = fmaxf(m_reg, pmax); alpha = __builtin_amdgcn_exp2f((m_reg - mn) * C2); m_reg = mn; }
    const float mnL = -mn * C2;
    for (int r = 0; r < 16; ++r) p0[r] = fmaf(p0[r], C2, mnL); for (int r = 0; r < 16; ++r) p1[r] = fmaf(p1[r], C2, mnL);
    for (int r = 0; r < 16; ++r) p0[r] = __builtin_amdgcn_exp2f(p0[r]);
}
__device__ __forceinline__ void finishSM(f32x16& p0, f32x16& p1, float alpha, float& l_reg, bf16x8& pa0, bf16x8& pa1, bf16x8& pa2, bf16x8& pa3) {
    for (int r = 0; r < 16; ++r) p1[r] = __builtin_amdgcn_exp2f(p1[r]);
    float ps = 0; for (int r = 0; r < 16; ++r) ps += p0[r]; for (int r = 0; r < 16; ++r) ps += p1[r];
    { auto rr = __builtin_amdgcn_permlane32_swap(__float_as_uint(ps), __float_as_uint(ps), false, false);
      ps = __uint_as_float(rr[0]) + __uint_as_float(rr[1]); }
    l_reg = l_reg * alpha + ps;
#define PK4(P, B_, OUT) do { unsigned a0 = cvtpk(P[B_+0], P[B_+1]), a1 = cvtpk(P[B_+2], P[B_+3]);                          \
        unsigned b0 = cvtpk(P[B_+4], P[B_+5]), b1 = cvtpk(P[B_+6], P[B_+7]);                                             \
        auto r0 = __builtin_amdgcn_permlane32_swap(a0, b0, false, false); auto r1 = __builtin_amdgcn_permlane32_swap(a1, b1, false, false); \
        u32x4 w = {r0[0], r1[0], r0[1], r1[1]}; OUT = *reinterpret_cast<bf16x8*>(&w); } while (0)
    PK4(p0, 0, pa0); PK4(p0, 8, pa1); PK4(p1, 0, pa2); PK4(p1, 8, pa3);
#undef PK4
}
template <int KB, bool SK>
__device__ __forceinline__ void qkt(f32x16& p0, f32x16& p1, const char* K_lds, int r32, int hi, const bf16x8* qr, bool act) {
    if (SK && !act) { const float NEG = -__builtin_inff();
#pragma unroll
        for (int r = 0; r < 16; ++r) { p0[r] = NEG; p1[r] = NEG; } return; }
    { const f32x16* bp = reinterpret_cast<const f32x16*>(K_lds - 2 * SHM_V + LDS_BIAS + KB * 256 + hi * 128); p0 = bp[0]; p1 = bp[1]; }
    const char* kb[4];
#pragma unroll
    for (int dd = 0; dd < 4; ++dd) kb[dd] = K_lds + KB * SHM_K + KSWZ(r32, (dd * 16 + hi * 8) * 2);
#pragma unroll
    for (int d0 = 0; d0 < 8; ++d0) { const char* a = kb[d0 & 3] + (d0 >> 2) * 128;
        bf16x8 b0 = *reinterpret_cast<const bf16x8*>(a);
        bf16x8 b1 = *reinterpret_cast<const bf16x8*>(a + 32 * 256);
        p0 = __builtin_amdgcn_mfma_f32_32x32x16_bf16(b0, qr[d0], p0, 0, 0, 0);
        p1 = __builtin_amdgcn_mfma_f32_32x32x16_bf16(b1, qr[d0], p1, 0, 0, 0); }
}
template <int VB, bool SK>
__device__ __forceinline__ void pv_tile(f32x16* o, int vb0, bf16x8 pa0, bf16x8 pa1, bf16x8 pa2, bf16x8 pa3, bool act) {
    if (SK && !act) return;
#define TRRD(dst, off) asm volatile("ds_read_b64_tr_b16 %0, %1 offset:%2" : "=&v"(dst) : "v"(vb0), "i"(off) : "memory")
#define PV_D0(d0) do { s16x4 l0, l1, l2, l3, h0, h1, h2, h3; constexpr int b_ = VB * SHM_V + v_rd_off(d0, 0, 0);     \
        TRRD(l0, b_); TRRD(h0, b_ + 2048); TRRD(l1, b_ + 4096); TRRD(h1, b_ + 6144); TRRD(l2, b_ + 8192); TRRD(h2, b_ + 10240); TRRD(l3, b_ + 12288); TRRD(h3, b_ + 14336); \
        asm volatile("s_waitcnt lgkmcnt(0)" ::: "memory"); SBAR();                 \
        o[d0] = __builtin_amdgcn_mfma_f32_32x32x16_bf16(pa0, (bf16x8){l0[0], l0[1], l0[2], l0[3], h0[0], h0[1], h0[2], h0[3]}, o[d0], 0, 0, 0);   \
        o[d0] = __builtin_amdgcn_mfma_f32_32x32x16_bf16(pa1, (bf16x8){l1[0], l1[1], l1[2], l1[3], h1[0], h1[1], h1[2], h1[3]}, o[d0], 0, 0, 0);   \
        o[d0] = __builtin_amdgcn_mfma_f32_32x32x16_bf16(pa2, (bf16x8){l2[0], l2[1], l2[2], l2[3], h2[0], h2[1], h2[2], h2[3]}, o[d0], 0, 0, 0);   \
        o[d0] = __builtin_amdgcn_mfma_f32_32x32x16_bf16(pa3, (bf16x8){l3[0], l3[1], l3[2], l3[3], h3[0], h3[1], h3[2], h3[3]}, o[d0], 0, 0, 0); } while (0)
    PV_D0(0); PV_D0(1); PV_D0(2); PV_D0(3);
#undef PV_D0
#undef TRRD
}

template <class TIn, class TOut> struct BlockRef { const TIn* Q; const TIn* K; const TIn* V; TOut* O; int P0; const float* Fb; const float* gain; };
template <class TIn> struct Seam {
    bf16x8 qr[8];
    bf16x8 st_v0, st_v1, st_k0, st_k1; f32x4 sf0, sf1, sf2, sf3; float st_b;
    f32x4 tq[16];
};
__device__ __forceinline__ int swa_jlo(int P0, int W) { const int lowk = P0 - W + 1; return lowk > 0 ? lowk / KVBLK : 0; }
#define ROW(p, k0, rr) ((p) + (size_t)((k0) + (rr)) * PITCH + sc)
#define VMW() asm volatile("s_waitcnt vmcnt(0)" ::: "memory")
#define VMWN(n) asm volatile("s_waitcnt vmcnt(%0)" :: "i"(n) : "memory")
#define SLOAD_H(Kp, Vp, k0) SLOAD_HB(Kp, Vp, k0, cur)
#define SLOAD_HB(Kp, Vp, k0, blk) do { S.st_v0 = load8<TIn>(ROW(Vp, k0, sr)); S.st_v1 = load8<TIn>(ROW(Vp, k0, 32 + sr));              \
                         S.st_k0 = load8<TIn>(ROW(Kp, k0, sr)); S.st_k1 = load8<TIn>(ROW(Kp, k0, 32 + sr)); \
                         if (tid < 64) S.st_b = ((blk).Fb[(blk).P0] - (blk).Fb[(k0) + tid]) * (1.0f / SCALE); } while (0)
#define SWRITE_HK(bf) do { *(bf16x8*)(K_lds + (bf) * SHM_K + kws) = S.st_k0; *(bf16x8*)(K_lds + (bf) * SHM_K + kws + 32 * 256) = S.st_k1; \
                         if (tid < 64) *(float*)(K_lds - 2 * SHM_V + LDS_BIAS + (bf) * 256 + bws) = S.st_b; } while (0)
#define SWRITE_HV(bf) do { *(bf16x8*)(V_lds + (bf) * SHM_V + vst0) = S.st_v0; *(bf16x8*)(V_lds + (bf) * SHM_V + vst1) = S.st_v1; } while (0)
#define SWRITE_H(bf) do { SWRITE_HV(bf); SWRITE_HK(bf); } while (0)
#define SLOAD_F(p, k0) do { S.sf0 = *(const f32x4*)ROW(p, k0, sr); S.sf1 = *(const f32x4*)(ROW(p, k0, sr) + 4);                \
                            S.sf2 = *(const f32x4*)ROW(p, k0, 32 + sr); S.sf3 = *(const f32x4*)(ROW(p, k0, 32 + sr) + 4); } while (0)
#define SWRITE_KF(bf) do { *(bf16x8*)(K_lds + (bf) * SHM_K + kws) = pack8(S.sf0, S.sf1); *(bf16x8*)(K_lds + (bf) * SHM_K + kws + 32 * 256) = pack8(S.sf2, S.sf3); } while (0)
#define SWRITE_VF(bf) do { *(bf16x8*)(V_lds + (bf) * SHM_V + vst0) = pack8(S.sf0, S.sf1); *(bf16x8*)(V_lds + (bf) * SHM_V + vst1) = pack8(S.sf2, S.sf3); } while (0)
template <class TIn, class TOut>
__device__ __forceinline__ void causal_swa_prime(const BlockRef<TIn, TOut>& cur, int W, char* lds, Seam<TIn>& S) {
    constexpr bool F32 = same_t<TIn, float>::v;
    const int tid = threadIdx.x, wid = __builtin_amdgcn_readfirstlane(tid >> 6), lane = tid & 63, r32 = lane & 31, hi = lane >> 5;
    const int sr = tid >> 4, sc = (tid & 15) * 8, kws = KSWZ(sr, sc * 2); char* K_lds = lds + 2 * SHM_V;
    const int bws = bias_slot(tid & 63) * 4;
    const int kb0 = swa_jlo(cur.P0, W) * KVBLK;
    for (int d0 = 0; d0 < 8; ++d0) S.qr[d0] = load8<TIn>(cur.Q + (size_t)(wid * QBLK + r32) * PITCH + d0 * 16 + hi * 8);
    if constexpr (F32) { SLOAD_F((const float*)cur.K, kb0); VMW(); SWRITE_KF(0); SBAR(); SLOAD_F((const float*)cur.V, kb0); }
    else { SLOAD_H(cur.K, cur.V, kb0); VMW(); SWRITE_HK(0); }
    __syncthreads();
}
template <class TIn, class TOut>
__device__ __forceinline__ void causal_swa_block(const BlockRef<TIn, TOut>& cur, const BlockRef<TIn, TOut>& nxt, int skv, int W, char* lds, Seam<TIn>& S) {
    constexpr bool F32 = same_t<TIn, float>::v;
    const int tid = threadIdx.x, wid = __builtin_amdgcn_readfirstlane(tid >> 6), lane = tid & 63, r32 = lane & 31, hi = lane >> 5;
    const int j_lo = swa_jlo(cur.P0, W);
    int j_hi = (cur.P0 + QB - 1) / KVBLK + 1; if (j_hi > skv / KVBLK) j_hi = skv / KVBLK;
    const int NT = j_hi - j_lo;
    const int kbn = swa_jlo(nxt.P0, W) * KVBLK;
    const int qlo = cur.P0 + wid * QBLK, qm = qlo + r32 - 4 * hi;
    char* V_lds = lds; char* K_lds = lds + 2 * SHM_V;
    float* ws = (float*)(lds + 2 * SHM_V + 2 * SHM_K) + wid * 64; float* li_l = ws, * al_l = ws + 32;
    float m_reg = -1e30f, l_reg = 0; f32x16 o[4] = {};
    const int sr = tid >> 4, sc = (tid & 15) * 8, vst0 = v_st(sr, sc), vst1 = v_st(32 + sr, sc), kws = KSWZ(sr, sc * 2);
    const int bws = bias_slot(tid & 63) * 4;
    const int vb0 = (int)(uintptr_t)V_lds + v_rd_base(lane);
    const TIn* Kh = cur.K; const TIn* Vh = cur.V;
#define RESC(a) do { if (__any((a) < 1.f)) { if (hi == 0) al_l[r32] = (a); asm volatile("s_waitcnt lgkmcnt(0)" ::: "memory");              \
                     for (int d_ = 0; d_ < 4; ++d_) for (int r = 0; r < 16; ++r) o[d_][r] *= al_l[crow(r, hi)]; } } while (0)
#define KBASE(t) ((j_lo + (t)) * KVBLK)
#define ACT(t) (KBASE(t) <= qlo + QBLK - 1 && KBASE(t) + KVBLK - 1 >= qlo - W + 1)
#define MASKT(P0_, P1_, t) do { const int kb_ = KBASE(t); if ((!SK || ACT(t)) && (kb_ + KVBLK - 1 > qlo || kb_ <= qlo + QBLK - 1 - W)) mask_tile(P0_, P1_, qm - kb_, (unsigned)W); } while (0)
    constexpr int NQL = F32 ? 16 : 8;
    constexpr bool SK = WSKIP && !F32;
#define SEAM_K0() do { VMWN(NQL); if constexpr (F32) { SWRITE_KF(0); SBAR(); SLOAD_F((const float*)nxt.V, kbn); } else { SWRITE_HK(0); } SBAR(); } while (0)
    f32x16 pA0, pA1, pB0, pB1; float mnA, mnB, alA, alB; bf16x8 pa0, pa1, pa2, pa3;
    if constexpr (F32) { VMW(); SWRITE_VF(0); SBAR(); } else { SWRITE_HV(0); SBAR(); }
    if (NT > 1) { if constexpr (F32) SLOAD_F((const float*)Kh, KBASE(1)); else SLOAD_H(Kh, Vh, KBASE(1)); }
    SBAR(); qkt<0, SK>(pA0, pA1, K_lds, r32, hi, S.qr, ACT(0));
    if constexpr (F32) { if (NT > 1) { VMW(); SWRITE_KF(1); SBAR(); SLOAD_F((const float*)Vh, KBASE(1)); } }
    MASKT(pA0, pA1, 0); partialSM(pA0, pA1, m_reg, mnA, alA);
    if (NT > 1) { VMW(); if constexpr (F32) { SWRITE_VF(1); SBAR(); if (NT > 2) SLOAD_F((const float*)Kh, KBASE(2)); } else SWRITE_H(1); }
    __syncthreads();
#define HALF_STEP(PX0, PX1, mnX, alX, PY0, PY1, alY, t, KB, VB, SB) do {                                                      \
        SBAR(); qkt<KB, SK>(PX0, PX1, K_lds, r32, hi, S.qr, ACT(t));                                             \
        finishSM(PY0, PY1, alY, l_reg, pa0, pa1, pa2, pa3); SBAR();                                                           \
        if ((t) + 1 < NT) { if constexpr (F32) { VMW(); SWRITE_KF(SB); SBAR(); SLOAD_F((const float*)Vh, KBASE((t) + 1)); }  \
                            else { SLOAD_H(Kh, Vh, KBASE((t) + 1)); } SBAR(); }                                               \
        pv_tile<VB, SK>(o, vb0, pa0, pa1, pa2, pa3, ACT((t) - 1)); MASKT(PX0, PX1, (t)); partialSM(PX0, PX1, m_reg, mnX, alX);                                        \
        __syncthreads();                                                                                                      \
        if ((t) + 1 < NT) { VMW(); if constexpr (F32) { SWRITE_VF(SB); SBAR(); if ((t) + 2 < NT) SLOAD_F((const float*)Kh, KBASE((t) + 2)); } \
                            else { SWRITE_H(SB); } }                                                                          \
        RESC(alX); __syncthreads(); } while (0)
    for (int t = 1; t + 1 < NT; t += 2) {
        HALF_STEP(pB0, pB1, mnB, alB, pA0, pA1, alA, t, 1, 0, 0);
        HALF_STEP(pA0, pA1, mnA, alA, pB0, pB1, alB, t + 1, 0, 1, 1);
    }
    const bool even = (NT & 1) == 0;
    if (even) { SBAR(); qkt<1, SK>(pB0, pB1, K_lds, r32, hi, S.qr, ACT(NT - 1)); SBAR(); }
#define QROW(e) (nxt.Q + (size_t)(wid * QBLK + r32) * PITCH + ((e) >> 1) * 16 + hi * 8 + ((e) & 1) * 4)
    if constexpr (F32) { SLOAD_F((const float*)nxt.K, kbn); SBAR();
#pragma unroll
        for (int e = 0; e < 8; ++e) S.tq[e] = *(const f32x4*)QROW(e); }
    else { SLOAD_HB(nxt.K, nxt.V, kbn, nxt); SBAR();
#pragma unroll
        for (int d0 = 0; d0 < 8; ++d0) S.qr[d0] = load8<TIn>(nxt.Q + (size_t)(wid * QBLK + r32) * PITCH + d0 * 16 + hi * 8); }
    SBAR();
    finishSM(pA0, pA1, alA, l_reg, pa0, pa1, pa2, pa3); SBAR();
    if constexpr (F32) {
#pragma unroll
        for (int e = 8; e < 16; ++e) S.tq[e] = *(const f32x4*)QROW(e); SBAR(); }
#undef QROW
    pv_tile<0, SK>(o, vb0, pa0, pa1, pa2, pa3, ACT(even ? NT - 2 : NT - 1));
    if (even) { MASKT(pB0, pB1, NT - 1); partialSM(pB0, pB1, m_reg, mnB, alB); __syncthreads(); RESC(alB);
        finishSM(pB0, pB1, alB, l_reg, pa0, pa1, pa2, pa3); SBAR(); pv_tile<1, SK>(o, vb0, pa0, pa1, pa2, pa3, ACT(NT - 1)); }
    SBAR(); SEAM_K0();
    if (hi == 0) li_l[r32] = l_reg; asm volatile("s_waitcnt lgkmcnt(0)" ::: "memory");
    int ro = r32; asm volatile("" : "+v"(ro));
    TOut* Or = cur.O + (size_t)(wid * QBLK + 4 * hi) * OPITCH + ro;
    float gn[4];
#pragma unroll
    for (int d0 = 0; d0 < 4; ++d0) gn[d0] = cur.gain[d0 * 32 + ro];
#pragma unroll
    for (int r = 0; r < 16; ++r) { const int orow = crow(r, hi); const float rl = __builtin_amdgcn_rcpf(li_l[orow]);
        float v[4]; float ss = 0.f;
#pragma unroll
        for (int d0 = 0; d0 < 4; ++d0) { v[d0] = o[d0][r] * rl; ss += v[d0] * v[d0]; }
        ss += __shfl_xor(ss, 1); ss += __shfl_xor(ss, 2); ss += __shfl_xor(ss, 4); ss += __shfl_xor(ss, 8); ss += __shfl_xor(ss, 16);
        const float rn = __builtin_amdgcn_rsqf(ss * (1.0f / 128.0f) + 1e-6f);
#pragma unroll
        for (int d0 = 0; d0 < 4; ++d0) { const float vv = v[d0] * rn * gn[d0]; const float vn = __shfl_xor(vv, 1);
            if ((ro & 1) == 0) *(unsigned*)(Or + d0 * 32) = cvtpk(vv, vn); }
        Or += ((r & 3) == 3 ? 5 : 1) * OPITCH; asm volatile("" : "+v"(Or) :: "memory"); }
    if constexpr (F32) {
#pragma unroll
        for (int d0 = 0; d0 < 8; ++d0) S.qr[d0] = pack8(S.tq[2 * d0], S.tq[2 * d0 + 1]); }
    __syncthreads();
#undef RESC
#undef KBASE
#undef ACT
#undef MASKT
#undef SEAM_K0
#undef HALF_STEP
}
#undef ROW
#undef VMW
#undef VMWN
#undef SLOAD_H
#undef SWRITE_HK
#undef SWRITE_HV
#undef SWRITE_H
#undef SLOAD_F
#undef SWRITE_KF
#undef SWRITE_VF

}
namespace mk {
typedef short s16x8 __attribute__((ext_vector_type(8)));
#define MFMA32(a, b, c) __builtin_amdgcn_mfma_f32_32x32x16_bf16((a), (b), (c), 0, 0, 0)
__device__ __forceinline__ int crow32(int r, int hi) { return (r & 3) + 8 * (r >> 2) + 4 * hi; }
constexpr float SCALEQ = 0.08838834764831845f;
__device__ __forceinline__ float wave_scan_add(float v, int lane) {
#pragma unroll
    for (int o = 1; o < 64; o <<= 1) { const float t = __shfl_up(v, o); if (lane >= o) v += t; }
    return v;
}
__device__ __forceinline__ float wave_scan_max(float v, int lane) {
#pragma unroll
    for (int o = 1; o < 64; o <<= 1) { const float t = __shfl_up(v, o); if (lane >= o) v = fmaxf(v, t); }
    return v;
}
__device__ __forceinline__ float wave_max(float v) {
#pragma unroll
    for (int o = 1; o < 64; o <<= 1) v = fmaxf(v, __shfl_xor(v, o));
    return v;
}
constexpr int TSTR = 72;
template <bool SCALED>
__device__ __forceinline__ void stage_transposed(const bf16* src, int ncols, LAS bf16* T, const LAS float* wl, int tid) {
    const int cpr = ncols / 8;
    for (int q = tid; q < 64 * cpr; q += NTHR) { const int s = q / cpr, c8 = (q % cpr) * 8;
        const v4u raw = *(const GAS v4u*)(src + (size_t)s * NPP + c8);
        const unsigned w4[4] = {raw.x, raw.y, raw.z, raw.w};
#pragma unroll
        for (int j = 0; j < 4; ++j) { unsigned lo = w4[j] & 0xffffu, hi = w4[j] >> 16;
            if (SCALED) { const float sc = wl[s]; lo = f2bf(bf2f((unsigned short)lo) * sc); hi = f2bf(bf2f((unsigned short)hi) * sc); }
            T[(c8 + 2 * j) * TSTR + s] = (bf16)lo; T[(c8 + 2 * j + 1) * TSTR + s] = (bf16)hi; } }
}
__device__ __forceinline__ void p3_prep(Frame& F) {
    const int gw = F.vcu * NWAVES + F.wave, NGW = F.G * NWAVES, lane = F.lane, tid = F.tid;
    bf16* proj = wsp<bf16>(F, WS_PROJ); const float* gates = wsp<float>(F, WS_GATES);
    {
        const int seg = lane >> 2, qd = (lane & 3) * 32; const float* gn = (seg < 8 ? F.in[IN_FOXQN] : F.in[IN_FOXKN]) + qd;
        for (int m = gw; m < S; m += NGW) {
            bf16* p = proj + (size_t)m * NPP + C_FQ + seg * 128 + qd; v4u raw[4]; float x[32]; float ss = 0.f;
#pragma unroll
            for (int j = 0; j < 4; ++j) raw[j] = *(const GAS v4u*)(p + 8 * j);
#pragma unroll
            for (int j = 0; j < 4; ++j) { const unsigned w4[4] = {raw[j].x, raw[j].y, raw[j].z, raw[j].w};
#pragma unroll
                for (int i = 0; i < 4; ++i) { x[8 * j + 2 * i] = bf2f((unsigned short)(w4[i] & 0xffffu)); x[8 * j + 2 * i + 1] = bf2f((unsigned short)(w4[i] >> 16)); } }
#pragma unroll
            for (int i = 0; i < 32; ++i) ss += x[i] * x[i];
            ss += __shfl_xor(ss, 1); ss += __shfl_xor(ss, 2);
            const float r = rsqrtf(ss * (1.f / 128.f) + 1e-6f);
#pragma unroll
            for (int j = 0; j < 4; ++j) { v4u o; const f32x4 g0 = *(const GAS f32x4*)(gn + 8 * j), g1 = *(const GAS f32x4*)(gn + 8 * j + 4);
                o.x = pk2(x[8 * j] * r * g0.x, x[8 * j + 1] * r * g0.y); o.y = pk2(x[8 * j + 2] * r * g0.z, x[8 * j + 3] * r * g0.w);
                o.z = pk2(x[8 * j + 4] * r * g1.x, x[8 * j + 5] * r * g1.y); o.w = pk2(x[8 * j + 6] * r * g1.z, x[8 * j + 7] * r * g1.w);
                *(GAS v4u*)(p + 8 * j) = o; }
        }
    }
    if (blockIdx.x < 8) {
        const int h = blockIdx.x; const float b = F.in[IN_FOXBF][h]; float* Fo = wsp<float>(F, WS_F) + h * S;
        LAS double* tot = (LAS double*)(F.lds + RING_OFF);
        double loc[16]; double acc = 0.0;
#pragma unroll
        for (int i = 0; i < 16; ++i) { acc += (double)log_sigmoid_f(gates[(size_t)(tid * 16 + i) * 16 + 8 + h] + b); loc[i] = acc; }
        tot[tid] = acc;
        __syncthreads();
        if (F.wave == 0) { double v[8]; double s = 0.0;
#pragma unroll
            for (int i = 0; i < 8; ++i) { v[i] = tot[lane * 8 + i]; s += v[i]; }
            double inc = s;
#pragma unroll
            for (int o = 1; o < 64; o <<= 1) { const double t = __shfl_up(inc, o); if (lane >= o) inc += t; }
            double ex = inc - s;
#pragma unroll
            for (int i = 0; i < 8; ++i) { tot[lane * 8 + i] = ex; ex += v[i]; } }
        __syncthreads();
        const double off = tot[tid];
#pragma unroll
        for (int i = 0; i < 16; ++i) Fo[tid * 16 + i] = (float)(off + loc[i]);
        __syncthreads();
    }
    {
        LAS bf16* KT = (LAS bf16*)(F.lds + RING_OFF);
        LAS bf16* VT = KT + 128 * TSTR;
        LAS float* wl = (LAS float*)(VT + 256 * TSTR);
        float* UL = wsp<float>(F, WS_UL); float* NL = wsp<float>(F, WS_NL); float* GLAL = wsp<float>(F, WS_GLAL);
        const int hi = lane >> 5, l31 = lane & 31, w = F.wave;
        for (int u = F.vcu; u < 4 * NCH; u += F.G) {
            const int h = u >> 7, ch = u & 127, t0 = ch * LCH;
            if (w == 0) {
                const float ip = softcap_f(gates[(size_t)(t0 + lane) * 16 + h] + F.in[IN_BI][h]);
                const float fp = softcap_f(gates[(size_t)(t0 + lane) * 16 + 4 + h] + F.in[IN_BF][h]);
                const float g = wave_scan_add(log_sigmoid_f(fp), lane), a = ip - g, amax = wave_max(a);
                wl[lane] = __expf(a - amax);
                if (lane == 63) { GLAL[u * 2] = g; GLAL[u * 2 + 1] = amax; }
            }
            __syncthreads();
            stage_transposed<true>(proj + (size_t)t0 * NPP + C_MK + h * 128, 128, KT, wl, tid);
            stage_transposed<false>(proj + (size_t)t0 * NPP + C_MV + h * 256, 256, VT, wl, tid);
            __syncthreads();
            f32x16 acc[4];
#pragma unroll
            for (int dt = 0; dt < 4; ++dt)
#pragma unroll
                for (int r = 0; r < 16; ++r) acc[dt][r] = 0.f;
#pragma unroll
            for (int ks = 0; ks < 4; ++ks) { const s16x8 a = *(const LAS s16x8*)(VT + (32 * w + l31) * TSTR + 16 * ks + 8 * hi);
#pragma unroll
                for (int dt = 0; dt < 4; ++dt) { const s16x8 b = *(const LAS s16x8*)(KT + (32 * dt + l31) * TSTR + 16 * ks + 8 * hi); acc[dt] = MFMA32(a, b, acc[dt]); } }
            float* ut = UL + (size_t)u * 256 * 128;
#pragma unroll
            for (int dt = 0; dt < 4; ++dt)
#pragma unroll
                for (int r = 0; r < 16; ++r) ut[(size_t)(32 * w + crow32(r, hi)) * 128 + 32 * dt + l31] = acc[dt][r];
            if (tid < 128) { float s = 0.f;
#pragma unroll
                for (int j = 0; j < 8; ++j) { const s16x8 kv = *(const LAS s16x8*)(KT + tid * TSTR + 8 * j);
#pragma unroll
                    for (int i = 0; i < 8; ++i) s += bf2f((unsigned short)kv[i]); }
                NL[u * 128 + tid] = s; }
            __syncthreads();
        }
    }
}
__device__ __forceinline__ void p4_scan(Frame& F) {
    LAS float* gl = (LAS float*)(F.lds + RING_OFF);
    LAS float* dec = gl + 256; LAS float* scl = dec + 128; LAS float* mv = scl + 128;
    const float* UL = wsp<float>(F, WS_UL); const float* NL = wsp<float>(F, WS_NL); const float* GLAL = wsp<float>(F, WS_GLAL);
    bf16* CS = wsp<bf16>(F, WS_CS); float* NS = wsp<float>(F, WS_NS); float* MS = wsp<float>(F, WS_MS);
    const int tid = F.tid;
    for (int blk = F.vcu; blk < 4 * 64; blk += F.G) {
        const int h = blk >> 6, rem0 = (blk & 63) * 512;
        if (tid < 256) gl[tid] = GLAL[h * 256 + tid];
        __syncthreads();
        if (tid == 0) { float m = 0.f;
            for (int c = 0; c < NCH; ++c) { const float g = gl[2 * c], al = gl[2 * c + 1], mn = g + fmaxf(m, al);
                mv[c] = m; dec[c] = __expf(g + m - mn); scl[c] = __expf(g + al - mn); m = mn; } }
        __syncthreads();
        if (rem0 == 0 && tid < 128) MS[h * 128 + tid] = mv[tid];
        const int rem = rem0 + tid;
        const float* ul = UL + (size_t)h * NCH * 32768 + rem; bf16* cs = CS + (size_t)h * NCH * 32768 + rem;
        float C = 0.f;
#pragma unroll 8
        for (int c = 0; c < NCH; ++c) { cs[(size_t)c * 32768] = (bf16)f2bf(C); C = dec[c] * C + scl[c] * ul[(size_t)c * 32768]; }
        if (rem0 == 0 && tid < 128) { float n = 0.f; const float* nl = NL + (size_t)h * NCH * 128 + tid; float* ns = NS + (size_t)h * NCH * 128 + tid;
#pragma unroll 8
            for (int c = 0; c < NCH; ++c) { ns[c * 128] = n; n = dec[c] * n + scl[c] * nl[c * 128]; } }
        __syncthreads();
    }
}
constexpr int NUMSTR = 260;
__device__ __forceinline__ void p5_mlstm_out(Frame& F) {
    LAS bf16* VT = (LAS bf16*)(F.lds + RING_OFF);
    LAS bf16* Pm = VT + 256 * TSTR;
    LAS float* NUM = (LAS float*)(Pm + 64 * TSTR);
    LAS float* a_s = NUM + 64 * NUMSTR; LAS float* Mt = a_s + 64; LAS float* inter = Mt + 64; LAS float* emt = inter + 64; LAS float* qn = emt + 64; LAS float* dinv = qn + 64;
    const bf16* proj = wsp<bf16>(F, WS_PROJ); const float* gates = wsp<float>(F, WS_GATES); const bf16* CS = wsp<bf16>(F, WS_CS);
    const float* NS = wsp<float>(F, WS_NS); const float* MS = wsp<float>(F, WS_MS); bf16* concat = wsp<bf16>(F, WS_CONCAT);
    const int tid = F.tid, lane = F.lane, w = F.wave, hi = lane >> 5, l31 = lane & 31;
    for (int u = F.vcu; u < 4 * NCH; u += F.G) {
        const int h = u >> 7, ch = u & 127, t0 = ch * LCH;
        const bf16* qbase = proj + (size_t)t0 * NPP + C_MQ + h * 128; const bf16* kbase = proj + (size_t)t0 * NPP + C_MK + h * 128;
        if (w == 0) {
            const float ip = softcap_f(gates[(size_t)(t0 + lane) * 16 + h] + F.in[IN_BI][h]);
            const float fp = softcap_f(gates[(size_t)(t0 + lane) * 16 + 4 + h] + F.in[IN_BF][h]);
            const float g = wave_scan_add(log_sigmoid_f(fp), lane), a = ip - g, cm = wave_scan_max(a, lane);
            const float mp = MS[u], M = fmaxf(mp, cm);
            a_s[lane] = a; Mt[lane] = M; inter[lane] = __expf(mp - M); emt[lane] = __expf(-(g + M));
        }
        stage_transposed<false>(proj + (size_t)t0 * NPP + C_MV + h * 256, 256, VT, a_s, tid);
        __syncthreads();
        if (w < 4) {
            const int ti = w >> 1, si = w & 1;
            if (si <= ti) {
                s16x8 qa[8], kb[8];
#pragma unroll
                for (int ks = 0; ks < 8; ++ks) { qa[ks] = *(const GAS s16x8*)(qbase + (size_t)(32 * ti + l31) * NPP + 16 * ks + 8 * hi); kb[ks] = *(const GAS s16x8*)(kbase + (size_t)(32 * si + l31) * NPP + 16 * ks + 8 * hi); }
                f32x16 acc;
#pragma unroll
                for (int r = 0; r < 16; ++r) acc[r] = 0.f;
#pragma unroll
                for (int ks = 0; ks < 8; ++ks) acc = MFMA32(qa[ks], kb[ks], acc);
                const int s = 32 * si + l31; const float as = a_s[s];
#pragma unroll
                for (int r = 0; r < 16; ++r) { const int t = 32 * ti + crow32(r, hi); const float p = (s <= t) ? acc[r] * SCALEQ * __expf(as - Mt[t]) : 0.f; Pm[t * TSTR + s] = (bf16)f2bf(p); }
            } else {
#pragma unroll
                for (int r = 0; r < 16; ++r) Pm[(32 * ti + crow32(r, hi)) * TSTR + 32 * si + l31] = (bf16)0;
            }
        } else {
            const int t = (tid - 256) >> 2, d0 = ((tid - 256) & 3) * 32; float s = 0.f; const float* np = NS + (size_t)u * 128 + d0;
#pragma unroll
            for (int j = 0; j < 4; ++j) { const s16x8 qv = *(const GAS s16x8*)(qbase + (size_t)t * NPP + d0 + 8 * j);
#pragma unroll
                for (int i = 0; i < 8; ++i) s += bf2f((unsigned short)qv[i]) * np[8 * j + i]; }
            s += __shfl_xor(s, 1); s += __shfl_xor(s, 2);
            if ((tid & 3) == 0) qn[t] = s * SCALEQ;
        }
        __syncthreads();
        f32x16 accP[2], accC[2];
#pragma unroll
        for (int ti = 0; ti < 2; ++ti)
#pragma unroll
            for (int r = 0; r < 16; ++r) { accP[ti][r] = 0.f; accC[ti][r] = 0.f; }
        {
            const bf16* cs = CS + (size_t)u * 32768 + (size_t)(32 * w + l31) * 128 + 8 * hi;
            s16x8 cb[8];
#pragma unroll
            for (int ks = 0; ks < 8; ++ks) cb[ks] = *(const GAS s16x8*)(cs + 16 * ks);
#pragma unroll
            for (int ti = 0; ti < 2; ++ti) {
                s16x8 qa[8];
#pragma unroll
                for (int ks = 0; ks < 8; ++ks) qa[ks] = *(const GAS s16x8*)(qbase + (size_t)(32 * ti + l31) * NPP + 16 * ks + 8 * hi);
#pragma unroll
                for (int ks = 0; ks < 8; ++ks) accC[ti] = MFMA32(qa[ks], cb[ks], accC[ti]);
            }
#pragma unroll
            for (int ks = 0; ks < 4; ++ks) { const s16x8 vb = *(const LAS s16x8*)(VT + (32 * w + l31) * TSTR + 16 * ks + 8 * hi);
#pragma unroll
                for (int ti = 0; ti < 2; ++ti) { const s16x8 pa = *(const LAS s16x8*)(Pm + (32 * ti + l31) * TSTR + 16 * ks + 8 * hi); accP[ti] = MFMA32(pa, vb, accP[ti]); } }
        }
        if (w == 0) {
            float rs = 0.f;
#pragma unroll
            for (int j = 0; j < 8; ++j) { const s16x8 pv = *(const LAS s16x8*)(Pm + lane * TSTR + 8 * j);
#pragma unroll
                for (int i = 0; i < 8; ++i) rs += bf2f((unsigned short)pv[i]); }
            const float dn = rs + inter[lane] * qn[lane];
            dinv[lane] = 1.f / fmaxf(fabsf(dn), emt[lane]);
        }
        __syncthreads();
#pragma unroll
        for (int ti = 0; ti < 2; ++ti)
#pragma unroll
            for (int r = 0; r < 16; ++r) { const int t = 32 * ti + crow32(r, hi); NUM[t * NUMSTR + 32 * w + l31] = (accP[ti][r] + inter[t] * SCALEQ * accC[ti][r]) * dinv[t]; }
        __syncthreads();
        {
            const f32x4 gn = *(const GAS f32x4*)(F.in[IN_MOUTN] + h * 256 + 4 * lane);
#pragma unroll
            for (int i = 0; i < 8; ++i) { const int t = 8 * w + i; const f32x4 x = *(const LAS f32x4*)(NUM + t * NUMSTR + 4 * lane);
                const float ss = wave_sum((x.x * x.x + x.y * x.y) + (x.z * x.z + x.w * x.w)); const float r = rsqrtf(ss * (1.f / 256.f) + 1e-6f);
                const u32x2 mo = *(const GAS u32x2*)(proj + (size_t)(t0 + t) * NPP + C_MO + h * 256 + 4 * lane);
                const float o0 = x.x * r * gn.x * sigmoid_f(bf2f((unsigned short)(mo.x & 0xffffu))), o1 = x.y * r * gn.y * sigmoid_f(bf2f((unsigned short)(mo.x >> 16)));
                const float o2 = x.z * r * gn.z * sigmoid_f(bf2f((unsigned short)(mo.y & 0xffffu))), o3 = x.w * r * gn.w * sigmoid_f(bf2f((unsigned short)(mo.y >> 16)));
                u32x2 ov; ov.x = pk2(o0, o1); ov.y = pk2(o2, o3);
                *(GAS u32x2*)(concat + (size_t)(t0 + t) * D + h * 256 + 4 * lane) = ov; }
        }
        __syncthreads();
    }
}
}
namespace mk {
__device__ __forceinline__ fox::BlockRef<fox::bf16, fox::bf16> fox_ref(const Frame& F, int L) {
    const int h = L >> 5, qb = L & 31; fox::BlockRef<fox::bf16, fox::bf16> r;
    const fox::bf16* proj = (const fox::bf16*)(F.ws + WS_PROJ);
    r.Q = proj + (size_t)(qb * 256) * fox::PITCH + C_FQ + h * 128; r.K = proj + C_FK + h * 128; r.V = proj + C_FV + h * 128;
    r.O = (fox::bf16*)(F.ws + WS_CONCAT) + (size_t)(qb * 256) * D + 1024 + h * 128; r.P0 = qb * 256;
    r.Fb = (const float*)(F.ws + WS_F) + h * S; r.gain = F.in[IN_FOUTN] + h * 128;
    return r;
}
__device__ __forceinline__ void p5_attention(Frame& F, char* ldsg) {
    typedef fox::BlockRef<fox::bf16, fox::bf16> BR;
    int L = F.vcu; if (L >= 256) return;
    BR cur = fox_ref(F, L);
    fox::Seam<fox::bf16> Sm;
    fox::causal_swa_prime<fox::bf16, fox::bf16>(cur, S, ldsg, Sm);
    for (;;) {
        const bool more = L + F.G < 256;
        const BR nxt = more ? fox_ref(F, L + F.G) : cur;
        fox::causal_swa_block<fox::bf16, fox::bf16>(cur, nxt, S, S, ldsg, Sm);
        if (!more) break;
        cur = nxt; L += F.G;
    }
}
constexpr int RROWS = 8, NITER = S / RROWS;
__device__ __forceinline__ void p7_router(Frame& F) {
    LAS float* shs = (LAS float*)(F.lds + RING_OFF);
    LAS float* H2L = shs + 2 * D;
    LAS float* red = H2L + RROWS * D;
    LAS int* selE = (LAS int*)(red + 16 * RROWS * NE);
    const float* mod = wsp<float>(F, WS_MOD); const float* h1 = wsp<float>(F, WS_H1); bf16* h2 = wsp<bf16>(F, WS_HN);
    int* top_i = wsp<int>(F, WS_TOPI); float* top_w = wsp<float>(F, WS_TOPW); int* hist = wsp<int>(F, WS_HIST); int* lrank = wsp<int>(F, WS_LRANK);
    const int tid = F.tid, lane = F.lane, w = F.wave;
    for (int i = tid; i < 2 * D; i += NTHR) shs[i] = mod[3 * D + i];
    __syncthreads();
    const float* wr = F.in[IN_WR];
    for (int it = F.vcu; it < NITER; it += F.G) {
        const int r0 = it * RROWS;
        {
            const int m = r0 + w; const GAS f32x4* xr = (const GAS f32x4*)(h1 + (size_t)m * D) + lane; f32x4 v[8]; float s2 = 0.f;
#pragma unroll
            for (int j = 0; j < 8; ++j) { v[j] = xr[64 * j]; s2 += (v[j].x * v[j].x + v[j].y * v[j].y) + (v[j].z * v[j].z + v[j].w * v[j].w); }
            const float r = rsqrtf(wave_sum(s2) * (1.f / D) + 1e-6f);
            GAS u32x2* o8 = (GAS u32x2*)(h2 + (size_t)m * D) + lane;
#pragma unroll
            for (int j = 0; j < 8; ++j) { const int c0 = 4 * lane + 256 * j; const f32x4 gg = *(const GAS f32x4*)(F.in[IN_NFFN] + c0); const f32x4 a = *(const LAS f32x4*)(shs + D + c0), b = *(const LAS f32x4*)(shs + c0);
                const f32x4 y = v[j] * r * gg * (a + 1.f) + b; u32x2 o; o.x = pk2(y.x, y.y); o.y = pk2(y.z, y.w); o8[64 * j] = o;
                *(LAS f32x4*)(H2L + w * D + c0) = y; }
        }
        __syncthreads();
        {
            const int e = tid & 31, kp = tid >> 5; float acc[RROWS];
#pragma unroll
            for (int r = 0; r < RROWS; ++r) acc[r] = 0.f;
            const float* wp = wr + (size_t)(kp * 128) * NE + e;
#pragma unroll 2
            for (int k4 = 0; k4 < 32; ++k4) {
                const float w0 = wp[(k4 * 4 + 0) * NE], w1 = wp[(k4 * 4 + 1) * NE], w2 = wp[(k4 * 4 + 2) * NE], w3 = wp[(k4 * 4 + 3) * NE];
#pragma unroll
                for (int r = 0; r < RROWS; ++r) { const f32x4 hv = *(const LAS f32x4*)(H2L + r * D + kp * 128 + k4 * 4); acc[r] += (hv.x * w0 + hv.y * w1) + (hv.z * w2 + hv.w * w3); }
            }
#pragma unroll
            for (int r = 0; r < RROWS; ++r) red[(kp * RROWS + r) * NE + e] = acc[r];
        }
        __syncthreads();
        if (tid < RROWS * NE) {
            const int r = tid >> 5, e = tid & 31; float lg = F.in[IN_BR][e];
#pragma unroll
            for (int kp = 0; kp < 16; ++kp) lg += red[(kp * RROWS + r) * NE + e];
            float cur = lg, mx = 0.f, sum = 0.f, mysel = 0.f; int myidx = 0;
#pragma unroll
            for (int q = 0; q < 4; ++q) { float best = cur; int bi = e;
#pragma unroll
                for (int o = 1; o < 32; o <<= 1) { const float ob = __shfl_xor(best, o); const int oi = __shfl_xor(bi, o); if (ob > best || (ob == best && oi < bi)) { best = ob; bi = oi; } }
                if (q == 0) mx = best;
                sum += __expf(best - mx);
                if (e == q) { mysel = best; myidx = bi; }
                if (e == bi) cur = -3.0e38f; }
            if (e < 4) { const int t = r0 + r; top_i[t * 4 + e] = myidx; top_w[t * 4 + e] = __expf(mysel - mx) / sum; selE[r * 4 + e] = myidx; }
        }
        __syncthreads();
        if (tid < 32) { const int me = selE[tid]; int rank = 0, cnt = 0;
#pragma unroll
            for (int p = 0; p < 32; ++p) { const int ep = selE[p]; rank += (ep == me && p < tid) ? 1 : 0; cnt += (ep == tid) ? 1 : 0; }
            lrank[it * 32 + tid] = rank; hist[it * NE + tid] = cnt; }
        __syncthreads();
    }
}
__device__ __forceinline__ void build_expert_table(Frame& F, const int* counts_g) {
    LAS int* tab = (LAS int*)(F.lds + TAB_OFF);
    if (F.tid == 0) { int acc = 0; for (int e = 0; e < NE; ++e) { const int c = counts_g[e]; tab[e] = acc; tab[40 + e] = c; acc += (c + 255) >> 8; } tab[32] = acc; }
    __syncthreads();
}
__device__ __forceinline__ void p8_gather(Frame& F) {
    LAS int* psum = (LAS int*)(F.lds + RING_OFF);
    LAS int* startr = psum + 16 * NE;
    LAS int* base = startr + NE;
    const int* hist = wsp<int>(F, WS_HIST); const int* lrank = wsp<int>(F, WS_LRANK); const int* top_i = wsp<int>(F, WS_TOPI); const float* top_w = wsp<float>(F, WS_TOPW);
    int* pos = wsp<int>(F, WS_POS); float* roww = wsp<float>(F, WS_ROWW); const bf16* h2 = wsp<bf16>(F, WS_HN); bf16* xg = wsp<bf16>(F, WS_XG);
    int* counts_g = (int*)(F.ws + WS_POS) + S * 4;
    const int tid = F.tid, lane = F.lane, w = F.wave;
    { const int e = tid & 31, part = tid >> 5; int s = 0; for (int i = 0; i < NITER / 16; ++i) s += hist[(part * (NITER / 16) + i) * NE + e]; psum[part * NE + e] = s; }
    __syncthreads();
    if (tid == 0) { int acc = 0; for (int e = 0; e < NE; ++e) { int c = 0; for (int p = 0; p < 16; ++p) c += psum[p * NE + e]; startr[e] = acc; acc += ((c + 255) >> 8) << 8; if (blockIdx.x == 0) counts_g[e] = c; } }
    __syncthreads();
    for (int it = F.vcu; it < NITER; it += F.G) {
        if (tid < NE) { const int part = it / (NITER / 16); int b = 0; for (int p = 0; p < part; ++p) b += psum[p * NE + tid];
            for (int i = part * (NITER / 16); i < it; ++i) b += hist[i * NE + tid]; base[tid] = b; }
        __syncthreads();
#pragma unroll
        for (int j = 0; j < 4; ++j) { const int p = w + 8 * j, pair = it * 32 + p, e = top_i[pair], dest = startr[e] + base[e] + lrank[pair], t = pair >> 2;
            if (lane == 0) { pos[pair] = dest; roww[dest] = top_w[pair]; }
            const GAS v4u* src = (const GAS v4u*)(h2 + (size_t)t * D) + lane; GAS v4u* dst = (GAS v4u*)(xg + (size_t)dest * D) + lane;
#pragma unroll
            for (int q = 0; q < 4; ++q) dst[64 * q] = src[64 * q]; }
        __syncthreads();
    }
}
struct GroupedOrder {
    const LAS int* tab; int ntn, G, c;
    __device__ __forceinline__ bool next(int i, Unit& u) const {
        const int L = i * G + c, total = tab[32] * ntn; if (L >= total) return false;
        int e = 0;
#pragma unroll 1
        while (e < NE - 1 && tab[e + 1] * ntn <= L) ++e;
        const int ts = tab[e], tc = tab[e + 1] - ts, within = L - ts * ntn;
        u.pm = ts + within % tc; u.pn = within / tc; u.e = e; u.pb = e * ntn + u.pn; return true;
    }
    __device__ __forceinline__ void a_ready(const Unit&) const {}
    __device__ __forceinline__ void done(const Unit&) const {}
};
struct EpiSwiglu {
    static constexpr bool PERM = true, AFTER_DRAIN = false;
    bf16* act; const float* bug;
    __device__ __forceinline__ void operator()(const pg8::f32x4 (&acc)[2][2][4][2], const Unit& u, int wr, int wc, int fr, int fq) const {
        const int row0 = u.pm * 256 + wr * 64 + fr, f0 = u.pn * 128 + wc * 32 + 8 * fq;
        const float* bg = bug + (size_t)u.e * 4096 + f0; pg8::f32x4 bgv[2], buv[2];
#pragma unroll
        for (int n = 0; n < 2; ++n) { bgv[n] = *(const pg8::f32x4*)(bg + 4 * n); buv[n] = *(const pg8::f32x4*)(bg + 2048 + 4 * n); }
#pragma unroll
        for (int ai = 0; ai < 2; ++ai)
#pragma unroll
            for (int m = 0; m < 4; ++m) { float o[8];
#pragma unroll
                for (int n = 0; n < 2; ++n)
#pragma unroll
                    for (int i = 0; i < 4; ++i) { const float g = fminf(acc[ai][0][m][n][i] + bgv[n][i], 7.f); const float up = fminf(fmaxf(acc[ai][1][m][n][i] + buv[n][i], -7.f), 7.f);
                        o[4 * n + i] = (up + 1.f) * g * sigmoid_f(1.702f * g); }
                pg8::u32x4 wv; wv.x = cvt_pk_bf16(o[0], o[1]); wv.y = cvt_pk_bf16(o[2], o[3]); wv.z = cvt_pk_bf16(o[4], o[5]); wv.w = cvt_pk_bf16(o[6], o[7]);
                *(pg8::u32x4*)(act + (size_t)(row0 + ai * 128 + m * 16) * FF + f0) = wv; }
    }
};
struct EpiDown {
    static constexpr bool PERM = true, AFTER_DRAIN = false;
    bf16* y; const float* bd; const float* roww;
    __device__ __forceinline__ void operator()(const pg8::f32x4 (&acc)[2][2][4][2], const Unit& u, int wr, int wc, int fr, int fq) const {
        const int row0 = u.pm * 256 + wr * 64 + fr, col0 = u.pn * 256 + wc * 32 + 8 * fq;
        pg8::f32x4 bv[2][2];
#pragma unroll
        for (int bj = 0; bj < 2; ++bj)
#pragma unroll
            for (int n = 0; n < 2; ++n) bv[bj][n] = *(const pg8::f32x4*)(bd + (size_t)u.e * D + col0 + bj * 128 + 4 * n);
#pragma unroll
        for (int ai = 0; ai < 2; ++ai)
#pragma unroll
            for (int m = 0; m < 4; ++m) { const int row = row0 + ai * 128 + m * 16; const float rw = roww[row]; bf16* rowp = y + (size_t)row * D + col0;
#pragma unroll
                for (int bj = 0; bj < 2; ++bj) { const pg8::f32x4 v0 = (acc[ai][bj][m][0] + bv[bj][0]) * rw, v1 = (acc[ai][bj][m][1] + bv[bj][1]) * rw;
                    pg8::u32x4 wv; wv.x = cvt_pk_bf16(v0[0], v0[1]); wv.y = cvt_pk_bf16(v0[2], v0[3]); wv.z = cvt_pk_bf16(v1[0], v1[1]); wv.w = cvt_pk_bf16(v1[2], v1[3]);
                    *(pg8::u32x4*)(rowp + bj * 128) = wv; } }
    }
};
__device__ __forceinline__ void p11_final(Frame& F) {
    LAS float* ms = (LAS float*)(F.lds + RING_OFF);
    const float* mod = wsp<float>(F, WS_MOD);
    for (int i = F.tid; i < 3 * D; i += NTHR) ms[i] = mod[5 * D + i];
    __syncthreads();
    const float* h1 = wsp<float>(F, WS_H1); const bf16* y = wsp<bf16>(F, WS_Y); const int* pos = wsp<int>(F, WS_POS);
    const int gw = F.vcu * NWAVES + F.wave, NGW = F.G * NWAVES, lane = F.lane;
    for (int t = gw; t < S; t += NGW) {
        asm volatile("" ::: "memory");
        const GAS f32x4* xr = (const GAS f32x4*)(h1 + (size_t)t * D) + lane;
        const GAS u32x2* y0 = (const GAS u32x2*)(y + (size_t)pos[t * 4 + 0] * D) + lane; const GAS u32x2* y1 = (const GAS u32x2*)(y + (size_t)pos[t * 4 + 1] * D) + lane;
        const GAS u32x2* y2 = (const GAS u32x2*)(y + (size_t)pos[t * 4 + 2] * D) + lane; const GAS u32x2* y3 = (const GAS u32x2*)(y + (size_t)pos[t * 4 + 3] * D) + lane;
        f32x4 v[8]; float s2 = 0.f;
#pragma unroll
        for (int j = 0; j < 8; ++j) { const u32x2 a = y0[64 * j], b = y1[64 * j], c = y2[64 * j], d = y3[64 * j]; const f32x4 g2 = *(const LAS f32x4*)(ms + 4 * lane + 256 * j);
            f32x4 f;
            f.x = (bf2f((unsigned short)(a.x & 0xffffu)) + bf2f((unsigned short)(b.x & 0xffffu))) + (bf2f((unsigned short)(c.x & 0xffffu)) + bf2f((unsigned short)(d.x & 0xffffu)));
            f.y = (bf2f((unsigned short)(a.x >> 16)) + bf2f((unsigned short)(b.x >> 16))) + (bf2f((unsigned short)(c.x >> 16)) + bf2f((unsigned short)(d.x >> 16)));
            f.z = (bf2f((unsigned short)(a.y & 0xffffu)) + bf2f((unsigned short)(b.y & 0xffffu))) + (bf2f((unsigned short)(c.y & 0xffffu)) + bf2f((unsigned short)(d.y & 0xffffu)));
            f.w = (bf2f((unsigned short)(a.y >> 16)) + bf2f((unsigned short)(b.y >> 16))) + (bf2f((unsigned short)(c.y >> 16)) + bf2f((unsigned short)(d.y >> 16)));
            v[j] = xr[64 * j] + g2 * f; s2 += (v[j].x * v[j].x + v[j].y * v[j].y) + (v[j].z * v[j].z + v[j].w * v[j].w); }
        const float r = rsqrtf(wave_sum(s2) * (1.f / D) + 1e-6f);
        GAS f32x4* o = (GAS f32x4*)(F.out + (size_t)t * D) + lane;
#pragma unroll
        for (int j = 0; j < 8; ++j) { const int c0 = 4 * lane + 256 * j; const f32x4 gg = *(const GAS f32x4*)(F.in[IN_NFIN] + c0); const f32x4 sh = *(const LAS f32x4*)(ms + D + c0), sc = *(const LAS f32x4*)(ms + 2 * D + c0);
            o[64 * j] = v[j] * r * gg * (sc + 1.f) + sh; }
    }
}
}
namespace mk {
struct Args { const float* in[24]; float* out; unsigned char* ws; int ph_lo, ph_hi, li, pad; };
constexpr int N_PHASES = 12;
__global__ void __launch_bounds__(NTHR, 2) mega_fwd(Args args) {
    extern __shared__ __attribute__((aligned(16))) unsigned char lds[];
    Frame F;
    F.lds = (LAS unsigned char*)lds;
    F.MISC = (volatile LAS unsigned*)(F.lds + MISC_OFF);
    F.tid = threadIdx.x; F.lane = F.tid & 63; F.wave = __builtin_amdgcn_readfirstlane(F.tid >> 6);
    F.G = gridDim.x; { const int bx = blockIdx.x; F.vcu = (F.G % 8 == 0) ? (bx % 8) * (F.G / 8) + bx / 8 : bx; }
    F.ws = args.ws; F.out = args.out; F.ctl = (gu32*)(args.ws + WS_CTL);
#pragma unroll
    for (int i = 0; i < 24; ++i) F.in[i] = args.in[i];
    for (int u = F.tid; u < (LDS_BYTES - LDSCTL_OFF) / 4; u += NTHR) ((LAS unsigned*)(F.lds + LDSCTL_OFF))[u] = 0u;
    __syncthreads();
    XcdBarrier bar = xcd_barrier_post((unsigned*)(F.ctl + CW_BAR) + args.li * XCD_BAR_WORDS, F.MISC + 8);
    const int lo = args.ph_lo, hi = args.ph_hi;
#define IN(k) (lo <= (k) && (k) < hi)
#define SEAM(k) do { if (IN(k) && IN((k) + 1)) xcd_barrier(bar); } while (0)

    if (IN(0)) { p0_prologue(F); } SEAM(0);
    if (IN(1)) { p1_modulate(F); } SEAM(1);
    if (IN(2)) {
        pg8::Gemm g{wsp<pg8::bf16_t>(F, WS_HN), wsp<pg8::bf16_t>(F, WS_WIN), S, NPAD, D}; pg8::StaticOrder So; So.init(S, NPAD, F.G, (int)blockIdx.x);
        EpiProj E{wsp<bf16>(F, WS_PROJ), wsp<float>(F, WS_GATES)};
        pg8::gemm_phase<EpiProj, pg8::StaticOrder, true, true>(F.lds + RING_OFF, g, So, E);
    } SEAM(2);
    if (IN(3)) { p3_prep(F); } SEAM(3);
    if (IN(4)) { p4_scan(F); } SEAM(4);
    if (IN(5)) { p5_mlstm_out(F); p5_attention(F, (char*)lds); } SEAM(5);
    if (IN(6)) {
        pg8::Gemm g{wsp<pg8::bf16_t>(F, WS_CONCAT), wsp<pg8::bf16_t>(F, WS_WOUT), S, D, D}; pg8::StaticOrder So; So.init(S, D, F.G, (int)blockIdx.x);
        EpiOut E{F.in[IN_X], wsp<float>(F, WS_MOD) + 2 * D, wsp<float>(F, WS_H1)};
        pg8::gemm_phase<EpiOut, pg8::StaticOrder, false, true>(F.lds + RING_OFF, g, So, E);
    } SEAM(6);
    if (IN(7)) { p7_router(F); } SEAM(7);
    if (IN(8)) { p8_gather(F); } SEAM(8);
    if (IN(9)) {
        build_expert_table(F, (const int*)(F.ws + WS_POS) + S * 4);
        pg8::Gemm g{wsp<pg8::bf16_t>(F, WS_XG), wsp<pg8::bf16_t>(F, WS_WUG), MAXROWS, 4096, D}; GroupedOrder So{(const LAS int*)(F.lds + TAB_OFF), 16, F.G, (int)blockIdx.x};
        EpiSwiglu E{wsp<bf16>(F, WS_ACT), F.in[IN_BUG]};
        pg8::gemm_phase<EpiSwiglu, GroupedOrder, true, true>(F.lds + RING_OFF, g, So, E);
    } SEAM(9);
    if (IN(10)) {
        build_expert_table(F, (const int*)(F.ws + WS_POS) + S * 4);
        pg8::Gemm g{wsp<pg8::bf16_t>(F, WS_ACT), wsp<pg8::bf16_t>(F, WS_WD), MAXROWS, D, FF}; GroupedOrder So{(const LAS int*)(F.lds + TAB_OFF), 8, F.G, (int)blockIdx.x};
        EpiDown E{wsp<bf16>(F, WS_Y), F.in[IN_BD], wsp<float>(F, WS_ROWW)};
        pg8::gemm_phase<EpiDown, GroupedOrder, true, true>(F.lds + RING_OFF, g, So, E);
    } SEAM(10);
    if (IN(11)) { p11_final(F); }
#undef IN
#undef SEAM
}
}
#ifndef MK_DEBUG
#define MK_DEBUG 0
#endif
#ifndef MK_PH_END
#define MK_PH_END mk::N_PHASES
#endif
#ifndef MK_SPLIT
#define MK_SPLIT 0
#endif
extern "C" void kernel_launch(void* const* d_in, const int* in_sizes, int n_in, void* d_out, int out_size, void* d_ws, size_t ws_size, hipStream_t stream) {
    using namespace mk;
    static int grid = 0;
    if (grid == 0) {
        int dev = 0, cus = 0, per_cu = 0;
        if (hipGetDevice(&dev) != hipSuccess || hipDeviceGetAttribute(&cus, hipDeviceAttributeMultiprocessorCount, dev) != hipSuccess) { fprintf(stderr, "kernel_launch: device query failed\n"); grid = -1; return; }
        if (hipFuncSetAttribute((const void*)mega_fwd, hipFuncAttributeMaxDynamicSharedMemorySize, LDS_BYTES) != hipSuccess) { fprintf(stderr, "kernel_launch: hipFuncSetAttribute failed\n"); grid = -1; return; }
        if (hipOccupancyMaxActiveBlocksPerMultiprocessor(&per_cu, (const void*)mega_fwd, NTHR, LDS_BYTES) != hipSuccess || per_cu < 1) fprintf(stderr, "kernel_launch: occupancy query reports %d\n", per_cu);
        (void)hipGetLastError();
        grid = cus;
        if (n_in != 24 || out_size != S * D || ws_size < (MK_DEBUG ? WS_NAIVE + (size_t)2300 * MiB : WS_END)) fprintf(stderr, "kernel_launch: unexpected sizes n_in %d out %d ws %zu\n", n_in, out_size, ws_size);
    }
    if (grid < 0) return;
    (void)hipMemsetAsync((char*)d_ws + WS_CTL, 0, CTL_ZERO_BYTES, stream);
    Args a{};
    for (int i = 0; i < 24; ++i) a.in[i] = (const float*)d_in[i];
    a.out = (float*)d_out; a.ws = (unsigned char*)d_ws;
#if MK_DEBUG
    nv::naive_forward(d_in, (float*)d_out, (char*)d_ws + WS_NAIVE, stream);
#endif
#if MK_SPLIT
    for (int p = 0; p < MK_PH_END; ++p) { a.ph_lo = p; a.ph_hi = p + 1; a.li = p; hipLaunchKernelGGL(mega_fwd, dim3(grid), dim3(NTHR), LDS_BYTES, stream, a); }
#else
    a.ph_lo = 0; a.ph_hi = MK_PH_END; a.li = 0;
    hipLaunchKernelGGL(mega_fwd, dim3(grid), dim3(NTHR), LDS_BYTES, stream, a);
#endif
    { const hipError_t le = hipPeekAtLastError(); if (le != hipSuccess) fprintf(stderr, "kernel_launch: launch failed: %s\n", hipGetErrorName(le)); }
#if MK_DEBUG
    {
        nv::NaiveWs w = nv::carve((char*)d_ws + WS_NAIVE);
        double* slots = (double*)((char*)d_ws + WS_CTL + 512 * 1024);
        unsigned char* ws = (unsigned char*)d_ws; int nc = 0;
        MK_DEBUG_CHECKS
        dbg::k_finish<<<1024, 256, 0, stream>>>((float*)d_out, (size_t)S * D, slots, nc, 1e-3);
    }
#endif
}
```

```cpp
#include <hip/hip_runtime.h>
#include <hip/hip_bf16.h>
#include <cstdio>
#include <cstdint>
namespace pg8 {
#define PG8_LAS __attribute__((address_space(3)))
typedef unsigned short bf16_t;
typedef short bf16x8 __attribute__((ext_vector_type(8)));
typedef float f32x4 __attribute__((ext_vector_type(4)));
typedef unsigned u32x4 __attribute__((ext_vector_type(4)));
constexpr int BM = 256, BK = 64, HALF = 128, HTB = HALF * BK * 2  , STAGE_BYTES = 8 * HTB, NXCD = 8, WGM = 8;

__host__ __device__ __forceinline__ int lds_byte(int r, int c) { const int st = (r >> 4) * 2 + (c >> 5), rr = r & 15, cc = c & 31, ob = rr * 64 + cc * 2; return st * 1024 + (ob ^ (((ob >> 9) & 1) << 5)); }
__host__ __device__ __forceinline__ void stage_rc(int b, int& R, int& C) { const int st = b / 1024, sb = b % 1024, swz = sb ^ (((sb >> 9) & 1) << 5); R = (st >> 1) * 16 + swz / 64; C = (st & 1) * 32 + (swz % 64) / 2; }
__host__ __device__ __forceinline__ int perm32(int rho) { const int n = rho >> 4, i = rho & 15; return 8 * (i >> 2) + 4 * n + (i & 3); }

struct Unit { int pm, pn, pb, e; };
struct Gemm { const bf16_t* A; const bf16_t* Bt; int M, N, K; };

struct StaticOrder {
    int nM, nN, nwg, G, c;
    __host__ __device__ void init(int M, int N, int G_, int c_) { nM = M / BM; nN = N / BM; nwg = nM * nN; G = G_; c = c_; }
    __host__ __device__ bool next(int i, Unit& u) const {
        const long L = (long)i * G + c; if (L >= nwg) return false;
        int wgid = (int)L; { const int q = nwg / NXCD, r = nwg % NXCD, xcd = wgid % NXCD, off = wgid / NXCD; wgid = (xcd < r ? xcd * (q + 1) : r * (q + 1) + (xcd - r) * q) + off; }
        const int nig = WGM * nN, gid = wgid / nig, fm = gid * WGM, gsz = (nM - fm) < WGM ? (nM - fm) : WGM;
        u.pm = fm + ((wgid % nig) % gsz); u.pn = (wgid % nig) / gsz; u.pb = u.pn; u.e = 0; return true;
    }
    __device__ __forceinline__ void a_ready(const Unit&) const {}
    __device__ __forceinline__ void done(const Unit&) const {}
};

__device__ __forceinline__ unsigned cvt_pk_bf16(float lo, float hi) { unsigned r; asm volatile("v_cvt_pk_bf16_f32 %0, %1, %2" : "=v"(r) : "v"(lo), "v"(hi)); return r; }
template <class Epi, class Sched, bool ALIGN_EPI = false, bool SP2 = false>
__device__ __forceinline__ void gemm_phase(PG8_LAS unsigned char* lds, const Gemm g, const Sched& S, const Epi& E) {
    const int tid = threadIdx.x, wid = __builtin_amdgcn_readfirstlane(tid >> 6), lane = tid & 63, wr = wid >> 2, wc = wid & 3, fr = lane & 15, fq = lane >> 4;
    const int K = g.K, nt = K / BK;
    unsigned voffA[2], voffB[2];
#pragma unroll
    for (int i = 0; i < 2; ++i) { int R, C; stage_rc(tid * 16 + i * 8192, R, C); const int Rb = Epi::PERM ? ((R & ~31) + perm32(R & 31)) : R;
        voffA[i] = (unsigned)(R * K + C) * 2u; voffB[i] = (unsigned)(Rb * K + C) * 2u; }
    const size_t kstep = (size_t)(BK * 2);
    const size_t hstep = (size_t)HALF * K * 2;
    const size_t tstep = 2 * hstep;
    const unsigned ldsw = (unsigned)wid * 1024u;
    const int aoff = lds_byte(wr * 64 + fr, fq * 8), boff = lds_byte(wc * 32 + fr, fq * 8);
#define PG8_SA(b, h) (((b) * 2 + (h)) * HTB)
#define PG8_SB(b, h) ((4 + (b) * 2 + (h)) * HTB)
#define PG8_STAGE(bufoff, gbase, voff) do { _Pragma("unroll") for (int _i = 0; _i < 2; ++_i) \
        __builtin_amdgcn_global_load_lds((const unsigned*)((const char*)(gbase) + (voff)[_i]), (PG8_LAS unsigned*)(lds + (bufoff) + ldsw + _i * 8192), 16, 0, 0); } while (0)
#define PG8_LDA(dst, b, h) do { _Pragma("unroll") for (int m = 0; m < 4; ++m) _Pragma("unroll") for (int k = 0; k < 2; ++k) dst[m][k] = *(const PG8_LAS bf16x8*)(lds + PG8_SA(b, h) + aoff + m * 2048 + k * 1024); } while (0)
#define PG8_LDB(dst, b, h) do { _Pragma("unroll") for (int n = 0; n < 2; ++n) _Pragma("unroll") for (int k = 0; k < 2; ++k) dst[n][k] = *(const PG8_LAS bf16x8*)(lds + PG8_SB(b, h) + boff + n * 2048 + k * 1024); } while (0)
#define PG8_MMA(ai, bj, At, Bt) do { __builtin_amdgcn_s_setprio(1); _Pragma("unroll") for (int m = 0; m < 4; ++m) _Pragma("unroll") for (int n = 0; n < 2; ++n) _Pragma("unroll") for (int k = 0; k < 2; ++k) \
        acc[ai][bj][m][n] = __builtin_amdgcn_mfma_f32_16x16x32_bf16(Bt[n][k], At[m][k], acc[ai][bj][m][n], 0, 0, 0); __builtin_amdgcn_s_setprio(0); } while (0)
#define PG8_WAIT_V(n) asm volatile("s_waitcnt vmcnt(" #n ")" ::: "memory")
#define PG8_WAIT_L(n) asm volatile("s_waitcnt lgkmcnt(" #n ")" ::: "memory")
#define PG8_BAR __builtin_amdgcn_s_barrier()
#define PG8_SCHED __builtin_amdgcn_sched_barrier(0)
    Unit cur, nxt; int ui = 0;
    if (!S.next(0, cur)) return;
    f32x4 acc[2][2][4][2];
#pragma unroll
    for (int a = 0; a < 2; ++a)
#pragma unroll
        for (int b = 0; b < 2; ++b)
#pragma unroll
            for (int m = 0; m < 4; ++m)
#pragma unroll
                for (int n = 0; n < 2; ++n) acc[a][b][m][n] = (f32x4){0.f, 0.f, 0.f, 0.f};
    bf16x8 At[4][2], B0[2][2], B1[2][2];
    const char* cA = (const char*)g.A + (size_t)cur.pm * tstep; const char* cB = (const char*)g.Bt + (size_t)cur.pb * tstep;
    S.a_ready(cur);
    if constexpr (SP2) {
        PG8_STAGE(PG8_SB(0, 0), cB, voffB); PG8_STAGE(PG8_SB(0, 1), cB + hstep, voffB); PG8_STAGE(PG8_SA(0, 0), cA, voffA); PG8_STAGE(PG8_SA(0, 1), cA + hstep, voffA);
        if (wr == 1) PG8_BAR;
        PG8_WAIT_V(2); PG8_BAR;
        PG8_STAGE(PG8_SB(1, 0), cB + kstep, voffB); PG8_STAGE(PG8_SA(1, 0), cA + kstep, voffA); PG8_STAGE(PG8_SB(1, 1), cB + hstep + kstep, voffB);
        PG8_WAIT_V(6); PG8_BAR;
    } else {
        PG8_STAGE(PG8_SB(0, 0), cB, voffB); PG8_STAGE(PG8_SA(0, 0), cA, voffA); PG8_STAGE(PG8_SB(0, 1), cB + hstep, voffB); PG8_STAGE(PG8_SA(0, 1), cA + hstep, voffA);
        if (wr == 1) PG8_BAR;
        PG8_WAIT_V(4); PG8_BAR;
        PG8_STAGE(PG8_SB(1, 0), cB + kstep, voffB); PG8_STAGE(PG8_SA(1, 0), cA + kstep, voffA); PG8_STAGE(PG8_SB(1, 1), cB + hstep + kstep, voffB);
        PG8_WAIT_V(6); PG8_BAR;
    }
    for (;;) {
        const bool has_next = S.next(ui + 1, nxt);
        const char* nA = has_next ? (const char*)g.A + (size_t)nxt.pm * tstep : cA; const char* nB = has_next ? (const char*)g.Bt + (size_t)nxt.pb * tstep : cB;
        for (int t = 0; t < nt; t += 2) {
            const bool last = (t == nt - 2);
            const char* a1 = cA + (size_t)(t + 1) * kstep;
            const char* a2 = last ? nA : cA + (size_t)(t + 2) * kstep; const char* b2 = last ? nB : cB + (size_t)(t + 2) * kstep;
            const char* a3 = a2 + kstep; const char* b3 = b2 + kstep;
            if (last && has_next) S.a_ready(nxt);
            if constexpr (SP2) {
            PG8_LDB(B0, 0, 0); PG8_LDB(B1, 0, 1); PG8_SCHED; PG8_LDA(At, 0, 0); PG8_STAGE(PG8_SA(1, 1), a1 + hstep, voffA);
            PG8_WAIT_V(8); PG8_WAIT_L(0); PG8_BAR; PG8_MMA(0, 0, At, B0); PG8_MMA(0, 1, At, B1); PG8_BAR; PG8_SCHED;
            PG8_LDA(At, 0, 1); PG8_STAGE(PG8_SB(0, 0), b2, voffB); PG8_STAGE(PG8_SB(0, 1), b2 + hstep, voffB); PG8_STAGE(PG8_SA(0, 0), a2, voffA);
            PG8_WAIT_V(8); PG8_WAIT_L(0); PG8_BAR; PG8_MMA(1, 0, At, B0); PG8_MMA(1, 1, At, B1); PG8_BAR; PG8_SCHED;
            PG8_LDB(B0, 1, 0); PG8_LDB(B1, 1, 1); PG8_SCHED; PG8_LDA(At, 1, 0); PG8_STAGE(PG8_SA(0, 1), a2 + hstep, voffA);
            PG8_WAIT_V(8); PG8_WAIT_L(0); PG8_BAR; PG8_MMA(0, 0, At, B0); PG8_MMA(0, 1, At, B1); PG8_BAR; PG8_SCHED;
            PG8_LDA(At, 1, 1); PG8_STAGE(PG8_SB(1, 0), b3, voffB); PG8_STAGE(PG8_SB(1, 1), b3 + hstep, voffB); PG8_STAGE(PG8_SA(1, 0), a3, voffA);
            PG8_WAIT_V(8); PG8_WAIT_L(0); PG8_BAR; PG8_MMA(1, 0, At, B0); PG8_MMA(1, 1, At, B1); PG8_BAR; PG8_SCHED;
            } else {
            PG8_LDB(B0, 0, 0); PG8_SCHED; PG8_LDA(At, 0, 0); PG8_STAGE(PG8_SA(1, 1), a1 + hstep, voffA);
            PG8_WAIT_L(8); PG8_BAR; PG8_WAIT_L(0); PG8_MMA(0, 0, At, B0); PG8_BAR; PG8_SCHED;
            PG8_LDB(B1, 0, 1); PG8_STAGE(PG8_SB(0, 0), b2, voffB);
            PG8_BAR; PG8_WAIT_L(0); PG8_MMA(0, 1, At, B1); PG8_BAR;
            PG8_LDA(At, 0, 1); PG8_STAGE(PG8_SA(0, 0), a2, voffA);
            PG8_BAR; PG8_WAIT_L(0); PG8_MMA(1, 0, At, B0); PG8_BAR; PG8_SCHED;
            PG8_STAGE(PG8_SB(0, 1), b2 + hstep, voffB);
            PG8_WAIT_V(6); PG8_BAR; PG8_MMA(1, 1, At, B1); PG8_BAR;
            PG8_LDB(B0, 1, 0); PG8_SCHED; PG8_LDA(At, 1, 0); PG8_STAGE(PG8_SA(0, 1), a2 + hstep, voffA);
            PG8_WAIT_L(8); PG8_BAR; PG8_WAIT_L(0); PG8_MMA(0, 0, At, B0); PG8_BAR; PG8_SCHED;
            PG8_LDB(B1, 1, 1); PG8_STAGE(PG8_SB(1, 0), b3, voffB);
            PG8_BAR; PG8_WAIT_L(0); PG8_MMA(0, 1, At, B1); PG8_BAR;
            PG8_LDA(At, 1, 1); PG8_STAGE(PG8_SA(1, 0), a3, voffA);
            PG8_BAR; PG8_WAIT_L(0); PG8_MMA(1, 0, At, B0); PG8_BAR; PG8_SCHED;
            PG8_STAGE(PG8_SB(1, 1), b3 + hstep, voffB);
            PG8_WAIT_V(6); PG8_BAR; PG8_MMA(1, 1, At, B1); PG8_BAR;
            }
        }
        if constexpr (ALIGN_EPI) { if (wr == 0) PG8_BAR; }
        if constexpr (!Epi::AFTER_DRAIN) { E(acc, cur, wr, wc, fr, fq); S.done(cur); }
        if (!has_next) break;
#pragma unroll
        for (int a = 0; a < 2; ++a)
#pragma unroll
            for (int b = 0; b < 2; ++b)
#pragma unroll
                for (int m = 0; m < 4; ++m)
#pragma unroll
                    for (int n = 0; n < 2; ++n) acc[a][b][m][n] = (f32x4){0.f, 0.f, 0.f, 0.f};
        cur = nxt; cA = nA; cB = nB; ++ui;
        if constexpr (ALIGN_EPI) { if (wr == 1) PG8_BAR; }
    }
    PG8_WAIT_V(0);
    if constexpr (!ALIGN_EPI) { if (wr == 0) PG8_BAR; }
    PG8_BAR;
    if constexpr (Epi::AFTER_DRAIN) { E.fused(acc, cur, wr, wc, fr, fq, lds, wid, lane); S.done(cur); }
#undef PG8_SA
#undef PG8_SB
#undef PG8_STAGE
#undef PG8_LDA
#undef PG8_LDB
#undef PG8_MMA
#undef PG8_WAIT_V
#undef PG8_WAIT_L
#undef PG8_BAR
#undef PG8_SCHED
}
}
#define GAS __attribute__((address_space(1)))
#define LAS __attribute__((address_space(3)))
typedef unsigned short bf16;
typedef unsigned v4u __attribute__((ext_vector_type(4)));
typedef float f32x4 __attribute__((ext_vector_type(4)));
typedef short bf16x8 __attribute__((ext_vector_type(8)));
typedef GAS unsigned gu32;
typedef GAS unsigned long long gu64;
#define RLX_AGENT __ATOMIC_RELAXED, __HIP_MEMORY_SCOPE_AGENT
#define LDS_WAIT() asm volatile("s_waitcnt lgkmcnt(0)" ::: "memory")
#define VM_WAIT() asm volatile("s_waitcnt vmcnt(0)" ::: "memory")
__device__ __forceinline__ unsigned long long rt() { return __builtin_amdgcn_s_memrealtime(); }
__device__ __forceinline__ unsigned f2bf(float f) { unsigned u = __builtin_bit_cast(unsigned, f); return (u + 0x7fffu + ((u >> 16) & 1u)) >> 16; }
__device__ __forceinline__ unsigned pk2(float lo, float hi) { return f2bf(lo) | (f2bf(hi) << 16); }

#define XB_TMO      128
#define XB_XCNT(j)  (256  + 64 * (j))
#define XB_XSUB(j)  (1280 + 64 * (j))
#define XB_XGEN(j)  (2304 + 64 * (j))
#define XB_TOP      3328
#define XB_TOPGEN   3392
#define XCD_BAR_WORDS 3456
#define XB_SPIN_CAP (1u << 18)

__device__ __forceinline__ unsigned xb_ld(unsigned* p)              { return __hip_atomic_load(p, __ATOMIC_RELAXED, __HIP_MEMORY_SCOPE_AGENT); }
__device__ __forceinline__ unsigned xb_add(unsigned* p, unsigned v) { return __hip_atomic_fetch_add(p, v, __ATOMIC_RELAXED, __HIP_MEMORY_SCOPE_AGENT); }
__device__ __forceinline__ unsigned xb_xcc_id() { return (unsigned)__builtin_amdgcn_s_getreg((3 << 11) | 20) & 0xFu; }
#define XB_SPIN(cond, bar) do { unsigned _sp = 0; while (cond) { __builtin_amdgcn_s_sleep(1); \
    if ((++_sp & 255u) == 0u) { if (xb_ld(&(bar)[XB_TMO])) break; if (_sp > XB_SPIN_CAP) { atomicAdd(&(bar)[XB_TMO], 1u); break; } } } } while (0)

struct XcdBarrier {
    unsigned* bar; unsigned x;
    volatile LAS unsigned* st;
};

__device__ __forceinline__ XcdBarrier xcd_barrier_post(unsigned* bar, volatile LAS unsigned* st) {
    XcdBarrier b; b.bar = bar; b.x = xb_xcc_id(); b.st = st;
    if (threadIdx.x == 0) (void)xb_add(&bar[XB_XCNT(b.x)], 1u);
    return b;
}
__device__ __forceinline__ void xcd_barrier_complete(unsigned* bar, unsigned x, unsigned& nloc, unsigned& nx) {
    const unsigned G = gridDim.x * gridDim.y * gridDim.z;
    unsigned sum, cnt, mine, sp = 0u;
    for (;;) {
        sum = 0u; cnt = 0u; mine = 0u;
#pragma unroll
        for (unsigned j = 0; j < 16; ++j) { const unsigned c = xb_ld(&bar[XB_XCNT(j)]); sum += c; cnt += (c > 0u) ? 1u : 0u; mine = (j == x) ? c : mine; }
        if (sum == G) break;
        __builtin_amdgcn_s_sleep(1);
        if ((++sp & 255u) == 0u) { if (xb_ld(&bar[XB_TMO])) break; if (sp > XB_SPIN_CAP) { atomicAdd(&bar[XB_TMO], 1u); break; } }
    }
    nloc = mine > 0u ? mine : 1u; nx = cnt > 0u ? cnt : 1u;
}

__device__ __forceinline__ void xcd_barrier(const XcdBarrier& b) {
    asm volatile("s_waitcnt vmcnt(0)" ::: "memory");
    __syncthreads();
    if (threadIdx.x == 0) {
        unsigned* bar = b.bar;
        __builtin_amdgcn_s_waitcnt(0);
        unsigned nloc = b.st[0], nx = b.st[1];
        if (nloc == 0u) { xcd_barrier_complete(bar, b.x, nloc, nx); b.st[0] = nloc; b.st[1] = nx; }
        const unsigned old = xb_add(&bar[XB_XSUB(b.x)], 1u);
        const unsigned gen = old / nloc;
        if (old + 1u == (gen + 1u) * nloc) {
            __builtin_amdgcn_fence(__ATOMIC_RELEASE, "agent");
            asm volatile("s_waitcnt vmcnt(0)" ::: "memory");
            const unsigned og = xb_add(&bar[XB_TOP], 1u);
            const unsigned tg = og / nx;
            if (og + 1u == (tg + 1u) * nx) xb_add(&bar[XB_TOPGEN], 1u);
            else XB_SPIN(xb_ld(&bar[XB_TOPGEN]) == tg, bar);
            __builtin_amdgcn_fence(__ATOMIC_ACQUIRE, "agent");
            xb_add(&bar[XB_XGEN(b.x)], 1u);
            asm volatile("s_waitcnt vmcnt(0)" ::: "memory");
        } else {
            XB_SPIN(xb_ld(&bar[XB_XGEN(b.x)]) == gen, bar);
            __builtin_amdgcn_fence(__ATOMIC_ACQUIRE, "agent");
            asm volatile("s_waitcnt vmcnt(0)" ::: "memory");
        }
    }
    __syncthreads();
}
namespace mk {
constexpr int S = 8192, D = 2048, NPROJ = 6160, NPP = 6144, NPAD = 6400, NE = 32, FF = 2048, NWAVES = 8, NTHR = 512;
constexpr int C_MQ = 0, C_MK = 512, C_MV = 1024, C_MO = 2048, C_FQ = 3072, C_FK = 4096, C_FV = 5120;
constexpr int MAXROWS = S * 4 + NE * 256;
constexpr int NCH = 128, LCH = 64;
constexpr size_t MiB = 1u << 20;
constexpr size_t WS_CTL = 0, CTL_ZERO_BYTES = 1 * MiB;
constexpr size_t WS_MODP = 1 * MiB;
constexpr size_t WS_MOD = 2 * MiB;
constexpr size_t WS_GATES = 3 * MiB;
constexpr size_t WS_F = 4 * MiB;
constexpr size_t WS_NL = 5 * MiB;
constexpr size_t WS_NS = 6 * MiB;
constexpr size_t WS_GLAL = 7 * MiB;
constexpr size_t WS_MS = 7 * MiB + 65536;
constexpr size_t WS_TOPI = 8 * MiB;
constexpr size_t WS_TOPW = 9 * MiB;
constexpr size_t WS_HIST = 10 * MiB;
constexpr size_t WS_LRANK = 11 * MiB;
constexpr size_t WS_POS = 12 * MiB;
constexpr size_t WS_ROWW = 13 * MiB;
constexpr size_t WS_WIN = 16 * MiB;
constexpr size_t WS_WOUT = 42 * MiB;
constexpr size_t WS_HN = 50 * MiB;
constexpr size_t WS_PROJ = 82 * MiB;
constexpr size_t WS_UL = 178 * MiB;
constexpr size_t WS_CS = 242 * MiB;
constexpr size_t WS_CONCAT = 274 * MiB;
constexpr size_t WS_H1 = 306 * MiB;
constexpr size_t WS_XG = 370 * MiB;
constexpr size_t WS_ACT = 530 * MiB;
constexpr size_t WS_Y = 690 * MiB;
constexpr size_t WS_WUG = 850 * MiB;
constexpr size_t WS_WD = 1362 * MiB;
constexpr size_t WS_OPART = 1618 * MiB;
constexpr size_t WS_MLP = 1786 * MiB;
constexpr size_t WS_JLO = 1789 * MiB;
constexpr size_t WS_END = 1790 * MiB;
constexpr size_t WS_NAIVE = 1792 * MiB;
constexpr int CW_TMO = 0, CW_CODE = 1, CW_BAR = 4096;
constexpr int RING_OFF = 0, RING_BYTES = 131072;
constexpr int LDSCTL_OFF = RING_BYTES, MISC_OFF = LDSCTL_OFF + 320;
constexpr int TAB_OFF = LDSCTL_OFF + 1024;
constexpr int ATT_CH = 16;
constexpr int LDS_BYTES = 147456;
}
namespace mk {
typedef float f32x2 __attribute__((ext_vector_type(2)));
typedef unsigned u32x2 __attribute__((ext_vector_type(2)));
typedef float f32x16 __attribute__((ext_vector_type(16)));
struct Frame {
    LAS unsigned char* lds;
    volatile LAS unsigned* MISC;
    gu32* ctl;
    int tid, lane, wave, vcu, G;
    const float* in[24];
    float* out; unsigned char* ws;
};
#define IN_X 0
#define IN_C 1
#define IN_WADA 2
#define IN_BADA 3
#define IN_NMIX 4
#define IN_WIN 5
#define IN_BI 6
#define IN_BF 7
#define IN_FOXBF 8
#define IN_FOXQN 9
#define IN_FOXKN 10
#define IN_MOUTN 11
#define IN_FOUTN 12
#define IN_WOUT 13
#define IN_NFFN 14
#define IN_WR 15
#define IN_BR 16
#define IN_WUG 17
#define IN_BUG 18
#define IN_WD 19
#define IN_BD 20
#define IN_WAF 21
#define IN_BAF 22
#define IN_NFIN 23
template <class T> __device__ __forceinline__ T* wsp(const Frame& F, size_t off) { return (T*)(F.ws + off); }
__device__ __forceinline__ float wave_sum(float v) {
#pragma unroll
    for (int o = 1; o < 64; o <<= 1) v += __shfl_xor(v, o);
    return v;
}
__device__ __forceinline__ float sigmoid_f(float v) { return 1.f / (1.f + __expf(-v)); }
__device__ __forceinline__ float log_sigmoid_f(float v) { return fminf(v, 0.f) - log1pf(__expf(-fabsf(v))); }
__device__ __forceinline__ float softcap_f(float v) { return 15.f * tanhf(v * (1.f / 15.f)); }
__device__ __forceinline__ float bf2f(unsigned short b) { return __uint_as_float(((unsigned)b) << 16); }

struct CvtItem { const float* src; bf16* dst; };
__device__ __forceinline__ void cvt_load(const CvtItem& it, int ldw, f32x4 (&v)[16], int lane) {
    const float* p = it.src + (size_t)((lane >> 4) * 16) * ldw + (lane & 15) * 4;
#pragma unroll
    for (int i = 0; i < 16; ++i) v[i] = *(const GAS f32x4*)(p + (size_t)i * ldw);
}
__device__ __forceinline__ void cvt_store(const CvtItem& it, int K, const f32x4 (&v)[16], LAS unsigned char* scr, int lane) {
    const int c = lane & 15, g = lane >> 4;
#pragma unroll
    for (int j = 0; j < 4; ++j) {
        v4u a, b;
        a.x = pk2(v[0][j], v[1][j]); a.y = pk2(v[2][j], v[3][j]); a.z = pk2(v[4][j], v[5][j]); a.w = pk2(v[6][j], v[7][j]);
        b.x = pk2(v[8][j], v[9][j]); b.y = pk2(v[10][j], v[11][j]); b.z = pk2(v[12][j], v[13][j]); b.w = pk2(v[14][j], v[15][j]);
        LAS unsigned char* q = scr + (4 * c + j) * 144 + 32 * g;
        *(LAS v4u*)q = a; *(LAS v4u*)(q + 16) = b; }
    LDS_WAIT(); asm volatile("" ::: "memory");
#pragma unroll
    for (int i = 0; i < 8; ++i) { const int row = (lane >> 3) + 8 * i; const v4u o = *(const LAS v4u*)(scr + row * 144 + (lane & 7) * 16);
        *(GAS v4u*)(it.dst + (size_t)row * K + (lane & 7) * 8) = o; }
    LDS_WAIT(); asm volatile("" ::: "memory");
}
constexpr int CV_UG = NE * 32 * 64, CV_D = NE * 32 * 32, CV_IN = 32 * 96, CV_OUT = 32 * 32, CV_TOTAL = CV_UG + CV_D + CV_IN + CV_OUT;
__device__ __forceinline__ CvtItem cvt_item(const Frame& F, int it, int& ldw, int& K) {
    CvtItem r;
    if (it < CV_UG) { const int e = it >> 11, q = it & 2047, kb = q >> 6, nb = q & 63, d0 = nb * 64, j = d0 >> 8, wv = d0 & 255, sc = wv < 128 ? 128 * j + wv : 2048 + 128 * j + (wv - 128);
        ldw = 4096; K = D; r.src = F.in[IN_WUG] + (size_t)e * D * 4096 + (size_t)(kb * 64) * 4096 + sc; r.dst = wsp<bf16>(F, WS_WUG) + (size_t)e * 4096 * D + (size_t)d0 * D + kb * 64; return r; }
    it -= CV_UG;
    if (it < CV_D) { const int e = it >> 10, q = it & 1023, kb = q >> 5, nb = q & 31;
        ldw = D; K = FF; r.src = F.in[IN_WD] + (size_t)e * FF * D + (size_t)(kb * 64) * D + nb * 64; r.dst = wsp<bf16>(F, WS_WD) + (size_t)e * D * FF + (size_t)(nb * 64) * FF + kb * 64; return r; }
    it -= CV_D;
    if (it < CV_IN) { const int kb = it / 96, nb = it % 96, d0 = nb * 64, sc = d0 < 3072 ? d0 : d0 + 8;
        ldw = NPROJ; K = D; r.src = F.in[IN_WIN] + (size_t)(kb * 64) * NPROJ + sc; r.dst = wsp<bf16>(F, WS_WIN) + (size_t)d0 * D + kb * 64; return r; }
    it -= CV_IN;
    { const int kb = it >> 5, nb = it & 31; ldw = D; K = D; r.src = F.in[IN_WOUT] + (size_t)(kb * 64) * D + nb * 64; r.dst = wsp<bf16>(F, WS_WOUT) + (size_t)(nb * 64) * D + kb * 64; return r; }
}
__device__ __forceinline__ void p0_prologue(Frame& F) {
    const int gw = F.vcu * NWAVES + F.wave, NGW = F.G * NWAVES, lane = F.lane;
    {
        const float* c = F.in[IN_C]; float* modp = wsp<float>(F, WS_MODP);
        for (int task = gw; task < 4096; task += NGW) {
            const int cg = task & 255, ks = task >> 8, j = cg * 64 + lane;
            const float* w; int ld, col;
            if (j < 6 * D) { w = F.in[IN_WADA]; ld = 6 * D; col = j; } else { w = F.in[IN_WAF]; ld = 2 * D; col = j - 6 * D; }
            const float c0 = c[ks * 128 + lane], c1 = c[ks * 128 + 64 + lane];
            const float s0 = c0 * sigmoid_f(c0), s1 = c1 * sigmoid_f(c1);
            const float* wp = w + (size_t)(ks * 128) * ld + col; float acc = 0.f;
#pragma unroll 16
            for (int i = 0; i < 64; ++i) acc += __builtin_bit_cast(float, __builtin_amdgcn_readlane(__builtin_bit_cast(int, s0), i)) * wp[(size_t)i * ld];
#pragma unroll 16
            for (int i = 0; i < 64; ++i) acc += __builtin_bit_cast(float, __builtin_amdgcn_readlane(__builtin_bit_cast(int, s1), i)) * wp[(size_t)(64 + i) * ld];
            modp[ks * 16384 + j] = acc;
        }
    }
    {
        LAS unsigned char* scr = F.lds + RING_OFF + F.wave * 9216;
        int it = gw;
        if (it < CV_TOTAL) {
            int ldw, K; CvtItem cur = cvt_item(F, it, ldw, K); f32x4 va[16], vb[16];
            cvt_load(cur, ldw, va, lane);
            for (;;) {
                int itn = it + NGW; int ldn = 0, Kn = 0; CvtItem nx = cur; const bool more = itn < CV_TOTAL;
                if (more) { nx = cvt_item(F, itn, ldn, Kn); cvt_load(nx, ldn, vb, lane); }
                cvt_store(cur, K, va, scr, lane);
                if (!more) break;
                it = itn + NGW; const bool more2 = it < CV_TOTAL; CvtItem n2 = nx; int ld2 = 0, K2 = 0;
                if (more2) { n2 = cvt_item(F, it, ld2, K2); cvt_load(n2, ld2, va, lane); }
                cvt_store(nx, Kn, vb, scr, lane);
                if (!more2) break;
                cur = n2; K = K2;
            }
        }
        bf16* win_t = wsp<bf16>(F, WS_WIN);
        for (int i2 = gw; i2 < D / 4; i2 += NGW) {
            const int col = lane & 15, k = 4 * i2 + (lane >> 4), sc = col < 8 ? 3072 + col : 6152 + (col - 8);
            win_t[(size_t)(NPP + col) * D + k] = (bf16)f2bf(F.in[IN_WIN][(size_t)k * NPROJ + sc]); }
        const v4u z = {0u, 0u, 0u, 0u};
        for (int i = gw * 64 + lane; i < (NPAD - NPROJ) * D / 8; i += NGW * 64) *(GAS v4u*)(win_t + (size_t)NPROJ * D + (size_t)i * 8) = z;
    }
}
__device__ __forceinline__ void mod_reduce_lds(Frame& F, int j0, int n, LAS float* dst) {
    const float* modp = wsp<float>(F, WS_MODP);
    for (int i = F.tid; i < n; i += NTHR) { const int j = j0 + i; float a = j < 6 * D ? F.in[IN_BADA][j] : F.in[IN_BAF][j - 6 * D];
#pragma unroll
        for (int ks = 0; ks < 16; ++ks) a += modp[ks * 16384 + j];
        dst[i] = a; }
}
__device__ __forceinline__ void modulate_row_bf16(const float* xrow, const float* g, const LAS float* sh, const LAS float* sc, bf16* orow, int lane) {
    const GAS f32x4* xr = (const GAS f32x4*)xrow + lane; f32x4 v[8]; float s2 = 0.f;
#pragma unroll
    for (int j = 0; j < 8; ++j) { v[j] = xr[64 * j]; s2 += (v[j].x * v[j].x + v[j].y * v[j].y) + (v[j].z * v[j].z + v[j].w * v[j].w); }
    const float r = rsqrtf(wave_sum(s2) * (1.f / D) + 1e-6f);
    GAS u32x2* o8 = (GAS u32x2*)orow + lane;
#pragma unroll
    for (int j = 0; j < 8; ++j) { const int c0 = 4 * lane + 256 * j; const f32x4 gg = *(const GAS f32x4*)(g + c0); const f32x4 a = *(const LAS f32x4*)(sc + c0), b = *(const LAS f32x4*)(sh + c0);
        const f32x4 y = v[j] * r * gg * (a + 1.f) + b; u32x2 w; w.x = pk2(y.x, y.y); w.y = pk2(y.z, y.w); o8[64 * j] = w; }
}
__device__ __forceinline__ void p1_modulate(Frame& F) {
    LAS float* shs = (LAS float*)(F.lds + RING_OFF);
    mod_reduce_lds(F, 0, 2 * D, shs);
    if (F.tid < 64) {
        const float* modp = wsp<float>(F, WS_MODP); float* mod = wsp<float>(F, WS_MOD);
        for (int j = blockIdx.x * 64 + F.tid; j < 16384; j += F.G * 64) { float a = j < 6 * D ? F.in[IN_BADA][j] : F.in[IN_BAF][j - 6 * D];
#pragma unroll
            for (int ks = 0; ks < 16; ++ks) a += modp[ks * 16384 + j];
            mod[j] = a; }
    }
    __syncthreads();
    const int gw = F.vcu * NWAVES + F.wave, NGW = F.G * NWAVES; bf16* hn = wsp<bf16>(F, WS_HN);
    for (int m = gw; m < S; m += NGW) modulate_row_bf16(F.in[IN_X] + (size_t)m * D, F.in[IN_NMIX], shs, shs + D, hn + (size_t)m * D, F.lane);
    __syncthreads();
}
using pg8::Unit; using pg8::cvt_pk_bf16;
struct EpiProj {
    static constexpr bool PERM = true, AFTER_DRAIN = false;
    bf16* O; float* gates;
    __device__ __forceinline__ void operator()(const pg8::f32x4 (&acc)[2][2][4][2], const Unit& u, int wr, int wc, int fr, int fq) const {
        const int row0 = u.pm * 256 + wr * 64 + fr;
        if (u.pn < 24) {
            const int col0 = u.pn * 256 + wc * 32 + 8 * fq;
#pragma unroll
            for (int ai = 0; ai < 2; ++ai)
#pragma unroll
                for (int m = 0; m < 4; ++m) { bf16* rowp = O + (size_t)(row0 + ai * 128 + m * 16) * NPP + col0;
#pragma unroll
                    for (int bj = 0; bj < 2; ++bj) { const pg8::f32x4 v0 = acc[ai][bj][m][0], v1 = acc[ai][bj][m][1];
                        pg8::u32x4 w; w.x = cvt_pk_bf16(v0[0], v0[1]); w.y = cvt_pk_bf16(v0[2], v0[3]); w.z = cvt_pk_bf16(v1[0], v1[1]); w.w = cvt_pk_bf16(v1[2], v1[3]);
                        *(pg8::u32x4*)(rowp + bj * 128) = w; } }
        } else if (wc == 0 && fq < 2) {
#pragma unroll
            for (int ai = 0; ai < 2; ++ai)
#pragma unroll
                for (int m = 0; m < 4; ++m) { float* gp = gates + (size_t)(row0 + ai * 128 + m * 16) * 16 + 8 * fq;
                    *(pg8::f32x4*)gp = acc[ai][0][m][0]; *(pg8::f32x4*)(gp + 4) = acc[ai][0][m][1]; }
        }
    }
};
struct EpiOut {
    static constexpr bool PERM = false, AFTER_DRAIN = false;
    const float* x; const float* g1; float* h1;
    __device__ __forceinline__ void operator()(const pg8::f32x4 (&acc)[2][2][4][2], const Unit& u, int wr, int wc, int fr, int fq) const {
        const int row0 = u.pm * 256 + wr * 64 + fr, col0 = u.pn * 256 + wc * 32 + 4 * fq;
        pg8::f32x4 gv[2][2];
#pragma unroll
        for (int bj = 0; bj < 2; ++bj)
#pragma unroll
            for (int n = 0; n < 2; ++n) gv[bj][n] = *(const pg8::f32x4*)(g1 + col0 + bj * 128 + n * 16);
#pragma unroll
        for (int ai = 0; ai < 2; ++ai)
#pragma unroll
            for (int m = 0; m < 4; ++m) { const size_t off = (size_t)(row0 + ai * 128 + m * 16) * D + col0;
#pragma unroll
                for (int bj = 0; bj < 2; ++bj)
#pragma unroll
                    for (int n = 0; n < 2; ++n) { const pg8::f32x4 xv = *(const pg8::f32x4*)(x + off + bj * 128 + n * 16);
                        *(pg8::f32x4*)(h1 + off + bj * 128 + n * 16) = xv + gv[bj][n] * acc[ai][bj][m][n]; } }
    }
};
}
namespace fox {
constexpr int D = 128, SQ = 8192, SKV = 8192; constexpr float THR = 8.f; constexpr bool WSKIP = false;
constexpr int PITCH = 6144;
constexpr int OPITCH = 2048;
constexpr float SCALE = 0.08838834764831845f;
constexpr int NW = 8, QBLK = 32, KVBLK = 64, QB = NW * QBLK;
constexpr int SHM_V = KVBLK * D * 2, SHM_K = KVBLK * D * 2;
constexpr int LDS_BIAS = 2 * SHM_V + 2 * SHM_K + NW * 64 * 4;
constexpr int LDS_BYTES = LDS_BIAS + 512;

using bf16 = __hip_bfloat16;
typedef short bf16x8 __attribute__((ext_vector_type(8)));
typedef short s16x4 __attribute__((ext_vector_type(4)));
typedef float f32x16 __attribute__((ext_vector_type(16)));
typedef float f32x4 __attribute__((ext_vector_type(4)));
typedef unsigned u32x4 __attribute__((ext_vector_type(4)));
template <class A, class Bt> struct same_t { static constexpr bool v = false; };
template <class A> struct same_t<A, A> { static constexpr bool v = true; };

#define KSWZ(row, colB) ((row) * 256 + ((colB) ^ (((row) & 7) << 4)))
#define SBAR() __builtin_amdgcn_sched_barrier(0)
__device__ __forceinline__ int v_st(int k, int c) { const int kk = (k & ~0xC) | ((k & 4) << 1) | ((k & 8) >> 1); return ((kk >> 3) * 4 + (c >> 5)) * 512 + ((kk & 7) * 32 + (c & 31)) * 2; }
__device__ __forceinline__ int v_rd_base(int lane) { return ((lane & 3) << 3) | (((lane >> 2) & 3) << 6) | (((lane >> 4) & 1) << 5) | (((lane >> 5) & 1) << 8); }
constexpr int v_rd_off(int d0, int ks, int half) { return d0 * 512 + ks * 4096 + half * 2048; }
__device__ __forceinline__ int crow(int r, int hi) { return (r & 3) + 8 * (r >> 2) + 4 * hi; }
__device__ __forceinline__ int bias_slot(int kk) { return ((kk >> 2) & 1) * 32 + (kk >> 5) * 16 + (kk & 3) + 4 * ((kk & 31) >> 3); }
__device__ __forceinline__ unsigned cvtpk(float lo, float hi) {
    unsigned r; asm volatile("v_cvt_pk_bf16_f32 %0, %1, %2" : "=v"(r) : "v"(lo), "v"(hi)); return r;
}
__device__ __forceinline__ bf16x8 pack8(f32x4 a, f32x4 b) {
    u32x4 w = {cvtpk(a[0], a[1]), cvtpk(a[2], a[3]), cvtpk(b[0], b[1]), cvtpk(b[2], b[3])};
    return *reinterpret_cast<bf16x8*>(&w);
}
template <class T> __device__ __forceinline__ bf16x8 load8(const T* p) {
    if constexpr (same_t<T, float>::v) { return pack8(*(const f32x4*)p, *(const f32x4*)(p + 4)); }
    else { return *reinterpret_cast<const bf16x8*>(p); }
}
__device__ __forceinline__ void mask_tile(f32x16& p0, f32x16& p1, int dq, unsigned W) {
    const float NEG = -__builtin_inff();
#pragma unroll
    for (int r = 0; r < 16; ++r) {
        const int c = (r & 3) + 8 * (r >> 2);
        if ((unsigned)(dq - c) >= W) p0[r] = NEG;
        if ((unsigned)(dq - c - 32) >= W) p1[r] = NEG;
    }
}
__device__ __forceinline__ void partialSM(f32x16& p0, f32x16& p1, float& m_reg, float& mn, float& alpha) {
    float pmax = p0[0]; for (int r = 1; r < 16; ++r) pmax = fmaxf(pmax, p0[r]); for (int r = 0; r < 16; ++r) pmax = fmaxf(pmax, p1[r]);
    { auto rr = __builtin_amdgcn_permlane32_swap(__float_as_uint(pmax), __float_as_uint(pmax), false, false);
      pmax = fmaxf(__uint_as_float(rr[0]), __uint_as_float(rr[1])); }
    constexpr float C2 = 1.4426950408889634f * SCALE;
    if (__builtin_expect(__all((pmax - m_reg) * SCALE <= THR), 1)) { mn = m_reg; alpha = 1.f; }
    else { mn = fmaxf(m_reg, pmax); alpha = __builtin_amdgcn_exp2f((m_reg - mn) * C2); m_reg = mn; }
    const float mnL = -mn * C2;
    for (int r = 0; r < 16; ++r) p0[r] = fmaf(p0[r], C2, mnL); for (int r = 0; r < 16; ++r) p1[r] = fmaf(p1[r], C2, mnL);
    for (int r = 0; r < 16; ++r) p0[r] = __builtin_amdgcn_exp2f(p0[r]);
}
__device__ __forceinline__ void finishSM(f32x16& p0, f32x16& p1, float alpha, float& l_reg, bf16x8& pa0, bf16x8& pa1, bf16x8& pa2, bf16x8& pa3) {
    for (int r = 0; r < 16; ++r) p1[r] = __builtin_amdgcn_exp2f(p1[r]);
    float ps = 0; for (int r = 0; r < 16; ++r) ps += p0[r]; for (int r = 0; r < 16; ++r) ps += p1[r];
    { auto rr = __builtin_amdgcn_permlane32_swap(__float_as_uint(ps), __float_as_uint(ps), false, false);
      ps = __uint_as_float(rr[0]) + __uint_as_float(rr[1]); }
    l_reg = l_reg * alpha + ps;
#define PK4(P, B_, OUT) do { unsigned a0 = cvtpk(P[B_+0], P[B_+1]), a1 = cvtpk(P[B_+2], P[B_+3]);                          \
        unsigned b0 = cvtpk(P[B_+4], P[B_+5]), b1 = cvtpk(P[B_+6], P[B_+7]);                                             \
        auto r0 = __builtin_amdgcn_permlane32_swap(a0, b0, false, false); auto r1 = __builtin_amdgcn_permlane32_swap(a1, b1, false, false); \
        u32x4 w = {r0[0], r1[0], r0[1], r1[1]}; OUT = *reinterpret_cast<bf16x8*>(&w); } while (0)
    PK4(p0, 0, pa0); PK4(p0, 8, pa1); PK4(p1, 0, pa2); PK4(p1, 8, pa3);
#undef PK4
}
template <int KB, bool SK>
__device__ __forceinline__ void qkt(f32x16& p0, f32x16& p1, const char* K_lds, int r32, int hi, const bf16x8* qr, bool act) {
    if (SK && !act) { const float NEG = -__builtin_inff();
#pragma unroll
        for (int r = 0; r < 16; ++r) { p0[r] = NEG; p1[r] = NEG; } return; }
    { const f32x16* bp = reinterpret_cast<const f32x16*>(K_lds - 2 * SHM_V + LDS_BIAS + KB * 256 + hi * 128); p0 = bp[0]; p1 = bp[1]; }
    const char* kb[4];
#pragma unroll
    for (int dd = 0; dd < 4; ++dd) kb[dd] = K_lds + KB * SHM_K + KSWZ(r32, (dd * 16 + hi * 8) * 2);
#pragma unroll
    for (int d0 = 0; d0 < 8; ++d0) { const char* a = kb[d0 & 3] + (d0 >> 2) * 128;
        bf16x8 b0 = *reinterpret_cast<const bf16x8*>(a);
        bf16x8 b1 = *reinterpret_cast<const bf16x8*>(a + 32 * 256);
        p0 = __builtin_amdgcn_mfma_f32_32x32x16_bf16(b0, qr[d0], p0, 0, 0, 0);
        p1 = __builtin_amdgcn_mfma_f32_32x32x16_bf16(b1, qr[d0], p1, 0, 0, 0); }
}
template <int VB, bool SK>
__device__ __forceinline__ void pv_tile(f32x16* o, int vb0, bf16x8 pa0, bf16x8 pa1, bf16x8 pa2, bf16x8 pa3, bool act) {
    if (SK && !act) return;
#define TRRD(dst, off) asm volatile("ds_read_b64_tr_b16 %0, %1 offset:%2" : "=&v"(dst) : "v"(vb0), "i"(off) : "memory")
#define PV_D0(d0) do { s16x4 l0, l1, l2, l3, h0, h1, h2, h3; constexpr int b_ = VB * SHM_V + v_rd_off(d0, 0, 0);     \
        TRRD(l0, b_); TRRD(h0, b_ + 2048); TRRD(l1, b_ + 4096); TRRD(h1, b_ + 6144); TRRD(l2, b_ + 8192); TRRD(h2, b_ + 10240); TRRD(l3, b_ + 12288); TRRD(h3, b_ + 14336); \
        asm volatile("s_waitcnt lgkmcnt(0)" ::: "memory"); SBAR();                 \
        o[d0] = __builtin_amdgcn_mfma_f32_32x32x16_bf16(pa0, (bf16x8){l0[0], l0[1], l0[2], l0[3], h0[0], h0[1], h0[2], h0[3]}, o[d0], 0, 0, 0);   \
        o[d0] = __builtin_amdgcn_mfma_f32_32x32x16_bf16(pa1, (bf16x8){l1[0], l1[1], l1[2], l1[3], h1[0], h1[1], h1[2], h1[3]}, o[d0], 0, 0, 0);   \
        o[d0] = __builtin_amdgcn_mfma_f32_32x32x16_bf16(pa2, (bf16x8){l2[0], l2[1], l2[2], l2[3], h2[0], h2[1], h2[2], h2[3]}, o[d0], 0, 0, 0);   \
        o[d0] = __builtin_amdgcn_mfma_f32_32x32x16_bf16(pa3, (bf16x8){l3[0], l3[1], l3[2], l3[3], h3[0], h3[1], h3[2], h3[3]}, o[d0], 0, 0, 0); } while (0)
    PV_D0(0); PV_D0(1); PV_D0(2); PV_D0(3);
#undef PV_D0
#undef TRRD
}

template <class TIn, class TOut> struct BlockRef { const TIn* Q; const TIn* K; const TIn* V; TOut* O; int P0; const float* Fb; const float* gain;
    int jlo, jhi;
    float* Op; float* ML; };
template <class TIn> struct Seam {
    bf16x8 qr[8];
    bf16x8 st_v0, st_v1, st_k0, st_k1; f32x4 sf0, sf1, sf2, sf3; float st_b;
    f32x4 tq[16];
};
__device__ __forceinline__ int swa_jlo(int P0, int W) { const int lowk = P0 - W + 1; return lowk > 0 ? lowk / KVBLK : 0; }
#define ROW(p, k0, rr) ((p) + (size_t)((k0) + (rr)) * PITCH + sc)
#define VMW() asm volatile("s_waitcnt vmcnt(0)" ::: "memory")
#define VMWN(n) asm volatile("s_waitcnt vmcnt(%0)" :: "i"(n) : "memory")
#define SLOAD_H(Kp, Vp, k0) SLOAD_HB(Kp, Vp, k0, cur)
#define SLOAD_HB(Kp, Vp, k0, blk) do { S.st_v0 = load8<TIn>(ROW(Vp, k0, sr)); S.st_v1 = load8<TIn>(ROW(Vp, k0, 32 + sr));              \
                         S.st_k0 = load8<TIn>(ROW(Kp, k0, sr)); S.st_k1 = load8<TIn>(ROW(Kp, k0, 32 + sr)); \
                         if (tid < 64) S.st_b = ((blk).Fb[(blk).P0] - (blk).Fb[(k0) + tid]) * (1.0f / SCALE); } while (0)
#define SWRITE_HK(bf) do { *(bf16x8*)(K_lds + (bf) * SHM_K + kws) = S.st_k0; *(bf16x8*)(K_lds + (bf) * SHM_K + kws + 32 * 256) = S.st_k1; \
                         if (tid < 64) *(float*)(K_lds - 2 * SHM_V + LDS_BIAS + (bf) * 256 + bws) = S.st_b; } while (0)
#define SWRITE_HV(bf) do { *(bf16x8*)(V_lds + (bf) * SHM_V + vst0) = S.st_v0; *(bf16x8*)(V_lds + (bf) * SHM_V + vst1) = S.st_v1; } while (0)
#define SWRITE_H(bf) do { SWRITE_HV(bf); SWRITE_HK(bf); } while (0)
#define SLOAD_F(p, k0) do { S.sf0 = *(const f32x4*)ROW(p, k0, sr); S.sf1 = *(const f32x4*)(ROW(p, k0, sr) + 4);                \
                            S.sf2 = *(const f32x4*)ROW(p, k0, 32 + sr); S.sf3 = *(const f32x4*)(ROW(p, k0, 32 + sr) + 4); } while (0)
#define SWRITE_KF(bf) do { *(bf16x8*)(K_lds + (bf) * SHM_K + kws) = pack8(S.sf0, S.sf1); *(bf16x8*)(K_lds + (bf) * SHM_K + kws + 32 * 256) = pack8(S.sf2, S.sf3); } while (0)
#define SWRITE_VF(bf) do { *(bf16x8*)(V_lds + (bf) * SHM_V + vst0) = pack8(S.sf0, S.sf1); *(bf16x8*)(V_lds + (bf) * SHM_V + vst1) = pack8(S.sf2, S.sf3); } while (0)
template <class TIn, class TOut>
__device__ __forceinline__ void causal_swa_prime(const BlockRef<TIn, TOut>& cur, int W, char* lds, Seam<TIn>& S) {
    constexpr bool F32 = same_t<TIn, float>::v;
    const int tid = threadIdx.x, wid = __builtin_amdgcn_readfirstlane(tid >> 6), lane = tid & 63, r32 = lane & 31, hi = lane >> 5;
    const int sr = tid >> 4, sc = (tid & 15) * 8, kws = KSWZ(sr, sc * 2); char* K_lds = lds + 2 * SHM_V;
    const int bws = bias_slot(tid & 63) * 4;
    const int kb0 = cur.jlo * KVBLK;
    for (int d0 = 0; d0 < 8; ++d0) S.qr[d0] = load8<TIn>(cur.Q + (size_t)(wid * QBLK + r32) * PITCH + d0 * 16 + hi * 8);
    if constexpr (F32) { SLOAD_F((const float*)cur.K, kb0); VMW(); SWRITE_KF(0); SBAR(); SLOAD_F((const float*)cur.V, kb0); }
    else { SLOAD_H(cur.K, cur.V, kb0); VMW(); SWRITE_HK(0); }
    __syncthreads();
}
template <class TIn, class TOut>
__device__ __forceinline__ void causal_swa_block(const BlockRef<TIn, TOut>& cur, const BlockRef<TIn, TOut>& nxt, int skv, int W, char* lds, Seam<TIn>& S) {
    constexpr bool F32 = same_t<TIn, float>::v;
    const int tid = threadIdx.x, wid = __builtin_amdgcn_readfirstlane(tid >> 6), lane = tid & 63, r32 = lane & 31, hi = lane >> 5;
    const int j_lo = cur.jlo; const int j_hi = cur.jhi;
    const int NT = j_hi - j_lo;
    const int kbn = nxt.jlo * KVBLK;
    const int qlo = cur.P0 + wid * QBLK, qm = qlo + r32 - 4 * hi;
    char* V_lds = lds; char* K_lds = lds + 2 * SHM_V;
    float* ws = (float*)(lds + 2 * SHM_V + 2 * SHM_K) + wid * 64; float* li_l = ws, * al_l = ws + 32;
    float m_reg = -1e30f, l_reg = 0; f32x16 o[4] = {};
    const int sr = tid >> 4, sc = (tid & 15) * 8, vst0 = v_st(sr, sc), vst1 = v_st(32 + sr, sc), kws = KSWZ(sr, sc * 2);
    const int bws = bias_slot(tid & 63) * 4;
    const int vb0 = (int)(uintptr_t)V_lds + v_rd_base(lane);
    const TIn* Kh = cur.K; const TIn* Vh = cur.V;
#define RESC(a) do { if (__any((a) < 1.f)) { if (hi == 0) al_l[r32] = (a); asm volatile("s_waitcnt lgkmcnt(0)" ::: "memory");              \
                     for (int d_ = 0; d_ < 4; ++d_) for (int r = 0; r < 16; ++r) o[d_][r] *= al_l[crow(r, hi)]; } } while (0)
#define KBASE(t) ((j_lo + (t)) * KVBLK)
#define ACT(t) (KBASE(t) <= qlo + QBLK - 1 && KBASE(t) + KVBLK - 1 >= qlo - W + 1)
#define MASKT(P0_, P1_, t) do { const int kb_ = KBASE(t); if ((!SK || ACT(t)) && (kb_ + KVBLK - 1 > qlo || kb_ <= qlo + QBLK - 1 - W)) mask_tile(P0_, P1_, qm - kb_, (unsigned)W); } while (0)
    constexpr int NQL = F32 ? 16 : 8;
    constexpr bool SK = WSKIP && !F32;
#define SEAM_K0() do { VMWN(NQL); if constexpr (F32) { SWRITE_KF(0); SBAR(); SLOAD_F((const float*)nxt.V, kbn); } else { SWRITE_HK(0); } SBAR(); } while (0)
    f32x16 pA0, pA1, pB0, pB1; float mnA, mnB, alA, alB; bf16x8 pa0, pa1, pa2, pa3;
    if constexpr (F32) { VMW(); SWRITE_VF(0); SBAR(); } else { SWRITE_HV(0); SBAR(); }
    if (NT > 1) { if constexpr (F32) SLOAD_F((const float*)Kh, KBASE(1)); else SLOAD_H(Kh, Vh, KBASE(1)); }
    SBAR(); qkt<0, SK>(pA0, pA1, K_lds, r32, hi, S.qr, ACT(0));
    if constexpr (F32) { if (NT > 1) { VMW(); SWRITE_KF(1); SBAR(); SLOAD_F((const float*)Vh, KBASE(1)); } }
    MASKT(pA0, pA1, 0); partialSM(pA0, pA1, m_reg, mnA, alA);
    if (NT > 1) { VMW(); if constexpr (F32) { SWRITE_VF(1); SBAR(); if (NT > 2) SLOAD_F((const float*)Kh, KBASE(2)); } else SWRITE_H(1); }
    __syncthreads();
#define HALF_STEP(PX0, PX1, mnX, alX, PY0, PY1, alY, t, KB, VB, SB) do {                                                      \
        SBAR(); qkt<KB, SK>(PX0, PX1, K_lds, r32, hi, S.qr, ACT(t));                                             \
        finishSM(PY0, PY1, alY, l_reg, pa0, pa1, pa2, pa3); SBAR();                                                           \
        if ((t) + 1 < NT) { if constexpr (F32) { VMW(); SWRITE_KF(SB); SBAR(); SLOAD_F((const float*)Vh, KBASE((t) + 1)); }  \
                            else { SLOAD_H(Kh, Vh, KBASE((t) + 1)); } SBAR(); }                                               \
        pv_tile<VB, SK>(o, vb0, pa0, pa1, pa2, pa3, ACT((t) - 1)); MASKT(PX0, PX1, (t)); partialSM(PX0, PX1, m_reg, mnX, alX);                                        \
        __syncthreads();                                                                                                      \
        if ((t) + 1 < NT) { VMW(); if constexpr (F32) { SWRITE_VF(SB); SBAR(); if ((t) + 2 < NT) SLOAD_F((const float*)Kh, KBASE((t) + 2)); } \
                            else { SWRITE_H(SB); } }                                                                          \
        RESC(alX); __syncthreads(); } while (0)
    for (int t = 1; t + 1 < NT; t += 2) {
        HALF_STEP(pB0, pB1, mnB, alB, pA0, pA1, alA, t, 1, 0, 0);
        HALF_STEP(pA0, pA1, mnA, alA, pB0, pB1, alB, t + 1, 0, 1, 1);
    }
    const bool even = (NT & 1) == 0;
    if (even) { SBAR(); qkt<1, SK>(pB0, pB1, K_lds, r32, hi, S.qr, ACT(NT - 1)); SBAR(); }
#define QROW(e) (nxt.Q + (size_t)(wid * QBLK + r32) * PITCH + ((e) >> 1) * 16 + hi * 8 + ((e) & 1) * 4)
    if constexpr (F32) { SLOAD_F((const float*)nxt.K, kbn); SBAR();
#pragma unroll
        for (int e = 0; e < 8; ++e) S.tq[e] = *(const f32x4*)QROW(e); }
    else { SLOAD_HB(nxt.K, nxt.V, kbn, nxt); SBAR();
#pragma unroll
        for (int d0 = 0; d0 < 8; ++d0) S.qr[d0] = load8<TIn>(nxt.Q + (size_t)(wid * QBLK + r32) * PITCH + d0 * 16 + hi * 8); }
    SBAR();
    finishSM(pA0, pA1, alA, l_reg, pa0, pa1, pa2, pa3); SBAR();
    if constexpr (F32) {
#pragma unroll
        for (int e = 8; e < 16; ++e) S.tq[e] = *(const f32x4*)QROW(e); SBAR(); }
#undef QROW
    pv_tile<0, SK>(o, vb0, pa0, pa1, pa2, pa3, ACT(even ? NT - 2 : NT - 1));
    if (even) { MASKT(pB0, pB1, NT - 1); partialSM(pB0, pB1, m_reg, mnB, alB); __syncthreads(); RESC(alB);
        finishSM(pB0, pB1, alB, l_reg, pa0, pa1, pa2, pa3); SBAR(); pv_tile<1, SK>(o, vb0, pa0, pa1, pa2, pa3, ACT(NT - 1)); }
    SBAR(); SEAM_K0();
    if (hi == 0) li_l[r32] = l_reg; asm volatile("s_waitcnt lgkmcnt(0)" ::: "memory");
    if (cur.Op != nullptr) {
        int rp = r32; asm volatile("" : "+v"(rp));
        if (hi == 0) { float2 mlv; mlv.x = m_reg; mlv.y = l_reg; *(float2*)(cur.ML + 2 * (wid * QBLK + rp)) = mlv; }
        float* Pr = cur.Op + (size_t)(wid * QBLK + 4 * hi) * D + rp;
#pragma unroll
        for (int r = 0; r < 16; ++r) {
#pragma unroll
            for (int d0 = 0; d0 < 4; ++d0) Pr[d0 * 32] = o[d0][r];
            Pr += ((r & 3) == 3 ? 5 : 1) * D; asm volatile("" : "+v"(Pr) :: "memory"); }
    } else {
    int ro = r32; asm volatile("" : "+v"(ro));
    TOut* Or = cur.O + (size_t)(wid * QBLK + 4 * hi) * OPITCH + ro;
    float gn[4];
#pragma unroll
    for (int d0 = 0; d0 < 4; ++d0) gn[d0] = cur.gain[d0 * 32 + ro];
#pragma unroll
    for (int r = 0; r < 16; ++r) { const int orow = crow(r, hi); const float rl = __builtin_amdgcn_rcpf(li_l[orow]);
        float v[4]; float ss = 0.f;
#pragma unroll
        for (int d0 = 0; d0 < 4; ++d0) { v[d0] = o[d0][r] * rl; ss += v[d0] * v[d0]; }
        ss += __shfl_xor(ss, 1); ss += __shfl_xor(ss, 2); ss += __shfl_xor(ss, 4); ss += __shfl_xor(ss, 8); ss += __shfl_xor(ss, 16);
        const float rn = __builtin_amdgcn_rsqf(ss * (1.0f / 128.0f) + 1e-6f);
#pragma unroll
        for (int d0 = 0; d0 < 4; ++d0) { const float vv = v[d0] * rn * gn[d0]; const float vn = __shfl_xor(vv, 1);
            if ((ro & 1) == 0) *(unsigned*)(Or + d0 * 32) = cvtpk(vv, vn); }
        Or += ((r & 3) == 3 ? 5 : 1) * OPITCH; asm volatile("" : "+v"(Or) :: "memory"); }
    }
    if constexpr (F32) {
#pragma unroll
        for (int d0 = 0; d0 < 8; ++d0) S.qr[d0] = pack8(S.tq[2 * d0], S.tq[2 * d0 + 1]); }
    __syncthreads();
#undef RESC
#undef KBASE
#undef ACT
#undef MASKT
#undef SEAM_K0
#undef HALF_STEP
}
#undef ROW
#undef VMW
#undef VMWN
#undef SLOAD_H
#undef SWRITE_HK
#undef SWRITE_HV
#undef SWRITE_H
#undef SLOAD_F
#undef SWRITE_KF
#undef SWRITE_VF

}
namespace mk {
typedef short s16x8 __attribute__((ext_vector_type(8)));
#define MFMA32(a, b, c) __builtin_amdgcn_mfma_f32_32x32x16_bf16((a), (b), (c), 0, 0, 0)
__device__ __forceinline__ int crow32(int r, int hi) { return (r & 3) + 8 * (r >> 2) + 4 * hi; }
constexpr float SCALEQ = 0.08838834764831845f;
__device__ __forceinline__ float wave_scan_add(float v, int lane) {
#pragma unroll
    for (int o = 1; o < 64; o <<= 1) { const float t = __shfl_up(v, o); if (lane >= o) v += t; }
    return v;
}
__device__ __forceinline__ float wave_scan_max(float v, int lane) {
#pragma unroll
    for (int o = 1; o < 64; o <<= 1) { const float t = __shfl_up(v, o); if (lane >= o) v = fmaxf(v, t); }
    return v;
}
__device__ __forceinline__ float wave_max(float v) {
#pragma unroll
    for (int o = 1; o < 64; o <<= 1) v = fmaxf(v, __shfl_xor(v, o));
    return v;
}
constexpr int TSTR = 72;
template <bool SCALED>
__device__ __forceinline__ void stage_transposed(const bf16* src, int ncols, LAS bf16* T, const LAS float* wl, int tid) {
    const int cpr = ncols / 8;
    for (int q = tid; q < 64 * cpr; q += NTHR) { const int s = q / cpr, c8 = (q % cpr) * 8;
        const v4u raw = *(const GAS v4u*)(src + (size_t)s * NPP + c8);
        const unsigned w4[4] = {raw.x, raw.y, raw.z, raw.w};
#pragma unroll
        for (int j = 0; j < 4; ++j) { unsigned lo = w4[j] & 0xffffu, hi = w4[j] >> 16;
            if (SCALED) { const float sc = wl[s]; lo = f2bf(bf2f((unsigned short)lo) * sc); hi = f2bf(bf2f((unsigned short)hi) * sc); }
            T[(c8 + 2 * j) * TSTR + s] = (bf16)lo; T[(c8 + 2 * j + 1) * TSTR + s] = (bf16)hi; } }
}
__device__ __forceinline__ void p3_prep(Frame& F) {
    const int gw = F.vcu * NWAVES + F.wave, NGW = F.G * NWAVES, lane = F.lane, tid = F.tid;
    bf16* proj = wsp<bf16>(F, WS_PROJ); const float* gates = wsp<float>(F, WS_GATES);
    {
        const int seg = lane >> 2, qd = (lane & 3) * 32; const float* gn = (seg < 8 ? F.in[IN_FOXQN] : F.in[IN_FOXKN]) + qd;
        for (int m = gw; m < S; m += NGW) {
            bf16* p = proj + (size_t)m * NPP + C_FQ + seg * 128 + qd; v4u raw[4]; float x[32]; float ss = 0.f;
#pragma unroll
            for (int j = 0; j < 4; ++j) raw[j] = *(const GAS v4u*)(p + 8 * j);
#pragma unroll
            for (int j = 0; j < 4; ++j) { const unsigned w4[4] = {raw[j].x, raw[j].y, raw[j].z, raw[j].w};
#pragma unroll
                for (int i = 0; i < 4; ++i) { x[8 * j + 2 * i] = bf2f((unsigned short)(w4[i] & 0xffffu)); x[8 * j + 2 * i + 1] = bf2f((unsigned short)(w4[i] >> 16)); } }
#pragma unroll
            for (int i = 0; i < 32; ++i) ss += x[i] * x[i];
            ss += __shfl_xor(ss, 1); ss += __shfl_xor(ss, 2);
            const float r = rsqrtf(ss * (1.f / 128.f) + 1e-6f);
#pragma unroll
            for (int j = 0; j < 4; ++j) { v4u o; const f32x4 g0 = *(const GAS f32x4*)(gn + 8 * j), g1 = *(const GAS f32x4*)(gn + 8 * j + 4);
                o.x = pk2(x[8 * j] * r * g0.x, x[8 * j + 1] * r * g0.y); o.y = pk2(x[8 * j + 2] * r * g0.z, x[8 * j + 3] * r * g0.w);
                o.z = pk2(x[8 * j + 4] * r * g1.x, x[8 * j + 5] * r * g1.y); o.w = pk2(x[8 * j + 6] * r * g1.z, x[8 * j + 7] * r * g1.w);
                *(GAS v4u*)(p + 8 * j) = o; }
        }
    }
    if (blockIdx.x < 8) {
        const int h = blockIdx.x; const float b = F.in[IN_FOXBF][h]; float* Fo = wsp<float>(F, WS_F) + h * S;
        LAS double* tot = (LAS double*)(F.lds + RING_OFF);
        double loc[16]; double acc = 0.0;
#pragma unroll
        for (int i = 0; i < 16; ++i) { acc += (double)log_sigmoid_f(gates[(size_t)(tid * 16 + i) * 16 + 8 + h] + b); loc[i] = acc; }
        tot[tid] = acc;
        __syncthreads();
        if (F.wave == 0) { double v[8]; double s = 0.0;
#pragma unroll
            for (int i = 0; i < 8; ++i) { v[i] = tot[lane * 8 + i]; s += v[i]; }
            double inc = s;
#pragma unroll
            for (int o = 1; o < 64; o <<= 1) { const double t = __shfl_up(inc, o); if (lane >= o) inc += t; }
            double ex = inc - s;
#pragma unroll
            for (int i = 0; i < 8; ++i) { tot[lane * 8 + i] = ex; ex += v[i]; } }
        __syncthreads();
        const double off = tot[tid];
        LAS float* Fl = (LAS float*)(F.lds + RING_OFF + 8192);
#pragma unroll
        for (int i = 0; i < 16; ++i) { const float fv = (float)(off + loc[i]); Fo[tid * 16 + i] = fv; Fl[tid * 16 + i] = fv; }
        __syncthreads();
        if (tid < 32) {
            float gq = 0.f, gk = 0.f;
            for (int d = 0; d < 128; ++d) { gq = fmaxf(gq, fabsf(F.in[IN_FOXQN][d])); gk = fmaxf(gk, fabsf(F.in[IN_FOXKN][d])); }
            const float thr = 2.f * 11.3137085f * gq * gk + 26.f;
            const int qb = tid, P0 = qb * 256; const float f0 = Fl[P0];
            int lo = 0, hi2 = 4 * qb;
            while (lo < hi2) { const int mid = (lo + hi2) >> 1; if (Fl[64 * mid + 63] - f0 <= thr) hi2 = mid; else lo = mid + 1; }
            wsp<int>(F, WS_JLO)[h * 32 + qb] = lo;
        }
        __syncthreads();
    }
    {
        LAS bf16* KT = (LAS bf16*)(F.lds + RING_OFF);
        LAS bf16* VT = KT + 128 * TSTR;
        LAS float* wl = (LAS float*)(VT + 256 * TSTR);
        float* UL = wsp<float>(F, WS_UL); float* NL = wsp<float>(F, WS_NL); float* GLAL = wsp<float>(F, WS_GLAL);
        const int hi = lane >> 5, l31 = lane & 31, w = F.wave;
        for (int u = F.vcu; u < 4 * NCH; u += F.G) {
            const int h = u >> 7, ch = u & 127, t0 = ch * LCH;
            if (w == 0) {
                const float ip = softcap_f(gates[(size_t)(t0 + lane) * 16 + h] + F.in[IN_BI][h]);
                const float fp = softcap_f(gates[(size_t)(t0 + lane) * 16 + 4 + h] + F.in[IN_BF][h]);
                const float g = wave_scan_add(log_sigmoid_f(fp), lane), a = ip - g, amax = wave_max(a);
                wl[lane] = __expf(a - amax);
                if (lane == 63) { GLAL[u * 2] = g; GLAL[u * 2 + 1] = amax; }
            }
            __syncthreads();
            stage_transposed<true>(proj + (size_t)t0 * NPP + C_MK + h * 128, 128, KT, wl, tid);
            stage_transposed<false>(proj + (size_t)t0 * NPP + C_MV + h * 256, 256, VT, wl, tid);
            __syncthreads();
            f32x16 acc[4];
#pragma unroll
            for (int dt = 0; dt < 4; ++dt)
#pragma unroll
                for (int r = 0; r < 16; ++r) acc[dt][r] = 0.f;
#pragma unroll
            for (int ks = 0; ks < 4; ++ks) { const s16x8 a = *(const LAS s16x8*)(VT + (32 * w + l31) * TSTR + 16 * ks + 8 * hi);
#pragma unroll
                for (int dt = 0; dt < 4; ++dt) { const s16x8 b = *(const LAS s16x8*)(KT + (32 * dt + l31) * TSTR + 16 * ks + 8 * hi); acc[dt] = MFMA32(a, b, acc[dt]); } }
            float* ut = UL + (size_t)u * 256 * 128;
#pragma unroll
            for (int dt = 0; dt < 4; ++dt)
#pragma unroll
                for (int r = 0; r < 16; ++r) ut[(size_t)(32 * w + crow32(r, hi)) * 128 + 32 * dt + l31] = acc[dt][r];
            if (tid < 128) { float s = 0.f;
#pragma unroll
                for (int j = 0; j < 8; ++j) { const s16x8 kv = *(const LAS s16x8*)(KT + tid * TSTR + 8 * j);
#pragma unroll
                    for (int i = 0; i < 8; ++i) s += bf2f((unsigned short)kv[i]); }
                NL[u * 128 + tid] = s; }
            __syncthreads();
        }
    }
}
__device__ __forceinline__ void p4_scan(Frame& F) {
    LAS float* gl = (LAS float*)(F.lds + RING_OFF);
    LAS float* dec = gl + 256; LAS float* scl = dec + 128; LAS float* mv = scl + 128;
    const float* UL = wsp<float>(F, WS_UL); const float* NL = wsp<float>(F, WS_NL); const float* GLAL = wsp<float>(F, WS_GLAL);
    bf16* CS = wsp<bf16>(F, WS_CS); float* NS = wsp<float>(F, WS_NS); float* MS = wsp<float>(F, WS_MS);
    const int tid = F.tid;
    for (int blk = F.vcu; blk < 4 * 64; blk += F.G) {
        const int h = blk >> 6, rem0 = (blk & 63) * 512;
        if (tid < 256) gl[tid] = GLAL[h * 256 + tid];
        __syncthreads();
        if (tid == 0) { float m = 0.f;
            for (int c = 0; c < NCH; ++c) { const float g = gl[2 * c], al = gl[2 * c + 1], mn = g + fmaxf(m, al);
                mv[c] = m; dec[c] = __expf(g + m - mn); scl[c] = __expf(g + al - mn); m = mn; } }
        __syncthreads();
        if (rem0 == 0 && tid < 128) MS[h * 128 + tid] = mv[tid];
        const int rem = rem0 + tid;
        const float* ul = UL + (size_t)h * NCH * 32768 + rem; bf16* cs = CS + (size_t)h * NCH * 32768 + rem;
        float C = 0.f;
#pragma unroll 8
        for (int c = 0; c < NCH; ++c) { cs[(size_t)c * 32768] = (bf16)f2bf(C); C = dec[c] * C + scl[c] * ul[(size_t)c * 32768]; }
        if (rem0 == 0 && tid < 128) { float n = 0.f; const float* nl = NL + (size_t)h * NCH * 128 + tid; float* ns = NS + (size_t)h * NCH * 128 + tid;
#pragma unroll 8
            for (int c = 0; c < NCH; ++c) { ns[c * 128] = n; n = dec[c] * n + scl[c] * nl[c * 128]; } }
        __syncthreads();
    }
}
constexpr int NUMSTR = 260;
__device__ __forceinline__ void p5_mlstm_out(Frame& F) {
    LAS bf16* VT = (LAS bf16*)(F.lds + RING_OFF);
    LAS bf16* Pm = VT + 256 * TSTR;
    LAS float* NUM = (LAS float*)(Pm + 64 * TSTR);
    LAS float* a_s = NUM + 64 * NUMSTR; LAS float* Mt = a_s + 64; LAS float* inter = Mt + 64; LAS float* emt = inter + 64; LAS float* qn = emt + 64; LAS float* dinv = qn + 64;
    const bf16* proj = wsp<bf16>(F, WS_PROJ); const float* gates = wsp<float>(F, WS_GATES); const bf16* CS = wsp<bf16>(F, WS_CS);
    const float* NS = wsp<float>(F, WS_NS); const float* MS = wsp<float>(F, WS_MS); bf16* concat = wsp<bf16>(F, WS_CONCAT);
    const int tid = F.tid, lane = F.lane, w = F.wave, hi = lane >> 5, l31 = lane & 31;
    for (int u = F.vcu; u < 4 * NCH; u += F.G) {
        const int h = u >> 7, ch = u & 127, t0 = ch * LCH;
        const bf16* qbase = proj + (size_t)t0 * NPP + C_MQ + h * 128; const bf16* kbase = proj + (size_t)t0 * NPP + C_MK + h * 128;
        if (w == 0) {
            const float ip = softcap_f(gates[(size_t)(t0 + lane) * 16 + h] + F.in[IN_BI][h]);
            const float fp = softcap_f(gates[(size_t)(t0 + lane) * 16 + 4 + h] + F.in[IN_BF][h]);
            const float g = wave_scan_add(log_sigmoid_f(fp), lane), a = ip - g, cm = wave_scan_max(a, lane);
            const float mp = MS[u], M = fmaxf(mp, cm);
            a_s[lane] = a; Mt[lane] = M; inter[lane] = __expf(mp - M); emt[lane] = __expf(-(g + M));
        }
        stage_transposed<false>(proj + (size_t)t0 * NPP + C_MV + h * 256, 256, VT, a_s, tid);
        __syncthreads();
        if (w < 4) {
            const int ti = w >> 1, si = w & 1;
            if (si <= ti) {
                s16x8 qa[8], kb[8];
#pragma unroll
                for (int ks = 0; ks < 8; ++ks) { qa[ks] = *(const GAS s16x8*)(qbase + (size_t)(32 * ti + l31) * NPP + 16 * ks + 8 * hi); kb[ks] = *(const GAS s16x8*)(kbase + (size_t)(32 * si + l31) * NPP + 16 * ks + 8 * hi); }
                f32x16 acc;
#pragma unroll
                for (int r = 0; r < 16; ++r) acc[r] = 0.f;
#pragma unroll
                for (int ks = 0; ks < 8; ++ks) acc = MFMA32(qa[ks], kb[ks], acc);
                const int s = 32 * si + l31; const float as = a_s[s];
#pragma unroll
                for (int r = 0; r < 16; ++r) { const int t = 32 * ti + crow32(r, hi); const float p = (s <= t) ? acc[r] * SCALEQ * __expf(as - Mt[t]) : 0.f; Pm[t * TSTR + s] = (bf16)f2bf(p); }
            } else {
#pragma unroll
                for (int r = 0; r < 16; ++r) Pm[(32 * ti + crow32(r, hi)) * TSTR + 32 * si + l31] = (bf16)0;
            }
        } else {
            const int t = (tid - 256) >> 2, d0 = ((tid - 256) & 3) * 32; float s = 0.f; const float* np = NS + (size_t)u * 128 + d0;
#pragma unroll
            for (int j = 0; j < 4; ++j) { const s16x8 qv = *(const GAS s16x8*)(qbase + (size_t)t * NPP + d0 + 8 * j);
#pragma unroll
                for (int i = 0; i < 8; ++i) s += bf2f((unsigned short)qv[i]) * np[8 * j + i]; }
            s += __shfl_xor(s, 1); s += __shfl_xor(s, 2);
            if ((tid & 3) == 0) qn[t] = s * SCALEQ;
        }
        __syncthreads();
        f32x16 accP[2], accC[2];
#pragma unroll
        for (int ti = 0; ti < 2; ++ti)
#pragma unroll
            for (int r = 0; r < 16; ++r) { accP[ti][r] = 0.f; accC[ti][r] = 0.f; }
        {
            const bf16* cs = CS + (size_t)u * 32768 + (size_t)(32 * w + l31) * 128 + 8 * hi;
            s16x8 cb[8];
#pragma unroll
            for (int ks = 0; ks < 8; ++ks) cb[ks] = *(const GAS s16x8*)(cs + 16 * ks);
#pragma unroll
            for (int ti = 0; ti < 2; ++ti) {
                s16x8 qa[8];
#pragma unroll
                for (int ks = 0; ks < 8; ++ks) qa[ks] = *(const GAS s16x8*)(qbase + (size_t)(32 * ti + l31) * NPP + 16 * ks + 8 * hi);
#pragma unroll
                for (int ks = 0; ks < 8; ++ks) accC[ti] = MFMA32(qa[ks], cb[ks], accC[ti]);
            }
#pragma unroll
            for (int ks = 0; ks < 4; ++ks) { const s16x8 vb = *(const LAS s16x8*)(VT + (32 * w + l31) * TSTR + 16 * ks + 8 * hi);
#pragma unroll
                for (int ti = 0; ti < 2; ++ti) { const s16x8 pa = *(const LAS s16x8*)(Pm + (32 * ti + l31) * TSTR + 16 * ks + 8 * hi); accP[ti] = MFMA32(pa, vb, accP[ti]); } }
        }
        if (w == 0) {
            float rs = 0.f;
#pragma unroll
            for (int j = 0; j < 8; ++j) { const s16x8 pv = *(const LAS s16x8*)(Pm + lane * TSTR + 8 * j);
#pragma unroll
                for (int i = 0; i < 8; ++i) rs += bf2f((unsigned short)pv[i]); }
            const float dn = rs + inter[lane] * qn[lane];
            dinv[lane] = 1.f / fmaxf(fabsf(dn), emt[lane]);
        }
        __syncthreads();
#pragma unroll
        for (int ti = 0; ti < 2; ++ti)
#pragma unroll
            for (int r = 0; r < 16; ++r) { const int t = 32 * ti + crow32(r, hi); NUM[t * NUMSTR + 32 * w + l31] = (accP[ti][r] + inter[t] * SCALEQ * accC[ti][r]) * dinv[t]; }
        __syncthreads();
        {
            const f32x4 gn = *(const GAS f32x4*)(F.in[IN_MOUTN] + h * 256 + 4 * lane);
#pragma unroll
            for (int i = 0; i < 8; ++i) { const int t = 8 * w + i; const f32x4 x = *(const LAS f32x4*)(NUM + t * NUMSTR + 4 * lane);
                const float ss = wave_sum((x.x * x.x + x.y * x.y) + (x.z * x.z + x.w * x.w)); const float r = rsqrtf(ss * (1.f / 256.f) + 1e-6f);
                const u32x2 mo = *(const GAS u32x2*)(proj + (size_t)(t0 + t) * NPP + C_MO + h * 256 + 4 * lane);
                const float o0 = x.x * r * gn.x * sigmoid_f(bf2f((unsigned short)(mo.x & 0xffffu))), o1 = x.y * r * gn.y * sigmoid_f(bf2f((unsigned short)(mo.x >> 16)));
                const float o2 = x.z * r * gn.z * sigmoid_f(bf2f((unsigned short)(mo.y & 0xffffu))), o3 = x.w * r * gn.w * sigmoid_f(bf2f((unsigned short)(mo.y >> 16)));
                u32x2 ov; ov.x = pk2(o0, o1); ov.y = pk2(o2, o3);
                *(GAS u32x2*)(concat + (size_t)(t0 + t) * D + h * 256 + 4 * lane) = ov; }
        }
        __syncthreads();
    }
}
}
namespace mk {
__device__ __forceinline__ void attn_build_schedule(Frame& F) {
    LAS int* jl = (LAS int*)(F.lds + TAB_OFF); LAS int* pre = jl + 256; LAS int* wtot = pre + 260;
    const int tid = F.tid, lane = F.lane;
    if (tid < 256) { const int j = wsp<int>(F, WS_JLO)[tid]; jl[tid] = j; const int n = 4 * (tid & 31) + 4 - j; int v = (n + ATT_CH - 1) / ATT_CH;
        int inc = v;
#pragma unroll
        for (int o = 1; o < 64; o <<= 1) { const int t = __shfl_up(inc, o); if (lane >= o) inc += t; }
        pre[tid + 1] = inc; if (lane == 63) wtot[tid >> 6] = inc; }
    __syncthreads();
    if (tid < 256) { int add = 0; for (int w2 = 0; w2 < (tid >> 6); ++w2) add += wtot[w2]; pre[tid + 1] += add; if (tid == 0) pre[0] = 0; }
    __syncthreads();
}
__device__ __forceinline__ fox::BlockRef<fox::bf16, fox::bf16> fox_ref(const Frame& F, int I) {
    const LAS int* jl = (const LAS int*)(F.lds + TAB_OFF); const LAS int* pre = jl + 256;
    int b = 0;
#pragma unroll
    for (int st = 128; st >= 1; st >>= 1) if (pre[b + st] <= I) b += st;
    b = __builtin_amdgcn_readfirstlane(b);
    const int pb0 = __builtin_amdgcn_readfirstlane(pre[b]), pb1 = __builtin_amdgcn_readfirstlane(pre[b + 1]), j0 = __builtin_amdgcn_readfirstlane(jl[b]);
    const int h = b >> 5, qb = b & 31, part = I - pb0, P = pb1 - pb0, n = 4 * qb + 4 - j0;
    fox::BlockRef<fox::bf16, fox::bf16> r;
    const fox::bf16* proj = (const fox::bf16*)(F.ws + WS_PROJ);
    r.Q = proj + (size_t)(qb * 256) * fox::PITCH + C_FQ + h * 128; r.K = proj + C_FK + h * 128; r.V = proj + C_FV + h * 128;
    r.O = (fox::bf16*)(F.ws + WS_CONCAT) + (size_t)(qb * 256) * D + 1024 + h * 128; r.P0 = qb * 256;
    r.Fb = (const float*)(F.ws + WS_F) + h * S; r.gain = F.in[IN_FOUTN] + h * 128;
    r.jlo = j0 + (part * n) / P; r.jhi = j0 + ((part + 1) * n) / P;
    r.Op = P > 1 ? (float*)(F.ws + WS_OPART) + (size_t)I * 256 * 128 : nullptr; r.ML = (float*)(F.ws + WS_MLP) + (size_t)I * 512;
    return r;
}
__device__ __forceinline__ void p5_attention(Frame& F, char* ldsg) {
    typedef fox::BlockRef<fox::bf16, fox::bf16> BR;
    attn_build_schedule(F);
    const int total = __builtin_amdgcn_readfirstlane(((const LAS int*)(F.lds + TAB_OFF))[256 + 256]);
    int L = F.vcu; if (L >= total) return;
    BR cur = fox_ref(F, L);
    fox::Seam<fox::bf16> Sm;
    fox::causal_swa_prime<fox::bf16, fox::bf16>(cur, S, ldsg, Sm);
    for (;;) {
        const bool more = L + F.G < total;
        const BR nxt = more ? fox_ref(F, L + F.G) : cur;
        fox::causal_swa_block<fox::bf16, fox::bf16>(cur, nxt, S, S, ldsg, Sm);
        if (!more) break;
        cur = nxt; L += F.G;
    }
}
__device__ __forceinline__ void p6_combine(Frame& F) {
    attn_build_schedule(F);
    const LAS int* pre = (const LAS int*)(F.lds + TAB_OFF) + 256;
    const float* OP = wsp<float>(F, WS_OPART); const float* MLP = wsp<float>(F, WS_MLP); bf16* concat = wsp<bf16>(F, WS_CONCAT);
    const int gw = F.vcu * NWAVES + F.wave, NGW = F.G * NWAVES, lane = F.lane;
    constexpr float C2 = 1.4426950408889634f * SCALEQ;
    for (int idx = gw; idx < 256 * 256; idx += NGW) {
        const int b = idx >> 8, r = idx & 255, i0 = pre[b], P = pre[b + 1] - i0; if (P <= 1) continue;
        const int h = b >> 5, qb = b & 31;
        float ms = -3.0e38f;
        for (int p2 = 0; p2 < P; ++p2) ms = fmaxf(ms, MLP[(size_t)(i0 + p2) * 512 + 2 * r]);
        float n0 = 0.f, n1 = 0.f, den = 0.f;
        for (int p2 = 0; p2 < P; ++p2) { const f32x2 ml = *(const GAS f32x2*)(MLP + (size_t)(i0 + p2) * 512 + 2 * r); const float wgt = __builtin_amdgcn_exp2f((ml.x - ms) * C2);
            const f32x2 ov = *(const GAS f32x2*)(OP + ((size_t)(i0 + p2) * 256 + r) * 128 + 2 * lane); n0 += wgt * ov.x; n1 += wgt * ov.y; den += wgt * ml.y; }
        const float inv = 1.f / den, v0 = n0 * inv, v1 = n1 * inv;
        const float ss = wave_sum(v0 * v0 + v1 * v1), rn = rsqrtf(ss * (1.f / 128.f) + 1e-6f);
        const f32x2 gn = *(const GAS f32x2*)(F.in[IN_FOUTN] + h * 128 + 2 * lane);
        *(GAS unsigned*)(concat + (size_t)(qb * 256 + r) * D + 1024 + h * 128 + 2 * lane) = pk2(v0 * rn * gn.x, v1 * rn * gn.y);
    }
}
constexpr int RROWS = 8, NITER = S / RROWS;
__device__ __forceinline__ void p7_router(Frame& F) {
    LAS float* shs = (LAS float*)(F.lds + RING_OFF);
    LAS float* H2L = shs + 2 * D;
    LAS float* red = H2L + RROWS * D;
    LAS int* selE = (LAS int*)(red + 16 * RROWS * NE);
    const float* mod = wsp<float>(F, WS_MOD); const float* h1 = wsp<float>(F, WS_H1); bf16* h2 = wsp<bf16>(F, WS_HN);
    int* top_i = wsp<int>(F, WS_TOPI); float* top_w = wsp<float>(F, WS_TOPW); int* hist = wsp<int>(F, WS_HIST); int* lrank = wsp<int>(F, WS_LRANK);
    const int tid = F.tid, lane = F.lane, w = F.wave;
    for (int i = tid; i < 2 * D; i += NTHR) shs[i] = mod[3 * D + i];
    __syncthreads();
    float wreg[128];
    { const float* wp = F.in[IN_WR] + (size_t)((tid >> 5) * 128) * NE + (tid & 31);
#pragma unroll
        for (int k = 0; k < 128; ++k) wreg[k] = wp[k * NE]; }
    for (int it = F.vcu; it < NITER; it += F.G) {
        const int r0 = it * RROWS;
        {
            const int m = r0 + w; const GAS f32x4* xr = (const GAS f32x4*)(h1 + (size_t)m * D) + lane; f32x4 v[8]; float s2 = 0.f;
#pragma unroll
            for (int j = 0; j < 8; ++j) { v[j] = xr[64 * j]; s2 += (v[j].x * v[j].x + v[j].y * v[j].y) + (v[j].z * v[j].z + v[j].w * v[j].w); }
            const float r = rsqrtf(wave_sum(s2) * (1.f / D) + 1e-6f);
            GAS u32x2* o8 = (GAS u32x2*)(h2 + (size_t)m * D) + lane;
#pragma unroll
            for (int j = 0; j < 8; ++j) { const int c0 = 4 * lane + 256 * j; const f32x4 gg = *(const GAS f32x4*)(F.in[IN_NFFN] + c0); const f32x4 a = *(const LAS f32x4*)(shs + D + c0), b = *(const LAS f32x4*)(shs + c0);
                const f32x4 y = v[j] * r * gg * (a + 1.f) + b; u32x2 o; o.x = pk2(y.x, y.y); o.y = pk2(y.z, y.w); o8[64 * j] = o;
                *(LAS f32x4*)(H2L + w * D + c0) = y; }
        }
        __syncthreads();
        {
            const int e = tid & 31, kp = tid >> 5; float acc[RROWS];
#pragma unroll
            for (int r = 0; r < RROWS; ++r) acc[r] = 0.f;
#pragma unroll
            for (int k4 = 0; k4 < 32; ++k4) {
#pragma unroll
                for (int r = 0; r < RROWS; ++r) { const f32x4 hv = *(const LAS f32x4*)(H2L + r * D + kp * 128 + k4 * 4); acc[r] += (hv.x * wreg[4 * k4] + hv.y * wreg[4 * k4 + 1]) + (hv.z * wreg[4 * k4 + 2] + hv.w * wreg[4 * k4 + 3]); }
            }
#pragma unroll
            for (int r = 0; r < RROWS; ++r) red[(kp * RROWS + r) * NE + e] = acc[r];
        }
        __syncthreads();
        if (tid < RROWS * NE) {
            const int r = tid >> 5, e = tid & 31; float lg = F.in[IN_BR][e];
#pragma unroll
            for (int kp = 0; kp < 16; ++kp) lg += red[(kp * RROWS + r) * NE + e];
            float cur = lg, mx = 0.f, sum = 0.f, mysel = 0.f; int myidx = 0;
#pragma unroll
            for (int q = 0; q < 4; ++q) { float best = cur; int bi = e;
#pragma unroll
                for (int o = 1; o < 32; o <<= 1) { const float ob = __shfl_xor(best, o); const int oi = __shfl_xor(bi, o); if (ob > best || (ob == best && oi < bi)) { best = ob; bi = oi; } }
                if (q == 0) mx = best;
                sum += __expf(best - mx);
                if (e == q) { mysel = best; myidx = bi; }
                if (e == bi) cur = -3.0e38f; }
            if (e < 4) { const int t = r0 + r; top_i[t * 4 + e] = myidx; top_w[t * 4 + e] = __expf(mysel - mx) / sum; selE[r * 4 + e] = myidx; }
        }
        __syncthreads();
        if (tid < 32) { const int me = selE[tid]; int rank = 0, cnt = 0;
#pragma unroll
            for (int p = 0; p < 32; ++p) { const int ep = selE[p]; rank += (ep == me && p < tid) ? 1 : 0; cnt += (ep == tid) ? 1 : 0; }
            lrank[it * 32 + tid] = rank; hist[it * NE + tid] = cnt; }
        __syncthreads();
    }
}
__device__ __forceinline__ void build_expert_table(Frame& F, const int* counts_g) {
    LAS int* tab = (LAS int*)(F.lds + TAB_OFF);
    if (F.tid == 0) { int acc = 0; for (int e = 0; e < NE; ++e) { const int c = counts_g[e]; tab[e] = acc; tab[40 + e] = c; acc += (c + 255) >> 8; } tab[32] = acc; }
    __syncthreads();
}
__device__ __forceinline__ void p8_gather(Frame& F) {
    LAS int* psum = (LAS int*)(F.lds + RING_OFF);
    LAS int* startr = psum + 16 * NE;
    LAS int* base = startr + NE;
    const int* hist = wsp<int>(F, WS_HIST); const int* lrank = wsp<int>(F, WS_LRANK); const int* top_i = wsp<int>(F, WS_TOPI); const float* top_w = wsp<float>(F, WS_TOPW);
    int* pos = wsp<int>(F, WS_POS); float* roww = wsp<float>(F, WS_ROWW); const bf16* h2 = wsp<bf16>(F, WS_HN); bf16* xg = wsp<bf16>(F, WS_XG);
    int* counts_g = (int*)(F.ws + WS_POS) + S * 4;
    const int tid = F.tid, lane = F.lane, w = F.wave;
    { const int e = tid & 31, part = tid >> 5; int s = 0; for (int i = 0; i < NITER / 16; ++i) s += hist[(part * (NITER / 16) + i) * NE + e]; psum[part * NE + e] = s; }
    __syncthreads();
    if (tid == 0) { int acc = 0; for (int e = 0; e < NE; ++e) { int c = 0; for (int p = 0; p < 16; ++p) c += psum[p * NE + e]; startr[e] = acc; acc += ((c + 255) >> 8) << 8; if (blockIdx.x == 0) counts_g[e] = c; } }
    __syncthreads();
    for (int it = F.vcu; it < NITER; it += F.G) {
        {
            const int part = it / (NITER / 16), i0 = part * (NITER / 16);
            if (w < 4) { const bool on = (i0 + lane) < it;
#pragma unroll
                for (int q = 0; q < 8; ++q) { const int e = w * 8 + q; int v = on ? hist[(i0 + lane) * NE + e] : 0;
#pragma unroll
                    for (int o = 1; o < 64; o <<= 1) v += __shfl_xor(v, o);
                    if (lane == 0) { int b = v; for (int pp = 0; pp < part; ++pp) b += psum[pp * NE + e]; base[e] = b; } } }
        }
        __syncthreads();
#pragma unroll
        for (int j = 0; j < 4; ++j) { const int p = w + 8 * j, pair = it * 32 + p, e = top_i[pair], dest = startr[e] + base[e] + lrank[pair], t = pair >> 2;
            if (lane == 0) { pos[pair] = dest; roww[dest] = top_w[pair]; }
            const GAS v4u* src = (const GAS v4u*)(h2 + (size_t)t * D) + lane; GAS v4u* dst = (GAS v4u*)(xg + (size_t)dest * D) + lane;
#pragma unroll
            for (int q = 0; q < 4; ++q) dst[64 * q] = src[64 * q]; }
        __syncthreads();
    }
}
struct GroupedOrder {
    const LAS int* tab; int ntn, G, c;
    __device__ __forceinline__ bool next(int i, Unit& u) const {
        const int L = i * G + c, total = tab[32] * ntn; if (L >= total) return false;
        int e = 0;
#pragma unroll 1
        while (e < NE - 1 && tab[e + 1] * ntn <= L) ++e;
        const int ts = tab[e], tc = tab[e + 1] - ts, within = L - ts * ntn;
        u.pm = ts + within % tc; u.pn = within / tc; u.e = e; u.pb = e * ntn + u.pn; return true;
    }
    __device__ __forceinline__ void a_ready(const Unit&) const {}
    __device__ __forceinline__ void done(const Unit&) const {}
};
struct EpiSwiglu {
    static constexpr bool PERM = true, AFTER_DRAIN = false;
    bf16* act; const float* bug;
    __device__ __forceinline__ void operator()(const pg8::f32x4 (&acc)[2][2][4][2], const Unit& u, int wr, int wc, int fr, int fq) const {
        const int row0 = u.pm * 256 + wr * 64 + fr, f0 = u.pn * 128 + wc * 32 + 8 * fq;
        const float* bg = bug + (size_t)u.e * 4096 + f0; pg8::f32x4 bgv[2], buv[2];
#pragma unroll
        for (int n = 0; n < 2; ++n) { bgv[n] = *(const pg8::f32x4*)(bg + 4 * n); buv[n] = *(const pg8::f32x4*)(bg + 2048 + 4 * n); }
#pragma unroll
        for (int ai = 0; ai < 2; ++ai)
#pragma unroll
            for (int m = 0; m < 4; ++m) { float o[8];
#pragma unroll
                for (int n = 0; n < 2; ++n)
#pragma unroll
                    for (int i = 0; i < 4; ++i) { const float g = fminf(acc[ai][0][m][n][i] + bgv[n][i], 7.f); const float up = fminf(fmaxf(acc[ai][1][m][n][i] + buv[n][i], -7.f), 7.f);
                        o[4 * n + i] = (up + 1.f) * g * sigmoid_f(1.702f * g); }
                pg8::u32x4 wv; wv.x = cvt_pk_bf16(o[0], o[1]); wv.y = cvt_pk_bf16(o[2], o[3]); wv.z = cvt_pk_bf16(o[4], o[5]); wv.w = cvt_pk_bf16(o[6], o[7]);
                *(pg8::u32x4*)(act + (size_t)(row0 + ai * 128 + m * 16) * FF + f0) = wv; }
    }
};
struct EpiDown {
    static constexpr bool PERM = true, AFTER_DRAIN = false;
    bf16* y; const float* bd; const float* roww;
    __device__ __forceinline__ void operator()(const pg8::f32x4 (&acc)[2][2][4][2], const Unit& u, int wr, int wc, int fr, int fq) const {
        const int row0 = u.pm * 256 + wr * 64 + fr, col0 = u.pn * 256 + wc * 32 + 8 * fq;
        pg8::f32x4 bv[2][2];
#pragma unroll
        for (int bj = 0; bj < 2; ++bj)
#pragma unroll
            for (int n = 0; n < 2; ++n) bv[bj][n] = *(const pg8::f32x4*)(bd + (size_t)u.e * D + col0 + bj * 128 + 4 * n);
#pragma unroll
        for (int ai = 0; ai < 2; ++ai)
#pragma unroll
            for (int m = 0; m < 4; ++m) { const int row = row0 + ai * 128 + m * 16; const float rw = roww[row]; bf16* rowp = y + (size_t)row * D + col0;
#pragma unroll
                for (int bj = 0; bj < 2; ++bj) { const pg8::f32x4 v0 = (acc[ai][bj][m][0] + bv[bj][0]) * rw, v1 = (acc[ai][bj][m][1] + bv[bj][1]) * rw;
                    pg8::u32x4 wv; wv.x = cvt_pk_bf16(v0[0], v0[1]); wv.y = cvt_pk_bf16(v0[2], v0[3]); wv.z = cvt_pk_bf16(v1[0], v1[1]); wv.w = cvt_pk_bf16(v1[2], v1[3]);
                    *(pg8::u32x4*)(rowp + bj * 128) = wv; } }
    }
};
__device__ __forceinline__ void p11_final(Frame& F, float oscale) {
    LAS float* ms = (LAS float*)(F.lds + RING_OFF);
    const float* mod = wsp<float>(F, WS_MOD);
    for (int i = F.tid; i < 3 * D; i += NTHR) ms[i] = mod[5 * D + i];
    __syncthreads();
    const float* h1 = wsp<float>(F, WS_H1); const bf16* y = wsp<bf16>(F, WS_Y); const int* pos = wsp<int>(F, WS_POS);
    const int gw = F.vcu * NWAVES + F.wave, NGW = F.G * NWAVES, lane = F.lane;
    for (int t = gw; t < S; t += NGW) {
        asm volatile("" ::: "memory");
        const GAS f32x4* xr = (const GAS f32x4*)(h1 + (size_t)t * D) + lane;
        const GAS u32x2* y0 = (const GAS u32x2*)(y + (size_t)pos[t * 4 + 0] * D) + lane; const GAS u32x2* y1 = (const GAS u32x2*)(y + (size_t)pos[t * 4 + 1] * D) + lane;
        const GAS u32x2* y2 = (const GAS u32x2*)(y + (size_t)pos[t * 4 + 2] * D) + lane; const GAS u32x2* y3 = (const GAS u32x2*)(y + (size_t)pos[t * 4 + 3] * D) + lane;
        f32x4 v[8]; float s2 = 0.f;
#pragma unroll
        for (int j = 0; j < 8; ++j) { const u32x2 a = y0[64 * j], b = y1[64 * j], c = y2[64 * j], d = y3[64 * j]; const f32x4 g2 = *(const LAS f32x4*)(ms + 4 * lane + 256 * j);
            f32x4 f;
            f.x = (bf2f((unsigned short)(a.x & 0xffffu)) + bf2f((unsigned short)(b.x & 0xffffu))) + (bf2f((unsigned short)(c.x & 0xffffu)) + bf2f((unsigned short)(d.x & 0xffffu)));
            f.y = (bf2f((unsigned short)(a.x >> 16)) + bf2f((unsigned short)(b.x >> 16))) + (bf2f((unsigned short)(c.x >> 16)) + bf2f((unsigned short)(d.x >> 16)));
            f.z = (bf2f((unsigned short)(a.y & 0xffffu)) + bf2f((unsigned short)(b.y & 0xffffu))) + (bf2f((unsigned short)(c.y & 0xffffu)) + bf2f((unsigned short)(d.y & 0xffffu)));
            f.w = (bf2f((unsigned short)(a.y >> 16)) + bf2f((unsigned short)(b.y >> 16))) + (bf2f((unsigned short)(c.y >> 16)) + bf2f((unsigned short)(d.y >> 16)));
            v[j] = xr[64 * j] + g2 * f; s2 += (v[j].x * v[j].x + v[j].y * v[j].y) + (v[j].z * v[j].z + v[j].w * v[j].w); }
        const float r = rsqrtf(wave_sum(s2) * (1.f / D) + 1e-6f);
        GAS f32x4* o = (GAS f32x4*)(F.out + (size_t)t * D) + lane;
#pragma unroll
        for (int j = 0; j < 8; ++j) { const int c0 = 4 * lane + 256 * j; const f32x4 gg = *(const GAS f32x4*)(F.in[IN_NFIN] + c0); const f32x4 sh = *(const LAS f32x4*)(ms + D + c0), sc = *(const LAS f32x4*)(ms + 2 * D + c0);
            o[64 * j] = (v[j] * r * gg * (sc + 1.f) + sh) * oscale; }
    }
}
}
namespace mk {
struct Args { const float* in[24]; float* out; unsigned char* ws; int ph_lo, ph_hi, li, pad; };
constexpr int N_PHASES = 13;
__global__ void __launch_bounds__(NTHR, 2) mega_fwd(Args args) {
    extern __shared__ __attribute__((aligned(16))) unsigned char lds[];
    Frame F;
    F.lds = (LAS unsigned char*)lds;
    F.MISC = (volatile LAS unsigned*)(F.lds + MISC_OFF);
    F.tid = threadIdx.x; F.lane = F.tid & 63; F.wave = __builtin_amdgcn_readfirstlane(F.tid >> 6);
    F.G = gridDim.x; { const int bx = blockIdx.x; F.vcu = (F.G % 8 == 0) ? (bx % 8) * (F.G / 8) + bx / 8 : bx; }
    F.ws = args.ws; F.out = args.out; F.ctl = (gu32*)(args.ws + WS_CTL);
#pragma unroll
    for (int i = 0; i < 24; ++i) F.in[i] = args.in[i];
    for (int u = F.tid; u < (LDS_BYTES - LDSCTL_OFF) / 4; u += NTHR) ((LAS unsigned*)(F.lds + LDSCTL_OFF))[u] = 0u;
    __syncthreads();
    XcdBarrier bar = xcd_barrier_post((unsigned*)(F.ctl + CW_BAR) + args.li * XCD_BAR_WORDS, F.MISC + 8);
    const int lo = args.ph_lo, hi = args.ph_hi;
#define IN(k) (lo <= (k) && (k) < hi)
#define SEAM(k) do { if (IN(k) && IN((k) + 1)) xcd_barrier(bar); } while (0)

#ifndef MK_DOUBLE
#define MK_DOUBLE 0
#endif
#define DBL(k) ((MK_DOUBLE >> (k)) & 1)
#ifdef MK_PROBE_LO
    unsigned long long* stamps = (unsigned long long*)(F.ctl + 131072);
#define STAMP(k) do { if (blockIdx.x == 0 && F.tid == 0) stamps[k] = rt(); } while (0)
#define PROBE_SCALE() (1.f + sqrtf((float)(stamps[MK_PROBE_HI] - stamps[MK_PROBE_LO]) * 0.01f * 2e-5f))
#else
#define STAMP(k) do { } while (0)
#define PROBE_SCALE() 1.f
#endif
    STAMP(0); if (IN(0)) { p0_prologue(F); if (DBL(0)) p0_prologue(F); } SEAM(0);
    STAMP(1); if (IN(1)) { p1_modulate(F); if (DBL(1)) p1_modulate(F); } SEAM(1);
    STAMP(2); if (IN(2)) {
        pg8::Gemm g{wsp<pg8::bf16_t>(F, WS_HN), wsp<pg8::bf16_t>(F, WS_WIN), S, NPAD, D}; pg8::StaticOrder So; So.init(S, NPAD, F.G, (int)blockIdx.x);
        EpiProj E{wsp<bf16>(F, WS_PROJ), wsp<float>(F, WS_GATES)};
        pg8::gemm_phase<EpiProj, pg8::StaticOrder, true, true>(F.lds + RING_OFF, g, So, E);
        if (DBL(2)) pg8::gemm_phase<EpiProj, pg8::StaticOrder, true, true>(F.lds + RING_OFF, g, So, E);
    } SEAM(2);
    STAMP(3); if (IN(3)) { p3_prep(F); } SEAM(3);
    STAMP(4); if (IN(4)) { p4_scan(F); if (DBL(4)) p4_scan(F); } SEAM(4);
    STAMP(5); if (IN(5)) { p5_mlstm_out(F); if (DBL(14)) p5_mlstm_out(F); p5_attention(F, (char*)lds); } SEAM(5);
    STAMP(6); if (IN(6)) { p6_combine(F); } SEAM(6);
    STAMP(7); if (IN(7)) {
        pg8::Gemm g{wsp<pg8::bf16_t>(F, WS_CONCAT), wsp<pg8::bf16_t>(F, WS_WOUT), S, D, D}; pg8::StaticOrder So; So.init(S, D, F.G, (int)blockIdx.x);
        EpiOut E{F.in[IN_X], wsp<float>(F, WS_MOD) + 2 * D, wsp<float>(F, WS_H1)};
        pg8::gemm_phase<EpiOut, pg8::StaticOrder, false, true>(F.lds + RING_OFF, g, So, E);
        if (DBL(7)) pg8::gemm_phase<EpiOut, pg8::StaticOrder, false, true>(F.lds + RING_OFF, g, So, E);
    } SEAM(7);
    STAMP(8); if (IN(8)) { p7_router(F); if (DBL(8)) p7_router(F); } SEAM(8);
    STAMP(9); if (IN(9)) { p8_gather(F); if (DBL(9)) p8_gather(F); } SEAM(9);
    STAMP(10); if (IN(10)) {
        build_expert_table(F, (const int*)(F.ws + WS_POS) + S * 4);
        pg8::Gemm g{wsp<pg8::bf16_t>(F, WS_XG), wsp<pg8::bf16_t>(F, WS_WUG), MAXROWS, 4096, D}; GroupedOrder So{(const LAS int*)(F.lds + TAB_OFF), 16, F.G, (int)blockIdx.x};
        EpiSwiglu E{wsp<bf16>(F, WS_ACT), F.in[IN_BUG]};
        pg8::gemm_phase<EpiSwiglu, GroupedOrder, true, true>(F.lds + RING_OFF, g, So, E);
        if (DBL(10)) pg8::gemm_phase<EpiSwiglu, GroupedOrder, true, true>(F.lds + RING_OFF, g, So, E);
    } SEAM(10);
    STAMP(11); if (IN(11)) {
        build_expert_table(F, (const int*)(F.ws + WS_POS) + S * 4);
        pg8::Gemm g{wsp<pg8::bf16_t>(F, WS_ACT), wsp<pg8::bf16_t>(F, WS_WD), MAXROWS, D, FF}; GroupedOrder So{(const LAS int*)(F.lds + TAB_OFF), 8, F.G, (int)blockIdx.x};
        EpiDown E{wsp<bf16>(F, WS_Y), F.in[IN_BD], wsp<float>(F, WS_ROWW)};
        pg8::gemm_phase<EpiDown, GroupedOrder, true, true>(F.lds + RING_OFF, g, So, E);
        if (DBL(11)) pg8::gemm_phase<EpiDown, GroupedOrder, true, true>(F.lds + RING_OFF, g, So, E);
    } SEAM(11);
    STAMP(12); if (IN(12)) { p11_final(F, PROBE_SCALE()); if (DBL(12)) p11_final(F, PROBE_SCALE()); }
#undef IN
#undef SEAM
}
}
#ifndef MK_DEBUG
#define MK_DEBUG 0
#endif
#ifndef MK_PH_END
#define MK_PH_END mk::N_PHASES
#endif
#ifndef MK_SPLIT
#define MK_SPLIT 0
#endif
extern "C" void kernel_launch(void* const* d_in, const int* in_sizes, int n_in, void* d_out, int out_size, void* d_ws, size_t ws_size, hipStream_t stream) {
    using namespace mk;
    static int grid = 0;
    if (grid == 0) {
        int dev = 0, cus = 0, per_cu = 0;
        if (hipGetDevice(&dev) != hipSuccess || hipDeviceGetAttribute(&cus, hipDeviceAttributeMultiprocessorCount, dev) != hipSuccess) { fprintf(stderr, "kernel_launch: device query failed\n"); grid = -1; return; }
        if (hipFuncSetAttribute((const void*)mega_fwd, hipFuncAttributeMaxDynamicSharedMemorySize, LDS_BYTES) != hipSuccess) { fprintf(stderr, "kernel_launch: hipFuncSetAttribute failed\n"); grid = -1; return; }
        if (hipOccupancyMaxActiveBlocksPerMultiprocessor(&per_cu, (const void*)mega_fwd, NTHR, LDS_BYTES) != hipSuccess || per_cu < 1) fprintf(stderr, "kernel_launch: occupancy query reports %d\n", per_cu);
        (void)hipGetLastError();
        grid = cus;
        if (n_in != 24 || out_size != S * D || ws_size < (MK_DEBUG ? WS_NAIVE + (size_t)2300 * MiB : WS_END)) fprintf(stderr, "kernel_launch: unexpected sizes n_in %d out %d ws %zu\n", n_in, out_size, ws_size);
    }
    if (grid < 0) return;
    (void)hipMemsetAsync((char*)d_ws + WS_CTL, 0, CTL_ZERO_BYTES, stream);
    Args a{};
    for (int i = 0; i < 24; ++i) a.in[i] = (const float*)d_in[i];
    a.out = (float*)d_out; a.ws = (unsigned char*)d_ws;
#if MK_DEBUG
    nv::naive_forward(d_in, (float*)d_out, (char*)d_ws + WS_NAIVE, stream);
#endif
#if MK_SPLIT
    for (int p = 0; p < MK_PH_END; ++p) { a.ph_lo = p; a.ph_hi = p + 1; a.li = p; hipLaunchKernelGGL(mega_fwd, dim3(grid), dim3(NTHR), LDS_BYTES, stream, a); }
#else
    a.ph_lo = 0; a.ph_hi = MK_PH_END; a.li = 0;
    hipLaunchKernelGGL(mega_fwd, dim3(grid), dim3(NTHR), LDS_BYTES, stream, a);
#endif
#ifdef MK_EXTRA_LO
    a.ph_lo = MK_EXTRA_LO; a.ph_hi = MK_EXTRA_HI; a.li = 1;
    hipLaunchKernelGGL(mega_fwd, dim3(grid), dim3(NTHR), LDS_BYTES, stream, a);
#endif
    { const hipError_t le = hipPeekAtLastError(); if (le != hipSuccess) fprintf(stderr, "kernel_launch: launch failed: %s\n", hipGetErrorName(le)); }
#if MK_DEBUG
    {
        nv::NaiveWs w = nv::carve((char*)d_ws + WS_NAIVE);
        double* slots = (double*)((char*)d_ws + WS_CTL + 512 * 1024);
        unsigned char* ws = (unsigned char*)d_ws; int nc = 0;
        MK_DEBUG_CHECKS
        dbg::k_finish<<<1024, 256, 0, stream>>>((float*)d_out, (size_t)S * D, slots, nc, 1e-3);
    }
#endif
}
```

```cpp
#include <hip/hip_runtime.h>
#include <hip/hip_bf16.h>
#include <cstdio>
#include <cstdint>
namespace pg8 {
#define PG8_LAS __attribute__((address_space(3)))
typedef unsigned short bf16_t;
typedef short bf16x8 __attribute__((ext_vector_type(8)));
typedef float f32x4 __attribute__((ext_vector_type(4)));
typedef unsigned u32x4 __attribute__((ext_vector_type(4)));
constexpr int BM = 256, BK = 64, HALF = 128, HTB = HALF * BK * 2  , STAGE_BYTES = 8 * HTB, NXCD = 8, WGM = 8;

__host__ __device__ __forceinline__ int lds_byte(int r, int c) { const int st = (r >> 4) * 2 + (c >> 5), rr = r & 15, cc = c & 31, ob = rr * 64 + cc * 2; return st * 1024 + (ob ^ (((ob >> 9) & 1) << 5)); }
__host__ __device__ __forceinline__ void stage_rc(int b, int& R, int& C) { const int st = b / 1024, sb = b % 1024, swz = sb ^ (((sb >> 9) & 1) << 5); R = (st >> 1) * 16 + swz / 64; C = (st & 1) * 32 + (swz % 64) / 2; }
__host__ __device__ __forceinline__ int perm32(int rho) { const int n = rho >> 4, i = rho & 15; return 8 * (i >> 2) + 4 * n + (i & 3); }

struct Unit { int pm, pn, pb, e; };
struct Gemm { const bf16_t* A; const bf16_t* Bt; int M, N, K; };

struct StaticOrder {
    int nM, nN, nwg, G, c;
    __host__ __device__ void init(int M, int N, int G_, int c_) { nM = M / BM; nN = N / BM; nwg = nM * nN; G = G_; c = c_; }
    __host__ __device__ bool next(int i, Unit& u) const {
        const long L = (long)i * G + c; if (L >= nwg) return false;
        int wgid = (int)L; { const int q = nwg / NXCD, r = nwg % NXCD, xcd = wgid % NXCD, off = wgid / NXCD; wgid = (xcd < r ? xcd * (q + 1) : r * (q + 1) + (xcd - r) * q) + off; }
        const int nig = WGM * nN, gid = wgid / nig, fm = gid * WGM, gsz = (nM - fm) < WGM ? (nM - fm) : WGM;
        u.pm = fm + ((wgid % nig) % gsz); u.pn = (wgid % nig) / gsz; u.pb = u.pn; u.e = 0; return true;
    }
    __device__ __forceinline__ void a_ready(const Unit&) const {}
    __device__ __forceinline__ void done(const Unit&) const {}
};

__device__ __forceinline__ unsigned cvt_pk_bf16(float lo, float hi) { unsigned r; asm volatile("v_cvt_pk_bf16_f32 %0, %1, %2" : "=v"(r) : "v"(lo), "v"(hi)); return r; }
template <class Epi, class Sched, bool ALIGN_EPI = false, bool SP2 = false>
__device__ __forceinline__ void gemm_phase(PG8_LAS unsigned char* lds, const Gemm g, const Sched& S, const Epi& E) {
    const int tid = threadIdx.x, wid = __builtin_amdgcn_readfirstlane(tid >> 6), lane = tid & 63, wr = wid >> 2, wc = wid & 3, fr = lane & 15, fq = lane >> 4;
    const int K = g.K, nt = K / BK;
    unsigned voffA[2], voffB[2];
#pragma unroll
    for (int i = 0; i < 2; ++i) { int R, C; stage_rc(tid * 16 + i * 8192, R, C); const int Rb = Epi::PERM ? ((R & ~31) + perm32(R & 31)) : R;
        voffA[i] = (unsigned)(R * K + C) * 2u; voffB[i] = (unsigned)(Rb * K + C) * 2u; }
    const size_t kstep = (size_t)(BK * 2);
    const size_t hstep = (size_t)HALF * K * 2;
    const size_t tstep = 2 * hstep;
    const unsigned ldsw = (unsigned)wid * 1024u;
    const int aoff = lds_byte(wr * 64 + fr, fq * 8), boff = lds_byte(wc * 32 + fr, fq * 8);
#define PG8_SA(b, h) (((b) * 2 + (h)) * HTB)
#define PG8_SB(b, h) ((4 + (b) * 2 + (h)) * HTB)
#define PG8_STAGE(bufoff, gbase, voff) do { _Pragma("unroll") for (int _i = 0; _i < 2; ++_i) \
        __builtin_amdgcn_global_load_lds((const unsigned*)((const char*)(gbase) + (voff)[_i]), (PG8_LAS unsigned*)(lds + (bufoff) + ldsw + _i * 8192), 16, 0, 0); } while (0)
#define PG8_LDA(dst, b, h) do { _Pragma("unroll") for (int m = 0; m < 4; ++m) _Pragma("unroll") for (int k = 0; k < 2; ++k) dst[m][k] = *(const PG8_LAS bf16x8*)(lds + PG8_SA(b, h) + aoff + m * 2048 + k * 1024); } while (0)
#define PG8_LDB(dst, b, h) do { _Pragma("unroll") for (int n = 0; n < 2; ++n) _Pragma("unroll") for (int k = 0; k < 2; ++k) dst[n][k] = *(const PG8_LAS bf16x8*)(lds + PG8_SB(b, h) + boff + n * 2048 + k * 1024); } while (0)
#define PG8_MMA(ai, bj, At, Bt) do { __builtin_amdgcn_s_setprio(1); _Pragma("unroll") for (int m = 0; m < 4; ++m) _Pragma("unroll") for (int n = 0; n < 2; ++n) _Pragma("unroll") for (int k = 0; k < 2; ++k) \
        acc[ai][bj][m][n] = __builtin_amdgcn_mfma_f32_16x16x32_bf16(Bt[n][k], At[m][k], acc[ai][bj][m][n], 0, 0, 0); __builtin_amdgcn_s_setprio(0); } while (0)
#define PG8_WAIT_V(n) asm volatile("s_waitcnt vmcnt(" #n ")" ::: "memory")
#define PG8_WAIT_L(n) asm volatile("s_waitcnt lgkmcnt(" #n ")" ::: "memory")
#define PG8_BAR __builtin_amdgcn_s_barrier()
#define PG8_SCHED __builtin_amdgcn_sched_barrier(0)
    Unit cur, nxt; int ui = 0;
    if (!S.next(0, cur)) return;
    f32x4 acc[2][2][4][2];
#pragma unroll
    for (int a = 0; a < 2; ++a)
#pragma unroll
        for (int b = 0; b < 2; ++b)
#pragma unroll
            for (int m = 0; m < 4; ++m)
#pragma unroll
                for (int n = 0; n < 2; ++n) acc[a][b][m][n] = (f32x4){0.f, 0.f, 0.f, 0.f};
    bf16x8 At[4][2], B0[2][2], B1[2][2];
    const char* cA = (const char*)g.A + (size_t)cur.pm * tstep; const char* cB = (const char*)g.Bt + (size_t)cur.pb * tstep;
    S.a_ready(cur);
    if constexpr (SP2) {
        PG8_STAGE(PG8_SB(0, 0), cB, voffB); PG8_STAGE(PG8_SB(0, 1), cB + hstep, voffB); PG8_STAGE(PG8_SA(0, 0), cA, voffA); PG8_STAGE(PG8_SA(0, 1), cA + hstep, voffA);
        if (wr == 1) PG8_BAR;
        PG8_WAIT_V(2); PG8_BAR;
        PG8_STAGE(PG8_SB(1, 0), cB + kstep, voffB); PG8_STAGE(PG8_SA(1, 0), cA + kstep, voffA); PG8_STAGE(PG8_SB(1, 1), cB + hstep + kstep, voffB);
        PG8_WAIT_V(6); PG8_BAR;
    } else {
        PG8_STAGE(PG8_SB(0, 0), cB, voffB); PG8_STAGE(PG8_SA(0, 0), cA, voffA); PG8_STAGE(PG8_SB(0, 1), cB + hstep, voffB); PG8_STAGE(PG8_SA(0, 1), cA + hstep, voffA);
        if (wr == 1) PG8_BAR;
        PG8_WAIT_V(4); PG8_BAR;
        PG8_STAGE(PG8_SB(1, 0), cB + kstep, voffB); PG8_STAGE(PG8_SA(1, 0), cA + kstep, voffA); PG8_STAGE(PG8_SB(1, 1), cB + hstep + kstep, voffB);
        PG8_WAIT_V(6); PG8_BAR;
    }
    for (;;) {
        const bool has_next = S.next(ui + 1, nxt);
        const char* nA = has_next ? (const char*)g.A + (size_t)nxt.pm * tstep : cA; const char* nB = has_next ? (const char*)g.Bt + (size_t)nxt.pb * tstep : cB;
        for (int t = 0; t < nt; t += 2) {
            const bool last = (t == nt - 2);
            const char* a1 = cA + (size_t)(t + 1) * kstep;
            const char* a2 = last ? nA : cA + (size_t)(t + 2) * kstep; const char* b2 = last ? nB : cB + (size_t)(t + 2) * kstep;
            const char* a3 = a2 + kstep; const char* b3 = b2 + kstep;
            if (last && has_next) S.a_ready(nxt);
            if constexpr (SP2) {
            PG8_LDB(B0, 0, 0); PG8_LDB(B1, 0, 1); PG8_SCHED; PG8_LDA(At, 0, 0); PG8_STAGE(PG8_SA(1, 1), a1 + hstep, voffA);
            PG8_WAIT_V(8); PG8_WAIT_L(0); PG8_BAR; PG8_MMA(0, 0, At, B0); PG8_MMA(0, 1, At, B1); PG8_BAR; PG8_SCHED;
            PG8_LDA(At, 0, 1); PG8_STAGE(PG8_SB(0, 0), b2, voffB); PG8_STAGE(PG8_SB(0, 1), b2 + hstep, voffB); PG8_STAGE(PG8_SA(0, 0), a2, voffA);
            PG8_WAIT_V(8); PG8_WAIT_L(0); PG8_BAR; PG8_MMA(1, 0, At, B0); PG8_MMA(1, 1, At, B1); PG8_BAR; PG8_SCHED;
            PG8_LDB(B0, 1, 0); PG8_LDB(B1, 1, 1); PG8_SCHED; PG8_LDA(At, 1, 0); PG8_STAGE(PG8_SA(0, 1), a2 + hstep, voffA);
            PG8_WAIT_V(8); PG8_WAIT_L(0); PG8_BAR; PG8_MMA(0, 0, At, B0); PG8_MMA(0, 1, At, B1); PG8_BAR; PG8_SCHED;
            PG8_LDA(At, 1, 1); PG8_STAGE(PG8_SB(1, 0), b3, voffB); PG8_STAGE(PG8_SB(1, 1), b3 + hstep, voffB); PG8_STAGE(PG8_SA(1, 0), a3, voffA);
            PG8_WAIT_V(8); PG8_WAIT_L(0); PG8_BAR; PG8_MMA(1, 0, At, B0); PG8_MMA(1, 1, At, B1); PG8_BAR; PG8_SCHED;
            } else {
            PG8_LDB(B0, 0, 0); PG8_SCHED; PG8_LDA(At, 0, 0); PG8_STAGE(PG8_SA(1, 1), a1 + hstep, voffA);
            PG8_WAIT_L(8); PG8_BAR; PG8_WAIT_L(0); PG8_MMA(0, 0, At, B0); PG8_BAR; PG8_SCHED;
            PG8_LDB(B1, 0, 1); PG8_STAGE(PG8_SB(0, 0), b2, voffB);
            PG8_BAR; PG8_WAIT_L(0); PG8_MMA(0, 1, At, B1); PG8_BAR;
            PG8_LDA(At, 0, 1); PG8_STAGE(PG8_SA(0, 0), a2, voffA);
            PG8_BAR; PG8_WAIT_L(0); PG8_MMA(1, 0, At, B0); PG8_BAR; PG8_SCHED;
            PG8_STAGE(PG8_SB(0, 1), b2 + hstep, voffB);
            PG8_WAIT_V(6); PG8_BAR; PG8_MMA(1, 1, At, B1); PG8_BAR;
            PG8_LDB(B0, 1, 0); PG8_SCHED; PG8_LDA(At, 1, 0); PG8_STAGE(PG8_SA(0, 1), a2 + hstep, voffA);
            PG8_WAIT_L(8); PG8_BAR; PG8_WAIT_L(0); PG8_MMA(0, 0, At, B0); PG8_BAR; PG8_SCHED;
            PG8_LDB(B1, 1, 1); PG8_STAGE(PG8_SB(1, 0), b3, voffB);
            PG8_BAR; PG8_WAIT_L(0); PG8_MMA(0, 1, At, B1); PG8_BAR;
            PG8_LDA(At, 1, 1); PG8_STAGE(PG8_SA(1, 0), a3, voffA);
            PG8_BAR; PG8_WAIT_L(0); PG8_MMA(1, 0, At, B0); PG8_BAR; PG8_SCHED;
            PG8_STAGE(PG8_SB(1, 1), b3 + hstep, voffB);
            PG8_WAIT_V(6); PG8_BAR; PG8_MMA(1, 1, At, B1); PG8_BAR;
            }
        }
        if constexpr (ALIGN_EPI) { if (wr == 0) PG8_BAR; }
        if constexpr (!Epi::AFTER_DRAIN) { E(acc, cur, wr, wc, fr, fq); S.done(cur); }
        if (!has_next) break;
#pragma unroll
        for (int a = 0; a < 2; ++a)
#pragma unroll
            for (int b = 0; b < 2; ++b)
#pragma unroll
                for (int m = 0; m < 4; ++m)
#pragma unroll
                    for (int n = 0; n < 2; ++n) acc[a][b][m][n] = (f32x4){0.f, 0.f, 0.f, 0.f};
        cur = nxt; cA = nA; cB = nB; ++ui;
        if constexpr (ALIGN_EPI) { if (wr == 1) PG8_BAR; }
    }
    PG8_WAIT_V(0);
    if constexpr (!ALIGN_EPI) { if (wr == 0) PG8_BAR; }
    PG8_BAR;
    if constexpr (Epi::AFTER_DRAIN) { E.fused(acc, cur, wr, wc, fr, fq, lds, wid, lane); S.done(cur); }
#undef PG8_SA
#undef PG8_SB
#undef PG8_STAGE
#undef PG8_LDA
#undef PG8_LDB
#undef PG8_MMA
#undef PG8_WAIT_V
#undef PG8_WAIT_L
#undef PG8_BAR
#undef PG8_SCHED
}
typedef int v8i __attribute__((ext_vector_type(8)));
typedef int v4i __attribute__((ext_vector_type(4)));
constexpr int SCALE_W8 = 0x78787878, SCALE_A8 = 0x7f7f7f7f;
template <class Epi, class Sched, bool ALIGN_EPI = false, bool SP2 = false>
__device__ __forceinline__ void gemm_phase8(PG8_LAS unsigned char* lds, const Gemm g, const Sched& S, const Epi& E) {
    const int tid = threadIdx.x, wid = __builtin_amdgcn_readfirstlane(tid >> 6), lane = tid & 63, wr = wid >> 2, wc = wid & 3, fr = lane & 15, fq = lane >> 4;
    const int K = g.K, nt = K / BK;
    unsigned voffA[2], voffB[2];
#pragma unroll
    for (int i = 0; i < 2; ++i) { int R, C; stage_rc(tid * 16 + i * 8192, R, C); const int Rb = Epi::PERM ? ((R & ~31) + perm32(R & 31)) : R;
        voffA[i] = (unsigned)(R * K + C) * 2u; voffB[i] = (unsigned)(Rb * K + C) * 2u; }
    const size_t kstep = (size_t)(BK * 2);
    const size_t hstep = (size_t)HALF * K * 2;
    const size_t tstep = 2 * hstep;
    const unsigned ldsw = (unsigned)wid * 1024u;
    const int aoff = lds_byte(wr * 64 + fr, (fq & 1) * 16) + (fq >> 1) * 1024, boff = lds_byte(wc * 32 + fr, (fq & 1) * 16) + (fq >> 1) * 1024;
#define PG8_SA(b, h) (((b) * 2 + (h)) * HTB)
#define PG8_SB(b, h) ((4 + (b) * 2 + (h)) * HTB)
#define PG8_STAGE(bufoff, gbase, voff) do { _Pragma("unroll") for (int _i = 0; _i < 2; ++_i) \
        __builtin_amdgcn_global_load_lds((const unsigned*)((const char*)(gbase) + (voff)[_i]), (PG8_LAS unsigned*)(lds + (bufoff) + ldsw + _i * 8192), 16, 0, 0); } while (0)
#define PG8_LDA(dst, b, h) do { _Pragma("unroll") for (int m = 0; m < 4; ++m) { const v4i lo_ = *(const PG8_LAS v4i*)(lds + PG8_SA(b, h) + aoff + m * 2048), hi_ = *(const PG8_LAS v4i*)(lds + PG8_SA(b, h) + aoff + m * 2048 + 16); \
        dst[m] = __builtin_shufflevector(lo_, hi_, 0, 1, 2, 3, 4, 5, 6, 7); } } while (0)
#define PG8_LDB(dst, b, h) do { _Pragma("unroll") for (int n = 0; n < 2; ++n) { const v4i lo_ = *(const PG8_LAS v4i*)(lds + PG8_SB(b, h) + boff + n * 2048), hi_ = *(const PG8_LAS v4i*)(lds + PG8_SB(b, h) + boff + n * 2048 + 16); \
        dst[n] = __builtin_shufflevector(lo_, hi_, 0, 1, 2, 3, 4, 5, 6, 7); } } while (0)
#define PG8_MMA(ai, bj, At, Bt) do { __builtin_amdgcn_s_setprio(1); _Pragma("unroll") for (int m = 0; m < 4; ++m) _Pragma("unroll") for (int n = 0; n < 2; ++n) \
        asm volatile("v_mfma_scale_f32_16x16x128_f8f6f4 %0, %1, %2, %0, %3, %4 op_sel_hi:[0,0,0]" : "+v"(acc[ai][bj][m][n]) : "v"(Bt[n]), "v"(At[m]), "v"(sw8), "v"(sa8)); __builtin_amdgcn_s_setprio(0); } while (0)
#define PG8_WAIT_V(n) asm volatile("s_waitcnt vmcnt(" #n ")" ::: "memory")
#define PG8_WAIT_L(n) asm volatile("s_waitcnt lgkmcnt(" #n ")" ::: "memory")
#define PG8_BAR __builtin_amdgcn_s_barrier()
#define PG8_SCHED __builtin_amdgcn_sched_barrier(0)
    Unit cur, nxt; int ui = 0;
    if (!S.next(0, cur)) return;
    f32x4 acc[2][2][4][2];
#pragma unroll
    for (int a = 0; a < 2; ++a)
#pragma unroll
        for (int b = 0; b < 2; ++b)
#pragma unroll
            for (int m = 0; m < 4; ++m)
#pragma unroll
                for (int n = 0; n < 2; ++n) acc[a][b][m][n] = (f32x4){0.f, 0.f, 0.f, 0.f};
    v8i At[4], B0[2], B1[2]; int sw8 = SCALE_W8, sa8 = SCALE_A8;
    const char* cA = (const char*)g.A + (size_t)cur.pm * tstep; const char* cB = (const char*)g.Bt + (size_t)cur.pb * tstep;
    S.a_ready(cur);
    if constexpr (SP2) {
        PG8_STAGE(PG8_SB(0, 0), cB, voffB); PG8_STAGE(PG8_SB(0, 1), cB + hstep, voffB); PG8_STAGE(PG8_SA(0, 0), cA, voffA); PG8_STAGE(PG8_SA(0, 1), cA + hstep, voffA);
        if (wr == 1) PG8_BAR;
        PG8_WAIT_V(2); PG8_BAR;
        PG8_STAGE(PG8_SB(1, 0), cB + kstep, voffB); PG8_STAGE(PG8_SA(1, 0), cA + kstep, voffA); PG8_STAGE(PG8_SB(1, 1), cB + hstep + kstep, voffB);
        PG8_WAIT_V(6); PG8_BAR;
    } else {
        PG8_STAGE(PG8_SB(0, 0), cB, voffB); PG8_STAGE(PG8_SA(0, 0), cA, voffA); PG8_STAGE(PG8_SB(0, 1), cB + hstep, voffB); PG8_STAGE(PG8_SA(0, 1), cA + hstep, voffA);
        if (wr == 1) PG8_BAR;
        PG8_WAIT_V(4); PG8_BAR;
        PG8_STAGE(PG8_SB(1, 0), cB + kstep, voffB); PG8_STAGE(PG8_SA(1, 0), cA + kstep, voffA); PG8_STAGE(PG8_SB(1, 1), cB + hstep + kstep, voffB);
        PG8_WAIT_V(6); PG8_BAR;
    }
    for (;;) {
        const bool has_next = S.next(ui + 1, nxt);
        const char* nA = has_next ? (const char*)g.A + (size_t)nxt.pm * tstep : cA; const char* nB = has_next ? (const char*)g.Bt + (size_t)nxt.pb * tstep : cB;
        for (int t = 0; t < nt; t += 2) {
            const bool last = (t == nt - 2);
            const char* a1 = cA + (size_t)(t + 1) * kstep;
            const char* a2 = last ? nA : cA + (size_t)(t + 2) * kstep; const char* b2 = last ? nB : cB + (size_t)(t + 2) * kstep;
            const char* a3 = a2 + kstep; const char* b3 = b2 + kstep;
            if (last && has_next) S.a_ready(nxt);
            if constexpr (SP2) {
            PG8_LDB(B0, 0, 0); PG8_LDB(B1, 0, 1); PG8_SCHED; PG8_LDA(At, 0, 0); PG8_STAGE(PG8_SA(1, 1), a1 + hstep, voffA);
            PG8_WAIT_V(8); PG8_WAIT_L(0); PG8_BAR; PG8_MMA(0, 0, At, B0); PG8_MMA(0, 1, At, B1); PG8_BAR; PG8_SCHED;
            PG8_LDA(At, 0, 1); PG8_STAGE(PG8_SB(0, 0), b2, voffB); PG8_STAGE(PG8_SB(0, 1), b2 + hstep, voffB); PG8_STAGE(PG8_SA(0, 0), a2, voffA);
            PG8_WAIT_V(8); PG8_WAIT_L(0); PG8_BAR; PG8_MMA(1, 0, At, B0); PG8_MMA(1, 1, At, B1); PG8_BAR; PG8_SCHED;
            PG8_LDB(B0, 1, 0); PG8_LDB(B1, 1, 1); PG8_SCHED; PG8_LDA(At, 1, 0); PG8_STAGE(PG8_SA(0, 1), a2 + hstep, voffA);
            PG8_WAIT_V(8); PG8_WAIT_L(0); PG8_BAR; PG8_MMA(0, 0, At, B0); PG8_MMA(0, 1, At, B1); PG8_BAR; PG8_SCHED;
            PG8_LDA(At, 1, 1); PG8_STAGE(PG8_SB(1, 0), b3, voffB); PG8_STAGE(PG8_SB(1, 1), b3 + hstep, voffB); PG8_STAGE(PG8_SA(1, 0), a3, voffA);
            PG8_WAIT_V(8); PG8_WAIT_L(0); PG8_BAR; PG8_MMA(1, 0, At, B0); PG8_MMA(1, 1, At, B1); PG8_BAR; PG8_SCHED;
            } else {
            PG8_LDB(B0, 0, 0); PG8_SCHED; PG8_LDA(At, 0, 0); PG8_STAGE(PG8_SA(1, 1), a1 + hstep, voffA);
            PG8_WAIT_L(8); PG8_BAR; PG8_WAIT_L(0); PG8_MMA(0, 0, At, B0); PG8_BAR; PG8_SCHED;
            PG8_LDB(B1, 0, 1); PG8_STAGE(PG8_SB(0, 0), b2, voffB);
            PG8_BAR; PG8_WAIT_L(0); PG8_MMA(0, 1, At, B1); PG8_BAR;
            PG8_LDA(At, 0, 1); PG8_STAGE(PG8_SA(0, 0), a2, voffA);
            PG8_BAR; PG8_WAIT_L(0); PG8_MMA(1, 0, At, B0); PG8_BAR; PG8_SCHED;
            PG8_STAGE(PG8_SB(0, 1), b2 + hstep, voffB);
            PG8_WAIT_V(6); PG8_BAR; PG8_MMA(1, 1, At, B1); PG8_BAR;
            PG8_LDB(B0, 1, 0); PG8_SCHED; PG8_LDA(At, 1, 0); PG8_STAGE(PG8_SA(0, 1), a2 + hstep, voffA);
            PG8_WAIT_L(8); PG8_BAR; PG8_WAIT_L(0); PG8_MMA(0, 0, At, B0); PG8_BAR; PG8_SCHED;
            PG8_LDB(B1, 1, 1); PG8_STAGE(PG8_SB(1, 0), b3, voffB);
            PG8_BAR; PG8_WAIT_L(0); PG8_MMA(0, 1, At, B1); PG8_BAR;
            PG8_LDA(At, 1, 1); PG8_STAGE(PG8_SA(1, 0), a3, voffA);
            PG8_BAR; PG8_WAIT_L(0); PG8_MMA(1, 0, At, B0); PG8_BAR; PG8_SCHED;
            PG8_STAGE(PG8_SB(1, 1), b3 + hstep, voffB);
            PG8_WAIT_V(6); PG8_BAR; PG8_MMA(1, 1, At, B1); PG8_BAR;
            }
        }
        if constexpr (ALIGN_EPI) { if (wr == 0) PG8_BAR; }
        asm volatile("s_nop 15\n\ts_nop 7" ::: "memory");
        if constexpr (!Epi::AFTER_DRAIN) { E(acc, cur, wr, wc, fr, fq); S.done(cur); }
        if (!has_next) break;
#pragma unroll
        for (int a = 0; a < 2; ++a)
#pragma unroll
            for (int b = 0; b < 2; ++b)
#pragma unroll
                for (int m = 0; m < 4; ++m)
#pragma unroll
                    for (int n = 0; n < 2; ++n) acc[a][b][m][n] = (f32x4){0.f, 0.f, 0.f, 0.f};
        cur = nxt; cA = nA; cB = nB; ++ui;
        if constexpr (ALIGN_EPI) { if (wr == 1) PG8_BAR; }
    }
    PG8_WAIT_V(0);
    if constexpr (!ALIGN_EPI) { if (wr == 0) PG8_BAR; }
    PG8_BAR;
    if constexpr (Epi::AFTER_DRAIN) { E.fused(acc, cur, wr, wc, fr, fq, lds, wid, lane); S.done(cur); }
#undef PG8_SA
#undef PG8_SB
#undef PG8_STAGE
#undef PG8_LDA
#undef PG8_LDB
#undef PG8_MMA
#undef PG8_WAIT_V
#undef PG8_WAIT_L
#undef PG8_BAR
#undef PG8_SCHED
}
}
#define GAS __attribute__((address_space(1)))
#define LAS __attribute__((address_space(3)))
typedef unsigned short bf16;
typedef unsigned v4u __attribute__((ext_vector_type(4)));
typedef float f32x4 __attribute__((ext_vector_type(4)));
typedef short bf16x8 __attribute__((ext_vector_type(8)));
typedef GAS unsigned gu32;
typedef GAS unsigned long long gu64;
#define RLX_AGENT __ATOMIC_RELAXED, __HIP_MEMORY_SCOPE_AGENT
#define LDS_WAIT() asm volatile("s_waitcnt lgkmcnt(0)" ::: "memory")
#define VM_WAIT() asm volatile("s_waitcnt vmcnt(0)" ::: "memory")
__device__ __forceinline__ unsigned long long rt() { return __builtin_amdgcn_s_memrealtime(); }
__device__ __forceinline__ unsigned f2bf(float f) { unsigned u = __builtin_bit_cast(unsigned, f); return (u + 0x7fffu + ((u >> 16) & 1u)) >> 16; }
__device__ __forceinline__ unsigned pk2(float lo, float hi) { return f2bf(lo) | (f2bf(hi) << 16); }

#define XB_TMO      128
#define XB_XCNT(j)  (256  + 64 * (j))
#define XB_XSUB(j)  (1280 + 64 * (j))
#define XB_XGEN(j)  (2304 + 64 * (j))
#define XB_TOP      3328
#define XB_TOPGEN   3392
#define XCD_BAR_WORDS 3456
#define XB_SPIN_CAP (1u << 18)

__device__ __forceinline__ unsigned xb_ld(unsigned* p)              { return __hip_atomic_load(p, __ATOMIC_RELAXED, __HIP_MEMORY_SCOPE_AGENT); }
__device__ __forceinline__ unsigned xb_add(unsigned* p, unsigned v) { return __hip_atomic_fetch_add(p, v, __ATOMIC_RELAXED, __HIP_MEMORY_SCOPE_AGENT); }
__device__ __forceinline__ unsigned xb_xcc_id() { return (unsigned)__builtin_amdgcn_s_getreg((3 << 11) | 20) & 0xFu; }
#define XB_SPIN(cond, bar) do { unsigned _sp = 0; while (cond) { __builtin_amdgcn_s_sleep(1); \
    if ((++_sp & 255u) == 0u) { if (xb_ld(&(bar)[XB_TMO])) break; if (_sp > XB_SPIN_CAP) { atomicAdd(&(bar)[XB_TMO], 1u); break; } } } } while (0)

struct XcdBarrier {
    unsigned* bar; unsigned x;
    volatile LAS unsigned* st;
};

__device__ __forceinline__ XcdBarrier xcd_barrier_post(unsigned* bar, volatile LAS unsigned* st) {
    XcdBarrier b; b.bar = bar; b.x = xb_xcc_id(); b.st = st;
    if (threadIdx.x == 0) (void)xb_add(&bar[XB_XCNT(b.x)], 1u);
    return b;
}
__device__ __forceinline__ void xcd_barrier_complete(unsigned* bar, unsigned x, unsigned& nloc, unsigned& nx) {
    const unsigned G = gridDim.x * gridDim.y * gridDim.z;
    unsigned sum, cnt, mine, sp = 0u;
    for (;;) {
        sum = 0u; cnt = 0u; mine = 0u;
#pragma unroll
        for (unsigned j = 0; j < 16; ++j) { const unsigned c = xb_ld(&bar[XB_XCNT(j)]); sum += c; cnt += (c > 0u) ? 1u : 0u; mine = (j == x) ? c : mine; }
        if (sum == G) break;
        __builtin_amdgcn_s_sleep(1);
        if ((++sp & 255u) == 0u) { if (xb_ld(&bar[XB_TMO])) break; if (sp > XB_SPIN_CAP) { atomicAdd(&bar[XB_TMO], 1u); break; } }
    }
    nloc = mine > 0u ? mine : 1u; nx = cnt > 0u ? cnt : 1u;
}

__device__ __forceinline__ void xcd_barrier(const XcdBarrier& b) {
    asm volatile("s_waitcnt vmcnt(0)" ::: "memory");
    __syncthreads();
    if (threadIdx.x == 0) {
        unsigned* bar = b.bar;
        __builtin_amdgcn_s_waitcnt(0);
        unsigned nloc = b.st[0], nx = b.st[1];
        if (nloc == 0u) { xcd_barrier_complete(bar, b.x, nloc, nx); b.st[0] = nloc; b.st[1] = nx; }
        const unsigned old = xb_add(&bar[XB_XSUB(b.x)], 1u);
        const unsigned gen = old / nloc;
        if (old + 1u == (gen + 1u) * nloc) {
            __builtin_amdgcn_fence(__ATOMIC_RELEASE, "agent");
            asm volatile("s_waitcnt vmcnt(0)" ::: "memory");
            const unsigned og = xb_add(&bar[XB_TOP], 1u);
            const unsigned tg = og / nx;
            if (og + 1u == (tg + 1u) * nx) xb_add(&bar[XB_TOPGEN], 1u);
            else XB_SPIN(xb_ld(&bar[XB_TOPGEN]) == tg, bar);
            __builtin_amdgcn_fence(__ATOMIC_ACQUIRE, "agent");
            xb_add(&bar[XB_XGEN(b.x)], 1u);
            asm volatile("s_waitcnt vmcnt(0)" ::: "memory");
        } else {
            XB_SPIN(xb_ld(&bar[XB_XGEN(b.x)]) == gen, bar);
            __builtin_amdgcn_fence(__ATOMIC_ACQUIRE, "agent");
            asm volatile("s_waitcnt vmcnt(0)" ::: "memory");
        }
    }
    __syncthreads();
}
namespace mk {
constexpr int S = 8192, D = 2048, NPROJ = 6160, NPP = 6144, NPAD = 6400, NE = 32, FF = 2048, NWAVES = 8, NTHR = 512;
constexpr int C_MQ = 0, C_MK = 512, C_MV = 1024, C_MO = 2048, C_FQ = 3072, C_FK = 4096, C_FV = 5120;
constexpr int MAXROWS = S * 4 + NE * 256;
constexpr int NCH = 128, LCH = 64;
constexpr size_t MiB = 1u << 20;
constexpr size_t WS_CTL = 0, CTL_ZERO_BYTES = 1 * MiB;
constexpr size_t WS_MODP = 1 * MiB;
constexpr size_t WS_MOD = 2 * MiB;
constexpr size_t WS_GATES = 3 * MiB;
constexpr size_t WS_F = 4 * MiB;
constexpr size_t WS_NL = 5 * MiB;
constexpr size_t WS_NS = 6 * MiB;
constexpr size_t WS_GLAL = 7 * MiB;
constexpr size_t WS_MS = 7 * MiB + 65536;
constexpr size_t WS_TOPI = 8 * MiB;
constexpr size_t WS_TOPW = 9 * MiB;
constexpr size_t WS_HIST = 10 * MiB;
constexpr size_t WS_LRANK = 11 * MiB;
constexpr size_t WS_POS = 12 * MiB;
constexpr size_t WS_ROWW = 13 * MiB;
constexpr size_t WS_WIN = 16 * MiB;
constexpr size_t WS_WOUT = 42 * MiB;
constexpr size_t WS_HN = 50 * MiB;
constexpr size_t WS_PROJ = 82 * MiB;
constexpr size_t WS_UL = 178 * MiB;
constexpr size_t WS_CS = 242 * MiB;
constexpr size_t WS_CONCAT = 274 * MiB;
constexpr size_t WS_H1 = 306 * MiB;
constexpr size_t WS_XG = 370 * MiB;
constexpr size_t WS_ACT = 530 * MiB;
constexpr size_t WS_Y = 690 * MiB;
constexpr size_t WS_WUG = 850 * MiB;
constexpr size_t WS_WD = 1362 * MiB;
constexpr size_t WS_OPART = 1618 * MiB;
constexpr size_t WS_MLP = 1786 * MiB;
constexpr size_t WS_JLO = 1789 * MiB;
constexpr size_t WS_END = 1790 * MiB;
constexpr size_t WS_NAIVE = 1792 * MiB;
constexpr int CW_TMO = 0, CW_CODE = 1, CW_BAR = 4096;
constexpr int RING_OFF = 0, RING_BYTES = 131072;
constexpr int LDSCTL_OFF = RING_BYTES, MISC_OFF = LDSCTL_OFF + 320;
constexpr int TAB_OFF = LDSCTL_OFF + 1024;
constexpr int ATT_CH = 16;
constexpr int LDS_BYTES = 147456;
}
namespace mk {
typedef float f32x2 __attribute__((ext_vector_type(2)));
typedef unsigned u32x2 __attribute__((ext_vector_type(2)));
typedef float f32x16 __attribute__((ext_vector_type(16)));
struct Frame {
    LAS unsigned char* lds;
    volatile LAS unsigned* MISC;
    gu32* ctl;
    int tid, lane, wave, vcu, G;
    const float* in[24];
    float* out; unsigned char* ws;
};
#define IN_X 0
#define IN_C 1
#define IN_WADA 2
#define IN_BADA 3
#define IN_NMIX 4
#define IN_WIN 5
#define IN_BI 6
#define IN_BF 7
#define IN_FOXBF 8
#define IN_FOXQN 9
#define IN_FOXKN 10
#define IN_MOUTN 11
#define IN_FOUTN 12
#define IN_WOUT 13
#define IN_NFFN 14
#define IN_WR 15
#define IN_BR 16
#define IN_WUG 17
#define IN_BUG 18
#define IN_WD 19
#define IN_BD 20
#define IN_WAF 21
#define IN_BAF 22
#define IN_NFIN 23
template <class T> __device__ __forceinline__ T* wsp(const Frame& F, size_t off) { return (T*)(F.ws + off); }
__device__ __forceinline__ float wave_sum(float v) {
#pragma unroll
    for (int o = 1; o < 64; o <<= 1) v += __shfl_xor(v, o);
    return v;
}
__device__ __forceinline__ float sigmoid_f(float v) { return 1.f / (1.f + __expf(-v)); }
__device__ __forceinline__ float log_sigmoid_f(float v) { return fminf(v, 0.f) - log1pf(__expf(-fabsf(v))); }
__device__ __forceinline__ float softcap_f(float v) { return 15.f * tanhf(v * (1.f / 15.f)); }
__device__ __forceinline__ float bf2f(unsigned short b) { return __uint_as_float(((unsigned)b) << 16); }

struct CvtItem { const float* src; bf16* dst; };
__device__ __forceinline__ void cvt_load(const CvtItem& it, int ldw, f32x4 (&v)[16], int lane) {
    const float* p = it.src + (size_t)((lane >> 4) * 16) * ldw + (lane & 15) * 4;
#pragma unroll
    for (int i = 0; i < 16; ++i) v[i] = *(const GAS f32x4*)(p + (size_t)i * ldw);
}
__device__ __forceinline__ void cvt_store(const CvtItem& it, int K, const f32x4 (&v)[16], LAS unsigned char* scr, int lane) {
    const int c = lane & 15, g = lane >> 4;
#pragma unroll
    for (int j = 0; j < 4; ++j) {
        v4u a, b;
        a.x = pk2(v[0][j], v[1][j]); a.y = pk2(v[2][j], v[3][j]); a.z = pk2(v[4][j], v[5][j]); a.w = pk2(v[6][j], v[7][j]);
        b.x = pk2(v[8][j], v[9][j]); b.y = pk2(v[10][j], v[11][j]); b.z = pk2(v[12][j], v[13][j]); b.w = pk2(v[14][j], v[15][j]);
        LAS unsigned char* q = scr + (4 * c + j) * 144 + 32 * g;
        *(LAS v4u*)q = a; *(LAS v4u*)(q + 16) = b; }
    LDS_WAIT(); asm volatile("" ::: "memory");
#pragma unroll
    for (int i = 0; i < 8; ++i) { const int row = (lane >> 3) + 8 * i; const v4u o = *(const LAS v4u*)(scr + row * 144 + (lane & 7) * 16);
        *(GAS v4u*)(it.dst + (size_t)row * K + (lane & 7) * 8) = o; }
    LDS_WAIT(); asm volatile("" ::: "memory");
}
__device__ __forceinline__ unsigned pk4_fp8(float a, float b, float c, float d) { int r = __builtin_amdgcn_cvt_pk_fp8_f32(a, b, 0, false); r = __builtin_amdgcn_cvt_pk_fp8_f32(c, d, r, true); return (unsigned)r; }
constexpr float W8S = 128.f;
__device__ __forceinline__ void cvt8_pack(const f32x4 (&v)[16], LAS unsigned char* scr, int half, int lane) {
    const int c = lane & 15, g = lane >> 4;
#pragma unroll
    for (int j = 0; j < 4; ++j) { v4u a;
        a.x = pk4_fp8(v[0][j] * W8S, v[1][j] * W8S, v[2][j] * W8S, v[3][j] * W8S); a.y = pk4_fp8(v[4][j] * W8S, v[5][j] * W8S, v[6][j] * W8S, v[7][j] * W8S);
        a.z = pk4_fp8(v[8][j] * W8S, v[9][j] * W8S, v[10][j] * W8S, v[11][j] * W8S); a.w = pk4_fp8(v[12][j] * W8S, v[13][j] * W8S, v[14][j] * W8S, v[15][j] * W8S);
        *(LAS v4u*)(scr + (4 * c + j) * 144 + half * 64 + 16 * g) = a; }
}
__device__ __forceinline__ void cvt8_flush(unsigned char* dst, int kbytes, LAS unsigned char* scr, int lane) {
    LDS_WAIT(); asm volatile("" ::: "memory");
#pragma unroll
    for (int i = 0; i < 8; ++i) { const int row = (lane >> 3) + 8 * i; const v4u o = *(const LAS v4u*)(scr + row * 144 + (lane & 7) * 16);
        *(GAS v4u*)(dst + (size_t)row * kbytes + (lane & 7) * 16) = o; }
    LDS_WAIT(); asm volatile("" ::: "memory");
}
constexpr int CV8_UG = NE * 16 * 64, CV8_D = NE * 16 * 32, CV8_TOTAL = CV8_UG + CV8_D;
struct Cvt8Item { const float* src; unsigned char* dst; int ldw; };
__device__ __forceinline__ Cvt8Item cvt8_item(const Frame& F, int it, int half) {
    Cvt8Item r;
    if (it < CV8_UG) { const int e = it >> 10, q = it & 1023, kb = q >> 6, nb = q & 63, d0 = nb * 64, j = d0 >> 8, wv = d0 & 255, sc = wv < 128 ? 128 * j + wv : 2048 + 128 * j + (wv - 128);
        r.ldw = 4096; r.src = F.in[IN_WUG] + (size_t)e * D * 4096 + (size_t)(kb * 128 + half * 64) * 4096 + sc; r.dst = wsp<unsigned char>(F, WS_WUG) + (size_t)e * 4096 * D + (size_t)d0 * D + kb * 128; return r; }
    it -= CV8_UG;
    { const int e = it >> 9, q = it & 511, kb = q >> 5, nb = q & 31;
        r.ldw = D; r.src = F.in[IN_WD] + (size_t)e * FF * D + (size_t)(kb * 128 + half * 64) * D + nb * 64; r.dst = wsp<unsigned char>(F, WS_WD) + (size_t)e * D * FF + (size_t)(nb * 64) * FF + kb * 128; return r; }
}
__device__ __forceinline__ void cvt8_load(const Cvt8Item& it, f32x4 (&v)[16], int lane) {
    const float* p = it.src + (size_t)((lane >> 4) * 16) * it.ldw + (lane & 15) * 4;
#pragma unroll
    for (int i = 0; i < 16; ++i) v[i] = *(const GAS f32x4*)(p + (size_t)i * it.ldw);
}
constexpr int CV_IN = 32 * 96, CV_OUT = 32 * 32, CV_TOTAL = CV_IN + CV_OUT;
__device__ __forceinline__ CvtItem cvt_item(const Frame& F, int it, int& ldw, int& K) {
    CvtItem r;
    if (it < CV_IN) { const int kb = it / 96, nb = it % 96, d0 = nb * 64, sc = d0 < 3072 ? d0 : d0 + 8;
        ldw = NPROJ; K = D; r.src = F.in[IN_WIN] + (size_t)(kb * 64) * NPROJ + sc; r.dst = wsp<bf16>(F, WS_WIN) + (size_t)d0 * D + kb * 64; return r; }
    it -= CV_IN;
    { const int kb = it >> 5, nb = it & 31; ldw = D; K = D; r.src = F.in[IN_WOUT] + (size_t)(kb * 64) * D + nb * 64; r.dst = wsp<bf16>(F, WS_WOUT) + (size_t)(nb * 64) * D + kb * 64; return r; }
}
__device__ __forceinline__ void p0_prologue(Frame& F) {
    const int gw = F.vcu * NWAVES + F.wave, NGW = F.G * NWAVES, lane = F.lane;
    {
        const float* c = F.in[IN_C]; float* modp = wsp<float>(F, WS_MODP);
        for (int task = gw; task < 4096; task += NGW) {
            const int cg = task & 255, ks = task >> 8, j = cg * 64 + lane;
            const float* w; int ld, col;
            if (j < 6 * D) { w = F.in[IN_WADA]; ld = 6 * D; col = j; } else { w = F.in[IN_WAF]; ld = 2 * D; col = j - 6 * D; }
            const float c0 = c[ks * 128 + lane], c1 = c[ks * 128 + 64 + lane];
            const float s0 = c0 * sigmoid_f(c0), s1 = c1 * sigmoid_f(c1);
            const float* wp = w + (size_t)(ks * 128) * ld + col; float acc = 0.f;
#pragma unroll 16
            for (int i = 0; i < 64; ++i) acc += __builtin_bit_cast(float, __builtin_amdgcn_readlane(__builtin_bit_cast(int, s0), i)) * wp[(size_t)i * ld];
#pragma unroll 16
            for (int i = 0; i < 64; ++i) acc += __builtin_bit_cast(float, __builtin_amdgcn_readlane(__builtin_bit_cast(int, s1), i)) * wp[(size_t)(64 + i) * ld];
            modp[ks * 16384 + j] = acc;
        }
    }
    {
        LAS unsigned char* scr = F.lds + RING_OFF + F.wave * 9216;
        const int nmine = gw < CV8_TOTAL ? (CV8_TOTAL - gw + NGW - 1) / NGW : 0, nsteps = 2 * nmine;
        if (nsteps > 0) {
            f32x4 va[16], vb[16];
            Cvt8Item cur = cvt8_item(F, gw, 0); cvt8_load(cur, va, lane);
            for (int s = 0; s < nsteps; s += 2) {
                const int it = gw + (s >> 1) * NGW;
                const Cvt8Item c1 = cvt8_item(F, it, 1); cvt8_load(c1, vb, lane);
                cvt8_pack(va, scr, 0, lane);
                const bool more = s + 2 < nsteps; Cvt8Item nx = cur;
                if (more) { nx = cvt8_item(F, it + NGW, 0); cvt8_load(nx, va, lane); }
                cvt8_pack(vb, scr, 1, lane);
                cvt8_flush(cur.dst, D, scr, lane);
                cur = nx;
            }
        }
    }
    {
        LAS unsigned char* scr = F.lds + RING_OFF + F.wave * 9216;
        int it = gw;
        if (it < CV_TOTAL) {
            int ldw, K; CvtItem cur = cvt_item(F, it, ldw, K); f32x4 va[16], vb[16];
            cvt_load(cur, ldw, va, lane);
            for (;;) {
                int itn = it + NGW; int ldn = 0, Kn = 0; CvtItem nx = cur; const bool more = itn < CV_TOTAL;
                if (more) { nx = cvt_item(F, itn, ldn, Kn); cvt_load(nx, ldn, vb, lane); }
                cvt_store(cur, K, va, scr, lane);
                if (!more) break;
                it = itn + NGW; const bool more2 = it < CV_TOTAL; CvtItem n2 = nx; int ld2 = 0, K2 = 0;
                if (more2) { n2 = cvt_item(F, it, ld2, K2); cvt_load(n2, ld2, va, lane); }
                cvt_store(nx, Kn, vb, scr, lane);
                if (!more2) break;
                cur = n2; K = K2;
            }
        }
        bf16* win_t = wsp<bf16>(F, WS_WIN);
        for (int i2 = gw; i2 < D / 4; i2 += NGW) {
            const int col = lane & 15, k = 4 * i2 + (lane >> 4), sc = col < 8 ? 3072 + col : 6152 + (col - 8);
            win_t[(size_t)(NPP + col) * D + k] = (bf16)f2bf(F.in[IN_WIN][(size_t)k * NPROJ + sc]); }
        const v4u z = {0u, 0u, 0u, 0u};
        for (int i = gw * 64 + lane; i < (NPAD - NPROJ) * D / 8; i += NGW * 64) *(GAS v4u*)(win_t + (size_t)NPROJ * D + (size_t)i * 8) = z;
    }
}
__device__ __forceinline__ void mod_reduce_lds(Frame& F, int j0, int n, LAS float* dst) {
    const float* modp = wsp<float>(F, WS_MODP);
    for (int i = F.tid; i < n; i += NTHR) { const int j = j0 + i; float a = j < 6 * D ? F.in[IN_BADA][j] : F.in[IN_BAF][j - 6 * D];
#pragma unroll
        for (int ks = 0; ks < 16; ++ks) a += modp[ks * 16384 + j];
        dst[i] = a; }
}
__device__ __forceinline__ void modulate_row_bf16(const float* xrow, const float* g, const LAS float* sh, const LAS float* sc, bf16* orow, int lane) {
    const GAS f32x4* xr = (const GAS f32x4*)xrow + lane; f32x4 v[8]; float s2 = 0.f;
#pragma unroll
    for (int j = 0; j < 8; ++j) { v[j] = xr[64 * j]; s2 += (v[j].x * v[j].x + v[j].y * v[j].y) + (v[j].z * v[j].z + v[j].w * v[j].w); }
    const float r = rsqrtf(wave_sum(s2) * (1.f / D) + 1e-6f);
    GAS u32x2* o8 = (GAS u32x2*)orow + lane;
#pragma unroll
    for (int j = 0; j < 8; ++j) { const int c0 = 4 * lane + 256 * j; const f32x4 gg = *(const GAS f32x4*)(g + c0); const f32x4 a = *(const LAS f32x4*)(sc + c0), b = *(const LAS f32x4*)(sh + c0);
        const f32x4 y = v[j] * r * gg * (a + 1.f) + b; u32x2 w; w.x = pk2(y.x, y.y); w.y = pk2(y.z, y.w); o8[64 * j] = w; }
}
__device__ __forceinline__ void p1_modulate(Frame& F) {
    LAS float* shs = (LAS float*)(F.lds + RING_OFF);
    mod_reduce_lds(F, 0, 2 * D, shs);
    if (F.tid < 64) {
        const float* modp = wsp<float>(F, WS_MODP); float* mod = wsp<float>(F, WS_MOD);
        for (int j = blockIdx.x * 64 + F.tid; j < 16384; j += F.G * 64) { float a = j < 6 * D ? F.in[IN_BADA][j] : F.in[IN_BAF][j - 6 * D];
#pragma unroll
            for (int ks = 0; ks < 16; ++ks) a += modp[ks * 16384 + j];
            mod[j] = a; }
    }
    __syncthreads();
    const int gw = F.vcu * NWAVES + F.wave, NGW = F.G * NWAVES; bf16* hn = wsp<bf16>(F, WS_HN);
    for (int m = gw; m < S; m += NGW) modulate_row_bf16(F.in[IN_X] + (size_t)m * D, F.in[IN_NMIX], shs, shs + D, hn + (size_t)m * D, F.lane);
    __syncthreads();
}
using pg8::Unit; using pg8::cvt_pk_bf16;
struct EpiProj {
    static constexpr bool PERM = true, AFTER_DRAIN = false;
    bf16* O; float* gates;
    __device__ __forceinline__ void operator()(const pg8::f32x4 (&acc)[2][2][4][2], const Unit& u, int wr, int wc, int fr, int fq) const {
        const int row0 = u.pm * 256 + wr * 64 + fr;
        if (u.pn < 24) {
            const int col0 = u.pn * 256 + wc * 32 + 8 * fq;
#pragma unroll
            for (int ai = 0; ai < 2; ++ai)
#pragma unroll
                for (int m = 0; m < 4; ++m) { bf16* rowp = O + (size_t)(row0 + ai * 128 + m * 16) * NPP + col0;
#pragma unroll
                    for (int bj = 0; bj < 2; ++bj) { const pg8::f32x4 v0 = acc[ai][bj][m][0], v1 = acc[ai][bj][m][1];
                        pg8::u32x4 w; w.x = cvt_pk_bf16(v0[0], v0[1]); w.y = cvt_pk_bf16(v0[2], v0[3]); w.z = cvt_pk_bf16(v1[0], v1[1]); w.w = cvt_pk_bf16(v1[2], v1[3]);
                        *(pg8::u32x4*)(rowp + bj * 128) = w; } }
        } else if (wc == 0 && fq < 2) {
#pragma unroll
            for (int ai = 0; ai < 2; ++ai)
#pragma unroll
                for (int m = 0; m < 4; ++m) { float* gp = gates + (size_t)(row0 + ai * 128 + m * 16) * 16 + 8 * fq;
                    *(pg8::f32x4*)gp = acc[ai][0][m][0]; *(pg8::f32x4*)(gp + 4) = acc[ai][0][m][1]; }
        }
    }
};
struct EpiOut {
    static constexpr bool PERM = false, AFTER_DRAIN = false;
    const float* x; const float* g1; float* h1;
    __device__ __forceinline__ void operator()(const pg8::f32x4 (&acc)[2][2][4][2], const Unit& u, int wr, int wc, int fr, int fq) const {
        const int row0 = u.pm * 256 + wr * 64 + fr, col0 = u.pn * 256 + wc * 32 + 4 * fq;
        pg8::f32x4 gv[2][2];
#pragma unroll
        for (int bj = 0; bj < 2; ++bj)
#pragma unroll
            for (int n = 0; n < 2; ++n) gv[bj][n] = *(const pg8::f32x4*)(g1 + col0 + bj * 128 + n * 16);
#pragma unroll
        for (int ai = 0; ai < 2; ++ai)
#pragma unroll
            for (int m = 0; m < 4; ++m) { const size_t off = (size_t)(row0 + ai * 128 + m * 16) * D + col0;
#pragma unroll
                for (int bj = 0; bj < 2; ++bj)
#pragma unroll
                    for (int n = 0; n < 2; ++n) { const pg8::f32x4 xv = *(const pg8::f32x4*)(x + off + bj * 128 + n * 16);
                        *(pg8::f32x4*)(h1 + off + bj * 128 + n * 16) = xv + gv[bj][n] * acc[ai][bj][m][n]; } }
    }
};
}
namespace fox {
constexpr int D = 128, SQ = 8192, SKV = 8192; constexpr float THR = 8.f; constexpr bool WSKIP = false;
constexpr int PITCH = 6144;
constexpr int OPITCH = 2048;
constexpr float SCALE = 0.08838834764831845f;
constexpr int NW = 8, QBLK = 32, KVBLK = 64, QB = NW * QBLK;
constexpr int SHM_V = KVBLK * D * 2, SHM_K = KVBLK * D * 2;
constexpr int LDS_BIAS = 2 * SHM_V + 2 * SHM_K + NW * 64 * 4;
constexpr int LDS_BYTES = LDS_BIAS + 512;

using bf16 = __hip_bfloat16;
typedef short bf16x8 __attribute__((ext_vector_type(8)));
typedef short s16x4 __attribute__((ext_vector_type(4)));
typedef float f32x16 __attribute__((ext_vector_type(16)));
typedef float f32x4 __attribute__((ext_vector_type(4)));
typedef unsigned u32x4 __attribute__((ext_vector_type(4)));
template <class A, class Bt> struct same_t { static constexpr bool v = false; };
template <class A> struct same_t<A, A> { static constexpr bool v = true; };

#define KSWZ(row, colB) ((row) * 256 + ((colB) ^ (((row) & 7) << 4)))
#define SBAR() __builtin_amdgcn_sched_barrier(0)
__device__ __forceinline__ int v_st(int k, int c) { const int kk = (k & ~0xC) | ((k & 4) << 1) | ((k & 8) >> 1); return ((kk >> 3) * 4 + (c >> 5)) * 512 + ((kk & 7) * 32 + (c & 31)) * 2; }
__device__ __forceinline__ int v_rd_base(int lane) { return ((lane & 3) << 3) | (((lane >> 2) & 3) << 6) | (((lane >> 4) & 1) << 5) | (((lane >> 5) & 1) << 8); }
constexpr int v_rd_off(int d0, int ks, int half) { return d0 * 512 + ks * 4096 + half * 2048; }
__device__ __forceinline__ int crow(int r, int hi) { return (r & 3) + 8 * (r >> 2) + 4 * hi; }
__device__ __forceinline__ int bias_slot(int kk) { return ((kk >> 2) & 1) * 32 + (kk >> 5) * 16 + (kk & 3) + 4 * ((kk & 31) >> 3); }
__device__ __forceinline__ unsigned cvtpk(float lo, float hi) {
    unsigned r; asm volatile("v_cvt_pk_bf16_f32 %0, %1, %2" : "=v"(r) : "v"(lo), "v"(hi)); return r;
}
__device__ __forceinline__ bf16x8 pack8(f32x4 a, f32x4 b) {
    u32x4 w = {cvtpk(a[0], a[1]), cvtpk(a[2], a[3]), cvtpk(b[0], b[1]), cvtpk(b[2], b[3])};
    return *reinterpret_cast<bf16x8*>(&w);
}
template <class T> __device__ __forceinline__ bf16x8 load8(const T* p) {
    if constexpr (same_t<T, float>::v) { return pack8(*(const f32x4*)p, *(const f32x4*)(p + 4)); }
    else { return *reinterpret_cast<const bf16x8*>(p); }
}
__device__ __forceinline__ void mask_tile(f32x16& p0, f32x16& p1, int dq, unsigned W) {
    const float NEG = -__builtin_inff();
#pragma unroll
    for (int r = 0; r < 16; ++r) {
        const int c = (r & 3) + 8 * (r >> 2);
        if ((unsigned)(dq - c) >= W) p0[r] = NEG;
        if ((unsigned)(dq - c - 32) >= W) p1[r] = NEG;
    }
}
__device__ __forceinline__ void partialSM(f32x16& p0, f32x16& p1, float& m_reg, float& mn, float& alpha) {
    float pmax = p0[0]; for (int r = 1; r < 16; ++r) pmax = fmaxf(pmax, p0[r]); for (int r = 0; r < 16; ++r) pmax = fmaxf(pmax, p1[r]);
    { auto rr = __builtin_amdgcn_permlane32_swap(__float_as_uint(pmax), __float_as_uint(pmax), false, false);
      pmax = fmaxf(__uint_as_float(rr[0]), __uint_as_float(rr[1])); }
    constexpr float C2 = 1.4426950408889634f * SCALE;
    if (__builtin_expect(__all((pmax - m_reg) * SCALE <= THR), 1)) { mn = m_reg; alpha = 1.f; }
    else { mn = fmaxf(m_reg, pmax); alpha = __builtin_amdgcn_exp2f((m_reg - mn) * C2); m_reg = mn; }
    const float mnL = -mn * C2;
    for (int r = 0; r < 16; ++r) p0[r] = fmaf(p0[r], C2, mnL); for (int r = 0; r < 16; ++r) p1[r] = fmaf(p1[r], C2, mnL);
    for (int r = 0; r < 16; ++r) p0[r] = __builtin_amdgcn_exp2f(p0[r]);
}
__device__ __forceinline__ void finishSM(f32x16& p0, f32x16& p1, float alpha, float& l_reg, bf16x8& pa0, bf16x8& pa1, bf16x8& pa2, bf16x8& pa3) {
    for (int r = 0; r < 16; ++r) p1[r] = __builtin_amdgcn_exp2f(p1[r]);
    float ps = 0; for (int r = 0; r < 16; ++r) ps += p0[r]; for (int r = 0; r < 16; ++r) ps += p1[r];
    { auto rr = __builtin_amdgcn_permlane32_swap(__float_as_uint(ps), __float_as_uint(ps), false, false);
      ps = __uint_as_float(rr[0]) + __uint_as_float(rr[1]); }
    l_reg = l_reg * alpha + ps;
#define PK4(P, B_, OUT) do { unsigned a0 = cvtpk(P[B_+0], P[B_+1]), a1 = cvtpk(P[B_+2], P[B_+3]);                          \
        unsigned b0 = cvtpk(P[B_+4], P[B_+5]), b1 = cvtpk(P[B_+6], P[B_+7]);                                             \
        auto r0 = __builtin_amdgcn_permlane32_swap(a0, b0, false, false); auto r1 = __builtin_amdgcn_permlane32_swap(a1, b1, false, false); \
        u32x4 w = {r0[0], r1[0], r0[1], r1[1]}; OUT = *reinterpret_cast<bf16x8*>(&w); } while (0)
    PK4(p0, 0, pa0); PK4(p0, 8, pa1); PK4(p1, 0, pa2); PK4(p1, 8, pa3);
#undef PK4
}
template <int KB, bool SK>
__device__ __forceinline__ void qkt(f32x16& p0, f32x16& p1, const char* K_lds, int r32, int hi, const bf16x8* qr, bool act) {
    if (SK && !act) { const float NEG = -__builtin_inff();
#pragma unroll
        for (int r = 0; r < 16; ++r) { p0[r] = NEG; p1[r] = NEG; } return; }
    { const f32x16* bp = reinterpret_cast<const f32x16*>(K_lds - 2 * SHM_V + LDS_BIAS + KB * 256 + hi * 128); p0 = bp[0]; p1 = bp[1]; }
    const char* kb[4];
#pragma unroll
    for (int dd = 0; dd < 4; ++dd) kb[dd] = K_lds + KB * SHM_K + KSWZ(r32, (dd * 16 + hi * 8) * 2);
#pragma unroll
    for (int d0 = 0; d0 < 8; ++d0) { const char* a = kb[d0 & 3] + (d0 >> 2) * 128;
        bf16x8 b0 = *reinterpret_cast<const bf16x8*>(a);
        bf16x8 b1 = *reinterpret_cast<const bf16x8*>(a + 32 * 256);
        p0 = __builtin_amdgcn_mfma_f32_32x32x16_bf16(b0, qr[d0], p0, 0, 0, 0);
        p1 = __builtin_amdgcn_mfma_f32_32x32x16_bf16(b1, qr[d0], p1, 0, 0, 0); }
}
template <int VB, bool SK>
__device__ __forceinline__ void pv_tile(f32x16* o, int vb0, bf16x8 pa0, bf16x8 pa1, bf16x8 pa2, bf16x8 pa3, bool act) {
    if (SK && !act) return;
#define TRRD(dst, off) asm volatile("ds_read_b64_tr_b16 %0, %1 offset:%2" : "=&v"(dst) : "v"(vb0), "i"(off) : "memory")
#define PV_D0(d0) do { s16x4 l0, l1, l2, l3, h0, h1, h2, h3; constexpr int b_ = VB * SHM_V + v_rd_off(d0, 0, 0);     \
        TRRD(l0, b_); TRRD(h0, b_ + 2048); TRRD(l1, b_ + 4096); TRRD(h1, b_ + 6144); TRRD(l2, b_ + 8192); TRRD(h2, b_ + 10240); TRRD(l3, b_ + 12288); TRRD(h3, b_ + 14336); \
        asm volatile("s_waitcnt lgkmcnt(0)" ::: "memory"); SBAR();                 \
        o[d0] = __builtin_amdgcn_mfma_f32_32x32x16_bf16(pa0, (bf16x8){l0[0], l0[1], l0[2], l0[3], h0[0], h0[1], h0[2], h0[3]}, o[d0], 0, 0, 0);   \
        o[d0] = __builtin_amdgcn_mfma_f32_32x32x16_bf16(pa1, (bf16x8){l1[0], l1[1], l1[2], l1[3], h1[0], h1[1], h1[2], h1[3]}, o[d0], 0, 0, 0);   \
        o[d0] = __builtin_amdgcn_mfma_f32_32x32x16_bf16(pa2, (bf16x8){l2[0], l2[1], l2[2], l2[3], h2[0], h2[1], h2[2], h2[3]}, o[d0], 0, 0, 0);   \
        o[d0] = __builtin_amdgcn_mfma_f32_32x32x16_bf16(pa3, (bf16x8){l3[0], l3[1], l3[2], l3[3], h3[0], h3[1], h3[2], h3[3]}, o[d0], 0, 0, 0); } while (0)
    PV_D0(0); PV_D0(1); PV_D0(2); PV_D0(3);
#undef PV_D0
#undef TRRD
}

template <class TIn, class TOut> struct BlockRef { const TIn* Q; const TIn* K; const TIn* V; TOut* O; int P0; const float* Fb; const float* gain;
    int jlo, jhi;
    float* Op; float* ML; };
template <class TIn> struct Seam {
    bf16x8 qr[8];
    bf16x8 st_v0, st_v1, st_k0, st_k1; f32x4 sf0, sf1, sf2, sf3; float st_b;
    f32x4 tq[16];
};
__device__ __forceinline__ int swa_jlo(int P0, int W) { const int lowk = P0 - W + 1; return lowk > 0 ? lowk / KVBLK : 0; }
#define ROW(p, k0, rr) ((p) + (size_t)((k0) + (rr)) * PITCH + sc)
#define VMW() asm volatile("s_waitcnt vmcnt(0)" ::: "memory")
#define VMWN(n) asm volatile("s_waitcnt vmcnt(%0)" :: "i"(n) : "memory")
#define SLOAD_H(Kp, Vp, k0) SLOAD_HB(Kp, Vp, k0, cur)
#define SLOAD_HB(Kp, Vp, k0, blk) do { S.st_v0 = load8<TIn>(ROW(Vp, k0, sr)); S.st_v1 = load8<TIn>(ROW(Vp, k0, 32 + sr));              \
                         S.st_k0 = load8<TIn>(ROW(Kp, k0, sr)); S.st_k1 = load8<TIn>(ROW(Kp, k0, 32 + sr)); \
                         if (tid < 64) S.st_b = ((blk).Fb[(blk).P0] - (blk).Fb[(k0) + tid]) * (1.0f / SCALE); } while (0)
#define SWRITE_HK(bf) do { *(bf16x8*)(K_lds + (bf) * SHM_K + kws) = S.st_k0; *(bf16x8*)(K_lds + (bf) * SHM_K + kws + 32 * 256) = S.st_k1; \
                         if (tid < 64) *(float*)(K_lds - 2 * SHM_V + LDS_BIAS + (bf) * 256 + bws) = S.st_b; } while (0)
#define SWRITE_HV(bf) do { *(bf16x8*)(V_lds + (bf) * SHM_V + vst0) = S.st_v0; *(bf16x8*)(V_lds + (bf) * SHM_V + vst1) = S.st_v1; } while (0)
#define SWRITE_H(bf) do { SWRITE_HV(bf); SWRITE_HK(bf); } while (0)
#define SLOAD_F(p, k0) do { S.sf0 = *(const f32x4*)ROW(p, k0, sr); S.sf1 = *(const f32x4*)(ROW(p, k0, sr) + 4);                \
                            S.sf2 = *(const f32x4*)ROW(p, k0, 32 + sr); S.sf3 = *(const f32x4*)(ROW(p, k0, 32 + sr) + 4); } while (0)
#define SWRITE_KF(bf) do { *(bf16x8*)(K_lds + (bf) * SHM_K + kws) = pack8(S.sf0, S.sf1); *(bf16x8*)(K_lds + (bf) * SHM_K + kws + 32 * 256) = pack8(S.sf2, S.sf3); } while (0)
#define SWRITE_VF(bf) do { *(bf16x8*)(V_lds + (bf) * SHM_V + vst0) = pack8(S.sf0, S.sf1); *(bf16x8*)(V_lds + (bf) * SHM_V + vst1) = pack8(S.sf2, S.sf3); } while (0)
template <class TIn, class TOut>
__device__ __forceinline__ void causal_swa_prime(const BlockRef<TIn, TOut>& cur, int W, char* lds, Seam<TIn>& S) {
    constexpr bool F32 = same_t<TIn, float>::v;
    const int tid = threadIdx.x, wid = __builtin_amdgcn_readfirstlane(tid >> 6), lane = tid & 63, r32 = lane & 31, hi = lane >> 5;
    const int sr = tid >> 4, sc = (tid & 15) * 8, kws = KSWZ(sr, sc * 2); char* K_lds = lds + 2 * SHM_V;
    const int bws = bias_slot(tid & 63) * 4;
    const int kb0 = cur.jlo * KVBLK;
    for (int d0 = 0; d0 < 8; ++d0) S.qr[d0] = load8<TIn>(cur.Q + (size_t)(wid * QBLK + r32) * PITCH + d0 * 16 + hi * 8);
    if constexpr (F32) { SLOAD_F((const float*)cur.K, kb0); VMW(); SWRITE_KF(0); SBAR(); SLOAD_F((const float*)cur.V, kb0); }
    else { SLOAD_H(cur.K, cur.V, kb0); VMW(); SWRITE_HK(0); }
    __syncthreads();
}
template <class TIn, class TOut>
__device__ __forceinline__ void causal_swa_block(const BlockRef<TIn, TOut>& cur, const BlockRef<TIn, TOut>& nxt, int skv, int W, char* lds, Seam<TIn>& S) {
    constexpr bool F32 = same_t<TIn, float>::v;
    const int tid = threadIdx.x, wid = __builtin_amdgcn_readfirstlane(tid >> 6), lane = tid & 63, r32 = lane & 31, hi = lane >> 5;
    const int j_lo = cur.jlo; const int j_hi = cur.jhi;
    const int NT = j_hi - j_lo;
    const int kbn = nxt.jlo * KVBLK;
    const int qlo = cur.P0 + wid * QBLK, qm = qlo + r32 - 4 * hi;
    char* V_lds = lds; char* K_lds = lds + 2 * SHM_V;
    float* ws = (float*)(lds + 2 * SHM_V + 2 * SHM_K) + wid * 64; float* li_l = ws, * al_l = ws + 32;
    float m_reg = -1e30f, l_reg = 0; f32x16 o[4] = {};
    const int sr = tid >> 4, sc = (tid & 15) * 8, vst0 = v_st(sr, sc), vst1 = v_st(32 + sr, sc), kws = KSWZ(sr, sc * 2);
    const int bws = bias_slot(tid & 63) * 4;
    const int vb0 = (int)(uintptr_t)V_lds + v_rd_base(lane);
    const TIn* Kh = cur.K; const TIn* Vh = cur.V;
#define RESC(a) do { if (__any((a) < 1.f)) { if (hi == 0) al_l[r32] = (a); asm volatile("s_waitcnt lgkmcnt(0)" ::: "memory");              \
                     for (int d_ = 0; d_ < 4; ++d_) for (int r = 0; r < 16; ++r) o[d_][r] *= al_l[crow(r, hi)]; } } while (0)
#define KBASE(t) ((j_lo + (t)) * KVBLK)
#define ACT(t) (KBASE(t) <= qlo + QBLK - 1 && KBASE(t) + KVBLK - 1 >= qlo - W + 1)
#define MASKT(P0_, P1_, t) do { const int kb_ = KBASE(t); if ((!SK || ACT(t)) && (kb_ + KVBLK - 1 > qlo || kb_ <= qlo + QBLK - 1 - W)) mask_tile(P0_, P1_, qm - kb_, (unsigned)W); } while (0)
    constexpr int NQL = F32 ? 16 : 8;
    constexpr bool SK = WSKIP && !F32;
#define SEAM_K0() do { VMWN(NQL); if constexpr (F32) { SWRITE_KF(0); SBAR(); SLOAD_F((const float*)nxt.V, kbn); } else { SWRITE_HK(0); } SBAR(); } while (0)
    f32x16 pA0, pA1, pB0, pB1; float mnA, mnB, alA, alB; bf16x8 pa0, pa1, pa2, pa3;
    if constexpr (F32) { VMW(); SWRITE_VF(0); SBAR(); } else { SWRITE_HV(0); SBAR(); }
    if (NT > 1) { if constexpr (F32) SLOAD_F((const float*)Kh, KBASE(1)); else SLOAD_H(Kh, Vh, KBASE(1)); }
    SBAR(); qkt<0, SK>(pA0, pA1, K_lds, r32, hi, S.qr, ACT(0));
    if constexpr (F32) { if (NT > 1) { VMW(); SWRITE_KF(1); SBAR(); SLOAD_F((const float*)Vh, KBASE(1)); } }
    MASKT(pA0, pA1, 0); partialSM(pA0, pA1, m_reg, mnA, alA);
    if (NT > 1) { VMW(); if constexpr (F32) { SWRITE_VF(1); SBAR(); if (NT > 2) SLOAD_F((const float*)Kh, KBASE(2)); } else SWRITE_H(1); }
    __syncthreads();
#define HALF_STEP(PX0, PX1, mnX, alX, PY0, PY1, alY, t, KB, VB, SB) do {                                                      \
        SBAR(); qkt<KB, SK>(PX0, PX1, K_lds, r32, hi, S.qr, ACT(t));                                             \
        finishSM(PY0, PY1, alY, l_reg, pa0, pa1, pa2, pa3); SBAR();                                                           \
        if ((t) + 1 < NT) { if constexpr (F32) { VMW(); SWRITE_KF(SB); SBAR(); SLOAD_F((const float*)Vh, KBASE((t) + 1)); }  \
                            else { SLOAD_H(Kh, Vh, KBASE((t) + 1)); } SBAR(); }                                               \
        pv_tile<VB, SK>(o, vb0, pa0, pa1, pa2, pa3, ACT((t) - 1)); MASKT(PX0, PX1, (t)); partialSM(PX0, PX1, m_reg, mnX, alX);                                        \
        __syncthreads();                                                                                                      \
        if ((t) + 1 < NT) { VMW(); if constexpr (F32) { SWRITE_VF(SB); SBAR(); if ((t) + 2 < NT) SLOAD_F((const float*)Kh, KBASE((t) + 2)); } \
                            else { SWRITE_H(SB); } }                                                                          \
        RESC(alX); __syncthreads(); } while (0)
    for (int t = 1; t + 1 < NT; t += 2) {
        HALF_STEP(pB0, pB1, mnB, alB, pA0, pA1, alA, t, 1, 0, 0);
        HALF_STEP(pA0, pA1, mnA, alA, pB0, pB1, alB, t + 1, 0, 1, 1);
    }
    const bool even = (NT & 1) == 0;
    if (even) { SBAR(); qkt<1, SK>(pB0, pB1, K_lds, r32, hi, S.qr, ACT(NT - 1)); SBAR(); }
#define QROW(e) (nxt.Q + (size_t)(wid * QBLK + r32) * PITCH + ((e) >> 1) * 16 + hi * 8 + ((e) & 1) * 4)
    if constexpr (F32) { SLOAD_F((const float*)nxt.K, kbn); SBAR();
#pragma unroll
        for (int e = 0; e < 8; ++e) S.tq[e] = *(const f32x4*)QROW(e); }
    else { SLOAD_HB(nxt.K, nxt.V, kbn, nxt); SBAR();
#pragma unroll
        for (int d0 = 0; d0 < 8; ++d0) S.qr[d0] = load8<TIn>(nxt.Q + (size_t)(wid * QBLK + r32) * PITCH + d0 * 16 + hi * 8); }
    SBAR();
    finishSM(pA0, pA1, alA, l_reg, pa0, pa1, pa2, pa3); SBAR();
    if constexpr (F32) {
#pragma unroll
        for (int e = 8; e < 16; ++e) S.tq[e] = *(const f32x4*)QROW(e); SBAR(); }
#undef QROW
    pv_tile<0, SK>(o, vb0, pa0, pa1, pa2, pa3, ACT(even ? NT - 2 : NT - 1));
    if (even) { MASKT(pB0, pB1, NT - 1); partialSM(pB0, pB1, m_reg, mnB, alB); __syncthreads(); RESC(alB);
        finishSM(pB0, pB1, alB, l_reg, pa0, pa1, pa2, pa3); SBAR(); pv_tile<1, SK>(o, vb0, pa0, pa1, pa2, pa3, ACT(NT - 1)); }
    SBAR(); SEAM_K0();
    if (hi == 0) li_l[r32] = l_reg; asm volatile("s_waitcnt lgkmcnt(0)" ::: "memory");
    if (cur.Op != nullptr) {
        int rp = r32; asm volatile("" : "+v"(rp));
        if (hi == 0) { float2 mlv; mlv.x = m_reg; mlv.y = l_reg; *(float2*)(cur.ML + 2 * (wid * QBLK + rp)) = mlv; }
        float* Pr = cur.Op + (size_t)(wid * QBLK + 4 * hi) * D + rp;
#pragma unroll
        for (int r = 0; r < 16; ++r) {
#pragma unroll
            for (int d0 = 0; d0 < 4; ++d0) Pr[d0 * 32] = o[d0][r];
            Pr += ((r & 3) == 3 ? 5 : 1) * D; asm volatile("" : "+v"(Pr) :: "memory"); }
    } else {
    int ro = r32; asm volatile("" : "+v"(ro));
    TOut* Or = cur.O + (size_t)(wid * QBLK + 4 * hi) * OPITCH + ro;
    float gn[4];
#pragma unroll
    for (int d0 = 0; d0 < 4; ++d0) gn[d0] = cur.gain[d0 * 32 + ro];
#pragma unroll
    for (int r = 0; r < 16; ++r) { const int orow = crow(r, hi); const float rl = __builtin_amdgcn_rcpf(li_l[orow]);
        float v[4]; float ss = 0.f;
#pragma unroll
        for (int d0 = 0; d0 < 4; ++d0) { v[d0] = o[d0][r] * rl; ss += v[d0] * v[d0]; }
        ss += __shfl_xor(ss, 1); ss += __shfl_xor(ss, 2); ss += __shfl_xor(ss, 4); ss += __shfl_xor(ss, 8); ss += __shfl_xor(ss, 16);
        const float rn = __builtin_amdgcn_rsqf(ss * (1.0f / 128.0f) + 1e-6f);
#pragma unroll
        for (int d0 = 0; d0 < 4; ++d0) { const float vv = v[d0] * rn * gn[d0]; const float vn = __shfl_xor(vv, 1);
            if ((ro & 1) == 0) *(unsigned*)(Or + d0 * 32) = cvtpk(vv, vn); }
        Or += ((r & 3) == 3 ? 5 : 1) * OPITCH; asm volatile("" : "+v"(Or) :: "memory"); }
    }
    if constexpr (F32) {
#pragma unroll
        for (int d0 = 0; d0 < 8; ++d0) S.qr[d0] = pack8(S.tq[2 * d0], S.tq[2 * d0 + 1]); }
    __syncthreads();
#undef RESC
#undef KBASE
#undef ACT
#undef MASKT
#undef SEAM_K0
#undef HALF_STEP
}
#undef ROW
#undef VMW
#undef VMWN
#undef SLOAD_H
#undef SWRITE_HK
#undef SWRITE_HV
#undef SWRITE_H
#undef SLOAD_F
#undef SWRITE_KF
#undef SWRITE_VF

}
namespace mk {
typedef short s16x8 __attribute__((ext_vector_type(8)));
#define MFMA32(a, b, c) __builtin_amdgcn_mfma_f32_32x32x16_bf16((a), (b), (c), 0, 0, 0)
__device__ __forceinline__ int crow32(int r, int hi) { return (r & 3) + 8 * (r >> 2) + 4 * hi; }
constexpr float SCALEQ = 0.08838834764831845f;
__device__ __forceinline__ float wave_scan_add(float v, int lane) {
#pragma unroll
    for (int o = 1; o < 64; o <<= 1) { const float t = __shfl_up(v, o); if (lane >= o) v += t; }
    return v;
}
__device__ __forceinline__ float wave_scan_max(float v, int lane) {
#pragma unroll
    for (int o = 1; o < 64; o <<= 1) { const float t = __shfl_up(v, o); if (lane >= o) v = fmaxf(v, t); }
    return v;
}
__device__ __forceinline__ float wave_max(float v) {
#pragma unroll
    for (int o = 1; o < 64; o <<= 1) v = fmaxf(v, __shfl_xor(v, o));
    return v;
}
constexpr int TSTR = 72;
template <bool SCALED>
__device__ __forceinline__ void stage_transposed(const bf16* src, int ncols, LAS bf16* T, const LAS float* wl, int tid) {
    const int cpr = ncols / 8;
    for (int q = tid; q < 64 * cpr; q += NTHR) { const int s = q / cpr, c8 = (q % cpr) * 8;
        const v4u raw = *(const GAS v4u*)(src + (size_t)s * NPP + c8);
        const unsigned w4[4] = {raw.x, raw.y, raw.z, raw.w};
#pragma unroll
        for (int j = 0; j < 4; ++j) { unsigned lo = w4[j] & 0xffffu, hi = w4[j] >> 16;
            if (SCALED) { const float sc = wl[s]; lo = f2bf(bf2f((unsigned short)lo) * sc); hi = f2bf(bf2f((unsigned short)hi) * sc); }
            T[(c8 + 2 * j) * TSTR + s] = (bf16)lo; T[(c8 + 2 * j + 1) * TSTR + s] = (bf16)hi; } }
}
__device__ __forceinline__ void p3_prep(Frame& F) {
    const int gw = F.vcu * NWAVES + F.wave, NGW = F.G * NWAVES, lane = F.lane, tid = F.tid;
    bf16* proj = wsp<bf16>(F, WS_PROJ); const float* gates = wsp<float>(F, WS_GATES);
    {
        const int seg = lane >> 2, qd = (lane & 3) * 32; const float* gn = (seg < 8 ? F.in[IN_FOXQN] : F.in[IN_FOXKN]) + qd;
        for (int m = gw; m < S; m += NGW) {
            bf16* p = proj + (size_t)m * NPP + C_FQ + seg * 128 + qd; v4u raw[4]; float x[32]; float ss = 0.f;
#pragma unroll
            for (int j = 0; j < 4; ++j) raw[j] = *(const GAS v4u*)(p + 8 * j);
#pragma unroll
            for (int j = 0; j < 4; ++j) { const unsigned w4[4] = {raw[j].x, raw[j].y, raw[j].z, raw[j].w};
#pragma unroll
                for (int i = 0; i < 4; ++i) { x[8 * j + 2 * i] = bf2f((unsigned short)(w4[i] & 0xffffu)); x[8 * j + 2 * i + 1] = bf2f((unsigned short)(w4[i] >> 16)); } }
#pragma unroll
            for (int i = 0; i < 32; ++i) ss += x[i] * x[i];
            ss += __shfl_xor(ss, 1); ss += __shfl_xor(ss, 2);
            const float r = rsqrtf(ss * (1.f / 128.f) + 1e-6f);
#pragma unroll
            for (int j = 0; j < 4; ++j) { v4u o; const f32x4 g0 = *(const GAS f32x4*)(gn + 8 * j), g1 = *(const GAS f32x4*)(gn + 8 * j + 4);
                o.x = pk2(x[8 * j] * r * g0.x, x[8 * j + 1] * r * g0.y); o.y = pk2(x[8 * j + 2] * r * g0.z, x[8 * j + 3] * r * g0.w);
                o.z = pk2(x[8 * j + 4] * r * g1.x, x[8 * j + 5] * r * g1.y); o.w = pk2(x[8 * j + 6] * r * g1.z, x[8 * j + 7] * r * g1.w);
                *(GAS v4u*)(p + 8 * j) = o; }
        }
    }
    if (blockIdx.x < 8) {
        const int h = blockIdx.x; const float b = F.in[IN_FOXBF][h]; float* Fo = wsp<float>(F, WS_F) + h * S;
        LAS double* tot = (LAS double*)(F.lds + RING_OFF);
        double loc[16]; double acc = 0.0;
#pragma unroll
        for (int i = 0; i < 16; ++i) { acc += (double)log_sigmoid_f(gates[(size_t)(tid * 16 + i) * 16 + 8 + h] + b); loc[i] = acc; }
        tot[tid] = acc;
        __syncthreads();
        if (F.wave == 0) { double v[8]; double s = 0.0;
#pragma unroll
            for (int i = 0; i < 8; ++i) { v[i] = tot[lane * 8 + i]; s += v[i]; }
            double inc = s;
#pragma unroll
            for (int o = 1; o < 64; o <<= 1) { const double t = __shfl_up(inc, o); if (lane >= o) inc += t; }
            double ex = inc - s;
#pragma unroll
            for (int i = 0; i < 8; ++i) { tot[lane * 8 + i] = ex; ex += v[i]; } }
        __syncthreads();
        const double off = tot[tid];
        LAS float* Fl = (LAS float*)(F.lds + RING_OFF + 8192);
#pragma unroll
        for (int i = 0; i < 16; ++i) { const float fv = (float)(off + loc[i]); Fo[tid * 16 + i] = fv; Fl[tid * 16 + i] = fv; }
        __syncthreads();
        if (tid < 32) {
            float gq = 0.f, gk = 0.f;
            for (int d = 0; d < 128; ++d) { gq = fmaxf(gq, fabsf(F.in[IN_FOXQN][d])); gk = fmaxf(gk, fabsf(F.in[IN_FOXKN][d])); }
            const float thr = 2.f * 11.3137085f * gq * gk + 26.f;
            const int qb = tid, P0 = qb * 256; const float f0 = Fl[P0];
            int lo = 0, hi2 = 4 * qb;
            while (lo < hi2) { const int mid = (lo + hi2) >> 1; if (Fl[64 * mid + 63] - f0 <= thr) hi2 = mid; else lo = mid + 1; }
            wsp<int>(F, WS_JLO)[h * 32 + qb] = lo;
        }
        __syncthreads();
    }
    {
        LAS bf16* KT = (LAS bf16*)(F.lds + RING_OFF);
        LAS bf16* VT = KT + 128 * TSTR;
        LAS float* wl = (LAS float*)(VT + 256 * TSTR);
        float* UL = wsp<float>(F, WS_UL); float* NL = wsp<float>(F, WS_NL); float* GLAL = wsp<float>(F, WS_GLAL);
        const int hi = lane >> 5, l31 = lane & 31, w = F.wave;
        for (int u = F.vcu; u < 4 * NCH; u += F.G) {
            const int h = u >> 7, ch = u & 127, t0 = ch * LCH;
            if (w == 0) {
                const float ip = softcap_f(gates[(size_t)(t0 + lane) * 16 + h] + F.in[IN_BI][h]);
                const float fp = softcap_f(gates[(size_t)(t0 + lane) * 16 + 4 + h] + F.in[IN_BF][h]);
                const float g = wave_scan_add(log_sigmoid_f(fp), lane), a = ip - g, amax = wave_max(a);
                wl[lane] = __expf(a - amax);
                if (lane == 63) { GLAL[u * 2] = g; GLAL[u * 2 + 1] = amax; }
            }
            __syncthreads();
            stage_transposed<true>(proj + (size_t)t0 * NPP + C_MK + h * 128, 128, KT, wl, tid);
            stage_transposed<false>(proj + (size_t)t0 * NPP + C_MV + h * 256, 256, VT, wl, tid);
            __syncthreads();
            f32x16 acc[4];
#pragma unroll
            for (int dt = 0; dt < 4; ++dt)
#pragma unroll
                for (int r = 0; r < 16; ++r) acc[dt][r] = 0.f;
#pragma unroll
            for (int ks = 0; ks < 4; ++ks) { const s16x8 a = *(const LAS s16x8*)(VT + (32 * w + l31) * TSTR + 16 * ks + 8 * hi);
#pragma unroll
                for (int dt = 0; dt < 4; ++dt) { const s16x8 b = *(const LAS s16x8*)(KT + (32 * dt + l31) * TSTR + 16 * ks + 8 * hi); acc[dt] = MFMA32(a, b, acc[dt]); } }
            float* ut = UL + (size_t)u * 256 * 128;
#pragma unroll
            for (int dt = 0; dt < 4; ++dt)
#pragma unroll
                for (int r = 0; r < 16; ++r) ut[(size_t)(32 * w + crow32(r, hi)) * 128 + 32 * dt + l31] = acc[dt][r];
            if (tid < 128) { float s = 0.f;
#pragma unroll
                for (int j = 0; j < 8; ++j) { const s16x8 kv = *(const LAS s16x8*)(KT + tid * TSTR + 8 * j);
#pragma unroll
                    for (int i = 0; i < 8; ++i) s += bf2f((unsigned short)kv[i]); }
                NL[u * 128 + tid] = s; }
            __syncthreads();
        }
    }
}
__device__ __forceinline__ void p4_scan(Frame& F) {
    LAS float* gl = (LAS float*)(F.lds + RING_OFF);
    LAS float* dec = gl + 256; LAS float* scl = dec + 128; LAS float* mv = scl + 128;
    const float* UL = wsp<float>(F, WS_UL); const float* NL = wsp<float>(F, WS_NL); const float* GLAL = wsp<float>(F, WS_GLAL);
    bf16* CS = wsp<bf16>(F, WS_CS); float* NS = wsp<float>(F, WS_NS); float* MS = wsp<float>(F, WS_MS);
    const int tid = F.tid;
    for (int blk = F.vcu; blk < 4 * 64; blk += F.G) {
        const int h = blk >> 6, rem0 = (blk & 63) * 512;
        if (tid < 256) gl[tid] = GLAL[h * 256 + tid];
        __syncthreads();
        if (tid == 0) { float m = 0.f;
            for (int c = 0; c < NCH; ++c) { const float g = gl[2 * c], al = gl[2 * c + 1], mn = g + fmaxf(m, al);
                mv[c] = m; dec[c] = __expf(g + m - mn); scl[c] = __expf(g + al - mn); m = mn; } }
        __syncthreads();
        if (rem0 == 0 && tid < 128) MS[h * 128 + tid] = mv[tid];
        const int rem = rem0 + tid;
        const float* ul = UL + (size_t)h * NCH * 32768 + rem; bf16* cs = CS + (size_t)h * NCH * 32768 + rem;
        float C = 0.f;
#pragma unroll 8
        for (int c = 0; c < NCH; ++c) { cs[(size_t)c * 32768] = (bf16)f2bf(C); C = dec[c] * C + scl[c] * ul[(size_t)c * 32768]; }
        if (rem0 == 0 && tid < 128) { float n = 0.f; const float* nl = NL + (size_t)h * NCH * 128 + tid; float* ns = NS + (size_t)h * NCH * 128 + tid;
#pragma unroll 8
            for (int c = 0; c < NCH; ++c) { ns[c * 128] = n; n = dec[c] * n + scl[c] * nl[c * 128]; } }
        __syncthreads();
    }
}
constexpr int NUMSTR = 260;
__device__ __forceinline__ void p5_mlstm_out(Frame& F) {
    LAS bf16* VT = (LAS bf16*)(F.lds + RING_OFF);
    LAS bf16* Pm = VT + 256 * TSTR;
    LAS float* NUM = (LAS float*)(Pm + 64 * TSTR);
    LAS float* a_s = NUM + 64 * NUMSTR; LAS float* Mt = a_s + 64; LAS float* inter = Mt + 64; LAS float* emt = inter + 64; LAS float* qn = emt + 64; LAS float* dinv = qn + 64;
    const bf16* proj = wsp<bf16>(F, WS_PROJ); const float* gates = wsp<float>(F, WS_GATES); const bf16* CS = wsp<bf16>(F, WS_CS);
    const float* NS = wsp<float>(F, WS_NS); const float* MS = wsp<float>(F, WS_MS); bf16* concat = wsp<bf16>(F, WS_CONCAT);
    const int tid = F.tid, lane = F.lane, w = F.wave, hi = lane >> 5, l31 = lane & 31;
    for (int u = F.vcu; u < 4 * NCH; u += F.G) {
        const int h = u >> 7, ch = u & 127, t0 = ch * LCH;
        const bf16* qbase = proj + (size_t)t0 * NPP + C_MQ + h * 128; const bf16* kbase = proj + (size_t)t0 * NPP + C_MK + h * 128;
        if (w == 0) {
            const float ip = softcap_f(gates[(size_t)(t0 + lane) * 16 + h] + F.in[IN_BI][h]);
            const float fp = softcap_f(gates[(size_t)(t0 + lane) * 16 + 4 + h] + F.in[IN_BF][h]);
            const float g = wave_scan_add(log_sigmoid_f(fp), lane), a = ip - g, cm = wave_scan_max(a, lane);
            const float mp = MS[u], M = fmaxf(mp, cm);
            a_s[lane] = a; Mt[lane] = M; inter[lane] = __expf(mp - M); emt[lane] = __expf(-(g + M));
        }
        stage_transposed<false>(proj + (size_t)t0 * NPP + C_MV + h * 256, 256, VT, a_s, tid);
        __syncthreads();
        if (w < 4) {
            const int ti = w >> 1, si = w & 1;
            if (si <= ti) {
                s16x8 qa[8], kb[8];
#pragma unroll
                for (int ks = 0; ks < 8; ++ks) { qa[ks] = *(const GAS s16x8*)(qbase + (size_t)(32 * ti + l31) * NPP + 16 * ks + 8 * hi); kb[ks] = *(const GAS s16x8*)(kbase + (size_t)(32 * si + l31) * NPP + 16 * ks + 8 * hi); }
                f32x16 acc;
#pragma unroll
                for (int r = 0; r < 16; ++r) acc[r] = 0.f;
#pragma unroll
                for (int ks = 0; ks < 8; ++ks) acc = MFMA32(qa[ks], kb[ks], acc);
                const int s = 32 * si + l31; const float as = a_s[s];
#pragma unroll
                for (int r = 0; r < 16; ++r) { const int t = 32 * ti + crow32(r, hi); const float p = (s <= t) ? acc[r] * SCALEQ * __expf(as - Mt[t]) : 0.f; Pm[t * TSTR + s] = (bf16)f2bf(p); }
            } else {
#pragma unroll
                for (int r = 0; r < 16; ++r) Pm[(32 * ti + crow32(r, hi)) * TSTR + 32 * si + l31] = (bf16)0;
            }
        } else {
            const int t = (tid - 256) >> 2, d0 = ((tid - 256) & 3) * 32; float s = 0.f; const float* np = NS + (size_t)u * 128 + d0;
#pragma unroll
            for (int j = 0; j < 4; ++j) { const s16x8 qv = *(const GAS s16x8*)(qbase + (size_t)t * NPP + d0 + 8 * j);
#pragma unroll
                for (int i = 0; i < 8; ++i) s += bf2f((unsigned short)qv[i]) * np[8 * j + i]; }
            s += __shfl_xor(s, 1); s += __shfl_xor(s, 2);
            if ((tid & 3) == 0) qn[t] = s * SCALEQ;
        }
        __syncthreads();
        f32x16 accP[2], accC[2];
#pragma unroll
        for (int ti = 0; ti < 2; ++ti)
#pragma unroll
            for (int r = 0; r < 16; ++r) { accP[ti][r] = 0.f; accC[ti][r] = 0.f; }
        {
            const bf16* cs = CS + (size_t)u * 32768 + (size_t)(32 * w + l31) * 128 + 8 * hi;
            s16x8 cb[8];
#pragma unroll
            for (int ks = 0; ks < 8; ++ks) cb[ks] = *(const GAS s16x8*)(cs + 16 * ks);
#pragma unroll
            for (int ti = 0; ti < 2; ++ti) {
                s16x8 qa[8];
#pragma unroll
                for (int ks = 0; ks < 8; ++ks) qa[ks] = *(const GAS s16x8*)(qbase + (size_t)(32 * ti + l31) * NPP + 16 * ks + 8 * hi);
#pragma unroll
                for (int ks = 0; ks < 8; ++ks) accC[ti] = MFMA32(qa[ks], cb[ks], accC[ti]);
            }
#pragma unroll
            for (int ks = 0; ks < 4; ++ks) { const s16x8 vb = *(const LAS s16x8*)(VT + (32 * w + l31) * TSTR + 16 * ks + 8 * hi);
#pragma unroll
                for (int ti = 0; ti < 2; ++ti) { const s16x8 pa = *(const LAS s16x8*)(Pm + (32 * ti + l31) * TSTR + 16 * ks + 8 * hi); accP[ti] = MFMA32(pa, vb, accP[ti]); } }
        }
        if (w == 0) {
            float rs = 0.f;
#pragma unroll
            for (int j = 0; j < 8; ++j) { const s16x8 pv = *(const LAS s16x8*)(Pm + lane * TSTR + 8 * j);
#pragma unroll
                for (int i = 0; i < 8; ++i) rs += bf2f((unsigned short)pv[i]); }
            const float dn = rs + inter[lane] * qn[lane];
            dinv[lane] = 1.f / fmaxf(fabsf(dn), emt[lane]);
        }
        __syncthreads();
#pragma unroll
        for (int ti = 0; ti < 2; ++ti)
#pragma unroll
            for (int r = 0; r < 16; ++r) { const int t = 32 * ti + crow32(r, hi); NUM[t * NUMSTR + 32 * w + l31] = (accP[ti][r] + inter[t] * SCALEQ * accC[ti][r]) * dinv[t]; }
        __syncthreads();
        {
            const f32x4 gn = *(const GAS f32x4*)(F.in[IN_MOUTN] + h * 256 + 4 * lane);
#pragma unroll
            for (int i = 0; i < 8; ++i) { const int t = 8 * w + i; const f32x4 x = *(const LAS f32x4*)(NUM + t * NUMSTR + 4 * lane);
                const float ss = wave_sum((x.x * x.x + x.y * x.y) + (x.z * x.z + x.w * x.w)); const float r = rsqrtf(ss * (1.f / 256.f) + 1e-6f);
                const u32x2 mo = *(const GAS u32x2*)(proj + (size_t)(t0 + t) * NPP + C_MO + h * 256 + 4 * lane);
                const float o0 = x.x * r * gn.x * sigmoid_f(bf2f((unsigned short)(mo.x & 0xffffu))), o1 = x.y * r * gn.y * sigmoid_f(bf2f((unsigned short)(mo.x >> 16)));
                const float o2 = x.z * r * gn.z * sigmoid_f(bf2f((unsigned short)(mo.y & 0xffffu))), o3 = x.w * r * gn.w * sigmoid_f(bf2f((unsigned short)(mo.y >> 16)));
                u32x2 ov; ov.x = pk2(o0, o1); ov.y = pk2(o2, o3);
                *(GAS u32x2*)(concat + (size_t)(t0 + t) * D + h * 256 + 4 * lane) = ov; }
        }
        __syncthreads();
    }
}
}
namespace mk {
__device__ __forceinline__ void attn_build_schedule(Frame& F) {
    LAS int* jl = (LAS int*)(F.lds + TAB_OFF); LAS int* pre = jl + 256; LAS int* wtot = pre + 260;
    const int tid = F.tid, lane = F.lane;
    if (tid < 256) { const int j = wsp<int>(F, WS_JLO)[tid]; jl[tid] = j; const int n = 4 * (tid & 31) + 4 - j; int v = (n + ATT_CH - 1) / ATT_CH;
        int inc = v;
#pragma unroll
        for (int o = 1; o < 64; o <<= 1) { const int t = __shfl_up(inc, o); if (lane >= o) inc += t; }
        pre[tid + 1] = inc; if (lane == 63) wtot[tid >> 6] = inc; }
    __syncthreads();
    if (tid < 256) { int add = 0; for (int w2 = 0; w2 < (tid >> 6); ++w2) add += wtot[w2]; pre[tid + 1] += add; if (tid == 0) pre[0] = 0; }
    __syncthreads();
}
__device__ __forceinline__ fox::BlockRef<fox::bf16, fox::bf16> fox_ref(const Frame& F, int I) {
    const LAS int* jl = (const LAS int*)(F.lds + TAB_OFF); const LAS int* pre = jl + 256;
    int b = 0;
#pragma unroll
    for (int st = 128; st >= 1; st >>= 1) if (pre[b + st] <= I) b += st;
    b = __builtin_amdgcn_readfirstlane(b);
    const int pb0 = __builtin_amdgcn_readfirstlane(pre[b]), pb1 = __builtin_amdgcn_readfirstlane(pre[b + 1]), j0 = __builtin_amdgcn_readfirstlane(jl[b]);
    const int h = b >> 5, qb = b & 31, part = I - pb0, P = pb1 - pb0, n = 4 * qb + 4 - j0;
    fox::BlockRef<fox::bf16, fox::bf16> r;
    const fox::bf16* proj = (const fox::bf16*)(F.ws + WS_PROJ);
    r.Q = proj + (size_t)(qb * 256) * fox::PITCH + C_FQ + h * 128; r.K = proj + C_FK + h * 128; r.V = proj + C_FV + h * 128;
    r.O = (fox::bf16*)(F.ws + WS_CONCAT) + (size_t)(qb * 256) * D + 1024 + h * 128; r.P0 = qb * 256;
    r.Fb = (const float*)(F.ws + WS_F) + h * S; r.gain = F.in[IN_FOUTN] + h * 128;
    r.jlo = j0 + (part * n) / P; r.jhi = j0 + ((part + 1) * n) / P;
    r.Op = P > 1 ? (float*)(F.ws + WS_OPART) + (size_t)I * 256 * 128 : nullptr; r.ML = (float*)(F.ws + WS_MLP) + (size_t)I * 512;
    return r;
}
__device__ __forceinline__ void p5_attention(Frame& F, char* ldsg) {
    typedef fox::BlockRef<fox::bf16, fox::bf16> BR;
    attn_build_schedule(F);
    const int total = __builtin_amdgcn_readfirstlane(((const LAS int*)(F.lds + TAB_OFF))[256 + 256]);
    int L = F.vcu; if (L >= total) return;
    BR cur = fox_ref(F, L);
    fox::Seam<fox::bf16> Sm;
    fox::causal_swa_prime<fox::bf16, fox::bf16>(cur, S, ldsg, Sm);
    for (;;) {
        const bool more = L + F.G < total;
        const BR nxt = more ? fox_ref(F, L + F.G) : cur;
        fox::causal_swa_block<fox::bf16, fox::bf16>(cur, nxt, S, S, ldsg, Sm);
        if (!more) break;
        cur = nxt; L += F.G;
    }
}
__device__ __forceinline__ void p6_combine(Frame& F) {
    attn_build_schedule(F);
    const LAS int* pre = (const LAS int*)(F.lds + TAB_OFF) + 256;
    const float* OP = wsp<float>(F, WS_OPART); const float* MLP = wsp<float>(F, WS_MLP); bf16* concat = wsp<bf16>(F, WS_CONCAT);
    const int gw = F.vcu * NWAVES + F.wave, NGW = F.G * NWAVES, lane = F.lane;
    constexpr float C2 = 1.4426950408889634f * SCALEQ;
    for (int idx = gw; idx < 256 * 256; idx += NGW) {
        const int b = idx >> 8, r = idx & 255, i0 = pre[b], P = pre[b + 1] - i0; if (P <= 1) continue;
        const int h = b >> 5, qb = b & 31;
        float ms = -3.0e38f;
        for (int p2 = 0; p2 < P; ++p2) ms = fmaxf(ms, MLP[(size_t)(i0 + p2) * 512 + 2 * r]);
        float n0 = 0.f, n1 = 0.f, den = 0.f;
        for (int p2 = 0; p2 < P; ++p2) { const f32x2 ml = *(const GAS f32x2*)(MLP + (size_t)(i0 + p2) * 512 + 2 * r); const float wgt = __builtin_amdgcn_exp2f((ml.x - ms) * C2);
            const f32x2 ov = *(const GAS f32x2*)(OP + ((size_t)(i0 + p2) * 256 + r) * 128 + 2 * lane); n0 += wgt * ov.x; n1 += wgt * ov.y; den += wgt * ml.y; }
        const float inv = 1.f / den, v0 = n0 * inv, v1 = n1 * inv;
        const float ss = wave_sum(v0 * v0 + v1 * v1), rn = rsqrtf(ss * (1.f / 128.f) + 1e-6f);
        const f32x2 gn = *(const GAS f32x2*)(F.in[IN_FOUTN] + h * 128 + 2 * lane);
        *(GAS unsigned*)(concat + (size_t)(qb * 256 + r) * D + 1024 + h * 128 + 2 * lane) = pk2(v0 * rn * gn.x, v1 * rn * gn.y);
    }
}
constexpr int RROWS = 8, NITER = S / RROWS;
__device__ __forceinline__ void p7_router(Frame& F) {
    LAS float* shs = (LAS float*)(F.lds + RING_OFF);
    LAS float* H2L = shs + 2 * D;
    LAS float* red = H2L + RROWS * D;
    LAS int* selE = (LAS int*)(red + 16 * RROWS * NE);
    const float* mod = wsp<float>(F, WS_MOD); const float* h1 = wsp<float>(F, WS_H1); unsigned char* h2 = wsp<unsigned char>(F, WS_HN);
    int* top_i = wsp<int>(F, WS_TOPI); float* top_w = wsp<float>(F, WS_TOPW); int* hist = wsp<int>(F, WS_HIST); int* lrank = wsp<int>(F, WS_LRANK);
    const int tid = F.tid, lane = F.lane, w = F.wave;
    for (int i = tid; i < 2 * D; i += NTHR) shs[i] = mod[3 * D + i];
    __syncthreads();
    float wreg[128];
    { const float* wp = F.in[IN_WR] + (size_t)((tid >> 5) * 128) * NE + (tid & 31);
#pragma unroll
        for (int k = 0; k < 128; ++k) wreg[k] = wp[k * NE]; }
    for (int it = F.vcu; it < NITER; it += F.G) {
        const int r0 = it * RROWS;
        {
            const int m = r0 + w; const GAS f32x4* xr = (const GAS f32x4*)(h1 + (size_t)m * D) + lane; f32x4 v[8]; float s2 = 0.f;
#pragma unroll
            for (int j = 0; j < 8; ++j) { v[j] = xr[64 * j]; s2 += (v[j].x * v[j].x + v[j].y * v[j].y) + (v[j].z * v[j].z + v[j].w * v[j].w); }
            const float r = rsqrtf(wave_sum(s2) * (1.f / D) + 1e-6f);
            GAS unsigned* o8 = (GAS unsigned*)(h2 + (size_t)m * D) + lane;
#pragma unroll
            for (int j = 0; j < 8; ++j) { const int c0 = 4 * lane + 256 * j; const f32x4 gg = *(const GAS f32x4*)(F.in[IN_NFFN] + c0); const f32x4 a = *(const LAS f32x4*)(shs + D + c0), b = *(const LAS f32x4*)(shs + c0);
                const f32x4 y = v[j] * r * gg * (a + 1.f) + b; o8[64 * j] = pk4_fp8(y.x, y.y, y.z, y.w);
                *(LAS f32x4*)(H2L + w * D + c0) = y; }
        }
        __syncthreads();
        {
            const int e = tid & 31, kp = tid >> 5; float acc[RROWS];
#pragma unroll
            for (int r = 0; r < RROWS; ++r) acc[r] = 0.f;
#pragma unroll
            for (int k4 = 0; k4 < 32; ++k4) {
#pragma unroll
                for (int r = 0; r < RROWS; ++r) { const f32x4 hv = *(const LAS f32x4*)(H2L + r * D + kp * 128 + k4 * 4); acc[r] += (hv.x * wreg[4 * k4] + hv.y * wreg[4 * k4 + 1]) + (hv.z * wreg[4 * k4 + 2] + hv.w * wreg[4 * k4 + 3]); }
            }
#pragma unroll
            for (int r = 0; r < RROWS; ++r) red[(kp * RROWS + r) * NE + e] = acc[r];
        }
        __syncthreads();
        if (tid < RROWS * NE) {
            const int r = tid >> 5, e = tid & 31; float lg = F.in[IN_BR][e];
#pragma unroll
            for (int kp = 0; kp < 16; ++kp) lg += red[(kp * RROWS + r) * NE + e];
            float cur = lg, mx = 0.f, sum = 0.f, mysel = 0.f; int myidx = 0;
#pragma unroll
            for (int q = 0; q < 4; ++q) { float best = cur; int bi = e;
#pragma unroll
                for (int o = 1; o < 32; o <<= 1) { const float ob = __shfl_xor(best, o); const int oi = __shfl_xor(bi, o); if (ob > best || (ob == best && oi < bi)) { best = ob; bi = oi; } }
                if (q == 0) mx = best;
                sum += __expf(best - mx);
                if (e == q) { mysel = best; myidx = bi; }
                if (e == bi) cur = -3.0e38f; }
            if (e < 4) { const int t = r0 + r; top_i[t * 4 + e] = myidx; top_w[t * 4 + e] = __expf(mysel - mx) / sum; selE[r * 4 + e] = myidx; }
        }
        __syncthreads();
        if (tid < 32) { const int me = selE[tid]; int rank = 0, cnt = 0;
#pragma unroll
            for (int p = 0; p < 32; ++p) { const int ep = selE[p]; rank += (ep == me && p < tid) ? 1 : 0; cnt += (ep == tid) ? 1 : 0; }
            lrank[it * 32 + tid] = rank; hist[it * NE + tid] = cnt; }
        __syncthreads();
    }
}
__device__ __forceinline__ void build_expert_table(Frame& F, const int* counts_g) {
    LAS int* tab = (LAS int*)(F.lds + TAB_OFF);
    if (F.tid == 0) { int acc = 0; for (int e = 0; e < NE; ++e) { const int c = counts_g[e]; tab[e] = acc; tab[40 + e] = c; acc += (c + 255) >> 8; } tab[32] = acc; }
    __syncthreads();
}
__device__ __forceinline__ void p8_gather(Frame& F) {
    LAS int* psum = (LAS int*)(F.lds + RING_OFF);
    LAS int* startr = psum + 16 * NE;
    LAS int* base = startr + NE;
    const int* hist = wsp<int>(F, WS_HIST); const int* lrank = wsp<int>(F, WS_LRANK); const int* top_i = wsp<int>(F, WS_TOPI); const float* top_w = wsp<float>(F, WS_TOPW);
    int* pos = wsp<int>(F, WS_POS); float* roww = wsp<float>(F, WS_ROWW); const unsigned char* h2 = wsp<unsigned char>(F, WS_HN); unsigned char* xg = wsp<unsigned char>(F, WS_XG);
    int* counts_g = (int*)(F.ws + WS_POS) + S * 4;
    const int tid = F.tid, lane = F.lane, w = F.wave;
    { const int e = tid & 31, part = tid >> 5; int s = 0; for (int i = 0; i < NITER / 16; ++i) s += hist[(part * (NITER / 16) + i) * NE + e]; psum[part * NE + e] = s; }
    __syncthreads();
    if (tid == 0) { int acc = 0; for (int e = 0; e < NE; ++e) { int c = 0; for (int p = 0; p < 16; ++p) c += psum[p * NE + e]; startr[e] = acc; acc += ((c + 255) >> 8) << 8; if (blockIdx.x == 0) counts_g[e] = c; } }
    __syncthreads();
    for (int it = F.vcu; it < NITER; it += F.G) {
        {
            const int part = it / (NITER / 16), i0 = part * (NITER / 16);
            if (w < 4) { const bool on = (i0 + lane) < it;
#pragma unroll
                for (int q = 0; q < 8; ++q) { const int e = w * 8 + q; int v = on ? hist[(i0 + lane) * NE + e] : 0;
#pragma unroll
                    for (int o = 1; o < 64; o <<= 1) v += __shfl_xor(v, o);
                    if (lane == 0) { int b = v; for (int pp = 0; pp < part; ++pp) b += psum[pp * NE + e]; base[e] = b; } } }
        }
        __syncthreads();
#pragma unroll
        for (int j = 0; j < 4; ++j) { const int p = w + 8 * j, pair = it * 32 + p, e = top_i[pair], dest = startr[e] + base[e] + lrank[pair], t = pair >> 2;
            if (lane == 0) { pos[pair] = dest; roww[dest] = top_w[pair]; }
            const GAS v4u* src = (const GAS v4u*)(h2 + (size_t)t * D) + lane; GAS v4u* dst = (GAS v4u*)(xg + (size_t)dest * D) + lane;
#pragma unroll
            for (int q = 0; q < 2; ++q) dst[64 * q] = src[64 * q]; }
        __syncthreads();
    }
}
struct GroupedOrder {
    const LAS int* tab; int ntn, G, c;
    __device__ __forceinline__ bool next(int i, Unit& u) const {
        const int L = i * G + c, total = tab[32] * ntn; if (L >= total) return false;
        int e = 0;
#pragma unroll 1
        while (e < NE - 1 && tab[e + 1] * ntn <= L) ++e;
        const int ts = tab[e], tc = tab[e + 1] - ts, within = L - ts * ntn;
        u.pm = ts + within % tc; u.pn = within / tc; u.e = e; u.pb = e * ntn + u.pn; return true;
    }
    __device__ __forceinline__ void a_ready(const Unit&) const {}
    __device__ __forceinline__ void done(const Unit&) const {}
};
struct EpiSwiglu {
    static constexpr bool PERM = true, AFTER_DRAIN = false;
    unsigned char* act; const float* bug;
    __device__ __forceinline__ void operator()(const pg8::f32x4 (&acc)[2][2][4][2], const Unit& u, int wr, int wc, int fr, int fq) const {
        const int row0 = u.pm * 256 + wr * 64 + fr, f0 = u.pn * 128 + wc * 32 + 8 * fq;
        const float* bg = bug + (size_t)u.e * 4096 + f0; pg8::f32x4 bgv[2], buv[2];
#pragma unroll
        for (int n = 0; n < 2; ++n) { bgv[n] = *(const pg8::f32x4*)(bg + 4 * n); buv[n] = *(const pg8::f32x4*)(bg + 2048 + 4 * n); }
#pragma unroll
        for (int ai = 0; ai < 2; ++ai)
#pragma unroll
            for (int m = 0; m < 4; ++m) { float o[8];
#pragma unroll
                for (int n = 0; n < 2; ++n)
#pragma unroll
                    for (int i = 0; i < 4; ++i) { const float g = fminf(acc[ai][0][m][n][i] + bgv[n][i], 7.f); const float up = fminf(fmaxf(acc[ai][1][m][n][i] + buv[n][i], -7.f), 7.f);
                        o[4 * n + i] = (up + 1.f) * g * sigmoid_f(1.702f * g); }
                u32x2 wv; wv.x = pk4_fp8(o[0], o[1], o[2], o[3]); wv.y = pk4_fp8(o[4], o[5], o[6], o[7]);
                *(u32x2*)(act + (size_t)(row0 + ai * 128 + m * 16) * FF + f0) = wv; }
    }
};
struct EpiDown {
    static constexpr bool PERM = true, AFTER_DRAIN = false;
    bf16* y; const float* bd; const float* roww;
    __device__ __forceinline__ void operator()(const pg8::f32x4 (&acc)[2][2][4][2], const Unit& u, int wr, int wc, int fr, int fq) const {
        const int row0 = u.pm * 256 + wr * 64 + fr, col0 = u.pn * 256 + wc * 32 + 8 * fq;
        pg8::f32x4 bv[2][2];
#pragma unroll
        for (int bj = 0; bj < 2; ++bj)
#pragma unroll
            for (int n = 0; n < 2; ++n) bv[bj][n] = *(const pg8::f32x4*)(bd + (size_t)u.e * D + col0 + bj * 128 + 4 * n);
#pragma unroll
        for (int ai = 0; ai < 2; ++ai)
#pragma unroll
            for (int m = 0; m < 4; ++m) { const int row = row0 + ai * 128 + m * 16; const float rw = roww[row]; bf16* rowp = y + (size_t)row * D + col0;
#pragma unroll
                for (int bj = 0; bj < 2; ++bj) { const pg8::f32x4 v0 = (acc[ai][bj][m][0] + bv[bj][0]) * rw, v1 = (acc[ai][bj][m][1] + bv[bj][1]) * rw;
                    pg8::u32x4 wv; wv.x = cvt_pk_bf16(v0[0], v0[1]); wv.y = cvt_pk_bf16(v0[2], v0[3]); wv.z = cvt_pk_bf16(v1[0], v1[1]); wv.w = cvt_pk_bf16(v1[2], v1[3]);
                    *(pg8::u32x4*)(rowp + bj * 128) = wv; } }
    }
};
__device__ __forceinline__ void p11_final(Frame& F, float oscale) {
    LAS float* ms = (LAS float*)(F.lds + RING_OFF);
    const float* mod = wsp<float>(F, WS_MOD);
    for (int i = F.tid; i < 3 * D; i += NTHR) ms[i] = mod[5 * D + i];
    __syncthreads();
    const float* h1 = wsp<float>(F, WS_H1); const bf16* y = wsp<bf16>(F, WS_Y); const int* pos = wsp<int>(F, WS_POS);
    const int gw = F.vcu * NWAVES + F.wave, NGW = F.G * NWAVES, lane = F.lane;
    for (int t = gw; t < S; t += NGW) {
        asm volatile("" ::: "memory");
        const GAS f32x4* xr = (const GAS f32x4*)(h1 + (size_t)t * D) + lane;
        const GAS u32x2* y0 = (const GAS u32x2*)(y + (size_t)pos[t * 4 + 0] * D) + lane; const GAS u32x2* y1 = (const GAS u32x2*)(y + (size_t)pos[t * 4 + 1] * D) + lane;
        const GAS u32x2* y2 = (const GAS u32x2*)(y + (size_t)pos[t * 4 + 2] * D) + lane; const GAS u32x2* y3 = (const GAS u32x2*)(y + (size_t)pos[t * 4 + 3] * D) + lane;
        f32x4 v[8]; float s2 = 0.f;
#pragma unroll
        for (int j = 0; j < 8; ++j) { const u32x2 a = y0[64 * j], b = y1[64 * j], c = y2[64 * j], d = y3[64 * j]; const f32x4 g2 = *(const LAS f32x4*)(ms + 4 * lane + 256 * j);
            f32x4 f;
            f.x = (bf2f((unsigned short)(a.x & 0xffffu)) + bf2f((unsigned short)(b.x & 0xffffu))) + (bf2f((unsigned short)(c.x & 0xffffu)) + bf2f((unsigned short)(d.x & 0xffffu)));
            f.y = (bf2f((unsigned short)(a.x >> 16)) + bf2f((unsigned short)(b.x >> 16))) + (bf2f((unsigned short)(c.x >> 16)) + bf2f((unsigned short)(d.x >> 16)));
            f.z = (bf2f((unsigned short)(a.y & 0xffffu)) + bf2f((unsigned short)(b.y & 0xffffu))) + (bf2f((unsigned short)(c.y & 0xffffu)) + bf2f((unsigned short)(d.y & 0xffffu)));
            f.w = (bf2f((unsigned short)(a.y >> 16)) + bf2f((unsigned short)(b.y >> 16))) + (bf2f((unsigned short)(c.y >> 16)) + bf2f((unsigned short)(d.y >> 16)));
            v[j] = xr[64 * j] + g2 * f; s2 += (v[j].x * v[j].x + v[j].y * v[j].y) + (v[j].z * v[j].z + v[j].w * v[j].w); }
        const float r = rsqrtf(wave_sum(s2) * (1.f / D) + 1e-6f);
        GAS f32x4* o = (GAS f32x4*)(F.out + (size_t)t * D) + lane;
#pragma unroll
        for (int j = 0; j < 8; ++j) { const int c0 = 4 * lane + 256 * j; const f32x4 gg = *(const GAS f32x4*)(F.in[IN_NFIN] + c0); const f32x4 sh = *(const LAS f32x4*)(ms + D + c0), sc = *(const LAS f32x4*)(ms + 2 * D + c0);
            o[64 * j] = (v[j] * r * gg * (sc + 1.f) + sh) * oscale; }
    }
}
}
namespace mk {
struct Args { const float* in[24]; float* out; unsigned char* ws; int ph_lo, ph_hi, li, pad; };
constexpr int N_PHASES = 13;
__global__ void __launch_bounds__(NTHR, 2) mega_fwd(Args args) {
    extern __shared__ __attribute__((aligned(16))) unsigned char lds[];
    Frame F;
    F.lds = (LAS unsigned char*)lds;
    F.MISC = (volatile LAS unsigned*)(F.lds + MISC_OFF);
    F.tid = threadIdx.x; F.lane = F.tid & 63; F.wave = __builtin_amdgcn_readfirstlane(F.tid >> 6);
    F.G = gridDim.x; { const int bx = blockIdx.x; F.vcu = (F.G % 8 == 0) ? (bx % 8) * (F.G / 8) + bx / 8 : bx; }
    F.ws = args.ws; F.out = args.out; F.ctl = (gu32*)(args.ws + WS_CTL);
#pragma unroll
    for (int i = 0; i < 24; ++i) F.in[i] = args.in[i];
    for (int u = F.tid; u < (LDS_BYTES - LDSCTL_OFF) / 4; u += NTHR) ((LAS unsigned*)(F.lds + LDSCTL_OFF))[u] = 0u;
    __syncthreads();
    XcdBarrier bar = xcd_barrier_post((unsigned*)(F.ctl + CW_BAR) + args.li * XCD_BAR_WORDS, F.MISC + 8);
    const int lo = args.ph_lo, hi = args.ph_hi;
#define IN(k) (lo <= (k) && (k) < hi)
#define SEAM(k) do { if (IN(k) && IN((k) + 1)) xcd_barrier(bar); } while (0)

#ifndef MK_DOUBLE
#define MK_DOUBLE 0
#endif
#define DBL(k) ((MK_DOUBLE >> (k)) & 1)
#ifdef MK_PROBE_LO
    unsigned long long* stamps = (unsigned long long*)(F.ctl + 131072);
#define STAMP(k) do { if (blockIdx.x == 0 && F.tid == 0) stamps[k] = rt(); } while (0)
#define PROBE_SCALE() (1.f + sqrtf((float)(stamps[MK_PROBE_HI] - stamps[MK_PROBE_LO]) * 0.01f * 2e-5f))
#else
#define STAMP(k) do { } while (0)
#define PROBE_SCALE() 1.f
#endif
    STAMP(0); if (IN(0)) { p0_prologue(F); if (DBL(0)) p0_prologue(F); } SEAM(0);
    STAMP(1); if (IN(1)) { p1_modulate(F); if (DBL(1)) p1_modulate(F); } SEAM(1);
    STAMP(2); if (IN(2)) {
        pg8::Gemm g{wsp<pg8::bf16_t>(F, WS_HN), wsp<pg8::bf16_t>(F, WS_WIN), S, NPAD, D}; pg8::StaticOrder So; So.init(S, NPAD, F.G, (int)blockIdx.x);
        EpiProj E{wsp<bf16>(F, WS_PROJ), wsp<float>(F, WS_GATES)};
        pg8::gemm_phase<EpiProj, pg8::StaticOrder, true, true>(F.lds + RING_OFF, g, So, E);
        if (DBL(2)) pg8::gemm_phase<EpiProj, pg8::StaticOrder, true, true>(F.lds + RING_OFF, g, So, E);
    } SEAM(2);
    STAMP(3); if (IN(3)) { p3_prep(F); } SEAM(3);
    STAMP(4); if (IN(4)) { p4_scan(F); if (DBL(4)) p4_scan(F); } SEAM(4);
    STAMP(5); if (IN(5)) { p5_mlstm_out(F); if (DBL(14)) p5_mlstm_out(F); p5_attention(F, (char*)lds); } SEAM(5);
    STAMP(6); if (IN(6)) { p6_combine(F); } SEAM(6);
    STAMP(7); if (IN(7)) {
        pg8::Gemm g{wsp<pg8::bf16_t>(F, WS_CONCAT), wsp<pg8::bf16_t>(F, WS_WOUT), S, D, D}; pg8::StaticOrder So; So.init(S, D, F.G, (int)blockIdx.x);
        EpiOut E{F.in[IN_X], wsp<float>(F, WS_MOD) + 2 * D, wsp<float>(F, WS_H1)};
        pg8::gemm_phase<EpiOut, pg8::StaticOrder, false, true>(F.lds + RING_OFF, g, So, E);
        if (DBL(7)) pg8::gemm_phase<EpiOut, pg8::StaticOrder, false, true>(F.lds + RING_OFF, g, So, E);
    } SEAM(7);
    STAMP(8); if (IN(8)) { p7_router(F); if (DBL(8)) p7_router(F); } SEAM(8);
    STAMP(9); if (IN(9)) { p8_gather(F); if (DBL(9)) p8_gather(F); } SEAM(9);
    STAMP(10); if (IN(10)) {
        build_expert_table(F, (const int*)(F.ws + WS_POS) + S * 4);
        pg8::Gemm g{wsp<pg8::bf16_t>(F, WS_XG), wsp<pg8::bf16_t>(F, WS_WUG), MAXROWS, 4096, D / 2}; GroupedOrder So{(const LAS int*)(F.lds + TAB_OFF), 16, F.G, (int)blockIdx.x};
        EpiSwiglu E{wsp<unsigned char>(F, WS_ACT), F.in[IN_BUG]};
        pg8::gemm_phase8<EpiSwiglu, GroupedOrder, true, true>(F.lds + RING_OFF, g, So, E);
        if (DBL(10)) pg8::gemm_phase8<EpiSwiglu, GroupedOrder, true, true>(F.lds + RING_OFF, g, So, E);
    } SEAM(10);
    STAMP(11); if (IN(11)) {
        build_expert_table(F, (const int*)(F.ws + WS_POS) + S * 4);
        pg8::Gemm g{wsp<pg8::bf16_t>(F, WS_ACT), wsp<pg8::bf16_t>(F, WS_WD), MAXROWS, D, FF / 2}; GroupedOrder So{(const LAS int*)(F.lds + TAB_OFF), 8, F.G, (int)blockIdx.x};
        EpiDown E{wsp<bf16>(F, WS_Y), F.in[IN_BD], wsp<float>(F, WS_ROWW)};
        pg8::gemm_phase8<EpiDown, GroupedOrder, true, true>(F.lds + RING_OFF, g, So, E);
        if (DBL(11)) pg8::gemm_phase8<EpiDown, GroupedOrder, true, true>(F.lds + RING_OFF, g, So, E);
    } SEAM(11);
    STAMP(12); if (IN(12)) { p11_final(F, PROBE_SCALE()); if (DBL(12)) p11_final(F, PROBE_SCALE()); }
#undef IN
#undef SEAM
}
}
#ifndef MK_DEBUG
#define MK_DEBUG 0
#endif
#ifndef MK_PH_END
#define MK_PH_END mk::N_PHASES
#endif
#ifndef MK_SPLIT
#define MK_SPLIT 0
#endif
extern "C" void kernel_launch(void* const* d_in, const int* in_sizes, int n_in, void* d_out, int out_size, void* d_ws, size_t ws_size, hipStream_t stream) {
    using namespace mk;
    static int grid = 0;
    if (grid == 0) {
        int dev = 0, cus = 0, per_cu = 0;
        if (hipGetDevice(&dev) != hipSuccess || hipDeviceGetAttribute(&cus, hipDeviceAttributeMultiprocessorCount, dev) != hipSuccess) { fprintf(stderr, "kernel_launch: device query failed\n"); grid = -1; return; }
        if (hipFuncSetAttribute((const void*)mega_fwd, hipFuncAttributeMaxDynamicSharedMemorySize, LDS_BYTES) != hipSuccess) { fprintf(stderr, "kernel_launch: hipFuncSetAttribute failed\n"); grid = -1; return; }
        if (hipOccupancyMaxActiveBlocksPerMultiprocessor(&per_cu, (const void*)mega_fwd, NTHR, LDS_BYTES) != hipSuccess || per_cu < 1) fprintf(stderr, "kernel_launch: occupancy query reports %d\n", per_cu);
        (void)hipGetLastError();
        grid = cus;
        if (n_in != 24 || out_size != S * D || ws_size < (MK_DEBUG ? WS_NAIVE + (size_t)2300 * MiB : WS_END)) fprintf(stderr, "kernel_launch: unexpected sizes n_in %d out %d ws %zu\n", n_in, out_size, ws_size);
    }
    if (grid < 0) return;
    (void)hipMemsetAsync((char*)d_ws + WS_CTL, 0, CTL_ZERO_BYTES, stream);
    Args a{};
    for (int i = 0; i < 24; ++i) a.in[i] = (const float*)d_in[i];
    a.out = (float*)d_out; a.ws = (unsigned char*)d_ws;
#if MK_DEBUG
    nv::naive_forward(d_in, (float*)d_out, (char*)d_ws + WS_NAIVE, stream);
#endif
#if MK_SPLIT
    for (int p = 0; p < MK_PH_END; ++p) { a.ph_lo = p; a.ph_hi = p + 1; a.li = p; hipLaunchKernelGGL(mega_fwd, dim3(grid), dim3(NTHR), LDS_BYTES, stream, a); }
#else
    a.ph_lo = 0; a.ph_hi = MK_PH_END; a.li = 0;
    hipLaunchKernelGGL(mega_fwd, dim3(grid), dim3(NTHR), LDS_BYTES, stream, a);
#endif
#ifdef MK_EXTRA_LO
    a.ph_lo = MK_EXTRA_LO; a.ph_hi = MK_EXTRA_HI; a.li = 1;
    hipLaunchKernelGGL(mega_fwd, dim3(grid), dim3(NTHR), LDS_BYTES, stream, a);
#endif
    { const hipError_t le = hipPeekAtLastError(); if (le != hipSuccess) fprintf(stderr, "kernel_launch: launch failed: %s\n", hipGetErrorName(le)); }
#if MK_DEBUG
    {
        nv::NaiveWs w = nv::carve((char*)d_ws + WS_NAIVE);
        double* slots = (double*)((char*)d_ws + WS_CTL + 512 * 1024);
        unsigned char* ws = (unsigned char*)d_ws; int nc = 0;
        MK_DEBUG_CHECKS
        dbg::k_finish<<<1024, 256, 0, stream>>>((float*)d_out, (size_t)S * D, slots, nc, 1e-3);
    }
#endif
}
```

```cpp
#include <hip/hip_runtime.h>
#include <hip/hip_bf16.h>
#include <cstdio>
#include <cstdint>
namespace pg8 {
#define PG8_LAS __attribute__((address_space(3)))
typedef unsigned short bf16_t;
typedef short bf16x8 __attribute__((ext_vector_type(8)));
typedef float f32x4 __attribute__((ext_vector_type(4)));
typedef unsigned u32x4 __attribute__((ext_vector_type(4)));
constexpr int BM = 256, BK = 64, HALF = 128, HTB = HALF * BK * 2  , STAGE_BYTES = 8 * HTB, NXCD = 8, WGM = 8;

__host__ __device__ __forceinline__ int lds_byte(int r, int c) { const int st = (r >> 4) * 2 + (c >> 5), rr = r & 15, cc = c & 31, ob = rr * 64 + cc * 2; return st * 1024 + (ob ^ (((ob >> 9) & 1) << 5)); }
__host__ __device__ __forceinline__ void stage_rc(int b, int& R, int& C) { const int st = b / 1024, sb = b % 1024, swz = sb ^ (((sb >> 9) & 1) << 5); R = (st >> 1) * 16 + swz / 64; C = (st & 1) * 32 + (swz % 64) / 2; }
__host__ __device__ __forceinline__ int perm32(int rho) { const int n = rho >> 4, i = rho & 15; return 8 * (i >> 2) + 4 * n + (i & 3); }

struct Unit { int pm, pn, pb, e; };
struct Gemm { const bf16_t* A; const bf16_t* Bt; int M, N, K; };

struct StaticOrder {
    int nM, nN, nwg, G, c;
    __host__ __device__ void init(int M, int N, int G_, int c_) { nM = M / BM; nN = N / BM; nwg = nM * nN; G = G_; c = c_; }
    __host__ __device__ bool next(int i, Unit& u) const {
        const long L = (long)i * G + c; if (L >= nwg) return false;
        int wgid = (int)L; { const int q = nwg / NXCD, r = nwg % NXCD, xcd = wgid % NXCD, off = wgid / NXCD; wgid = (xcd < r ? xcd * (q + 1) : r * (q + 1) + (xcd - r) * q) + off; }
        const int nig = WGM * nN, gid = wgid / nig, fm = gid * WGM, gsz = (nM - fm) < WGM ? (nM - fm) : WGM;
        u.pm = fm + ((wgid % nig) % gsz); u.pn = (wgid % nig) / gsz; u.pb = u.pn; u.e = 0; return true;
    }
    __device__ __forceinline__ void a_ready(const Unit&) const {}
    __device__ __forceinline__ void done(const Unit&) const {}
};

__device__ __forceinline__ unsigned cvt_pk_bf16(float lo, float hi) { unsigned r; asm volatile("v_cvt_pk_bf16_f32 %0, %1, %2" : "=v"(r) : "v"(lo), "v"(hi)); return r; }
template <class Epi, class Sched, bool ALIGN_EPI = false, bool SP2 = false>
__device__ __forceinline__ void gemm_phase(PG8_LAS unsigned char* lds, const Gemm g, const Sched& S, const Epi& E) {
    const int tid = threadIdx.x, wid = __builtin_amdgcn_readfirstlane(tid >> 6), lane = tid & 63, wr = wid >> 2, wc = wid & 3, fr = lane & 15, fq = lane >> 4;
    const int K = g.K, nt = K / BK;
    unsigned voffA[2], voffB[2];
#pragma unroll
    for (int i = 0; i < 2; ++i) { int R, C; stage_rc(tid * 16 + i * 8192, R, C); const int Rb = Epi::PERM ? ((R & ~31) + perm32(R & 31)) : R;
        voffA[i] = (unsigned)(R * K + C) * 2u; voffB[i] = (unsigned)(Rb * K + C) * 2u; }
    const size_t kstep = (size_t)(BK * 2);
    const size_t hstep = (size_t)HALF * K * 2;
    const size_t tstep = 2 * hstep;
    const unsigned ldsw = (unsigned)wid * 1024u;
    const int aoff = lds_byte(wr * 64 + fr, fq * 8), boff = lds_byte(wc * 32 + fr, fq * 8);
#define PG8_SA(b, h) (((b) * 2 + (h)) * HTB)
#define PG8_SB(b, h) ((4 + (b) * 2 + (h)) * HTB)
#define PG8_STAGE(bufoff, gbase, voff) do { _Pragma("unroll") for (int _i = 0; _i < 2; ++_i) \
        __builtin_amdgcn_global_load_lds((const unsigned*)((const char*)(gbase) + (voff)[_i]), (PG8_LAS unsigned*)(lds + (bufoff) + ldsw + _i * 8192), 16, 0, 0); } while (0)
#define PG8_LDA(dst, b, h) do { _Pragma("unroll") for (int m = 0; m < 4; ++m) _Pragma("unroll") for (int k = 0; k < 2; ++k) dst[m][k] = *(const PG8_LAS bf16x8*)(lds + PG8_SA(b, h) + aoff + m * 2048 + k * 1024); } while (0)
#define PG8_LDB(dst, b, h) do { _Pragma("unroll") for (int n = 0; n < 2; ++n) _Pragma("unroll") for (int k = 0; k < 2; ++k) dst[n][k] = *(const PG8_LAS bf16x8*)(lds + PG8_SB(b, h) + boff + n * 2048 + k * 1024); } while (0)
#define PG8_MMA(ai, bj, At, Bt) do { __builtin_amdgcn_s_setprio(1); _Pragma("unroll") for (int m = 0; m < 4; ++m) _Pragma("unroll") for (int n = 0; n < 2; ++n) _Pragma("unroll") for (int k = 0; k < 2; ++k) \
        acc[ai][bj][m][n] = __builtin_amdgcn_mfma_f32_16x16x32_bf16(Bt[n][k], At[m][k], acc[ai][bj][m][n], 0, 0, 0); __builtin_amdgcn_s_setprio(0); } while (0)
#define PG8_WAIT_V(n) asm volatile("s_waitcnt vmcnt(" #n ")" ::: "memory")
#define PG8_WAIT_L(n) asm volatile("s_waitcnt lgkmcnt(" #n ")" ::: "memory")
#define PG8_BAR __builtin_amdgcn_s_barrier()
#define PG8_SCHED __builtin_amdgcn_sched_barrier(0)
    Unit cur, nxt; int ui = 0;
    if (!S.next(0, cur)) return;
    f32x4 acc[2][2][4][2];
#pragma unroll
    for (int a = 0; a < 2; ++a)
#pragma unroll
        for (int b = 0; b < 2; ++b)
#pragma unroll
            for (int m = 0; m < 4; ++m)
#pragma unroll
                for (int n = 0; n < 2; ++n) acc[a][b][m][n] = (f32x4){0.f, 0.f, 0.f, 0.f};
    bf16x8 At[4][2], B0[2][2], B1[2][2];
    const char* cA = (const char*)g.A + (size_t)cur.pm * tstep; const char* cB = (const char*)g.Bt + (size_t)cur.pb * tstep;
    S.a_ready(cur);
    if constexpr (SP2) {
        PG8_STAGE(PG8_SB(0, 0), cB, voffB); PG8_STAGE(PG8_SB(0, 1), cB + hstep, voffB); PG8_STAGE(PG8_SA(0, 0), cA, voffA); PG8_STAGE(PG8_SA(0, 1), cA + hstep, voffA);
        if (wr == 1) PG8_BAR;
        PG8_WAIT_V(2); PG8_BAR;
        PG8_STAGE(PG8_SB(1, 0), cB + kstep, voffB); PG8_STAGE(PG8_SA(1, 0), cA + kstep, voffA); PG8_STAGE(PG8_SB(1, 1), cB + hstep + kstep, voffB);
        PG8_WAIT_V(6); PG8_BAR;
    } else {
        PG8_STAGE(PG8_SB(0, 0), cB, voffB); PG8_STAGE(PG8_SA(0, 0), cA, voffA); PG8_STAGE(PG8_SB(0, 1), cB + hstep, voffB); PG8_STAGE(PG8_SA(0, 1), cA + hstep, voffA);
        if (wr == 1) PG8_BAR;
        PG8_WAIT_V(4); PG8_BAR;
        PG8_STAGE(PG8_SB(1, 0), cB + kstep, voffB); PG8_STAGE(PG8_SA(1, 0), cA + kstep, voffA); PG8_STAGE(PG8_SB(1, 1), cB + hstep + kstep, voffB);
        PG8_WAIT_V(6); PG8_BAR;
    }
    for (;;) {
        const bool has_next = S.next(ui + 1, nxt);
        const char* nA = has_next ? (const char*)g.A + (size_t)nxt.pm * tstep : cA; const char* nB = has_next ? (const char*)g.Bt + (size_t)nxt.pb * tstep : cB;
        for (int t = 0; t < nt; t += 2) {
            const bool last = (t == nt - 2);
            const char* a1 = cA + (size_t)(t + 1) * kstep;
            const char* a2 = last ? nA : cA + (size_t)(t + 2) * kstep; const char* b2 = last ? nB : cB + (size_t)(t + 2) * kstep;
            const char* a3 = a2 + kstep; const char* b3 = b2 + kstep;
            if (last && has_next) S.a_ready(nxt);
            if constexpr (SP2) {
            PG8_LDB(B0, 0, 0); PG8_LDB(B1, 0, 1); PG8_SCHED; PG8_LDA(At, 0, 0); PG8_STAGE(PG8_SA(1, 1), a1 + hstep, voffA);
            PG8_WAIT_V(8); PG8_WAIT_L(0); PG8_BAR; PG8_MMA(0, 0, At, B0); PG8_MMA(0, 1, At, B1); PG8_BAR; PG8_SCHED;
            PG8_LDA(At, 0, 1); PG8_STAGE(PG8_SB(0, 0), b2, voffB); PG8_STAGE(PG8_SB(0, 1), b2 + hstep, voffB); PG8_STAGE(PG8_SA(0, 0), a2, voffA);
            PG8_WAIT_V(8); PG8_WAIT_L(0); PG8_BAR; PG8_MMA(1, 0, At, B0); PG8_MMA(1, 1, At, B1); PG8_BAR; PG8_SCHED;
            PG8_LDB(B0, 1, 0); PG8_LDB(B1, 1, 1); PG8_SCHED; PG8_LDA(At, 1, 0); PG8_STAGE(PG8_SA(0, 1), a2 + hstep, voffA);
            PG8_WAIT_V(8); PG8_WAIT_L(0); PG8_BAR; PG8_MMA(0, 0, At, B0); PG8_MMA(0, 1, At, B1); PG8_BAR; PG8_SCHED;
            PG8_LDA(At, 1, 1); PG8_STAGE(PG8_SB(1, 0), b3, voffB); PG8_STAGE(PG8_SB(1, 1), b3 + hstep, voffB); PG8_STAGE(PG8_SA(1, 0), a3, voffA);
            PG8_WAIT_V(8); PG8_WAIT_L(0); PG8_BAR; PG8_MMA(1, 0, At, B0); PG8_MMA(1, 1, At, B1); PG8_BAR; PG8_SCHED;
            } else {
            PG8_LDB(B0, 0, 0); PG8_SCHED; PG8_LDA(At, 0, 0); PG8_STAGE(PG8_SA(1, 1), a1 + hstep, voffA);
            PG8_WAIT_L(8); PG8_BAR; PG8_WAIT_L(0); PG8_MMA(0, 0, At, B0); PG8_BAR; PG8_SCHED;
            PG8_LDB(B1, 0, 1); PG8_STAGE(PG8_SB(0, 0), b2, voffB);
            PG8_BAR; PG8_WAIT_L(0); PG8_MMA(0, 1, At, B1); PG8_BAR;
            PG8_LDA(At, 0, 1); PG8_STAGE(PG8_SA(0, 0), a2, voffA);
            PG8_BAR; PG8_WAIT_L(0); PG8_MMA(1, 0, At, B0); PG8_BAR; PG8_SCHED;
            PG8_STAGE(PG8_SB(0, 1), b2 + hstep, voffB);
            PG8_WAIT_V(6); PG8_BAR; PG8_MMA(1, 1, At, B1); PG8_BAR;
            PG8_LDB(B0, 1, 0); PG8_SCHED; PG8_LDA(At, 1, 0); PG8_STAGE(PG8_SA(0, 1), a2 + hstep, voffA);
            PG8_WAIT_L(8); PG8_BAR; PG8_WAIT_L(0); PG8_MMA(0, 0, At, B0); PG8_BAR; PG8_SCHED;
            PG8_LDB(B1, 1, 1); PG8_STAGE(PG8_SB(1, 0), b3, voffB);
            PG8_BAR; PG8_WAIT_L(0); PG8_MMA(0, 1, At, B1); PG8_BAR;
            PG8_LDA(At, 1, 1); PG8_STAGE(PG8_SA(1, 0), a3, voffA);
            PG8_BAR; PG8_WAIT_L(0); PG8_MMA(1, 0, At, B0); PG8_BAR; PG8_SCHED;
            PG8_STAGE(PG8_SB(1, 1), b3 + hstep, voffB);
            PG8_WAIT_V(6); PG8_BAR; PG8_MMA(1, 1, At, B1); PG8_BAR;
            }
        }
        if constexpr (ALIGN_EPI) { if (wr == 0) PG8_BAR; }
        if constexpr (!Epi::AFTER_DRAIN) { E(acc, cur, wr, wc, fr, fq); S.done(cur); }
        if (!has_next) break;
#pragma unroll
        for (int a = 0; a < 2; ++a)
#pragma unroll
            for (int b = 0; b < 2; ++b)
#pragma unroll
                for (int m = 0; m < 4; ++m)
#pragma unroll
                    for (int n = 0; n < 2; ++n) acc[a][b][m][n] = (f32x4){0.f, 0.f, 0.f, 0.f};
        cur = nxt; cA = nA; cB = nB; ++ui;
        if constexpr (ALIGN_EPI) { if (wr == 1) PG8_BAR; }
    }
    PG8_WAIT_V(0);
    if constexpr (!ALIGN_EPI) { if (wr == 0) PG8_BAR; }
    PG8_BAR;
    if constexpr (Epi::AFTER_DRAIN) { E.fused(acc, cur, wr, wc, fr, fq, lds, wid, lane); S.done(cur); }
#undef PG8_SA
#undef PG8_SB
#undef PG8_STAGE
#undef PG8_LDA
#undef PG8_LDB
#undef PG8_MMA
#undef PG8_WAIT_V
#undef PG8_WAIT_L
#undef PG8_BAR
#undef PG8_SCHED
}
typedef int v8i __attribute__((ext_vector_type(8)));
typedef int v4i __attribute__((ext_vector_type(4)));
constexpr int SCALE_W8 = 0x78787878, SCALE_A8 = 0x7f7f7f7f;
template <class Epi, class Sched, bool ALIGN_EPI = false, bool SP2 = false>
__device__ __forceinline__ void gemm_phase8(PG8_LAS unsigned char* lds, const Gemm g, const Sched& S, const Epi& E) {
    const int tid = threadIdx.x, wid = __builtin_amdgcn_readfirstlane(tid >> 6), lane = tid & 63, wr = wid >> 2, wc = wid & 3, fr = lane & 15, fq = lane >> 4;
    const int K = g.K, nt = K / BK;
    unsigned voffA[2], voffB[2];
#pragma unroll
    for (int i = 0; i < 2; ++i) { int R, C; stage_rc(tid * 16 + i * 8192, R, C); const int Rb = Epi::PERM ? ((R & ~31) + perm32(R & 31)) : R;
        voffA[i] = (unsigned)(R * K + C) * 2u; voffB[i] = (unsigned)(Rb * K + C) * 2u; }
    const size_t kstep = (size_t)(BK * 2);
    const size_t hstep = (size_t)HALF * K * 2;
    const size_t tstep = 2 * hstep;
    const unsigned ldsw = (unsigned)wid * 1024u;
    const int aoff = lds_byte(wr * 64 + fr, fq * 8), boff = lds_byte(wc * 32 + fr, fq * 8);
#define PG8_SA(b, h) (((b) * 2 + (h)) * HTB)
#define PG8_SB(b, h) ((4 + (b) * 2 + (h)) * HTB)
#define PG8_STAGE(bufoff, gbase, voff) do { _Pragma("unroll") for (int _i = 0; _i < 2; ++_i) \
        __builtin_amdgcn_global_load_lds((const unsigned*)((const char*)(gbase) + (voff)[_i]), (PG8_LAS unsigned*)(lds + (bufoff) + ldsw + _i * 8192), 16, 0, 0); } while (0)
#define PG8_LDA(dst, b, h) do { _Pragma("unroll") for (int m = 0; m < 4; ++m) { const v4i lo_ = *(const PG8_LAS v4i*)(lds + PG8_SA(b, h) + aoff + m * 2048), hi_ = *(const PG8_LAS v4i*)(lds + PG8_SA(b, h) + aoff + m * 2048 + 1024); \
        dst[m] = __builtin_shufflevector(lo_, hi_, 0, 1, 2, 3, 4, 5, 6, 7); } } while (0)
#define PG8_LDB(dst, b, h) do { _Pragma("unroll") for (int n = 0; n < 2; ++n) { const v4i lo_ = *(const PG8_LAS v4i*)(lds + PG8_SB(b, h) + boff + n * 2048), hi_ = *(const PG8_LAS v4i*)(lds + PG8_SB(b, h) + boff + n * 2048 + 1024); \
        dst[n] = __builtin_shufflevector(lo_, hi_, 0, 1, 2, 3, 4, 5, 6, 7); } } while (0)
#define PG8_MMA(ai, bj, At, Bt) do { __builtin_amdgcn_s_setprio(1); _Pragma("unroll") for (int m = 0; m < 4; ++m) _Pragma("unroll") for (int n = 0; n < 2; ++n) \
        asm volatile("v_mfma_scale_f32_16x16x128_f8f6f4 %0, %1, %2, %0, %3, %4 op_sel_hi:[0,0,0]" : "+v"(acc[ai][bj][m][n]) : "v"(Bt[n]), "v"(At[m]), "v"(sw8), "v"(sa8)); __builtin_amdgcn_s_setprio(0); } while (0)
#define PG8_WAIT_V(n) asm volatile("s_waitcnt vmcnt(" #n ")" ::: "memory")
#define PG8_WAIT_L(n) asm volatile("s_waitcnt lgkmcnt(" #n ")" ::: "memory")
#define PG8_BAR __builtin_amdgcn_s_barrier()
#define PG8_SCHED __builtin_amdgcn_sched_barrier(0)
    Unit cur, nxt; int ui = 0;
    if (!S.next(0, cur)) return;
    f32x4 acc[2][2][4][2];
#pragma unroll
    for (int a = 0; a < 2; ++a)
#pragma unroll
        for (int b = 0; b < 2; ++b)
#pragma unroll
            for (int m = 0; m < 4; ++m)
#pragma unroll
                for (int n = 0; n < 2; ++n) acc[a][b][m][n] = (f32x4){0.f, 0.f, 0.f, 0.f};
    v8i At[4], B0[2], B1[2]; int sw8 = SCALE_W8, sa8 = SCALE_A8;
    const char* cA = (const char*)g.A + (size_t)cur.pm * tstep; const char* cB = (const char*)g.Bt + (size_t)cur.pb * tstep;
    S.a_ready(cur);
    if constexpr (SP2) {
        PG8_STAGE(PG8_SB(0, 0), cB, voffB); PG8_STAGE(PG8_SB(0, 1), cB + hstep, voffB); PG8_STAGE(PG8_SA(0, 0), cA, voffA); PG8_STAGE(PG8_SA(0, 1), cA + hstep, voffA);
        if (wr == 1) PG8_BAR;
        PG8_WAIT_V(2); PG8_BAR;
        PG8_STAGE(PG8_SB(1, 0), cB + kstep, voffB); PG8_STAGE(PG8_SA(1, 0), cA + kstep, voffA); PG8_STAGE(PG8_SB(1, 1), cB + hstep + kstep, voffB);
        PG8_WAIT_V(6); PG8_BAR;
    } else {
        PG8_STAGE(PG8_SB(0, 0), cB, voffB); PG8_STAGE(PG8_SA(0, 0), cA, voffA); PG8_STAGE(PG8_SB(0, 1), cB + hstep, voffB); PG8_STAGE(PG8_SA(0, 1), cA + hstep, voffA);
        if (wr == 1) PG8_BAR;
        PG8_WAIT_V(4); PG8_BAR;
        PG8_STAGE(PG8_SB(1, 0), cB + kstep, voffB); PG8_STAGE(PG8_SA(1, 0), cA + kstep, voffA); PG8_STAGE(PG8_SB(1, 1), cB + hstep + kstep, voffB);
        PG8_WAIT_V(6); PG8_BAR;
    }
    for (;;) {
        const bool has_next = S.next(ui + 1, nxt);
        const char* nA = has_next ? (const char*)g.A + (size_t)nxt.pm * tstep : cA; const char* nB = has_next ? (const char*)g.Bt + (size_t)nxt.pb * tstep : cB;
        for (int t = 0; t < nt; t += 2) {
            const bool last = (t == nt - 2);
            const char* a1 = cA + (size_t)(t + 1) * kstep;
            const char* a2 = last ? nA : cA + (size_t)(t + 2) * kstep; const char* b2 = last ? nB : cB + (size_t)(t + 2) * kstep;
            const char* a3 = a2 + kstep; const char* b3 = b2 + kstep;
            if (last && has_next) S.a_ready(nxt);
            if constexpr (SP2) {
            PG8_LDB(B0, 0, 0); PG8_LDB(B1, 0, 1); PG8_SCHED; PG8_LDA(At, 0, 0); PG8_STAGE(PG8_SA(1, 1), a1 + hstep, voffA);
            PG8_WAIT_V(8); PG8_WAIT_L(0); PG8_BAR; PG8_MMA(0, 0, At, B0); PG8_MMA(0, 1, At, B1); PG8_BAR; PG8_SCHED;
            PG8_LDA(At, 0, 1); PG8_STAGE(PG8_SB(0, 0), b2, voffB); PG8_STAGE(PG8_SB(0, 1), b2 + hstep, voffB); PG8_STAGE(PG8_SA(0, 0), a2, voffA);
            PG8_WAIT_V(8); PG8_WAIT_L(0); PG8_BAR; PG8_MMA(1, 0, At, B0); PG8_MMA(1, 1, At, B1); PG8_BAR; PG8_SCHED;
            PG8_LDB(B0, 1, 0); PG8_LDB(B1, 1, 1); PG8_SCHED; PG8_LDA(At, 1, 0); PG8_STAGE(PG8_SA(0, 1), a2 + hstep, voffA);
            PG8_WAIT_V(8); PG8_WAIT_L(0); PG8_BAR; PG8_MMA(0, 0, At, B0); PG8_MMA(0, 1, At, B1); PG8_BAR; PG8_SCHED;
            PG8_LDA(At, 1, 1); PG8_STAGE(PG8_SB(1, 0), b3, voffB); PG8_STAGE(PG8_SB(1, 1), b3 + hstep, voffB); PG8_STAGE(PG8_SA(1, 0), a3, voffA);
            PG8_WAIT_V(8); PG8_WAIT_L(0); PG8_BAR; PG8_MMA(1, 0, At, B0); PG8_MMA(1, 1, At, B1); PG8_BAR; PG8_SCHED;
            } else {
            PG8_LDB(B0, 0, 0); PG8_SCHED; PG8_LDA(At, 0, 0); PG8_STAGE(PG8_SA(1, 1), a1 + hstep, voffA);
            PG8_WAIT_L(8); PG8_BAR; PG8_WAIT_L(0); PG8_MMA(0, 0, At, B0); PG8_BAR; PG8_SCHED;
            PG8_LDB(B1, 0, 1); PG8_STAGE(PG8_SB(0, 0), b2, voffB);
            PG8_BAR; PG8_WAIT_L(0); PG8_MMA(0, 1, At, B1); PG8_BAR;
            PG8_LDA(At, 0, 1); PG8_STAGE(PG8_SA(0, 0), a2, voffA);
            PG8_BAR; PG8_WAIT_L(0); PG8_MMA(1, 0, At, B0); PG8_BAR; PG8_SCHED;
            PG8_STAGE(PG8_SB(0, 1), b2 + hstep, voffB);
            PG8_WAIT_V(6); PG8_BAR; PG8_MMA(1, 1, At, B1); PG8_BAR;
            PG8_LDB(B0, 1, 0); PG8_SCHED; PG8_LDA(At, 1, 0); PG8_STAGE(PG8_SA(0, 1), a2 + hstep, voffA);
            PG8_WAIT_L(8); PG8_BAR; PG8_WAIT_L(0); PG8_MMA(0, 0, At, B0); PG8_BAR; PG8_SCHED;
            PG8_LDB(B1, 1, 1); PG8_STAGE(PG8_SB(1, 0), b3, voffB);
            PG8_BAR; PG8_WAIT_L(0); PG8_MMA(0, 1, At, B1); PG8_BAR;
            PG8_LDA(At, 1, 1); PG8_STAGE(PG8_SA(1, 0), a3, voffA);
            PG8_BAR; PG8_WAIT_L(0); PG8_MMA(1, 0, At, B0); PG8_BAR; PG8_SCHED;
            PG8_STAGE(PG8_SB(1, 1), b3 + hstep, voffB);
            PG8_WAIT_V(6); PG8_BAR; PG8_MMA(1, 1, At, B1); PG8_BAR;
            }
        }
        if constexpr (ALIGN_EPI) { if (wr == 0) PG8_BAR; }
        asm volatile("s_nop 15\n\ts_nop 7" ::: "memory");
        if constexpr (!Epi::AFTER_DRAIN) { E(acc, cur, wr, wc, fr, fq); S.done(cur); }
        if (!has_next) break;
#pragma unroll
        for (int a = 0; a < 2; ++a)
#pragma unroll
            for (int b = 0; b < 2; ++b)
#pragma unroll
                for (int m = 0; m < 4; ++m)
#pragma unroll
                    for (int n = 0; n < 2; ++n) acc[a][b][m][n] = (f32x4){0.f, 0.f, 0.f, 0.f};
        cur = nxt; cA = nA; cB = nB; ++ui;
        if constexpr (ALIGN_EPI) { if (wr == 1) PG8_BAR; }
    }
    PG8_WAIT_V(0);
    if constexpr (!ALIGN_EPI) { if (wr == 0) PG8_BAR; }
    PG8_BAR;
    if constexpr (Epi::AFTER_DRAIN) { E.fused(acc, cur, wr, wc, fr, fq, lds, wid, lane); S.done(cur); }
#undef PG8_SA
#undef PG8_SB
#undef PG8_STAGE
#undef PG8_LDA
#undef PG8_LDB
#undef PG8_MMA
#undef PG8_WAIT_V
#undef PG8_WAIT_L
#undef PG8_BAR
#undef PG8_SCHED
}
}
#define GAS __attribute__((address_space(1)))
#define LAS __attribute__((address_space(3)))
typedef unsigned short bf16;
typedef unsigned v4u __attribute__((ext_vector_type(4)));
typedef float f32x4 __attribute__((ext_vector_type(4)));
typedef short bf16x8 __attribute__((ext_vector_type(8)));
typedef GAS unsigned gu32;
typedef GAS unsigned long long gu64;
#define RLX_AGENT __ATOMIC_RELAXED, __HIP_MEMORY_SCOPE_AGENT
#define LDS_WAIT() asm volatile("s_waitcnt lgkmcnt(0)" ::: "memory")
#define VM_WAIT() asm volatile("s_waitcnt vmcnt(0)" ::: "memory")
__device__ __forceinline__ unsigned long long rt() { return __builtin_amdgcn_s_memrealtime(); }
__device__ __forceinline__ unsigned f2bf(float f) { unsigned u = __builtin_bit_cast(unsigned, f); return (u + 0x7fffu + ((u >> 16) & 1u)) >> 16; }
__device__ __forceinline__ unsigned pk2(float lo, float hi) { return f2bf(lo) | (f2bf(hi) << 16); }

#define XB_TMO      128
#define XB_XCNT(j)  (256  + 64 * (j))
#define XB_XSUB(j)  (1280 + 64 * (j))
#define XB_XGEN(j)  (2304 + 64 * (j))
#define XB_TOP      3328
#define XB_TOPGEN   3392
#define XCD_BAR_WORDS 3456
#define XB_SPIN_CAP (1u << 18)

__device__ __forceinline__ unsigned xb_ld(unsigned* p)              { return __hip_atomic_load(p, __ATOMIC_RELAXED, __HIP_MEMORY_SCOPE_AGENT); }
__device__ __forceinline__ unsigned xb_add(unsigned* p, unsigned v) { return __hip_atomic_fetch_add(p, v, __ATOMIC_RELAXED, __HIP_MEMORY_SCOPE_AGENT); }
__device__ __forceinline__ unsigned xb_xcc_id() { return (unsigned)__builtin_amdgcn_s_getreg((3 << 11) | 20) & 0xFu; }
#define XB_SPIN(cond, bar) do { unsigned _sp = 0; while (cond) { __builtin_amdgcn_s_sleep(1); \
    if ((++_sp & 255u) == 0u) { if (xb_ld(&(bar)[XB_TMO])) break; if (_sp > XB_SPIN_CAP) { atomicAdd(&(bar)[XB_TMO], 1u); break; } } } } while (0)

struct XcdBarrier {
    unsigned* bar; unsigned x;
    volatile LAS unsigned* st;
};

__device__ __forceinline__ XcdBarrier xcd_barrier_post(unsigned* bar, volatile LAS unsigned* st) {
    XcdBarrier b; b.bar = bar; b.x = xb_xcc_id(); b.st = st;
    if (threadIdx.x == 0) (void)xb_add(&bar[XB_XCNT(b.x)], 1u);
    return b;
}
__device__ __forceinline__ void xcd_barrier_complete(unsigned* bar, unsigned x, unsigned& nloc, unsigned& nx) {
    const unsigned G = gridDim.x * gridDim.y * gridDim.z;
    unsigned sum, cnt, mine, sp = 0u;
    for (;;) {
        sum = 0u; cnt = 0u; mine = 0u;
#pragma unroll
        for (unsigned j = 0; j < 16; ++j) { const unsigned c = xb_ld(&bar[XB_XCNT(j)]); sum += c; cnt += (c > 0u) ? 1u : 0u; mine = (j == x) ? c : mine; }
        if (sum == G) break;
        __builtin_amdgcn_s_sleep(1);
        if ((++sp & 255u) == 0u) { if (xb_ld(&bar[XB_TMO])) break; if (sp > XB_SPIN_CAP) { atomicAdd(&bar[XB_TMO], 1u); break; } }
    }
    nloc = mine > 0u ? mine : 1u; nx = cnt > 0u ? cnt : 1u;
}

__device__ __forceinline__ void xcd_barrier(const XcdBarrier& b) {
    asm volatile("s_waitcnt vmcnt(0)" ::: "memory");
    __syncthreads();
    if (threadIdx.x == 0) {
        unsigned* bar = b.bar;
        __builtin_amdgcn_s_waitcnt(0);
        unsigned nloc = b.st[0], nx = b.st[1];
        if (nloc == 0u) { xcd_barrier_complete(bar, b.x, nloc, nx); b.st[0] = nloc; b.st[1] = nx; }
        const unsigned old = xb_add(&bar[XB_XSUB(b.x)], 1u);
        const unsigned gen = old / nloc;
        if (old + 1u == (gen + 1u) * nloc) {
            __builtin_amdgcn_fence(__ATOMIC_RELEASE, "agent");
            asm volatile("s_waitcnt vmcnt(0)" ::: "memory");
            const unsigned og = xb_add(&bar[XB_TOP], 1u);
            const unsigned tg = og / nx;
            if (og + 1u == (tg + 1u) * nx) xb_add(&bar[XB_TOPGEN], 1u);
            else XB_SPIN(xb_ld(&bar[XB_TOPGEN]) == tg, bar);
            __builtin_amdgcn_fence(__ATOMIC_ACQUIRE, "agent");
            xb_add(&bar[XB_XGEN(b.x)], 1u);
            asm volatile("s_waitcnt vmcnt(0)" ::: "memory");
        } else {
            XB_SPIN(xb_ld(&bar[XB_XGEN(b.x)]) == gen, bar);
            __builtin_amdgcn_fence(__ATOMIC_ACQUIRE, "agent");
            asm volatile("s_waitcnt vmcnt(0)" ::: "memory");
        }
    }
    __syncthreads();
}
namespace mk {
constexpr int S = 8192, D = 2048, NPROJ = 6160, NPP = 6144, NPAD = 6400, NE = 32, FF = 2048, NWAVES = 8, NTHR = 512;
constexpr int C_MQ = 0, C_MK = 512, C_MV = 1024, C_MO = 2048, C_FQ = 3072, C_FK = 4096, C_FV = 5120;
constexpr int MAXROWS = S * 4 + NE * 256;
constexpr int NCH = 128, LCH = 64;
constexpr size_t MiB = 1u << 20;
constexpr size_t WS_CTL = 0, CTL_ZERO_BYTES = 1 * MiB;
constexpr size_t WS_MODP = 14 * MiB;
constexpr size_t WS_MOD = 2 * MiB;
constexpr size_t WS_GATES = 3 * MiB;
constexpr size_t WS_F = 4 * MiB;
constexpr size_t WS_NL = 5 * MiB;
constexpr size_t WS_NS = 6 * MiB;
constexpr size_t WS_GLAL = 7 * MiB;
constexpr size_t WS_MS = 7 * MiB + 65536;
constexpr size_t WS_TOPI = 8 * MiB;
constexpr size_t WS_TOPW = 9 * MiB;
constexpr size_t WS_HIST = 10 * MiB;
constexpr size_t WS_LRANK = 11 * MiB;
constexpr size_t WS_POS = 12 * MiB;
constexpr size_t WS_ROWW = 13 * MiB;
constexpr size_t WS_WIN = 16 * MiB;
constexpr size_t WS_WOUT = 42 * MiB;
constexpr size_t WS_HN = 50 * MiB;
constexpr size_t WS_PROJ = 82 * MiB;
constexpr size_t WS_UL = 178 * MiB;
constexpr size_t WS_CS = 242 * MiB;
constexpr size_t WS_CONCAT = 274 * MiB;
constexpr size_t WS_H1 = 306 * MiB;
constexpr size_t WS_XG = 370 * MiB;
constexpr size_t WS_ACT = 530 * MiB;
constexpr size_t WS_Y = 690 * MiB;
constexpr size_t WS_WUG = 850 * MiB;
constexpr size_t WS_WD = 1362 * MiB;
constexpr size_t WS_OPART = 1618 * MiB;
constexpr size_t WS_MLP = 1786 * MiB;
constexpr size_t WS_JLO = 1789 * MiB;
constexpr size_t WS_END = 1790 * MiB;
constexpr size_t WS_NAIVE = 1792 * MiB;
constexpr int CW_TMO = 0, CW_CODE = 1, CW_BAR = 4096;
constexpr int RING_OFF = 0, RING_BYTES = 131072;
constexpr int LDSCTL_OFF = RING_BYTES, MISC_OFF = LDSCTL_OFF + 320;
constexpr int TAB_OFF = LDSCTL_OFF + 1024;
constexpr int ATT_CH = 16;
constexpr int LDS_BYTES = 147456;
}
namespace mk {
typedef float f32x2 __attribute__((ext_vector_type(2)));
typedef unsigned u32x2 __attribute__((ext_vector_type(2)));
struct Frame {
    LAS unsigned char* lds;
    volatile LAS unsigned* MISC;
    gu32* ctl;
    int tid, lane, wave, vcu, G;
    const float* in[24];
    float* out; unsigned char* ws;
};
#define IN_X 0
#define IN_C 1
#define IN_WADA 2
#define IN_BADA 3
#define IN_NMIX 4
#define IN_WIN 5
#define IN_BI 6
#define IN_BF 7
#define IN_FOXBF 8
#define IN_FOXQN 9
#define IN_FOXKN 10
#define IN_MOUTN 11
#define IN_FOUTN 12
#define IN_WOUT 13
#define IN_NFFN 14
#define IN_WR 15
#define IN_BR 16
#define IN_WUG 17
#define IN_BUG 18
#define IN_WD 19
#define IN_BD 20
#define IN_WAF 21
#define IN_BAF 22
#define IN_NFIN 23
template <class T> __device__ __forceinline__ T* wsp(const Frame& F, size_t off) { return (T*)(F.ws + off); }
__device__ __forceinline__ float wave_sum(float v) {
#pragma unroll
    for (int o = 1; o < 64; o <<= 1) v += __shfl_xor(v, o);
    return v;
}
__device__ __forceinline__ float sigmoid_f(float v) { return 1.f / (1.f + __expf(-v)); }
__device__ __forceinline__ float log_sigmoid_f(float v) { return fminf(v, 0.f) - log1pf(__expf(-fabsf(v))); }
__device__ __forceinline__ float softcap_f(float v) { return 15.f * tanhf(v * (1.f / 15.f)); }
__device__ __forceinline__ float bf2f(unsigned short b) { return __uint_as_float(((unsigned)b) << 16); }

struct CvtItem { const float* src; bf16* dst; };
__device__ __forceinline__ void cvt_load(const CvtItem& it, int ldw, f32x4 (&v)[16], int lane) {
    const float* p = it.src + (size_t)((lane >> 4) * 16) * ldw + (lane & 15) * 4;
#pragma unroll
    for (int i = 0; i < 16; ++i) v[i] = __builtin_nontemporal_load((const GAS f32x4*)(p + (size_t)i * ldw));
}
__device__ __forceinline__ void cvt_store(const CvtItem& it, int K, const f32x4 (&v)[16], LAS unsigned char* scr, int lane) {
    const int c = lane & 15, g = lane >> 4;
#pragma unroll
    for (int j = 0; j < 4; ++j) {
        v4u a, b;
        a.x = pk2(v[0][j], v[1][j]); a.y = pk2(v[2][j], v[3][j]); a.z = pk2(v[4][j], v[5][j]); a.w = pk2(v[6][j], v[7][j]);
        b.x = pk2(v[8][j], v[9][j]); b.y = pk2(v[10][j], v[11][j]); b.z = pk2(v[12][j], v[13][j]); b.w = pk2(v[14][j], v[15][j]);
        LAS unsigned char* q = scr + (4 * c + j) * 144 + 32 * g;
        *(LAS v4u*)q = a; *(LAS v4u*)(q + 16) = b; }
    LDS_WAIT(); asm volatile("" ::: "memory");
#pragma unroll
    for (int i = 0; i < 8; ++i) { const int row = (lane >> 3) + 8 * i; const v4u o = *(const LAS v4u*)(scr + row * 144 + (lane & 7) * 16);
        *(GAS v4u*)(it.dst + (size_t)row * K + (lane & 7) * 8) = o; }
    LDS_WAIT(); asm volatile("" ::: "memory");
}
__device__ __forceinline__ unsigned pk4_fp8(float a, float b, float c, float d) { int r = __builtin_amdgcn_cvt_pk_fp8_f32(a, b, 0, false); r = __builtin_amdgcn_cvt_pk_fp8_f32(c, d, r, true); return (unsigned)r; }
constexpr float W8S = 128.f;
__device__ __forceinline__ void cvt8_pack(const f32x4 (&v)[16], LAS unsigned char* scr, int half, int lane) {
    const int c = lane & 15, g = lane >> 4;
#pragma unroll
    for (int j = 0; j < 4; ++j) { v4u a;
        a.x = pk4_fp8(v[0][j] * W8S, v[1][j] * W8S, v[2][j] * W8S, v[3][j] * W8S); a.y = pk4_fp8(v[4][j] * W8S, v[5][j] * W8S, v[6][j] * W8S, v[7][j] * W8S);
        a.z = pk4_fp8(v[8][j] * W8S, v[9][j] * W8S, v[10][j] * W8S, v[11][j] * W8S); a.w = pk4_fp8(v[12][j] * W8S, v[13][j] * W8S, v[14][j] * W8S, v[15][j] * W8S);
        *(LAS v4u*)(scr + (4 * c + j) * 144 + half * 64 + 16 * g) = a; }
}
__device__ __forceinline__ void cvt8_flush(unsigned char* dst, int kbytes, LAS unsigned char* scr, int lane) {
    LDS_WAIT(); asm volatile("" ::: "memory");
#pragma unroll
    for (int i = 0; i < 8; ++i) { const int row = (lane >> 3) + 8 * i; const v4u o = *(const LAS v4u*)(scr + row * 144 + (lane & 7) * 16);
        *(GAS v4u*)(dst + (size_t)row * kbytes + (lane & 7) * 16) = o; }
    LDS_WAIT(); asm volatile("" ::: "memory");
}
constexpr int CV8_UG = NE * 16 * 64, CV8_D = NE * 16 * 32, CV8_TOTAL = CV8_UG + CV8_D;
struct Cvt8Item { const float* src; unsigned char* dst; int ldw; };
__device__ __forceinline__ Cvt8Item cvt8_item(const Frame& F, int it, int half) {
    Cvt8Item r;
    if (it < CV8_UG) { const int e = it >> 10, q = it & 1023, kb = q >> 6, nb = q & 63, d0 = nb * 64, j = d0 >> 8, wv = d0 & 255, sc = wv < 128 ? 128 * j + wv : 2048 + 128 * j + (wv - 128);
        r.ldw = 4096; r.src = F.in[IN_WUG] + (size_t)e * D * 4096 + (size_t)(kb * 128 + half * 64) * 4096 + sc; r.dst = wsp<unsigned char>(F, WS_WUG) + (size_t)e * 4096 * D + (size_t)d0 * D + kb * 128; return r; }
    it -= CV8_UG;
    { const int e = it >> 9, q = it & 511, kb = q >> 5, nb = q & 31;
        r.ldw = D; r.src = F.in[IN_WD] + (size_t)e * FF * D + (size_t)(kb * 128 + half * 64) * D + nb * 64; r.dst = wsp<unsigned char>(F, WS_WD) + (size_t)e * D * FF + (size_t)(nb * 64) * FF + kb * 128; return r; }
}
__device__ __forceinline__ void cvt8_load(const Cvt8Item& it, f32x4 (&v)[16], int lane) {
    const float* p = it.src + (size_t)((lane >> 4) * 16) * it.ldw + (lane & 15) * 4;
#pragma unroll
    for (int i = 0; i < 16; ++i) v[i] = __builtin_nontemporal_load((const GAS f32x4*)(p + (size_t)i * it.ldw));
}
constexpr int CV_IN = 32 * 96, CV_OUT = 32 * 32, CV_TOTAL = CV_IN + CV_OUT;
__device__ __forceinline__ CvtItem cvt_item(const Frame& F, int it, int& ldw, int& K) {
    CvtItem r;
    if (it < CV_IN) { const int kb = it / 96, nb = it % 96, d0 = nb * 64, sc = d0 < 3072 ? d0 : d0 + 8;
        ldw = NPROJ; K = D; r.src = F.in[IN_WIN] + (size_t)(kb * 64) * NPROJ + sc; r.dst = wsp<bf16>(F, WS_WIN) + (size_t)d0 * D + kb * 64; return r; }
    it -= CV_IN;
    { const int kb = it >> 5, nb = it & 31; ldw = D; K = D; r.src = F.in[IN_WOUT] + (size_t)(kb * 64) * D + nb * 64; r.dst = wsp<bf16>(F, WS_WOUT) + (size_t)(nb * 64) * D + kb * 64; return r; }
}
__device__ __forceinline__ void p0_gemv(Frame& F) {
    const int gw = F.vcu * NWAVES + F.wave, NGW = F.G * NWAVES, lane = F.lane;
    {
        const float* c = F.in[IN_C]; float* modp = wsp<float>(F, WS_MODP);
        for (int task = gw; task < 2048; task += NGW) {
            const int cg = task & 63, ks = task >> 6, j = cg * 256 + 4 * lane;
            const float* w; int ld, col;
            if (j < 6 * D) { w = F.in[IN_WADA]; ld = 6 * D; col = j; } else { w = F.in[IN_WAF]; ld = 2 * D; col = j - 6 * D; }
            const float c0 = c[ks * 64 + lane]; const float s0 = c0 * sigmoid_f(c0);
            const float* wp = w + (size_t)(ks * 64) * ld + col; f32x4 acc = {0.f, 0.f, 0.f, 0.f};
#pragma unroll 16
            for (int i = 0; i < 64; ++i) acc += __builtin_nontemporal_load((const GAS f32x4*)(wp + (size_t)i * ld)) * __builtin_bit_cast(float, __builtin_amdgcn_readlane(__builtin_bit_cast(int, s0), i));
            *(GAS f32x4*)(modp + ks * 16384 + j) = acc;
        }
    }
    {
        bf16* win_t = wsp<bf16>(F, WS_WIN);
        for (int i2 = gw; i2 < D / 4; i2 += NGW) {
            const int col = lane & 15, k = 4 * i2 + (lane >> 4), sc = col < 8 ? 3072 + col : 6152 + (col - 8);
            win_t[(size_t)(NPP + col) * D + k] = (bf16)f2bf(F.in[IN_WIN][(size_t)k * NPROJ + sc]); }
        const v4u z = {0u, 0u, 0u, 0u};
        for (int i = gw * 64 + lane; i < 16 * D / 8; i += NGW * 64) *(GAS v4u*)(win_t + (size_t)NPROJ * D + (size_t)i * 8) = z;
    }
}
__device__ __forceinline__ void p1_convert(Frame& F) {
    const int gw = F.vcu * NWAVES + F.wave, NGW = F.G * NWAVES, lane = F.lane;
    {
        LAS unsigned char* scr = F.lds + RING_OFF + F.wave * 9216;
        const int nmine = gw < CV8_TOTAL ? (CV8_TOTAL - gw + NGW - 1) / NGW : 0, nsteps = 2 * nmine;
        if (nsteps > 0) {
            f32x4 va[16], vb[16];
            Cvt8Item cur = cvt8_item(F, gw, 0); cvt8_load(cur, va, lane);
            for (int s = 0; s < nsteps; s += 2) {
                const int it = gw + (s >> 1) * NGW;
                const Cvt8Item c1 = cvt8_item(F, it, 1); cvt8_load(c1, vb, lane);
                cvt8_pack(va, scr, 0, lane);
                const bool more = s + 2 < nsteps; Cvt8Item nx = cur;
                if (more) { nx = cvt8_item(F, it + NGW, 0); cvt8_load(nx, va, lane); }
                cvt8_pack(vb, scr, 1, lane);
                cvt8_flush(cur.dst, D, scr, lane);
                cur = nx;
            }
        }
    }
    {
        LAS unsigned char* scr = F.lds + RING_OFF + F.wave * 9216;
        int it = gw;
        if (it < CV_TOTAL) {
            int ldw, K; CvtItem cur = cvt_item(F, it, ldw, K); f32x4 va[16], vb[16];
            cvt_load(cur, ldw, va, lane);
            for (;;) {
                int itn = it + NGW; int ldn = 0, Kn = 0; CvtItem nx = cur; const bool more = itn < CV_TOTAL;
                if (more) { nx = cvt_item(F, itn, ldn, Kn); cvt_load(nx, ldn, vb, lane); }
                cvt_store(cur, K, va, scr, lane);
                if (!more) break;
                it = itn + NGW; const bool more2 = it < CV_TOTAL; CvtItem n2 = nx; int ld2 = 0, K2 = 0;
                if (more2) { n2 = cvt_item(F, it, ld2, K2); cvt_load(n2, ld2, va, lane); }
                cvt_store(nx, Kn, vb, scr, lane);
                if (!more2) break;
                cur = n2; K = K2;
            }
        }
    }
}
__device__ __forceinline__ void mod_reduce_lds(Frame& F, int j0, int n, LAS float* dst) {
    const float* modp = wsp<float>(F, WS_MODP);
    for (int i = F.tid; i < n; i += NTHR) { const int j = j0 + i; float a = j < 6 * D ? F.in[IN_BADA][j] : F.in[IN_BAF][j - 6 * D];
#pragma unroll
        for (int ks = 0; ks < 32; ++ks) a += modp[ks * 16384 + j];
        dst[i] = a; }
}
__device__ __forceinline__ void modulate_row_bf16(const float* xrow, const float* g, const LAS float* sh, const LAS float* sc, bf16* orow, int lane) {
    const GAS f32x4* xr = (const GAS f32x4*)xrow + lane; f32x4 v[8]; float s2 = 0.f;
#pragma unroll
    for (int j = 0; j < 8; ++j) { v[j] = xr[64 * j]; s2 += (v[j].x * v[j].x + v[j].y * v[j].y) + (v[j].z * v[j].z + v[j].w * v[j].w); }
    const float r = rsqrtf(wave_sum(s2) * (1.f / D) + 1e-6f);
    GAS u32x2* o8 = (GAS u32x2*)orow + lane;
#pragma unroll
    for (int j = 0; j < 8; ++j) { const int c0 = 4 * lane + 256 * j; const f32x4 gg = *(const GAS f32x4*)(g + c0); const f32x4 a = *(const LAS f32x4*)(sc + c0), b = *(const LAS f32x4*)(sh + c0);
        const f32x4 y = v[j] * r * gg * (a + 1.f) + b; u32x2 w; w.x = pk2(y.x, y.y); w.y = pk2(y.z, y.w); o8[64 * j] = w; }
}
typedef float f32x16 __attribute__((ext_vector_type(16)));
typedef short s16x8g __attribute__((ext_vector_type(8)));
__device__ __forceinline__ void p1_modulate(Frame& F) {
    LAS float* shs = (LAS float*)(F.lds + RING_OFF + 81920);
    LAS float* gred = (LAS float*)(F.lds + RING_OFF + 98304);
    mod_reduce_lds(F, 0, 2 * D, shs);
    if (F.tid < 64) {
        const float* modp = wsp<float>(F, WS_MODP); float* mod = wsp<float>(F, WS_MOD);
        for (int j = blockIdx.x * 64 + F.tid; j < 16384; j += F.G * 64) { float a = j < 6 * D ? F.in[IN_BADA][j] : F.in[IN_BAF][j - 6 * D];
#pragma unroll
            for (int ks = 0; ks < 32; ++ks) a += modp[ks * 16384 + j];
            mod[j] = a; }
    }
    __syncthreads();
    bf16* hn = wsp<bf16>(F, WS_HN); const bf16* wg = wsp<bf16>(F, WS_WIN) + (size_t)NPP * D; float* gates = wsp<float>(F, WS_GATES);
    const int lane = F.lane, w = F.wave, hi = lane >> 5, l31 = lane & 31;
    for (int rb = F.vcu; rb < S / 32; rb += F.G) {
        const int row0 = rb * 32;
#pragma unroll 1
        for (int i = 0; i < 4; ++i) { const int m = row0 + 4 * w + i; asm volatile("" ::: "memory"); modulate_row_bf16(F.in[IN_X] + (size_t)m * D, F.in[IN_NMIX], shs, shs + D, hn + (size_t)m * D, lane); }
        asm volatile("s_waitcnt vmcnt(0)" ::: "memory");
        __syncthreads();
        f32x16 acc;
#pragma unroll
        for (int r = 0; r < 16; ++r) acc[r] = 0.f;
        const bf16* ap = hn + (size_t)(row0 + l31) * D + 256 * w + 8 * hi; const bf16* bp = wg + (size_t)l31 * D + 256 * w + 8 * hi;
#pragma unroll
        for (int ks = 0; ks < 16; ++ks) { const s16x8g a = *(const GAS s16x8g*)(ap + 16 * ks), b = *(const GAS s16x8g*)(bp + 16 * ks); acc = __builtin_amdgcn_mfma_f32_32x32x16_bf16(a, b, acc, 0, 0, 0); }
        if (l31 < 16) {
#pragma unroll
            for (int r = 0; r < 16; ++r) gred[(w * 32 + (r & 3) + 8 * (r >> 2) + 4 * hi) * 16 + l31] = acc[r]; }
        __syncthreads();
        { const int row = F.tid >> 4, n = F.tid & 15; float s = 0.f;
#pragma unroll
            for (int q = 0; q < 8; ++q) s += gred[(q * 32 + row) * 16 + n];
            gates[(size_t)(row0 + row) * 16 + n] = s; }
        __syncthreads();
    }
    p1_convert(F);
}
using pg8::Unit; using pg8::cvt_pk_bf16;
struct EpiProj {
    static constexpr bool PERM = true, AFTER_DRAIN = false;
    bf16* O;
    __device__ __forceinline__ void operator()(const pg8::f32x4 (&acc)[2][2][4][2], const Unit& u, int wr, int wc, int fr, int fq) const {
        const int row0 = u.pm * 256 + wr * 64 + fr, col0 = u.pn * 256 + wc * 32 + 8 * fq;
#pragma unroll
        for (int ai = 0; ai < 2; ++ai)
#pragma unroll
            for (int m = 0; m < 4; ++m) { bf16* rowp = O + (size_t)(row0 + ai * 128 + m * 16) * NPP + col0;
#pragma unroll
                for (int bj = 0; bj < 2; ++bj) { const pg8::f32x4 v0 = acc[ai][bj][m][0], v1 = acc[ai][bj][m][1];
                    pg8::u32x4 w; w.x = cvt_pk_bf16(v0[0], v0[1]); w.y = cvt_pk_bf16(v0[2], v0[3]); w.z = cvt_pk_bf16(v1[0], v1[1]); w.w = cvt_pk_bf16(v1[2], v1[3]);
                    *(pg8::u32x4*)(rowp + bj * 128) = w; } }
    }
};
struct EpiOut {
    static constexpr bool PERM = false, AFTER_DRAIN = false;
    const float* x; const float* g1; float* h1;
    __device__ __forceinline__ void operator()(const pg8::f32x4 (&acc)[2][2][4][2], const Unit& u, int wr, int wc, int fr, int fq) const {
        const int row0 = u.pm * 256 + wr * 64 + fr, col0 = u.pn * 256 + wc * 32 + 4 * fq;
        pg8::f32x4 gv[2][2];
#pragma unroll
        for (int bj = 0; bj < 2; ++bj)
#pragma unroll
            for (int n = 0; n < 2; ++n) gv[bj][n] = *(const pg8::f32x4*)(g1 + col0 + bj * 128 + n * 16);
#pragma unroll
        for (int ai = 0; ai < 2; ++ai)
#pragma unroll
            for (int m = 0; m < 4; ++m) { const size_t off = (size_t)(row0 + ai * 128 + m * 16) * D + col0;
#pragma unroll
                for (int bj = 0; bj < 2; ++bj)
#pragma unroll
                    for (int n = 0; n < 2; ++n) { const pg8::f32x4 xv = *(const pg8::f32x4*)(x + off + bj * 128 + n * 16);
                        *(pg8::f32x4*)(h1 + off + bj * 128 + n * 16) = xv + gv[bj][n] * acc[ai][bj][m][n]; } }
    }
};
}
namespace fox {
constexpr int D = 128, SQ = 8192, SKV = 8192; constexpr float THR = 8.f; constexpr bool WSKIP = false;
constexpr int PITCH = 6144;
constexpr int OPITCH = 2048;
constexpr float SCALE = 0.08838834764831845f;
constexpr int NW = 8, QBLK = 32, KVBLK = 64, QB = NW * QBLK;
constexpr int SHM_V = KVBLK * D * 2, SHM_K = KVBLK * D * 2;
constexpr int LDS_BIAS = 2 * SHM_V + 2 * SHM_K + NW * 64 * 4;
constexpr int LDS_BYTES = LDS_BIAS + 512;

using bf16 = __hip_bfloat16;
typedef short bf16x8 __attribute__((ext_vector_type(8)));
typedef short s16x4 __attribute__((ext_vector_type(4)));
typedef float f32x16 __attribute__((ext_vector_type(16)));
typedef float f32x4 __attribute__((ext_vector_type(4)));
typedef unsigned u32x4 __attribute__((ext_vector_type(4)));
template <class A, class Bt> struct same_t { static constexpr bool v = false; };
template <class A> struct same_t<A, A> { static constexpr bool v = true; };

#define KSWZ(row, colB) ((row) * 256 + ((colB) ^ (((row) & 7) << 4)))
#define SBAR() __builtin_amdgcn_sched_barrier(0)
__device__ __forceinline__ int v_st(int k, int c) { const int kk = (k & ~0xC) | ((k & 4) << 1) | ((k & 8) >> 1); return ((kk >> 3) * 4 + (c >> 5)) * 512 + ((kk & 7) * 32 + (c & 31)) * 2; }
__device__ __forceinline__ int v_rd_base(int lane) { return ((lane & 3) << 3) | (((lane >> 2) & 3) << 6) | (((lane >> 4) & 1) << 5) | (((lane >> 5) & 1) << 8); }
constexpr int v_rd_off(int d0, int ks, int half) { return d0 * 512 + ks * 4096 + half * 2048; }
__device__ __forceinline__ int crow(int r, int hi) { return (r & 3) + 8 * (r >> 2) + 4 * hi; }
__device__ __forceinline__ int bias_slot(int kk) { return ((kk >> 2) & 1) * 32 + (kk >> 5) * 16 + (kk & 3) + 4 * ((kk & 31) >> 3); }
__device__ __forceinline__ unsigned cvtpk(float lo, float hi) {
    unsigned r; asm volatile("v_cvt_pk_bf16_f32 %0, %1, %2" : "=v"(r) : "v"(lo), "v"(hi)); return r;
}
__device__ __forceinline__ bf16x8 pack8(f32x4 a, f32x4 b) {
    u32x4 w = {cvtpk(a[0], a[1]), cvtpk(a[2], a[3]), cvtpk(b[0], b[1]), cvtpk(b[2], b[3])};
    return *reinterpret_cast<bf16x8*>(&w);
}
template <class T> __device__ __forceinline__ bf16x8 load8(const T* p) {
    if constexpr (same_t<T, float>::v) { return pack8(*(const f32x4*)p, *(const f32x4*)(p + 4)); }
    else { return *reinterpret_cast<const bf16x8*>(p); }
}
__device__ __forceinline__ void mask_tile(f32x16& p0, f32x16& p1, int dq, unsigned W) {
    const float NEG = -__builtin_inff();
#pragma unroll
    for (int r = 0; r < 16; ++r) {
        const int c = (r & 3) + 8 * (r >> 2);
        if ((unsigned)(dq - c) >= W) p0[r] = NEG;
        if ((unsigned)(dq - c - 32) >= W) p1[r] = NEG;
    }
}
__device__ __forceinline__ void partialSM(f32x16& p0, f32x16& p1, float& m_reg, float& mn, float& alpha) {
    float pmax = p0[0]; for (int r = 1; r < 16; ++r) pmax = fmaxf(pmax, p0[r]); for (int r = 0; r < 16; ++r) pmax = fmaxf(pmax, p1[r]);
    { auto rr = __builtin_amdgcn_permlane32_swap(__float_as_uint(pmax), __float_as_uint(pmax), false, false);
      pmax = fmaxf(__uint_as_float(rr[0]), __uint_as_float(rr[1])); }
    constexpr float C2 = 1.4426950408889634f * SCALE;
    if (__builtin_expect(__all((pmax - m_reg) * SCALE <= THR), 1)) { mn = m_reg; alpha = 1.f; }
    else { mn = fmaxf(m_reg, pmax); alpha = __builtin_amdgcn_exp2f((m_reg - mn) * C2); m_reg = mn; }
    const float mnL = -mn * C2;
    for (int r = 0; r < 16; ++r) p0[r] = fmaf(p0[r], C2, mnL); for (int r = 0; r < 16; ++r) p1[r] = fmaf(p1[r], C2, mnL);
    for (int r = 0; r < 16; ++r) p0[r] = __builtin_amdgcn_exp2f(p0[r]);
}
__device__ __forceinline__ void finishSM(f32x16& p0, f32x16& p1, float alpha, float& l_reg, bf16x8& pa0, bf16x8& pa1, bf16x8& pa2, bf16x8& pa3) {
    for (int r = 0; r < 16; ++r) p1[r] = __builtin_amdgcn_exp2f(p1[r]);
    float ps = 0; for (int r = 0; r < 16; ++r) ps += p0[r]; for (int r = 0; r < 16; ++r) ps += p1[r];
    { auto rr = __builtin_amdgcn_permlane32_swap(__float_as_uint(ps), __float_as_uint(ps), false, false);
      ps = __uint_as_float(rr[0]) + __uint_as_float(rr[1]); }
    l_reg = l_reg * alpha + ps;
#define PK4(P, B_, OUT) do { unsigned a0 = cvtpk(P[B_+0], P[B_+1]), a1 = cvtpk(P[B_+2], P[B_+3]);                          \
        unsigned b0 = cvtpk(P[B_+4], P[B_+5]), b1 = cvtpk(P[B_+6], P[B_+7]);                                             \
        auto r0 = __builtin_amdgcn_permlane32_swap(a0, b0, false, false); auto r1 = __builtin_amdgcn_permlane32_swap(a1, b1, false, false); \
        u32x4 w = {r0[0], r1[0], r0[1], r1[1]}; OUT = *reinterpret_cast<bf16x8*>(&w); } while (0)
    PK4(p0, 0, pa0); PK4(p0, 8, pa1); PK4(p1, 0, pa2); PK4(p1, 8, pa3);
#undef PK4
}
template <int KB, bool SK>
__device__ __forceinline__ void qkt(f32x16& p0, f32x16& p1, const char* K_lds, int r32, int hi, const bf16x8* qr, bool act) {
    if (SK && !act) { const float NEG = -__builtin_inff();
#pragma unroll
        for (int r = 0; r < 16; ++r) { p0[r] = NEG; p1[r] = NEG; } return; }
    { const f32x16* bp = reinterpret_cast<const f32x16*>(K_lds - 2 * SHM_V + LDS_BIAS + KB * 256 + hi * 128); p0 = bp[0]; p1 = bp[1]; }
    const char* kb[4];
#pragma unroll
    for (int dd = 0; dd < 4; ++dd) kb[dd] = K_lds + KB * SHM_K + KSWZ(r32, (dd * 16 + hi * 8) * 2);
#pragma unroll
    for (int d0 = 0; d0 < 8; ++d0) { const char* a = kb[d0 & 3] + (d0 >> 2) * 128;
        bf16x8 b0 = *reinterpret_cast<const bf16x8*>(a);
        bf16x8 b1 = *reinterpret_cast<const bf16x8*>(a + 32 * 256);
        p0 = __builtin_amdgcn_mfma_f32_32x32x16_bf16(b0, qr[d0], p0, 0, 0, 0);
        p1 = __builtin_amdgcn_mfma_f32_32x32x16_bf16(b1, qr[d0], p1, 0, 0, 0); }
}
template <int VB, bool SK>
__device__ __forceinline__ void pv_tile(f32x16* o, int vb0, bf16x8 pa0, bf16x8 pa1, bf16x8 pa2, bf16x8 pa3, bool act) {
    if (SK && !act) return;
#define TRRD(dst, off) asm volatile("ds_read_b64_tr_b16 %0, %1 offset:%2" : "=&v"(dst) : "v"(vb0), "i"(off) : "memory")
#define PV_D0(d0) do { s16x4 l0, l1, l2, l3, h0, h1, h2, h3; constexpr int b_ = VB * SHM_V + v_rd_off(d0, 0, 0);     \
        TRRD(l0, b_); TRRD(h0, b_ + 2048); TRRD(l1, b_ + 4096); TRRD(h1, b_ + 6144); TRRD(l2, b_ + 8192); TRRD(h2, b_ + 10240); TRRD(l3, b_ + 12288); TRRD(h3, b_ + 14336); \
        asm volatile("s_waitcnt lgkmcnt(0)" ::: "memory"); SBAR();                 \
        o[d0] = __builtin_amdgcn_mfma_f32_32x32x16_bf16(pa0, (bf16x8){l0[0], l0[1], l0[2], l0[3], h0[0], h0[1], h0[2], h0[3]}, o[d0], 0, 0, 0);   \
        o[d0] = __builtin_amdgcn_mfma_f32_32x32x16_bf16(pa1, (bf16x8){l1[0], l1[1], l1[2], l1[3], h1[0], h1[1], h1[2], h1[3]}, o[d0], 0, 0, 0);   \
        o[d0] = __builtin_amdgcn_mfma_f32_32x32x16_bf16(pa2, (bf16x8){l2[0], l2[1], l2[2], l2[3], h2[0], h2[1], h2[2], h2[3]}, o[d0], 0, 0, 0);   \
        o[d0] = __builtin_amdgcn_mfma_f32_32x32x16_bf16(pa3, (bf16x8){l3[0], l3[1], l3[2], l3[3], h3[0], h3[1], h3[2], h3[3]}, o[d0], 0, 0, 0); } while (0)
    PV_D0(0); PV_D0(1); PV_D0(2); PV_D0(3);
#undef PV_D0
#undef TRRD
}

template <class TIn, class TOut> struct BlockRef { const TIn* Q; const TIn* K; const TIn* V; TOut* O; int P0; const float* Fb; const float* gain;
    int jlo, jhi;
    float* Op; float* ML; };
template <class TIn> struct Seam {
    bf16x8 qr[8];
    bf16x8 st_v0, st_v1, st_k0, st_k1; f32x4 sf0, sf1, sf2, sf3; float st_b;
    f32x4 tq[16];
};
__device__ __forceinline__ int swa_jlo(int P0, int W) { const int lowk = P0 - W + 1; return lowk > 0 ? lowk / KVBLK : 0; }
#define ROW(p, k0, rr) ((p) + (size_t)((k0) + (rr)) * PITCH + sc)
#define VMW() asm volatile("s_waitcnt vmcnt(0)" ::: "memory")
#define VMWN(n) asm volatile("s_waitcnt vmcnt(%0)" :: "i"(n) : "memory")
#define SLOAD_H(Kp, Vp, k0) SLOAD_HB(Kp, Vp, k0, cur)
#define SLOAD_HB(Kp, Vp, k0, blk) do { S.st_v0 = load8<TIn>(ROW(Vp, k0, sr)); S.st_v1 = load8<TIn>(ROW(Vp, k0, 32 + sr));              \
                         S.st_k0 = load8<TIn>(ROW(Kp, k0, sr)); S.st_k1 = load8<TIn>(ROW(Kp, k0, 32 + sr)); \
                         if (tid < 64) S.st_b = ((blk).Fb[(blk).P0] - (blk).Fb[(k0) + tid]) * (1.0f / SCALE); } while (0)
#define SWRITE_HK(bf) do { *(bf16x8*)(K_lds + (bf) * SHM_K + kws) = S.st_k0; *(bf16x8*)(K_lds + (bf) * SHM_K + kws + 32 * 256) = S.st_k1; \
                         if (tid < 64) *(float*)(K_lds - 2 * SHM_V + LDS_BIAS + (bf) * 256 + bws) = S.st_b; } while (0)
#define SWRITE_HV(bf) do { *(bf16x8*)(V_lds + (bf) * SHM_V + vst0) = S.st_v0; *(bf16x8*)(V_lds + (bf) * SHM_V + vst1) = S.st_v1; } while (0)
#define SWRITE_H(bf) do { SWRITE_HV(bf); SWRITE_HK(bf); } while (0)
#define SLOAD_F(p, k0) do { S.sf0 = *(const f32x4*)ROW(p, k0, sr); S.sf1 = *(const f32x4*)(ROW(p, k0, sr) + 4);                \
                            S.sf2 = *(const f32x4*)ROW(p, k0, 32 + sr); S.sf3 = *(const f32x4*)(ROW(p, k0, 32 + sr) + 4); } while (0)
#define SWRITE_KF(bf) do { *(bf16x8*)(K_lds + (bf) * SHM_K + kws) = pack8(S.sf0, S.sf1); *(bf16x8*)(K_lds + (bf) * SHM_K + kws + 32 * 256) = pack8(S.sf2, S.sf3); } while (0)
#define SWRITE_VF(bf) do { *(bf16x8*)(V_lds + (bf) * SHM_V + vst0) = pack8(S.sf0, S.sf1); *(bf16x8*)(V_lds + (bf) * SHM_V + vst1) = pack8(S.sf2, S.sf3); } while (0)
template <class TIn, class TOut>
__device__ __forceinline__ void causal_swa_prime(const BlockRef<TIn, TOut>& cur, int W, char* lds, Seam<TIn>& S) {
    constexpr bool F32 = same_t<TIn, float>::v;
    const int tid = threadIdx.x, wid = __builtin_amdgcn_readfirstlane(tid >> 6), lane = tid & 63, r32 = lane & 31, hi = lane >> 5;
    const int sr = tid >> 4, sc = (tid & 15) * 8, kws = KSWZ(sr, sc * 2); char* K_lds = lds + 2 * SHM_V;
    const int bws = bias_slot(tid & 63) * 4;
    const int kb0 = cur.jlo * KVBLK;
    for (int d0 = 0; d0 < 8; ++d0) S.qr[d0] = load8<TIn>(cur.Q + (size_t)(wid * QBLK + r32) * PITCH + d0 * 16 + hi * 8);
    if constexpr (F32) { SLOAD_F((const float*)cur.K, kb0); VMW(); SWRITE_KF(0); SBAR(); SLOAD_F((const float*)cur.V, kb0); }
    else { SLOAD_H(cur.K, cur.V, kb0); VMW(); SWRITE_HK(0); }
    __syncthreads();
}
template <class TIn, class TOut>
__device__ __forceinline__ void causal_swa_block(const BlockRef<TIn, TOut>& cur, const BlockRef<TIn, TOut>& nxt, int skv, int W, char* lds, Seam<TIn>& S) {
    constexpr bool F32 = same_t<TIn, float>::v;
    const int tid = threadIdx.x, wid = __builtin_amdgcn_readfirstlane(tid >> 6), lane = tid & 63, r32 = lane & 31, hi = lane >> 5;
    const int j_lo = cur.jlo; const int j_hi = cur.jhi;
    const int NT = j_hi - j_lo;
    const int kbn = nxt.jlo * KVBLK;
    const int qlo = cur.P0 + wid * QBLK, qm = qlo + r32 - 4 * hi;
    char* V_lds = lds; char* K_lds = lds + 2 * SHM_V;
    float* ws = (float*)(lds + 2 * SHM_V + 2 * SHM_K) + wid * 64; float* li_l = ws, * al_l = ws + 32;
    float m_reg = -1e30f, l_reg = 0; f32x16 o[4] = {};
    const int sr = tid >> 4, sc = (tid & 15) * 8, vst0 = v_st(sr, sc), vst1 = v_st(32 + sr, sc), kws = KSWZ(sr, sc * 2);
    const int bws = bias_slot(tid & 63) * 4;
    const int vb0 = (int)(uintptr_t)V_lds + v_rd_base(lane);
    const TIn* Kh = cur.K; const TIn* Vh = cur.V;
#define RESC(a) do { if (__any((a) < 1.f)) { if (hi == 0) al_l[r32] = (a); asm volatile("s_waitcnt lgkmcnt(0)" ::: "memory");              \
                     for (int d_ = 0; d_ < 4; ++d_) for (int r = 0; r < 16; ++r) o[d_][r] *= al_l[crow(r, hi)]; } } while (0)
#define KBASE(t) ((j_lo + (t)) * KVBLK)
#define ACT(t) (KBASE(t) <= qlo + QBLK - 1 && KBASE(t) + KVBLK - 1 >= qlo - W + 1)
#define MASKT(P0_, P1_, t) do { const int kb_ = KBASE(t); if ((!SK || ACT(t)) && (kb_ + KVBLK - 1 > qlo || kb_ <= qlo + QBLK - 1 - W)) mask_tile(P0_, P1_, qm - kb_, (unsigned)W); } while (0)
    constexpr int NQL = F32 ? 16 : 8;
    constexpr bool SK = WSKIP && !F32;
#define SEAM_K0() do { VMWN(NQL); if constexpr (F32) { SWRITE_KF(0); SBAR(); SLOAD_F((const float*)nxt.V, kbn); } else { SWRITE_HK(0); } SBAR(); } while (0)
    f32x16 pA0, pA1, pB0, pB1; float mnA, mnB, alA, alB; bf16x8 pa0, pa1, pa2, pa3;
    if constexpr (F32) { VMW(); SWRITE_VF(0); SBAR(); } else { SWRITE_HV(0); SBAR(); }
    if (NT > 1) { if constexpr (F32) SLOAD_F((const float*)Kh, KBASE(1)); else SLOAD_H(Kh, Vh, KBASE(1)); }
    SBAR(); qkt<0, SK>(pA0, pA1, K_lds, r32, hi, S.qr, ACT(0));
    if constexpr (F32) { if (NT > 1) { VMW(); SWRITE_KF(1); SBAR(); SLOAD_F((const float*)Vh, KBASE(1)); } }
    MASKT(pA0, pA1, 0); partialSM(pA0, pA1, m_reg, mnA, alA);
    if (NT > 1) { VMW(); if constexpr (F32) { SWRITE_VF(1); SBAR(); if (NT > 2) SLOAD_F((const float*)Kh, KBASE(2)); } else SWRITE_H(1); }
    __syncthreads();
#define HALF_STEP(PX0, PX1, mnX, alX, PY0, PY1, alY, t, KB, VB, SB) do {                                                      \
        SBAR(); qkt<KB, SK>(PX0, PX1, K_lds, r32, hi, S.qr, ACT(t));                                             \
        finishSM(PY0, PY1, alY, l_reg, pa0, pa1, pa2, pa3); SBAR();                                                           \
        if ((t) + 1 < NT) { if constexpr (F32) { VMW(); SWRITE_KF(SB); SBAR(); SLOAD_F((const float*)Vh, KBASE((t) + 1)); }  \
                            else { SLOAD_H(Kh, Vh, KBASE((t) + 1)); } SBAR(); }                                               \
        pv_tile<VB, SK>(o, vb0, pa0, pa1, pa2, pa3, ACT((t) - 1)); MASKT(PX0, PX1, (t)); partialSM(PX0, PX1, m_reg, mnX, alX);                                        \
        __syncthreads();                                                                                                      \
        if ((t) + 1 < NT) { VMW(); if constexpr (F32) { SWRITE_VF(SB); SBAR(); if ((t) + 2 < NT) SLOAD_F((const float*)Kh, KBASE((t) + 2)); } \
                            else { SWRITE_H(SB); } }                                                                          \
        RESC(alX); __syncthreads(); } while (0)
    for (int t = 1; t + 1 < NT; t += 2) {
        HALF_STEP(pB0, pB1, mnB, alB, pA0, pA1, alA, t, 1, 0, 0);
        HALF_STEP(pA0, pA1, mnA, alA, pB0, pB1, alB, t + 1, 0, 1, 1);
    }
    const bool even = (NT & 1) == 0;
    if (even) { SBAR(); qkt<1, SK>(pB0, pB1, K_lds, r32, hi, S.qr, ACT(NT - 1)); SBAR(); }
#define QROW(e) (nxt.Q + (size_t)(wid * QBLK + r32) * PITCH + ((e) >> 1) * 16 + hi * 8 + ((e) & 1) * 4)
    if constexpr (F32) { SLOAD_F((const float*)nxt.K, kbn); SBAR();
#pragma unroll
        for (int e = 0; e < 8; ++e) S.tq[e] = *(const f32x4*)QROW(e); }
    else { SLOAD_HB(nxt.K, nxt.V, kbn, nxt); SBAR();
#pragma unroll
        for (int d0 = 0; d0 < 8; ++d0) S.qr[d0] = load8<TIn>(nxt.Q + (size_t)(wid * QBLK + r32) * PITCH + d0 * 16 + hi * 8); }
    SBAR();
    finishSM(pA0, pA1, alA, l_reg, pa0, pa1, pa2, pa3); SBAR();
    if constexpr (F32) {
#pragma unroll
        for (int e = 8; e < 16; ++e) S.tq[e] = *(const f32x4*)QROW(e); SBAR(); }
#undef QROW
    pv_tile<0, SK>(o, vb0, pa0, pa1, pa2, pa3, ACT(even ? NT - 2 : NT - 1));
    if (even) { MASKT(pB0, pB1, NT - 1); partialSM(pB0, pB1, m_reg, mnB, alB); __syncthreads(); RESC(alB);
        finishSM(pB0, pB1, alB, l_reg, pa0, pa1, pa2, pa3); SBAR(); pv_tile<1, SK>(o, vb0, pa0, pa1, pa2, pa3, ACT(NT - 1)); }
    SBAR(); SEAM_K0();
    if (hi == 0) li_l[r32] = l_reg; asm volatile("s_waitcnt lgkmcnt(0)" ::: "memory");
    if (cur.Op != nullptr) {
        int rp = r32; asm volatile("" : "+v"(rp));
        if (hi == 0) { float2 mlv; mlv.x = m_reg; mlv.y = l_reg; *(float2*)(cur.ML + 2 * (wid * QBLK + rp)) = mlv; }
        float* Pr = cur.Op + (size_t)(wid * QBLK + 4 * hi) * D + rp;
#pragma unroll
        for (int r = 0; r < 16; ++r) {
#pragma unroll
            for (int d0 = 0; d0 < 4; ++d0) Pr[d0 * 32] = o[d0][r];
            Pr += ((r & 3) == 3 ? 5 : 1) * D; asm volatile("" : "+v"(Pr) :: "memory"); }
    } else {
    int ro = r32; asm volatile("" : "+v"(ro));
    TOut* Or = cur.O + (size_t)(wid * QBLK + 4 * hi) * OPITCH + ro;
    float gn[4];
#pragma unroll
    for (int d0 = 0; d0 < 4; ++d0) gn[d0] = cur.gain[d0 * 32 + ro];
#pragma unroll
    for (int r = 0; r < 16; ++r) { const int orow = crow(r, hi); const float rl = __builtin_amdgcn_rcpf(li_l[orow]);
        float v[4]; float ss = 0.f;
#pragma unroll
        for (int d0 = 0; d0 < 4; ++d0) { v[d0] = o[d0][r] * rl; ss += v[d0] * v[d0]; }
        ss += __shfl_xor(ss, 1); ss += __shfl_xor(ss, 2); ss += __shfl_xor(ss, 4); ss += __shfl_xor(ss, 8); ss += __shfl_xor(ss, 16);
        const float rn = __builtin_amdgcn_rsqf(ss * (1.0f / 128.0f) + 1e-6f);
#pragma unroll
        for (int d0 = 0; d0 < 4; ++d0) { const float vv = v[d0] * rn * gn[d0]; const float vn = __shfl_xor(vv, 1);
            if ((ro & 1) == 0) *(unsigned*)(Or + d0 * 32) = cvtpk(vv, vn); }
        Or += ((r & 3) == 3 ? 5 : 1) * OPITCH; asm volatile("" : "+v"(Or) :: "memory"); }
    }
    if constexpr (F32) {
#pragma unroll
        for (int d0 = 0; d0 < 8; ++d0) S.qr[d0] = pack8(S.tq[2 * d0], S.tq[2 * d0 + 1]); }
    __syncthreads();
#undef RESC
#undef KBASE
#undef ACT
#undef MASKT
#undef SEAM_K0
#undef HALF_STEP
}
#undef ROW
#undef VMW
#undef VMWN
#undef SLOAD_H
#undef SWRITE_HK
#undef SWRITE_HV
#undef SWRITE_H
#undef SLOAD_F
#undef SWRITE_KF
#undef SWRITE_VF

}
namespace mk {
typedef short s16x8 __attribute__((ext_vector_type(8)));
#define MFMA32(a, b, c) __builtin_amdgcn_mfma_f32_32x32x16_bf16((a), (b), (c), 0, 0, 0)
__device__ __forceinline__ int crow32(int r, int hi) { return (r & 3) + 8 * (r >> 2) + 4 * hi; }
constexpr float SCALEQ = 0.08838834764831845f;
__device__ __forceinline__ float wave_scan_add(float v, int lane) {
#pragma unroll
    for (int o = 1; o < 64; o <<= 1) { const float t = __shfl_up(v, o); if (lane >= o) v += t; }
    return v;
}
__device__ __forceinline__ float wave_scan_max(float v, int lane) {
#pragma unroll
    for (int o = 1; o < 64; o <<= 1) { const float t = __shfl_up(v, o); if (lane >= o) v = fmaxf(v, t); }
    return v;
}
__device__ __forceinline__ float wave_max(float v) {
#pragma unroll
    for (int o = 1; o < 64; o <<= 1) v = fmaxf(v, __shfl_xor(v, o));
    return v;
}
constexpr int TSTR = 72;
template <bool SCALED>
__device__ __forceinline__ void stage_transposed(const bf16* src, int ncols, LAS bf16* T, const LAS float* wl, int tid) {
    const int cpr = ncols / 8;
    for (int q = tid; q < 64 * cpr; q += NTHR) { const int s = q / cpr, c8 = (q % cpr) * 8;
        const v4u raw = *(const GAS v4u*)(src + (size_t)s * NPP + c8);
        const unsigned w4[4] = {raw.x, raw.y, raw.z, raw.w};
#pragma unroll
        for (int j = 0; j < 4; ++j) { unsigned lo = w4[j] & 0xffffu, hi = w4[j] >> 16;
            if (SCALED) { const float sc = wl[s]; lo = f2bf(bf2f((unsigned short)lo) * sc); hi = f2bf(bf2f((unsigned short)hi) * sc); }
            T[(c8 + 2 * j) * TSTR + s] = (bf16)lo; T[(c8 + 2 * j + 1) * TSTR + s] = (bf16)hi; } }
}
__device__ __forceinline__ void p3_prep(Frame& F) {
    const int gw = F.vcu * NWAVES + F.wave, NGW = F.G * NWAVES, lane = F.lane, tid = F.tid;
    bf16* proj = wsp<bf16>(F, WS_PROJ); const float* gates = wsp<float>(F, WS_GATES);
    {
        const int seg = lane >> 2, qd = (lane & 3) * 32; const float* gn = (seg < 8 ? F.in[IN_FOXQN] : F.in[IN_FOXKN]) + qd;
        for (int m = gw; m < S; m += NGW) {
            bf16* p = proj + (size_t)m * NPP + C_FQ + seg * 128 + qd; v4u raw[4]; float x[32]; float ss = 0.f;
#pragma unroll
            for (int j = 0; j < 4; ++j) raw[j] = *(const GAS v4u*)(p + 8 * j);
#pragma unroll
            for (int j = 0; j < 4; ++j) { const unsigned w4[4] = {raw[j].x, raw[j].y, raw[j].z, raw[j].w};
#pragma unroll
                for (int i = 0; i < 4; ++i) { x[8 * j + 2 * i] = bf2f((unsigned short)(w4[i] & 0xffffu)); x[8 * j + 2 * i + 1] = bf2f((unsigned short)(w4[i] >> 16)); } }
#pragma unroll
            for (int i = 0; i < 32; ++i) ss += x[i] * x[i];
            ss += __shfl_xor(ss, 1); ss += __shfl_xor(ss, 2);
            const float r = rsqrtf(ss * (1.f / 128.f) + 1e-6f);
#pragma unroll
            for (int j = 0; j < 4; ++j) { v4u o; const f32x4 g0 = *(const GAS f32x4*)(gn + 8 * j), g1 = *(const GAS f32x4*)(gn + 8 * j + 4);
                o.x = pk2(x[8 * j] * r * g0.x, x[8 * j + 1] * r * g0.y); o.y = pk2(x[8 * j + 2] * r * g0.z, x[8 * j + 3] * r * g0.w);
                o.z = pk2(x[8 * j + 4] * r * g1.x, x[8 * j + 5] * r * g1.y); o.w = pk2(x[8 * j + 6] * r * g1.z, x[8 * j + 7] * r * g1.w);
                *(GAS v4u*)(p + 8 * j) = o; }
        }
    }
    if (blockIdx.x < 8) {
        const int h = blockIdx.x; const float b = F.in[IN_FOXBF][h]; float* Fo = wsp<float>(F, WS_F) + h * S;
        LAS double* tot = (LAS double*)(F.lds + RING_OFF);
        double loc[16]; double acc = 0.0;
#pragma unroll
        for (int i = 0; i < 16; ++i) { acc += (double)log_sigmoid_f(gates[(size_t)(tid * 16 + i) * 16 + 8 + h] + b); loc[i] = acc; }
        tot[tid] = acc;
        __syncthreads();
        if (F.wave == 0) { double v[8]; double s = 0.0;
#pragma unroll
            for (int i = 0; i < 8; ++i) { v[i] = tot[lane * 8 + i]; s += v[i]; }
            double inc = s;
#pragma unroll
            for (int o = 1; o < 64; o <<= 1) { const double t = __shfl_up(inc, o); if (lane >= o) inc += t; }
            double ex = inc - s;
#pragma unroll
            for (int i = 0; i < 8; ++i) { tot[lane * 8 + i] = ex; ex += v[i]; } }
        __syncthreads();
        const double off = tot[tid];
        LAS float* Fl = (LAS float*)(F.lds + RING_OFF + 8192);
#pragma unroll
        for (int i = 0; i < 16; ++i) { const float fv = (float)(off + loc[i]); Fo[tid * 16 + i] = fv; Fl[tid * 16 + i] = fv; }
        __syncthreads();
        if (tid < 32) {
            float gq = 0.f, gk = 0.f;
            for (int d = 0; d < 128; ++d) { gq = fmaxf(gq, fabsf(F.in[IN_FOXQN][d])); gk = fmaxf(gk, fabsf(F.in[IN_FOXKN][d])); }
            const float thr = 2.f * 11.3137085f * gq * gk + 26.f;
            const int qb = tid, P0 = qb * 256; const float f0 = Fl[P0];
            int lo = 0, hi2 = 4 * qb;
            while (lo < hi2) { const int mid = (lo + hi2) >> 1; if (Fl[64 * mid + 63] - f0 <= thr) hi2 = mid; else lo = mid + 1; }
            wsp<int>(F, WS_JLO)[h * 32 + qb] = lo;
        }
        __syncthreads();
    }
    {
        LAS bf16* KT = (LAS bf16*)(F.lds + RING_OFF);
        LAS bf16* VT = KT + 128 * TSTR;
        LAS float* wl = (LAS float*)(VT + 256 * TSTR);
        float* UL = wsp<float>(F, WS_UL); float* NL = wsp<float>(F, WS_NL); float* GLAL = wsp<float>(F, WS_GLAL);
        const int hi = lane >> 5, l31 = lane & 31, w = F.wave;
        for (int u = F.vcu; u < 4 * NCH; u += F.G) {
            const int h = u >> 7, ch = u & 127, t0 = ch * LCH;
            if (w == 0) {
                const float ip = softcap_f(gates[(size_t)(t0 + lane) * 16 + h] + F.in[IN_BI][h]);
                const float fp = softcap_f(gates[(size_t)(t0 + lane) * 16 + 4 + h] + F.in[IN_BF][h]);
                const float g = wave_scan_add(log_sigmoid_f(fp), lane), a = ip - g, amax = wave_max(a);
                wl[lane] = __expf(a - amax);
                if (lane == 63) { GLAL[u * 2] = g; GLAL[u * 2 + 1] = amax; }
            }
            __syncthreads();
            stage_transposed<true>(proj + (size_t)t0 * NPP + C_MK + h * 128, 128, KT, wl, tid);
            stage_transposed<false>(proj + (size_t)t0 * NPP + C_MV + h * 256, 256, VT, wl, tid);
            __syncthreads();
            f32x16 acc[4];
#pragma unroll
            for (int dt = 0; dt < 4; ++dt)
#pragma unroll
                for (int r = 0; r < 16; ++r) acc[dt][r] = 0.f;
#pragma unroll
            for (int ks = 0; ks < 4; ++ks) { const s16x8 a = *(const LAS s16x8*)(VT + (32 * w + l31) * TSTR + 16 * ks + 8 * hi);
#pragma unroll
                for (int dt = 0; dt < 4; ++dt) { const s16x8 b = *(const LAS s16x8*)(KT + (32 * dt + l31) * TSTR + 16 * ks + 8 * hi); acc[dt] = MFMA32(a, b, acc[dt]); } }
            float* ut = UL + (size_t)u * 256 * 128;
#pragma unroll
            for (int dt = 0; dt < 4; ++dt)
#pragma unroll
                for (int r = 0; r < 16; ++r) ut[(size_t)(32 * w + crow32(r, hi)) * 128 + 32 * dt + l31] = acc[dt][r];
            if (tid < 128) { float s = 0.f;
#pragma unroll
                for (int j = 0; j < 8; ++j) { const s16x8 kv = *(const LAS s16x8*)(KT + tid * TSTR + 8 * j);
#pragma unroll
                    for (int i = 0; i < 8; ++i) s += bf2f((unsigned short)kv[i]); }
                NL[u * 128 + tid] = s; }
            __syncthreads();
        }
    }
}
__device__ __forceinline__ void p4_scan(Frame& F) {
    LAS float* gl = (LAS float*)(F.lds + RING_OFF);
    LAS float* dec = gl + 256; LAS float* scl = dec + 128; LAS float* mv = scl + 128;
    const float* UL = wsp<float>(F, WS_UL); const float* NL = wsp<float>(F, WS_NL); const float* GLAL = wsp<float>(F, WS_GLAL);
    bf16* CS = wsp<bf16>(F, WS_CS); float* NS = wsp<float>(F, WS_NS); float* MS = wsp<float>(F, WS_MS);
    const int tid = F.tid;
    for (int blk = F.vcu; blk < 4 * 64; blk += F.G) {
        const int h = blk >> 6, rem0 = (blk & 63) * 512;
        if (tid < 256) gl[tid] = GLAL[h * 256 + tid];
        __syncthreads();
        if (tid == 0) { float m = 0.f;
            for (int c = 0; c < NCH; ++c) { const float g = gl[2 * c], al = gl[2 * c + 1], mn = g + fmaxf(m, al);
                mv[c] = m; dec[c] = __expf(g + m - mn); scl[c] = __expf(g + al - mn); m = mn; } }
        __syncthreads();
        if (rem0 == 0 && tid < 128) MS[h * 128 + tid] = mv[tid];
        const int rem = rem0 + tid;
        const float* ul = UL + (size_t)h * NCH * 32768 + rem; bf16* cs = CS + (size_t)h * NCH * 32768 + rem;
        float C = 0.f;
#pragma unroll 32
        for (int c = 0; c < NCH; ++c) { cs[(size_t)c * 32768] = (bf16)f2bf(C); C = dec[c] * C + scl[c] * ul[(size_t)c * 32768]; }
        if (rem0 == 0 && tid < 128) { float n = 0.f; const float* nl = NL + (size_t)h * NCH * 128 + tid; float* ns = NS + (size_t)h * NCH * 128 + tid;
#pragma unroll 8
            for (int c = 0; c < NCH; ++c) { ns[c * 128] = n; n = dec[c] * n + scl[c] * nl[c * 128]; } }
        __syncthreads();
    }
}
constexpr int NUMSTR = 260;
__device__ __forceinline__ void p5_mlstm_out(Frame& F) {
    LAS bf16* VT = (LAS bf16*)(F.lds + RING_OFF);
    LAS bf16* Pm = VT + 256 * TSTR;
    LAS float* NUM = (LAS float*)(Pm + 64 * TSTR);
    LAS float* a_s = NUM + 64 * NUMSTR; LAS float* Mt = a_s + 64; LAS float* inter = Mt + 64; LAS float* emt = inter + 64; LAS float* qn = emt + 64; LAS float* dinv = qn + 64;
    const bf16* proj = wsp<bf16>(F, WS_PROJ); const float* gates = wsp<float>(F, WS_GATES); const bf16* CS = wsp<bf16>(F, WS_CS);
    const float* NS = wsp<float>(F, WS_NS); const float* MS = wsp<float>(F, WS_MS); bf16* concat = wsp<bf16>(F, WS_CONCAT);
    const int tid = F.tid, lane = F.lane, w = F.wave, hi = lane >> 5, l31 = lane & 31;
    for (int u = F.vcu; u < 4 * NCH; u += F.G) {
        const int h = u >> 7, ch = u & 127, t0 = ch * LCH;
        const bf16* qbase = proj + (size_t)t0 * NPP + C_MQ + h * 128; const bf16* kbase = proj + (size_t)t0 * NPP + C_MK + h * 128;
        if (w == 0) {
            const float ip = softcap_f(gates[(size_t)(t0 + lane) * 16 + h] + F.in[IN_BI][h]);
            const float fp = softcap_f(gates[(size_t)(t0 + lane) * 16 + 4 + h] + F.in[IN_BF][h]);
            const float g = wave_scan_add(log_sigmoid_f(fp), lane), a = ip - g, cm = wave_scan_max(a, lane);
            const float mp = MS[u], M = fmaxf(mp, cm);
            a_s[lane] = a; Mt[lane] = M; inter[lane] = __expf(mp - M); emt[lane] = __expf(-(g + M));
        }
        stage_transposed<false>(proj + (size_t)t0 * NPP + C_MV + h * 256, 256, VT, a_s, tid);
        __syncthreads();
        if (w < 4) {
            const int ti = w >> 1, si = w & 1;
            if (si <= ti) {
                s16x8 qa[8], kb[8];
#pragma unroll
                for (int ks = 0; ks < 8; ++ks) { qa[ks] = *(const GAS s16x8*)(qbase + (size_t)(32 * ti + l31) * NPP + 16 * ks + 8 * hi); kb[ks] = *(const GAS s16x8*)(kbase + (size_t)(32 * si + l31) * NPP + 16 * ks + 8 * hi); }
                f32x16 acc;
#pragma unroll
                for (int r = 0; r < 16; ++r) acc[r] = 0.f;
#pragma unroll
                for (int ks = 0; ks < 8; ++ks) acc = MFMA32(qa[ks], kb[ks], acc);
                const int s = 32 * si + l31; const float as = a_s[s];
#pragma unroll
                for (int r = 0; r < 16; ++r) { const int t = 32 * ti + crow32(r, hi); const float p = (s <= t) ? acc[r] * SCALEQ * __expf(as - Mt[t]) : 0.f; Pm[t * TSTR + s] = (bf16)f2bf(p); }
            } else {
#pragma unroll
                for (int r = 0; r < 16; ++r) Pm[(32 * ti + crow32(r, hi)) * TSTR + 32 * si + l31] = (bf16)0;
            }
        } else {
            const int t = (tid - 256) >> 2, d0 = ((tid - 256) & 3) * 32; float s = 0.f; const float* np = NS + (size_t)u * 128 + d0;
#pragma unroll
            for (int j = 0; j < 4; ++j) { const s16x8 qv = *(const GAS s16x8*)(qbase + (size_t)t * NPP + d0 + 8 * j);
#pragma unroll
                for (int i = 0; i < 8; ++i) s += bf2f((unsigned short)qv[i]) * np[8 * j + i]; }
            s += __shfl_xor(s, 1); s += __shfl_xor(s, 2);
            if ((tid & 3) == 0) qn[t] = s * SCALEQ;
        }
        __syncthreads();
        f32x16 accP[2], accC[2];
#pragma unroll
        for (int ti = 0; ti < 2; ++ti)
#pragma unroll
            for (int r = 0; r < 16; ++r) { accP[ti][r] = 0.f; accC[ti][r] = 0.f; }
        {
            const bf16* cs = CS + (size_t)u * 32768 + (size_t)(32 * w + l31) * 128 + 8 * hi;
            s16x8 cb[8];
#pragma unroll
            for (int ks = 0; ks < 8; ++ks) cb[ks] = *(const GAS s16x8*)(cs + 16 * ks);
#pragma unroll
            for (int ti = 0; ti < 2; ++ti) {
                s16x8 qa[8];
#pragma unroll
                for (int ks = 0; ks < 8; ++ks) qa[ks] = *(const GAS s16x8*)(qbase + (size_t)(32 * ti + l31) * NPP + 16 * ks + 8 * hi);
#pragma unroll
                for (int ks = 0; ks < 8; ++ks) accC[ti] = MFMA32(qa[ks], cb[ks], accC[ti]);
            }
#pragma unroll
            for (int ks = 0; ks < 4; ++ks) { const s16x8 vb = *(const LAS s16x8*)(VT + (32 * w + l31) * TSTR + 16 * ks + 8 * hi);
#pragma unroll
                for (int ti = 0; ti < 2; ++ti) { const s16x8 pa = *(const LAS s16x8*)(Pm + (32 * ti + l31) * TSTR + 16 * ks + 8 * hi); accP[ti] = MFMA32(pa, vb, accP[ti]); } }
        }
        if (w == 0) {
            float rs = 0.f;
#pragma unroll
            for (int j = 0; j < 8; ++j) { const s16x8 pv = *(const LAS s16x8*)(Pm + lane * TSTR + 8 * j);
#pragma unroll
                for (int i = 0; i < 8; ++i) rs += bf2f((unsigned short)pv[i]); }
            const float dn = rs + inter[lane] * qn[lane];
            dinv[lane] = 1.f / fmaxf(fabsf(dn), emt[lane]);
        }
        __syncthreads();
#pragma unroll
        for (int ti = 0; ti < 2; ++ti)
#pragma unroll
            for (int r = 0; r < 16; ++r) { const int t = 32 * ti + crow32(r, hi); NUM[t * NUMSTR + 32 * w + l31] = (accP[ti][r] + inter[t] * SCALEQ * accC[ti][r]) * dinv[t]; }
        __syncthreads();
        {
            const f32x4 gn = *(const GAS f32x4*)(F.in[IN_MOUTN] + h * 256 + 4 * lane);
#pragma unroll
            for (int i = 0; i < 8; ++i) { const int t = 8 * w + i; const f32x4 x = *(const LAS f32x4*)(NUM + t * NUMSTR + 4 * lane);
                const float ss = wave_sum((x.x * x.x + x.y * x.y) + (x.z * x.z + x.w * x.w)); const float r = rsqrtf(ss * (1.f / 256.f) + 1e-6f);
                const u32x2 mo = *(const GAS u32x2*)(proj + (size_t)(t0 + t) * NPP + C_MO + h * 256 + 4 * lane);
                const float o0 = x.x * r * gn.x * sigmoid_f(bf2f((unsigned short)(mo.x & 0xffffu))), o1 = x.y * r * gn.y * sigmoid_f(bf2f((unsigned short)(mo.x >> 16)));
                const float o2 = x.z * r * gn.z * sigmoid_f(bf2f((unsigned short)(mo.y & 0xffffu))), o3 = x.w * r * gn.w * sigmoid_f(bf2f((unsigned short)(mo.y >> 16)));
                u32x2 ov; ov.x = pk2(o0, o1); ov.y = pk2(o2, o3);
                *(GAS u32x2*)(concat + (size_t)(t0 + t) * D + h * 256 + 4 * lane) = ov; }
        }
        __syncthreads();
    }
}
}
namespace mk {
__device__ __forceinline__ void attn_build_schedule(Frame& F) {
    LAS int* jl = (LAS int*)(F.lds + TAB_OFF); LAS int* pre = jl + 256; LAS int* wtot = pre + 260;
    const int tid = F.tid, lane = F.lane;
    if (tid < 256) { const int j = wsp<int>(F, WS_JLO)[tid]; jl[tid] = j; const int n = 4 * (tid & 31) + 4 - j; int v = (n + ATT_CH - 1) / ATT_CH;
        int inc = v;
#pragma unroll
        for (int o = 1; o < 64; o <<= 1) { const int t = __shfl_up(inc, o); if (lane >= o) inc += t; }
        pre[tid + 1] = inc; if (lane == 63) wtot[tid >> 6] = inc; }
    __syncthreads();
    if (tid < 256) { int add = 0; for (int w2 = 0; w2 < (tid >> 6); ++w2) add += wtot[w2]; pre[tid + 1] += add; if (tid == 0) pre[0] = 0; }
    __syncthreads();
}
__device__ __forceinline__ fox::BlockRef<fox::bf16, fox::bf16> fox_ref(const Frame& F, int I) {
    const LAS int* jl = (const LAS int*)(F.lds + TAB_OFF); const LAS int* pre = jl + 256;
    int b = 0;
#pragma unroll
    for (int st = 128; st >= 1; st >>= 1) if (pre[b + st] <= I) b += st;
    b = __builtin_amdgcn_readfirstlane(b);
    const int pb0 = __builtin_amdgcn_readfirstlane(pre[b]), pb1 = __builtin_amdgcn_readfirstlane(pre[b + 1]), j0 = __builtin_amdgcn_readfirstlane(jl[b]);
    const int h = b >> 5, qb = b & 31, part = I - pb0, P = pb1 - pb0, n = 4 * qb + 4 - j0;
    fox::BlockRef<fox::bf16, fox::bf16> r;
    const fox::bf16* proj = (const fox::bf16*)(F.ws + WS_PROJ);
    r.Q = proj + (size_t)(qb * 256) * fox::PITCH + C_FQ + h * 128; r.K = proj + C_FK + h * 128; r.V = proj + C_FV + h * 128;
    r.O = (fox::bf16*)(F.ws + WS_CONCAT) + (size_t)(qb * 256) * D + 1024 + h * 128; r.P0 = qb * 256;
    r.Fb = (const float*)(F.ws + WS_F) + h * S; r.gain = F.in[IN_FOUTN] + h * 128;
    r.jlo = j0 + (part * n) / P; r.jhi = j0 + ((part + 1) * n) / P;
    r.Op = P > 1 ? (float*)(F.ws + WS_OPART) + (size_t)I * 256 * 128 : nullptr; r.ML = (float*)(F.ws + WS_MLP) + (size_t)I * 512;
    return r;
}
__device__ __forceinline__ void p5_attention(Frame& F, char* ldsg) {
    typedef fox::BlockRef<fox::bf16, fox::bf16> BR;
    attn_build_schedule(F);
    const int total = __builtin_amdgcn_readfirstlane(((const LAS int*)(F.lds + TAB_OFF))[256 + 256]);
    int L = F.vcu; if (L >= total) return;
    BR cur = fox_ref(F, L);
    fox::Seam<fox::bf16> Sm;
    fox::causal_swa_prime<fox::bf16, fox::bf16>(cur, S, ldsg, Sm);
    for (;;) {
        const bool more = L + F.G < total;
        const BR nxt = more ? fox_ref(F, L + F.G) : cur;
        fox::causal_swa_block<fox::bf16, fox::bf16>(cur, nxt, S, S, ldsg, Sm);
        if (!more) break;
        cur = nxt; L += F.G;
    }
}
__device__ __forceinline__ void p6_combine(Frame& F) {
    attn_build_schedule(F);
    const LAS int* pre = (const LAS int*)(F.lds + TAB_OFF) + 256;
    const float* OP = wsp<float>(F, WS_OPART); const float* MLP = wsp<float>(F, WS_MLP); bf16* concat = wsp<bf16>(F, WS_CONCAT);
    const int gw = F.vcu * NWAVES + F.wave, NGW = F.G * NWAVES, lane = F.lane;
    constexpr float C2 = 1.4426950408889634f * SCALEQ;
    for (int idx = gw; idx < 256 * 256; idx += NGW) {
        const int b = idx >> 8, r = idx & 255, i0 = pre[b], P = pre[b + 1] - i0; if (P <= 1) continue;
        const int h = b >> 5, qb = b & 31;
        float ms = -3.0e38f;
        for (int p2 = 0; p2 < P; ++p2) ms = fmaxf(ms, MLP[(size_t)(i0 + p2) * 512 + 2 * r]);
        float n0 = 0.f, n1 = 0.f, den = 0.f;
        for (int p2 = 0; p2 < P; ++p2) { const f32x2 ml = *(const GAS f32x2*)(MLP + (size_t)(i0 + p2) * 512 + 2 * r); const float wgt = __builtin_amdgcn_exp2f((ml.x - ms) * C2);
            const f32x2 ov = *(const GAS f32x2*)(OP + ((size_t)(i0 + p2) * 256 + r) * 128 + 2 * lane); n0 += wgt * ov.x; n1 += wgt * ov.y; den += wgt * ml.y; }
        const float inv = 1.f / den, v0 = n0 * inv, v1 = n1 * inv;
        const float ss = wave_sum(v0 * v0 + v1 * v1), rn = rsqrtf(ss * (1.f / 128.f) + 1e-6f);
        const f32x2 gn = *(const GAS f32x2*)(F.in[IN_FOUTN] + h * 128 + 2 * lane);
        *(GAS unsigned*)(concat + (size_t)(qb * 256 + r) * D + 1024 + h * 128 + 2 * lane) = pk2(v0 * rn * gn.x, v1 * rn * gn.y);
    }
}
constexpr int RROWS = 8, NITER = S / RROWS;
__device__ __forceinline__ void p7_router(Frame& F) {
    LAS float* shs = (LAS float*)(F.lds + RING_OFF);
    LAS float* H2L = shs + 2 * D;
    LAS float* red = H2L + RROWS * D;
    LAS int* selE = (LAS int*)(red + 16 * RROWS * NE);
    const float* mod = wsp<float>(F, WS_MOD); const float* h1 = wsp<float>(F, WS_H1); unsigned char* h2 = wsp<unsigned char>(F, WS_HN);
    int* top_i = wsp<int>(F, WS_TOPI); float* top_w = wsp<float>(F, WS_TOPW); int* hist = wsp<int>(F, WS_HIST); int* lrank = wsp<int>(F, WS_LRANK);
    const int tid = F.tid, lane = F.lane, w = F.wave;
    for (int i = tid; i < 2 * D; i += NTHR) shs[i] = mod[3 * D + i];
    __syncthreads();
    float wreg[128];
    { const float* wp = F.in[IN_WR] + (size_t)((tid >> 5) * 128) * NE + (tid & 31);
#pragma unroll
        for (int k = 0; k < 128; ++k) wreg[k] = wp[k * NE]; }
    for (int it = F.vcu; it < NITER; it += F.G) {
        const int r0 = it * RROWS;
        {
            const int m = r0 + w; const GAS f32x4* xr = (const GAS f32x4*)(h1 + (size_t)m * D) + lane; f32x4 v[8]; float s2 = 0.f;
#pragma unroll
            for (int j = 0; j < 8; ++j) { v[j] = xr[64 * j]; s2 += (v[j].x * v[j].x + v[j].y * v[j].y) + (v[j].z * v[j].z + v[j].w * v[j].w); }
            const float r = rsqrtf(wave_sum(s2) * (1.f / D) + 1e-6f);
            GAS unsigned* o8 = (GAS unsigned*)(h2 + (size_t)m * D) + lane;
#pragma unroll
            for (int j = 0; j < 8; ++j) { const int c0 = 4 * lane + 256 * j; const f32x4 gg = *(const GAS f32x4*)(F.in[IN_NFFN] + c0); const f32x4 a = *(const LAS f32x4*)(shs + D + c0), b = *(const LAS f32x4*)(shs + c0);
                const f32x4 y = v[j] * r * gg * (a + 1.f) + b; o8[64 * j] = pk4_fp8(y.x, y.y, y.z, y.w);
                *(LAS f32x4*)(H2L + w * D + c0) = y; }
        }
        __syncthreads();
        {
            const int e = tid & 31, kp = tid >> 5; float acc[RROWS];
#pragma unroll
            for (int r = 0; r < RROWS; ++r) acc[r] = 0.f;
#pragma unroll
            for (int k4 = 0; k4 < 32; ++k4) {
#pragma unroll
                for (int r = 0; r < RROWS; ++r) { const f32x4 hv = *(const LAS f32x4*)(H2L + r * D + kp * 128 + k4 * 4); acc[r] += (hv.x * wreg[4 * k4] + hv.y * wreg[4 * k4 + 1]) + (hv.z * wreg[4 * k4 + 2] + hv.w * wreg[4 * k4 + 3]); }
            }
#pragma unroll
            for (int r = 0; r < RROWS; ++r) red[(kp * RROWS + r) * NE + e] = acc[r];
        }
        __syncthreads();
        if (tid < RROWS * NE) {
            const int r = tid >> 5, e = tid & 31; float lg = F.in[IN_BR][e];
#pragma unroll
            for (int kp = 0; kp < 16; ++kp) lg += red[(kp * RROWS + r) * NE + e];
            float cur = lg, mx = 0.f, sum = 0.f, mysel = 0.f; int myidx = 0;
#pragma unroll
            for (int q = 0; q < 4; ++q) { float best = cur; int bi = e;
#pragma unroll
                for (int o = 1; o < 32; o <<= 1) { const float ob = __shfl_xor(best, o); const int oi = __shfl_xor(bi, o); if (ob > best || (ob == best && oi < bi)) { best = ob; bi = oi; } }
                if (q == 0) mx = best;
                sum += __expf(best - mx);
                if (e == q) { mysel = best; myidx = bi; }
                if (e == bi) cur = -3.0e38f; }
            if (e < 4) { const int t = r0 + r; top_i[t * 4 + e] = myidx; top_w[t * 4 + e] = __expf(mysel - mx) / sum; selE[r * 4 + e] = myidx; }
        }
        __syncthreads();
        if (tid < 32) { const int me = selE[tid]; int rank = 0, cnt = 0;
#pragma unroll
            for (int p = 0; p < 32; ++p) { const int ep = selE[p]; rank += (ep == me && p < tid) ? 1 : 0; cnt += (ep == tid) ? 1 : 0; }
            lrank[it * 32 + tid] = rank; hist[it * NE + tid] = cnt; }
        __syncthreads();
    }
}
__device__ __forceinline__ void build_expert_table(Frame& F, const int* counts_g) {
    LAS int* tab = (LAS int*)(F.lds + TAB_OFF);
    if (F.tid == 0) { int acc = 0; for (int e = 0; e < NE; ++e) { const int c = counts_g[e]; tab[e] = acc; tab[40 + e] = c; acc += (c + 255) >> 8; } tab[32] = acc; }
    __syncthreads();
}
__device__ __forceinline__ void p8_gather(Frame& F) {
    LAS int* psum = (LAS int*)(F.lds + RING_OFF);
    LAS int* startr = psum + 16 * NE;
    LAS int* base = startr + NE;
    const int* hist = wsp<int>(F, WS_HIST); const int* lrank = wsp<int>(F, WS_LRANK); const int* top_i = wsp<int>(F, WS_TOPI); const float* top_w = wsp<float>(F, WS_TOPW);
    int* pos = wsp<int>(F, WS_POS); float* roww = wsp<float>(F, WS_ROWW); const unsigned char* h2 = wsp<unsigned char>(F, WS_HN); unsigned char* xg = wsp<unsigned char>(F, WS_XG);
    int* counts_g = (int*)(F.ws + WS_POS) + S * 4;
    const int tid = F.tid, lane = F.lane, w = F.wave;
    { const int e = tid & 31, part = tid >> 5; int s = 0; for (int i = 0; i < NITER / 16; ++i) s += hist[(part * (NITER / 16) + i) * NE + e]; psum[part * NE + e] = s; }
    __syncthreads();
    if (tid == 0) { int acc = 0; for (int e = 0; e < NE; ++e) { int c = 0; for (int p = 0; p < 16; ++p) c += psum[p * NE + e]; startr[e] = acc; acc += ((c + 255) >> 8) << 8; if (blockIdx.x == 0) counts_g[e] = c; } }
    __syncthreads();
    for (int it = F.vcu; it < NITER; it += F.G) {
        {
            const int part = it / (NITER / 16), i0 = part * (NITER / 16);
            if (w < 4) { const bool on = (i0 + lane) < it;
#pragma unroll
                for (int q = 0; q < 8; ++q) { const int e = w * 8 + q; int v = on ? hist[(i0 + lane) * NE + e] : 0;
#pragma unroll
                    for (int o = 1; o < 64; o <<= 1) v += __shfl_xor(v, o);
                    if (lane == 0) { int b = v; for (int pp = 0; pp < part; ++pp) b += psum[pp * NE + e]; base[e] = b; } } }
        }
        __syncthreads();
#pragma unroll
        for (int j = 0; j < 4; ++j) { const int p = w + 8 * j, pair = it * 32 + p, e = top_i[pair], dest = startr[e] + base[e] + lrank[pair], t = pair >> 2;
            if (lane == 0) { pos[pair] = dest; roww[dest] = top_w[pair]; }
            const GAS v4u* src = (const GAS v4u*)(h2 + (size_t)t * D) + lane; GAS v4u* dst = (GAS v4u*)(xg + (size_t)dest * D) + lane;
#pragma unroll
            for (int q = 0; q < 2; ++q) dst[64 * q] = src[64 * q]; }
        __syncthreads();
    }
}
struct GroupedOrder {
    const LAS int* tab; int ntn, G, c;
    __device__ __forceinline__ bool next(int i, Unit& u) const {
        const int L = i * G + c, total = tab[32] * ntn; if (L >= total) return false;
        int e = 0;
#pragma unroll 1
        while (e < NE - 1 && tab[e + 1] * ntn <= L) ++e;
        const int ts = tab[e], tc = tab[e + 1] - ts, within = L - ts * ntn;
        u.pm = ts + within % tc; u.pn = within / tc; u.e = e; u.pb = e * ntn + u.pn; return true;
    }
    __device__ __forceinline__ void a_ready(const Unit&) const {}
    __device__ __forceinline__ void done(const Unit&) const {}
};
struct EpiSwiglu {
    static constexpr bool PERM = true, AFTER_DRAIN = false;
    unsigned char* act; const float* bug;
    __device__ __forceinline__ void operator()(const pg8::f32x4 (&acc)[2][2][4][2], const Unit& u, int wr, int wc, int fr, int fq) const {
        const int row0 = u.pm * 256 + wr * 64 + fr, f0 = u.pn * 128 + wc * 32 + 8 * fq;
        const float* bg = bug + (size_t)u.e * 4096 + f0; pg8::f32x4 bgv[2], buv[2];
#pragma unroll
        for (int n = 0; n < 2; ++n) { bgv[n] = *(const pg8::f32x4*)(bg + 4 * n); buv[n] = *(const pg8::f32x4*)(bg + 2048 + 4 * n); }
#pragma unroll
        for (int ai = 0; ai < 2; ++ai)
#pragma unroll
            for (int m = 0; m < 4; ++m) { float o[8];
#pragma unroll
                for (int n = 0; n < 2; ++n)
#pragma unroll
                    for (int i = 0; i < 4; ++i) { const float g = fminf(acc[ai][0][m][n][i] + bgv[n][i], 7.f); const float up = fminf(fmaxf(acc[ai][1][m][n][i] + buv[n][i], -7.f), 7.f);
                        o[4 * n + i] = (up + 1.f) * g * __builtin_amdgcn_rcpf(1.f + __builtin_amdgcn_exp2f(-2.45546696f * g)); }
                u32x2 wv; wv.x = pk4_fp8(o[0], o[1], o[2], o[3]); wv.y = pk4_fp8(o[4], o[5], o[6], o[7]);
                *(u32x2*)(act + (size_t)(row0 + ai * 128 + m * 16) * FF + f0) = wv; }
    }
};
struct EpiDown {
    static constexpr bool PERM = true, AFTER_DRAIN = false;
    bf16* y; const float* bd; const float* roww;
    __device__ __forceinline__ void operator()(const pg8::f32x4 (&acc)[2][2][4][2], const Unit& u, int wr, int wc, int fr, int fq) const {
        const int row0 = u.pm * 256 + wr * 64 + fr, col0 = u.pn * 256 + wc * 32 + 8 * fq;
        pg8::f32x4 bv[2][2];
#pragma unroll
        for (int bj = 0; bj < 2; ++bj)
#pragma unroll
            for (int n = 0; n < 2; ++n) bv[bj][n] = *(const pg8::f32x4*)(bd + (size_t)u.e * D + col0 + bj * 128 + 4 * n);
#pragma unroll
        for (int ai = 0; ai < 2; ++ai)
#pragma unroll
            for (int m = 0; m < 4; ++m) { const int row = row0 + ai * 128 + m * 16; const float rw = roww[row]; bf16* rowp = y + (size_t)row * D + col0;
#pragma unroll
                for (int bj = 0; bj < 2; ++bj) { const pg8::f32x4 v0 = (acc[ai][bj][m][0] + bv[bj][0]) * rw, v1 = (acc[ai][bj][m][1] + bv[bj][1]) * rw;
                    pg8::u32x4 wv; wv.x = cvt_pk_bf16(v0[0], v0[1]); wv.y = cvt_pk_bf16(v0[2], v0[3]); wv.z = cvt_pk_bf16(v1[0], v1[1]); wv.w = cvt_pk_bf16(v1[2], v1[3]);
                    *(pg8::u32x4*)(rowp + bj * 128) = wv; } }
    }
};
__device__ __forceinline__ void p11_final(Frame& F, float oscale) {
    LAS float* ms = (LAS float*)(F.lds + RING_OFF);
    const float* mod = wsp<float>(F, WS_MOD);
    for (int i = F.tid; i < 3 * D; i += NTHR) ms[i] = mod[5 * D + i];
    __syncthreads();
    const float* h1 = wsp<float>(F, WS_H1); const bf16* y = wsp<bf16>(F, WS_Y); const int* pos = wsp<int>(F, WS_POS);
    const int gw = F.vcu * NWAVES + F.wave, NGW = F.G * NWAVES, lane = F.lane;
    for (int t = gw; t < S; t += NGW) {
        asm volatile("" ::: "memory");
        const GAS f32x4* xr = (const GAS f32x4*)(h1 + (size_t)t * D) + lane;
        const GAS u32x2* y0 = (const GAS u32x2*)(y + (size_t)pos[t * 4 + 0] * D) + lane; const GAS u32x2* y1 = (const GAS u32x2*)(y + (size_t)pos[t * 4 + 1] * D) + lane;
        const GAS u32x2* y2 = (const GAS u32x2*)(y + (size_t)pos[t * 4 + 2] * D) + lane; const GAS u32x2* y3 = (const GAS u32x2*)(y + (size_t)pos[t * 4 + 3] * D) + lane;
        f32x4 v[8]; float s2 = 0.f;
#pragma unroll
        for (int j = 0; j < 8; ++j) { const u32x2 a = y0[64 * j], b = y1[64 * j], c = y2[64 * j], d = y3[64 * j]; const f32x4 g2 = *(const LAS f32x4*)(ms + 4 * lane + 256 * j);
            f32x4 f;
            f.x = (bf2f((unsigned short)(a.x & 0xffffu)) + bf2f((unsigned short)(b.x & 0xffffu))) + (bf2f((unsigned short)(c.x & 0xffffu)) + bf2f((unsigned short)(d.x & 0xffffu)));
            f.y = (bf2f((unsigned short)(a.x >> 16)) + bf2f((unsigned short)(b.x >> 16))) + (bf2f((unsigned short)(c.x >> 16)) + bf2f((unsigned short)(d.x >> 16)));
            f.z = (bf2f((unsigned short)(a.y & 0xffffu)) + bf2f((unsigned short)(b.y & 0xffffu))) + (bf2f((unsigned short)(c.y & 0xffffu)) + bf2f((unsigned short)(d.y & 0xffffu)));
            f.w = (bf2f((unsigned short)(a.y >> 16)) + bf2f((unsigned short)(b.y >> 16))) + (bf2f((unsigned short)(c.y >> 16)) + bf2f((unsigned short)(d.y >> 16)));
            v[j] = xr[64 * j] + g2 * f; s2 += (v[j].x * v[j].x + v[j].y * v[j].y) + (v[j].z * v[j].z + v[j].w * v[j].w); }
        const float r = rsqrtf(wave_sum(s2) * (1.f / D) + 1e-6f);
        GAS f32x4* o = (GAS f32x4*)(F.out + (size_t)t * D) + lane;
#pragma unroll
        for (int j = 0; j < 8; ++j) { const int c0 = 4 * lane + 256 * j; const f32x4 gg = *(const GAS f32x4*)(F.in[IN_NFIN] + c0); const f32x4 sh = *(const LAS f32x4*)(ms + D + c0), sc = *(const LAS f32x4*)(ms + 2 * D + c0);
            o[64 * j] = (v[j] * r * gg * (sc + 1.f) + sh) * oscale; }
    }
}
}
namespace mk {
struct Args { const float* in[24]; float* out; unsigned char* ws; int ph_lo, ph_hi, li, pad; };
constexpr int N_PHASES = 13;
__global__ void __launch_bounds__(NTHR, 2) mega_fwd(Args args) {
    extern __shared__ __attribute__((aligned(16))) unsigned char lds[];
    Frame F;
    F.lds = (LAS unsigned char*)lds;
    F.MISC = (volatile LAS unsigned*)(F.lds + MISC_OFF);
    F.tid = threadIdx.x; F.lane = F.tid & 63; F.wave = __builtin_amdgcn_readfirstlane(F.tid >> 6);
    F.G = gridDim.x; { const int bx = blockIdx.x; F.vcu = (F.G % 8 == 0) ? (bx % 8) * (F.G / 8) + bx / 8 : bx; }
    F.ws = args.ws; F.out = args.out; F.ctl = (gu32*)(args.ws + WS_CTL);
#pragma unroll
    for (int i = 0; i < 24; ++i) F.in[i] = args.in[i];
    for (int u = F.tid; u < (LDS_BYTES - LDSCTL_OFF) / 4; u += NTHR) ((LAS unsigned*)(F.lds + LDSCTL_OFF))[u] = 0u;
    __syncthreads();
    XcdBarrier bar = xcd_barrier_post((unsigned*)(F.ctl + CW_BAR) + args.li * XCD_BAR_WORDS, F.MISC + 8);
    const int lo = args.ph_lo, hi = args.ph_hi;
#define IN(k) (lo <= (k) && (k) < hi)
#define SEAM(k) do { if (IN(k) && IN((k) + 1)) xcd_barrier(bar); } while (0)

#ifndef MK_DOUBLE
#define MK_DOUBLE 0
#endif
#define DBL(k) ((MK_DOUBLE >> (k)) & 1)
#ifdef MK_PROBE_LO
    unsigned long long* stamps = (unsigned long long*)(F.ctl + 131072);
#define STAMP(k) do { if (blockIdx.x == 0 && F.tid == 0) stamps[k] = rt(); } while (0)
#define PROBE_SCALE() (1.f + sqrtf((float)(stamps[MK_PROBE_HI] - stamps[MK_PROBE_LO]) * 0.01f * 2e-5f))
#else
#define STAMP(k) do { } while (0)
#define PROBE_SCALE() 1.f
#endif
    STAMP(0); if (IN(0)) { p0_gemv(F); } SEAM(0);
    STAMP(1); if (IN(1)) { p1_modulate(F); if (DBL(1)) p1_modulate(F); } SEAM(1);
    STAMP(2); if (IN(2)) {
        pg8::Gemm g{wsp<pg8::bf16_t>(F, WS_HN), wsp<pg8::bf16_t>(F, WS_WIN), S, NPP, D}; pg8::StaticOrder So; So.init(S, NPP, F.G, (int)blockIdx.x);
        EpiProj E{wsp<bf16>(F, WS_PROJ)};
        pg8::gemm_phase<EpiProj, pg8::StaticOrder, true, true>(F.lds + RING_OFF, g, So, E);
        if (DBL(2)) pg8::gemm_phase<EpiProj, pg8::StaticOrder, true, true>(F.lds + RING_OFF, g, So, E);
    } SEAM(2);
    STAMP(3); if (IN(3)) { p3_prep(F); } SEAM(3);
    STAMP(4); if (IN(4)) { p4_scan(F); if (DBL(4)) p4_scan(F); } SEAM(4);
    STAMP(5); if (IN(5)) { p5_mlstm_out(F); if (DBL(14)) p5_mlstm_out(F); p5_attention(F, (char*)lds); } SEAM(5);
    STAMP(6); if (IN(6)) { p6_combine(F); } SEAM(6);
    STAMP(7); if (IN(7)) {
        pg8::Gemm g{wsp<pg8::bf16_t>(F, WS_CONCAT), wsp<pg8::bf16_t>(F, WS_WOUT), S, D, D}; pg8::StaticOrder So; So.init(S, D, F.G, (int)blockIdx.x);
        EpiOut E{F.in[IN_X], wsp<float>(F, WS_MOD) + 2 * D, wsp<float>(F, WS_H1)};
        pg8::gemm_phase<EpiOut, pg8::StaticOrder, false, true>(F.lds + RING_OFF, g, So, E);
        if (DBL(7)) pg8::gemm_phase<EpiOut, pg8::StaticOrder, false, true>(F.lds + RING_OFF, g, So, E);
    } SEAM(7);
    STAMP(8); if (IN(8)) { p7_router(F); if (DBL(8)) p7_router(F); } SEAM(8);
    STAMP(9); if (IN(9)) { p8_gather(F); if (DBL(9)) p8_gather(F); } SEAM(9);
    STAMP(10); if (IN(10)) {
        build_expert_table(F, (const int*)(F.ws + WS_POS) + S * 4);
        pg8::Gemm g{wsp<pg8::bf16_t>(F, WS_XG), wsp<pg8::bf16_t>(F, WS_WUG), MAXROWS, 4096, D / 2}; GroupedOrder So{(const LAS int*)(F.lds + TAB_OFF), 16, F.G, (int)blockIdx.x};
        EpiSwiglu E{wsp<unsigned char>(F, WS_ACT), F.in[IN_BUG]};
        pg8::gemm_phase8<EpiSwiglu, GroupedOrder, true, true>(F.lds + RING_OFF, g, So, E);
        if (DBL(10)) pg8::gemm_phase8<EpiSwiglu, GroupedOrder, true, true>(F.lds + RING_OFF, g, So, E);
    } SEAM(10);
    STAMP(11); if (IN(11)) {
        build_expert_table(F, (const int*)(F.ws + WS_POS) + S * 4);
        pg8::Gemm g{wsp<pg8::bf16_t>(F, WS_ACT), wsp<pg8::bf16_t>(F, WS_WD), MAXROWS, D, FF / 2}; GroupedOrder So{(const LAS int*)(F.lds + TAB_OFF), 8, F.G, (int)blockIdx.x};
        EpiDown E{wsp<bf16>(F, WS_Y), F.in[IN_BD], wsp<float>(F, WS_ROWW)};
        pg8::gemm_phase8<EpiDown, GroupedOrder, true, true>(F.lds + RING_OFF, g, So, E);
        if (DBL(11)) pg8::gemm_phase8<EpiDown, GroupedOrder, true, true>(F.lds + RING_OFF, g, So, E);
    } SEAM(11);
    STAMP(12); if (IN(12)) { p11_final(F, PROBE_SCALE()); if (DBL(12)) p11_final(F, PROBE_SCALE()); }
#undef IN
#undef SEAM
}
}
#ifndef MK_DEBUG
#define MK_DEBUG 0
#endif
#ifndef MK_PH_END
#define MK_PH_END mk::N_PHASES
#endif
#ifndef MK_SPLIT
#define MK_SPLIT 0
#endif
extern "C" void kernel_launch(void* const* d_in, const int* in_sizes, int n_in, void* d_out, int out_size, void* d_ws, size_t ws_size, hipStream_t stream) {
    using namespace mk;
    static int grid = 0;
    if (grid == 0) {
        int dev = 0, cus = 0, per_cu = 0;
        if (hipGetDevice(&dev) != hipSuccess || hipDeviceGetAttribute(&cus, hipDeviceAttributeMultiprocessorCount, dev) != hipSuccess) { fprintf(stderr, "kernel_launch: device query failed\n"); grid = -1; return; }
        if (hipFuncSetAttribute((const void*)mega_fwd, hipFuncAttributeMaxDynamicSharedMemorySize, LDS_BYTES) != hipSuccess) { fprintf(stderr, "kernel_launch: hipFuncSetAttribute failed\n"); grid = -1; return; }
        if (hipOccupancyMaxActiveBlocksPerMultiprocessor(&per_cu, (const void*)mega_fwd, NTHR, LDS_BYTES) != hipSuccess || per_cu < 1) fprintf(stderr, "kernel_launch: occupancy query reports %d\n", per_cu);
        (void)hipGetLastError();
        grid = cus;
        if (n_in != 24 || out_size != S * D || ws_size < (MK_DEBUG ? WS_NAIVE + (size_t)2300 * MiB : WS_END)) fprintf(stderr, "kernel_launch: unexpected sizes n_in %d out %d ws %zu\n", n_in, out_size, ws_size);
    }
    if (grid < 0) return;
    (void)hipMemsetAsync((char*)d_ws + WS_CTL, 0, CTL_ZERO_BYTES, stream);
    Args a{};
    for (int i = 0; i < 24; ++i) a.in[i] = (const float*)d_in[i];
    a.out = (float*)d_out; a.ws = (unsigned char*)d_ws;
#if MK_DEBUG
    nv::naive_forward(d_in, (float*)d_out, (char*)d_ws + WS_NAIVE, stream);
#endif
#if MK_SPLIT
    for (int p = 0; p < MK_PH_END; ++p) { a.ph_lo = p; a.ph_hi = p + 1; a.li = p; hipLaunchKernelGGL(mega_fwd, dim3(grid), dim3(NTHR), LDS_BYTES, stream, a); }
#else
    a.ph_lo = 0; a.ph_hi = MK_PH_END; a.li = 0;
    hipLaunchKernelGGL(mega_fwd, dim3(grid), dim3(NTHR), LDS_BYTES, stream, a);
#endif
#ifdef MK_EXTRA_LO
    a.ph_lo = MK_EXTRA_LO; a.ph_hi = MK_EXTRA_HI; a.li = 1;
    hipLaunchKernelGGL(mega_fwd, dim3(grid), dim3(NTHR), LDS_BYTES, stream, a);
#endif
    { const hipError_t le = hipPeekAtLastError(); if (le != hipSuccess) fprintf(stderr, "kernel_launch: launch failed: %s\n", hipGetErrorName(le)); }
#if MK_DEBUG
    {
        nv::NaiveWs w = nv::carve((char*)d_ws + WS_NAIVE);
        double* slots = (double*)((char*)d_ws + WS_CTL + 512 * 1024);
        unsigned char* ws = (unsigned char*)d_ws; int nc = 0;
        MK_DEBUG_CHECKS
        dbg::k_finish<<<1024, 256, 0, stream>>>((float*)d_out, (size_t)S * D, slots, nc, 1e-3);
    }
#endif
}
```

```cpp
#include <hip/hip_runtime.h>
#include <hip/hip_bf16.h>
#include <cstdio>
#include <cstdint>
namespace pg8 {
#define PG8_LAS __attribute__((address_space(3)))
typedef unsigned short bf16_t;
typedef short bf16x8 __attribute__((ext_vector_type(8)));
typedef float f32x4 __attribute__((ext_vector_type(4)));
typedef unsigned u32x4 __attribute__((ext_vector_type(4)));
constexpr int BM = 256, BK = 64, HALF = 128, HTB = HALF * BK * 2  , STAGE_BYTES = 8 * HTB, NXCD = 8, WGM = 8;

__host__ __device__ __forceinline__ int lds_byte(int r, int c) { const int st = (r >> 4) * 2 + (c >> 5), rr = r & 15, cc = c & 31, ob = rr * 64 + cc * 2; return st * 1024 + (ob ^ (((ob >> 9) & 1) << 5)); }
__host__ __device__ __forceinline__ void stage_rc(int b, int& R, int& C) { const int st = b / 1024, sb = b % 1024, swz = sb ^ (((sb >> 9) & 1) << 5); R = (st >> 1) * 16 + swz / 64; C = (st & 1) * 32 + (swz % 64) / 2; }
__host__ __device__ __forceinline__ int perm32(int rho) { const int n = rho >> 4, i = rho & 15; return 8 * (i >> 2) + 4 * n + (i & 3); }

struct Unit { int pm, pn, pb, e; };
struct Gemm { const bf16_t* A; const bf16_t* Bt; int M, N, K; };

struct StaticOrder {
    int nM, nN, nwg, G, c;
    __host__ __device__ void init(int M, int N, int G_, int c_) { nM = M / BM; nN = N / BM; nwg = nM * nN; G = G_; c = c_; }
    __host__ __device__ bool next(int i, Unit& u) const {
        const long L = (long)i * G + c; if (L >= nwg) return false;
        int wgid = (int)L; { const int q = nwg / NXCD, r = nwg % NXCD, xcd = wgid % NXCD, off = wgid / NXCD; wgid = (xcd < r ? xcd * (q + 1) : r * (q + 1) + (xcd - r) * q) + off; }
        const int nig = WGM * nN, gid = wgid / nig, fm = gid * WGM, gsz = (nM - fm) < WGM ? (nM - fm) : WGM;
        u.pm = fm + ((wgid % nig) % gsz); u.pn = (wgid % nig) / gsz; u.pb = u.pn; u.e = 0; return true;
    }
    __device__ __forceinline__ void a_ready(const Unit&) const {}
    __device__ __forceinline__ void done(const Unit&) const {}
};

__device__ __forceinline__ unsigned cvt_pk_bf16(float lo, float hi) { unsigned r; asm volatile("v_cvt_pk_bf16_f32 %0, %1, %2" : "=v"(r) : "v"(lo), "v"(hi)); return r; }
template <class Epi, class Sched, bool ALIGN_EPI = false, bool SP2 = false>
__device__ __forceinline__ void gemm_phase(PG8_LAS unsigned char* lds, const Gemm g, const Sched& S, const Epi& E) {
    const int tid = threadIdx.x, wid = __builtin_amdgcn_readfirstlane(tid >> 6), lane = tid & 63, wr = wid >> 2, wc = wid & 3, fr = lane & 15, fq = lane >> 4;
    const int K = g.K, nt = K / BK;
    unsigned voffA[2], voffB[2];
#pragma unroll
    for (int i = 0; i < 2; ++i) { int R, C; stage_rc(tid * 16 + i * 8192, R, C); const int Rb = Epi::PERM ? ((R & ~31) + perm32(R & 31)) : R;
        voffA[i] = (unsigned)(R * K + C) * 2u; voffB[i] = (unsigned)(Rb * K + C) * 2u; }
    const size_t kstep = (size_t)(BK * 2);
    const size_t hstep = (size_t)HALF * K * 2;
    const size_t tstep = 2 * hstep;
    const unsigned ldsw = (unsigned)wid * 1024u;
    const int aoff = lds_byte(wr * 64 + fr, fq * 8), boff = lds_byte(wc * 32 + fr, fq * 8);
#define PG8_SA(b, h) (((b) * 2 + (h)) * HTB)
#define PG8_SB(b, h) ((4 + (b) * 2 + (h)) * HTB)
#define PG8_STAGE(bufoff, gbase, voff) do { _Pragma("unroll") for (int _i = 0; _i < 2; ++_i) \
        __builtin_amdgcn_global_load_lds((const unsigned*)((const char*)(gbase) + (voff)[_i]), (PG8_LAS unsigned*)(lds + (bufoff) + ldsw + _i * 8192), 16, 0, 0); } while (0)
#define PG8_LDA(dst, b, h) do { _Pragma("unroll") for (int m = 0; m < 4; ++m) _Pragma("unroll") for (int k = 0; k < 2; ++k) dst[m][k] = *(const PG8_LAS bf16x8*)(lds + PG8_SA(b, h) + aoff + m * 2048 + k * 1024); } while (0)
#define PG8_LDB(dst, b, h) do { _Pragma("unroll") for (int n = 0; n < 2; ++n) _Pragma("unroll") for (int k = 0; k < 2; ++k) dst[n][k] = *(const PG8_LAS bf16x8*)(lds + PG8_SB(b, h) + boff + n * 2048 + k * 1024); } while (0)
#define PG8_MMA(ai, bj, At, Bt) do { __builtin_amdgcn_s_setprio(1); _Pragma("unroll") for (int m = 0; m < 4; ++m) _Pragma("unroll") for (int n = 0; n < 2; ++n) _Pragma("unroll") for (int k = 0; k < 2; ++k) \
        acc[ai][bj][m][n] = __builtin_amdgcn_mfma_f32_16x16x32_bf16(Bt[n][k], At[m][k], acc[ai][bj][m][n], 0, 0, 0); __builtin_amdgcn_s_setprio(0); } while (0)
#define PG8_WAIT_V(n) asm volatile("s_waitcnt vmcnt(" #n ")" ::: "memory")
#define PG8_WAIT_L(n) asm volatile("s_waitcnt lgkmcnt(" #n ")" ::: "memory")
#define PG8_BAR __builtin_amdgcn_s_barrier()
#define PG8_SCHED __builtin_amdgcn_sched_barrier(0)
    Unit cur, nxt; int ui = 0;
    if (!S.next(0, cur)) return;
    f32x4 acc[2][2][4][2];
#pragma unroll
    for (int a = 0; a < 2; ++a)
#pragma unroll
        for (int b = 0; b < 2; ++b)
#pragma unroll
            for (int m = 0; m < 4; ++m)
#pragma unroll
                for (int n = 0; n < 2; ++n) acc[a][b][m][n] = (f32x4){0.f, 0.f, 0.f, 0.f};
    bf16x8 At[4][2], B0[2][2], B1[2][2];
    const char* cA = (const char*)g.A + (size_t)cur.pm * tstep; const char* cB = (const char*)g.Bt + (size_t)cur.pb * tstep;
    S.a_ready(cur);
    if constexpr (SP2) {
        PG8_STAGE(PG8_SB(0, 0), cB, voffB); PG8_STAGE(PG8_SB(0, 1), cB + hstep, voffB); PG8_STAGE(PG8_SA(0, 0), cA, voffA); PG8_STAGE(PG8_SA(0, 1), cA + hstep, voffA);
        if (wr == 1) PG8_BAR;
        PG8_WAIT_V(2); PG8_BAR;
        PG8_STAGE(PG8_SB(1, 0), cB + kstep, voffB); PG8_STAGE(PG8_SA(1, 0), cA + kstep, voffA); PG8_STAGE(PG8_SB(1, 1), cB + hstep + kstep, voffB);
        PG8_WAIT_V(6); PG8_BAR;
    } else {
        PG8_STAGE(PG8_SB(0, 0), cB, voffB); PG8_STAGE(PG8_SA(0, 0), cA, voffA); PG8_STAGE(PG8_SB(0, 1), cB + hstep, voffB); PG8_STAGE(PG8_SA(0, 1), cA + hstep, voffA);
        if (wr == 1) PG8_BAR;
        PG8_WAIT_V(4); PG8_BAR;
        PG8_STAGE(PG8_SB(1, 0), cB + kstep, voffB); PG8_STAGE(PG8_SA(1, 0), cA + kstep, voffA); PG8_STAGE(PG8_SB(1, 1), cB + hstep + kstep, voffB);
        PG8_WAIT_V(6); PG8_BAR;
    }
    for (;;) {
        const bool has_next = S.next(ui + 1, nxt);
        const char* nA = has_next ? (const char*)g.A + (size_t)nxt.pm * tstep : cA; const char* nB = has_next ? (const char*)g.Bt + (size_t)nxt.pb * tstep : cB;
        for (int t = 0; t < nt; t += 2) {
            const bool last = (t == nt - 2);
            const char* a1 = cA + (size_t)(t + 1) * kstep;
            const char* a2 = last ? nA : cA + (size_t)(t + 2) * kstep; const char* b2 = last ? nB : cB + (size_t)(t + 2) * kstep;
            const char* a3 = a2 + kstep; const char* b3 = b2 + kstep;
            if (last && has_next) S.a_ready(nxt);
            if constexpr (SP2) {
            PG8_LDB(B0, 0, 0); PG8_LDB(B1, 0, 1); PG8_SCHED; PG8_LDA(At, 0, 0); PG8_STAGE(PG8_SA(1, 1), a1 + hstep, voffA);
            PG8_WAIT_V(8); PG8_WAIT_L(0); PG8_BAR; PG8_MMA(0, 0, At, B0); PG8_MMA(0, 1, At, B1); PG8_BAR; PG8_SCHED;
            PG8_LDA(At, 0, 1); PG8_STAGE(PG8_SB(0, 0), b2, voffB); PG8_STAGE(PG8_SB(0, 1), b2 + hstep, voffB); PG8_STAGE(PG8_SA(0, 0), a2, voffA);
            PG8_WAIT_V(8); PG8_WAIT_L(0); PG8_BAR; PG8_MMA(1, 0, At, B0); PG8_MMA(1, 1, At, B1); PG8_BAR; PG8_SCHED;
            PG8_LDB(B0, 1, 0); PG8_LDB(B1, 1, 1); PG8_SCHED; PG8_LDA(At, 1, 0); PG8_STAGE(PG8_SA(0, 1), a2 + hstep, voffA);
            PG8_WAIT_V(8); PG8_WAIT_L(0); PG8_BAR; PG8_MMA(0, 0, At, B0); PG8_MMA(0, 1, At, B1); PG8_BAR; PG8_SCHED;
            PG8_LDA(At, 1, 1); PG8_STAGE(PG8_SB(1, 0), b3, voffB); PG8_STAGE(PG8_SB(1, 1), b3 + hstep, voffB); PG8_STAGE(PG8_SA(1, 0), a3, voffA);
            PG8_WAIT_V(8); PG8_WAIT_L(0); PG8_BAR; PG8_MMA(1, 0, At, B0); PG8_MMA(1, 1, At, B1); PG8_BAR; PG8_SCHED;
            } else {
            PG8_LDB(B0, 0, 0); PG8_SCHED; PG8_LDA(At, 0, 0); PG8_STAGE(PG8_SA(1, 1), a1 + hstep, voffA);
            PG8_WAIT_L(8); PG8_BAR; PG8_WAIT_L(0); PG8_MMA(0, 0, At, B0); PG8_BAR; PG8_SCHED;
            PG8_LDB(B1, 0, 1); PG8_STAGE(PG8_SB(0, 0), b2, voffB);
            PG8_BAR; PG8_WAIT_L(0); PG8_MMA(0, 1, At, B1); PG8_BAR;
            PG8_LDA(At, 0, 1); PG8_STAGE(PG8_SA(0, 0), a2, voffA);
            PG8_BAR; PG8_WAIT_L(0); PG8_MMA(1, 0, At, B0); PG8_BAR; PG8_SCHED;
            PG8_STAGE(PG8_SB(0, 1), b2 + hstep, voffB);
            PG8_WAIT_V(6); PG8_BAR; PG8_MMA(1, 1, At, B1); PG8_BAR;
            PG8_LDB(B0, 1, 0); PG8_SCHED; PG8_LDA(At, 1, 0); PG8_STAGE(PG8_SA(0, 1), a2 + hstep, voffA);
            PG8_WAIT_L(8); PG8_BAR; PG8_WAIT_L(0); PG8_MMA(0, 0, At, B0); PG8_BAR; PG8_SCHED;
            PG8_LDB(B1, 1, 1); PG8_STAGE(PG8_SB(1, 0), b3, voffB);
            PG8_BAR; PG8_WAIT_L(0); PG8_MMA(0, 1, At, B1); PG8_BAR;
            PG8_LDA(At, 1, 1); PG8_STAGE(PG8_SA(1, 0), a3, voffA);
            PG8_BAR; PG8_WAIT_L(0); PG8_MMA(1, 0, At, B0); PG8_BAR; PG8_SCHED;
            PG8_STAGE(PG8_SB(1, 1), b3 + hstep, voffB);
            PG8_WAIT_V(6); PG8_BAR; PG8_MMA(1, 1, At, B1); PG8_BAR;
            }
        }
        if constexpr (ALIGN_EPI) { if (wr == 0) PG8_BAR; }
        if constexpr (!Epi::AFTER_DRAIN) { E(acc, cur, wr, wc, fr, fq); S.done(cur); }
        if (!has_next) break;
#pragma unroll
        for (int a = 0; a < 2; ++a)
#pragma unroll
            for (int b = 0; b < 2; ++b)
#pragma unroll
                for (int m = 0; m < 4; ++m)
#pragma unroll
                    for (int n = 0; n < 2; ++n) acc[a][b][m][n] = (f32x4){0.f, 0.f, 0.f, 0.f};
        cur = nxt; cA = nA; cB = nB; ++ui;
        if constexpr (ALIGN_EPI) { if (wr == 1) PG8_BAR; }
    }
    PG8_WAIT_V(0);
    if constexpr (!ALIGN_EPI) { if (wr == 0) PG8_BAR; }
    PG8_BAR;
    if constexpr (Epi::AFTER_DRAIN) { E.fused(acc, cur, wr, wc, fr, fq, lds, wid, lane); S.done(cur); }
#undef PG8_SA
#undef PG8_SB
#undef PG8_STAGE
#undef PG8_LDA
#undef PG8_LDB
#undef PG8_MMA
#undef PG8_WAIT_V
#undef PG8_WAIT_L
#undef PG8_BAR
#undef PG8_SCHED
}
typedef int v8i __attribute__((ext_vector_type(8)));
typedef int v4i __attribute__((ext_vector_type(4)));
constexpr int SCALE_W8 = 0x78787878, SCALE_A8 = 0x7f7f7f7f;
template <class Epi, class Sched, bool ALIGN_EPI = false, bool SP2 = false>
__device__ __forceinline__ void gemm_phase8(PG8_LAS unsigned char* lds, const Gemm g, const Sched& S, const Epi& E) {
    const int tid = threadIdx.x, wid = __builtin_amdgcn_readfirstlane(tid >> 6), lane = tid & 63, wr = wid >> 2, wc = wid & 3, fr = lane & 15, fq = lane >> 4;
    const int K = g.K, nt = K / BK;
    unsigned voffA[2], voffB[2];
#pragma unroll
    for (int i = 0; i < 2; ++i) { int R, C; stage_rc(tid * 16 + i * 8192, R, C); const int Rb = Epi::PERM ? ((R & ~31) + perm32(R & 31)) : R;
        voffA[i] = (unsigned)(R * K + C) * 2u; voffB[i] = (unsigned)(Rb * K + C) * 2u; }
    const size_t kstep = (size_t)(BK * 2);
    const size_t hstep = (size_t)HALF * K * 2;
    const size_t tstep = 2 * hstep;
    const unsigned ldsw = (unsigned)wid * 1024u;
    const int aoff = lds_byte(wr * 64 + fr, fq * 8), boff = lds_byte(wc * 32 + fr, fq * 8);
#define PG8_SA(b, h) (((b) * 2 + (h)) * HTB)
#define PG8_SB(b, h) ((4 + (b) * 2 + (h)) * HTB)
#define PG8_STAGE(bufoff, gbase, voff) do { _Pragma("unroll") for (int _i = 0; _i < 2; ++_i) \
        __builtin_amdgcn_global_load_lds((const unsigned*)((const char*)(gbase) + (voff)[_i]), (PG8_LAS unsigned*)(lds + (bufoff) + ldsw + _i * 8192), 16, 0, 0); } while (0)
#define PG8_LDA(dst, b, h) do { _Pragma("unroll") for (int m = 0; m < 4; ++m) { const v4i lo_ = *(const PG8_LAS v4i*)(lds + PG8_SA(b, h) + aoff + m * 2048), hi_ = *(const PG8_LAS v4i*)(lds + PG8_SA(b, h) + aoff + m * 2048 + 1024); \
        dst[m] = __builtin_shufflevector(lo_, hi_, 0, 1, 2, 3, 4, 5, 6, 7); } } while (0)
#define PG8_LDB(dst, b, h) do { _Pragma("unroll") for (int n = 0; n < 2; ++n) { const v4i lo_ = *(const PG8_LAS v4i*)(lds + PG8_SB(b, h) + boff + n * 2048), hi_ = *(const PG8_LAS v4i*)(lds + PG8_SB(b, h) + boff + n * 2048 + 1024); \
        dst[n] = __builtin_shufflevector(lo_, hi_, 0, 1, 2, 3, 4, 5, 6, 7); } } while (0)
#define PG8_MMA(ai, bj, At, Bt) do { __builtin_amdgcn_s_setprio(1); _Pragma("unroll") for (int m = 0; m < 4; ++m) _Pragma("unroll") for (int n = 0; n < 2; ++n) \
        asm volatile("v_mfma_scale_f32_16x16x128_f8f6f4 %0, %1, %2, %0, %3, %4 op_sel_hi:[0,0,0]" : "+v"(acc[ai][bj][m][n]) : "v"(Bt[n]), "v"(At[m]), "v"(sw8), "v"(sa8)); __builtin_amdgcn_s_setprio(0); } while (0)
#define PG8_WAIT_V(n) asm volatile("s_waitcnt vmcnt(" #n ")" ::: "memory")
#define PG8_WAIT_L(n) asm volatile("s_waitcnt lgkmcnt(" #n ")" ::: "memory")
#define PG8_BAR __builtin_amdgcn_s_barrier()
#define PG8_SCHED __builtin_amdgcn_sched_barrier(0)
    Unit cur, nxt; int ui = 0;
    if (!S.next(0, cur)) return;
    f32x4 acc[2][2][4][2];
#pragma unroll
    for (int a = 0; a < 2; ++a)
#pragma unroll
        for (int b = 0; b < 2; ++b)
#pragma unroll
            for (int m = 0; m < 4; ++m)
#pragma unroll
                for (int n = 0; n < 2; ++n) acc[a][b][m][n] = (f32x4){0.f, 0.f, 0.f, 0.f};
    v8i At[4], B0[2], B1[2]; int sw8 = SCALE_W8, sa8 = SCALE_A8;
    const char* cA = (const char*)g.A + (size_t)cur.pm * tstep; const char* cB = (const char*)g.Bt + (size_t)cur.pb * tstep;
    S.a_ready(cur);
    if constexpr (SP2) {
        PG8_STAGE(PG8_SB(0, 0), cB, voffB); PG8_STAGE(PG8_SB(0, 1), cB + hstep, voffB); PG8_STAGE(PG8_SA(0, 0), cA, voffA); PG8_STAGE(PG8_SA(0, 1), cA + hstep, voffA);
        if (wr == 1) PG8_BAR;
        PG8_WAIT_V(2); PG8_BAR;
        PG8_STAGE(PG8_SB(1, 0), cB + kstep, voffB); PG8_STAGE(PG8_SA(1, 0), cA + kstep, voffA); PG8_STAGE(PG8_SB(1, 1), cB + hstep + kstep, voffB);
        PG8_WAIT_V(6); PG8_BAR;
    } else {
        PG8_STAGE(PG8_SB(0, 0), cB, voffB); PG8_STAGE(PG8_SA(0, 0), cA, voffA); PG8_STAGE(PG8_SB(0, 1), cB + hstep, voffB); PG8_STAGE(PG8_SA(0, 1), cA + hstep, voffA);
        if (wr == 1) PG8_BAR;
        PG8_WAIT_V(4); PG8_BAR;
        PG8_STAGE(PG8_SB(1, 0), cB + kstep, voffB); PG8_STAGE(PG8_SA(1, 0), cA + kstep, voffA); PG8_STAGE(PG8_SB(1, 1), cB + hstep + kstep, voffB);
        PG8_WAIT_V(6); PG8_BAR;
    }
    for (;;) {
        const bool has_next = S.next(ui + 1, nxt);
        const char* nA = has_next ? (const char*)g.A + (size_t)nxt.pm * tstep : cA; const char* nB = has_next ? (const char*)g.Bt + (size_t)nxt.pb * tstep : cB;
        for (int t = 0; t < nt; t += 2) {
            const bool last = (t == nt - 2);
            const char* a1 = cA + (size_t)(t + 1) * kstep;
            const char* a2 = last ? nA : cA + (size_t)(t + 2) * kstep; const char* b2 = last ? nB : cB + (size_t)(t + 2) * kstep;
            const char* a3 = a2 + kstep; const char* b3 = b2 + kstep;
            if (last && has_next) S.a_ready(nxt);
            if constexpr (SP2) {
            PG8_LDB(B0, 0, 0); PG8_LDB(B1, 0, 1); PG8_SCHED; PG8_LDA(At, 0, 0); PG8_STAGE(PG8_SA(1, 1), a1 + hstep, voffA);
            PG8_WAIT_V(8); PG8_WAIT_L(0); PG8_BAR; PG8_MMA(0, 0, At, B0); PG8_MMA(0, 1, At, B1); PG8_BAR; PG8_SCHED;
            PG8_LDA(At, 0, 1); PG8_STAGE(PG8_SB(0, 0), b2, voffB); PG8_STAGE(PG8_SB(0, 1), b2 + hstep, voffB); PG8_STAGE(PG8_SA(0, 0), a2, voffA);
            PG8_WAIT_V(8); PG8_WAIT_L(0); PG8_BAR; PG8_MMA(1, 0, At, B0); PG8_MMA(1, 1, At, B1); PG8_BAR; PG8_SCHED;
            PG8_LDB(B0, 1, 0); PG8_LDB(B1, 1, 1); PG8_SCHED; PG8_LDA(At, 1, 0); PG8_STAGE(PG8_SA(0, 1), a2 + hstep, voffA);
            PG8_WAIT_V(8); PG8_WAIT_L(0); PG8_BAR; PG8_MMA(0, 0, At, B0); PG8_MMA(0, 1, At, B1); PG8_BAR; PG8_SCHED;
            PG8_LDA(At, 1, 1); PG8_STAGE(PG8_SB(1, 0), b3, voffB); PG8_STAGE(PG8_SB(1, 1), b3 + hstep, voffB); PG8_STAGE(PG8_SA(1, 0), a3, voffA);
            PG8_WAIT_V(8); PG8_WAIT_L(0); PG8_BAR; PG8_MMA(1, 0, At, B0); PG8_MMA(1, 1, At, B1); PG8_BAR; PG8_SCHED;
            } else {
            PG8_LDB(B0, 0, 0); PG8_SCHED; PG8_LDA(At, 0, 0); PG8_STAGE(PG8_SA(1, 1), a1 + hstep, voffA);
            PG8_WAIT_L(8); PG8_BAR; PG8_WAIT_L(0); PG8_MMA(0, 0, At, B0); PG8_BAR; PG8_SCHED;
            PG8_LDB(B1, 0, 1); PG8_STAGE(PG8_SB(0, 0), b2, voffB);
            PG8_BAR; PG8_WAIT_L(0); PG8_MMA(0, 1, At, B1); PG8_BAR;
            PG8_LDA(At, 0, 1); PG8_STAGE(PG8_SA(0, 0), a2, voffA);
            PG8_BAR; PG8_WAIT_L(0); PG8_MMA(1, 0, At, B0); PG8_BAR; PG8_SCHED;
            PG8_STAGE(PG8_SB(0, 1), b2 + hstep, voffB);
            PG8_WAIT_V(6); PG8_BAR; PG8_MMA(1, 1, At, B1); PG8_BAR;
            PG8_LDB(B0, 1, 0); PG8_SCHED; PG8_LDA(At, 1, 0); PG8_STAGE(PG8_SA(0, 1), a2 + hstep, voffA);
            PG8_WAIT_L(8); PG8_BAR; PG8_WAIT_L(0); PG8_MMA(0, 0, At, B0); PG8_BAR; PG8_SCHED;
            PG8_LDB(B1, 1, 1); PG8_STAGE(PG8_SB(1, 0), b3, voffB);
            PG8_BAR; PG8_WAIT_L(0); PG8_MMA(0, 1, At, B1); PG8_BAR;
            PG8_LDA(At, 1, 1); PG8_STAGE(PG8_SA(1, 0), a3, voffA);
            PG8_BAR; PG8_WAIT_L(0); PG8_MMA(1, 0, At, B0); PG8_BAR; PG8_SCHED;
            PG8_STAGE(PG8_SB(1, 1), b3 + hstep, voffB);
            PG8_WAIT_V(6); PG8_BAR; PG8_MMA(1, 1, At, B1); PG8_BAR;
            }
        }
        if constexpr (ALIGN_EPI) { if (wr == 0) PG8_BAR; }
        asm volatile("s_nop 15\n\ts_nop 7" ::: "memory");
        if constexpr (!Epi::AFTER_DRAIN) { E(acc, cur, wr, wc, fr, fq); S.done(cur); }
        if (!has_next) break;
#pragma unroll
        for (int a = 0; a < 2; ++a)
#pragma unroll
            for (int b = 0; b < 2; ++b)
#pragma unroll
                for (int m = 0; m < 4; ++m)
#pragma unroll
                    for (int n = 0; n < 2; ++n) acc[a][b][m][n] = (f32x4){0.f, 0.f, 0.f, 0.f};
        cur = nxt; cA = nA; cB = nB; ++ui;
        if constexpr (ALIGN_EPI) { if (wr == 1) PG8_BAR; }
    }
    PG8_WAIT_V(0);
    if constexpr (!ALIGN_EPI) { if (wr == 0) PG8_BAR; }
    PG8_BAR;
    if constexpr (Epi::AFTER_DRAIN) { E.fused(acc, cur, wr, wc, fr, fq, lds, wid, lane); S.done(cur); }
#undef PG8_SA
#undef PG8_SB
#undef PG8_STAGE
#undef PG8_LDA
#undef PG8_LDB
#undef PG8_MMA
#undef PG8_WAIT_V
#undef PG8_WAIT_L
#undef PG8_BAR
#undef PG8_SCHED
}
}
#define GAS __attribute__((address_space(1)))
#define LAS __attribute__((address_space(3)))
typedef unsigned short bf16;
typedef unsigned v4u __attribute__((ext_vector_type(4)));
typedef float f32x4 __attribute__((ext_vector_type(4)));
typedef short bf16x8 __attribute__((ext_vector_type(8)));
typedef GAS unsigned gu32;
typedef GAS unsigned long long gu64;
#define RLX_AGENT __ATOMIC_RELAXED, __HIP_MEMORY_SCOPE_AGENT
#define LDS_WAIT() asm volatile("s_waitcnt lgkmcnt(0)" ::: "memory")
#define VM_WAIT() asm volatile("s_waitcnt vmcnt(0)" ::: "memory")
__device__ __forceinline__ unsigned long long rt() { return __builtin_amdgcn_s_memrealtime(); }
__device__ __forceinline__ unsigned f2bf(float f) { unsigned u = __builtin_bit_cast(unsigned, f); return (u + 0x7fffu + ((u >> 16) & 1u)) >> 16; }
__device__ __forceinline__ unsigned pk2(float lo, float hi) { return f2bf(lo) | (f2bf(hi) << 16); }

#define XB_TMO      128
#define XB_XCNT(j)  (256  + 64 * (j))
#define XB_XSUB(j)  (1280 + 64 * (j))
#define XB_XGEN(j)  (2304 + 64 * (j))
#define XB_TOP      3328
#define XB_TOPGEN   3392
#define XCD_BAR_WORDS 3456
#define XB_SPIN_CAP (1u << 18)

__device__ __forceinline__ unsigned xb_ld(unsigned* p)              { return __hip_atomic_load(p, __ATOMIC_RELAXED, __HIP_MEMORY_SCOPE_AGENT); }
__device__ __forceinline__ unsigned xb_add(unsigned* p, unsigned v) { return __hip_atomic_fetch_add(p, v, __ATOMIC_RELAXED, __HIP_MEMORY_SCOPE_AGENT); }
__device__ __forceinline__ unsigned xb_xcc_id() { return (unsigned)__builtin_amdgcn_s_getreg((3 << 11) | 20) & 0xFu; }
#define XB_SPIN(cond, bar) do { unsigned _sp = 0; while (cond) { __builtin_amdgcn_s_sleep(1); \
    if ((++_sp & 255u) == 0u) { if (xb_ld(&(bar)[XB_TMO])) break; if (_sp > XB_SPIN_CAP) { atomicAdd(&(bar)[XB_TMO], 1u); break; } } } } while (0)

struct XcdBarrier {
    unsigned* bar; unsigned x;
    volatile LAS unsigned* st;
};

__device__ __forceinline__ XcdBarrier xcd_barrier_post(unsigned* bar, volatile LAS unsigned* st) {
    XcdBarrier b; b.bar = bar; b.x = xb_xcc_id(); b.st = st;
    if (threadIdx.x == 0) (void)xb_add(&bar[XB_XCNT(b.x)], 1u);
    return b;
}
__device__ __forceinline__ void xcd_barrier_complete(unsigned* bar, unsigned x, unsigned& nloc, unsigned& nx) {
    const unsigned G = gridDim.x * gridDim.y * gridDim.z;
    unsigned sum, cnt, mine, sp = 0u;
    for (;;) {
        sum = 0u; cnt = 0u; mine = 0u;
#pragma unroll
        for (unsigned j = 0; j < 16; ++j) { const unsigned c = xb_ld(&bar[XB_XCNT(j)]); sum += c; cnt += (c > 0u) ? 1u : 0u; mine = (j == x) ? c : mine; }
        if (sum == G) break;
        __builtin_amdgcn_s_sleep(1);
        if ((++sp & 255u) == 0u) { if (xb_ld(&bar[XB_TMO])) break; if (sp > XB_SPIN_CAP) { atomicAdd(&bar[XB_TMO], 1u); break; } }
    }
    nloc = mine > 0u ? mine : 1u; nx = cnt > 0u ? cnt : 1u;
}

__device__ __forceinline__ void xcd_barrier(const XcdBarrier& b) {
    asm volatile("s_waitcnt vmcnt(0)" ::: "memory");
    __syncthreads();
    if (threadIdx.x == 0) {
        unsigned* bar = b.bar;
        __builtin_amdgcn_s_waitcnt(0);
        unsigned nloc = b.st[0], nx = b.st[1];
        if (nloc == 0u) { xcd_barrier_complete(bar, b.x, nloc, nx); b.st[0] = nloc; b.st[1] = nx; }
        const unsigned old = xb_add(&bar[XB_XSUB(b.x)], 1u);
        const unsigned gen = old / nloc;
        if (old + 1u == (gen + 1u) * nloc) {
            __builtin_amdgcn_fence(__ATOMIC_RELEASE, "agent");
            asm volatile("s_waitcnt vmcnt(0)" ::: "memory");
            const unsigned og = xb_add(&bar[XB_TOP], 1u);
            const unsigned tg = og / nx;
            if (og + 1u == (tg + 1u) * nx) xb_add(&bar[XB_TOPGEN], 1u);
            else XB_SPIN(xb_ld(&bar[XB_TOPGEN]) == tg, bar);
            __builtin_amdgcn_fence(__ATOMIC_ACQUIRE, "agent");
            xb_add(&bar[XB_XGEN(b.x)], 1u);
            asm volatile("s_waitcnt vmcnt(0)" ::: "memory");
        } else {
            XB_SPIN(xb_ld(&bar[XB_XGEN(b.x)]) == gen, bar);
            __builtin_amdgcn_fence(__ATOMIC_ACQUIRE, "agent");
            asm volatile("s_waitcnt vmcnt(0)" ::: "memory");
        }
    }
    __syncthreads();
}
namespace mk {
constexpr int S = 8192, D = 2048, NPROJ = 6160, NPP = 6144, NPAD = 6400, NE = 32, FF = 2048, NWAVES = 8, NTHR = 512;
constexpr int C_MQ = 0, C_MK = 512, C_MV = 1024, C_MO = 2048, C_FQ = 3072, C_FK = 4096, C_FV = 5120;
constexpr int MAXROWS = S * 4 + NE * 256;
constexpr int NCH = 128, LCH = 64;
constexpr size_t MiB = 1u << 20;
constexpr size_t WS_CTL = 0, CTL_ZERO_BYTES = 1 * MiB;
constexpr size_t WS_MODP = 14 * MiB;
constexpr size_t WS_MOD = 2 * MiB;
constexpr size_t WS_GATES = 3 * MiB;
constexpr size_t WS_F = 4 * MiB;
constexpr size_t WS_NL = 5 * MiB;
constexpr size_t WS_NS = 6 * MiB;
constexpr size_t WS_GLAL = 7 * MiB;
constexpr size_t WS_MS = 7 * MiB + 65536;
constexpr size_t WS_TOPI = 8 * MiB;
constexpr size_t WS_TOPW = 9 * MiB;
constexpr size_t WS_HIST = 10 * MiB;
constexpr size_t WS_LRANK = 11 * MiB;
constexpr size_t WS_POS = 12 * MiB;
constexpr size_t WS_ROWW = 13 * MiB;
constexpr size_t WS_WIN = 16 * MiB;
constexpr size_t WS_WOUT = 42 * MiB;
constexpr size_t WS_HN = 50 * MiB;
constexpr size_t WS_PROJ = 82 * MiB;
constexpr size_t WS_UL = 178 * MiB;
constexpr size_t WS_CS = 242 * MiB;
constexpr size_t WS_CONCAT = 274 * MiB;
constexpr size_t WS_H1 = 306 * MiB;
constexpr size_t WS_XG = 370 * MiB;
constexpr size_t WS_ACT = 530 * MiB;
constexpr size_t WS_Y = 690 * MiB;
constexpr size_t WS_WUG = 850 * MiB;
constexpr size_t WS_WD = 1362 * MiB;
constexpr size_t WS_OPART = 1618 * MiB;
constexpr size_t WS_MLP = 1786 * MiB;
constexpr size_t WS_JLO = 1789 * MiB;
constexpr size_t WS_END = 1790 * MiB;
constexpr size_t WS_NAIVE = 1792 * MiB;
constexpr int CW_TMO = 0, CW_CODE = 1, CW_CONV = 2048, CW_DONE = 2048 + 64 * 8, CW_BAR = 4096;
constexpr int GC_INPROJ = 128, GC_ATTN = 192;
constexpr int RING_OFF = 0, RING_BYTES = 131072;
constexpr int LDSCTL_OFF = RING_BYTES, MISC_OFF = LDSCTL_OFF + 320;
constexpr int TAB_OFF = LDSCTL_OFF + 1024;
constexpr int ATT_CH = 16;
constexpr int LDS_BYTES = 147456;
}
namespace mk {
typedef float f32x2 __attribute__((ext_vector_type(2)));
typedef unsigned u32x2 __attribute__((ext_vector_type(2)));
struct Frame {
    LAS unsigned char* lds;
    volatile LAS unsigned* MISC;
    gu32* ctl;
    int tid, lane, wave, vcu, G, bid;
    const float* in[24];
    float* out; unsigned char* ws;
};
#define IN_X 0
#define IN_C 1
#define IN_WADA 2
#define IN_BADA 3
#define IN_NMIX 4
#define IN_WIN 5
#define IN_BI 6
#define IN_BF 7
#define IN_FOXBF 8
#define IN_FOXQN 9
#define IN_FOXKN 10
#define IN_MOUTN 11
#define IN_FOUTN 12
#define IN_WOUT 13
#define IN_NFFN 14
#define IN_WR 15
#define IN_BR 16
#define IN_WUG 17
#define IN_BUG 18
#define IN_WD 19
#define IN_BD 20
#define IN_WAF 21
#define IN_BAF 22
#define IN_NFIN 23
template <class T> __device__ __forceinline__ T* wsp(const Frame& F, size_t off) { return (T*)(F.ws + off); }
__device__ __forceinline__ float wave_sum(float v) {
#pragma unroll
    for (int o = 1; o < 64; o <<= 1) v += __shfl_xor(v, o);
    return v;
}
__device__ __forceinline__ float sigmoid_f(float v) { return 1.f / (1.f + __expf(-v)); }
__device__ __forceinline__ float log_sigmoid_f(float v) { return fminf(v, 0.f) - log1pf(__expf(-fabsf(v))); }
__device__ __forceinline__ float softcap_f(float v) { return 15.f * tanhf(v * (1.f / 15.f)); }
__device__ __forceinline__ float bf2f(unsigned short b) { return __uint_as_float(((unsigned)b) << 16); }

struct CvtItem { const float* src; bf16* dst; };
__device__ __forceinline__ void cvt_load(const CvtItem& it, int ldw, f32x4 (&v)[16], int lane) {
    const float* p = it.src + (size_t)((lane >> 4) * 16) * ldw + (lane & 15) * 4;
#pragma unroll
    for (int i = 0; i < 16; ++i) v[i] = __builtin_nontemporal_load((const GAS f32x4*)(p + (size_t)i * ldw));
}
__device__ __forceinline__ void cvt_store(const CvtItem& it, int K, const f32x4 (&v)[16], LAS unsigned char* scr, int lane) {
    const int c = lane & 15, g = lane >> 4;
#pragma unroll
    for (int j = 0; j < 4; ++j) {
        v4u a, b;
        a.x = pk2(v[0][j], v[1][j]); a.y = pk2(v[2][j], v[3][j]); a.z = pk2(v[4][j], v[5][j]); a.w = pk2(v[6][j], v[7][j]);
        b.x = pk2(v[8][j], v[9][j]); b.y = pk2(v[10][j], v[11][j]); b.z = pk2(v[12][j], v[13][j]); b.w = pk2(v[14][j], v[15][j]);
        LAS unsigned char* q = scr + (4 * c + j) * 144 + 32 * g;
        *(LAS v4u*)q = a; *(LAS v4u*)(q + 16) = b; }
    LDS_WAIT(); asm volatile("" ::: "memory");
#pragma unroll
    for (int i = 0; i < 8; ++i) { const int row = (lane >> 3) + 8 * i; const v4u o = *(const LAS v4u*)(scr + row * 144 + (lane & 7) * 16);
        *(GAS v4u*)(it.dst + (size_t)row * K + (lane & 7) * 8) = o; }
    LDS_WAIT(); asm volatile("" ::: "memory");
}
__device__ __forceinline__ unsigned pk4_fp8(float a, float b, float c, float d) { int r = __builtin_amdgcn_cvt_pk_fp8_f32(a, b, 0, false); r = __builtin_amdgcn_cvt_pk_fp8_f32(c, d, r, true); return (unsigned)r; }
constexpr float W8S = 128.f;
__device__ __forceinline__ void cvt8_pack(const f32x4 (&v)[16], LAS unsigned char* scr, int half, int lane) {
    const int c = lane & 15, g = lane >> 4;
#pragma unroll
    for (int j = 0; j < 4; ++j) { v4u a;
        a.x = pk4_fp8(v[0][j] * W8S, v[1][j] * W8S, v[2][j] * W8S, v[3][j] * W8S); a.y = pk4_fp8(v[4][j] * W8S, v[5][j] * W8S, v[6][j] * W8S, v[7][j] * W8S);
        a.z = pk4_fp8(v[8][j] * W8S, v[9][j] * W8S, v[10][j] * W8S, v[11][j] * W8S); a.w = pk4_fp8(v[12][j] * W8S, v[13][j] * W8S, v[14][j] * W8S, v[15][j] * W8S);
        *(LAS v4u*)(scr + (4 * c + j) * 144 + half * 64 + 16 * g) = a; }
}
__device__ __forceinline__ void cvt8_flush(unsigned char* dst, int kbytes, LAS unsigned char* scr, int lane) {
    LDS_WAIT(); asm volatile("" ::: "memory");
#pragma unroll
    for (int i = 0; i < 8; ++i) { const int row = (lane >> 3) + 8 * i; const v4u o = *(const LAS v4u*)(scr + row * 144 + (lane & 7) * 16);
        *(GAS v4u*)(dst + (size_t)row * kbytes + (lane & 7) * 16) = o; }
    LDS_WAIT(); asm volatile("" ::: "memory");
}
constexpr int CV8_UG = NE * 16 * 64, CV8_D = NE * 16 * 32, CV8_TOTAL = CV8_UG + CV8_D;
struct Cvt8Item { const float* src; unsigned char* dst; int ldw; };
__device__ __forceinline__ Cvt8Item cvt8_item(const Frame& F, int it, int half) {
    Cvt8Item r;
    if (it < CV8_UG) { const int e = it >> 10, q = it & 1023, kb = q >> 6, nb = q & 63, d0 = nb * 64, j = d0 >> 8, wv = d0 & 255, sc = wv < 128 ? 128 * j + wv : 2048 + 128 * j + (wv - 128);
        r.ldw = 4096; r.src = F.in[IN_WUG] + (size_t)e * D * 4096 + (size_t)(kb * 128 + half * 64) * 4096 + sc; r.dst = wsp<unsigned char>(F, WS_WUG) + (size_t)e * 4096 * D + (size_t)d0 * D + kb * 128; return r; }
    it -= CV8_UG;
    { const int e = it >> 9, q = it & 511, kb = q >> 5, nb = q & 31;
        r.ldw = D; r.src = F.in[IN_WD] + (size_t)e * FF * D + (size_t)(kb * 128 + half * 64) * D + nb * 64; r.dst = wsp<unsigned char>(F, WS_WD) + (size_t)e * D * FF + (size_t)(nb * 64) * FF + kb * 128; return r; }
}
__device__ __forceinline__ void cvt8_load(const Cvt8Item& it, f32x4 (&v)[16], int lane) {
    const float* p = it.src + (size_t)((lane >> 4) * 16) * it.ldw + (lane & 15) * 4;
#pragma unroll
    for (int i = 0; i < 16; ++i) v[i] = __builtin_nontemporal_load((const GAS f32x4*)(p + (size_t)i * it.ldw));
}
constexpr int CV_IN = 32 * 96, CV_OUT = 32 * 32, CV_TOTAL = CV_IN + CV_OUT;
__device__ __forceinline__ CvtItem cvt_item(const Frame& F, int it, int& ldw, int& K) {
    CvtItem r;
    if (it < CV_IN) { const int kb = it / 96, nb = it % 96, d0 = nb * 64, sc = d0 < 3072 ? d0 : d0 + 8;
        ldw = NPROJ; K = D; r.src = F.in[IN_WIN] + (size_t)(kb * 64) * NPROJ + sc; r.dst = wsp<bf16>(F, WS_WIN) + (size_t)d0 * D + kb * 64; return r; }
    it -= CV_IN;
    { const int kb = it >> 5, nb = it & 31; ldw = D; K = D; r.src = F.in[IN_WOUT] + (size_t)(kb * 64) * D + nb * 64; r.dst = wsp<bf16>(F, WS_WOUT) + (size_t)(nb * 64) * D + kb * 64; return r; }
}
__device__ __forceinline__ void p0_gemv(Frame& F) {
    const int gw = F.vcu * NWAVES + F.wave, NGW = F.G * NWAVES, lane = F.lane;
    {
        const float* c = F.in[IN_C]; float* modp = wsp<float>(F, WS_MODP);
        for (int task = gw; task < 2048; task += NGW) {
            const int cg = task & 63, ks = task >> 6, j = cg * 256 + 4 * lane;
            const float* w; int ld, col;
            if (j < 6 * D) { w = F.in[IN_WADA]; ld = 6 * D; col = j; } else { w = F.in[IN_WAF]; ld = 2 * D; col = j - 6 * D; }
            const float c0 = c[ks * 64 + lane]; const float s0 = c0 * sigmoid_f(c0);
            const float* wp = w + (size_t)(ks * 64) * ld + col; f32x4 acc = {0.f, 0.f, 0.f, 0.f};
#pragma unroll 16
            for (int i = 0; i < 64; ++i) acc += __builtin_nontemporal_load((const GAS f32x4*)(wp + (size_t)i * ld)) * __builtin_bit_cast(float, __builtin_amdgcn_readlane(__builtin_bit_cast(int, s0), i));
            *(GAS f32x4*)(modp + ks * 16384 + j) = acc;
        }
    }
    {
        bf16* win_t = wsp<bf16>(F, WS_WIN);
        for (int i2 = gw; i2 < D / 4; i2 += NGW) {
            const int col = lane & 15, k = 4 * i2 + (lane >> 4), sc = col < 8 ? 3072 + col : 6152 + (col - 8);
            win_t[(size_t)(NPP + col) * D + k] = (bf16)f2bf(F.in[IN_WIN][(size_t)k * NPROJ + sc]); }
        const v4u z = {0u, 0u, 0u, 0u};
        for (int i = gw * 64 + lane; i < 16 * D / 8; i += NGW * 64) *(GAS v4u*)(win_t + (size_t)NPROJ * D + (size_t)i * 8) = z;
    }
}
constexpr int CV8_SHARD = CV8_TOTAL / 8, CV8_CHUNK = 4;
#define CONV_NEXT(var) do { if (cpos < cend) { var = cpos++; } else { const int b_ = __builtin_amdgcn_readfirstlane((int)(lane == 0 ? __hip_atomic_fetch_add(ctr, (unsigned)CV8_CHUNK, RLX_AGENT) : 0u)); \
        if (b_ < CV8_SHARD) { var = xbase + b_; cpos = var + 1; cend = xbase + (b_ + CV8_CHUNK < CV8_SHARD ? b_ + CV8_CHUNK : CV8_SHARD); } else { var = CV8_TOTAL; } } } while (0)
__device__ __forceinline__ void conv_worker(Frame& F, gu32* stop, unsigned target) {
    LAS unsigned char* scr = F.lds + RING_OFF + F.wave * 9216; const int lane = F.lane, xs = (int)(blockIdx.x & 7), xbase = xs * CV8_SHARD; gu32* ctr = F.ctl + CW_CONV + 64 * xs;
    int cpos = 0, cend = 0, it; CONV_NEXT(it); if (it >= CV8_TOTAL) return;
    f32x4 va[16], vb[16];
    Cvt8Item cur = cvt8_item(F, it, 0); cvt8_load(cur, va, lane);
    for (;;) {
        const Cvt8Item c1 = cvt8_item(F, it, 1); cvt8_load(c1, vb, lane);
        bool stopnow = false;
        if (stop && cpos >= cend) stopnow = (unsigned)__builtin_amdgcn_readfirstlane((int)__hip_atomic_load(stop, RLX_AGENT)) >= target;
        int itn = CV8_TOTAL; if (!stopnow) CONV_NEXT(itn);
        cvt8_pack(va, scr, 0, lane);
        const bool more = itn < CV8_TOTAL; Cvt8Item nx = cur;
        if (more) { nx = cvt8_item(F, itn, 0); cvt8_load(nx, va, lane); }
        cvt8_pack(vb, scr, 1, lane);
        cvt8_flush(cur.dst, D, scr, lane);
        if (!more) break;
        cur = nx; it = itn;
    }
}
__device__ __forceinline__ bool enter_group(Frame& F, int Gc) {
    if (F.G != 256 || Gc >= 256) return true;
    const int bx = (int)blockIdx.x, slot = bx >> 3, xcd = bx & 7, per = Gc >> 3;
    if (slot >= per) return false;
    F.vcu = xcd * per + slot; F.bid = slot * 8 + xcd; F.G = Gc; return true;
}
__device__ __forceinline__ void leave_group(Frame& F) { const int bx = (int)blockIdx.x, G = (int)gridDim.x; F.G = G; F.bid = bx; F.vcu = (G % 8 == 0) ? (bx % 8) * (G / 8) + bx / 8 : bx; }
__device__ __forceinline__ void p1_convert(Frame& F) {
    const int gw = F.vcu * NWAVES + F.wave, NGW = F.G * NWAVES, lane = F.lane;
    {
        LAS unsigned char* scr = F.lds + RING_OFF + F.wave * 9216;
        int it = gw;
        if (it < CV_TOTAL) {
            int ldw, K; CvtItem cur = cvt_item(F, it, ldw, K); f32x4 va[16], vb[16];
            cvt_load(cur, ldw, va, lane);
            for (;;) {
                int itn = it + NGW; int ldn = 0, Kn = 0; CvtItem nx = cur; const bool more = itn < CV_TOTAL;
                if (more) { nx = cvt_item(F, itn, ldn, Kn); cvt_load(nx, ldn, vb, lane); }
                cvt_store(cur, K, va, scr, lane);
                if (!more) break;
                it = itn + NGW; const bool more2 = it < CV_TOTAL; CvtItem n2 = nx; int ld2 = 0, K2 = 0;
                if (more2) { n2 = cvt_item(F, it, ld2, K2); cvt_load(n2, ld2, va, lane); }
                cvt_store(nx, Kn, vb, scr, lane);
                if (!more2) break;
                cur = n2; K = K2;
            }
        }
    }
}
__device__ __forceinline__ void mod_reduce_lds(Frame& F, int j0, int n, LAS float* dst) {
    const float* modp = wsp<float>(F, WS_MODP);
    for (int i = F.tid; i < n; i += NTHR) { const int j = j0 + i; float a = j < 6 * D ? F.in[IN_BADA][j] : F.in[IN_BAF][j - 6 * D];
#pragma unroll
        for (int ks = 0; ks < 32; ++ks) a += modp[ks * 16384 + j];
        dst[i] = a; }
}
__device__ __forceinline__ void modulate_row_bf16(const float* xrow, const float* g, const LAS float* sh, const LAS float* sc, bf16* orow, int lane) {
    const GAS f32x4* xr = (const GAS f32x4*)xrow + lane; f32x4 v[8]; float s2 = 0.f;
#pragma unroll
    for (int j = 0; j < 8; ++j) { v[j] = xr[64 * j]; s2 += (v[j].x * v[j].x + v[j].y * v[j].y) + (v[j].z * v[j].z + v[j].w * v[j].w); }
    const float r = rsqrtf(wave_sum(s2) * (1.f / D) + 1e-6f);
    GAS u32x2* o8 = (GAS u32x2*)orow + lane;
#pragma unroll
    for (int j = 0; j < 8; ++j) { const int c0 = 4 * lane + 256 * j; const f32x4 gg = *(const GAS f32x4*)(g + c0); const f32x4 a = *(const LAS f32x4*)(sc + c0), b = *(const LAS f32x4*)(sh + c0);
        const f32x4 y = v[j] * r * gg * (a + 1.f) + b; u32x2 w; w.x = pk2(y.x, y.y); w.y = pk2(y.z, y.w); o8[64 * j] = w; }
}
typedef float f32x16 __attribute__((ext_vector_type(16)));
typedef short s16x8g __attribute__((ext_vector_type(8)));
__device__ __forceinline__ void p1_modulate(Frame& F) {
    LAS float* shs = (LAS float*)(F.lds + RING_OFF + 81920);
    LAS float* gred = (LAS float*)(F.lds + RING_OFF + 98304);
    mod_reduce_lds(F, 0, 2 * D, shs);
    if (F.tid < 64) {
        const float* modp = wsp<float>(F, WS_MODP); float* mod = wsp<float>(F, WS_MOD);
        for (int j = blockIdx.x * 64 + F.tid; j < 16384; j += F.G * 64) { float a = j < 6 * D ? F.in[IN_BADA][j] : F.in[IN_BAF][j - 6 * D];
#pragma unroll
            for (int ks = 0; ks < 32; ++ks) a += modp[ks * 16384 + j];
            mod[j] = a; }
    }
    __syncthreads();
    bf16* hn = wsp<bf16>(F, WS_HN); const bf16* wg = wsp<bf16>(F, WS_WIN) + (size_t)NPP * D; float* gates = wsp<float>(F, WS_GATES);
    const int lane = F.lane, w = F.wave, hi = lane >> 5, l31 = lane & 31;
    for (int rb = F.vcu; rb < S / 32; rb += F.G) {
        const int row0 = rb * 32;
#pragma unroll 1
        for (int i = 0; i < 4; ++i) { const int m = row0 + 4 * w + i; asm volatile("" ::: "memory"); modulate_row_bf16(F.in[IN_X] + (size_t)m * D, F.in[IN_NMIX], shs, shs + D, hn + (size_t)m * D, lane); }
        asm volatile("s_waitcnt vmcnt(0)" ::: "memory");
        __syncthreads();
        f32x16 acc;
#pragma unroll
        for (int r = 0; r < 16; ++r) acc[r] = 0.f;
        const bf16* ap = hn + (size_t)(row0 + l31) * D + 256 * w + 8 * hi; const bf16* bp = wg + (size_t)l31 * D + 256 * w + 8 * hi;
#pragma unroll
        for (int ks = 0; ks < 16; ++ks) { const s16x8g a = *(const GAS s16x8g*)(ap + 16 * ks), b = *(const GAS s16x8g*)(bp + 16 * ks); acc = __builtin_amdgcn_mfma_f32_32x32x16_bf16(a, b, acc, 0, 0, 0); }
        if (l31 < 16) {
#pragma unroll
            for (int r = 0; r < 16; ++r) gred[(w * 32 + (r & 3) + 8 * (r >> 2) + 4 * hi) * 16 + l31] = acc[r]; }
        __syncthreads();
        { const int row = F.tid >> 4, n = F.tid & 15; float s = 0.f;
#pragma unroll
            for (int q = 0; q < 8; ++q) s += gred[(q * 32 + row) * 16 + n];
            gates[(size_t)(row0 + row) * 16 + n] = s; }
        __syncthreads();
    }
    p1_convert(F);
}
using pg8::Unit; using pg8::cvt_pk_bf16;
struct EpiProj {
    static constexpr bool PERM = true, AFTER_DRAIN = false;
    bf16* O;
    __device__ __forceinline__ void operator()(const pg8::f32x4 (&acc)[2][2][4][2], const Unit& u, int wr, int wc, int fr, int fq) const {
        const int row0 = u.pm * 256 + wr * 64 + fr, col0 = u.pn * 256 + wc * 32 + 8 * fq;
#pragma unroll
        for (int ai = 0; ai < 2; ++ai)
#pragma unroll
            for (int m = 0; m < 4; ++m) { bf16* rowp = O + (size_t)(row0 + ai * 128 + m * 16) * NPP + col0;
#pragma unroll
                for (int bj = 0; bj < 2; ++bj) { const pg8::f32x4 v0 = acc[ai][bj][m][0], v1 = acc[ai][bj][m][1];
                    pg8::u32x4 w; w.x = cvt_pk_bf16(v0[0], v0[1]); w.y = cvt_pk_bf16(v0[2], v0[3]); w.z = cvt_pk_bf16(v1[0], v1[1]); w.w = cvt_pk_bf16(v1[2], v1[3]);
                    *(pg8::u32x4*)(rowp + bj * 128) = w; } }
    }
};
struct EpiOut {
    static constexpr bool PERM = false, AFTER_DRAIN = false;
    const float* x; const float* g1; float* h1;
    __device__ __forceinline__ void operator()(const pg8::f32x4 (&acc)[2][2][4][2], const Unit& u, int wr, int wc, int fr, int fq) const {
        const int row0 = u.pm * 256 + wr * 64 + fr, col0 = u.pn * 256 + wc * 32 + 4 * fq;
        pg8::f32x4 gv[2][2];
#pragma unroll
        for (int bj = 0; bj < 2; ++bj)
#pragma unroll
            for (int n = 0; n < 2; ++n) gv[bj][n] = *(const pg8::f32x4*)(g1 + col0 + bj * 128 + n * 16);
#pragma unroll
        for (int ai = 0; ai < 2; ++ai)
#pragma unroll
            for (int m = 0; m < 4; ++m) { const size_t off = (size_t)(row0 + ai * 128 + m * 16) * D + col0;
#pragma unroll
                for (int bj = 0; bj < 2; ++bj)
#pragma unroll
                    for (int n = 0; n < 2; ++n) { const pg8::f32x4 xv = *(const pg8::f32x4*)(x + off + bj * 128 + n * 16);
                        *(pg8::f32x4*)(h1 + off + bj * 128 + n * 16) = xv + gv[bj][n] * acc[ai][bj][m][n]; } }
    }
};
}
namespace fox {
constexpr int D = 128, SQ = 8192, SKV = 8192; constexpr float THR = 8.f; constexpr bool WSKIP = false;
constexpr int PITCH = 6144;
constexpr int OPITCH = 2048;
constexpr float SCALE = 0.08838834764831845f;
constexpr int NW = 8, QBLK = 32, KVBLK = 64, QB = NW * QBLK;
constexpr int SHM_V = KVBLK * D * 2, SHM_K = KVBLK * D * 2;
constexpr int LDS_BIAS = 2 * SHM_V + 2 * SHM_K + NW * 64 * 4;
constexpr int LDS_BYTES = LDS_BIAS + 512;

using bf16 = __hip_bfloat16;
typedef short bf16x8 __attribute__((ext_vector_type(8)));
typedef short s16x4 __attribute__((ext_vector_type(4)));
typedef float f32x16 __attribute__((ext_vector_type(16)));
typedef float f32x4 __attribute__((ext_vector_type(4)));
typedef unsigned u32x4 __attribute__((ext_vector_type(4)));
template <class A, class Bt> struct same_t { static constexpr bool v = false; };
template <class A> struct same_t<A, A> { static constexpr bool v = true; };

#define KSWZ(row, colB) ((row) * 256 + ((colB) ^ (((row) & 7) << 4)))
#define SBAR() __builtin_amdgcn_sched_barrier(0)
__device__ __forceinline__ int v_st(int k, int c) { const int kk = (k & ~0xC) | ((k & 4) << 1) | ((k & 8) >> 1); return ((kk >> 3) * 4 + (c >> 5)) * 512 + ((kk & 7) * 32 + (c & 31)) * 2; }
__device__ __forceinline__ int v_rd_base(int lane) { return ((lane & 3) << 3) | (((lane >> 2) & 3) << 6) | (((lane >> 4) & 1) << 5) | (((lane >> 5) & 1) << 8); }
constexpr int v_rd_off(int d0, int ks, int half) { return d0 * 512 + ks * 4096 + half * 2048; }
__device__ __forceinline__ int crow(int r, int hi) { return (r & 3) + 8 * (r >> 2) + 4 * hi; }
__device__ __forceinline__ int bias_slot(int kk) { return ((kk >> 2) & 1) * 32 + (kk >> 5) * 16 + (kk & 3) + 4 * ((kk & 31) >> 3); }
__device__ __forceinline__ unsigned cvtpk(float lo, float hi) {
    unsigned r; asm volatile("v_cvt_pk_bf16_f32 %0, %1, %2" : "=v"(r) : "v"(lo), "v"(hi)); return r;
}
__device__ __forceinline__ bf16x8 pack8(f32x4 a, f32x4 b) {
    u32x4 w = {cvtpk(a[0], a[1]), cvtpk(a[2], a[3]), cvtpk(b[0], b[1]), cvtpk(b[2], b[3])};
    return *reinterpret_cast<bf16x8*>(&w);
}
template <class T> __device__ __forceinline__ bf16x8 load8(const T* p) {
    if constexpr (same_t<T, float>::v) { return pack8(*(const f32x4*)p, *(const f32x4*)(p + 4)); }
    else { return *reinterpret_cast<const bf16x8*>(p); }
}
__device__ __forceinline__ void mask_tile(f32x16& p0, f32x16& p1, int dq, unsigned W) {
    const float NEG = -__builtin_inff();
#pragma unroll
    for (int r = 0; r < 16; ++r) {
        const int c = (r & 3) + 8 * (r >> 2);
        if ((unsigned)(dq - c) >= W) p0[r] = NEG;
        if ((unsigned)(dq - c - 32) >= W) p1[r] = NEG;
    }
}
__device__ __forceinline__ void partialSM(f32x16& p0, f32x16& p1, float& m_reg, float& mn, float& alpha) {
    float pmax = p0[0]; for (int r = 1; r < 16; ++r) pmax = fmaxf(pmax, p0[r]); for (int r = 0; r < 16; ++r) pmax = fmaxf(pmax, p1[r]);
    { auto rr = __builtin_amdgcn_permlane32_swap(__float_as_uint(pmax), __float_as_uint(pmax), false, false);
      pmax = fmaxf(__uint_as_float(rr[0]), __uint_as_float(rr[1])); }
    constexpr float C2 = 1.4426950408889634f * SCALE;
    if (__builtin_expect(__all((pmax - m_reg) * SCALE <= THR), 1)) { mn = m_reg; alpha = 1.f; }
    else { mn = fmaxf(m_reg, pmax); alpha = __builtin_amdgcn_exp2f((m_reg - mn) * C2); m_reg = mn; }
    const float mnL = -mn * C2;
    for (int r = 0; r < 16; ++r) p0[r] = fmaf(p0[r], C2, mnL); for (int r = 0; r < 16; ++r) p1[r] = fmaf(p1[r], C2, mnL);
    for (int r = 0; r < 16; ++r) p0[r] = __builtin_amdgcn_exp2f(p0[r]);
}
__device__ __forceinline__ void finishSM(f32x16& p0, f32x16& p1, float alpha, float& l_reg, bf16x8& pa0, bf16x8& pa1, bf16x8& pa2, bf16x8& pa3) {
    for (int r = 0; r < 16; ++r) p1[r] = __builtin_amdgcn_exp2f(p1[r]);
    float ps = 0; for (int r = 0; r < 16; ++r) ps += p0[r]; for (int r = 0; r < 16; ++r) ps += p1[r];
    { auto rr = __builtin_amdgcn_permlane32_swap(__float_as_uint(ps), __float_as_uint(ps), false, false);
      ps = __uint_as_float(rr[0]) + __uint_as_float(rr[1]); }
    l_reg = l_reg * alpha + ps;
#define PK4(P, B_, OUT) do { unsigned a0 = cvtpk(P[B_+0], P[B_+1]), a1 = cvtpk(P[B_+2], P[B_+3]);                          \
        unsigned b0 = cvtpk(P[B_+4], P[B_+5]), b1 = cvtpk(P[B_+6], P[B_+7]);                                             \
        auto r0 = __builtin_amdgcn_permlane32_swap(a0, b0, false, false); auto r1 = __builtin_amdgcn_permlane32_swap(a1, b1, false, false); \
        u32x4 w = {r0[0], r1[0], r0[1], r1[1]}; OUT = *reinterpret_cast<bf16x8*>(&w); } while (0)
    PK4(p0, 0, pa0); PK4(p0, 8, pa1); PK4(p1, 0, pa2); PK4(p1, 8, pa3);
#undef PK4
}
template <int KB, bool SK>
__device__ __forceinline__ void qkt(f32x16& p0, f32x16& p1, const char* K_lds, int r32, int hi, const bf16x8* qr, bool act) {
    if (SK && !act) { const float NEG = -__builtin_inff();
#pragma unroll
        for (int r = 0; r < 16; ++r) { p0[r] = NEG; p1[r] = NEG; } return; }
    { const f32x16* bp = reinterpret_cast<const f32x16*>(K_lds - 2 * SHM_V + LDS_BIAS + KB * 256 + hi * 128); p0 = bp[0]; p1 = bp[1]; }
    const char* kb[4];
#pragma unroll
    for (int dd = 0; dd < 4; ++dd) kb[dd] = K_lds + KB * SHM_K + KSWZ(r32, (dd * 16 + hi * 8) * 2);
#pragma unroll
    for (int d0 = 0; d0 < 8; ++d0) { const char* a = kb[d0 & 3] + (d0 >> 2) * 128;
        bf16x8 b0 = *reinterpret_cast<const bf16x8*>(a);
        bf16x8 b1 = *reinterpret_cast<const bf16x8*>(a + 32 * 256);
        p0 = __builtin_amdgcn_mfma_f32_32x32x16_bf16(b0, qr[d0], p0, 0, 0, 0);
        p1 = __builtin_amdgcn_mfma_f32_32x32x16_bf16(b1, qr[d0], p1, 0, 0, 0); }
}
template <int VB, bool SK>
__device__ __forceinline__ void pv_tile(f32x16* o, int vb0, bf16x8 pa0, bf16x8 pa1, bf16x8 pa2, bf16x8 pa3, bool act) {
    if (SK && !act) return;
#define TRRD(dst, off) asm volatile("ds_read_b64_tr_b16 %0, %1 offset:%2" : "=&v"(dst) : "v"(vb0), "i"(off) : "memory")
#define PV_D0(d0) do { s16x4 l0, l1, l2, l3, h0, h1, h2, h3; constexpr int b_ = VB * SHM_V + v_rd_off(d0, 0, 0);     \
        TRRD(l0, b_); TRRD(h0, b_ + 2048); TRRD(l1, b_ + 4096); TRRD(h1, b_ + 6144); TRRD(l2, b_ + 8192); TRRD(h2, b_ + 10240); TRRD(l3, b_ + 12288); TRRD(h3, b_ + 14336); \
        asm volatile("s_waitcnt lgkmcnt(0)" ::: "memory"); SBAR();                 \
        o[d0] = __builtin_amdgcn_mfma_f32_32x32x16_bf16(pa0, (bf16x8){l0[0], l0[1], l0[2], l0[3], h0[0], h0[1], h0[2], h0[3]}, o[d0], 0, 0, 0);   \
        o[d0] = __builtin_amdgcn_mfma_f32_32x32x16_bf16(pa1, (bf16x8){l1[0], l1[1], l1[2], l1[3], h1[0], h1[1], h1[2], h1[3]}, o[d0], 0, 0, 0);   \
        o[d0] = __builtin_amdgcn_mfma_f32_32x32x16_bf16(pa2, (bf16x8){l2[0], l2[1], l2[2], l2[3], h2[0], h2[1], h2[2], h2[3]}, o[d0], 0, 0, 0);   \
        o[d0] = __builtin_amdgcn_mfma_f32_32x32x16_bf16(pa3, (bf16x8){l3[0], l3[1], l3[2], l3[3], h3[0], h3[1], h3[2], h3[3]}, o[d0], 0, 0, 0); } while (0)
    PV_D0(0); PV_D0(1); PV_D0(2); PV_D0(3);
#undef PV_D0
#undef TRRD
}

template <class TIn, class TOut> struct BlockRef { const TIn* Q; const TIn* K; const TIn* V; TOut* O; int P0; const float* Fb; const float* gain;
    int jlo, jhi;
    float* Op; float* ML; };
template <class TIn> struct Seam {
    bf16x8 qr[8];
    bf16x8 st_v0, st_v1, st_k0, st_k1; f32x4 sf0, sf1, sf2, sf3; float st_b;
    f32x4 tq[16];
};
__device__ __forceinline__ int swa_jlo(int P0, int W) { const int lowk = P0 - W + 1; return lowk > 0 ? lowk / KVBLK : 0; }
#define ROW(p, k0, rr) ((p) + (size_t)((k0) + (rr)) * PITCH + sc)
#define VMW() asm volatile("s_waitcnt vmcnt(0)" ::: "memory")
#define VMWN(n) asm volatile("s_waitcnt vmcnt(%0)" :: "i"(n) : "memory")
#define SLOAD_H(Kp, Vp, k0) SLOAD_HB(Kp, Vp, k0, cur)
#define SLOAD_HB(Kp, Vp, k0, blk) do { S.st_v0 = load8<TIn>(ROW(Vp, k0, sr)); S.st_v1 = load8<TIn>(ROW(Vp, k0, 32 + sr));              \
                         S.st_k0 = load8<TIn>(ROW(Kp, k0, sr)); S.st_k1 = load8<TIn>(ROW(Kp, k0, 32 + sr)); \
                         if (tid < 64) S.st_b = ((blk).Fb[(blk).P0] - (blk).Fb[(k0) + tid]) * (1.0f / SCALE); } while (0)
#define SWRITE_HK(bf) do { *(bf16x8*)(K_lds + (bf) * SHM_K + kws) = S.st_k0; *(bf16x8*)(K_lds + (bf) * SHM_K + kws + 32 * 256) = S.st_k1; \
                         if (tid < 64) *(float*)(K_lds - 2 * SHM_V + LDS_BIAS + (bf) * 256 + bws) = S.st_b; } while (0)
#define SWRITE_HV(bf) do { *(bf16x8*)(V_lds + (bf) * SHM_V + vst0) = S.st_v0; *(bf16x8*)(V_lds + (bf) * SHM_V + vst1) = S.st_v1; } while (0)
#define SWRITE_H(bf) do { SWRITE_HV(bf); SWRITE_HK(bf); } while (0)
#define SLOAD_F(p, k0) do { S.sf0 = *(const f32x4*)ROW(p, k0, sr); S.sf1 = *(const f32x4*)(ROW(p, k0, sr) + 4);                \
                            S.sf2 = *(const f32x4*)ROW(p, k0, 32 + sr); S.sf3 = *(const f32x4*)(ROW(p, k0, 32 + sr) + 4); } while (0)
#define SWRITE_KF(bf) do { *(bf16x8*)(K_lds + (bf) * SHM_K + kws) = pack8(S.sf0, S.sf1); *(bf16x8*)(K_lds + (bf) * SHM_K + kws + 32 * 256) = pack8(S.sf2, S.sf3); } while (0)
#define SWRITE_VF(bf) do { *(bf16x8*)(V_lds + (bf) * SHM_V + vst0) = pack8(S.sf0, S.sf1); *(bf16x8*)(V_lds + (bf) * SHM_V + vst1) = pack8(S.sf2, S.sf3); } while (0)
template <class TIn, class TOut>
__device__ __forceinline__ void causal_swa_prime(const BlockRef<TIn, TOut>& cur, int W, char* lds, Seam<TIn>& S) {
    constexpr bool F32 = same_t<TIn, float>::v;
    const int tid = threadIdx.x, wid = __builtin_amdgcn_readfirstlane(tid >> 6), lane = tid & 63, r32 = lane & 31, hi = lane >> 5;
    const int sr = tid >> 4, sc = (tid & 15) * 8, kws = KSWZ(sr, sc * 2); char* K_lds = lds + 2 * SHM_V;
    const int bws = bias_slot(tid & 63) * 4;
    const int kb0 = cur.jlo * KVBLK;
    for (int d0 = 0; d0 < 8; ++d0) S.qr[d0] = load8<TIn>(cur.Q + (size_t)(wid * QBLK + r32) * PITCH + d0 * 16 + hi * 8);
    if constexpr (F32) { SLOAD_F((const float*)cur.K, kb0); VMW(); SWRITE_KF(0); SBAR(); SLOAD_F((const float*)cur.V, kb0); }
    else { SLOAD_H(cur.K, cur.V, kb0); VMW(); SWRITE_HK(0); }
    __syncthreads();
}
template <class TIn, class TOut>
__device__ __forceinline__ void causal_swa_block(const BlockRef<TIn, TOut>& cur, const BlockRef<TIn, TOut>& nxt, int skv, int W, char* lds, Seam<TIn>& S) {
    constexpr bool F32 = same_t<TIn, float>::v;
    const int tid = threadIdx.x, wid = __builtin_amdgcn_readfirstlane(tid >> 6), lane = tid & 63, r32 = lane & 31, hi = lane >> 5;
    const int j_lo = cur.jlo; const int j_hi = cur.jhi;
    const int NT = j_hi - j_lo;
    const int kbn = nxt.jlo * KVBLK;
    const int qlo = cur.P0 + wid * QBLK, qm = qlo + r32 - 4 * hi;
    char* V_lds = lds; char* K_lds = lds + 2 * SHM_V;
    float* ws = (float*)(lds + 2 * SHM_V + 2 * SHM_K) + wid * 64; float* li_l = ws, * al_l = ws + 32;
    float m_reg = -1e30f, l_reg = 0; f32x16 o[4] = {};
    const int sr = tid >> 4, sc = (tid & 15) * 8, vst0 = v_st(sr, sc), vst1 = v_st(32 + sr, sc), kws = KSWZ(sr, sc * 2);
    const int bws = bias_slot(tid & 63) * 4;
    const int vb0 = (int)(uintptr_t)V_lds + v_rd_base(lane);
    const TIn* Kh = cur.K; const TIn* Vh = cur.V;
#define RESC(a) do { if (__any((a) < 1.f)) { if (hi == 0) al_l[r32] = (a); asm volatile("s_waitcnt lgkmcnt(0)" ::: "memory");              \
                     for (int d_ = 0; d_ < 4; ++d_) for (int r = 0; r < 16; ++r) o[d_][r] *= al_l[crow(r, hi)]; } } while (0)
#define KBASE(t) ((j_lo + (t)) * KVBLK)
#define ACT(t) (KBASE(t) <= qlo + QBLK - 1 && KBASE(t) + KVBLK - 1 >= qlo - W + 1)
#define MASKT(P0_, P1_, t) do { const int kb_ = KBASE(t); if ((!SK || ACT(t)) && (kb_ + KVBLK - 1 > qlo || kb_ <= qlo + QBLK - 1 - W)) mask_tile(P0_, P1_, qm - kb_, (unsigned)W); } while (0)
    constexpr int NQL = F32 ? 16 : 8;
    constexpr bool SK = WSKIP && !F32;
#define SEAM_K0() do { VMWN(NQL); if constexpr (F32) { SWRITE_KF(0); SBAR(); SLOAD_F((const float*)nxt.V, kbn); } else { SWRITE_HK(0); } SBAR(); } while (0)
    f32x16 pA0, pA1, pB0, pB1; float mnA, mnB, alA, alB; bf16x8 pa0, pa1, pa2, pa3;
    if constexpr (F32) { VMW(); SWRITE_VF(0); SBAR(); } else { SWRITE_HV(0); SBAR(); }
    if (NT > 1) { if constexpr (F32) SLOAD_F((const float*)Kh, KBASE(1)); else SLOAD_H(Kh, Vh, KBASE(1)); }
    SBAR(); qkt<0, SK>(pA0, pA1, K_lds, r32, hi, S.qr, ACT(0));
    if constexpr (F32) { if (NT > 1) { VMW(); SWRITE_KF(1); SBAR(); SLOAD_F((const float*)Vh, KBASE(1)); } }
    MASKT(pA0, pA1, 0); partialSM(pA0, pA1, m_reg, mnA, alA);
    if (NT > 1) { VMW(); if constexpr (F32) { SWRITE_VF(1); SBAR(); if (NT > 2) SLOAD_F((const float*)Kh, KBASE(2)); } else SWRITE_H(1); }
    __syncthreads();
#define HALF_STEP(PX0, PX1, mnX, alX, PY0, PY1, alY, t, KB, VB, SB) do {                                                      \
        SBAR(); qkt<KB, SK>(PX0, PX1, K_lds, r32, hi, S.qr, ACT(t));                                             \
        finishSM(PY0, PY1, alY, l_reg, pa0, pa1, pa2, pa3); SBAR();                                                           \
        if ((t) + 1 < NT) { if constexpr (F32) { VMW(); SWRITE_KF(SB); SBAR(); SLOAD_F((const float*)Vh, KBASE((t) + 1)); }  \
                            else { SLOAD_H(Kh, Vh, KBASE((t) + 1)); } SBAR(); }                                               \
        pv_tile<VB, SK>(o, vb0, pa0, pa1, pa2, pa3, ACT((t) - 1)); MASKT(PX0, PX1, (t)); partialSM(PX0, PX1, m_reg, mnX, alX);                                        \
        __syncthreads();                                                                                                      \
        if ((t) + 1 < NT) { VMW(); if constexpr (F32) { SWRITE_VF(SB); SBAR(); if ((t) + 2 < NT) SLOAD_F((const float*)Kh, KBASE((t) + 2)); } \
                            else { SWRITE_H(SB); } }                                                                          \
        RESC(alX); __syncthreads(); } while (0)
    for (int t = 1; t + 1 < NT; t += 2) {
        HALF_STEP(pB0, pB1, mnB, alB, pA0, pA1, alA, t, 1, 0, 0);
        HALF_STEP(pA0, pA1, mnA, alA, pB0, pB1, alB, t + 1, 0, 1, 1);
    }
    const bool even = (NT & 1) == 0;
    if (even) { SBAR(); qkt<1, SK>(pB0, pB1, K_lds, r32, hi, S.qr, ACT(NT - 1)); SBAR(); }
#define QROW(e) (nxt.Q + (size_t)(wid * QBLK + r32) * PITCH + ((e) >> 1) * 16 + hi * 8 + ((e) & 1) * 4)
    if constexpr (F32) { SLOAD_F((const float*)nxt.K, kbn); SBAR();
#pragma unroll
        for (int e = 0; e < 8; ++e) S.tq[e] = *(const f32x4*)QROW(e); }
    else { SLOAD_HB(nxt.K, nxt.V, kbn, nxt); SBAR();
#pragma unroll
        for (int d0 = 0; d0 < 8; ++d0) S.qr[d0] = load8<TIn>(nxt.Q + (size_t)(wid * QBLK + r32) * PITCH + d0 * 16 + hi * 8); }
    SBAR();
    finishSM(pA0, pA1, alA, l_reg, pa0, pa1, pa2, pa3); SBAR();
    if constexpr (F32) {
#pragma unroll
        for (int e = 8; e < 16; ++e) S.tq[e] = *(const f32x4*)QROW(e); SBAR(); }
#undef QROW
    pv_tile<0, SK>(o, vb0, pa0, pa1, pa2, pa3, ACT(even ? NT - 2 : NT - 1));
    if (even) { MASKT(pB0, pB1, NT - 1); partialSM(pB0, pB1, m_reg, mnB, alB); __syncthreads(); RESC(alB);
        finishSM(pB0, pB1, alB, l_reg, pa0, pa1, pa2, pa3); SBAR(); pv_tile<1, SK>(o, vb0, pa0, pa1, pa2, pa3, ACT(NT - 1)); }
    SBAR(); SEAM_K0();
    if (hi == 0) li_l[r32] = l_reg; asm volatile("s_waitcnt lgkmcnt(0)" ::: "memory");
    if (cur.Op != nullptr) {
        int rp = r32; asm volatile("" : "+v"(rp));
        if (hi == 0) { float2 mlv; mlv.x = m_reg; mlv.y = l_reg; *(float2*)(cur.ML + 2 * (wid * QBLK + rp)) = mlv; }
        float* Pr = cur.Op + (size_t)(wid * QBLK + 4 * hi) * D + rp;
#pragma unroll
        for (int r = 0; r < 16; ++r) {
#pragma unroll
            for (int d0 = 0; d0 < 4; ++d0) Pr[d0 * 32] = o[d0][r];
            Pr += ((r & 3) == 3 ? 5 : 1) * D; asm volatile("" : "+v"(Pr) :: "memory"); }
    } else {
    int ro = r32; asm volatile("" : "+v"(ro));
    TOut* Or = cur.O + (size_t)(wid * QBLK + 4 * hi) * OPITCH + ro;
    float gn[4];
#pragma unroll
    for (int d0 = 0; d0 < 4; ++d0) gn[d0] = cur.gain[d0 * 32 + ro];
#pragma unroll
    for (int r = 0; r < 16; ++r) { const int orow = crow(r, hi); const float rl = __builtin_amdgcn_rcpf(li_l[orow]);
        float v[4]; float ss = 0.f;
#pragma unroll
        for (int d0 = 0; d0 < 4; ++d0) { v[d0] = o[d0][r] * rl; ss += v[d0] * v[d0]; }
        ss += __shfl_xor(ss, 1); ss += __shfl_xor(ss, 2); ss += __shfl_xor(ss, 4); ss += __shfl_xor(ss, 8); ss += __shfl_xor(ss, 16);
        const float rn = __builtin_amdgcn_rsqf(ss * (1.0f / 128.0f) + 1e-6f);
#pragma unroll
        for (int d0 = 0; d0 < 4; ++d0) { const float vv = v[d0] * rn * gn[d0]; const float vn = __shfl_xor(vv, 1);
            if ((ro & 1) == 0) *(unsigned*)(Or + d0 * 32) = cvtpk(vv, vn); }
        Or += ((r & 3) == 3 ? 5 : 1) * OPITCH; asm volatile("" : "+v"(Or) :: "memory"); }
    }
    if constexpr (F32) {
#pragma unroll
        for (int d0 = 0; d0 < 8; ++d0) S.qr[d0] = pack8(S.tq[2 * d0], S.tq[2 * d0 + 1]); }
    __syncthreads();
#undef RESC
#undef KBASE
#undef ACT
#undef MASKT
#undef SEAM_K0
#undef HALF_STEP
}
#undef ROW
#undef VMW
#undef VMWN
#undef SLOAD_H
#undef SWRITE_HK
#undef SWRITE_HV
#undef SWRITE_H
#undef SLOAD_F
#undef SWRITE_KF
#undef SWRITE_VF

}
namespace mk {
typedef short s16x8 __attribute__((ext_vector_type(8)));
#define MFMA32(a, b, c) __builtin_amdgcn_mfma_f32_32x32x16_bf16((a), (b), (c), 0, 0, 0)
__device__ __forceinline__ int crow32(int r, int hi) { return (r & 3) + 8 * (r >> 2) + 4 * hi; }
constexpr float SCALEQ = 0.08838834764831845f;
__device__ __forceinline__ float wave_scan_add(float v, int lane) {
#pragma unroll
    for (int o = 1; o < 64; o <<= 1) { const float t = __shfl_up(v, o); if (lane >= o) v += t; }
    return v;
}
__device__ __forceinline__ float wave_scan_max(float v, int lane) {
#pragma unroll
    for (int o = 1; o < 64; o <<= 1) { const float t = __shfl_up(v, o); if (lane >= o) v = fmaxf(v, t); }
    return v;
}
__device__ __forceinline__ float wave_max(float v) {
#pragma unroll
    for (int o = 1; o < 64; o <<= 1) v = fmaxf(v, __shfl_xor(v, o));
    return v;
}
constexpr int TSTR = 72;
template <bool SCALED>
__device__ __forceinline__ void stage_transposed(const bf16* src, int ncols, LAS bf16* T, const LAS float* wl, int tid) {
    const int cpr = ncols / 8;
    for (int q = tid; q < 64 * cpr; q += NTHR) { const int s = q / cpr, c8 = (q % cpr) * 8;
        const v4u raw = *(const GAS v4u*)(src + (size_t)s * NPP + c8);
        const unsigned w4[4] = {raw.x, raw.y, raw.z, raw.w};
#pragma unroll
        for (int j = 0; j < 4; ++j) { unsigned lo = w4[j] & 0xffffu, hi = w4[j] >> 16;
            if (SCALED) { const float sc = wl[s]; lo = f2bf(bf2f((unsigned short)lo) * sc); hi = f2bf(bf2f((unsigned short)hi) * sc); }
            T[(c8 + 2 * j) * TSTR + s] = (bf16)lo; T[(c8 + 2 * j + 1) * TSTR + s] = (bf16)hi; } }
}
__device__ __forceinline__ void p3_prep(Frame& F) {
    const int gw = F.vcu * NWAVES + F.wave, NGW = F.G * NWAVES, lane = F.lane, tid = F.tid;
    bf16* proj = wsp<bf16>(F, WS_PROJ); const float* gates = wsp<float>(F, WS_GATES);
    {
        const int seg = lane >> 2, qd = (lane & 3) * 32; const float* gn = (seg < 8 ? F.in[IN_FOXQN] : F.in[IN_FOXKN]) + qd;
        for (int m = gw; m < S; m += NGW) {
            bf16* p = proj + (size_t)m * NPP + C_FQ + seg * 128 + qd; v4u raw[4]; float x[32]; float ss = 0.f;
#pragma unroll
            for (int j = 0; j < 4; ++j) raw[j] = *(const GAS v4u*)(p + 8 * j);
#pragma unroll
            for (int j = 0; j < 4; ++j) { const unsigned w4[4] = {raw[j].x, raw[j].y, raw[j].z, raw[j].w};
#pragma unroll
                for (int i = 0; i < 4; ++i) { x[8 * j + 2 * i] = bf2f((unsigned short)(w4[i] & 0xffffu)); x[8 * j + 2 * i + 1] = bf2f((unsigned short)(w4[i] >> 16)); } }
#pragma unroll
            for (int i = 0; i < 32; ++i) ss += x[i] * x[i];
            ss += __shfl_xor(ss, 1); ss += __shfl_xor(ss, 2);
            const float r = rsqrtf(ss * (1.f / 128.f) + 1e-6f);
#pragma unroll
            for (int j = 0; j < 4; ++j) { v4u o; const f32x4 g0 = *(const GAS f32x4*)(gn + 8 * j), g1 = *(const GAS f32x4*)(gn + 8 * j + 4);
                o.x = pk2(x[8 * j] * r * g0.x, x[8 * j + 1] * r * g0.y); o.y = pk2(x[8 * j + 2] * r * g0.z, x[8 * j + 3] * r * g0.w);
                o.z = pk2(x[8 * j + 4] * r * g1.x, x[8 * j + 5] * r * g1.y); o.w = pk2(x[8 * j + 6] * r * g1.z, x[8 * j + 7] * r * g1.w);
                *(GAS v4u*)(p + 8 * j) = o; }
        }
    }
    if (blockIdx.x < 8) {
        const int h = blockIdx.x; const float b = F.in[IN_FOXBF][h]; float* Fo = wsp<float>(F, WS_F) + h * S;
        LAS double* tot = (LAS double*)(F.lds + RING_OFF);
        double loc[16]; double acc = 0.0;
#pragma unroll
        for (int i = 0; i < 16; ++i) { acc += (double)log_sigmoid_f(gates[(size_t)(tid * 16 + i) * 16 + 8 + h] + b); loc[i] = acc; }
        tot[tid] = acc;
        __syncthreads();
        if (F.wave == 0) { double v[8]; double s = 0.0;
#pragma unroll
            for (int i = 0; i < 8; ++i) { v[i] = tot[lane * 8 + i]; s += v[i]; }
            double inc = s;
#pragma unroll
            for (int o = 1; o < 64; o <<= 1) { const double t = __shfl_up(inc, o); if (lane >= o) inc += t; }
            double ex = inc - s;
#pragma unroll
            for (int i = 0; i < 8; ++i) { tot[lane * 8 + i] = ex; ex += v[i]; } }
        __syncthreads();
        const double off = tot[tid];
        LAS float* Fl = (LAS float*)(F.lds + RING_OFF + 8192);
#pragma unroll
        for (int i = 0; i < 16; ++i) { const float fv = (float)(off + loc[i]); Fo[tid * 16 + i] = fv; Fl[tid * 16 + i] = fv; }
        __syncthreads();
        if (tid < 32) {
            float gq = 0.f, gk = 0.f;
            for (int d = 0; d < 128; ++d) { gq = fmaxf(gq, fabsf(F.in[IN_FOXQN][d])); gk = fmaxf(gk, fabsf(F.in[IN_FOXKN][d])); }
            const float thr = 2.f * 11.3137085f * gq * gk + 26.f;
            const int qb = tid, P0 = qb * 256; const float f0 = Fl[P0];
            int lo = 0, hi2 = 4 * qb;
            while (lo < hi2) { const int mid = (lo + hi2) >> 1; if (Fl[64 * mid + 63] - f0 <= thr) hi2 = mid; else lo = mid + 1; }
            wsp<int>(F, WS_JLO)[h * 32 + qb] = lo;
        }
        __syncthreads();
    }
    {
        LAS bf16* KT = (LAS bf16*)(F.lds + RING_OFF);
        LAS bf16* VT = KT + 128 * TSTR;
        LAS float* wl = (LAS float*)(VT + 256 * TSTR);
        float* UL = wsp<float>(F, WS_UL); float* NL = wsp<float>(F, WS_NL); float* GLAL = wsp<float>(F, WS_GLAL);
        const int hi = lane >> 5, l31 = lane & 31, w = F.wave;
        for (int u = F.vcu; u < 4 * NCH; u += F.G) {
            const int h = u >> 7, ch = u & 127, t0 = ch * LCH;
            if (w == 0) {
                const float ip = softcap_f(gates[(size_t)(t0 + lane) * 16 + h] + F.in[IN_BI][h]);
                const float fp = softcap_f(gates[(size_t)(t0 + lane) * 16 + 4 + h] + F.in[IN_BF][h]);
                const float g = wave_scan_add(log_sigmoid_f(fp), lane), a = ip - g, amax = wave_max(a);
                wl[lane] = __expf(a - amax);
                if (lane == 63) { GLAL[u * 2] = g; GLAL[u * 2 + 1] = amax; }
            }
            __syncthreads();
            stage_transposed<true>(proj + (size_t)t0 * NPP + C_MK + h * 128, 128, KT, wl, tid);
            stage_transposed<false>(proj + (size_t)t0 * NPP + C_MV + h * 256, 256, VT, wl, tid);
            __syncthreads();
            f32x16 acc[4];
#pragma unroll
            for (int dt = 0; dt < 4; ++dt)
#pragma unroll
                for (int r = 0; r < 16; ++r) acc[dt][r] = 0.f;
#pragma unroll
            for (int ks = 0; ks < 4; ++ks) { const s16x8 a = *(const LAS s16x8*)(VT + (32 * w + l31) * TSTR + 16 * ks + 8 * hi);
#pragma unroll
                for (int dt = 0; dt < 4; ++dt) { const s16x8 b = *(const LAS s16x8*)(KT + (32 * dt + l31) * TSTR + 16 * ks + 8 * hi); acc[dt] = MFMA32(a, b, acc[dt]); } }
            float* ut = UL + (size_t)u * 256 * 128;
#pragma unroll
            for (int dt = 0; dt < 4; ++dt)
#pragma unroll
                for (int r = 0; r < 16; ++r) ut[(size_t)(32 * w + crow32(r, hi)) * 128 + 32 * dt + l31] = acc[dt][r];
            if (tid < 128) { float s = 0.f;
#pragma unroll
                for (int j = 0; j < 8; ++j) { const s16x8 kv = *(const LAS s16x8*)(KT + tid * TSTR + 8 * j);
#pragma unroll
                    for (int i = 0; i < 8; ++i) s += bf2f((unsigned short)kv[i]); }
                NL[u * 128 + tid] = s; }
            __syncthreads();
        }
    }
}
__device__ __forceinline__ void p4_scan(Frame& F) {
    LAS float* gl = (LAS float*)(F.lds + RING_OFF);
    LAS float* dec = gl + 256; LAS float* scl = dec + 128; LAS float* mv = scl + 128;
    const float* UL = wsp<float>(F, WS_UL); const float* NL = wsp<float>(F, WS_NL); const float* GLAL = wsp<float>(F, WS_GLAL);
    bf16* CS = wsp<bf16>(F, WS_CS); float* NS = wsp<float>(F, WS_NS); float* MS = wsp<float>(F, WS_MS);
    const int tid = F.tid;
    for (int blk = F.vcu; blk < 4 * 64; blk += F.G) {
        const int h = blk >> 6, rem0 = (blk & 63) * 512;
        if (tid < 256) gl[tid] = GLAL[h * 256 + tid];
        __syncthreads();
        if (tid == 0) { float m = 0.f;
            for (int c = 0; c < NCH; ++c) { const float g = gl[2 * c], al = gl[2 * c + 1], mn = g + fmaxf(m, al);
                mv[c] = m; dec[c] = __expf(g + m - mn); scl[c] = __expf(g + al - mn); m = mn; } }
        __syncthreads();
        if (rem0 == 0 && tid < 128) MS[h * 128 + tid] = mv[tid];
        const int rem = rem0 + tid;
        const float* ul = UL + (size_t)h * NCH * 32768 + rem; bf16* cs = CS + (size_t)h * NCH * 32768 + rem;
        float C = 0.f;
#pragma unroll 32
        for (int c = 0; c < NCH; ++c) { cs[(size_t)c * 32768] = (bf16)f2bf(C); C = dec[c] * C + scl[c] * ul[(size_t)c * 32768]; }
        if (rem0 == 0 && tid < 128) { float n = 0.f; const float* nl = NL + (size_t)h * NCH * 128 + tid; float* ns = NS + (size_t)h * NCH * 128 + tid;
#pragma unroll 8
            for (int c = 0; c < NCH; ++c) { ns[c * 128] = n; n = dec[c] * n + scl[c] * nl[c * 128]; } }
        __syncthreads();
    }
}
constexpr int NUMSTR = 260;
__device__ __forceinline__ void p5_mlstm_out(Frame& F) {
    LAS bf16* VT = (LAS bf16*)(F.lds + RING_OFF);
    LAS bf16* Pm = VT + 256 * TSTR;
    LAS float* NUM = (LAS float*)(Pm + 64 * TSTR);
    LAS float* a_s = NUM + 64 * NUMSTR; LAS float* Mt = a_s + 64; LAS float* inter = Mt + 64; LAS float* emt = inter + 64; LAS float* qn = emt + 64; LAS float* dinv = qn + 64;
    const bf16* proj = wsp<bf16>(F, WS_PROJ); const float* gates = wsp<float>(F, WS_GATES); const bf16* CS = wsp<bf16>(F, WS_CS);
    const float* NS = wsp<float>(F, WS_NS); const float* MS = wsp<float>(F, WS_MS); bf16* concat = wsp<bf16>(F, WS_CONCAT);
    const int tid = F.tid, lane = F.lane, w = F.wave, hi = lane >> 5, l31 = lane & 31;
    for (int u = F.vcu; u < 4 * NCH; u += F.G) {
        const int h = u >> 7, ch = u & 127, t0 = ch * LCH;
        const bf16* qbase = proj + (size_t)t0 * NPP + C_MQ + h * 128; const bf16* kbase = proj + (size_t)t0 * NPP + C_MK + h * 128;
        if (w == 0) {
            const float ip = softcap_f(gates[(size_t)(t0 + lane) * 16 + h] + F.in[IN_BI][h]);
            const float fp = softcap_f(gates[(size_t)(t0 + lane) * 16 + 4 + h] + F.in[IN_BF][h]);
            const float g = wave_scan_add(log_sigmoid_f(fp), lane), a = ip - g, cm = wave_scan_max(a, lane);
            const float mp = MS[u], M = fmaxf(mp, cm);
            a_s[lane] = a; Mt[lane] = M; inter[lane] = __expf(mp - M); emt[lane] = __expf(-(g + M));
        }
        stage_transposed<false>(proj + (size_t)t0 * NPP + C_MV + h * 256, 256, VT, a_s, tid);
        __syncthreads();
        if (w < 4) {
            const int ti = w >> 1, si = w & 1;
            if (si <= ti) {
                s16x8 qa[8], kb[8];
#pragma unroll
                for (int ks = 0; ks < 8; ++ks) { qa[ks] = *(const GAS s16x8*)(qbase + (size_t)(32 * ti + l31) * NPP + 16 * ks + 8 * hi); kb[ks] = *(const GAS s16x8*)(kbase + (size_t)(32 * si + l31) * NPP + 16 * ks + 8 * hi); }
                f32x16 acc;
#pragma unroll
                for (int r = 0; r < 16; ++r) acc[r] = 0.f;
#pragma unroll
                for (int ks = 0; ks < 8; ++ks) acc = MFMA32(qa[ks], kb[ks], acc);
                const int s = 32 * si + l31; const float as = a_s[s];
#pragma unroll
                for (int r = 0; r < 16; ++r) { const int t = 32 * ti + crow32(r, hi); const float p = (s <= t) ? acc[r] * SCALEQ * __expf(as - Mt[t]) : 0.f; Pm[t * TSTR + s] = (bf16)f2bf(p); }
            } else {
#pragma unroll
                for (int r = 0; r < 16; ++r) Pm[(32 * ti + crow32(r, hi)) * TSTR + 32 * si + l31] = (bf16)0;
            }
        } else {
            const int t = (tid - 256) >> 2, d0 = ((tid - 256) & 3) * 32; float s = 0.f; const float* np = NS + (size_t)u * 128 + d0;
#pragma unroll
            for (int j = 0; j < 4; ++j) { const s16x8 qv = *(const GAS s16x8*)(qbase + (size_t)t * NPP + d0 + 8 * j);
#pragma unroll
                for (int i = 0; i < 8; ++i) s += bf2f((unsigned short)qv[i]) * np[8 * j + i]; }
            s += __shfl_xor(s, 1); s += __shfl_xor(s, 2);
            if ((tid & 3) == 0) qn[t] = s * SCALEQ;
        }
        __syncthreads();
        f32x16 accP[2], accC[2];
#pragma unroll
        for (int ti = 0; ti < 2; ++ti)
#pragma unroll
            for (int r = 0; r < 16; ++r) { accP[ti][r] = 0.f; accC[ti][r] = 0.f; }
        {
            const bf16* cs = CS + (size_t)u * 32768 + (size_t)(32 * w + l31) * 128 + 8 * hi;
            s16x8 cb[8];
#pragma unroll
            for (int ks = 0; ks < 8; ++ks) cb[ks] = *(const GAS s16x8*)(cs + 16 * ks);
#pragma unroll
            for (int ti = 0; ti < 2; ++ti) {
                s16x8 qa[8];
#pragma unroll
                for (int ks = 0; ks < 8; ++ks) qa[ks] = *(const GAS s16x8*)(qbase + (size_t)(32 * ti + l31) * NPP + 16 * ks + 8 * hi);
#pragma unroll
                for (int ks = 0; ks < 8; ++ks) accC[ti] = MFMA32(qa[ks], cb[ks], accC[ti]);
            }
#pragma unroll
            for (int ks = 0; ks < 4; ++ks) { const s16x8 vb = *(const LAS s16x8*)(VT + (32 * w + l31) * TSTR + 16 * ks + 8 * hi);
#pragma unroll
                for (int ti = 0; ti < 2; ++ti) { const s16x8 pa = *(const LAS s16x8*)(Pm + (32 * ti + l31) * TSTR + 16 * ks + 8 * hi); accP[ti] = MFMA32(pa, vb, accP[ti]); } }
        }
        if (w == 0) {
            float rs = 0.f;
#pragma unroll
            for (int j = 0; j < 8; ++j) { const s16x8 pv = *(const LAS s16x8*)(Pm + lane * TSTR + 8 * j);
#pragma unroll
                for (int i = 0; i < 8; ++i) rs += bf2f((unsigned short)pv[i]); }
            const float dn = rs + inter[lane] * qn[lane];
            dinv[lane] = 1.f / fmaxf(fabsf(dn), emt[lane]);
        }
        __syncthreads();
#pragma unroll
        for (int ti = 0; ti < 2; ++ti)
#pragma unroll
            for (int r = 0; r < 16; ++r) { const int t = 32 * ti + crow32(r, hi); NUM[t * NUMSTR + 32 * w + l31] = (accP[ti][r] + inter[t] * SCALEQ * accC[ti][r]) * dinv[t]; }
        __syncthreads();
        {
            const f32x4 gn = *(const GAS f32x4*)(F.in[IN_MOUTN] + h * 256 + 4 * lane);
#pragma unroll
            for (int i = 0; i < 8; ++i) { const int t = 8 * w + i; const f32x4 x = *(const LAS f32x4*)(NUM + t * NUMSTR + 4 * lane);
                const float ss = wave_sum((x.x * x.x + x.y * x.y) + (x.z * x.z + x.w * x.w)); const float r = rsqrtf(ss * (1.f / 256.f) + 1e-6f);
                const u32x2 mo = *(const GAS u32x2*)(proj + (size_t)(t0 + t) * NPP + C_MO + h * 256 + 4 * lane);
                const float o0 = x.x * r * gn.x * sigmoid_f(bf2f((unsigned short)(mo.x & 0xffffu))), o1 = x.y * r * gn.y * sigmoid_f(bf2f((unsigned short)(mo.x >> 16)));
                const float o2 = x.z * r * gn.z * sigmoid_f(bf2f((unsigned short)(mo.y & 0xffffu))), o3 = x.w * r * gn.w * sigmoid_f(bf2f((unsigned short)(mo.y >> 16)));
                u32x2 ov; ov.x = pk2(o0, o1); ov.y = pk2(o2, o3);
                *(GAS u32x2*)(concat + (size_t)(t0 + t) * D + h * 256 + 4 * lane) = ov; }
        }
        __syncthreads();
    }
}
}
namespace mk {
__device__ __forceinline__ void attn_build_schedule(Frame& F) {
    LAS int* jl = (LAS int*)(F.lds + TAB_OFF); LAS int* pre = jl + 256; LAS int* wtot = pre + 260;
    const int tid = F.tid, lane = F.lane;
    if (tid < 256) { const int j = wsp<int>(F, WS_JLO)[tid]; jl[tid] = j; const int n = 4 * (tid & 31) + 4 - j; int v = (n + ATT_CH - 1) / ATT_CH;
        int inc = v;
#pragma unroll
        for (int o = 1; o < 64; o <<= 1) { const int t = __shfl_up(inc, o); if (lane >= o) inc += t; }
        pre[tid + 1] = inc; if (lane == 63) wtot[tid >> 6] = inc; }
    __syncthreads();
    if (tid < 256) { int add = 0; for (int w2 = 0; w2 < (tid >> 6); ++w2) add += wtot[w2]; pre[tid + 1] += add; if (tid == 0) pre[0] = 0; }
    __syncthreads();
}
__device__ __forceinline__ fox::BlockRef<fox::bf16, fox::bf16> fox_ref(const Frame& F, int I) {
    const LAS int* jl = (const LAS int*)(F.lds + TAB_OFF); const LAS int* pre = jl + 256;
    int b = 0;
#pragma unroll
    for (int st = 128; st >= 1; st >>= 1) if (pre[b + st] <= I) b += st;
    b = __builtin_amdgcn_readfirstlane(b);
    const int pb0 = __builtin_amdgcn_readfirstlane(pre[b]), pb1 = __builtin_amdgcn_readfirstlane(pre[b + 1]), j0 = __builtin_amdgcn_readfirstlane(jl[b]);
    const int h = b >> 5, qb = b & 31, part = I - pb0, P = pb1 - pb0, n = 4 * qb + 4 - j0;
    fox::BlockRef<fox::bf16, fox::bf16> r;
    const fox::bf16* proj = (const fox::bf16*)(F.ws + WS_PROJ);
    r.Q = proj + (size_t)(qb * 256) * fox::PITCH + C_FQ + h * 128; r.K = proj + C_FK + h * 128; r.V = proj + C_FV + h * 128;
    r.O = (fox::bf16*)(F.ws + WS_CONCAT) + (size_t)(qb * 256) * D + 1024 + h * 128; r.P0 = qb * 256;
    r.Fb = (const float*)(F.ws + WS_F) + h * S; r.gain = F.in[IN_FOUTN] + h * 128;
    r.jlo = j0 + (part * n) / P; r.jhi = j0 + ((part + 1) * n) / P;
    r.Op = P > 1 ? (float*)(F.ws + WS_OPART) + (size_t)I * 256 * 128 : nullptr; r.ML = (float*)(F.ws + WS_MLP) + (size_t)I * 512;
    return r;
}
__device__ __forceinline__ void p5_attention(Frame& F, char* ldsg) {
    typedef fox::BlockRef<fox::bf16, fox::bf16> BR;
    attn_build_schedule(F);
    const int total = __builtin_amdgcn_readfirstlane(((const LAS int*)(F.lds + TAB_OFF))[256 + 256]);
    int L = F.vcu; if (L >= total) return;
    BR cur = fox_ref(F, L);
    fox::Seam<fox::bf16> Sm;
    fox::causal_swa_prime<fox::bf16, fox::bf16>(cur, S, ldsg, Sm);
    for (;;) {
        const bool more = L + F.G < total;
        const BR nxt = more ? fox_ref(F, L + F.G) : cur;
        fox::causal_swa_block<fox::bf16, fox::bf16>(cur, nxt, S, S, ldsg, Sm);
        if (!more) break;
        cur = nxt; L += F.G;
    }
}
__device__ __forceinline__ void p6_combine(Frame& F) {
    attn_build_schedule(F);
    const LAS int* pre = (const LAS int*)(F.lds + TAB_OFF) + 256;
    const float* OP = wsp<float>(F, WS_OPART); const float* MLP = wsp<float>(F, WS_MLP); bf16* concat = wsp<bf16>(F, WS_CONCAT);
    const int gw = F.vcu * NWAVES + F.wave, NGW = F.G * NWAVES, lane = F.lane;
    constexpr float C2 = 1.4426950408889634f * SCALEQ;
    for (int idx = gw; idx < 256 * 256; idx += NGW) {
        const int b = idx >> 8, r = idx & 255, i0 = pre[b], P = pre[b + 1] - i0; if (P <= 1) continue;
        const int h = b >> 5, qb = b & 31;
        float ms = -3.0e38f;
        for (int p2 = 0; p2 < P; ++p2) ms = fmaxf(ms, MLP[(size_t)(i0 + p2) * 512 + 2 * r]);
        float n0 = 0.f, n1 = 0.f, den = 0.f;
        for (int p2 = 0; p2 < P; ++p2) { const f32x2 ml = *(const GAS f32x2*)(MLP + (size_t)(i0 + p2) * 512 + 2 * r); const float wgt = __builtin_amdgcn_exp2f((ml.x - ms) * C2);
            const f32x2 ov = *(const GAS f32x2*)(OP + ((size_t)(i0 + p2) * 256 + r) * 128 + 2 * lane); n0 += wgt * ov.x; n1 += wgt * ov.y; den += wgt * ml.y; }
        const float inv = 1.f / den, v0 = n0 * inv, v1 = n1 * inv;
        const float ss = wave_sum(v0 * v0 + v1 * v1), rn = rsqrtf(ss * (1.f / 128.f) + 1e-6f);
        const f32x2 gn = *(const GAS f32x2*)(F.in[IN_FOUTN] + h * 128 + 2 * lane);
        *(GAS unsigned*)(concat + (size_t)(qb * 256 + r) * D + 1024 + h * 128 + 2 * lane) = pk2(v0 * rn * gn.x, v1 * rn * gn.y);
    }
}
constexpr int RROWS = 8, NITER = S / RROWS;
__device__ __forceinline__ void p7_router(Frame& F) {
    LAS float* shs = (LAS float*)(F.lds + RING_OFF);
    LAS float* H2L = shs + 2 * D;
    LAS float* red = H2L + RROWS * D;
    LAS int* selE = (LAS int*)(red + 16 * RROWS * NE);
    const float* mod = wsp<float>(F, WS_MOD); const float* h1 = wsp<float>(F, WS_H1); unsigned char* h2 = wsp<unsigned char>(F, WS_HN);
    int* top_i = wsp<int>(F, WS_TOPI); float* top_w = wsp<float>(F, WS_TOPW); int* hist = wsp<int>(F, WS_HIST); int* lrank = wsp<int>(F, WS_LRANK);
    const int tid = F.tid, lane = F.lane, w = F.wave;
    for (int i = tid; i < 2 * D; i += NTHR) shs[i] = mod[3 * D + i];
    __syncthreads();
    float wreg[128];
    { const float* wp = F.in[IN_WR] + (size_t)((tid >> 5) * 128) * NE + (tid & 31);
#pragma unroll
        for (int k = 0; k < 128; ++k) wreg[k] = wp[k * NE]; }
    for (int it = F.vcu; it < NITER; it += F.G) {
        const int r0 = it * RROWS;
        {
            const int m = r0 + w; const GAS f32x4* xr = (const GAS f32x4*)(h1 + (size_t)m * D) + lane; f32x4 v[8]; float s2 = 0.f;
#pragma unroll
            for (int j = 0; j < 8; ++j) { v[j] = xr[64 * j]; s2 += (v[j].x * v[j].x + v[j].y * v[j].y) + (v[j].z * v[j].z + v[j].w * v[j].w); }
            const float r = rsqrtf(wave_sum(s2) * (1.f / D) + 1e-6f);
            GAS unsigned* o8 = (GAS unsigned*)(h2 + (size_t)m * D) + lane;
#pragma unroll
            for (int j = 0; j < 8; ++j) { const int c0 = 4 * lane + 256 * j; const f32x4 gg = *(const GAS f32x4*)(F.in[IN_NFFN] + c0); const f32x4 a = *(const LAS f32x4*)(shs + D + c0), b = *(const LAS f32x4*)(shs + c0);
                const f32x4 y = v[j] * r * gg * (a + 1.f) + b; o8[64 * j] = pk4_fp8(y.x, y.y, y.z, y.w);
                *(LAS f32x4*)(H2L + w * D + c0) = y; }
        }
        __syncthreads();
        {
            const int e = tid & 31, kp = tid >> 5; float acc[RROWS];
#pragma unroll
            for (int r = 0; r < RROWS; ++r) acc[r] = 0.f;
#pragma unroll
            for (int k4 = 0; k4 < 32; ++k4) {
#pragma unroll
                for (int r = 0; r < RROWS; ++r) { const f32x4 hv = *(const LAS f32x4*)(H2L + r * D + kp * 128 + k4 * 4); acc[r] += (hv.x * wreg[4 * k4] + hv.y * wreg[4 * k4 + 1]) + (hv.z * wreg[4 * k4 + 2] + hv.w * wreg[4 * k4 + 3]); }
            }
#pragma unroll
            for (int r = 0; r < RROWS; ++r) red[(kp * RROWS + r) * NE + e] = acc[r];
        }
        __syncthreads();
        if (tid < RROWS * NE) {
            const int r = tid >> 5, e = tid & 31; float lg = F.in[IN_BR][e];
#pragma unroll
            for (int kp = 0; kp < 16; ++kp) lg += red[(kp * RROWS + r) * NE + e];
            float cur = lg, mx = 0.f, sum = 0.f, mysel = 0.f; int myidx = 0;
#pragma unroll
            for (int q = 0; q < 4; ++q) { float best = cur; int bi = e;
#pragma unroll
                for (int o = 1; o < 32; o <<= 1) { const float ob = __shfl_xor(best, o); const int oi = __shfl_xor(bi, o); if (ob > best || (ob == best && oi < bi)) { best = ob; bi = oi; } }
                if (q == 0) mx = best;
                sum += __expf(best - mx);
                if (e == q) { mysel = best; myidx = bi; }
                if (e == bi) cur = -3.0e38f; }
            if (e < 4) { const int t = r0 + r; top_i[t * 4 + e] = myidx; top_w[t * 4 + e] = __expf(mysel - mx) / sum; selE[r * 4 + e] = myidx; }
        }
        __syncthreads();
        if (tid < 32) { const int me = selE[tid]; int rank = 0, cnt = 0;
#pragma unroll
            for (int p = 0; p < 32; ++p) { const int ep = selE[p]; rank += (ep == me && p < tid) ? 1 : 0; cnt += (ep == tid) ? 1 : 0; }
            lrank[it * 32 + tid] = rank; hist[it * NE + tid] = cnt; }
        __syncthreads();
    }
}
__device__ __forceinline__ void build_expert_table(Frame& F, const int* counts_g) {
    LAS int* tab = (LAS int*)(F.lds + TAB_OFF);
    if (F.tid == 0) { int acc = 0; for (int e = 0; e < NE; ++e) { const int c = counts_g[e]; tab[e] = acc; tab[40 + e] = c; acc += (c + 255) >> 8; } tab[32] = acc; }
    __syncthreads();
}
__device__ __forceinline__ void p8_gather(Frame& F) {
    LAS int* psum = (LAS int*)(F.lds + RING_OFF);
    LAS int* startr = psum + 16 * NE;
    LAS int* base = startr + NE;
    const int* hist = wsp<int>(F, WS_HIST); const int* lrank = wsp<int>(F, WS_LRANK); const int* top_i = wsp<int>(F, WS_TOPI); const float* top_w = wsp<float>(F, WS_TOPW);
    int* pos = wsp<int>(F, WS_POS); float* roww = wsp<float>(F, WS_ROWW); const unsigned char* h2 = wsp<unsigned char>(F, WS_HN); unsigned char* xg = wsp<unsigned char>(F, WS_XG);
    int* counts_g = (int*)(F.ws + WS_POS) + S * 4;
    const int tid = F.tid, lane = F.lane, w = F.wave;
    { const int e = tid & 31, part = tid >> 5; int s = 0; for (int i = 0; i < NITER / 16; ++i) s += hist[(part * (NITER / 16) + i) * NE + e]; psum[part * NE + e] = s; }
    __syncthreads();
    if (tid == 0) { int acc = 0; for (int e = 0; e < NE; ++e) { int c = 0; for (int p = 0; p < 16; ++p) c += psum[p * NE + e]; startr[e] = acc; acc += ((c + 255) >> 8) << 8; if (blockIdx.x == 0) counts_g[e] = c; } }
    __syncthreads();
    for (int it = F.vcu; it < NITER; it += F.G) {
        {
            const int part = it / (NITER / 16), i0 = part * (NITER / 16);
            if (w < 4) { const bool on = (i0 + lane) < it;
#pragma unroll
                for (int q = 0; q < 8; ++q) { const int e = w * 8 + q; int v = on ? hist[(i0 + lane) * NE + e] : 0;
#pragma unroll
                    for (int o = 1; o < 64; o <<= 1) v += __shfl_xor(v, o);
                    if (lane == 0) { int b = v; for (int pp = 0; pp < part; ++pp) b += psum[pp * NE + e]; base[e] = b; } } }
        }
        __syncthreads();
#pragma unroll
        for (int j = 0; j < 4; ++j) { const int p = w + 8 * j, pair = it * 32 + p, e = top_i[pair], dest = startr[e] + base[e] + lrank[pair], t = pair >> 2;
            if (lane == 0) { pos[pair] = dest; roww[dest] = top_w[pair]; }
            const GAS v4u* src = (const GAS v4u*)(h2 + (size_t)t * D) + lane; GAS v4u* dst = (GAS v4u*)(xg + (size_t)dest * D) + lane;
#pragma unroll
            for (int q = 0; q < 2; ++q) dst[64 * q] = src[64 * q]; }
        __syncthreads();
    }
}
struct GroupedOrder {
    const LAS int* tab; int ntn, G, c;
    __device__ __forceinline__ bool next(int i, Unit& u) const {
        const int L = i * G + c, total = tab[32] * ntn; if (L >= total) return false;
        int e = 0;
#pragma unroll 1
        while (e < NE - 1 && tab[e + 1] * ntn <= L) ++e;
        const int ts = tab[e], tc = tab[e + 1] - ts, within = L - ts * ntn;
        u.pm = ts + within % tc; u.pn = within / tc; u.e = e; u.pb = e * ntn + u.pn; return true;
    }
    __device__ __forceinline__ void a_ready(const Unit&) const {}
    __device__ __forceinline__ void done(const Unit&) const {}
};
struct EpiSwiglu {
    static constexpr bool PERM = true, AFTER_DRAIN = false;
    unsigned char* act; const float* bug;
    __device__ __forceinline__ void operator()(const pg8::f32x4 (&acc)[2][2][4][2], const Unit& u, int wr, int wc, int fr, int fq) const {
        const int row0 = u.pm * 256 + wr * 64 + fr, f0 = u.pn * 128 + wc * 32 + 8 * fq;
        const float* bg = bug + (size_t)u.e * 4096 + f0; pg8::f32x4 bgv[2], buv[2];
#pragma unroll
        for (int n = 0; n < 2; ++n) { bgv[n] = *(const pg8::f32x4*)(bg + 4 * n); buv[n] = *(const pg8::f32x4*)(bg + 2048 + 4 * n); }
#pragma unroll
        for (int ai = 0; ai < 2; ++ai)
#pragma unroll
            for (int m = 0; m < 4; ++m) { float o[8];
#pragma unroll
                for (int n = 0; n < 2; ++n)
#pragma unroll
                    for (int i = 0; i < 4; ++i) { const float g = fminf(acc[ai][0][m][n][i] + bgv[n][i], 7.f); const float up = fminf(fmaxf(acc[ai][1][m][n][i] + buv[n][i], -7.f), 7.f);
                        o[4 * n + i] = (up + 1.f) * g * __builtin_amdgcn_rcpf(1.f + __builtin_amdgcn_exp2f(-2.45546696f * g)); }
                u32x2 wv; wv.x = pk4_fp8(o[0], o[1], o[2], o[3]); wv.y = pk4_fp8(o[4], o[5], o[6], o[7]);
                *(u32x2*)(act + (size_t)(row0 + ai * 128 + m * 16) * FF + f0) = wv; }
    }
};
struct EpiDown {
    static constexpr bool PERM = true, AFTER_DRAIN = false;
    bf16* y; const float* bd; const float* roww;
    __device__ __forceinline__ void operator()(const pg8::f32x4 (&acc)[2][2][4][2], const Unit& u, int wr, int wc, int fr, int fq) const {
        const int row0 = u.pm * 256 + wr * 64 + fr, col0 = u.pn * 256 + wc * 32 + 8 * fq;
        pg8::f32x4 bv[2][2];
#pragma unroll
        for (int bj = 0; bj < 2; ++bj)
#pragma unroll
            for (int n = 0; n < 2; ++n) bv[bj][n] = *(const pg8::f32x4*)(bd + (size_t)u.e * D + col0 + bj * 128 + 4 * n);
#pragma unroll
        for (int ai = 0; ai < 2; ++ai)
#pragma unroll
            for (int m = 0; m < 4; ++m) { const int row = row0 + ai * 128 + m * 16; const float rw = roww[row]; bf16* rowp = y + (size_t)row * D + col0;
#pragma unroll
                for (int bj = 0; bj < 2; ++bj) { const pg8::f32x4 v0 = (acc[ai][bj][m][0] + bv[bj][0]) * rw, v1 = (acc[ai][bj][m][1] + bv[bj][1]) * rw;
                    pg8::u32x4 wv; wv.x = cvt_pk_bf16(v0[0], v0[1]); wv.y = cvt_pk_bf16(v0[2], v0[3]); wv.z = cvt_pk_bf16(v1[0], v1[1]); wv.w = cvt_pk_bf16(v1[2], v1[3]);
                    *(pg8::u32x4*)(rowp + bj * 128) = wv; } }
    }
};
__device__ __forceinline__ void p11_final(Frame& F, float oscale) {
    LAS float* ms = (LAS float*)(F.lds + RING_OFF);
    const float* mod = wsp<float>(F, WS_MOD);
    for (int i = F.tid; i < 3 * D; i += NTHR) ms[i] = mod[5 * D + i];
    __syncthreads();
    const float* h1 = wsp<float>(F, WS_H1); const bf16* y = wsp<bf16>(F, WS_Y); const int* pos = wsp<int>(F, WS_POS);
    const int gw = F.vcu * NWAVES + F.wave, NGW = F.G * NWAVES, lane = F.lane;
    for (int t = gw; t < S; t += NGW) {
        asm volatile("" ::: "memory");
        const GAS f32x4* xr = (const GAS f32x4*)(h1 + (size_t)t * D) + lane;
        const GAS u32x2* y0 = (const GAS u32x2*)(y + (size_t)pos[t * 4 + 0] * D) + lane; const GAS u32x2* y1 = (const GAS u32x2*)(y + (size_t)pos[t * 4 + 1] * D) + lane;
        const GAS u32x2* y2 = (const GAS u32x2*)(y + (size_t)pos[t * 4 + 2] * D) + lane; const GAS u32x2* y3 = (const GAS u32x2*)(y + (size_t)pos[t * 4 + 3] * D) + lane;
        f32x4 v[8]; float s2 = 0.f;
#pragma unroll
        for (int j = 0; j < 8; ++j) { const u32x2 a = y0[64 * j], b = y1[64 * j], c = y2[64 * j], d = y3[64 * j]; const f32x4 g2 = *(const LAS f32x4*)(ms + 4 * lane + 256 * j);
            f32x4 f;
            f.x = (bf2f((unsigned short)(a.x & 0xffffu)) + bf2f((unsigned short)(b.x & 0xffffu))) + (bf2f((unsigned short)(c.x & 0xffffu)) + bf2f((unsigned short)(d.x & 0xffffu)));
            f.y = (bf2f((unsigned short)(a.x >> 16)) + bf2f((unsigned short)(b.x >> 16))) + (bf2f((unsigned short)(c.x >> 16)) + bf2f((unsigned short)(d.x >> 16)));
            f.z = (bf2f((unsigned short)(a.y & 0xffffu)) + bf2f((unsigned short)(b.y & 0xffffu))) + (bf2f((unsigned short)(c.y & 0xffffu)) + bf2f((unsigned short)(d.y & 0xffffu)));
            f.w = (bf2f((unsigned short)(a.y >> 16)) + bf2f((unsigned short)(b.y >> 16))) + (bf2f((unsigned short)(c.y >> 16)) + bf2f((unsigned short)(d.y >> 16)));
            v[j] = xr[64 * j] + g2 * f; s2 += (v[j].x * v[j].x + v[j].y * v[j].y) + (v[j].z * v[j].z + v[j].w * v[j].w); }
        const float r = rsqrtf(wave_sum(s2) * (1.f / D) + 1e-6f);
        GAS f32x4* o = (GAS f32x4*)(F.out + (size_t)t * D) + lane;
#pragma unroll
        for (int j = 0; j < 8; ++j) { const int c0 = 4 * lane + 256 * j; const f32x4 gg = *(const GAS f32x4*)(F.in[IN_NFIN] + c0); const f32x4 sh = *(const LAS f32x4*)(ms + D + c0), sc = *(const LAS f32x4*)(ms + 2 * D + c0);
            o[64 * j] = (v[j] * r * gg * (sc + 1.f) + sh) * oscale; }
    }
}
}
namespace mk {
struct Args { const float* in[24]; float* out; unsigned char* ws; int ph_lo, ph_hi, li, pad; };
constexpr int N_PHASES = 13;
__global__ void __launch_bounds__(NTHR, 2) mega_fwd(Args args) {
    extern __shared__ __attribute__((aligned(16))) unsigned char lds[];
    Frame F;
    F.lds = (LAS unsigned char*)lds;
    F.MISC = (volatile LAS unsigned*)(F.lds + MISC_OFF);
    F.tid = threadIdx.x; F.lane = F.tid & 63; F.wave = __builtin_amdgcn_readfirstlane(F.tid >> 6);
    leave_group(F);
    F.ws = args.ws; F.out = args.out; F.ctl = (gu32*)(args.ws + WS_CTL);
#pragma unroll
    for (int i = 0; i < 24; ++i) F.in[i] = args.in[i];
    for (int u = F.tid; u < (LDS_BYTES - LDSCTL_OFF) / 4; u += NTHR) ((LAS unsigned*)(F.lds + LDSCTL_OFF))[u] = 0u;
    __syncthreads();
    XcdBarrier bar = xcd_barrier_post((unsigned*)(F.ctl + CW_BAR) + args.li * XCD_BAR_WORDS, F.MISC + 8);
    const int lo = args.ph_lo, hi = args.ph_hi;
#define IN(k) (lo <= (k) && (k) < hi)
#define SEAM(k) do { if (IN(k) && IN((k) + 1)) xcd_barrier(bar); } while (0)

#ifndef MK_DOUBLE
#define MK_DOUBLE 0
#endif
#define DBL(k) ((MK_DOUBLE >> (k)) & 1)
#ifdef MK_PROBE_LO
    unsigned long long* stamps = (unsigned long long*)(F.ctl + 131072);
#define STAMP(k) do { if (blockIdx.x == 0 && F.tid == 0) stamps[k] = rt(); } while (0)
#define PROBE_SCALE() (1.f + sqrtf((float)(stamps[MK_PROBE_HI] - stamps[MK_PROBE_LO]) * 0.01f * 2e-5f))
#else
#define STAMP(k) do { } while (0)
#define PROBE_SCALE() 1.f
#endif
    STAMP(0); if (IN(0)) { p0_gemv(F); } SEAM(0);
    STAMP(1); if (IN(1)) { p1_modulate(F); if (DBL(1)) p1_modulate(F); } SEAM(1);
    STAMP(2); if (IN(2)) {
        gu32* done = F.ctl + CW_DONE + 64 * 2;
        if (enter_group(F, GC_INPROJ)) {
            pg8::Gemm g{wsp<pg8::bf16_t>(F, WS_HN), wsp<pg8::bf16_t>(F, WS_WIN), S, NPP, D}; pg8::StaticOrder So; So.init(S, NPP, F.G, F.bid);
            EpiProj E{wsp<bf16>(F, WS_PROJ)};
            pg8::gemm_phase<EpiProj, pg8::StaticOrder, true, true>(F.lds + RING_OFF, g, So, E);
            if (DBL(2)) pg8::gemm_phase<EpiProj, pg8::StaticOrder, true, true>(F.lds + RING_OFF, g, So, E);
            __syncthreads();
            if (F.tid == 0) __hip_atomic_fetch_add(done, 1u, RLX_AGENT);
        }
        const unsigned tgt = (unsigned)F.G; leave_group(F);
        conv_worker(F, done, F.G == 256 ? (unsigned)GC_INPROJ : tgt);
        __syncthreads();
    } SEAM(2);
    STAMP(3); if (IN(3)) { p3_prep(F); } SEAM(3);
    STAMP(4); if (IN(4)) { p4_scan(F); if (DBL(4)) p4_scan(F); } SEAM(4);
    STAMP(5); if (IN(5)) {
        gu32* done = F.ctl + CW_DONE + 64 * 5;
        if (enter_group(F, GC_ATTN)) {
            p5_mlstm_out(F); if (DBL(14)) p5_mlstm_out(F); p5_attention(F, (char*)lds);
            __syncthreads();
            if (F.tid == 0) __hip_atomic_fetch_add(done, 1u, RLX_AGENT);
        }
        const unsigned tgt = (unsigned)F.G; leave_group(F);
        conv_worker(F, done, F.G == 256 ? (unsigned)GC_ATTN : tgt);
        __syncthreads();
    } SEAM(5);
    STAMP(6); if (IN(6)) { p6_combine(F); } SEAM(6);
    STAMP(7); if (IN(7)) {
        pg8::Gemm g{wsp<pg8::bf16_t>(F, WS_CONCAT), wsp<pg8::bf16_t>(F, WS_WOUT), S, D, D}; pg8::StaticOrder So; So.init(S, D, F.G, F.bid);
        EpiOut E{F.in[IN_X], wsp<float>(F, WS_MOD) + 2 * D, wsp<float>(F, WS_H1)};
        pg8::gemm_phase<EpiOut, pg8::StaticOrder, false, true>(F.lds + RING_OFF, g, So, E);
        if (DBL(7)) pg8::gemm_phase<EpiOut, pg8::StaticOrder, false, true>(F.lds + RING_OFF, g, So, E);
    } SEAM(7);
    STAMP(8); if (IN(8)) { p7_router(F); if (DBL(8)) p7_router(F); } SEAM(8);
    STAMP(9); if (IN(9)) { p8_gather(F); if (DBL(9)) p8_gather(F); __syncthreads(); conv_worker(F, nullptr, 0u); __syncthreads(); } SEAM(9);
    STAMP(10); if (IN(10)) {
        build_expert_table(F, (const int*)(F.ws + WS_POS) + S * 4);
        pg8::Gemm g{wsp<pg8::bf16_t>(F, WS_XG), wsp<pg8::bf16_t>(F, WS_WUG), MAXROWS, 4096, D / 2}; GroupedOrder So{(const LAS int*)(F.lds + TAB_OFF), 16, F.G, F.bid};
        EpiSwiglu E{wsp<unsigned char>(F, WS_ACT), F.in[IN_BUG]};
        pg8::gemm_phase8<EpiSwiglu, GroupedOrder, true, true>(F.lds + RING_OFF, g, So, E);
        if (DBL(10)) pg8::gemm_phase8<EpiSwiglu, GroupedOrder, true, true>(F.lds + RING_OFF, g, So, E);
    } SEAM(10);
    STAMP(11); if (IN(11)) {
        build_expert_table(F, (const int*)(F.ws + WS_POS) + S * 4);
        pg8::Gemm g{wsp<pg8::bf16_t>(F, WS_ACT), wsp<pg8::bf16_t>(F, WS_WD), MAXROWS, D, FF / 2}; GroupedOrder So{(const LAS int*)(F.lds + TAB_OFF), 8, F.G, F.bid};
        EpiDown E{wsp<bf16>(F, WS_Y), F.in[IN_BD], wsp<float>(F, WS_ROWW)};
        pg8::gemm_phase8<EpiDown, GroupedOrder, true, true>(F.lds + RING_OFF, g, So, E);
        if (DBL(11)) pg8::gemm_phase8<EpiDown, GroupedOrder, true, true>(F.lds + RING_OFF, g, So, E);
    } SEAM(11);
    STAMP(12); if (IN(12)) { p11_final(F, PROBE_SCALE()); if (DBL(12)) p11_final(F, PROBE_SCALE()); }
#undef IN
#undef SEAM
}
}
#ifndef MK_DEBUG
#define MK_DEBUG 0
#endif
#ifndef MK_PH_END
#define MK_PH_END mk::N_PHASES
#endif
#ifndef MK_SPLIT
#define MK_SPLIT 0
#endif
extern "C" void kernel_launch(void* const* d_in, const int* in_sizes, int n_in, void* d_out, int out_size, void* d_ws, size_t ws_size, hipStream_t stream) {
    using namespace mk;
    static int grid = 0;
    if (grid == 0) {
        int dev = 0, cus = 0, per_cu = 0;
        if (hipGetDevice(&dev) != hipSuccess || hipDeviceGetAttribute(&cus, hipDeviceAttributeMultiprocessorCount, dev) != hipSuccess) { fprintf(stderr, "kernel_launch: device query failed\n"); grid = -1; return; }
        if (hipFuncSetAttribute((const void*)mega_fwd, hipFuncAttributeMaxDynamicSharedMemorySize, LDS_BYTES) != hipSuccess) { fprintf(stderr, "kernel_launch: hipFuncSetAttribute failed\n"); grid = -1; return; }
        if (hipOccupancyMaxActiveBlocksPerMultiprocessor(&per_cu, (const void*)mega_fwd, NTHR, LDS_BYTES) != hipSuccess || per_cu < 1) fprintf(stderr, "kernel_launch: occupancy query reports %d\n", per_cu);
        (void)hipGetLastError();
        grid = cus;
        if (n_in != 24 || out_size != S * D || ws_size < (MK_DEBUG ? WS_NAIVE + (size_t)2300 * MiB : WS_END)) fprintf(stderr, "kernel_launch: unexpected sizes n_in %d out %d ws %zu\n", n_in, out_size, ws_size);
    }
    if (grid < 0) return;
    (void)hipMemsetAsync((char*)d_ws + WS_CTL, 0, CTL_ZERO_BYTES, stream);
    Args a{};
    for (int i = 0; i < 24; ++i) a.in[i] = (const float*)d_in[i];
    a.out = (float*)d_out; a.ws = (unsigned char*)d_ws;
#if MK_DEBUG
    nv::naive_forward(d_in, (float*)d_out, (char*)d_ws + WS_NAIVE, stream);
#endif
#if MK_SPLIT
    for (int p = 0; p < MK_PH_END; ++p) { a.ph_lo = p; a.ph_hi = p + 1; a.li = p; hipLaunchKernelGGL(mega_fwd, dim3(grid), dim3(NTHR), LDS_BYTES, stream, a); }
#else
    a.ph_lo = 0; a.ph_hi = MK_PH_END; a.li = 0;
    hipLaunchKernelGGL(mega_fwd, dim3(grid), dim3(NTHR), LDS_BYTES, stream, a);
#endif
#ifdef MK_EXTRA_LO
    a.ph_lo = MK_EXTRA_LO; a.ph_hi = MK_EXTRA_HI; a.li = 1;
    hipLaunchKernelGGL(mega_fwd, dim3(grid), dim3(NTHR), LDS_BYTES, stream, a);
#endif
    { const hipError_t le = hipPeekAtLastError(); if (le != hipSuccess) fprintf(stderr, "kernel_launch: launch failed: %s\n", hipGetErrorName(le)); }
#if MK_DEBUG
    {
        nv::NaiveWs w = nv::carve((char*)d_ws + WS_NAIVE);
        double* slots = (double*)((char*)d_ws + WS_CTL + 512 * 1024);
        unsigned char* ws = (unsigned char*)d_ws; int nc = 0;
        MK_DEBUG_CHECKS
        dbg::k_finish<<<1024, 256, 0, stream>>>((float*)d_out, (size_t)S * D, slots, nc, 1e-3);
    }
#endif
}
```

```cpp
#include <hip/hip_runtime.h>
#include <hip/hip_bf16.h>
#include <cstdio>
#include <cstdint>
namespace pg8 {
#define PG8_LAS __attribute__((address_space(3)))
typedef unsigned short bf16_t;
typedef short bf16x8 __attribute__((ext_vector_type(8)));
typedef float f32x4 __attribute__((ext_vector_type(4)));
typedef unsigned u32x4 __attribute__((ext_vector_type(4)));
constexpr int BM = 256, BK = 64, HALF = 128, HTB = HALF * BK * 2  , STAGE_BYTES = 8 * HTB, NXCD = 8, WGM = 8;

__host__ __device__ __forceinline__ int lds_byte(int r, int c) { const int st = (r >> 4) * 2 + (c >> 5), rr = r & 15, cc = c & 31, ob = rr * 64 + cc * 2; return st * 1024 + (ob ^ (((ob >> 9) & 1) << 5)); }
__host__ __device__ __forceinline__ void stage_rc(int b, int& R, int& C) { const int st = b / 1024, sb = b % 1024, swz = sb ^ (((sb >> 9) & 1) << 5); R = (st >> 1) * 16 + swz / 64; C = (st & 1) * 32 + (swz % 64) / 2; }
__host__ __device__ __forceinline__ int perm32(int rho) { const int n = rho >> 4, i = rho & 15; return 8 * (i >> 2) + 4 * n + (i & 3); }

struct Unit { int pm, pn, pb, e; };
struct Gemm { const bf16_t* A; const bf16_t* Bt; int M, N, K; };

struct StaticOrder {
    int nM, nN, nwg, G, c;
    __host__ __device__ void init(int M, int N, int G_, int c_) { nM = M / BM; nN = N / BM; nwg = nM * nN; G = G_; c = c_; }
    __host__ __device__ bool next(int i, Unit& u) const {
        const long L = (long)i * G + c; if (L >= nwg) return false;
        int wgid = (int)L; { const int q = nwg / NXCD, r = nwg % NXCD, xcd = wgid % NXCD, off = wgid / NXCD; wgid = (xcd < r ? xcd * (q + 1) : r * (q + 1) + (xcd - r) * q) + off; }
        const int nig = WGM * nN, gid = wgid / nig, fm = gid * WGM, gsz = (nM - fm) < WGM ? (nM - fm) : WGM;
        u.pm = fm + ((wgid % nig) % gsz); u.pn = (wgid % nig) / gsz; u.pb = u.pn; u.e = 0; return true;
    }
    __device__ __forceinline__ void a_ready(const Unit&) const {}
    __device__ __forceinline__ void done(const Unit&) const {}
};

__device__ __forceinline__ unsigned cvt_pk_bf16(float lo, float hi) { unsigned r; asm volatile("v_cvt_pk_bf16_f32 %0, %1, %2" : "=v"(r) : "v"(lo), "v"(hi)); return r; }
template <class Epi, class Sched, bool ALIGN_EPI = false, bool SP2 = false>
__device__ __forceinline__ void gemm_phase(PG8_LAS unsigned char* lds, const Gemm g, const Sched& S, const Epi& E) {
    const int tid = threadIdx.x, wid = __builtin_amdgcn_readfirstlane(tid >> 6), lane = tid & 63, wr = wid >> 2, wc = wid & 3, fr = lane & 15, fq = lane >> 4;
    const int K = g.K, nt = K / BK;
    unsigned voffA[2], voffB[2];
#pragma unroll
    for (int i = 0; i < 2; ++i) { int R, C; stage_rc(tid * 16 + i * 8192, R, C); const int Rb = Epi::PERM ? ((R & ~31) + perm32(R & 31)) : R;
        voffA[i] = (unsigned)(R * K + C) * 2u; voffB[i] = (unsigned)(Rb * K + C) * 2u; }
    const size_t kstep = (size_t)(BK * 2);
    const size_t hstep = (size_t)HALF * K * 2;
    const size_t tstep = 2 * hstep;
    const unsigned ldsw = (unsigned)wid * 1024u;
    const int aoff = lds_byte(wr * 64 + fr, fq * 8), boff = lds_byte(wc * 32 + fr, fq * 8);
#define PG8_SA(b, h) (((b) * 2 + (h)) * HTB)
#define PG8_SB(b, h) ((4 + (b) * 2 + (h)) * HTB)
#define PG8_STAGE(bufoff, gbase, voff) do { _Pragma("unroll") for (int _i = 0; _i < 2; ++_i) \
        __builtin_amdgcn_global_load_lds((const unsigned*)((const char*)(gbase) + (voff)[_i]), (PG8_LAS unsigned*)(lds + (bufoff) + ldsw + _i * 8192), 16, 0, 0); } while (0)
#define PG8_LDA(dst, b, h) do { _Pragma("unroll") for (int m = 0; m < 4; ++m) _Pragma("unroll") for (int k = 0; k < 2; ++k) dst[m][k] = *(const PG8_LAS bf16x8*)(lds + PG8_SA(b, h) + aoff + m * 2048 + k * 1024); } while (0)
#define PG8_LDB(dst, b, h) do { _Pragma("unroll") for (int n = 0; n < 2; ++n) _Pragma("unroll") for (int k = 0; k < 2; ++k) dst[n][k] = *(const PG8_LAS bf16x8*)(lds + PG8_SB(b, h) + boff + n * 2048 + k * 1024); } while (0)
#define PG8_MMA(ai, bj, At, Bt) do { __builtin_amdgcn_s_setprio(1); _Pragma("unroll") for (int m = 0; m < 4; ++m) _Pragma("unroll") for (int n = 0; n < 2; ++n) _Pragma("unroll") for (int k = 0; k < 2; ++k) \
        acc[ai][bj][m][n] = __builtin_amdgcn_mfma_f32_16x16x32_bf16(Bt[n][k], At[m][k], acc[ai][bj][m][n], 0, 0, 0); __builtin_amdgcn_s_setprio(0); } while (0)
#define PG8_WAIT_V(n) asm volatile("s_waitcnt vmcnt(" #n ")" ::: "memory")
#define PG8_WAIT_L(n) asm volatile("s_waitcnt lgkmcnt(" #n ")" ::: "memory")
#define PG8_BAR __builtin_amdgcn_s_barrier()
#define PG8_SCHED __builtin_amdgcn_sched_barrier(0)
    Unit cur, nxt; int ui = 0;
    if (!S.next(0, cur)) return;
    f32x4 acc[2][2][4][2];
#pragma unroll
    for (int a = 0; a < 2; ++a)
#pragma unroll
        for (int b = 0; b < 2; ++b)
#pragma unroll
            for (int m = 0; m < 4; ++m)
#pragma unroll
                for (int n = 0; n < 2; ++n) acc[a][b][m][n] = (f32x4){0.f, 0.f, 0.f, 0.f};
    bf16x8 At[4][2], B0[2][2], B1[2][2];
    const char* cA = (const char*)g.A + (size_t)cur.pm * tstep; const char* cB = (const char*)g.Bt + (size_t)cur.pb * tstep;
    S.a_ready(cur);
    if constexpr (SP2) {
        PG8_STAGE(PG8_SB(0, 0), cB, voffB); PG8_STAGE(PG8_SB(0, 1), cB + hstep, voffB); PG8_STAGE(PG8_SA(0, 0), cA, voffA); PG8_STAGE(PG8_SA(0, 1), cA + hstep, voffA);
        if (wr == 1) PG8_BAR;
        PG8_WAIT_V(2); PG8_BAR;
        PG8_STAGE(PG8_SB(1, 0), cB + kstep, voffB); PG8_STAGE(PG8_SA(1, 0), cA + kstep, voffA); PG8_STAGE(PG8_SB(1, 1), cB + hstep + kstep, voffB);
        PG8_WAIT_V(6); PG8_BAR;
    } else {
        PG8_STAGE(PG8_SB(0, 0), cB, voffB); PG8_STAGE(PG8_SA(0, 0), cA, voffA); PG8_STAGE(PG8_SB(0, 1), cB + hstep, voffB); PG8_STAGE(PG8_SA(0, 1), cA + hstep, voffA);
        if (wr == 1) PG8_BAR;
        PG8_WAIT_V(4); PG8_BAR;
        PG8_STAGE(PG8_SB(1, 0), cB + kstep, voffB); PG8_STAGE(PG8_SA(1, 0), cA + kstep, voffA); PG8_STAGE(PG8_SB(1, 1), cB + hstep + kstep, voffB);
        PG8_WAIT_V(6); PG8_BAR;
    }
    for (;;) {
        const bool has_next = S.next(ui + 1, nxt);
        const char* nA = has_next ? (const char*)g.A + (size_t)nxt.pm * tstep : cA; const char* nB = has_next ? (const char*)g.Bt + (size_t)nxt.pb * tstep : cB;
        for (int t = 0; t < nt; t += 2) {
            const bool last = (t == nt - 2);
            const char* a1 = cA + (size_t)(t + 1) * kstep;
            const char* a2 = last ? nA : cA + (size_t)(t + 2) * kstep; const char* b2 = last ? nB : cB + (size_t)(t + 2) * kstep;
            const char* a3 = a2 + kstep; const char* b3 = b2 + kstep;
            if (last && has_next) S.a_ready(nxt);
            if constexpr (SP2) {
            PG8_LDB(B0, 0, 0); PG8_LDB(B1, 0, 1); PG8_SCHED; PG8_LDA(At, 0, 0); PG8_STAGE(PG8_SA(1, 1), a1 + hstep, voffA);
            PG8_WAIT_V(8); PG8_WAIT_L(0); PG8_BAR; PG8_MMA(0, 0, At, B0); PG8_MMA(0, 1, At, B1); PG8_BAR; PG8_SCHED;
            PG8_LDA(At, 0, 1); PG8_STAGE(PG8_SB(0, 0), b2, voffB); PG8_STAGE(PG8_SB(0, 1), b2 + hstep, voffB); PG8_STAGE(PG8_SA(0, 0), a2, voffA);
            PG8_WAIT_V(8); PG8_WAIT_L(0); PG8_BAR; PG8_MMA(1, 0, At, B0); PG8_MMA(1, 1, At, B1); PG8_BAR; PG8_SCHED;
            PG8_LDB(B0, 1, 0); PG8_LDB(B1, 1, 1); PG8_SCHED; PG8_LDA(At, 1, 0); PG8_STAGE(PG8_SA(0, 1), a2 + hstep, voffA);
            PG8_WAIT_V(8); PG8_WAIT_L(0); PG8_BAR; PG8_MMA(0, 0, At, B0); PG8_MMA(0, 1, At, B1); PG8_BAR; PG8_SCHED;
            PG8_LDA(At, 1, 1); PG8_STAGE(PG8_SB(1, 0), b3, voffB); PG8_STAGE(PG8_SB(1, 1), b3 + hstep, voffB); PG8_STAGE(PG8_SA(1, 0), a3, voffA);
            PG8_WAIT_V(8); PG8_WAIT_L(0); PG8_BAR; PG8_MMA(1, 0, At, B0); PG8_MMA(1, 1, At, B1); PG8_BAR; PG8_SCHED;
            } else {
            PG8_LDB(B0, 0, 0); PG8_SCHED; PG8_LDA(At, 0, 0); PG8_STAGE(PG8_SA(1, 1), a1 + hstep, voffA);
            PG8_WAIT_L(8); PG8_BAR; PG8_WAIT_L(0); PG8_MMA(0, 0, At, B0); PG8_BAR; PG8_SCHED;
            PG8_LDB(B1, 0, 1); PG8_STAGE(PG8_SB(0, 0), b2, voffB);
            PG8_BAR; PG8_WAIT_L(0); PG8_MMA(0, 1, At, B1); PG8_BAR;
            PG8_LDA(At, 0, 1); PG8_STAGE(PG8_SA(0, 0), a2, voffA);
            PG8_BAR; PG8_WAIT_L(0); PG8_MMA(1, 0, At, B0); PG8_BAR; PG8_SCHED;
            PG8_STAGE(PG8_SB(0, 1), b2 + hstep, voffB);
            PG8_WAIT_V(6); PG8_BAR; PG8_MMA(1, 1, At, B1); PG8_BAR;
            PG8_LDB(B0, 1, 0); PG8_SCHED; PG8_LDA(At, 1, 0); PG8_STAGE(PG8_SA(0, 1), a2 + hstep, voffA);
            PG8_WAIT_L(8); PG8_BAR; PG8_WAIT_L(0); PG8_MMA(0, 0, At, B0); PG8_BAR; PG8_SCHED;
            PG8_LDB(B1, 1, 1); PG8_STAGE(PG8_SB(1, 0), b3, voffB);
            PG8_BAR; PG8_WAIT_L(0); PG8_MMA(0, 1, At, B1); PG8_BAR;
            PG8_LDA(At, 1, 1); PG8_STAGE(PG8_SA(1, 0), a3, voffA);
            PG8_BAR; PG8_WAIT_L(0); PG8_MMA(1, 0, At, B0); PG8_BAR; PG8_SCHED;
            PG8_STAGE(PG8_SB(1, 1), b3 + hstep, voffB);
            PG8_WAIT_V(6); PG8_BAR; PG8_MMA(1, 1, At, B1); PG8_BAR;
            }
        }
        if constexpr (ALIGN_EPI) { if (wr == 0) PG8_BAR; }
        if constexpr (!Epi::AFTER_DRAIN) { E(acc, cur, wr, wc, fr, fq); S.done(cur); }
        if (!has_next) break;
#pragma unroll
        for (int a = 0; a < 2; ++a)
#pragma unroll
            for (int b = 0; b < 2; ++b)
#pragma unroll
                for (int m = 0; m < 4; ++m)
#pragma unroll
                    for (int n = 0; n < 2; ++n) acc[a][b][m][n] = (f32x4){0.f, 0.f, 0.f, 0.f};
        cur = nxt; cA = nA; cB = nB; ++ui;
        if constexpr (ALIGN_EPI) { if (wr == 1) PG8_BAR; }
    }
    PG8_WAIT_V(0);
    if constexpr (!ALIGN_EPI) { if (wr == 0) PG8_BAR; }
    PG8_BAR;
    if constexpr (Epi::AFTER_DRAIN) { E.fused(acc, cur, wr, wc, fr, fq, lds, wid, lane); S.done(cur); }
#undef PG8_SA
#undef PG8_SB
#undef PG8_STAGE
#undef PG8_LDA
#undef PG8_LDB
#undef PG8_MMA
#undef PG8_WAIT_V
#undef PG8_WAIT_L
#undef PG8_BAR
#undef PG8_SCHED
}
typedef int v8i __attribute__((ext_vector_type(8)));
typedef int v4i __attribute__((ext_vector_type(4)));
constexpr int SCALE_W8 = 0x78787878, SCALE_A8 = 0x7f7f7f7f;
template <class Epi, class Sched, bool ALIGN_EPI = false, bool SP2 = false>
__device__ __forceinline__ void gemm_phase8(PG8_LAS unsigned char* lds, const Gemm g, const Sched& S, const Epi& E) {
    const int tid = threadIdx.x, wid = __builtin_amdgcn_readfirstlane(tid >> 6), lane = tid & 63, wr = wid >> 2, wc = wid & 3, fr = lane & 15, fq = lane >> 4;
    const int K = g.K, nt = K / BK;
    unsigned voffA[2], voffB[2];
#pragma unroll
    for (int i = 0; i < 2; ++i) { int R, C; stage_rc(tid * 16 + i * 8192, R, C); const int Rb = Epi::PERM ? ((R & ~31) + perm32(R & 31)) : R;
        voffA[i] = (unsigned)(R * K + C) * 2u; voffB[i] = (unsigned)(Rb * K + C) * 2u; }
    const size_t kstep = (size_t)(BK * 2);
    const size_t hstep = (size_t)HALF * K * 2;
    const size_t tstep = 2 * hstep;
    const unsigned ldsw = (unsigned)wid * 1024u;
    const int aoff = lds_byte(wr * 64 + fr, fq * 8), boff = lds_byte(wc * 32 + fr, fq * 8);
#define PG8_SA(b, h) (((b) * 2 + (h)) * HTB)
#define PG8_SB(b, h) ((4 + (b) * 2 + (h)) * HTB)
#define PG8_STAGE(bufoff, gbase, voff) do { _Pragma("unroll") for (int _i = 0; _i < 2; ++_i) \
        __builtin_amdgcn_global_load_lds((const unsigned*)((const char*)(gbase) + (voff)[_i]), (PG8_LAS unsigned*)(lds + (bufoff) + ldsw + _i * 8192), 16, 0, 0); } while (0)
#define PG8_LDA(dst, b, h) do { _Pragma("unroll") for (int m = 0; m < 4; ++m) { const v4i lo_ = *(const PG8_LAS v4i*)(lds + PG8_SA(b, h) + aoff + m * 2048), hi_ = *(const PG8_LAS v4i*)(lds + PG8_SA(b, h) + aoff + m * 2048 + 1024); \
        dst[m] = __builtin_shufflevector(lo_, hi_, 0, 1, 2, 3, 4, 5, 6, 7); } } while (0)
#define PG8_LDB(dst, b, h) do { _Pragma("unroll") for (int n = 0; n < 2; ++n) { const v4i lo_ = *(const PG8_LAS v4i*)(lds + PG8_SB(b, h) + boff + n * 2048), hi_ = *(const PG8_LAS v4i*)(lds + PG8_SB(b, h) + boff + n * 2048 + 1024); \
        dst[n] = __builtin_shufflevector(lo_, hi_, 0, 1, 2, 3, 4, 5, 6, 7); } } while (0)
#define PG8_MMA(ai, bj, At, Bt) do { __builtin_amdgcn_s_setprio(1); _Pragma("unroll") for (int m = 0; m < 4; ++m) _Pragma("unroll") for (int n = 0; n < 2; ++n) \
        asm volatile("v_mfma_scale_f32_16x16x128_f8f6f4 %0, %1, %2, %0, %3, %4 op_sel_hi:[0,0,0]" : "+v"(acc[ai][bj][m][n]) : "v"(Bt[n]), "v"(At[m]), "v"(sw8), "v"(sa8)); __builtin_amdgcn_s_setprio(0); } while (0)
#define PG8_WAIT_V(n) asm volatile("s_waitcnt vmcnt(" #n ")" ::: "memory")
#define PG8_WAIT_L(n) asm volatile("s_waitcnt lgkmcnt(" #n ")" ::: "memory")
#define PG8_BAR __builtin_amdgcn_s_barrier()
#define PG8_SCHED __builtin_amdgcn_sched_barrier(0)
    Unit cur, nxt; int ui = 0;
    if (!S.next(0, cur)) return;
    f32x4 acc[2][2][4][2];
#pragma unroll
    for (int a = 0; a < 2; ++a)
#pragma unroll
        for (int b = 0; b < 2; ++b)
#pragma unroll
            for (int m = 0; m < 4; ++m)
#pragma unroll
                for (int n = 0; n < 2; ++n) acc[a][b][m][n] = (f32x4){0.f, 0.f, 0.f, 0.f};
    v8i At[4], B0[2], B1[2]; int sw8 = SCALE_W8, sa8 = SCALE_A8;
    const char* cA = (const char*)g.A + (size_t)cur.pm * tstep; const char* cB = (const char*)g.Bt + (size_t)cur.pb * tstep;
    S.a_ready(cur);
    if constexpr (SP2) {
        PG8_STAGE(PG8_SB(0, 0), cB, voffB); PG8_STAGE(PG8_SB(0, 1), cB + hstep, voffB); PG8_STAGE(PG8_SA(0, 0), cA, voffA); PG8_STAGE(PG8_SA(0, 1), cA + hstep, voffA);
        if (wr == 1) PG8_BAR;
        PG8_WAIT_V(2); PG8_BAR;
        PG8_STAGE(PG8_SB(1, 0), cB + kstep, voffB); PG8_STAGE(PG8_SA(1, 0), cA + kstep, voffA); PG8_STAGE(PG8_SB(1, 1), cB + hstep + kstep, voffB);
        PG8_WAIT_V(6); PG8_BAR;
    } else {
        PG8_STAGE(PG8_SB(0, 0), cB, voffB); PG8_STAGE(PG8_SA(0, 0), cA, voffA); PG8_STAGE(PG8_SB(0, 1), cB + hstep, voffB); PG8_STAGE(PG8_SA(0, 1), cA + hstep, voffA);
        if (wr == 1) PG8_BAR;
        PG8_WAIT_V(4); PG8_BAR;
        PG8_STAGE(PG8_SB(1, 0), cB + kstep, voffB); PG8_STAGE(PG8_SA(1, 0), cA + kstep, voffA); PG8_STAGE(PG8_SB(1, 1), cB + hstep + kstep, voffB);
        PG8_WAIT_V(6); PG8_BAR;
    }
    for (;;) {
        const bool has_next = S.next(ui + 1, nxt);
        const char* nA = has_next ? (const char*)g.A + (size_t)nxt.pm * tstep : cA; const char* nB = has_next ? (const char*)g.Bt + (size_t)nxt.pb * tstep : cB;
        for (int t = 0; t < nt; t += 2) {
            const bool last = (t == nt - 2);
            const char* a1 = cA + (size_t)(t + 1) * kstep;
            const char* a2 = last ? nA : cA + (size_t)(t + 2) * kstep; const char* b2 = last ? nB : cB + (size_t)(t + 2) * kstep;
            const char* a3 = a2 + kstep; const char* b3 = b2 + kstep;
            if (last && has_next) S.a_ready(nxt);
            if constexpr (SP2) {
            PG8_LDB(B0, 0, 0); PG8_LDB(B1, 0, 1); PG8_SCHED; PG8_LDA(At, 0, 0); PG8_STAGE(PG8_SA(1, 1), a1 + hstep, voffA);
            PG8_WAIT_V(8); PG8_WAIT_L(0); PG8_BAR; PG8_MMA(0, 0, At, B0); PG8_MMA(0, 1, At, B1); PG8_BAR; PG8_SCHED;
            PG8_LDA(At, 0, 1); PG8_STAGE(PG8_SB(0, 0), b2, voffB); PG8_STAGE(PG8_SB(0, 1), b2 + hstep, voffB); PG8_STAGE(PG8_SA(0, 0), a2, voffA);
            PG8_WAIT_V(8); PG8_WAIT_L(0); PG8_BAR; PG8_MMA(1, 0, At, B0); PG8_MMA(1, 1, At, B1); PG8_BAR; PG8_SCHED;
            PG8_LDB(B0, 1, 0); PG8_LDB(B1, 1, 1); PG8_SCHED; PG8_LDA(At, 1, 0); PG8_STAGE(PG8_SA(0, 1), a2 + hstep, voffA);
            PG8_WAIT_V(8); PG8_WAIT_L(0); PG8_BAR; PG8_MMA(0, 0, At, B0); PG8_MMA(0, 1, At, B1); PG8_BAR; PG8_SCHED;
            PG8_LDA(At, 1, 1); PG8_STAGE(PG8_SB(1, 0), b3, voffB); PG8_STAGE(PG8_SB(1, 1), b3 + hstep, voffB); PG8_STAGE(PG8_SA(1, 0), a3, voffA);
            PG8_WAIT_V(8); PG8_WAIT_L(0); PG8_BAR; PG8_MMA(1, 0, At, B0); PG8_MMA(1, 1, At, B1); PG8_BAR; PG8_SCHED;
            } else {
            PG8_LDB(B0, 0, 0); PG8_SCHED; PG8_LDA(At, 0, 0); PG8_STAGE(PG8_SA(1, 1), a1 + hstep, voffA);
            PG8_WAIT_L(8); PG8_BAR; PG8_WAIT_L(0); PG8_MMA(0, 0, At, B0); PG8_BAR; PG8_SCHED;
            PG8_LDB(B1, 0, 1); PG8_STAGE(PG8_SB(0, 0), b2, voffB);
            PG8_BAR; PG8_WAIT_L(0); PG8_MMA(0, 1, At, B1); PG8_BAR;
            PG8_LDA(At, 0, 1); PG8_STAGE(PG8_SA(0, 0), a2, voffA);
            PG8_BAR; PG8_WAIT_L(0); PG8_MMA(1, 0, At, B0); PG8_BAR; PG8_SCHED;
            PG8_STAGE(PG8_SB(0, 1), b2 + hstep, voffB);
            PG8_WAIT_V(6); PG8_BAR; PG8_MMA(1, 1, At, B1); PG8_BAR;
            PG8_LDB(B0, 1, 0); PG8_SCHED; PG8_LDA(At, 1, 0); PG8_STAGE(PG8_SA(0, 1), a2 + hstep, voffA);
            PG8_WAIT_L(8); PG8_BAR; PG8_WAIT_L(0); PG8_MMA(0, 0, At, B0); PG8_BAR; PG8_SCHED;
            PG8_LDB(B1, 1, 1); PG8_STAGE(PG8_SB(1, 0), b3, voffB);
            PG8_BAR; PG8_WAIT_L(0); PG8_MMA(0, 1, At, B1); PG8_BAR;
            PG8_LDA(At, 1, 1); PG8_STAGE(PG8_SA(1, 0), a3, voffA);
            PG8_BAR; PG8_WAIT_L(0); PG8_MMA(1, 0, At, B0); PG8_BAR; PG8_SCHED;
            PG8_STAGE(PG8_SB(1, 1), b3 + hstep, voffB);
            PG8_WAIT_V(6); PG8_BAR; PG8_MMA(1, 1, At, B1); PG8_BAR;
            }
        }
        if constexpr (ALIGN_EPI) { if (wr == 0) PG8_BAR; }
        asm volatile("s_nop 15\n\ts_nop 7" ::: "memory");
        if constexpr (!Epi::AFTER_DRAIN) { E(acc, cur, wr, wc, fr, fq); S.done(cur); }
        if (!has_next) break;
#pragma unroll
        for (int a = 0; a < 2; ++a)
#pragma unroll
            for (int b = 0; b < 2; ++b)
#pragma unroll
                for (int m = 0; m < 4; ++m)
#pragma unroll
                    for (int n = 0; n < 2; ++n) acc[a][b][m][n] = (f32x4){0.f, 0.f, 0.f, 0.f};
        cur = nxt; cA = nA; cB = nB; ++ui;
        if constexpr (ALIGN_EPI) { if (wr == 1) PG8_BAR; }
    }
    PG8_WAIT_V(0);
    if constexpr (!ALIGN_EPI) { if (wr == 0) PG8_BAR; }
    PG8_BAR;
    if constexpr (Epi::AFTER_DRAIN) { E.fused(acc, cur, wr, wc, fr, fq, lds, wid, lane); S.done(cur); }
#undef PG8_SA
#undef PG8_SB
#undef PG8_STAGE
#undef PG8_LDA
#undef PG8_LDB
#undef PG8_MMA
#undef PG8_WAIT_V
#undef PG8_WAIT_L
#undef PG8_BAR
#undef PG8_SCHED
}
}
#define GAS __attribute__((address_space(1)))
#define LAS __attribute__((address_space(3)))
typedef unsigned short bf16;
typedef unsigned v4u __attribute__((ext_vector_type(4)));
typedef float f32x4 __attribute__((ext_vector_type(4)));
typedef short bf16x8 __attribute__((ext_vector_type(8)));
typedef GAS unsigned gu32;
typedef GAS unsigned long long gu64;
#define RLX_AGENT __ATOMIC_RELAXED, __HIP_MEMORY_SCOPE_AGENT
#define LDS_WAIT() asm volatile("s_waitcnt lgkmcnt(0)" ::: "memory")
#define VM_WAIT() asm volatile("s_waitcnt vmcnt(0)" ::: "memory")
__device__ __forceinline__ unsigned long long rt() { return __builtin_amdgcn_s_memrealtime(); }
__device__ __forceinline__ unsigned f2bf(float f) { unsigned u = __builtin_bit_cast(unsigned, f); return (u + 0x7fffu + ((u >> 16) & 1u)) >> 16; }
__device__ __forceinline__ unsigned pk2(float lo, float hi) { return f2bf(lo) | (f2bf(hi) << 16); }

#define XB_TMO      128
#define XB_XCNT(j)  (256  + 64 * (j))
#define XB_XSUB(j)  (1280 + 64 * (j))
#define XB_XGEN(j)  (2304 + 64 * (j))
#define XB_TOP      3328
#define XB_TOPGEN   3392
#define XCD_BAR_WORDS 3456
#define XB_SPIN_CAP (1u << 18)

__device__ __forceinline__ unsigned xb_ld(unsigned* p)              { return __hip_atomic_load(p, __ATOMIC_RELAXED, __HIP_MEMORY_SCOPE_AGENT); }
__device__ __forceinline__ unsigned xb_add(unsigned* p, unsigned v) { return __hip_atomic_fetch_add(p, v, __ATOMIC_RELAXED, __HIP_MEMORY_SCOPE_AGENT); }
__device__ __forceinline__ unsigned xb_xcc_id() { return (unsigned)__builtin_amdgcn_s_getreg((3 << 11) | 20) & 0xFu; }
#define XB_SPIN(cond, bar) do { unsigned _sp = 0; while (cond) { __builtin_amdgcn_s_sleep(1); \
    if ((++_sp & 255u) == 0u) { if (xb_ld(&(bar)[XB_TMO])) break; if (_sp > XB_SPIN_CAP) { atomicAdd(&(bar)[XB_TMO], 1u); break; } } } } while (0)

struct XcdBarrier {
    unsigned* bar; unsigned x;
    volatile LAS unsigned* st;
};

__device__ __forceinline__ XcdBarrier xcd_barrier_post(unsigned* bar, volatile LAS unsigned* st) {
    XcdBarrier b; b.bar = bar; b.x = xb_xcc_id(); b.st = st;
    if (threadIdx.x == 0) (void)xb_add(&bar[XB_XCNT(b.x)], 1u);
    return b;
}
__device__ __forceinline__ void xcd_barrier_complete(unsigned* bar, unsigned x, unsigned& nloc, unsigned& nx) {
    const unsigned G = gridDim.x * gridDim.y * gridDim.z;
    unsigned sum, cnt, mine, sp = 0u;
    for (;;) {
        sum = 0u; cnt = 0u; mine = 0u;
#pragma unroll
        for (unsigned j = 0; j < 16; ++j) { const unsigned c = xb_ld(&bar[XB_XCNT(j)]); sum += c; cnt += (c > 0u) ? 1u : 0u; mine = (j == x) ? c : mine; }
        if (sum == G) break;
        __builtin_amdgcn_s_sleep(1);
        if ((++sp & 255u) == 0u) { if (xb_ld(&bar[XB_TMO])) break; if (sp > XB_SPIN_CAP) { atomicAdd(&bar[XB_TMO], 1u); break; } }
    }
    nloc = mine > 0u ? mine : 1u; nx = cnt > 0u ? cnt : 1u;
}

__device__ __forceinline__ void xcd_barrier(const XcdBarrier& b) {
    asm volatile("s_waitcnt vmcnt(0)" ::: "memory");
    __syncthreads();
    if (threadIdx.x == 0) {
        unsigned* bar = b.bar;
        __builtin_amdgcn_s_waitcnt(0);
        unsigned nloc = b.st[0], nx = b.st[1];
        if (nloc == 0u) { xcd_barrier_complete(bar, b.x, nloc, nx); b.st[0] = nloc; b.st[1] = nx; }
        const unsigned old = xb_add(&bar[XB_XSUB(b.x)], 1u);
        const unsigned gen = old / nloc;
        if (old + 1u == (gen + 1u) * nloc) {
            __builtin_amdgcn_fence(__ATOMIC_RELEASE, "agent");
            asm volatile("s_waitcnt vmcnt(0)" ::: "memory");
            const unsigned og = xb_add(&bar[XB_TOP], 1u);
            const unsigned tg = og / nx;
            if (og + 1u == (tg + 1u) * nx) xb_add(&bar[XB_TOPGEN], 1u);
            else XB_SPIN(xb_ld(&bar[XB_TOPGEN]) == tg, bar);
            __builtin_amdgcn_fence(__ATOMIC_ACQUIRE, "agent");
            xb_add(&bar[XB_XGEN(b.x)], 1u);
            asm volatile("s_waitcnt vmcnt(0)" ::: "memory");
        } else {
            XB_SPIN(xb_ld(&bar[XB_XGEN(b.x)]) == gen, bar);
            __builtin_amdgcn_fence(__ATOMIC_ACQUIRE, "agent");
            asm volatile("s_waitcnt vmcnt(0)" ::: "memory");
        }
    }
    __syncthreads();
}
namespace mk {
constexpr int S = 8192, D = 2048, NPROJ = 6160, NPP = 6144, NPAD = 6400, NE = 32, FF = 2048, NWAVES = 8, NTHR = 512;
constexpr int C_MQ = 0, C_MK = 512, C_MV = 1024, C_MO = 2048, C_FQ = 3072, C_FK = 4096, C_FV = 5120;
constexpr int MAXROWS = S * 4 + NE * 256;
constexpr int NCH = 128, LCH = 64;
constexpr size_t MiB = 1u << 20;
constexpr size_t WS_CTL = 0, CTL_ZERO_BYTES = 1 * MiB;
constexpr size_t WS_MODP = 14 * MiB;
constexpr size_t WS_MOD = 2 * MiB;
constexpr size_t WS_GATES = 3 * MiB;
constexpr size_t WS_F = 4 * MiB;
constexpr size_t WS_NL = 5 * MiB;
constexpr size_t WS_NS = 6 * MiB;
constexpr size_t WS_GLAL = 7 * MiB;
constexpr size_t WS_MS = 7 * MiB + 65536;
constexpr size_t WS_TOPI = 8 * MiB;
constexpr size_t WS_TOPW = 9 * MiB;
constexpr size_t WS_HIST = 10 * MiB;
constexpr size_t WS_LRANK = 11 * MiB;
constexpr size_t WS_POS = 12 * MiB;
constexpr size_t WS_ROWW = 13 * MiB;
constexpr size_t WS_WIN = 16 * MiB;
constexpr size_t WS_WOUT = 42 * MiB;
constexpr size_t WS_HN = 50 * MiB;
constexpr size_t WS_PROJ = 82 * MiB;
constexpr size_t WS_UL = 178 * MiB;
constexpr size_t WS_CS = 242 * MiB;
constexpr size_t WS_CONCAT = 274 * MiB;
constexpr size_t WS_H1 = 306 * MiB;
constexpr size_t WS_XG = 370 * MiB;
constexpr size_t WS_ACT = 530 * MiB;
constexpr size_t WS_Y = 690 * MiB;
constexpr size_t WS_WUG = 850 * MiB;
constexpr size_t WS_WD = 1362 * MiB;
constexpr size_t WS_OPART = 1618 * MiB;
constexpr size_t WS_MLP = 1786 * MiB;
constexpr size_t WS_JLO = 1789 * MiB;
constexpr size_t WS_END = 1790 * MiB;
constexpr size_t WS_NAIVE = 1792 * MiB;
constexpr int CW_TMO = 0, CW_CODE = 1, CW_CONV = 65536, CW_DONE = 2048, CW_BAR = 4096;
constexpr int GC_INPROJ = 160, GC_ATTN = 160, GC_PREP = 192;
constexpr int RING_OFF = 0, RING_BYTES = 131072;
constexpr int LDSCTL_OFF = RING_BYTES, MISC_OFF = LDSCTL_OFF + 320;
constexpr int TAB_OFF = LDSCTL_OFF + 1024;
constexpr int ATT_CH = 16;
constexpr int LDS_BYTES = 147456;
}
namespace mk {
typedef float f32x2 __attribute__((ext_vector_type(2)));
typedef unsigned u32x2 __attribute__((ext_vector_type(2)));
struct Frame {
    LAS unsigned char* lds;
    volatile LAS unsigned* MISC;
    gu32* ctl;
    int tid, lane, wave, vcu, G, bid;
    const float* in[24];
    float* out; unsigned char* ws;
};
#define IN_X 0
#define IN_C 1
#define IN_WADA 2
#define IN_BADA 3
#define IN_NMIX 4
#define IN_WIN 5
#define IN_BI 6
#define IN_BF 7
#define IN_FOXBF 8
#define IN_FOXQN 9
#define IN_FOXKN 10
#define IN_MOUTN 11
#define IN_FOUTN 12
#define IN_WOUT 13
#define IN_NFFN 14
#define IN_WR 15
#define IN_BR 16
#define IN_WUG 17
#define IN_BUG 18
#define IN_WD 19
#define IN_BD 20
#define IN_WAF 21
#define IN_BAF 22
#define IN_NFIN 23
template <class T> __device__ __forceinline__ T* wsp(const Frame& F, size_t off) { return (T*)(F.ws + off); }
__device__ __forceinline__ float wave_sum(float v) {
#pragma unroll
    for (int o = 1; o < 64; o <<= 1) v += __shfl_xor(v, o);
    return v;
}
__device__ __forceinline__ float sigmoid_f(float v) { return 1.f / (1.f + __expf(-v)); }
__device__ __forceinline__ float log_sigmoid_f(float v) { return fminf(v, 0.f) - log1pf(__expf(-fabsf(v))); }
__device__ __forceinline__ float softcap_f(float v) { return 15.f * tanhf(v * (1.f / 15.f)); }
__device__ __forceinline__ float bf2f(unsigned short b) { return __uint_as_float(((unsigned)b) << 16); }

struct CvtItem { const float* src; bf16* dst; };
__device__ __forceinline__ void cvt_load(const CvtItem& it, int ldw, f32x4 (&v)[16], int lane) {
    const float* p = it.src + (size_t)((lane >> 4) * 16) * ldw + (lane & 15) * 4;
#pragma unroll
    for (int i = 0; i < 16; ++i) v[i] = __builtin_nontemporal_load((const GAS f32x4*)(p + (size_t)i * ldw));
}
__device__ __forceinline__ void cvt_store(const CvtItem& it, int K, const f32x4 (&v)[16], LAS unsigned char* scr, int lane) {
    const int c = lane & 15, g = lane >> 4;
#pragma unroll
    for (int j = 0; j < 4; ++j) {
        v4u a, b;
        a.x = pk2(v[0][j], v[1][j]); a.y = pk2(v[2][j], v[3][j]); a.z = pk2(v[4][j], v[5][j]); a.w = pk2(v[6][j], v[7][j]);
        b.x = pk2(v[8][j], v[9][j]); b.y = pk2(v[10][j], v[11][j]); b.z = pk2(v[12][j], v[13][j]); b.w = pk2(v[14][j], v[15][j]);
        LAS unsigned char* q = scr + (4 * c + j) * 144 + 32 * g;
        *(LAS v4u*)q = a; *(LAS v4u*)(q + 16) = b; }
    LDS_WAIT(); asm volatile("" ::: "memory");
#pragma unroll
    for (int i = 0; i < 8; ++i) { const int row = (lane >> 3) + 8 * i; const v4u o = *(const LAS v4u*)(scr + row * 144 + (lane & 7) * 16);
        *(GAS v4u*)(it.dst + (size_t)row * K + (lane & 7) * 8) = o; }
    LDS_WAIT(); asm volatile("" ::: "memory");
}
__device__ __forceinline__ unsigned pk4_fp8(float a, float b, float c, float d) { int r = __builtin_amdgcn_cvt_pk_fp8_f32(a, b, 0, false); r = __builtin_amdgcn_cvt_pk_fp8_f32(c, d, r, true); return (unsigned)r; }
constexpr float W8S = 128.f;
__device__ __forceinline__ void cvt8_pack(const f32x4 (&v)[16], LAS unsigned char* scr, int half, int lane) {
    const int c = lane & 15, g = lane >> 4;
#pragma unroll
    for (int j = 0; j < 4; ++j) { v4u a;
        a.x = pk4_fp8(v[0][j] * W8S, v[1][j] * W8S, v[2][j] * W8S, v[3][j] * W8S); a.y = pk4_fp8(v[4][j] * W8S, v[5][j] * W8S, v[6][j] * W8S, v[7][j] * W8S);
        a.z = pk4_fp8(v[8][j] * W8S, v[9][j] * W8S, v[10][j] * W8S, v[11][j] * W8S); a.w = pk4_fp8(v[12][j] * W8S, v[13][j] * W8S, v[14][j] * W8S, v[15][j] * W8S);
        *(LAS v4u*)(scr + (4 * c + j) * 144 + half * 64 + 16 * g) = a; }
}
__device__ __forceinline__ void cvt8_flush(unsigned char* dst, int kbytes, LAS unsigned char* scr, int lane) {
    LDS_WAIT(); asm volatile("" ::: "memory");
#pragma unroll
    for (int i = 0; i < 8; ++i) { const int row = (lane >> 3) + 8 * i; const v4u o = *(const LAS v4u*)(scr + row * 144 + (lane & 7) * 16);
        *(GAS v4u*)(dst + (size_t)row * kbytes + (lane & 7) * 16) = o; }
    LDS_WAIT(); asm volatile("" ::: "memory");
}
constexpr int CV8_UG = NE * 16 * 64, CV8_D = NE * 16 * 32, CV8_TOTAL = CV8_UG + CV8_D;
struct Cvt8Item { const float* src; unsigned char* dst; int ldw; };
__device__ __forceinline__ Cvt8Item cvt8_item(const Frame& F, int it, int half) {
    Cvt8Item r;
    if (it < CV8_UG) { const int e = it >> 10, q = it & 1023, kb = q >> 6, nb = q & 63, d0 = nb * 64, j = d0 >> 8, wv = d0 & 255, sc = wv < 128 ? 128 * j + wv : 2048 + 128 * j + (wv - 128);
        r.ldw = 4096; r.src = F.in[IN_WUG] + (size_t)e * D * 4096 + (size_t)(kb * 128 + half * 64) * 4096 + sc; r.dst = wsp<unsigned char>(F, WS_WUG) + (size_t)e * 4096 * D + (size_t)d0 * D + kb * 128; return r; }
    it -= CV8_UG;
    { const int e = it >> 9, q = it & 511, kb = q >> 5, nb = q & 31;
        r.ldw = D; r.src = F.in[IN_WD] + (size_t)e * FF * D + (size_t)(kb * 128 + half * 64) * D + nb * 64; r.dst = wsp<unsigned char>(F, WS_WD) + (size_t)e * D * FF + (size_t)(nb * 64) * FF + kb * 128; return r; }
}
__device__ __forceinline__ void cvt8_load(const Cvt8Item& it, f32x4 (&v)[16], int lane) {
    const float* p = it.src + (size_t)((lane >> 4) * 16) * it.ldw + (lane & 15) * 4;
#pragma unroll
    for (int i = 0; i < 16; ++i) v[i] = __builtin_nontemporal_load((const GAS f32x4*)(p + (size_t)i * it.ldw));
}
constexpr int CV_IN = 32 * 96, CV_OUT = 32 * 32, CV_TOTAL = CV_IN + CV_OUT;
__device__ __forceinline__ CvtItem cvt_item(const Frame& F, int it, int& ldw, int& K) {
    CvtItem r;
    if (it < CV_IN) { const int kb = it / 96, nb = it % 96, d0 = nb * 64, sc = d0 < 3072 ? d0 : d0 + 8;
        ldw = NPROJ; K = D; r.src = F.in[IN_WIN] + (size_t)(kb * 64) * NPROJ + sc; r.dst = wsp<bf16>(F, WS_WIN) + (size_t)d0 * D + kb * 64; return r; }
    it -= CV_IN;
    { const int kb = it >> 5, nb = it & 31; ldw = D; K = D; r.src = F.in[IN_WOUT] + (size_t)(kb * 64) * D + nb * 64; r.dst = wsp<bf16>(F, WS_WOUT) + (size_t)(nb * 64) * D + kb * 64; return r; }
}
__device__ __forceinline__ void p0_gemv(Frame& F) {
    const int gw = F.vcu * NWAVES + F.wave, NGW = F.G * NWAVES, lane = F.lane;
    {
        const float* c = F.in[IN_C]; float* modp = wsp<float>(F, WS_MODP);
        for (int task = gw; task < 2048; task += NGW) {
            const int cg = task & 63, ks = task >> 6, j = cg * 256 + 4 * lane;
            const float* w; int ld, col;
            if (j < 6 * D) { w = F.in[IN_WADA]; ld = 6 * D; col = j; } else { w = F.in[IN_WAF]; ld = 2 * D; col = j - 6 * D; }
            const float c0 = c[ks * 64 + lane]; const float s0 = c0 * sigmoid_f(c0);
            const float* wp = w + (size_t)(ks * 64) * ld + col; f32x4 acc = {0.f, 0.f, 0.f, 0.f};
#pragma unroll 16
            for (int i = 0; i < 64; ++i) acc += __builtin_nontemporal_load((const GAS f32x4*)(wp + (size_t)i * ld)) * __builtin_bit_cast(float, __builtin_amdgcn_readlane(__builtin_bit_cast(int, s0), i));
            *(GAS f32x4*)(modp + ks * 16384 + j) = acc;
        }
    }
    {
        bf16* win_t = wsp<bf16>(F, WS_WIN);
        for (int i2 = gw; i2 < D / 4; i2 += NGW) {
            const int col = lane & 15, k = 4 * i2 + (lane >> 4), sc = col < 8 ? 3072 + col : 6152 + (col - 8);
            win_t[(size_t)(NPP + col) * D + k] = (bf16)f2bf(F.in[IN_WIN][(size_t)k * NPROJ + sc]); }
        const v4u z = {0u, 0u, 0u, 0u};
        for (int i = gw * 64 + lane; i < 16 * D / 8; i += NGW * 64) *(GAS v4u*)(win_t + (size_t)NPROJ * D + (size_t)i * 8) = z;
    }
}
constexpr int CV8_NSH = 32, CV8_SHARD = CV8_TOTAL / CV8_NSH, CV8_CHUNK = 1;
#define CONV_NEXT(var) do { if (cpos < cend) { var = cpos++; } else { const int b_ = __builtin_amdgcn_readfirstlane((int)(lane == 0 ? __hip_atomic_fetch_add(ctr, (unsigned)CV8_CHUNK, RLX_AGENT) : 0u)); \
        if (b_ < CV8_SHARD) { var = xbase + b_; cpos = var + 1; cend = xbase + (b_ + CV8_CHUNK < CV8_SHARD ? b_ + CV8_CHUNK : CV8_SHARD); } else { var = CV8_TOTAL; } } } while (0)
__device__ __forceinline__ void conv_worker(Frame& F, gu32* stop, unsigned target) {
    LAS unsigned char* scr = F.lds + RING_OFF + F.wave * 9216; const int lane = F.lane, xs = (int)(blockIdx.x & (CV8_NSH - 1)), xbase = xs * CV8_SHARD; gu32* ctr = F.ctl + CW_CONV + 64 * xs;
    int cpos = 0, cend = 0, it; CONV_NEXT(it); if (it >= CV8_TOTAL) return;
    f32x4 va[16], vb[16];
    Cvt8Item cur = cvt8_item(F, it, 0); cvt8_load(cur, va, lane);
    for (;;) {
        const Cvt8Item c1 = cvt8_item(F, it, 1); cvt8_load(c1, vb, lane);
        bool stopnow = false;
        if (stop && cpos >= cend) stopnow = (unsigned)__builtin_amdgcn_readfirstlane((int)__hip_atomic_load(stop, RLX_AGENT)) >= target;
        int itn = CV8_TOTAL; if (!stopnow) CONV_NEXT(itn);
        cvt8_pack(va, scr, 0, lane);
        const bool more = itn < CV8_TOTAL; Cvt8Item nx = cur;
        if (more) { nx = cvt8_item(F, itn, 0); cvt8_load(nx, va, lane); }
        cvt8_pack(vb, scr, 1, lane);
        cvt8_flush(cur.dst, D, scr, lane);
        if (!more) break;
        cur = nx; it = itn;
    }
}
__device__ __forceinline__ bool enter_group(Frame& F, int Gc) {
    if (F.G != 256 || Gc >= 256) return true;
    const int bx = (int)blockIdx.x, slot = bx >> 3, xcd = bx & 7, per = Gc >> 3;
    if (slot >= per) return false;
    F.vcu = xcd * per + slot; F.bid = slot * 8 + xcd; F.G = Gc; return true;
}
__device__ __forceinline__ void leave_group(Frame& F) { const int bx = (int)blockIdx.x, G = (int)gridDim.x; F.G = G; F.bid = bx; F.vcu = (G % 8 == 0) ? (bx % 8) * (G / 8) + bx / 8 : bx; }
__device__ __forceinline__ void p1_convert(Frame& F) {
    const int gw = F.vcu * NWAVES + F.wave, NGW = F.G * NWAVES, lane = F.lane;
    {
        LAS unsigned char* scr = F.lds + RING_OFF + F.wave * 9216;
        int it = gw;
        if (it < CV_TOTAL) {
            int ldw, K; CvtItem cur = cvt_item(F, it, ldw, K); f32x4 va[16], vb[16];
            cvt_load(cur, ldw, va, lane);
            for (;;) {
                int itn = it + NGW; int ldn = 0, Kn = 0; CvtItem nx = cur; const bool more = itn < CV_TOTAL;
                if (more) { nx = cvt_item(F, itn, ldn, Kn); cvt_load(nx, ldn, vb, lane); }
                cvt_store(cur, K, va, scr, lane);
                if (!more) break;
                it = itn + NGW; const bool more2 = it < CV_TOTAL; CvtItem n2 = nx; int ld2 = 0, K2 = 0;
                if (more2) { n2 = cvt_item(F, it, ld2, K2); cvt_load(n2, ld2, va, lane); }
                cvt_store(nx, Kn, vb, scr, lane);
                if (!more2) break;
                cur = n2; K = K2;
            }
        }
    }
}
__device__ __forceinline__ void mod_reduce_lds(Frame& F, int j0, int n, LAS float* dst) {
    const float* modp = wsp<float>(F, WS_MODP);
    for (int i = F.tid; i < n; i += NTHR) { const int j = j0 + i; float a = j < 6 * D ? F.in[IN_BADA][j] : F.in[IN_BAF][j - 6 * D];
#pragma unroll
        for (int ks = 0; ks < 32; ++ks) a += modp[ks * 16384 + j];
        dst[i] = a; }
}
__device__ __forceinline__ void modulate_row_bf16(const float* xrow, const float* g, const LAS float* sh, const LAS float* sc, bf16* orow, int lane) {
    const GAS f32x4* xr = (const GAS f32x4*)xrow + lane; f32x4 v[8]; float s2 = 0.f;
#pragma unroll
    for (int j = 0; j < 8; ++j) { v[j] = xr[64 * j]; s2 += (v[j].x * v[j].x + v[j].y * v[j].y) + (v[j].z * v[j].z + v[j].w * v[j].w); }
    const float r = rsqrtf(wave_sum(s2) * (1.f / D) + 1e-6f);
    GAS u32x2* o8 = (GAS u32x2*)orow + lane;
#pragma unroll
    for (int j = 0; j < 8; ++j) { const int c0 = 4 * lane + 256 * j; const f32x4 gg = *(const GAS f32x4*)(g + c0); const f32x4 a = *(const LAS f32x4*)(sc + c0), b = *(const LAS f32x4*)(sh + c0);
        const f32x4 y = v[j] * r * gg * (a + 1.f) + b; u32x2 w; w.x = pk2(y.x, y.y); w.y = pk2(y.z, y.w); o8[64 * j] = w; }
}
typedef float f32x16 __attribute__((ext_vector_type(16)));
typedef short s16x8g __attribute__((ext_vector_type(8)));
__device__ __forceinline__ void p1_modulate(Frame& F) {
    LAS float* shs = (LAS float*)(F.lds + RING_OFF + 81920);
    LAS float* gred = (LAS float*)(F.lds + RING_OFF + 98304);
    mod_reduce_lds(F, 0, 2 * D, shs);
    if (F.tid < 64) {
        const float* modp = wsp<float>(F, WS_MODP); float* mod = wsp<float>(F, WS_MOD);
        for (int j = blockIdx.x * 64 + F.tid; j < 16384; j += F.G * 64) { float a = j < 6 * D ? F.in[IN_BADA][j] : F.in[IN_BAF][j - 6 * D];
#pragma unroll
            for (int ks = 0; ks < 32; ++ks) a += modp[ks * 16384 + j];
            mod[j] = a; }
    }
    __syncthreads();
    bf16* hn = wsp<bf16>(F, WS_HN); const bf16* wg = wsp<bf16>(F, WS_WIN) + (size_t)NPP * D; float* gates = wsp<float>(F, WS_GATES);
    const int lane = F.lane, w = F.wave, hi = lane >> 5, l31 = lane & 31;
    for (int rb = F.vcu; rb < S / 32; rb += F.G) {
        const int row0 = rb * 32;
#pragma unroll 1
        for (int i = 0; i < 4; ++i) { const int m = row0 + 4 * w + i; asm volatile("" ::: "memory"); modulate_row_bf16(F.in[IN_X] + (size_t)m * D, F.in[IN_NMIX], shs, shs + D, hn + (size_t)m * D, lane); }
        asm volatile("s_waitcnt vmcnt(0)" ::: "memory");
        __syncthreads();
        f32x16 acc;
#pragma unroll
        for (int r = 0; r < 16; ++r) acc[r] = 0.f;
        const bf16* ap = hn + (size_t)(row0 + l31) * D + 256 * w + 8 * hi; const bf16* bp = wg + (size_t)l31 * D + 256 * w + 8 * hi;
#pragma unroll
        for (int ks = 0; ks < 16; ++ks) { const s16x8g a = *(const GAS s16x8g*)(ap + 16 * ks), b = *(const GAS s16x8g*)(bp + 16 * ks); acc = __builtin_amdgcn_mfma_f32_32x32x16_bf16(a, b, acc, 0, 0, 0); }
        if (l31 < 16) {
#pragma unroll
            for (int r = 0; r < 16; ++r) gred[(w * 32 + (r & 3) + 8 * (r >> 2) + 4 * hi) * 16 + l31] = acc[r]; }
        __syncthreads();
        { const int row = F.tid >> 4, n = F.tid & 15; float s = 0.f;
#pragma unroll
            for (int q = 0; q < 8; ++q) s += gred[(q * 32 + row) * 16 + n];
            gates[(size_t)(row0 + row) * 16 + n] = s; }
        __syncthreads();
    }
    p1_convert(F);
}
using pg8::Unit; using pg8::cvt_pk_bf16;
struct EpiProj {
    static constexpr bool PERM = true, AFTER_DRAIN = false;
    bf16* O;
    __device__ __forceinline__ void operator()(const pg8::f32x4 (&acc)[2][2][4][2], const Unit& u, int wr, int wc, int fr, int fq) const {
        const int row0 = u.pm * 256 + wr * 64 + fr, col0 = u.pn * 256 + wc * 32 + 8 * fq;
#pragma unroll
        for (int ai = 0; ai < 2; ++ai)
#pragma unroll
            for (int m = 0; m < 4; ++m) { bf16* rowp = O + (size_t)(row0 + ai * 128 + m * 16) * NPP + col0;
#pragma unroll
                for (int bj = 0; bj < 2; ++bj) { const pg8::f32x4 v0 = acc[ai][bj][m][0], v1 = acc[ai][bj][m][1];
                    pg8::u32x4 w; w.x = cvt_pk_bf16(v0[0], v0[1]); w.y = cvt_pk_bf16(v0[2], v0[3]); w.z = cvt_pk_bf16(v1[0], v1[1]); w.w = cvt_pk_bf16(v1[2], v1[3]);
                    *(pg8::u32x4*)(rowp + bj * 128) = w; } }
    }
};
struct EpiOut {
    static constexpr bool PERM = false, AFTER_DRAIN = false;
    const float* x; const float* g1; float* h1;
    __device__ __forceinline__ void operator()(const pg8::f32x4 (&acc)[2][2][4][2], const Unit& u, int wr, int wc, int fr, int fq) const {
        const int row0 = u.pm * 256 + wr * 64 + fr, col0 = u.pn * 256 + wc * 32 + 4 * fq;
        pg8::f32x4 gv[2][2];
#pragma unroll
        for (int bj = 0; bj < 2; ++bj)
#pragma unroll
            for (int n = 0; n < 2; ++n) gv[bj][n] = *(const pg8::f32x4*)(g1 + col0 + bj * 128 + n * 16);
#pragma unroll
        for (int ai = 0; ai < 2; ++ai)
#pragma unroll
            for (int m = 0; m < 4; ++m) { const size_t off = (size_t)(row0 + ai * 128 + m * 16) * D + col0;
#pragma unroll
                for (int bj = 0; bj < 2; ++bj)
#pragma unroll
                    for (int n = 0; n < 2; ++n) { const pg8::f32x4 xv = *(const pg8::f32x4*)(x + off + bj * 128 + n * 16);
                        *(pg8::f32x4*)(h1 + off + bj * 128 + n * 16) = xv + gv[bj][n] * acc[ai][bj][m][n]; } }
    }
};
}
namespace fox {
constexpr int D = 128, SQ = 8192, SKV = 8192; constexpr float THR = 8.f; constexpr bool WSKIP = false;
constexpr int PITCH = 6144;
constexpr int OPITCH = 2048;
constexpr float SCALE = 0.08838834764831845f;
constexpr int NW = 8, QBLK = 32, KVBLK = 64, QB = NW * QBLK;
constexpr int SHM_V = KVBLK * D * 2, SHM_K = KVBLK * D * 2;
constexpr int LDS_BIAS = 2 * SHM_V + 2 * SHM_K + NW * 64 * 4;
constexpr int LDS_BYTES = LDS_BIAS + 512;

using bf16 = __hip_bfloat16;
typedef short bf16x8 __attribute__((ext_vector_type(8)));
typedef short s16x4 __attribute__((ext_vector_type(4)));
typedef float f32x16 __attribute__((ext_vector_type(16)));
typedef float f32x4 __attribute__((ext_vector_type(4)));
typedef unsigned u32x4 __attribute__((ext_vector_type(4)));
template <class A, class Bt> struct same_t { static constexpr bool v = false; };
template <class A> struct same_t<A, A> { static constexpr bool v = true; };

#define KSWZ(row, colB) ((row) * 256 + ((colB) ^ (((row) & 7) << 4)))
#define SBAR() __builtin_amdgcn_sched_barrier(0)
__device__ __forceinline__ int v_st(int k, int c) { const int kk = (k & ~0xC) | ((k & 4) << 1) | ((k & 8) >> 1); return ((kk >> 3) * 4 + (c >> 5)) * 512 + ((kk & 7) * 32 + (c & 31)) * 2; }
__device__ __forceinline__ int v_rd_base(int lane) { return ((lane & 3) << 3) | (((lane >> 2) & 3) << 6) | (((lane >> 4) & 1) << 5) | (((lane >> 5) & 1) << 8); }
constexpr int v_rd_off(int d0, int ks, int half) { return d0 * 512 + ks * 4096 + half * 2048; }
__device__ __forceinline__ int crow(int r, int hi) { return (r & 3) + 8 * (r >> 2) + 4 * hi; }
__device__ __forceinline__ int bias_slot(int kk) { return ((kk >> 2) & 1) * 32 + (kk >> 5) * 16 + (kk & 3) + 4 * ((kk & 31) >> 3); }
__device__ __forceinline__ unsigned cvtpk(float lo, float hi) {
    unsigned r; asm volatile("v_cvt_pk_bf16_f32 %0, %1, %2" : "=v"(r) : "v"(lo), "v"(hi)); return r;
}
__device__ __forceinline__ bf16x8 pack8(f32x4 a, f32x4 b) {
    u32x4 w = {cvtpk(a[0], a[1]), cvtpk(a[2], a[3]), cvtpk(b[0], b[1]), cvtpk(b[2], b[3])};
    return *reinterpret_cast<bf16x8*>(&w);
}
template <class T> __device__ __forceinline__ bf16x8 load8(const T* p) {
    if constexpr (same_t<T, float>::v) { return pack8(*(const f32x4*)p, *(const f32x4*)(p + 4)); }
    else { return *reinterpret_cast<const bf16x8*>(p); }
}
__device__ __forceinline__ void mask_tile(f32x16& p0, f32x16& p1, int dq, unsigned W) {
    const float NEG = -__builtin_inff();
#pragma unroll
    for (int r = 0; r < 16; ++r) {
        const int c = (r & 3) + 8 * (r >> 2);
        if ((unsigned)(dq - c) >= W) p0[r] = NEG;
        if ((unsigned)(dq - c - 32) >= W) p1[r] = NEG;
    }
}
__device__ __forceinline__ void partialSM(f32x16& p0, f32x16& p1, float& m_reg, float& mn, float& alpha) {
    float pmax = p0[0]; for (int r = 1; r < 16; ++r) pmax = fmaxf(pmax, p0[r]); for (int r = 0; r < 16; ++r) pmax = fmaxf(pmax, p1[r]);
    { auto rr = __builtin_amdgcn_permlane32_swap(__float_as_uint(pmax), __float_as_uint(pmax), false, false);
      pmax = fmaxf(__uint_as_float(rr[0]), __uint_as_float(rr[1])); }
    constexpr float C2 = 1.4426950408889634f * SCALE;
    if (__builtin_expect(__all((pmax - m_reg) * SCALE <= THR), 1)) { mn = m_reg; alpha = 1.f; }
    else { mn = fmaxf(m_reg, pmax); alpha = __builtin_amdgcn_exp2f((m_reg - mn) * C2); m_reg = mn; }
    const float mnL = -mn * C2;
    for (int r = 0; r < 16; ++r) p0[r] = fmaf(p0[r], C2, mnL); for (int r = 0; r < 16; ++r) p1[r] = fmaf(p1[r], C2, mnL);
    for (int r = 0; r < 16; ++r) p0[r] = __builtin_amdgcn_exp2f(p0[r]);
}
__device__ __forceinline__ void finishSM(f32x16& p0, f32x16& p1, float alpha, float& l_reg, bf16x8& pa0, bf16x8& pa1, bf16x8& pa2, bf16x8& pa3) {
    for (int r = 0; r < 16; ++r) p1[r] = __builtin_amdgcn_exp2f(p1[r]);
    float ps = 0; for (int r = 0; r < 16; ++r) ps += p0[r]; for (int r = 0; r < 16; ++r) ps += p1[r];
    { auto rr = __builtin_amdgcn_permlane32_swap(__float_as_uint(ps), __float_as_uint(ps), false, false);
      ps = __uint_as_float(rr[0]) + __uint_as_float(rr[1]); }
    l_reg = l_reg * alpha + ps;
#define PK4(P, B_, OUT) do { unsigned a0 = cvtpk(P[B_+0], P[B_+1]), a1 = cvtpk(P[B_+2], P[B_+3]);                          \
        unsigned b0 = cvtpk(P[B_+4], P[B_+5]), b1 = cvtpk(P[B_+6], P[B_+7]);                                             \
        auto r0 = __builtin_amdgcn_permlane32_swap(a0, b0, false, false); auto r1 = __builtin_amdgcn_permlane32_swap(a1, b1, false, false); \
        u32x4 w = {r0[0], r1[0], r0[1], r1[1]}; OUT = *reinterpret_cast<bf16x8*>(&w); } while (0)
    PK4(p0, 0, pa0); PK4(p0, 8, pa1); PK4(p1, 0, pa2); PK4(p1, 8, pa3);
#undef PK4
}
template <int KB, bool SK>
__device__ __forceinline__ void qkt(f32x16& p0, f32x16& p1, const char* K_lds, int r32, int hi, const bf16x8* qr, bool act) {
    if (SK && !act) { const float NEG = -__builtin_inff();
#pragma unroll
        for (int r = 0; r < 16; ++r) { p0[r] = NEG; p1[r] = NEG; } return; }
    { const f32x16* bp = reinterpret_cast<const f32x16*>(K_lds - 2 * SHM_V + LDS_BIAS + KB * 256 + hi * 128); p0 = bp[0]; p1 = bp[1]; }
    const char* kb[4];
#pragma unroll
    for (int dd = 0; dd < 4; ++dd) kb[dd] = K_lds + KB * SHM_K + KSWZ(r32, (dd * 16 + hi * 8) * 2);
#pragma unroll
    for (int d0 = 0; d0 < 8; ++d0) { const char* a = kb[d0 & 3] + (d0 >> 2) * 128;
        bf16x8 b0 = *reinterpret_cast<const bf16x8*>(a);
        bf16x8 b1 = *reinterpret_cast<const bf16x8*>(a + 32 * 256);
        p0 = __builtin_amdgcn_mfma_f32_32x32x16_bf16(b0, qr[d0], p0, 0, 0, 0);
        p1 = __builtin_amdgcn_mfma_f32_32x32x16_bf16(b1, qr[d0], p1, 0, 0, 0); }
}
template <int VB, bool SK>
__device__ __forceinline__ void pv_tile(f32x16* o, int vb0, bf16x8 pa0, bf16x8 pa1, bf16x8 pa2, bf16x8 pa3, bool act) {
    if (SK && !act) return;
#define TRRD(dst, off) asm volatile("ds_read_b64_tr_b16 %0, %1 offset:%2" : "=&v"(dst) : "v"(vb0), "i"(off) : "memory")
#define PV_D0(d0) do { s16x4 l0, l1, l2, l3, h0, h1, h2, h3; constexpr int b_ = VB * SHM_V + v_rd_off(d0, 0, 0);     \
        TRRD(l0, b_); TRRD(h0, b_ + 2048); TRRD(l1, b_ + 4096); TRRD(h1, b_ + 6144); TRRD(l2, b_ + 8192); TRRD(h2, b_ + 10240); TRRD(l3, b_ + 12288); TRRD(h3, b_ + 14336); \
        asm volatile("s_waitcnt lgkmcnt(0)" ::: "memory"); SBAR();                 \
        o[d0] = __builtin_amdgcn_mfma_f32_32x32x16_bf16(pa0, (bf16x8){l0[0], l0[1], l0[2], l0[3], h0[0], h0[1], h0[2], h0[3]}, o[d0], 0, 0, 0);   \
        o[d0] = __builtin_amdgcn_mfma_f32_32x32x16_bf16(pa1, (bf16x8){l1[0], l1[1], l1[2], l1[3], h1[0], h1[1], h1[2], h1[3]}, o[d0], 0, 0, 0);   \
        o[d0] = __builtin_amdgcn_mfma_f32_32x32x16_bf16(pa2, (bf16x8){l2[0], l2[1], l2[2], l2[3], h2[0], h2[1], h2[2], h2[3]}, o[d0], 0, 0, 0);   \
        o[d0] = __builtin_amdgcn_mfma_f32_32x32x16_bf16(pa3, (bf16x8){l3[0], l3[1], l3[2], l3[3], h3[0], h3[1], h3[2], h3[3]}, o[d0], 0, 0, 0); } while (0)
    PV_D0(0); PV_D0(1); PV_D0(2); PV_D0(3);
#undef PV_D0
#undef TRRD
}

template <class TIn, class TOut> struct BlockRef { const TIn* Q; const TIn* K; const TIn* V; TOut* O; int P0; const float* Fb; const float* gain;
    int jlo, jhi;
    float* Op; float* ML; };
template <class TIn> struct Seam {
    bf16x8 qr[8];
    bf16x8 st_v0, st_v1, st_k0, st_k1; f32x4 sf0, sf1, sf2, sf3; float st_b;
    f32x4 tq[16];
};
__device__ __forceinline__ int swa_jlo(int P0, int W) { const int lowk = P0 - W + 1; return lowk > 0 ? lowk / KVBLK : 0; }
#define ROW(p, k0, rr) ((p) + (size_t)((k0) + (rr)) * PITCH + sc)
#define VMW() asm volatile("s_waitcnt vmcnt(0)" ::: "memory")
#define VMWN(n) asm volatile("s_waitcnt vmcnt(%0)" :: "i"(n) : "memory")
#define SLOAD_H(Kp, Vp, k0) SLOAD_HB(Kp, Vp, k0, cur)
#define SLOAD_HB(Kp, Vp, k0, blk) do { S.st_v0 = load8<TIn>(ROW(Vp, k0, sr)); S.st_v1 = load8<TIn>(ROW(Vp, k0, 32 + sr));              \
                         S.st_k0 = load8<TIn>(ROW(Kp, k0, sr)); S.st_k1 = load8<TIn>(ROW(Kp, k0, 32 + sr)); \
                         if (tid < 64) S.st_b = ((blk).Fb[(blk).P0] - (blk).Fb[(k0) + tid]) * (1.0f / SCALE); } while (0)
#define SWRITE_HK(bf) do { *(bf16x8*)(K_lds + (bf) * SHM_K + kws) = S.st_k0; *(bf16x8*)(K_lds + (bf) * SHM_K + kws + 32 * 256) = S.st_k1; \
                         if (tid < 64) *(float*)(K_lds - 2 * SHM_V + LDS_BIAS + (bf) * 256 + bws) = S.st_b; } while (0)
#define SWRITE_HV(bf) do { *(bf16x8*)(V_lds + (bf) * SHM_V + vst0) = S.st_v0; *(bf16x8*)(V_lds + (bf) * SHM_V + vst1) = S.st_v1; } while (0)
#define SWRITE_H(bf) do { SWRITE_HV(bf); SWRITE_HK(bf); } while (0)
#define SLOAD_F(p, k0) do { S.sf0 = *(const f32x4*)ROW(p, k0, sr); S.sf1 = *(const f32x4*)(ROW(p, k0, sr) + 4);                \
                            S.sf2 = *(const f32x4*)ROW(p, k0, 32 + sr); S.sf3 = *(const f32x4*)(ROW(p, k0, 32 + sr) + 4); } while (0)
#define SWRITE_KF(bf) do { *(bf16x8*)(K_lds + (bf) * SHM_K + kws) = pack8(S.sf0, S.sf1); *(bf16x8*)(K_lds + (bf) * SHM_K + kws + 32 * 256) = pack8(S.sf2, S.sf3); } while (0)
#define SWRITE_VF(bf) do { *(bf16x8*)(V_lds + (bf) * SHM_V + vst0) = pack8(S.sf0, S.sf1); *(bf16x8*)(V_lds + (bf) * SHM_V + vst1) = pack8(S.sf2, S.sf3); } while (0)
template <class TIn, class TOut>
__device__ __forceinline__ void causal_swa_prime(const BlockRef<TIn, TOut>& cur, int W, char* lds, Seam<TIn>& S) {
    constexpr bool F32 = same_t<TIn, float>::v;
    const int tid = threadIdx.x, wid = __builtin_amdgcn_readfirstlane(tid >> 6), lane = tid & 63, r32 = lane & 31, hi = lane >> 5;
    const int sr = tid >> 4, sc = (tid & 15) * 8, kws = KSWZ(sr, sc * 2); char* K_lds = lds + 2 * SHM_V;
    const int bws = bias_slot(tid & 63) * 4;
    const int kb0 = cur.jlo * KVBLK;
    for (int d0 = 0; d0 < 8; ++d0) S.qr[d0] = load8<TIn>(cur.Q + (size_t)(wid * QBLK + r32) * PITCH + d0 * 16 + hi * 8);
    if constexpr (F32) { SLOAD_F((const float*)cur.K, kb0); VMW(); SWRITE_KF(0); SBAR(); SLOAD_F((const float*)cur.V, kb0); }
    else { SLOAD_H(cur.K, cur.V, kb0); VMW(); SWRITE_HK(0); }
    __syncthreads();
}
template <class TIn, class TOut>
__device__ __forceinline__ void causal_swa_block(const BlockRef<TIn, TOut>& cur, const BlockRef<TIn, TOut>& nxt, int skv, int W, char* lds, Seam<TIn>& S) {
    constexpr bool F32 = same_t<TIn, float>::v;
    const int tid = threadIdx.x, wid = __builtin_amdgcn_readfirstlane(tid >> 6), lane = tid & 63, r32 = lane & 31, hi = lane >> 5;
    const int j_lo = cur.jlo; const int j_hi = cur.jhi;
    const int NT = j_hi - j_lo;
    const int kbn = nxt.jlo * KVBLK;
    const int qlo = cur.P0 + wid * QBLK, qm = qlo + r32 - 4 * hi;
    char* V_lds = lds; char* K_lds = lds + 2 * SHM_V;
    float* ws = (float*)(lds + 2 * SHM_V + 2 * SHM_K) + wid * 64; float* li_l = ws, * al_l = ws + 32;
    float m_reg = -1e30f, l_reg = 0; f32x16 o[4] = {};
    const int sr = tid >> 4, sc = (tid & 15) * 8, vst0 = v_st(sr, sc), vst1 = v_st(32 + sr, sc), kws = KSWZ(sr, sc * 2);
    const int bws = bias_slot(tid & 63) * 4;
    const int vb0 = (int)(uintptr_t)V_lds + v_rd_base(lane);
    const TIn* Kh = cur.K; const TIn* Vh = cur.V;
#define RESC(a) do { if (__any((a) < 1.f)) { if (hi == 0) al_l[r32] = (a); asm volatile("s_waitcnt lgkmcnt(0)" ::: "memory");              \
                     for (int d_ = 0; d_ < 4; ++d_) for (int r = 0; r < 16; ++r) o[d_][r] *= al_l[crow(r, hi)]; } } while (0)
#define KBASE(t) ((j_lo + (t)) * KVBLK)
#define ACT(t) (KBASE(t) <= qlo + QBLK - 1 && KBASE(t) + KVBLK - 1 >= qlo - W + 1)
#define MASKT(P0_, P1_, t) do { const int kb_ = KBASE(t); if ((!SK || ACT(t)) && (kb_ + KVBLK - 1 > qlo || kb_ <= qlo + QBLK - 1 - W)) mask_tile(P0_, P1_, qm - kb_, (unsigned)W); } while (0)
    constexpr int NQL = F32 ? 16 : 8;
    constexpr bool SK = WSKIP && !F32;
#define SEAM_K0() do { VMWN(NQL); if constexpr (F32) { SWRITE_KF(0); SBAR(); SLOAD_F((const float*)nxt.V, kbn); } else { SWRITE_HK(0); } SBAR(); } while (0)
    f32x16 pA0, pA1, pB0, pB1; float mnA, mnB, alA, alB; bf16x8 pa0, pa1, pa2, pa3;
    if constexpr (F32) { VMW(); SWRITE_VF(0); SBAR(); } else { SWRITE_HV(0); SBAR(); }
    if (NT > 1) { if constexpr (F32) SLOAD_F((const float*)Kh, KBASE(1)); else SLOAD_H(Kh, Vh, KBASE(1)); }
    SBAR(); qkt<0, SK>(pA0, pA1, K_lds, r32, hi, S.qr, ACT(0));
    if constexpr (F32) { if (NT > 1) { VMW(); SWRITE_KF(1); SBAR(); SLOAD_F((const float*)Vh, KBASE(1)); } }
    MASKT(pA0, pA1, 0); partialSM(pA0, pA1, m_reg, mnA, alA);
    if (NT > 1) { VMW(); if constexpr (F32) { SWRITE_VF(1); SBAR(); if (NT > 2) SLOAD_F((const float*)Kh, KBASE(2)); } else SWRITE_H(1); }
    __syncthreads();
#define HALF_STEP(PX0, PX1, mnX, alX, PY0, PY1, alY, t, KB, VB, SB) do {                                                      \
        SBAR(); qkt<KB, SK>(PX0, PX1, K_lds, r32, hi, S.qr, ACT(t));                                             \
        finishSM(PY0, PY1, alY, l_reg, pa0, pa1, pa2, pa3); SBAR();                                                           \
        if ((t) + 1 < NT) { if constexpr (F32) { VMW(); SWRITE_KF(SB); SBAR(); SLOAD_F((const float*)Vh, KBASE((t) + 1)); }  \
                            else { SLOAD_H(Kh, Vh, KBASE((t) + 1)); } SBAR(); }                                               \
        pv_tile<VB, SK>(o, vb0, pa0, pa1, pa2, pa3, ACT((t) - 1)); MASKT(PX0, PX1, (t)); partialSM(PX0, PX1, m_reg, mnX, alX);                                        \
        __syncthreads();                                                                                                      \
        if ((t) + 1 < NT) { VMW(); if constexpr (F32) { SWRITE_VF(SB); SBAR(); if ((t) + 2 < NT) SLOAD_F((const float*)Kh, KBASE((t) + 2)); } \
                            else { SWRITE_H(SB); } }                                                                          \
        RESC(alX); __syncthreads(); } while (0)
    for (int t = 1; t + 1 < NT; t += 2) {
        HALF_STEP(pB0, pB1, mnB, alB, pA0, pA1, alA, t, 1, 0, 0);
        HALF_STEP(pA0, pA1, mnA, alA, pB0, pB1, alB, t + 1, 0, 1, 1);
    }
    const bool even = (NT & 1) == 0;
    if (even) { SBAR(); qkt<1, SK>(pB0, pB1, K_lds, r32, hi, S.qr, ACT(NT - 1)); SBAR(); }
#define QROW(e) (nxt.Q + (size_t)(wid * QBLK + r32) * PITCH + ((e) >> 1) * 16 + hi * 8 + ((e) & 1) * 4)
    if constexpr (F32) { SLOAD_F((const float*)nxt.K, kbn); SBAR();
#pragma unroll
        for (int e = 0; e < 8; ++e) S.tq[e] = *(const f32x4*)QROW(e); }
    else { SLOAD_HB(nxt.K, nxt.V, kbn, nxt); SBAR();
#pragma unroll
        for (int d0 = 0; d0 < 8; ++d0) S.qr[d0] = load8<TIn>(nxt.Q + (size_t)(wid * QBLK + r32) * PITCH + d0 * 16 + hi * 8); }
    SBAR();
    finishSM(pA0, pA1, alA, l_reg, pa0, pa1, pa2, pa3); SBAR();
    if constexpr (F32) {
#pragma unroll
        for (int e = 8; e < 16; ++e) S.tq[e] = *(const f32x4*)QROW(e); SBAR(); }
#undef QROW
    pv_tile<0, SK>(o, vb0, pa0, pa1, pa2, pa3, ACT(even ? NT - 2 : NT - 1));
    if (even) { MASKT(pB0, pB1, NT - 1); partialSM(pB0, pB1, m_reg, mnB, alB); __syncthreads(); RESC(alB);
        finishSM(pB0, pB1, alB, l_reg, pa0, pa1, pa2, pa3); SBAR(); pv_tile<1, SK>(o, vb0, pa0, pa1, pa2, pa3, ACT(NT - 1)); }
    SBAR(); SEAM_K0();
    if (hi == 0) li_l[r32] = l_reg; asm volatile("s_waitcnt lgkmcnt(0)" ::: "memory");
    if (cur.Op != nullptr) {
        int rp = r32; asm volatile("" : "+v"(rp));
        if (hi == 0) { float2 mlv; mlv.x = m_reg; mlv.y = l_reg; *(float2*)(cur.ML + 2 * (wid * QBLK + rp)) = mlv; }
        float* Pr = cur.Op + (size_t)(wid * QBLK + 4 * hi) * D + rp;
#pragma unroll
        for (int r = 0; r < 16; ++r) {
#pragma unroll
            for (int d0 = 0; d0 < 4; ++d0) Pr[d0 * 32] = o[d0][r];
            Pr += ((r & 3) == 3 ? 5 : 1) * D; asm volatile("" : "+v"(Pr) :: "memory"); }
    } else {
    int ro = r32; asm volatile("" : "+v"(ro));
    TOut* Or = cur.O + (size_t)(wid * QBLK + 4 * hi) * OPITCH + ro;
    float gn[4];
#pragma unroll
    for (int d0 = 0; d0 < 4; ++d0) gn[d0] = cur.gain[d0 * 32 + ro];
#pragma unroll
    for (int r = 0; r < 16; ++r) { const int orow = crow(r, hi); const float rl = __builtin_amdgcn_rcpf(li_l[orow]);
        float v[4]; float ss = 0.f;
#pragma unroll
        for (int d0 = 0; d0 < 4; ++d0) { v[d0] = o[d0][r] * rl; ss += v[d0] * v[d0]; }
        ss += __shfl_xor(ss, 1); ss += __shfl_xor(ss, 2); ss += __shfl_xor(ss, 4); ss += __shfl_xor(ss, 8); ss += __shfl_xor(ss, 16);
        const float rn = __builtin_amdgcn_rsqf(ss * (1.0f / 128.0f) + 1e-6f);
#pragma unroll
        for (int d0 = 0; d0 < 4; ++d0) { const float vv = v[d0] * rn * gn[d0]; const float vn = __shfl_xor(vv, 1);
            if ((ro & 1) == 0) *(unsigned*)(Or + d0 * 32) = cvtpk(vv, vn); }
        Or += ((r & 3) == 3 ? 5 : 1) * OPITCH; asm volatile("" : "+v"(Or) :: "memory"); }
    }
    if constexpr (F32) {
#pragma unroll
        for (int d0 = 0; d0 < 8; ++d0) S.qr[d0] = pack8(S.tq[2 * d0], S.tq[2 * d0 + 1]); }
    __syncthreads();
#undef RESC
#undef KBASE
#undef ACT
#undef MASKT
#undef SEAM_K0
#undef HALF_STEP
}
#undef ROW
#undef VMW
#undef VMWN
#undef SLOAD_H
#undef SWRITE_HK
#undef SWRITE_HV
#undef SWRITE_H
#undef SLOAD_F
#undef SWRITE_KF
#undef SWRITE_VF

}
namespace mk {
typedef short s16x8 __attribute__((ext_vector_type(8)));
#define MFMA32(a, b, c) __builtin_amdgcn_mfma_f32_32x32x16_bf16((a), (b), (c), 0, 0, 0)
__device__ __forceinline__ int crow32(int r, int hi) { return (r & 3) + 8 * (r >> 2) + 4 * hi; }
constexpr float SCALEQ = 0.08838834764831845f;
__device__ __forceinline__ float wave_scan_add(float v, int lane) {
#pragma unroll
    for (int o = 1; o < 64; o <<= 1) { const float t = __shfl_up(v, o); if (lane >= o) v += t; }
    return v;
}
__device__ __forceinline__ float wave_scan_max(float v, int lane) {
#pragma unroll
    for (int o = 1; o < 64; o <<= 1) { const float t = __shfl_up(v, o); if (lane >= o) v = fmaxf(v, t); }
    return v;
}
__device__ __forceinline__ float wave_max(float v) {
#pragma unroll
    for (int o = 1; o < 64; o <<= 1) v = fmaxf(v, __shfl_xor(v, o));
    return v;
}
constexpr int TSTR = 72;
template <bool SCALED>
__device__ __forceinline__ void stage_transposed(const bf16* src, int ncols, LAS bf16* T, const LAS float* wl, int tid) {
    const int cpr = ncols / 8;
    for (int q = tid; q < 64 * cpr; q += NTHR) { const int s = q / cpr, c8 = (q % cpr) * 8;
        const v4u raw = *(const GAS v4u*)(src + (size_t)s * NPP + c8);
        const unsigned w4[4] = {raw.x, raw.y, raw.z, raw.w};
#pragma unroll
        for (int j = 0; j < 4; ++j) { unsigned lo = w4[j] & 0xffffu, hi = w4[j] >> 16;
            if (SCALED) { const float sc = wl[s]; lo = f2bf(bf2f((unsigned short)lo) * sc); hi = f2bf(bf2f((unsigned short)hi) * sc); }
            T[(c8 + 2 * j) * TSTR + s] = (bf16)lo; T[(c8 + 2 * j + 1) * TSTR + s] = (bf16)hi; } }
}
__device__ __forceinline__ void p3_prep(Frame& F) {
    const int gw = F.vcu * NWAVES + F.wave, NGW = F.G * NWAVES, lane = F.lane, tid = F.tid;
    bf16* proj = wsp<bf16>(F, WS_PROJ); const float* gates = wsp<float>(F, WS_GATES);
    {
        const int seg = lane >> 2, qd = (lane & 3) * 32; const float* gn = (seg < 8 ? F.in[IN_FOXQN] : F.in[IN_FOXKN]) + qd;
        for (int m = gw; m < S; m += NGW) {
            bf16* p = proj + (size_t)m * NPP + C_FQ + seg * 128 + qd; v4u raw[4]; float x[32]; float ss = 0.f;
#pragma unroll
            for (int j = 0; j < 4; ++j) raw[j] = *(const GAS v4u*)(p + 8 * j);
#pragma unroll
            for (int j = 0; j < 4; ++j) { const unsigned w4[4] = {raw[j].x, raw[j].y, raw[j].z, raw[j].w};
#pragma unroll
                for (int i = 0; i < 4; ++i) { x[8 * j + 2 * i] = bf2f((unsigned short)(w4[i] & 0xffffu)); x[8 * j + 2 * i + 1] = bf2f((unsigned short)(w4[i] >> 16)); } }
#pragma unroll
            for (int i = 0; i < 32; ++i) ss += x[i] * x[i];
            ss += __shfl_xor(ss, 1); ss += __shfl_xor(ss, 2);
            const float r = rsqrtf(ss * (1.f / 128.f) + 1e-6f);
#pragma unroll
            for (int j = 0; j < 4; ++j) { v4u o; const f32x4 g0 = *(const GAS f32x4*)(gn + 8 * j), g1 = *(const GAS f32x4*)(gn + 8 * j + 4);
                o.x = pk2(x[8 * j] * r * g0.x, x[8 * j + 1] * r * g0.y); o.y = pk2(x[8 * j + 2] * r * g0.z, x[8 * j + 3] * r * g0.w);
                o.z = pk2(x[8 * j + 4] * r * g1.x, x[8 * j + 5] * r * g1.y); o.w = pk2(x[8 * j + 6] * r * g1.z, x[8 * j + 7] * r * g1.w);
                *(GAS v4u*)(p + 8 * j) = o; }
        }
    }
    if (blockIdx.x < 8) {
        const int h = blockIdx.x; const float b = F.in[IN_FOXBF][h]; float* Fo = wsp<float>(F, WS_F) + h * S;
        LAS double* tot = (LAS double*)(F.lds + RING_OFF);
        double loc[16]; double acc = 0.0;
#pragma unroll
        for (int i = 0; i < 16; ++i) { acc += (double)log_sigmoid_f(gates[(size_t)(tid * 16 + i) * 16 + 8 + h] + b); loc[i] = acc; }
        tot[tid] = acc;
        __syncthreads();
        if (F.wave == 0) { double v[8]; double s = 0.0;
#pragma unroll
            for (int i = 0; i < 8; ++i) { v[i] = tot[lane * 8 + i]; s += v[i]; }
            double inc = s;
#pragma unroll
            for (int o = 1; o < 64; o <<= 1) { const double t = __shfl_up(inc, o); if (lane >= o) inc += t; }
            double ex = inc - s;
#pragma unroll
            for (int i = 0; i < 8; ++i) { tot[lane * 8 + i] = ex; ex += v[i]; } }
        __syncthreads();
        const double off = tot[tid];
        LAS float* Fl = (LAS float*)(F.lds + RING_OFF + 8192);
#pragma unroll
        for (int i = 0; i < 16; ++i) { const float fv = (float)(off + loc[i]); Fo[tid * 16 + i] = fv; Fl[tid * 16 + i] = fv; }
        __syncthreads();
        if (tid < 32) {
            float gq = 0.f, gk = 0.f;
            for (int d = 0; d < 128; ++d) { gq = fmaxf(gq, fabsf(F.in[IN_FOXQN][d])); gk = fmaxf(gk, fabsf(F.in[IN_FOXKN][d])); }
            const float thr = 2.f * 11.3137085f * gq * gk + 26.f;
            const int qb = tid, P0 = qb * 256; const float f0 = Fl[P0];
            int lo = 0, hi2 = 4 * qb;
            while (lo < hi2) { const int mid = (lo + hi2) >> 1; if (Fl[64 * mid + 63] - f0 <= thr) hi2 = mid; else lo = mid + 1; }
            wsp<int>(F, WS_JLO)[h * 32 + qb] = lo;
        }
        __syncthreads();
    }
    {
        LAS bf16* KT = (LAS bf16*)(F.lds + RING_OFF);
        LAS bf16* VT = KT + 128 * TSTR;
        LAS float* wl = (LAS float*)(VT + 256 * TSTR);
        float* UL = wsp<float>(F, WS_UL); float* NL = wsp<float>(F, WS_NL); float* GLAL = wsp<float>(F, WS_GLAL);
        const int hi = lane >> 5, l31 = lane & 31, w = F.wave;
        for (int u = F.vcu; u < 4 * NCH; u += F.G) {
            const int h = u >> 7, ch = u & 127, t0 = ch * LCH;
            if (w == 0) {
                const float ip = softcap_f(gates[(size_t)(t0 + lane) * 16 + h] + F.in[IN_BI][h]);
                const float fp = softcap_f(gates[(size_t)(t0 + lane) * 16 + 4 + h] + F.in[IN_BF][h]);
                const float g = wave_scan_add(log_sigmoid_f(fp), lane), a = ip - g, amax = wave_max(a);
                wl[lane] = __expf(a - amax);
                if (lane == 63) { GLAL[u * 2] = g; GLAL[u * 2 + 1] = amax; }
            }
            __syncthreads();
            stage_transposed<true>(proj + (size_t)t0 * NPP + C_MK + h * 128, 128, KT, wl, tid);
            stage_transposed<false>(proj + (size_t)t0 * NPP + C_MV + h * 256, 256, VT, wl, tid);
            __syncthreads();
            f32x16 acc[4];
#pragma unroll
            for (int dt = 0; dt < 4; ++dt)
#pragma unroll
                for (int r = 0; r < 16; ++r) acc[dt][r] = 0.f;
#pragma unroll
            for (int ks = 0; ks < 4; ++ks) { const s16x8 a = *(const LAS s16x8*)(VT + (32 * w + l31) * TSTR + 16 * ks + 8 * hi);
#pragma unroll
                for (int dt = 0; dt < 4; ++dt) { const s16x8 b = *(const LAS s16x8*)(KT + (32 * dt + l31) * TSTR + 16 * ks + 8 * hi); acc[dt] = MFMA32(a, b, acc[dt]); } }
            float* ut = UL + (size_t)u * 256 * 128;
#pragma unroll
            for (int dt = 0; dt < 4; ++dt)
#pragma unroll
                for (int r = 0; r < 16; ++r) ut[(size_t)(32 * w + crow32(r, hi)) * 128 + 32 * dt + l31] = acc[dt][r];
            if (tid < 128) { float s = 0.f;
#pragma unroll
                for (int j = 0; j < 8; ++j) { const s16x8 kv = *(const LAS s16x8*)(KT + tid * TSTR + 8 * j);
#pragma unroll
                    for (int i = 0; i < 8; ++i) s += bf2f((unsigned short)kv[i]); }
                NL[u * 128 + tid] = s; }
            __syncthreads();
        }
    }
}
__device__ __forceinline__ void p4_scan(Frame& F) {
    LAS float* gl = (LAS float*)(F.lds + RING_OFF);
    LAS float* dec = gl + 256; LAS float* scl = dec + 128; LAS float* mv = scl + 128;
    const float* UL = wsp<float>(F, WS_UL); const float* NL = wsp<float>(F, WS_NL); const float* GLAL = wsp<float>(F, WS_GLAL);
    bf16* CS = wsp<bf16>(F, WS_CS); float* NS = wsp<float>(F, WS_NS); float* MS = wsp<float>(F, WS_MS);
    const int tid = F.tid;
    for (int blk = F.vcu; blk < 4 * 64; blk += F.G) {
        const int h = blk >> 6, rem0 = (blk & 63) * 512;
        if (tid < 256) gl[tid] = GLAL[h * 256 + tid];
        __syncthreads();
        if (tid == 0) { float m = 0.f;
            for (int c = 0; c < NCH; ++c) { const float g = gl[2 * c], al = gl[2 * c + 1], mn = g + fmaxf(m, al);
                mv[c] = m; dec[c] = __expf(g + m - mn); scl[c] = __expf(g + al - mn); m = mn; } }
        __syncthreads();
        if (rem0 == 0 && tid < 128) MS[h * 128 + tid] = mv[tid];
        const int rem = rem0 + tid;
        const float* ul = UL + (size_t)h * NCH * 32768 + rem; bf16* cs = CS + (size_t)h * NCH * 32768 + rem;
        float C = 0.f;
#pragma unroll 32
        for (int c = 0; c < NCH; ++c) { cs[(size_t)c * 32768] = (bf16)f2bf(C); C = dec[c] * C + scl[c] * ul[(size_t)c * 32768]; }
        if (rem0 == 0 && tid < 128) { float n = 0.f; const float* nl = NL + (size_t)h * NCH * 128 + tid; float* ns = NS + (size_t)h * NCH * 128 + tid;
#pragma unroll 8
            for (int c = 0; c < NCH; ++c) { ns[c * 128] = n; n = dec[c] * n + scl[c] * nl[c * 128]; } }
        __syncthreads();
    }
}
constexpr int NUMSTR = 260;
__device__ __forceinline__ void p5_mlstm_out(Frame& F) {
    LAS bf16* VT = (LAS bf16*)(F.lds + RING_OFF);
    LAS bf16* Pm = VT + 256 * TSTR;
    LAS float* NUM = (LAS float*)(Pm + 64 * TSTR);
    LAS float* a_s = NUM + 64 * NUMSTR; LAS float* Mt = a_s + 64; LAS float* inter = Mt + 64; LAS float* emt = inter + 64; LAS float* qn = emt + 64; LAS float* dinv = qn + 64;
    const bf16* proj = wsp<bf16>(F, WS_PROJ); const float* gates = wsp<float>(F, WS_GATES); const bf16* CS = wsp<bf16>(F, WS_CS);
    const float* NS = wsp<float>(F, WS_NS); const float* MS = wsp<float>(F, WS_MS); bf16* concat = wsp<bf16>(F, WS_CONCAT);
    const int tid = F.tid, lane = F.lane, w = F.wave, hi = lane >> 5, l31 = lane & 31;
    for (int u = F.vcu; u < 4 * NCH; u += F.G) {
        const int h = u >> 7, ch = u & 127, t0 = ch * LCH;
        const bf16* qbase = proj + (size_t)t0 * NPP + C_MQ + h * 128; const bf16* kbase = proj + (size_t)t0 * NPP + C_MK + h * 128;
        if (w == 0) {
            const float ip = softcap_f(gates[(size_t)(t0 + lane) * 16 + h] + F.in[IN_BI][h]);
            const float fp = softcap_f(gates[(size_t)(t0 + lane) * 16 + 4 + h] + F.in[IN_BF][h]);
            const float g = wave_scan_add(log_sigmoid_f(fp), lane), a = ip - g, cm = wave_scan_max(a, lane);
            const float mp = MS[u], M = fmaxf(mp, cm);
            a_s[lane] = a; Mt[lane] = M; inter[lane] = __expf(mp - M); emt[lane] = __expf(-(g + M));
        }
        stage_transposed<false>(proj + (size_t)t0 * NPP + C_MV + h * 256, 256, VT, a_s, tid);
        __syncthreads();
        if (w < 4) {
            const int ti = w >> 1, si = w & 1;
            if (si <= ti) {
                s16x8 qa[8], kb[8];
#pragma unroll
                for (int ks = 0; ks < 8; ++ks) { qa[ks] = *(const GAS s16x8*)(qbase + (size_t)(32 * ti + l31) * NPP + 16 * ks + 8 * hi); kb[ks] = *(const GAS s16x8*)(kbase + (size_t)(32 * si + l31) * NPP + 16 * ks + 8 * hi); }
                f32x16 acc;
#pragma unroll
                for (int r = 0; r < 16; ++r) acc[r] = 0.f;
#pragma unroll
                for (int ks = 0; ks < 8; ++ks) acc = MFMA32(qa[ks], kb[ks], acc);
                const int s = 32 * si + l31; const float as = a_s[s];
#pragma unroll
                for (int r = 0; r < 16; ++r) { const int t = 32 * ti + crow32(r, hi); const float p = (s <= t) ? acc[r] * SCALEQ * __expf(as - Mt[t]) : 0.f; Pm[t * TSTR + s] = (bf16)f2bf(p); }
            } else {
#pragma unroll
                for (int r = 0; r < 16; ++r) Pm[(32 * ti + crow32(r, hi)) * TSTR + 32 * si + l31] = (bf16)0;
            }
        } else {
            const int t = (tid - 256) >> 2, d0 = ((tid - 256) & 3) * 32; float s = 0.f; const float* np = NS + (size_t)u * 128 + d0;
#pragma unroll
            for (int j = 0; j < 4; ++j) { const s16x8 qv = *(const GAS s16x8*)(qbase + (size_t)t * NPP + d0 + 8 * j);
#pragma unroll
                for (int i = 0; i < 8; ++i) s += bf2f((unsigned short)qv[i]) * np[8 * j + i]; }
            s += __shfl_xor(s, 1); s += __shfl_xor(s, 2);
            if ((tid & 3) == 0) qn[t] = s * SCALEQ;
        }
        __syncthreads();
        f32x16 accP[2], accC[2];
#pragma unroll
        for (int ti = 0; ti < 2; ++ti)
#pragma unroll
            for (int r = 0; r < 16; ++r) { accP[ti][r] = 0.f; accC[ti][r] = 0.f; }
        {
            const bf16* cs = CS + (size_t)u * 32768 + (size_t)(32 * w + l31) * 128 + 8 * hi;
            s16x8 cb[8];
#pragma unroll
            for (int ks = 0; ks < 8; ++ks) cb[ks] = *(const GAS s16x8*)(cs + 16 * ks);
#pragma unroll
            for (int ti = 0; ti < 2; ++ti) {
                s16x8 qa[8];
#pragma unroll
                for (int ks = 0; ks < 8; ++ks) qa[ks] = *(const GAS s16x8*)(qbase + (size_t)(32 * ti + l31) * NPP + 16 * ks + 8 * hi);
#pragma unroll
                for (int ks = 0; ks < 8; ++ks) accC[ti] = MFMA32(qa[ks], cb[ks], accC[ti]);
            }
#pragma unroll
            for (int ks = 0; ks < 4; ++ks) { const s16x8 vb = *(const LAS s16x8*)(VT + (32 * w + l31) * TSTR + 16 * ks + 8 * hi);
#pragma unroll
                for (int ti = 0; ti < 2; ++ti) { const s16x8 pa = *(const LAS s16x8*)(Pm + (32 * ti + l31) * TSTR + 16 * ks + 8 * hi); accP[ti] = MFMA32(pa, vb, accP[ti]); } }
        }
        if (w == 0) {
            float rs = 0.f;
#pragma unroll
            for (int j = 0; j < 8; ++j) { const s16x8 pv = *(const LAS s16x8*)(Pm + lane * TSTR + 8 * j);
#pragma unroll
                for (int i = 0; i < 8; ++i) rs += bf2f((unsigned short)pv[i]); }
            const float dn = rs + inter[lane] * qn[lane];
            dinv[lane] = 1.f / fmaxf(fabsf(dn), emt[lane]);
        }
        __syncthreads();
#pragma unroll
        for (int ti = 0; ti < 2; ++ti)
#pragma unroll
            for (int r = 0; r < 16; ++r) { const int t = 32 * ti + crow32(r, hi); NUM[t * NUMSTR + 32 * w + l31] = (accP[ti][r] + inter[t] * SCALEQ * accC[ti][r]) * dinv[t]; }
        __syncthreads();
        {
            const f32x4 gn = *(const GAS f32x4*)(F.in[IN_MOUTN] + h * 256 + 4 * lane);
#pragma unroll
            for (int i = 0; i < 8; ++i) { const int t = 8 * w + i; const f32x4 x = *(const LAS f32x4*)(NUM + t * NUMSTR + 4 * lane);
                const float ss = wave_sum((x.x * x.x + x.y * x.y) + (x.z * x.z + x.w * x.w)); const float r = rsqrtf(ss * (1.f / 256.f) + 1e-6f);
                const u32x2 mo = *(const GAS u32x2*)(proj + (size_t)(t0 + t) * NPP + C_MO + h * 256 + 4 * lane);
                const float o0 = x.x * r * gn.x * sigmoid_f(bf2f((unsigned short)(mo.x & 0xffffu))), o1 = x.y * r * gn.y * sigmoid_f(bf2f((unsigned short)(mo.x >> 16)));
                const float o2 = x.z * r * gn.z * sigmoid_f(bf2f((unsigned short)(mo.y & 0xffffu))), o3 = x.w * r * gn.w * sigmoid_f(bf2f((unsigned short)(mo.y >> 16)));
                u32x2 ov; ov.x = pk2(o0, o1); ov.y = pk2(o2, o3);
                *(GAS u32x2*)(concat + (size_t)(t0 + t) * D + h * 256 + 4 * lane) = ov; }
        }
        __syncthreads();
    }
}
}
namespace mk {
__device__ __forceinline__ void attn_build_schedule(Frame& F) {
    LAS int* jl = (LAS int*)(F.lds + TAB_OFF); LAS int* pre = jl + 256; LAS int* wtot = pre + 260;
    const int tid = F.tid, lane = F.lane;
    if (tid < 256) { const int j = wsp<int>(F, WS_JLO)[tid]; jl[tid] = j; const int n = 4 * (tid & 31) + 4 - j; int v = (n + ATT_CH - 1) / ATT_CH;
        int inc = v;
#pragma unroll
        for (int o = 1; o < 64; o <<= 1) { const int t = __shfl_up(inc, o); if (lane >= o) inc += t; }
        pre[tid + 1] = inc; if (lane == 63) wtot[tid >> 6] = inc; }
    __syncthreads();
    if (tid < 256) { int add = 0; for (int w2 = 0; w2 < (tid >> 6); ++w2) add += wtot[w2]; pre[tid + 1] += add; if (tid == 0) pre[0] = 0; }
    __syncthreads();
}
__device__ __forceinline__ fox::BlockRef<fox::bf16, fox::bf16> fox_ref(const Frame& F, int I) {
    const LAS int* jl = (const LAS int*)(F.lds + TAB_OFF); const LAS int* pre = jl + 256;
    int b = 0;
#pragma unroll
    for (int st = 128; st >= 1; st >>= 1) if (pre[b + st] <= I) b += st;
    b = __builtin_amdgcn_readfirstlane(b);
    const int pb0 = __builtin_amdgcn_readfirstlane(pre[b]), pb1 = __builtin_amdgcn_readfirstlane(pre[b + 1]), j0 = __builtin_amdgcn_readfirstlane(jl[b]);
    const int h = b >> 5, qb = b & 31, part = I - pb0, P = pb1 - pb0, n = 4 * qb + 4 - j0;
    fox::BlockRef<fox::bf16, fox::bf16> r;
    const fox::bf16* proj = (const fox::bf16*)(F.ws + WS_PROJ);
    r.Q = proj + (size_t)(qb * 256) * fox::PITCH + C_FQ + h * 128; r.K = proj + C_FK + h * 128; r.V = proj + C_FV + h * 128;
    r.O = (fox::bf16*)(F.ws + WS_CONCAT) + (size_t)(qb * 256) * D + 1024 + h * 128; r.P0 = qb * 256;
    r.Fb = (const float*)(F.ws + WS_F) + h * S; r.gain = F.in[IN_FOUTN] + h * 128;
    r.jlo = j0 + (part * n) / P; r.jhi = j0 + ((part + 1) * n) / P;
    r.Op = P > 1 ? (float*)(F.ws + WS_OPART) + (size_t)I * 256 * 128 : nullptr; r.ML = (float*)(F.ws + WS_MLP) + (size_t)I * 512;
    return r;
}
__device__ __forceinline__ void p5_attention(Frame& F, char* ldsg) {
    typedef fox::BlockRef<fox::bf16, fox::bf16> BR;
    attn_build_schedule(F);
    const int total = __builtin_amdgcn_readfirstlane(((const LAS int*)(F.lds + TAB_OFF))[256 + 256]);
    int L = F.vcu; if (L >= total) return;
    BR cur = fox_ref(F, L);
    fox::Seam<fox::bf16> Sm;
    fox::causal_swa_prime<fox::bf16, fox::bf16>(cur, S, ldsg, Sm);
    for (;;) {
        const bool more = L + F.G < total;
        const BR nxt = more ? fox_ref(F, L + F.G) : cur;
        fox::causal_swa_block<fox::bf16, fox::bf16>(cur, nxt, S, S, ldsg, Sm);
        if (!more) break;
        cur = nxt; L += F.G;
    }
}
__device__ __forceinline__ void p6_combine(Frame& F) {
    attn_build_schedule(F);
    const LAS int* pre = (const LAS int*)(F.lds + TAB_OFF) + 256;
    const float* OP = wsp<float>(F, WS_OPART); const float* MLP = wsp<float>(F, WS_MLP); bf16* concat = wsp<bf16>(F, WS_CONCAT);
    const int gw = F.vcu * NWAVES + F.wave, NGW = F.G * NWAVES, lane = F.lane;
    constexpr float C2 = 1.4426950408889634f * SCALEQ;
    for (int idx = gw; idx < 256 * 256; idx += NGW) {
        const int b = idx >> 8, r = idx & 255, i0 = pre[b], P = pre[b + 1] - i0; if (P <= 1) continue;
        const int h = b >> 5, qb = b & 31;
        float ms = -3.0e38f;
        for (int p2 = 0; p2 < P; ++p2) ms = fmaxf(ms, MLP[(size_t)(i0 + p2) * 512 + 2 * r]);
        float n0 = 0.f, n1 = 0.f, den = 0.f;
        for (int p2 = 0; p2 < P; ++p2) { const f32x2 ml = *(const GAS f32x2*)(MLP + (size_t)(i0 + p2) * 512 + 2 * r); const float wgt = __builtin_amdgcn_exp2f((ml.x - ms) * C2);
            const f32x2 ov = *(const GAS f32x2*)(OP + ((size_t)(i0 + p2) * 256 + r) * 128 + 2 * lane); n0 += wgt * ov.x; n1 += wgt * ov.y; den += wgt * ml.y; }
        const float inv = 1.f / den, v0 = n0 * inv, v1 = n1 * inv;
        const float ss = wave_sum(v0 * v0 + v1 * v1), rn = rsqrtf(ss * (1.f / 128.f) + 1e-6f);
        const f32x2 gn = *(const GAS f32x2*)(F.in[IN_FOUTN] + h * 128 + 2 * lane);
        *(GAS unsigned*)(concat + (size_t)(qb * 256 + r) * D + 1024 + h * 128 + 2 * lane) = pk2(v0 * rn * gn.x, v1 * rn * gn.y);
    }
}
constexpr int RROWS = 8, NITER = S / RROWS;
__device__ __forceinline__ void p7_router(Frame& F) {
    LAS float* shs = (LAS float*)(F.lds + RING_OFF);
    LAS float* H2L = shs + 2 * D;
    LAS float* red = H2L + RROWS * D;
    LAS int* selE = (LAS int*)(red + 16 * RROWS * NE);
    const float* mod = wsp<float>(F, WS_MOD); const float* h1 = wsp<float>(F, WS_H1); unsigned char* h2 = wsp<unsigned char>(F, WS_HN);
    int* top_i = wsp<int>(F, WS_TOPI); float* top_w = wsp<float>(F, WS_TOPW); int* hist = wsp<int>(F, WS_HIST); int* lrank = wsp<int>(F, WS_LRANK);
    const int tid = F.tid, lane = F.lane, w = F.wave;
    for (int i = tid; i < 2 * D; i += NTHR) shs[i] = mod[3 * D + i];
    __syncthreads();
    float wreg[128];
    { const float* wp = F.in[IN_WR] + (size_t)((tid >> 5) * 128) * NE + (tid & 31);
#pragma unroll
        for (int k = 0; k < 128; ++k) wreg[k] = wp[k * NE]; }
    for (int it = F.vcu; it < NITER; it += F.G) {
        const int r0 = it * RROWS;
        {
            const int m = r0 + w; const GAS f32x4* xr = (const GAS f32x4*)(h1 + (size_t)m * D) + lane; f32x4 v[8]; float s2 = 0.f;
#pragma unroll
            for (int j = 0; j < 8; ++j) { v[j] = xr[64 * j]; s2 += (v[j].x * v[j].x + v[j].y * v[j].y) + (v[j].z * v[j].z + v[j].w * v[j].w); }
            const float r = rsqrtf(wave_sum(s2) * (1.f / D) + 1e-6f);
            GAS unsigned* o8 = (GAS unsigned*)(h2 + (size_t)m * D) + lane;
#pragma unroll
            for (int j = 0; j < 8; ++j) { const int c0 = 4 * lane + 256 * j; const f32x4 gg = *(const GAS f32x4*)(F.in[IN_NFFN] + c0); const f32x4 a = *(const LAS f32x4*)(shs + D + c0), b = *(const LAS f32x4*)(shs + c0);
                const f32x4 y = v[j] * r * gg * (a + 1.f) + b; o8[64 * j] = pk4_fp8(y.x, y.y, y.z, y.w);
                *(LAS f32x4*)(H2L + w * D + c0) = y; }
        }
        __syncthreads();
        {
            const int e = tid & 31, kp = tid >> 5; float acc[RROWS];
#pragma unroll
            for (int r = 0; r < RROWS; ++r) acc[r] = 0.f;
#pragma unroll
            for (int k4 = 0; k4 < 32; ++k4) {
#pragma unroll
                for (int r = 0; r < RROWS; ++r) { const f32x4 hv = *(const LAS f32x4*)(H2L + r * D + kp * 128 + k4 * 4); acc[r] += (hv.x * wreg[4 * k4] + hv.y * wreg[4 * k4 + 1]) + (hv.z * wreg[4 * k4 + 2] + hv.w * wreg[4 * k4 + 3]); }
            }
#pragma unroll
            for (int r = 0; r < RROWS; ++r) red[(kp * RROWS + r) * NE + e] = acc[r];
        }
        __syncthreads();
        if (tid < RROWS * NE) {
            const int r = tid >> 5, e = tid & 31; float lg = F.in[IN_BR][e];
#pragma unroll
            for (int kp = 0; kp < 16; ++kp) lg += red[(kp * RROWS + r) * NE + e];
            float cur = lg, mx = 0.f, sum = 0.f, mysel = 0.f; int myidx = 0;
#pragma unroll
            for (int q = 0; q < 4; ++q) { float best = cur; int bi = e;
#pragma unroll
                for (int o = 1; o < 32; o <<= 1) { const float ob = __shfl_xor(best, o); const int oi = __shfl_xor(bi, o); if (ob > best || (ob == best && oi < bi)) { best = ob; bi = oi; } }
                if (q == 0) mx = best;
                sum += __expf(best - mx);
                if (e == q) { mysel = best; myidx = bi; }
                if (e == bi) cur = -3.0e38f; }
            if (e < 4) { const int t = r0 + r; top_i[t * 4 + e] = myidx; top_w[t * 4 + e] = __expf(mysel - mx) / sum; selE[r * 4 + e] = myidx; }
        }
        __syncthreads();
        if (tid < 32) { const int me = selE[tid]; int rank = 0, cnt = 0;
#pragma unroll
            for (int p = 0; p < 32; ++p) { const int ep = selE[p]; rank += (ep == me && p < tid) ? 1 : 0; cnt += (ep == tid) ? 1 : 0; }
            lrank[it * 32 + tid] = rank; hist[it * NE + tid] = cnt; }
        __syncthreads();
    }
}
__device__ __forceinline__ void build_expert_table(Frame& F, const int* counts_g) {
    LAS int* tab = (LAS int*)(F.lds + TAB_OFF);
    if (F.tid == 0) { int acc = 0; for (int e = 0; e < NE; ++e) { const int c = counts_g[e]; tab[e] = acc; tab[40 + e] = c; acc += (c + 255) >> 8; } tab[32] = acc; }
    __syncthreads();
}
__device__ __forceinline__ void p8_gather(Frame& F) {
    LAS int* psum = (LAS int*)(F.lds + RING_OFF);
    LAS int* startr = psum + 16 * NE;
    LAS int* base = startr + NE;
    const int* hist = wsp<int>(F, WS_HIST); const int* lrank = wsp<int>(F, WS_LRANK); const int* top_i = wsp<int>(F, WS_TOPI); const float* top_w = wsp<float>(F, WS_TOPW);
    int* pos = wsp<int>(F, WS_POS); float* roww = wsp<float>(F, WS_ROWW); const unsigned char* h2 = wsp<unsigned char>(F, WS_HN); unsigned char* xg = wsp<unsigned char>(F, WS_XG);
    int* counts_g = (int*)(F.ws + WS_POS) + S * 4;
    const int tid = F.tid, lane = F.lane, w = F.wave;
    { const int e = tid & 31, part = tid >> 5; int s = 0; for (int i = 0; i < NITER / 16; ++i) s += hist[(part * (NITER / 16) + i) * NE + e]; psum[part * NE + e] = s; }
    __syncthreads();
    if (tid == 0) { int acc = 0; for (int e = 0; e < NE; ++e) { int c = 0; for (int p = 0; p < 16; ++p) c += psum[p * NE + e]; startr[e] = acc; acc += ((c + 255) >> 8) << 8; if (blockIdx.x == 0) counts_g[e] = c; } }
    __syncthreads();
    for (int it = F.vcu; it < NITER; it += F.G) {
        {
            const int part = it / (NITER / 16), i0 = part * (NITER / 16);
            if (w < 4) { const bool on = (i0 + lane) < it;
#pragma unroll
                for (int q = 0; q < 8; ++q) { const int e = w * 8 + q; int v = on ? hist[(i0 + lane) * NE + e] : 0;
#pragma unroll
                    for (int o = 1; o < 64; o <<= 1) v += __shfl_xor(v, o);
                    if (lane == 0) { int b = v; for (int pp = 0; pp < part; ++pp) b += psum[pp * NE + e]; base[e] = b; } } }
        }
        __syncthreads();
#pragma unroll
        for (int j = 0; j < 4; ++j) { const int p = w + 8 * j, pair = it * 32 + p, e = top_i[pair], dest = startr[e] + base[e] + lrank[pair], t = pair >> 2;
            if (lane == 0) { pos[pair] = dest; roww[dest] = top_w[pair]; }
            const GAS v4u* src = (const GAS v4u*)(h2 + (size_t)t * D) + lane; GAS v4u* dst = (GAS v4u*)(xg + (size_t)dest * D) + lane;
#pragma unroll
            for (int q = 0; q < 2; ++q) dst[64 * q] = src[64 * q]; }
        __syncthreads();
    }
}
struct GroupedOrder {
    const LAS int* tab; int ntn, G, c;
    __device__ __forceinline__ bool next(int i, Unit& u) const {
        const int L = i * G + c, total = tab[32] * ntn; if (L >= total) return false;
        int e = 0;
#pragma unroll 1
        while (e < NE - 1 && tab[e + 1] * ntn <= L) ++e;
        const int ts = tab[e], tc = tab[e + 1] - ts, within = L - ts * ntn;
        u.pm = ts + within % tc; u.pn = within / tc; u.e = e; u.pb = e * ntn + u.pn; return true;
    }
    __device__ __forceinline__ void a_ready(const Unit&) const {}
    __device__ __forceinline__ void done(const Unit&) const {}
};
struct EpiSwiglu {
    static constexpr bool PERM = true, AFTER_DRAIN = false;
    unsigned char* act; const float* bug;
    __device__ __forceinline__ void operator()(const pg8::f32x4 (&acc)[2][2][4][2], const Unit& u, int wr, int wc, int fr, int fq) const {
        const int row0 = u.pm * 256 + wr * 64 + fr, f0 = u.pn * 128 + wc * 32 + 8 * fq;
        const float* bg = bug + (size_t)u.e * 4096 + f0; pg8::f32x4 bgv[2], buv[2];
#pragma unroll
        for (int n = 0; n < 2; ++n) { bgv[n] = *(const pg8::f32x4*)(bg + 4 * n); buv[n] = *(const pg8::f32x4*)(bg + 2048 + 4 * n); }
#pragma unroll
        for (int ai = 0; ai < 2; ++ai)
#pragma unroll
            for (int m = 0; m < 4; ++m) { float o[8];
#pragma unroll
                for (int n = 0; n < 2; ++n)
#pragma unroll
                    for (int i = 0; i < 4; ++i) { const float g = fminf(acc[ai][0][m][n][i] + bgv[n][i], 7.f); const float up = fminf(fmaxf(acc[ai][1][m][n][i] + buv[n][i], -7.f), 7.f);
                        o[4 * n + i] = (up + 1.f) * g * __builtin_amdgcn_rcpf(1.f + __builtin_amdgcn_exp2f(-2.45546696f * g)); }
                u32x2 wv; wv.x = pk4_fp8(o[0], o[1], o[2], o[3]); wv.y = pk4_fp8(o[4], o[5], o[6], o[7]);
                *(u32x2*)(act + (size_t)(row0 + ai * 128 + m * 16) * FF + f0) = wv; }
    }
};
struct EpiDown {
    static constexpr bool PERM = true, AFTER_DRAIN = false;
    bf16* y; const float* bd; const float* roww;
    __device__ __forceinline__ void operator()(const pg8::f32x4 (&acc)[2][2][4][2], const Unit& u, int wr, int wc, int fr, int fq) const {
        const int row0 = u.pm * 256 + wr * 64 + fr, col0 = u.pn * 256 + wc * 32 + 8 * fq;
        pg8::f32x4 bv[2][2];
#pragma unroll
        for (int bj = 0; bj < 2; ++bj)
#pragma unroll
            for (int n = 0; n < 2; ++n) bv[bj][n] = *(const pg8::f32x4*)(bd + (size_t)u.e * D + col0 + bj * 128 + 4 * n);
#pragma unroll
        for (int ai = 0; ai < 2; ++ai)
#pragma unroll
            for (int m = 0; m < 4; ++m) { const int row = row0 + ai * 128 + m * 16; const float rw = roww[row]; bf16* rowp = y + (size_t)row * D + col0;
#pragma unroll
                for (int bj = 0; bj < 2; ++bj) { const pg8::f32x4 v0 = (acc[ai][bj][m][0] + bv[bj][0]) * rw, v1 = (acc[ai][bj][m][1] + bv[bj][1]) * rw;
                    pg8::u32x4 wv; wv.x = cvt_pk_bf16(v0[0], v0[1]); wv.y = cvt_pk_bf16(v0[2], v0[3]); wv.z = cvt_pk_bf16(v1[0], v1[1]); wv.w = cvt_pk_bf16(v1[2], v1[3]);
                    *(pg8::u32x4*)(rowp + bj * 128) = wv; } }
    }
};
__device__ __forceinline__ void p11_final(Frame& F, float oscale) {
    LAS float* ms = (LAS float*)(F.lds + RING_OFF);
    const float* mod = wsp<float>(F, WS_MOD);
    for (int i = F.tid; i < 3 * D; i += NTHR) ms[i] = mod[5 * D + i];
    __syncthreads();
    const float* h1 = wsp<float>(F, WS_H1); const bf16* y = wsp<bf16>(F, WS_Y); const int* pos = wsp<int>(F, WS_POS);
    const int gw = F.vcu * NWAVES + F.wave, NGW = F.G * NWAVES, lane = F.lane;
    for (int t = gw; t < S; t += NGW) {
        asm volatile("" ::: "memory");
        const GAS f32x4* xr = (const GAS f32x4*)(h1 + (size_t)t * D) + lane;
        const GAS u32x2* y0 = (const GAS u32x2*)(y + (size_t)pos[t * 4 + 0] * D) + lane; const GAS u32x2* y1 = (const GAS u32x2*)(y + (size_t)pos[t * 4 + 1] * D) + lane;
        const GAS u32x2* y2 = (const GAS u32x2*)(y + (size_t)pos[t * 4 + 2] * D) + lane; const GAS u32x2* y3 = (const GAS u32x2*)(y + (size_t)pos[t * 4 + 3] * D) + lane;
        f32x4 v[8]; float s2 = 0.f;
#pragma unroll
        for (int j = 0; j < 8; ++j) { const u32x2 a = y0[64 * j], b = y1[64 * j], c = y2[64 * j], d = y3[64 * j]; const f32x4 g2 = *(const LAS f32x4*)(ms + 4 * lane + 256 * j);
            f32x4 f;
            f.x = (bf2f((unsigned short)(a.x & 0xffffu)) + bf2f((unsigned short)(b.x & 0xffffu))) + (bf2f((unsigned short)(c.x & 0xffffu)) + bf2f((unsigned short)(d.x & 0xffffu)));
            f.y = (bf2f((unsigned short)(a.x >> 16)) + bf2f((unsigned short)(b.x >> 16))) + (bf2f((unsigned short)(c.x >> 16)) + bf2f((unsigned short)(d.x >> 16)));
            f.z = (bf2f((unsigned short)(a.y & 0xffffu)) + bf2f((unsigned short)(b.y & 0xffffu))) + (bf2f((unsigned short)(c.y & 0xffffu)) + bf2f((unsigned short)(d.y & 0xffffu)));
            f.w = (bf2f((unsigned short)(a.y >> 16)) + bf2f((unsigned short)(b.y >> 16))) + (bf2f((unsigned short)(c.y >> 16)) + bf2f((unsigned short)(d.y >> 16)));
            v[j] = xr[64 * j] + g2 * f; s2 += (v[j].x * v[j].x + v[j].y * v[j].y) + (v[j].z * v[j].z + v[j].w * v[j].w); }
        const float r = rsqrtf(wave_sum(s2) * (1.f / D) + 1e-6f);
        GAS f32x4* o = (GAS f32x4*)(F.out + (size_t)t * D) + lane;
#pragma unroll
        for (int j = 0; j < 8; ++j) { const int c0 = 4 * lane + 256 * j; const f32x4 gg = *(const GAS f32x4*)(F.in[IN_NFIN] + c0); const f32x4 sh = *(const LAS f32x4*)(ms + D + c0), sc = *(const LAS f32x4*)(ms + 2 * D + c0);
            o[64 * j] = (v[j] * r * gg * (sc + 1.f) + sh) * oscale; }
    }
}
}
namespace mk {
struct Args { const float* in[24]; float* out; unsigned char* ws; int ph_lo, ph_hi, li, pad; };
constexpr int N_PHASES = 13;
__global__ void __launch_bounds__(NTHR, 2) mega_fwd(Args args) {
    extern __shared__ __attribute__((aligned(16))) unsigned char lds[];
    Frame F;
    F.lds = (LAS unsigned char*)lds;
    F.MISC = (volatile LAS unsigned*)(F.lds + MISC_OFF);
    F.tid = threadIdx.x; F.lane = F.tid & 63; F.wave = __builtin_amdgcn_readfirstlane(F.tid >> 6);
    leave_group(F);
    F.ws = args.ws; F.out = args.out; F.ctl = (gu32*)(args.ws + WS_CTL);
#pragma unroll
    for (int i = 0; i < 24; ++i) F.in[i] = args.in[i];
    for (int u = F.tid; u < (LDS_BYTES - LDSCTL_OFF) / 4; u += NTHR) ((LAS unsigned*)(F.lds + LDSCTL_OFF))[u] = 0u;
    __syncthreads();
    XcdBarrier bar = xcd_barrier_post((unsigned*)(F.ctl + CW_BAR) + args.li * XCD_BAR_WORDS, F.MISC + 8);
    const int lo = args.ph_lo, hi = args.ph_hi;
#define IN(k) (lo <= (k) && (k) < hi)
#define SEAM(k) do { if (IN(k) && IN((k) + 1)) xcd_barrier(bar); } while (0)

#ifndef MK_DOUBLE
#define MK_DOUBLE 0
#endif
#define DBL(k) ((MK_DOUBLE >> (k)) & 1)
#ifdef MK_PROBE_LO
    unsigned long long* stamps = (unsigned long long*)(F.ctl + 131072);
#define STAMP(k) do { if (blockIdx.x == 0 && F.tid == 0) stamps[k] = rt(); } while (0)
#define PROBE_SCALE() (1.f + sqrtf((float)(stamps[MK_PROBE_HI] - stamps[MK_PROBE_LO]) * 0.01f * 2e-5f))
#else
#define STAMP(k) do { } while (0)
#define PROBE_SCALE() 1.f
#endif
    STAMP(0); if (IN(0)) { p0_gemv(F); } SEAM(0);
    STAMP(1); if (IN(1)) { p1_modulate(F); if (DBL(1)) p1_modulate(F); } SEAM(1);
    STAMP(2); if (IN(2)) {
        gu32* done = F.ctl + CW_DONE + 64 * 2;
        if (enter_group(F, GC_INPROJ)) {
            pg8::Gemm g{wsp<pg8::bf16_t>(F, WS_HN), wsp<pg8::bf16_t>(F, WS_WIN), S, NPP, D}; pg8::StaticOrder So; So.init(S, NPP, F.G, F.bid);
            EpiProj E{wsp<bf16>(F, WS_PROJ)};
            pg8::gemm_phase<EpiProj, pg8::StaticOrder, true, true>(F.lds + RING_OFF, g, So, E);
            if (DBL(2)) pg8::gemm_phase<EpiProj, pg8::StaticOrder, true, true>(F.lds + RING_OFF, g, So, E);
            __syncthreads();
            if (F.tid == 0) __hip_atomic_fetch_add(done, 1u, RLX_AGENT);
        }
        const unsigned tgt = (unsigned)F.G; leave_group(F);
        conv_worker(F, done, F.G == 256 ? (unsigned)GC_INPROJ : tgt);
        __syncthreads();
    } SEAM(2);
#define GROUPED(k, Gc, body) do { gu32* done_ = F.ctl + CW_DONE + 64 * (k); if (enter_group(F, (Gc))) { body; __syncthreads(); if (F.tid == 0) __hip_atomic_fetch_add(done_, 1u, RLX_AGENT); } \
        const unsigned tgt_ = (unsigned)F.G; leave_group(F); conv_worker(F, done_, F.G == 256 ? (unsigned)(Gc) : tgt_); __syncthreads(); } while (0)
    STAMP(3); if (IN(3)) { p3_prep(F); } SEAM(3);
    STAMP(4); if (IN(4)) { p4_scan(F); if (DBL(4)) p4_scan(F); } SEAM(4);
    STAMP(5); if (IN(5)) {
        gu32* done = F.ctl + CW_DONE + 64 * 5;
        if (enter_group(F, GC_ATTN)) {
            p5_mlstm_out(F); if (DBL(14)) p5_mlstm_out(F); p5_attention(F, (char*)lds);
            __syncthreads();
            if (F.tid == 0) __hip_atomic_fetch_add(done, 1u, RLX_AGENT);
        }
        const unsigned tgt = (unsigned)F.G; leave_group(F);
        conv_worker(F, done, F.G == 256 ? (unsigned)GC_ATTN : tgt);
        __syncthreads();
    } SEAM(5);
    STAMP(6); if (IN(6)) { p6_combine(F); } SEAM(6);
    STAMP(7); if (IN(7)) {
        pg8::Gemm g{wsp<pg8::bf16_t>(F, WS_CONCAT), wsp<pg8::bf16_t>(F, WS_WOUT), S, D, D}; pg8::StaticOrder So; So.init(S, D, F.G, F.bid);
        EpiOut E{F.in[IN_X], wsp<float>(F, WS_MOD) + 2 * D, wsp<float>(F, WS_H1)};
        pg8::gemm_phase<EpiOut, pg8::StaticOrder, false, true>(F.lds + RING_OFF, g, So, E);
        if (DBL(7)) pg8::gemm_phase<EpiOut, pg8::StaticOrder, false, true>(F.lds + RING_OFF, g, So, E);
    } SEAM(7);
    STAMP(8); if (IN(8)) { p7_router(F); if (DBL(8)) p7_router(F); } SEAM(8);
    STAMP(9); if (IN(9)) { p8_gather(F); if (DBL(9)) p8_gather(F); __syncthreads(); conv_worker(F, nullptr, 0u); __syncthreads(); } SEAM(9);
    STAMP(10); if (IN(10)) {
        build_expert_table(F, (const int*)(F.ws + WS_POS) + S * 4);
        pg8::Gemm g{wsp<pg8::bf16_t>(F, WS_XG), wsp<pg8::bf16_t>(F, WS_WUG), MAXROWS, 4096, D / 2}; GroupedOrder So{(const LAS int*)(F.lds + TAB_OFF), 16, F.G, F.bid};
        EpiSwiglu E{wsp<unsigned char>(F, WS_ACT), F.in[IN_BUG]};
        pg8::gemm_phase8<EpiSwiglu, GroupedOrder, true, true>(F.lds + RING_OFF, g, So, E);
        if (DBL(10)) pg8::gemm_phase8<EpiSwiglu, GroupedOrder, true, true>(F.lds + RING_OFF, g, So, E);
    } SEAM(10);
    STAMP(11); if (IN(11)) {
        build_expert_table(F, (const int*)(F.ws + WS_POS) + S * 4);
        pg8::Gemm g{wsp<pg8::bf16_t>(F, WS_ACT), wsp<pg8::bf16_t>(F, WS_WD), MAXROWS, D, FF / 2}; GroupedOrder So{(const LAS int*)(F.lds + TAB_OFF), 8, F.G, F.bid};
        EpiDown E{wsp<bf16>(F, WS_Y), F.in[IN_BD], wsp<float>(F, WS_ROWW)};
        pg8::gemm_phase8<EpiDown, GroupedOrder, true, true>(F.lds + RING_OFF, g, So, E);
        if (DBL(11)) pg8::gemm_phase8<EpiDown, GroupedOrder, true, true>(F.lds + RING_OFF, g, So, E);
    } SEAM(11);
    STAMP(12); if (IN(12)) { p11_final(F, PROBE_SCALE()); if (DBL(12)) p11_final(F, PROBE_SCALE()); }
#undef IN
#undef SEAM
}
}
#ifndef MK_DEBUG
#define MK_DEBUG 0
#endif
#ifndef MK_PH_END
#define MK_PH_END mk::N_PHASES
#endif
#ifndef MK_SPLIT
#define MK_SPLIT 0
#endif
extern "C" void kernel_launch(void* const* d_in, const int* in_sizes, int n_in, void* d_out, int out_size, void* d_ws, size_t ws_size, hipStream_t stream) {
    using namespace mk;
    static int grid = 0;
    if (grid == 0) {
        int dev = 0, cus = 0, per_cu = 0;
        if (hipGetDevice(&dev) != hipSuccess || hipDeviceGetAttribute(&cus, hipDeviceAttributeMultiprocessorCount, dev) != hipSuccess) { fprintf(stderr, "kernel_launch: device query failed\n"); grid = -1; return; }
        if (hipFuncSetAttribute((const void*)mega_fwd, hipFuncAttributeMaxDynamicSharedMemorySize, LDS_BYTES) != hipSuccess) { fprintf(stderr, "kernel_launch: hipFuncSetAttribute failed\n"); grid = -1; return; }
        if (hipOccupancyMaxActiveBlocksPerMultiprocessor(&per_cu, (const void*)mega_fwd, NTHR, LDS_BYTES) != hipSuccess || per_cu < 1) fprintf(stderr, "kernel_launch: occupancy query reports %d\n", per_cu);
        (void)hipGetLastError();
        grid = cus;
        if (n_in != 24 || out_size != S * D || ws_size < (MK_DEBUG ? WS_NAIVE + (size_t)2300 * MiB : WS_END)) fprintf(stderr, "kernel_launch: unexpected sizes n_in %d out %d ws %zu\n", n_in, out_size, ws_size);
    }
    if (grid < 0) return;
    (void)hipMemsetAsync((char*)d_ws + WS_CTL, 0, CTL_ZERO_BYTES, stream);
    Args a{};
    for (int i = 0; i < 24; ++i) a.in[i] = (const float*)d_in[i];
    a.out = (float*)d_out; a.ws = (unsigned char*)d_ws;
#if MK_DEBUG
    nv::naive_forward(d_in, (float*)d_out, (char*)d_ws + WS_NAIVE, stream);
#endif
#if MK_SPLIT
    for (int p = 0; p < MK_PH_END; ++p) { a.ph_lo = p; a.ph_hi = p + 1; a.li = p; hipLaunchKernelGGL(mega_fwd, dim3(grid), dim3(NTHR), LDS_BYTES, stream, a); }
#else
    a.ph_lo = 0; a.ph_hi = MK_PH_END; a.li = 0;
    hipLaunchKernelGGL(mega_fwd, dim3(grid), dim3(NTHR), LDS_BYTES, stream, a);
#endif
#ifdef MK_EXTRA_LO
    a.ph_lo = MK_EXTRA_LO; a.ph_hi = MK_EXTRA_HI; a.li = 1;
    hipLaunchKernelGGL(mega_fwd, dim3(grid), dim3(NTHR), LDS_BYTES, stream, a);
#endif
    { const hipError_t le = hipPeekAtLastError(); if (le != hipSuccess) fprintf(stderr, "kernel_launch: launch failed: %s\n", hipGetErrorName(le)); }
#if MK_DEBUG
    {
        nv::NaiveWs w = nv::carve((char*)d_ws + WS_NAIVE);
        double* slots = (double*)((char*)d_ws + WS_CTL + 512 * 1024);
        unsigned char* ws = (unsigned char*)d_ws; int nc = 0;
        MK_DEBUG_CHECKS
        dbg::k_finish<<<1024, 256, 0, stream>>>((float*)d_out, (size_t)S * D, slots, nc, 1e-3);
    }
#endif
}
```

```cpp
#include <hip/hip_runtime.h>
#include <hip/hip_bf16.h>
#include <cstdio>
#include <cstdint>
namespace pg8 {
#define PG8_LAS __attribute__((address_space(3)))
typedef unsigned short bf16_t;
typedef short bf16x8 __attribute__((ext_vector_type(8)));
typedef float f32x4 __attribute__((ext_vector_type(4)));
typedef unsigned u32x4 __attribute__((ext_vector_type(4)));
constexpr int BM = 256, BK = 64, HALF = 128, HTB = HALF * BK * 2  , STAGE_BYTES = 8 * HTB, NXCD = 8, WGM = 8;

__host__ __device__ __forceinline__ int lds_byte(int r, int c) { const int st = (r >> 4) * 2 + (c >> 5), rr = r & 15, cc = c & 31, ob = rr * 64 + cc * 2; return st * 1024 + (ob ^ (((ob >> 9) & 1) << 5)); }
__host__ __device__ __forceinline__ void stage_rc(int b, int& R, int& C) { const int st = b / 1024, sb = b % 1024, swz = sb ^ (((sb >> 9) & 1) << 5); R = (st >> 1) * 16 + swz / 64; C = (st & 1) * 32 + (swz % 64) / 2; }
__host__ __device__ __forceinline__ int perm32(int rho) { const int n = rho >> 4, i = rho & 15; return 8 * (i >> 2) + 4 * n + (i & 3); }

struct Unit { int pm, pn, pb, e; };
struct Gemm { const bf16_t* A; const bf16_t* Bt; int M, N, K; };

struct StaticOrder {
    int nM, nN, nwg, G, c;
    __host__ __device__ void init(int M, int N, int G_, int c_) { nM = M / BM; nN = N / BM; nwg = nM * nN; G = G_; c = c_; }
    __host__ __device__ bool next(int i, Unit& u) const {
        const long L = (long)i * G + c; if (L >= nwg) return false;
        int wgid = (int)L; { const int q = nwg / NXCD, r = nwg % NXCD, xcd = wgid % NXCD, off = wgid / NXCD; wgid = (xcd < r ? xcd * (q + 1) : r * (q + 1) + (xcd - r) * q) + off; }
        const int nig = WGM * nN, gid = wgid / nig, fm = gid * WGM, gsz = (nM - fm) < WGM ? (nM - fm) : WGM;
        u.pm = fm + ((wgid % nig) % gsz); u.pn = (wgid % nig) / gsz; u.pb = u.pn; u.e = 0; return true;
    }
    __device__ __forceinline__ void a_ready(const Unit&) const {}
    __device__ __forceinline__ void done(const Unit&) const {}
};

__device__ __forceinline__ unsigned cvt_pk_bf16(float lo, float hi) { unsigned r; asm volatile("v_cvt_pk_bf16_f32 %0, %1, %2" : "=v"(r) : "v"(lo), "v"(hi)); return r; }
template <class Epi, class Sched, bool ALIGN_EPI = false, bool SP2 = false>
__device__ __forceinline__ void gemm_phase(PG8_LAS unsigned char* lds, const Gemm g, const Sched& S, const Epi& E) {
    const int tid = threadIdx.x, wid = __builtin_amdgcn_readfirstlane(tid >> 6), lane = tid & 63, wr = wid >> 2, wc = wid & 3, fr = lane & 15, fq = lane >> 4;
    const int K = g.K, nt = K / BK;
    unsigned voffA[2], voffB[2];
#pragma unroll
    for (int i = 0; i < 2; ++i) { int R, C; stage_rc(tid * 16 + i * 8192, R, C); const int Rb = Epi::PERM ? ((R & ~31) + perm32(R & 31)) : R;
        voffA[i] = (unsigned)(R * K + C) * 2u; voffB[i] = (unsigned)(Rb * K + C) * 2u; }
    const size_t kstep = (size_t)(BK * 2);
    const size_t hstep = (size_t)HALF * K * 2;
    const size_t tstep = 2 * hstep;
    const unsigned ldsw = (unsigned)wid * 1024u;
    const int aoff = lds_byte(wr * 64 + fr, fq * 8), boff = lds_byte(wc * 32 + fr, fq * 8);
#define PG8_SA(b, h) (((b) * 2 + (h)) * HTB)
#define PG8_SB(b, h) ((4 + (b) * 2 + (h)) * HTB)
#define PG8_STAGE(bufoff, gbase, voff) do { _Pragma("unroll") for (int _i = 0; _i < 2; ++_i) \
        __builtin_amdgcn_global_load_lds((const unsigned*)((const char*)(gbase) + (voff)[_i]), (PG8_LAS unsigned*)(lds + (bufoff) + ldsw + _i * 8192), 16, 0, 0); } while (0)
#define PG8_LDA(dst, b, h) do { _Pragma("unroll") for (int m = 0; m < 4; ++m) _Pragma("unroll") for (int k = 0; k < 2; ++k) dst[m][k] = *(const PG8_LAS bf16x8*)(lds + PG8_SA(b, h) + aoff + m * 2048 + k * 1024); } while (0)
#define PG8_LDB(dst, b, h) do { _Pragma("unroll") for (int n = 0; n < 2; ++n) _Pragma("unroll") for (int k = 0; k < 2; ++k) dst[n][k] = *(const PG8_LAS bf16x8*)(lds + PG8_SB(b, h) + boff + n * 2048 + k * 1024); } while (0)
#define PG8_MMA(ai, bj, At, Bt) do { __builtin_amdgcn_s_setprio(1); _Pragma("unroll") for (int m = 0; m < 4; ++m) _Pragma("unroll") for (int n = 0; n < 2; ++n) _Pragma("unroll") for (int k = 0; k < 2; ++k) \
        acc[ai][bj][m][n] = __builtin_amdgcn_mfma_f32_16x16x32_bf16(Bt[n][k], At[m][k], acc[ai][bj][m][n], 0, 0, 0); __builtin_amdgcn_s_setprio(0); } while (0)
#define PG8_WAIT_V(n) asm volatile("s_waitcnt vmcnt(" #n ")" ::: "memory")
#define PG8_WAIT_L(n) asm volatile("s_waitcnt lgkmcnt(" #n ")" ::: "memory")
#define PG8_BAR __builtin_amdgcn_s_barrier()
#define PG8_SCHED __builtin_amdgcn_sched_barrier(0)
    Unit cur, nxt; int ui = 0;
    if (!S.next(0, cur)) return;
    f32x4 acc[2][2][4][2];
#pragma unroll
    for (int a = 0; a < 2; ++a)
#pragma unroll
        for (int b = 0; b < 2; ++b)
#pragma unroll
            for (int m = 0; m < 4; ++m)
#pragma unroll
                for (int n = 0; n < 2; ++n) acc[a][b][m][n] = (f32x4){0.f, 0.f, 0.f, 0.f};
    bf16x8 At[4][2], B0[2][2], B1[2][2];
    const char* cA = (const char*)g.A + (size_t)cur.pm * tstep; const char* cB = (const char*)g.Bt + (size_t)cur.pb * tstep;
    S.a_ready(cur);
    if constexpr (SP2) {
        PG8_STAGE(PG8_SB(0, 0), cB, voffB); PG8_STAGE(PG8_SB(0, 1), cB + hstep, voffB); PG8_STAGE(PG8_SA(0, 0), cA, voffA); PG8_STAGE(PG8_SA(0, 1), cA + hstep, voffA);
        if (wr == 1) PG8_BAR;
        PG8_WAIT_V(2); PG8_BAR;
        PG8_STAGE(PG8_SB(1, 0), cB + kstep, voffB); PG8_STAGE(PG8_SA(1, 0), cA + kstep, voffA); PG8_STAGE(PG8_SB(1, 1), cB + hstep + kstep, voffB);
        PG8_WAIT_V(6); PG8_BAR;
    } else {
        PG8_STAGE(PG8_SB(0, 0), cB, voffB); PG8_STAGE(PG8_SA(0, 0), cA, voffA); PG8_STAGE(PG8_SB(0, 1), cB + hstep, voffB); PG8_STAGE(PG8_SA(0, 1), cA + hstep, voffA);
        if (wr == 1) PG8_BAR;
        PG8_WAIT_V(4); PG8_BAR;
        PG8_STAGE(PG8_SB(1, 0), cB + kstep, voffB); PG8_STAGE(PG8_SA(1, 0), cA + kstep, voffA); PG8_STAGE(PG8_SB(1, 1), cB + hstep + kstep, voffB);
        PG8_WAIT_V(6); PG8_BAR;
    }
    for (;;) {
        const bool has_next = S.next(ui + 1, nxt);
        const char* nA = has_next ? (const char*)g.A + (size_t)nxt.pm * tstep : cA; const char* nB = has_next ? (const char*)g.Bt + (size_t)nxt.pb * tstep : cB;
        for (int t = 0; t < nt; t += 2) {
            const bool last = (t == nt - 2);
            const char* a1 = cA + (size_t)(t + 1) * kstep;
            const char* a2 = last ? nA : cA + (size_t)(t + 2) * kstep; const char* b2 = last ? nB : cB + (size_t)(t + 2) * kstep;
            const char* a3 = a2 + kstep; const char* b3 = b2 + kstep;
            if (last && has_next) S.a_ready(nxt);
            if constexpr (SP2) {
            PG8_LDB(B0, 0, 0); PG8_LDB(B1, 0, 1); PG8_SCHED; PG8_LDA(At, 0, 0); PG8_STAGE(PG8_SA(1, 1), a1 + hstep, voffA);
            PG8_WAIT_V(8); PG8_WAIT_L(0); PG8_BAR; PG8_MMA(0, 0, At, B0); PG8_MMA(0, 1, At, B1); PG8_BAR; PG8_SCHED;
            PG8_LDA(At, 0, 1); PG8_STAGE(PG8_SB(0, 0), b2, voffB); PG8_STAGE(PG8_SB(0, 1), b2 + hstep, voffB); PG8_STAGE(PG8_SA(0, 0), a2, voffA);
            PG8_WAIT_V(8); PG8_WAIT_L(0); PG8_BAR; PG8_MMA(1, 0, At, B0); PG8_MMA(1, 1, At, B1); PG8_BAR; PG8_SCHED;
            PG8_LDB(B0, 1, 0); PG8_LDB(B1, 1, 1); PG8_SCHED; PG8_LDA(At, 1, 0); PG8_STAGE(PG8_SA(0, 1), a2 + hstep, voffA);
            PG8_WAIT_V(8); PG8_WAIT_L(0); PG8_BAR; PG8_MMA(0, 0, At, B0); PG8_MMA(0, 1, At, B1); PG8_BAR; PG8_SCHED;
            PG8_LDA(At, 1, 1); PG8_STAGE(PG8_SB(1, 0), b3, voffB); PG8_STAGE(PG8_SB(1, 1), b3 + hstep, voffB); PG8_STAGE(PG8_SA(1, 0), a3, voffA);
            PG8_WAIT_V(8); PG8_WAIT_L(0); PG8_BAR; PG8_MMA(1, 0, At, B0); PG8_MMA(1, 1, At, B1); PG8_BAR; PG8_SCHED;
            } else {
            PG8_LDB(B0, 0, 0); PG8_SCHED; PG8_LDA(At, 0, 0); PG8_STAGE(PG8_SA(1, 1), a1 + hstep, voffA);
            PG8_WAIT_L(8); PG8_BAR; PG8_WAIT_L(0); PG8_MMA(0, 0, At, B0); PG8_BAR; PG8_SCHED;
            PG8_LDB(B1, 0, 1); PG8_STAGE(PG8_SB(0, 0), b2, voffB);
            PG8_BAR; PG8_WAIT_L(0); PG8_MMA(0, 1, At, B1); PG8_BAR;
            PG8_LDA(At, 0, 1); PG8_STAGE(PG8_SA(0, 0), a2, voffA);
            PG8_BAR; PG8_WAIT_L(0); PG8_MMA(1, 0, At, B0); PG8_BAR; PG8_SCHED;
            PG8_STAGE(PG8_SB(0, 1), b2 + hstep, voffB);
            PG8_WAIT_V(6); PG8_BAR; PG8_MMA(1, 1, At, B1); PG8_BAR;
            PG8_LDB(B0, 1, 0); PG8_SCHED; PG8_LDA(At, 1, 0); PG8_STAGE(PG8_SA(0, 1), a2 + hstep, voffA);
            PG8_WAIT_L(8); PG8_BAR; PG8_WAIT_L(0); PG8_MMA(0, 0, At, B0); PG8_BAR; PG8_SCHED;
            PG8_LDB(B1, 1, 1); PG8_STAGE(PG8_SB(1, 0), b3, voffB);
            PG8_BAR; PG8_WAIT_L(0); PG8_MMA(0, 1, At, B1); PG8_BAR;
            PG8_LDA(At, 1, 1); PG8_STAGE(PG8_SA(1, 0), a3, voffA);
            PG8_BAR; PG8_WAIT_L(0); PG8_MMA(1, 0, At, B0); PG8_BAR; PG8_SCHED;
            PG8_STAGE(PG8_SB(1, 1), b3 + hstep, voffB);
            PG8_WAIT_V(6); PG8_BAR; PG8_MMA(1, 1, At, B1); PG8_BAR;
            }
        }
        if constexpr (ALIGN_EPI) { if (wr == 0) PG8_BAR; }
        if constexpr (!Epi::AFTER_DRAIN) { E(acc, cur, wr, wc, fr, fq); S.done(cur); }
        if (!has_next) break;
#pragma unroll
        for (int a = 0; a < 2; ++a)
#pragma unroll
            for (int b = 0; b < 2; ++b)
#pragma unroll
                for (int m = 0; m < 4; ++m)
#pragma unroll
                    for (int n = 0; n < 2; ++n) acc[a][b][m][n] = (f32x4){0.f, 0.f, 0.f, 0.f};
        cur = nxt; cA = nA; cB = nB; ++ui;
        if constexpr (ALIGN_EPI) { if (wr == 1) PG8_BAR; }
    }
    PG8_WAIT_V(0);
    if constexpr (!ALIGN_EPI) { if (wr == 0) PG8_BAR; }
    PG8_BAR;
    if constexpr (Epi::AFTER_DRAIN) { E.fused(acc, cur, wr, wc, fr, fq, lds, wid, lane); S.done(cur); }
#undef PG8_SA
#undef PG8_SB
#undef PG8_STAGE
#undef PG8_LDA
#undef PG8_LDB
#undef PG8_MMA
#undef PG8_WAIT_V
#undef PG8_WAIT_L
#undef PG8_BAR
#undef PG8_SCHED
}
typedef int v8i __attribute__((ext_vector_type(8)));
typedef int v4i __attribute__((ext_vector_type(4)));
constexpr int SCALE_W8 = 0x78787878, SCALE_A8 = 0x7f7f7f7f;
template <class Epi, class Sched, bool ALIGN_EPI = false, bool SP2 = false>
__device__ __forceinline__ void gemm_phase8(PG8_LAS unsigned char* lds, const Gemm g, const Sched& S, const Epi& E) {
    const int tid = threadIdx.x, wid = __builtin_amdgcn_readfirstlane(tid >> 6), lane = tid & 63, wr = wid >> 2, wc = wid & 3, fr = lane & 15, fq = lane >> 4;
    const int K = g.K, nt = K / BK;
    unsigned voffA[2], voffB[2];
#pragma unroll
    for (int i = 0; i < 2; ++i) { int R, C; stage_rc(tid * 16 + i * 8192, R, C); const int Rb = Epi::PERM ? ((R & ~31) + perm32(R & 31)) : R;
        voffA[i] = (unsigned)(R * K + C) * 2u; voffB[i] = (unsigned)(Rb * K + C) * 2u; }
    const size_t kstep = (size_t)(BK * 2);
    const size_t hstep = (size_t)HALF * K * 2;
    const size_t tstep = 2 * hstep;
    const unsigned ldsw = (unsigned)wid * 1024u;
    const int aoff = lds_byte(wr * 64 + fr, fq * 8), boff = lds_byte(wc * 32 + fr, fq * 8);
#define PG8_SA(b, h) (((b) * 2 + (h)) * HTB)
#define PG8_SB(b, h) ((4 + (b) * 2 + (h)) * HTB)
#define PG8_STAGE(bufoff, gbase, voff) do { _Pragma("unroll") for (int _i = 0; _i < 2; ++_i) \
        __builtin_amdgcn_global_load_lds((const unsigned*)((const char*)(gbase) + (voff)[_i]), (PG8_LAS unsigned*)(lds + (bufoff) + ldsw + _i * 8192), 16, 0, 0); } while (0)
#define PG8_LDA(dst, b, h) do { _Pragma("unroll") for (int m = 0; m < 4; ++m) { const v4i lo_ = *(const PG8_LAS v4i*)(lds + PG8_SA(b, h) + aoff + m * 2048), hi_ = *(const PG8_LAS v4i*)(lds + PG8_SA(b, h) + aoff + m * 2048 + 1024); \
        dst[m] = __builtin_shufflevector(lo_, hi_, 0, 1, 2, 3, 4, 5, 6, 7); } } while (0)
#define PG8_LDB(dst, b, h) do { _Pragma("unroll") for (int n = 0; n < 2; ++n) { const v4i lo_ = *(const PG8_LAS v4i*)(lds + PG8_SB(b, h) + boff + n * 2048), hi_ = *(const PG8_LAS v4i*)(lds + PG8_SB(b, h) + boff + n * 2048 + 1024); \
        dst[n] = __builtin_shufflevector(lo_, hi_, 0, 1, 2, 3, 4, 5, 6, 7); } } while (0)
#define PG8_MMA(ai, bj, At, Bt) do { __builtin_amdgcn_s_setprio(1); _Pragma("unroll") for (int m = 0; m < 4; ++m) _Pragma("unroll") for (int n = 0; n < 2; ++n) \
        asm volatile("v_mfma_scale_f32_16x16x128_f8f6f4 %0, %1, %2, %0, %3, %4 op_sel_hi:[0,0,0]" : "+v"(acc[ai][bj][m][n]) : "v"(Bt[n]), "v"(At[m]), "v"(sw8), "v"(sa8)); __builtin_amdgcn_s_setprio(0); } while (0)
#define PG8_WAIT_V(n) asm volatile("s_waitcnt vmcnt(" #n ")" ::: "memory")
#define PG8_WAIT_L(n) asm volatile("s_waitcnt lgkmcnt(" #n ")" ::: "memory")
#define PG8_BAR __builtin_amdgcn_s_barrier()
#define PG8_SCHED __builtin_amdgcn_sched_barrier(0)
    Unit cur, nxt; int ui = 0;
    if (!S.next(0, cur)) return;
    f32x4 acc[2][2][4][2];
#pragma unroll
    for (int a = 0; a < 2; ++a)
#pragma unroll
        for (int b = 0; b < 2; ++b)
#pragma unroll
            for (int m = 0; m < 4; ++m)
#pragma unroll
                for (int n = 0; n < 2; ++n) acc[a][b][m][n] = (f32x4){0.f, 0.f, 0.f, 0.f};
    v8i At[4], B0[2], B1[2]; int sw8 = SCALE_W8, sa8 = SCALE_A8;
    const char* cA = (const char*)g.A + (size_t)cur.pm * tstep; const char* cB = (const char*)g.Bt + (size_t)cur.pb * tstep;
    S.a_ready(cur);
    if constexpr (SP2) {
        PG8_STAGE(PG8_SB(0, 0), cB, voffB); PG8_STAGE(PG8_SB(0, 1), cB + hstep, voffB); PG8_STAGE(PG8_SA(0, 0), cA, voffA); PG8_STAGE(PG8_SA(0, 1), cA + hstep, voffA);
        if (wr == 1) PG8_BAR;
        PG8_WAIT_V(2); PG8_BAR;
        PG8_STAGE(PG8_SB(1, 0), cB + kstep, voffB); PG8_STAGE(PG8_SA(1, 0), cA + kstep, voffA); PG8_STAGE(PG8_SB(1, 1), cB + hstep + kstep, voffB);
        PG8_WAIT_V(6); PG8_BAR;
    } else {
        PG8_STAGE(PG8_SB(0, 0), cB, voffB); PG8_STAGE(PG8_SA(0, 0), cA, voffA); PG8_STAGE(PG8_SB(0, 1), cB + hstep, voffB); PG8_STAGE(PG8_SA(0, 1), cA + hstep, voffA);
        if (wr == 1) PG8_BAR;
        PG8_WAIT_V(4); PG8_BAR;
        PG8_STAGE(PG8_SB(1, 0), cB + kstep, voffB); PG8_STAGE(PG8_SA(1, 0), cA + kstep, voffA); PG8_STAGE(PG8_SB(1, 1), cB + hstep + kstep, voffB);
        PG8_WAIT_V(6); PG8_BAR;
    }
    for (;;) {
        const bool has_next = S.next(ui + 1, nxt);
        const char* nA = has_next ? (const char*)g.A + (size_t)nxt.pm * tstep : cA; const char* nB = has_next ? (const char*)g.Bt + (size_t)nxt.pb * tstep : cB;
        for (int t = 0; t < nt; t += 2) {
            const bool last = (t == nt - 2);
            const char* a1 = cA + (size_t)(t + 1) * kstep;
            const char* a2 = last ? nA : cA + (size_t)(t + 2) * kstep; const char* b2 = last ? nB : cB + (size_t)(t + 2) * kstep;
            const char* a3 = a2 + kstep; const char* b3 = b2 + kstep;
            if (last && has_next) S.a_ready(nxt);
            if constexpr (SP2) {
            PG8_LDB(B0, 0, 0); PG8_LDB(B1, 0, 1); PG8_SCHED; PG8_LDA(At, 0, 0); PG8_STAGE(PG8_SA(1, 1), a1 + hstep, voffA);
            PG8_WAIT_V(8); PG8_WAIT_L(0); PG8_BAR; PG8_MMA(0, 0, At, B0); PG8_MMA(0, 1, At, B1); PG8_BAR; PG8_SCHED;
            PG8_LDA(At, 0, 1); PG8_STAGE(PG8_SB(0, 0), b2, voffB); PG8_STAGE(PG8_SB(0, 1), b2 + hstep, voffB); PG8_STAGE(PG8_SA(0, 0), a2, voffA);
            PG8_WAIT_V(8); PG8_WAIT_L(0); PG8_BAR; PG8_MMA(1, 0, At, B0); PG8_MMA(1, 1, At, B1); PG8_BAR; PG8_SCHED;
            PG8_LDB(B0, 1, 0); PG8_LDB(B1, 1, 1); PG8_SCHED; PG8_LDA(At, 1, 0); PG8_STAGE(PG8_SA(0, 1), a2 + hstep, voffA);
            PG8_WAIT_V(8); PG8_WAIT_L(0); PG8_BAR; PG8_MMA(0, 0, At, B0); PG8_MMA(0, 1, At, B1); PG8_BAR; PG8_SCHED;
            PG8_LDA(At, 1, 1); PG8_STAGE(PG8_SB(1, 0), b3, voffB); PG8_STAGE(PG8_SB(1, 1), b3 + hstep, voffB); PG8_STAGE(PG8_SA(1, 0), a3, voffA);
            PG8_WAIT_V(8); PG8_WAIT_L(0); PG8_BAR; PG8_MMA(1, 0, At, B0); PG8_MMA(1, 1, At, B1); PG8_BAR; PG8_SCHED;
            } else {
            PG8_LDB(B0, 0, 0); PG8_SCHED; PG8_LDA(At, 0, 0); PG8_STAGE(PG8_SA(1, 1), a1 + hstep, voffA);
            PG8_WAIT_L(8); PG8_BAR; PG8_WAIT_L(0); PG8_MMA(0, 0, At, B0); PG8_BAR; PG8_SCHED;
            PG8_LDB(B1, 0, 1); PG8_STAGE(PG8_SB(0, 0), b2, voffB);
            PG8_BAR; PG8_WAIT_L(0); PG8_MMA(0, 1, At, B1); PG8_BAR;
            PG8_LDA(At, 0, 1); PG8_STAGE(PG8_SA(0, 0), a2, voffA);
            PG8_BAR; PG8_WAIT_L(0); PG8_MMA(1, 0, At, B0); PG8_BAR; PG8_SCHED;
            PG8_STAGE(PG8_SB(0, 1), b2 + hstep, voffB);
            PG8_WAIT_V(6); PG8_BAR; PG8_MMA(1, 1, At, B1); PG8_BAR;
            PG8_LDB(B0, 1, 0); PG8_SCHED; PG8_LDA(At, 1, 0); PG8_STAGE(PG8_SA(0, 1), a2 + hstep, voffA);
            PG8_WAIT_L(8); PG8_BAR; PG8_WAIT_L(0); PG8_MMA(0, 0, At, B0); PG8_BAR; PG8_SCHED;
            PG8_LDB(B1, 1, 1); PG8_STAGE(PG8_SB(1, 0), b3, voffB);
            PG8_BAR; PG8_WAIT_L(0); PG8_MMA(0, 1, At, B1); PG8_BAR;
            PG8_LDA(At, 1, 1); PG8_STAGE(PG8_SA(1, 0), a3, voffA);
            PG8_BAR; PG8_WAIT_L(0); PG8_MMA(1, 0, At, B0); PG8_BAR; PG8_SCHED;
            PG8_STAGE(PG8_SB(1, 1), b3 + hstep, voffB);
            PG8_WAIT_V(6); PG8_BAR; PG8_MMA(1, 1, At, B1); PG8_BAR;
            }
        }
        if constexpr (ALIGN_EPI) { if (wr == 0) PG8_BAR; }
        asm volatile("s_nop 15\n\ts_nop 7" ::: "memory");
        if constexpr (!Epi::AFTER_DRAIN) { E(acc, cur, wr, wc, fr, fq); S.done(cur); }
        if (!has_next) break;
#pragma unroll
        for (int a = 0; a < 2; ++a)
#pragma unroll
            for (int b = 0; b < 2; ++b)
#pragma unroll
                for (int m = 0; m < 4; ++m)
#pragma unroll
                    for (int n = 0; n < 2; ++n) acc[a][b][m][n] = (f32x4){0.f, 0.f, 0.f, 0.f};
        cur = nxt; cA = nA; cB = nB; ++ui;
        if constexpr (ALIGN_EPI) { if (wr == 1) PG8_BAR; }
    }
    PG8_WAIT_V(0);
    if constexpr (!ALIGN_EPI) { if (wr == 0) PG8_BAR; }
    PG8_BAR;
    if constexpr (Epi::AFTER_DRAIN) { E.fused(acc, cur, wr, wc, fr, fq, lds, wid, lane); S.done(cur); }
#undef PG8_SA
#undef PG8_SB
#undef PG8_STAGE
#undef PG8_LDA
#undef PG8_LDB
#undef PG8_MMA
#undef PG8_WAIT_V
#undef PG8_WAIT_L
#undef PG8_BAR
#undef PG8_SCHED
}
}
#define GAS __attribute__((address_space(1)))
#define LAS __attribute__((address_space(3)))
typedef unsigned short bf16;
typedef unsigned v4u __attribute__((ext_vector_type(4)));
typedef float f32x4 __attribute__((ext_vector_type(4)));
typedef short bf16x8 __attribute__((ext_vector_type(8)));
typedef GAS unsigned gu32;
typedef GAS unsigned long long gu64;
#define RLX_AGENT __ATOMIC_RELAXED, __HIP_MEMORY_SCOPE_AGENT
#define LDS_WAIT() asm volatile("s_waitcnt lgkmcnt(0)" ::: "memory")
#define VM_WAIT() asm volatile("s_waitcnt vmcnt(0)" ::: "memory")
__device__ __forceinline__ unsigned long long rt() { return __builtin_amdgcn_s_memrealtime(); }
__device__ __forceinline__ unsigned f2bf(float f) { unsigned u = __builtin_bit_cast(unsigned, f); return (u + 0x7fffu + ((u >> 16) & 1u)) >> 16; }
__device__ __forceinline__ unsigned pk2(float lo, float hi) { return f2bf(lo) | (f2bf(hi) << 16); }

#define XB_TMO      128
#define XB_XCNT(j)  (256  + 64 * (j))
#define XB_XSUB(j)  (1280 + 64 * (j))
#define XB_XGEN(j)  (2304 + 64 * (j))
#define XB_TOP      3328
#define XB_TOPGEN   3392
#define XCD_BAR_WORDS 3456
#define XB_SPIN_CAP (1u << 18)

__device__ __forceinline__ unsigned xb_ld(unsigned* p)              { return __hip_atomic_load(p, __ATOMIC_RELAXED, __HIP_MEMORY_SCOPE_AGENT); }
__device__ __forceinline__ unsigned xb_add(unsigned* p, unsigned v) { return __hip_atomic_fetch_add(p, v, __ATOMIC_RELAXED, __HIP_MEMORY_SCOPE_AGENT); }
__device__ __forceinline__ unsigned xb_xcc_id() { return (unsigned)__builtin_amdgcn_s_getreg((3 << 11) | 20) & 0xFu; }
#define XB_SPIN(cond, bar) do { unsigned _sp = 0; while (cond) { __builtin_amdgcn_s_sleep(1); \
    if ((++_sp & 255u) == 0u) { if (xb_ld(&(bar)[XB_TMO])) break; if (_sp > XB_SPIN_CAP) { atomicAdd(&(bar)[XB_TMO], 1u); break; } } } } while (0)

struct XcdBarrier {
    unsigned* bar; unsigned x;
    volatile LAS unsigned* st;
};

__device__ __forceinline__ XcdBarrier xcd_barrier_post(unsigned* bar, volatile LAS unsigned* st) {
    XcdBarrier b; b.bar = bar; b.x = xb_xcc_id(); b.st = st;
    if (threadIdx.x == 0) (void)xb_add(&bar[XB_XCNT(b.x)], 1u);
    return b;
}
__device__ __forceinline__ void xcd_barrier_complete(unsigned* bar, unsigned x, unsigned& nloc, unsigned& nx) {
    const unsigned G = gridDim.x * gridDim.y * gridDim.z;
    unsigned sum, cnt, mine, sp = 0u;
    for (;;) {
        sum = 0u; cnt = 0u; mine = 0u;
#pragma unroll
        for (unsigned j = 0; j < 16; ++j) { const unsigned c = xb_ld(&bar[XB_XCNT(j)]); sum += c; cnt += (c > 0u) ? 1u : 0u; mine = (j == x) ? c : mine; }
        if (sum == G) break;
        __builtin_amdgcn_s_sleep(1);
        if ((++sp & 255u) == 0u) { if (xb_ld(&bar[XB_TMO])) break; if (sp > XB_SPIN_CAP) { atomicAdd(&bar[XB_TMO], 1u); break; } }
    }
    nloc = mine > 0u ? mine : 1u; nx = cnt > 0u ? cnt : 1u;
}

__device__ __forceinline__ void xcd_barrier(const XcdBarrier& b) {
    asm volatile("s_waitcnt vmcnt(0)" ::: "memory");
    __syncthreads();
    if (threadIdx.x == 0) {
        unsigned* bar = b.bar;
        __builtin_amdgcn_s_waitcnt(0);
        unsigned nloc = b.st[0], nx = b.st[1];
        if (nloc == 0u) { xcd_barrier_complete(bar, b.x, nloc, nx); b.st[0] = nloc; b.st[1] = nx; }
        const unsigned old = xb_add(&bar[XB_XSUB(b.x)], 1u);
        const unsigned gen = old / nloc;
        if (old + 1u == (gen + 1u) * nloc) {
            __builtin_amdgcn_fence(__ATOMIC_RELEASE, "agent");
            asm volatile("s_waitcnt vmcnt(0)" ::: "memory");
            const unsigned og = xb_add(&bar[XB_TOP], 1u);
            const unsigned tg = og / nx;
            if (og + 1u == (tg + 1u) * nx) xb_add(&bar[XB_TOPGEN], 1u);
            else XB_SPIN(xb_ld(&bar[XB_TOPGEN]) == tg, bar);
            __builtin_amdgcn_fence(__ATOMIC_ACQUIRE, "agent");
            xb_add(&bar[XB_XGEN(b.x)], 1u);
            asm volatile("s_waitcnt vmcnt(0)" ::: "memory");
        } else {
            XB_SPIN(xb_ld(&bar[XB_XGEN(b.x)]) == gen, bar);
            __builtin_amdgcn_fence(__ATOMIC_ACQUIRE, "agent");
            asm volatile("s_waitcnt vmcnt(0)" ::: "memory");
        }
    }
    __syncthreads();
}
namespace mk {
constexpr int S = 8192, D = 2048, NPROJ = 6160, NPP = 6144, NPAD = 6400, NE = 32, FF = 2048, NWAVES = 8, NTHR = 512;
constexpr int C_MQ = 0, C_MK = 512, C_MV = 1024, C_MO = 2048, C_FQ = 3072, C_FK = 4096, C_FV = 5120;
constexpr int MAXROWS = S * 4 + NE * 256;
constexpr int NCH = 128, LCH = 64;
constexpr size_t MiB = 1u << 20;
constexpr size_t WS_CTL = 0, CTL_ZERO_BYTES = 1 * MiB;
constexpr size_t WS_MODP = 14 * MiB;
constexpr size_t WS_MOD = 2 * MiB;
constexpr size_t WS_GATES = 3 * MiB;
constexpr size_t WS_F = 4 * MiB;
constexpr size_t WS_NL = 5 * MiB;
constexpr size_t WS_NS = 6 * MiB;
constexpr size_t WS_GLAL = 7 * MiB;
constexpr size_t WS_MS = 7 * MiB + 65536;
constexpr size_t WS_TOPI = 8 * MiB;
constexpr size_t WS_TOPW = 9 * MiB;
constexpr size_t WS_HIST = 10 * MiB;
constexpr size_t WS_LRANK = 11 * MiB;
constexpr size_t WS_POS = 12 * MiB;
constexpr size_t WS_ROWW = 13 * MiB;
constexpr size_t WS_WIN = 16 * MiB;
constexpr size_t WS_WOUT = 42 * MiB;
constexpr size_t WS_HN = 50 * MiB;
constexpr size_t WS_PROJ = 82 * MiB;
constexpr size_t WS_UL = 178 * MiB;
constexpr size_t WS_CS = 242 * MiB;
constexpr size_t WS_CONCAT = 274 * MiB;
constexpr size_t WS_H1 = 306 * MiB;
constexpr size_t WS_XG = 370 * MiB;
constexpr size_t WS_ACT = 530 * MiB;
constexpr size_t WS_Y = 690 * MiB;
constexpr size_t WS_WUG = 850 * MiB;
constexpr size_t WS_WD = 1362 * MiB;
constexpr size_t WS_OPART = 1618 * MiB;
constexpr size_t WS_MLP = 1786 * MiB;
constexpr size_t WS_JLO = 1789 * MiB;
constexpr size_t WS_END = 1790 * MiB;
constexpr size_t WS_NAIVE = 1792 * MiB;
constexpr int CW_TMO = 0, CW_CODE = 1, CW_CONV = 65536, CW_DONE = 2048, CW_BAR = 4096;
constexpr int GC_INPROJ = 160, GC_ATTN = 160, GC_PREP = 192;
constexpr int RING_OFF = 0, RING_BYTES = 131072;
constexpr int LDSCTL_OFF = RING_BYTES, MISC_OFF = LDSCTL_OFF + 320;
constexpr int TAB_OFF = LDSCTL_OFF + 1024;
constexpr int ATT_CH = 16;
constexpr int LDS_BYTES = 147456;
}
namespace mk {
typedef float f32x2 __attribute__((ext_vector_type(2)));
typedef unsigned u32x2 __attribute__((ext_vector_type(2)));
struct Frame {
    LAS unsigned char* lds;
    volatile LAS unsigned* MISC;
    gu32* ctl;
    int tid, lane, wave, vcu, G, bid;
    const float* in[24];
    float* out; unsigned char* ws;
};
#define IN_X 0
#define IN_C 1
#define IN_WADA 2
#define IN_BADA 3
#define IN_NMIX 4
#define IN_WIN 5
#define IN_BI 6
#define IN_BF 7
#define IN_FOXBF 8
#define IN_FOXQN 9
#define IN_FOXKN 10
#define IN_MOUTN 11
#define IN_FOUTN 12
#define IN_WOUT 13
#define IN_NFFN 14
#define IN_WR 15
#define IN_BR 16
#define IN_WUG 17
#define IN_BUG 18
#define IN_WD 19
#define IN_BD 20
#define IN_WAF 21
#define IN_BAF 22
#define IN_NFIN 23
template <class T> __device__ __forceinline__ T* wsp(const Frame& F, size_t off) { return (T*)(F.ws + off); }
__device__ __forceinline__ float wave_sum(float v) {
#pragma unroll
    for (int o = 1; o < 64; o <<= 1) v += __shfl_xor(v, o);
    return v;
}
__device__ __forceinline__ float sigmoid_f(float v) { return 1.f / (1.f + __expf(-v)); }
__device__ __forceinline__ float log_sigmoid_f(float v) { return fminf(v, 0.f) - log1pf(__expf(-fabsf(v))); }
__device__ __forceinline__ float softcap_f(float v) { return 15.f * tanhf(v * (1.f / 15.f)); }
__device__ __forceinline__ float bf2f(unsigned short b) { return __uint_as_float(((unsigned)b) << 16); }

struct CvtItem { const float* src; bf16* dst; };
__device__ __forceinline__ void cvt_load(const CvtItem& it, int ldw, f32x4 (&v)[16], int lane) {
    const float* p = it.src + (size_t)((lane >> 4) * 16) * ldw + (lane & 15) * 4;
#pragma unroll
    for (int i = 0; i < 16; ++i) v[i] = __builtin_nontemporal_load((const GAS f32x4*)(p + (size_t)i * ldw));
}
__device__ __forceinline__ void cvt_store(const CvtItem& it, int K, const f32x4 (&v)[16], LAS unsigned char* scr, int lane) {
    const int c = lane & 15, g = lane >> 4;
#pragma unroll
    for (int j = 0; j < 4; ++j) {
        v4u a, b;
        a.x = pk2(v[0][j], v[1][j]); a.y = pk2(v[2][j], v[3][j]); a.z = pk2(v[4][j], v[5][j]); a.w = pk2(v[6][j], v[7][j]);
        b.x = pk2(v[8][j], v[9][j]); b.y = pk2(v[10][j], v[11][j]); b.z = pk2(v[12][j], v[13][j]); b.w = pk2(v[14][j], v[15][j]);
        LAS unsigned char* q = scr + (4 * c + j) * 144 + 32 * g;
        *(LAS v4u*)q = a; *(LAS v4u*)(q + 16) = b; }
    LDS_WAIT(); asm volatile("" ::: "memory");
#pragma unroll
    for (int i = 0; i < 8; ++i) { const int row = (lane >> 3) + 8 * i; const v4u o = *(const LAS v4u*)(scr + row * 144 + (lane & 7) * 16);
        *(GAS v4u*)(it.dst + (size_t)row * K + (lane & 7) * 8) = o; }
    LDS_WAIT(); asm volatile("" ::: "memory");
}
__device__ __forceinline__ unsigned pk4_fp8(float a, float b, float c, float d) { int r = __builtin_amdgcn_cvt_pk_fp8_f32(a, b, 0, false); r = __builtin_amdgcn_cvt_pk_fp8_f32(c, d, r, true); return (unsigned)r; }
constexpr float W8S = 128.f;
__device__ __forceinline__ void cvt8_pack(const f32x4 (&v)[16], LAS unsigned char* scr, int half, int lane) {
    const int c = lane & 15, g = lane >> 4;
#pragma unroll
    for (int j = 0; j < 4; ++j) { v4u a;
        a.x = pk4_fp8(v[0][j] * W8S, v[1][j] * W8S, v[2][j] * W8S, v[3][j] * W8S); a.y = pk4_fp8(v[4][j] * W8S, v[5][j] * W8S, v[6][j] * W8S, v[7][j] * W8S);
        a.z = pk4_fp8(v[8][j] * W8S, v[9][j] * W8S, v[10][j] * W8S, v[11][j] * W8S); a.w = pk4_fp8(v[12][j] * W8S, v[13][j] * W8S, v[14][j] * W8S, v[15][j] * W8S);
        *(LAS v4u*)(scr + (4 * c + j) * 144 + half * 64 + 16 * g) = a; }
}
__device__ __forceinline__ void cvt8_flush(unsigned char* dst, int kbytes, LAS unsigned char* scr, int lane) {
    LDS_WAIT(); asm volatile("" ::: "memory");
#pragma unroll
    for (int i = 0; i < 8; ++i) { const int row = (lane >> 3) + 8 * i; const v4u o = *(const LAS v4u*)(scr + row * 144 + (lane & 7) * 16);
        __builtin_nontemporal_store(o, (GAS v4u*)(dst + (size_t)row * kbytes + (lane & 7) * 16)); }
    LDS_WAIT(); asm volatile("" ::: "memory");
}
constexpr int CV8_UG = NE * 16 * 64, CV8_D = NE * 16 * 32, CV8_TOTAL = CV8_UG + CV8_D;
struct Cvt8Item { const float* src; unsigned char* dst; int ldw; };
__device__ __forceinline__ Cvt8Item cvt8_item(const Frame& F, int it, int half) {
    Cvt8Item r;
    if (it < CV8_UG) { const int e = it >> 10, q = it & 1023, kb = q >> 6, nb = q & 63, d0 = nb * 64, j = d0 >> 8, wv = d0 & 255, sc = wv < 128 ? 128 * j + wv : 2048 + 128 * j + (wv - 128);
        r.ldw = 4096; r.src = F.in[IN_WUG] + (size_t)e * D * 4096 + (size_t)(kb * 128 + half * 64) * 4096 + sc; r.dst = wsp<unsigned char>(F, WS_WUG) + (size_t)e * 4096 * D + (size_t)d0 * D + kb * 128; return r; }
    it -= CV8_UG;
    { const int e = it >> 9, q = it & 511, kb = q >> 5, nb = q & 31;
        r.ldw = D; r.src = F.in[IN_WD] + (size_t)e * FF * D + (size_t)(kb * 128 + half * 64) * D + nb * 64; r.dst = wsp<unsigned char>(F, WS_WD) + (size_t)e * D * FF + (size_t)(nb * 64) * FF + kb * 128; return r; }
}
__device__ __forceinline__ void cvt8_load(const Cvt8Item& it, f32x4 (&v)[16], int lane) {
    const float* p = it.src + (size_t)((lane >> 4) * 16) * it.ldw + (lane & 15) * 4;
#pragma unroll
    for (int i = 0; i < 16; ++i) v[i] = __builtin_nontemporal_load((const GAS f32x4*)(p + (size_t)i * it.ldw));
}
constexpr int CV_IN = 32 * 96, CV_OUT = 32 * 32, CV_TOTAL = CV_IN + CV_OUT;
__device__ __forceinline__ CvtItem cvt_item(const Frame& F, int it, int& ldw, int& K) {
    CvtItem r;
    if (it < CV_IN) { const int kb = it / 96, nb = it % 96, d0 = nb * 64, sc = d0 < 3072 ? d0 : d0 + 8;
        ldw = NPROJ; K = D; r.src = F.in[IN_WIN] + (size_t)(kb * 64) * NPROJ + sc; r.dst = wsp<bf16>(F, WS_WIN) + (size_t)d0 * D + kb * 64; return r; }
    it -= CV_IN;
    { const int kb = it >> 5, nb = it & 31; ldw = D; K = D; r.src = F.in[IN_WOUT] + (size_t)(kb * 64) * D + nb * 64; r.dst = wsp<bf16>(F, WS_WOUT) + (size_t)(nb * 64) * D + kb * 64; return r; }
}
__device__ __forceinline__ void p0_gemv(Frame& F) {
    const int gw = F.vcu * NWAVES + F.wave, NGW = F.G * NWAVES, lane = F.lane;
    {
        const float* c = F.in[IN_C]; float* modp = wsp<float>(F, WS_MODP);
        for (int task = gw; task < 2048; task += NGW) {
            const int cg = task & 63, ks = task >> 6, j = cg * 256 + 4 * lane;
            const float* w; int ld, col;
            if (j < 6 * D) { w = F.in[IN_WADA]; ld = 6 * D; col = j; } else { w = F.in[IN_WAF]; ld = 2 * D; col = j - 6 * D; }
            const float c0 = c[ks * 64 + lane]; const float s0 = c0 * sigmoid_f(c0);
            const float* wp = w + (size_t)(ks * 64) * ld + col; f32x4 acc = {0.f, 0.f, 0.f, 0.f};
#pragma unroll 16
            for (int i = 0; i < 64; ++i) acc += __builtin_nontemporal_load((const GAS f32x4*)(wp + (size_t)i * ld)) * __builtin_bit_cast(float, __builtin_amdgcn_readlane(__builtin_bit_cast(int, s0), i));
            *(GAS f32x4*)(modp + ks * 16384 + j) = acc;
        }
    }
    {
        bf16* win_t = wsp<bf16>(F, WS_WIN);
        for (int i2 = gw; i2 < D / 4; i2 += NGW) {
            const int col = lane & 15, k = 4 * i2 + (lane >> 4), sc = col < 8 ? 3072 + col : 6152 + (col - 8);
            win_t[(size_t)(NPP + col) * D + k] = (bf16)f2bf(F.in[IN_WIN][(size_t)k * NPROJ + sc]); }
        const v4u z = {0u, 0u, 0u, 0u};
        for (int i = gw * 64 + lane; i < 16 * D / 8; i += NGW * 64) *(GAS v4u*)(win_t + (size_t)NPROJ * D + (size_t)i * 8) = z;
    }
}
constexpr int CV8_NSH = 32, CV8_SHA = CV8_UG / CV8_NSH, CV8_SHB = CV8_D / CV8_NSH;
#define CONV_NEXT(var) do { var = CV8_TOTAL; \
        if (useA) { const int b_ = __builtin_amdgcn_readfirstlane((int)(lane == 0 ? __hip_atomic_fetch_add(ctrA, 1u, RLX_AGENT) : 0u)); if (b_ < CV8_SHA) var = xs * CV8_SHA + b_; else useA = false; } \
        if (var == CV8_TOTAL && useB) { const int b_ = __builtin_amdgcn_readfirstlane((int)(lane == 0 ? __hip_atomic_fetch_add(ctrB, 1u, RLX_AGENT) : 0u)); if (b_ < CV8_SHB) var = CV8_UG + xs * CV8_SHB + b_; else useB = false; } } while (0)
__device__ __forceinline__ void conv_worker(Frame& F, gu32* stop, unsigned target, int which) {
    LAS unsigned char* scr = F.lds + RING_OFF + F.wave * 9216; const int lane = F.lane, xs = (int)(blockIdx.x & (CV8_NSH - 1));
    gu32* ctrA = F.ctl + CW_CONV + 64 * xs; gu32* ctrB = F.ctl + CW_CONV + 64 * (CV8_NSH + xs);
    bool useA = which != 2, useB = which != 1;
    int it; CONV_NEXT(it); if (it >= CV8_TOTAL) return;
    f32x4 va[16], vb[16];
    Cvt8Item cur = cvt8_item(F, it, 0); cvt8_load(cur, va, lane);
    for (;;) {
        const Cvt8Item c1 = cvt8_item(F, it, 1); cvt8_load(c1, vb, lane);
        bool stopnow = false;
        if (stop) stopnow = (unsigned)__builtin_amdgcn_readfirstlane((int)__hip_atomic_load(stop, RLX_AGENT)) >= target;
        int itn = CV8_TOTAL; if (!stopnow) CONV_NEXT(itn);
        cvt8_pack(va, scr, 0, lane);
        const bool more = itn < CV8_TOTAL; Cvt8Item nx = cur;
        if (more) { nx = cvt8_item(F, itn, 0); cvt8_load(nx, va, lane); }
        cvt8_pack(vb, scr, 1, lane);
        cvt8_flush(cur.dst, D, scr, lane);
        if (!more) break;
        cur = nx; it = itn;
    }
}
__device__ __forceinline__ bool enter_group(Frame& F, int Gc) {
    if (F.G != 256 || Gc >= 256) return true;
    const int bx = (int)blockIdx.x, slot = bx >> 3, xcd = bx & 7, per = Gc >> 3;
    if (slot >= per) return false;
    F.vcu = xcd * per + slot; F.bid = slot * 8 + xcd; F.G = Gc; return true;
}
__device__ __forceinline__ void leave_group(Frame& F) { const int bx = (int)blockIdx.x, G = (int)gridDim.x; F.G = G; F.bid = bx; F.vcu = (G % 8 == 0) ? (bx % 8) * (G / 8) + bx / 8 : bx; }
__device__ __forceinline__ void p1_convert(Frame& F) {
    const int gw = F.vcu * NWAVES + F.wave, NGW = F.G * NWAVES, lane = F.lane;
    {
        LAS unsigned char* scr = F.lds + RING_OFF + F.wave * 9216;
        int it = gw;
        if (it < CV_TOTAL) {
            int ldw, K; CvtItem cur = cvt_item(F, it, ldw, K); f32x4 va[16], vb[16];
            cvt_load(cur, ldw, va, lane);
            for (;;) {
                int itn = it + NGW; int ldn = 0, Kn = 0; CvtItem nx = cur; const bool more = itn < CV_TOTAL;
                if (more) { nx = cvt_item(F, itn, ldn, Kn); cvt_load(nx, ldn, vb, lane); }
                cvt_store(cur, K, va, scr, lane);
                if (!more) break;
                it = itn + NGW; const bool more2 = it < CV_TOTAL; CvtItem n2 = nx; int ld2 = 0, K2 = 0;
                if (more2) { n2 = cvt_item(F, it, ld2, K2); cvt_load(n2, ld2, va, lane); }
                cvt_store(nx, Kn, vb, scr, lane);
                if (!more2) break;
                cur = n2; K = K2;
            }
        }
    }
}
__device__ __forceinline__ void mod_reduce_lds(Frame& F, int j0, int n, LAS float* dst) {
    const float* modp = wsp<float>(F, WS_MODP);
    for (int i = F.tid; i < n; i += NTHR) { const int j = j0 + i; float a = j < 6 * D ? F.in[IN_BADA][j] : F.in[IN_BAF][j - 6 * D];
#pragma unroll
        for (int ks = 0; ks < 32; ++ks) a += modp[ks * 16384 + j];
        dst[i] = a; }
}
__device__ __forceinline__ void modulate_row_bf16(const float* xrow, const float* g, const LAS float* sh, const LAS float* sc, bf16* orow, int lane) {
    const GAS f32x4* xr = (const GAS f32x4*)xrow + lane; f32x4 v[8]; float s2 = 0.f;
#pragma unroll
    for (int j = 0; j < 8; ++j) { v[j] = xr[64 * j]; s2 += (v[j].x * v[j].x + v[j].y * v[j].y) + (v[j].z * v[j].z + v[j].w * v[j].w); }
    const float r = rsqrtf(wave_sum(s2) * (1.f / D) + 1e-6f);
    GAS u32x2* o8 = (GAS u32x2*)orow + lane;
#pragma unroll
    for (int j = 0; j < 8; ++j) { const int c0 = 4 * lane + 256 * j; const f32x4 gg = *(const GAS f32x4*)(g + c0); const f32x4 a = *(const LAS f32x4*)(sc + c0), b = *(const LAS f32x4*)(sh + c0);
        const f32x4 y = v[j] * r * gg * (a + 1.f) + b; u32x2 w; w.x = pk2(y.x, y.y); w.y = pk2(y.z, y.w); o8[64 * j] = w; }
}
typedef float f32x16 __attribute__((ext_vector_type(16)));
typedef short s16x8g __attribute__((ext_vector_type(8)));
__device__ __forceinline__ void p1_modulate(Frame& F) {
    LAS float* shs = (LAS float*)(F.lds + RING_OFF + 81920);
    LAS float* gred = (LAS float*)(F.lds + RING_OFF + 98304);
    mod_reduce_lds(F, 0, 2 * D, shs);
    if (F.tid < 64) {
        const float* modp = wsp<float>(F, WS_MODP); float* mod = wsp<float>(F, WS_MOD);
        for (int j = blockIdx.x * 64 + F.tid; j < 16384; j += F.G * 64) { float a = j < 6 * D ? F.in[IN_BADA][j] : F.in[IN_BAF][j - 6 * D];
#pragma unroll
            for (int ks = 0; ks < 32; ++ks) a += modp[ks * 16384 + j];
            mod[j] = a; }
    }
    __syncthreads();
    bf16* hn = wsp<bf16>(F, WS_HN); const bf16* wg = wsp<bf16>(F, WS_WIN) + (size_t)NPP * D; float* gates = wsp<float>(F, WS_GATES);
    const int lane = F.lane, w = F.wave, hi = lane >> 5, l31 = lane & 31;
    for (int rb = F.vcu; rb < S / 32; rb += F.G) {
        const int row0 = rb * 32;
#pragma unroll 1
        for (int i = 0; i < 4; ++i) { const int m = row0 + 4 * w + i; asm volatile("" ::: "memory"); modulate_row_bf16(F.in[IN_X] + (size_t)m * D, F.in[IN_NMIX], shs, shs + D, hn + (size_t)m * D, lane); }
        asm volatile("s_waitcnt vmcnt(0)" ::: "memory");
        __syncthreads();
        f32x16 acc;
#pragma unroll
        for (int r = 0; r < 16; ++r) acc[r] = 0.f;
        const bf16* ap = hn + (size_t)(row0 + l31) * D + 256 * w + 8 * hi; const bf16* bp = wg + (size_t)l31 * D + 256 * w + 8 * hi;
#pragma unroll
        for (int ks = 0; ks < 16; ++ks) { const s16x8g a = *(const GAS s16x8g*)(ap + 16 * ks), b = *(const GAS s16x8g*)(bp + 16 * ks); acc = __builtin_amdgcn_mfma_f32_32x32x16_bf16(a, b, acc, 0, 0, 0); }
        if (l31 < 16) {
#pragma unroll
            for (int r = 0; r < 16; ++r) gred[(w * 32 + (r & 3) + 8 * (r >> 2) + 4 * hi) * 16 + l31] = acc[r]; }
        __syncthreads();
        { const int row = F.tid >> 4, n = F.tid & 15; float s = 0.f;
#pragma unroll
            for (int q = 0; q < 8; ++q) s += gred[(q * 32 + row) * 16 + n];
            gates[(size_t)(row0 + row) * 16 + n] = s; }
        __syncthreads();
    }
    p1_convert(F);
}
using pg8::Unit; using pg8::cvt_pk_bf16;
struct EpiProj {
    static constexpr bool PERM = true, AFTER_DRAIN = false;
    bf16* O;
    __device__ __forceinline__ void operator()(const pg8::f32x4 (&acc)[2][2][4][2], const Unit& u, int wr, int wc, int fr, int fq) const {
        const int row0 = u.pm * 256 + wr * 64 + fr, col0 = u.pn * 256 + wc * 32 + 8 * fq;
#pragma unroll
        for (int ai = 0; ai < 2; ++ai)
#pragma unroll
            for (int m = 0; m < 4; ++m) { bf16* rowp = O + (size_t)(row0 + ai * 128 + m * 16) * NPP + col0;
#pragma unroll
                for (int bj = 0; bj < 2; ++bj) { const pg8::f32x4 v0 = acc[ai][bj][m][0], v1 = acc[ai][bj][m][1];
                    pg8::u32x4 w; w.x = cvt_pk_bf16(v0[0], v0[1]); w.y = cvt_pk_bf16(v0[2], v0[3]); w.z = cvt_pk_bf16(v1[0], v1[1]); w.w = cvt_pk_bf16(v1[2], v1[3]);
                    *(pg8::u32x4*)(rowp + bj * 128) = w; } }
    }
};
struct EpiOut {
    static constexpr bool PERM = false, AFTER_DRAIN = false;
    const float* x; const float* g1; float* h1;
    __device__ __forceinline__ void operator()(const pg8::f32x4 (&acc)[2][2][4][2], const Unit& u, int wr, int wc, int fr, int fq) const {
        const int row0 = u.pm * 256 + wr * 64 + fr, col0 = u.pn * 256 + wc * 32 + 4 * fq;
        pg8::f32x4 gv[2][2];
#pragma unroll
        for (int bj = 0; bj < 2; ++bj)
#pragma unroll
            for (int n = 0; n < 2; ++n) gv[bj][n] = *(const pg8::f32x4*)(g1 + col0 + bj * 128 + n * 16);
#pragma unroll
        for (int ai = 0; ai < 2; ++ai)
#pragma unroll
            for (int m = 0; m < 4; ++m) { const size_t off = (size_t)(row0 + ai * 128 + m * 16) * D + col0;
#pragma unroll
                for (int bj = 0; bj < 2; ++bj)
#pragma unroll
                    for (int n = 0; n < 2; ++n) { const pg8::f32x4 xv = *(const pg8::f32x4*)(x + off + bj * 128 + n * 16);
                        *(pg8::f32x4*)(h1 + off + bj * 128 + n * 16) = xv + gv[bj][n] * acc[ai][bj][m][n]; } }
    }
};
}
namespace fox {
constexpr int D = 128, SQ = 8192, SKV = 8192; constexpr float THR = 8.f; constexpr bool WSKIP = false;
constexpr int PITCH = 6144;
constexpr int OPITCH = 2048;
constexpr float SCALE = 0.08838834764831845f;
constexpr int NW = 8, QBLK = 32, KVBLK = 64, QB = NW * QBLK;
constexpr int SHM_V = KVBLK * D * 2, SHM_K = KVBLK * D * 2;
constexpr int LDS_BIAS = 2 * SHM_V + 2 * SHM_K + NW * 64 * 4;
constexpr int LDS_BYTES = LDS_BIAS + 512;

using bf16 = __hip_bfloat16;
typedef short bf16x8 __attribute__((ext_vector_type(8)));
typedef short s16x4 __attribute__((ext_vector_type(4)));
typedef float f32x16 __attribute__((ext_vector_type(16)));
typedef float f32x4 __attribute__((ext_vector_type(4)));
typedef unsigned u32x4 __attribute__((ext_vector_type(4)));
template <class A, class Bt> struct same_t { static constexpr bool v = false; };
template <class A> struct same_t<A, A> { static constexpr bool v = true; };

#define KSWZ(row, colB) ((row) * 256 + ((colB) ^ (((row) & 7) << 4)))
#define SBAR() __builtin_amdgcn_sched_barrier(0)
__device__ __forceinline__ int v_st(int k, int c) { const int kk = (k & ~0xC) | ((k & 4) << 1) | ((k & 8) >> 1); return ((kk >> 3) * 4 + (c >> 5)) * 512 + ((kk & 7) * 32 + (c & 31)) * 2; }
__device__ __forceinline__ int v_rd_base(int lane) { return ((lane & 3) << 3) | (((lane >> 2) & 3) << 6) | (((lane >> 4) & 1) << 5) | (((lane >> 5) & 1) << 8); }
constexpr int v_rd_off(int d0, int ks, int half) { return d0 * 512 + ks * 4096 + half * 2048; }
__device__ __forceinline__ int crow(int r, int hi) { return (r & 3) + 8 * (r >> 2) + 4 * hi; }
__device__ __forceinline__ int bias_slot(int kk) { return ((kk >> 2) & 1) * 32 + (kk >> 5) * 16 + (kk & 3) + 4 * ((kk & 31) >> 3); }
__device__ __forceinline__ unsigned cvtpk(float lo, float hi) {
    unsigned r; asm volatile("v_cvt_pk_bf16_f32 %0, %1, %2" : "=v"(r) : "v"(lo), "v"(hi)); return r;
}
__device__ __forceinline__ bf16x8 pack8(f32x4 a, f32x4 b) {
    u32x4 w = {cvtpk(a[0], a[1]), cvtpk(a[2], a[3]), cvtpk(b[0], b[1]), cvtpk(b[2], b[3])};
    return *reinterpret_cast<bf16x8*>(&w);
}
template <class T> __device__ __forceinline__ bf16x8 load8(const T* p) {
    if constexpr (same_t<T, float>::v) { return pack8(*(const f32x4*)p, *(const f32x4*)(p + 4)); }
    else { return *reinterpret_cast<const bf16x8*>(p); }
}
__device__ __forceinline__ void mask_tile(f32x16& p0, f32x16& p1, int dq, unsigned W) {
    const float NEG = -__builtin_inff();
#pragma unroll
    for (int r = 0; r < 16; ++r) {
        const int c = (r & 3) + 8 * (r >> 2);
        if ((unsigned)(dq - c) >= W) p0[r] = NEG;
        if ((unsigned)(dq - c - 32) >= W) p1[r] = NEG;
    }
}
__device__ __forceinline__ void partialSM(f32x16& p0, f32x16& p1, float& m_reg, float& mn, float& alpha) {
    float pmax = p0[0]; for (int r = 1; r < 16; ++r) pmax = fmaxf(pmax, p0[r]); for (int r = 0; r < 16; ++r) pmax = fmaxf(pmax, p1[r]);
    { auto rr = __builtin_amdgcn_permlane32_swap(__float_as_uint(pmax), __float_as_uint(pmax), false, false);
      pmax = fmaxf(__uint_as_float(rr[0]), __uint_as_float(rr[1])); }
    constexpr float C2 = 1.4426950408889634f * SCALE;
    if (__builtin_expect(__all((pmax - m_reg) * SCALE <= THR), 1)) { mn = m_reg; alpha = 1.f; }
    else { mn = fmaxf(m_reg, pmax); alpha = __builtin_amdgcn_exp2f((m_reg - mn) * C2); m_reg = mn; }
    const float mnL = -mn * C2;
    for (int r = 0; r < 16; ++r) p0[r] = fmaf(p0[r], C2, mnL); for (int r = 0; r < 16; ++r) p1[r] = fmaf(p1[r], C2, mnL);
    for (int r = 0; r < 16; ++r) p0[r] = __builtin_amdgcn_exp2f(p0[r]);
}
__device__ __forceinline__ void finishSM(f32x16& p0, f32x16& p1, float alpha, float& l_reg, bf16x8& pa0, bf16x8& pa1, bf16x8& pa2, bf16x8& pa3) {
    for (int r = 0; r < 16; ++r) p1[r] = __builtin_amdgcn_exp2f(p1[r]);
    float ps = 0; for (int r = 0; r < 16; ++r) ps += p0[r]; for (int r = 0; r < 16; ++r) ps += p1[r];
    { auto rr = __builtin_amdgcn_permlane32_swap(__float_as_uint(ps), __float_as_uint(ps), false, false);
      ps = __uint_as_float(rr[0]) + __uint_as_float(rr[1]); }
    l_reg = l_reg * alpha + ps;
#define PK4(P, B_, OUT) do { unsigned a0 = cvtpk(P[B_+0], P[B_+1]), a1 = cvtpk(P[B_+2], P[B_+3]);                          \
        unsigned b0 = cvtpk(P[B_+4], P[B_+5]), b1 = cvtpk(P[B_+6], P[B_+7]);                                             \
        auto r0 = __builtin_amdgcn_permlane32_swap(a0, b0, false, false); auto r1 = __builtin_amdgcn_permlane32_swap(a1, b1, false, false); \
        u32x4 w = {r0[0], r1[0], r0[1], r1[1]}; OUT = *reinterpret_cast<bf16x8*>(&w); } while (0)
    PK4(p0, 0, pa0); PK4(p0, 8, pa1); PK4(p1, 0, pa2); PK4(p1, 8, pa3);
#undef PK4
}
template <int KB, bool SK>
__device__ __forceinline__ void qkt(f32x16& p0, f32x16& p1, const char* K_lds, int r32, int hi, const bf16x8* qr, bool act) {
    if (SK && !act) { const float NEG = -__builtin_inff();
#pragma unroll
        for (int r = 0; r < 16; ++r) { p0[r] = NEG; p1[r] = NEG; } return; }
    { const f32x16* bp = reinterpret_cast<const f32x16*>(K_lds - 2 * SHM_V + LDS_BIAS + KB * 256 + hi * 128); p0 = bp[0]; p1 = bp[1]; }
    const char* kb[4];
#pragma unroll
    for (int dd = 0; dd < 4; ++dd) kb[dd] = K_lds + KB * SHM_K + KSWZ(r32, (dd * 16 + hi * 8) * 2);
#pragma unroll
    for (int d0 = 0; d0 < 8; ++d0) { const char* a = kb[d0 & 3] + (d0 >> 2) * 128;
        bf16x8 b0 = *reinterpret_cast<const bf16x8*>(a);
        bf16x8 b1 = *reinterpret_cast<const bf16x8*>(a + 32 * 256);
        p0 = __builtin_amdgcn_mfma_f32_32x32x16_bf16(b0, qr[d0], p0, 0, 0, 0);
        p1 = __builtin_amdgcn_mfma_f32_32x32x16_bf16(b1, qr[d0], p1, 0, 0, 0); }
}
template <int VB, bool SK>
__device__ __forceinline__ void pv_tile(f32x16* o, int vb0, bf16x8 pa0, bf16x8 pa1, bf16x8 pa2, bf16x8 pa3, bool act) {
    if (SK && !act) return;
#define TRRD(dst, off) asm volatile("ds_read_b64_tr_b16 %0, %1 offset:%2" : "=&v"(dst) : "v"(vb0), "i"(off) : "memory")
#define PV_D0(d0) do { s16x4 l0, l1, l2, l3, h0, h1, h2, h3; constexpr int b_ = VB * SHM_V + v_rd_off(d0, 0, 0);     \
        TRRD(l0, b_); TRRD(h0, b_ + 2048); TRRD(l1, b_ + 4096); TRRD(h1, b_ + 6144); TRRD(l2, b_ + 8192); TRRD(h2, b_ + 10240); TRRD(l3, b_ + 12288); TRRD(h3, b_ + 14336); \
        asm volatile("s_waitcnt lgkmcnt(0)" ::: "memory"); SBAR();                 \
        o[d0] = __builtin_amdgcn_mfma_f32_32x32x16_bf16(pa0, (bf16x8){l0[0], l0[1], l0[2], l0[3], h0[0], h0[1], h0[2], h0[3]}, o[d0], 0, 0, 0);   \
        o[d0] = __builtin_amdgcn_mfma_f32_32x32x16_bf16(pa1, (bf16x8){l1[0], l1[1], l1[2], l1[3], h1[0], h1[1], h1[2], h1[3]}, o[d0], 0, 0, 0);   \
        o[d0] = __builtin_amdgcn_mfma_f32_32x32x16_bf16(pa2, (bf16x8){l2[0], l2[1], l2[2], l2[3], h2[0], h2[1], h2[2], h2[3]}, o[d0], 0, 0, 0);   \
        o[d0] = __builtin_amdgcn_mfma_f32_32x32x16_bf16(pa3, (bf16x8){l3[0], l3[1], l3[2], l3[3], h3[0], h3[1], h3[2], h3[3]}, o[d0], 0, 0, 0); } while (0)
    PV_D0(0); PV_D0(1); PV_D0(2); PV_D0(3);
#undef PV_D0
#undef TRRD
}

template <class TIn, class TOut> struct BlockRef { const TIn* Q; const TIn* K; const TIn* V; TOut* O; int P0; const float* Fb; const float* gain;
    int jlo, jhi;
    float* Op; float* ML; };
template <class TIn> struct Seam {
    bf16x8 qr[8];
    bf16x8 st_v0, st_v1, st_k0, st_k1; f32x4 sf0, sf1, sf2, sf3; float st_b;
    f32x4 tq[16];
};
__device__ __forceinline__ int swa_jlo(int P0, int W) { const int lowk = P0 - W + 1; return lowk > 0 ? lowk / KVBLK : 0; }
#define ROW(p, k0, rr) ((p) + (size_t)((k0) + (rr)) * PITCH + sc)
#define VMW() asm volatile("s_waitcnt vmcnt(0)" ::: "memory")
#define VMWN(n) asm volatile("s_waitcnt vmcnt(%0)" :: "i"(n) : "memory")
#define SLOAD_H(Kp, Vp, k0) SLOAD_HB(Kp, Vp, k0, cur)
#define SLOAD_HB(Kp, Vp, k0, blk) do { S.st_v0 = load8<TIn>(ROW(Vp, k0, sr)); S.st_v1 = load8<TIn>(ROW(Vp, k0, 32 + sr));              \
                         S.st_k0 = load8<TIn>(ROW(Kp, k0, sr)); S.st_k1 = load8<TIn>(ROW(Kp, k0, 32 + sr)); \
                         if (tid < 64) S.st_b = ((blk).Fb[(blk).P0] - (blk).Fb[(k0) + tid]) * (1.0f / SCALE); } while (0)
#define SWRITE_HK(bf) do { *(bf16x8*)(K_lds + (bf) * SHM_K + kws) = S.st_k0; *(bf16x8*)(K_lds + (bf) * SHM_K + kws + 32 * 256) = S.st_k1; \
                         if (tid < 64) *(float*)(K_lds - 2 * SHM_V + LDS_BIAS + (bf) * 256 + bws) = S.st_b; } while (0)
#define SWRITE_HV(bf) do { *(bf16x8*)(V_lds + (bf) * SHM_V + vst0) = S.st_v0; *(bf16x8*)(V_lds + (bf) * SHM_V + vst1) = S.st_v1; } while (0)
#define SWRITE_H(bf) do { SWRITE_HV(bf); SWRITE_HK(bf); } while (0)
#define SLOAD_F(p, k0) do { S.sf0 = *(const f32x4*)ROW(p, k0, sr); S.sf1 = *(const f32x4*)(ROW(p, k0, sr) + 4);                \
                            S.sf2 = *(const f32x4*)ROW(p, k0, 32 + sr); S.sf3 = *(const f32x4*)(ROW(p, k0, 32 + sr) + 4); } while (0)
#define SWRITE_KF(bf) do { *(bf16x8*)(K_lds + (bf) * SHM_K + kws) = pack8(S.sf0, S.sf1); *(bf16x8*)(K_lds + (bf) * SHM_K + kws + 32 * 256) = pack8(S.sf2, S.sf3); } while (0)
#define SWRITE_VF(bf) do { *(bf16x8*)(V_lds + (bf) * SHM_V + vst0) = pack8(S.sf0, S.sf1); *(bf16x8*)(V_lds + (bf) * SHM_V + vst1) = pack8(S.sf2, S.sf3); } while (0)
template <class TIn, class TOut>
__device__ __forceinline__ void causal_swa_prime(const BlockRef<TIn, TOut>& cur, int W, char* lds, Seam<TIn>& S) {
    constexpr bool F32 = same_t<TIn, float>::v;
    const int tid = threadIdx.x, wid = __builtin_amdgcn_readfirstlane(tid >> 6), lane = tid & 63, r32 = lane & 31, hi = lane >> 5;
    const int sr = tid >> 4, sc = (tid & 15) * 8, kws = KSWZ(sr, sc * 2); char* K_lds = lds + 2 * SHM_V;
    const int bws = bias_slot(tid & 63) * 4;
    const int kb0 = cur.jlo * KVBLK;
    for (int d0 = 0; d0 < 8; ++d0) S.qr[d0] = load8<TIn>(cur.Q + (size_t)(wid * QBLK + r32) * PITCH + d0 * 16 + hi * 8);
    if constexpr (F32) { SLOAD_F((const float*)cur.K, kb0); VMW(); SWRITE_KF(0); SBAR(); SLOAD_F((const float*)cur.V, kb0); }
    else { SLOAD_H(cur.K, cur.V, kb0); VMW(); SWRITE_HK(0); }
    __syncthreads();
}
template <class TIn, class TOut>
__device__ __forceinline__ void causal_swa_block(const BlockRef<TIn, TOut>& cur, const BlockRef<TIn, TOut>& nxt, int skv, int W, char* lds, Seam<TIn>& S) {
    constexpr bool F32 = same_t<TIn, float>::v;
    const int tid = threadIdx.x, wid = __builtin_amdgcn_readfirstlane(tid >> 6), lane = tid & 63, r32 = lane & 31, hi = lane >> 5;
    const int j_lo = cur.jlo; const int j_hi = cur.jhi;
    const int NT = j_hi - j_lo;
    const int kbn = nxt.jlo * KVBLK;
    const int qlo = cur.P0 + wid * QBLK, qm = qlo + r32 - 4 * hi;
    char* V_lds = lds; char* K_lds = lds + 2 * SHM_V;
    float* ws = (float*)(lds + 2 * SHM_V + 2 * SHM_K) + wid * 64; float* li_l = ws, * al_l = ws + 32;
    float m_reg = -1e30f, l_reg = 0; f32x16 o[4] = {};
    const int sr = tid >> 4, sc = (tid & 15) * 8, vst0 = v_st(sr, sc), vst1 = v_st(32 + sr, sc), kws = KSWZ(sr, sc * 2);
    const int bws = bias_slot(tid & 63) * 4;
    const int vb0 = (int)(uintptr_t)V_lds + v_rd_base(lane);
    const TIn* Kh = cur.K; const TIn* Vh = cur.V;
#define RESC(a) do { if (__any((a) < 1.f)) { if (hi == 0) al_l[r32] = (a); asm volatile("s_waitcnt lgkmcnt(0)" ::: "memory");              \
                     for (int d_ = 0; d_ < 4; ++d_) for (int r = 0; r < 16; ++r) o[d_][r] *= al_l[crow(r, hi)]; } } while (0)
#define KBASE(t) ((j_lo + (t)) * KVBLK)
#define ACT(t) (KBASE(t) <= qlo + QBLK - 1 && KBASE(t) + KVBLK - 1 >= qlo - W + 1)
#define MASKT(P0_, P1_, t) do { const int kb_ = KBASE(t); if ((!SK || ACT(t)) && (kb_ + KVBLK - 1 > qlo || kb_ <= qlo + QBLK - 1 - W)) mask_tile(P0_, P1_, qm - kb_, (unsigned)W); } while (0)
    constexpr int NQL = F32 ? 16 : 8;
    constexpr bool SK = WSKIP && !F32;
#define SEAM_K0() do { VMWN(NQL); if constexpr (F32) { SWRITE_KF(0); SBAR(); SLOAD_F((const float*)nxt.V, kbn); } else { SWRITE_HK(0); } SBAR(); } while (0)
    f32x16 pA0, pA1, pB0, pB1; float mnA, mnB, alA, alB; bf16x8 pa0, pa1, pa2, pa3;
    if constexpr (F32) { VMW(); SWRITE_VF(0); SBAR(); } else { SWRITE_HV(0); SBAR(); }
    if (NT > 1) { if constexpr (F32) SLOAD_F((const float*)Kh, KBASE(1)); else SLOAD_H(Kh, Vh, KBASE(1)); }
    SBAR(); qkt<0, SK>(pA0, pA1, K_lds, r32, hi, S.qr, ACT(0));
    if constexpr (F32) { if (NT > 1) { VMW(); SWRITE_KF(1); SBAR(); SLOAD_F((const float*)Vh, KBASE(1)); } }
    MASKT(pA0, pA1, 0); partialSM(pA0, pA1, m_reg, mnA, alA);
    if (NT > 1) { VMW(); if constexpr (F32) { SWRITE_VF(1); SBAR(); if (NT > 2) SLOAD_F((const float*)Kh, KBASE(2)); } else SWRITE_H(1); }
    __syncthreads();
#define HALF_STEP(PX0, PX1, mnX, alX, PY0, PY1, alY, t, KB, VB, SB) do {                                                      \
        SBAR(); qkt<KB, SK>(PX0, PX1, K_lds, r32, hi, S.qr, ACT(t));                                             \
        finishSM(PY0, PY1, alY, l_reg, pa0, pa1, pa2, pa3); SBAR();                                                           \
        if ((t) + 1 < NT) { if constexpr (F32) { VMW(); SWRITE_KF(SB); SBAR(); SLOAD_F((const float*)Vh, KBASE((t) + 1)); }  \
                            else { SLOAD_H(Kh, Vh, KBASE((t) + 1)); } SBAR(); }                                               \
        pv_tile<VB, SK>(o, vb0, pa0, pa1, pa2, pa3, ACT((t) - 1)); MASKT(PX0, PX1, (t)); partialSM(PX0, PX1, m_reg, mnX, alX);                                        \
        __syncthreads();                                                                                                      \
        if ((t) + 1 < NT) { VMW(); if constexpr (F32) { SWRITE_VF(SB); SBAR(); if ((t) + 2 < NT) SLOAD_F((const float*)Kh, KBASE((t) + 2)); } \
                            else { SWRITE_H(SB); } }                                                                          \
        RESC(alX); __syncthreads(); } while (0)
    for (int t = 1; t + 1 < NT; t += 2) {
        HALF_STEP(pB0, pB1, mnB, alB, pA0, pA1, alA, t, 1, 0, 0);
        HALF_STEP(pA0, pA1, mnA, alA, pB0, pB1, alB, t + 1, 0, 1, 1);
    }
    const bool even = (NT & 1) == 0;
    if (even) { SBAR(); qkt<1, SK>(pB0, pB1, K_lds, r32, hi, S.qr, ACT(NT - 1)); SBAR(); }
#define QROW(e) (nxt.Q + (size_t)(wid * QBLK + r32) * PITCH + ((e) >> 1) * 16 + hi * 8 + ((e) & 1) * 4)
    if constexpr (F32) { SLOAD_F((const float*)nxt.K, kbn); SBAR();
#pragma unroll
        for (int e = 0; e < 8; ++e) S.tq[e] = *(const f32x4*)QROW(e); }
    else { SLOAD_HB(nxt.K, nxt.V, kbn, nxt); SBAR();
#pragma unroll
        for (int d0 = 0; d0 < 8; ++d0) S.qr[d0] = load8<TIn>(nxt.Q + (size_t)(wid * QBLK + r32) * PITCH + d0 * 16 + hi * 8); }
    SBAR();
    finishSM(pA0, pA1, alA, l_reg, pa0, pa1, pa2, pa3); SBAR();
    if constexpr (F32) {
#pragma unroll
        for (int e = 8; e < 16; ++e) S.tq[e] = *(const f32x4*)QROW(e); SBAR(); }
#undef QROW
    pv_tile<0, SK>(o, vb0, pa0, pa1, pa2, pa3, ACT(even ? NT - 2 : NT - 1));
    if (even) { MASKT(pB0, pB1, NT - 1); partialSM(pB0, pB1, m_reg, mnB, alB); __syncthreads(); RESC(alB);
        finishSM(pB0, pB1, alB, l_reg, pa0, pa1, pa2, pa3); SBAR(); pv_tile<1, SK>(o, vb0, pa0, pa1, pa2, pa3, ACT(NT - 1)); }
    SBAR(); SEAM_K0();
    if (hi == 0) li_l[r32] = l_reg; asm volatile("s_waitcnt lgkmcnt(0)" ::: "memory");
    if (cur.Op != nullptr) {
        int rp = r32; asm volatile("" : "+v"(rp));
        if (hi == 0) { float2 mlv; mlv.x = m_reg; mlv.y = l_reg; *(float2*)(cur.ML + 2 * (wid * QBLK + rp)) = mlv; }
        float* Pr = cur.Op + (size_t)(wid * QBLK + 4 * hi) * D + rp;
#pragma unroll
        for (int r = 0; r < 16; ++r) {
#pragma unroll
            for (int d0 = 0; d0 < 4; ++d0) Pr[d0 * 32] = o[d0][r];
            Pr += ((r & 3) == 3 ? 5 : 1) * D; asm volatile("" : "+v"(Pr) :: "memory"); }
    } else {
    int ro = r32; asm volatile("" : "+v"(ro));
    TOut* Or = cur.O + (size_t)(wid * QBLK + 4 * hi) * OPITCH + ro;
    float gn[4];
#pragma unroll
    for (int d0 = 0; d0 < 4; ++d0) gn[d0] = cur.gain[d0 * 32 + ro];
#pragma unroll
    for (int r = 0; r < 16; ++r) { const int orow = crow(r, hi); const float rl = __builtin_amdgcn_rcpf(li_l[orow]);
        float v[4]; float ss = 0.f;
#pragma unroll
        for (int d0 = 0; d0 < 4; ++d0) { v[d0] = o[d0][r] * rl; ss += v[d0] * v[d0]; }
        ss += __shfl_xor(ss, 1); ss += __shfl_xor(ss, 2); ss += __shfl_xor(ss, 4); ss += __shfl_xor(ss, 8); ss += __shfl_xor(ss, 16);
        const float rn = __builtin_amdgcn_rsqf(ss * (1.0f / 128.0f) + 1e-6f);
#pragma unroll
        for (int d0 = 0; d0 < 4; ++d0) { const float vv = v[d0] * rn * gn[d0]; const float vn = __shfl_xor(vv, 1);
            if ((ro & 1) == 0) *(unsigned*)(Or + d0 * 32) = cvtpk(vv, vn); }
        Or += ((r & 3) == 3 ? 5 : 1) * OPITCH; asm volatile("" : "+v"(Or) :: "memory"); }
    }
    if constexpr (F32) {
#pragma unroll
        for (int d0 = 0; d0 < 8; ++d0) S.qr[d0] = pack8(S.tq[2 * d0], S.tq[2 * d0 + 1]); }
    __syncthreads();
#undef RESC
#undef KBASE
#undef ACT
#undef MASKT
#undef SEAM_K0
#undef HALF_STEP
}
#undef ROW
#undef VMW
#undef VMWN
#undef SLOAD_H
#undef SWRITE_HK
#undef SWRITE_HV
#undef SWRITE_H
#undef SLOAD_F
#undef SWRITE_KF
#undef SWRITE_VF

}
namespace mk {
typedef short s16x8 __attribute__((ext_vector_type(8)));
#define MFMA32(a, b, c) __builtin_amdgcn_mfma_f32_32x32x16_bf16((a), (b), (c), 0, 0, 0)
__device__ __forceinline__ int crow32(int r, int hi) { return (r & 3) + 8 * (r >> 2) + 4 * hi; }
constexpr float SCALEQ = 0.08838834764831845f;
__device__ __forceinline__ float wave_scan_add(float v, int lane) {
#pragma unroll
    for (int o = 1; o < 64; o <<= 1) { const float t = __shfl_up(v, o); if (lane >= o) v += t; }
    return v;
}
__device__ __forceinline__ float wave_scan_max(float v, int lane) {
#pragma unroll
    for (int o = 1; o < 64; o <<= 1) { const float t = __shfl_up(v, o); if (lane >= o) v = fmaxf(v, t); }
    return v;
}
__device__ __forceinline__ float wave_max(float v) {
#pragma unroll
    for (int o = 1; o < 64; o <<= 1) v = fmaxf(v, __shfl_xor(v, o));
    return v;
}
constexpr int TSTR = 72;
template <bool SCALED>
__device__ __forceinline__ void stage_transposed(const bf16* src, int ncols, LAS bf16* T, const LAS float* wl, int tid) {
    const int cpr = ncols / 8;
    for (int q = tid; q < 64 * cpr; q += NTHR) { const int s = q / cpr, c8 = (q % cpr) * 8;
        const v4u raw = *(const GAS v4u*)(src + (size_t)s * NPP + c8);
        const unsigned w4[4] = {raw.x, raw.y, raw.z, raw.w};
#pragma unroll
        for (int j = 0; j < 4; ++j) { unsigned lo = w4[j] & 0xffffu, hi = w4[j] >> 16;
            if (SCALED) { const float sc = wl[s]; lo = f2bf(bf2f((unsigned short)lo) * sc); hi = f2bf(bf2f((unsigned short)hi) * sc); }
            T[(c8 + 2 * j) * TSTR + s] = (bf16)lo; T[(c8 + 2 * j + 1) * TSTR + s] = (bf16)hi; } }
}
__device__ __forceinline__ void p3_prep(Frame& F) {
    const int gw = F.vcu * NWAVES + F.wave, NGW = F.G * NWAVES, lane = F.lane, tid = F.tid;
    bf16* proj = wsp<bf16>(F, WS_PROJ); const float* gates = wsp<float>(F, WS_GATES);
    {
        const int seg = lane >> 2, qd = (lane & 3) * 32; const float* gn = (seg < 8 ? F.in[IN_FOXQN] : F.in[IN_FOXKN]) + qd;
        for (int m = gw; m < S; m += NGW) {
            bf16* p = proj + (size_t)m * NPP + C_FQ + seg * 128 + qd; v4u raw[4]; float x[32]; float ss = 0.f;
#pragma unroll
            for (int j = 0; j < 4; ++j) raw[j] = *(const GAS v4u*)(p + 8 * j);
#pragma unroll
            for (int j = 0; j < 4; ++j) { const unsigned w4[4] = {raw[j].x, raw[j].y, raw[j].z, raw[j].w};
#pragma unroll
                for (int i = 0; i < 4; ++i) { x[8 * j + 2 * i] = bf2f((unsigned short)(w4[i] & 0xffffu)); x[8 * j + 2 * i + 1] = bf2f((unsigned short)(w4[i] >> 16)); } }
#pragma unroll
            for (int i = 0; i < 32; ++i) ss += x[i] * x[i];
            ss += __shfl_xor(ss, 1); ss += __shfl_xor(ss, 2);
            const float r = rsqrtf(ss * (1.f / 128.f) + 1e-6f);
#pragma unroll
            for (int j = 0; j < 4; ++j) { v4u o; const f32x4 g0 = *(const GAS f32x4*)(gn + 8 * j), g1 = *(const GAS f32x4*)(gn + 8 * j + 4);
                o.x = pk2(x[8 * j] * r * g0.x, x[8 * j + 1] * r * g0.y); o.y = pk2(x[8 * j + 2] * r * g0.z, x[8 * j + 3] * r * g0.w);
                o.z = pk2(x[8 * j + 4] * r * g1.x, x[8 * j + 5] * r * g1.y); o.w = pk2(x[8 * j + 6] * r * g1.z, x[8 * j + 7] * r * g1.w);
                *(GAS v4u*)(p + 8 * j) = o; }
        }
    }
    if (blockIdx.x < 8) {
        const int h = blockIdx.x; const float b = F.in[IN_FOXBF][h]; float* Fo = wsp<float>(F, WS_F) + h * S;
        LAS double* tot = (LAS double*)(F.lds + RING_OFF);
        double loc[16]; double acc = 0.0;
#pragma unroll
        for (int i = 0; i < 16; ++i) { acc += (double)log_sigmoid_f(gates[(size_t)(tid * 16 + i) * 16 + 8 + h] + b); loc[i] = acc; }
        tot[tid] = acc;
        __syncthreads();
        if (F.wave == 0) { double v[8]; double s = 0.0;
#pragma unroll
            for (int i = 0; i < 8; ++i) { v[i] = tot[lane * 8 + i]; s += v[i]; }
            double inc = s;
#pragma unroll
            for (int o = 1; o < 64; o <<= 1) { const double t = __shfl_up(inc, o); if (lane >= o) inc += t; }
            double ex = inc - s;
#pragma unroll
            for (int i = 0; i < 8; ++i) { tot[lane * 8 + i] = ex; ex += v[i]; } }
        __syncthreads();
        const double off = tot[tid];
        LAS float* Fl = (LAS float*)(F.lds + RING_OFF + 8192);
#pragma unroll
        for (int i = 0; i < 16; ++i) { const float fv = (float)(off + loc[i]); Fo[tid * 16 + i] = fv; Fl[tid * 16 + i] = fv; }
        __syncthreads();
        if (tid < 32) {
            float gq = 0.f, gk = 0.f;
            for (int d = 0; d < 128; ++d) { gq = fmaxf(gq, fabsf(F.in[IN_FOXQN][d])); gk = fmaxf(gk, fabsf(F.in[IN_FOXKN][d])); }
            const float thr = 2.f * 11.3137085f * gq * gk + 26.f;
            const int qb = tid, P0 = qb * 256; const float f0 = Fl[P0];
            int lo = 0, hi2 = 4 * qb;
            while (lo < hi2) { const int mid = (lo + hi2) >> 1; if (Fl[64 * mid + 63] - f0 <= thr) hi2 = mid; else lo = mid + 1; }
            wsp<int>(F, WS_JLO)[h * 32 + qb] = lo;
        }
        __syncthreads();
    }
    {
        LAS bf16* KT = (LAS bf16*)(F.lds + RING_OFF);
        LAS bf16* VT = KT + 128 * TSTR;
        LAS float* wl = (LAS float*)(VT + 256 * TSTR);
        float* UL = wsp<float>(F, WS_UL); float* NL = wsp<float>(F, WS_NL); float* GLAL = wsp<float>(F, WS_GLAL);
        const int hi = lane >> 5, l31 = lane & 31, w = F.wave;
        for (int u = F.vcu; u < 4 * NCH; u += F.G) {
            const int h = u >> 7, ch = u & 127, t0 = ch * LCH;
            if (w == 0) {
                const float ip = softcap_f(gates[(size_t)(t0 + lane) * 16 + h] + F.in[IN_BI][h]);
                const float fp = softcap_f(gates[(size_t)(t0 + lane) * 16 + 4 + h] + F.in[IN_BF][h]);
                const float g = wave_scan_add(log_sigmoid_f(fp), lane), a = ip - g, amax = wave_max(a);
                wl[lane] = __expf(a - amax);
                if (lane == 63) { GLAL[u * 2] = g; GLAL[u * 2 + 1] = amax; }
            }
            __syncthreads();
            stage_transposed<true>(proj + (size_t)t0 * NPP + C_MK + h * 128, 128, KT, wl, tid);
            stage_transposed<false>(proj + (size_t)t0 * NPP + C_MV + h * 256, 256, VT, wl, tid);
            __syncthreads();
            f32x16 acc[4];
#pragma unroll
            for (int dt = 0; dt < 4; ++dt)
#pragma unroll
                for (int r = 0; r < 16; ++r) acc[dt][r] = 0.f;
#pragma unroll
            for (int ks = 0; ks < 4; ++ks) { const s16x8 a = *(const LAS s16x8*)(VT + (32 * w + l31) * TSTR + 16 * ks + 8 * hi);
#pragma unroll
                for (int dt = 0; dt < 4; ++dt) { const s16x8 b = *(const LAS s16x8*)(KT + (32 * dt + l31) * TSTR + 16 * ks + 8 * hi); acc[dt] = MFMA32(a, b, acc[dt]); } }
            float* ut = UL + (size_t)u * 256 * 128;
#pragma unroll
            for (int dt = 0; dt < 4; ++dt)
#pragma unroll
                for (int r = 0; r < 16; ++r) ut[(size_t)(32 * w + crow32(r, hi)) * 128 + 32 * dt + l31] = acc[dt][r];
            if (tid < 128) { float s = 0.f;
#pragma unroll
                for (int j = 0; j < 8; ++j) { const s16x8 kv = *(const LAS s16x8*)(KT + tid * TSTR + 8 * j);
#pragma unroll
                    for (int i = 0; i < 8; ++i) s += bf2f((unsigned short)kv[i]); }
                NL[u * 128 + tid] = s; }
            __syncthreads();
        }
    }
}
__device__ __forceinline__ void p4_scan(Frame& F) {
    LAS float* gl = (LAS float*)(F.lds + RING_OFF);
    LAS float* dec = gl + 256; LAS float* scl = dec + 128; LAS float* mv = scl + 128;
    const float* UL = wsp<float>(F, WS_UL); const float* NL = wsp<float>(F, WS_NL); const float* GLAL = wsp<float>(F, WS_GLAL);
    bf16* CS = wsp<bf16>(F, WS_CS); float* NS = wsp<float>(F, WS_NS); float* MS = wsp<float>(F, WS_MS);
    const int tid = F.tid;
    for (int blk = F.vcu; blk < 4 * 64; blk += F.G) {
        const int h = blk >> 6, rem0 = (blk & 63) * 512;
        if (tid < 256) gl[tid] = GLAL[h * 256 + tid];
        __syncthreads();
        if (tid == 0) { float m = 0.f;
            for (int c = 0; c < NCH; ++c) { const float g = gl[2 * c], al = gl[2 * c + 1], mn = g + fmaxf(m, al);
                mv[c] = m; dec[c] = __expf(g + m - mn); scl[c] = __expf(g + al - mn); m = mn; } }
        __syncthreads();
        if (rem0 == 0 && tid < 128) MS[h * 128 + tid] = mv[tid];
        const int rem = rem0 + tid;
        const float* ul = UL + (size_t)h * NCH * 32768 + rem; bf16* cs = CS + (size_t)h * NCH * 32768 + rem;
        float C = 0.f;
#pragma unroll 32
        for (int c = 0; c < NCH; ++c) { cs[(size_t)c * 32768] = (bf16)f2bf(C); C = dec[c] * C + scl[c] * ul[(size_t)c * 32768]; }
        if (rem0 == 0 && tid < 128) { float n = 0.f; const float* nl = NL + (size_t)h * NCH * 128 + tid; float* ns = NS + (size_t)h * NCH * 128 + tid;
#pragma unroll 8
            for (int c = 0; c < NCH; ++c) { ns[c * 128] = n; n = dec[c] * n + scl[c] * nl[c * 128]; } }
        __syncthreads();
    }
}
constexpr int NUMSTR = 260;
__device__ __forceinline__ void p5_mlstm_out(Frame& F) {
    LAS bf16* VT = (LAS bf16*)(F.lds + RING_OFF);
    LAS bf16* Pm = VT + 256 * TSTR;
    LAS float* NUM = (LAS float*)(Pm + 64 * TSTR);
    LAS float* a_s = NUM + 64 * NUMSTR; LAS float* Mt = a_s + 64; LAS float* inter = Mt + 64; LAS float* emt = inter + 64; LAS float* qn = emt + 64; LAS float* dinv = qn + 64;
    const bf16* proj = wsp<bf16>(F, WS_PROJ); const float* gates = wsp<float>(F, WS_GATES); const bf16* CS = wsp<bf16>(F, WS_CS);
    const float* NS = wsp<float>(F, WS_NS); const float* MS = wsp<float>(F, WS_MS); bf16* concat = wsp<bf16>(F, WS_CONCAT);
    const int tid = F.tid, lane = F.lane, w = F.wave, hi = lane >> 5, l31 = lane & 31;
    for (int u = F.vcu; u < 4 * NCH; u += F.G) {
        const int h = u >> 7, ch = u & 127, t0 = ch * LCH;
        const bf16* qbase = proj + (size_t)t0 * NPP + C_MQ + h * 128; const bf16* kbase = proj + (size_t)t0 * NPP + C_MK + h * 128;
        if (w == 0) {
            const float ip = softcap_f(gates[(size_t)(t0 + lane) * 16 + h] + F.in[IN_BI][h]);
            const float fp = softcap_f(gates[(size_t)(t0 + lane) * 16 + 4 + h] + F.in[IN_BF][h]);
            const float g = wave_scan_add(log_sigmoid_f(fp), lane), a = ip - g, cm = wave_scan_max(a, lane);
            const float mp = MS[u], M = fmaxf(mp, cm);
            a_s[lane] = a; Mt[lane] = M; inter[lane] = __expf(mp - M); emt[lane] = __expf(-(g + M));
        }
        stage_transposed<false>(proj + (size_t)t0 * NPP + C_MV + h * 256, 256, VT, a_s, tid);
        __syncthreads();
        if (w < 4) {
            const int ti = w >> 1, si = w & 1;
            if (si <= ti) {
                s16x8 qa[8], kb[8];
#pragma unroll
                for (int ks = 0; ks < 8; ++ks) { qa[ks] = *(const GAS s16x8*)(qbase + (size_t)(32 * ti + l31) * NPP + 16 * ks + 8 * hi); kb[ks] = *(const GAS s16x8*)(kbase + (size_t)(32 * si + l31) * NPP + 16 * ks + 8 * hi); }
                f32x16 acc;
#pragma unroll
                for (int r = 0; r < 16; ++r) acc[r] = 0.f;
#pragma unroll
                for (int ks = 0; ks < 8; ++ks) acc = MFMA32(qa[ks], kb[ks], acc);
                const int s = 32 * si + l31; const float as = a_s[s];
#pragma unroll
                for (int r = 0; r < 16; ++r) { const int t = 32 * ti + crow32(r, hi); const float p = (s <= t) ? acc[r] * SCALEQ * __expf(as - Mt[t]) : 0.f; Pm[t * TSTR + s] = (bf16)f2bf(p); }
            } else {
#pragma unroll
                for (int r = 0; r < 16; ++r) Pm[(32 * ti + crow32(r, hi)) * TSTR + 32 * si + l31] = (bf16)0;
            }
        } else {
            const int t = (tid - 256) >> 2, d0 = ((tid - 256) & 3) * 32; float s = 0.f; const float* np = NS + (size_t)u * 128 + d0;
#pragma unroll
            for (int j = 0; j < 4; ++j) { const s16x8 qv = *(const GAS s16x8*)(qbase + (size_t)t * NPP + d0 + 8 * j);
#pragma unroll
                for (int i = 0; i < 8; ++i) s += bf2f((unsigned short)qv[i]) * np[8 * j + i]; }
            s += __shfl_xor(s, 1); s += __shfl_xor(s, 2);
            if ((tid & 3) == 0) qn[t] = s * SCALEQ;
        }
        __syncthreads();
        f32x16 accP[2], accC[2];
#pragma unroll
        for (int ti = 0; ti < 2; ++ti)
#pragma unroll
            for (int r = 0; r < 16; ++r) { accP[ti][r] = 0.f; accC[ti][r] = 0.f; }
        {
            const bf16* cs = CS + (size_t)u * 32768 + (size_t)(32 * w + l31) * 128 + 8 * hi;
            s16x8 cb[8];
#pragma unroll
            for (int ks = 0; ks < 8; ++ks) cb[ks] = *(const GAS s16x8*)(cs + 16 * ks);
#pragma unroll
            for (int ti = 0; ti < 2; ++ti) {
                s16x8 qa[8];
#pragma unroll
                for (int ks = 0; ks < 8; ++ks) qa[ks] = *(const GAS s16x8*)(qbase + (size_t)(32 * ti + l31) * NPP + 16 * ks + 8 * hi);
#pragma unroll
                for (int ks = 0; ks < 8; ++ks) accC[ti] = MFMA32(qa[ks], cb[ks], accC[ti]);
            }
#pragma unroll
            for (int ks = 0; ks < 4; ++ks) { const s16x8 vb = *(const LAS s16x8*)(VT + (32 * w + l31) * TSTR + 16 * ks + 8 * hi);
#pragma unroll
                for (int ti = 0; ti < 2; ++ti) { const s16x8 pa = *(const LAS s16x8*)(Pm + (32 * ti + l31) * TSTR + 16 * ks + 8 * hi); accP[ti] = MFMA32(pa, vb, accP[ti]); } }
        }
        if (w == 0) {
            float rs = 0.f;
#pragma unroll
            for (int j = 0; j < 8; ++j) { const s16x8 pv = *(const LAS s16x8*)(Pm + lane * TSTR + 8 * j);
#pragma unroll
                for (int i = 0; i < 8; ++i) rs += bf2f((unsigned short)pv[i]); }
            const float dn = rs + inter[lane] * qn[lane];
            dinv[lane] = 1.f / fmaxf(fabsf(dn), emt[lane]);
        }
        __syncthreads();
#pragma unroll
        for (int ti = 0; ti < 2; ++ti)
#pragma unroll
            for (int r = 0; r < 16; ++r) { const int t = 32 * ti + crow32(r, hi); NUM[t * NUMSTR + 32 * w + l31] = (accP[ti][r] + inter[t] * SCALEQ * accC[ti][r]) * dinv[t]; }
        __syncthreads();
        {
            const f32x4 gn = *(const GAS f32x4*)(F.in[IN_MOUTN] + h * 256 + 4 * lane);
#pragma unroll
            for (int i = 0; i < 8; ++i) { const int t = 8 * w + i; const f32x4 x = *(const LAS f32x4*)(NUM + t * NUMSTR + 4 * lane);
                const float ss = wave_sum((x.x * x.x + x.y * x.y) + (x.z * x.z + x.w * x.w)); const float r = rsqrtf(ss * (1.f / 256.f) + 1e-6f);
                const u32x2 mo = *(const GAS u32x2*)(proj + (size_t)(t0 + t) * NPP + C_MO + h * 256 + 4 * lane);
                const float o0 = x.x * r * gn.x * sigmoid_f(bf2f((unsigned short)(mo.x & 0xffffu))), o1 = x.y * r * gn.y * sigmoid_f(bf2f((unsigned short)(mo.x >> 16)));
                const float o2 = x.z * r * gn.z * sigmoid_f(bf2f((unsigned short)(mo.y & 0xffffu))), o3 = x.w * r * gn.w * sigmoid_f(bf2f((unsigned short)(mo.y >> 16)));
                u32x2 ov; ov.x = pk2(o0, o1); ov.y = pk2(o2, o3);
                *(GAS u32x2*)(concat + (size_t)(t0 + t) * D + h * 256 + 4 * lane) = ov; }
        }
        __syncthreads();
    }
}
}
namespace mk {
__device__ __forceinline__ void attn_build_schedule(Frame& F) {
    LAS int* jl = (LAS int*)(F.lds + TAB_OFF); LAS int* pre = jl + 256; LAS int* wtot = pre + 260;
    const int tid = F.tid, lane = F.lane;
    if (tid < 256) { const int j = wsp<int>(F, WS_JLO)[tid]; jl[tid] = j; const int n = 4 * (tid & 31) + 4 - j; int v = (n + ATT_CH - 1) / ATT_CH;
        int inc = v;
#pragma unroll
        for (int o = 1; o < 64; o <<= 1) { const int t = __shfl_up(inc, o); if (lane >= o) inc += t; }
        pre[tid + 1] = inc; if (lane == 63) wtot[tid >> 6] = inc; }
    __syncthreads();
    if (tid < 256) { int add = 0; for (int w2 = 0; w2 < (tid >> 6); ++w2) add += wtot[w2]; pre[tid + 1] += add; if (tid == 0) pre[0] = 0; }
    __syncthreads();
}
__device__ __forceinline__ fox::BlockRef<fox::bf16, fox::bf16> fox_ref(const Frame& F, int I) {
    const LAS int* jl = (const LAS int*)(F.lds + TAB_OFF); const LAS int* pre = jl + 256;
    int b = 0;
#pragma unroll
    for (int st = 128; st >= 1; st >>= 1) if (pre[b + st] <= I) b += st;
    b = __builtin_amdgcn_readfirstlane(b);
    const int pb0 = __builtin_amdgcn_readfirstlane(pre[b]), pb1 = __builtin_amdgcn_readfirstlane(pre[b + 1]), j0 = __builtin_amdgcn_readfirstlane(jl[b]);
    const int h = b >> 5, qb = b & 31, part = I - pb0, P = pb1 - pb0, n = 4 * qb + 4 - j0;
    fox::BlockRef<fox::bf16, fox::bf16> r;
    const fox::bf16* proj = (const fox::bf16*)(F.ws + WS_PROJ);
    r.Q = proj + (size_t)(qb * 256) * fox::PITCH + C_FQ + h * 128; r.K = proj + C_FK + h * 128; r.V = proj + C_FV + h * 128;
    r.O = (fox::bf16*)(F.ws + WS_CONCAT) + (size_t)(qb * 256) * D + 1024 + h * 128; r.P0 = qb * 256;
    r.Fb = (const float*)(F.ws + WS_F) + h * S; r.gain = F.in[IN_FOUTN] + h * 128;
    r.jlo = j0 + (part * n) / P; r.jhi = j0 + ((part + 1) * n) / P;
    r.Op = P > 1 ? (float*)(F.ws + WS_OPART) + (size_t)I * 256 * 128 : nullptr; r.ML = (float*)(F.ws + WS_MLP) + (size_t)I * 512;
    return r;
}
__device__ __forceinline__ void p5_attention(Frame& F, char* ldsg) {
    typedef fox::BlockRef<fox::bf16, fox::bf16> BR;
    attn_build_schedule(F);
    const int total = __builtin_amdgcn_readfirstlane(((const LAS int*)(F.lds + TAB_OFF))[256 + 256]);
    int L = F.vcu; if (L >= total) return;
    BR cur = fox_ref(F, L);
    fox::Seam<fox::bf16> Sm;
    fox::causal_swa_prime<fox::bf16, fox::bf16>(cur, S, ldsg, Sm);
    for (;;) {
        const bool more = L + F.G < total;
        const BR nxt = more ? fox_ref(F, L + F.G) : cur;
        fox::causal_swa_block<fox::bf16, fox::bf16>(cur, nxt, S, S, ldsg, Sm);
        if (!more) break;
        cur = nxt; L += F.G;
    }
}
__device__ __forceinline__ void p6_combine(Frame& F) {
    attn_build_schedule(F);
    const LAS int* pre = (const LAS int*)(F.lds + TAB_OFF) + 256;
    const float* OP = wsp<float>(F, WS_OPART); const float* MLP = wsp<float>(F, WS_MLP); bf16* concat = wsp<bf16>(F, WS_CONCAT);
    const int gw = F.vcu * NWAVES + F.wave, NGW = F.G * NWAVES, lane = F.lane;
    constexpr float C2 = 1.4426950408889634f * SCALEQ;
    for (int idx = gw; idx < 256 * 256; idx += NGW) {
        const int b = idx >> 8, r = idx & 255, i0 = pre[b], P = pre[b + 1] - i0; if (P <= 1) continue;
        const int h = b >> 5, qb = b & 31;
        float ms = -3.0e38f;
        for (int p2 = 0; p2 < P; ++p2) ms = fmaxf(ms, MLP[(size_t)(i0 + p2) * 512 + 2 * r]);
        float n0 = 0.f, n1 = 0.f, den = 0.f;
        for (int p2 = 0; p2 < P; ++p2) { const f32x2 ml = *(const GAS f32x2*)(MLP + (size_t)(i0 + p2) * 512 + 2 * r); const float wgt = __builtin_amdgcn_exp2f((ml.x - ms) * C2);
            const f32x2 ov = *(const GAS f32x2*)(OP + ((size_t)(i0 + p2) * 256 + r) * 128 + 2 * lane); n0 += wgt * ov.x; n1 += wgt * ov.y; den += wgt * ml.y; }
        const float inv = 1.f / den, v0 = n0 * inv, v1 = n1 * inv;
        const float ss = wave_sum(v0 * v0 + v1 * v1), rn = rsqrtf(ss * (1.f / 128.f) + 1e-6f);
        const f32x2 gn = *(const GAS f32x2*)(F.in[IN_FOUTN] + h * 128 + 2 * lane);
        *(GAS unsigned*)(concat + (size_t)(qb * 256 + r) * D + 1024 + h * 128 + 2 * lane) = pk2(v0 * rn * gn.x, v1 * rn * gn.y);
    }
}
constexpr int RROWS = 8, NITER = S / RROWS;
__device__ __forceinline__ void p7_router(Frame& F) {
    LAS float* shs = (LAS float*)(F.lds + RING_OFF);
    constexpr int HSTR = 2064;
    LAS bf16* H2hi = (LAS bf16*)(shs + 2 * D);
    LAS bf16* H2lo = H2hi + RROWS * HSTR;
    LAS float* red = (LAS float*)(H2lo + RROWS * HSTR);
    LAS int* selE = (LAS int*)(red + 8 * RROWS * NE);
    const float* mod = wsp<float>(F, WS_MOD); const float* h1 = wsp<float>(F, WS_H1); unsigned char* h2 = wsp<unsigned char>(F, WS_HN);
    int* top_i = wsp<int>(F, WS_TOPI); float* top_w = wsp<float>(F, WS_TOPW); int* hist = wsp<int>(F, WS_HIST); int* lrank = wsp<int>(F, WS_LRANK);
    const int tid = F.tid, lane = F.lane, w = F.wave;
    for (int i = tid; i < 2 * D; i += NTHR) shs[i] = mod[3 * D + i];
    __syncthreads();
    s16x8 whi[16], wlo[16];
    { const int hh = lane >> 5; const float* wp = F.in[IN_WR] + (size_t)(256 * w + 8 * hh) * NE + (lane & 31);
#pragma unroll
        for (int ks = 0; ks < 16; ++ks) { float wv[8];
#pragma unroll
            for (int j = 0; j < 8; ++j) wv[j] = wp[(size_t)(16 * ks + j) * NE];
            unsigned hw[4], lw[4];
#pragma unroll
            for (int j = 0; j < 4; ++j) { const unsigned a = f2bf(wv[2 * j]), b = f2bf(wv[2 * j + 1]); hw[j] = a | (b << 16); lw[j] = pk2(wv[2 * j] - bf2f((unsigned short)a), wv[2 * j + 1] - bf2f((unsigned short)b)); }
            const v4u hv4 = {hw[0], hw[1], hw[2], hw[3]}, lv4 = {lw[0], lw[1], lw[2], lw[3]};
            whi[ks] = __builtin_bit_cast(s16x8, hv4); wlo[ks] = __builtin_bit_cast(s16x8, lv4); } }
    for (int it = F.vcu; it < NITER; it += F.G) {
        const int r0 = it * RROWS;
        {
            const int m = r0 + w; const GAS f32x4* xr = (const GAS f32x4*)(h1 + (size_t)m * D) + lane; f32x4 v[8]; float s2 = 0.f;
#pragma unroll
            for (int j = 0; j < 8; ++j) { v[j] = xr[64 * j]; s2 += (v[j].x * v[j].x + v[j].y * v[j].y) + (v[j].z * v[j].z + v[j].w * v[j].w); }
            const float r = rsqrtf(wave_sum(s2) * (1.f / D) + 1e-6f);
            GAS unsigned* o8 = (GAS unsigned*)(h2 + (size_t)m * D) + lane;
#pragma unroll
            for (int j = 0; j < 8; ++j) { const int c0 = 4 * lane + 256 * j; const f32x4 gg = *(const GAS f32x4*)(F.in[IN_NFFN] + c0); const f32x4 a = *(const LAS f32x4*)(shs + D + c0), b = *(const LAS f32x4*)(shs + c0);
                const f32x4 y = v[j] * r * gg * (a + 1.f) + b; o8[64 * j] = pk4_fp8(y.x, y.y, y.z, y.w);
                const unsigned h0 = pk2(y.x, y.y), h1w = pk2(y.z, y.w); u32x2 hv; hv.x = h0; hv.y = h1w;
                u32x2 lv; lv.x = pk2(y.x - bf2f((unsigned short)(h0 & 0xffffu)), y.y - bf2f((unsigned short)(h0 >> 16))); lv.y = pk2(y.z - bf2f((unsigned short)(h1w & 0xffffu)), y.w - bf2f((unsigned short)(h1w >> 16)));
                *(LAS u32x2*)(H2hi + w * HSTR + c0) = hv; *(LAS u32x2*)(H2lo + w * HSTR + c0) = lv; }
        }
        __syncthreads();
        {
            f32x16 acc;
#pragma unroll
            for (int r = 0; r < 16; ++r) acc[r] = 0.f;
            const int hh = lane >> 5; const LAS bf16* bh = H2hi + (lane & 7) * HSTR + 256 * w + 8 * hh; const LAS bf16* bl = H2lo + (lane & 7) * HSTR + 256 * w + 8 * hh;
#pragma unroll
            for (int ks = 0; ks < 16; ++ks) { const s16x8 xh = *(const LAS s16x8*)(bh + 16 * ks), xl = *(const LAS s16x8*)(bl + 16 * ks);
                acc = MFMA32(whi[ks], xh, acc); acc = MFMA32(whi[ks], xl, acc); acc = MFMA32(wlo[ks], xh, acc); }
            if ((lane & 31) < RROWS) {
#pragma unroll
                for (int r = 0; r < 16; ++r) red[(w * RROWS + (lane & 31)) * NE + crow32(r, hh)] = acc[r]; }
        }
        __syncthreads();
        if (tid < RROWS * NE) {
            const int r = tid >> 5, e = tid & 31; float lg = F.in[IN_BR][e];
#pragma unroll
            for (int kp = 0; kp < 8; ++kp) lg += red[(kp * RROWS + r) * NE + e];
            float cur = lg, mx = 0.f, sum = 0.f, mysel = 0.f; int myidx = 0;
#pragma unroll
            for (int q = 0; q < 4; ++q) { float best = cur; int bi = e;
#pragma unroll
                for (int o = 1; o < 32; o <<= 1) { const float ob = __shfl_xor(best, o); const int oi = __shfl_xor(bi, o); if (ob > best || (ob == best && oi < bi)) { best = ob; bi = oi; } }
                if (q == 0) mx = best;
                sum += __expf(best - mx);
                if (e == q) { mysel = best; myidx = bi; }
                if (e == bi) cur = -3.0e38f; }
            if (e < 4) { const int t = r0 + r; top_i[t * 4 + e] = myidx; top_w[t * 4 + e] = __expf(mysel - mx) / sum; selE[r * 4 + e] = myidx; }
        }
        __syncthreads();
        if (tid < 32) { const int me = selE[tid]; int rank = 0, cnt = 0;
#pragma unroll
            for (int p = 0; p < 32; ++p) { const int ep = selE[p]; rank += (ep == me && p < tid) ? 1 : 0; cnt += (ep == tid) ? 1 : 0; }
            lrank[it * 32 + tid] = rank; hist[it * NE + tid] = cnt; }
        __syncthreads();
    }
}
__device__ __forceinline__ void build_expert_table(Frame& F, const int* counts_g) {
    LAS int* tab = (LAS int*)(F.lds + TAB_OFF);
    if (F.tid == 0) { int acc = 0; for (int e = 0; e < NE; ++e) { const int c = counts_g[e]; tab[e] = acc; tab[40 + e] = c; acc += (c + 255) >> 8; } tab[32] = acc; }
    __syncthreads();
}
__device__ __forceinline__ void p8_gather(Frame& F) {
    LAS int* psum = (LAS int*)(F.lds + RING_OFF);
    LAS int* startr = psum + 16 * NE;
    LAS int* base = startr + NE;
    const int* hist = wsp<int>(F, WS_HIST); const int* lrank = wsp<int>(F, WS_LRANK); const int* top_i = wsp<int>(F, WS_TOPI); const float* top_w = wsp<float>(F, WS_TOPW);
    int* pos = wsp<int>(F, WS_POS); float* roww = wsp<float>(F, WS_ROWW); const unsigned char* h2 = wsp<unsigned char>(F, WS_HN); unsigned char* xg = wsp<unsigned char>(F, WS_XG);
    int* counts_g = (int*)(F.ws + WS_POS) + S * 4;
    const int tid = F.tid, lane = F.lane, w = F.wave;
    { const int e = tid & 31, part = tid >> 5; int s = 0; for (int i = 0; i < NITER / 16; ++i) s += hist[(part * (NITER / 16) + i) * NE + e]; psum[part * NE + e] = s; }
    __syncthreads();
    if (tid == 0) { int acc = 0; for (int e = 0; e < NE; ++e) { int c = 0; for (int p = 0; p < 16; ++p) c += psum[p * NE + e]; startr[e] = acc; acc += ((c + 255) >> 8) << 8; if (blockIdx.x == 0) counts_g[e] = c; } }
    __syncthreads();
    for (int it = F.vcu; it < NITER; it += F.G) {
        {
            const int part = it / (NITER / 16), i0 = part * (NITER / 16);
            if (w < 4) { const bool on = (i0 + lane) < it;
#pragma unroll
                for (int q = 0; q < 8; ++q) { const int e = w * 8 + q; int v = on ? hist[(i0 + lane) * NE + e] : 0;
#pragma unroll
                    for (int o = 1; o < 64; o <<= 1) v += __shfl_xor(v, o);
                    if (lane == 0) { int b = v; for (int pp = 0; pp < part; ++pp) b += psum[pp * NE + e]; base[e] = b; } } }
        }
        __syncthreads();
#pragma unroll
        for (int j = 0; j < 4; ++j) { const int p = w + 8 * j, pair = it * 32 + p, e = top_i[pair], dest = startr[e] + base[e] + lrank[pair], t = pair >> 2;
            if (lane == 0) { pos[pair] = dest; roww[dest] = top_w[pair]; }
            const GAS v4u* src = (const GAS v4u*)(h2 + (size_t)t * D) + lane; GAS v4u* dst = (GAS v4u*)(xg + (size_t)dest * D) + lane;
#pragma unroll
            for (int q = 0; q < 2; ++q) dst[64 * q] = src[64 * q]; }
        __syncthreads();
    }
}
struct GroupedOrder {
    const LAS int* tab; int ntn, G, c;
    __device__ __forceinline__ bool next(int i, Unit& u) const {
        const int L = i * G + c, total = tab[32] * ntn; if (L >= total) return false;
        int e = 0;
#pragma unroll 1
        while (e < NE - 1 && tab[e + 1] * ntn <= L) ++e;
        const int ts = tab[e], tc = tab[e + 1] - ts, within = L - ts * ntn;
        u.pm = ts + within % tc; u.pn = within / tc; u.e = e; u.pb = e * ntn + u.pn; return true;
    }
    __device__ __forceinline__ void a_ready(const Unit&) const {}
    __device__ __forceinline__ void done(const Unit&) const {}
};
struct EpiSwiglu {
    static constexpr bool PERM = true, AFTER_DRAIN = false;
    unsigned char* act; const float* bug;
    __device__ __forceinline__ void operator()(const pg8::f32x4 (&acc)[2][2][4][2], const Unit& u, int wr, int wc, int fr, int fq) const {
        const int row0 = u.pm * 256 + wr * 64 + fr, f0 = u.pn * 128 + wc * 32 + 8 * fq;
        const float* bg = bug + (size_t)u.e * 4096 + f0; pg8::f32x4 bgv[2], buv[2];
#pragma unroll
        for (int n = 0; n < 2; ++n) { bgv[n] = *(const pg8::f32x4*)(bg + 4 * n); buv[n] = *(const pg8::f32x4*)(bg + 2048 + 4 * n); }
#pragma unroll
        for (int ai = 0; ai < 2; ++ai)
#pragma unroll
            for (int m = 0; m < 4; ++m) { float o[8];
#pragma unroll
                for (int n = 0; n < 2; ++n)
#pragma unroll
                    for (int i = 0; i < 4; ++i) { const float g = fminf(acc[ai][0][m][n][i] + bgv[n][i], 7.f); const float up = fminf(fmaxf(acc[ai][1][m][n][i] + buv[n][i], -7.f), 7.f);
                        o[4 * n + i] = (up + 1.f) * g * __builtin_amdgcn_rcpf(1.f + __builtin_amdgcn_exp2f(-2.45546696f * g)); }
                u32x2 wv; wv.x = pk4_fp8(o[0], o[1], o[2], o[3]); wv.y = pk4_fp8(o[4], o[5], o[6], o[7]);
                *(u32x2*)(act + (size_t)(row0 + ai * 128 + m * 16) * FF + f0) = wv; }
    }
};
struct EpiDown {
    static constexpr bool PERM = true, AFTER_DRAIN = false;
    bf16* y; const float* bd; const float* roww;
    __device__ __forceinline__ void operator()(const pg8::f32x4 (&acc)[2][2][4][2], const Unit& u, int wr, int wc, int fr, int fq) const {
        const int row0 = u.pm * 256 + wr * 64 + fr, col0 = u.pn * 256 + wc * 32 + 8 * fq;
        pg8::f32x4 bv[2][2];
#pragma unroll
        for (int bj = 0; bj < 2; ++bj)
#pragma unroll
            for (int n = 0; n < 2; ++n) bv[bj][n] = *(const pg8::f32x4*)(bd + (size_t)u.e * D + col0 + bj * 128 + 4 * n);
#pragma unroll
        for (int ai = 0; ai < 2; ++ai)
#pragma unroll
            for (int m = 0; m < 4; ++m) { const int row = row0 + ai * 128 + m * 16; const float rw = roww[row]; bf16* rowp = y + (size_t)row * D + col0;
#pragma unroll
                for (int bj = 0; bj < 2; ++bj) { const pg8::f32x4 v0 = (acc[ai][bj][m][0] + bv[bj][0]) * rw, v1 = (acc[ai][bj][m][1] + bv[bj][1]) * rw;
                    pg8::u32x4 wv; wv.x = cvt_pk_bf16(v0[0], v0[1]); wv.y = cvt_pk_bf16(v0[2], v0[3]); wv.z = cvt_pk_bf16(v1[0], v1[1]); wv.w = cvt_pk_bf16(v1[2], v1[3]);
                    *(pg8::u32x4*)(rowp + bj * 128) = wv; } }
    }
};
__device__ __forceinline__ void p11_final(Frame& F, float oscale) {
    LAS float* ms = (LAS float*)(F.lds + RING_OFF);
    const float* mod = wsp<float>(F, WS_MOD);
    for (int i = F.tid; i < 3 * D; i += NTHR) ms[i] = mod[5 * D + i];
    __syncthreads();
    const float* h1 = wsp<float>(F, WS_H1); const bf16* y = wsp<bf16>(F, WS_Y); const int* pos = wsp<int>(F, WS_POS);
    const int gw = F.vcu * NWAVES + F.wave, NGW = F.G * NWAVES, lane = F.lane;
    for (int t = gw; t < S; t += NGW) {
        asm volatile("" ::: "memory");
        const GAS f32x4* xr = (const GAS f32x4*)(h1 + (size_t)t * D) + lane;
        const GAS u32x2* y0 = (const GAS u32x2*)(y + (size_t)pos[t * 4 + 0] * D) + lane; const GAS u32x2* y1 = (const GAS u32x2*)(y + (size_t)pos[t * 4 + 1] * D) + lane;
        const GAS u32x2* y2 = (const GAS u32x2*)(y + (size_t)pos[t * 4 + 2] * D) + lane; const GAS u32x2* y3 = (const GAS u32x2*)(y + (size_t)pos[t * 4 + 3] * D) + lane;
        f32x4 v[8]; float s2 = 0.f;
#pragma unroll
        for (int j = 0; j < 8; ++j) { const u32x2 a = y0[64 * j], b = y1[64 * j], c = y2[64 * j], d = y3[64 * j]; const f32x4 g2 = *(const LAS f32x4*)(ms + 4 * lane + 256 * j);
            f32x4 f;
            f.x = (bf2f((unsigned short)(a.x & 0xffffu)) + bf2f((unsigned short)(b.x & 0xffffu))) + (bf2f((unsigned short)(c.x & 0xffffu)) + bf2f((unsigned short)(d.x & 0xffffu)));
            f.y = (bf2f((unsigned short)(a.x >> 16)) + bf2f((unsigned short)(b.x >> 16))) + (bf2f((unsigned short)(c.x >> 16)) + bf2f((unsigned short)(d.x >> 16)));
            f.z = (bf2f((unsigned short)(a.y & 0xffffu)) + bf2f((unsigned short)(b.y & 0xffffu))) + (bf2f((unsigned short)(c.y & 0xffffu)) + bf2f((unsigned short)(d.y & 0xffffu)));
            f.w = (bf2f((unsigned short)(a.y >> 16)) + bf2f((unsigned short)(b.y >> 16))) + (bf2f((unsigned short)(c.y >> 16)) + bf2f((unsigned short)(d.y >> 16)));
            v[j] = xr[64 * j] + g2 * f; s2 += (v[j].x * v[j].x + v[j].y * v[j].y) + (v[j].z * v[j].z + v[j].w * v[j].w); }
        const float r = rsqrtf(wave_sum(s2) * (1.f / D) + 1e-6f);
        GAS f32x4* o = (GAS f32x4*)(F.out + (size_t)t * D) + lane;
#pragma unroll
        for (int j = 0; j < 8; ++j) { const int c0 = 4 * lane + 256 * j; const f32x4 gg = *(const GAS f32x4*)(F.in[IN_NFIN] + c0); const f32x4 sh = *(const LAS f32x4*)(ms + D + c0), sc = *(const LAS f32x4*)(ms + 2 * D + c0);
            o[64 * j] = (v[j] * r * gg * (sc + 1.f) + sh) * oscale; }
    }
}
}
namespace mk {
struct Args { const float* in[24]; float* out; unsigned char* ws; int ph_lo, ph_hi, li, pad; };
constexpr int N_PHASES = 13;
__global__ void __launch_bounds__(NTHR, 2) mega_fwd(Args args) {
    extern __shared__ __attribute__((aligned(16))) unsigned char lds[];
    Frame F;
    F.lds = (LAS unsigned char*)lds;
    F.MISC = (volatile LAS unsigned*)(F.lds + MISC_OFF);
    F.tid = threadIdx.x; F.lane = F.tid & 63; F.wave = __builtin_amdgcn_readfirstlane(F.tid >> 6);
    leave_group(F);
    F.ws = args.ws; F.out = args.out; F.ctl = (gu32*)(args.ws + WS_CTL);
#pragma unroll
    for (int i = 0; i < 24; ++i) F.in[i] = args.in[i];
    for (int u = F.tid; u < (LDS_BYTES - LDSCTL_OFF) / 4; u += NTHR) ((LAS unsigned*)(F.lds + LDSCTL_OFF))[u] = 0u;
    __syncthreads();
    XcdBarrier bar = xcd_barrier_post((unsigned*)(F.ctl + CW_BAR) + args.li * XCD_BAR_WORDS, F.MISC + 8);
    const int lo = args.ph_lo, hi = args.ph_hi;
#define IN(k) (lo <= (k) && (k) < hi)
#define SEAM(k) do { if (IN(k) && IN((k) + 1)) xcd_barrier(bar); } while (0)

#ifndef MK_DOUBLE
#define MK_DOUBLE 0
#endif
#define DBL(k) ((MK_DOUBLE >> (k)) & 1)
#ifdef MK_PROBE_LO
    unsigned long long* stamps = (unsigned long long*)(F.ctl + 131072);
#define STAMP(k) do { if (blockIdx.x == 0 && F.tid == 0) stamps[k] = rt(); } while (0)
#define PROBE_SCALE() (1.f + sqrtf((float)(stamps[MK_PROBE_HI] - stamps[MK_PROBE_LO]) * 0.01f * 2e-5f))
#else
#define STAMP(k) do { } while (0)
#define PROBE_SCALE() 1.f
#endif
    STAMP(0); if (IN(0)) { p0_gemv(F); } SEAM(0);
    STAMP(1); if (IN(1)) { p1_modulate(F); if (DBL(1)) p1_modulate(F); } SEAM(1);
    STAMP(2); if (IN(2)) {
        gu32* done = F.ctl + CW_DONE + 64 * 2;
        if (enter_group(F, GC_INPROJ)) {
            pg8::Gemm g{wsp<pg8::bf16_t>(F, WS_HN), wsp<pg8::bf16_t>(F, WS_WIN), S, NPP, D}; pg8::StaticOrder So; So.init(S, NPP, F.G, F.bid);
            EpiProj E{wsp<bf16>(F, WS_PROJ)};
            pg8::gemm_phase<EpiProj, pg8::StaticOrder, true, true>(F.lds + RING_OFF, g, So, E);
            if (DBL(2)) pg8::gemm_phase<EpiProj, pg8::StaticOrder, true, true>(F.lds + RING_OFF, g, So, E);
            __syncthreads();
            if (F.tid == 0) __hip_atomic_fetch_add(done, 1u, RLX_AGENT);
        }
        const unsigned tgt = (unsigned)F.G; leave_group(F);
        conv_worker(F, done, F.G == 256 ? (unsigned)GC_INPROJ : tgt, 0);
        __syncthreads();
    } SEAM(2);
#define GROUPED(k, Gc, body) do { gu32* done_ = F.ctl + CW_DONE + 64 * (k); if (enter_group(F, (Gc))) { body; __syncthreads(); if (F.tid == 0) __hip_atomic_fetch_add(done_, 1u, RLX_AGENT); } \
        const unsigned tgt_ = (unsigned)F.G; leave_group(F); conv_worker(F, done_, F.G == 256 ? (unsigned)(Gc) : tgt_, 0); __syncthreads(); } while (0)
    STAMP(3); if (IN(3)) { p3_prep(F); } SEAM(3);
    STAMP(4); if (IN(4)) { p4_scan(F); if (DBL(4)) p4_scan(F); } SEAM(4);
    STAMP(5); if (IN(5)) {
        gu32* done = F.ctl + CW_DONE + 64 * 5;
        if (enter_group(F, GC_ATTN)) {
            p5_mlstm_out(F); if (DBL(14)) p5_mlstm_out(F); p5_attention(F, (char*)lds);
            __syncthreads();
            if (F.tid == 0) __hip_atomic_fetch_add(done, 1u, RLX_AGENT);
        }
        const unsigned tgt = (unsigned)F.G; leave_group(F);
        conv_worker(F, done, F.G == 256 ? (unsigned)GC_ATTN : tgt, 0);
        __syncthreads();
    } SEAM(5);
    STAMP(6); if (IN(6)) { p6_combine(F); } SEAM(6);
    STAMP(7); if (IN(7)) {
        pg8::Gemm g{wsp<pg8::bf16_t>(F, WS_CONCAT), wsp<pg8::bf16_t>(F, WS_WOUT), S, D, D}; pg8::StaticOrder So; So.init(S, D, F.G, F.bid);
        EpiOut E{F.in[IN_X], wsp<float>(F, WS_MOD) + 2 * D, wsp<float>(F, WS_H1)};
        pg8::gemm_phase<EpiOut, pg8::StaticOrder, false, true>(F.lds + RING_OFF, g, So, E);
        if (DBL(7)) pg8::gemm_phase<EpiOut, pg8::StaticOrder, false, true>(F.lds + RING_OFF, g, So, E);
    } SEAM(7);
    STAMP(8); if (IN(8)) { p7_router(F); if (DBL(8)) p7_router(F); } SEAM(8);
    STAMP(9); if (IN(9)) { p8_gather(F); if (DBL(9)) p8_gather(F); __syncthreads(); conv_worker(F, nullptr, 0u, 1); __syncthreads(); } SEAM(9);
    STAMP(10); if (IN(10)) {
        build_expert_table(F, (const int*)(F.ws + WS_POS) + S * 4);
        gu32* done = F.ctl + CW_DONE + 64 * 10;
        const int units = ((const LAS int*)(F.lds + TAB_OFF))[32] * 16, rounds = (units + 255) >> 8; int gc = rounds > 0 ? (((units + rounds - 1) / rounds + 7) >> 3) << 3 : 256; gc = gc > 256 ? 256 : gc;
        gc = __builtin_amdgcn_readfirstlane(gc);
        if (enter_group(F, gc)) {
            pg8::Gemm g{wsp<pg8::bf16_t>(F, WS_XG), wsp<pg8::bf16_t>(F, WS_WUG), MAXROWS, 4096, D / 2}; GroupedOrder So{(const LAS int*)(F.lds + TAB_OFF), 16, F.G, F.bid};
            EpiSwiglu E{wsp<unsigned char>(F, WS_ACT), F.in[IN_BUG]};
            pg8::gemm_phase8<EpiSwiglu, GroupedOrder, true, true>(F.lds + RING_OFF, g, So, E);
            __syncthreads();
            if (F.tid == 0) __hip_atomic_fetch_add(done, 1u, RLX_AGENT);
        }
        leave_group(F);
        __syncthreads(); conv_worker(F, nullptr, 0u, 2); __syncthreads();
    } SEAM(10);
    STAMP(11); if (IN(11)) {
        build_expert_table(F, (const int*)(F.ws + WS_POS) + S * 4);
        pg8::Gemm g{wsp<pg8::bf16_t>(F, WS_ACT), wsp<pg8::bf16_t>(F, WS_WD), MAXROWS, D, FF / 2}; GroupedOrder So{(const LAS int*)(F.lds + TAB_OFF), 8, F.G, F.bid};
        EpiDown E{wsp<bf16>(F, WS_Y), F.in[IN_BD], wsp<float>(F, WS_ROWW)};
        pg8::gemm_phase8<EpiDown, GroupedOrder, true, true>(F.lds + RING_OFF, g, So, E);
        if (DBL(11)) pg8::gemm_phase8<EpiDown, GroupedOrder, true, true>(F.lds + RING_OFF, g, So, E);
    } SEAM(11);
    STAMP(12); if (IN(12)) { p11_final(F, PROBE_SCALE()); if (DBL(12)) p11_final(F, PROBE_SCALE()); }
#undef IN
#undef SEAM
}
}
#ifndef MK_DEBUG
#define MK_DEBUG 0
#endif
#ifndef MK_PH_END
#define MK_PH_END mk::N_PHASES
#endif
#ifndef MK_SPLIT
#define MK_SPLIT 0
#endif
extern "C" void kernel_launch(void* const* d_in, const int* in_sizes, int n_in, void* d_out, int out_size, void* d_ws, size_t ws_size, hipStream_t stream) {
    using namespace mk;
    static int grid = 0;
    if (grid == 0) {
        int dev = 0, cus = 0, per_cu = 0;
        if (hipGetDevice(&dev) != hipSuccess || hipDeviceGetAttribute(&cus, hipDeviceAttributeMultiprocessorCount, dev) != hipSuccess) { fprintf(stderr, "kernel_launch: device query failed\n"); grid = -1; return; }
        if (hipFuncSetAttribute((const void*)mega_fwd, hipFuncAttributeMaxDynamicSharedMemorySize, LDS_BYTES) != hipSuccess) { fprintf(stderr, "kernel_launch: hipFuncSetAttribute failed\n"); grid = -1; return; }
        if (hipOccupancyMaxActiveBlocksPerMultiprocessor(&per_cu, (const void*)mega_fwd, NTHR, LDS_BYTES) != hipSuccess || per_cu < 1) fprintf(stderr, "kernel_launch: occupancy query reports %d\n", per_cu);
        (void)hipGetLastError();
        grid = cus;
        if (n_in != 24 || out_size != S * D || ws_size < (MK_DEBUG ? WS_NAIVE + (size_t)2300 * MiB : WS_END)) fprintf(stderr, "kernel_launch: unexpected sizes n_in %d out %d ws %zu\n", n_in, out_size, ws_size);
    }
    if (grid < 0) return;
    (void)hipMemsetAsync((char*)d_ws + WS_CTL, 0, CTL_ZERO_BYTES, stream);
    Args a{};
    for (int i = 0; i < 24; ++i) a.in[i] = (const float*)d_in[i];
    a.out = (float*)d_out; a.ws = (unsigned char*)d_ws;
#if MK_DEBUG
    nv::naive_forward(d_in, (float*)d_out, (char*)d_ws + WS_NAIVE, stream);
#endif
#if MK_SPLIT
    for (int p = 0; p < MK_PH_END; ++p) { a.ph_lo = p; a.ph_hi = p + 1; a.li = p; hipLaunchKernelGGL(mega_fwd, dim3(grid), dim3(NTHR), LDS_BYTES, stream, a); }
#else
    a.ph_lo = 0; a.ph_hi = MK_PH_END; a.li = 0;
    hipLaunchKernelGGL(mega_fwd, dim3(grid), dim3(NTHR), LDS_BYTES, stream, a);
#endif
#ifdef MK_EXTRA_LO
    a.ph_lo = MK_EXTRA_LO; a.ph_hi = MK_EXTRA_HI; a.li = 1;
    hipLaunchKernelGGL(mega_fwd, dim3(grid), dim3(NTHR), LDS_BYTES, stream, a);
#endif
    { const hipError_t le = hipPeekAtLastError(); if (le != hipSuccess) fprintf(stderr, "kernel_launch: launch failed: %s\n", hipGetErrorName(le)); }
#if MK_DEBUG
    {
        nv::NaiveWs w = nv::carve((char*)d_ws + WS_NAIVE);
        double* slots = (double*)((char*)d_ws + WS_CTL + 512 * 1024);
        unsigned char* ws = (unsigned char*)d_ws; int nc = 0;
        MK_DEBUG_CHECKS
        dbg::k_finish<<<1024, 256, 0, stream>>>((float*)d_out, (size_t)S * D, slots, nc, 1e-3);
    }
#endif
}
```

```cpp
#include <hip/hip_runtime.h>
#include <hip/hip_bf16.h>
#include <cstdio>
#include <cstdint>
namespace pg8 {
#define PG8_LAS __attribute__((address_space(3)))
typedef unsigned short bf16_t;
typedef short bf16x8 __attribute__((ext_vector_type(8)));
typedef float f32x4 __attribute__((ext_vector_type(4)));
typedef unsigned u32x4 __attribute__((ext_vector_type(4)));
constexpr int BM = 256, BK = 64, HALF = 128, HTB = HALF * BK * 2  , STAGE_BYTES = 8 * HTB, NXCD = 8, WGM = 8;

__host__ __device__ __forceinline__ int lds_byte(int r, int c) { const int st = (r >> 4) * 2 + (c >> 5), rr = r & 15, cc = c & 31, ob = rr * 64 + cc * 2; return st * 1024 + (ob ^ (((ob >> 9) & 1) << 5)); }
__host__ __device__ __forceinline__ void stage_rc(int b, int& R, int& C) { const int st = b / 1024, sb = b % 1024, swz = sb ^ (((sb >> 9) & 1) << 5); R = (st >> 1) * 16 + swz / 64; C = (st & 1) * 32 + (swz % 64) / 2; }
__host__ __device__ __forceinline__ int perm32(int rho) { const int n = rho >> 4, i = rho & 15; return 8 * (i >> 2) + 4 * n + (i & 3); }

struct Unit { int pm, pn, pb, e; };
struct Gemm { const bf16_t* A; const bf16_t* Bt; int M, N, K; };

struct StaticOrder {
    int nM, nN, nwg, G, c;
    __host__ __device__ void init(int M, int N, int G_, int c_) { nM = M / BM; nN = N / BM; nwg = nM * nN; G = G_; c = c_; }
    __host__ __device__ bool next(int i, Unit& u) const {
        const long L = (long)i * G + c; if (L >= nwg) return false;
        int wgid = (int)L; { const int q = nwg / NXCD, r = nwg % NXCD, xcd = wgid % NXCD, off = wgid / NXCD; wgid = (xcd < r ? xcd * (q + 1) : r * (q + 1) + (xcd - r) * q) + off; }
        const int nig = WGM * nN, gid = wgid / nig, fm = gid * WGM, gsz = (nM - fm) < WGM ? (nM - fm) : WGM;
        u.pm = fm + ((wgid % nig) % gsz); u.pn = (wgid % nig) / gsz; u.pb = u.pn; u.e = 0; return true;
    }
    __device__ __forceinline__ void a_ready(const Unit&) const {}
    __device__ __forceinline__ void done(const Unit&) const {}
};

__device__ __forceinline__ unsigned cvt_pk_bf16(float lo, float hi) { unsigned r; asm volatile("v_cvt_pk_bf16_f32 %0, %1, %2" : "=v"(r) : "v"(lo), "v"(hi)); return r; }
template <class Epi, class Sched, bool ALIGN_EPI = false, bool SP2 = false>
__device__ __forceinline__ void gemm_phase(PG8_LAS unsigned char* lds, const Gemm g, const Sched& S, const Epi& E) {
    const int tid = threadIdx.x, wid = __builtin_amdgcn_readfirstlane(tid >> 6), lane = tid & 63, wr = wid >> 2, wc = wid & 3, fr = lane & 15, fq = lane >> 4;
    const int K = g.K, nt = K / BK;
    unsigned voffA[2], voffB[2];
#pragma unroll
    for (int i = 0; i < 2; ++i) { int R, C; stage_rc(tid * 16 + i * 8192, R, C); const int Rb = Epi::PERM ? ((R & ~31) + perm32(R & 31)) : R;
        voffA[i] = (unsigned)(R * K + C) * 2u; voffB[i] = (unsigned)(Rb * K + C) * 2u; }
    const size_t kstep = (size_t)(BK * 2);
    const size_t hstep = (size_t)HALF * K * 2;
    const size_t tstep = 2 * hstep;
    const unsigned ldsw = (unsigned)wid * 1024u;
    const int aoff = lds_byte(wr * 64 + fr, fq * 8), boff = lds_byte(wc * 32 + fr, fq * 8);
#define PG8_SA(b, h) (((b) * 2 + (h)) * HTB)
#define PG8_SB(b, h) ((4 + (b) * 2 + (h)) * HTB)
#define PG8_STAGE(bufoff, gbase, voff) do { _Pragma("unroll") for (int _i = 0; _i < 2; ++_i) \
        __builtin_amdgcn_global_load_lds((const unsigned*)((const char*)(gbase) + (voff)[_i]), (PG8_LAS unsigned*)(lds + (bufoff) + ldsw + _i * 8192), 16, 0, 0); } while (0)
#define PG8_LDA(dst, b, h) do { _Pragma("unroll") for (int m = 0; m < 4; ++m) _Pragma("unroll") for (int k = 0; k < 2; ++k) dst[m][k] = *(const PG8_LAS bf16x8*)(lds + PG8_SA(b, h) + aoff + m * 2048 + k * 1024); } while (0)
#define PG8_LDB(dst, b, h) do { _Pragma("unroll") for (int n = 0; n < 2; ++n) _Pragma("unroll") for (int k = 0; k < 2; ++k) dst[n][k] = *(const PG8_LAS bf16x8*)(lds + PG8_SB(b, h) + boff + n * 2048 + k * 1024); } while (0)
#define PG8_MMA(ai, bj, At, Bt) do { __builtin_amdgcn_s_setprio(1); _Pragma("unroll") for (int m = 0; m < 4; ++m) _Pragma("unroll") for (int n = 0; n < 2; ++n) _Pragma("unroll") for (int k = 0; k < 2; ++k) \
        acc[ai][bj][m][n] = __builtin_amdgcn_mfma_f32_16x16x32_bf16(Bt[n][k], At[m][k], acc[ai][bj][m][n], 0, 0, 0); __builtin_amdgcn_s_setprio(0); } while (0)
#define PG8_WAIT_V(n) asm volatile("s_waitcnt vmcnt(" #n ")" ::: "memory")
#define PG8_WAIT_L(n) asm volatile("s_waitcnt lgkmcnt(" #n ")" ::: "memory")
#define PG8_BAR __builtin_amdgcn_s_barrier()
#define PG8_SCHED __builtin_amdgcn_sched_barrier(0)
    Unit cur, nxt; int ui = 0;
    if (!S.next(0, cur)) return;
    f32x4 acc[2][2][4][2];
#pragma unroll
    for (int a = 0; a < 2; ++a)
#pragma unroll
        for (int b = 0; b < 2; ++b)
#pragma unroll
            for (int m = 0; m < 4; ++m)
#pragma unroll
                for (int n = 0; n < 2; ++n) acc[a][b][m][n] = (f32x4){0.f, 0.f, 0.f, 0.f};
    bf16x8 At[4][2], B0[2][2], B1[2][2];
    const char* cA = (const char*)g.A + (size_t)cur.pm * tstep; const char* cB = (const char*)g.Bt + (size_t)cur.pb * tstep;
    S.a_ready(cur);
    if constexpr (SP2) {
        PG8_STAGE(PG8_SB(0, 0), cB, voffB); PG8_STAGE(PG8_SB(0, 1), cB + hstep, voffB); PG8_STAGE(PG8_SA(0, 0), cA, voffA); PG8_STAGE(PG8_SA(0, 1), cA + hstep, voffA);
        if (wr == 1) PG8_BAR;
        PG8_WAIT_V(2); PG8_BAR;
        PG8_STAGE(PG8_SB(1, 0), cB + kstep, voffB); PG8_STAGE(PG8_SA(1, 0), cA + kstep, voffA); PG8_STAGE(PG8_SB(1, 1), cB + hstep + kstep, voffB);
        PG8_WAIT_V(6); PG8_BAR;
    } else {
        PG8_STAGE(PG8_SB(0, 0), cB, voffB); PG8_STAGE(PG8_SA(0, 0), cA, voffA); PG8_STAGE(PG8_SB(0, 1), cB + hstep, voffB); PG8_STAGE(PG8_SA(0, 1), cA + hstep, voffA);
        if (wr == 1) PG8_BAR;
        PG8_WAIT_V(4); PG8_BAR;
        PG8_STAGE(PG8_SB(1, 0), cB + kstep, voffB); PG8_STAGE(PG8_SA(1, 0), cA + kstep, voffA); PG8_STAGE(PG8_SB(1, 1), cB + hstep + kstep, voffB);
        PG8_WAIT_V(6); PG8_BAR;
    }
    for (;;) {
        const bool has_next = S.next(ui + 1, nxt);
        const char* nA = has_next ? (const char*)g.A + (size_t)nxt.pm * tstep : cA; const char* nB = has_next ? (const char*)g.Bt + (size_t)nxt.pb * tstep : cB;
        for (int t = 0; t < nt; t += 2) {
            const bool last = (t == nt - 2);
            const char* a1 = cA + (size_t)(t + 1) * kstep;
            const char* a2 = last ? nA : cA + (size_t)(t + 2) * kstep; const char* b2 = last ? nB : cB + (size_t)(t + 2) * kstep;
            const char* a3 = a2 + kstep; const char* b3 = b2 + kstep;
            if (last && has_next) S.a_ready(nxt);
            if constexpr (SP2) {
            PG8_LDB(B0, 0, 0); PG8_LDB(B1, 0, 1); PG8_SCHED; PG8_LDA(At, 0, 0); PG8_STAGE(PG8_SA(1, 1), a1 + hstep, voffA);
            PG8_WAIT_V(8); PG8_WAIT_L(0); PG8_BAR; PG8_MMA(0, 0, At, B0); PG8_MMA(0, 1, At, B1); PG8_BAR; PG8_SCHED;
            PG8_LDA(At, 0, 1); PG8_STAGE(PG8_SB(0, 0), b2, voffB); PG8_STAGE(PG8_SB(0, 1), b2 + hstep, voffB); PG8_STAGE(PG8_SA(0, 0), a2, voffA);
            PG8_WAIT_V(8); PG8_WAIT_L(0); PG8_BAR; PG8_MMA(1, 0, At, B0); PG8_MMA(1, 1, At, B1); PG8_BAR; PG8_SCHED;
            PG8_LDB(B0, 1, 0); PG8_LDB(B1, 1, 1); PG8_SCHED; PG8_LDA(At, 1, 0); PG8_STAGE(PG8_SA(0, 1), a2 + hstep, voffA);
            PG8_WAIT_V(8); PG8_WAIT_L(0); PG8_BAR; PG8_MMA(0, 0, At, B0); PG8_MMA(0, 1, At, B1); PG8_BAR; PG8_SCHED;
            PG8_LDA(At, 1, 1); PG8_STAGE(PG8_SB(1, 0), b3, voffB); PG8_STAGE(PG8_SB(1, 1), b3 + hstep, voffB); PG8_STAGE(PG8_SA(1, 0), a3, voffA);
            PG8_WAIT_V(8); PG8_WAIT_L(0); PG8_BAR; PG8_MMA(1, 0, At, B0); PG8_MMA(1, 1, At, B1); PG8_BAR; PG8_SCHED;
            } else {
            PG8_LDB(B0, 0, 0); PG8_SCHED; PG8_LDA(At, 0, 0); PG8_STAGE(PG8_SA(1, 1), a1 + hstep, voffA);
            PG8_WAIT_L(8); PG8_BAR; PG8_WAIT_L(0); PG8_MMA(0, 0, At, B0); PG8_BAR; PG8_SCHED;
            PG8_LDB(B1, 0, 1); PG8_STAGE(PG8_SB(0, 0), b2, voffB);
            PG8_BAR; PG8_WAIT_L(0); PG8_MMA(0, 1, At, B1); PG8_BAR;
            PG8_LDA(At, 0, 1); PG8_STAGE(PG8_SA(0, 0), a2, voffA);
            PG8_BAR; PG8_WAIT_L(0); PG8_MMA(1, 0, At, B0); PG8_BAR; PG8_SCHED;
            PG8_STAGE(PG8_SB(0, 1), b2 + hstep, voffB);
            PG8_WAIT_V(6); PG8_BAR; PG8_MMA(1, 1, At, B1); PG8_BAR;
            PG8_LDB(B0, 1, 0); PG8_SCHED; PG8_LDA(At, 1, 0); PG8_STAGE(PG8_SA(0, 1), a2 + hstep, voffA);
            PG8_WAIT_L(8); PG8_BAR; PG8_WAIT_L(0); PG8_MMA(0, 0, At, B0); PG8_BAR; PG8_SCHED;
            PG8_LDB(B1, 1, 1); PG8_STAGE(PG8_SB(1, 0), b3, voffB);
            PG8_BAR; PG8_WAIT_L(0); PG8_MMA(0, 1, At, B1); PG8_BAR;
            PG8_LDA(At, 1, 1); PG8_STAGE(PG8_SA(1, 0), a3, voffA);
            PG8_BAR; PG8_WAIT_L(0); PG8_MMA(1, 0, At, B0); PG8_BAR; PG8_SCHED;
            PG8_STAGE(PG8_SB(1, 1), b3 + hstep, voffB);
            PG8_WAIT_V(6); PG8_BAR; PG8_MMA(1, 1, At, B1); PG8_BAR;
            }
        }
        if constexpr (ALIGN_EPI) { if (wr == 0) PG8_BAR; }
        if constexpr (!Epi::AFTER_DRAIN) { E(acc, cur, wr, wc, fr, fq); S.done(cur); }
        if (!has_next) break;
#pragma unroll
        for (int a = 0; a < 2; ++a)
#pragma unroll
            for (int b = 0; b < 2; ++b)
#pragma unroll
                for (int m = 0; m < 4; ++m)
#pragma unroll
                    for (int n = 0; n < 2; ++n) acc[a][b][m][n] = (f32x4){0.f, 0.f, 0.f, 0.f};
        cur = nxt; cA = nA; cB = nB; ++ui;
        if constexpr (ALIGN_EPI) { if (wr == 1) PG8_BAR; }
    }
    PG8_WAIT_V(0);
    if constexpr (!ALIGN_EPI) { if (wr == 0) PG8_BAR; }
    PG8_BAR;
    if constexpr (Epi::AFTER_DRAIN) { E.fused(acc, cur, wr, wc, fr, fq, lds, wid, lane); S.done(cur); }
#undef PG8_SA
#undef PG8_SB
#undef PG8_STAGE
#undef PG8_LDA
#undef PG8_LDB
#undef PG8_MMA
#undef PG8_WAIT_V
#undef PG8_WAIT_L
#undef PG8_BAR
#undef PG8_SCHED
}
typedef int v8i __attribute__((ext_vector_type(8)));
typedef int v4i __attribute__((ext_vector_type(4)));
constexpr int SCALE_W8 = 0x78787878, SCALE_A8 = 0x7f7f7f7f;
template <class Epi, class Sched, bool ALIGN_EPI = false, bool SP2 = false>
__device__ __forceinline__ void gemm_phase8(PG8_LAS unsigned char* lds, const Gemm g, const Sched& S, const Epi& E) {
    const int tid = threadIdx.x, wid = __builtin_amdgcn_readfirstlane(tid >> 6), lane = tid & 63, wr = wid >> 2, wc = wid & 3, fr = lane & 15, fq = lane >> 4;
    const int K = g.K, nt = K / BK;
    unsigned voffA[2], voffB[2];
#pragma unroll
    for (int i = 0; i < 2; ++i) { int R, C; stage_rc(tid * 16 + i * 8192, R, C); const int Rb = Epi::PERM ? ((R & ~31) + perm32(R & 31)) : R;
        voffA[i] = (unsigned)(R * K + C) * 2u; voffB[i] = (unsigned)(Rb * K + C) * 2u; }
    const size_t kstep = (size_t)(BK * 2);
    const size_t hstep = (size_t)HALF * K * 2;
    const size_t tstep = 2 * hstep;
    const unsigned ldsw = (unsigned)wid * 1024u;
    const int aoff = lds_byte(wr * 64 + fr, fq * 8), boff = lds_byte(wc * 32 + fr, fq * 8);
#define PG8_SA(b, h) (((b) * 2 + (h)) * HTB)
#define PG8_SB(b, h) ((4 + (b) * 2 + (h)) * HTB)
#define PG8_STAGE(bufoff, gbase, voff) do { _Pragma("unroll") for (int _i = 0; _i < 2; ++_i) \
        __builtin_amdgcn_global_load_lds((const unsigned*)((const char*)(gbase) + (voff)[_i]), (PG8_LAS unsigned*)(lds + (bufoff) + ldsw + _i * 8192), 16, 0, 0); } while (0)
#define PG8_LDA(dst, b, h) do { _Pragma("unroll") for (int m = 0; m < 4; ++m) { const v4i lo_ = *(const PG8_LAS v4i*)(lds + PG8_SA(b, h) + aoff + m * 2048), hi_ = *(const PG8_LAS v4i*)(lds + PG8_SA(b, h) + aoff + m * 2048 + 1024); \
        dst[m] = __builtin_shufflevector(lo_, hi_, 0, 1, 2, 3, 4, 5, 6, 7); } } while (0)
#define PG8_LDB(dst, b, h) do { _Pragma("unroll") for (int n = 0; n < 2; ++n) { const v4i lo_ = *(const PG8_LAS v4i*)(lds + PG8_SB(b, h) + boff + n * 2048), hi_ = *(const PG8_LAS v4i*)(lds + PG8_SB(b, h) + boff + n * 2048 + 1024); \
        dst[n] = __builtin_shufflevector(lo_, hi_, 0, 1, 2, 3, 4, 5, 6, 7); } } while (0)
#define PG8_MMA(ai, bj, At, Bt) do { __builtin_amdgcn_s_setprio(1); _Pragma("unroll") for (int m = 0; m < 4; ++m) _Pragma("unroll") for (int n = 0; n < 2; ++n) \
        asm volatile("v_mfma_scale_f32_16x16x128_f8f6f4 %0, %1, %2, %0, %3, %4 op_sel_hi:[0,0,0]" : "+v"(acc[ai][bj][m][n]) : "v"(Bt[n]), "v"(At[m]), "v"(sw8), "v"(sa8)); __builtin_amdgcn_s_setprio(0); } while (0)
#define PG8_WAIT_V(n) asm volatile("s_waitcnt vmcnt(" #n ")" ::: "memory")
#define PG8_WAIT_L(n) asm volatile("s_waitcnt lgkmcnt(" #n ")" ::: "memory")
#define PG8_BAR __builtin_amdgcn_s_barrier()
#define PG8_SCHED __builtin_amdgcn_sched_barrier(0)
    Unit cur, nxt; int ui = 0;
    if (!S.next(0, cur)) return;
    f32x4 acc[2][2][4][2];
#pragma unroll
    for (int a = 0; a < 2; ++a)
#pragma unroll
        for (int b = 0; b < 2; ++b)
#pragma unroll
            for (int m = 0; m < 4; ++m)
#pragma unroll
                for (int n = 0; n < 2; ++n) acc[a][b][m][n] = (f32x4){0.f, 0.f, 0.f, 0.f};
    v8i At[4], B0[2], B1[2]; int sw8 = SCALE_W8, sa8 = SCALE_A8;
    const char* cA = (const char*)g.A + (size_t)cur.pm * tstep; const char* cB = (const char*)g.Bt + (size_t)cur.pb * tstep;
    S.a_ready(cur);
    if constexpr (SP2) {
        PG8_STAGE(PG8_SB(0, 0), cB, voffB); PG8_STAGE(PG8_SB(0, 1), cB + hstep, voffB); PG8_STAGE(PG8_SA(0, 0), cA, voffA); PG8_STAGE(PG8_SA(0, 1), cA + hstep, voffA);
        if (wr == 1) PG8_BAR;
        PG8_WAIT_V(2); PG8_BAR;
        PG8_STAGE(PG8_SB(1, 0), cB + kstep, voffB); PG8_STAGE(PG8_SA(1, 0), cA + kstep, voffA); PG8_STAGE(PG8_SB(1, 1), cB + hstep + kstep, voffB);
        PG8_WAIT_V(6); PG8_BAR;
    } else {
        PG8_STAGE(PG8_SB(0, 0), cB, voffB); PG8_STAGE(PG8_SA(0, 0), cA, voffA); PG8_STAGE(PG8_SB(0, 1), cB + hstep, voffB); PG8_STAGE(PG8_SA(0, 1), cA + hstep, voffA);
        if (wr == 1) PG8_BAR;
        PG8_WAIT_V(4); PG8_BAR;
        PG8_STAGE(PG8_SB(1, 0), cB + kstep, voffB); PG8_STAGE(PG8_SA(1, 0), cA + kstep, voffA); PG8_STAGE(PG8_SB(1, 1), cB + hstep + kstep, voffB);
        PG8_WAIT_V(6); PG8_BAR;
    }
    for (;;) {
        const bool has_next = S.next(ui + 1, nxt);
        const char* nA = has_next ? (const char*)g.A + (size_t)nxt.pm * tstep : cA; const char* nB = has_next ? (const char*)g.Bt + (size_t)nxt.pb * tstep : cB;
        for (int t = 0; t < nt; t += 2) {
            const bool last = (t == nt - 2);
            const char* a1 = cA + (size_t)(t + 1) * kstep;
            const char* a2 = last ? nA : cA + (size_t)(t + 2) * kstep; const char* b2 = last ? nB : cB + (size_t)(t + 2) * kstep;
            const char* a3 = a2 + kstep; const char* b3 = b2 + kstep;
            if (last && has_next) S.a_ready(nxt);
            if constexpr (SP2) {
            PG8_LDB(B0, 0, 0); PG8_LDB(B1, 0, 1); PG8_SCHED; PG8_LDA(At, 0, 0); PG8_STAGE(PG8_SA(1, 1), a1 + hstep, voffA);
            PG8_WAIT_V(8); PG8_WAIT_L(0); PG8_BAR; PG8_MMA(0, 0, At, B0); PG8_MMA(0, 1, At, B1); PG8_BAR; PG8_SCHED;
            PG8_LDA(At, 0, 1); PG8_STAGE(PG8_SB(0, 0), b2, voffB); PG8_STAGE(PG8_SB(0, 1), b2 + hstep, voffB); PG8_STAGE(PG8_SA(0, 0), a2, voffA);
            PG8_WAIT_V(8); PG8_WAIT_L(0); PG8_BAR; PG8_MMA(1, 0, At, B0); PG8_MMA(1, 1, At, B1); PG8_BAR; PG8_SCHED;
            PG8_LDB(B0, 1, 0); PG8_LDB(B1, 1, 1); PG8_SCHED; PG8_LDA(At, 1, 0); PG8_STAGE(PG8_SA(0, 1), a2 + hstep, voffA);
            PG8_WAIT_V(8); PG8_WAIT_L(0); PG8_BAR; PG8_MMA(0, 0, At, B0); PG8_MMA(0, 1, At, B1); PG8_BAR; PG8_SCHED;
            PG8_LDA(At, 1, 1); PG8_STAGE(PG8_SB(1, 0), b3, voffB); PG8_STAGE(PG8_SB(1, 1), b3 + hstep, voffB); PG8_STAGE(PG8_SA(1, 0), a3, voffA);
            PG8_WAIT_V(8); PG8_WAIT_L(0); PG8_BAR; PG8_MMA(1, 0, At, B0); PG8_MMA(1, 1, At, B1); PG8_BAR; PG8_SCHED;
            } else {
            PG8_LDB(B0, 0, 0); PG8_SCHED; PG8_LDA(At, 0, 0); PG8_STAGE(PG8_SA(1, 1), a1 + hstep, voffA);
            PG8_WAIT_L(8); PG8_BAR; PG8_WAIT_L(0); PG8_MMA(0, 0, At, B0); PG8_BAR; PG8_SCHED;
            PG8_LDB(B1, 0, 1); PG8_STAGE(PG8_SB(0, 0), b2, voffB);
            PG8_BAR; PG8_WAIT_L(0); PG8_MMA(0, 1, At, B1); PG8_BAR;
            PG8_LDA(At, 0, 1); PG8_STAGE(PG8_SA(0, 0), a2, voffA);
            PG8_BAR; PG8_WAIT_L(0); PG8_MMA(1, 0, At, B0); PG8_BAR; PG8_SCHED;
            PG8_STAGE(PG8_SB(0, 1), b2 + hstep, voffB);
            PG8_WAIT_V(6); PG8_BAR; PG8_MMA(1, 1, At, B1); PG8_BAR;
            PG8_LDB(B0, 1, 0); PG8_SCHED; PG8_LDA(At, 1, 0); PG8_STAGE(PG8_SA(0, 1), a2 + hstep, voffA);
            PG8_WAIT_L(8); PG8_BAR; PG8_WAIT_L(0); PG8_MMA(0, 0, At, B0); PG8_BAR; PG8_SCHED;
            PG8_LDB(B1, 1, 1); PG8_STAGE(PG8_SB(1, 0), b3, voffB);
            PG8_BAR; PG8_WAIT_L(0); PG8_MMA(0, 1, At, B1); PG8_BAR;
            PG8_LDA(At, 1, 1); PG8_STAGE(PG8_SA(1, 0), a3, voffA);
            PG8_BAR; PG8_WAIT_L(0); PG8_MMA(1, 0, At, B0); PG8_BAR; PG8_SCHED;
            PG8_STAGE(PG8_SB(1, 1), b3 + hstep, voffB);
            PG8_WAIT_V(6); PG8_BAR; PG8_MMA(1, 1, At, B1); PG8_BAR;
            }
        }
        if constexpr (ALIGN_EPI) { if (wr == 0) PG8_BAR; }
        asm volatile("s_nop 15\n\ts_nop 7" ::: "memory");
        if constexpr (!Epi::AFTER_DRAIN) { E(acc, cur, wr, wc, fr, fq); S.done(cur); }
        if (!has_next) break;
#pragma unroll
        for (int a = 0; a < 2; ++a)
#pragma unroll
            for (int b = 0; b < 2; ++b)
#pragma unroll
                for (int m = 0; m < 4; ++m)
#pragma unroll
                    for (int n = 0; n < 2; ++n) acc[a][b][m][n] = (f32x4){0.f, 0.f, 0.f, 0.f};
        cur = nxt; cA = nA; cB = nB; ++ui;
        if constexpr (ALIGN_EPI) { if (wr == 1) PG8_BAR; }
    }
    PG8_WAIT_V(0);
    if constexpr (!ALIGN_EPI) { if (wr == 0) PG8_BAR; }
    PG8_BAR;
    if constexpr (Epi::AFTER_DRAIN) { E.fused(acc, cur, wr, wc, fr, fq, lds, wid, lane); S.done(cur); }
#undef PG8_SA
#undef PG8_SB
#undef PG8_STAGE
#undef PG8_LDA
#undef PG8_LDB
#undef PG8_MMA
#undef PG8_WAIT_V
#undef PG8_WAIT_L
#undef PG8_BAR
#undef PG8_SCHED
}
}
#define GAS __attribute__((address_space(1)))
#define LAS __attribute__((address_space(3)))
typedef unsigned short bf16;
typedef unsigned v4u __attribute__((ext_vector_type(4)));
typedef float f32x4 __attribute__((ext_vector_type(4)));
typedef short bf16x8 __attribute__((ext_vector_type(8)));
typedef GAS unsigned gu32;
typedef GAS unsigned long long gu64;
#define RLX_AGENT __ATOMIC_RELAXED, __HIP_MEMORY_SCOPE_AGENT
#define LDS_WAIT() asm volatile("s_waitcnt lgkmcnt(0)" ::: "memory")
#define VM_WAIT() asm volatile("s_waitcnt vmcnt(0)" ::: "memory")
__device__ __forceinline__ unsigned long long rt() { return __builtin_amdgcn_s_memrealtime(); }
__device__ __forceinline__ unsigned f2bf(float f) { unsigned u = __builtin_bit_cast(unsigned, f); return (u + 0x7fffu + ((u >> 16) & 1u)) >> 16; }
__device__ __forceinline__ unsigned pk2(float lo, float hi) { return f2bf(lo) | (f2bf(hi) << 16); }

#define XB_TMO      128
#define XB_XCNT(j)  (256  + 64 * (j))
#define XB_XSUB(j)  (1280 + 64 * (j))
#define XB_XGEN(j)  (2304 + 64 * (j))
#define XB_TOP      3328
#define XB_TOPGEN   3392
#define XCD_BAR_WORDS 3456
#define XB_SPIN_CAP (1u << 18)

__device__ __forceinline__ unsigned xb_ld(unsigned* p)              { return __hip_atomic_load(p, __ATOMIC_RELAXED, __HIP_MEMORY_SCOPE_AGENT); }
__device__ __forceinline__ unsigned xb_add(unsigned* p, unsigned v) { return __hip_atomic_fetch_add(p, v, __ATOMIC_RELAXED, __HIP_MEMORY_SCOPE_AGENT); }
__device__ __forceinline__ unsigned xb_xcc_id() { return (unsigned)__builtin_amdgcn_s_getreg((3 << 11) | 20) & 0xFu; }
#define XB_SPIN(cond, bar) do { unsigned _sp = 0; while (cond) { __builtin_amdgcn_s_sleep(1); \
    if ((++_sp & 255u) == 0u) { if (xb_ld(&(bar)[XB_TMO])) break; if (_sp > XB_SPIN_CAP) { atomicAdd(&(bar)[XB_TMO], 1u); break; } } } } while (0)

struct XcdBarrier {
    unsigned* bar; unsigned x;
    volatile LAS unsigned* st;
};

__device__ __forceinline__ XcdBarrier xcd_barrier_post(unsigned* bar, volatile LAS unsigned* st) {
    XcdBarrier b; b.bar = bar; b.x = xb_xcc_id(); b.st = st;
    if (threadIdx.x == 0) (void)xb_add(&bar[XB_XCNT(b.x)], 1u);
    return b;
}
__device__ __forceinline__ void xcd_barrier_complete(unsigned* bar, unsigned x, unsigned& nloc, unsigned& nx) {
    const unsigned G = gridDim.x * gridDim.y * gridDim.z;
    unsigned sum, cnt, mine, sp = 0u;
    for (;;) {
        sum = 0u; cnt = 0u; mine = 0u;
#pragma unroll
        for (unsigned j = 0; j < 16; ++j) { const unsigned c = xb_ld(&bar[XB_XCNT(j)]); sum += c; cnt += (c > 0u) ? 1u : 0u; mine = (j == x) ? c : mine; }
        if (sum == G) break;
        __builtin_amdgcn_s_sleep(1);
        if ((++sp & 255u) == 0u) { if (xb_ld(&bar[XB_TMO])) break; if (sp > XB_SPIN_CAP) { atomicAdd(&bar[XB_TMO], 1u); break; } }
    }
    nloc = mine > 0u ? mine : 1u; nx = cnt > 0u ? cnt : 1u;
}

__device__ __forceinline__ void xcd_barrier(const XcdBarrier& b) {
    asm volatile("s_waitcnt vmcnt(0)" ::: "memory");
    __syncthreads();
    if (threadIdx.x == 0) {
        unsigned* bar = b.bar;
        __builtin_amdgcn_s_waitcnt(0);
        unsigned nloc = b.st[0], nx = b.st[1];
        if (nloc == 0u) { xcd_barrier_complete(bar, b.x, nloc, nx); b.st[0] = nloc; b.st[1] = nx; }
        const unsigned old = xb_add(&bar[XB_XSUB(b.x)], 1u);
        const unsigned gen = old / nloc;
        if (old + 1u == (gen + 1u) * nloc) {
            __builtin_amdgcn_fence(__ATOMIC_RELEASE, "agent");
            asm volatile("s_waitcnt vmcnt(0)" ::: "memory");
            const unsigned og = xb_add(&bar[XB_TOP], 1u);
            const unsigned tg = og / nx;
            if (og + 1u == (tg + 1u) * nx) xb_add(&bar[XB_TOPGEN], 1u);
            else XB_SPIN(xb_ld(&bar[XB_TOPGEN]) == tg, bar);
            __builtin_amdgcn_fence(__ATOMIC_ACQUIRE, "agent");
            xb_add(&bar[XB_XGEN(b.x)], 1u);
            asm volatile("s_waitcnt vmcnt(0)" ::: "memory");
        } else {
            XB_SPIN(xb_ld(&bar[XB_XGEN(b.x)]) == gen, bar);
            __builtin_amdgcn_fence(__ATOMIC_ACQUIRE, "agent");
            asm volatile("s_waitcnt vmcnt(0)" ::: "memory");
        }
    }
    __syncthreads();
}
namespace mk {
constexpr int S = 8192, D = 2048, NPROJ = 6160, NPP = 6144, NPAD = 6400, NE = 32, FF = 2048, NWAVES = 8, NTHR = 512;
constexpr int C_MQ = 0, C_MK = 512, C_MV = 1024, C_MO = 2048, C_FQ = 3072, C_FK = 4096, C_FV = 5120;
constexpr int MAXROWS = S * 4 + NE * 256;
constexpr int NCH = 128, LCH = 64;
constexpr size_t MiB = 1u << 20;
constexpr size_t WS_CTL = 0, CTL_ZERO_BYTES = 1 * MiB;
constexpr size_t WS_MODP = 14 * MiB;
constexpr size_t WS_MOD = 2 * MiB;
constexpr size_t WS_GATES = 3 * MiB;
constexpr size_t WS_F = 4 * MiB;
constexpr size_t WS_NL = 5 * MiB;
constexpr size_t WS_NS = 6 * MiB;
constexpr size_t WS_GLAL = 7 * MiB;
constexpr size_t WS_MS = 7 * MiB + 65536;
constexpr size_t WS_TOPI = 8 * MiB;
constexpr size_t WS_TOPW = 9 * MiB;
constexpr size_t WS_HIST = 10 * MiB;
constexpr size_t WS_LRANK = 11 * MiB;
constexpr size_t WS_POS = 12 * MiB;
constexpr size_t WS_ROWW = 13 * MiB;
constexpr size_t WS_WIN = 16 * MiB;
constexpr size_t WS_WOUT = 42 * MiB;
constexpr size_t WS_HN = 50 * MiB;
constexpr size_t WS_PROJ = 82 * MiB;
constexpr size_t WS_UL = 178 * MiB;
constexpr size_t WS_CS = 242 * MiB;
constexpr size_t WS_CONCAT = 274 * MiB;
constexpr size_t WS_H1 = 306 * MiB;
constexpr size_t WS_XG = 370 * MiB;
constexpr size_t WS_ACT = 530 * MiB;
constexpr size_t WS_Y = 690 * MiB;
constexpr size_t WS_WUG = 850 * MiB;
constexpr size_t WS_WD = 1362 * MiB;
constexpr size_t WS_OPART = 1618 * MiB;
constexpr size_t WS_MLP = 1786 * MiB;
constexpr size_t WS_JLO = 1789 * MiB;
constexpr size_t WS_END = 1790 * MiB;
constexpr size_t WS_NAIVE = 1792 * MiB;
constexpr int CW_TMO = 0, CW_CODE = 1, CW_CONV = 65536, CW_DONE = 2048, CW_BAR = 4096;
constexpr int GC_INPROJ = 160, GC_ATTN = 160, GC_PREP = 192;
constexpr int RING_OFF = 0, RING_BYTES = 131072;
constexpr int LDSCTL_OFF = RING_BYTES, MISC_OFF = LDSCTL_OFF + 320;
constexpr int TAB_OFF = LDSCTL_OFF + 1024;
constexpr int ATT_CH = 16;
constexpr int LDS_BYTES = 147456;
}
namespace mk {
typedef float f32x2 __attribute__((ext_vector_type(2)));
typedef unsigned u32x2 __attribute__((ext_vector_type(2)));
struct Frame {
    LAS unsigned char* lds;
    volatile LAS unsigned* MISC;
    gu32* ctl;
    int tid, lane, wave, vcu, G, bid;
    const float* in[24];
    float* out; unsigned char* ws;
};
#define IN_X 0
#define IN_C 1
#define IN_WADA 2
#define IN_BADA 3
#define IN_NMIX 4
#define IN_WIN 5
#define IN_BI 6
#define IN_BF 7
#define IN_FOXBF 8
#define IN_FOXQN 9
#define IN_FOXKN 10
#define IN_MOUTN 11
#define IN_FOUTN 12
#define IN_WOUT 13
#define IN_NFFN 14
#define IN_WR 15
#define IN_BR 16
#define IN_WUG 17
#define IN_BUG 18
#define IN_WD 19
#define IN_BD 20
#define IN_WAF 21
#define IN_BAF 22
#define IN_NFIN 23
template <class T> __device__ __forceinline__ T* wsp(const Frame& F, size_t off) { return (T*)(F.ws + off); }
__device__ __forceinline__ float wave_sum(float v) {
#pragma unroll
    for (int o = 1; o < 64; o <<= 1) v += __shfl_xor(v, o);
    return v;
}
__device__ __forceinline__ float sigmoid_f(float v) { return 1.f / (1.f + __expf(-v)); }
__device__ __forceinline__ float log_sigmoid_f(float v) { return fminf(v, 0.f) - log1pf(__expf(-fabsf(v))); }
__device__ __forceinline__ float softcap_f(float v) { return 15.f * tanhf(v * (1.f / 15.f)); }
__device__ __forceinline__ float bf2f(unsigned short b) { return __uint_as_float(((unsigned)b) << 16); }

struct CvtItem { const float* src; bf16* dst; };
__device__ __forceinline__ void cvt_load(const CvtItem& it, int ldw, f32x4 (&v)[16], int lane) {
    const float* p = it.src + (size_t)((lane >> 4) * 16) * ldw + (lane & 15) * 4;
#pragma unroll
    for (int i = 0; i < 16; ++i) v[i] = __builtin_nontemporal_load((const GAS f32x4*)(p + (size_t)i * ldw));
}
__device__ __forceinline__ void cvt_store(const CvtItem& it, int K, const f32x4 (&v)[16], LAS unsigned char* scr, int lane) {
    const int c = lane & 15, g = lane >> 4;
#pragma unroll
    for (int j = 0; j < 4; ++j) {
        v4u a, b;
        a.x = pk2(v[0][j], v[1][j]); a.y = pk2(v[2][j], v[3][j]); a.z = pk2(v[4][j], v[5][j]); a.w = pk2(v[6][j], v[7][j]);
        b.x = pk2(v[8][j], v[9][j]); b.y = pk2(v[10][j], v[11][j]); b.z = pk2(v[12][j], v[13][j]); b.w = pk2(v[14][j], v[15][j]);
        LAS unsigned char* q = scr + (4 * c + j) * 144 + 32 * g;
        *(LAS v4u*)q = a; *(LAS v4u*)(q + 16) = b; }
    LDS_WAIT(); asm volatile("" ::: "memory");
#pragma unroll
    for (int i = 0; i < 8; ++i) { const int row = (lane >> 3) + 8 * i; const v4u o = *(const LAS v4u*)(scr + row * 144 + (lane & 7) * 16);
        *(GAS v4u*)(it.dst + (size_t)row * K + (lane & 7) * 8) = o; }
    LDS_WAIT(); asm volatile("" ::: "memory");
}
__device__ __forceinline__ unsigned pk4_fp8(float a, float b, float c, float d) { int r = __builtin_amdgcn_cvt_pk_fp8_f32(a, b, 0, false); r = __builtin_amdgcn_cvt_pk_fp8_f32(c, d, r, true); return (unsigned)r; }
constexpr float W8S = 128.f;
__device__ __forceinline__ void cvt8_pack(const f32x4 (&v)[16], LAS unsigned char* scr, int half, int lane) {
    const int c = lane & 15, g = lane >> 4;
#pragma unroll
    for (int j = 0; j < 4; ++j) { v4u a;
        a.x = pk4_fp8(v[0][j] * W8S, v[1][j] * W8S, v[2][j] * W8S, v[3][j] * W8S); a.y = pk4_fp8(v[4][j] * W8S, v[5][j] * W8S, v[6][j] * W8S, v[7][j] * W8S);
        a.z = pk4_fp8(v[8][j] * W8S, v[9][j] * W8S, v[10][j] * W8S, v[11][j] * W8S); a.w = pk4_fp8(v[12][j] * W8S, v[13][j] * W8S, v[14][j] * W8S, v[15][j] * W8S);
        *(LAS v4u*)(scr + (4 * c + j) * 144 + half * 64 + 16 * g) = a; }
}
__device__ __forceinline__ void cvt8_flush(unsigned char* dst, int kbytes, LAS unsigned char* scr, int lane) {
    LDS_WAIT(); asm volatile("" ::: "memory");
#pragma unroll
    for (int i = 0; i < 8; ++i) { const int row = (lane >> 3) + 8 * i; const v4u o = *(const LAS v4u*)(scr + row * 144 + (lane & 7) * 16);
        __builtin_nontemporal_store(o, (GAS v4u*)(dst + (size_t)row * kbytes + (lane & 7) * 16)); }
    LDS_WAIT(); asm volatile("" ::: "memory");
}
constexpr int CV8_UG = NE * 16 * 64, CV8_D = NE * 16 * 32, CV8_TOTAL = CV8_UG + CV8_D;
struct Cvt8Item { const float* src; unsigned char* dst; int ldw; };
__device__ __forceinline__ Cvt8Item cvt8_item(const Frame& F, int it, int half) {
    Cvt8Item r;
    if (it < CV8_UG) { const int e = it >> 10, q = it & 1023, kb = q >> 6, nb = q & 63, d0 = nb * 64, j = d0 >> 8, wv = d0 & 255, sc = wv < 128 ? 128 * j + wv : 2048 + 128 * j + (wv - 128);
        r.ldw = 4096; r.src = F.in[IN_WUG] + (size_t)e * D * 4096 + (size_t)(kb * 128 + half * 64) * 4096 + sc; r.dst = wsp<unsigned char>(F, WS_WUG) + (size_t)e * 4096 * D + (size_t)d0 * D + kb * 128; return r; }
    it -= CV8_UG;
    { const int e = it >> 9, q = it & 511, kb = q >> 5, nb = q & 31;
        r.ldw = D; r.src = F.in[IN_WD] + (size_t)e * FF * D + (size_t)(kb * 128 + half * 64) * D + nb * 64; r.dst = wsp<unsigned char>(F, WS_WD) + (size_t)e * D * FF + (size_t)(nb * 64) * FF + kb * 128; return r; }
}
__device__ __forceinline__ void cvt8_load(const Cvt8Item& it, f32x4 (&v)[16], int lane) {
    const float* p = it.src + (size_t)((lane >> 4) * 16) * it.ldw + (lane & 15) * 4;
#pragma unroll
    for (int i = 0; i < 16; ++i) v[i] = __builtin_nontemporal_load((const GAS f32x4*)(p + (size_t)i * it.ldw));
}
constexpr int CV_IN = 32 * 96, CV_OUT = 32 * 32, CV_TOTAL = CV_IN + CV_OUT;
__device__ __forceinline__ CvtItem cvt_item(const Frame& F, int it, int& ldw, int& K) {
    CvtItem r;
    if (it < CV_IN) { const int kb = it / 96, nb = it % 96, d0 = nb * 64, sc = d0 < 3072 ? d0 : d0 + 8;
        ldw = NPROJ; K = D; r.src = F.in[IN_WIN] + (size_t)(kb * 64) * NPROJ + sc; r.dst = wsp<bf16>(F, WS_WIN) + (size_t)d0 * D + kb * 64; return r; }
    it -= CV_IN;
    { const int kb = it >> 5, nb = it & 31; ldw = D; K = D; r.src = F.in[IN_WOUT] + (size_t)(kb * 64) * D + nb * 64; r.dst = wsp<bf16>(F, WS_WOUT) + (size_t)(nb * 64) * D + kb * 64; return r; }
}
__device__ __forceinline__ void p0_gemv(Frame& F) {
    const int gw = F.vcu * NWAVES + F.wave, NGW = F.G * NWAVES, lane = F.lane;
    {
        const float* c = F.in[IN_C]; float* modp = wsp<float>(F, WS_MODP);
        for (int task = gw; task < 2048; task += NGW) {
            const int cg = task & 63, ks = task >> 6, j = cg * 256 + 4 * lane;
            const float* w; int ld, col;
            if (j < 6 * D) { w = F.in[IN_WADA]; ld = 6 * D; col = j; } else { w = F.in[IN_WAF]; ld = 2 * D; col = j - 6 * D; }
            const float c0 = c[ks * 64 + lane]; const float s0 = c0 * sigmoid_f(c0);
            const float* wp = w + (size_t)(ks * 64) * ld + col; f32x4 acc = {0.f, 0.f, 0.f, 0.f};
#pragma unroll 16
            for (int i = 0; i < 64; ++i) acc += __builtin_nontemporal_load((const GAS f32x4*)(wp + (size_t)i * ld)) * __builtin_bit_cast(float, __builtin_amdgcn_readlane(__builtin_bit_cast(int, s0), i));
            *(GAS f32x4*)(modp + ks * 16384 + j) = acc;
        }
    }
    {
        bf16* win_t = wsp<bf16>(F, WS_WIN);
        for (int i2 = gw; i2 < D / 4; i2 += NGW) {
            const int col = lane & 15, k = 4 * i2 + (lane >> 4), sc = col < 8 ? 3072 + col : 6152 + (col - 8);
            win_t[(size_t)(NPP + col) * D + k] = (bf16)f2bf(F.in[IN_WIN][(size_t)k * NPROJ + sc]); }
        const v4u z = {0u, 0u, 0u, 0u};
        for (int i = gw * 64 + lane; i < 16 * D / 8; i += NGW * 64) *(GAS v4u*)(win_t + (size_t)NPROJ * D + (size_t)i * 8) = z;
    }
}
constexpr int CV8_NSH = 32, CV8_SHA = CV8_UG / CV8_NSH, CV8_SHB = CV8_D / CV8_NSH;
#define CONV_NEXT(var) do { var = CV8_TOTAL; \
        if (useA) { const int b_ = __builtin_amdgcn_readfirstlane((int)(lane == 0 ? __hip_atomic_fetch_add(ctrA, 1u, RLX_AGENT) : 0u)); if (b_ < CV8_SHA) var = xs * CV8_SHA + b_; else useA = false; } \
        if (var == CV8_TOTAL && useB) { const int b_ = __builtin_amdgcn_readfirstlane((int)(lane == 0 ? __hip_atomic_fetch_add(ctrB, 1u, RLX_AGENT) : 0u)); if (b_ < CV8_SHB) var = CV8_UG + xs * CV8_SHB + b_; else useB = false; } } while (0)
__device__ __forceinline__ void conv_worker(Frame& F, gu32* stop, unsigned target, int which) {
    LAS unsigned char* scr = F.lds + RING_OFF + F.wave * 9216; const int lane = F.lane, xs = (int)(blockIdx.x & (CV8_NSH - 1));
    gu32* ctrA = F.ctl + CW_CONV + 64 * xs; gu32* ctrB = F.ctl + CW_CONV + 64 * (CV8_NSH + xs);
    bool useA = which != 2, useB = which != 1;
    int it; CONV_NEXT(it); if (it >= CV8_TOTAL) return;
    f32x4 va[16], vb[16];
    Cvt8Item cur = cvt8_item(F, it, 0); cvt8_load(cur, va, lane);
    for (;;) {
        const Cvt8Item c1 = cvt8_item(F, it, 1); cvt8_load(c1, vb, lane);
        bool stopnow = false;
        if (stop) stopnow = (unsigned)__builtin_amdgcn_readfirstlane((int)__hip_atomic_load(stop, RLX_AGENT)) >= target;
        int itn = CV8_TOTAL; if (!stopnow) CONV_NEXT(itn);
        cvt8_pack(va, scr, 0, lane);
        const bool more = itn < CV8_TOTAL; Cvt8Item nx = cur;
        if (more) { nx = cvt8_item(F, itn, 0); cvt8_load(nx, va, lane); }
        cvt8_pack(vb, scr, 1, lane);
        cvt8_flush(cur.dst, D, scr, lane);
        if (!more) break;
        cur = nx; it = itn;
    }
}
__device__ __forceinline__ bool enter_group(Frame& F, int Gc) {
    if (F.G != 256 || Gc >= 256) return true;
    const int bx = (int)blockIdx.x, slot = bx >> 3, xcd = bx & 7, per = Gc >> 3;
    if (slot >= per) return false;
    F.vcu = xcd * per + slot; F.bid = slot * 8 + xcd; F.G = Gc; return true;
}
__device__ __forceinline__ void leave_group(Frame& F) { const int bx = (int)blockIdx.x, G = (int)gridDim.x; F.G = G; F.bid = bx; F.vcu = (G % 8 == 0) ? (bx % 8) * (G / 8) + bx / 8 : bx; }
__device__ __forceinline__ void p1_convert(Frame& F) {
    const int gw = F.vcu * NWAVES + F.wave, NGW = F.G * NWAVES, lane = F.lane;
    {
        LAS unsigned char* scr = F.lds + RING_OFF + F.wave * 9216;
        int it = gw;
        if (it < CV_TOTAL) {
            int ldw, K; CvtItem cur = cvt_item(F, it, ldw, K); f32x4 va[16], vb[16];
            cvt_load(cur, ldw, va, lane);
            for (;;) {
                int itn = it + NGW; int ldn = 0, Kn = 0; CvtItem nx = cur; const bool more = itn < CV_TOTAL;
                if (more) { nx = cvt_item(F, itn, ldn, Kn); cvt_load(nx, ldn, vb, lane); }
                cvt_store(cur, K, va, scr, lane);
                if (!more) break;
                it = itn + NGW; const bool more2 = it < CV_TOTAL; CvtItem n2 = nx; int ld2 = 0, K2 = 0;
                if (more2) { n2 = cvt_item(F, it, ld2, K2); cvt_load(n2, ld2, va, lane); }
                cvt_store(nx, Kn, vb, scr, lane);
                if (!more2) break;
                cur = n2; K = K2;
            }
        }
    }
}
__device__ __forceinline__ void mod_reduce_lds(Frame& F, int j0, int n, LAS float* dst) {
    const float* modp = wsp<float>(F, WS_MODP);
    for (int i = F.tid; i < n; i += NTHR) { const int j = j0 + i; float a = j < 6 * D ? F.in[IN_BADA][j] : F.in[IN_BAF][j - 6 * D];
#pragma unroll
        for (int ks = 0; ks < 32; ++ks) a += modp[ks * 16384 + j];
        dst[i] = a; }
}
__device__ __forceinline__ void modulate_row_bf16(const float* xrow, const float* g, const LAS float* sh, const LAS float* sc, bf16* orow, int lane) {
    const GAS f32x4* xr = (const GAS f32x4*)xrow + lane; f32x4 v[8]; float s2 = 0.f;
#pragma unroll
    for (int j = 0; j < 8; ++j) { v[j] = xr[64 * j]; s2 += (v[j].x * v[j].x + v[j].y * v[j].y) + (v[j].z * v[j].z + v[j].w * v[j].w); }
    const float r = rsqrtf(wave_sum(s2) * (1.f / D) + 1e-6f);
    GAS u32x2* o8 = (GAS u32x2*)orow + lane;
#pragma unroll
    for (int j = 0; j < 8; ++j) { const int c0 = 4 * lane + 256 * j; const f32x4 gg = *(const GAS f32x4*)(g + c0); const f32x4 a = *(const LAS f32x4*)(sc + c0), b = *(const LAS f32x4*)(sh + c0);
        const f32x4 y = v[j] * r * gg * (a + 1.f) + b; u32x2 w; w.x = pk2(y.x, y.y); w.y = pk2(y.z, y.w); o8[64 * j] = w; }
}
typedef float f32x16 __attribute__((ext_vector_type(16)));
typedef short s16x8g __attribute__((ext_vector_type(8)));
__device__ __forceinline__ void p1_modulate(Frame& F) {
    LAS float* shs = (LAS float*)(F.lds + RING_OFF + 81920);
    LAS float* gred = (LAS float*)(F.lds + RING_OFF + 98304);
    mod_reduce_lds(F, 0, 2 * D, shs);
    if (F.tid < 64) {
        const float* modp = wsp<float>(F, WS_MODP); float* mod = wsp<float>(F, WS_MOD);
        for (int j = blockIdx.x * 64 + F.tid; j < 16384; j += F.G * 64) { float a = j < 6 * D ? F.in[IN_BADA][j] : F.in[IN_BAF][j - 6 * D];
#pragma unroll
            for (int ks = 0; ks < 32; ++ks) a += modp[ks * 16384 + j];
            mod[j] = a; }
    }
    __syncthreads();
    bf16* hn = wsp<bf16>(F, WS_HN); const bf16* wg = wsp<bf16>(F, WS_WIN) + (size_t)NPP * D; float* gates = wsp<float>(F, WS_GATES);
    const int lane = F.lane, w = F.wave, hi = lane >> 5, l31 = lane & 31;
    for (int rb = F.vcu; rb < S / 32; rb += F.G) {
        const int row0 = rb * 32;
#pragma unroll 1
        for (int i = 0; i < 4; ++i) { const int m = row0 + 4 * w + i; asm volatile("" ::: "memory"); modulate_row_bf16(F.in[IN_X] + (size_t)m * D, F.in[IN_NMIX], shs, shs + D, hn + (size_t)m * D, lane); }
        asm volatile("s_waitcnt vmcnt(0)" ::: "memory");
        __syncthreads();
        f32x16 acc;
#pragma unroll
        for (int r = 0; r < 16; ++r) acc[r] = 0.f;
        const bf16* ap = hn + (size_t)(row0 + l31) * D + 256 * w + 8 * hi; const bf16* bp = wg + (size_t)l31 * D + 256 * w + 8 * hi;
#pragma unroll
        for (int ks = 0; ks < 16; ++ks) { const s16x8g a = *(const GAS s16x8g*)(ap + 16 * ks), b = *(const GAS s16x8g*)(bp + 16 * ks); acc = __builtin_amdgcn_mfma_f32_32x32x16_bf16(a, b, acc, 0, 0, 0); }
        if (l31 < 16) {
#pragma unroll
            for (int r = 0; r < 16; ++r) gred[(w * 32 + (r & 3) + 8 * (r >> 2) + 4 * hi) * 16 + l31] = acc[r]; }
        __syncthreads();
        { const int row = F.tid >> 4, n = F.tid & 15; float s = 0.f;
#pragma unroll
            for (int q = 0; q < 8; ++q) s += gred[(q * 32 + row) * 16 + n];
            gates[(size_t)(row0 + row) * 16 + n] = s; }
        __syncthreads();
    }
    p1_convert(F);
}
using pg8::Unit; using pg8::cvt_pk_bf16;
struct EpiProj {
    static constexpr bool PERM = true, AFTER_DRAIN = false;
    bf16* O;
    __device__ __forceinline__ void operator()(const pg8::f32x4 (&acc)[2][2][4][2], const Unit& u, int wr, int wc, int fr, int fq) const {
        const int row0 = u.pm * 256 + wr * 64 + fr, col0 = u.pn * 256 + wc * 32 + 8 * fq;
#pragma unroll
        for (int ai = 0; ai < 2; ++ai)
#pragma unroll
            for (int m = 0; m < 4; ++m) { bf16* rowp = O + (size_t)(row0 + ai * 128 + m * 16) * NPP + col0;
#pragma unroll
                for (int bj = 0; bj < 2; ++bj) { const pg8::f32x4 v0 = acc[ai][bj][m][0], v1 = acc[ai][bj][m][1];
                    pg8::u32x4 w; w.x = cvt_pk_bf16(v0[0], v0[1]); w.y = cvt_pk_bf16(v0[2], v0[3]); w.z = cvt_pk_bf16(v1[0], v1[1]); w.w = cvt_pk_bf16(v1[2], v1[3]);
                    *(pg8::u32x4*)(rowp + bj * 128) = w; } }
    }
};
struct EpiOut {
    static constexpr bool PERM = false, AFTER_DRAIN = false;
    const float* x; const float* g1; float* h1;
    __device__ __forceinline__ void operator()(const pg8::f32x4 (&acc)[2][2][4][2], const Unit& u, int wr, int wc, int fr, int fq) const {
        const int row0 = u.pm * 256 + wr * 64 + fr, col0 = u.pn * 256 + wc * 32 + 4 * fq;
        pg8::f32x4 gv[2][2];
#pragma unroll
        for (int bj = 0; bj < 2; ++bj)
#pragma unroll
            for (int n = 0; n < 2; ++n) gv[bj][n] = *(const pg8::f32x4*)(g1 + col0 + bj * 128 + n * 16);
#pragma unroll
        for (int ai = 0; ai < 2; ++ai)
#pragma unroll
            for (int m = 0; m < 4; ++m) { const size_t off = (size_t)(row0 + ai * 128 + m * 16) * D + col0;
#pragma unroll
                for (int bj = 0; bj < 2; ++bj)
#pragma unroll
                    for (int n = 0; n < 2; ++n) { const pg8::f32x4 xv = *(const pg8::f32x4*)(x + off + bj * 128 + n * 16);
                        *(pg8::f32x4*)(h1 + off + bj * 128 + n * 16) = xv + gv[bj][n] * acc[ai][bj][m][n]; } }
    }
};
}
namespace fox {
constexpr int D = 128, SQ = 8192, SKV = 8192; constexpr float THR = 8.f; constexpr bool WSKIP = false;
constexpr int PITCH = 6144;
constexpr int OPITCH = 2048;
constexpr float SCALE = 0.08838834764831845f;
constexpr int NW = 8, QBLK = 32, KVBLK = 64, QB = NW * QBLK;
constexpr int SHM_V = KVBLK * D * 2, SHM_K = KVBLK * D * 2;
constexpr int LDS_BIAS = 2 * SHM_V + 2 * SHM_K + NW * 64 * 4;
constexpr int LDS_BYTES = LDS_BIAS + 512;

using bf16 = __hip_bfloat16;
typedef short bf16x8 __attribute__((ext_vector_type(8)));
typedef short s16x4 __attribute__((ext_vector_type(4)));
typedef float f32x16 __attribute__((ext_vector_type(16)));
typedef float f32x4 __attribute__((ext_vector_type(4)));
typedef unsigned u32x4 __attribute__((ext_vector_type(4)));
template <class A, class Bt> struct same_t { static constexpr bool v = false; };
template <class A> struct same_t<A, A> { static constexpr bool v = true; };

#define KSWZ(row, colB) ((row) * 256 + ((colB) ^ (((row) & 7) << 4)))
#define SBAR() __builtin_amdgcn_sched_barrier(0)
__device__ __forceinline__ int v_st(int k, int c) { const int kk = (k & ~0xC) | ((k & 4) << 1) | ((k & 8) >> 1); return ((kk >> 3) * 4 + (c >> 5)) * 512 + ((kk & 7) * 32 + (c & 31)) * 2; }
__device__ __forceinline__ int v_rd_base(int lane) { return ((lane & 3) << 3) | (((lane >> 2) & 3) << 6) | (((lane >> 4) & 1) << 5) | (((lane >> 5) & 1) << 8); }
constexpr int v_rd_off(int d0, int ks, int half) { return d0 * 512 + ks * 4096 + half * 2048; }
__device__ __forceinline__ int crow(int r, int hi) { return (r & 3) + 8 * (r >> 2) + 4 * hi; }
__device__ __forceinline__ int bias_slot(int kk) { return ((kk >> 2) & 1) * 32 + (kk >> 5) * 16 + (kk & 3) + 4 * ((kk & 31) >> 3); }
__device__ __forceinline__ unsigned cvtpk(float lo, float hi) {
    unsigned r; asm volatile("v_cvt_pk_bf16_f32 %0, %1, %2" : "=v"(r) : "v"(lo), "v"(hi)); return r;
}
__device__ __forceinline__ bf16x8 pack8(f32x4 a, f32x4 b) {
    u32x4 w = {cvtpk(a[0], a[1]), cvtpk(a[2], a[3]), cvtpk(b[0], b[1]), cvtpk(b[2], b[3])};
    return *reinterpret_cast<bf16x8*>(&w);
}
template <class T> __device__ __forceinline__ bf16x8 load8(const T* p) {
    if constexpr (same_t<T, float>::v) { return pack8(*(const f32x4*)p, *(const f32x4*)(p + 4)); }
    else { return *reinterpret_cast<const bf16x8*>(p); }
}
__device__ __forceinline__ void mask_tile(f32x16& p0, f32x16& p1, int dq, unsigned W) {
    const float NEG = -__builtin_inff();
#pragma unroll
    for (int r = 0; r < 16; ++r) {
        const int c = (r & 3) + 8 * (r >> 2);
        if ((unsigned)(dq - c) >= W) p0[r] = NEG;
        if ((unsigned)(dq - c - 32) >= W) p1[r] = NEG;
    }
}
__device__ __forceinline__ void partialSM(f32x16& p0, f32x16& p1, float& m_reg, float& mn, float& alpha) {
    float pmax = p0[0]; for (int r = 1; r < 16; ++r) pmax = fmaxf(pmax, p0[r]); for (int r = 0; r < 16; ++r) pmax = fmaxf(pmax, p1[r]);
    { auto rr = __builtin_amdgcn_permlane32_swap(__float_as_uint(pmax), __float_as_uint(pmax), false, false);
      pmax = fmaxf(__uint_as_float(rr[0]), __uint_as_float(rr[1])); }
    constexpr float C2 = 1.4426950408889634f * SCALE;
    if (__builtin_expect(__all((pmax - m_reg) * SCALE <= THR), 1)) { mn = m_reg; alpha = 1.f; }
    else { mn = fmaxf(m_reg, pmax); alpha = __builtin_amdgcn_exp2f((m_reg - mn) * C2); m_reg = mn; }
    const float mnL = -mn * C2;
    for (int r = 0; r < 16; ++r) p0[r] = fmaf(p0[r], C2, mnL); for (int r = 0; r < 16; ++r) p1[r] = fmaf(p1[r], C2, mnL);
    for (int r = 0; r < 16; ++r) p0[r] = __builtin_amdgcn_exp2f(p0[r]);
}
__device__ __forceinline__ void finishSM(f32x16& p0, f32x16& p1, float alpha, float& l_reg, bf16x8& pa0, bf16x8& pa1, bf16x8& pa2, bf16x8& pa3) {
    for (int r = 0; r < 16; ++r) p1[r] = __builtin_amdgcn_exp2f(p1[r]);
    float ps = 0; for (int r = 0; r < 16; ++r) ps += p0[r]; for (int r = 0; r < 16; ++r) ps += p1[r];
    { auto rr = __builtin_amdgcn_permlane32_swap(__float_as_uint(ps), __float_as_uint(ps), false, false);
      ps = __uint_as_float(rr[0]) + __uint_as_float(rr[1]); }
    l_reg = l_reg * alpha + ps;
#define PK4(P, B_, OUT) do { unsigned a0 = cvtpk(P[B_+0], P[B_+1]), a1 = cvtpk(P[B_+2], P[B_+3]);                          \
        unsigned b0 = cvtpk(P[B_+4], P[B_+5]), b1 = cvtpk(P[B_+6], P[B_+7]);                                             \
        auto r0 = __builtin_amdgcn_permlane32_swap(a0, b0, false, false); auto r1 = __builtin_amdgcn_permlane32_swap(a1, b1, false, false); \
        u32x4 w = {r0[0], r1[0], r0[1], r1[1]}; OUT = *reinterpret_cast<bf16x8*>(&w); } while (0)
    PK4(p0, 0, pa0); PK4(p0, 8, pa1); PK4(p1, 0, pa2); PK4(p1, 8, pa3);
#undef PK4
}
template <int KB, bool SK>
__device__ __forceinline__ void qkt(f32x16& p0, f32x16& p1, const char* K_lds, int r32, int hi, const bf16x8* qr, bool act) {
    if (SK && !act) { const float NEG = -__builtin_inff();
#pragma unroll
        for (int r = 0; r < 16; ++r) { p0[r] = NEG; p1[r] = NEG; } return; }
    { const f32x16* bp = reinterpret_cast<const f32x16*>(K_lds - 2 * SHM_V + LDS_BIAS + KB * 256 + hi * 128); p0 = bp[0]; p1 = bp[1]; }
    const char* kb[4];
#pragma unroll
    for (int dd = 0; dd < 4; ++dd) kb[dd] = K_lds + KB * SHM_K + KSWZ(r32, (dd * 16 + hi * 8) * 2);
#pragma unroll
    for (int d0 = 0; d0 < 8; ++d0) { const char* a = kb[d0 & 3] + (d0 >> 2) * 128;
        bf16x8 b0 = *reinterpret_cast<const bf16x8*>(a);
        bf16x8 b1 = *reinterpret_cast<const bf16x8*>(a + 32 * 256);
        p0 = __builtin_amdgcn_mfma_f32_32x32x16_bf16(b0, qr[d0], p0, 0, 0, 0);
        p1 = __builtin_amdgcn_mfma_f32_32x32x16_bf16(b1, qr[d0], p1, 0, 0, 0); }
}
template <int VB, bool SK>
__device__ __forceinline__ void pv_tile(f32x16* o, int vb0, bf16x8 pa0, bf16x8 pa1, bf16x8 pa2, bf16x8 pa3, bool act) {
    if (SK && !act) return;
#define TRRD(dst, off) asm volatile("ds_read_b64_tr_b16 %0, %1 offset:%2" : "=&v"(dst) : "v"(vb0), "i"(off) : "memory")
#define PV_D0(d0) do { s16x4 l0, l1, l2, l3, h0, h1, h2, h3; constexpr int b_ = VB * SHM_V + v_rd_off(d0, 0, 0);     \
        TRRD(l0, b_); TRRD(h0, b_ + 2048); TRRD(l1, b_ + 4096); TRRD(h1, b_ + 6144); TRRD(l2, b_ + 8192); TRRD(h2, b_ + 10240); TRRD(l3, b_ + 12288); TRRD(h3, b_ + 14336); \
        asm volatile("s_waitcnt lgkmcnt(0)" ::: "memory"); SBAR();                 \
        o[d0] = __builtin_amdgcn_mfma_f32_32x32x16_bf16(pa0, (bf16x8){l0[0], l0[1], l0[2], l0[3], h0[0], h0[1], h0[2], h0[3]}, o[d0], 0, 0, 0);   \
        o[d0] = __builtin_amdgcn_mfma_f32_32x32x16_bf16(pa1, (bf16x8){l1[0], l1[1], l1[2], l1[3], h1[0], h1[1], h1[2], h1[3]}, o[d0], 0, 0, 0);   \
        o[d0] = __builtin_amdgcn_mfma_f32_32x32x16_bf16(pa2, (bf16x8){l2[0], l2[1], l2[2], l2[3], h2[0], h2[1], h2[2], h2[3]}, o[d0], 0, 0, 0);   \
        o[d0] = __builtin_amdgcn_mfma_f32_32x32x16_bf16(pa3, (bf16x8){l3[0], l3[1], l3[2], l3[3], h3[0], h3[1], h3[2], h3[3]}, o[d0], 0, 0, 0); } while (0)
    PV_D0(0); PV_D0(1); PV_D0(2); PV_D0(3);
#undef PV_D0
#undef TRRD
}

template <class TIn, class TOut> struct BlockRef { const TIn* Q; const TIn* K; const TIn* V; TOut* O; int P0; const float* Fb; const float* gain;
    int jlo, jhi;
    float* Op; float* ML; };
template <class TIn> struct Seam {
    bf16x8 qr[8];
    bf16x8 st_v0, st_v1, st_k0, st_k1; f32x4 sf0, sf1, sf2, sf3; float st_b;
    f32x4 tq[16];
};
__device__ __forceinline__ int swa_jlo(int P0, int W) { const int lowk = P0 - W + 1; return lowk > 0 ? lowk / KVBLK : 0; }
#define ROW(p, k0, rr) ((p) + (size_t)((k0) + (rr)) * PITCH + sc)
#define VMW() asm volatile("s_waitcnt vmcnt(0)" ::: "memory")
#define VMWN(n) asm volatile("s_waitcnt vmcnt(%0)" :: "i"(n) : "memory")
#define SLOAD_H(Kp, Vp, k0) SLOAD_HB(Kp, Vp, k0, cur)
#define SLOAD_HB(Kp, Vp, k0, blk) do { S.st_v0 = load8<TIn>(ROW(Vp, k0, sr)); S.st_v1 = load8<TIn>(ROW(Vp, k0, 32 + sr));              \
                         S.st_k0 = load8<TIn>(ROW(Kp, k0, sr)); S.st_k1 = load8<TIn>(ROW(Kp, k0, 32 + sr)); \
                         if (tid < 64) S.st_b = ((blk).Fb[(blk).P0] - (blk).Fb[(k0) + tid]) * (1.0f / SCALE); } while (0)
#define SWRITE_HK(bf) do { *(bf16x8*)(K_lds + (bf) * SHM_K + kws) = S.st_k0; *(bf16x8*)(K_lds + (bf) * SHM_K + kws + 32 * 256) = S.st_k1; \
                         if (tid < 64) *(float*)(K_lds - 2 * SHM_V + LDS_BIAS + (bf) * 256 + bws) = S.st_b; } while (0)
#define SWRITE_HV(bf) do { *(bf16x8*)(V_lds + (bf) * SHM_V + vst0) = S.st_v0; *(bf16x8*)(V_lds + (bf) * SHM_V + vst1) = S.st_v1; } while (0)
#define SWRITE_H(bf) do { SWRITE_HV(bf); SWRITE_HK(bf); } while (0)
#define SLOAD_F(p, k0) do { S.sf0 = *(const f32x4*)ROW(p, k0, sr); S.sf1 = *(const f32x4*)(ROW(p, k0, sr) + 4);                \
                            S.sf2 = *(const f32x4*)ROW(p, k0, 32 + sr); S.sf3 = *(const f32x4*)(ROW(p, k0, 32 + sr) + 4); } while (0)
#define SWRITE_KF(bf) do { *(bf16x8*)(K_lds + (bf) * SHM_K + kws) = pack8(S.sf0, S.sf1); *(bf16x8*)(K_lds + (bf) * SHM_K + kws + 32 * 256) = pack8(S.sf2, S.sf3); } while (0)
#define SWRITE_VF(bf) do { *(bf16x8*)(V_lds + (bf) * SHM_V + vst0) = pack8(S.sf0, S.sf1); *(bf16x8*)(V_lds + (bf) * SHM_V + vst1) = pack8(S.sf2, S.sf3); } while (0)
template <class TIn, class TOut>
__device__ __forceinline__ void causal_swa_prime(const BlockRef<TIn, TOut>& cur, int W, char* lds, Seam<TIn>& S) {
    constexpr bool F32 = same_t<TIn, float>::v;
    const int tid = threadIdx.x, wid = __builtin_amdgcn_readfirstlane(tid >> 6), lane = tid & 63, r32 = lane & 31, hi = lane >> 5;
    const int sr = tid >> 4, sc = (tid & 15) * 8, kws = KSWZ(sr, sc * 2); char* K_lds = lds + 2 * SHM_V;
    const int bws = bias_slot(tid & 63) * 4;
    const int kb0 = cur.jlo * KVBLK;
    for (int d0 = 0; d0 < 8; ++d0) S.qr[d0] = load8<TIn>(cur.Q + (size_t)(wid * QBLK + r32) * PITCH + d0 * 16 + hi * 8);
    if constexpr (F32) { SLOAD_F((const float*)cur.K, kb0); VMW(); SWRITE_KF(0); SBAR(); SLOAD_F((const float*)cur.V, kb0); }
    else { SLOAD_H(cur.K, cur.V, kb0); VMW(); SWRITE_HK(0); }
    __syncthreads();
}
template <class TIn, class TOut>
__device__ __forceinline__ void causal_swa_block(const BlockRef<TIn, TOut>& cur, const BlockRef<TIn, TOut>& nxt, int skv, int W, char* lds, Seam<TIn>& S) {
    constexpr bool F32 = same_t<TIn, float>::v;
    const int tid = threadIdx.x, wid = __builtin_amdgcn_readfirstlane(tid >> 6), lane = tid & 63, r32 = lane & 31, hi = lane >> 5;
    const int j_lo = cur.jlo; const int j_hi = cur.jhi;
    const int NT = j_hi - j_lo;
    const int kbn = nxt.jlo * KVBLK;
    const int qlo = cur.P0 + wid * QBLK, qm = qlo + r32 - 4 * hi;
    char* V_lds = lds; char* K_lds = lds + 2 * SHM_V;
    float* ws = (float*)(lds + 2 * SHM_V + 2 * SHM_K) + wid * 64; float* li_l = ws, * al_l = ws + 32;
    float m_reg = -1e30f, l_reg = 0; f32x16 o[4] = {};
    const int sr = tid >> 4, sc = (tid & 15) * 8, vst0 = v_st(sr, sc), vst1 = v_st(32 + sr, sc), kws = KSWZ(sr, sc * 2);
    const int bws = bias_slot(tid & 63) * 4;
    const int vb0 = (int)(uintptr_t)V_lds + v_rd_base(lane);
    const TIn* Kh = cur.K; const TIn* Vh = cur.V;
#define RESC(a) do { if (__any((a) < 1.f)) { if (hi == 0) al_l[r32] = (a); asm volatile("s_waitcnt lgkmcnt(0)" ::: "memory");              \
                     for (int d_ = 0; d_ < 4; ++d_) for (int r = 0; r < 16; ++r) o[d_][r] *= al_l[crow(r, hi)]; } } while (0)
#define KBASE(t) ((j_lo + (t)) * KVBLK)
#define ACT(t) (KBASE(t) <= qlo + QBLK - 1 && KBASE(t) + KVBLK - 1 >= qlo - W + 1)
#define MASKT(P0_, P1_, t) do { const int kb_ = KBASE(t); if ((!SK || ACT(t)) && (kb_ + KVBLK - 1 > qlo || kb_ <= qlo + QBLK - 1 - W)) mask_tile(P0_, P1_, qm - kb_, (unsigned)W); } while (0)
    constexpr int NQL = F32 ? 16 : 8;
    constexpr bool SK = WSKIP && !F32;
#define SEAM_K0() do { VMWN(NQL); if constexpr (F32) { SWRITE_KF(0); SBAR(); SLOAD_F((const float*)nxt.V, kbn); } else { SWRITE_HK(0); } SBAR(); } while (0)
    f32x16 pA0, pA1, pB0, pB1; float mnA, mnB, alA, alB; bf16x8 pa0, pa1, pa2, pa3;
    if constexpr (F32) { VMW(); SWRITE_VF(0); SBAR(); } else { SWRITE_HV(0); SBAR(); }
    if (NT > 1) { if constexpr (F32) SLOAD_F((const float*)Kh, KBASE(1)); else SLOAD_H(Kh, Vh, KBASE(1)); }
    SBAR(); qkt<0, SK>(pA0, pA1, K_lds, r32, hi, S.qr, ACT(0));
    if constexpr (F32) { if (NT > 1) { VMW(); SWRITE_KF(1); SBAR(); SLOAD_F((const float*)Vh, KBASE(1)); } }
    MASKT(pA0, pA1, 0); partialSM(pA0, pA1, m_reg, mnA, alA);
    if (NT > 1) { VMW(); if constexpr (F32) { SWRITE_VF(1); SBAR(); if (NT > 2) SLOAD_F((const float*)Kh, KBASE(2)); } else SWRITE_H(1); }
    __syncthreads();
#define HALF_STEP(PX0, PX1, mnX, alX, PY0, PY1, alY, t, KB, VB, SB) do {                                                      \
        SBAR(); qkt<KB, SK>(PX0, PX1, K_lds, r32, hi, S.qr, ACT(t));                                             \
        finishSM(PY0, PY1, alY, l_reg, pa0, pa1, pa2, pa3); SBAR();                                                           \
        if ((t) + 1 < NT) { if constexpr (F32) { VMW(); SWRITE_KF(SB); SBAR(); SLOAD_F((const float*)Vh, KBASE((t) + 1)); }  \
                            else { SLOAD_H(Kh, Vh, KBASE((t) + 1)); } SBAR(); }                                               \
        pv_tile<VB, SK>(o, vb0, pa0, pa1, pa2, pa3, ACT((t) - 1)); MASKT(PX0, PX1, (t)); partialSM(PX0, PX1, m_reg, mnX, alX);                                        \
        __syncthreads();                                                                                                      \
        if ((t) + 1 < NT) { VMW(); if constexpr (F32) { SWRITE_VF(SB); SBAR(); if ((t) + 2 < NT) SLOAD_F((const float*)Kh, KBASE((t) + 2)); } \
                            else { SWRITE_H(SB); } }                                                                          \
        RESC(alX); __syncthreads(); } while (0)
    for (int t = 1; t + 1 < NT; t += 2) {
        HALF_STEP(pB0, pB1, mnB, alB, pA0, pA1, alA, t, 1, 0, 0);
        HALF_STEP(pA0, pA1, mnA, alA, pB0, pB1, alB, t + 1, 0, 1, 1);
    }
    const bool even = (NT & 1) == 0;
    if (even) { SBAR(); qkt<1, SK>(pB0, pB1, K_lds, r32, hi, S.qr, ACT(NT - 1)); SBAR(); }
#define QROW(e) (nxt.Q + (size_t)(wid * QBLK + r32) * PITCH + ((e) >> 1) * 16 + hi * 8 + ((e) & 1) * 4)
    if constexpr (F32) { SLOAD_F((const float*)nxt.K, kbn); SBAR();
#pragma unroll
        for (int e = 0; e < 8; ++e) S.tq[e] = *(const f32x4*)QROW(e); }
    else { SLOAD_HB(nxt.K, nxt.V, kbn, nxt); SBAR();
#pragma unroll
        for (int d0 = 0; d0 < 8; ++d0) S.qr[d0] = load8<TIn>(nxt.Q + (size_t)(wid * QBLK + r32) * PITCH + d0 * 16 + hi * 8); }
    SBAR();
    finishSM(pA0, pA1, alA, l_reg, pa0, pa1, pa2, pa3); SBAR();
    if constexpr (F32) {
#pragma unroll
        for (int e = 8; e < 16; ++e) S.tq[e] = *(const f32x4*)QROW(e); SBAR(); }
#undef QROW
    pv_tile<0, SK>(o, vb0, pa0, pa1, pa2, pa3, ACT(even ? NT - 2 : NT - 1));
    if (even) { MASKT(pB0, pB1, NT - 1); partialSM(pB0, pB1, m_reg, mnB, alB); __syncthreads(); RESC(alB);
        finishSM(pB0, pB1, alB, l_reg, pa0, pa1, pa2, pa3); SBAR(); pv_tile<1, SK>(o, vb0, pa0, pa1, pa2, pa3, ACT(NT - 1)); }
    SBAR(); SEAM_K0();
    if (hi == 0) li_l[r32] = l_reg; asm volatile("s_waitcnt lgkmcnt(0)" ::: "memory");
    if (cur.Op != nullptr) {
        int rp = r32; asm volatile("" : "+v"(rp));
        if (hi == 0) { float2 mlv; mlv.x = m_reg; mlv.y = l_reg; *(float2*)(cur.ML + 2 * (wid * QBLK + rp)) = mlv; }
        float* Pr = cur.Op + (size_t)(wid * QBLK + 4 * hi) * D + rp;
#pragma unroll
        for (int r = 0; r < 16; ++r) {
#pragma unroll
            for (int d0 = 0; d0 < 4; ++d0) Pr[d0 * 32] = o[d0][r];
            Pr += ((r & 3) == 3 ? 5 : 1) * D; asm volatile("" : "+v"(Pr) :: "memory"); }
    } else {
    int ro = r32; asm volatile("" : "+v"(ro));
    TOut* Or = cur.O + (size_t)(wid * QBLK + 4 * hi) * OPITCH + ro;
    float gn[4];
#pragma unroll
    for (int d0 = 0; d0 < 4; ++d0) gn[d0] = cur.gain[d0 * 32 + ro];
#pragma unroll
    for (int r = 0; r < 16; ++r) { const int orow = crow(r, hi); const float rl = __builtin_amdgcn_rcpf(li_l[orow]);
        float v[4]; float ss = 0.f;
#pragma unroll
        for (int d0 = 0; d0 < 4; ++d0) { v[d0] = o[d0][r] * rl; ss += v[d0] * v[d0]; }
        ss += __shfl_xor(ss, 1); ss += __shfl_xor(ss, 2); ss += __shfl_xor(ss, 4); ss += __shfl_xor(ss, 8); ss += __shfl_xor(ss, 16);
        const float rn = __builtin_amdgcn_rsqf(ss * (1.0f / 128.0f) + 1e-6f);
#pragma unroll
        for (int d0 = 0; d0 < 4; ++d0) { const float vv = v[d0] * rn * gn[d0]; const float vn = __shfl_xor(vv, 1);
            if ((ro & 1) == 0) *(unsigned*)(Or + d0 * 32) = cvtpk(vv, vn); }
        Or += ((r & 3) == 3 ? 5 : 1) * OPITCH; asm volatile("" : "+v"(Or) :: "memory"); }
    }
    if constexpr (F32) {
#pragma unroll
        for (int d0 = 0; d0 < 8; ++d0) S.qr[d0] = pack8(S.tq[2 * d0], S.tq[2 * d0 + 1]); }
    __syncthreads();
#undef RESC
#undef KBASE
#undef ACT
#undef MASKT
#undef SEAM_K0
#undef HALF_STEP
}
#undef ROW
#undef VMW
#undef VMWN
#undef SLOAD_H
#undef SWRITE_HK
#undef SWRITE_HV
#undef SWRITE_H
#undef SLOAD_F
#undef SWRITE_KF
#undef SWRITE_VF

}
namespace mk {
typedef short s16x8 __attribute__((ext_vector_type(8)));
#define MFMA32(a, b, c) __builtin_amdgcn_mfma_f32_32x32x16_bf16((a), (b), (c), 0, 0, 0)
__device__ __forceinline__ int crow32(int r, int hi) { return (r & 3) + 8 * (r >> 2) + 4 * hi; }
constexpr float SCALEQ = 0.08838834764831845f;
__device__ __forceinline__ float wave_scan_add(float v, int lane) {
#pragma unroll
    for (int o = 1; o < 64; o <<= 1) { const float t = __shfl_up(v, o); if (lane >= o) v += t; }
    return v;
}
__device__ __forceinline__ float wave_scan_max(float v, int lane) {
#pragma unroll
    for (int o = 1; o < 64; o <<= 1) { const float t = __shfl_up(v, o); if (lane >= o) v = fmaxf(v, t); }
    return v;
}
__device__ __forceinline__ float wave_max(float v) {
#pragma unroll
    for (int o = 1; o < 64; o <<= 1) v = fmaxf(v, __shfl_xor(v, o));
    return v;
}
constexpr int TSTR = 72;
template <bool SCALED>
__device__ __forceinline__ void stage_transposed(const bf16* src, int ncols, LAS bf16* T, const LAS float* wl, int tid) {
    const int cpr = ncols / 8;
    for (int q = tid; q < 64 * cpr; q += NTHR) { const int s = q / cpr, c8 = (q % cpr) * 8;
        const v4u raw = *(const GAS v4u*)(src + (size_t)s * NPP + c8);
        const unsigned w4[4] = {raw.x, raw.y, raw.z, raw.w};
#pragma unroll
        for (int j = 0; j < 4; ++j) { unsigned lo = w4[j] & 0xffffu, hi = w4[j] >> 16;
            if (SCALED) { const float sc = wl[s]; lo = f2bf(bf2f((unsigned short)lo) * sc); hi = f2bf(bf2f((unsigned short)hi) * sc); }
            T[(c8 + 2 * j) * TSTR + s] = (bf16)lo; T[(c8 + 2 * j + 1) * TSTR + s] = (bf16)hi; } }
}
__device__ __forceinline__ void p3_prep(Frame& F) {
    const int gw = F.vcu * NWAVES + F.wave, NGW = F.G * NWAVES, lane = F.lane, tid = F.tid;
    bf16* proj = wsp<bf16>(F, WS_PROJ); const float* gates = wsp<float>(F, WS_GATES);
    {
        const int seg = lane >> 2, qd = (lane & 3) * 32; const float* gn = (seg < 8 ? F.in[IN_FOXQN] : F.in[IN_FOXKN]) + qd;
        for (int m = gw; m < S; m += NGW) {
            bf16* p = proj + (size_t)m * NPP + C_FQ + seg * 128 + qd; v4u raw[4]; float x[32]; float ss = 0.f;
#pragma unroll
            for (int j = 0; j < 4; ++j) raw[j] = *(const GAS v4u*)(p + 8 * j);
#pragma unroll
            for (int j = 0; j < 4; ++j) { const unsigned w4[4] = {raw[j].x, raw[j].y, raw[j].z, raw[j].w};
#pragma unroll
                for (int i = 0; i < 4; ++i) { x[8 * j + 2 * i] = bf2f((unsigned short)(w4[i] & 0xffffu)); x[8 * j + 2 * i + 1] = bf2f((unsigned short)(w4[i] >> 16)); } }
#pragma unroll
            for (int i = 0; i < 32; ++i) ss += x[i] * x[i];
            ss += __shfl_xor(ss, 1); ss += __shfl_xor(ss, 2);
            const float r = rsqrtf(ss * (1.f / 128.f) + 1e-6f);
#pragma unroll
            for (int j = 0; j < 4; ++j) { v4u o; const f32x4 g0 = *(const GAS f32x4*)(gn + 8 * j), g1 = *(const GAS f32x4*)(gn + 8 * j + 4);
                o.x = pk2(x[8 * j] * r * g0.x, x[8 * j + 1] * r * g0.y); o.y = pk2(x[8 * j + 2] * r * g0.z, x[8 * j + 3] * r * g0.w);
                o.z = pk2(x[8 * j + 4] * r * g1.x, x[8 * j + 5] * r * g1.y); o.w = pk2(x[8 * j + 6] * r * g1.z, x[8 * j + 7] * r * g1.w);
                *(GAS v4u*)(p + 8 * j) = o; }
        }
    }
    if (blockIdx.x < 8) {
        const int h = blockIdx.x; const float b = F.in[IN_FOXBF][h]; float* Fo = wsp<float>(F, WS_F) + h * S;
        LAS double* tot = (LAS double*)(F.lds + RING_OFF);
        double loc[16]; double acc = 0.0;
#pragma unroll
        for (int i = 0; i < 16; ++i) { acc += (double)log_sigmoid_f(gates[(size_t)(tid * 16 + i) * 16 + 8 + h] + b); loc[i] = acc; }
        tot[tid] = acc;
        __syncthreads();
        if (F.wave == 0) { double v[8]; double s = 0.0;
#pragma unroll
            for (int i = 0; i < 8; ++i) { v[i] = tot[lane * 8 + i]; s += v[i]; }
            double inc = s;
#pragma unroll
            for (int o = 1; o < 64; o <<= 1) { const double t = __shfl_up(inc, o); if (lane >= o) inc += t; }
            double ex = inc - s;
#pragma unroll
            for (int i = 0; i < 8; ++i) { tot[lane * 8 + i] = ex; ex += v[i]; } }
        __syncthreads();
        const double off = tot[tid];
        LAS float* Fl = (LAS float*)(F.lds + RING_OFF + 8192);
#pragma unroll
        for (int i = 0; i < 16; ++i) { const float fv = (float)(off + loc[i]); Fo[tid * 16 + i] = fv; Fl[tid * 16 + i] = fv; }
        __syncthreads();
        if (tid < 32) {
            float gq = 0.f, gk = 0.f;
#pragma unroll
            for (int j = 0; j < 4; ++j) { gq = fmaxf(gq, fabsf(F.in[IN_FOXQN][tid + 32 * j])); gk = fmaxf(gk, fabsf(F.in[IN_FOXKN][tid + 32 * j])); }
#pragma unroll
            for (int o = 1; o < 32; o <<= 1) { gq = fmaxf(gq, __shfl_xor(gq, o)); gk = fmaxf(gk, __shfl_xor(gk, o)); }
            const float thr = 2.f * 11.3137085f * gq * gk + 26.f;
            const int qb = tid, P0 = qb * 256; const float f0 = Fl[P0];
            int lo = 0, hi2 = 4 * qb;
            while (lo < hi2) { const int mid = (lo + hi2) >> 1; if (Fl[64 * mid + 63] - f0 <= thr) hi2 = mid; else lo = mid + 1; }
            wsp<int>(F, WS_JLO)[h * 32 + qb] = lo;
        }
        __syncthreads();
    }
    {
        LAS bf16* KT = (LAS bf16*)(F.lds + RING_OFF);
        LAS bf16* VT = KT + 128 * TSTR;
        LAS float* wl = (LAS float*)(VT + 256 * TSTR);
        float* UL = wsp<float>(F, WS_UL); float* NL = wsp<float>(F, WS_NL); float* GLAL = wsp<float>(F, WS_GLAL);
        const int hi = lane >> 5, l31 = lane & 31, w = F.wave;
        for (int u = F.vcu; u < 4 * NCH; u += F.G) {
            const int h = u >> 7, ch = u & 127, t0 = ch * LCH;
            if (w == 0) {
                const float ip = softcap_f(gates[(size_t)(t0 + lane) * 16 + h] + F.in[IN_BI][h]);
                const float fp = softcap_f(gates[(size_t)(t0 + lane) * 16 + 4 + h] + F.in[IN_BF][h]);
                const float g = wave_scan_add(log_sigmoid_f(fp), lane), a = ip - g, amax = wave_max(a);
                wl[lane] = __expf(a - amax);
                if (lane == 63) { GLAL[u * 2] = g; GLAL[u * 2 + 1] = amax; }
            }
            __syncthreads();
            stage_transposed<true>(proj + (size_t)t0 * NPP + C_MK + h * 128, 128, KT, wl, tid);
            stage_transposed<false>(proj + (size_t)t0 * NPP + C_MV + h * 256, 256, VT, wl, tid);
            __syncthreads();
            f32x16 acc[4];
#pragma unroll
            for (int dt = 0; dt < 4; ++dt)
#pragma unroll
                for (int r = 0; r < 16; ++r) acc[dt][r] = 0.f;
#pragma unroll
            for (int ks = 0; ks < 4; ++ks) { const s16x8 a = *(const LAS s16x8*)(VT + (32 * w + l31) * TSTR + 16 * ks + 8 * hi);
#pragma unroll
                for (int dt = 0; dt < 4; ++dt) { const s16x8 b = *(const LAS s16x8*)(KT + (32 * dt + l31) * TSTR + 16 * ks + 8 * hi); acc[dt] = MFMA32(a, b, acc[dt]); } }
            float* ut = UL + (size_t)u * 256 * 128;
#pragma unroll
            for (int dt = 0; dt < 4; ++dt)
#pragma unroll
                for (int r = 0; r < 16; ++r) ut[(size_t)(32 * w + crow32(r, hi)) * 128 + 32 * dt + l31] = acc[dt][r];
            if (tid < 128) { float s = 0.f;
#pragma unroll
                for (int j = 0; j < 8; ++j) { const s16x8 kv = *(const LAS s16x8*)(KT + tid * TSTR + 8 * j);
#pragma unroll
                    for (int i = 0; i < 8; ++i) s += bf2f((unsigned short)kv[i]); }
                NL[u * 128 + tid] = s; }
            __syncthreads();
        }
    }
}
__device__ __forceinline__ void p4_scan(Frame& F) {
    LAS float* gl = (LAS float*)(F.lds + RING_OFF);
    LAS float* dec = gl + 256; LAS float* scl = dec + 128; LAS float* mv = scl + 128;
    const float* UL = wsp<float>(F, WS_UL); const float* NL = wsp<float>(F, WS_NL); const float* GLAL = wsp<float>(F, WS_GLAL);
    bf16* CS = wsp<bf16>(F, WS_CS); float* NS = wsp<float>(F, WS_NS); float* MS = wsp<float>(F, WS_MS);
    const int tid = F.tid;
    for (int blk = F.vcu; blk < 4 * 64; blk += F.G) {
        const int h = blk >> 6, rem0 = (blk & 63) * 512;
        if (tid < 256) gl[tid] = GLAL[h * 256 + tid];
        __syncthreads();
        if (tid == 0) { float m = 0.f;
            for (int c = 0; c < NCH; ++c) { const float g = gl[2 * c], al = gl[2 * c + 1], mn = g + fmaxf(m, al);
                mv[c] = m; dec[c] = __expf(g + m - mn); scl[c] = __expf(g + al - mn); m = mn; } }
        __syncthreads();
        if (rem0 == 0 && tid < 128) MS[h * 128 + tid] = mv[tid];
        const int rem = rem0 + tid;
        const float* ul = UL + (size_t)h * NCH * 32768 + rem; bf16* cs = CS + (size_t)h * NCH * 32768 + rem;
        float C = 0.f;
#pragma unroll 1
        for (int c0 = 0; c0 < NCH; c0 += 64) {
            float u[64];
#pragma unroll
            for (int i = 0; i < 64; ++i) u[i] = ul[(size_t)(c0 + i) * 32768];
#pragma unroll
            for (int i = 0; i < 64; ++i) { cs[(size_t)(c0 + i) * 32768] = (bf16)f2bf(C); C = dec[c0 + i] * C + scl[c0 + i] * u[i]; }
        }
        if (rem0 == 0 && tid < 128) { float n = 0.f; const float* nl = NL + (size_t)h * NCH * 128 + tid; float* ns = NS + (size_t)h * NCH * 128 + tid;
#pragma unroll 8
            for (int c = 0; c < NCH; ++c) { ns[c * 128] = n; n = dec[c] * n + scl[c] * nl[c * 128]; } }
        __syncthreads();
    }
}
constexpr int NUMSTR = 260;
__device__ __forceinline__ void p5_mlstm_out(Frame& F) {
    LAS bf16* VT = (LAS bf16*)(F.lds + RING_OFF);
    LAS bf16* Pm = VT + 256 * TSTR;
    LAS float* NUM = (LAS float*)(Pm + 64 * TSTR);
    LAS float* a_s = NUM + 64 * NUMSTR; LAS float* Mt = a_s + 64; LAS float* inter = Mt + 64; LAS float* emt = inter + 64; LAS float* qn = emt + 64; LAS float* dinv = qn + 64;
    const bf16* proj = wsp<bf16>(F, WS_PROJ); const float* gates = wsp<float>(F, WS_GATES); const bf16* CS = wsp<bf16>(F, WS_CS);
    const float* NS = wsp<float>(F, WS_NS); const float* MS = wsp<float>(F, WS_MS); bf16* concat = wsp<bf16>(F, WS_CONCAT);
    const int tid = F.tid, lane = F.lane, w = F.wave, hi = lane >> 5, l31 = lane & 31;
    for (int u = F.vcu; u < 4 * NCH; u += F.G) {
        const int h = u >> 7, ch = u & 127, t0 = ch * LCH;
        const bf16* qbase = proj + (size_t)t0 * NPP + C_MQ + h * 128; const bf16* kbase = proj + (size_t)t0 * NPP + C_MK + h * 128;
        if (w == 0) {
            const float ip = softcap_f(gates[(size_t)(t0 + lane) * 16 + h] + F.in[IN_BI][h]);
            const float fp = softcap_f(gates[(size_t)(t0 + lane) * 16 + 4 + h] + F.in[IN_BF][h]);
            const float g = wave_scan_add(log_sigmoid_f(fp), lane), a = ip - g, cm = wave_scan_max(a, lane);
            const float mp = MS[u], M = fmaxf(mp, cm);
            a_s[lane] = a; Mt[lane] = M; inter[lane] = __expf(mp - M); emt[lane] = __expf(-(g + M));
        }
        stage_transposed<false>(proj + (size_t)t0 * NPP + C_MV + h * 256, 256, VT, a_s, tid);
        __syncthreads();
        if (w < 4) {
            const int ti = w >> 1, si = w & 1;
            if (si <= ti) {
                s16x8 qa[8], kb[8];
#pragma unroll
                for (int ks = 0; ks < 8; ++ks) { qa[ks] = *(const GAS s16x8*)(qbase + (size_t)(32 * ti + l31) * NPP + 16 * ks + 8 * hi); kb[ks] = *(const GAS s16x8*)(kbase + (size_t)(32 * si + l31) * NPP + 16 * ks + 8 * hi); }
                f32x16 acc;
#pragma unroll
                for (int r = 0; r < 16; ++r) acc[r] = 0.f;
#pragma unroll
                for (int ks = 0; ks < 8; ++ks) acc = MFMA32(qa[ks], kb[ks], acc);
                const int s = 32 * si + l31; const float as = a_s[s];
#pragma unroll
                for (int r = 0; r < 16; ++r) { const int t = 32 * ti + crow32(r, hi); const float p = (s <= t) ? acc[r] * SCALEQ * __expf(as - Mt[t]) : 0.f; Pm[t * TSTR + s] = (bf16)f2bf(p); }
            } else {
#pragma unroll
                for (int r = 0; r < 16; ++r) Pm[(32 * ti + crow32(r, hi)) * TSTR + 32 * si + l31] = (bf16)0;
            }
        } else {
            const int t = (tid - 256) >> 2, d0 = ((tid - 256) & 3) * 32; float s = 0.f; const float* np = NS + (size_t)u * 128 + d0;
#pragma unroll
            for (int j = 0; j < 4; ++j) { const s16x8 qv = *(const GAS s16x8*)(qbase + (size_t)t * NPP + d0 + 8 * j);
#pragma unroll
                for (int i = 0; i < 8; ++i) s += bf2f((unsigned short)qv[i]) * np[8 * j + i]; }
            s += __shfl_xor(s, 1); s += __shfl_xor(s, 2);
            if ((tid & 3) == 0) qn[t] = s * SCALEQ;
        }
        __syncthreads();
        f32x16 accP[2], accC[2];
#pragma unroll
        for (int ti = 0; ti < 2; ++ti)
#pragma unroll
            for (int r = 0; r < 16; ++r) { accP[ti][r] = 0.f; accC[ti][r] = 0.f; }
        {
            const bf16* cs = CS + (size_t)u * 32768 + (size_t)(32 * w + l31) * 128 + 8 * hi;
            s16x8 cb[8];
#pragma unroll
            for (int ks = 0; ks < 8; ++ks) cb[ks] = *(const GAS s16x8*)(cs + 16 * ks);
#pragma unroll
            for (int ti = 0; ti < 2; ++ti) {
                s16x8 qa[8];
#pragma unroll
                for (int ks = 0; ks < 8; ++ks) qa[ks] = *(const GAS s16x8*)(qbase + (size_t)(32 * ti + l31) * NPP + 16 * ks + 8 * hi);
#pragma unroll
                for (int ks = 0; ks < 8; ++ks) accC[ti] = MFMA32(qa[ks], cb[ks], accC[ti]);
            }
#pragma unroll
            for (int ks = 0; ks < 4; ++ks) { const s16x8 vb = *(const LAS s16x8*)(VT + (32 * w + l31) * TSTR + 16 * ks + 8 * hi);
#pragma unroll
                for (int ti = 0; ti < 2; ++ti) { const s16x8 pa = *(const LAS s16x8*)(Pm + (32 * ti + l31) * TSTR + 16 * ks + 8 * hi); accP[ti] = MFMA32(pa, vb, accP[ti]); } }
        }
        if (w == 0) {
            float rs = 0.f;
#pragma unroll
            for (int j = 0; j < 8; ++j) { const s16x8 pv = *(const LAS s16x8*)(Pm + lane * TSTR + 8 * j);
#pragma unroll
                for (int i = 0; i < 8; ++i) rs += bf2f((unsigned short)pv[i]); }
            const float dn = rs + inter[lane] * qn[lane];
            dinv[lane] = 1.f / fmaxf(fabsf(dn), emt[lane]);
        }
        __syncthreads();
#pragma unroll
        for (int ti = 0; ti < 2; ++ti)
#pragma unroll
            for (int r = 0; r < 16; ++r) { const int t = 32 * ti + crow32(r, hi); NUM[t * NUMSTR + 32 * w + l31] = (accP[ti][r] + inter[t] * SCALEQ * accC[ti][r]) * dinv[t]; }
        __syncthreads();
        {
            const f32x4 gn = *(const GAS f32x4*)(F.in[IN_MOUTN] + h * 256 + 4 * lane);
#pragma unroll
            for (int i = 0; i < 8; ++i) { const int t = 8 * w + i; const f32x4 x = *(const LAS f32x4*)(NUM + t * NUMSTR + 4 * lane);
                const float ss = wave_sum((x.x * x.x + x.y * x.y) + (x.z * x.z + x.w * x.w)); const float r = rsqrtf(ss * (1.f / 256.f) + 1e-6f);
                const u32x2 mo = *(const GAS u32x2*)(proj + (size_t)(t0 + t) * NPP + C_MO + h * 256 + 4 * lane);
                const float o0 = x.x * r * gn.x * sigmoid_f(bf2f((unsigned short)(mo.x & 0xffffu))), o1 = x.y * r * gn.y * sigmoid_f(bf2f((unsigned short)(mo.x >> 16)));
                const float o2 = x.z * r * gn.z * sigmoid_f(bf2f((unsigned short)(mo.y & 0xffffu))), o3 = x.w * r * gn.w * sigmoid_f(bf2f((unsigned short)(mo.y >> 16)));
                u32x2 ov; ov.x = pk2(o0, o1); ov.y = pk2(o2, o3);
                *(GAS u32x2*)(concat + (size_t)(t0 + t) * D + h * 256 + 4 * lane) = ov; }
        }
        __syncthreads();
    }
}
}
namespace mk {
__device__ __forceinline__ void attn_build_schedule(Frame& F) {
    LAS int* jl = (LAS int*)(F.lds + TAB_OFF); LAS int* pre = jl + 256; LAS int* wtot = pre + 260;
    const int tid = F.tid, lane = F.lane;
    if (tid < 256) { const int j = wsp<int>(F, WS_JLO)[tid]; jl[tid] = j; const int n = 4 * (tid & 31) + 4 - j; int v = (n + ATT_CH - 1) / ATT_CH;
        int inc = v;
#pragma unroll
        for (int o = 1; o < 64; o <<= 1) { const int t = __shfl_up(inc, o); if (lane >= o) inc += t; }
        pre[tid + 1] = inc; if (lane == 63) wtot[tid >> 6] = inc; }
    __syncthreads();
    if (tid < 256) { int add = 0; for (int w2 = 0; w2 < (tid >> 6); ++w2) add += wtot[w2]; pre[tid + 1] += add; if (tid == 0) pre[0] = 0; }
    __syncthreads();
}
__device__ __forceinline__ fox::BlockRef<fox::bf16, fox::bf16> fox_ref(const Frame& F, int I) {
    const LAS int* jl = (const LAS int*)(F.lds + TAB_OFF); const LAS int* pre = jl + 256;
    int b = 0;
#pragma unroll
    for (int st = 128; st >= 1; st >>= 1) if (pre[b + st] <= I) b += st;
    b = __builtin_amdgcn_readfirstlane(b);
    const int pb0 = __builtin_amdgcn_readfirstlane(pre[b]), pb1 = __builtin_amdgcn_readfirstlane(pre[b + 1]), j0 = __builtin_amdgcn_readfirstlane(jl[b]);
    const int h = b >> 5, qb = b & 31, part = I - pb0, P = pb1 - pb0, n = 4 * qb + 4 - j0;
    fox::BlockRef<fox::bf16, fox::bf16> r;
    const fox::bf16* proj = (const fox::bf16*)(F.ws + WS_PROJ);
    r.Q = proj + (size_t)(qb * 256) * fox::PITCH + C_FQ + h * 128; r.K = proj + C_FK + h * 128; r.V = proj + C_FV + h * 128;
    r.O = (fox::bf16*)(F.ws + WS_CONCAT) + (size_t)(qb * 256) * D + 1024 + h * 128; r.P0 = qb * 256;
    r.Fb = (const float*)(F.ws + WS_F) + h * S; r.gain = F.in[IN_FOUTN] + h * 128;
    r.jlo = j0 + (part * n) / P; r.jhi = j0 + ((part + 1) * n) / P;
    r.Op = P > 1 ? (float*)(F.ws + WS_OPART) + (size_t)I * 256 * 128 : nullptr; r.ML = (float*)(F.ws + WS_MLP) + (size_t)I * 512;
    return r;
}
__device__ __forceinline__ void p5_attention(Frame& F, char* ldsg) {
    typedef fox::BlockRef<fox::bf16, fox::bf16> BR;
    attn_build_schedule(F);
    const int total = __builtin_amdgcn_readfirstlane(((const LAS int*)(F.lds + TAB_OFF))[256 + 256]);
    int L = F.vcu; if (L >= total) return;
    BR cur = fox_ref(F, L);
    fox::Seam<fox::bf16> Sm;
    fox::causal_swa_prime<fox::bf16, fox::bf16>(cur, S, ldsg, Sm);
    for (;;) {
        const bool more = L + F.G < total;
        const BR nxt = more ? fox_ref(F, L + F.G) : cur;
        fox::causal_swa_block<fox::bf16, fox::bf16>(cur, nxt, S, S, ldsg, Sm);
        if (!more) break;
        cur = nxt; L += F.G;
    }
}
__device__ __forceinline__ void p6_combine(Frame& F) {
    attn_build_schedule(F);
    const LAS int* pre = (const LAS int*)(F.lds + TAB_OFF) + 256;
    const float* OP = wsp<float>(F, WS_OPART); const float* MLP = wsp<float>(F, WS_MLP); bf16* concat = wsp<bf16>(F, WS_CONCAT);
    const int gw = F.vcu * NWAVES + F.wave, NGW = F.G * NWAVES, lane = F.lane;
    constexpr float C2 = 1.4426950408889634f * SCALEQ;
    for (int idx = gw; idx < 256 * 256; idx += NGW) {
        const int b = idx >> 8, r = idx & 255, i0 = __builtin_amdgcn_readfirstlane(pre[b]), P = __builtin_amdgcn_readfirstlane(pre[b + 1]) - i0; if (P <= 1) continue;
        const int h = b >> 5, qb = b & 31;
        f32x2 ml[8], ov[8];
#pragma unroll
        for (int p2 = 0; p2 < 8; ++p2) if (p2 < P) { ml[p2] = *(const GAS f32x2*)(MLP + (size_t)(i0 + p2) * 512 + 2 * r); ov[p2] = *(const GAS f32x2*)(OP + ((size_t)(i0 + p2) * 256 + r) * 128 + 2 * lane); }
        float ms = -3.0e38f;
#pragma unroll
        for (int p2 = 0; p2 < 8; ++p2) if (p2 < P) ms = fmaxf(ms, ml[p2].x);
        float n0 = 0.f, n1 = 0.f, den = 0.f;
#pragma unroll
        for (int p2 = 0; p2 < 8; ++p2) if (p2 < P) { const float wgt = __builtin_amdgcn_exp2f((ml[p2].x - ms) * C2); n0 += wgt * ov[p2].x; n1 += wgt * ov[p2].y; den += wgt * ml[p2].y; }
        const float inv = 1.f / den, v0 = n0 * inv, v1 = n1 * inv;
        const float ss = wave_sum(v0 * v0 + v1 * v1), rn = rsqrtf(ss * (1.f / 128.f) + 1e-6f);
        const f32x2 gn = *(const GAS f32x2*)(F.in[IN_FOUTN] + h * 128 + 2 * lane);
        *(GAS unsigned*)(concat + (size_t)(qb * 256 + r) * D + 1024 + h * 128 + 2 * lane) = pk2(v0 * rn * gn.x, v1 * rn * gn.y);
    }
}
constexpr int RROWS = 8, NITER = S / RROWS;
__device__ __forceinline__ void p7_router(Frame& F) {
    LAS float* shs = (LAS float*)(F.lds + RING_OFF);
    constexpr int HSTR = 2064;
    LAS bf16* H2hi = (LAS bf16*)(shs + 2 * D);
    LAS bf16* H2lo = H2hi + RROWS * HSTR;
    LAS float* red = (LAS float*)(H2lo + RROWS * HSTR);
    LAS int* selE = (LAS int*)(red + 8 * RROWS * NE);
    const float* mod = wsp<float>(F, WS_MOD); const float* h1 = wsp<float>(F, WS_H1); unsigned char* h2 = wsp<unsigned char>(F, WS_HN);
    int* top_i = wsp<int>(F, WS_TOPI); float* top_w = wsp<float>(F, WS_TOPW); int* hist = wsp<int>(F, WS_HIST); int* lrank = wsp<int>(F, WS_LRANK);
    const int tid = F.tid, lane = F.lane, w = F.wave;
    for (int i = tid; i < 2 * D; i += NTHR) shs[i] = mod[3 * D + i];
    __syncthreads();
    s16x8 whi[16], wlo[16];
    { const int hh = lane >> 5; const float* wp = F.in[IN_WR] + (size_t)(256 * w + 8 * hh) * NE + (lane & 31);
#pragma unroll
        for (int ks = 0; ks < 16; ++ks) { float wv[8];
#pragma unroll
            for (int j = 0; j < 8; ++j) wv[j] = wp[(size_t)(16 * ks + j) * NE];
            unsigned hw[4], lw[4];
#pragma unroll
            for (int j = 0; j < 4; ++j) { const unsigned a = f2bf(wv[2 * j]), b = f2bf(wv[2 * j + 1]); hw[j] = a | (b << 16); lw[j] = pk2(wv[2 * j] - bf2f((unsigned short)a), wv[2 * j + 1] - bf2f((unsigned short)b)); }
            const v4u hv4 = {hw[0], hw[1], hw[2], hw[3]}, lv4 = {lw[0], lw[1], lw[2], lw[3]};
            whi[ks] = __builtin_bit_cast(s16x8, hv4); wlo[ks] = __builtin_bit_cast(s16x8, lv4); } }
    for (int it = F.vcu; it < NITER; it += F.G) {
        const int r0 = it * RROWS;
        {
            const int m = r0 + w; const GAS f32x4* xr = (const GAS f32x4*)(h1 + (size_t)m * D) + lane; f32x4 v[8]; float s2 = 0.f;
#pragma unroll
            for (int j = 0; j < 8; ++j) { v[j] = xr[64 * j]; s2 += (v[j].x * v[j].x + v[j].y * v[j].y) + (v[j].z * v[j].z + v[j].w * v[j].w); }
            const float r = rsqrtf(wave_sum(s2) * (1.f / D) + 1e-6f);
            GAS unsigned* o8 = (GAS unsigned*)(h2 + (size_t)m * D) + lane;
#pragma unroll
            for (int j = 0; j < 8; ++j) { const int c0 = 4 * lane + 256 * j; const f32x4 gg = *(const GAS f32x4*)(F.in[IN_NFFN] + c0); const f32x4 a = *(const LAS f32x4*)(shs + D + c0), b = *(const LAS f32x4*)(shs + c0);
                const f32x4 y = v[j] * r * gg * (a + 1.f) + b; o8[64 * j] = pk4_fp8(y.x, y.y, y.z, y.w);
                const unsigned h0 = pk2(y.x, y.y), h1w = pk2(y.z, y.w); u32x2 hv; hv.x = h0; hv.y = h1w;
                u32x2 lv; lv.x = pk2(y.x - bf2f((unsigned short)(h0 & 0xffffu)), y.y - bf2f((unsigned short)(h0 >> 16))); lv.y = pk2(y.z - bf2f((unsigned short)(h1w & 0xffffu)), y.w - bf2f((unsigned short)(h1w >> 16)));
                *(LAS u32x2*)(H2hi + w * HSTR + c0) = hv; *(LAS u32x2*)(H2lo + w * HSTR + c0) = lv; }
        }
        __syncthreads();
        {
            f32x16 acc;
#pragma unroll
            for (int r = 0; r < 16; ++r) acc[r] = 0.f;
            const int hh = lane >> 5; const LAS bf16* bh = H2hi + (lane & 7) * HSTR + 256 * w + 8 * hh; const LAS bf16* bl = H2lo + (lane & 7) * HSTR + 256 * w + 8 * hh;
#pragma unroll
            for (int ks = 0; ks < 16; ++ks) { const s16x8 xh = *(const LAS s16x8*)(bh + 16 * ks), xl = *(const LAS s16x8*)(bl + 16 * ks);
                acc = MFMA32(whi[ks], xh, acc); acc = MFMA32(whi[ks], xl, acc); acc = MFMA32(wlo[ks], xh, acc); }
            if ((lane & 31) < RROWS) {
#pragma unroll
                for (int r = 0; r < 16; ++r) red[(w * RROWS + (lane & 31)) * NE + crow32(r, hh)] = acc[r]; }
        }
        __syncthreads();
        if (tid < RROWS * NE) {
            const int r = tid >> 5, e = tid & 31; float lg = F.in[IN_BR][e];
#pragma unroll
            for (int kp = 0; kp < 8; ++kp) lg += red[(kp * RROWS + r) * NE + e];
            float cur = lg, mx = 0.f, sum = 0.f, mysel = 0.f; int myidx = 0;
#pragma unroll
            for (int q = 0; q < 4; ++q) { float best = cur; int bi = e;
#pragma unroll
                for (int o = 1; o < 32; o <<= 1) { const float ob = __shfl_xor(best, o); const int oi = __shfl_xor(bi, o); if (ob > best || (ob == best && oi < bi)) { best = ob; bi = oi; } }
                if (q == 0) mx = best;
                sum += __expf(best - mx);
                if (e == q) { mysel = best; myidx = bi; }
                if (e == bi) cur = -3.0e38f; }
            if (e < 4) { const int t = r0 + r; top_i[t * 4 + e] = myidx; top_w[t * 4 + e] = __expf(mysel - mx) / sum; selE[r * 4 + e] = myidx; }
        }
        __syncthreads();
        if (tid < 32) { const int me = selE[tid]; int rank = 0, cnt = 0;
#pragma unroll
            for (int p = 0; p < 32; ++p) { const int ep = selE[p]; rank += (ep == me && p < tid) ? 1 : 0; cnt += (ep == tid) ? 1 : 0; }
            lrank[it * 32 + tid] = rank; hist[it * NE + tid] = cnt; }
        __syncthreads();
    }
}
__device__ __forceinline__ void build_expert_table(Frame& F, const int* counts_g) {
    LAS int* tab = (LAS int*)(F.lds + TAB_OFF);
    if (F.tid == 0) { int acc = 0; for (int e = 0; e < NE; ++e) { const int c = counts_g[e]; tab[e] = acc; tab[40 + e] = c; acc += (c + 255) >> 8; } tab[32] = acc; }
    __syncthreads();
}
__device__ __forceinline__ void p8_gather(Frame& F) {
    LAS int* psum = (LAS int*)(F.lds + RING_OFF);
    LAS int* startr = psum + 16 * NE;
    LAS int* base = startr + NE;
    const int* hist = wsp<int>(F, WS_HIST); const int* lrank = wsp<int>(F, WS_LRANK); const int* top_i = wsp<int>(F, WS_TOPI); const float* top_w = wsp<float>(F, WS_TOPW);
    int* pos = wsp<int>(F, WS_POS); float* roww = wsp<float>(F, WS_ROWW); const unsigned char* h2 = wsp<unsigned char>(F, WS_HN); unsigned char* xg = wsp<unsigned char>(F, WS_XG);
    int* counts_g = (int*)(F.ws + WS_POS) + S * 4;
    const int tid = F.tid, lane = F.lane, w = F.wave;
    { const int e = tid & 31, part = tid >> 5; int s = 0; for (int i = 0; i < NITER / 16; ++i) s += hist[(part * (NITER / 16) + i) * NE + e]; psum[part * NE + e] = s; }
    __syncthreads();
    if (tid == 0) { int acc = 0; for (int e = 0; e < NE; ++e) { int c = 0; for (int p = 0; p < 16; ++p) c += psum[p * NE + e]; startr[e] = acc; acc += ((c + 255) >> 8) << 8; if (blockIdx.x == 0) counts_g[e] = c; } }
    __syncthreads();
    for (int it = F.vcu; it < NITER; it += F.G) {
        {
            const int part = it / (NITER / 16), i0 = part * (NITER / 16);
            if (w < 4) { const bool on = (i0 + lane) < it;
#pragma unroll
                for (int q = 0; q < 8; ++q) { const int e = w * 8 + q; int v = on ? hist[(i0 + lane) * NE + e] : 0;
#pragma unroll
                    for (int o = 1; o < 64; o <<= 1) v += __shfl_xor(v, o);
                    if (lane == 0) { int b = v; for (int pp = 0; pp < part; ++pp) b += psum[pp * NE + e]; base[e] = b; } } }
        }
        __syncthreads();
#pragma unroll
        for (int j = 0; j < 4; ++j) { const int p = w + 8 * j, pair = it * 32 + p, e = top_i[pair], dest = startr[e] + base[e] + lrank[pair], t = pair >> 2;
            if (lane == 0) { pos[pair] = dest; roww[dest] = top_w[pair]; }
            const GAS v4u* src = (const GAS v4u*)(h2 + (size_t)t * D) + lane; GAS v4u* dst = (GAS v4u*)(xg + (size_t)dest * D) + lane;
#pragma unroll
            for (int q = 0; q < 2; ++q) dst[64 * q] = src[64 * q]; }
        __syncthreads();
    }
}
struct GroupedOrder {
    const LAS int* tab; int ntn, G, c;
    __device__ __forceinline__ bool next(int i, Unit& u) const {
        const int L = i * G + c, total = tab[32] * ntn; if (L >= total) return false;
        int e = 0;
#pragma unroll 1
        while (e < NE - 1 && tab[e + 1] * ntn <= L) ++e;
        const int ts = tab[e], tc = tab[e + 1] - ts, within = L - ts * ntn;
        u.pm = ts + within % tc; u.pn = within / tc; u.e = e; u.pb = e * ntn + u.pn; return true;
    }
    __device__ __forceinline__ void a_ready(const Unit&) const {}
    __device__ __forceinline__ void done(const Unit&) const {}
};
struct EpiSwiglu {
    static constexpr bool PERM = true, AFTER_DRAIN = false;
    unsigned char* act; const float* bug;
    __device__ __forceinline__ void operator()(const pg8::f32x4 (&acc)[2][2][4][2], const Unit& u, int wr, int wc, int fr, int fq) const {
        const int row0 = u.pm * 256 + wr * 64 + fr, f0 = u.pn * 128 + wc * 32 + 8 * fq;
        const float* bg = bug + (size_t)u.e * 4096 + f0; pg8::f32x4 bgv[2], buv[2];
#pragma unroll
        for (int n = 0; n < 2; ++n) { bgv[n] = *(const pg8::f32x4*)(bg + 4 * n); buv[n] = *(const pg8::f32x4*)(bg + 2048 + 4 * n); }
#pragma unroll
        for (int ai = 0; ai < 2; ++ai)
#pragma unroll
            for (int m = 0; m < 4; ++m) { float o[8];
#pragma unroll
                for (int n = 0; n < 2; ++n)
#pragma unroll
                    for (int i = 0; i < 4; ++i) { const float g = fminf(acc[ai][0][m][n][i] + bgv[n][i], 7.f); const float up = fminf(fmaxf(acc[ai][1][m][n][i] + buv[n][i], -7.f), 7.f);
                        o[4 * n + i] = (up + 1.f) * g * __builtin_amdgcn_rcpf(1.f + __builtin_amdgcn_exp2f(-2.45546696f * g)); }
                u32x2 wv; wv.x = pk4_fp8(o[0], o[1], o[2], o[3]); wv.y = pk4_fp8(o[4], o[5], o[6], o[7]);
                *(u32x2*)(act + (size_t)(row0 + ai * 128 + m * 16) * FF + f0) = wv; }
    }
};
struct EpiDown {
    static constexpr bool PERM = true, AFTER_DRAIN = false;
    bf16* y; const float* bd; const float* roww;
    __device__ __forceinline__ void operator()(const pg8::f32x4 (&acc)[2][2][4][2], const Unit& u, int wr, int wc, int fr, int fq) const {
        const int row0 = u.pm * 256 + wr * 64 + fr, col0 = u.pn * 256 + wc * 32 + 8 * fq;
        pg8::f32x4 bv[2][2];
#pragma unroll
        for (int bj = 0; bj < 2; ++bj)
#pragma unroll
            for (int n = 0; n < 2; ++n) bv[bj][n] = *(const pg8::f32x4*)(bd + (size_t)u.e * D + col0 + bj * 128 + 4 * n);
#pragma unroll
        for (int ai = 0; ai < 2; ++ai)
#pragma unroll
            for (int m = 0; m < 4; ++m) { const int row = row0 + ai * 128 + m * 16; const float rw = roww[row]; bf16* rowp = y + (size_t)row * D + col0;
#pragma unroll
                for (int bj = 0; bj < 2; ++bj) { const pg8::f32x4 v0 = (acc[ai][bj][m][0] + bv[bj][0]) * rw, v1 = (acc[ai][bj][m][1] + bv[bj][1]) * rw;
                    pg8::u32x4 wv; wv.x = cvt_pk_bf16(v0[0], v0[1]); wv.y = cvt_pk_bf16(v0[2], v0[3]); wv.z = cvt_pk_bf16(v1[0], v1[1]); wv.w = cvt_pk_bf16(v1[2], v1[3]);
                    *(pg8::u32x4*)(rowp + bj * 128) = wv; } }
    }
};
__device__ __forceinline__ void p11_final(Frame& F, float oscale) {
    LAS float* ms = (LAS float*)(F.lds + RING_OFF);
    const float* mod = wsp<float>(F, WS_MOD);
    for (int i = F.tid; i < 3 * D; i += NTHR) ms[i] = mod[5 * D + i];
    __syncthreads();
    const float* h1 = wsp<float>(F, WS_H1); const bf16* y = wsp<bf16>(F, WS_Y); const int* pos = wsp<int>(F, WS_POS);
    const int gw = F.vcu * NWAVES + F.wave, NGW = F.G * NWAVES, lane = F.lane;
    for (int t = gw; t < S; t += NGW) {
        asm volatile("" ::: "memory");
        const GAS f32x4* xr = (const GAS f32x4*)(h1 + (size_t)t * D) + lane;
        const GAS u32x2* y0 = (const GAS u32x2*)(y + (size_t)pos[t * 4 + 0] * D) + lane; const GAS u32x2* y1 = (const GAS u32x2*)(y + (size_t)pos[t * 4 + 1] * D) + lane;
        const GAS u32x2* y2 = (const GAS u32x2*)(y + (size_t)pos[t * 4 + 2] * D) + lane; const GAS u32x2* y3 = (const GAS u32x2*)(y + (size_t)pos[t * 4 + 3] * D) + lane;
        f32x4 v[8]; float s2 = 0.f;
#pragma unroll
        for (int j = 0; j < 8; ++j) { const u32x2 a = y0[64 * j], b = y1[64 * j], c = y2[64 * j], d = y3[64 * j]; const f32x4 g2 = *(const LAS f32x4*)(ms + 4 * lane + 256 * j);
            f32x4 f;
            f.x = (bf2f((unsigned short)(a.x & 0xffffu)) + bf2f((unsigned short)(b.x & 0xffffu))) + (bf2f((unsigned short)(c.x & 0xffffu)) + bf2f((unsigned short)(d.x & 0xffffu)));
            f.y = (bf2f((unsigned short)(a.x >> 16)) + bf2f((unsigned short)(b.x >> 16))) + (bf2f((unsigned short)(c.x >> 16)) + bf2f((unsigned short)(d.x >> 16)));
            f.z = (bf2f((unsigned short)(a.y & 0xffffu)) + bf2f((unsigned short)(b.y & 0xffffu))) + (bf2f((unsigned short)(c.y & 0xffffu)) + bf2f((unsigned short)(d.y & 0xffffu)));
            f.w = (bf2f((unsigned short)(a.y >> 16)) + bf2f((unsigned short)(b.y >> 16))) + (bf2f((unsigned short)(c.y >> 16)) + bf2f((unsigned short)(d.y >> 16)));
            v[j] = xr[64 * j] + g2 * f; s2 += (v[j].x * v[j].x + v[j].y * v[j].y) + (v[j].z * v[j].z + v[j].w * v[j].w); }
        const float r = rsqrtf(wave_sum(s2) * (1.f / D) + 1e-6f);
        GAS f32x4* o = (GAS f32x4*)(F.out + (size_t)t * D) + lane;
#pragma unroll
        for (int j = 0; j < 8; ++j) { const int c0 = 4 * lane + 256 * j; const f32x4 gg = *(const GAS f32x4*)(F.in[IN_NFIN] + c0); const f32x4 sh = *(const LAS f32x4*)(ms + D + c0), sc = *(const LAS f32x4*)(ms + 2 * D + c0);
            o[64 * j] = (v[j] * r * gg * (sc + 1.f) + sh) * oscale; }
    }
}
}
namespace mk {
struct Args { const float* in[24]; float* out; unsigned char* ws; int ph_lo, ph_hi, li, pad; };
constexpr int N_PHASES = 13;
__global__ void __launch_bounds__(NTHR, 2) mega_fwd(Args args) {
    extern __shared__ __attribute__((aligned(16))) unsigned char lds[];
    Frame F;
    F.lds = (LAS unsigned char*)lds;
    F.MISC = (volatile LAS unsigned*)(F.lds + MISC_OFF);
    F.tid = threadIdx.x; F.lane = F.tid & 63; F.wave = __builtin_amdgcn_readfirstlane(F.tid >> 6);
    leave_group(F);
    F.ws = args.ws; F.out = args.out; F.ctl = (gu32*)(args.ws + WS_CTL);
#pragma unroll
    for (int i = 0; i < 24; ++i) F.in[i] = args.in[i];
    for (int u = F.tid; u < (LDS_BYTES - LDSCTL_OFF) / 4; u += NTHR) ((LAS unsigned*)(F.lds + LDSCTL_OFF))[u] = 0u;
    __syncthreads();
    XcdBarrier bar = xcd_barrier_post((unsigned*)(F.ctl + CW_BAR) + args.li * XCD_BAR_WORDS, F.MISC + 8);
    const int lo = args.ph_lo, hi = args.ph_hi;
#define IN(k) (lo <= (k) && (k) < hi)
#define SEAM(k) do { if (IN(k) && IN((k) + 1)) xcd_barrier(bar); } while (0)

#ifndef MK_DOUBLE
#define MK_DOUBLE 0
#endif
#define DBL(k) ((MK_DOUBLE >> (k)) & 1)
#ifdef MK_PROBE_LO
    unsigned long long* stamps = (unsigned long long*)(F.ctl + 131072);
#define STAMP(k) do { if (blockIdx.x == 0 && F.tid == 0) stamps[k] = rt(); } while (0)
#define PROBE_SCALE() (1.f + sqrtf((float)(stamps[MK_PROBE_HI] - stamps[MK_PROBE_LO]) * 0.01f * 2e-5f))
#else
#define STAMP(k) do { } while (0)
#define PROBE_SCALE() 1.f
#endif
    STAMP(0); if (IN(0)) { p0_gemv(F); } SEAM(0);
    STAMP(1); if (IN(1)) { p1_modulate(F); if (DBL(1)) p1_modulate(F); } SEAM(1);
    STAMP(2); if (IN(2)) {
        gu32* done = F.ctl + CW_DONE + 64 * 2;
        if (enter_group(F, GC_INPROJ)) {
            pg8::Gemm g{wsp<pg8::bf16_t>(F, WS_HN), wsp<pg8::bf16_t>(F, WS_WIN), S, NPP, D}; pg8::StaticOrder So; So.init(S, NPP, F.G, F.bid);
            EpiProj E{wsp<bf16>(F, WS_PROJ)};
            pg8::gemm_phase<EpiProj, pg8::StaticOrder, true, true>(F.lds + RING_OFF, g, So, E);
            if (DBL(2)) pg8::gemm_phase<EpiProj, pg8::StaticOrder, true, true>(F.lds + RING_OFF, g, So, E);
            __syncthreads();
            if (F.tid == 0) __hip_atomic_fetch_add(done, 1u, RLX_AGENT);
        }
        const unsigned tgt = (unsigned)F.G; leave_group(F);
        conv_worker(F, done, F.G == 256 ? (unsigned)GC_INPROJ : tgt, 0);
        __syncthreads();
    } SEAM(2);
#define GROUPED(k, Gc, body) do { gu32* done_ = F.ctl + CW_DONE + 64 * (k); if (enter_group(F, (Gc))) { body; __syncthreads(); if (F.tid == 0) __hip_atomic_fetch_add(done_, 1u, RLX_AGENT); } \
        const unsigned tgt_ = (unsigned)F.G; leave_group(F); conv_worker(F, done_, F.G == 256 ? (unsigned)(Gc) : tgt_, 0); __syncthreads(); } while (0)
    STAMP(3); if (IN(3)) { p3_prep(F); } SEAM(3);
    STAMP(4); if (IN(4)) { p4_scan(F); if (DBL(4)) p4_scan(F); } SEAM(4);
    STAMP(5); if (IN(5)) {
        gu32* done = F.ctl + CW_DONE + 64 * 5;
        if (enter_group(F, GC_ATTN)) {
            p5_mlstm_out(F); if (DBL(14)) p5_mlstm_out(F); p5_attention(F, (char*)lds);
            __syncthreads();
            if (F.tid == 0) __hip_atomic_fetch_add(done, 1u, RLX_AGENT);
        }
        const unsigned tgt = (unsigned)F.G; leave_group(F);
        conv_worker(F, done, F.G == 256 ? (unsigned)GC_ATTN : tgt, 0);
        __syncthreads();
    } SEAM(5);
    STAMP(6); if (IN(6)) { p6_combine(F); } SEAM(6);
    STAMP(7); if (IN(7)) {
        pg8::Gemm g{wsp<pg8::bf16_t>(F, WS_CONCAT), wsp<pg8::bf16_t>(F, WS_WOUT), S, D, D}; pg8::StaticOrder So; So.init(S, D, F.G, F.bid);
        EpiOut E{F.in[IN_X], wsp<float>(F, WS_MOD) + 2 * D, wsp<float>(F, WS_H1)};
        pg8::gemm_phase<EpiOut, pg8::StaticOrder, false, true>(F.lds + RING_OFF, g, So, E);
        if (DBL(7)) pg8::gemm_phase<EpiOut, pg8::StaticOrder, false, true>(F.lds + RING_OFF, g, So, E);
    } SEAM(7);
    STAMP(8); if (IN(8)) { p7_router(F); if (DBL(8)) p7_router(F); } SEAM(8);
    STAMP(9); if (IN(9)) { p8_gather(F); if (DBL(9)) p8_gather(F); __syncthreads(); conv_worker(F, nullptr, 0u, 1); __syncthreads(); } SEAM(9);
    STAMP(10); if (IN(10)) {
        build_expert_table(F, (const int*)(F.ws + WS_POS) + S * 4);
        gu32* done = F.ctl + CW_DONE + 64 * 10;
        const int units = ((const LAS int*)(F.lds + TAB_OFF))[32] * 16, rounds = (units + 255) >> 8; int gc = rounds > 0 ? (((units + rounds - 1) / rounds + 7) >> 3) << 3 : 256; gc = gc > 256 ? 256 : gc;
        gc = __builtin_amdgcn_readfirstlane(gc);
        if (enter_group(F, gc)) {
            pg8::Gemm g{wsp<pg8::bf16_t>(F, WS_XG), wsp<pg8::bf16_t>(F, WS_WUG), MAXROWS, 4096, D / 2}; GroupedOrder So{(const LAS int*)(F.lds + TAB_OFF), 16, F.G, F.bid};
            EpiSwiglu E{wsp<unsigned char>(F, WS_ACT), F.in[IN_BUG]};
            pg8::gemm_phase8<EpiSwiglu, GroupedOrder, true, true>(F.lds + RING_OFF, g, So, E);
            __syncthreads();
            if (F.tid == 0) __hip_atomic_fetch_add(done, 1u, RLX_AGENT);
        }
        leave_group(F);
        __syncthreads(); conv_worker(F, nullptr, 0u, 2); __syncthreads();
    } SEAM(10);
    STAMP(11); if (IN(11)) {
        build_expert_table(F, (const int*)(F.ws + WS_POS) + S * 4);
        pg8::Gemm g{wsp<pg8::bf16_t>(F, WS_ACT), wsp<pg8::bf16_t>(F, WS_WD), MAXROWS, D, FF / 2}; GroupedOrder So{(const LAS int*)(F.lds + TAB_OFF), 8, F.G, F.bid};
        EpiDown E{wsp<bf16>(F, WS_Y), F.in[IN_BD], wsp<float>(F, WS_ROWW)};
        pg8::gemm_phase8<EpiDown, GroupedOrder, true, true>(F.lds + RING_OFF, g, So, E);
        if (DBL(11)) pg8::gemm_phase8<EpiDown, GroupedOrder, true, true>(F.lds + RING_OFF, g, So, E);
    } SEAM(11);
    STAMP(12); if (IN(12)) { p11_final(F, PROBE_SCALE()); if (DBL(12)) p11_final(F, PROBE_SCALE()); }
#undef IN
#undef SEAM
}
}
#ifndef MK_DEBUG
#define MK_DEBUG 0
#endif
#ifndef MK_PH_END
#define MK_PH_END mk::N_PHASES
#endif
#ifndef MK_SPLIT
#define MK_SPLIT 0
#endif
extern "C" void kernel_launch(void* const* d_in, const int* in_sizes, int n_in, void* d_out, int out_size, void* d_ws, size_t ws_size, hipStream_t stream) {
    using namespace mk;
    static int grid = 0;
    if (grid == 0) {
        int dev = 0, cus = 0, per_cu = 0;
        if (hipGetDevice(&dev) != hipSuccess || hipDeviceGetAttribute(&cus, hipDeviceAttributeMultiprocessorCount, dev) != hipSuccess) { fprintf(stderr, "kernel_launch: device query failed\n"); grid = -1; return; }
        if (hipFuncSetAttribute((const void*)mega_fwd, hipFuncAttributeMaxDynamicSharedMemorySize, LDS_BYTES) != hipSuccess) { fprintf(stderr, "kernel_launch: hipFuncSetAttribute failed\n"); grid = -1; return; }
        if (hipOccupancyMaxActiveBlocksPerMultiprocessor(&per_cu, (const void*)mega_fwd, NTHR, LDS_BYTES) != hipSuccess || per_cu < 1) fprintf(stderr, "kernel_launch: occupancy query reports %d\n", per_cu);
        (void)hipGetLastError();
        grid = cus;
        if (n_in != 24 || out_size != S * D || ws_size < (MK_DEBUG ? WS_NAIVE + (size_t)2300 * MiB : WS_END)) fprintf(stderr, "kernel_launch: unexpected sizes n_in %d out %d ws %zu\n", n_in, out_size, ws_size);
    }
    if (grid < 0) return;
    (void)hipMemsetAsync((char*)d_ws + WS_CTL, 0, CTL_ZERO_BYTES, stream);
    Args a{};
    for (int i = 0; i < 24; ++i) a.in[i] = (const float*)d_in[i];
    a.out = (float*)d_out; a.ws = (unsigned char*)d_ws;
#if MK_DEBUG
    nv::naive_forward(d_in, (float*)d_out, (char*)d_ws + WS_NAIVE, stream);
#endif
#if MK_SPLIT
    for (int p = 0; p < MK_PH_END; ++p) { a.ph_lo = p; a.ph_hi = p + 1; a.li = p; hipLaunchKernelGGL(mega_fwd, dim3(grid), dim3(NTHR), LDS_BYTES, stream, a); }
#else
    a.ph_lo = 0; a.ph_hi = MK_PH_END; a.li = 0;
    hipLaunchKernelGGL(mega_fwd, dim3(grid), dim3(NTHR), LDS_BYTES, stream, a);
#endif
#ifdef MK_EXTRA_LO
    a.ph_lo = MK_EXTRA_LO; a.ph_hi = MK_EXTRA_HI; a.li = 1;
    hipLaunchKernelGGL(mega_fwd, dim3(grid), dim3(NTHR), LDS_BYTES, stream, a);
#endif
    { const hipError_t le = hipPeekAtLastError(); if (le != hipSuccess) fprintf(stderr, "kernel_launch: launch failed: %s\n", hipGetErrorName(le)); }
#if MK_DEBUG
    {
        nv::NaiveWs w = nv::carve((char*)d_ws + WS_NAIVE);
        double* slots = (double*)((char*)d_ws + WS_CTL + 512 * 1024);
        unsigned char* ws = (unsigned char*)d_ws; int nc = 0;
        MK_DEBUG_CHECKS
        dbg::k_finish<<<1024, 256, 0, stream>>>((float*)d_out, (size_t)S * D, slots, nc, 1e-3);
    }
#endif
}
```

```cpp
#include <hip/hip_runtime.h>
#include <hip/hip_bf16.h>
#include <cstdio>
#include <cstdint>
namespace pg8 {
#define PG8_LAS __attribute__((address_space(3)))
typedef unsigned short bf16_t;
typedef short bf16x8 __attribute__((ext_vector_type(8)));
typedef float f32x4 __attribute__((ext_vector_type(4)));
typedef unsigned u32x4 __attribute__((ext_vector_type(4)));
constexpr int BM = 256, BK = 64, HALF = 128, HTB = HALF * BK * 2  , STAGE_BYTES = 8 * HTB, NXCD = 8, WGM = 8;

__host__ __device__ __forceinline__ int lds_byte(int r, int c) { const int st = (r >> 4) * 2 + (c >> 5), rr = r & 15, cc = c & 31, ob = rr * 64 + cc * 2; return st * 1024 + (ob ^ (((ob >> 9) & 1) << 5)); }
__host__ __device__ __forceinline__ void stage_rc(int b, int& R, int& C) { const int st = b / 1024, sb = b % 1024, swz = sb ^ (((sb >> 9) & 1) << 5); R = (st >> 1) * 16 + swz / 64; C = (st & 1) * 32 + (swz % 64) / 2; }
__host__ __device__ __forceinline__ int perm32(int rho) { const int n = rho >> 4, i = rho & 15; return 8 * (i >> 2) + 4 * n + (i & 3); }

struct Unit { int pm, pn, pb, e; };
struct Gemm { const bf16_t* A; const bf16_t* Bt; int M, N, K; };

struct StaticOrder {
    int nM, nN, nwg, G, c;
    __host__ __device__ void init(int M, int N, int G_, int c_) { nM = M / BM; nN = N / BM; nwg = nM * nN; G = G_; c = c_; }
    __host__ __device__ bool next(int i, Unit& u) const {
        const long L = (long)i * G + c; if (L >= nwg) return false;
        int wgid = (int)L; { const int q = nwg / NXCD, r = nwg % NXCD, xcd = wgid % NXCD, off = wgid / NXCD; wgid = (xcd < r ? xcd * (q + 1) : r * (q + 1) + (xcd - r) * q) + off; }
        const int nig = WGM * nN, gid = wgid / nig, fm = gid * WGM, gsz = (nM - fm) < WGM ? (nM - fm) : WGM;
        u.pm = fm + ((wgid % nig) % gsz); u.pn = (wgid % nig) / gsz; u.pb = u.pn; u.e = 0; return true;
    }
    __device__ __forceinline__ void a_ready(const Unit&) const {}
    __device__ __forceinline__ void done(const Unit&) const {}
};

__device__ __forceinline__ unsigned cvt_pk_bf16(float lo, float hi) { unsigned r; asm volatile("v_cvt_pk_bf16_f32 %0, %1, %2" : "=v"(r) : "v"(lo), "v"(hi)); return r; }
template <class Epi, class Sched, bool ALIGN_EPI = false, bool SP2 = false>
__device__ __forceinline__ void gemm_phase(PG8_LAS unsigned char* lds, const Gemm g, const Sched& S, const Epi& E) {
    const int tid = threadIdx.x, wid = __builtin_amdgcn_readfirstlane(tid >> 6), lane = tid & 63, wr = wid >> 2, wc = wid & 3, fr = lane & 15, fq = lane >> 4;
    const int K = g.K, nt = K / BK;
    unsigned voffA[2], voffB[2];
#pragma unroll
    for (int i = 0; i < 2; ++i) { int R, C; stage_rc(tid * 16 + i * 8192, R, C); const int Rb = Epi::PERM ? ((R & ~31) + perm32(R & 31)) : R;
        voffA[i] = (unsigned)(R * K + C) * 2u; voffB[i] = (unsigned)(Rb * K + C) * 2u; }
    const size_t kstep = (size_t)(BK * 2);
    const size_t hstep = (size_t)HALF * K * 2;
    const size_t tstep = 2 * hstep;
    const unsigned ldsw = (unsigned)wid * 1024u;
    const int aoff = lds_byte(wr * 64 + fr, fq * 8), boff = lds_byte(wc * 32 + fr, fq * 8);
#define PG8_SA(b, h) (((b) * 2 + (h)) * HTB)
#define PG8_SB(b, h) ((4 + (b) * 2 + (h)) * HTB)
#define PG8_STAGE(bufoff, gbase, voff) do { _Pragma("unroll") for (int _i = 0; _i < 2; ++_i) \
        __builtin_amdgcn_global_load_lds((const unsigned*)((const char*)(gbase) + (voff)[_i]), (PG8_LAS unsigned*)(lds + (bufoff) + ldsw + _i * 8192), 16, 0, 0); } while (0)
#define PG8_LDA(dst, b, h) do { _Pragma("unroll") for (int m = 0; m < 4; ++m) _Pragma("unroll") for (int k = 0; k < 2; ++k) dst[m][k] = *(const PG8_LAS bf16x8*)(lds + PG8_SA(b, h) + aoff + m * 2048 + k * 1024); } while (0)
#define PG8_LDB(dst, b, h) do { _Pragma("unroll") for (int n = 0; n < 2; ++n) _Pragma("unroll") for (int k = 0; k < 2; ++k) dst[n][k] = *(const PG8_LAS bf16x8*)(lds + PG8_SB(b, h) + boff + n * 2048 + k * 1024); } while (0)
#define PG8_MMA(ai, bj, At, Bt) do { __builtin_amdgcn_s_setprio(1); _Pragma("unroll") for (int m = 0; m < 4; ++m) _Pragma("unroll") for (int n = 0; n < 2; ++n) _Pragma("unroll") for (int k = 0; k < 2; ++k) \
        acc[ai][bj][m][n] = __builtin_amdgcn_mfma_f32_16x16x32_bf16(Bt[n][k], At[m][k], acc[ai][bj][m][n], 0, 0, 0); __builtin_amdgcn_s_setprio(0); } while (0)
#define PG8_WAIT_V(n) asm volatile("s_waitcnt vmcnt(" #n ")" ::: "memory")
#define PG8_WAIT_L(n) asm volatile("s_waitcnt lgkmcnt(" #n ")" ::: "memory")
#define PG8_BAR __builtin_amdgcn_s_barrier()
#define PG8_SCHED __builtin_amdgcn_sched_barrier(0)
    Unit cur = {0, 0, 0, 0}, nxt = {0, 0, 0, 0}; int ui = 0;
    if (!S.next(0, cur)) return;
    f32x4 acc[2][2][4][2];
#pragma unroll
    for (int a = 0; a < 2; ++a)
#pragma unroll
        for (int b = 0; b < 2; ++b)
#pragma unroll
            for (int m = 0; m < 4; ++m)
#pragma unroll
                for (int n = 0; n < 2; ++n) acc[a][b][m][n] = (f32x4){0.f, 0.f, 0.f, 0.f};
    bf16x8 At[4][2], B0[2][2], B1[2][2];
    const char* cA = (const char*)g.A + (size_t)cur.pm * tstep; const char* cB = (const char*)g.Bt + (size_t)cur.pb * tstep;
    S.a_ready(cur);
    if constexpr (SP2) {
        PG8_STAGE(PG8_SB(0, 0), cB, voffB); PG8_STAGE(PG8_SB(0, 1), cB + hstep, voffB); PG8_STAGE(PG8_SA(0, 0), cA, voffA); PG8_STAGE(PG8_SA(0, 1), cA + hstep, voffA);
        if (wr == 1) PG8_BAR;
        PG8_WAIT_V(2); PG8_BAR;
        PG8_STAGE(PG8_SB(1, 0), cB + kstep, voffB); PG8_STAGE(PG8_SA(1, 0), cA + kstep, voffA); PG8_STAGE(PG8_SB(1, 1), cB + hstep + kstep, voffB);
        PG8_WAIT_V(6); PG8_BAR;
    } else {
        PG8_STAGE(PG8_SB(0, 0), cB, voffB); PG8_STAGE(PG8_SA(0, 0), cA, voffA); PG8_STAGE(PG8_SB(0, 1), cB + hstep, voffB); PG8_STAGE(PG8_SA(0, 1), cA + hstep, voffA);
        if (wr == 1) PG8_BAR;
        PG8_WAIT_V(4); PG8_BAR;
        PG8_STAGE(PG8_SB(1, 0), cB + kstep, voffB); PG8_STAGE(PG8_SA(1, 0), cA + kstep, voffA); PG8_STAGE(PG8_SB(1, 1), cB + hstep + kstep, voffB);
        PG8_WAIT_V(6); PG8_BAR;
    }
    for (;;) {
        const bool has_next = S.next(ui + 1, nxt);
        const char* nA = has_next ? (const char*)g.A + (size_t)nxt.pm * tstep : cA; const char* nB = has_next ? (const char*)g.Bt + (size_t)nxt.pb * tstep : cB;
        for (int t = 0; t < nt; t += 2) {
            const bool last = (t == nt - 2);
            const char* a1 = cA + (size_t)(t + 1) * kstep;
            const char* a2 = last ? nA : cA + (size_t)(t + 2) * kstep; const char* b2 = last ? nB : cB + (size_t)(t + 2) * kstep;
            const char* a3 = a2 + kstep; const char* b3 = b2 + kstep;
            if (last && has_next) S.a_ready(nxt);
            if constexpr (SP2) {
            PG8_LDB(B0, 0, 0); PG8_LDB(B1, 0, 1); PG8_SCHED; PG8_LDA(At, 0, 0); PG8_STAGE(PG8_SA(1, 1), a1 + hstep, voffA);
            PG8_WAIT_V(8); PG8_WAIT_L(0); PG8_BAR; PG8_MMA(0, 0, At, B0); PG8_MMA(0, 1, At, B1); PG8_BAR; PG8_SCHED;
            PG8_LDA(At, 0, 1); PG8_STAGE(PG8_SB(0, 0), b2, voffB); PG8_STAGE(PG8_SB(0, 1), b2 + hstep, voffB); PG8_STAGE(PG8_SA(0, 0), a2, voffA);
            PG8_WAIT_V(8); PG8_WAIT_L(0); PG8_BAR; PG8_MMA(1, 0, At, B0); PG8_MMA(1, 1, At, B1); PG8_BAR; PG8_SCHED;
            PG8_LDB(B0, 1, 0); PG8_LDB(B1, 1, 1); PG8_SCHED; PG8_LDA(At, 1, 0); PG8_STAGE(PG8_SA(0, 1), a2 + hstep, voffA);
            PG8_WAIT_V(8); PG8_WAIT_L(0); PG8_BAR; PG8_MMA(0, 0, At, B0); PG8_MMA(0, 1, At, B1); PG8_BAR; PG8_SCHED;
            PG8_LDA(At, 1, 1); PG8_STAGE(PG8_SB(1, 0), b3, voffB); PG8_STAGE(PG8_SB(1, 1), b3 + hstep, voffB); PG8_STAGE(PG8_SA(1, 0), a3, voffA);
            PG8_WAIT_V(8); PG8_WAIT_L(0); PG8_BAR; PG8_MMA(1, 0, At, B0); PG8_MMA(1, 1, At, B1); PG8_BAR; PG8_SCHED;
            } else {
            PG8_LDB(B0, 0, 0); PG8_SCHED; PG8_LDA(At, 0, 0); PG8_STAGE(PG8_SA(1, 1), a1 + hstep, voffA);
            PG8_WAIT_L(8); PG8_BAR; PG8_WAIT_L(0); PG8_MMA(0, 0, At, B0); PG8_BAR; PG8_SCHED;
            PG8_LDB(B1, 0, 1); PG8_STAGE(PG8_SB(0, 0), b2, voffB);
            PG8_BAR; PG8_WAIT_L(0); PG8_MMA(0, 1, At, B1); PG8_BAR;
            PG8_LDA(At, 0, 1); PG8_STAGE(PG8_SA(0, 0), a2, voffA);
            PG8_BAR; PG8_WAIT_L(0); PG8_MMA(1, 0, At, B0); PG8_BAR; PG8_SCHED;
            PG8_STAGE(PG8_SB(0, 1), b2 + hstep, voffB);
            PG8_WAIT_V(6); PG8_BAR; PG8_MMA(1, 1, At, B1); PG8_BAR;
            PG8_LDB(B0, 1, 0); PG8_SCHED; PG8_LDA(At, 1, 0); PG8_STAGE(PG8_SA(0, 1), a2 + hstep, voffA);
            PG8_WAIT_L(8); PG8_BAR; PG8_WAIT_L(0); PG8_MMA(0, 0, At, B0); PG8_BAR; PG8_SCHED;
            PG8_LDB(B1, 1, 1); PG8_STAGE(PG8_SB(1, 0), b3, voffB);
            PG8_BAR; PG8_WAIT_L(0); PG8_MMA(0, 1, At, B1); PG8_BAR;
            PG8_LDA(At, 1, 1); PG8_STAGE(PG8_SA(1, 0), a3, voffA);
            PG8_BAR; PG8_WAIT_L(0); PG8_MMA(1, 0, At, B0); PG8_BAR; PG8_SCHED;
            PG8_STAGE(PG8_SB(1, 1), b3 + hstep, voffB);
            PG8_WAIT_V(6); PG8_BAR; PG8_MMA(1, 1, At, B1); PG8_BAR;
            }
        }
        if constexpr (ALIGN_EPI) { if (wr == 0) PG8_BAR; }
        if constexpr (!Epi::AFTER_DRAIN) { E(acc, cur, wr, wc, fr, fq); S.done(cur); }
        if (!has_next) break;
#pragma unroll
        for (int a = 0; a < 2; ++a)
#pragma unroll
            for (int b = 0; b < 2; ++b)
#pragma unroll
                for (int m = 0; m < 4; ++m)
#pragma unroll
                    for (int n = 0; n < 2; ++n) acc[a][b][m][n] = (f32x4){0.f, 0.f, 0.f, 0.f};
        cur = nxt; cA = nA; cB = nB; ++ui;
        if constexpr (ALIGN_EPI) { if (wr == 1) PG8_BAR; }
    }
    PG8_WAIT_V(0);
    if constexpr (!ALIGN_EPI) { if (wr == 0) PG8_BAR; }
    PG8_BAR;
    if constexpr (Epi::AFTER_DRAIN) { E.fused(acc, cur, wr, wc, fr, fq, lds, wid, lane); S.done(cur); }
#undef PG8_SA
#undef PG8_SB
#undef PG8_STAGE
#undef PG8_LDA
#undef PG8_LDB
#undef PG8_MMA
#undef PG8_WAIT_V
#undef PG8_WAIT_L
#undef PG8_BAR
#undef PG8_SCHED
}
typedef int v8i __attribute__((ext_vector_type(8)));
typedef int v4i __attribute__((ext_vector_type(4)));
constexpr int SCALE_W8 = 0x78787878, SCALE_A8 = 0x7f7f7f7f;
template <class Epi, class Sched, bool ALIGN_EPI = false, bool SP2 = false>
__device__ __forceinline__ void gemm_phase8(PG8_LAS unsigned char* lds, const Gemm g, const Sched& S, const Epi& E) {
    const int tid = threadIdx.x, wid = __builtin_amdgcn_readfirstlane(tid >> 6), lane = tid & 63, wr = wid >> 2, wc = wid & 3, fr = lane & 15, fq = lane >> 4;
    const int K = g.K, nt = K / BK;
    unsigned voffA[2], voffB[2];
#pragma unroll
    for (int i = 0; i < 2; ++i) { int R, C; stage_rc(tid * 16 + i * 8192, R, C); const int Rb = Epi::PERM ? ((R & ~31) + perm32(R & 31)) : R;
        voffA[i] = (unsigned)(R * K + C) * 2u; voffB[i] = (unsigned)(Rb * K + C) * 2u; }
    const size_t kstep = (size_t)(BK * 2);
    const size_t hstep = (size_t)HALF * K * 2;
    const size_t tstep = 2 * hstep;
    const unsigned ldsw = (unsigned)wid * 1024u;
    const int aoff = lds_byte(wr * 64 + fr, fq * 8), boff = lds_byte(wc * 32 + fr, fq * 8);
#define PG8_SA(b, h) (((b) * 2 + (h)) * HTB)
#define PG8_SB(b, h) ((4 + (b) * 2 + (h)) * HTB)
#define PG8_STAGE(bufoff, gbase, voff) do { _Pragma("unroll") for (int _i = 0; _i < 2; ++_i) \
        __builtin_amdgcn_global_load_lds((const unsigned*)((const char*)(gbase) + (voff)[_i]), (PG8_LAS unsigned*)(lds + (bufoff) + ldsw + _i * 8192), 16, 0, 0); } while (0)
#define PG8_LDA(dst, b, h) do { _Pragma("unroll") for (int m = 0; m < 4; ++m) { const v4i lo_ = *(const PG8_LAS v4i*)(lds + PG8_SA(b, h) + aoff + m * 2048), hi_ = *(const PG8_LAS v4i*)(lds + PG8_SA(b, h) + aoff + m * 2048 + 1024); \
        dst[m] = __builtin_shufflevector(lo_, hi_, 0, 1, 2, 3, 4, 5, 6, 7); } } while (0)
#define PG8_LDB(dst, b, h) do { _Pragma("unroll") for (int n = 0; n < 2; ++n) { const v4i lo_ = *(const PG8_LAS v4i*)(lds + PG8_SB(b, h) + boff + n * 2048), hi_ = *(const PG8_LAS v4i*)(lds + PG8_SB(b, h) + boff + n * 2048 + 1024); \
        dst[n] = __builtin_shufflevector(lo_, hi_, 0, 1, 2, 3, 4, 5, 6, 7); } } while (0)
#define PG8_MMA(ai, bj, At, Bt) do { __builtin_amdgcn_s_setprio(1); _Pragma("unroll") for (int m = 0; m < 4; ++m) _Pragma("unroll") for (int n = 0; n < 2; ++n) \
        asm volatile("v_mfma_scale_f32_16x16x128_f8f6f4 %0, %1, %2, %0, %3, %4 op_sel_hi:[0,0,0]" : "+v"(acc[ai][bj][m][n]) : "v"(Bt[n]), "v"(At[m]), "v"(sw8), "v"(sa8)); __builtin_amdgcn_s_setprio(0); } while (0)
#define PG8_WAIT_V(n) asm volatile("s_waitcnt vmcnt(" #n ")" ::: "memory")
#define PG8_WAIT_L(n) asm volatile("s_waitcnt lgkmcnt(" #n ")" ::: "memory")
#define PG8_BAR __builtin_amdgcn_s_barrier()
#define PG8_SCHED __builtin_amdgcn_sched_barrier(0)
    Unit cur = {0, 0, 0, 0}, nxt = {0, 0, 0, 0}; int ui = 0;
    if (!S.next(0, cur)) return;
    f32x4 acc[2][2][4][2];
#pragma unroll
    for (int a = 0; a < 2; ++a)
#pragma unroll
        for (int b = 0; b < 2; ++b)
#pragma unroll
            for (int m = 0; m < 4; ++m)
#pragma unroll
                for (int n = 0; n < 2; ++n) acc[a][b][m][n] = (f32x4){0.f, 0.f, 0.f, 0.f};
    v8i At[4], B0[2], B1[2]; int sw8 = SCALE_W8, sa8 = SCALE_A8;
    const char* cA = (const char*)g.A + (size_t)cur.pm * tstep; const char* cB = (const char*)g.Bt + (size_t)cur.pb * tstep;
    S.a_ready(cur);
    if constexpr (SP2) {
        PG8_STAGE(PG8_SB(0, 0), cB, voffB); PG8_STAGE(PG8_SB(0, 1), cB + hstep, voffB); PG8_STAGE(PG8_SA(0, 0), cA, voffA); PG8_STAGE(PG8_SA(0, 1), cA + hstep, voffA);
        if (wr == 1) PG8_BAR;
        PG8_WAIT_V(2); PG8_BAR;
        PG8_STAGE(PG8_SB(1, 0), cB + kstep, voffB); PG8_STAGE(PG8_SA(1, 0), cA + kstep, voffA); PG8_STAGE(PG8_SB(1, 1), cB + hstep + kstep, voffB);
        PG8_WAIT_V(6); PG8_BAR;
    } else {
        PG8_STAGE(PG8_SB(0, 0), cB, voffB); PG8_STAGE(PG8_SA(0, 0), cA, voffA); PG8_STAGE(PG8_SB(0, 1), cB + hstep, voffB); PG8_STAGE(PG8_SA(0, 1), cA + hstep, voffA);
        if (wr == 1) PG8_BAR;
        PG8_WAIT_V(4); PG8_BAR;
        PG8_STAGE(PG8_SB(1, 0), cB + kstep, voffB); PG8_STAGE(PG8_SA(1, 0), cA + kstep, voffA); PG8_STAGE(PG8_SB(1, 1), cB + hstep + kstep, voffB);
        PG8_WAIT_V(6); PG8_BAR;
    }
    for (;;) {
        const bool has_next = S.next(ui + 1, nxt);
        const char* nA = has_next ? (const char*)g.A + (size_t)nxt.pm * tstep : cA; const char* nB = has_next ? (const char*)g.Bt + (size_t)nxt.pb * tstep : cB;
        for (int t = 0; t < nt; t += 2) {
            const bool last = (t == nt - 2);
            const char* a1 = cA + (size_t)(t + 1) * kstep;
            const char* a2 = last ? nA : cA + (size_t)(t + 2) * kstep; const char* b2 = last ? nB : cB + (size_t)(t + 2) * kstep;
            const char* a3 = a2 + kstep; const char* b3 = b2 + kstep;
            if (last && has_next) S.a_ready(nxt);
            if constexpr (SP2) {
            PG8_LDB(B0, 0, 0); PG8_LDB(B1, 0, 1); PG8_SCHED; PG8_LDA(At, 0, 0); PG8_STAGE(PG8_SA(1, 1), a1 + hstep, voffA);
            PG8_WAIT_V(8); PG8_WAIT_L(0); PG8_BAR; PG8_MMA(0, 0, At, B0); PG8_MMA(0, 1, At, B1); PG8_BAR; PG8_SCHED;
            PG8_LDA(At, 0, 1); PG8_STAGE(PG8_SB(0, 0), b2, voffB); PG8_STAGE(PG8_SB(0, 1), b2 + hstep, voffB); PG8_STAGE(PG8_SA(0, 0), a2, voffA);
            PG8_WAIT_V(8); PG8_WAIT_L(0); PG8_BAR; PG8_MMA(1, 0, At, B0); PG8_MMA(1, 1, At, B1); PG8_BAR; PG8_SCHED;
            PG8_LDB(B0, 1, 0); PG8_LDB(B1, 1, 1); PG8_SCHED; PG8_LDA(At, 1, 0); PG8_STAGE(PG8_SA(0, 1), a2 + hstep, voffA);
            PG8_WAIT_V(8); PG8_WAIT_L(0); PG8_BAR; PG8_MMA(0, 0, At, B0); PG8_MMA(0, 1, At, B1); PG8_BAR; PG8_SCHED;
            PG8_LDA(At, 1, 1); PG8_STAGE(PG8_SB(1, 0), b3, voffB); PG8_STAGE(PG8_SB(1, 1), b3 + hstep, voffB); PG8_STAGE(PG8_SA(1, 0), a3, voffA);
            PG8_WAIT_V(8); PG8_WAIT_L(0); PG8_BAR; PG8_MMA(1, 0, At, B0); PG8_MMA(1, 1, At, B1); PG8_BAR; PG8_SCHED;
            } else {
            PG8_LDB(B0, 0, 0); PG8_SCHED; PG8_LDA(At, 0, 0); PG8_STAGE(PG8_SA(1, 1), a1 + hstep, voffA);
            PG8_WAIT_L(8); PG8_BAR; PG8_WAIT_L(0); PG8_MMA(0, 0, At, B0); PG8_BAR; PG8_SCHED;
            PG8_LDB(B1, 0, 1); PG8_STAGE(PG8_SB(0, 0), b2, voffB);
            PG8_BAR; PG8_WAIT_L(0); PG8_MMA(0, 1, At, B1); PG8_BAR;
            PG8_LDA(At, 0, 1); PG8_STAGE(PG8_SA(0, 0), a2, voffA);
            PG8_BAR; PG8_WAIT_L(0); PG8_MMA(1, 0, At, B0); PG8_BAR; PG8_SCHED;
            PG8_STAGE(PG8_SB(0, 1), b2 + hstep, voffB);
            PG8_WAIT_V(6); PG8_BAR; PG8_MMA(1, 1, At, B1); PG8_BAR;
            PG8_LDB(B0, 1, 0); PG8_SCHED; PG8_LDA(At, 1, 0); PG8_STAGE(PG8_SA(0, 1), a2 + hstep, voffA);
            PG8_WAIT_L(8); PG8_BAR; PG8_WAIT_L(0); PG8_MMA(0, 0, At, B0); PG8_BAR; PG8_SCHED;
            PG8_LDB(B1, 1, 1); PG8_STAGE(PG8_SB(1, 0), b3, voffB);
            PG8_BAR; PG8_WAIT_L(0); PG8_MMA(0, 1, At, B1); PG8_BAR;
            PG8_LDA(At, 1, 1); PG8_STAGE(PG8_SA(1, 0), a3, voffA);
            PG8_BAR; PG8_WAIT_L(0); PG8_MMA(1, 0, At, B0); PG8_BAR; PG8_SCHED;
            PG8_STAGE(PG8_SB(1, 1), b3 + hstep, voffB);
            PG8_WAIT_V(6); PG8_BAR; PG8_MMA(1, 1, At, B1); PG8_BAR;
            }
        }
        if constexpr (ALIGN_EPI) { if (wr == 0) PG8_BAR; }
        asm volatile("s_nop 15\n\ts_nop 7" ::: "memory");
        if constexpr (!Epi::AFTER_DRAIN) { E(acc, cur, wr, wc, fr, fq); S.done(cur); }
        if (!has_next) break;
#pragma unroll
        for (int a = 0; a < 2; ++a)
#pragma unroll
            for (int b = 0; b < 2; ++b)
#pragma unroll
                for (int m = 0; m < 4; ++m)
#pragma unroll
                    for (int n = 0; n < 2; ++n) acc[a][b][m][n] = (f32x4){0.f, 0.f, 0.f, 0.f};
        cur = nxt; cA = nA; cB = nB; ++ui;
        if constexpr (ALIGN_EPI) { if (wr == 1) PG8_BAR; }
    }
    PG8_WAIT_V(0);
    if constexpr (!ALIGN_EPI) { if (wr == 0) PG8_BAR; }
    PG8_BAR;
    if constexpr (Epi::AFTER_DRAIN) { E.fused(acc, cur, wr, wc, fr, fq, lds, wid, lane); S.done(cur); }
#undef PG8_SA
#undef PG8_SB
#undef PG8_STAGE
#undef PG8_LDA
#undef PG8_LDB
#undef PG8_MMA
#undef PG8_WAIT_V
#undef PG8_WAIT_L
#undef PG8_BAR
#undef PG8_SCHED
}
}
#define GAS __attribute__((address_space(1)))
#define LAS __attribute__((address_space(3)))
typedef unsigned short bf16;
typedef unsigned v4u __attribute__((ext_vector_type(4)));
typedef float f32x4 __attribute__((ext_vector_type(4)));
typedef short bf16x8 __attribute__((ext_vector_type(8)));
typedef GAS unsigned gu32;
typedef GAS unsigned long long gu64;
#define RLX_AGENT __ATOMIC_RELAXED, __HIP_MEMORY_SCOPE_AGENT
#define LDS_WAIT() asm volatile("s_waitcnt lgkmcnt(0)" ::: "memory")
#define VM_WAIT() asm volatile("s_waitcnt vmcnt(0)" ::: "memory")
__device__ __forceinline__ unsigned long long rt() { return __builtin_amdgcn_s_memrealtime(); }
__device__ __forceinline__ unsigned f2bf(float f) { unsigned u = __builtin_bit_cast(unsigned, f); return (u + 0x7fffu + ((u >> 16) & 1u)) >> 16; }
__device__ __forceinline__ unsigned pk2(float lo, float hi) { return f2bf(lo) | (f2bf(hi) << 16); }

#define XB_TMO      128
#define XB_XCNT(j)  (256  + 64 * (j))
#define XB_XSUB(j)  (1280 + 64 * (j))
#define XB_XGEN(j)  (2304 + 64 * (j))
#define XB_TOP      3328
#define XB_TOPGEN   3392
#define XCD_BAR_WORDS 3456
#define XB_SPIN_CAP (1u << 18)

__device__ __forceinline__ unsigned xb_ld(unsigned* p)              { return __hip_atomic_load(p, __ATOMIC_RELAXED, __HIP_MEMORY_SCOPE_AGENT); }
__device__ __forceinline__ unsigned xb_add(unsigned* p, unsigned v) { return __hip_atomic_fetch_add(p, v, __ATOMIC_RELAXED, __HIP_MEMORY_SCOPE_AGENT); }
__device__ __forceinline__ unsigned xb_xcc_id() { return (unsigned)__builtin_amdgcn_s_getreg((3 << 11) | 20) & 0xFu; }
#define XB_SPIN(cond, bar) do { unsigned _sp = 0; while (cond) { __builtin_amdgcn_s_sleep(1); \
    if ((++_sp & 255u) == 0u) { if (xb_ld(&(bar)[XB_TMO])) break; if (_sp > XB_SPIN_CAP) { atomicAdd(&(bar)[XB_TMO], 1u); break; } } } } while (0)

struct XcdBarrier {
    unsigned* bar; unsigned x;
    volatile LAS unsigned* st;
};

__device__ __forceinline__ XcdBarrier xcd_barrier_post(unsigned* bar, volatile LAS unsigned* st) {
    XcdBarrier b; b.bar = bar; b.x = xb_xcc_id(); b.st = st;
    if (threadIdx.x == 0) (void)xb_add(&bar[XB_XCNT(b.x)], 1u);
    return b;
}
__device__ __forceinline__ void xcd_barrier_complete(unsigned* bar, unsigned x, unsigned& nloc, unsigned& nx) {
    const unsigned G = gridDim.x * gridDim.y * gridDim.z;
    unsigned sum, cnt, mine, sp = 0u;
    for (;;) {
        sum = 0u; cnt = 0u; mine = 0u;
#pragma unroll
        for (unsigned j = 0; j < 16; ++j) { const unsigned c = xb_ld(&bar[XB_XCNT(j)]); sum += c; cnt += (c > 0u) ? 1u : 0u; mine = (j == x) ? c : mine; }
        if (sum == G) break;
        __builtin_amdgcn_s_sleep(1);
        if ((++sp & 255u) == 0u) { if (xb_ld(&bar[XB_TMO])) break; if (sp > XB_SPIN_CAP) { atomicAdd(&bar[XB_TMO], 1u); break; } }
    }
    nloc = mine > 0u ? mine : 1u; nx = cnt > 0u ? cnt : 1u;
}

__device__ __forceinline__ void xcd_barrier(const XcdBarrier& b) {
    asm volatile("s_waitcnt vmcnt(0)" ::: "memory");
    __syncthreads();
    if (threadIdx.x == 0) {
        unsigned* bar = b.bar;
        __builtin_amdgcn_s_waitcnt(0);
        unsigned nloc = b.st[0], nx = b.st[1];
        if (nloc == 0u) { xcd_barrier_complete(bar, b.x, nloc, nx); b.st[0] = nloc; b.st[1] = nx; }
        const unsigned old = xb_add(&bar[XB_XSUB(b.x)], 1u);
        const unsigned gen = old / nloc;
        if (old + 1u == (gen + 1u) * nloc) {
            __builtin_amdgcn_fence(__ATOMIC_RELEASE, "agent");
            asm volatile("s_waitcnt vmcnt(0)" ::: "memory");
            const unsigned og = xb_add(&bar[XB_TOP], 1u);
            const unsigned tg = og / nx;
            if (og + 1u == (tg + 1u) * nx) xb_add(&bar[XB_TOPGEN], 1u);
            else XB_SPIN(xb_ld(&bar[XB_TOPGEN]) == tg, bar);
            __builtin_amdgcn_fence(__ATOMIC_ACQUIRE, "agent");
            xb_add(&bar[XB_XGEN(b.x)], 1u);
            asm volatile("s_waitcnt vmcnt(0)" ::: "memory");
        } else {
            XB_SPIN(xb_ld(&bar[XB_XGEN(b.x)]) == gen, bar);
            __builtin_amdgcn_fence(__ATOMIC_ACQUIRE, "agent");
            asm volatile("s_waitcnt vmcnt(0)" ::: "memory");
        }
    }
    __syncthreads();
}
namespace mk {
constexpr int S = 8192, D = 2048, NPROJ = 6160, NPP = 6144, NPAD = 6400, NE = 32, FF = 2048, NWAVES = 8, NTHR = 512;
constexpr int C_MQ = 0, C_MK = 512, C_MV = 1024, C_MO = 2048, C_FQ = 3072, C_FK = 4096, C_FV = 5120;
constexpr int MAXROWS = S * 4 + NE * 256;
constexpr int NCH = 128, LCH = 64;
constexpr size_t MiB = 1u << 20;
constexpr size_t WS_CTL = 0, CTL_ZERO_BYTES = 1 * MiB;
constexpr size_t WS_MODP = 14 * MiB;
constexpr size_t WS_MOD = 2 * MiB;
constexpr size_t WS_GATES = 3 * MiB;
constexpr size_t WS_F = 4 * MiB;
constexpr size_t WS_NL = 5 * MiB;
constexpr size_t WS_NS = 6 * MiB;
constexpr size_t WS_GLAL = 7 * MiB;
constexpr size_t WS_MS = 7 * MiB + 65536;
constexpr size_t WS_TOPI = 8 * MiB;
constexpr size_t WS_TOPW = 9 * MiB;
constexpr size_t WS_HIST = 10 * MiB;
constexpr size_t WS_LRANK = 11 * MiB;
constexpr size_t WS_POS = 12 * MiB;
constexpr size_t WS_ROWW = 13 * MiB;
constexpr size_t WS_WIN = 16 * MiB;
constexpr size_t WS_WOUT = 42 * MiB;
constexpr size_t WS_HN = 50 * MiB;
constexpr size_t WS_PROJ = 82 * MiB;
constexpr size_t WS_UL = 178 * MiB;
constexpr size_t WS_CS = 242 * MiB;
constexpr size_t WS_CONCAT = 274 * MiB;
constexpr size_t WS_H1 = 306 * MiB;
constexpr size_t WS_XG = 370 * MiB;
constexpr size_t WS_ACT = 530 * MiB;
constexpr size_t WS_Y = 690 * MiB;
constexpr size_t WS_WUG = 850 * MiB;
constexpr size_t WS_WD = 1362 * MiB;
constexpr size_t WS_OPART = 1618 * MiB;
constexpr size_t WS_MLP = 1786 * MiB;
constexpr size_t WS_JLO = 1789 * MiB;
constexpr size_t WS_END = 1790 * MiB;
constexpr size_t WS_NAIVE = 1792 * MiB;
constexpr int CW_TMO = 0, CW_CODE = 1, CW_CONV = 65536, CW_DONE = 2048, CW_BAR = 4096;
constexpr int GC_INPROJ = 160, GC_ATTN = 160, GC_PREP = 192;
constexpr int RING_OFF = 0, RING_BYTES = 131072;
constexpr int LDSCTL_OFF = RING_BYTES, MISC_OFF = LDSCTL_OFF + 320;
constexpr int TAB_OFF = LDSCTL_OFF + 1024;
constexpr int ATT_CH = 16;
constexpr int LDS_BYTES = 147456;
static_assert(GC_INPROJ <= 248 && GC_INPROJ % 8 == 0 && GC_ATTN % 8 == 0, "compute groups: multiples of 8; the in-proj group leaves slot 31 to the forget-gate scans");
}
namespace mk {
typedef float f32x2 __attribute__((ext_vector_type(2)));
typedef unsigned u32x2 __attribute__((ext_vector_type(2)));
struct Frame {
    LAS unsigned char* lds;
    volatile LAS unsigned* MISC;
    gu32* ctl;
    int tid, lane, wave, vcu, G, bid;
    const float* in[24];
    float* out; unsigned char* ws;
};
#define IN_X 0
#define IN_C 1
#define IN_WADA 2
#define IN_BADA 3
#define IN_NMIX 4
#define IN_WIN 5
#define IN_BI 6
#define IN_BF 7
#define IN_FOXBF 8
#define IN_FOXQN 9
#define IN_FOXKN 10
#define IN_MOUTN 11
#define IN_FOUTN 12
#define IN_WOUT 13
#define IN_NFFN 14
#define IN_WR 15
#define IN_BR 16
#define IN_WUG 17
#define IN_BUG 18
#define IN_WD 19
#define IN_BD 20
#define IN_WAF 21
#define IN_BAF 22
#define IN_NFIN 23
template <class T> __device__ __forceinline__ T* wsp(const Frame& F, size_t off) { return (T*)(F.ws + off); }
__device__ __forceinline__ float wave_sum(float v) {
#pragma unroll
    for (int o = 1; o < 64; o <<= 1) v += __shfl_xor(v, o);
    return v;
}
__device__ __forceinline__ float sigmoid_f(float v) { return 1.f / (1.f + __expf(-v)); }
__device__ __forceinline__ float log_sigmoid_f(float v) { return fminf(v, 0.f) - log1pf(__expf(-fabsf(v))); }
__device__ __forceinline__ float softcap_f(float v) { return 15.f * tanhf(v * (1.f / 15.f)); }
__device__ __forceinline__ float bf2f(unsigned short b) { return __uint_as_float(((unsigned)b) << 16); }

struct CvtItem { const float* src; bf16* dst; };
__device__ __forceinline__ void cvt_load(const CvtItem& it, int ldw, f32x4 (&v)[16], int lane) {
    const float* p = it.src + (size_t)((lane >> 4) * 16) * ldw + (lane & 15) * 4;
#pragma unroll
    for (int i = 0; i < 16; ++i) v[i] = __builtin_nontemporal_load((const GAS f32x4*)(p + (size_t)i * ldw));
}
__device__ __forceinline__ void cvt_store(const CvtItem& it, int K, const f32x4 (&v)[16], LAS unsigned char* scr, int lane) {
    const int c = lane & 15, g = lane >> 4;
#pragma unroll
    for (int j = 0; j < 4; ++j) {
        v4u a, b;
        a.x = pk2(v[0][j], v[1][j]); a.y = pk2(v[2][j], v[3][j]); a.z = pk2(v[4][j], v[5][j]); a.w = pk2(v[6][j], v[7][j]);
        b.x = pk2(v[8][j], v[9][j]); b.y = pk2(v[10][j], v[11][j]); b.z = pk2(v[12][j], v[13][j]); b.w = pk2(v[14][j], v[15][j]);
        LAS unsigned char* q = scr + (4 * c + j) * 144 + 32 * g;
        *(LAS v4u*)q = a; *(LAS v4u*)(q + 16) = b; }
    LDS_WAIT(); asm volatile("" ::: "memory");
#pragma unroll
    for (int i = 0; i < 8; ++i) { const int row = (lane >> 3) + 8 * i; const v4u o = *(const LAS v4u*)(scr + row * 144 + (lane & 7) * 16);
        *(GAS v4u*)(it.dst + (size_t)row * K + (lane & 7) * 8) = o; }
    LDS_WAIT(); asm volatile("" ::: "memory");
}
__device__ __forceinline__ unsigned pk4_fp8(float a, float b, float c, float d) { int r = __builtin_amdgcn_cvt_pk_fp8_f32(a, b, 0, false); r = __builtin_amdgcn_cvt_pk_fp8_f32(c, d, r, true); return (unsigned)r; }
constexpr float W8S = 128.f;
__device__ __forceinline__ void cvt8_pack(const f32x4 (&v)[16], LAS unsigned char* scr, int half, int lane) {
    const int c = lane & 15, g = lane >> 4;
#pragma unroll
    for (int j = 0; j < 4; ++j) { v4u a;
        a.x = pk4_fp8(v[0][j] * W8S, v[1][j] * W8S, v[2][j] * W8S, v[3][j] * W8S); a.y = pk4_fp8(v[4][j] * W8S, v[5][j] * W8S, v[6][j] * W8S, v[7][j] * W8S);
        a.z = pk4_fp8(v[8][j] * W8S, v[9][j] * W8S, v[10][j] * W8S, v[11][j] * W8S); a.w = pk4_fp8(v[12][j] * W8S, v[13][j] * W8S, v[14][j] * W8S, v[15][j] * W8S);
        *(LAS v4u*)(scr + (4 * c + j) * 144 + half * 64 + 16 * g) = a; }
}
__device__ __forceinline__ void cvt8_flush(unsigned char* dst, int kbytes, LAS unsigned char* scr, int lane) {
    LDS_WAIT(); asm volatile("" ::: "memory");
#pragma unroll
    for (int i = 0; i < 8; ++i) { const int row = (lane >> 3) + 8 * i; const v4u o = *(const LAS v4u*)(scr + row * 144 + (lane & 7) * 16);
        __builtin_nontemporal_store(o, (GAS v4u*)(dst + (size_t)row * kbytes + (lane & 7) * 16)); }
    LDS_WAIT(); asm volatile("" ::: "memory");
}
constexpr int CV8_UG = NE * 16 * 64, CV8_D = NE * 16 * 32, CV8_TOTAL = CV8_UG + CV8_D;
struct Cvt8Item { const float* src; unsigned char* dst; int ldw; };
__device__ __forceinline__ Cvt8Item cvt8_item(const Frame& F, int it, int half) {
    Cvt8Item r;
    if (it < CV8_UG) { const int e = it >> 10, q = it & 1023, kb = q >> 6, nb = q & 63, d0 = nb * 64, j = d0 >> 8, wv = d0 & 255, sc = wv < 128 ? 128 * j + wv : 2048 + 128 * j + (wv - 128);
        r.ldw = 4096; r.src = F.in[IN_WUG] + (size_t)e * D * 4096 + (size_t)(kb * 128 + half * 64) * 4096 + sc; r.dst = wsp<unsigned char>(F, WS_WUG) + (size_t)e * 4096 * D + (size_t)d0 * D + kb * 128; return r; }
    it -= CV8_UG;
    { const int e = it >> 9, q = it & 511, kb = q >> 5, nb = q & 31;
        r.ldw = D; r.src = F.in[IN_WD] + (size_t)e * FF * D + (size_t)(kb * 128 + half * 64) * D + nb * 64; r.dst = wsp<unsigned char>(F, WS_WD) + (size_t)e * D * FF + (size_t)(nb * 64) * FF + kb * 128; return r; }
}
__device__ __forceinline__ void cvt8_load(const Cvt8Item& it, f32x4 (&v)[16], int lane) {
    const float* p = it.src + (size_t)((lane >> 4) * 16) * it.ldw + (lane & 15) * 4;
#pragma unroll
    for (int i = 0; i < 16; ++i) v[i] = __builtin_nontemporal_load((const GAS f32x4*)(p + (size_t)i * it.ldw));
}
constexpr int CV_IN = 32 * 96, CV_OUT = 32 * 32, CV_TOTAL = CV_IN + CV_OUT;
__device__ __forceinline__ CvtItem cvt_item(const Frame& F, int it, int& ldw, int& K) {
    CvtItem r;
    if (it < CV_IN) { const int kb = it / 96, nb = it % 96, d0 = nb * 64, sc = d0 < 3072 ? d0 : d0 + 8;
        ldw = NPROJ; K = D; r.src = F.in[IN_WIN] + (size_t)(kb * 64) * NPROJ + sc; r.dst = wsp<bf16>(F, WS_WIN) + (size_t)d0 * D + kb * 64; return r; }
    it -= CV_IN;
    { const int kb = it >> 5, nb = it & 31; ldw = D; K = D; r.src = F.in[IN_WOUT] + (size_t)(kb * 64) * D + nb * 64; r.dst = wsp<bf16>(F, WS_WOUT) + (size_t)(nb * 64) * D + kb * 64; return r; }
}
__device__ __forceinline__ void p0_gemv(Frame& F) {
    const int gw = F.vcu * NWAVES + F.wave, NGW = F.G * NWAVES, lane = F.lane;
    {
        const float* c = F.in[IN_C]; float* modp = wsp<float>(F, WS_MODP);
        for (int task = gw; task < 2048; task += NGW) {
            const int cg = task & 63, ks = task >> 6, j = cg * 256 + 4 * lane;
            const float* w; int ld, col;
            if (j < 6 * D) { w = F.in[IN_WADA]; ld = 6 * D; col = j; } else { w = F.in[IN_WAF]; ld = 2 * D; col = j - 6 * D; }
            const float c0 = c[ks * 64 + lane]; const float s0 = c0 * sigmoid_f(c0);
            const float* wp = w + (size_t)(ks * 64) * ld + col; f32x4 acc = {0.f, 0.f, 0.f, 0.f};
#pragma unroll 16
            for (int i = 0; i < 64; ++i) acc += __builtin_nontemporal_load((const GAS f32x4*)(wp + (size_t)i * ld)) * __builtin_bit_cast(float, __builtin_amdgcn_readlane(__builtin_bit_cast(int, s0), i));
            *(GAS f32x4*)(modp + ks * 16384 + j) = acc;
        }
    }
    {
        bf16* win_t = wsp<bf16>(F, WS_WIN);
        for (int i2 = gw; i2 < D / 4; i2 += NGW) {
            const int col = lane & 15, k = 4 * i2 + (lane >> 4), sc = col < 8 ? 3072 + col : 6152 + (col - 8);
            win_t[(size_t)(NPP + col) * D + k] = (bf16)f2bf(F.in[IN_WIN][(size_t)k * NPROJ + sc]); }
        const v4u z = {0u, 0u, 0u, 0u};
        for (int i = gw * 64 + lane; i < 16 * D / 8; i += NGW * 64) *(GAS v4u*)(win_t + (size_t)NPROJ * D + (size_t)i * 8) = z;
    }
}
constexpr int CV8_NSH = 32, CV8_SHA = CV8_UG / CV8_NSH, CV8_SHB = CV8_D / CV8_NSH;
#define CONV_NEXT(var) do { var = CV8_TOTAL; \
        if (useA) { const int b_ = __builtin_amdgcn_readfirstlane((int)(lane == 0 ? __hip_atomic_fetch_add(ctrA, 1u, RLX_AGENT) : 0u)); if (b_ < CV8_SHA) var = xs * CV8_SHA + b_; else useA = false; } \
        if (var == CV8_TOTAL && useB) { const int b_ = __builtin_amdgcn_readfirstlane((int)(lane == 0 ? __hip_atomic_fetch_add(ctrB, 1u, RLX_AGENT) : 0u)); if (b_ < CV8_SHB) var = CV8_UG + xs * CV8_SHB + b_; else useB = false; } } while (0)
__device__ __forceinline__ void conv_worker(Frame& F, gu32* stop, unsigned target, int which) {
    LAS unsigned char* scr = F.lds + RING_OFF + F.wave * 9216; const int lane = F.lane, xs = (int)(blockIdx.x & (CV8_NSH - 1));
    gu32* ctrA = F.ctl + CW_CONV + 64 * xs; gu32* ctrB = F.ctl + CW_CONV + 64 * (CV8_NSH + xs);
    bool useA = which != 2, useB = which != 1;
    int it; CONV_NEXT(it); if (it >= CV8_TOTAL) return;
    f32x4 va[16], vb[16];
    Cvt8Item cur = cvt8_item(F, it, 0); cvt8_load(cur, va, lane);
    for (;;) {
        const Cvt8Item c1 = cvt8_item(F, it, 1); cvt8_load(c1, vb, lane);
        bool stopnow = false;
        if (stop) stopnow = (unsigned)__builtin_amdgcn_readfirstlane((int)__hip_atomic_load(stop, RLX_AGENT)) >= target;
        int itn = CV8_TOTAL; if (!stopnow) CONV_NEXT(itn);
        cvt8_pack(va, scr, 0, lane);
        const bool more = itn < CV8_TOTAL; Cvt8Item nx = cur;
        if (more) { nx = cvt8_item(F, itn, 0); cvt8_load(nx, va, lane); }
        cvt8_pack(vb, scr, 1, lane);
        cvt8_flush(cur.dst, D, scr, lane);
        if (!more) break;
        cur = nx; it = itn;
    }
}
__device__ __forceinline__ bool enter_group(Frame& F, int Gc) {
    if (F.G != 256 || Gc >= 256) return true;
    const int bx = (int)blockIdx.x, slot = bx >> 3, xcd = bx & 7, per = Gc >> 3;
    if (slot >= per) return false;
    F.vcu = xcd * per + slot; F.bid = slot * 8 + xcd; F.G = Gc; return true;
}
__device__ __forceinline__ void leave_group(Frame& F) { const int bx = (int)blockIdx.x, G = (int)gridDim.x; F.G = G; F.bid = bx; F.vcu = (G % 8 == 0) ? (bx % 8) * (G / 8) + bx / 8 : bx; }
__device__ __forceinline__ void p1_convert(Frame& F) {
    const int gw = F.vcu * NWAVES + F.wave, NGW = F.G * NWAVES, lane = F.lane;
    {
        LAS unsigned char* scr = F.lds + RING_OFF + F.wave * 9216;
        int it = gw;
        if (it < CV_TOTAL) {
            int ldw, K; CvtItem cur = cvt_item(F, it, ldw, K); f32x4 va[16], vb[16];
            cvt_load(cur, ldw, va, lane);
            for (;;) {
                int itn = it + NGW; int ldn = 0, Kn = 0; CvtItem nx = cur; const bool more = itn < CV_TOTAL;
                if (more) { nx = cvt_item(F, itn, ldn, Kn); cvt_load(nx, ldn, vb, lane); }
                cvt_store(cur, K, va, scr, lane);
                if (!more) break;
                it = itn + NGW; const bool more2 = it < CV_TOTAL; CvtItem n2 = nx; int ld2 = 0, K2 = 0;
                if (more2) { n2 = cvt_item(F, it, ld2, K2); cvt_load(n2, ld2, va, lane); }
                cvt_store(nx, Kn, vb, scr, lane);
                if (!more2) break;
                cur = n2; K = K2;
            }
        }
    }
}
__device__ __forceinline__ void mod_reduce_lds(Frame& F, int j0, int n, LAS float* dst) {
    const float* modp = wsp<float>(F, WS_MODP);
    for (int i = F.tid; i < n; i += NTHR) { const int j = j0 + i; float a = j < 6 * D ? F.in[IN_BADA][j] : F.in[IN_BAF][j - 6 * D];
#pragma unroll
        for (int ks = 0; ks < 32; ++ks) a += modp[ks * 16384 + j];
        dst[i] = a; }
}
__device__ __forceinline__ void modulate_row_bf16(const float* xrow, const float* g, const LAS float* sh, const LAS float* sc, bf16* orow, int lane) {
    const GAS f32x4* xr = (const GAS f32x4*)xrow + lane; f32x4 v[8]; float s2 = 0.f;
#pragma unroll
    for (int j = 0; j < 8; ++j) { v[j] = xr[64 * j]; s2 += (v[j].x * v[j].x + v[j].y * v[j].y) + (v[j].z * v[j].z + v[j].w * v[j].w); }
    const float r = rsqrtf(wave_sum(s2) * (1.f / D) + 1e-6f);
    GAS u32x2* o8 = (GAS u32x2*)orow + lane;
#pragma unroll
    for (int j = 0; j < 8; ++j) { const int c0 = 4 * lane + 256 * j; const f32x4 gg = *(const GAS f32x4*)(g + c0); const f32x4 a = *(const LAS f32x4*)(sc + c0), b = *(const LAS f32x4*)(sh + c0);
        const f32x4 y = v[j] * r * gg * (a + 1.f) + b; u32x2 w; w.x = pk2(y.x, y.y); w.y = pk2(y.z, y.w); o8[64 * j] = w; }
}
typedef float f32x16 __attribute__((ext_vector_type(16)));
typedef short s16x8g __attribute__((ext_vector_type(8)));
__device__ __forceinline__ void p1_modulate(Frame& F) {
    LAS float* shs = (LAS float*)(F.lds + RING_OFF + 81920);
    LAS float* gred = (LAS float*)(F.lds + RING_OFF + 98304);
    mod_reduce_lds(F, 0, 2 * D, shs);
    if (F.tid < 64) {
        const float* modp = wsp<float>(F, WS_MODP); float* mod = wsp<float>(F, WS_MOD);
        for (int j = blockIdx.x * 64 + F.tid; j < 16384; j += F.G * 64) { float a = j < 6 * D ? F.in[IN_BADA][j] : F.in[IN_BAF][j - 6 * D];
#pragma unroll
            for (int ks = 0; ks < 32; ++ks) a += modp[ks * 16384 + j];
            mod[j] = a; }
    }
    __syncthreads();
    bf16* hn = wsp<bf16>(F, WS_HN); const bf16* wg = wsp<bf16>(F, WS_WIN) + (size_t)NPP * D; float* gates = wsp<float>(F, WS_GATES);
    const int lane = F.lane, w = F.wave, hi = lane >> 5, l31 = lane & 31;
    for (int rb = F.vcu; rb < S / 32; rb += F.G) {
        const int row0 = rb * 32;
#pragma unroll 1
        for (int i = 0; i < 4; ++i) { const int m = row0 + 4 * w + i; asm volatile("" ::: "memory"); modulate_row_bf16(F.in[IN_X] + (size_t)m * D, F.in[IN_NMIX], shs, shs + D, hn + (size_t)m * D, lane); }
        asm volatile("s_waitcnt vmcnt(0)" ::: "memory");
        __syncthreads();
        f32x16 acc;
#pragma unroll
        for (int r = 0; r < 16; ++r) acc[r] = 0.f;
        const bf16* ap = hn + (size_t)(row0 + l31) * D + 256 * w + 8 * hi; const bf16* bp = wg + (size_t)l31 * D + 256 * w + 8 * hi;
#pragma unroll
        for (int ks = 0; ks < 16; ++ks) { const s16x8g a = *(const GAS s16x8g*)(ap + 16 * ks), b = *(const GAS s16x8g*)(bp + 16 * ks); acc = __builtin_amdgcn_mfma_f32_32x32x16_bf16(a, b, acc, 0, 0, 0); }
        if (l31 < 16) {
#pragma unroll
            for (int r = 0; r < 16; ++r) gred[(w * 32 + (r & 3) + 8 * (r >> 2) + 4 * hi) * 16 + l31] = acc[r]; }
        __syncthreads();
        { const int row = F.tid >> 4, n = F.tid & 15; float s = 0.f;
#pragma unroll
            for (int q = 0; q < 8; ++q) s += gred[(q * 32 + row) * 16 + n];
            gates[(size_t)(row0 + row) * 16 + n] = s; }
        __syncthreads();
    }
    p1_convert(F);
}
using pg8::Unit; using pg8::cvt_pk_bf16;
struct EpiProj {
    static constexpr bool PERM = true, AFTER_DRAIN = false;
    bf16* O;
    __device__ __forceinline__ void operator()(const pg8::f32x4 (&acc)[2][2][4][2], const Unit& u, int wr, int wc, int fr, int fq) const {
        const int row0 = u.pm * 256 + wr * 64 + fr, col0 = u.pn * 256 + wc * 32 + 8 * fq;
#pragma unroll
        for (int ai = 0; ai < 2; ++ai)
#pragma unroll
            for (int m = 0; m < 4; ++m) { bf16* rowp = O + (size_t)(row0 + ai * 128 + m * 16) * NPP + col0;
#pragma unroll
                for (int bj = 0; bj < 2; ++bj) { const pg8::f32x4 v0 = acc[ai][bj][m][0], v1 = acc[ai][bj][m][1];
                    pg8::u32x4 w; w.x = cvt_pk_bf16(v0[0], v0[1]); w.y = cvt_pk_bf16(v0[2], v0[3]); w.z = cvt_pk_bf16(v1[0], v1[1]); w.w = cvt_pk_bf16(v1[2], v1[3]);
                    *(pg8::u32x4*)(rowp + bj * 128) = w; } }
    }
};
struct EpiOut {
    static constexpr bool PERM = false, AFTER_DRAIN = false;
    const float* x; const float* g1; float* h1;
    __device__ __forceinline__ void operator()(const pg8::f32x4 (&acc)[2][2][4][2], const Unit& u, int wr, int wc, int fr, int fq) const {
        const int row0 = u.pm * 256 + wr * 64 + fr, col0 = u.pn * 256 + wc * 32 + 4 * fq;
        pg8::f32x4 gv[2][2];
#pragma unroll
        for (int bj = 0; bj < 2; ++bj)
#pragma unroll
            for (int n = 0; n < 2; ++n) gv[bj][n] = *(const pg8::f32x4*)(g1 + col0 + bj * 128 + n * 16);
#pragma unroll
        for (int ai = 0; ai < 2; ++ai)
#pragma unroll
            for (int m = 0; m < 4; ++m) { const size_t off = (size_t)(row0 + ai * 128 + m * 16) * D + col0;
#pragma unroll
                for (int bj = 0; bj < 2; ++bj)
#pragma unroll
                    for (int n = 0; n < 2; ++n) { const pg8::f32x4 xv = *(const pg8::f32x4*)(x + off + bj * 128 + n * 16);
                        *(pg8::f32x4*)(h1 + off + bj * 128 + n * 16) = xv + gv[bj][n] * acc[ai][bj][m][n]; } }
    }
};
}
namespace fox {
constexpr int D = 128, SQ = 8192, SKV = 8192; constexpr float THR = 8.f; constexpr bool WSKIP = false;
constexpr int PITCH = 6144;
constexpr int OPITCH = 2048;
constexpr float SCALE = 0.08838834764831845f;
constexpr int NW = 8, QBLK = 32, KVBLK = 64, QB = NW * QBLK;
constexpr int SHM_V = KVBLK * D * 2, SHM_K = KVBLK * D * 2;
constexpr int LDS_BIAS = 2 * SHM_V + 2 * SHM_K + NW * 64 * 4;
constexpr int LDS_BYTES = LDS_BIAS + 512;

using bf16 = __hip_bfloat16;
typedef short bf16x8 __attribute__((ext_vector_type(8)));
typedef short s16x4 __attribute__((ext_vector_type(4)));
typedef float f32x16 __attribute__((ext_vector_type(16)));
typedef float f32x4 __attribute__((ext_vector_type(4)));
typedef unsigned u32x4 __attribute__((ext_vector_type(4)));
template <class A, class Bt> struct same_t { static constexpr bool v = false; };
template <class A> struct same_t<A, A> { static constexpr bool v = true; };

#define KSWZ(row, colB) ((row) * 256 + ((colB) ^ (((row) & 7) << 4)))
#define SBAR() __builtin_amdgcn_sched_barrier(0)
__device__ __forceinline__ int v_st(int k, int c) { const int kk = (k & ~0xC) | ((k & 4) << 1) | ((k & 8) >> 1); return ((kk >> 3) * 4 + (c >> 5)) * 512 + ((kk & 7) * 32 + (c & 31)) * 2; }
__device__ __forceinline__ int v_rd_base(int lane) { return ((lane & 3) << 3) | (((lane >> 2) & 3) << 6) | (((lane >> 4) & 1) << 5) | (((lane >> 5) & 1) << 8); }
constexpr int v_rd_off(int d0, int ks, int half) { return d0 * 512 + ks * 4096 + half * 2048; }
__device__ __forceinline__ int crow(int r, int hi) { return (r & 3) + 8 * (r >> 2) + 4 * hi; }
__device__ __forceinline__ int bias_slot(int kk) { return ((kk >> 2) & 1) * 32 + (kk >> 5) * 16 + (kk & 3) + 4 * ((kk & 31) >> 3); }
__device__ __forceinline__ unsigned cvtpk(float lo, float hi) {
    unsigned r; asm volatile("v_cvt_pk_bf16_f32 %0, %1, %2" : "=v"(r) : "v"(lo), "v"(hi)); return r;
}
__device__ __forceinline__ bf16x8 pack8(f32x4 a, f32x4 b) {
    u32x4 w = {cvtpk(a[0], a[1]), cvtpk(a[2], a[3]), cvtpk(b[0], b[1]), cvtpk(b[2], b[3])};
    return *reinterpret_cast<bf16x8*>(&w);
}
template <class T> __device__ __forceinline__ bf16x8 load8(const T* p) {
    if constexpr (same_t<T, float>::v) { return pack8(*(const f32x4*)p, *(const f32x4*)(p + 4)); }
    else { return *reinterpret_cast<const bf16x8*>(p); }
}
__device__ __forceinline__ void mask_tile(f32x16& p0, f32x16& p1, int dq, unsigned W) {
    const float NEG = -__builtin_inff();
#pragma unroll
    for (int r = 0; r < 16; ++r) {
        const int c = (r & 3) + 8 * (r >> 2);
        if ((unsigned)(dq - c) >= W) p0[r] = NEG;
        if ((unsigned)(dq - c - 32) >= W) p1[r] = NEG;
    }
}
__device__ __forceinline__ void partialSM(f32x16& p0, f32x16& p1, float& m_reg, float& mn, float& alpha) {
    float pmax = p0[0]; for (int r = 1; r < 16; ++r) pmax = fmaxf(pmax, p0[r]); for (int r = 0; r < 16; ++r) pmax = fmaxf(pmax, p1[r]);
    { auto rr = __builtin_amdgcn_permlane32_swap(__float_as_uint(pmax), __float_as_uint(pmax), false, false);
      pmax = fmaxf(__uint_as_float(rr[0]), __uint_as_float(rr[1])); }
    constexpr float C2 = 1.4426950408889634f * SCALE;
    if (__builtin_expect(__all((pmax - m_reg) * SCALE <= THR), 1)) { mn = m_reg; alpha = 1.f; }
    else { mn = fmaxf(m_reg, pmax); alpha = __builtin_amdgcn_exp2f((m_reg - mn) * C2); m_reg = mn; }
    const float mnL = -mn * C2;
    for (int r = 0; r < 16; ++r) p0[r] = fmaf(p0[r], C2, mnL); for (int r = 0; r < 16; ++r) p1[r] = fmaf(p1[r], C2, mnL);
    for (int r = 0; r < 16; ++r) p0[r] = __builtin_amdgcn_exp2f(p0[r]);
}
__device__ __forceinline__ void finishSM(f32x16& p0, f32x16& p1, float alpha, float& l_reg, bf16x8& pa0, bf16x8& pa1, bf16x8& pa2, bf16x8& pa3) {
    for (int r = 0; r < 16; ++r) p1[r] = __builtin_amdgcn_exp2f(p1[r]);
    float ps = 0; for (int r = 0; r < 16; ++r) ps += p0[r]; for (int r = 0; r < 16; ++r) ps += p1[r];
    { auto rr = __builtin_amdgcn_permlane32_swap(__float_as_uint(ps), __float_as_uint(ps), false, false);
      ps = __uint_as_float(rr[0]) + __uint_as_float(rr[1]); }
    l_reg = l_reg * alpha + ps;
#define PK4(P, B_, OUT) do { unsigned a0 = cvtpk(P[B_+0], P[B_+1]), a1 = cvtpk(P[B_+2], P[B_+3]);                          \
        unsigned b0 = cvtpk(P[B_+4], P[B_+5]), b1 = cvtpk(P[B_+6], P[B_+7]);                                             \
        auto r0 = __builtin_amdgcn_permlane32_swap(a0, b0, false, false); auto r1 = __builtin_amdgcn_permlane32_swap(a1, b1, false, false); \
        u32x4 w = {r0[0], r1[0], r0[1], r1[1]}; OUT = *reinterpret_cast<bf16x8*>(&w); } while (0)
    PK4(p0, 0, pa0); PK4(p0, 8, pa1); PK4(p1, 0, pa2); PK4(p1, 8, pa3);
#undef PK4
}
template <int KB, bool SK>
__device__ __forceinline__ void qkt(f32x16& p0, f32x16& p1, const char* K_lds, int r32, int hi, const bf16x8* qr, bool act) {
    if (SK && !act) { const float NEG = -__builtin_inff();
#pragma unroll
        for (int r = 0; r < 16; ++r) { p0[r] = NEG; p1[r] = NEG; } return; }
    { const f32x16* bp = reinterpret_cast<const f32x16*>(K_lds - 2 * SHM_V + LDS_BIAS + KB * 256 + hi * 128); p0 = bp[0]; p1 = bp[1]; }
    const char* kb[4];
#pragma unroll
    for (int dd = 0; dd < 4; ++dd) kb[dd] = K_lds + KB * SHM_K + KSWZ(r32, (dd * 16 + hi * 8) * 2);
#pragma unroll
    for (int d0 = 0; d0 < 8; ++d0) { const char* a = kb[d0 & 3] + (d0 >> 2) * 128;
        bf16x8 b0 = *reinterpret_cast<const bf16x8*>(a);
        bf16x8 b1 = *reinterpret_cast<const bf16x8*>(a + 32 * 256);
        p0 = __builtin_amdgcn_mfma_f32_32x32x16_bf16(b0, qr[d0], p0, 0, 0, 0);
        p1 = __builtin_amdgcn_mfma_f32_32x32x16_bf16(b1, qr[d0], p1, 0, 0, 0); }
}
template <int VB, bool SK>
__device__ __forceinline__ void pv_tile(f32x16* o, int vb0, bf16x8 pa0, bf16x8 pa1, bf16x8 pa2, bf16x8 pa3, bool act) {
    if (SK && !act) return;
#define TRRD(dst, off) asm volatile("ds_read_b64_tr_b16 %0, %1 offset:%2" : "=&v"(dst) : "v"(vb0), "i"(off) : "memory")
#define PV_D0(d0) do { s16x4 l0, l1, l2, l3, h0, h1, h2, h3; constexpr int b_ = VB * SHM_V + v_rd_off(d0, 0, 0);     \
        TRRD(l0, b_); TRRD(h0, b_ + 2048); TRRD(l1, b_ + 4096); TRRD(h1, b_ + 6144); TRRD(l2, b_ + 8192); TRRD(h2, b_ + 10240); TRRD(l3, b_ + 12288); TRRD(h3, b_ + 14336); \
        asm volatile("s_waitcnt lgkmcnt(0)" ::: "memory"); SBAR();                 \
        o[d0] = __builtin_amdgcn_mfma_f32_32x32x16_bf16(pa0, (bf16x8){l0[0], l0[1], l0[2], l0[3], h0[0], h0[1], h0[2], h0[3]}, o[d0], 0, 0, 0);   \
        o[d0] = __builtin_amdgcn_mfma_f32_32x32x16_bf16(pa1, (bf16x8){l1[0], l1[1], l1[2], l1[3], h1[0], h1[1], h1[2], h1[3]}, o[d0], 0, 0, 0);   \
        o[d0] = __builtin_amdgcn_mfma_f32_32x32x16_bf16(pa2, (bf16x8){l2[0], l2[1], l2[2], l2[3], h2[0], h2[1], h2[2], h2[3]}, o[d0], 0, 0, 0);   \
        o[d0] = __builtin_amdgcn_mfma_f32_32x32x16_bf16(pa3, (bf16x8){l3[0], l3[1], l3[2], l3[3], h3[0], h3[1], h3[2], h3[3]}, o[d0], 0, 0, 0); } while (0)
    PV_D0(0); PV_D0(1); PV_D0(2); PV_D0(3);
#undef PV_D0
#undef TRRD
}

template <class TIn, class TOut> struct BlockRef { const TIn* Q; const TIn* K; const TIn* V; TOut* O; int P0; const float* Fb; const float* gain;
    int jlo, jhi;
    float* Op; float* ML; };
template <class TIn> struct Seam {
    bf16x8 qr[8];
    bf16x8 st_v0, st_v1, st_k0, st_k1; f32x4 sf0, sf1, sf2, sf3; float st_b;
    f32x4 tq[16];
};
__device__ __forceinline__ int swa_jlo(int P0, int W) { const int lowk = P0 - W + 1; return lowk > 0 ? lowk / KVBLK : 0; }
#define ROW(p, k0, rr) ((p) + (size_t)((k0) + (rr)) * PITCH + sc)
#define VMW() asm volatile("s_waitcnt vmcnt(0)" ::: "memory")
#define VMWN(n) asm volatile("s_waitcnt vmcnt(%0)" :: "i"(n) : "memory")
#define SLOAD_H(Kp, Vp, k0) SLOAD_HB(Kp, Vp, k0, cur)
#define SLOAD_HB(Kp, Vp, k0, blk) do { S.st_v0 = load8<TIn>(ROW(Vp, k0, sr)); S.st_v1 = load8<TIn>(ROW(Vp, k0, 32 + sr));              \
                         S.st_k0 = load8<TIn>(ROW(Kp, k0, sr)); S.st_k1 = load8<TIn>(ROW(Kp, k0, 32 + sr)); \
                         if (tid < 64) S.st_b = ((blk).Fb[(blk).P0] - (blk).Fb[(k0) + tid]) * (1.0f / SCALE); } while (0)
#define SWRITE_HK(bf) do { *(bf16x8*)(K_lds + (bf) * SHM_K + kws) = S.st_k0; *(bf16x8*)(K_lds + (bf) * SHM_K + kws + 32 * 256) = S.st_k1; \
                         if (tid < 64) *(float*)(K_lds - 2 * SHM_V + LDS_BIAS + (bf) * 256 + bws) = S.st_b; } while (0)
#define SWRITE_HV(bf) do { *(bf16x8*)(V_lds + (bf) * SHM_V + vst0) = S.st_v0; *(bf16x8*)(V_lds + (bf) * SHM_V + vst1) = S.st_v1; } while (0)
#define SWRITE_H(bf) do { SWRITE_HV(bf); SWRITE_HK(bf); } while (0)
#define SLOAD_F(p, k0) do { S.sf0 = *(const f32x4*)ROW(p, k0, sr); S.sf1 = *(const f32x4*)(ROW(p, k0, sr) + 4);                \
                            S.sf2 = *(const f32x4*)ROW(p, k0, 32 + sr); S.sf3 = *(const f32x4*)(ROW(p, k0, 32 + sr) + 4); } while (0)
#define SWRITE_KF(bf) do { *(bf16x8*)(K_lds + (bf) * SHM_K + kws) = pack8(S.sf0, S.sf1); *(bf16x8*)(K_lds + (bf) * SHM_K + kws + 32 * 256) = pack8(S.sf2, S.sf3); } while (0)
#define SWRITE_VF(bf) do { *(bf16x8*)(V_lds + (bf) * SHM_V + vst0) = pack8(S.sf0, S.sf1); *(bf16x8*)(V_lds + (bf) * SHM_V + vst1) = pack8(S.sf2, S.sf3); } while (0)
template <class TIn, class TOut>
__device__ __forceinline__ void causal_swa_prime(const BlockRef<TIn, TOut>& cur, int W, char* lds, Seam<TIn>& S) {
    constexpr bool F32 = same_t<TIn, float>::v;
    const int tid = threadIdx.x, wid = __builtin_amdgcn_readfirstlane(tid >> 6), lane = tid & 63, r32 = lane & 31, hi = lane >> 5;
    const int sr = tid >> 4, sc = (tid & 15) * 8, kws = KSWZ(sr, sc * 2); char* K_lds = lds + 2 * SHM_V;
    const int bws = bias_slot(tid & 63) * 4;
    const int kb0 = cur.jlo * KVBLK;
    for (int d0 = 0; d0 < 8; ++d0) S.qr[d0] = load8<TIn>(cur.Q + (size_t)(wid * QBLK + r32) * PITCH + d0 * 16 + hi * 8);
    if constexpr (F32) { SLOAD_F((const float*)cur.K, kb0); VMW(); SWRITE_KF(0); SBAR(); SLOAD_F((const float*)cur.V, kb0); }
    else { SLOAD_H(cur.K, cur.V, kb0); VMW(); SWRITE_HK(0); }
    __syncthreads();
}
template <class TIn, class TOut>
__device__ __forceinline__ void causal_swa_block(const BlockRef<TIn, TOut>& cur, const BlockRef<TIn, TOut>& nxt, int skv, int W, char* lds, Seam<TIn>& S) {
    constexpr bool F32 = same_t<TIn, float>::v;
    const int tid = threadIdx.x, wid = __builtin_amdgcn_readfirstlane(tid >> 6), lane = tid & 63, r32 = lane & 31, hi = lane >> 5;
    const int j_lo = cur.jlo; const int j_hi = cur.jhi;
    const int NT = j_hi - j_lo;
    const int kbn = nxt.jlo * KVBLK;
    const int qlo = cur.P0 + wid * QBLK, qm = qlo + r32 - 4 * hi;
    char* V_lds = lds; char* K_lds = lds + 2 * SHM_V;
    float* ws = (float*)(lds + 2 * SHM_V + 2 * SHM_K) + wid * 64; float* li_l = ws, * al_l = ws + 32;
    float m_reg = -1e30f, l_reg = 0; f32x16 o[4] = {};
    const int sr = tid >> 4, sc = (tid & 15) * 8, vst0 = v_st(sr, sc), vst1 = v_st(32 + sr, sc), kws = KSWZ(sr, sc * 2);
    const int bws = bias_slot(tid & 63) * 4;
    const int vb0 = (int)(uintptr_t)V_lds + v_rd_base(lane);
    const TIn* Kh = cur.K; const TIn* Vh = cur.V;
#define RESC(a) do { if (__any((a) < 1.f)) { if (hi == 0) al_l[r32] = (a); asm volatile("s_waitcnt lgkmcnt(0)" ::: "memory");              \
                     for (int d_ = 0; d_ < 4; ++d_) for (int r = 0; r < 16; ++r) o[d_][r] *= al_l[crow(r, hi)]; } } while (0)
#define KBASE(t) ((j_lo + (t)) * KVBLK)
#define ACT(t) (KBASE(t) <= qlo + QBLK - 1 && KBASE(t) + KVBLK - 1 >= qlo - W + 1)
#define MASKT(P0_, P1_, t) do { const int kb_ = KBASE(t); if ((!SK || ACT(t)) && (kb_ + KVBLK - 1 > qlo || kb_ <= qlo + QBLK - 1 - W)) mask_tile(P0_, P1_, qm - kb_, (unsigned)W); } while (0)
    constexpr int NQL = F32 ? 16 : 8;
    constexpr bool SK = WSKIP && !F32;
#define SEAM_K0() do { VMWN(NQL); if constexpr (F32) { SWRITE_KF(0); SBAR(); SLOAD_F((const float*)nxt.V, kbn); } else { SWRITE_HK(0); } SBAR(); } while (0)
    f32x16 pA0, pA1, pB0, pB1; float mnA, mnB, alA, alB; bf16x8 pa0, pa1, pa2, pa3;
    if constexpr (F32) { VMW(); SWRITE_VF(0); SBAR(); } else { SWRITE_HV(0); SBAR(); }
    if (NT > 1) { if constexpr (F32) SLOAD_F((const float*)Kh, KBASE(1)); else SLOAD_H(Kh, Vh, KBASE(1)); }
    SBAR(); qkt<0, SK>(pA0, pA1, K_lds, r32, hi, S.qr, ACT(0));
    if constexpr (F32) { if (NT > 1) { VMW(); SWRITE_KF(1); SBAR(); SLOAD_F((const float*)Vh, KBASE(1)); } }
    MASKT(pA0, pA1, 0); partialSM(pA0, pA1, m_reg, mnA, alA);
    if (NT > 1) { VMW(); if constexpr (F32) { SWRITE_VF(1); SBAR(); if (NT > 2) SLOAD_F((const float*)Kh, KBASE(2)); } else SWRITE_H(1); }
    __syncthreads();
#define HALF_STEP(PX0, PX1, mnX, alX, PY0, PY1, alY, t, KB, VB, SB) do {                                                      \
        SBAR(); qkt<KB, SK>(PX0, PX1, K_lds, r32, hi, S.qr, ACT(t));                                             \
        finishSM(PY0, PY1, alY, l_reg, pa0, pa1, pa2, pa3); SBAR();                                                           \
        if ((t) + 1 < NT) { if constexpr (F32) { VMW(); SWRITE_KF(SB); SBAR(); SLOAD_F((const float*)Vh, KBASE((t) + 1)); }  \
                            else { SLOAD_H(Kh, Vh, KBASE((t) + 1)); } SBAR(); }                                               \
        pv_tile<VB, SK>(o, vb0, pa0, pa1, pa2, pa3, ACT((t) - 1)); MASKT(PX0, PX1, (t)); partialSM(PX0, PX1, m_reg, mnX, alX);                                        \
        __syncthreads();                                                                                                      \
        if ((t) + 1 < NT) { VMW(); if constexpr (F32) { SWRITE_VF(SB); SBAR(); if ((t) + 2 < NT) SLOAD_F((const float*)Kh, KBASE((t) + 2)); } \
                            else { SWRITE_H(SB); } }                                                                          \
        RESC(alX); __syncthreads(); } while (0)
    for (int t = 1; t + 1 < NT; t += 2) {
        HALF_STEP(pB0, pB1, mnB, alB, pA0, pA1, alA, t, 1, 0, 0);
        HALF_STEP(pA0, pA1, mnA, alA, pB0, pB1, alB, t + 1, 0, 1, 1);
    }
    const bool even = (NT & 1) == 0;
    if (even) { SBAR(); qkt<1, SK>(pB0, pB1, K_lds, r32, hi, S.qr, ACT(NT - 1)); SBAR(); }
#define QROW(e) (nxt.Q + (size_t)(wid * QBLK + r32) * PITCH + ((e) >> 1) * 16 + hi * 8 + ((e) & 1) * 4)
    if constexpr (F32) { SLOAD_F((const float*)nxt.K, kbn); SBAR();
#pragma unroll
        for (int e = 0; e < 8; ++e) S.tq[e] = *(const f32x4*)QROW(e); }
    else { SLOAD_HB(nxt.K, nxt.V, kbn, nxt); SBAR();
#pragma unroll
        for (int d0 = 0; d0 < 8; ++d0) S.qr[d0] = load8<TIn>(nxt.Q + (size_t)(wid * QBLK + r32) * PITCH + d0 * 16 + hi * 8); }
    SBAR();
    finishSM(pA0, pA1, alA, l_reg, pa0, pa1, pa2, pa3); SBAR();
    if constexpr (F32) {
#pragma unroll
        for (int e = 8; e < 16; ++e) S.tq[e] = *(const f32x4*)QROW(e); SBAR(); }
#undef QROW
    pv_tile<0, SK>(o, vb0, pa0, pa1, pa2, pa3, ACT(even ? NT - 2 : NT - 1));
    if (even) { MASKT(pB0, pB1, NT - 1); partialSM(pB0, pB1, m_reg, mnB, alB); __syncthreads(); RESC(alB);
        finishSM(pB0, pB1, alB, l_reg, pa0, pa1, pa2, pa3); SBAR(); pv_tile<1, SK>(o, vb0, pa0, pa1, pa2, pa3, ACT(NT - 1)); }
    SBAR(); SEAM_K0();
    if (hi == 0) li_l[r32] = l_reg; asm volatile("s_waitcnt lgkmcnt(0)" ::: "memory");
    if (cur.Op != nullptr) {
        int rp = r32; asm volatile("" : "+v"(rp));
        if (hi == 0) { float2 mlv; mlv.x = m_reg; mlv.y = l_reg; *(float2*)(cur.ML + 2 * (wid * QBLK + rp)) = mlv; }
        float* Pr = cur.Op + (size_t)(wid * QBLK + 4 * hi) * D + rp;
#pragma unroll
        for (int r = 0; r < 16; ++r) {
#pragma unroll
            for (int d0 = 0; d0 < 4; ++d0) Pr[d0 * 32] = o[d0][r];
            Pr += ((r & 3) == 3 ? 5 : 1) * D; asm volatile("" : "+v"(Pr) :: "memory"); }
    } else {
    int ro = r32; asm volatile("" : "+v"(ro));
    TOut* Or = cur.O + (size_t)(wid * QBLK + 4 * hi) * OPITCH + ro;
    float gn[4];
#pragma unroll
    for (int d0 = 0; d0 < 4; ++d0) gn[d0] = cur.gain[d0 * 32 + ro];
#pragma unroll
    for (int r = 0; r < 16; ++r) { const int orow = crow(r, hi); const float rl = __builtin_amdgcn_rcpf(li_l[orow]);
        float v[4]; float ss = 0.f;
#pragma unroll
        for (int d0 = 0; d0 < 4; ++d0) { v[d0] = o[d0][r] * rl; ss += v[d0] * v[d0]; }
        ss += __shfl_xor(ss, 1); ss += __shfl_xor(ss, 2); ss += __shfl_xor(ss, 4); ss += __shfl_xor(ss, 8); ss += __shfl_xor(ss, 16);
        const float rn = __builtin_amdgcn_rsqf(ss * (1.0f / 128.0f) + 1e-6f);
#pragma unroll
        for (int d0 = 0; d0 < 4; ++d0) { const float vv = v[d0] * rn * gn[d0]; const float vn = __shfl_xor(vv, 1);
            if ((ro & 1) == 0) *(unsigned*)(Or + d0 * 32) = cvtpk(vv, vn); }
        Or += ((r & 3) == 3 ? 5 : 1) * OPITCH; asm volatile("" : "+v"(Or) :: "memory"); }
    }
    if constexpr (F32) {
#pragma unroll
        for (int d0 = 0; d0 < 8; ++d0) S.qr[d0] = pack8(S.tq[2 * d0], S.tq[2 * d0 + 1]); }
    __syncthreads();
#undef RESC
#undef KBASE
#undef ACT
#undef MASKT
#undef SEAM_K0
#undef HALF_STEP
}
#undef ROW
#undef VMW
#undef VMWN
#undef SLOAD_H
#undef SWRITE_HK
#undef SWRITE_HV
#undef SWRITE_H
#undef SLOAD_F
#undef SWRITE_KF
#undef SWRITE_VF

}
namespace mk {
typedef short s16x8 __attribute__((ext_vector_type(8)));
#define MFMA32(a, b, c) __builtin_amdgcn_mfma_f32_32x32x16_bf16((a), (b), (c), 0, 0, 0)
__device__ __forceinline__ int crow32(int r, int hi) { return (r & 3) + 8 * (r >> 2) + 4 * hi; }
constexpr float SCALEQ = 0.08838834764831845f;
__device__ __forceinline__ float wave_scan_add(float v, int lane) {
#pragma unroll
    for (int o = 1; o < 64; o <<= 1) { const float t = __shfl_up(v, o); if (lane >= o) v += t; }
    return v;
}
__device__ __forceinline__ float wave_scan_max(float v, int lane) {
#pragma unroll
    for (int o = 1; o < 64; o <<= 1) { const float t = __shfl_up(v, o); if (lane >= o) v = fmaxf(v, t); }
    return v;
}
__device__ __forceinline__ float wave_max(float v) {
#pragma unroll
    for (int o = 1; o < 64; o <<= 1) v = fmaxf(v, __shfl_xor(v, o));
    return v;
}
constexpr int TSTR = 72;
template <bool SCALED>
__device__ __forceinline__ void stage_transposed(const bf16* src, int ncols, LAS bf16* T, const LAS float* wl, int tid) {
    const int cpr = ncols / 8;
    for (int q = tid; q < 64 * cpr; q += NTHR) { const int s = q / cpr, c8 = (q % cpr) * 8;
        const v4u raw = *(const GAS v4u*)(src + (size_t)s * NPP + c8);
        const unsigned w4[4] = {raw.x, raw.y, raw.z, raw.w};
#pragma unroll
        for (int j = 0; j < 4; ++j) { unsigned lo = w4[j] & 0xffffu, hi = w4[j] >> 16;
            if (SCALED) { const float sc = wl[s]; lo = f2bf(bf2f((unsigned short)lo) * sc); hi = f2bf(bf2f((unsigned short)hi) * sc); }
            T[(c8 + 2 * j) * TSTR + s] = (bf16)lo; T[(c8 + 2 * j + 1) * TSTR + s] = (bf16)hi; } }
}
__device__ __forceinline__ void p_fscan(Frame& F, int h) {
    const int tid = F.tid, lane = F.lane; const float* gates = wsp<float>(F, WS_GATES);
        const float b = F.in[IN_FOXBF][h]; float* Fo = wsp<float>(F, WS_F) + h * S;
        LAS double* tot = (LAS double*)(F.lds + RING_OFF);
        double loc[16]; double acc = 0.0;
#pragma unroll
        for (int i = 0; i < 16; ++i) { acc += (double)log_sigmoid_f(gates[(size_t)(tid * 16 + i) * 16 + 8 + h] + b); loc[i] = acc; }
        tot[tid] = acc;
        __syncthreads();
        if (F.wave == 0) { double v[8]; double s = 0.0;
#pragma unroll
            for (int i = 0; i < 8; ++i) { v[i] = tot[lane * 8 + i]; s += v[i]; }
            double inc = s;
#pragma unroll
            for (int o = 1; o < 64; o <<= 1) { const double t = __shfl_up(inc, o); if (lane >= o) inc += t; }
            double ex = inc - s;
#pragma unroll
            for (int i = 0; i < 8; ++i) { tot[lane * 8 + i] = ex; ex += v[i]; } }
        __syncthreads();
        const double off = tot[tid];
        LAS float* Fl = (LAS float*)(F.lds + RING_OFF + 8192);
#pragma unroll
        for (int i = 0; i < 16; ++i) { const float fv = (float)(off + loc[i]); Fo[tid * 16 + i] = fv; Fl[tid * 16 + i] = fv; }
        __syncthreads();
        if (tid < 32) {
            float gq = 0.f, gk = 0.f;
#pragma unroll
            for (int j = 0; j < 4; ++j) { gq = fmaxf(gq, fabsf(F.in[IN_FOXQN][tid + 32 * j])); gk = fmaxf(gk, fabsf(F.in[IN_FOXKN][tid + 32 * j])); }
#pragma unroll
            for (int o = 1; o < 32; o <<= 1) { gq = fmaxf(gq, __shfl_xor(gq, o)); gk = fmaxf(gk, __shfl_xor(gk, o)); }
            const float thr = 2.f * 11.3137085f * gq * gk + 26.f;
            const int qb = tid, P0 = qb * 256; const float f0 = Fl[P0];
            int lo = 0, hi2 = 4 * qb;
            while (lo < hi2) { const int mid = (lo + hi2) >> 1; if (Fl[64 * mid + 63] - f0 <= thr) hi2 = mid; else lo = mid + 1; }
            wsp<int>(F, WS_JLO)[h * 32 + qb] = lo;
        }
        __syncthreads();
}
__device__ __forceinline__ void p3_prep(Frame& F) {
    const int gw = F.vcu * NWAVES + F.wave, NGW = F.G * NWAVES, lane = F.lane, tid = F.tid;
    bf16* proj = wsp<bf16>(F, WS_PROJ); const float* gates = wsp<float>(F, WS_GATES);
    {
        const int seg = lane >> 2, qd = (lane & 3) * 32; const float* gn = (seg < 8 ? F.in[IN_FOXQN] : F.in[IN_FOXKN]) + qd;
        for (int m = gw; m < S; m += NGW) {
            bf16* p = proj + (size_t)m * NPP + C_FQ + seg * 128 + qd; v4u raw[4]; float x[32]; float ss = 0.f;
#pragma unroll
            for (int j = 0; j < 4; ++j) raw[j] = *(const GAS v4u*)(p + 8 * j);
#pragma unroll
            for (int j = 0; j < 4; ++j) { const unsigned w4[4] = {raw[j].x, raw[j].y, raw[j].z, raw[j].w};
#pragma unroll
                for (int i = 0; i < 4; ++i) { x[8 * j + 2 * i] = bf2f((unsigned short)(w4[i] & 0xffffu)); x[8 * j + 2 * i + 1] = bf2f((unsigned short)(w4[i] >> 16)); } }
#pragma unroll
            for (int i = 0; i < 32; ++i) ss += x[i] * x[i];
            ss += __shfl_xor(ss, 1); ss += __shfl_xor(ss, 2);
            const float r = rsqrtf(ss * (1.f / 128.f) + 1e-6f);
#pragma unroll
            for (int j = 0; j < 4; ++j) { v4u o; const f32x4 g0 = *(const GAS f32x4*)(gn + 8 * j), g1 = *(const GAS f32x4*)(gn + 8 * j + 4);
                o.x = pk2(x[8 * j] * r * g0.x, x[8 * j + 1] * r * g0.y); o.y = pk2(x[8 * j + 2] * r * g0.z, x[8 * j + 3] * r * g0.w);
                o.z = pk2(x[8 * j + 4] * r * g1.x, x[8 * j + 5] * r * g1.y); o.w = pk2(x[8 * j + 6] * r * g1.z, x[8 * j + 7] * r * g1.w);
                *(GAS v4u*)(p + 8 * j) = o; }
        }
    }
    if (F.G != 256 && blockIdx.x < 8) p_fscan(F, (int)blockIdx.x);
    {
        LAS bf16* KT = (LAS bf16*)(F.lds + RING_OFF);
        LAS bf16* VT = KT + 128 * TSTR;
        LAS float* wl = (LAS float*)(VT + 256 * TSTR);
        float* UL = wsp<float>(F, WS_UL); float* NL = wsp<float>(F, WS_NL); float* GLAL = wsp<float>(F, WS_GLAL);
        const int hi = lane >> 5, l31 = lane & 31, w = F.wave;
        for (int u = F.vcu; u < 4 * NCH; u += F.G) {
            const int h = u >> 7, ch = u & 127, t0 = ch * LCH;
            if (w == 0) {
                const float ip = softcap_f(gates[(size_t)(t0 + lane) * 16 + h] + F.in[IN_BI][h]);
                const float fp = softcap_f(gates[(size_t)(t0 + lane) * 16 + 4 + h] + F.in[IN_BF][h]);
                const float g = wave_scan_add(log_sigmoid_f(fp), lane), a = ip - g, amax = wave_max(a);
                wl[lane] = __expf(a - amax);
                if (lane == 63) { GLAL[u * 2] = g; GLAL[u * 2 + 1] = amax; }
            }
            __syncthreads();
            stage_transposed<true>(proj + (size_t)t0 * NPP + C_MK + h * 128, 128, KT, wl, tid);
            stage_transposed<false>(proj + (size_t)t0 * NPP + C_MV + h * 256, 256, VT, wl, tid);
            __syncthreads();
            f32x16 acc[4];
#pragma unroll
            for (int dt = 0; dt < 4; ++dt)
#pragma unroll
                for (int r = 0; r < 16; ++r) acc[dt][r] = 0.f;
#pragma unroll
            for (int ks = 0; ks < 4; ++ks) { const s16x8 a = *(const LAS s16x8*)(VT + (32 * w + l31) * TSTR + 16 * ks + 8 * hi);
#pragma unroll
                for (int dt = 0; dt < 4; ++dt) { const s16x8 b = *(const LAS s16x8*)(KT + (32 * dt + l31) * TSTR + 16 * ks + 8 * hi); acc[dt] = MFMA32(a, b, acc[dt]); } }
            float* ut = UL + (size_t)u * 256 * 128;
#pragma unroll
            for (int dt = 0; dt < 4; ++dt)
#pragma unroll
                for (int r = 0; r < 16; ++r) ut[(size_t)(32 * w + crow32(r, hi)) * 128 + 32 * dt + l31] = acc[dt][r];
            if (tid < 128) { float s = 0.f;
#pragma unroll
                for (int j = 0; j < 8; ++j) { const s16x8 kv = *(const LAS s16x8*)(KT + tid * TSTR + 8 * j);
#pragma unroll
                    for (int i = 0; i < 8; ++i) s += bf2f((unsigned short)kv[i]); }
                NL[u * 128 + tid] = s; }
            __syncthreads();
        }
    }
}
__device__ __forceinline__ void p4_scan(Frame& F) {
    LAS float* gl = (LAS float*)(F.lds + RING_OFF);
    LAS float* dec = gl + 256; LAS float* scl = dec + 128; LAS float* mv = scl + 128;
    const float* UL = wsp<float>(F, WS_UL); const float* NL = wsp<float>(F, WS_NL); const float* GLAL = wsp<float>(F, WS_GLAL);
    bf16* CS = wsp<bf16>(F, WS_CS); float* NS = wsp<float>(F, WS_NS); float* MS = wsp<float>(F, WS_MS);
    const int tid = F.tid;
    for (int blk = F.vcu; blk < 4 * 64; blk += F.G) {
        const int h = blk >> 6, rem0 = (blk & 63) * 512;
        if (tid < 256) gl[tid] = GLAL[h * 256 + tid];
        __syncthreads();
        if (tid == 0) { float m = 0.f;
            for (int c = 0; c < NCH; ++c) { const float g = gl[2 * c], al = gl[2 * c + 1], mn = g + fmaxf(m, al);
                mv[c] = m; dec[c] = __expf(g + m - mn); scl[c] = __expf(g + al - mn); m = mn; } }
        __syncthreads();
        if (rem0 == 0 && tid < 128) MS[h * 128 + tid] = mv[tid];
        const int rem = rem0 + tid;
        const float* ul = UL + (size_t)h * NCH * 32768 + rem; bf16* cs = CS + (size_t)h * NCH * 32768 + rem;
        float C = 0.f;
#pragma unroll 1
        for (int c0 = 0; c0 < NCH; c0 += 64) {
            float u[64];
#pragma unroll
            for (int i = 0; i < 64; ++i) u[i] = ul[(size_t)(c0 + i) * 32768];
#pragma unroll
            for (int i = 0; i < 64; ++i) { cs[(size_t)(c0 + i) * 32768] = (bf16)f2bf(C); C = dec[c0 + i] * C + scl[c0 + i] * u[i]; }
        }
        if (rem0 == 0 && tid < 128) { float n = 0.f; const float* nl = NL + (size_t)h * NCH * 128 + tid; float* ns = NS + (size_t)h * NCH * 128 + tid;
#pragma unroll 8
            for (int c = 0; c < NCH; ++c) { ns[c * 128] = n; n = dec[c] * n + scl[c] * nl[c * 128]; } }
        __syncthreads();
    }
}
constexpr int NUMSTR = 260;
__device__ __forceinline__ void p5_mlstm_out(Frame& F) {
    LAS bf16* VT = (LAS bf16*)(F.lds + RING_OFF);
    LAS bf16* Pm = VT + 256 * TSTR;
    LAS float* NUM = (LAS float*)(Pm + 64 * TSTR);
    LAS float* a_s = NUM + 64 * NUMSTR; LAS float* Mt = a_s + 64; LAS float* inter = Mt + 64; LAS float* emt = inter + 64; LAS float* qn = emt + 64; LAS float* dinv = qn + 64;
    const bf16* proj = wsp<bf16>(F, WS_PROJ); const float* gates = wsp<float>(F, WS_GATES); const bf16* CS = wsp<bf16>(F, WS_CS);
    const float* NS = wsp<float>(F, WS_NS); const float* MS = wsp<float>(F, WS_MS); bf16* concat = wsp<bf16>(F, WS_CONCAT);
    const int tid = F.tid, lane = F.lane, w = F.wave, hi = lane >> 5, l31 = lane & 31;
    for (int u = F.vcu; u < 4 * NCH; u += F.G) {
        const int h = u >> 7, ch = u & 127, t0 = ch * LCH;
        const bf16* qbase = proj + (size_t)t0 * NPP + C_MQ + h * 128; const bf16* kbase = proj + (size_t)t0 * NPP + C_MK + h * 128;
        if (w == 0) {
            const float ip = softcap_f(gates[(size_t)(t0 + lane) * 16 + h] + F.in[IN_BI][h]);
            const float fp = softcap_f(gates[(size_t)(t0 + lane) * 16 + 4 + h] + F.in[IN_BF][h]);
            const float g = wave_scan_add(log_sigmoid_f(fp), lane), a = ip - g, cm = wave_scan_max(a, lane);
            const float mp = MS[u], M = fmaxf(mp, cm);
            a_s[lane] = a; Mt[lane] = M; inter[lane] = __expf(mp - M); emt[lane] = __expf(-(g + M));
        }
        stage_transposed<false>(proj + (size_t)t0 * NPP + C_MV + h * 256, 256, VT, a_s, tid);
        __syncthreads();
        if (w < 4) {
            const int ti = w >> 1, si = w & 1;
            if (si <= ti) {
                s16x8 qa[8], kb[8];
#pragma unroll
                for (int ks = 0; ks < 8; ++ks) { qa[ks] = *(const GAS s16x8*)(qbase + (size_t)(32 * ti + l31) * NPP + 16 * ks + 8 * hi); kb[ks] = *(const GAS s16x8*)(kbase + (size_t)(32 * si + l31) * NPP + 16 * ks + 8 * hi); }
                f32x16 acc;
#pragma unroll
                for (int r = 0; r < 16; ++r) acc[r] = 0.f;
#pragma unroll
                for (int ks = 0; ks < 8; ++ks) acc = MFMA32(qa[ks], kb[ks], acc);
                const int s = 32 * si + l31; const float as = a_s[s];
#pragma unroll
                for (int r = 0; r < 16; ++r) { const int t = 32 * ti + crow32(r, hi); const float p = (s <= t) ? acc[r] * SCALEQ * __expf(as - Mt[t]) : 0.f; Pm[t * TSTR + s] = (bf16)f2bf(p); }
            } else {
#pragma unroll
                for (int r = 0; r < 16; ++r) Pm[(32 * ti + crow32(r, hi)) * TSTR + 32 * si + l31] = (bf16)0;
            }
        } else {
            const int t = (tid - 256) >> 2, d0 = ((tid - 256) & 3) * 32; float s = 0.f; const float* np = NS + (size_t)u * 128 + d0;
#pragma unroll
            for (int j = 0; j < 4; ++j) { const s16x8 qv = *(const GAS s16x8*)(qbase + (size_t)t * NPP + d0 + 8 * j);
#pragma unroll
                for (int i = 0; i < 8; ++i) s += bf2f((unsigned short)qv[i]) * np[8 * j + i]; }
            s += __shfl_xor(s, 1); s += __shfl_xor(s, 2);
            if ((tid & 3) == 0) qn[t] = s * SCALEQ;
        }
        __syncthreads();
        f32x16 accP[2], accC[2];
#pragma unroll
        for (int ti = 0; ti < 2; ++ti)
#pragma unroll
            for (int r = 0; r < 16; ++r) { accP[ti][r] = 0.f; accC[ti][r] = 0.f; }
        {
            const bf16* cs = CS + (size_t)u * 32768 + (size_t)(32 * w + l31) * 128 + 8 * hi;
            s16x8 cb[8];
#pragma unroll
            for (int ks = 0; ks < 8; ++ks) cb[ks] = *(const GAS s16x8*)(cs + 16 * ks);
#pragma unroll
            for (int ti = 0; ti < 2; ++ti) {
                s16x8 qa[8];
#pragma unroll
                for (int ks = 0; ks < 8; ++ks) qa[ks] = *(const GAS s16x8*)(qbase + (size_t)(32 * ti + l31) * NPP + 16 * ks + 8 * hi);
#pragma unroll
                for (int ks = 0; ks < 8; ++ks) accC[ti] = MFMA32(qa[ks], cb[ks], accC[ti]);
            }
#pragma unroll
            for (int ks = 0; ks < 4; ++ks) { const s16x8 vb = *(const LAS s16x8*)(VT + (32 * w + l31) * TSTR + 16 * ks + 8 * hi);
#pragma unroll
                for (int ti = 0; ti < 2; ++ti) { const s16x8 pa = *(const LAS s16x8*)(Pm + (32 * ti + l31) * TSTR + 16 * ks + 8 * hi); accP[ti] = MFMA32(pa, vb, accP[ti]); } }
        }
        if (w == 0) {
            float rs = 0.f;
#pragma unroll
            for (int j = 0; j < 8; ++j) { const s16x8 pv = *(const LAS s16x8*)(Pm + lane * TSTR + 8 * j);
#pragma unroll
                for (int i = 0; i < 8; ++i) rs += bf2f((unsigned short)pv[i]); }
            const float dn = rs + inter[lane] * qn[lane];
            dinv[lane] = 1.f / fmaxf(fabsf(dn), emt[lane]);
        }
        __syncthreads();
#pragma unroll
        for (int ti = 0; ti < 2; ++ti)
#pragma unroll
            for (int r = 0; r < 16; ++r) { const int t = 32 * ti + crow32(r, hi); NUM[t * NUMSTR + 32 * w + l31] = (accP[ti][r] + inter[t] * SCALEQ * accC[ti][r]) * dinv[t]; }
        __syncthreads();
        {
            const f32x4 gn = *(const GAS f32x4*)(F.in[IN_MOUTN] + h * 256 + 4 * lane);
#pragma unroll
            for (int i = 0; i < 8; ++i) { const int t = 8 * w + i; const f32x4 x = *(const LAS f32x4*)(NUM + t * NUMSTR + 4 * lane);
                const float ss = wave_sum((x.x * x.x + x.y * x.y) + (x.z * x.z + x.w * x.w)); const float r = rsqrtf(ss * (1.f / 256.f) + 1e-6f);
                const u32x2 mo = *(const GAS u32x2*)(proj + (size_t)(t0 + t) * NPP + C_MO + h * 256 + 4 * lane);
                const float o0 = x.x * r * gn.x * sigmoid_f(bf2f((unsigned short)(mo.x & 0xffffu))), o1 = x.y * r * gn.y * sigmoid_f(bf2f((unsigned short)(mo.x >> 16)));
                const float o2 = x.z * r * gn.z * sigmoid_f(bf2f((unsigned short)(mo.y & 0xffffu))), o3 = x.w * r * gn.w * sigmoid_f(bf2f((unsigned short)(mo.y >> 16)));
                u32x2 ov; ov.x = pk2(o0, o1); ov.y = pk2(o2, o3);
                *(GAS u32x2*)(concat + (size_t)(t0 + t) * D + h * 256 + 4 * lane) = ov; }
        }
        __syncthreads();
    }
}
}
namespace mk {
__device__ __forceinline__ void attn_build_schedule(Frame& F) {
    LAS int* jl = (LAS int*)(F.lds + TAB_OFF); LAS int* pre = jl + 256; LAS int* wtot = pre + 260;
    const int tid = F.tid, lane = F.lane;
    if (tid < 256) { const int j = wsp<int>(F, WS_JLO)[tid]; jl[tid] = j; const int n = 4 * (tid & 31) + 4 - j; int v = (n + ATT_CH - 1) / ATT_CH;
        int inc = v;
#pragma unroll
        for (int o = 1; o < 64; o <<= 1) { const int t = __shfl_up(inc, o); if (lane >= o) inc += t; }
        pre[tid + 1] = inc; if (lane == 63) wtot[tid >> 6] = inc; }
    __syncthreads();
    if (tid < 256) { int add = 0; for (int w2 = 0; w2 < (tid >> 6); ++w2) add += wtot[w2]; pre[tid + 1] += add; if (tid == 0) pre[0] = 0; }
    __syncthreads();
}
__device__ __forceinline__ fox::BlockRef<fox::bf16, fox::bf16> fox_ref(const Frame& F, int I) {
    const LAS int* jl = (const LAS int*)(F.lds + TAB_OFF); const LAS int* pre = jl + 256;
    int b = 0;
#pragma unroll
    for (int st = 128; st >= 1; st >>= 1) if (pre[b + st] <= I) b += st;
    b = __builtin_amdgcn_readfirstlane(b);
    const int pb0 = __builtin_amdgcn_readfirstlane(pre[b]), pb1 = __builtin_amdgcn_readfirstlane(pre[b + 1]), j0 = __builtin_amdgcn_readfirstlane(jl[b]);
    const int h = b >> 5, qb = b & 31, part = I - pb0, P = pb1 - pb0, n = 4 * qb + 4 - j0;
    fox::BlockRef<fox::bf16, fox::bf16> r;
    const fox::bf16* proj = (const fox::bf16*)(F.ws + WS_PROJ);
    r.Q = proj + (size_t)(qb * 256) * fox::PITCH + C_FQ + h * 128; r.K = proj + C_FK + h * 128; r.V = proj + C_FV + h * 128;
    r.O = (fox::bf16*)(F.ws + WS_CONCAT) + (size_t)(qb * 256) * D + 1024 + h * 128; r.P0 = qb * 256;
    r.Fb = (const float*)(F.ws + WS_F) + h * S; r.gain = F.in[IN_FOUTN] + h * 128;
    r.jlo = j0 + (part * n) / P; r.jhi = j0 + ((part + 1) * n) / P;
    r.Op = P > 1 ? (float*)(F.ws + WS_OPART) + (size_t)I * 256 * 128 : nullptr; r.ML = (float*)(F.ws + WS_MLP) + (size_t)I * 512;
    return r;
}
__device__ __forceinline__ void p5_attention(Frame& F, char* ldsg) {
    typedef fox::BlockRef<fox::bf16, fox::bf16> BR;
    attn_build_schedule(F);
    const int total = __builtin_amdgcn_readfirstlane(((const LAS int*)(F.lds + TAB_OFF))[256 + 256]);
    int L = F.vcu; if (L >= total) return;
    BR cur = fox_ref(F, L);
    fox::Seam<fox::bf16> Sm;
    fox::causal_swa_prime<fox::bf16, fox::bf16>(cur, S, ldsg, Sm);
    for (;;) {
        const bool more = L + F.G < total;
        const BR nxt = more ? fox_ref(F, L + F.G) : cur;
        fox::causal_swa_block<fox::bf16, fox::bf16>(cur, nxt, S, S, ldsg, Sm);
        if (!more) break;
        cur = nxt; L += F.G;
    }
}
__device__ __forceinline__ void p6_combine(Frame& F) {
    attn_build_schedule(F);
    const LAS int* pre = (const LAS int*)(F.lds + TAB_OFF) + 256;
    const float* OP = wsp<float>(F, WS_OPART); const float* MLP = wsp<float>(F, WS_MLP); bf16* concat = wsp<bf16>(F, WS_CONCAT);
    const int gw = F.vcu * NWAVES + F.wave, NGW = F.G * NWAVES, lane = F.lane;
    constexpr float C2 = 1.4426950408889634f * SCALEQ;
    for (int idx = gw; idx < 256 * 256; idx += NGW) {
        const int b = idx >> 8, r = idx & 255, i0 = __builtin_amdgcn_readfirstlane(pre[b]), P = __builtin_amdgcn_readfirstlane(pre[b + 1]) - i0; if (P <= 1) continue;
        const int h = b >> 5, qb = b & 31;
        f32x2 ml[8], ov[8];
#pragma unroll
        for (int p2 = 0; p2 < 8; ++p2) if (p2 < P) { ml[p2] = *(const GAS f32x2*)(MLP + (size_t)(i0 + p2) * 512 + 2 * r); ov[p2] = *(const GAS f32x2*)(OP + ((size_t)(i0 + p2) * 256 + r) * 128 + 2 * lane); }
        float ms = -3.0e38f;
#pragma unroll
        for (int p2 = 0; p2 < 8; ++p2) if (p2 < P) ms = fmaxf(ms, ml[p2].x);
        float n0 = 0.f, n1 = 0.f, den = 0.f;
#pragma unroll
        for (int p2 = 0; p2 < 8; ++p2) if (p2 < P) { const float wgt = __builtin_amdgcn_exp2f((ml[p2].x - ms) * C2); n0 += wgt * ov[p2].x; n1 += wgt * ov[p2].y; den += wgt * ml[p2].y; }
        const float inv = 1.f / den, v0 = n0 * inv, v1 = n1 * inv;
        const float ss = wave_sum(v0 * v0 + v1 * v1), rn = rsqrtf(ss * (1.f / 128.f) + 1e-6f);
        const f32x2 gn = *(const GAS f32x2*)(F.in[IN_FOUTN] + h * 128 + 2 * lane);
        *(GAS unsigned*)(concat + (size_t)(qb * 256 + r) * D + 1024 + h * 128 + 2 * lane) = pk2(v0 * rn * gn.x, v1 * rn * gn.y);
    }
}
constexpr int RROWS = 8, NITER = S / RROWS;
__device__ __forceinline__ void p7_router(Frame& F) {
    LAS float* shs = (LAS float*)(F.lds + RING_OFF);
    constexpr int HSTR = 2064;
    LAS bf16* H2hi = (LAS bf16*)(shs + 2 * D);
    LAS bf16* H2lo = H2hi + RROWS * HSTR;
    LAS float* red = (LAS float*)(H2lo + RROWS * HSTR);
    LAS int* selE = (LAS int*)(red + 8 * RROWS * NE);
    const float* mod = wsp<float>(F, WS_MOD); const float* h1 = wsp<float>(F, WS_H1); unsigned char* h2 = wsp<unsigned char>(F, WS_HN);
    int* top_i = wsp<int>(F, WS_TOPI); float* top_w = wsp<float>(F, WS_TOPW); int* hist = wsp<int>(F, WS_HIST); int* lrank = wsp<int>(F, WS_LRANK);
    const int tid = F.tid, lane = F.lane, w = F.wave;
    for (int i = tid; i < 2 * D; i += NTHR) shs[i] = mod[3 * D + i];
    __syncthreads();
    s16x8 whi[16], wlo[16];
    { const int hh = lane >> 5; const float* wp = F.in[IN_WR] + (size_t)(256 * w + 8 * hh) * NE + (lane & 31);
#pragma unroll
        for (int ks = 0; ks < 16; ++ks) { float wv[8];
#pragma unroll
            for (int j = 0; j < 8; ++j) wv[j] = wp[(size_t)(16 * ks + j) * NE];
            unsigned hw[4], lw[4];
#pragma unroll
            for (int j = 0; j < 4; ++j) { const unsigned a = f2bf(wv[2 * j]), b = f2bf(wv[2 * j + 1]); hw[j] = a | (b << 16); lw[j] = pk2(wv[2 * j] - bf2f((unsigned short)a), wv[2 * j + 1] - bf2f((unsigned short)b)); }
            const v4u hv4 = {hw[0], hw[1], hw[2], hw[3]}, lv4 = {lw[0], lw[1], lw[2], lw[3]};
            whi[ks] = __builtin_bit_cast(s16x8, hv4); wlo[ks] = __builtin_bit_cast(s16x8, lv4); } }
    for (int it = F.vcu; it < NITER; it += F.G) {
        const int r0 = it * RROWS;
        {
            const int m = r0 + w; const GAS f32x4* xr = (const GAS f32x4*)(h1 + (size_t)m * D) + lane; f32x4 v[8]; float s2 = 0.f;
#pragma unroll
            for (int j = 0; j < 8; ++j) { v[j] = xr[64 * j]; s2 += (v[j].x * v[j].x + v[j].y * v[j].y) + (v[j].z * v[j].z + v[j].w * v[j].w); }
            const float r = rsqrtf(wave_sum(s2) * (1.f / D) + 1e-6f);
            GAS unsigned* o8 = (GAS unsigned*)(h2 + (size_t)m * D) + lane;
#pragma unroll
            for (int j = 0; j < 8; ++j) { const int c0 = 4 * lane + 256 * j; const f32x4 gg = *(const GAS f32x4*)(F.in[IN_NFFN] + c0); const f32x4 a = *(const LAS f32x4*)(shs + D + c0), b = *(const LAS f32x4*)(shs + c0);
                const f32x4 y = v[j] * r * gg * (a + 1.f) + b; o8[64 * j] = pk4_fp8(y.x, y.y, y.z, y.w);
                const unsigned h0 = pk2(y.x, y.y), h1w = pk2(y.z, y.w); u32x2 hv; hv.x = h0; hv.y = h1w;
                u32x2 lv; lv.x = pk2(y.x - bf2f((unsigned short)(h0 & 0xffffu)), y.y - bf2f((unsigned short)(h0 >> 16))); lv.y = pk2(y.z - bf2f((unsigned short)(h1w & 0xffffu)), y.w - bf2f((unsigned short)(h1w >> 16)));
                *(LAS u32x2*)(H2hi + w * HSTR + c0) = hv; *(LAS u32x2*)(H2lo + w * HSTR + c0) = lv; }
        }
        __syncthreads();
        {
            f32x16 acc;
#pragma unroll
            for (int r = 0; r < 16; ++r) acc[r] = 0.f;
            const int hh = lane >> 5; const LAS bf16* bh = H2hi + (lane & 7) * HSTR + 256 * w + 8 * hh; const LAS bf16* bl = H2lo + (lane & 7) * HSTR + 256 * w + 8 * hh;
#pragma unroll
            for (int ks = 0; ks < 16; ++ks) { const s16x8 xh = *(const LAS s16x8*)(bh + 16 * ks), xl = *(const LAS s16x8*)(bl + 16 * ks);
                acc = MFMA32(whi[ks], xh, acc); acc = MFMA32(whi[ks], xl, acc); acc = MFMA32(wlo[ks], xh, acc); }
            if ((lane & 31) < RROWS) {
#pragma unroll
                for (int r = 0; r < 16; ++r) red[(w * RROWS + (lane & 31)) * NE + crow32(r, hh)] = acc[r]; }
        }
        __syncthreads();
        if (tid < RROWS * NE) {
            const int r = tid >> 5, e = tid & 31; float lg = F.in[IN_BR][e];
#pragma unroll
            for (int kp = 0; kp < 8; ++kp) lg += red[(kp * RROWS + r) * NE + e];
            float cur = lg, mx = 0.f, sum = 0.f, mysel = 0.f; int myidx = 0;
#pragma unroll
            for (int q = 0; q < 4; ++q) { float best = cur; int bi = e;
#pragma unroll
                for (int o = 1; o < 32; o <<= 1) { const float ob = __shfl_xor(best, o); const int oi = __shfl_xor(bi, o); if (ob > best || (ob == best && oi < bi)) { best = ob; bi = oi; } }
                if (q == 0) mx = best;
                sum += __expf(best - mx);
                if (e == q) { mysel = best; myidx = bi; }
                if (e == bi) cur = -3.0e38f; }
            if (e < 4) { const int t = r0 + r; top_i[t * 4 + e] = myidx; top_w[t * 4 + e] = __expf(mysel - mx) / sum; selE[r * 4 + e] = myidx; }
        }
        __syncthreads();
        if (tid < 32) { const int me = selE[tid]; int rank = 0, cnt = 0;
#pragma unroll
            for (int p = 0; p < 32; ++p) { const int ep = selE[p]; rank += (ep == me && p < tid) ? 1 : 0; cnt += (ep == tid) ? 1 : 0; }
            lrank[it * 32 + tid] = rank; hist[it * NE + tid] = cnt; }
        __syncthreads();
    }
}
__device__ __forceinline__ void build_expert_table(Frame& F, const int* counts_g) {
    LAS int* tab = (LAS int*)(F.lds + TAB_OFF);
    if (F.tid < 64) {
        const int lane = F.tid, c = lane < NE ? counts_g[lane] : 0, nt = (c + 255) >> 8; int inc = nt;
#pragma unroll
        for (int o = 1; o < 64; o <<= 1) { const int t = __shfl_up(inc, o); if (lane >= o) inc += t; }
        if (lane < NE) { tab[lane] = inc - nt; tab[40 + lane] = c; }
        if (lane == NE - 1) tab[32] = inc; }
    __syncthreads();
}
__device__ __forceinline__ void p8_gather(Frame& F) {
    LAS unsigned short* loc = (LAS unsigned short*)(F.lds + RING_OFF);
    LAS int* psum = (LAS int*)(F.lds + RING_OFF + 65536);
    LAS int* startr = psum + 16 * NE;
    const int* hist = wsp<int>(F, WS_HIST); const int* lrank = wsp<int>(F, WS_LRANK); const int* top_i = wsp<int>(F, WS_TOPI); const float* top_w = wsp<float>(F, WS_TOPW);
    int* pos = wsp<int>(F, WS_POS); float* roww = wsp<float>(F, WS_ROWW); const unsigned char* h2 = wsp<unsigned char>(F, WS_HN); unsigned char* xg = wsp<unsigned char>(F, WS_XG);
    int* counts_g = (int*)(F.ws + WS_POS) + S * 4;
    const int tid = F.tid, lane = F.lane, w = F.wave;
    { const int e = tid & 31, part = tid >> 5; int hv[64];
#pragma unroll
        for (int i = 0; i < 64; ++i) hv[i] = hist[(part * 64 + i) * NE + e];
        int s = 0;
#pragma unroll
        for (int i = 0; i < 64; ++i) { loc[(part * 64 + i) * NE + e] = (unsigned short)s; s += hv[i]; }
        psum[part * NE + e] = s; }
    __syncthreads();
    if (tid < 64) { int tot = 0;
        if (tid < NE) {
#pragma unroll
            for (int p = 0; p < 16; ++p) { const int v = psum[p * NE + tid]; psum[p * NE + tid] = tot; tot += v; } }
        const int padded = ((tot + 255) >> 8) << 8; int inc = padded;
#pragma unroll
        for (int o = 1; o < 64; o <<= 1) { const int t = __shfl_up(inc, o); if (lane >= o) inc += t; }
        if (tid < NE) { startr[tid] = inc - padded; if (blockIdx.x == 0) counts_g[tid] = tot; } }
    __syncthreads();
    for (int itb = F.vcu; itb < NITER; itb += 4 * F.G) {
        const int pi = 16 * w + (lane & 15), it = itb + (pi >> 5) * F.G; const bool valid = it < NITER;
        int dest = 0, tok = 0;
        if (valid) { const int pair = it * 32 + (pi & 31), e = top_i[pair]; dest = startr[e] + psum[(it >> 6) * NE + e] + (int)loc[it * NE + e] + lrank[pair]; tok = pair >> 2;
            if (lane < 16) { pos[pair] = dest; roww[dest] = top_w[pair]; } }
        v4u buf[16][2];
#pragma unroll
        for (int j = 0; j < 16; ++j) { const int tj = __builtin_amdgcn_readlane(tok, j); const GAS v4u* src = (const GAS v4u*)(h2 + (size_t)tj * D) + lane; buf[j][0] = src[0]; buf[j][1] = src[64]; }
#pragma unroll
        for (int j = 0; j < 16; ++j) { const int dj = __builtin_amdgcn_readlane(dest, j); const bool vj = __builtin_amdgcn_readlane((int)valid, j) != 0;
            if (vj) { GAS v4u* dst = (GAS v4u*)(xg + (size_t)dj * D) + lane; dst[0] = buf[j][0]; dst[64] = buf[j][1]; } }
    }
}
struct GroupedOrder {
    const LAS int* tab; int ntn, G, c;
    __device__ __forceinline__ bool next(int i, Unit& u) const {
        const int L = i * G + c, total = tab[32] * ntn; if (L >= total) return false;
        int e = (u.e > 0 && u.e < NE && tab[u.e] * ntn <= L) ? u.e : 0;
#pragma unroll 1
        while (e < NE - 1 && tab[e + 1] * ntn <= L) ++e;
        const int ts = tab[e], tc = tab[e + 1] - ts, within = L - ts * ntn;
        u.pm = ts + within % tc; u.pn = within / tc; u.e = e; u.pb = e * ntn + u.pn; return true;
    }
    __device__ __forceinline__ void a_ready(const Unit&) const {}
    __device__ __forceinline__ void done(const Unit&) const {}
};
struct EpiSwiglu {
    static constexpr bool PERM = true, AFTER_DRAIN = false;
    unsigned char* act; const float* bug;
    __device__ __forceinline__ void operator()(const pg8::f32x4 (&acc)[2][2][4][2], const Unit& u, int wr, int wc, int fr, int fq) const {
        const int row0 = u.pm * 256 + wr * 64 + fr, f0 = u.pn * 128 + wc * 32 + 8 * fq;
        const float* bg = bug + (size_t)u.e * 4096 + f0; pg8::f32x4 bgv[2], buv[2];
#pragma unroll
        for (int n = 0; n < 2; ++n) { bgv[n] = *(const pg8::f32x4*)(bg + 4 * n); buv[n] = *(const pg8::f32x4*)(bg + 2048 + 4 * n); }
#pragma unroll
        for (int ai = 0; ai < 2; ++ai)
#pragma unroll
            for (int m = 0; m < 4; ++m) { float o[8];
#pragma unroll
                for (int n = 0; n < 2; ++n)
#pragma unroll
                    for (int i = 0; i < 4; ++i) { const float g = fminf(acc[ai][0][m][n][i] + bgv[n][i], 7.f); const float up = fminf(fmaxf(acc[ai][1][m][n][i] + buv[n][i], -7.f), 7.f);
                        o[4 * n + i] = (up + 1.f) * g * __builtin_amdgcn_rcpf(1.f + __builtin_amdgcn_exp2f(-2.45546696f * g)); }
                u32x2 wv; wv.x = pk4_fp8(o[0], o[1], o[2], o[3]); wv.y = pk4_fp8(o[4], o[5], o[6], o[7]);
                *(u32x2*)(act + (size_t)(row0 + ai * 128 + m * 16) * FF + f0) = wv; }
    }
};
struct EpiDown {
    static constexpr bool PERM = true, AFTER_DRAIN = false;
    bf16* y; const float* bd; const float* roww;
    __device__ __forceinline__ void operator()(const pg8::f32x4 (&acc)[2][2][4][2], const Unit& u, int wr, int wc, int fr, int fq) const {
        const int row0 = u.pm * 256 + wr * 64 + fr, col0 = u.pn * 256 + wc * 32 + 8 * fq;
        pg8::f32x4 bv[2][2];
#pragma unroll
        for (int bj = 0; bj < 2; ++bj)
#pragma unroll
            for (int n = 0; n < 2; ++n) bv[bj][n] = *(const pg8::f32x4*)(bd + (size_t)u.e * D + col0 + bj * 128 + 4 * n);
#pragma unroll
        for (int ai = 0; ai < 2; ++ai)
#pragma unroll
            for (int m = 0; m < 4; ++m) { const int row = row0 + ai * 128 + m * 16; const float rw = roww[row]; bf16* rowp = y + (size_t)row * D + col0;
#pragma unroll
                for (int bj = 0; bj < 2; ++bj) { const pg8::f32x4 v0 = (acc[ai][bj][m][0] + bv[bj][0]) * rw, v1 = (acc[ai][bj][m][1] + bv[bj][1]) * rw;
                    pg8::u32x4 wv; wv.x = cvt_pk_bf16(v0[0], v0[1]); wv.y = cvt_pk_bf16(v0[2], v0[3]); wv.z = cvt_pk_bf16(v1[0], v1[1]); wv.w = cvt_pk_bf16(v1[2], v1[3]);
                    *(pg8::u32x4*)(rowp + bj * 128) = wv; } }
    }
};
__device__ __forceinline__ void p11_final(Frame& F, float oscale) {
    LAS float* ms = (LAS float*)(F.lds + RING_OFF);
    const float* mod = wsp<float>(F, WS_MOD);
    for (int i = F.tid; i < 3 * D; i += NTHR) ms[i] = mod[5 * D + i];
    __syncthreads();
    const float* h1 = wsp<float>(F, WS_H1); const bf16* y = wsp<bf16>(F, WS_Y); const int* pos = wsp<int>(F, WS_POS);
    const int gw = F.vcu * NWAVES + F.wave, NGW = F.G * NWAVES, lane = F.lane;
    for (int t = gw; t < S; t += NGW) {
        asm volatile("" ::: "memory");
        const GAS f32x4* xr = (const GAS f32x4*)(h1 + (size_t)t * D) + lane;
        const GAS u32x2* y0 = (const GAS u32x2*)(y + (size_t)pos[t * 4 + 0] * D) + lane; const GAS u32x2* y1 = (const GAS u32x2*)(y + (size_t)pos[t * 4 + 1] * D) + lane;
        const GAS u32x2* y2 = (const GAS u32x2*)(y + (size_t)pos[t * 4 + 2] * D) + lane; const GAS u32x2* y3 = (const GAS u32x2*)(y + (size_t)pos[t * 4 + 3] * D) + lane;
        f32x4 v[8]; float s2 = 0.f;
#pragma unroll
        for (int j = 0; j < 8; ++j) { const u32x2 a = y0[64 * j], b = y1[64 * j], c = y2[64 * j], d = y3[64 * j]; const f32x4 g2 = *(const LAS f32x4*)(ms + 4 * lane + 256 * j);
            f32x4 f;
            f.x = (bf2f((unsigned short)(a.x & 0xffffu)) + bf2f((unsigned short)(b.x & 0xffffu))) + (bf2f((unsigned short)(c.x & 0xffffu)) + bf2f((unsigned short)(d.x & 0xffffu)));
            f.y = (bf2f((unsigned short)(a.x >> 16)) + bf2f((unsigned short)(b.x >> 16))) + (bf2f((unsigned short)(c.x >> 16)) + bf2f((unsigned short)(d.x >> 16)));
            f.z = (bf2f((unsigned short)(a.y & 0xffffu)) + bf2f((unsigned short)(b.y & 0xffffu))) + (bf2f((unsigned short)(c.y & 0xffffu)) + bf2f((unsigned short)(d.y & 0xffffu)));
            f.w = (bf2f((unsigned short)(a.y >> 16)) + bf2f((unsigned short)(b.y >> 16))) + (bf2f((unsigned short)(c.y >> 16)) + bf2f((unsigned short)(d.y >> 16)));
            v[j] = xr[64 * j] + g2 * f; s2 += (v[j].x * v[j].x + v[j].y * v[j].y) + (v[j].z * v[j].z + v[j].w * v[j].w); }
        const float r = rsqrtf(wave_sum(s2) * (1.f / D) + 1e-6f);
        GAS f32x4* o = (GAS f32x4*)(F.out + (size_t)t * D) + lane;
#pragma unroll
        for (int j = 0; j < 8; ++j) { const int c0 = 4 * lane + 256 * j; const f32x4 gg = *(const GAS f32x4*)(F.in[IN_NFIN] + c0); const f32x4 sh = *(const LAS f32x4*)(ms + D + c0), sc = *(const LAS f32x4*)(ms + 2 * D + c0);
            o[64 * j] = (v[j] * r * gg * (sc + 1.f) + sh) * oscale; }
    }
}
}
namespace mk {
struct Args { const float* in[24]; float* out; unsigned char* ws; int ph_lo, ph_hi, li, pad; };
constexpr int N_PHASES = 13;
__global__ void __launch_bounds__(NTHR, 2) mega_fwd(Args args) {
    extern __shared__ __attribute__((aligned(16))) unsigned char lds[];
    Frame F;
    F.lds = (LAS unsigned char*)lds;
    F.MISC = (volatile LAS unsigned*)(F.lds + MISC_OFF);
    F.tid = threadIdx.x; F.lane = F.tid & 63; F.wave = __builtin_amdgcn_readfirstlane(F.tid >> 6);
    leave_group(F);
    F.ws = args.ws; F.out = args.out; F.ctl = (gu32*)(args.ws + WS_CTL);
#pragma unroll
    for (int i = 0; i < 24; ++i) F.in[i] = args.in[i];
    for (int u = F.tid; u < (LDS_BYTES - LDSCTL_OFF) / 4; u += NTHR) ((LAS unsigned*)(F.lds + LDSCTL_OFF))[u] = 0u;
    __syncthreads();
    XcdBarrier bar = xcd_barrier_post((unsigned*)(F.ctl + CW_BAR) + args.li * XCD_BAR_WORDS, F.MISC + 8);
    const int lo = args.ph_lo, hi = args.ph_hi;
#define IN(k) (lo <= (k) && (k) < hi)
#define SEAM(k) do { if (IN(k) && IN((k) + 1)) xcd_barrier(bar); } while (0)

#ifndef MK_DOUBLE
#define MK_DOUBLE 0
#endif
#define DBL(k) ((MK_DOUBLE >> (k)) & 1)
#ifdef MK_PROBE_LO
    unsigned long long* stamps = (unsigned long long*)(F.ctl + 131072);
#define STAMP(k) do { if (blockIdx.x == 0 && F.tid == 0) stamps[k] = rt(); } while (0)
#define PROBE_SCALE() (1.f + sqrtf((float)(stamps[MK_PROBE_HI] - stamps[MK_PROBE_LO]) * 0.01f * 2e-5f))
#else
#define STAMP(k) do { } while (0)
#define PROBE_SCALE() 1.f
#endif
    STAMP(0); if (IN(0)) { p0_gemv(F); } SEAM(0);
    STAMP(1); if (IN(1)) { p1_modulate(F); if (DBL(1)) p1_modulate(F); } SEAM(1);
    STAMP(2); if (IN(2)) {
        gu32* done = F.ctl + CW_DONE + 64 * 2;
        if (enter_group(F, GC_INPROJ)) {
            pg8::Gemm g{wsp<pg8::bf16_t>(F, WS_HN), wsp<pg8::bf16_t>(F, WS_WIN), S, NPP, D}; pg8::StaticOrder So; So.init(S, NPP, F.G, F.bid);
            EpiProj E{wsp<bf16>(F, WS_PROJ)};
            pg8::gemm_phase<EpiProj, pg8::StaticOrder, true, true>(F.lds + RING_OFF, g, So, E);
            if (DBL(2)) pg8::gemm_phase<EpiProj, pg8::StaticOrder, true, true>(F.lds + RING_OFF, g, So, E);
            __syncthreads();
            if (F.tid == 0) __hip_atomic_fetch_add(done, 1u, RLX_AGENT);
        }
        const unsigned tgt = (unsigned)F.G; leave_group(F);
        if (F.G == 256 && (blockIdx.x >> 3) == 31) p_fscan(F, (int)(blockIdx.x & 7));
        conv_worker(F, done, F.G == 256 ? (unsigned)GC_INPROJ : tgt, 0);
        __syncthreads();
    } SEAM(2);
#define GROUPED(k, Gc, body) do { gu32* done_ = F.ctl + CW_DONE + 64 * (k); if (enter_group(F, (Gc))) { body; __syncthreads(); if (F.tid == 0) __hip_atomic_fetch_add(done_, 1u, RLX_AGENT); } \
        const unsigned tgt_ = (unsigned)F.G; leave_group(F); conv_worker(F, done_, F.G == 256 ? (unsigned)(Gc) : tgt_, 0); __syncthreads(); } while (0)
    STAMP(3); if (IN(3)) { p3_prep(F); } SEAM(3);
    STAMP(4); if (IN(4)) { p4_scan(F); if (DBL(4)) p4_scan(F); } SEAM(4);
    STAMP(5); if (IN(5)) {
        gu32* done = F.ctl + CW_DONE + 64 * 5;
        p5_mlstm_out(F);
        if (enter_group(F, GC_ATTN)) {
            p5_attention(F, (char*)lds);
            __syncthreads();
            if (F.tid == 0) __hip_atomic_fetch_add(done, 1u, RLX_AGENT);
        }
        const unsigned tgt = (unsigned)F.G; leave_group(F);
        conv_worker(F, done, F.G == 256 ? (unsigned)GC_ATTN : tgt, 0);
        __syncthreads();
    } SEAM(5);
    STAMP(6); if (IN(6)) { p6_combine(F); } SEAM(6);
    STAMP(7); if (IN(7)) {
        pg8::Gemm g{wsp<pg8::bf16_t>(F, WS_CONCAT), wsp<pg8::bf16_t>(F, WS_WOUT), S, D, D}; pg8::StaticOrder So; So.init(S, D, F.G, F.bid);
        EpiOut E{F.in[IN_X], wsp<float>(F, WS_MOD) + 2 * D, wsp<float>(F, WS_H1)};
        pg8::gemm_phase<EpiOut, pg8::StaticOrder, false, true>(F.lds + RING_OFF, g, So, E);
        if (DBL(7)) pg8::gemm_phase<EpiOut, pg8::StaticOrder, false, true>(F.lds + RING_OFF, g, So, E);
    } SEAM(7);
    STAMP(8); if (IN(8)) { p7_router(F); if (DBL(8)) p7_router(F); } SEAM(8);
    STAMP(9); if (IN(9)) { p8_gather(F); if (DBL(9)) p8_gather(F); __syncthreads(); conv_worker(F, nullptr, 0u, 1); __syncthreads(); } SEAM(9);
    STAMP(10); if (IN(10)) {
        build_expert_table(F, (const int*)(F.ws + WS_POS) + S * 4);
        gu32* done = F.ctl + CW_DONE + 64 * 10;
        const int units = ((const LAS int*)(F.lds + TAB_OFF))[32] * 16, rounds = (units + 255) >> 8; int gc = rounds > 0 ? (((units + rounds - 1) / rounds + 7) >> 3) << 3 : 256; gc = gc > 256 ? 256 : gc;
        gc = __builtin_amdgcn_readfirstlane(gc);
        if (enter_group(F, gc)) {
            pg8::Gemm g{wsp<pg8::bf16_t>(F, WS_XG), wsp<pg8::bf16_t>(F, WS_WUG), MAXROWS, 4096, D / 2}; GroupedOrder So{(const LAS int*)(F.lds + TAB_OFF), 16, F.G, F.bid};
            EpiSwiglu E{wsp<unsigned char>(F, WS_ACT), F.in[IN_BUG]};
            pg8::gemm_phase8<EpiSwiglu, GroupedOrder, true, true>(F.lds + RING_OFF, g, So, E);
            __syncthreads();
            if (F.tid == 0) __hip_atomic_fetch_add(done, 1u, RLX_AGENT);
        }
        leave_group(F);
        __syncthreads(); conv_worker(F, nullptr, 0u, 2); __syncthreads();
    } SEAM(10);
    STAMP(11); if (IN(11)) {
        build_expert_table(F, (const int*)(F.ws + WS_POS) + S * 4);
        pg8::Gemm g{wsp<pg8::bf16_t>(F, WS_ACT), wsp<pg8::bf16_t>(F, WS_WD), MAXROWS, D, FF / 2}; GroupedOrder So{(const LAS int*)(F.lds + TAB_OFF), 8, F.G, F.bid};
        EpiDown E{wsp<bf16>(F, WS_Y), F.in[IN_BD], wsp<float>(F, WS_ROWW)};
        pg8::gemm_phase8<EpiDown, GroupedOrder, true, true>(F.lds + RING_OFF, g, So, E);
        if (DBL(11)) pg8::gemm_phase8<EpiDown, GroupedOrder, true, true>(F.lds + RING_OFF, g, So, E);
    } SEAM(11);
    STAMP(12); if (IN(12)) { p11_final(F, PROBE_SCALE()); if (DBL(12)) p11_final(F, PROBE_SCALE()); }
#undef IN
#undef SEAM
}
}
#ifndef MK_DEBUG
#define MK_DEBUG 0
#endif
#ifndef MK_PH_END
#define MK_PH_END mk::N_PHASES
#endif
#ifndef MK_SPLIT
#define MK_SPLIT 0
#endif
extern "C" void kernel_launch(void* const* d_in, const int* in_sizes, int n_in, void* d_out, int out_size, void* d_ws, size_t ws_size, hipStream_t stream) {
    using namespace mk;
    static int grid = 0;
    if (grid == 0) {
        int dev = 0, cus = 0, per_cu = 0;
        if (hipGetDevice(&dev) != hipSuccess || hipDeviceGetAttribute(&cus, hipDeviceAttributeMultiprocessorCount, dev) != hipSuccess) { fprintf(stderr, "kernel_launch: device query failed\n"); grid = -1; return; }
        if (hipFuncSetAttribute((const void*)mega_fwd, hipFuncAttributeMaxDynamicSharedMemorySize, LDS_BYTES) != hipSuccess) { fprintf(stderr, "kernel_launch: hipFuncSetAttribute failed\n"); grid = -1; return; }
        if (hipOccupancyMaxActiveBlocksPerMultiprocessor(&per_cu, (const void*)mega_fwd, NTHR, LDS_BYTES) != hipSuccess || per_cu < 1) fprintf(stderr, "kernel_launch: occupancy query reports %d\n", per_cu);
        (void)hipGetLastError();
        grid = cus;
        if (n_in != 24 || out_size != S * D || ws_size < (MK_DEBUG ? WS_NAIVE + (size_t)2300 * MiB : WS_END)) fprintf(stderr, "kernel_launch: unexpected sizes n_in %d out %d ws %zu\n", n_in, out_size, ws_size);
    }
    if (grid < 0) return;
    (void)hipMemsetAsync((char*)d_ws + WS_CTL, 0, CTL_ZERO_BYTES, stream);
    Args a{};
    for (int i = 0; i < 24; ++i) a.in[i] = (const float*)d_in[i];
    a.out = (float*)d_out; a.ws = (unsigned char*)d_ws;
#if MK_DEBUG
    nv::naive_forward(d_in, (float*)d_out, (char*)d_ws + WS_NAIVE, stream);
#endif
#if MK_SPLIT
    for (int p = 0; p < MK_PH_END; ++p) { a.ph_lo = p; a.ph_hi = p + 1; a.li = p; hipLaunchKernelGGL(mega_fwd, dim3(grid), dim3(NTHR), LDS_BYTES, stream, a); }
#else
    a.ph_lo = 0; a.ph_hi = MK_PH_END; a.li = 0;
    hipLaunchKernelGGL(mega_fwd, dim3(grid), dim3(NTHR), LDS_BYTES, stream, a);
#endif
#ifdef MK_EXTRA_LO
    a.ph_lo = MK_EXTRA_LO; a.ph_hi = MK_EXTRA_HI; a.li = 1;
    hipLaunchKernelGGL(mega_fwd, dim3(grid), dim3(NTHR), LDS_BYTES, stream, a);
#endif
    { const hipError_t le = hipPeekAtLastError(); if (le != hipSuccess) fprintf(stderr, "kernel_launch: launch failed: %s\n", hipGetErrorName(le)); }
#if MK_DEBUG
    {
        nv::NaiveWs w = nv::carve((char*)d_ws + WS_NAIVE);
        double* slots = (double*)((char*)d_ws + WS_CTL + 512 * 1024);
        unsigned char* ws = (unsigned char*)d_ws; int nc = 0;
        MK_DEBUG_CHECKS
        dbg::k_finish<<<1024, 256, 0, stream>>>((float*)d_out, (size_t)S * D, slots, nc, 1e-3);
    }
#endif
}
```

```cpp
#include <hip/hip_runtime.h>
#include <hip/hip_bf16.h>
#include <cstdio>
#include <cstdint>
namespace pg8 {
#define PG8_LAS __attribute__((address_space(3)))
typedef unsigned short bf16_t;
typedef short bf16x8 __attribute__((ext_vector_type(8)));
typedef float f32x4 __attribute__((ext_vector_type(4)));
typedef unsigned u32x4 __attribute__((ext_vector_type(4)));
constexpr int BM = 256, BK = 64, HALF = 128, HTB = HALF * BK * 2  , STAGE_BYTES = 8 * HTB, NXCD = 8, WGM = 8;

__host__ __device__ __forceinline__ int lds_byte(int r, int c) { const int st = (r >> 4) * 2 + (c >> 5), rr = r & 15, cc = c & 31, ob = rr * 64 + cc * 2; return st * 1024 + (ob ^ (((ob >> 9) & 1) << 5)); }
__host__ __device__ __forceinline__ void stage_rc(int b, int& R, int& C) { const int st = b / 1024, sb = b % 1024, swz = sb ^ (((sb >> 9) & 1) << 5); R = (st >> 1) * 16 + swz / 64; C = (st & 1) * 32 + (swz % 64) / 2; }
__host__ __device__ __forceinline__ int perm32(int rho) { const int n = rho >> 4, i = rho & 15; return 8 * (i >> 2) + 4 * n + (i & 3); }

struct Unit { int pm, pn, pb, e; };
struct Gemm { const bf16_t* A; const bf16_t* Bt; int M, N, K; };

struct StaticOrder {
    int nM, nN, nwg, G, c;
    __host__ __device__ void init(int M, int N, int G_, int c_) { nM = M / BM; nN = N / BM; nwg = nM * nN; G = G_; c = c_; }
    __host__ __device__ bool next(int i, Unit& u) const {
        const long L = (long)i * G + c; if (L >= nwg) return false;
        int wgid = (int)L; { const int q = nwg / NXCD, r = nwg % NXCD, xcd = wgid % NXCD, off = wgid / NXCD; wgid = (xcd < r ? xcd * (q + 1) : r * (q + 1) + (xcd - r) * q) + off; }
        const int nig = WGM * nN, gid = wgid / nig, fm = gid * WGM, gsz = (nM - fm) < WGM ? (nM - fm) : WGM;
        u.pm = fm + ((wgid % nig) % gsz); u.pn = (wgid % nig) / gsz; u.pb = u.pn; u.e = 0; return true;
    }
    __device__ __forceinline__ void a_ready(const Unit&) const {}
    __device__ __forceinline__ void done(const Unit&) const {}
};

__device__ __forceinline__ unsigned cvt_pk_bf16(float lo, float hi) { unsigned r; asm volatile("v_cvt_pk_bf16_f32 %0, %1, %2" : "=v"(r) : "v"(lo), "v"(hi)); return r; }
template <class Epi, class Sched, bool ALIGN_EPI = false, bool SP2 = false>
__device__ __forceinline__ void gemm_phase(PG8_LAS unsigned char* lds, const Gemm g, const Sched& S, const Epi& E) {
    const int tid = threadIdx.x, wid = __builtin_amdgcn_readfirstlane(tid >> 6), lane = tid & 63, wr = wid >> 2, wc = wid & 3, fr = lane & 15, fq = lane >> 4;
    const int K = g.K, nt = K / BK;
    unsigned voffA[2], voffB[2];
#pragma unroll
    for (int i = 0; i < 2; ++i) { int R, C; stage_rc(tid * 16 + i * 8192, R, C); const int Rb = Epi::PERM ? ((R & ~31) + perm32(R & 31)) : R;
        voffA[i] = (unsigned)(R * K + C) * 2u; voffB[i] = (unsigned)(Rb * K + C) * 2u; }
    const size_t kstep = (size_t)(BK * 2);
    const size_t hstep = (size_t)HALF * K * 2;
    const size_t tstep = 2 * hstep;
    const unsigned ldsw = (unsigned)wid * 1024u;
    const int aoff = lds_byte(wr * 64 + fr, fq * 8), boff = lds_byte(wc * 32 + fr, fq * 8);
#define PG8_SA(b, h) (((b) * 2 + (h)) * HTB)
#define PG8_SB(b, h) ((4 + (b) * 2 + (h)) * HTB)
#define PG8_STAGE(bufoff, gbase, voff) do { _Pragma("unroll") for (int _i = 0; _i < 2; ++_i) \
        __builtin_amdgcn_global_load_lds((const unsigned*)((const char*)(gbase) + (voff)[_i]), (PG8_LAS unsigned*)(lds + (bufoff) + ldsw + _i * 8192), 16, 0, 0); } while (0)
#define PG8_LDA(dst, b, h) do { _Pragma("unroll") for (int m = 0; m < 4; ++m) _Pragma("unroll") for (int k = 0; k < 2; ++k) dst[m][k] = *(const PG8_LAS bf16x8*)(lds + PG8_SA(b, h) + aoff + m * 2048 + k * 1024); } while (0)
#define PG8_LDB(dst, b, h) do { _Pragma("unroll") for (int n = 0; n < 2; ++n) _Pragma("unroll") for (int k = 0; k < 2; ++k) dst[n][k] = *(const PG8_LAS bf16x8*)(lds + PG8_SB(b, h) + boff + n * 2048 + k * 1024); } while (0)
#define PG8_MMA(ai, bj, At, Bt) do { __builtin_amdgcn_s_setprio(1); _Pragma("unroll") for (int m = 0; m < 4; ++m) _Pragma("unroll") for (int n = 0; n < 2; ++n) _Pragma("unroll") for (int k = 0; k < 2; ++k) \
        acc[ai][bj][m][n] = __builtin_amdgcn_mfma_f32_16x16x32_bf16(Bt[n][k], At[m][k], acc[ai][bj][m][n], 0, 0, 0); __builtin_amdgcn_s_setprio(0); } while (0)
#define PG8_WAIT_V(n) asm volatile("s_waitcnt vmcnt(" #n ")" ::: "memory")
#define PG8_WAIT_L(n) asm volatile("s_waitcnt lgkmcnt(" #n ")" ::: "memory")
#define PG8_BAR __builtin_amdgcn_s_barrier()
#define PG8_SCHED __builtin_amdgcn_sched_barrier(0)
    Unit cur = {0, 0, 0, 0}, nxt = {0, 0, 0, 0}; int ui = 0;
    if (!S.next(0, cur)) return;
    f32x4 acc[2][2][4][2];
#pragma unroll
    for (int a = 0; a < 2; ++a)
#pragma unroll
        for (int b = 0; b < 2; ++b)
#pragma unroll
            for (int m = 0; m < 4; ++m)
#pragma unroll
                for (int n = 0; n < 2; ++n) acc[a][b][m][n] = (f32x4){0.f, 0.f, 0.f, 0.f};
    bf16x8 At[4][2], B0[2][2], B1[2][2];
    const char* cA = (const char*)g.A + (size_t)cur.pm * tstep; const char* cB = (const char*)g.Bt + (size_t)cur.pb * tstep;
    S.a_ready(cur);
    if constexpr (SP2) {
        PG8_STAGE(PG8_SB(0, 0), cB, voffB); PG8_STAGE(PG8_SB(0, 1), cB + hstep, voffB); PG8_STAGE(PG8_SA(0, 0), cA, voffA); PG8_STAGE(PG8_SA(0, 1), cA + hstep, voffA);
        if (wr == 1) PG8_BAR;
        PG8_WAIT_V(2); PG8_BAR;
        PG8_STAGE(PG8_SB(1, 0), cB + kstep, voffB); PG8_STAGE(PG8_SA(1, 0), cA + kstep, voffA); PG8_STAGE(PG8_SB(1, 1), cB + hstep + kstep, voffB);
        PG8_WAIT_V(6); PG8_BAR;
    } else {
        PG8_STAGE(PG8_SB(0, 0), cB, voffB); PG8_STAGE(PG8_SA(0, 0), cA, voffA); PG8_STAGE(PG8_SB(0, 1), cB + hstep, voffB); PG8_STAGE(PG8_SA(0, 1), cA + hstep, voffA);
        if (wr == 1) PG8_BAR;
        PG8_WAIT_V(4); PG8_BAR;
        PG8_STAGE(PG8_SB(1, 0), cB + kstep, voffB); PG8_STAGE(PG8_SA(1, 0), cA + kstep, voffA); PG8_STAGE(PG8_SB(1, 1), cB + hstep + kstep, voffB);
        PG8_WAIT_V(6); PG8_BAR;
    }
    for (;;) {
        const bool has_next = S.next(ui + 1, nxt);
        const char* nA = has_next ? (const char*)g.A + (size_t)nxt.pm * tstep : cA; const char* nB = has_next ? (const char*)g.Bt + (size_t)nxt.pb * tstep : cB;
        for (int t = 0; t < nt; t += 2) {
            const bool last = (t == nt - 2);
            const char* a1 = cA + (size_t)(t + 1) * kstep;
            const char* a2 = last ? nA : cA + (size_t)(t + 2) * kstep; const char* b2 = last ? nB : cB + (size_t)(t + 2) * kstep;
            const char* a3 = a2 + kstep; const char* b3 = b2 + kstep;
            if (last && has_next) S.a_ready(nxt);
            if constexpr (SP2) {
            PG8_LDB(B0, 0, 0); PG8_LDB(B1, 0, 1); PG8_SCHED; PG8_LDA(At, 0, 0); PG8_STAGE(PG8_SA(1, 1), a1 + hstep, voffA);
            PG8_WAIT_V(8); PG8_WAIT_L(0); PG8_BAR; PG8_MMA(0, 0, At, B0); PG8_MMA(0, 1, At, B1); PG8_BAR; PG8_SCHED;
            PG8_LDA(At, 0, 1); PG8_STAGE(PG8_SB(0, 0), b2, voffB); PG8_STAGE(PG8_SB(0, 1), b2 + hstep, voffB); PG8_STAGE(PG8_SA(0, 0), a2, voffA);
            PG8_WAIT_V(8); PG8_WAIT_L(0); PG8_BAR; PG8_MMA(1, 0, At, B0); PG8_MMA(1, 1, At, B1); PG8_BAR; PG8_SCHED;
            PG8_LDB(B0, 1, 0); PG8_LDB(B1, 1, 1); PG8_SCHED; PG8_LDA(At, 1, 0); PG8_STAGE(PG8_SA(0, 1), a2 + hstep, voffA);
            PG8_WAIT_V(8); PG8_WAIT_L(0); PG8_BAR; PG8_MMA(0, 0, At, B0); PG8_MMA(0, 1, At, B1); PG8_BAR; PG8_SCHED;
            PG8_LDA(At, 1, 1); PG8_STAGE(PG8_SB(1, 0), b3, voffB); PG8_STAGE(PG8_SB(1, 1), b3 + hstep, voffB); PG8_STAGE(PG8_SA(1, 0), a3, voffA);
            PG8_WAIT_V(8); PG8_WAIT_L(0); PG8_BAR; PG8_MMA(1, 0, At, B0); PG8_MMA(1, 1, At, B1); PG8_BAR; PG8_SCHED;
            } else {
            PG8_LDB(B0, 0, 0); PG8_SCHED; PG8_LDA(At, 0, 0); PG8_STAGE(PG8_SA(1, 1), a1 + hstep, voffA);
            PG8_WAIT_L(8); PG8_BAR; PG8_WAIT_L(0); PG8_MMA(0, 0, At, B0); PG8_BAR; PG8_SCHED;
            PG8_LDB(B1, 0, 1); PG8_STAGE(PG8_SB(0, 0), b2, voffB);
            PG8_BAR; PG8_WAIT_L(0); PG8_MMA(0, 1, At, B1); PG8_BAR;
            PG8_LDA(At, 0, 1); PG8_STAGE(PG8_SA(0, 0), a2, voffA);
            PG8_BAR; PG8_WAIT_L(0); PG8_MMA(1, 0, At, B0); PG8_BAR; PG8_SCHED;
            PG8_STAGE(PG8_SB(0, 1), b2 + hstep, voffB);
            PG8_WAIT_V(6); PG8_BAR; PG8_MMA(1, 1, At, B1); PG8_BAR;
            PG8_LDB(B0, 1, 0); PG8_SCHED; PG8_LDA(At, 1, 0); PG8_STAGE(PG8_SA(0, 1), a2 + hstep, voffA);
            PG8_WAIT_L(8); PG8_BAR; PG8_WAIT_L(0); PG8_MMA(0, 0, At, B0); PG8_BAR; PG8_SCHED;
            PG8_LDB(B1, 1, 1); PG8_STAGE(PG8_SB(1, 0), b3, voffB);
            PG8_BAR; PG8_WAIT_L(0); PG8_MMA(0, 1, At, B1); PG8_BAR;
            PG8_LDA(At, 1, 1); PG8_STAGE(PG8_SA(1, 0), a3, voffA);
            PG8_BAR; PG8_WAIT_L(0); PG8_MMA(1, 0, At, B0); PG8_BAR; PG8_SCHED;
            PG8_STAGE(PG8_SB(1, 1), b3 + hstep, voffB);
            PG8_WAIT_V(6); PG8_BAR; PG8_MMA(1, 1, At, B1); PG8_BAR;
            }
        }
        if constexpr (ALIGN_EPI) { if (wr == 0) PG8_BAR; }
        if constexpr (!Epi::AFTER_DRAIN) { E(acc, cur, wr, wc, fr, fq); S.done(cur); }
        if (!has_next) break;
#pragma unroll
        for (int a = 0; a < 2; ++a)
#pragma unroll
            for (int b = 0; b < 2; ++b)
#pragma unroll
                for (int m = 0; m < 4; ++m)
#pragma unroll
                    for (int n = 0; n < 2; ++n) acc[a][b][m][n] = (f32x4){0.f, 0.f, 0.f, 0.f};
        cur = nxt; cA = nA; cB = nB; ++ui;
        if constexpr (ALIGN_EPI) { if (wr == 1) PG8_BAR; }
    }
    PG8_WAIT_V(0);
    if constexpr (!ALIGN_EPI) { if (wr == 0) PG8_BAR; }
    PG8_BAR;
    if constexpr (Epi::AFTER_DRAIN) { E.fused(acc, cur, wr, wc, fr, fq, lds, wid, lane); S.done(cur); }
#undef PG8_SA
#undef PG8_SB
#undef PG8_STAGE
#undef PG8_LDA
#undef PG8_LDB
#undef PG8_MMA
#undef PG8_WAIT_V
#undef PG8_WAIT_L
#undef PG8_BAR
#undef PG8_SCHED
}
typedef int v8i __attribute__((ext_vector_type(8)));
typedef int v4i __attribute__((ext_vector_type(4)));
constexpr int SCALE_W8 = 0x78787878, SCALE_A8 = 0x7f7f7f7f;
template <class Epi, class Sched, bool ALIGN_EPI = false, bool SP2 = false>
__device__ __forceinline__ void gemm_phase8(PG8_LAS unsigned char* lds, const Gemm g, const Sched& S, const Epi& E) {
    const int tid = threadIdx.x, wid = __builtin_amdgcn_readfirstlane(tid >> 6), lane = tid & 63, wr = wid >> 2, wc = wid & 3, fr = lane & 15, fq = lane >> 4;
    const int K = g.K, nt = K / BK;
    unsigned voffA[2], voffB[2];
#pragma unroll
    for (int i = 0; i < 2; ++i) { int R, C; stage_rc(tid * 16 + i * 8192, R, C); const int Rb = Epi::PERM ? ((R & ~31) + perm32(R & 31)) : R;
        voffA[i] = (unsigned)(R * K + C) * 2u; voffB[i] = (unsigned)(Rb * K + C) * 2u; }
    const size_t kstep = (size_t)(BK * 2);
    const size_t hstep = (size_t)HALF * K * 2;
    const size_t tstep = 2 * hstep;
    const unsigned ldsw = (unsigned)wid * 1024u;
    const int aoff = lds_byte(wr * 64 + fr, fq * 8), boff = lds_byte(wc * 32 + fr, fq * 8);
#define PG8_SA(b, h) (((b) * 2 + (h)) * HTB)
#define PG8_SB(b, h) ((4 + (b) * 2 + (h)) * HTB)
#define PG8_STAGE(bufoff, gbase, voff) do { _Pragma("unroll") for (int _i = 0; _i < 2; ++_i) \
        __builtin_amdgcn_global_load_lds((const unsigned*)((const char*)(gbase) + (voff)[_i]), (PG8_LAS unsigned*)(lds + (bufoff) + ldsw + _i * 8192), 16, 0, 0); } while (0)
#define PG8_LDA(dst, b, h) do { _Pragma("unroll") for (int m = 0; m < 4; ++m) { const v4i lo_ = *(const PG8_LAS v4i*)(lds + PG8_SA(b, h) + aoff + m * 2048), hi_ = *(const PG8_LAS v4i*)(lds + PG8_SA(b, h) + aoff + m * 2048 + 1024); \
        dst[m] = __builtin_shufflevector(lo_, hi_, 0, 1, 2, 3, 4, 5, 6, 7); } } while (0)
#define PG8_LDB(dst, b, h) do { _Pragma("unroll") for (int n = 0; n < 2; ++n) { const v4i lo_ = *(const PG8_LAS v4i*)(lds + PG8_SB(b, h) + boff + n * 2048), hi_ = *(const PG8_LAS v4i*)(lds + PG8_SB(b, h) + boff + n * 2048 + 1024); \
        dst[n] = __builtin_shufflevector(lo_, hi_, 0, 1, 2, 3, 4, 5, 6, 7); } } while (0)
#define PG8_MMA(ai, bj, At, Bt) do { __builtin_amdgcn_s_setprio(1); _Pragma("unroll") for (int m = 0; m < 4; ++m) _Pragma("unroll") for (int n = 0; n < 2; ++n) \
        asm volatile("v_mfma_scale_f32_16x16x128_f8f6f4 %0, %1, %2, %0, %3, %4 op_sel_hi:[0,0,0]" : "+v"(acc[ai][bj][m][n]) : "v"(Bt[n]), "v"(At[m]), "v"(sw8), "v"(sa8)); __builtin_amdgcn_s_setprio(0); } while (0)
#define PG8_WAIT_V(n) asm volatile("s_waitcnt vmcnt(" #n ")" ::: "memory")
#define PG8_WAIT_L(n) asm volatile("s_waitcnt lgkmcnt(" #n ")" ::: "memory")
#define PG8_BAR __builtin_amdgcn_s_barrier()
#define PG8_SCHED __builtin_amdgcn_sched_barrier(0)
    Unit cur = {0, 0, 0, 0}, nxt = {0, 0, 0, 0}; int ui = 0;
    if (!S.next(0, cur)) return;
    f32x4 acc[2][2][4][2];
#pragma unroll
    for (int a = 0; a < 2; ++a)
#pragma unroll
        for (int b = 0; b < 2; ++b)
#pragma unroll
            for (int m = 0; m < 4; ++m)
#pragma unroll
                for (int n = 0; n < 2; ++n) acc[a][b][m][n] = (f32x4){0.f, 0.f, 0.f, 0.f};
    v8i At[4], B0[2], B1[2]; int sw8 = SCALE_W8, sa8 = SCALE_A8;
    const char* cA = (const char*)g.A + (size_t)cur.pm * tstep; const char* cB = (const char*)g.Bt + (size_t)cur.pb * tstep;
    S.a_ready(cur);
    if constexpr (SP2) {
        PG8_STAGE(PG8_SB(0, 0), cB, voffB); PG8_STAGE(PG8_SB(0, 1), cB + hstep, voffB); PG8_STAGE(PG8_SA(0, 0), cA, voffA); PG8_STAGE(PG8_SA(0, 1), cA + hstep, voffA);
        if (wr == 1) PG8_BAR;
        PG8_WAIT_V(2); PG8_BAR;
        PG8_STAGE(PG8_SB(1, 0), cB + kstep, voffB); PG8_STAGE(PG8_SA(1, 0), cA + kstep, voffA); PG8_STAGE(PG8_SB(1, 1), cB + hstep + kstep, voffB);
        PG8_WAIT_V(6); PG8_BAR;
    } else {
        PG8_STAGE(PG8_SB(0, 0), cB, voffB); PG8_STAGE(PG8_SA(0, 0), cA, voffA); PG8_STAGE(PG8_SB(0, 1), cB + hstep, voffB); PG8_STAGE(PG8_SA(0, 1), cA + hstep, voffA);
        if (wr == 1) PG8_BAR;
        PG8_WAIT_V(4); PG8_BAR;
        PG8_STAGE(PG8_SB(1, 0), cB + kstep, voffB); PG8_STAGE(PG8_SA(1, 0), cA + kstep, voffA); PG8_STAGE(PG8_SB(1, 1), cB + hstep + kstep, voffB);
        PG8_WAIT_V(6); PG8_BAR;
    }
    for (;;) {
        const bool has_next = S.next(ui + 1, nxt);
        const char* nA = has_next ? (const char*)g.A + (size_t)nxt.pm * tstep : cA; const char* nB = has_next ? (const char*)g.Bt + (size_t)nxt.pb * tstep : cB;
        for (int t = 0; t < nt; t += 2) {
            const bool last = (t == nt - 2);
            const char* a1 = cA + (size_t)(t + 1) * kstep;
            const char* a2 = last ? nA : cA + (size_t)(t + 2) * kstep; const char* b2 = last ? nB : cB + (size_t)(t + 2) * kstep;
            const char* a3 = a2 + kstep; const char* b3 = b2 + kstep;
            if (last && has_next) S.a_ready(nxt);
            if constexpr (SP2) {
            PG8_LDB(B0, 0, 0); PG8_LDB(B1, 0, 1); PG8_SCHED; PG8_LDA(At, 0, 0); PG8_STAGE(PG8_SA(1, 1), a1 + hstep, voffA);
            PG8_WAIT_V(8); PG8_WAIT_L(0); PG8_BAR; PG8_MMA(0, 0, At, B0); PG8_MMA(0, 1, At, B1); PG8_BAR; PG8_SCHED;
            PG8_LDA(At, 0, 1); PG8_STAGE(PG8_SB(0, 0), b2, voffB); PG8_STAGE(PG8_SB(0, 1), b2 + hstep, voffB); PG8_STAGE(PG8_SA(0, 0), a2, voffA);
            PG8_WAIT_V(8); PG8_WAIT_L(0); PG8_BAR; PG8_MMA(1, 0, At, B0); PG8_MMA(1, 1, At, B1); PG8_BAR; PG8_SCHED;
            PG8_LDB(B0, 1, 0); PG8_LDB(B1, 1, 1); PG8_SCHED; PG8_LDA(At, 1, 0); PG8_STAGE(PG8_SA(0, 1), a2 + hstep, voffA);
            PG8_WAIT_V(8); PG8_WAIT_L(0); PG8_BAR; PG8_MMA(0, 0, At, B0); PG8_MMA(0, 1, At, B1); PG8_BAR; PG8_SCHED;
            PG8_LDA(At, 1, 1); PG8_STAGE(PG8_SB(1, 0), b3, voffB); PG8_STAGE(PG8_SB(1, 1), b3 + hstep, voffB); PG8_STAGE(PG8_SA(1, 0), a3, voffA);
            PG8_WAIT_V(8); PG8_WAIT_L(0); PG8_BAR; PG8_MMA(1, 0, At, B0); PG8_MMA(1, 1, At, B1); PG8_BAR; PG8_SCHED;
            } else {
            PG8_LDB(B0, 0, 0); PG8_SCHED; PG8_LDA(At, 0, 0); PG8_STAGE(PG8_SA(1, 1), a1 + hstep, voffA);
            PG8_WAIT_L(8); PG8_BAR; PG8_WAIT_L(0); PG8_MMA(0, 0, At, B0); PG8_BAR; PG8_SCHED;
            PG8_LDB(B1, 0, 1); PG8_STAGE(PG8_SB(0, 0), b2, voffB);
            PG8_BAR; PG8_WAIT_L(0); PG8_MMA(0, 1, At, B1); PG8_BAR;
            PG8_LDA(At, 0, 1); PG8_STAGE(PG8_SA(0, 0), a2, voffA);
            PG8_BAR; PG8_WAIT_L(0); PG8_MMA(1, 0, At, B0); PG8_BAR; PG8_SCHED;
            PG8_STAGE(PG8_SB(0, 1), b2 + hstep, voffB);
            PG8_WAIT_V(6); PG8_BAR; PG8_MMA(1, 1, At, B1); PG8_BAR;
            PG8_LDB(B0, 1, 0); PG8_SCHED; PG8_LDA(At, 1, 0); PG8_STAGE(PG8_SA(0, 1), a2 + hstep, voffA);
            PG8_WAIT_L(8); PG8_BAR; PG8_WAIT_L(0); PG8_MMA(0, 0, At, B0); PG8_BAR; PG8_SCHED;
            PG8_LDB(B1, 1, 1); PG8_STAGE(PG8_SB(1, 0), b3, voffB);
            PG8_BAR; PG8_WAIT_L(0); PG8_MMA(0, 1, At, B1); PG8_BAR;
            PG8_LDA(At, 1, 1); PG8_STAGE(PG8_SA(1, 0), a3, voffA);
            PG8_BAR; PG8_WAIT_L(0); PG8_MMA(1, 0, At, B0); PG8_BAR; PG8_SCHED;
            PG8_STAGE(PG8_SB(1, 1), b3 + hstep, voffB);
            PG8_WAIT_V(6); PG8_BAR; PG8_MMA(1, 1, At, B1); PG8_BAR;
            }
        }
        if constexpr (ALIGN_EPI) { if (wr == 0) PG8_BAR; }
        asm volatile("s_nop 15\n\ts_nop 7" ::: "memory");
        if constexpr (!Epi::AFTER_DRAIN) { E(acc, cur, wr, wc, fr, fq); S.done(cur); }
        if (!has_next) break;
#pragma unroll
        for (int a = 0; a < 2; ++a)
#pragma unroll
            for (int b = 0; b < 2; ++b)
#pragma unroll
                for (int m = 0; m < 4; ++m)
#pragma unroll
                    for (int n = 0; n < 2; ++n) acc[a][b][m][n] = (f32x4){0.f, 0.f, 0.f, 0.f};
        cur = nxt; cA = nA; cB = nB; ++ui;
        if constexpr (ALIGN_EPI) { if (wr == 1) PG8_BAR; }
    }
    PG8_WAIT_V(0);
    if constexpr (!ALIGN_EPI) { if (wr == 0) PG8_BAR; }
    PG8_BAR;
    if constexpr (Epi::AFTER_DRAIN) { E.fused(acc, cur, wr, wc, fr, fq, lds, wid, lane); S.done(cur); }
#undef PG8_SA
#undef PG8_SB
#undef PG8_STAGE
#undef PG8_LDA
#undef PG8_LDB
#undef PG8_MMA
#undef PG8_WAIT_V
#undef PG8_WAIT_L
#undef PG8_BAR
#undef PG8_SCHED
}
}
#define GAS __attribute__((address_space(1)))
#define LAS __attribute__((address_space(3)))
typedef unsigned short bf16;
typedef unsigned v4u __attribute__((ext_vector_type(4)));
typedef float f32x4 __attribute__((ext_vector_type(4)));
typedef short bf16x8 __attribute__((ext_vector_type(8)));
typedef GAS unsigned gu32;
typedef GAS unsigned long long gu64;
#define RLX_AGENT __ATOMIC_RELAXED, __HIP_MEMORY_SCOPE_AGENT
#define LDS_WAIT() asm volatile("s_waitcnt lgkmcnt(0)" ::: "memory")
#define VM_WAIT() asm volatile("s_waitcnt vmcnt(0)" ::: "memory")
__device__ __forceinline__ unsigned long long rt() { return __builtin_amdgcn_s_memrealtime(); }
__device__ __forceinline__ unsigned f2bf(float f) { unsigned u = __builtin_bit_cast(unsigned, f); return (u + 0x7fffu + ((u >> 16) & 1u)) >> 16; }
__device__ __forceinline__ unsigned pk2(float lo, float hi) { return f2bf(lo) | (f2bf(hi) << 16); }

#define XB_TMO      128
#define XB_XCNT(j)  (256  + 64 * (j))
#define XB_XSUB(j)  (1280 + 64 * (j))
#define XB_XGEN(j)  (2304 + 64 * (j))
#define XB_TOP      3328
#define XB_TOPGEN   3392
#define XCD_BAR_WORDS 3456
#define XB_SPIN_CAP (1u << 18)

__device__ __forceinline__ unsigned xb_ld(unsigned* p)              { return __hip_atomic_load(p, __ATOMIC_RELAXED, __HIP_MEMORY_SCOPE_AGENT); }
__device__ __forceinline__ unsigned xb_add(unsigned* p, unsigned v) { return __hip_atomic_fetch_add(p, v, __ATOMIC_RELAXED, __HIP_MEMORY_SCOPE_AGENT); }
__device__ __forceinline__ unsigned xb_xcc_id() { return (unsigned)__builtin_amdgcn_s_getreg((3 << 11) | 20) & 0xFu; }
#define XB_SPIN(cond, bar) do { unsigned _sp = 0; while (cond) { __builtin_amdgcn_s_sleep(1); \
    if ((++_sp & 255u) == 0u) { if (xb_ld(&(bar)[XB_TMO])) break; if (_sp > XB_SPIN_CAP) { atomicAdd(&(bar)[XB_TMO], 1u); break; } } } } while (0)

struct XcdBarrier {
    unsigned* bar; unsigned x;
    volatile LAS unsigned* st;
};

__device__ __forceinline__ XcdBarrier xcd_barrier_post(unsigned* bar, volatile LAS unsigned* st) {
    XcdBarrier b; b.bar = bar; b.x = xb_xcc_id(); b.st = st;
    if (threadIdx.x == 0) (void)xb_add(&bar[XB_XCNT(b.x)], 1u);
    return b;
}
__device__ __forceinline__ void xcd_barrier_complete(unsigned* bar, unsigned x, unsigned& nloc, unsigned& nx) {
    const unsigned G = gridDim.x * gridDim.y * gridDim.z;
    unsigned sum, cnt, mine, sp = 0u;
    for (;;) {
        sum = 0u; cnt = 0u; mine = 0u;
#pragma unroll
        for (unsigned j = 0; j < 16; ++j) { const unsigned c = xb_ld(&bar[XB_XCNT(j)]); sum += c; cnt += (c > 0u) ? 1u : 0u; mine = (j == x) ? c : mine; }
        if (sum == G) break;
        __builtin_amdgcn_s_sleep(1);
        if ((++sp & 255u) == 0u) { if (xb_ld(&bar[XB_TMO])) break; if (sp > XB_SPIN_CAP) { atomicAdd(&bar[XB_TMO], 1u); break; } }
    }
    nloc = mine > 0u ? mine : 1u; nx = cnt > 0u ? cnt : 1u;
}

__device__ __forceinline__ void xcd_barrier(const XcdBarrier& b) {
    asm volatile("s_waitcnt vmcnt(0)" ::: "memory");
    __syncthreads();
    if (threadIdx.x == 0) {
        unsigned* bar = b.bar;
        __builtin_amdgcn_s_waitcnt(0);
        unsigned nloc = b.st[0], nx = b.st[1];
        if (nloc == 0u) { xcd_barrier_complete(bar, b.x, nloc, nx); b.st[0] = nloc; b.st[1] = nx; }
        const unsigned old = xb_add(&bar[XB_XSUB(b.x)], 1u);
        const unsigned gen = old / nloc;
        if (old + 1u == (gen + 1u) * nloc) {
            __builtin_amdgcn_fence(__ATOMIC_RELEASE, "agent");
            asm volatile("s_waitcnt vmcnt(0)" ::: "memory");
            const unsigned og = xb_add(&bar[XB_TOP], 1u);
            const unsigned tg = og / nx;
            if (og + 1u == (tg + 1u) * nx) xb_add(&bar[XB_TOPGEN], 1u);
            else XB_SPIN(xb_ld(&bar[XB_TOPGEN]) == tg, bar);
            __builtin_amdgcn_fence(__ATOMIC_ACQUIRE, "agent");
            xb_add(&bar[XB_XGEN(b.x)], 1u);
            asm volatile("s_waitcnt vmcnt(0)" ::: "memory");
        } else {
            XB_SPIN(xb_ld(&bar[XB_XGEN(b.x)]) == gen, bar);
            __builtin_amdgcn_fence(__ATOMIC_ACQUIRE, "agent");
            asm volatile("s_waitcnt vmcnt(0)" ::: "memory");
        }
    }
    __syncthreads();
}
namespace mk {
constexpr int S = 8192, D = 2048, NPROJ = 6160, NPP = 6144, NPAD = 6400, NE = 32, FF = 2048, NWAVES = 8, NTHR = 512;
constexpr int C_MQ = 0, C_MK = 512, C_MV = 1024, C_MO = 2048, C_FQ = 3072, C_FK = 4096, C_FV = 5120;
constexpr int MAXROWS = S * 4 + NE * 256;
constexpr int NCH = 128, LCH = 64;
constexpr size_t MiB = 1u << 20;
constexpr size_t WS_CTL = 0, CTL_ZERO_BYTES = 1 * MiB;
constexpr size_t WS_MODP = 14 * MiB;
constexpr size_t WS_MOD = 2 * MiB;
constexpr size_t WS_GATES = 3 * MiB;
constexpr size_t WS_F = 4 * MiB;
constexpr size_t WS_NL = 5 * MiB;
constexpr size_t WS_NS = 6 * MiB;
constexpr size_t WS_GLAL = 7 * MiB;
constexpr size_t WS_MS = 7 * MiB + 65536;
constexpr size_t WS_TOPI = 8 * MiB;
constexpr size_t WS_TOPW = 9 * MiB;
constexpr size_t WS_HIST = 10 * MiB;
constexpr size_t WS_LRANK = 11 * MiB;
constexpr size_t WS_POS = 12 * MiB;
constexpr size_t WS_ROWW = 13 * MiB;
constexpr size_t WS_WIN = 16 * MiB;
constexpr size_t WS_WOUT = 42 * MiB;
constexpr size_t WS_HN = 50 * MiB;
constexpr size_t WS_PROJ = 82 * MiB;
constexpr size_t WS_UL = 178 * MiB;
constexpr size_t WS_CS = 242 * MiB;
constexpr size_t WS_CONCAT = 274 * MiB;
constexpr size_t WS_H1 = 306 * MiB;
constexpr size_t WS_XG = 370 * MiB;
constexpr size_t WS_ACT = 530 * MiB;
constexpr size_t WS_Y = 690 * MiB;
constexpr size_t WS_WUG = 850 * MiB;
constexpr size_t WS_WD = 1362 * MiB;
constexpr size_t WS_OPART = 1618 * MiB;
constexpr size_t WS_MLP = 1786 * MiB;
constexpr size_t WS_JLO = 1789 * MiB;
constexpr size_t WS_END = 1790 * MiB;
constexpr size_t WS_NAIVE = 1792 * MiB;
constexpr int CW_TMO = 0, CW_CODE = 1, CW_CONV = 65536, CW_DONE = 2048, CW_BAR = 4096;
constexpr int GC_INPROJ = 160, GC_ATTN = 160, GC_PREP = 192;
constexpr int RING_OFF = 0, RING_BYTES = 131072;
constexpr int LDSCTL_OFF = RING_BYTES, MISC_OFF = LDSCTL_OFF + 320;
constexpr int TAB_OFF = LDSCTL_OFF + 1024;
constexpr int ATT_CH = 16;
constexpr int LDS_BYTES = 147456;
static_assert(GC_INPROJ <= 248 && GC_INPROJ % 8 == 0 && GC_ATTN % 8 == 0, "compute groups: multiples of 8; the in-proj group leaves slot 31 to the forget-gate scans");
}
namespace mk {
typedef float f32x2 __attribute__((ext_vector_type(2)));
typedef unsigned u32x2 __attribute__((ext_vector_type(2)));
struct Frame {
    LAS unsigned char* lds;
    volatile LAS unsigned* MISC;
    gu32* ctl;
    int tid, lane, wave, vcu, G, bid;
    const float* in[24];
    float* out; unsigned char* ws;
};
#define IN_X 0
#define IN_C 1
#define IN_WADA 2
#define IN_BADA 3
#define IN_NMIX 4
#define IN_WIN 5
#define IN_BI 6
#define IN_BF 7
#define IN_FOXBF 8
#define IN_FOXQN 9
#define IN_FOXKN 10
#define IN_MOUTN 11
#define IN_FOUTN 12
#define IN_WOUT 13
#define IN_NFFN 14
#define IN_WR 15
#define IN_BR 16
#define IN_WUG 17
#define IN_BUG 18
#define IN_WD 19
#define IN_BD 20
#define IN_WAF 21
#define IN_BAF 22
#define IN_NFIN 23
template <class T> __device__ __forceinline__ T* wsp(const Frame& F, size_t off) { return (T*)(F.ws + off); }
__device__ __forceinline__ float wave_sum(float v) {
#pragma unroll
    for (int o = 1; o < 64; o <<= 1) v += __shfl_xor(v, o);
    return v;
}
__device__ __forceinline__ float sigmoid_f(float v) { return 1.f / (1.f + __expf(-v)); }
__device__ __forceinline__ float log_sigmoid_f(float v) { return fminf(v, 0.f) - log1pf(__expf(-fabsf(v))); }
__device__ __forceinline__ float softcap_f(float v) { return 15.f * tanhf(v * (1.f / 15.f)); }
__device__ __forceinline__ float bf2f(unsigned short b) { return __uint_as_float(((unsigned)b) << 16); }

struct CvtItem { const float* src; bf16* dst; };
__device__ __forceinline__ void cvt_load(const CvtItem& it, int ldw, f32x4 (&v)[16], int lane) {
    const float* p = it.src + (size_t)((lane >> 4) * 16) * ldw + (lane & 15) * 4;
#pragma unroll
    for (int i = 0; i < 16; ++i) v[i] = __builtin_nontemporal_load((const GAS f32x4*)(p + (size_t)i * ldw));
}
__device__ __forceinline__ void cvt_store(const CvtItem& it, int K, const f32x4 (&v)[16], LAS unsigned char* scr, int lane) {
    const int c = lane & 15, g = lane >> 4;
#pragma unroll
    for (int j = 0; j < 4; ++j) {
        v4u a, b;
        a.x = pk2(v[0][j], v[1][j]); a.y = pk2(v[2][j], v[3][j]); a.z = pk2(v[4][j], v[5][j]); a.w = pk2(v[6][j], v[7][j]);
        b.x = pk2(v[8][j], v[9][j]); b.y = pk2(v[10][j], v[11][j]); b.z = pk2(v[12][j], v[13][j]); b.w = pk2(v[14][j], v[15][j]);
        LAS unsigned char* q = scr + (4 * c + j) * 144 + 32 * g;
        *(LAS v4u*)q = a; *(LAS v4u*)(q + 16) = b; }
    LDS_WAIT(); asm volatile("" ::: "memory");
#pragma unroll
    for (int i = 0; i < 8; ++i) { const int row = (lane >> 3) + 8 * i; const v4u o = *(const LAS v4u*)(scr + row * 144 + (lane & 7) * 16);
        *(GAS v4u*)(it.dst + (size_t)row * K + (lane & 7) * 8) = o; }
    LDS_WAIT(); asm volatile("" ::: "memory");
}
__device__ __forceinline__ unsigned pk4_fp8(float a, float b, float c, float d) { int r = __builtin_amdgcn_cvt_pk_fp8_f32(a, b, 0, false); r = __builtin_amdgcn_cvt_pk_fp8_f32(c, d, r, true); return (unsigned)r; }
constexpr float W8S = 128.f;
__device__ __forceinline__ void cvt8_pack(const f32x4 (&v)[16], LAS unsigned char* scr, int half, int lane) {
    const int c = lane & 15, g = lane >> 4;
#pragma unroll
    for (int j = 0; j < 4; ++j) { v4u a;
        a.x = pk4_fp8(v[0][j] * W8S, v[1][j] * W8S, v[2][j] * W8S, v[3][j] * W8S); a.y = pk4_fp8(v[4][j] * W8S, v[5][j] * W8S, v[6][j] * W8S, v[7][j] * W8S);
        a.z = pk4_fp8(v[8][j] * W8S, v[9][j] * W8S, v[10][j] * W8S, v[11][j] * W8S); a.w = pk4_fp8(v[12][j] * W8S, v[13][j] * W8S, v[14][j] * W8S, v[15][j] * W8S);
        *(LAS v4u*)(scr + (4 * c + j) * 144 + half * 64 + 16 * g) = a; }
}
__device__ __forceinline__ void cvt8_flush(unsigned char* dst, int kbytes, LAS unsigned char* scr, int lane) {
    LDS_WAIT(); asm volatile("" ::: "memory");
#pragma unroll
    for (int i = 0; i < 8; ++i) { const int row = (lane >> 3) + 8 * i; const v4u o = *(const LAS v4u*)(scr + row * 144 + (lane & 7) * 16);
        __builtin_nontemporal_store(o, (GAS v4u*)(dst + (size_t)row * kbytes + (lane & 7) * 16)); }
    LDS_WAIT(); asm volatile("" ::: "memory");
}
constexpr int CV8_UG = NE * 16 * 64, CV8_D = NE * 16 * 32, CV8_TOTAL = CV8_UG + CV8_D;
struct Cvt8Item { const float* src; unsigned char* dst; int ldw; };
__device__ __forceinline__ Cvt8Item cvt8_item(const Frame& F, int it, int half) {
    Cvt8Item r;
    if (it < CV8_UG) { const int e = it >> 10, q = it & 1023, kb = q >> 6, nb = q & 63, d0 = nb * 64, j = d0 >> 8, wv = d0 & 255, sc = wv < 128 ? 128 * j + wv : 2048 + 128 * j + (wv - 128);
        r.ldw = 4096; r.src = F.in[IN_WUG] + (size_t)e * D * 4096 + (size_t)(kb * 128 + half * 64) * 4096 + sc; r.dst = wsp<unsigned char>(F, WS_WUG) + (size_t)e * 4096 * D + (size_t)d0 * D + kb * 128; return r; }
    it -= CV8_UG;
    { const int e = it >> 9, q = it & 511, kb = q >> 5, nb = q & 31;
        r.ldw = D; r.src = F.in[IN_WD] + (size_t)e * FF * D + (size_t)(kb * 128 + half * 64) * D + nb * 64; r.dst = wsp<unsigned char>(F, WS_WD) + (size_t)e * D * FF + (size_t)(nb * 64) * FF + kb * 128; return r; }
}
__device__ __forceinline__ void cvt8_load(const Cvt8Item& it, f32x4 (&v)[16], int lane) {
    const float* p = it.src + (size_t)((lane >> 4) * 16) * it.ldw + (lane & 15) * 4;
#pragma unroll
    for (int i = 0; i < 16; ++i) v[i] = __builtin_nontemporal_load((const GAS f32x4*)(p + (size_t)i * it.ldw));
}
constexpr int CV_IN = 32 * 96, CV_OUT = 32 * 32, CV_TOTAL = CV_IN + CV_OUT;
__device__ __forceinline__ CvtItem cvt_item(const Frame& F, int it, int& ldw, int& K) {
    CvtItem r;
    if (it < CV_IN) { const int kb = it / 96, nb = it % 96, d0 = nb * 64, sc = d0 < 3072 ? d0 : d0 + 8;
        ldw = NPROJ; K = D; r.src = F.in[IN_WIN] + (size_t)(kb * 64) * NPROJ + sc; r.dst = wsp<bf16>(F, WS_WIN) + (size_t)d0 * D + kb * 64; return r; }
    it -= CV_IN;
    { const int kb = it >> 5, nb = it & 31; ldw = D; K = D; r.src = F.in[IN_WOUT] + (size_t)(kb * 64) * D + nb * 64; r.dst = wsp<bf16>(F, WS_WOUT) + (size_t)(nb * 64) * D + kb * 64; return r; }
}
__device__ __forceinline__ void p0_gemv(Frame& F) {
    const int gw = F.vcu * NWAVES + F.wave, NGW = F.G * NWAVES, lane = F.lane;
    {
        const float* c = F.in[IN_C]; float* modp = wsp<float>(F, WS_MODP);
        for (int task = gw; task < 2048; task += NGW) {
            const int cg = task & 63, ks = task >> 6, j = cg * 256 + 4 * lane;
            const float* w; int ld, col;
            if (j < 6 * D) { w = F.in[IN_WADA]; ld = 6 * D; col = j; } else { w = F.in[IN_WAF]; ld = 2 * D; col = j - 6 * D; }
            const float c0 = c[ks * 64 + lane]; const float s0 = c0 * sigmoid_f(c0);
            const float* wp = w + (size_t)(ks * 64) * ld + col; f32x4 acc = {0.f, 0.f, 0.f, 0.f};
#pragma unroll 16
            for (int i = 0; i < 64; ++i) acc += __builtin_nontemporal_load((const GAS f32x4*)(wp + (size_t)i * ld)) * __builtin_bit_cast(float, __builtin_amdgcn_readlane(__builtin_bit_cast(int, s0), i));
            *(GAS f32x4*)(modp + ks * 16384 + j) = acc;
        }
    }
    {
        bf16* win_t = wsp<bf16>(F, WS_WIN);
        for (int i2 = gw; i2 < D / 4; i2 += NGW) {
            const int col = lane & 15, k = 4 * i2 + (lane >> 4), sc = col < 8 ? 3072 + col : 6152 + (col - 8);
            win_t[(size_t)(NPP + col) * D + k] = (bf16)f2bf(F.in[IN_WIN][(size_t)k * NPROJ + sc]); }
        const v4u z = {0u, 0u, 0u, 0u};
        for (int i = gw * 64 + lane; i < 16 * D / 8; i += NGW * 64) *(GAS v4u*)(win_t + (size_t)NPROJ * D + (size_t)i * 8) = z;
    }
}
constexpr int CV8_NSH = 32, CV8_SHA = CV8_UG / CV8_NSH, CV8_SHB = CV8_D / CV8_NSH;
#define CONV_NEXT(var) do { var = CV8_TOTAL; \
        if (useA) { const int b_ = __builtin_amdgcn_readfirstlane((int)(lane == 0 ? __hip_atomic_fetch_add(ctrA, 1u, RLX_AGENT) : 0u)); if (b_ < CV8_SHA) var = xs * CV8_SHA + b_; else useA = false; } \
        if (var == CV8_TOTAL && useB) { const int b_ = __builtin_amdgcn_readfirstlane((int)(lane == 0 ? __hip_atomic_fetch_add(ctrB, 1u, RLX_AGENT) : 0u)); if (b_ < CV8_SHB) var = CV8_UG + xs * CV8_SHB + b_; else useB = false; } } while (0)
__device__ __forceinline__ void conv_worker(Frame& F, gu32* stop, unsigned target, int which) {
    LAS unsigned char* scr = F.lds + RING_OFF + F.wave * 9216; const int lane = F.lane, xs = (int)(blockIdx.x & (CV8_NSH - 1));
    gu32* ctrA = F.ctl + CW_CONV + 64 * xs; gu32* ctrB = F.ctl + CW_CONV + 64 * (CV8_NSH + xs);
    bool useA = which != 2, useB = which != 1;
    int it; CONV_NEXT(it); if (it >= CV8_TOTAL) return;
    f32x4 va[16], vb[16];
    Cvt8Item cur = cvt8_item(F, it, 0); cvt8_load(cur, va, lane);
    for (;;) {
        const Cvt8Item c1 = cvt8_item(F, it, 1); cvt8_load(c1, vb, lane);
        bool stopnow = false;
        if (stop) stopnow = (unsigned)__builtin_amdgcn_readfirstlane((int)__hip_atomic_load(stop, RLX_AGENT)) >= target;
        int itn = CV8_TOTAL; if (!stopnow) CONV_NEXT(itn);
        cvt8_pack(va, scr, 0, lane);
        const bool more = itn < CV8_TOTAL; Cvt8Item nx = cur;
        if (more) { nx = cvt8_item(F, itn, 0); cvt8_load(nx, va, lane); }
        cvt8_pack(vb, scr, 1, lane);
        cvt8_flush(cur.dst, D, scr, lane);
        if (!more) break;
        cur = nx; it = itn;
    }
}
__device__ __forceinline__ bool enter_group(Frame& F, int Gc) {
    if (F.G != 256 || Gc >= 256) return true;
    const int bx = (int)blockIdx.x, slot = bx >> 3, xcd = bx & 7, per = Gc >> 3;
    if (slot >= per) return false;
    F.vcu = xcd * per + slot; F.bid = slot * 8 + xcd; F.G = Gc; return true;
}
__device__ __forceinline__ void leave_group(Frame& F) { const int bx = (int)blockIdx.x, G = (int)gridDim.x; F.G = G; F.bid = bx; F.vcu = (G % 8 == 0) ? (bx % 8) * (G / 8) + bx / 8 : bx; }
__device__ __forceinline__ void p1_convert(Frame& F) {
    const int gw = F.vcu * NWAVES + F.wave, NGW = F.G * NWAVES, lane = F.lane;
    {
        LAS unsigned char* scr = F.lds + RING_OFF + F.wave * 9216;
        int it = gw;
        if (it < CV_TOTAL) {
            int ldw, K; CvtItem cur = cvt_item(F, it, ldw, K); f32x4 va[16], vb[16];
            cvt_load(cur, ldw, va, lane);
            for (;;) {
                int itn = it + NGW; int ldn = 0, Kn = 0; CvtItem nx = cur; const bool more = itn < CV_TOTAL;
                if (more) { nx = cvt_item(F, itn, ldn, Kn); cvt_load(nx, ldn, vb, lane); }
                cvt_store(cur, K, va, scr, lane);
                if (!more) break;
                it = itn + NGW; const bool more2 = it < CV_TOTAL; CvtItem n2 = nx; int ld2 = 0, K2 = 0;
                if (more2) { n2 = cvt_item(F, it, ld2, K2); cvt_load(n2, ld2, va, lane); }
                cvt_store(nx, Kn, vb, scr, lane);
                if (!more2) break;
                cur = n2; K = K2;
            }
        }
    }
}
__device__ __forceinline__ void mod_reduce_lds(Frame& F, int j0, int n, LAS float* dst) {
    const float* modp = wsp<float>(F, WS_MODP);
    for (int i = F.tid; i < n; i += NTHR) { const int j = j0 + i; float a = j < 6 * D ? F.in[IN_BADA][j] : F.in[IN_BAF][j - 6 * D];
#pragma unroll
        for (int ks = 0; ks < 32; ++ks) a += modp[ks * 16384 + j];
        dst[i] = a; }
}
__device__ __forceinline__ void modulate_row_bf16(const float* xrow, const float* g, const LAS float* sh, const LAS float* sc, bf16* orow, int lane) {
    const GAS f32x4* xr = (const GAS f32x4*)xrow + lane; f32x4 v[8]; float s2 = 0.f;
#pragma unroll
    for (int j = 0; j < 8; ++j) { v[j] = xr[64 * j]; s2 += (v[j].x * v[j].x + v[j].y * v[j].y) + (v[j].z * v[j].z + v[j].w * v[j].w); }
    const float r = rsqrtf(wave_sum(s2) * (1.f / D) + 1e-6f);
    GAS u32x2* o8 = (GAS u32x2*)orow + lane;
#pragma unroll
    for (int j = 0; j < 8; ++j) { const int c0 = 4 * lane + 256 * j; const f32x4 gg = *(const GAS f32x4*)(g + c0); const f32x4 a = *(const LAS f32x4*)(sc + c0), b = *(const LAS f32x4*)(sh + c0);
        const f32x4 y = v[j] * r * gg * (a + 1.f) + b; u32x2 w; w.x = pk2(y.x, y.y); w.y = pk2(y.z, y.w); o8[64 * j] = w; }
}
typedef float f32x16 __attribute__((ext_vector_type(16)));
typedef short s16x8g __attribute__((ext_vector_type(8)));
__device__ __forceinline__ void p1_modulate(Frame& F) {
    LAS float* shs = (LAS float*)(F.lds + RING_OFF + 81920);
    LAS float* gred = (LAS float*)(F.lds + RING_OFF + 98304);
    mod_reduce_lds(F, 0, 2 * D, shs);
    if (F.tid < 64) {
        const float* modp = wsp<float>(F, WS_MODP); float* mod = wsp<float>(F, WS_MOD);
        for (int j = blockIdx.x * 64 + F.tid; j < 16384; j += F.G * 64) { float a = j < 6 * D ? F.in[IN_BADA][j] : F.in[IN_BAF][j - 6 * D];
#pragma unroll
            for (int ks = 0; ks < 32; ++ks) a += modp[ks * 16384 + j];
            mod[j] = a; }
    }
    __syncthreads();
    bf16* hn = wsp<bf16>(F, WS_HN); const bf16* wg = wsp<bf16>(F, WS_WIN) + (size_t)NPP * D; float* gates = wsp<float>(F, WS_GATES);
    const int lane = F.lane, w = F.wave, hi = lane >> 5, l31 = lane & 31;
    for (int rb = F.vcu; rb < S / 32; rb += F.G) {
        const int row0 = rb * 32;
        {
            f32x4 xv[4][8];
#pragma unroll
            for (int i = 0; i < 4; ++i) { const GAS f32x4* xr = (const GAS f32x4*)(F.in[IN_X] + (size_t)(row0 + 4 * w + i) * D) + lane;
#pragma unroll
                for (int j = 0; j < 8; ++j) xv[i][j] = xr[64 * j]; }
#pragma unroll
            for (int i = 0; i < 4; ++i) { float s2 = 0.f;
#pragma unroll
                for (int j = 0; j < 8; ++j) s2 += (xv[i][j].x * xv[i][j].x + xv[i][j].y * xv[i][j].y) + (xv[i][j].z * xv[i][j].z + xv[i][j].w * xv[i][j].w);
                const float r = rsqrtf(wave_sum(s2) * (1.f / D) + 1e-6f);
                GAS u32x2* o8 = (GAS u32x2*)(hn + (size_t)(row0 + 4 * w + i) * D) + lane;
#pragma unroll
                for (int j = 0; j < 8; ++j) { const int c0 = 4 * lane + 256 * j; const f32x4 gg = *(const GAS f32x4*)(F.in[IN_NMIX] + c0); const f32x4 a = *(const LAS f32x4*)(shs + D + c0), b = *(const LAS f32x4*)(shs + c0);
                    const f32x4 y = xv[i][j] * r * gg * (a + 1.f) + b; u32x2 wv; wv.x = pk2(y.x, y.y); wv.y = pk2(y.z, y.w); o8[64 * j] = wv; } }
        }
        asm volatile("s_waitcnt vmcnt(0)" ::: "memory");
        __syncthreads();
        f32x16 acc;
#pragma unroll
        for (int r = 0; r < 16; ++r) acc[r] = 0.f;
        const bf16* ap = hn + (size_t)(row0 + l31) * D + 256 * w + 8 * hi; const bf16* bp = wg + (size_t)l31 * D + 256 * w + 8 * hi;
#pragma unroll
        for (int ks = 0; ks < 16; ++ks) { const s16x8g a = *(const GAS s16x8g*)(ap + 16 * ks), b = *(const GAS s16x8g*)(bp + 16 * ks); acc = __builtin_amdgcn_mfma_f32_32x32x16_bf16(a, b, acc, 0, 0, 0); }
        if (l31 < 16) {
#pragma unroll
            for (int r = 0; r < 16; ++r) gred[(w * 32 + (r & 3) + 8 * (r >> 2) + 4 * hi) * 16 + l31] = acc[r]; }
        __syncthreads();
        { const int row = F.tid >> 4, n = F.tid & 15; float s = 0.f;
#pragma unroll
            for (int q = 0; q < 8; ++q) s += gred[(q * 32 + row) * 16 + n];
            gates[(size_t)(row0 + row) * 16 + n] = s; }
        __syncthreads();
    }
    p1_convert(F);
}
using pg8::Unit; using pg8::cvt_pk_bf16;
struct EpiProj {
    static constexpr bool PERM = true, AFTER_DRAIN = false;
    bf16* O;
    __device__ __forceinline__ void operator()(const pg8::f32x4 (&acc)[2][2][4][2], const Unit& u, int wr, int wc, int fr, int fq) const {
        const int row0 = u.pm * 256 + wr * 64 + fr, col0 = u.pn * 256 + wc * 32 + 8 * fq;
#pragma unroll
        for (int ai = 0; ai < 2; ++ai)
#pragma unroll
            for (int m = 0; m < 4; ++m) { bf16* rowp = O + (size_t)(row0 + ai * 128 + m * 16) * NPP + col0;
#pragma unroll
                for (int bj = 0; bj < 2; ++bj) { const pg8::f32x4 v0 = acc[ai][bj][m][0], v1 = acc[ai][bj][m][1];
                    pg8::u32x4 w; w.x = cvt_pk_bf16(v0[0], v0[1]); w.y = cvt_pk_bf16(v0[2], v0[3]); w.z = cvt_pk_bf16(v1[0], v1[1]); w.w = cvt_pk_bf16(v1[2], v1[3]);
                    *(pg8::u32x4*)(rowp + bj * 128) = w; } }
    }
};
struct EpiOut {
    static constexpr bool PERM = false, AFTER_DRAIN = false;
    const float* x; const float* g1; float* h1;
    __device__ __forceinline__ void operator()(const pg8::f32x4 (&acc)[2][2][4][2], const Unit& u, int wr, int wc, int fr, int fq) const {
        const int row0 = u.pm * 256 + wr * 64 + fr, col0 = u.pn * 256 + wc * 32 + 4 * fq;
        pg8::f32x4 gv[2][2];
#pragma unroll
        for (int bj = 0; bj < 2; ++bj)
#pragma unroll
            for (int n = 0; n < 2; ++n) gv[bj][n] = *(const pg8::f32x4*)(g1 + col0 + bj * 128 + n * 16);
#pragma unroll
        for (int ai = 0; ai < 2; ++ai)
#pragma unroll
            for (int m = 0; m < 4; ++m) { const size_t off = (size_t)(row0 + ai * 128 + m * 16) * D + col0;
#pragma unroll
                for (int bj = 0; bj < 2; ++bj)
#pragma unroll
                    for (int n = 0; n < 2; ++n) { const pg8::f32x4 xv = *(const pg8::f32x4*)(x + off + bj * 128 + n * 16);
                        *(pg8::f32x4*)(h1 + off + bj * 128 + n * 16) = xv + gv[bj][n] * acc[ai][bj][m][n]; } }
    }
};
}
namespace fox {
constexpr int D = 128, SQ = 8192, SKV = 8192; constexpr float THR = 8.f; constexpr bool WSKIP = false;
constexpr int PITCH = 6144;
constexpr int OPITCH = 2048;
constexpr float SCALE = 0.08838834764831845f;
constexpr int NW = 8, QBLK = 32, KVBLK = 64, QB = NW * QBLK;
constexpr int SHM_V = KVBLK * D * 2, SHM_K = KVBLK * D * 2;
constexpr int LDS_BIAS = 2 * SHM_V + 2 * SHM_K + NW * 64 * 4;
constexpr int LDS_BYTES = LDS_BIAS + 512;

using bf16 = __hip_bfloat16;
typedef short bf16x8 __attribute__((ext_vector_type(8)));
typedef short s16x4 __attribute__((ext_vector_type(4)));
typedef float f32x16 __attribute__((ext_vector_type(16)));
typedef float f32x4 __attribute__((ext_vector_type(4)));
typedef unsigned u32x4 __attribute__((ext_vector_type(4)));
template <class A, class Bt> struct same_t { static constexpr bool v = false; };
template <class A> struct same_t<A, A> { static constexpr bool v = true; };

#define KSWZ(row, colB) ((row) * 256 + ((colB) ^ (((row) & 7) << 4)))
#define SBAR() __builtin_amdgcn_sched_barrier(0)
__device__ __forceinline__ int v_st(int k, int c) { const int kk = (k & ~0xC) | ((k & 4) << 1) | ((k & 8) >> 1); return ((kk >> 3) * 4 + (c >> 5)) * 512 + ((kk & 7) * 32 + (c & 31)) * 2; }
__device__ __forceinline__ int v_rd_base(int lane) { return ((lane & 3) << 3) | (((lane >> 2) & 3) << 6) | (((lane >> 4) & 1) << 5) | (((lane >> 5) & 1) << 8); }
constexpr int v_rd_off(int d0, int ks, int half) { return d0 * 512 + ks * 4096 + half * 2048; }
__device__ __forceinline__ int crow(int r, int hi) { return (r & 3) + 8 * (r >> 2) + 4 * hi; }
__device__ __forceinline__ int bias_slot(int kk) { return ((kk >> 2) & 1) * 32 + (kk >> 5) * 16 + (kk & 3) + 4 * ((kk & 31) >> 3); }
__device__ __forceinline__ unsigned cvtpk(float lo, float hi) {
    unsigned r; asm volatile("v_cvt_pk_bf16_f32 %0, %1, %2" : "=v"(r) : "v"(lo), "v"(hi)); return r;
}
__device__ __forceinline__ bf16x8 pack8(f32x4 a, f32x4 b) {
    u32x4 w = {cvtpk(a[0], a[1]), cvtpk(a[2], a[3]), cvtpk(b[0], b[1]), cvtpk(b[2], b[3])};
    return *reinterpret_cast<bf16x8*>(&w);
}
template <class T> __device__ __forceinline__ bf16x8 load8(const T* p) {
    if constexpr (same_t<T, float>::v) { return pack8(*(const f32x4*)p, *(const f32x4*)(p + 4)); }
    else { return *reinterpret_cast<const bf16x8*>(p); }
}
__device__ __forceinline__ void mask_tile(f32x16& p0, f32x16& p1, int dq, unsigned W) {
    const float NEG = -__builtin_inff();
#pragma unroll
    for (int r = 0; r < 16; ++r) {
        const int c = (r & 3) + 8 * (r >> 2);
        if ((unsigned)(dq - c) >= W) p0[r] = NEG;
        if ((unsigned)(dq - c - 32) >= W) p1[r] = NEG;
    }
}
__device__ __forceinline__ void partialSM(f32x16& p0, f32x16& p1, float& m_reg, float& mn, float& alpha) {
    float pmax = p0[0]; for (int r = 1; r < 16; ++r) pmax = fmaxf(pmax, p0[r]); for (int r = 0; r < 16; ++r) pmax = fmaxf(pmax, p1[r]);
    { auto rr = __builtin_amdgcn_permlane32_swap(__float_as_uint(pmax), __float_as_uint(pmax), false, false);
      pmax = fmaxf(__uint_as_float(rr[0]), __uint_as_float(rr[1])); }
    constexpr float C2 = 1.4426950408889634f * SCALE;
    if (__builtin_expect(__all((pmax - m_reg) * SCALE <= THR), 1)) { mn = m_reg; alpha = 1.f; }
    else { mn = fmaxf(m_reg, pmax); alpha = __builtin_amdgcn_exp2f((m_reg - mn) * C2); m_reg = mn; }
    const float mnL = -mn * C2;
    for (int r = 0; r < 16; ++r) p0[r] = fmaf(p0[r], C2, mnL); for (int r = 0; r < 16; ++r) p1[r] = fmaf(p1[r], C2, mnL);
    for (int r = 0; r < 16; ++r) p0[r] = __builtin_amdgcn_exp2f(p0[r]);
}
__device__ __forceinline__ void finishSM(f32x16& p0, f32x16& p1, float alpha, float& l_reg, bf16x8& pa0, bf16x8& pa1, bf16x8& pa2, bf16x8& pa3) {
    for (int r = 0; r < 16; ++r) p1[r] = __builtin_amdgcn_exp2f(p1[r]);
    float ps = 0; for (int r = 0; r < 16; ++r) ps += p0[r]; for (int r = 0; r < 16; ++r) ps += p1[r];
    { auto rr = __builtin_amdgcn_permlane32_swap(__float_as_uint(ps), __float_as_uint(ps), false, false);
      ps = __uint_as_float(rr[0]) + __uint_as_float(rr[1]); }
    l_reg = l_reg * alpha + ps;
#define PK4(P, B_, OUT) do { unsigned a0 = cvtpk(P[B_+0], P[B_+1]), a1 = cvtpk(P[B_+2], P[B_+3]);                          \
        unsigned b0 = cvtpk(P[B_+4], P[B_+5]), b1 = cvtpk(P[B_+6], P[B_+7]);                                             \
        auto r0 = __builtin_amdgcn_permlane32_swap(a0, b0, false, false); auto r1 = __builtin_amdgcn_permlane32_swap(a1, b1, false, false); \
        u32x4 w = {r0[0], r1[0], r0[1], r1[1]}; OUT = *reinterpret_cast<bf16x8*>(&w); } while (0)
    PK4(p0, 0, pa0); PK4(p0, 8, pa1); PK4(p1, 0, pa2); PK4(p1, 8, pa3);
#undef PK4
}
template <int KB, bool SK>
__device__ __forceinline__ void qkt(f32x16& p0, f32x16& p1, const char* K_lds, int r32, int hi, const bf16x8* qr, bool act) {
    if (SK && !act) { const float NEG = -__builtin_inff();
#pragma unroll
        for (int r = 0; r < 16; ++r) { p0[r] = NEG; p1[r] = NEG; } return; }
    { const f32x16* bp = reinterpret_cast<const f32x16*>(K_lds - 2 * SHM_V + LDS_BIAS + KB * 256 + hi * 128); p0 = bp[0]; p1 = bp[1]; }
    const char* kb[4];
#pragma unroll
    for (int dd = 0; dd < 4; ++dd) kb[dd] = K_lds + KB * SHM_K + KSWZ(r32, (dd * 16 + hi * 8) * 2);
#pragma unroll
    for (int d0 = 0; d0 < 8; ++d0) { const char* a = kb[d0 & 3] + (d0 >> 2) * 128;
        bf16x8 b0 = *reinterpret_cast<const bf16x8*>(a);
        bf16x8 b1 = *reinterpret_cast<const bf16x8*>(a + 32 * 256);
        p0 = __builtin_amdgcn_mfma_f32_32x32x16_bf16(b0, qr[d0], p0, 0, 0, 0);
        p1 = __builtin_amdgcn_mfma_f32_32x32x16_bf16(b1, qr[d0], p1, 0, 0, 0); }
}
template <int VB, bool SK>
__device__ __forceinline__ void pv_tile(f32x16* o, int vb0, bf16x8 pa0, bf16x8 pa1, bf16x8 pa2, bf16x8 pa3, bool act) {
    if (SK && !act) return;
#define TRRD(dst, off) asm volatile("ds_read_b64_tr_b16 %0, %1 offset:%2" : "=&v"(dst) : "v"(vb0), "i"(off) : "memory")
#define PV_D0(d0) do { s16x4 l0, l1, l2, l3, h0, h1, h2, h3; constexpr int b_ = VB * SHM_V + v_rd_off(d0, 0, 0);     \
        TRRD(l0, b_); TRRD(h0, b_ + 2048); TRRD(l1, b_ + 4096); TRRD(h1, b_ + 6144); TRRD(l2, b_ + 8192); TRRD(h2, b_ + 10240); TRRD(l3, b_ + 12288); TRRD(h3, b_ + 14336); \
        asm volatile("s_waitcnt lgkmcnt(0)" ::: "memory"); SBAR();                 \
        o[d0] = __builtin_amdgcn_mfma_f32_32x32x16_bf16(pa0, (bf16x8){l0[0], l0[1], l0[2], l0[3], h0[0], h0[1], h0[2], h0[3]}, o[d0], 0, 0, 0);   \
        o[d0] = __builtin_amdgcn_mfma_f32_32x32x16_bf16(pa1, (bf16x8){l1[0], l1[1], l1[2], l1[3], h1[0], h1[1], h1[2], h1[3]}, o[d0], 0, 0, 0);   \
        o[d0] = __builtin_amdgcn_mfma_f32_32x32x16_bf16(pa2, (bf16x8){l2[0], l2[1], l2[2], l2[3], h2[0], h2[1], h2[2], h2[3]}, o[d0], 0, 0, 0);   \
        o[d0] = __builtin_amdgcn_mfma_f32_32x32x16_bf16(pa3, (bf16x8){l3[0], l3[1], l3[2], l3[3], h3[0], h3[1], h3[2], h3[3]}, o[d0], 0, 0, 0); } while (0)
    PV_D0(0); PV_D0(1); PV_D0(2); PV_D0(3);
#undef PV_D0
#undef TRRD
}

template <class TIn, class TOut> struct BlockRef { const TIn* Q; const TIn* K; const TIn* V; TOut* O; int P0; const float* Fb; const float* gain;
    int jlo, jhi;
    float* Op; float* ML; };
template <class TIn> struct Seam {
    bf16x8 qr[8];
    bf16x8 st_v0, st_v1, st_k0, st_k1; f32x4 sf0, sf1, sf2, sf3; float st_b;
    f32x4 tq[16];
};
__device__ __forceinline__ int swa_jlo(int P0, int W) { const int lowk = P0 - W + 1; return lowk > 0 ? lowk / KVBLK : 0; }
#define ROW(p, k0, rr) ((p) + (size_t)((k0) + (rr)) * PITCH + sc)
#define VMW() asm volatile("s_waitcnt vmcnt(0)" ::: "memory")
#define VMWN(n) asm volatile("s_waitcnt vmcnt(%0)" :: "i"(n) : "memory")
#define SLOAD_H(Kp, Vp, k0) SLOAD_HB(Kp, Vp, k0, cur)
#define SLOAD_HB(Kp, Vp, k0, blk) do { S.st_v0 = load8<TIn>(ROW(Vp, k0, sr)); S.st_v1 = load8<TIn>(ROW(Vp, k0, 32 + sr));              \
                         S.st_k0 = load8<TIn>(ROW(Kp, k0, sr)); S.st_k1 = load8<TIn>(ROW(Kp, k0, 32 + sr)); \
                         if (tid < 64) S.st_b = ((blk).Fb[(blk).P0] - (blk).Fb[(k0) + tid]) * (1.0f / SCALE); } while (0)
#define SWRITE_HK(bf) do { *(bf16x8*)(K_lds + (bf) * SHM_K + kws) = S.st_k0; *(bf16x8*)(K_lds + (bf) * SHM_K + kws + 32 * 256) = S.st_k1; \
                         if (tid < 64) *(float*)(K_lds - 2 * SHM_V + LDS_BIAS + (bf) * 256 + bws) = S.st_b; } while (0)
#define SWRITE_HV(bf) do { *(bf16x8*)(V_lds + (bf) * SHM_V + vst0) = S.st_v0; *(bf16x8*)(V_lds + (bf) * SHM_V + vst1) = S.st_v1; } while (0)
#define SWRITE_H(bf) do { SWRITE_HV(bf); SWRITE_HK(bf); } while (0)
#define SLOAD_F(p, k0) do { S.sf0 = *(const f32x4*)ROW(p, k0, sr); S.sf1 = *(const f32x4*)(ROW(p, k0, sr) + 4);                \
                            S.sf2 = *(const f32x4*)ROW(p, k0, 32 + sr); S.sf3 = *(const f32x4*)(ROW(p, k0, 32 + sr) + 4); } while (0)
#define SWRITE_KF(bf) do { *(bf16x8*)(K_lds + (bf) * SHM_K + kws) = pack8(S.sf0, S.sf1); *(bf16x8*)(K_lds + (bf) * SHM_K + kws + 32 * 256) = pack8(S.sf2, S.sf3); } while (0)
#define SWRITE_VF(bf) do { *(bf16x8*)(V_lds + (bf) * SHM_V + vst0) = pack8(S.sf0, S.sf1); *(bf16x8*)(V_lds + (bf) * SHM_V + vst1) = pack8(S.sf2, S.sf3); } while (0)
template <class TIn, class TOut>
__device__ __forceinline__ void causal_swa_prime(const BlockRef<TIn, TOut>& cur, int W, char* lds, Seam<TIn>& S) {
    constexpr bool F32 = same_t<TIn, float>::v;
    const int tid = threadIdx.x, wid = __builtin_amdgcn_readfirstlane(tid >> 6), lane = tid & 63, r32 = lane & 31, hi = lane >> 5;
    const int sr = tid >> 4, sc = (tid & 15) * 8, kws = KSWZ(sr, sc * 2); char* K_lds = lds + 2 * SHM_V;
    const int bws = bias_slot(tid & 63) * 4;
    const int kb0 = cur.jlo * KVBLK;
    for (int d0 = 0; d0 < 8; ++d0) S.qr[d0] = load8<TIn>(cur.Q + (size_t)(wid * QBLK + r32) * PITCH + d0 * 16 + hi * 8);
    if constexpr (F32) { SLOAD_F((const float*)cur.K, kb0); VMW(); SWRITE_KF(0); SBAR(); SLOAD_F((const float*)cur.V, kb0); }
    else { SLOAD_H(cur.K, cur.V, kb0); VMW(); SWRITE_HK(0); }
    __syncthreads();
}
template <class TIn, class TOut>
__device__ __forceinline__ void causal_swa_block(const BlockRef<TIn, TOut>& cur, const BlockRef<TIn, TOut>& nxt, int skv, int W, char* lds, Seam<TIn>& S) {
    constexpr bool F32 = same_t<TIn, float>::v;
    const int tid = threadIdx.x, wid = __builtin_amdgcn_readfirstlane(tid >> 6), lane = tid & 63, r32 = lane & 31, hi = lane >> 5;
    const int j_lo = cur.jlo; const int j_hi = cur.jhi;
    const int NT = j_hi - j_lo;
    const int kbn = nxt.jlo * KVBLK;
    const int qlo = cur.P0 + wid * QBLK, qm = qlo + r32 - 4 * hi;
    char* V_lds = lds; char* K_lds = lds + 2 * SHM_V;
    float* ws = (float*)(lds + 2 * SHM_V + 2 * SHM_K) + wid * 64; float* li_l = ws, * al_l = ws + 32;
    float m_reg = -1e30f, l_reg = 0; f32x16 o[4] = {};
    const int sr = tid >> 4, sc = (tid & 15) * 8, vst0 = v_st(sr, sc), vst1 = v_st(32 + sr, sc), kws = KSWZ(sr, sc * 2);
    const int bws = bias_slot(tid & 63) * 4;
    const int vb0 = (int)(uintptr_t)V_lds + v_rd_base(lane);
    const TIn* Kh = cur.K; const TIn* Vh = cur.V;
#define RESC(a) do { if (__any((a) < 1.f)) { if (hi == 0) al_l[r32] = (a); asm volatile("s_waitcnt lgkmcnt(0)" ::: "memory");              \
                     for (int d_ = 0; d_ < 4; ++d_) for (int r = 0; r < 16; ++r) o[d_][r] *= al_l[crow(r, hi)]; } } while (0)
#define KBASE(t) ((j_lo + (t)) * KVBLK)
#define ACT(t) (KBASE(t) <= qlo + QBLK - 1 && KBASE(t) + KVBLK - 1 >= qlo - W + 1)
#define MASKT(P0_, P1_, t) do { const int kb_ = KBASE(t); if ((!SK || ACT(t)) && (kb_ + KVBLK - 1 > qlo || kb_ <= qlo + QBLK - 1 - W)) mask_tile(P0_, P1_, qm - kb_, (unsigned)W); } while (0)
    constexpr int NQL = F32 ? 16 : 8;
    constexpr bool SK = WSKIP && !F32;
#define SEAM_K0() do { VMWN(NQL); if constexpr (F32) { SWRITE_KF(0); SBAR(); SLOAD_F((const float*)nxt.V, kbn); } else { SWRITE_HK(0); } SBAR(); } while (0)
    f32x16 pA0, pA1, pB0, pB1; float mnA, mnB, alA, alB; bf16x8 pa0, pa1, pa2, pa3;
    if constexpr (F32) { VMW(); SWRITE_VF(0); SBAR(); } else { SWRITE_HV(0); SBAR(); }
    if (NT > 1) { if constexpr (F32) SLOAD_F((const float*)Kh, KBASE(1)); else SLOAD_H(Kh, Vh, KBASE(1)); }
    SBAR(); qkt<0, SK>(pA0, pA1, K_lds, r32, hi, S.qr, ACT(0));
    if constexpr (F32) { if (NT > 1) { VMW(); SWRITE_KF(1); SBAR(); SLOAD_F((const float*)Vh, KBASE(1)); } }
    MASKT(pA0, pA1, 0); partialSM(pA0, pA1, m_reg, mnA, alA);
    if (NT > 1) { VMW(); if constexpr (F32) { SWRITE_VF(1); SBAR(); if (NT > 2) SLOAD_F((const float*)Kh, KBASE(2)); } else SWRITE_H(1); }
    __syncthreads();
#define HALF_STEP(PX0, PX1, mnX, alX, PY0, PY1, alY, t, KB, VB, SB) do {                                                      \
        SBAR(); qkt<KB, SK>(PX0, PX1, K_lds, r32, hi, S.qr, ACT(t));                                             \
        finishSM(PY0, PY1, alY, l_reg, pa0, pa1, pa2, pa3); SBAR();                                                           \
        if ((t) + 1 < NT) { if constexpr (F32) { VMW(); SWRITE_KF(SB); SBAR(); SLOAD_F((const float*)Vh, KBASE((t) + 1)); }  \
                            else { SLOAD_H(Kh, Vh, KBASE((t) + 1)); } SBAR(); }                                               \
        pv_tile<VB, SK>(o, vb0, pa0, pa1, pa2, pa3, ACT((t) - 1)); MASKT(PX0, PX1, (t)); partialSM(PX0, PX1, m_reg, mnX, alX);                                        \
        __syncthreads();                                                                                                      \
        if ((t) + 1 < NT) { VMW(); if constexpr (F32) { SWRITE_VF(SB); SBAR(); if ((t) + 2 < NT) SLOAD_F((const float*)Kh, KBASE((t) + 2)); } \
                            else { SWRITE_H(SB); } }                                                                          \
        RESC(alX); __syncthreads(); } while (0)
    for (int t = 1; t + 1 < NT; t += 2) {
        HALF_STEP(pB0, pB1, mnB, alB, pA0, pA1, alA, t, 1, 0, 0);
        HALF_STEP(pA0, pA1, mnA, alA, pB0, pB1, alB, t + 1, 0, 1, 1);
    }
    const bool even = (NT & 1) == 0;
    if (even) { SBAR(); qkt<1, SK>(pB0, pB1, K_lds, r32, hi, S.qr, ACT(NT - 1)); SBAR(); }
#define QROW(e) (nxt.Q + (size_t)(wid * QBLK + r32) * PITCH + ((e) >> 1) * 16 + hi * 8 + ((e) & 1) * 4)
    if constexpr (F32) { SLOAD_F((const float*)nxt.K, kbn); SBAR();
#pragma unroll
        for (int e = 0; e < 8; ++e) S.tq[e] = *(const f32x4*)QROW(e); }
    else { SLOAD_HB(nxt.K, nxt.V, kbn, nxt); SBAR();
#pragma unroll
        for (int d0 = 0; d0 < 8; ++d0) S.qr[d0] = load8<TIn>(nxt.Q + (size_t)(wid * QBLK + r32) * PITCH + d0 * 16 + hi * 8); }
    SBAR();
    finishSM(pA0, pA1, alA, l_reg, pa0, pa1, pa2, pa3); SBAR();
    if constexpr (F32) {
#pragma unroll
        for (int e = 8; e < 16; ++e) S.tq[e] = *(const f32x4*)QROW(e); SBAR(); }
#undef QROW
    pv_tile<0, SK>(o, vb0, pa0, pa1, pa2, pa3, ACT(even ? NT - 2 : NT - 1));
    if (even) { MASKT(pB0, pB1, NT - 1); partialSM(pB0, pB1, m_reg, mnB, alB); __syncthreads(); RESC(alB);
        finishSM(pB0, pB1, alB, l_reg, pa0, pa1, pa2, pa3); SBAR(); pv_tile<1, SK>(o, vb0, pa0, pa1, pa2, pa3, ACT(NT - 1)); }
    SBAR(); SEAM_K0();
    if (hi == 0) li_l[r32] = l_reg; asm volatile("s_waitcnt lgkmcnt(0)" ::: "memory");
    if (cur.Op != nullptr) {
        int rp = r32; asm volatile("" : "+v"(rp));
        if (hi == 0) { float2 mlv; mlv.x = m_reg; mlv.y = l_reg; *(float2*)(cur.ML + 2 * (wid * QBLK + rp)) = mlv; }
        float* Pr = cur.Op + (size_t)(wid * QBLK + 4 * hi) * D + rp;
#pragma unroll
        for (int r = 0; r < 16; ++r) {
#pragma unroll
            for (int d0 = 0; d0 < 4; ++d0) Pr[d0 * 32] = o[d0][r];
            Pr += ((r & 3) == 3 ? 5 : 1) * D; asm volatile("" : "+v"(Pr) :: "memory"); }
    } else {
    int ro = r32; asm volatile("" : "+v"(ro));
    TOut* Or = cur.O + (size_t)(wid * QBLK + 4 * hi) * OPITCH + ro;
    float gn[4];
#pragma unroll
    for (int d0 = 0; d0 < 4; ++d0) gn[d0] = cur.gain[d0 * 32 + ro];
#pragma unroll
    for (int r = 0; r < 16; ++r) { const int orow = crow(r, hi); const float rl = __builtin_amdgcn_rcpf(li_l[orow]);
        float v[4]; float ss = 0.f;
#pragma unroll
        for (int d0 = 0; d0 < 4; ++d0) { v[d0] = o[d0][r] * rl; ss += v[d0] * v[d0]; }
        ss += __shfl_xor(ss, 1); ss += __shfl_xor(ss, 2); ss += __shfl_xor(ss, 4); ss += __shfl_xor(ss, 8); ss += __shfl_xor(ss, 16);
        const float rn = __builtin_amdgcn_rsqf(ss * (1.0f / 128.0f) + 1e-6f);
#pragma unroll
        for (int d0 = 0; d0 < 4; ++d0) { const float vv = v[d0] * rn * gn[d0]; const float vn = __shfl_xor(vv, 1);
            if ((ro & 1) == 0) *(unsigned*)(Or + d0 * 32) = cvtpk(vv, vn); }
        Or += ((r & 3) == 3 ? 5 : 1) * OPITCH; asm volatile("" : "+v"(Or) :: "memory"); }
    }
    if constexpr (F32) {
#pragma unroll
        for (int d0 = 0; d0 < 8; ++d0) S.qr[d0] = pack8(S.tq[2 * d0], S.tq[2 * d0 + 1]); }
    __syncthreads();
#undef RESC
#undef KBASE
#undef ACT
#undef MASKT
#undef SEAM_K0
#undef HALF_STEP
}
#undef ROW
#undef VMW
#undef VMWN
#undef SLOAD_H
#undef SWRITE_HK
#undef SWRITE_HV
#undef SWRITE_H
#undef SLOAD_F
#undef SWRITE_KF
#undef SWRITE_VF

}
namespace mk {
typedef short s16x8 __attribute__((ext_vector_type(8)));
#define MFMA32(a, b, c) __builtin_amdgcn_mfma_f32_32x32x16_bf16((a), (b), (c), 0, 0, 0)
__device__ __forceinline__ int crow32(int r, int hi) { return (r & 3) + 8 * (r >> 2) + 4 * hi; }
constexpr float SCALEQ = 0.08838834764831845f;
__device__ __forceinline__ float wave_scan_add(float v, int lane) {
#pragma unroll
    for (int o = 1; o < 64; o <<= 1) { const float t = __shfl_up(v, o); if (lane >= o) v += t; }
    return v;
}
__device__ __forceinline__ float wave_scan_max(float v, int lane) {
#pragma unroll
    for (int o = 1; o < 64; o <<= 1) { const float t = __shfl_up(v, o); if (lane >= o) v = fmaxf(v, t); }
    return v;
}
__device__ __forceinline__ float wave_max(float v) {
#pragma unroll
    for (int o = 1; o < 64; o <<= 1) v = fmaxf(v, __shfl_xor(v, o));
    return v;
}
constexpr int TSTR = 72;
template <bool SCALED>
__device__ __forceinline__ void stage_transposed(const bf16* src, int ncols, LAS bf16* T, const LAS float* wl, int tid) {
    const int cpr = ncols / 8;
    for (int q = tid; q < 64 * cpr; q += NTHR) { const int s = q / cpr, c8 = (q % cpr) * 8;
        const v4u raw = *(const GAS v4u*)(src + (size_t)s * NPP + c8);
        const unsigned w4[4] = {raw.x, raw.y, raw.z, raw.w};
#pragma unroll
        for (int j = 0; j < 4; ++j) { unsigned lo = w4[j] & 0xffffu, hi = w4[j] >> 16;
            if (SCALED) { const float sc = wl[s]; lo = f2bf(bf2f((unsigned short)lo) * sc); hi = f2bf(bf2f((unsigned short)hi) * sc); }
            T[(c8 + 2 * j) * TSTR + s] = (bf16)lo; T[(c8 + 2 * j + 1) * TSTR + s] = (bf16)hi; } }
}
__device__ __forceinline__ void p_fscan(Frame& F, int h) {
    const int tid = F.tid, lane = F.lane; const float* gates = wsp<float>(F, WS_GATES);
        const float b = F.in[IN_FOXBF][h]; float* Fo = wsp<float>(F, WS_F) + h * S;
        LAS double* tot = (LAS double*)(F.lds + RING_OFF);
        double loc[16]; double acc = 0.0;
#pragma unroll
        for (int i = 0; i < 16; ++i) { acc += (double)log_sigmoid_f(gates[(size_t)(tid * 16 + i) * 16 + 8 + h] + b); loc[i] = acc; }
        tot[tid] = acc;
        __syncthreads();
        if (F.wave == 0) { double v[8]; double s = 0.0;
#pragma unroll
            for (int i = 0; i < 8; ++i) { v[i] = tot[lane * 8 + i]; s += v[i]; }
            double inc = s;
#pragma unroll
            for (int o = 1; o < 64; o <<= 1) { const double t = __shfl_up(inc, o); if (lane >= o) inc += t; }
            double ex = inc - s;
#pragma unroll
            for (int i = 0; i < 8; ++i) { tot[lane * 8 + i] = ex; ex += v[i]; } }
        __syncthreads();
        const double off = tot[tid];
        LAS float* Fl = (LAS float*)(F.lds + RING_OFF + 8192);
#pragma unroll
        for (int i = 0; i < 16; ++i) { const float fv = (float)(off + loc[i]); Fo[tid * 16 + i] = fv; Fl[tid * 16 + i] = fv; }
        __syncthreads();
        if (tid < 32) {
            float gq = 0.f, gk = 0.f;
#pragma unroll
            for (int j = 0; j < 4; ++j) { gq = fmaxf(gq, fabsf(F.in[IN_FOXQN][tid + 32 * j])); gk = fmaxf(gk, fabsf(F.in[IN_FOXKN][tid + 32 * j])); }
#pragma unroll
            for (int o = 1; o < 32; o <<= 1) { gq = fmaxf(gq, __shfl_xor(gq, o)); gk = fmaxf(gk, __shfl_xor(gk, o)); }
            const float thr = 2.f * 11.3137085f * gq * gk + 26.f;
            const int qb = tid, P0 = qb * 256; const float f0 = Fl[P0];
            int lo = 0, hi2 = 4 * qb;
            while (lo < hi2) { const int mid = (lo + hi2) >> 1; if (Fl[64 * mid + 63] - f0 <= thr) hi2 = mid; else lo = mid + 1; }
            wsp<int>(F, WS_JLO)[h * 32 + qb] = lo;
        }
        __syncthreads();
}
__device__ __forceinline__ void p3_prep(Frame& F) {
    const int gw = F.vcu * NWAVES + F.wave, NGW = F.G * NWAVES, lane = F.lane, tid = F.tid;
    bf16* proj = wsp<bf16>(F, WS_PROJ); const float* gates = wsp<float>(F, WS_GATES);
    {
        const int seg = lane >> 2, qd = (lane & 3) * 32; const float* gn = (seg < 8 ? F.in[IN_FOXQN] : F.in[IN_FOXKN]) + qd;
        for (int m0 = gw; m0 < S; m0 += 4 * NGW) {
            v4u raw[4][4];
#pragma unroll
            for (int i = 0; i < 4; ++i) { const int m = m0 + i * NGW; if (m < S) { const bf16* p = proj + (size_t)m * NPP + C_FQ + seg * 128 + qd;
#pragma unroll
                for (int j = 0; j < 4; ++j) raw[i][j] = *(const GAS v4u*)(p + 8 * j); } }
#pragma unroll
            for (int i = 0; i < 4; ++i) { const int m = m0 + i * NGW; if (m < S) { bf16* p = proj + (size_t)m * NPP + C_FQ + seg * 128 + qd; float x[32]; float ss = 0.f;
#pragma unroll
                for (int j = 0; j < 4; ++j) { const unsigned w4[4] = {raw[i][j].x, raw[i][j].y, raw[i][j].z, raw[i][j].w};
#pragma unroll
                    for (int k = 0; k < 4; ++k) { x[8 * j + 2 * k] = bf2f((unsigned short)(w4[k] & 0xffffu)); x[8 * j + 2 * k + 1] = bf2f((unsigned short)(w4[k] >> 16)); } }
#pragma unroll
                for (int k = 0; k < 32; ++k) ss += x[k] * x[k];
                ss += __shfl_xor(ss, 1); ss += __shfl_xor(ss, 2);
                const float r = rsqrtf(ss * (1.f / 128.f) + 1e-6f);
#pragma unroll
                for (int j = 0; j < 4; ++j) { v4u o; const f32x4 g0 = *(const GAS f32x4*)(gn + 8 * j), g1 = *(const GAS f32x4*)(gn + 8 * j + 4);
                    o.x = pk2(x[8 * j] * r * g0.x, x[8 * j + 1] * r * g0.y); o.y = pk2(x[8 * j + 2] * r * g0.z, x[8 * j + 3] * r * g0.w);
                    o.z = pk2(x[8 * j + 4] * r * g1.x, x[8 * j + 5] * r * g1.y); o.w = pk2(x[8 * j + 6] * r * g1.z, x[8 * j + 7] * r * g1.w);
                    *(GAS v4u*)(p + 8 * j) = o; } } }
        }
    }
    if (F.G != 256 && blockIdx.x < 8) p_fscan(F, (int)blockIdx.x);
    {
        LAS bf16* KT = (LAS bf16*)(F.lds + RING_OFF);
        LAS bf16* VT = KT + 128 * TSTR;
        LAS float* wl = (LAS float*)(VT + 256 * TSTR);
        float* UL = wsp<float>(F, WS_UL); float* NL = wsp<float>(F, WS_NL); float* GLAL = wsp<float>(F, WS_GLAL);
        const int hi = lane >> 5, l31 = lane & 31, w = F.wave;
        for (int u = F.vcu; u < 4 * NCH; u += F.G) {
            const int h = u >> 7, ch = u & 127, t0 = ch * LCH;
            if (w == 0) {
                const float ip = softcap_f(gates[(size_t)(t0 + lane) * 16 + h] + F.in[IN_BI][h]);
                const float fp = softcap_f(gates[(size_t)(t0 + lane) * 16 + 4 + h] + F.in[IN_BF][h]);
                const float g = wave_scan_add(log_sigmoid_f(fp), lane), a = ip - g, amax = wave_max(a);
                wl[lane] = __expf(a - amax);
                if (lane == 63) { GLAL[u * 2] = g; GLAL[u * 2 + 1] = amax; }
            }
            __syncthreads();
            stage_transposed<true>(proj + (size_t)t0 * NPP + C_MK + h * 128, 128, KT, wl, tid);
            stage_transposed<false>(proj + (size_t)t0 * NPP + C_MV + h * 256, 256, VT, wl, tid);
            __syncthreads();
            f32x16 acc[4];
#pragma unroll
            for (int dt = 0; dt < 4; ++dt)
#pragma unroll
                for (int r = 0; r < 16; ++r) acc[dt][r] = 0.f;
#pragma unroll
            for (int ks = 0; ks < 4; ++ks) { const s16x8 a = *(const LAS s16x8*)(VT + (32 * w + l31) * TSTR + 16 * ks + 8 * hi);
#pragma unroll
                for (int dt = 0; dt < 4; ++dt) { const s16x8 b = *(const LAS s16x8*)(KT + (32 * dt + l31) * TSTR + 16 * ks + 8 * hi); acc[dt] = MFMA32(a, b, acc[dt]); } }
            float* ut = UL + (size_t)u * 256 * 128;
#pragma unroll
            for (int dt = 0; dt < 4; ++dt)
#pragma unroll
                for (int r = 0; r < 16; ++r) ut[(size_t)(32 * w + crow32(r, hi)) * 128 + 32 * dt + l31] = acc[dt][r];
            if (tid < 128) { float s = 0.f;
#pragma unroll
                for (int j = 0; j < 8; ++j) { const s16x8 kv = *(const LAS s16x8*)(KT + tid * TSTR + 8 * j);
#pragma unroll
                    for (int i = 0; i < 8; ++i) s += bf2f((unsigned short)kv[i]); }
                NL[u * 128 + tid] = s; }
            __syncthreads();
        }
    }
}
__device__ __forceinline__ void p4_scan(Frame& F) {
    LAS float* gl = (LAS float*)(F.lds + RING_OFF);
    LAS float* dec = gl + 256; LAS float* scl = dec + 128; LAS float* mv = scl + 128;
    const float* UL = wsp<float>(F, WS_UL); const float* NL = wsp<float>(F, WS_NL); const float* GLAL = wsp<float>(F, WS_GLAL);
    bf16* CS = wsp<bf16>(F, WS_CS); float* NS = wsp<float>(F, WS_NS); float* MS = wsp<float>(F, WS_MS);
    const int tid = F.tid;
    for (int blk = F.vcu; blk < 4 * 64; blk += F.G) {
        const int h = blk >> 6, rem0 = (blk & 63) * 512;
        if (tid < 256) gl[tid] = GLAL[h * 256 + tid];
        __syncthreads();
        if (tid == 0) { float m = 0.f;
            for (int c = 0; c < NCH; ++c) { const float g = gl[2 * c], al = gl[2 * c + 1], mn = g + fmaxf(m, al);
                mv[c] = m; dec[c] = __expf(g + m - mn); scl[c] = __expf(g + al - mn); m = mn; } }
        __syncthreads();
        if (rem0 == 0 && tid < 128) MS[h * 128 + tid] = mv[tid];
        const int rem = rem0 + tid;
        const float* ul = UL + (size_t)h * NCH * 32768 + rem; bf16* cs = CS + (size_t)h * NCH * 32768 + rem;
        float C = 0.f;
#pragma unroll 1
        for (int c0 = 0; c0 < NCH; c0 += 64) {
            float u[64];
#pragma unroll
            for (int i = 0; i < 64; ++i) u[i] = ul[(size_t)(c0 + i) * 32768];
#pragma unroll
            for (int i = 0; i < 64; ++i) { cs[(size_t)(c0 + i) * 32768] = (bf16)f2bf(C); C = dec[c0 + i] * C + scl[c0 + i] * u[i]; }
        }
        if (rem0 == 0 && tid < 128) { float n = 0.f; const float* nl = NL + (size_t)h * NCH * 128 + tid; float* ns = NS + (size_t)h * NCH * 128 + tid;
#pragma unroll 8
            for (int c = 0; c < NCH; ++c) { ns[c * 128] = n; n = dec[c] * n + scl[c] * nl[c * 128]; } }
        __syncthreads();
    }
}
constexpr int NUMSTR = 260;
__device__ __forceinline__ void p5_mlstm_out(Frame& F) {
    LAS bf16* VT = (LAS bf16*)(F.lds + RING_OFF);
    LAS bf16* Pm = VT + 256 * TSTR;
    LAS float* NUM = (LAS float*)(Pm + 64 * TSTR);
    LAS float* a_s = NUM + 64 * NUMSTR; LAS float* Mt = a_s + 64; LAS float* inter = Mt + 64; LAS float* emt = inter + 64; LAS float* qn = emt + 64; LAS float* dinv = qn + 64;
    const bf16* proj = wsp<bf16>(F, WS_PROJ); const float* gates = wsp<float>(F, WS_GATES); const bf16* CS = wsp<bf16>(F, WS_CS);
    const float* NS = wsp<float>(F, WS_NS); const float* MS = wsp<float>(F, WS_MS); bf16* concat = wsp<bf16>(F, WS_CONCAT);
    const int tid = F.tid, lane = F.lane, w = F.wave, hi = lane >> 5, l31 = lane & 31;
    for (int u = F.vcu; u < 4 * NCH; u += F.G) {
        const int h = u >> 7, ch = u & 127, t0 = ch * LCH;
        const bf16* qbase = proj + (size_t)t0 * NPP + C_MQ + h * 128; const bf16* kbase = proj + (size_t)t0 * NPP + C_MK + h * 128;
        if (w == 0) {
            const float ip = softcap_f(gates[(size_t)(t0 + lane) * 16 + h] + F.in[IN_BI][h]);
            const float fp = softcap_f(gates[(size_t)(t0 + lane) * 16 + 4 + h] + F.in[IN_BF][h]);
            const float g = wave_scan_add(log_sigmoid_f(fp), lane), a = ip - g, cm = wave_scan_max(a, lane);
            const float mp = MS[u], M = fmaxf(mp, cm);
            a_s[lane] = a; Mt[lane] = M; inter[lane] = __expf(mp - M); emt[lane] = __expf(-(g + M));
        }
        stage_transposed<false>(proj + (size_t)t0 * NPP + C_MV + h * 256, 256, VT, a_s, tid);
        __syncthreads();
        if (w < 4) {
            const int ti = w >> 1, si = w & 1;
            if (si <= ti) {
                s16x8 qa[8], kb[8];
#pragma unroll
                for (int ks = 0; ks < 8; ++ks) { qa[ks] = *(const GAS s16x8*)(qbase + (size_t)(32 * ti + l31) * NPP + 16 * ks + 8 * hi); kb[ks] = *(const GAS s16x8*)(kbase + (size_t)(32 * si + l31) * NPP + 16 * ks + 8 * hi); }
                f32x16 acc;
#pragma unroll
                for (int r = 0; r < 16; ++r) acc[r] = 0.f;
#pragma unroll
                for (int ks = 0; ks < 8; ++ks) acc = MFMA32(qa[ks], kb[ks], acc);
                const int s = 32 * si + l31; const float as = a_s[s];
#pragma unroll
                for (int r = 0; r < 16; ++r) { const int t = 32 * ti + crow32(r, hi); const float p = (s <= t) ? acc[r] * SCALEQ * __expf(as - Mt[t]) : 0.f; Pm[t * TSTR + s] = (bf16)f2bf(p); }
            } else {
#pragma unroll
                for (int r = 0; r < 16; ++r) Pm[(32 * ti + crow32(r, hi)) * TSTR + 32 * si + l31] = (bf16)0;
            }
        } else {
            const int t = (tid - 256) >> 2, d0 = ((tid - 256) & 3) * 32; float s = 0.f; const float* np = NS + (size_t)u * 128 + d0;
#pragma unroll
            for (int j = 0; j < 4; ++j) { const s16x8 qv = *(const GAS s16x8*)(qbase + (size_t)t * NPP + d0 + 8 * j);
#pragma unroll
                for (int i = 0; i < 8; ++i) s += bf2f((unsigned short)qv[i]) * np[8 * j + i]; }
            s += __shfl_xor(s, 1); s += __shfl_xor(s, 2);
            if ((tid & 3) == 0) qn[t] = s * SCALEQ;
        }
        __syncthreads();
        f32x16 accP[2], accC[2];
#pragma unroll
        for (int ti = 0; ti < 2; ++ti)
#pragma unroll
            for (int r = 0; r < 16; ++r) { accP[ti][r] = 0.f; accC[ti][r] = 0.f; }
        {
            const bf16* cs = CS + (size_t)u * 32768 + (size_t)(32 * w + l31) * 128 + 8 * hi;
            s16x8 cb[8];
#pragma unroll
            for (int ks = 0; ks < 8; ++ks) cb[ks] = *(const GAS s16x8*)(cs + 16 * ks);
#pragma unroll
            for (int ti = 0; ti < 2; ++ti) {
                s16x8 qa[8];
#pragma unroll
                for (int ks = 0; ks < 8; ++ks) qa[ks] = *(const GAS s16x8*)(qbase + (size_t)(32 * ti + l31) * NPP + 16 * ks + 8 * hi);
#pragma unroll
                for (int ks = 0; ks < 8; ++ks) accC[ti] = MFMA32(qa[ks], cb[ks], accC[ti]);
            }
#pragma unroll
            for (int ks = 0; ks < 4; ++ks) { const s16x8 vb = *(const LAS s16x8*)(VT + (32 * w + l31) * TSTR + 16 * ks + 8 * hi);
#pragma unroll
                for (int ti = 0; ti < 2; ++ti) { const s16x8 pa = *(const LAS s16x8*)(Pm + (32 * ti + l31) * TSTR + 16 * ks + 8 * hi); accP[ti] = MFMA32(pa, vb, accP[ti]); } }
        }
        if (w == 0) {
            float rs = 0.f;
#pragma unroll
            for (int j = 0; j < 8; ++j) { const s16x8 pv = *(const LAS s16x8*)(Pm + lane * TSTR + 8 * j);
#pragma unroll
                for (int i = 0; i < 8; ++i) rs += bf2f((unsigned short)pv[i]); }
            const float dn = rs + inter[lane] * qn[lane];
            dinv[lane] = 1.f / fmaxf(fabsf(dn), emt[lane]);
        }
        __syncthreads();
#pragma unroll
        for (int ti = 0; ti < 2; ++ti)
#pragma unroll
            for (int r = 0; r < 16; ++r) { const int t = 32 * ti + crow32(r, hi); NUM[t * NUMSTR + 32 * w + l31] = (accP[ti][r] + inter[t] * SCALEQ * accC[ti][r]) * dinv[t]; }
        __syncthreads();
        {
            const f32x4 gn = *(const GAS f32x4*)(F.in[IN_MOUTN] + h * 256 + 4 * lane);
#pragma unroll
            for (int i = 0; i < 8; ++i) { const int t = 8 * w + i; const f32x4 x = *(const LAS f32x4*)(NUM + t * NUMSTR + 4 * lane);
                const float ss = wave_sum((x.x * x.x + x.y * x.y) + (x.z * x.z + x.w * x.w)); const float r = rsqrtf(ss * (1.f / 256.f) + 1e-6f);
                const u32x2 mo = *(const GAS u32x2*)(proj + (size_t)(t0 + t) * NPP + C_MO + h * 256 + 4 * lane);
                const float o0 = x.x * r * gn.x * sigmoid_f(bf2f((unsigned short)(mo.x & 0xffffu))), o1 = x.y * r * gn.y * sigmoid_f(bf2f((unsigned short)(mo.x >> 16)));
                const float o2 = x.z * r * gn.z * sigmoid_f(bf2f((unsigned short)(mo.y & 0xffffu))), o3 = x.w * r * gn.w * sigmoid_f(bf2f((unsigned short)(mo.y >> 16)));
                u32x2 ov; ov.x = pk2(o0, o1); ov.y = pk2(o2, o3);
                *(GAS u32x2*)(concat + (size_t)(t0 + t) * D + h * 256 + 4 * lane) = ov; }
        }
        __syncthreads();
    }
}
}
namespace mk {
__device__ __forceinline__ void attn_build_schedule(Frame& F) {
    LAS int* jl = (LAS int*)(F.lds + TAB_OFF); LAS int* pre = jl + 256; LAS int* wtot = pre + 260;
    const int tid = F.tid, lane = F.lane;
    if (tid < 256) { const int j = wsp<int>(F, WS_JLO)[tid]; jl[tid] = j; const int n = 4 * (tid & 31) + 4 - j; int v = (n + ATT_CH - 1) / ATT_CH;
        int inc = v;
#pragma unroll
        for (int o = 1; o < 64; o <<= 1) { const int t = __shfl_up(inc, o); if (lane >= o) inc += t; }
        pre[tid + 1] = inc; if (lane == 63) wtot[tid >> 6] = inc; }
    __syncthreads();
    if (tid < 256) { int add = 0; for (int w2 = 0; w2 < (tid >> 6); ++w2) add += wtot[w2]; pre[tid + 1] += add; if (tid == 0) pre[0] = 0; }
    __syncthreads();
}
__device__ __forceinline__ fox::BlockRef<fox::bf16, fox::bf16> fox_ref(const Frame& F, int I) {
    const LAS int* jl = (const LAS int*)(F.lds + TAB_OFF); const LAS int* pre = jl + 256;
    int b = 0;
#pragma unroll
    for (int st = 128; st >= 1; st >>= 1) if (pre[b + st] <= I) b += st;
    b = __builtin_amdgcn_readfirstlane(b);
    const int pb0 = __builtin_amdgcn_readfirstlane(pre[b]), pb1 = __builtin_amdgcn_readfirstlane(pre[b + 1]), j0 = __builtin_amdgcn_readfirstlane(jl[b]);
    const int h = b >> 5, qb = b & 31, part = I - pb0, P = pb1 - pb0, n = 4 * qb + 4 - j0;
    fox::BlockRef<fox::bf16, fox::bf16> r;
    const fox::bf16* proj = (const fox::bf16*)(F.ws + WS_PROJ);
    r.Q = proj + (size_t)(qb * 256) * fox::PITCH + C_FQ + h * 128; r.K = proj + C_FK + h * 128; r.V = proj + C_FV + h * 128;
    r.O = (fox::bf16*)(F.ws + WS_CONCAT) + (size_t)(qb * 256) * D + 1024 + h * 128; r.P0 = qb * 256;
    r.Fb = (const float*)(F.ws + WS_F) + h * S; r.gain = F.in[IN_FOUTN] + h * 128;
    r.jlo = j0 + (part * n) / P; r.jhi = j0 + ((part + 1) * n) / P;
    r.Op = P > 1 ? (float*)(F.ws + WS_OPART) + (size_t)I * 256 * 128 : nullptr; r.ML = (float*)(F.ws + WS_MLP) + (size_t)I * 512;
    return r;
}
__device__ __forceinline__ void p5_attention(Frame& F, char* ldsg) {
    typedef fox::BlockRef<fox::bf16, fox::bf16> BR;
    attn_build_schedule(F);
    const int total = __builtin_amdgcn_readfirstlane(((const LAS int*)(F.lds + TAB_OFF))[256 + 256]);
    int L = F.vcu; if (L >= total) return;
    BR cur = fox_ref(F, L);
    fox::Seam<fox::bf16> Sm;
    fox::causal_swa_prime<fox::bf16, fox::bf16>(cur, S, ldsg, Sm);
    for (;;) {
        const bool more = L + F.G < total;
        const BR nxt = more ? fox_ref(F, L + F.G) : cur;
        fox::causal_swa_block<fox::bf16, fox::bf16>(cur, nxt, S, S, ldsg, Sm);
        if (!more) break;
        cur = nxt; L += F.G;
    }
}
__device__ __forceinline__ void p6_combine(Frame& F) {
    attn_build_schedule(F);
    const LAS int* pre = (const LAS int*)(F.lds + TAB_OFF) + 256;
    const float* OP = wsp<float>(F, WS_OPART); const float* MLP = wsp<float>(F, WS_MLP); bf16* concat = wsp<bf16>(F, WS_CONCAT);
    const int gw = F.vcu * NWAVES + F.wave, NGW = F.G * NWAVES, lane = F.lane;
    constexpr float C2 = 1.4426950408889634f * SCALEQ;
    for (int idx = gw; idx < 256 * 256; idx += NGW) {
        const int b = idx >> 8, r = idx & 255, i0 = __builtin_amdgcn_readfirstlane(pre[b]), P = __builtin_amdgcn_readfirstlane(pre[b + 1]) - i0; if (P <= 1) continue;
        const int h = b >> 5, qb = b & 31;
        f32x2 ml[8], ov[8];
#pragma unroll
        for (int p2 = 0; p2 < 8; ++p2) if (p2 < P) { ml[p2] = *(const GAS f32x2*)(MLP + (size_t)(i0 + p2) * 512 + 2 * r); ov[p2] = *(const GAS f32x2*)(OP + ((size_t)(i0 + p2) * 256 + r) * 128 + 2 * lane); }
        float ms = -3.0e38f;
#pragma unroll
        for (int p2 = 0; p2 < 8; ++p2) if (p2 < P) ms = fmaxf(ms, ml[p2].x);
        float n0 = 0.f, n1 = 0.f, den = 0.f;
#pragma unroll
        for (int p2 = 0; p2 < 8; ++p2) if (p2 < P) { const float wgt = __builtin_amdgcn_exp2f((ml[p2].x - ms) * C2); n0 += wgt * ov[p2].x; n1 += wgt * ov[p2].y; den += wgt * ml[p2].y; }
        const float inv = 1.f / den, v0 = n0 * inv, v1 = n1 * inv;
        const float ss = wave_sum(v0 * v0 + v1 * v1), rn = rsqrtf(ss * (1.f / 128.f) + 1e-6f);
        const f32x2 gn = *(const GAS f32x2*)(F.in[IN_FOUTN] + h * 128 + 2 * lane);
        *(GAS unsigned*)(concat + (size_t)(qb * 256 + r) * D + 1024 + h * 128 + 2 * lane) = pk2(v0 * rn * gn.x, v1 * rn * gn.y);
    }
}
constexpr int RROWS = 8, NITER = S / RROWS;
__device__ __forceinline__ void p7_router(Frame& F) {
    LAS float* shs = (LAS float*)(F.lds + RING_OFF);
    constexpr int HSTR = 2064;
    LAS bf16* H2hi = (LAS bf16*)(shs + 2 * D);
    LAS bf16* H2lo = H2hi + RROWS * HSTR;
    LAS float* red = (LAS float*)(H2lo + RROWS * HSTR);
    LAS int* selE = (LAS int*)(red + 8 * RROWS * NE);
    const float* mod = wsp<float>(F, WS_MOD); const float* h1 = wsp<float>(F, WS_H1); unsigned char* h2 = wsp<unsigned char>(F, WS_HN);
    int* top_i = wsp<int>(F, WS_TOPI); float* top_w = wsp<float>(F, WS_TOPW); int* hist = wsp<int>(F, WS_HIST); int* lrank = wsp<int>(F, WS_LRANK);
    const int tid = F.tid, lane = F.lane, w = F.wave;
    for (int i = tid; i < 2 * D; i += NTHR) shs[i] = mod[3 * D + i];
    __syncthreads();
    s16x8 whi[16], wlo[16];
    { const int hh = lane >> 5; const float* wp = F.in[IN_WR] + (size_t)(256 * w + 8 * hh) * NE + (lane & 31);
#pragma unroll
        for (int ks = 0; ks < 16; ++ks) { float wv[8];
#pragma unroll
            for (int j = 0; j < 8; ++j) wv[j] = wp[(size_t)(16 * ks + j) * NE];
            unsigned hw[4], lw[4];
#pragma unroll
            for (int j = 0; j < 4; ++j) { const unsigned a = f2bf(wv[2 * j]), b = f2bf(wv[2 * j + 1]); hw[j] = a | (b << 16); lw[j] = pk2(wv[2 * j] - bf2f((unsigned short)a), wv[2 * j + 1] - bf2f((unsigned short)b)); }
            const v4u hv4 = {hw[0], hw[1], hw[2], hw[3]}, lv4 = {lw[0], lw[1], lw[2], lw[3]};
            whi[ks] = __builtin_bit_cast(s16x8, hv4); wlo[ks] = __builtin_bit_cast(s16x8, lv4); } }
    for (int it = F.vcu; it < NITER; it += F.G) {
        const int r0 = it * RROWS;
        {
            const int m = r0 + w; const GAS f32x4* xr = (const GAS f32x4*)(h1 + (size_t)m * D) + lane; f32x4 v[8]; float s2 = 0.f;
#pragma unroll
            for (int j = 0; j < 8; ++j) { v[j] = xr[64 * j]; s2 += (v[j].x * v[j].x + v[j].y * v[j].y) + (v[j].z * v[j].z + v[j].w * v[j].w); }
            const float r = rsqrtf(wave_sum(s2) * (1.f / D) + 1e-6f);
            GAS unsigned* o8 = (GAS unsigned*)(h2 + (size_t)m * D) + lane;
#pragma unroll
            for (int j = 0; j < 8; ++j) { const int c0 = 4 * lane + 256 * j; const f32x4 gg = *(const GAS f32x4*)(F.in[IN_NFFN] + c0); const f32x4 a = *(const LAS f32x4*)(shs + D + c0), b = *(const LAS f32x4*)(shs + c0);
                const f32x4 y = v[j] * r * gg * (a + 1.f) + b; o8[64 * j] = pk4_fp8(y.x, y.y, y.z, y.w);
                const unsigned h0 = pk2(y.x, y.y), h1w = pk2(y.z, y.w); u32x2 hv; hv.x = h0; hv.y = h1w;
                u32x2 lv; lv.x = pk2(y.x - bf2f((unsigned short)(h0 & 0xffffu)), y.y - bf2f((unsigned short)(h0 >> 16))); lv.y = pk2(y.z - bf2f((unsigned short)(h1w & 0xffffu)), y.w - bf2f((unsigned short)(h1w >> 16)));
                *(LAS u32x2*)(H2hi + w * HSTR + c0) = hv; *(LAS u32x2*)(H2lo + w * HSTR + c0) = lv; }
        }
        __syncthreads();
        {
            f32x16 acc;
#pragma unroll
            for (int r = 0; r < 16; ++r) acc[r] = 0.f;
            const int hh = lane >> 5; const LAS bf16* bh = H2hi + (lane & 7) * HSTR + 256 * w + 8 * hh; const LAS bf16* bl = H2lo + (lane & 7) * HSTR + 256 * w + 8 * hh;
#pragma unroll
            for (int ks = 0; ks < 16; ++ks) { const s16x8 xh = *(const LAS s16x8*)(bh + 16 * ks), xl = *(const LAS s16x8*)(bl + 16 * ks);
                acc = MFMA32(whi[ks], xh, acc); acc = MFMA32(whi[ks], xl, acc); acc = MFMA32(wlo[ks], xh, acc); }
            if ((lane & 31) < RROWS) {
#pragma unroll
                for (int r = 0; r < 16; ++r) red[(w * RROWS + (lane & 31)) * NE + crow32(r, hh)] = acc[r]; }
        }
        __syncthreads();
        if (tid < RROWS * NE) {
            const int r = tid >> 5, e = tid & 31; float lg = F.in[IN_BR][e];
#pragma unroll
            for (int kp = 0; kp < 8; ++kp) lg += red[(kp * RROWS + r) * NE + e];
            float cur = lg, mx = 0.f, sum = 0.f, mysel = 0.f; int myidx = 0;
#pragma unroll
            for (int q = 0; q < 4; ++q) { float best = cur; int bi = e;
#pragma unroll
                for (int o = 1; o < 32; o <<= 1) { const float ob = __shfl_xor(best, o); const int oi = __shfl_xor(bi, o); if (ob > best || (ob == best && oi < bi)) { best = ob; bi = oi; } }
                if (q == 0) mx = best;
                sum += __expf(best - mx);
                if (e == q) { mysel = best; myidx = bi; }
                if (e == bi) cur = -3.0e38f; }
            if (e < 4) { const int t = r0 + r; top_i[t * 4 + e] = myidx; top_w[t * 4 + e] = __expf(mysel - mx) / sum; selE[r * 4 + e] = myidx; }
        }
        __syncthreads();
        if (tid < 32) { const int me = selE[tid]; int rank = 0, cnt = 0;
#pragma unroll
            for (int p = 0; p < 32; ++p) { const int ep = selE[p]; rank += (ep == me && p < tid) ? 1 : 0; cnt += (ep == tid) ? 1 : 0; }
            lrank[it * 32 + tid] = rank; hist[it * NE + tid] = cnt; }
        __syncthreads();
    }
}
__device__ __forceinline__ void build_expert_table(Frame& F, const int* counts_g) {
    LAS int* tab = (LAS int*)(F.lds + TAB_OFF);
    if (F.tid < 64) {
        const int lane = F.tid, c = lane < NE ? counts_g[lane] : 0, nt = (c + 255) >> 8; int inc = nt;
#pragma unroll
        for (int o = 1; o < 64; o <<= 1) { const int t = __shfl_up(inc, o); if (lane >= o) inc += t; }
        if (lane < NE) { tab[lane] = inc - nt; tab[40 + lane] = c; }
        if (lane == NE - 1) tab[32] = inc; }
    __syncthreads();
}
__device__ __forceinline__ void p8_gather(Frame& F) {
    LAS unsigned short* loc = (LAS unsigned short*)(F.lds + RING_OFF);
    LAS int* psum = (LAS int*)(F.lds + RING_OFF + 65536);
    LAS int* startr = psum + 16 * NE;
    const int* hist = wsp<int>(F, WS_HIST); const int* lrank = wsp<int>(F, WS_LRANK); const int* top_i = wsp<int>(F, WS_TOPI); const float* top_w = wsp<float>(F, WS_TOPW);
    int* pos = wsp<int>(F, WS_POS); float* roww = wsp<float>(F, WS_ROWW); const unsigned char* h2 = wsp<unsigned char>(F, WS_HN); unsigned char* xg = wsp<unsigned char>(F, WS_XG);
    int* counts_g = (int*)(F.ws + WS_POS) + S * 4;
    const int tid = F.tid, lane = F.lane, w = F.wave;
    { const int e = tid & 31, part = tid >> 5; int hv[64];
#pragma unroll
        for (int i = 0; i < 64; ++i) hv[i] = hist[(part * 64 + i) * NE + e];
        int s = 0;
#pragma unroll
        for (int i = 0; i < 64; ++i) { loc[(part * 64 + i) * NE + e] = (unsigned short)s; s += hv[i]; }
        psum[part * NE + e] = s; }
    __syncthreads();
    if (tid < 64) { int tot = 0;
        if (tid < NE) {
#pragma unroll
            for (int p = 0; p < 16; ++p) { const int v = psum[p * NE + tid]; psum[p * NE + tid] = tot; tot += v; } }
        const int padded = ((tot + 255) >> 8) << 8; int inc = padded;
#pragma unroll
        for (int o = 1; o < 64; o <<= 1) { const int t = __shfl_up(inc, o); if (lane >= o) inc += t; }
        if (tid < NE) { startr[tid] = inc - padded; if (blockIdx.x == 0) counts_g[tid] = tot; } }
    __syncthreads();
    for (int itb = F.vcu; itb < NITER; itb += 4 * F.G) {
        const int pi = 16 * w + (lane & 15), it = itb + (pi >> 5) * F.G; const bool valid = it < NITER;
        int dest = 0, tok = 0;
        if (valid) { const int pair = it * 32 + (pi & 31), e = top_i[pair]; dest = startr[e] + psum[(it >> 6) * NE + e] + (int)loc[it * NE + e] + lrank[pair]; tok = pair >> 2;
            if (lane < 16) { pos[pair] = dest; roww[dest] = top_w[pair]; } }
        v4u buf[16][2];
#pragma unroll
        for (int j = 0; j < 16; ++j) { const int tj = __builtin_amdgcn_readlane(tok, j); const GAS v4u* src = (const GAS v4u*)(h2 + (size_t)tj * D) + lane; buf[j][0] = src[0]; buf[j][1] = src[64]; }
#pragma unroll
        for (int j = 0; j < 16; ++j) { const int dj = __builtin_amdgcn_readlane(dest, j); const bool vj = __builtin_amdgcn_readlane((int)valid, j) != 0;
            if (vj) { GAS v4u* dst = (GAS v4u*)(xg + (size_t)dj * D) + lane; dst[0] = buf[j][0]; dst[64] = buf[j][1]; } }
    }
}
struct GroupedOrder {
    const LAS int* tab; int ntn, G, c;
    __device__ __forceinline__ bool next(int i, Unit& u) const {
        const int L0 = i * G + c, total = tab[32] * ntn; if (L0 >= total) return false;
        int L; { const int qq = total / pg8::NXCD, rr = total % pg8::NXCD, xcd = L0 % pg8::NXCD, off = L0 / pg8::NXCD; L = (xcd < rr ? xcd * (qq + 1) : rr * (qq + 1) + (xcd - rr) * qq) + off; }
        int e = (u.e > 0 && u.e < NE && tab[u.e] * ntn <= L) ? u.e : 0;
#pragma unroll 1
        while (e < NE - 1 && tab[e + 1] * ntn <= L) ++e;
        const int ts = tab[e], tc = tab[e + 1] - ts, within = L - ts * ntn;
        u.pm = ts + within % tc; u.pn = within / tc; u.e = e; u.pb = e * ntn + u.pn; return true;
    }
    __device__ __forceinline__ void a_ready(const Unit&) const {}
    __device__ __forceinline__ void done(const Unit&) const {}
};
struct EpiSwiglu {
    static constexpr bool PERM = true, AFTER_DRAIN = false;
    unsigned char* act; const float* bug;
    __device__ __forceinline__ void operator()(const pg8::f32x4 (&acc)[2][2][4][2], const Unit& u, int wr, int wc, int fr, int fq) const {
        const int row0 = u.pm * 256 + wr * 64 + fr, f0 = u.pn * 128 + wc * 32 + 8 * fq;
        const float* bg = bug + (size_t)u.e * 4096 + f0; pg8::f32x4 bgv[2], buv[2];
#pragma unroll
        for (int n = 0; n < 2; ++n) { bgv[n] = *(const pg8::f32x4*)(bg + 4 * n); buv[n] = *(const pg8::f32x4*)(bg + 2048 + 4 * n); }
#pragma unroll
        for (int ai = 0; ai < 2; ++ai)
#pragma unroll
            for (int m = 0; m < 4; ++m) { float o[8];
#pragma unroll
                for (int n = 0; n < 2; ++n)
#pragma unroll
                    for (int i = 0; i < 4; ++i) { const float g = fminf(acc[ai][0][m][n][i] + bgv[n][i], 7.f); const float up = fminf(fmaxf(acc[ai][1][m][n][i] + buv[n][i], -7.f), 7.f);
                        o[4 * n + i] = (up + 1.f) * g * __builtin_amdgcn_rcpf(1.f + __builtin_amdgcn_exp2f(-2.45546696f * g)); }
                u32x2 wv; wv.x = pk4_fp8(o[0], o[1], o[2], o[3]); wv.y = pk4_fp8(o[4], o[5], o[6], o[7]);
                *(u32x2*)(act + (size_t)(row0 + ai * 128 + m * 16) * FF + f0) = wv; }
    }
};
struct EpiDown {
    static constexpr bool PERM = true, AFTER_DRAIN = false;
    bf16* y; const float* bd; const float* roww;
    __device__ __forceinline__ void operator()(const pg8::f32x4 (&acc)[2][2][4][2], const Unit& u, int wr, int wc, int fr, int fq) const {
        const int row0 = u.pm * 256 + wr * 64 + fr, col0 = u.pn * 256 + wc * 32 + 8 * fq;
        pg8::f32x4 bv[2][2];
#pragma unroll
        for (int bj = 0; bj < 2; ++bj)
#pragma unroll
            for (int n = 0; n < 2; ++n) bv[bj][n] = *(const pg8::f32x4*)(bd + (size_t)u.e * D + col0 + bj * 128 + 4 * n);
#pragma unroll
        for (int ai = 0; ai < 2; ++ai)
#pragma unroll
            for (int m = 0; m < 4; ++m) { const int row = row0 + ai * 128 + m * 16; const float rw = roww[row]; bf16* rowp = y + (size_t)row * D + col0;
#pragma unroll
                for (int bj = 0; bj < 2; ++bj) { const pg8::f32x4 v0 = (acc[ai][bj][m][0] + bv[bj][0]) * rw, v1 = (acc[ai][bj][m][1] + bv[bj][1]) * rw;
                    pg8::u32x4 wv; wv.x = cvt_pk_bf16(v0[0], v0[1]); wv.y = cvt_pk_bf16(v0[2], v0[3]); wv.z = cvt_pk_bf16(v1[0], v1[1]); wv.w = cvt_pk_bf16(v1[2], v1[3]);
                    *(pg8::u32x4*)(rowp + bj * 128) = wv; } }
    }
};
__device__ __forceinline__ void p11_final(Frame& F, float oscale) {
    LAS float* ms = (LAS float*)(F.lds + RING_OFF);
    const float* mod = wsp<float>(F, WS_MOD);
    for (int i = F.tid; i < 3 * D; i += NTHR) ms[i] = mod[5 * D + i];
    __syncthreads();
    const float* h1 = wsp<float>(F, WS_H1); const bf16* y = wsp<bf16>(F, WS_Y); const int* pos = wsp<int>(F, WS_POS);
    const int gw = F.vcu * NWAVES + F.wave, NGW = F.G * NWAVES, lane = F.lane;
    for (int t = gw; t < S; t += NGW) {
        asm volatile("" ::: "memory");
        const GAS f32x4* xr = (const GAS f32x4*)(h1 + (size_t)t * D) + lane;
        const GAS u32x2* y0 = (const GAS u32x2*)(y + (size_t)pos[t * 4 + 0] * D) + lane; const GAS u32x2* y1 = (const GAS u32x2*)(y + (size_t)pos[t * 4 + 1] * D) + lane;
        const GAS u32x2* y2 = (const GAS u32x2*)(y + (size_t)pos[t * 4 + 2] * D) + lane; const GAS u32x2* y3 = (const GAS u32x2*)(y + (size_t)pos[t * 4 + 3] * D) + lane;
        f32x4 v[8]; float s2 = 0.f;
#pragma unroll
        for (int j = 0; j < 8; ++j) { const u32x2 a = y0[64 * j], b = y1[64 * j], c = y2[64 * j], d = y3[64 * j]; const f32x4 g2 = *(const LAS f32x4*)(ms + 4 * lane + 256 * j);
            f32x4 f;
            f.x = (bf2f((unsigned short)(a.x & 0xffffu)) + bf2f((unsigned short)(b.x & 0xffffu))) + (bf2f((unsigned short)(c.x & 0xffffu)) + bf2f((unsigned short)(d.x & 0xffffu)));
            f.y = (bf2f((unsigned short)(a.x >> 16)) + bf2f((unsigned short)(b.x >> 16))) + (bf2f((unsigned short)(c.x >> 16)) + bf2f((unsigned short)(d.x >> 16)));
            f.z = (bf2f((unsigned short)(a.y & 0xffffu)) + bf2f((unsigned short)(b.y & 0xffffu))) + (bf2f((unsigned short)(c.y & 0xffffu)) + bf2f((unsigned short)(d.y & 0xffffu)));
            f.w = (bf2f((unsigned short)(a.y >> 16)) + bf2f((unsigned short)(b.y >> 16))) + (bf2f((unsigned short)(c.y >> 16)) + bf2f((unsigned short)(d.y >> 16)));
            v[j] = xr[64 * j] + g2 * f; s2 += (v[j].x * v[j].x + v[j].y * v[j].y) + (v[j].z * v[j].z + v[j].w * v[j].w); }
        const float r = rsqrtf(wave_sum(s2) * (1.f / D) + 1e-6f);
        GAS f32x4* o = (GAS f32x4*)(F.out + (size_t)t * D) + lane;
#pragma unroll
        for (int j = 0; j < 8; ++j) { const int c0 = 4 * lane + 256 * j; const f32x4 gg = *(const GAS f32x4*)(F.in[IN_NFIN] + c0); const f32x4 sh = *(const LAS f32x4*)(ms + D + c0), sc = *(const LAS f32x4*)(ms + 2 * D + c0);
            o[64 * j] = (v[j] * r * gg * (sc + 1.f) + sh) * oscale; }
    }
}
}
namespace mk {
struct Args { const float* in[24]; float* out; unsigned char* ws; int ph_lo, ph_hi, li, pad; };
constexpr int N_PHASES = 13;
__global__ void __launch_bounds__(NTHR, 2) mega_fwd(Args args) {
    extern __shared__ __attribute__((aligned(16))) unsigned char lds[];
    Frame F;
    F.lds = (LAS unsigned char*)lds;
    F.MISC = (volatile LAS unsigned*)(F.lds + MISC_OFF);
    F.tid = threadIdx.x; F.lane = F.tid & 63; F.wave = __builtin_amdgcn_readfirstlane(F.tid >> 6);
    leave_group(F);
    F.ws = args.ws; F.out = args.out; F.ctl = (gu32*)(args.ws + WS_CTL);
#pragma unroll
    for (int i = 0; i < 24; ++i) F.in[i] = args.in[i];
    for (int u = F.tid; u < (LDS_BYTES - LDSCTL_OFF) / 4; u += NTHR) ((LAS unsigned*)(F.lds + LDSCTL_OFF))[u] = 0u;
    __syncthreads();
    XcdBarrier bar = xcd_barrier_post((unsigned*)(F.ctl + CW_BAR) + args.li * XCD_BAR_WORDS, F.MISC + 8);
    const int lo = args.ph_lo, hi = args.ph_hi;
#define IN(k) (lo <= (k) && (k) < hi)
#define SEAM(k) do { if (IN(k) && IN((k) + 1)) xcd_barrier(bar); } while (0)

#ifndef MK_DOUBLE
#define MK_DOUBLE 0
#endif
#define DBL(k) ((MK_DOUBLE >> (k)) & 1)
#ifdef MK_PROBE_LO
    unsigned long long* stamps = (unsigned long long*)(F.ctl + 131072);
#define STAMP(k) do { if (blockIdx.x == 0 && F.tid == 0) stamps[k] = rt(); } while (0)
#define PROBE_SCALE() (1.f + sqrtf((float)(stamps[MK_PROBE_HI] - stamps[MK_PROBE_LO]) * 0.01f * 2e-5f))
#else
#define STAMP(k) do { } while (0)
#define PROBE_SCALE() 1.f
#endif
    STAMP(0); if (IN(0)) { p0_gemv(F); } SEAM(0);
    STAMP(1); if (IN(1)) { p1_modulate(F); if (DBL(1)) p1_modulate(F); } SEAM(1);
    STAMP(2); if (IN(2)) {
        gu32* done = F.ctl + CW_DONE + 64 * 2;
        if (enter_group(F, GC_INPROJ)) {
            pg8::Gemm g{wsp<pg8::bf16_t>(F, WS_HN), wsp<pg8::bf16_t>(F, WS_WIN), S, NPP, D}; pg8::StaticOrder So; So.init(S, NPP, F.G, F.bid);
            EpiProj E{wsp<bf16>(F, WS_PROJ)};
            pg8::gemm_phase<EpiProj, pg8::StaticOrder, true, true>(F.lds + RING_OFF, g, So, E);
            if (DBL(2)) pg8::gemm_phase<EpiProj, pg8::StaticOrder, true, true>(F.lds + RING_OFF, g, So, E);
            __syncthreads();
            if (F.tid == 0) __hip_atomic_fetch_add(done, 1u, RLX_AGENT);
        }
        const unsigned tgt = (unsigned)F.G; leave_group(F);
        if (F.G == 256 && (blockIdx.x >> 3) == 31) p_fscan(F, (int)(blockIdx.x & 7));
        conv_worker(F, done, F.G == 256 ? (unsigned)GC_INPROJ : tgt, 0);
        __syncthreads();
    } SEAM(2);
#define GROUPED(k, Gc, body) do { gu32* done_ = F.ctl + CW_DONE + 64 * (k); if (enter_group(F, (Gc))) { body; __syncthreads(); if (F.tid == 0) __hip_atomic_fetch_add(done_, 1u, RLX_AGENT); } \
        const unsigned tgt_ = (unsigned)F.G; leave_group(F); conv_worker(F, done_, F.G == 256 ? (unsigned)(Gc) : tgt_, 0); __syncthreads(); } while (0)
    STAMP(3); if (IN(3)) { p3_prep(F); } SEAM(3);
    STAMP(4); if (IN(4)) { p4_scan(F); if (DBL(4)) p4_scan(F); } SEAM(4);
    STAMP(5); if (IN(5)) {
        gu32* done = F.ctl + CW_DONE + 64 * 5;
        p5_mlstm_out(F);
        if (enter_group(F, GC_ATTN)) {
            p5_attention(F, (char*)lds);
            __syncthreads();
            if (F.tid == 0) __hip_atomic_fetch_add(done, 1u, RLX_AGENT);
        }
        const unsigned tgt = (unsigned)F.G; leave_group(F);
        conv_worker(F, done, F.G == 256 ? (unsigned)GC_ATTN : tgt, 0);
        __syncthreads();
    } SEAM(5);
    STAMP(6); if (IN(6)) { p6_combine(F); } SEAM(6);
    STAMP(7); if (IN(7)) {
        pg8::Gemm g{wsp<pg8::bf16_t>(F, WS_CONCAT), wsp<pg8::bf16_t>(F, WS_WOUT), S, D, D}; pg8::StaticOrder So; So.init(S, D, F.G, F.bid);
        EpiOut E{F.in[IN_X], wsp<float>(F, WS_MOD) + 2 * D, wsp<float>(F, WS_H1)};
        pg8::gemm_phase<EpiOut, pg8::StaticOrder, false, true>(F.lds + RING_OFF, g, So, E);
        if (DBL(7)) pg8::gemm_phase<EpiOut, pg8::StaticOrder, false, true>(F.lds + RING_OFF, g, So, E);
    } SEAM(7);
    STAMP(8); if (IN(8)) { p7_router(F); if (DBL(8)) p7_router(F); } SEAM(8);
    STAMP(9); if (IN(9)) { p8_gather(F); if (DBL(9)) p8_gather(F); __syncthreads(); conv_worker(F, nullptr, 0u, 1); __syncthreads(); } SEAM(9);
    STAMP(10); if (IN(10)) {
        build_expert_table(F, (const int*)(F.ws + WS_POS) + S * 4);
        gu32* done = F.ctl + CW_DONE + 64 * 10;
        const int units = ((const LAS int*)(F.lds + TAB_OFF))[32] * 16, rounds = (units + 255) >> 8; int gc = rounds > 0 ? (((units + rounds - 1) / rounds + 7) >> 3) << 3 : 256; gc = gc > 256 ? 256 : gc;
        gc = __builtin_amdgcn_readfirstlane(gc);
        if (enter_group(F, gc)) {
            pg8::Gemm g{wsp<pg8::bf16_t>(F, WS_XG), wsp<pg8::bf16_t>(F, WS_WUG), MAXROWS, 4096, D / 2}; GroupedOrder So{(const LAS int*)(F.lds + TAB_OFF), 16, F.G, F.bid};
            EpiSwiglu E{wsp<unsigned char>(F, WS_ACT), F.in[IN_BUG]};
            pg8::gemm_phase8<EpiSwiglu, GroupedOrder, true, true>(F.lds + RING_OFF, g, So, E);
            __syncthreads();
            if (F.tid == 0) __hip_atomic_fetch_add(done, 1u, RLX_AGENT);
        }
        leave_group(F);
        __syncthreads(); conv_worker(F, nullptr, 0u, 2); __syncthreads();
    } SEAM(10);
    STAMP(11); if (IN(11)) {
        build_expert_table(F, (const int*)(F.ws + WS_POS) + S * 4);
        pg8::Gemm g{wsp<pg8::bf16_t>(F, WS_ACT), wsp<pg8::bf16_t>(F, WS_WD), MAXROWS, D, FF / 2}; GroupedOrder So{(const LAS int*)(F.lds + TAB_OFF), 8, F.G, F.bid};
        EpiDown E{wsp<bf16>(F, WS_Y), F.in[IN_BD], wsp<float>(F, WS_ROWW)};
        pg8::gemm_phase8<EpiDown, GroupedOrder, true, true>(F.lds + RING_OFF, g, So, E);
        if (DBL(11)) pg8::gemm_phase8<EpiDown, GroupedOrder, true, true>(F.lds + RING_OFF, g, So, E);
    } SEAM(11);
    STAMP(12); if (IN(12)) { p11_final(F, PROBE_SCALE()); if (DBL(12)) p11_final(F, PROBE_SCALE()); }
#undef IN
#undef SEAM
}
}
#ifndef MK_DEBUG
#define MK_DEBUG 0
#endif
#ifndef MK_PH_END
#define MK_PH_END mk::N_PHASES
#endif
#ifndef MK_SPLIT
#define MK_SPLIT 0
#endif
extern "C" void kernel_launch(void* const* d_in, const int* in_sizes, int n_in, void* d_out, int out_size, void* d_ws, size_t ws_size, hipStream_t stream) {
    using namespace mk;
    static int grid = 0;
    if (grid == 0) {
        int dev = 0, cus = 0, per_cu = 0;
        if (hipGetDevice(&dev) != hipSuccess || hipDeviceGetAttribute(&cus, hipDeviceAttributeMultiprocessorCount, dev) != hipSuccess) { fprintf(stderr, "kernel_launch: device query failed\n"); grid = -1; return; }
        if (hipFuncSetAttribute((const void*)mega_fwd, hipFuncAttributeMaxDynamicSharedMemorySize, LDS_BYTES) != hipSuccess) { fprintf(stderr, "kernel_launch: hipFuncSetAttribute failed\n"); grid = -1; return; }
        if (hipOccupancyMaxActiveBlocksPerMultiprocessor(&per_cu, (const void*)mega_fwd, NTHR, LDS_BYTES) != hipSuccess || per_cu < 1) fprintf(stderr, "kernel_launch: occupancy query reports %d\n", per_cu);
        (void)hipGetLastError();
        grid = cus;
        if (n_in != 24 || out_size != S * D || ws_size < (MK_DEBUG ? WS_NAIVE + (size_t)2300 * MiB : WS_END)) fprintf(stderr, "kernel_launch: unexpected sizes n_in %d out %d ws %zu\n", n_in, out_size, ws_size);
    }
    if (grid < 0) return;
    (void)hipMemsetAsync((char*)d_ws + WS_CTL, 0, CTL_ZERO_BYTES, stream);
    Args a{};
    for (int i = 0; i < 24; ++i) a.in[i] = (const float*)d_in[i];
    a.out = (float*)d_out; a.ws = (unsigned char*)d_ws;
#if MK_DEBUG
    nv::naive_forward(d_in, (float*)d_out, (char*)d_ws + WS_NAIVE, stream);
#endif
#if MK_SPLIT
    for (int p = 0; p < MK_PH_END; ++p) { a.ph_lo = p; a.ph_hi = p + 1; a.li = p; hipLaunchKernelGGL(mega_fwd, dim3(grid), dim3(NTHR), LDS_BYTES, stream, a); }
#else
    a.ph_lo = 0; a.ph_hi = MK_PH_END; a.li = 0;
    hipLaunchKernelGGL(mega_fwd, dim3(grid), dim3(NTHR), LDS_BYTES, stream, a);
#endif
#ifdef MK_EXTRA_LO
    a.ph_lo = MK_EXTRA_LO; a.ph_hi = MK_EXTRA_HI; a.li = 1;
    hipLaunchKernelGGL(mega_fwd, dim3(grid), dim3(NTHR), LDS_BYTES, stream, a);
#endif
    { const hipError_t le = hipPeekAtLastError(); if (le != hipSuccess) fprintf(stderr, "kernel_launch: launch failed: %s\n", hipGetErrorName(le)); }
#if MK_DEBUG
    {
        nv::NaiveWs w = nv::carve((char*)d_ws + WS_NAIVE);
        double* slots = (double*)((char*)d_ws + WS_CTL + 512 * 1024);
        unsigned char* ws = (unsigned char*)d_ws; int nc = 0;
        MK_DEBUG_CHECKS
        dbg::k_finish<<<1024, 256, 0, stream>>>((float*)d_out, (size_t)S * D, slots, nc, 1e-3);
    }
#endif
}
```

```cpp
#include <hip/hip_runtime.h>
#include <hip/hip_bf16.h>
#include <cstdio>
#include <cstdint>
namespace pg8 {
#define PG8_LAS __attribute__((address_space(3)))
typedef unsigned short bf16_t;
typedef short bf16x8 __attribute__((ext_vector_type(8)));
typedef float f32x4 __attribute__((ext_vector_type(4)));
typedef unsigned u32x4 __attribute__((ext_vector_type(4)));
constexpr int BM = 256, BK = 64, HALF = 128, HTB = HALF * BK * 2  , STAGE_BYTES = 8 * HTB, NXCD = 8, WGM = 8;

__host__ __device__ __forceinline__ int lds_byte(int r, int c) { const int st = (r >> 4) * 2 + (c >> 5), rr = r & 15, cc = c & 31, ob = rr * 64 + cc * 2; return st * 1024 + (ob ^ (((ob >> 9) & 1) << 5)); }
__host__ __device__ __forceinline__ void stage_rc(int b, int& R, int& C) { const int st = b / 1024, sb = b % 1024, swz = sb ^ (((sb >> 9) & 1) << 5); R = (st >> 1) * 16 + swz / 64; C = (st & 1) * 32 + (swz % 64) / 2; }
__host__ __device__ __forceinline__ int perm32(int rho) { const int n = rho >> 4, i = rho & 15; return 8 * (i >> 2) + 4 * n + (i & 3); }

struct Unit { int pm, pn, pb, e; };
struct Gemm { const bf16_t* A; const bf16_t* Bt; int M, N, K; };

struct StaticOrder {
    int nM, nN, nwg, G, c;
    __host__ __device__ void init(int M, int N, int G_, int c_) { nM = M / BM; nN = N / BM; nwg = nM * nN; G = G_; c = c_; }
    __host__ __device__ bool next(int i, Unit& u) const {
        const long L = (long)i * G + c; if (L >= nwg) return false;
        int wgid = (int)L; { const int q = nwg / NXCD, r = nwg % NXCD, xcd = wgid % NXCD, off = wgid / NXCD; wgid = (xcd < r ? xcd * (q + 1) : r * (q + 1) + (xcd - r) * q) + off; }
        const int nig = WGM * nN, gid = wgid / nig, fm = gid * WGM, gsz = (nM - fm) < WGM ? (nM - fm) : WGM;
        u.pm = fm + ((wgid % nig) % gsz); u.pn = (wgid % nig) / gsz; u.pb = u.pn; u.e = 0; return true;
    }
    __device__ __forceinline__ void a_ready(const Unit&) const {}
    __device__ __forceinline__ void done(const Unit&) const {}
};

__device__ __forceinline__ unsigned cvt_pk_bf16(float lo, float hi) { unsigned r; asm volatile("v_cvt_pk_bf16_f32 %0, %1, %2" : "=v"(r) : "v"(lo), "v"(hi)); return r; }
template <class Epi, class Sched, bool ALIGN_EPI = false, bool SP2 = false>
__device__ __forceinline__ void gemm_phase(PG8_LAS unsigned char* lds, const Gemm g, const Sched& S, const Epi& E) {
    const int tid = threadIdx.x, wid = __builtin_amdgcn_readfirstlane(tid >> 6), lane = tid & 63, wr = wid >> 2, wc = wid & 3, fr = lane & 15, fq = lane >> 4;
    const int K = g.K, nt = K / BK;
    unsigned voffA[2], voffB[2];
#pragma unroll
    for (int i = 0; i < 2; ++i) { int R, C; stage_rc(tid * 16 + i * 8192, R, C); const int Rb = Epi::PERM ? ((R & ~31) + perm32(R & 31)) : R;
        voffA[i] = (unsigned)(R * K + C) * 2u; voffB[i] = (unsigned)(Rb * K + C) * 2u; }
    const size_t kstep = (size_t)(BK * 2);
    const size_t hstep = (size_t)HALF * K * 2;
    const size_t tstep = 2 * hstep;
    const unsigned ldsw = (unsigned)wid * 1024u;
    const int aoff = lds_byte(wr * 64 + fr, fq * 8), boff = lds_byte(wc * 32 + fr, fq * 8);
#define PG8_SA(b, h) (((b) * 2 + (h)) * HTB)
#define PG8_SB(b, h) ((4 + (b) * 2 + (h)) * HTB)
#define PG8_STAGE(bufoff, gbase, voff) do { _Pragma("unroll") for (int _i = 0; _i < 2; ++_i) \
        __builtin_amdgcn_global_load_lds((const unsigned*)((const char*)(gbase) + (voff)[_i]), (PG8_LAS unsigned*)(lds + (bufoff) + ldsw + _i * 8192), 16, 0, 0); } while (0)
#define PG8_LDA(dst, b, h) do { _Pragma("unroll") for (int m = 0; m < 4; ++m) _Pragma("unroll") for (int k = 0; k < 2; ++k) dst[m][k] = *(const PG8_LAS bf16x8*)(lds + PG8_SA(b, h) + aoff + m * 2048 + k * 1024); } while (0)
#define PG8_LDB(dst, b, h) do { _Pragma("unroll") for (int n = 0; n < 2; ++n) _Pragma("unroll") for (int k = 0; k < 2; ++k) dst[n][k] = *(const PG8_LAS bf16x8*)(lds + PG8_SB(b, h) + boff + n * 2048 + k * 1024); } while (0)
#define PG8_MMA(ai, bj, At, Bt) do { __builtin_amdgcn_s_setprio(1); _Pragma("unroll") for (int m = 0; m < 4; ++m) _Pragma("unroll") for (int n = 0; n < 2; ++n) _Pragma("unroll") for (int k = 0; k < 2; ++k) \
        acc[ai][bj][m][n] = __builtin_amdgcn_mfma_f32_16x16x32_bf16(Bt[n][k], At[m][k], acc[ai][bj][m][n], 0, 0, 0); __builtin_amdgcn_s_setprio(0); } while (0)
#define PG8_WAIT_V(n) asm volatile("s_waitcnt vmcnt(" #n ")" ::: "memory")
#define PG8_WAIT_L(n) asm volatile("s_waitcnt lgkmcnt(" #n ")" ::: "memory")
#define PG8_BAR __builtin_amdgcn_s_barrier()
#define PG8_SCHED __builtin_amdgcn_sched_barrier(0)
    Unit cur = {0, 0, 0, 0}, nxt = {0, 0, 0, 0}; int ui = 0;
    if (!S.next(0, cur)) return;
    f32x4 acc[2][2][4][2];
#pragma unroll
    for (int a = 0; a < 2; ++a)
#pragma unroll
        for (int b = 0; b < 2; ++b)
#pragma unroll
            for (int m = 0; m < 4; ++m)
#pragma unroll
                for (int n = 0; n < 2; ++n) acc[a][b][m][n] = (f32x4){0.f, 0.f, 0.f, 0.f};
    bf16x8 At[4][2], B0[2][2], B1[2][2];
    const char* cA = (const char*)g.A + (size_t)cur.pm * tstep; const char* cB = (const char*)g.Bt + (size_t)cur.pb * tstep;
    S.a_ready(cur);
    if constexpr (SP2) {
        PG8_STAGE(PG8_SB(0, 0), cB, voffB); PG8_STAGE(PG8_SB(0, 1), cB + hstep, voffB); PG8_STAGE(PG8_SA(0, 0), cA, voffA); PG8_STAGE(PG8_SA(0, 1), cA + hstep, voffA);
        if (wr == 1) PG8_BAR;
        PG8_WAIT_V(2); PG8_BAR;
        PG8_STAGE(PG8_SB(1, 0), cB + kstep, voffB); PG8_STAGE(PG8_SA(1, 0), cA + kstep, voffA); PG8_STAGE(PG8_SB(1, 1), cB + hstep + kstep, voffB);
        PG8_WAIT_V(6); PG8_BAR;
    } else {
        PG8_STAGE(PG8_SB(0, 0), cB, voffB); PG8_STAGE(PG8_SA(0, 0), cA, voffA); PG8_STAGE(PG8_SB(0, 1), cB + hstep, voffB); PG8_STAGE(PG8_SA(0, 1), cA + hstep, voffA);
        if (wr == 1) PG8_BAR;
        PG8_WAIT_V(4); PG8_BAR;
        PG8_STAGE(PG8_SB(1, 0), cB + kstep, voffB); PG8_STAGE(PG8_SA(1, 0), cA + kstep, voffA); PG8_STAGE(PG8_SB(1, 1), cB + hstep + kstep, voffB);
        PG8_WAIT_V(6); PG8_BAR;
    }
    for (;;) {
        const bool has_next = S.next(ui + 1, nxt);
        const char* nA = has_next ? (const char*)g.A + (size_t)nxt.pm * tstep : cA; const char* nB = has_next ? (const char*)g.Bt + (size_t)nxt.pb * tstep : cB;
        for (int t = 0; t < nt; t += 2) {
            const bool last = (t == nt - 2);
            const char* a1 = cA + (size_t)(t + 1) * kstep;
            const char* a2 = last ? nA : cA + (size_t)(t + 2) * kstep; const char* b2 = last ? nB : cB + (size_t)(t + 2) * kstep;
            const char* a3 = a2 + kstep; const char* b3 = b2 + kstep;
            if (last && has_next) S.a_ready(nxt);
            if constexpr (SP2) {
            PG8_LDB(B0, 0, 0); PG8_LDB(B1, 0, 1); PG8_SCHED; PG8_LDA(At, 0, 0); PG8_STAGE(PG8_SA(1, 1), a1 + hstep, voffA);
            PG8_WAIT_V(8); PG8_WAIT_L(0); PG8_BAR; PG8_MMA(0, 0, At, B0); PG8_MMA(0, 1, At, B1); PG8_BAR; PG8_SCHED;
            PG8_LDA(At, 0, 1); PG8_STAGE(PG8_SB(0, 0), b2, voffB); PG8_STAGE(PG8_SB(0, 1), b2 + hstep, voffB); PG8_STAGE(PG8_SA(0, 0), a2, voffA);
            PG8_WAIT_V(8); PG8_WAIT_L(0); PG8_BAR; PG8_MMA(1, 0, At, B0); PG8_MMA(1, 1, At, B1); PG8_BAR; PG8_SCHED;
            PG8_LDB(B0, 1, 0); PG8_LDB(B1, 1, 1); PG8_SCHED; PG8_LDA(At, 1, 0); PG8_STAGE(PG8_SA(0, 1), a2 + hstep, voffA);
            PG8_WAIT_V(8); PG8_WAIT_L(0); PG8_BAR; PG8_MMA(0, 0, At, B0); PG8_MMA(0, 1, At, B1); PG8_BAR; PG8_SCHED;
            PG8_LDA(At, 1, 1); PG8_STAGE(PG8_SB(1, 0), b3, voffB); PG8_STAGE(PG8_SB(1, 1), b3 + hstep, voffB); PG8_STAGE(PG8_SA(1, 0), a3, voffA);
            PG8_WAIT_V(8); PG8_WAIT_L(0); PG8_BAR; PG8_MMA(1, 0, At, B0); PG8_MMA(1, 1, At, B1); PG8_BAR; PG8_SCHED;
            } else {
            PG8_LDB(B0, 0, 0); PG8_SCHED; PG8_LDA(At, 0, 0); PG8_STAGE(PG8_SA(1, 1), a1 + hstep, voffA);
            PG8_WAIT_L(8); PG8_BAR; PG8_WAIT_L(0); PG8_MMA(0, 0, At, B0); PG8_BAR; PG8_SCHED;
            PG8_LDB(B1, 0, 1); PG8_STAGE(PG8_SB(0, 0), b2, voffB);
            PG8_BAR; PG8_WAIT_L(0); PG8_MMA(0, 1, At, B1); PG8_BAR;
            PG8_LDA(At, 0, 1); PG8_STAGE(PG8_SA(0, 0), a2, voffA);
            PG8_BAR; PG8_WAIT_L(0); PG8_MMA(1, 0, At, B0); PG8_BAR; PG8_SCHED;
            PG8_STAGE(PG8_SB(0, 1), b2 + hstep, voffB);
            PG8_WAIT_V(6); PG8_BAR; PG8_MMA(1, 1, At, B1); PG8_BAR;
            PG8_LDB(B0, 1, 0); PG8_SCHED; PG8_LDA(At, 1, 0); PG8_STAGE(PG8_SA(0, 1), a2 + hstep, voffA);
            PG8_WAIT_L(8); PG8_BAR; PG8_WAIT_L(0); PG8_MMA(0, 0, At, B0); PG8_BAR; PG8_SCHED;
            PG8_LDB(B1, 1, 1); PG8_STAGE(PG8_SB(1, 0), b3, voffB);
            PG8_BAR; PG8_WAIT_L(0); PG8_MMA(0, 1, At, B1); PG8_BAR;
            PG8_LDA(At, 1, 1); PG8_STAGE(PG8_SA(1, 0), a3, voffA);
            PG8_BAR; PG8_WAIT_L(0); PG8_MMA(1, 0, At, B0); PG8_BAR; PG8_SCHED;
            PG8_STAGE(PG8_SB(1, 1), b3 + hstep, voffB);
            PG8_WAIT_V(6); PG8_BAR; PG8_MMA(1, 1, At, B1); PG8_BAR;
            }
        }
        if constexpr (ALIGN_EPI) { if (wr == 0) PG8_BAR; }
        if constexpr (!Epi::AFTER_DRAIN) { E(acc, cur, wr, wc, fr, fq); S.done(cur); }
        if (!has_next) break;
#pragma unroll
        for (int a = 0; a < 2; ++a)
#pragma unroll
            for (int b = 0; b < 2; ++b)
#pragma unroll
                for (int m = 0; m < 4; ++m)
#pragma unroll
                    for (int n = 0; n < 2; ++n) acc[a][b][m][n] = (f32x4){0.f, 0.f, 0.f, 0.f};
        cur = nxt; cA = nA; cB = nB; ++ui;
        if constexpr (ALIGN_EPI) { if (wr == 1) PG8_BAR; }
    }
    PG8_WAIT_V(0);
    if constexpr (!ALIGN_EPI) { if (wr == 0) PG8_BAR; }
    PG8_BAR;
    if constexpr (Epi::AFTER_DRAIN) { E.fused(acc, cur, wr, wc, fr, fq, lds, wid, lane); S.done(cur); }
#undef PG8_SA
#undef PG8_SB
#undef PG8_STAGE
#undef PG8_LDA
#undef PG8_LDB
#undef PG8_MMA
#undef PG8_WAIT_V
#undef PG8_WAIT_L
#undef PG8_BAR
#undef PG8_SCHED
}
typedef int v8i __attribute__((ext_vector_type(8)));
typedef int v4i __attribute__((ext_vector_type(4)));
constexpr int SCALE_W8 = 0x78787878, SCALE_A8 = 0x7f7f7f7f;
template <class Epi, class Sched, bool ALIGN_EPI = false, bool SP2 = false>
__device__ __forceinline__ void gemm_phase8(PG8_LAS unsigned char* lds, const Gemm g, const Sched& S, const Epi& E) {
    const int tid = threadIdx.x, wid = __builtin_amdgcn_readfirstlane(tid >> 6), lane = tid & 63, wr = wid >> 2, wc = wid & 3, fr = lane & 15, fq = lane >> 4;
    const int K = g.K, nt = K / BK;
    unsigned voffA[2], voffB[2];
#pragma unroll
    for (int i = 0; i < 2; ++i) { int R, C; stage_rc(tid * 16 + i * 8192, R, C); const int Rb = Epi::PERM ? ((R & ~31) + perm32(R & 31)) : R;
        voffA[i] = (unsigned)(R * K + C) * 2u; voffB[i] = (unsigned)(Rb * K + C) * 2u; }
    const size_t kstep = (size_t)(BK * 2);
    const size_t hstep = (size_t)HALF * K * 2;
    const size_t tstep = 2 * hstep;
    const unsigned ldsw = (unsigned)wid * 1024u;
    const int aoff = lds_byte(wr * 64 + fr, fq * 8), boff = lds_byte(wc * 32 + fr, fq * 8);
#define PG8_SA(b, h) (((b) * 2 + (h)) * HTB)
#define PG8_SB(b, h) ((4 + (b) * 2 + (h)) * HTB)
#define PG8_STAGE(bufoff, gbase, voff) do { _Pragma("unroll") for (int _i = 0; _i < 2; ++_i) \
        __builtin_amdgcn_global_load_lds((const unsigned*)((const char*)(gbase) + (voff)[_i]), (PG8_LAS unsigned*)(lds + (bufoff) + ldsw + _i * 8192), 16, 0, 0); } while (0)
#define PG8_LDA(dst, b, h) do { _Pragma("unroll") for (int m = 0; m < 4; ++m) { const v4i lo_ = *(const PG8_LAS v4i*)(lds + PG8_SA(b, h) + aoff + m * 2048), hi_ = *(const PG8_LAS v4i*)(lds + PG8_SA(b, h) + aoff + m * 2048 + 1024); \
        dst[m] = __builtin_shufflevector(lo_, hi_, 0, 1, 2, 3, 4, 5, 6, 7); } } while (0)
#define PG8_LDB(dst, b, h) do { _Pragma("unroll") for (int n = 0; n < 2; ++n) { const v4i lo_ = *(const PG8_LAS v4i*)(lds + PG8_SB(b, h) + boff + n * 2048), hi_ = *(const PG8_LAS v4i*)(lds + PG8_SB(b, h) + boff + n * 2048 + 1024); \
        dst[n] = __builtin_shufflevector(lo_, hi_, 0, 1, 2, 3, 4, 5, 6, 7); } } while (0)
#define PG8_MMA(ai, bj, At, Bt) do { __builtin_amdgcn_s_setprio(1); _Pragma("unroll") for (int m = 0; m < 4; ++m) _Pragma("unroll") for (int n = 0; n < 2; ++n) \
        asm volatile("v_mfma_scale_f32_16x16x128_f8f6f4 %0, %1, %2, %0, %3, %4 op_sel_hi:[0,0,0]" : "+v"(acc[ai][bj][m][n]) : "v"(Bt[n]), "v"(At[m]), "v"(sw8), "v"(sa8)); __builtin_amdgcn_s_setprio(0); } while (0)
#define PG8_WAIT_V(n) asm volatile("s_waitcnt vmcnt(" #n ")" ::: "memory")
#define PG8_WAIT_L(n) asm volatile("s_waitcnt lgkmcnt(" #n ")" ::: "memory")
#define PG8_BAR __builtin_amdgcn_s_barrier()
#define PG8_SCHED __builtin_amdgcn_sched_barrier(0)
    Unit cur = {0, 0, 0, 0}, nxt = {0, 0, 0, 0}; int ui = 0;
    if (!S.next(0, cur)) return;
    f32x4 acc[2][2][4][2];
#pragma unroll
    for (int a = 0; a < 2; ++a)
#pragma unroll
        for (int b = 0; b < 2; ++b)
#pragma unroll
            for (int m = 0; m < 4; ++m)
#pragma unroll
                for (int n = 0; n < 2; ++n) acc[a][b][m][n] = (f32x4){0.f, 0.f, 0.f, 0.f};
    v8i At[4], B0[2], B1[2]; int sw8 = SCALE_W8, sa8 = SCALE_A8;
    const char* cA = (const char*)g.A + (size_t)cur.pm * tstep; const char* cB = (const char*)g.Bt + (size_t)cur.pb * tstep;
    S.a_ready(cur);
    if constexpr (SP2) {
        PG8_STAGE(PG8_SB(0, 0), cB, voffB); PG8_STAGE(PG8_SB(0, 1), cB + hstep, voffB); PG8_STAGE(PG8_SA(0, 0), cA, voffA); PG8_STAGE(PG8_SA(0, 1), cA + hstep, voffA);
        if (wr == 1) PG8_BAR;
        PG8_WAIT_V(2); PG8_BAR;
        PG8_STAGE(PG8_SB(1, 0), cB + kstep, voffB); PG8_STAGE(PG8_SA(1, 0), cA + kstep, voffA); PG8_STAGE(PG8_SB(1, 1), cB + hstep + kstep, voffB);
        PG8_WAIT_V(6); PG8_BAR;
    } else {
        PG8_STAGE(PG8_SB(0, 0), cB, voffB); PG8_STAGE(PG8_SA(0, 0), cA, voffA); PG8_STAGE(PG8_SB(0, 1), cB + hstep, voffB); PG8_STAGE(PG8_SA(0, 1), cA + hstep, voffA);
        if (wr == 1) PG8_BAR;
        PG8_WAIT_V(4); PG8_BAR;
        PG8_STAGE(PG8_SB(1, 0), cB + kstep, voffB); PG8_STAGE(PG8_SA(1, 0), cA + kstep, voffA); PG8_STAGE(PG8_SB(1, 1), cB + hstep + kstep, voffB);
        PG8_WAIT_V(6); PG8_BAR;
    }
    for (;;) {
        const bool has_next = S.next(ui + 1, nxt);
        const char* nA = has_next ? (const char*)g.A + (size_t)nxt.pm * tstep : cA; const char* nB = has_next ? (const char*)g.Bt + (size_t)nxt.pb * tstep : cB;
        for (int t = 0; t < nt; t += 2) {
            const bool last = (t == nt - 2);
            const char* a1 = cA + (size_t)(t + 1) * kstep;
            const char* a2 = last ? nA : cA + (size_t)(t + 2) * kstep; const char* b2 = last ? nB : cB + (size_t)(t + 2) * kstep;
            const char* a3 = a2 + kstep; const char* b3 = b2 + kstep;
            if (last && has_next) S.a_ready(nxt);
            if constexpr (SP2) {
            PG8_LDB(B0, 0, 0); PG8_LDB(B1, 0, 1); PG8_SCHED; PG8_LDA(At, 0, 0); PG8_STAGE(PG8_SA(1, 1), a1 + hstep, voffA);
            PG8_WAIT_V(8); PG8_WAIT_L(0); PG8_BAR; PG8_MMA(0, 0, At, B0); PG8_MMA(0, 1, At, B1); PG8_BAR; PG8_SCHED;
            PG8_LDA(At, 0, 1); PG8_STAGE(PG8_SB(0, 0), b2, voffB); PG8_STAGE(PG8_SB(0, 1), b2 + hstep, voffB); PG8_STAGE(PG8_SA(0, 0), a2, voffA);
            PG8_WAIT_V(8); PG8_WAIT_L(0); PG8_BAR; PG8_MMA(1, 0, At, B0); PG8_MMA(1, 1, At, B1); PG8_BAR; PG8_SCHED;
            PG8_LDB(B0, 1, 0); PG8_LDB(B1, 1, 1); PG8_SCHED; PG8_LDA(At, 1, 0); PG8_STAGE(PG8_SA(0, 1), a2 + hstep, voffA);
            PG8_WAIT_V(8); PG8_WAIT_L(0); PG8_BAR; PG8_MMA(0, 0, At, B0); PG8_MMA(0, 1, At, B1); PG8_BAR; PG8_SCHED;
            PG8_LDA(At, 1, 1); PG8_STAGE(PG8_SB(1, 0), b3, voffB); PG8_STAGE(PG8_SB(1, 1), b3 + hstep, voffB); PG8_STAGE(PG8_SA(1, 0), a3, voffA);
            PG8_WAIT_V(8); PG8_WAIT_L(0); PG8_BAR; PG8_MMA(1, 0, At, B0); PG8_MMA(1, 1, At, B1); PG8_BAR; PG8_SCHED;
            } else {
            PG8_LDB(B0, 0, 0); PG8_SCHED; PG8_LDA(At, 0, 0); PG8_STAGE(PG8_SA(1, 1), a1 + hstep, voffA);
            PG8_WAIT_L(8); PG8_BAR; PG8_WAIT_L(0); PG8_MMA(0, 0, At, B0); PG8_BAR; PG8_SCHED;
            PG8_LDB(B1, 0, 1); PG8_STAGE(PG8_SB(0, 0), b2, voffB);
            PG8_BAR; PG8_WAIT_L(0); PG8_MMA(0, 1, At, B1); PG8_BAR;
            PG8_LDA(At, 0, 1); PG8_STAGE(PG8_SA(0, 0), a2, voffA);
            PG8_BAR; PG8_WAIT_L(0); PG8_MMA(1, 0, At, B0); PG8_BAR; PG8_SCHED;
            PG8_STAGE(PG8_SB(0, 1), b2 + hstep, voffB);
            PG8_WAIT_V(6); PG8_BAR; PG8_MMA(1, 1, At, B1); PG8_BAR;
            PG8_LDB(B0, 1, 0); PG8_SCHED; PG8_LDA(At, 1, 0); PG8_STAGE(PG8_SA(0, 1), a2 + hstep, voffA);
            PG8_WAIT_L(8); PG8_BAR; PG8_WAIT_L(0); PG8_MMA(0, 0, At, B0); PG8_BAR; PG8_SCHED;
            PG8_LDB(B1, 1, 1); PG8_STAGE(PG8_SB(1, 0), b3, voffB);
            PG8_BAR; PG8_WAIT_L(0); PG8_MMA(0, 1, At, B1); PG8_BAR;
            PG8_LDA(At, 1, 1); PG8_STAGE(PG8_SA(1, 0), a3, voffA);
            PG8_BAR; PG8_WAIT_L(0); PG8_MMA(1, 0, At, B0); PG8_BAR; PG8_SCHED;
            PG8_STAGE(PG8_SB(1, 1), b3 + hstep, voffB);
            PG8_WAIT_V(6); PG8_BAR; PG8_MMA(1, 1, At, B1); PG8_BAR;
            }
        }
        if constexpr (ALIGN_EPI) { if (wr == 0) PG8_BAR; }
        asm volatile("s_nop 15\n\ts_nop 7" ::: "memory");
        if constexpr (!Epi::AFTER_DRAIN) { E(acc, cur, wr, wc, fr, fq); S.done(cur); }
        if (!has_next) break;
#pragma unroll
        for (int a = 0; a < 2; ++a)
#pragma unroll
            for (int b = 0; b < 2; ++b)
#pragma unroll
                for (int m = 0; m < 4; ++m)
#pragma unroll
                    for (int n = 0; n < 2; ++n) acc[a][b][m][n] = (f32x4){0.f, 0.f, 0.f, 0.f};
        cur = nxt; cA = nA; cB = nB; ++ui;
        if constexpr (ALIGN_EPI) { if (wr == 1) PG8_BAR; }
    }
    PG8_WAIT_V(0);
    if constexpr (!ALIGN_EPI) { if (wr == 0) PG8_BAR; }
    PG8_BAR;
    if constexpr (Epi::AFTER_DRAIN) { E.fused(acc, cur, wr, wc, fr, fq, lds, wid, lane); S.done(cur); }
#undef PG8_SA
#undef PG8_SB
#undef PG8_STAGE
#undef PG8_LDA
#undef PG8_LDB
#undef PG8_MMA
#undef PG8_WAIT_V
#undef PG8_WAIT_L
#undef PG8_BAR
#undef PG8_SCHED
}
}
#define GAS __attribute__((address_space(1)))
#define LAS __attribute__((address_space(3)))
typedef unsigned short bf16;
typedef unsigned v4u __attribute__((ext_vector_type(4)));
typedef float f32x4 __attribute__((ext_vector_type(4)));
typedef short bf16x8 __attribute__((ext_vector_type(8)));
typedef GAS unsigned gu32;
typedef GAS unsigned long long gu64;
#define RLX_AGENT __ATOMIC_RELAXED, __HIP_MEMORY_SCOPE_AGENT
#define LDS_WAIT() asm volatile("s_waitcnt lgkmcnt(0)" ::: "memory")
#define VM_WAIT() asm volatile("s_waitcnt vmcnt(0)" ::: "memory")
__device__ __forceinline__ unsigned long long rt() { return __builtin_amdgcn_s_memrealtime(); }
__device__ __forceinline__ unsigned f2bf(float f) { unsigned u = __builtin_bit_cast(unsigned, f); return (u + 0x7fffu + ((u >> 16) & 1u)) >> 16; }
__device__ __forceinline__ unsigned pk2(float lo, float hi) { return f2bf(lo) | (f2bf(hi) << 16); }

#define XB_TMO      128
#define XB_XCNT(j)  (256  + 64 * (j))
#define XB_XSUB(j)  (1280 + 64 * (j))
#define XB_XGEN(j)  (2304 + 64 * (j))
#define XB_TOP      3328
#define XB_TOPGEN   3392
#define XCD_BAR_WORDS 3456
#define XB_SPIN_CAP (1u << 18)

__device__ __forceinline__ unsigned xb_ld(unsigned* p)              { return __hip_atomic_load(p, __ATOMIC_RELAXED, __HIP_MEMORY_SCOPE_AGENT); }
__device__ __forceinline__ unsigned xb_add(unsigned* p, unsigned v) { return __hip_atomic_fetch_add(p, v, __ATOMIC_RELAXED, __HIP_MEMORY_SCOPE_AGENT); }
__device__ __forceinline__ unsigned xb_xcc_id() { return (unsigned)__builtin_amdgcn_s_getreg((3 << 11) | 20) & 0xFu; }
#define XB_SPIN(cond, bar) do { unsigned _sp = 0; while (cond) { __builtin_amdgcn_s_sleep(1); \
    if ((++_sp & 255u) == 0u) { if (xb_ld(&(bar)[XB_TMO])) break; if (_sp > XB_SPIN_CAP) { atomicAdd(&(bar)[XB_TMO], 1u); break; } } } } while (0)

struct XcdBarrier {
    unsigned* bar; unsigned x;
    volatile LAS unsigned* st;
};

__device__ __forceinline__ XcdBarrier xcd_barrier_post(unsigned* bar, volatile LAS unsigned* st) {
    XcdBarrier b; b.bar = bar; b.x = xb_xcc_id(); b.st = st;
    if (threadIdx.x == 0) (void)xb_add(&bar[XB_XCNT(b.x)], 1u);
    return b;
}
__device__ __forceinline__ void xcd_barrier_complete(unsigned* bar, unsigned x, unsigned& nloc, unsigned& nx) {
    const unsigned G = gridDim.x * gridDim.y * gridDim.z;
    unsigned sum, cnt, mine, sp = 0u;
    for (;;) {
        sum = 0u; cnt = 0u; mine = 0u;
#pragma unroll
        for (unsigned j = 0; j < 16; ++j) { const unsigned c = xb_ld(&bar[XB_XCNT(j)]); sum += c; cnt += (c > 0u) ? 1u : 0u; mine = (j == x) ? c : mine; }
        if (sum == G) break;
        __builtin_amdgcn_s_sleep(1);
        if ((++sp & 255u) == 0u) { if (xb_ld(&bar[XB_TMO])) break; if (sp > XB_SPIN_CAP) { atomicAdd(&bar[XB_TMO], 1u); break; } }
    }
    nloc = mine > 0u ? mine : 1u; nx = cnt > 0u ? cnt : 1u;
}

__device__ __forceinline__ void xcd_barrier(const XcdBarrier& b) {
    asm volatile("s_waitcnt vmcnt(0)" ::: "memory");
    __syncthreads();
    if (threadIdx.x == 0) {
        unsigned* bar = b.bar;
        __builtin_amdgcn_s_waitcnt(0);
        unsigned nloc = b.st[0], nx = b.st[1];
        if (nloc == 0u) { xcd_barrier_complete(bar, b.x, nloc, nx); b.st[0] = nloc; b.st[1] = nx; }
        const unsigned old = xb_add(&bar[XB_XSUB(b.x)], 1u);
        const unsigned gen = old / nloc;
        if (old + 1u == (gen + 1u) * nloc) {
            __builtin_amdgcn_fence(__ATOMIC_RELEASE, "agent");
            asm volatile("s_waitcnt vmcnt(0)" ::: "memory");
            const unsigned og = xb_add(&bar[XB_TOP], 1u);
            const unsigned tg = og / nx;
            if (og + 1u == (tg + 1u) * nx) xb_add(&bar[XB_TOPGEN], 1u);
            else XB_SPIN(xb_ld(&bar[XB_TOPGEN]) == tg, bar);
            __builtin_amdgcn_fence(__ATOMIC_ACQUIRE, "agent");
            xb_add(&bar[XB_XGEN(b.x)], 1u);
            asm volatile("s_waitcnt vmcnt(0)" ::: "memory");
        } else {
            XB_SPIN(xb_ld(&bar[XB_XGEN(b.x)]) == gen, bar);
            __builtin_amdgcn_fence(__ATOMIC_ACQUIRE, "agent");
            asm volatile("s_waitcnt vmcnt(0)" ::: "memory");
        }
    }
    __syncthreads();
}
namespace mk {
constexpr int S = 8192, D = 2048, NPROJ = 6160, NPP = 6144, NPAD = 6400, NE = 32, FF = 2048, NWAVES = 8, NTHR = 512;
constexpr int C_MQ = 0, C_MK = 512, C_MV = 1024, C_MO = 2048, C_FQ = 3072, C_FK = 4096, C_FV = 5120;
constexpr int MAXROWS = S * 4 + NE * 256;
constexpr int NCH = 128, LCH = 64;
constexpr size_t MiB = 1u << 20;
constexpr size_t WS_CTL = 0, CTL_ZERO_BYTES = 1 * MiB;
constexpr size_t WS_MODP = 14 * MiB;
constexpr size_t WS_MOD = 2 * MiB;
constexpr size_t WS_GATES = 3 * MiB;
constexpr size_t WS_F = 4 * MiB;
constexpr size_t WS_NL = 5 * MiB;
constexpr size_t WS_NS = 6 * MiB;
constexpr size_t WS_GLAL = 7 * MiB;
constexpr size_t WS_MS = 7 * MiB + 65536;
constexpr size_t WS_TOPI = 8 * MiB;
constexpr size_t WS_TOPW = 9 * MiB;
constexpr size_t WS_HIST = 10 * MiB;
constexpr size_t WS_LRANK = 11 * MiB;
constexpr size_t WS_POS = 12 * MiB;
constexpr size_t WS_ROWW = 13 * MiB;
constexpr size_t WS_WIN = 16 * MiB;
constexpr size_t WS_WOUT = 42 * MiB;
constexpr size_t WS_HN = 50 * MiB;
constexpr size_t WS_PROJ = 82 * MiB;
constexpr size_t WS_UL = 178 * MiB;
constexpr size_t WS_CS = 242 * MiB;
constexpr size_t WS_CONCAT = 274 * MiB;
constexpr size_t WS_H1 = 306 * MiB;
constexpr size_t WS_XG = 370 * MiB;
constexpr size_t WS_ACT = 530 * MiB;
constexpr size_t WS_Y = 690 * MiB;
constexpr size_t WS_WUG = 850 * MiB;
constexpr size_t WS_WD = 1362 * MiB;
constexpr size_t WS_OPART = 1618 * MiB;
constexpr size_t WS_MLP = 1786 * MiB;
constexpr size_t WS_JLO = 1789 * MiB;
constexpr size_t WS_END = 1790 * MiB;
constexpr size_t WS_NAIVE = 1792 * MiB;
constexpr int CW_TMO = 0, CW_CODE = 1, CW_CONV = 65536, CW_DONE = 2048, CW_BAR = 4096;
constexpr int GC_INPROJ = 160, GC_ATTN = 160, GC_PREP = 192;
constexpr int RING_OFF = 0, RING_BYTES = 131072;
constexpr int LDSCTL_OFF = RING_BYTES, MISC_OFF = LDSCTL_OFF + 320;
constexpr int TAB_OFF = LDSCTL_OFF + 1024;
constexpr int ATT_CH = 16;
constexpr int LDS_BYTES = 147456;
static_assert(GC_INPROJ <= 248 && GC_INPROJ % 8 == 0 && GC_ATTN % 8 == 0, "compute groups: multiples of 8; the in-proj group leaves slot 31 to the forget-gate scans");
}
namespace mk {
typedef float f32x2 __attribute__((ext_vector_type(2)));
typedef unsigned u32x2 __attribute__((ext_vector_type(2)));
struct Frame {
    LAS unsigned char* lds;
    volatile LAS unsigned* MISC;
    gu32* ctl;
    int tid, lane, wave, vcu, G, bid;
    const float* in[24];
    float* out; unsigned char* ws;
};
#define IN_X 0
#define IN_C 1
#define IN_WADA 2
#define IN_BADA 3
#define IN_NMIX 4
#define IN_WIN 5
#define IN_BI 6
#define IN_BF 7
#define IN_FOXBF 8
#define IN_FOXQN 9
#define IN_FOXKN 10
#define IN_MOUTN 11
#define IN_FOUTN 12
#define IN_WOUT 13
#define IN_NFFN 14
#define IN_WR 15
#define IN_BR 16
#define IN_WUG 17
#define IN_BUG 18
#define IN_WD 19
#define IN_BD 20
#define IN_WAF 21
#define IN_BAF 22
#define IN_NFIN 23
template <class T> __device__ __forceinline__ T* wsp(const Frame& F, size_t off) { return (T*)(F.ws + off); }
__device__ __forceinline__ float wave_sum(float v) {
#pragma unroll
    for (int o = 1; o < 64; o <<= 1) v += __shfl_xor(v, o);
    return v;
}
__device__ __forceinline__ float sigmoid_f(float v) { return 1.f / (1.f + __expf(-v)); }
__device__ __forceinline__ float log_sigmoid_f(float v) { return fminf(v, 0.f) - log1pf(__expf(-fabsf(v))); }
__device__ __forceinline__ float softcap_f(float v) { return 15.f * tanhf(v * (1.f / 15.f)); }
__device__ __forceinline__ float bf2f(unsigned short b) { return __uint_as_float(((unsigned)b) << 16); }

struct CvtItem { const float* src; bf16* dst; };
__device__ __forceinline__ void cvt_load(const CvtItem& it, int ldw, f32x4 (&v)[16], int lane) {
    const float* p = it.src + (size_t)((lane >> 4) * 16) * ldw + (lane & 15) * 4;
#pragma unroll
    for (int i = 0; i < 16; ++i) v[i] = __builtin_nontemporal_load((const GAS f32x4*)(p + (size_t)i * ldw));
}
__device__ __forceinline__ void cvt_store(const CvtItem& it, int K, const f32x4 (&v)[16], LAS unsigned char* scr, int lane) {
    const int c = lane & 15, g = lane >> 4;
#pragma unroll
    for (int j = 0; j < 4; ++j) {
        v4u a, b;
        a.x = pk2(v[0][j], v[1][j]); a.y = pk2(v[2][j], v[3][j]); a.z = pk2(v[4][j], v[5][j]); a.w = pk2(v[6][j], v[7][j]);
        b.x = pk2(v[8][j], v[9][j]); b.y = pk2(v[10][j], v[11][j]); b.z = pk2(v[12][j], v[13][j]); b.w = pk2(v[14][j], v[15][j]);
        LAS unsigned char* q = scr + (4 * c + j) * 144 + 32 * g;
        *(LAS v4u*)q = a; *(LAS v4u*)(q + 16) = b; }
    LDS_WAIT(); asm volatile("" ::: "memory");
#pragma unroll
    for (int i = 0; i < 8; ++i) { const int row = (lane >> 3) + 8 * i; const v4u o = *(const LAS v4u*)(scr + row * 144 + (lane & 7) * 16);
        *(GAS v4u*)(it.dst + (size_t)row * K + (lane & 7) * 8) = o; }
    LDS_WAIT(); asm volatile("" ::: "memory");
}
__device__ __forceinline__ unsigned pk4_fp8(float a, float b, float c, float d) { int r = __builtin_amdgcn_cvt_pk_fp8_f32(a, b, 0, false); r = __builtin_amdgcn_cvt_pk_fp8_f32(c, d, r, true); return (unsigned)r; }
constexpr float W8S = 128.f;
__device__ __forceinline__ void cvt8_pack(const f32x4 (&v)[16], LAS unsigned char* scr, int half, int lane) {
    const int c = lane & 15, g = lane >> 4;
#pragma unroll
    for (int j = 0; j < 4; ++j) { v4u a;
        a.x = pk4_fp8(v[0][j] * W8S, v[1][j] * W8S, v[2][j] * W8S, v[3][j] * W8S); a.y = pk4_fp8(v[4][j] * W8S, v[5][j] * W8S, v[6][j] * W8S, v[7][j] * W8S);
        a.z = pk4_fp8(v[8][j] * W8S, v[9][j] * W8S, v[10][j] * W8S, v[11][j] * W8S); a.w = pk4_fp8(v[12][j] * W8S, v[13][j] * W8S, v[14][j] * W8S, v[15][j] * W8S);
        *(LAS v4u*)(scr + (4 * c + j) * 144 + half * 64 + 16 * g) = a; }
}
__device__ __forceinline__ void cvt8_flush(unsigned char* dst, int kbytes, LAS unsigned char* scr, int lane) {
    LDS_WAIT(); asm volatile("" ::: "memory");
#pragma unroll
    for (int i = 0; i < 8; ++i) { const int row = (lane >> 3) + 8 * i; const v4u o = *(const LAS v4u*)(scr + row * 144 + (lane & 7) * 16);
        __builtin_nontemporal_store(o, (GAS v4u*)(dst + (size_t)row * kbytes + (lane & 7) * 16)); }
    LDS_WAIT(); asm volatile("" ::: "memory");
}
constexpr int CV8_UG = NE * 16 * 64, CV8_D = NE * 16 * 32, CV8_TOTAL = CV8_UG + CV8_D;
struct Cvt8Item { const float* src; unsigned char* dst; int ldw; };
__device__ __forceinline__ Cvt8Item cvt8_item(const Frame& F, int it, int half) {
    Cvt8Item r;
    if (it < CV8_UG) { const int e = it >> 10, q = it & 1023, kb = q >> 6, nb = q & 63, d0 = nb * 64, j = d0 >> 8, wv = d0 & 255, sc = wv < 128 ? 128 * j + wv : 2048 + 128 * j + (wv - 128);
        r.ldw = 4096; r.src = F.in[IN_WUG] + (size_t)e * D * 4096 + (size_t)(kb * 128 + half * 64) * 4096 + sc; r.dst = wsp<unsigned char>(F, WS_WUG) + (size_t)e * 4096 * D + (size_t)d0 * D + kb * 128; return r; }
    it -= CV8_UG;
    { const int e = it >> 9, q = it & 511, kb = q >> 5, nb = q & 31;
        r.ldw = D; r.src = F.in[IN_WD] + (size_t)e * FF * D + (size_t)(kb * 128 + half * 64) * D + nb * 64; r.dst = wsp<unsigned char>(F, WS_WD) + (size_t)e * D * FF + (size_t)(nb * 64) * FF + kb * 128; return r; }
}
__device__ __forceinline__ void cvt8_load(const Cvt8Item& it, f32x4 (&v)[16], int lane) {
    const float* p = it.src + (size_t)((lane >> 4) * 16) * it.ldw + (lane & 15) * 4;
#pragma unroll
    for (int i = 0; i < 16; ++i) v[i] = __builtin_nontemporal_load((const GAS f32x4*)(p + (size_t)i * it.ldw));
}
constexpr int CV_IN = 32 * 96, CV_OUT = 32 * 32, CV_TOTAL = CV_IN + CV_OUT;
__device__ __forceinline__ CvtItem cvt_item(const Frame& F, int it, int& ldw, int& K) {
    CvtItem r;
    if (it < CV_IN) { const int kb = it / 96, nb = it % 96, d0 = nb * 64, sc = d0 < 3072 ? d0 : d0 + 8;
        ldw = NPROJ; K = D; r.src = F.in[IN_WIN] + (size_t)(kb * 64) * NPROJ + sc; r.dst = wsp<bf16>(F, WS_WIN) + (size_t)d0 * D + kb * 64; return r; }
    it -= CV_IN;
    { const int kb = it >> 5, nb = it & 31; ldw = D; K = D; r.src = F.in[IN_WOUT] + (size_t)(kb * 64) * D + nb * 64; r.dst = wsp<bf16>(F, WS_WOUT) + (size_t)(nb * 64) * D + kb * 64; return r; }
}
__device__ __forceinline__ void p0_gemv(Frame& F) {
    const int gw = F.vcu * NWAVES + F.wave, NGW = F.G * NWAVES, lane = F.lane;
    {
        const float* c = F.in[IN_C]; float* modp = wsp<float>(F, WS_MODP);
        for (int task = gw; task < 2048; task += NGW) {
            const int cg = task & 63, ks = task >> 6, j = cg * 256 + 4 * lane;
            const float* w; int ld, col;
            if (j < 6 * D) { w = F.in[IN_WADA]; ld = 6 * D; col = j; } else { w = F.in[IN_WAF]; ld = 2 * D; col = j - 6 * D; }
            const float c0 = c[ks * 64 + lane]; const float s0 = c0 * sigmoid_f(c0);
            const float* wp = w + (size_t)(ks * 64) * ld + col; f32x4 acc = {0.f, 0.f, 0.f, 0.f};
#pragma unroll 16
            for (int i = 0; i < 64; ++i) acc += __builtin_nontemporal_load((const GAS f32x4*)(wp + (size_t)i * ld)) * __builtin_bit_cast(float, __builtin_amdgcn_readlane(__builtin_bit_cast(int, s0), i));
            *(GAS f32x4*)(modp + ks * 16384 + j) = acc;
        }
    }
    {
        bf16* win_t = wsp<bf16>(F, WS_WIN);
        for (int i2 = gw; i2 < D / 4; i2 += NGW) {
            const int col = lane & 15, k = 4 * i2 + (lane >> 4), sc = col < 8 ? 3072 + col : 6152 + (col - 8);
            win_t[(size_t)(NPP + col) * D + k] = (bf16)f2bf(F.in[IN_WIN][(size_t)k * NPROJ + sc]); }
        const v4u z = {0u, 0u, 0u, 0u};
        for (int i = gw * 64 + lane; i < 16 * D / 8; i += NGW * 64) *(GAS v4u*)(win_t + (size_t)NPROJ * D + (size_t)i * 8) = z;
    }
}
constexpr int CV8_NSH = 32, CV8_SHA = CV8_UG / CV8_NSH, CV8_SHB = CV8_D / CV8_NSH;
#define CONV_NEXT(var) do { var = CV8_TOTAL; \
        if (useA) { const int b_ = __builtin_amdgcn_readfirstlane((int)(lane == 0 ? __hip_atomic_fetch_add(ctrA, 1u, RLX_AGENT) : 0u)); if (b_ < CV8_SHA) var = xs * CV8_SHA + b_; else useA = false; } \
        if (var == CV8_TOTAL && useB) { const int b_ = __builtin_amdgcn_readfirstlane((int)(lane == 0 ? __hip_atomic_fetch_add(ctrB, 1u, RLX_AGENT) : 0u)); if (b_ < CV8_SHB) var = CV8_UG + xs * CV8_SHB + b_; else useB = false; } } while (0)
__device__ __forceinline__ void conv_worker(Frame& F, gu32* stop, unsigned target, int which) {
    LAS unsigned char* scr = F.lds + RING_OFF + F.wave * 9216; const int lane = F.lane, xs = (int)(blockIdx.x & (CV8_NSH - 1));
    gu32* ctrA = F.ctl + CW_CONV + 64 * xs; gu32* ctrB = F.ctl + CW_CONV + 64 * (CV8_NSH + xs);
    bool useA = which != 2, useB = which != 1;
    int it; CONV_NEXT(it); if (it >= CV8_TOTAL) return;
    f32x4 va[16], vb[16];
    Cvt8Item cur = cvt8_item(F, it, 0); cvt8_load(cur, va, lane);
    for (;;) {
        const Cvt8Item c1 = cvt8_item(F, it, 1); cvt8_load(c1, vb, lane);
        bool stopnow = false;
        if (stop) stopnow = (unsigned)__builtin_amdgcn_readfirstlane((int)__hip_atomic_load(stop, RLX_AGENT)) >= target;
        int itn = CV8_TOTAL; if (!stopnow) CONV_NEXT(itn);
        cvt8_pack(va, scr, 0, lane);
        const bool more = itn < CV8_TOTAL; Cvt8Item nx = cur;
        if (more) { nx = cvt8_item(F, itn, 0); cvt8_load(nx, va, lane); }
        cvt8_pack(vb, scr, 1, lane);
        cvt8_flush(cur.dst, D, scr, lane);
        if (!more) break;
        cur = nx; it = itn;
    }
}
__device__ __forceinline__ bool enter_group(Frame& F, int Gc) {
    if (F.G != 256 || Gc >= 256) return true;
    const int bx = (int)blockIdx.x, slot = bx >> 3, xcd = bx & 7, per = Gc >> 3;
    if (slot >= per) return false;
    F.vcu = xcd * per + slot; F.bid = slot * 8 + xcd; F.G = Gc; return true;
}
__device__ __forceinline__ void leave_group(Frame& F) { const int bx = (int)blockIdx.x, G = (int)gridDim.x; F.G = G; F.bid = bx; F.vcu = (G % 8 == 0) ? (bx % 8) * (G / 8) + bx / 8 : bx; }
__device__ __forceinline__ void p1_convert(Frame& F) {
    const int gw = F.vcu * NWAVES + F.wave, NGW = F.G * NWAVES, lane = F.lane;
    {
        LAS unsigned char* scr = F.lds + RING_OFF + F.wave * 9216;
        int it = gw;
        if (it < CV_TOTAL) {
            int ldw, K; CvtItem cur = cvt_item(F, it, ldw, K); f32x4 va[16], vb[16];
            cvt_load(cur, ldw, va, lane);
            for (;;) {
                int itn = it + NGW; int ldn = 0, Kn = 0; CvtItem nx = cur; const bool more = itn < CV_TOTAL;
                if (more) { nx = cvt_item(F, itn, ldn, Kn); cvt_load(nx, ldn, vb, lane); }
                cvt_store(cur, K, va, scr, lane);
                if (!more) break;
                it = itn + NGW; const bool more2 = it < CV_TOTAL; CvtItem n2 = nx; int ld2 = 0, K2 = 0;
                if (more2) { n2 = cvt_item(F, it, ld2, K2); cvt_load(n2, ld2, va, lane); }
                cvt_store(nx, Kn, vb, scr, lane);
                if (!more2) break;
                cur = n2; K = K2;
            }
        }
    }
}
__device__ __forceinline__ void mod_reduce_lds(Frame& F, int j0, int n, LAS float* dst) {
    const float* modp = wsp<float>(F, WS_MODP);
    for (int i = F.tid; i < n; i += NTHR) { const int j = j0 + i; float a = j < 6 * D ? F.in[IN_BADA][j] : F.in[IN_BAF][j - 6 * D];
#pragma unroll
        for (int ks = 0; ks < 32; ++ks) a += modp[ks * 16384 + j];
        dst[i] = a; }
}
__device__ __forceinline__ void modulate_row_bf16(const float* xrow, const float* g, const LAS float* sh, const LAS float* sc, bf16* orow, int lane) {
    const GAS f32x4* xr = (const GAS f32x4*)xrow + lane; f32x4 v[8]; float s2 = 0.f;
#pragma unroll
    for (int j = 0; j < 8; ++j) { v[j] = xr[64 * j]; s2 += (v[j].x * v[j].x + v[j].y * v[j].y) + (v[j].z * v[j].z + v[j].w * v[j].w); }
    const float r = rsqrtf(wave_sum(s2) * (1.f / D) + 1e-6f);
    GAS u32x2* o8 = (GAS u32x2*)orow + lane;
#pragma unroll
    for (int j = 0; j < 8; ++j) { const int c0 = 4 * lane + 256 * j; const f32x4 gg = *(const GAS f32x4*)(g + c0); const f32x4 a = *(const LAS f32x4*)(sc + c0), b = *(const LAS f32x4*)(sh + c0);
        const f32x4 y = v[j] * r * gg * (a + 1.f) + b; u32x2 w; w.x = pk2(y.x, y.y); w.y = pk2(y.z, y.w); o8[64 * j] = w; }
}
typedef float f32x16 __attribute__((ext_vector_type(16)));
typedef short s16x8g __attribute__((ext_vector_type(8)));
__device__ __forceinline__ void p1_modulate(Frame& F) {
    LAS float* shs = (LAS float*)(F.lds + RING_OFF + 81920);
    LAS float* gred = (LAS float*)(F.lds + RING_OFF + 98304);
    mod_reduce_lds(F, 0, 2 * D, shs);
    if (F.tid < 64) {
        const float* modp = wsp<float>(F, WS_MODP); float* mod = wsp<float>(F, WS_MOD);
        for (int j = blockIdx.x * 64 + F.tid; j < 16384; j += F.G * 64) { float a = j < 6 * D ? F.in[IN_BADA][j] : F.in[IN_BAF][j - 6 * D];
#pragma unroll
            for (int ks = 0; ks < 32; ++ks) a += modp[ks * 16384 + j];
            mod[j] = a; }
    }
    __syncthreads();
    bf16* hn = wsp<bf16>(F, WS_HN); const bf16* wg = wsp<bf16>(F, WS_WIN) + (size_t)NPP * D; float* gates = wsp<float>(F, WS_GATES);
    const int lane = F.lane, w = F.wave, hi = lane >> 5, l31 = lane & 31;
    for (int rb = F.vcu; rb < S / 32; rb += F.G) {
        const int row0 = rb * 32;
        {
            f32x4 xv[4][8];
#pragma unroll
            for (int i = 0; i < 4; ++i) { const GAS f32x4* xr = (const GAS f32x4*)(F.in[IN_X] + (size_t)(row0 + 4 * w + i) * D) + lane;
#pragma unroll
                for (int j = 0; j < 8; ++j) xv[i][j] = xr[64 * j]; }
#pragma unroll
            for (int i = 0; i < 4; ++i) { float s2 = 0.f;
#pragma unroll
                for (int j = 0; j < 8; ++j) s2 += (xv[i][j].x * xv[i][j].x + xv[i][j].y * xv[i][j].y) + (xv[i][j].z * xv[i][j].z + xv[i][j].w * xv[i][j].w);
                const float r = rsqrtf(wave_sum(s2) * (1.f / D) + 1e-6f);
                GAS u32x2* o8 = (GAS u32x2*)(hn + (size_t)(row0 + 4 * w + i) * D) + lane;
#pragma unroll
                for (int j = 0; j < 8; ++j) { const int c0 = 4 * lane + 256 * j; const f32x4 gg = *(const GAS f32x4*)(F.in[IN_NMIX] + c0); const f32x4 a = *(const LAS f32x4*)(shs + D + c0), b = *(const LAS f32x4*)(shs + c0);
                    const f32x4 y = xv[i][j] * r * gg * (a + 1.f) + b; u32x2 wv; wv.x = pk2(y.x, y.y); wv.y = pk2(y.z, y.w); o8[64 * j] = wv; } }
        }
        asm volatile("s_waitcnt vmcnt(0)" ::: "memory");
        __syncthreads();
        f32x16 acc;
#pragma unroll
        for (int r = 0; r < 16; ++r) acc[r] = 0.f;
        const bf16* ap = hn + (size_t)(row0 + l31) * D + 256 * w + 8 * hi; const bf16* bp = wg + (size_t)l31 * D + 256 * w + 8 * hi;
#pragma unroll
        for (int ks = 0; ks < 16; ++ks) { const s16x8g a = *(const GAS s16x8g*)(ap + 16 * ks), b = *(const GAS s16x8g*)(bp + 16 * ks); acc = __builtin_amdgcn_mfma_f32_32x32x16_bf16(a, b, acc, 0, 0, 0); }
        if (l31 < 16) {
#pragma unroll
            for (int r = 0; r < 16; ++r) gred[(w * 32 + (r & 3) + 8 * (r >> 2) + 4 * hi) * 16 + l31] = acc[r]; }
        __syncthreads();
        { const int row = F.tid >> 4, n = F.tid & 15; float s = 0.f;
#pragma unroll
            for (int q = 0; q < 8; ++q) s += gred[(q * 32 + row) * 16 + n];
            gates[(size_t)(row0 + row) * 16 + n] = s; }
        __syncthreads();
    }
    p1_convert(F);
}
using pg8::Unit; using pg8::cvt_pk_bf16;
struct EpiProj {
    static constexpr bool PERM = true, AFTER_DRAIN = false;
    bf16* O;
    __device__ __forceinline__ void operator()(const pg8::f32x4 (&acc)[2][2][4][2], const Unit& u, int wr, int wc, int fr, int fq) const {
        const int row0 = u.pm * 256 + wr * 64 + fr, col0 = u.pn * 256 + wc * 32 + 8 * fq;
#pragma unroll
        for (int ai = 0; ai < 2; ++ai)
#pragma unroll
            for (int m = 0; m < 4; ++m) { bf16* rowp = O + (size_t)(row0 + ai * 128 + m * 16) * NPP + col0;
#pragma unroll
                for (int bj = 0; bj < 2; ++bj) { const pg8::f32x4 v0 = acc[ai][bj][m][0], v1 = acc[ai][bj][m][1];
                    pg8::u32x4 w; w.x = cvt_pk_bf16(v0[0], v0[1]); w.y = cvt_pk_bf16(v0[2], v0[3]); w.z = cvt_pk_bf16(v1[0], v1[1]); w.w = cvt_pk_bf16(v1[2], v1[3]);
                    *(pg8::u32x4*)(rowp + bj * 128) = w; } }
    }
};
struct EpiOut {
    static constexpr bool PERM = false, AFTER_DRAIN = false;
    const float* x; const float* g1; float* h1;
    __device__ __forceinline__ void operator()(const pg8::f32x4 (&acc)[2][2][4][2], const Unit& u, int wr, int wc, int fr, int fq) const {
        const int row0 = u.pm * 256 + wr * 64 + fr, col0 = u.pn * 256 + wc * 32 + 4 * fq;
        pg8::f32x4 gv[2][2];
#pragma unroll
        for (int bj = 0; bj < 2; ++bj)
#pragma unroll
            for (int n = 0; n < 2; ++n) gv[bj][n] = *(const pg8::f32x4*)(g1 + col0 + bj * 128 + n * 16);
#pragma unroll
        for (int ai = 0; ai < 2; ++ai)
#pragma unroll
            for (int m = 0; m < 4; ++m) { const size_t off = (size_t)(row0 + ai * 128 + m * 16) * D + col0;
#pragma unroll
                for (int bj = 0; bj < 2; ++bj)
#pragma unroll
                    for (int n = 0; n < 2; ++n) { const pg8::f32x4 xv = *(const pg8::f32x4*)(x + off + bj * 128 + n * 16);
                        *(pg8::f32x4*)(h1 + off + bj * 128 + n * 16) = xv + gv[bj][n] * acc[ai][bj][m][n]; } }
    }
};
}
namespace fox {
constexpr int D = 128, SQ = 8192, SKV = 8192; constexpr float THR = 8.f; constexpr bool WSKIP = false;
constexpr int PITCH = 6144;
constexpr int OPITCH = 2048;
constexpr float SCALE = 0.08838834764831845f;
constexpr int NW = 8, QBLK = 32, KVBLK = 64, QB = NW * QBLK;
constexpr int SHM_V = KVBLK * D * 2, SHM_K = KVBLK * D * 2;
constexpr int LDS_BIAS = 2 * SHM_V + 2 * SHM_K + NW * 64 * 4;
constexpr int LDS_BYTES = LDS_BIAS + 512;

using bf16 = __hip_bfloat16;
typedef short bf16x8 __attribute__((ext_vector_type(8)));
typedef short s16x4 __attribute__((ext_vector_type(4)));
typedef float f32x16 __attribute__((ext_vector_type(16)));
typedef float f32x4 __attribute__((ext_vector_type(4)));
typedef unsigned u32x4 __attribute__((ext_vector_type(4)));
template <class A, class Bt> struct same_t { static constexpr bool v = false; };
template <class A> struct same_t<A, A> { static constexpr bool v = true; };

#define KSWZ(row, colB) ((row) * 256 + ((colB) ^ (((row) & 7) << 4)))
#define SBAR() __builtin_amdgcn_sched_barrier(0)
__device__ __forceinline__ int v_st(int k, int c) { const int kk = (k & ~0xC) | ((k & 4) << 1) | ((k & 8) >> 1); return ((kk >> 3) * 4 + (c >> 5)) * 512 + ((kk & 7) * 32 + (c & 31)) * 2; }
__device__ __forceinline__ int v_rd_base(int lane) { return ((lane & 3) << 3) | (((lane >> 2) & 3) << 6) | (((lane >> 4) & 1) << 5) | (((lane >> 5) & 1) << 8); }
constexpr int v_rd_off(int d0, int ks, int half) { return d0 * 512 + ks * 4096 + half * 2048; }
__device__ __forceinline__ int crow(int r, int hi) { return (r & 3) + 8 * (r >> 2) + 4 * hi; }
__device__ __forceinline__ int bias_slot(int kk) { return ((kk >> 2) & 1) * 32 + (kk >> 5) * 16 + (kk & 3) + 4 * ((kk & 31) >> 3); }
__device__ __forceinline__ unsigned cvtpk(float lo, float hi) {
    unsigned r; asm volatile("v_cvt_pk_bf16_f32 %0, %1, %2" : "=v"(r) : "v"(lo), "v"(hi)); return r;
}
__device__ __forceinline__ bf16x8 pack8(f32x4 a, f32x4 b) {
    u32x4 w = {cvtpk(a[0], a[1]), cvtpk(a[2], a[3]), cvtpk(b[0], b[1]), cvtpk(b[2], b[3])};
    return *reinterpret_cast<bf16x8*>(&w);
}
template <class T> __device__ __forceinline__ bf16x8 load8(const T* p) {
    if constexpr (same_t<T, float>::v) { return pack8(*(const f32x4*)p, *(const f32x4*)(p + 4)); }
    else { return *reinterpret_cast<const bf16x8*>(p); }
}
__device__ __forceinline__ void mask_tile(f32x16& p0, f32x16& p1, int dq, unsigned W) {
    const float NEG = -__builtin_inff();
#pragma unroll
    for (int r = 0; r < 16; ++r) {
        const int c = (r & 3) + 8 * (r >> 2);
        if ((unsigned)(dq - c) >= W) p0[r] = NEG;
        if ((unsigned)(dq - c - 32) >= W) p1[r] = NEG;
    }
}
__device__ __forceinline__ void partialSM(f32x16& p0, f32x16& p1, float& m_reg, float& mn, float& alpha) {
    float pmax = p0[0]; for (int r = 1; r < 16; ++r) pmax = fmaxf(pmax, p0[r]); for (int r = 0; r < 16; ++r) pmax = fmaxf(pmax, p1[r]);
    { auto rr = __builtin_amdgcn_permlane32_swap(__float_as_uint(pmax), __float_as_uint(pmax), false, false);
      pmax = fmaxf(__uint_as_float(rr[0]), __uint_as_float(rr[1])); }
    constexpr float C2 = 1.4426950408889634f * SCALE;
    if (__builtin_expect(__all((pmax - m_reg) * SCALE <= THR), 1)) { mn = m_reg; alpha = 1.f; }
    else { mn = fmaxf(m_reg, pmax); alpha = __builtin_amdgcn_exp2f((m_reg - mn) * C2); m_reg = mn; }
    const float mnL = -mn * C2;
    for (int r = 0; r < 16; ++r) p0[r] = fmaf(p0[r], C2, mnL); for (int r = 0; r < 16; ++r) p1[r] = fmaf(p1[r], C2, mnL);
    for (int r = 0; r < 16; ++r) p0[r] = __builtin_amdgcn_exp2f(p0[r]);
}
__device__ __forceinline__ void finishSM(f32x16& p0, f32x16& p1, float alpha, float& l_reg, bf16x8& pa0, bf16x8& pa1, bf16x8& pa2, bf16x8& pa3) {
    for (int r = 0; r < 16; ++r) p1[r] = __builtin_amdgcn_exp2f(p1[r]);
    float ps = 0; for (int r = 0; r < 16; ++r) ps += p0[r]; for (int r = 0; r < 16; ++r) ps += p1[r];
    { auto rr = __builtin_amdgcn_permlane32_swap(__float_as_uint(ps), __float_as_uint(ps), false, false);
      ps = __uint_as_float(rr[0]) + __uint_as_float(rr[1]); }
    l_reg = l_reg * alpha + ps;
#define PK4(P, B_, OUT) do { unsigned a0 = cvtpk(P[B_+0], P[B_+1]), a1 = cvtpk(P[B_+2], P[B_+3]);                          \
        unsigned b0 = cvtpk(P[B_+4], P[B_+5]), b1 = cvtpk(P[B_+6], P[B_+7]);                                             \
        auto r0 = __builtin_amdgcn_permlane32_swap(a0, b0, false, false); auto r1 = __builtin_amdgcn_permlane32_swap(a1, b1, false, false); \
        u32x4 w = {r0[0], r1[0], r0[1], r1[1]}; OUT = *reinterpret_cast<bf16x8*>(&w); } while (0)
    PK4(p0, 0, pa0); PK4(p0, 8, pa1); PK4(p1, 0, pa2); PK4(p1, 8, pa3);
#undef PK4
}
template <int KB, bool SK>
__device__ __forceinline__ void qkt(f32x16& p0, f32x16& p1, const char* K_lds, int r32, int hi, const bf16x8* qr, bool act) {
    if (SK && !act) { const float NEG = -__builtin_inff();
#pragma unroll
        for (int r = 0; r < 16; ++r) { p0[r] = NEG; p1[r] = NEG; } return; }
    { const f32x16* bp = reinterpret_cast<const f32x16*>(K_lds - 2 * SHM_V + LDS_BIAS + KB * 256 + hi * 128); p0 = bp[0]; p1 = bp[1]; }
    const char* kb[4];
#pragma unroll
    for (int dd = 0; dd < 4; ++dd) kb[dd] = K_lds + KB * SHM_K + KSWZ(r32, (dd * 16 + hi * 8) * 2);
#pragma unroll
    for (int d0 = 0; d0 < 8; ++d0) { const char* a = kb[d0 & 3] + (d0 >> 2) * 128;
        bf16x8 b0 = *reinterpret_cast<const bf16x8*>(a);
        bf16x8 b1 = *reinterpret_cast<const bf16x8*>(a + 32 * 256);
        p0 = __builtin_amdgcn_mfma_f32_32x32x16_bf16(b0, qr[d0], p0, 0, 0, 0);
        p1 = __builtin_amdgcn_mfma_f32_32x32x16_bf16(b1, qr[d0], p1, 0, 0, 0); }
}
template <int VB, bool SK>
__device__ __forceinline__ void pv_tile(f32x16* o, int vb0, bf16x8 pa0, bf16x8 pa1, bf16x8 pa2, bf16x8 pa3, bool act) {
    if (SK && !act) return;
#define TRRD(dst, off) asm volatile("ds_read_b64_tr_b16 %0, %1 offset:%2" : "=&v"(dst) : "v"(vb0), "i"(off) : "memory")
#define PV_D0(d0) do { s16x4 l0, l1, l2, l3, h0, h1, h2, h3; constexpr int b_ = VB * SHM_V + v_rd_off(d0, 0, 0);     \
        TRRD(l0, b_); TRRD(h0, b_ + 2048); TRRD(l1, b_ + 4096); TRRD(h1, b_ + 6144); TRRD(l2, b_ + 8192); TRRD(h2, b_ + 10240); TRRD(l3, b_ + 12288); TRRD(h3, b_ + 14336); \
        asm volatile("s_waitcnt lgkmcnt(0)" ::: "memory"); SBAR();                 \
        o[d0] = __builtin_amdgcn_mfma_f32_32x32x16_bf16(pa0, (bf16x8){l0[0], l0[1], l0[2], l0[3], h0[0], h0[1], h0[2], h0[3]}, o[d0], 0, 0, 0);   \
        o[d0] = __builtin_amdgcn_mfma_f32_32x32x16_bf16(pa1, (bf16x8){l1[0], l1[1], l1[2], l1[3], h1[0], h1[1], h1[2], h1[3]}, o[d0], 0, 0, 0);   \
        o[d0] = __builtin_amdgcn_mfma_f32_32x32x16_bf16(pa2, (bf16x8){l2[0], l2[1], l2[2], l2[3], h2[0], h2[1], h2[2], h2[3]}, o[d0], 0, 0, 0);   \
        o[d0] = __builtin_amdgcn_mfma_f32_32x32x16_bf16(pa3, (bf16x8){l3[0], l3[1], l3[2], l3[3], h3[0], h3[1], h3[2], h3[3]}, o[d0], 0, 0, 0); } while (0)
    PV_D0(0); PV_D0(1); PV_D0(2); PV_D0(3);
#undef PV_D0
#undef TRRD
}

template <class TIn, class TOut> struct BlockRef { const TIn* Q; const TIn* K; const TIn* V; TOut* O; int P0; const float* Fb; const float* gain;
    int jlo, jhi;
    float* Op; float* ML; };
template <class TIn> struct Seam {
    bf16x8 qr[8];
    bf16x8 st_v0, st_v1, st_k0, st_k1; f32x4 sf0, sf1, sf2, sf3; float st_b;
    f32x4 tq[16];
};
__device__ __forceinline__ int swa_jlo(int P0, int W) { const int lowk = P0 - W + 1; return lowk > 0 ? lowk / KVBLK : 0; }
#define ROW(p, k0, rr) ((p) + (size_t)((k0) + (rr)) * PITCH + sc)
#define VMW() asm volatile("s_waitcnt vmcnt(0)" ::: "memory")
#define VMWN(n) asm volatile("s_waitcnt vmcnt(%0)" :: "i"(n) : "memory")
#define SLOAD_H(Kp, Vp, k0) SLOAD_HB(Kp, Vp, k0, cur)
#define SLOAD_HB(Kp, Vp, k0, blk) do { S.st_v0 = load8<TIn>(ROW(Vp, k0, sr)); S.st_v1 = load8<TIn>(ROW(Vp, k0, 32 + sr));              \
                         S.st_k0 = load8<TIn>(ROW(Kp, k0, sr)); S.st_k1 = load8<TIn>(ROW(Kp, k0, 32 + sr)); \
                         if (tid < 64) S.st_b = ((blk).Fb[(blk).P0] - (blk).Fb[(k0) + tid]) * (1.0f / SCALE); } while (0)
#define SWRITE_HK(bf) do { *(bf16x8*)(K_lds + (bf) * SHM_K + kws) = S.st_k0; *(bf16x8*)(K_lds + (bf) * SHM_K + kws + 32 * 256) = S.st_k1; \
                         if (tid < 64) *(float*)(K_lds - 2 * SHM_V + LDS_BIAS + (bf) * 256 + bws) = S.st_b; } while (0)
#define SWRITE_HV(bf) do { *(bf16x8*)(V_lds + (bf) * SHM_V + vst0) = S.st_v0; *(bf16x8*)(V_lds + (bf) * SHM_V + vst1) = S.st_v1; } while (0)
#define SWRITE_H(bf) do { SWRITE_HV(bf); SWRITE_HK(bf); } while (0)
#define SLOAD_F(p, k0) do { S.sf0 = *(const f32x4*)ROW(p, k0, sr); S.sf1 = *(const f32x4*)(ROW(p, k0, sr) + 4);                \
                            S.sf2 = *(const f32x4*)ROW(p, k0, 32 + sr); S.sf3 = *(const f32x4*)(ROW(p, k0, 32 + sr) + 4); } while (0)
#define SWRITE_KF(bf) do { *(bf16x8*)(K_lds + (bf) * SHM_K + kws) = pack8(S.sf0, S.sf1); *(bf16x8*)(K_lds + (bf) * SHM_K + kws + 32 * 256) = pack8(S.sf2, S.sf3); } while (0)
#define SWRITE_VF(bf) do { *(bf16x8*)(V_lds + (bf) * SHM_V + vst0) = pack8(S.sf0, S.sf1); *(bf16x8*)(V_lds + (bf) * SHM_V + vst1) = pack8(S.sf2, S.sf3); } while (0)
template <class TIn, class TOut>
__device__ __forceinline__ void causal_swa_prime(const BlockRef<TIn, TOut>& cur, int W, char* lds, Seam<TIn>& S) {
    constexpr bool F32 = same_t<TIn, float>::v;
    const int tid = threadIdx.x, wid = __builtin_amdgcn_readfirstlane(tid >> 6), lane = tid & 63, r32 = lane & 31, hi = lane >> 5;
    const int sr = tid >> 4, sc = (tid & 15) * 8, kws = KSWZ(sr, sc * 2); char* K_lds = lds + 2 * SHM_V;
    const int bws = bias_slot(tid & 63) * 4;
    const int kb0 = cur.jlo * KVBLK;
    for (int d0 = 0; d0 < 8; ++d0) S.qr[d0] = load8<TIn>(cur.Q + (size_t)(wid * QBLK + r32) * PITCH + d0 * 16 + hi * 8);
    if constexpr (F32) { SLOAD_F((const float*)cur.K, kb0); VMW(); SWRITE_KF(0); SBAR(); SLOAD_F((const float*)cur.V, kb0); }
    else { SLOAD_H(cur.K, cur.V, kb0); VMW(); SWRITE_HK(0); }
    __syncthreads();
}
template <class TIn, class TOut>
__device__ __forceinline__ void causal_swa_block(const BlockRef<TIn, TOut>& cur, const BlockRef<TIn, TOut>& nxt, int skv, int W, char* lds, Seam<TIn>& S) {
    constexpr bool F32 = same_t<TIn, float>::v;
    const int tid = threadIdx.x, wid = __builtin_amdgcn_readfirstlane(tid >> 6), lane = tid & 63, r32 = lane & 31, hi = lane >> 5;
    const int j_lo = cur.jlo; const int j_hi = cur.jhi;
    const int NT = j_hi - j_lo;
    const int kbn = nxt.jlo * KVBLK;
    const int qlo = cur.P0 + wid * QBLK, qm = qlo + r32 - 4 * hi;
    char* V_lds = lds; char* K_lds = lds + 2 * SHM_V;
    float* ws = (float*)(lds + 2 * SHM_V + 2 * SHM_K) + wid * 64; float* li_l = ws, * al_l = ws + 32;
    float m_reg = -1e30f, l_reg = 0; f32x16 o[4] = {};
    const int sr = tid >> 4, sc = (tid & 15) * 8, vst0 = v_st(sr, sc), vst1 = v_st(32 + sr, sc), kws = KSWZ(sr, sc * 2);
    const int bws = bias_slot(tid & 63) * 4;
    const int vb0 = (int)(uintptr_t)V_lds + v_rd_base(lane);
    const TIn* Kh = cur.K; const TIn* Vh = cur.V;
#define RESC(a) do { if (__any((a) < 1.f)) { if (hi == 0) al_l[r32] = (a); asm volatile("s_waitcnt lgkmcnt(0)" ::: "memory");              \
                     for (int d_ = 0; d_ < 4; ++d_) for (int r = 0; r < 16; ++r) o[d_][r] *= al_l[crow(r, hi)]; } } while (0)
#define KBASE(t) ((j_lo + (t)) * KVBLK)
#define ACT(t) (KBASE(t) <= qlo + QBLK - 1 && KBASE(t) + KVBLK - 1 >= qlo - W + 1)
#define MASKT(P0_, P1_, t) do { const int kb_ = KBASE(t); if ((!SK || ACT(t)) && (kb_ + KVBLK - 1 > qlo || kb_ <= qlo + QBLK - 1 - W)) mask_tile(P0_, P1_, qm - kb_, (unsigned)W); } while (0)
    constexpr int NQL = F32 ? 16 : 8;
    constexpr bool SK = WSKIP && !F32;
#define SEAM_K0() do { VMWN(NQL); if constexpr (F32) { SWRITE_KF(0); SBAR(); SLOAD_F((const float*)nxt.V, kbn); } else { SWRITE_HK(0); } SBAR(); } while (0)
    f32x16 pA0, pA1, pB0, pB1; float mnA, mnB, alA, alB; bf16x8 pa0, pa1, pa2, pa3;
    if constexpr (F32) { VMW(); SWRITE_VF(0); SBAR(); } else { SWRITE_HV(0); SBAR(); }
    if (NT > 1) { if constexpr (F32) SLOAD_F((const float*)Kh, KBASE(1)); else SLOAD_H(Kh, Vh, KBASE(1)); }
    SBAR(); qkt<0, SK>(pA0, pA1, K_lds, r32, hi, S.qr, ACT(0));
    if constexpr (F32) { if (NT > 1) { VMW(); SWRITE_KF(1); SBAR(); SLOAD_F((const float*)Vh, KBASE(1)); } }
    MASKT(pA0, pA1, 0); partialSM(pA0, pA1, m_reg, mnA, alA);
    if (NT > 1) { VMW(); if constexpr (F32) { SWRITE_VF(1); SBAR(); if (NT > 2) SLOAD_F((const float*)Kh, KBASE(2)); } else SWRITE_H(1); }
    __syncthreads();
#define HALF_STEP(PX0, PX1, mnX, alX, PY0, PY1, alY, t, KB, VB, SB) do {                                                      \
        SBAR(); qkt<KB, SK>(PX0, PX1, K_lds, r32, hi, S.qr, ACT(t));                                             \
        finishSM(PY0, PY1, alY, l_reg, pa0, pa1, pa2, pa3); SBAR();                                                           \
        if ((t) + 1 < NT) { if constexpr (F32) { VMW(); SWRITE_KF(SB); SBAR(); SLOAD_F((const float*)Vh, KBASE((t) + 1)); }  \
                            else { SLOAD_H(Kh, Vh, KBASE((t) + 1)); } SBAR(); }                                               \
        pv_tile<VB, SK>(o, vb0, pa0, pa1, pa2, pa3, ACT((t) - 1)); MASKT(PX0, PX1, (t)); partialSM(PX0, PX1, m_reg, mnX, alX);                                        \
        __syncthreads();                                                                                                      \
        if ((t) + 1 < NT) { VMW(); if constexpr (F32) { SWRITE_VF(SB); SBAR(); if ((t) + 2 < NT) SLOAD_F((const float*)Kh, KBASE((t) + 2)); } \
                            else { SWRITE_H(SB); } }                                                                          \
        RESC(alX); __syncthreads(); } while (0)
    for (int t = 1; t + 1 < NT; t += 2) {
        HALF_STEP(pB0, pB1, mnB, alB, pA0, pA1, alA, t, 1, 0, 0);
        HALF_STEP(pA0, pA1, mnA, alA, pB0, pB1, alB, t + 1, 0, 1, 1);
    }
    const bool even = (NT & 1) == 0;
    if (even) { SBAR(); qkt<1, SK>(pB0, pB1, K_lds, r32, hi, S.qr, ACT(NT - 1)); SBAR(); }
#define QROW(e) (nxt.Q + (size_t)(wid * QBLK + r32) * PITCH + ((e) >> 1) * 16 + hi * 8 + ((e) & 1) * 4)
    if constexpr (F32) { SLOAD_F((const float*)nxt.K, kbn); SBAR();
#pragma unroll
        for (int e = 0; e < 8; ++e) S.tq[e] = *(const f32x4*)QROW(e); }
    else { SLOAD_HB(nxt.K, nxt.V, kbn, nxt); SBAR();
#pragma unroll
        for (int d0 = 0; d0 < 8; ++d0) S.qr[d0] = load8<TIn>(nxt.Q + (size_t)(wid * QBLK + r32) * PITCH + d0 * 16 + hi * 8); }
    SBAR();
    finishSM(pA0, pA1, alA, l_reg, pa0, pa1, pa2, pa3); SBAR();
    if constexpr (F32) {
#pragma unroll
        for (int e = 8; e < 16; ++e) S.tq[e] = *(const f32x4*)QROW(e); SBAR(); }
#undef QROW
    pv_tile<0, SK>(o, vb0, pa0, pa1, pa2, pa3, ACT(even ? NT - 2 : NT - 1));
    if (even) { MASKT(pB0, pB1, NT - 1); partialSM(pB0, pB1, m_reg, mnB, alB); __syncthreads(); RESC(alB);
        finishSM(pB0, pB1, alB, l_reg, pa0, pa1, pa2, pa3); SBAR(); pv_tile<1, SK>(o, vb0, pa0, pa1, pa2, pa3, ACT(NT - 1)); }
    SBAR(); SEAM_K0();
    if (hi == 0) li_l[r32] = l_reg; asm volatile("s_waitcnt lgkmcnt(0)" ::: "memory");
    if (cur.Op != nullptr) {
        int rp = r32; asm volatile("" : "+v"(rp));
        if (hi == 0) { float2 mlv; mlv.x = m_reg; mlv.y = l_reg; *(float2*)(cur.ML + 2 * (wid * QBLK + rp)) = mlv; }
        float* Pr = cur.Op + (size_t)(wid * QBLK + 4 * hi) * D + rp;
#pragma unroll
        for (int r = 0; r < 16; ++r) {
#pragma unroll
            for (int d0 = 0; d0 < 4; ++d0) Pr[d0 * 32] = o[d0][r];
            Pr += ((r & 3) == 3 ? 5 : 1) * D; asm volatile("" : "+v"(Pr) :: "memory"); }
    } else {
    int ro = r32; asm volatile("" : "+v"(ro));
    TOut* Or = cur.O + (size_t)(wid * QBLK + 4 * hi) * OPITCH + ro;
    float gn[4];
#pragma unroll
    for (int d0 = 0; d0 < 4; ++d0) gn[d0] = cur.gain[d0 * 32 + ro];
#pragma unroll
    for (int r = 0; r < 16; ++r) { const int orow = crow(r, hi); const float rl = __builtin_amdgcn_rcpf(li_l[orow]);
        float v[4]; float ss = 0.f;
#pragma unroll
        for (int d0 = 0; d0 < 4; ++d0) { v[d0] = o[d0][r] * rl; ss += v[d0] * v[d0]; }
        ss += __shfl_xor(ss, 1); ss += __shfl_xor(ss, 2); ss += __shfl_xor(ss, 4); ss += __shfl_xor(ss, 8); ss += __shfl_xor(ss, 16);
        const float rn = __builtin_amdgcn_rsqf(ss * (1.0f / 128.0f) + 1e-6f);
#pragma unroll
        for (int d0 = 0; d0 < 4; ++d0) { const float vv = v[d0] * rn * gn[d0]; const float vn = __shfl_xor(vv, 1);
            if ((ro & 1) == 0) *(unsigned*)(Or + d0 * 32) = cvtpk(vv, vn); }
        Or += ((r & 3) == 3 ? 5 : 1) * OPITCH; asm volatile("" : "+v"(Or) :: "memory"); }
    }
    if constexpr (F32) {
#pragma unroll
        for (int d0 = 0; d0 < 8; ++d0) S.qr[d0] = pack8(S.tq[2 * d0], S.tq[2 * d0 + 1]); }
    __syncthreads();
#undef RESC
#undef KBASE
#undef ACT
#undef MASKT
#undef SEAM_K0
#undef HALF_STEP
}
#undef ROW
#undef VMW
#undef VMWN
#undef SLOAD_H
#undef SWRITE_HK
#undef SWRITE_HV
#undef SWRITE_H
#undef SLOAD_F
#undef SWRITE_KF
#undef SWRITE_VF

}
namespace mk {
typedef short s16x8 __attribute__((ext_vector_type(8)));
#define MFMA32(a, b, c) __builtin_amdgcn_mfma_f32_32x32x16_bf16((a), (b), (c), 0, 0, 0)
__device__ __forceinline__ int crow32(int r, int hi) { return (r & 3) + 8 * (r >> 2) + 4 * hi; }
constexpr float SCALEQ = 0.08838834764831845f;
__device__ __forceinline__ float wave_scan_add(float v, int lane) {
#pragma unroll
    for (int o = 1; o < 64; o <<= 1) { const float t = __shfl_up(v, o); if (lane >= o) v += t; }
    return v;
}
__device__ __forceinline__ float wave_scan_max(float v, int lane) {
#pragma unroll
    for (int o = 1; o < 64; o <<= 1) { const float t = __shfl_up(v, o); if (lane >= o) v = fmaxf(v, t); }
    return v;
}
__device__ __forceinline__ float wave_max(float v) {
#pragma unroll
    for (int o = 1; o < 64; o <<= 1) v = fmaxf(v, __shfl_xor(v, o));
    return v;
}
constexpr int TSTR = 72;
template <bool SCALED>
__device__ __forceinline__ void stage_transposed(const bf16* src, int ncols, LAS bf16* T, const LAS float* wl, int tid) {
    const int cpr = ncols / 8;
    for (int q = tid; q < 64 * cpr; q += NTHR) { const int s = q / cpr, c8 = (q % cpr) * 8;
        const v4u raw = *(const GAS v4u*)(src + (size_t)s * NPP + c8);
        const unsigned w4[4] = {raw.x, raw.y, raw.z, raw.w};
#pragma unroll
        for (int j = 0; j < 4; ++j) { unsigned lo = w4[j] & 0xffffu, hi = w4[j] >> 16;
            if (SCALED) { const float sc = wl[s]; lo = f2bf(bf2f((unsigned short)lo) * sc); hi = f2bf(bf2f((unsigned short)hi) * sc); }
            T[(c8 + 2 * j) * TSTR + s] = (bf16)lo; T[(c8 + 2 * j + 1) * TSTR + s] = (bf16)hi; } }
}
__device__ __forceinline__ void p_fscan(Frame& F, int h) {
    const int tid = F.tid, lane = F.lane; const float* gates = wsp<float>(F, WS_GATES);
        const float b = F.in[IN_FOXBF][h]; float* Fo = wsp<float>(F, WS_F) + h * S;
        LAS double* tot = (LAS double*)(F.lds + RING_OFF);
        double loc[16]; double acc = 0.0;
#pragma unroll
        for (int i = 0; i < 16; ++i) { acc += (double)log_sigmoid_f(gates[(size_t)(tid * 16 + i) * 16 + 8 + h] + b); loc[i] = acc; }
        tot[tid] = acc;
        __syncthreads();
        if (F.wave == 0) { double v[8]; double s = 0.0;
#pragma unroll
            for (int i = 0; i < 8; ++i) { v[i] = tot[lane * 8 + i]; s += v[i]; }
            double inc = s;
#pragma unroll
            for (int o = 1; o < 64; o <<= 1) { const double t = __shfl_up(inc, o); if (lane >= o) inc += t; }
            double ex = inc - s;
#pragma unroll
            for (int i = 0; i < 8; ++i) { tot[lane * 8 + i] = ex; ex += v[i]; } }
        __syncthreads();
        const double off = tot[tid];
        LAS float* Fl = (LAS float*)(F.lds + RING_OFF + 8192);
#pragma unroll
        for (int i = 0; i < 16; ++i) { const float fv = (float)(off + loc[i]); Fo[tid * 16 + i] = fv; Fl[tid * 16 + i] = fv; }
        __syncthreads();
        if (tid < 32) {
            float gq = 0.f, gk = 0.f;
#pragma unroll
            for (int j = 0; j < 4; ++j) { gq = fmaxf(gq, fabsf(F.in[IN_FOXQN][tid + 32 * j])); gk = fmaxf(gk, fabsf(F.in[IN_FOXKN][tid + 32 * j])); }
#pragma unroll
            for (int o = 1; o < 32; o <<= 1) { gq = fmaxf(gq, __shfl_xor(gq, o)); gk = fmaxf(gk, __shfl_xor(gk, o)); }
            const float thr = 2.f * 11.3137085f * gq * gk + 26.f;
            const int qb = tid, P0 = qb * 256; const float f0 = Fl[P0];
            int lo = 0, hi2 = 4 * qb;
            while (lo < hi2) { const int mid = (lo + hi2) >> 1; if (Fl[64 * mid + 63] - f0 <= thr) hi2 = mid; else lo = mid + 1; }
            wsp<int>(F, WS_JLO)[h * 32 + qb] = lo;
        }
        __syncthreads();
}
__device__ __forceinline__ void p3_prep(Frame& F) {
    const int gw = F.vcu * NWAVES + F.wave, NGW = F.G * NWAVES, lane = F.lane, tid = F.tid;
    bf16* proj = wsp<bf16>(F, WS_PROJ); const float* gates = wsp<float>(F, WS_GATES);
    {
        const int seg = lane >> 2, qd = (lane & 3) * 32; const float* gn = (seg < 8 ? F.in[IN_FOXQN] : F.in[IN_FOXKN]) + qd;
        for (int m0 = gw; m0 < S; m0 += 4 * NGW) {
            v4u raw[4][4];
#pragma unroll
            for (int i = 0; i < 4; ++i) { const int m = m0 + i * NGW; if (m < S) { const bf16* p = proj + (size_t)m * NPP + C_FQ + seg * 128 + qd;
#pragma unroll
                for (int j = 0; j < 4; ++j) raw[i][j] = *(const GAS v4u*)(p + 8 * j); } }
#pragma unroll
            for (int i = 0; i < 4; ++i) { const int m = m0 + i * NGW; if (m < S) { bf16* p = proj + (size_t)m * NPP + C_FQ + seg * 128 + qd; float x[32]; float ss = 0.f;
#pragma unroll
                for (int j = 0; j < 4; ++j) { const unsigned w4[4] = {raw[i][j].x, raw[i][j].y, raw[i][j].z, raw[i][j].w};
#pragma unroll
                    for (int k = 0; k < 4; ++k) { x[8 * j + 2 * k] = bf2f((unsigned short)(w4[k] & 0xffffu)); x[8 * j + 2 * k + 1] = bf2f((unsigned short)(w4[k] >> 16)); } }
#pragma unroll
                for (int k = 0; k < 32; ++k) ss += x[k] * x[k];
                ss += __shfl_xor(ss, 1); ss += __shfl_xor(ss, 2);
                const float r = rsqrtf(ss * (1.f / 128.f) + 1e-6f);
#pragma unroll
                for (int j = 0; j < 4; ++j) { v4u o; const f32x4 g0 = *(const GAS f32x4*)(gn + 8 * j), g1 = *(const GAS f32x4*)(gn + 8 * j + 4);
                    o.x = pk2(x[8 * j] * r * g0.x, x[8 * j + 1] * r * g0.y); o.y = pk2(x[8 * j + 2] * r * g0.z, x[8 * j + 3] * r * g0.w);
                    o.z = pk2(x[8 * j + 4] * r * g1.x, x[8 * j + 5] * r * g1.y); o.w = pk2(x[8 * j + 6] * r * g1.z, x[8 * j + 7] * r * g1.w);
                    *(GAS v4u*)(p + 8 * j) = o; } } }
        }
    }
    if (F.G != 256 && blockIdx.x < 8) p_fscan(F, (int)blockIdx.x);
    {
        LAS bf16* KT = (LAS bf16*)(F.lds + RING_OFF);
        LAS bf16* VT = KT + 128 * TSTR;
        LAS float* wl = (LAS float*)(VT + 256 * TSTR);
        float* UL = wsp<float>(F, WS_UL); float* NL = wsp<float>(F, WS_NL); float* GLAL = wsp<float>(F, WS_GLAL);
        const int hi = lane >> 5, l31 = lane & 31, w = F.wave;
        for (int u = F.vcu; u < 4 * NCH; u += F.G) {
            const int h = u >> 7, ch = u & 127, t0 = ch * LCH;
            if (w == 0) {
                const float ip = softcap_f(gates[(size_t)(t0 + lane) * 16 + h] + F.in[IN_BI][h]);
                const float fp = softcap_f(gates[(size_t)(t0 + lane) * 16 + 4 + h] + F.in[IN_BF][h]);
                const float g = wave_scan_add(log_sigmoid_f(fp), lane), a = ip - g, amax = wave_max(a);
                wl[lane] = __expf(a - amax);
                if (lane == 63) { GLAL[u * 2] = g; GLAL[u * 2 + 1] = amax; }
            }
            __syncthreads();
            stage_transposed<true>(proj + (size_t)t0 * NPP + C_MK + h * 128, 128, KT, wl, tid);
            stage_transposed<false>(proj + (size_t)t0 * NPP + C_MV + h * 256, 256, VT, wl, tid);
            __syncthreads();
            f32x16 acc[4];
#pragma unroll
            for (int dt = 0; dt < 4; ++dt)
#pragma unroll
                for (int r = 0; r < 16; ++r) acc[dt][r] = 0.f;
#pragma unroll
            for (int ks = 0; ks < 4; ++ks) { const s16x8 a = *(const LAS s16x8*)(VT + (32 * w + l31) * TSTR + 16 * ks + 8 * hi);
#pragma unroll
                for (int dt = 0; dt < 4; ++dt) { const s16x8 b = *(const LAS s16x8*)(KT + (32 * dt + l31) * TSTR + 16 * ks + 8 * hi); acc[dt] = MFMA32(a, b, acc[dt]); } }
            float* ut = UL + (size_t)u * 256 * 128;
#pragma unroll
            for (int dt = 0; dt < 4; ++dt)
#pragma unroll
                for (int r = 0; r < 16; ++r) ut[(size_t)(32 * w + crow32(r, hi)) * 128 + 32 * dt + l31] = acc[dt][r];
            if (tid < 128) { float s = 0.f;
#pragma unroll
                for (int j = 0; j < 8; ++j) { const s16x8 kv = *(const LAS s16x8*)(KT + tid * TSTR + 8 * j);
#pragma unroll
                    for (int i = 0; i < 8; ++i) s += bf2f((unsigned short)kv[i]); }
                NL[u * 128 + tid] = s; }
            __syncthreads();
        }
    }
}
__device__ __forceinline__ void p4_scan(Frame& F) {
    LAS float* gl = (LAS float*)(F.lds + RING_OFF);
    LAS float* dec = gl + 256; LAS float* scl = dec + 128; LAS float* mv = scl + 128;
    const float* UL = wsp<float>(F, WS_UL); const float* NL = wsp<float>(F, WS_NL); const float* GLAL = wsp<float>(F, WS_GLAL);
    bf16* CS = wsp<bf16>(F, WS_CS); float* NS = wsp<float>(F, WS_NS); float* MS = wsp<float>(F, WS_MS);
    const int tid = F.tid;
    for (int blk = F.vcu; blk < 4 * 64; blk += F.G) {
        const int h = blk >> 6, rem0 = (blk & 63) * 512;
        if (tid < 256) gl[tid] = GLAL[h * 256 + tid];
        __syncthreads();
        if (tid == 0) { float m = 0.f;
            for (int c = 0; c < NCH; ++c) { const float g = gl[2 * c], al = gl[2 * c + 1], mn = g + fmaxf(m, al);
                mv[c] = m; dec[c] = __expf(g + m - mn); scl[c] = __expf(g + al - mn); m = mn; } }
        __syncthreads();
        if (rem0 == 0 && tid < 128) MS[h * 128 + tid] = mv[tid];
        const int rem = rem0 + tid;
        const float* ul = UL + (size_t)h * NCH * 32768 + rem; bf16* cs = CS + (size_t)h * NCH * 32768 + rem;
        float C = 0.f;
#pragma unroll 1
        for (int c0 = 0; c0 < NCH; c0 += 64) {
            float u[64];
#pragma unroll
            for (int i = 0; i < 64; ++i) u[i] = ul[(size_t)(c0 + i) * 32768];
#pragma unroll
            for (int i = 0; i < 64; ++i) { cs[(size_t)(c0 + i) * 32768] = (bf16)f2bf(C); C = dec[c0 + i] * C + scl[c0 + i] * u[i]; }
        }
        if (rem0 == 0 && tid < 128) { float n = 0.f; const float* nl = NL + (size_t)h * NCH * 128 + tid; float* ns = NS + (size_t)h * NCH * 128 + tid;
#pragma unroll 8
            for (int c = 0; c < NCH; ++c) { ns[c * 128] = n; n = dec[c] * n + scl[c] * nl[c * 128]; } }
        __syncthreads();
    }
}
constexpr int NUMSTR = 260;
__device__ __forceinline__ void p5_mlstm_out(Frame& F) {
    LAS bf16* VT = (LAS bf16*)(F.lds + RING_OFF);
    LAS bf16* Pm = VT + 256 * TSTR;
    LAS float* NUM = (LAS float*)(Pm + 64 * TSTR);
    LAS float* a_s = NUM + 64 * NUMSTR; LAS float* Mt = a_s + 64; LAS float* inter = Mt + 64; LAS float* emt = inter + 64; LAS float* qn = emt + 64; LAS float* dinv = qn + 64;
    const bf16* proj = wsp<bf16>(F, WS_PROJ); const float* gates = wsp<float>(F, WS_GATES); const bf16* CS = wsp<bf16>(F, WS_CS);
    const float* NS = wsp<float>(F, WS_NS); const float* MS = wsp<float>(F, WS_MS); bf16* concat = wsp<bf16>(F, WS_CONCAT);
    const int tid = F.tid, lane = F.lane, w = F.wave, hi = lane >> 5, l31 = lane & 31;
    for (int u = F.vcu; u < 4 * NCH; u += F.G) {
        const int h = u >> 7, ch = u & 127, t0 = ch * LCH;
        const bf16* qbase = proj + (size_t)t0 * NPP + C_MQ + h * 128; const bf16* kbase = proj + (size_t)t0 * NPP + C_MK + h * 128;
        if (w == 0) {
            const float ip = softcap_f(gates[(size_t)(t0 + lane) * 16 + h] + F.in[IN_BI][h]);
            const float fp = softcap_f(gates[(size_t)(t0 + lane) * 16 + 4 + h] + F.in[IN_BF][h]);
            const float g = wave_scan_add(log_sigmoid_f(fp), lane), a = ip - g, cm = wave_scan_max(a, lane);
            const float mp = MS[u], M = fmaxf(mp, cm);
            a_s[lane] = a; Mt[lane] = M; inter[lane] = __expf(mp - M); emt[lane] = __expf(-(g + M));
        }
        stage_transposed<false>(proj + (size_t)t0 * NPP + C_MV + h * 256, 256, VT, a_s, tid);
        __syncthreads();
        if (w < 4) {
            const int ti = w >> 1, si = w & 1;
            if (si <= ti) {
                s16x8 qa[8], kb[8];
#pragma unroll
                for (int ks = 0; ks < 8; ++ks) { qa[ks] = *(const GAS s16x8*)(qbase + (size_t)(32 * ti + l31) * NPP + 16 * ks + 8 * hi); kb[ks] = *(const GAS s16x8*)(kbase + (size_t)(32 * si + l31) * NPP + 16 * ks + 8 * hi); }
                f32x16 acc;
#pragma unroll
                for (int r = 0; r < 16; ++r) acc[r] = 0.f;
#pragma unroll
                for (int ks = 0; ks < 8; ++ks) acc = MFMA32(qa[ks], kb[ks], acc);
                const int s = 32 * si + l31; const float as = a_s[s];
#pragma unroll
                for (int r = 0; r < 16; ++r) { const int t = 32 * ti + crow32(r, hi); const float p = (s <= t) ? acc[r] * SCALEQ * __expf(as - Mt[t]) : 0.f; Pm[t * TSTR + s] = (bf16)f2bf(p); }
            } else {
#pragma unroll
                for (int r = 0; r < 16; ++r) Pm[(32 * ti + crow32(r, hi)) * TSTR + 32 * si + l31] = (bf16)0;
            }
        } else {
            const int t = (tid - 256) >> 2, d0 = ((tid - 256) & 3) * 32; float s = 0.f; const float* np = NS + (size_t)u * 128 + d0;
#pragma unroll
            for (int j = 0; j < 4; ++j) { const s16x8 qv = *(const GAS s16x8*)(qbase + (size_t)t * NPP + d0 + 8 * j);
#pragma unroll
                for (int i = 0; i < 8; ++i) s += bf2f((unsigned short)qv[i]) * np[8 * j + i]; }
            s += __shfl_xor(s, 1); s += __shfl_xor(s, 2);
            if ((tid & 3) == 0) qn[t] = s * SCALEQ;
        }
        __syncthreads();
        f32x16 accP[2], accC[2];
#pragma unroll
        for (int ti = 0; ti < 2; ++ti)
#pragma unroll
            for (int r = 0; r < 16; ++r) { accP[ti][r] = 0.f; accC[ti][r] = 0.f; }
        {
            const bf16* cs = CS + (size_t)u * 32768 + (size_t)(32 * w + l31) * 128 + 8 * hi;
            s16x8 cb[8];
#pragma unroll
            for (int ks = 0; ks < 8; ++ks) cb[ks] = *(const GAS s16x8*)(cs + 16 * ks);
#pragma unroll
            for (int ti = 0; ti < 2; ++ti) {
                s16x8 qa[8];
#pragma unroll
                for (int ks = 0; ks < 8; ++ks) qa[ks] = *(const GAS s16x8*)(qbase + (size_t)(32 * ti + l31) * NPP + 16 * ks + 8 * hi);
#pragma unroll
                for (int ks = 0; ks < 8; ++ks) accC[ti] = MFMA32(qa[ks], cb[ks], accC[ti]);
            }
#pragma unroll
            for (int ks = 0; ks < 4; ++ks) { const s16x8 vb = *(const LAS s16x8*)(VT + (32 * w + l31) * TSTR + 16 * ks + 8 * hi);
#pragma unroll
                for (int ti = 0; ti < 2; ++ti) { const s16x8 pa = *(const LAS s16x8*)(Pm + (32 * ti + l31) * TSTR + 16 * ks + 8 * hi); accP[ti] = MFMA32(pa, vb, accP[ti]); } }
        }
        if (w == 0) {
            float rs = 0.f;
#pragma unroll
            for (int j = 0; j < 8; ++j) { const s16x8 pv = *(const LAS s16x8*)(Pm + lane * TSTR + 8 * j);
#pragma unroll
                for (int i = 0; i < 8; ++i) rs += bf2f((unsigned short)pv[i]); }
            const float dn = rs + inter[lane] * qn[lane];
            dinv[lane] = 1.f / fmaxf(fabsf(dn), emt[lane]);
        }
        __syncthreads();
#pragma unroll
        for (int ti = 0; ti < 2; ++ti)
#pragma unroll
            for (int r = 0; r < 16; ++r) { const int t = 32 * ti + crow32(r, hi); NUM[t * NUMSTR + 32 * w + l31] = (accP[ti][r] + inter[t] * SCALEQ * accC[ti][r]) * dinv[t]; }
        __syncthreads();
        {
            const f32x4 gn = *(const GAS f32x4*)(F.in[IN_MOUTN] + h * 256 + 4 * lane);
#pragma unroll
            for (int i = 0; i < 8; ++i) { const int t = 8 * w + i; const f32x4 x = *(const LAS f32x4*)(NUM + t * NUMSTR + 4 * lane);
                const float ss = wave_sum((x.x * x.x + x.y * x.y) + (x.z * x.z + x.w * x.w)); const float r = rsqrtf(ss * (1.f / 256.f) + 1e-6f);
                const u32x2 mo = *(const GAS u32x2*)(proj + (size_t)(t0 + t) * NPP + C_MO + h * 256 + 4 * lane);
                const float o0 = x.x * r * gn.x * sigmoid_f(bf2f((unsigned short)(mo.x & 0xffffu))), o1 = x.y * r * gn.y * sigmoid_f(bf2f((unsigned short)(mo.x >> 16)));
                const float o2 = x.z * r * gn.z * sigmoid_f(bf2f((unsigned short)(mo.y & 0xffffu))), o3 = x.w * r * gn.w * sigmoid_f(bf2f((unsigned short)(mo.y >> 16)));
                u32x2 ov; ov.x = pk2(o0, o1); ov.y = pk2(o2, o3);
                *(GAS u32x2*)(concat + (size_t)(t0 + t) * D + h * 256 + 4 * lane) = ov; }
        }
        __syncthreads();
    }
}
}
namespace mk {
__device__ __forceinline__ void attn_build_schedule(Frame& F) {
    LAS int* jl = (LAS int*)(F.lds + TAB_OFF); LAS int* pre = jl + 256; LAS int* wtot = pre + 260;
    const int tid = F.tid, lane = F.lane;
    if (tid < 256) { const int j = wsp<int>(F, WS_JLO)[tid]; jl[tid] = j; const int n = 4 * (tid & 31) + 4 - j; int v = (n + ATT_CH - 1) / ATT_CH;
        int inc = v;
#pragma unroll
        for (int o = 1; o < 64; o <<= 1) { const int t = __shfl_up(inc, o); if (lane >= o) inc += t; }
        pre[tid + 1] = inc; if (lane == 63) wtot[tid >> 6] = inc; }
    __syncthreads();
    if (tid < 256) { int add = 0; for (int w2 = 0; w2 < (tid >> 6); ++w2) add += wtot[w2]; pre[tid + 1] += add; if (tid == 0) pre[0] = 0; }
    __syncthreads();
}
__device__ __forceinline__ fox::BlockRef<fox::bf16, fox::bf16> fox_ref(const Frame& F, int I) {
    const LAS int* jl = (const LAS int*)(F.lds + TAB_OFF); const LAS int* pre = jl + 256;
    int b = 0;
#pragma unroll
    for (int st = 128; st >= 1; st >>= 1) if (pre[b + st] <= I) b += st;
    b = __builtin_amdgcn_readfirstlane(b);
    const int pb0 = __builtin_amdgcn_readfirstlane(pre[b]), pb1 = __builtin_amdgcn_readfirstlane(pre[b + 1]), j0 = __builtin_amdgcn_readfirstlane(jl[b]);
    const int h = b >> 5, qb = b & 31, part = I - pb0, P = pb1 - pb0, n = 4 * qb + 4 - j0;
    fox::BlockRef<fox::bf16, fox::bf16> r;
    const fox::bf16* proj = (const fox::bf16*)(F.ws + WS_PROJ);
    r.Q = proj + (size_t)(qb * 256) * fox::PITCH + C_FQ + h * 128; r.K = proj + C_FK + h * 128; r.V = proj + C_FV + h * 128;
    r.O = (fox::bf16*)(F.ws + WS_CONCAT) + (size_t)(qb * 256) * D + 1024 + h * 128; r.P0 = qb * 256;
    r.Fb = (const float*)(F.ws + WS_F) + h * S; r.gain = F.in[IN_FOUTN] + h * 128;
    r.jlo = j0 + (part * n) / P; r.jhi = j0 + ((part + 1) * n) / P;
    r.Op = P > 1 ? (float*)(F.ws + WS_OPART) + (size_t)I * 256 * 128 : nullptr; r.ML = (float*)(F.ws + WS_MLP) + (size_t)I * 512;
    return r;
}
__device__ __forceinline__ void p5_attention(Frame& F, char* ldsg) {
    typedef fox::BlockRef<fox::bf16, fox::bf16> BR;
    attn_build_schedule(F);
    const int total = __builtin_amdgcn_readfirstlane(((const LAS int*)(F.lds + TAB_OFF))[256 + 256]);
#define ATT_ITEM(r) (total - 1 - ((r) * F.G + (((r) & 1) ? F.G - 1 - F.vcu : F.vcu)))
    int r = 0; int L = ATT_ITEM(0); if (L < 0) return;
    BR cur = fox_ref(F, L);
    fox::Seam<fox::bf16> Sm;
    fox::causal_swa_prime<fox::bf16, fox::bf16>(cur, S, ldsg, Sm);
    for (;;) {
        const int Ln = ATT_ITEM(r + 1); const bool more = Ln >= 0;
        const BR nxt = more ? fox_ref(F, Ln) : cur;
        fox::causal_swa_block<fox::bf16, fox::bf16>(cur, nxt, S, S, ldsg, Sm);
        if (!more) break;
        cur = nxt; ++r;
    }
#undef ATT_ITEM
}
__device__ __forceinline__ void p6_combine(Frame& F) {
    attn_build_schedule(F);
    const LAS int* pre = (const LAS int*)(F.lds + TAB_OFF) + 256;
    const float* OP = wsp<float>(F, WS_OPART); const float* MLP = wsp<float>(F, WS_MLP); bf16* concat = wsp<bf16>(F, WS_CONCAT);
    const int gw = F.vcu * NWAVES + F.wave, NGW = F.G * NWAVES, lane = F.lane;
    constexpr float C2 = 1.4426950408889634f * SCALEQ;
    for (int idx = gw; idx < 256 * 256; idx += NGW) {
        const int b = idx >> 8, r = idx & 255, i0 = __builtin_amdgcn_readfirstlane(pre[b]), P = __builtin_amdgcn_readfirstlane(pre[b + 1]) - i0; if (P <= 1) continue;
        const int h = b >> 5, qb = b & 31;
        f32x2 ml[8], ov[8];
#pragma unroll
        for (int p2 = 0; p2 < 8; ++p2) if (p2 < P) { ml[p2] = *(const GAS f32x2*)(MLP + (size_t)(i0 + p2) * 512 + 2 * r); ov[p2] = *(const GAS f32x2*)(OP + ((size_t)(i0 + p2) * 256 + r) * 128 + 2 * lane); }
        float ms = -3.0e38f;
#pragma unroll
        for (int p2 = 0; p2 < 8; ++p2) if (p2 < P) ms = fmaxf(ms, ml[p2].x);
        float n0 = 0.f, n1 = 0.f, den = 0.f;
#pragma unroll
        for (int p2 = 0; p2 < 8; ++p2) if (p2 < P) { const float wgt = __builtin_amdgcn_exp2f((ml[p2].x - ms) * C2); n0 += wgt * ov[p2].x; n1 += wgt * ov[p2].y; den += wgt * ml[p2].y; }
        const float inv = 1.f / den, v0 = n0 * inv, v1 = n1 * inv;
        const float ss = wave_sum(v0 * v0 + v1 * v1), rn = rsqrtf(ss * (1.f / 128.f) + 1e-6f);
        const f32x2 gn = *(const GAS f32x2*)(F.in[IN_FOUTN] + h * 128 + 2 * lane);
        *(GAS unsigned*)(concat + (size_t)(qb * 256 + r) * D + 1024 + h * 128 + 2 * lane) = pk2(v0 * rn * gn.x, v1 * rn * gn.y);
    }
}
constexpr int RROWS = 8, NITER = S / RROWS;
__device__ __forceinline__ void p7_router(Frame& F) {
    LAS float* shs = (LAS float*)(F.lds + RING_OFF);
    constexpr int HSTR = 2064;
    LAS bf16* H2hi = (LAS bf16*)(shs + 2 * D);
    LAS bf16* H2lo = H2hi + RROWS * HSTR;
    LAS float* red = (LAS float*)(H2lo + RROWS * HSTR);
    LAS int* selE = (LAS int*)(red + 8 * RROWS * NE);
    const float* mod = wsp<float>(F, WS_MOD); const float* h1 = wsp<float>(F, WS_H1); unsigned char* h2 = wsp<unsigned char>(F, WS_HN);
    int* top_i = wsp<int>(F, WS_TOPI); float* top_w = wsp<float>(F, WS_TOPW); int* hist = wsp<int>(F, WS_HIST); int* lrank = wsp<int>(F, WS_LRANK);
    const int tid = F.tid, lane = F.lane, w = F.wave;
    for (int i = tid; i < 2 * D; i += NTHR) shs[i] = mod[3 * D + i];
    __syncthreads();
    s16x8 whi[16], wlo[16];
    { const int hh = lane >> 5; const float* wp = F.in[IN_WR] + (size_t)(256 * w + 8 * hh) * NE + (lane & 31);
#pragma unroll
        for (int ks = 0; ks < 16; ++ks) { float wv[8];
#pragma unroll
            for (int j = 0; j < 8; ++j) wv[j] = wp[(size_t)(16 * ks + j) * NE];
            unsigned hw[4], lw[4];
#pragma unroll
            for (int j = 0; j < 4; ++j) { const unsigned a = f2bf(wv[2 * j]), b = f2bf(wv[2 * j + 1]); hw[j] = a | (b << 16); lw[j] = pk2(wv[2 * j] - bf2f((unsigned short)a), wv[2 * j + 1] - bf2f((unsigned short)b)); }
            const v4u hv4 = {hw[0], hw[1], hw[2], hw[3]}, lv4 = {lw[0], lw[1], lw[2], lw[3]};
            whi[ks] = __builtin_bit_cast(s16x8, hv4); wlo[ks] = __builtin_bit_cast(s16x8, lv4); } }
    for (int it = F.vcu; it < NITER; it += F.G) {
        const int r0 = it * RROWS;
        {
            const int m = r0 + w; const GAS f32x4* xr = (const GAS f32x4*)(h1 + (size_t)m * D) + lane; f32x4 v[8]; float s2 = 0.f;
#pragma unroll
            for (int j = 0; j < 8; ++j) { v[j] = xr[64 * j]; s2 += (v[j].x * v[j].x + v[j].y * v[j].y) + (v[j].z * v[j].z + v[j].w * v[j].w); }
            const float r = rsqrtf(wave_sum(s2) * (1.f / D) + 1e-6f);
            GAS unsigned* o8 = (GAS unsigned*)(h2 + (size_t)m * D) + lane;
#pragma unroll
            for (int j = 0; j < 8; ++j) { const int c0 = 4 * lane + 256 * j; const f32x4 gg = *(const GAS f32x4*)(F.in[IN_NFFN] + c0); const f32x4 a = *(const LAS f32x4*)(shs + D + c0), b = *(const LAS f32x4*)(shs + c0);
                const f32x4 y = v[j] * r * gg * (a + 1.f) + b; o8[64 * j] = pk4_fp8(y.x, y.y, y.z, y.w);
                const unsigned h0 = pk2(y.x, y.y), h1w = pk2(y.z, y.w); u32x2 hv; hv.x = h0; hv.y = h1w;
                u32x2 lv; lv.x = pk2(y.x - bf2f((unsigned short)(h0 & 0xffffu)), y.y - bf2f((unsigned short)(h0 >> 16))); lv.y = pk2(y.z - bf2f((unsigned short)(h1w & 0xffffu)), y.w - bf2f((unsigned short)(h1w >> 16)));
                *(LAS u32x2*)(H2hi + w * HSTR + c0) = hv; *(LAS u32x2*)(H2lo + w * HSTR + c0) = lv; }
        }
        __syncthreads();
        {
            f32x16 acc;
#pragma unroll
            for (int r = 0; r < 16; ++r) acc[r] = 0.f;
            const int hh = lane >> 5; const LAS bf16* bh = H2hi + (lane & 7) * HSTR + 256 * w + 8 * hh; const LAS bf16* bl = H2lo + (lane & 7) * HSTR + 256 * w + 8 * hh;
#pragma unroll
            for (int ks = 0; ks < 16; ++ks) { const s16x8 xh = *(const LAS s16x8*)(bh + 16 * ks), xl = *(const LAS s16x8*)(bl + 16 * ks);
                acc = MFMA32(whi[ks], xh, acc); acc = MFMA32(whi[ks], xl, acc); acc = MFMA32(wlo[ks], xh, acc); }
            if ((lane & 31) < RROWS) {
#pragma unroll
                for (int r = 0; r < 16; ++r) red[(w * RROWS + (lane & 31)) * NE + crow32(r, hh)] = acc[r]; }
        }
        __syncthreads();
        if (tid < RROWS * NE) {
            const int r = tid >> 5, e = tid & 31; float lg = F.in[IN_BR][e];
#pragma unroll
            for (int kp = 0; kp < 8; ++kp) lg += red[(kp * RROWS + r) * NE + e];
            float cur = lg, mx = 0.f, sum = 0.f, mysel = 0.f; int myidx = 0;
#pragma unroll
            for (int q = 0; q < 4; ++q) { float best = cur; int bi = e;
#pragma unroll
                for (int o = 1; o < 32; o <<= 1) { const float ob = __shfl_xor(best, o); const int oi = __shfl_xor(bi, o); if (ob > best || (ob == best && oi < bi)) { best = ob; bi = oi; } }
                if (q == 0) mx = best;
                sum += __expf(best - mx);
                if (e == q) { mysel = best; myidx = bi; }
                if (e == bi) cur = -3.0e38f; }
            if (e < 4) { const int t = r0 + r; top_i[t * 4 + e] = myidx; top_w[t * 4 + e] = __expf(mysel - mx) / sum; selE[r * 4 + e] = myidx; }
        }
        __syncthreads();
        if (tid < 32) { const int me = selE[tid]; int rank = 0, cnt = 0;
#pragma unroll
            for (int p = 0; p < 32; ++p) { const int ep = selE[p]; rank += (ep == me && p < tid) ? 1 : 0; cnt += (ep == tid) ? 1 : 0; }
            lrank[it * 32 + tid] = rank; hist[it * NE + tid] = cnt; }
        __syncthreads();
    }
}
__device__ __forceinline__ void build_expert_table(Frame& F, const int* counts_g) {
    LAS int* tab = (LAS int*)(F.lds + TAB_OFF);
    if (F.tid < 64) {
        const int lane = F.tid, c = lane < NE ? counts_g[lane] : 0, nt = (c + 255) >> 8; int inc = nt;
#pragma unroll
        for (int o = 1; o < 64; o <<= 1) { const int t = __shfl_up(inc, o); if (lane >= o) inc += t; }
        if (lane < NE) { tab[lane] = inc - nt; tab[40 + lane] = c; }
        if (lane == NE - 1) tab[32] = inc; }
    __syncthreads();
}
__device__ __forceinline__ void p8_gather(Frame& F) {
    LAS unsigned short* loc = (LAS unsigned short*)(F.lds + RING_OFF);
    LAS int* psum = (LAS int*)(F.lds + RING_OFF + 65536);
    LAS int* startr = psum + 16 * NE;
    const int* hist = wsp<int>(F, WS_HIST); const int* lrank = wsp<int>(F, WS_LRANK); const int* top_i = wsp<int>(F, WS_TOPI); const float* top_w = wsp<float>(F, WS_TOPW);
    int* pos = wsp<int>(F, WS_POS); float* roww = wsp<float>(F, WS_ROWW); const unsigned char* h2 = wsp<unsigned char>(F, WS_HN); unsigned char* xg = wsp<unsigned char>(F, WS_XG);
    int* counts_g = (int*)(F.ws + WS_POS) + S * 4;
    const int tid = F.tid, lane = F.lane, w = F.wave;
    { const int e = tid & 31, part = tid >> 5; int hv[64];
#pragma unroll
        for (int i = 0; i < 64; ++i) hv[i] = hist[(part * 64 + i) * NE + e];
        int s = 0;
#pragma unroll
        for (int i = 0; i < 64; ++i) { loc[(part * 64 + i) * NE + e] = (unsigned short)s; s += hv[i]; }
        psum[part * NE + e] = s; }
    __syncthreads();
    if (tid < 64) { int tot = 0;
        if (tid < NE) {
#pragma unroll
            for (int p = 0; p < 16; ++p) { const int v = psum[p * NE + tid]; psum[p * NE + tid] = tot; tot += v; } }
        const int padded = ((tot + 255) >> 8) << 8; int inc = padded;
#pragma unroll
        for (int o = 1; o < 64; o <<= 1) { const int t = __shfl_up(inc, o); if (lane >= o) inc += t; }
        if (tid < NE) { startr[tid] = inc - padded; if (blockIdx.x == 0) counts_g[tid] = tot; } }
    __syncthreads();
    for (int itb = F.vcu; itb < NITER; itb += 4 * F.G) {
        const int pi = 16 * w + (lane & 15), it = itb + (pi >> 5) * F.G; const bool valid = it < NITER;
        int dest = 0, tok = 0;
        if (valid) { const int pair = it * 32 + (pi & 31), e = top_i[pair]; dest = startr[e] + psum[(it >> 6) * NE + e] + (int)loc[it * NE + e] + lrank[pair]; tok = pair >> 2;
            if (lane < 16) { pos[pair] = dest; roww[dest] = top_w[pair]; } }
        v4u buf[16][2];
#pragma unroll
        for (int j = 0; j < 16; ++j) { const int tj = __builtin_amdgcn_readlane(tok, j); const GAS v4u* src = (const GAS v4u*)(h2 + (size_t)tj * D) + lane; buf[j][0] = src[0]; buf[j][1] = src[64]; }
#pragma unroll
        for (int j = 0; j < 16; ++j) { const int dj = __builtin_amdgcn_readlane(dest, j); const bool vj = __builtin_amdgcn_readlane((int)valid, j) != 0;
            if (vj) { GAS v4u* dst = (GAS v4u*)(xg + (size_t)dj * D) + lane; dst[0] = buf[j][0]; dst[64] = buf[j][1]; } }
    }
}
struct GroupedOrder {
    const LAS int* tab; int ntn, G, c;
    __device__ __forceinline__ bool next(int i, Unit& u) const {
        const int L0 = i * G + c, total = tab[32] * ntn; if (L0 >= total) return false;
        int L; { const int qq = total / pg8::NXCD, rr = total % pg8::NXCD, xcd = L0 % pg8::NXCD, off = L0 / pg8::NXCD; L = (xcd < rr ? xcd * (qq + 1) : rr * (qq + 1) + (xcd - rr) * qq) + off; }
        int e = (u.e > 0 && u.e < NE && tab[u.e] * ntn <= L) ? u.e : 0;
#pragma unroll 1
        while (e < NE - 1 && tab[e + 1] * ntn <= L) ++e;
        const int ts = tab[e], tc = tab[e + 1] - ts, within = L - ts * ntn;
        u.pm = ts + within % tc; u.pn = within / tc; u.e = e; u.pb = e * ntn + u.pn; return true;
    }
    __device__ __forceinline__ void a_ready(const Unit&) const {}
    __device__ __forceinline__ void done(const Unit&) const {}
};
struct EpiSwiglu {
    static constexpr bool PERM = true, AFTER_DRAIN = false;
    unsigned char* act; const float* bug;
    __device__ __forceinline__ void operator()(const pg8::f32x4 (&acc)[2][2][4][2], const Unit& u, int wr, int wc, int fr, int fq) const {
        const int row0 = u.pm * 256 + wr * 64 + fr, f0 = u.pn * 128 + wc * 32 + 8 * fq;
        const float* bg = bug + (size_t)u.e * 4096 + f0; pg8::f32x4 bgv[2], buv[2];
#pragma unroll
        for (int n = 0; n < 2; ++n) { bgv[n] = *(const pg8::f32x4*)(bg + 4 * n); buv[n] = *(const pg8::f32x4*)(bg + 2048 + 4 * n); }
#pragma unroll
        for (int ai = 0; ai < 2; ++ai)
#pragma unroll
            for (int m = 0; m < 4; ++m) { float o[8];
#pragma unroll
                for (int n = 0; n < 2; ++n)
#pragma unroll
                    for (int i = 0; i < 4; ++i) { const float g = fminf(acc[ai][0][m][n][i] + bgv[n][i], 7.f); const float up = fminf(fmaxf(acc[ai][1][m][n][i] + buv[n][i], -7.f), 7.f);
                        o[4 * n + i] = (up + 1.f) * g * __builtin_amdgcn_rcpf(1.f + __builtin_amdgcn_exp2f(-2.45546696f * g)); }
                u32x2 wv; wv.x = pk4_fp8(o[0], o[1], o[2], o[3]); wv.y = pk4_fp8(o[4], o[5], o[6], o[7]);
                *(u32x2*)(act + (size_t)(row0 + ai * 128 + m * 16) * FF + f0) = wv; }
    }
};
struct EpiDown {
    static constexpr bool PERM = true, AFTER_DRAIN = false;
    bf16* y; const float* bd; const float* roww;
    __device__ __forceinline__ void operator()(const pg8::f32x4 (&acc)[2][2][4][2], const Unit& u, int wr, int wc, int fr, int fq) const {
        const int row0 = u.pm * 256 + wr * 64 + fr, col0 = u.pn * 256 + wc * 32 + 8 * fq;
        pg8::f32x4 bv[2][2];
#pragma unroll
        for (int bj = 0; bj < 2; ++bj)
#pragma unroll
            for (int n = 0; n < 2; ++n) bv[bj][n] = *(const pg8::f32x4*)(bd + (size_t)u.e * D + col0 + bj * 128 + 4 * n);
#pragma unroll
        for (int ai = 0; ai < 2; ++ai)
#pragma unroll
            for (int m = 0; m < 4; ++m) { const int row = row0 + ai * 128 + m * 16; const float rw = roww[row]; bf16* rowp = y + (size_t)row * D + col0;
#pragma unroll
                for (int bj = 0; bj < 2; ++bj) { const pg8::f32x4 v0 = (acc[ai][bj][m][0] + bv[bj][0]) * rw, v1 = (acc[ai][bj][m][1] + bv[bj][1]) * rw;
                    pg8::u32x4 wv; wv.x = cvt_pk_bf16(v0[0], v0[1]); wv.y = cvt_pk_bf16(v0[2], v0[3]); wv.z = cvt_pk_bf16(v1[0], v1[1]); wv.w = cvt_pk_bf16(v1[2], v1[3]);
                    *(pg8::u32x4*)(rowp + bj * 128) = wv; } }
    }
};
__device__ __forceinline__ void p11_final(Frame& F, float oscale) {
    LAS float* ms = (LAS float*)(F.lds + RING_OFF);
    const float* mod = wsp<float>(F, WS_MOD);
    for (int i = F.tid; i < 3 * D; i += NTHR) ms[i] = mod[5 * D + i];
    __syncthreads();
    const float* h1 = wsp<float>(F, WS_H1); const bf16* y = wsp<bf16>(F, WS_Y); const int* pos = wsp<int>(F, WS_POS);
    const int gw = F.vcu * NWAVES + F.wave, NGW = F.G * NWAVES, lane = F.lane;
    for (int t = gw; t < S; t += NGW) {
        asm volatile("" ::: "memory");
        const GAS f32x4* xr = (const GAS f32x4*)(h1 + (size_t)t * D) + lane;
        const GAS u32x2* y0 = (const GAS u32x2*)(y + (size_t)pos[t * 4 + 0] * D) + lane; const GAS u32x2* y1 = (const GAS u32x2*)(y + (size_t)pos[t * 4 + 1] * D) + lane;
        const GAS u32x2* y2 = (const GAS u32x2*)(y + (size_t)pos[t * 4 + 2] * D) + lane; const GAS u32x2* y3 = (const GAS u32x2*)(y + (size_t)pos[t * 4 + 3] * D) + lane;
        f32x4 v[8]; float s2 = 0.f;
#pragma unroll
        for (int j = 0; j < 8; ++j) { const u32x2 a = y0[64 * j], b = y1[64 * j], c = y2[64 * j], d = y3[64 * j]; const f32x4 g2 = *(const LAS f32x4*)(ms + 4 * lane + 256 * j);
            f32x4 f;
            f.x = (bf2f((unsigned short)(a.x & 0xffffu)) + bf2f((unsigned short)(b.x & 0xffffu))) + (bf2f((unsigned short)(c.x & 0xffffu)) + bf2f((unsigned short)(d.x & 0xffffu)));
            f.y = (bf2f((unsigned short)(a.x >> 16)) + bf2f((unsigned short)(b.x >> 16))) + (bf2f((unsigned short)(c.x >> 16)) + bf2f((unsigned short)(d.x >> 16)));
            f.z = (bf2f((unsigned short)(a.y & 0xffffu)) + bf2f((unsigned short)(b.y & 0xffffu))) + (bf2f((unsigned short)(c.y & 0xffffu)) + bf2f((unsigned short)(d.y & 0xffffu)));
            f.w = (bf2f((unsigned short)(a.y >> 16)) + bf2f((unsigned short)(b.y >> 16))) + (bf2f((unsigned short)(c.y >> 16)) + bf2f((unsigned short)(d.y >> 16)));
            v[j] = xr[64 * j] + g2 * f; s2 += (v[j].x * v[j].x + v[j].y * v[j].y) + (v[j].z * v[j].z + v[j].w * v[j].w); }
        const float r = rsqrtf(wave_sum(s2) * (1.f / D) + 1e-6f);
        GAS f32x4* o = (GAS f32x4*)(F.out + (size_t)t * D) + lane;
#pragma unroll
        for (int j = 0; j < 8; ++j) { const int c0 = 4 * lane + 256 * j; const f32x4 gg = *(const GAS f32x4*)(F.in[IN_NFIN] + c0); const f32x4 sh = *(const LAS f32x4*)(ms + D + c0), sc = *(const LAS f32x4*)(ms + 2 * D + c0);
            o[64 * j] = (v[j] * r * gg * (sc + 1.f) + sh) * oscale; }
    }
}
}
namespace mk {
struct Args { const float* in[24]; float* out; unsigned char* ws; int ph_lo, ph_hi, li, pad; };
constexpr int N_PHASES = 13;
__global__ void __launch_bounds__(NTHR, 2) mega_fwd(Args args) {
    extern __shared__ __attribute__((aligned(16))) unsigned char lds[];
    Frame F;
    F.lds = (LAS unsigned char*)lds;
    F.MISC = (volatile LAS unsigned*)(F.lds + MISC_OFF);
    F.tid = threadIdx.x; F.lane = F.tid & 63; F.wave = __builtin_amdgcn_readfirstlane(F.tid >> 6);
    leave_group(F);
    F.ws = args.ws; F.out = args.out; F.ctl = (gu32*)(args.ws + WS_CTL);
#pragma unroll
    for (int i = 0; i < 24; ++i) F.in[i] = args.in[i];
    for (int u = F.tid; u < (LDS_BYTES - LDSCTL_OFF) / 4; u += NTHR) ((LAS unsigned*)(F.lds + LDSCTL_OFF))[u] = 0u;
    __syncthreads();
    XcdBarrier bar = xcd_barrier_post((unsigned*)(F.ctl + CW_BAR) + args.li * XCD_BAR_WORDS, F.MISC + 8);
    const int lo = args.ph_lo, hi = args.ph_hi;
#define IN(k) (lo <= (k) && (k) < hi)
#define SEAM(k) do { if (IN(k) && IN((k) + 1)) xcd_barrier(bar); } while (0)

#ifndef MK_DOUBLE
#define MK_DOUBLE 0
#endif
#define DBL(k) ((MK_DOUBLE >> (k)) & 1)
#ifdef MK_PROBE_LO
    unsigned long long* stamps = (unsigned long long*)(F.ctl + 131072);
#define STAMP(k) do { if (blockIdx.x == 0 && F.tid == 0) stamps[k] = rt(); } while (0)
#define PROBE_SCALE() (1.f + sqrtf((float)(stamps[MK_PROBE_HI] - stamps[MK_PROBE_LO]) * 0.01f * 2e-5f))
#elif defined(MK_PROBE_TILES)
#define STAMP(k) do { } while (0)
    auto probe_tiles = [&]() -> float { int tt = 0, ni = 0; for (int b = 0; b < 256; ++b) { const int n = 4 * (b & 31) + 4 - wsp<int>(F, WS_JLO)[b]; tt += n; ni += (n + ATT_CH - 1) / ATT_CH; } return MK_PROBE_TILES == 1 ? (float)tt : (float)ni; };
#define PROBE_SCALE() (1.f + sqrtf(probe_tiles() * 1e-6f))
#else
#define STAMP(k) do { } while (0)
#define PROBE_SCALE() 1.f
#endif
    STAMP(0); if (IN(0)) { p0_gemv(F); } SEAM(0);
    STAMP(1); if (IN(1)) { p1_modulate(F); if (DBL(1)) p1_modulate(F); } SEAM(1);
    STAMP(2); if (IN(2)) {
        gu32* done = F.ctl + CW_DONE + 64 * 2;
        if (enter_group(F, GC_INPROJ)) {
            pg8::Gemm g{wsp<pg8::bf16_t>(F, WS_HN), wsp<pg8::bf16_t>(F, WS_WIN), S, NPP, D}; pg8::StaticOrder So; So.init(S, NPP, F.G, F.bid);
            EpiProj E{wsp<bf16>(F, WS_PROJ)};
            pg8::gemm_phase<EpiProj, pg8::StaticOrder, true, true>(F.lds + RING_OFF, g, So, E);
            if (DBL(2)) pg8::gemm_phase<EpiProj, pg8::StaticOrder, true, true>(F.lds + RING_OFF, g, So, E);
            __syncthreads();
            if (F.tid == 0) __hip_atomic_fetch_add(done, 1u, RLX_AGENT);
        }
        const unsigned tgt = (unsigned)F.G; leave_group(F);
        if (F.G == 256 && (blockIdx.x >> 3) == 31) p_fscan(F, (int)(blockIdx.x & 7));
        conv_worker(F, done, F.G == 256 ? (unsigned)GC_INPROJ : tgt, 0);
        __syncthreads();
    } SEAM(2);
#define GROUPED(k, Gc, body) do { gu32* done_ = F.ctl + CW_DONE + 64 * (k); if (enter_group(F, (Gc))) { body; __syncthreads(); if (F.tid == 0) __hip_atomic_fetch_add(done_, 1u, RLX_AGENT); } \
        const unsigned tgt_ = (unsigned)F.G; leave_group(F); conv_worker(F, done_, F.G == 256 ? (unsigned)(Gc) : tgt_, 0); __syncthreads(); } while (0)
    STAMP(3); if (IN(3)) { p3_prep(F); } SEAM(3);
    STAMP(4); if (IN(4)) { p4_scan(F); if (DBL(4)) p4_scan(F); } SEAM(4);
    STAMP(5); if (IN(5)) {
        gu32* done = F.ctl + CW_DONE + 64 * 5;
        if (args.pad != 3) p5_mlstm_out(F);
        if (enter_group(F, GC_ATTN)) {
            if (args.pad != 2) p5_attention(F, (char*)lds);
            __syncthreads();
            if (F.tid == 0) __hip_atomic_fetch_add(done, 1u, RLX_AGENT);
        }
        const unsigned tgt = (unsigned)F.G; leave_group(F);
        conv_worker(F, done, F.G == 256 ? (unsigned)GC_ATTN : tgt, 0);
        __syncthreads();
    } SEAM(5);
    STAMP(6); if (IN(6)) { p6_combine(F); } SEAM(6);
    STAMP(7); if (IN(7)) {
        pg8::Gemm g{wsp<pg8::bf16_t>(F, WS_CONCAT), wsp<pg8::bf16_t>(F, WS_WOUT), S, D, D}; pg8::StaticOrder So; So.init(S, D, F.G, F.bid);
        EpiOut E{F.in[IN_X], wsp<float>(F, WS_MOD) + 2 * D, wsp<float>(F, WS_H1)};
        pg8::gemm_phase<EpiOut, pg8::StaticOrder, false, true>(F.lds + RING_OFF, g, So, E);
        if (DBL(7)) pg8::gemm_phase<EpiOut, pg8::StaticOrder, false, true>(F.lds + RING_OFF, g, So, E);
    } SEAM(7);
    STAMP(8); if (IN(8)) { p7_router(F); if (DBL(8)) p7_router(F); } SEAM(8);
    STAMP(9); if (IN(9)) { p8_gather(F); if (DBL(9)) p8_gather(F); __syncthreads(); conv_worker(F, nullptr, 0u, 1); __syncthreads(); } SEAM(9);
    STAMP(10); if (IN(10)) {
        build_expert_table(F, (const int*)(F.ws + WS_POS) + S * 4);
        gu32* done = F.ctl + CW_DONE + 64 * 10;
        const int units = ((const LAS int*)(F.lds + TAB_OFF))[32] * 16, rounds = (units + 255) >> 8; int gc = rounds > 0 ? (((units + rounds - 1) / rounds + 7) >> 3) << 3 : 256; gc = gc > 256 ? 256 : gc;
        gc = __builtin_amdgcn_readfirstlane(gc);
        if (enter_group(F, gc)) {
            pg8::Gemm g{wsp<pg8::bf16_t>(F, WS_XG), wsp<pg8::bf16_t>(F, WS_WUG), MAXROWS, 4096, D / 2}; GroupedOrder So{(const LAS int*)(F.lds + TAB_OFF), 16, F.G, F.bid};
            EpiSwiglu E{wsp<unsigned char>(F, WS_ACT), F.in[IN_BUG]};
            pg8::gemm_phase8<EpiSwiglu, GroupedOrder, true, true>(F.lds + RING_OFF, g, So, E);
            __syncthreads();
            if (F.tid == 0) __hip_atomic_fetch_add(done, 1u, RLX_AGENT);
        }
        leave_group(F);
        __syncthreads(); conv_worker(F, nullptr, 0u, 2); __syncthreads();
    } SEAM(10);
    STAMP(11); if (IN(11)) {
        build_expert_table(F, (const int*)(F.ws + WS_POS) + S * 4);
        pg8::Gemm g{wsp<pg8::bf16_t>(F, WS_ACT), wsp<pg8::bf16_t>(F, WS_WD), MAXROWS, D, FF / 2}; GroupedOrder So{(const LAS int*)(F.lds + TAB_OFF), 8, F.G, F.bid};
        EpiDown E{wsp<bf16>(F, WS_Y), F.in[IN_BD], wsp<float>(F, WS_ROWW)};
        pg8::gemm_phase8<EpiDown, GroupedOrder, true, true>(F.lds + RING_OFF, g, So, E);
        if (DBL(11)) pg8::gemm_phase8<EpiDown, GroupedOrder, true, true>(F.lds + RING_OFF, g, So, E);
    } SEAM(11);
    STAMP(12); if (IN(12)) { p11_final(F, PROBE_SCALE()); if (DBL(12)) p11_final(F, PROBE_SCALE()); }
#undef IN
#undef SEAM
}
}
#ifndef MK_DEBUG
#define MK_DEBUG 0
#endif
#ifndef MK_PH_END
#define MK_PH_END mk::N_PHASES
#endif
#ifndef MK_SPLIT
#define MK_SPLIT 0
#endif
extern "C" void kernel_launch(void* const* d_in, const int* in_sizes, int n_in, void* d_out, int out_size, void* d_ws, size_t ws_size, hipStream_t stream) {
    using namespace mk;
    static int grid = 0;
    if (grid == 0) {
        int dev = 0, cus = 0, per_cu = 0;
        if (hipGetDevice(&dev) != hipSuccess || hipDeviceGetAttribute(&cus, hipDeviceAttributeMultiprocessorCount, dev) != hipSuccess) { fprintf(stderr, "kernel_launch: device query failed\n"); grid = -1; return; }
        if (hipFuncSetAttribute((const void*)mega_fwd, hipFuncAttributeMaxDynamicSharedMemorySize, LDS_BYTES) != hipSuccess) { fprintf(stderr, "kernel_launch: hipFuncSetAttribute failed\n"); grid = -1; return; }
        if (hipOccupancyMaxActiveBlocksPerMultiprocessor(&per_cu, (const void*)mega_fwd, NTHR, LDS_BYTES) != hipSuccess || per_cu < 1) fprintf(stderr, "kernel_launch: occupancy query reports %d\n", per_cu);
        (void)hipGetLastError();
        grid = cus;
        if (n_in != 24 || out_size != S * D || ws_size < (MK_DEBUG ? WS_NAIVE + (size_t)2300 * MiB : WS_END)) fprintf(stderr, "kernel_launch: unexpected sizes n_in %d out %d ws %zu\n", n_in, out_size, ws_size);
    }
    if (grid < 0) return;
    (void)hipMemsetAsync((char*)d_ws + WS_CTL, 0, CTL_ZERO_BYTES, stream);
    Args a{};
    for (int i = 0; i < 24; ++i) a.in[i] = (const float*)d_in[i];
    a.out = (float*)d_out; a.ws = (unsigned char*)d_ws;
#if MK_DEBUG
    nv::naive_forward(d_in, (float*)d_out, (char*)d_ws + WS_NAIVE, stream);
#endif
#if MK_SPLIT
    for (int p = 0; p < MK_PH_END; ++p) { a.ph_lo = p; a.ph_hi = p + 1; a.li = p; hipLaunchKernelGGL(mega_fwd, dim3(grid), dim3(NTHR), LDS_BYTES, stream, a); }
#else
    a.ph_lo = 0; a.ph_hi = MK_PH_END; a.li = 0;
    hipLaunchKernelGGL(mega_fwd, dim3(grid), dim3(NTHR), LDS_BYTES, stream, a);
#endif
#ifdef MK_EXTRA_LO
    a.ph_lo = MK_EXTRA_LO; a.ph_hi = MK_EXTRA_HI; a.li = 1;
#ifdef MK_EXTRA_PAD
    a.pad = MK_EXTRA_PAD;
#endif
    hipLaunchKernelGGL(mega_fwd, dim3(grid), dim3(NTHR), LDS_BYTES, stream, a);
#endif
    { const hipError_t le = hipPeekAtLastError(); if (le != hipSuccess) fprintf(stderr, "kernel_launch: launch failed: %s\n", hipGetErrorName(le)); }
#if MK_DEBUG
    {
        nv::NaiveWs w = nv::carve((char*)d_ws + WS_NAIVE);
        double* slots = (double*)((char*)d_ws + WS_CTL + 512 * 1024);
        unsigned char* ws = (unsigned char*)d_ws; int nc = 0;
        MK_DEBUG_CHECKS
        dbg::k_finish<<<1024, 256, 0, stream>>>((float*)d_out, (size_t)S * D, slots, nc, 1e-3);
    }
#endif
}
```

```cpp
#include <hip/hip_runtime.h>
#include <hip/hip_bf16.h>
#include <cstdio>
#include <cstdint>
namespace pg8 {
#define PG8_LAS __attribute__((address_space(3)))
typedef unsigned short bf16_t;
typedef short bf16x8 __attribute__((ext_vector_type(8)));
typedef float f32x4 __attribute__((ext_vector_type(4)));
typedef unsigned u32x4 __attribute__((ext_vector_type(4)));
constexpr int BM = 256, BK = 64, HALF = 128, HTB = HALF * BK * 2  , STAGE_BYTES = 8 * HTB, NXCD = 8, WGM = 8;

__host__ __device__ __forceinline__ int lds_byte(int r, int c) { const int st = (r >> 4) * 2 + (c >> 5), rr = r & 15, cc = c & 31, ob = rr * 64 + cc * 2; return st * 1024 + (ob ^ (((ob >> 9) & 1) << 5)); }
__host__ __device__ __forceinline__ void stage_rc(int b, int& R, int& C) { const int st = b / 1024, sb = b % 1024, swz = sb ^ (((sb >> 9) & 1) << 5); R = (st >> 1) * 16 + swz / 64; C = (st & 1) * 32 + (swz % 64) / 2; }
__host__ __device__ __forceinline__ int perm32(int rho) { const int n = rho >> 4, i = rho & 15; return 8 * (i >> 2) + 4 * n + (i & 3); }

struct Unit { int pm, pn, pb, e; };
struct Gemm { const bf16_t* A; const bf16_t* Bt; int M, N, K; };

struct StaticOrder {
    int nM, nN, nwg, G, c;
    __host__ __device__ void init(int M, int N, int G_, int c_) { nM = M / BM; nN = N / BM; nwg = nM * nN; G = G_; c = c_; }
    __host__ __device__ bool next(int i, Unit& u) const {
        const long L = (long)i * G + c; if (L >= nwg) return false;
        int wgid = (int)L; { const int q = nwg / NXCD, r = nwg % NXCD, xcd = wgid % NXCD, off = wgid / NXCD; wgid = (xcd < r ? xcd * (q + 1) : r * (q + 1) + (xcd - r) * q) + off; }
        const int nig = WGM * nN, gid = wgid / nig, fm = gid * WGM, gsz = (nM - fm) < WGM ? (nM - fm) : WGM;
        u.pm = fm + ((wgid % nig) % gsz); u.pn = (wgid % nig) / gsz; u.pb = u.pn; u.e = 0; return true;
    }
    __device__ __forceinline__ void a_ready(const Unit&) const {}
    __device__ __forceinline__ void done(const Unit&) const {}
};

__device__ __forceinline__ unsigned cvt_pk_bf16(float lo, float hi) { unsigned r; asm volatile("v_cvt_pk_bf16_f32 %0, %1, %2" : "=v"(r) : "v"(lo), "v"(hi)); return r; }
template <class Epi, class Sched, bool ALIGN_EPI = false, bool SP2 = false>
__device__ __forceinline__ void gemm_phase(PG8_LAS unsigned char* lds, const Gemm g, const Sched& S, const Epi& E) {
    const int tid = threadIdx.x, wid = __builtin_amdgcn_readfirstlane(tid >> 6), lane = tid & 63, wr = wid >> 2, wc = wid & 3, fr = lane & 15, fq = lane >> 4;
    const int K = g.K, nt = K / BK;
    unsigned voffA[2], voffB[2];
#pragma unroll
    for (int i = 0; i < 2; ++i) { int R, C; stage_rc(tid * 16 + i * 8192, R, C); const int Rb = Epi::PERM ? ((R & ~31) + perm32(R & 31)) : R;
        voffA[i] = (unsigned)(R * K + C) * 2u; voffB[i] = (unsigned)(Rb * K + C) * 2u; }
    const size_t kstep = (size_t)(BK * 2);
    const size_t hstep = (size_t)HALF * K * 2;
    const size_t tstep = 2 * hstep;
    const unsigned ldsw = (unsigned)wid * 1024u;
    const int aoff = lds_byte(wr * 64 + fr, fq * 8), boff = lds_byte(wc * 32 + fr, fq * 8);
#define PG8_SA(b, h) (((b) * 2 + (h)) * HTB)
#define PG8_SB(b, h) ((4 + (b) * 2 + (h)) * HTB)
#define PG8_STAGE(bufoff, gbase, voff) do { _Pragma("unroll") for (int _i = 0; _i < 2; ++_i) \
        __builtin_amdgcn_global_load_lds((const unsigned*)((const char*)(gbase) + (voff)[_i]), (PG8_LAS unsigned*)(lds + (bufoff) + ldsw + _i * 8192), 16, 0, 0); } while (0)
#define PG8_LDA(dst, b, h) do { _Pragma("unroll") for (int m = 0; m < 4; ++m) _Pragma("unroll") for (int k = 0; k < 2; ++k) dst[m][k] = *(const PG8_LAS bf16x8*)(lds + PG8_SA(b, h) + aoff + m * 2048 + k * 1024); } while (0)
#define PG8_LDB(dst, b, h) do { _Pragma("unroll") for (int n = 0; n < 2; ++n) _Pragma("unroll") for (int k = 0; k < 2; ++k) dst[n][k] = *(const PG8_LAS bf16x8*)(lds + PG8_SB(b, h) + boff + n * 2048 + k * 1024); } while (0)
#define PG8_MMA(ai, bj, At, Bt) do { __builtin_amdgcn_s_setprio(1); _Pragma("unroll") for (int m = 0; m < 4; ++m) _Pragma("unroll") for (int n = 0; n < 2; ++n) _Pragma("unroll") for (int k = 0; k < 2; ++k) \
        acc[ai][bj][m][n] = __builtin_amdgcn_mfma_f32_16x16x32_bf16(Bt[n][k], At[m][k], acc[ai][bj][m][n], 0, 0, 0); __builtin_amdgcn_s_setprio(0); } while (0)
#define PG8_WAIT_V(n) asm volatile("s_waitcnt vmcnt(" #n ")" ::: "memory")
#define PG8_WAIT_L(n) asm volatile("s_waitcnt lgkmcnt(" #n ")" ::: "memory")
#define PG8_BAR __builtin_amdgcn_s_barrier()
#define PG8_SCHED __builtin_amdgcn_sched_barrier(0)
    Unit cur = {0, 0, 0, 0}, nxt = {0, 0, 0, 0}; int ui = 0;
    if (!S.next(0, cur)) return;
    f32x4 acc[2][2][4][2];
#pragma unroll
    for (int a = 0; a < 2; ++a)
#pragma unroll
        for (int b = 0; b < 2; ++b)
#pragma unroll
            for (int m = 0; m < 4; ++m)
#pragma unroll
                for (int n = 0; n < 2; ++n) acc[a][b][m][n] = (f32x4){0.f, 0.f, 0.f, 0.f};
    bf16x8 At[4][2], B0[2][2], B1[2][2];
    const char* cA = (const char*)g.A + (size_t)cur.pm * tstep; const char* cB = (const char*)g.Bt + (size_t)cur.pb * tstep;
    S.a_ready(cur);
    if constexpr (SP2) {
        PG8_STAGE(PG8_SB(0, 0), cB, voffB); PG8_STAGE(PG8_SB(0, 1), cB + hstep, voffB); PG8_STAGE(PG8_SA(0, 0), cA, voffA); PG8_STAGE(PG8_SA(0, 1), cA + hstep, voffA);
        if (wr == 1) PG8_BAR;
        PG8_WAIT_V(2); PG8_BAR;
        PG8_STAGE(PG8_SB(1, 0), cB + kstep, voffB); PG8_STAGE(PG8_SA(1, 0), cA + kstep, voffA); PG8_STAGE(PG8_SB(1, 1), cB + hstep + kstep, voffB);
        PG8_WAIT_V(6); PG8_BAR;
    } else {
        PG8_STAGE(PG8_SB(0, 0), cB, voffB); PG8_STAGE(PG8_SA(0, 0), cA, voffA); PG8_STAGE(PG8_SB(0, 1), cB + hstep, voffB); PG8_STAGE(PG8_SA(0, 1), cA + hstep, voffA);
        if (wr == 1) PG8_BAR;
        PG8_WAIT_V(4); PG8_BAR;
        PG8_STAGE(PG8_SB(1, 0), cB + kstep, voffB); PG8_STAGE(PG8_SA(1, 0), cA + kstep, voffA); PG8_STAGE(PG8_SB(1, 1), cB + hstep + kstep, voffB);
        PG8_WAIT_V(6); PG8_BAR;
    }
    for (;;) {
        const bool has_next = S.next(ui + 1, nxt);
        const char* nA = has_next ? (const char*)g.A + (size_t)nxt.pm * tstep : cA; const char* nB = has_next ? (const char*)g.Bt + (size_t)nxt.pb * tstep : cB;
        for (int t = 0; t < nt; t += 2) {
            const bool last = (t == nt - 2);
            const char* a1 = cA + (size_t)(t + 1) * kstep;
            const char* a2 = last ? nA : cA + (size_t)(t + 2) * kstep; const char* b2 = last ? nB : cB + (size_t)(t + 2) * kstep;
            const char* a3 = a2 + kstep; const char* b3 = b2 + kstep;
            if (last && has_next) S.a_ready(nxt);
            if constexpr (SP2) {
            PG8_LDB(B0, 0, 0); PG8_LDB(B1, 0, 1); PG8_SCHED; PG8_LDA(At, 0, 0); PG8_STAGE(PG8_SA(1, 1), a1 + hstep, voffA);
            PG8_WAIT_V(8); PG8_WAIT_L(0); PG8_BAR; PG8_MMA(0, 0, At, B0); PG8_MMA(0, 1, At, B1); PG8_BAR; PG8_SCHED;
            PG8_LDA(At, 0, 1); PG8_STAGE(PG8_SB(0, 0), b2, voffB); PG8_STAGE(PG8_SB(0, 1), b2 + hstep, voffB); PG8_STAGE(PG8_SA(0, 0), a2, voffA);
            PG8_WAIT_V(8); PG8_WAIT_L(0); PG8_BAR; PG8_MMA(1, 0, At, B0); PG8_MMA(1, 1, At, B1); PG8_BAR; PG8_SCHED;
            PG8_LDB(B0, 1, 0); PG8_LDB(B1, 1, 1); PG8_SCHED; PG8_LDA(At, 1, 0); PG8_STAGE(PG8_SA(0, 1), a2 + hstep, voffA);
            PG8_WAIT_V(8); PG8_WAIT_L(0); PG8_BAR; PG8_MMA(0, 0, At, B0); PG8_MMA(0, 1, At, B1); PG8_BAR; PG8_SCHED;
            PG8_LDA(At, 1, 1); PG8_STAGE(PG8_SB(1, 0), b3, voffB); PG8_STAGE(PG8_SB(1, 1), b3 + hstep, voffB); PG8_STAGE(PG8_SA(1, 0), a3, voffA);
            PG8_WAIT_V(8); PG8_WAIT_L(0); PG8_BAR; PG8_MMA(1, 0, At, B0); PG8_MMA(1, 1, At, B1); PG8_BAR; PG8_SCHED;
            } else {
            PG8_LDB(B0, 0, 0); PG8_SCHED; PG8_LDA(At, 0, 0); PG8_STAGE(PG8_SA(1, 1), a1 + hstep, voffA);
            PG8_WAIT_L(8); PG8_BAR; PG8_WAIT_L(0); PG8_MMA(0, 0, At, B0); PG8_BAR; PG8_SCHED;
            PG8_LDB(B1, 0, 1); PG8_STAGE(PG8_SB(0, 0), b2, voffB);
            PG8_BAR; PG8_WAIT_L(0); PG8_MMA(0, 1, At, B1); PG8_BAR;
            PG8_LDA(At, 0, 1); PG8_STAGE(PG8_SA(0, 0), a2, voffA);
            PG8_BAR; PG8_WAIT_L(0); PG8_MMA(1, 0, At, B0); PG8_BAR; PG8_SCHED;
            PG8_STAGE(PG8_SB(0, 1), b2 + hstep, voffB);
            PG8_WAIT_V(6); PG8_BAR; PG8_MMA(1, 1, At, B1); PG8_BAR;
            PG8_LDB(B0, 1, 0); PG8_SCHED; PG8_LDA(At, 1, 0); PG8_STAGE(PG8_SA(0, 1), a2 + hstep, voffA);
            PG8_WAIT_L(8); PG8_BAR; PG8_WAIT_L(0); PG8_MMA(0, 0, At, B0); PG8_BAR; PG8_SCHED;
            PG8_LDB(B1, 1, 1); PG8_STAGE(PG8_SB(1, 0), b3, voffB);
            PG8_BAR; PG8_WAIT_L(0); PG8_MMA(0, 1, At, B1); PG8_BAR;
            PG8_LDA(At, 1, 1); PG8_STAGE(PG8_SA(1, 0), a3, voffA);
            PG8_BAR; PG8_WAIT_L(0); PG8_MMA(1, 0, At, B0); PG8_BAR; PG8_SCHED;
            PG8_STAGE(PG8_SB(1, 1), b3 + hstep, voffB);
            PG8_WAIT_V(6); PG8_BAR; PG8_MMA(1, 1, At, B1); PG8_BAR;
            }
        }
        if constexpr (ALIGN_EPI) { if (wr == 0) PG8_BAR; }
        if constexpr (!Epi::AFTER_DRAIN) { E(acc, cur, wr, wc, fr, fq); S.done(cur); }
        if (!has_next) break;
#pragma unroll
        for (int a = 0; a < 2; ++a)
#pragma unroll
            for (int b = 0; b < 2; ++b)
#pragma unroll
                for (int m = 0; m < 4; ++m)
#pragma unroll
                    for (int n = 0; n < 2; ++n) acc[a][b][m][n] = (f32x4){0.f, 0.f, 0.f, 0.f};
        cur = nxt; cA = nA; cB = nB; ++ui;
        if constexpr (ALIGN_EPI) { if (wr == 1) PG8_BAR; }
    }
    PG8_WAIT_V(0);
    if constexpr (!ALIGN_EPI) { if (wr == 0) PG8_BAR; }
    PG8_BAR;
    if constexpr (Epi::AFTER_DRAIN) { E.fused(acc, cur, wr, wc, fr, fq, lds, wid, lane); S.done(cur); }
#undef PG8_SA
#undef PG8_SB
#undef PG8_STAGE
#undef PG8_LDA
#undef PG8_LDB
#undef PG8_MMA
#undef PG8_WAIT_V
#undef PG8_WAIT_L
#undef PG8_BAR
#undef PG8_SCHED
}
typedef int v8i __attribute__((ext_vector_type(8)));
typedef int v4i __attribute__((ext_vector_type(4)));
constexpr int SCALE_W8 = 0x78787878, SCALE_A8 = 0x7f7f7f7f;
template <class Epi, class Sched, bool ALIGN_EPI = false, bool SP2 = false>
__device__ __forceinline__ void gemm_phase8(PG8_LAS unsigned char* lds, const Gemm g, const Sched& S, const Epi& E) {
    const int tid = threadIdx.x, wid = __builtin_amdgcn_readfirstlane(tid >> 6), lane = tid & 63, wr = wid >> 2, wc = wid & 3, fr = lane & 15, fq = lane >> 4;
    const int K = g.K, nt = K / BK;
    unsigned voffA[2], voffB[2];
#pragma unroll
    for (int i = 0; i < 2; ++i) { int R, C; stage_rc(tid * 16 + i * 8192, R, C); const int Rb = Epi::PERM ? ((R & ~31) + perm32(R & 31)) : R;
        voffA[i] = (unsigned)(R * K + C) * 2u; voffB[i] = (unsigned)(Rb * K + C) * 2u; }
    const size_t kstep = (size_t)(BK * 2);
    const size_t hstep = (size_t)HALF * K * 2;
    const size_t tstep = 2 * hstep;
    const unsigned ldsw = (unsigned)wid * 1024u;
    const int aoff = lds_byte(wr * 64 + fr, fq * 8), boff = lds_byte(wc * 32 + fr, fq * 8);
#define PG8_SA(b, h) (((b) * 2 + (h)) * HTB)
#define PG8_SB(b, h) ((4 + (b) * 2 + (h)) * HTB)
#define PG8_STAGE(bufoff, gbase, voff) do { _Pragma("unroll") for (int _i = 0; _i < 2; ++_i) \
        __builtin_amdgcn_global_load_lds((const unsigned*)((const char*)(gbase) + (voff)[_i]), (PG8_LAS unsigned*)(lds + (bufoff) + ldsw + _i * 8192), 16, 0, 0); } while (0)
#define PG8_LDA(dst, b, h) do { _Pragma("unroll") for (int m = 0; m < 4; ++m) { const v4i lo_ = *(const PG8_LAS v4i*)(lds + PG8_SA(b, h) + aoff + m * 2048), hi_ = *(const PG8_LAS v4i*)(lds + PG8_SA(b, h) + aoff + m * 2048 + 1024); \
        dst[m] = __builtin_shufflevector(lo_, hi_, 0, 1, 2, 3, 4, 5, 6, 7); } } while (0)
#define PG8_LDB(dst, b, h) do { _Pragma("unroll") for (int n = 0; n < 2; ++n) { const v4i lo_ = *(const PG8_LAS v4i*)(lds + PG8_SB(b, h) + boff + n * 2048), hi_ = *(const PG8_LAS v4i*)(lds + PG8_SB(b, h) + boff + n * 2048 + 1024); \
        dst[n] = __builtin_shufflevector(lo_, hi_, 0, 1, 2, 3, 4, 5, 6, 7); } } while (0)
#define PG8_MMA(ai, bj, At, Bt) do { __builtin_amdgcn_s_setprio(1); _Pragma("unroll") for (int m = 0; m < 4; ++m) _Pragma("unroll") for (int n = 0; n < 2; ++n) \
        asm volatile("v_mfma_scale_f32_16x16x128_f8f6f4 %0, %1, %2, %0, %3, %4 op_sel_hi:[0,0,0]" : "+v"(acc[ai][bj][m][n]) : "v"(Bt[n]), "v"(At[m]), "v"(sw8), "v"(sa8)); __builtin_amdgcn_s_setprio(0); } while (0)
#define PG8_WAIT_V(n) asm volatile("s_waitcnt vmcnt(" #n ")" ::: "memory")
#define PG8_WAIT_L(n) asm volatile("s_waitcnt lgkmcnt(" #n ")" ::: "memory")
#define PG8_BAR __builtin_amdgcn_s_barrier()
#define PG8_SCHED __builtin_amdgcn_sched_barrier(0)
    Unit cur = {0, 0, 0, 0}, nxt = {0, 0, 0, 0}; int ui = 0;
    if (!S.next(0, cur)) return;
    f32x4 acc[2][2][4][2];
#pragma unroll
    for (int a = 0; a < 2; ++a)
#pragma unroll
        for (int b = 0; b < 2; ++b)
#pragma unroll
            for (int m = 0; m < 4; ++m)
#pragma unroll
                for (int n = 0; n < 2; ++n) acc[a][b][m][n] = (f32x4){0.f, 0.f, 0.f, 0.f};
    v8i At[4], B0[2], B1[2]; int sw8 = SCALE_W8, sa8 = SCALE_A8;
    const char* cA = (const char*)g.A + (size_t)cur.pm * tstep; const char* cB = (const char*)g.Bt + (size_t)cur.pb * tstep;
    S.a_ready(cur);
    if constexpr (SP2) {
        PG8_STAGE(PG8_SB(0, 0), cB, voffB); PG8_STAGE(PG8_SB(0, 1), cB + hstep, voffB); PG8_STAGE(PG8_SA(0, 0), cA, voffA); PG8_STAGE(PG8_SA(0, 1), cA + hstep, voffA);
        if (wr == 1) PG8_BAR;
        PG8_WAIT_V(2); PG8_BAR;
        PG8_STAGE(PG8_SB(1, 0), cB + kstep, voffB); PG8_STAGE(PG8_SA(1, 0), cA + kstep, voffA); PG8_STAGE(PG8_SB(1, 1), cB + hstep + kstep, voffB);
        PG8_WAIT_V(6); PG8_BAR;
    } else {
        PG8_STAGE(PG8_SB(0, 0), cB, voffB); PG8_STAGE(PG8_SA(0, 0), cA, voffA); PG8_STAGE(PG8_SB(0, 1), cB + hstep, voffB); PG8_STAGE(PG8_SA(0, 1), cA + hstep, voffA);
        if (wr == 1) PG8_BAR;
        PG8_WAIT_V(4); PG8_BAR;
        PG8_STAGE(PG8_SB(1, 0), cB + kstep, voffB); PG8_STAGE(PG8_SA(1, 0), cA + kstep, voffA); PG8_STAGE(PG8_SB(1, 1), cB + hstep + kstep, voffB);
        PG8_WAIT_V(6); PG8_BAR;
    }
    for (;;) {
        const bool has_next = S.next(ui + 1, nxt);
        const char* nA = has_next ? (const char*)g.A + (size_t)nxt.pm * tstep : cA; const char* nB = has_next ? (const char*)g.Bt + (size_t)nxt.pb * tstep : cB;
        for (int t = 0; t < nt; t += 2) {
            const bool last = (t == nt - 2);
            const char* a1 = cA + (size_t)(t + 1) * kstep;
            const char* a2 = last ? nA : cA + (size_t)(t + 2) * kstep; const char* b2 = last ? nB : cB + (size_t)(t + 2) * kstep;
            const char* a3 = a2 + kstep; const char* b3 = b2 + kstep;
            if (last && has_next) S.a_ready(nxt);
            if constexpr (SP2) {
            PG8_LDB(B0, 0, 0); PG8_LDB(B1, 0, 1); PG8_SCHED; PG8_LDA(At, 0, 0); PG8_STAGE(PG8_SA(1, 1), a1 + hstep, voffA);
            PG8_WAIT_V(8); PG8_WAIT_L(0); PG8_BAR; PG8_MMA(0, 0, At, B0); PG8_MMA(0, 1, At, B1); PG8_BAR; PG8_SCHED;
            PG8_LDA(At, 0, 1); PG8_STAGE(PG8_SB(0, 0), b2, voffB); PG8_STAGE(PG8_SB(0, 1), b2 + hstep, voffB); PG8_STAGE(PG8_SA(0, 0), a2, voffA);
            PG8_WAIT_V(8); PG8_WAIT_L(0); PG8_BAR; PG8_MMA(1, 0, At, B0); PG8_MMA(1, 1, At, B1); PG8_BAR; PG8_SCHED;
            PG8_LDB(B0, 1, 0); PG8_LDB(B1, 1, 1); PG8_SCHED; PG8_LDA(At, 1, 0); PG8_STAGE(PG8_SA(0, 1), a2 + hstep, voffA);
            PG8_WAIT_V(8); PG8_WAIT_L(0); PG8_BAR; PG8_MMA(0, 0, At, B0); PG8_MMA(0, 1, At, B1); PG8_BAR; PG8_SCHED;
            PG8_LDA(At, 1, 1); PG8_STAGE(PG8_SB(1, 0), b3, voffB); PG8_STAGE(PG8_SB(1, 1), b3 + hstep, voffB); PG8_STAGE(PG8_SA(1, 0), a3, voffA);
            PG8_WAIT_V(8); PG8_WAIT_L(0); PG8_BAR; PG8_MMA(1, 0, At, B0); PG8_MMA(1, 1, At, B1); PG8_BAR; PG8_SCHED;
            } else {
            PG8_LDB(B0, 0, 0); PG8_SCHED; PG8_LDA(At, 0, 0); PG8_STAGE(PG8_SA(1, 1), a1 + hstep, voffA);
            PG8_WAIT_L(8); PG8_BAR; PG8_WAIT_L(0); PG8_MMA(0, 0, At, B0); PG8_BAR; PG8_SCHED;
            PG8_LDB(B1, 0, 1); PG8_STAGE(PG8_SB(0, 0), b2, voffB);
            PG8_BAR; PG8_WAIT_L(0); PG8_MMA(0, 1, At, B1); PG8_BAR;
            PG8_LDA(At, 0, 1); PG8_STAGE(PG8_SA(0, 0), a2, voffA);
            PG8_BAR; PG8_WAIT_L(0); PG8_MMA(1, 0, At, B0); PG8_BAR; PG8_SCHED;
            PG8_STAGE(PG8_SB(0, 1), b2 + hstep, voffB);
            PG8_WAIT_V(6); PG8_BAR; PG8_MMA(1, 1, At, B1); PG8_BAR;
            PG8_LDB(B0, 1, 0); PG8_SCHED; PG8_LDA(At, 1, 0); PG8_STAGE(PG8_SA(0, 1), a2 + hstep, voffA);
            PG8_WAIT_L(8); PG8_BAR; PG8_WAIT_L(0); PG8_MMA(0, 0, At, B0); PG8_BAR; PG8_SCHED;
            PG8_LDB(B1, 1, 1); PG8_STAGE(PG8_SB(1, 0), b3, voffB);
            PG8_BAR; PG8_WAIT_L(0); PG8_MMA(0, 1, At, B1); PG8_BAR;
            PG8_LDA(At, 1, 1); PG8_STAGE(PG8_SA(1, 0), a3, voffA);
            PG8_BAR; PG8_WAIT_L(0); PG8_MMA(1, 0, At, B0); PG8_BAR; PG8_SCHED;
            PG8_STAGE(PG8_SB(1, 1), b3 + hstep, voffB);
            PG8_WAIT_V(6); PG8_BAR; PG8_MMA(1, 1, At, B1); PG8_BAR;
            }
        }
        if constexpr (ALIGN_EPI) { if (wr == 0) PG8_BAR; }
        asm volatile("s_nop 15\n\ts_nop 7" ::: "memory");
        if constexpr (!Epi::AFTER_DRAIN) { E(acc, cur, wr, wc, fr, fq); S.done(cur); }
        if (!has_next) break;
#pragma unroll
        for (int a = 0; a < 2; ++a)
#pragma unroll
            for (int b = 0; b < 2; ++b)
#pragma unroll
                for (int m = 0; m < 4; ++m)
#pragma unroll
                    for (int n = 0; n < 2; ++n) acc[a][b][m][n] = (f32x4){0.f, 0.f, 0.f, 0.f};
        cur = nxt; cA = nA; cB = nB; ++ui;
        if constexpr (ALIGN_EPI) { if (wr == 1) PG8_BAR; }
    }
    PG8_WAIT_V(0);
    if constexpr (!ALIGN_EPI) { if (wr == 0) PG8_BAR; }
    PG8_BAR;
    if constexpr (Epi::AFTER_DRAIN) { E.fused(acc, cur, wr, wc, fr, fq, lds, wid, lane); S.done(cur); }
#undef PG8_SA
#undef PG8_SB
#undef PG8_STAGE
#undef PG8_LDA
#undef PG8_LDB
#undef PG8_MMA
#undef PG8_WAIT_V
#undef PG8_WAIT_L
#undef PG8_BAR
#undef PG8_SCHED
}
template <class Epi, class Sched, bool ALIGN_EPI = false, bool SP2 = false>
__device__ __forceinline__ void gemm_phase8g(PG8_LAS unsigned char* lds, const Gemm g, const Sched& S, const Epi& E, const PG8_LAS int* rowc) {
    static_assert(SP2, "gathered-A variant: SP2 loop only");
    const int tid = threadIdx.x, wid = __builtin_amdgcn_readfirstlane(tid >> 6), lane = tid & 63, wr = wid >> 2, wc = wid & 3, fr = lane & 15, fq = lane >> 4;
    const int K = g.K, nt = K / BK;
    unsigned voffA[2], voffB[2];
#pragma unroll
    for (int i = 0; i < 2; ++i) { int R, C; stage_rc(tid * 16 + i * 8192, R, C); const int Rb = Epi::PERM ? ((R & ~31) + perm32(R & 31)) : R;
        voffA[i] = (unsigned)(R * K + C) * 2u; voffB[i] = (unsigned)(Rb * K + C) * 2u; }
    int RA[2], CA[2];
#pragma unroll
    for (int i = 0; i < 2; ++i) stage_rc(tid * 16 + i * 8192, RA[i], CA[i]);
    const unsigned rowB = (unsigned)K * 2u;
#define PG8_GOFF(dst, ui_) do { _Pragma("unroll") for (int h_ = 0; h_ < 2; ++h_) _Pragma("unroll") for (int i_ = 0; i_ < 2; ++i_) dst[h_][i_] = (unsigned)rowc[(ui_) * 256 + h_ * HALF + RA[i_]] * rowB + (unsigned)CA[i_] * 2u; } while (0)
    const size_t kstep = (size_t)(BK * 2);
    const size_t hstep = (size_t)HALF * K * 2;
    const size_t tstep = 2 * hstep;
    const unsigned ldsw = (unsigned)wid * 1024u;
    const int aoff = lds_byte(wr * 64 + fr, fq * 8), boff = lds_byte(wc * 32 + fr, fq * 8);
#define PG8_SA(b, h) (((b) * 2 + (h)) * HTB)
#define PG8_SB(b, h) ((4 + (b) * 2 + (h)) * HTB)
#define PG8_STAGE(bufoff, gbase, voff) do { _Pragma("unroll") for (int _i = 0; _i < 2; ++_i) \
        __builtin_amdgcn_global_load_lds((const unsigned*)((const char*)(gbase) + (voff)[_i]), (PG8_LAS unsigned*)(lds + (bufoff) + ldsw + _i * 8192), 16, 0, 0); } while (0)
#define PG8_LDA(dst, b, h) do { _Pragma("unroll") for (int m = 0; m < 4; ++m) { const v4i lo_ = *(const PG8_LAS v4i*)(lds + PG8_SA(b, h) + aoff + m * 2048), hi_ = *(const PG8_LAS v4i*)(lds + PG8_SA(b, h) + aoff + m * 2048 + 1024); \
        dst[m] = __builtin_shufflevector(lo_, hi_, 0, 1, 2, 3, 4, 5, 6, 7); } } while (0)
#define PG8_LDB(dst, b, h) do { _Pragma("unroll") for (int n = 0; n < 2; ++n) { const v4i lo_ = *(const PG8_LAS v4i*)(lds + PG8_SB(b, h) + boff + n * 2048), hi_ = *(const PG8_LAS v4i*)(lds + PG8_SB(b, h) + boff + n * 2048 + 1024); \
        dst[n] = __builtin_shufflevector(lo_, hi_, 0, 1, 2, 3, 4, 5, 6, 7); } } while (0)
#define PG8_MMA(ai, bj, At, Bt) do { __builtin_amdgcn_s_setprio(1); _Pragma("unroll") for (int m = 0; m < 4; ++m) _Pragma("unroll") for (int n = 0; n < 2; ++n) \
        asm volatile("v_mfma_scale_f32_16x16x128_f8f6f4 %0, %1, %2, %0, %3, %4 op_sel_hi:[0,0,0]" : "+v"(acc[ai][bj][m][n]) : "v"(Bt[n]), "v"(At[m]), "v"(sw8), "v"(sa8)); __builtin_amdgcn_s_setprio(0); } while (0)
#define PG8_WAIT_V(n) asm volatile("s_waitcnt vmcnt(" #n ")" ::: "memory")
#define PG8_WAIT_L(n) asm volatile("s_waitcnt lgkmcnt(" #n ")" ::: "memory")
#define PG8_BAR __builtin_amdgcn_s_barrier()
#define PG8_SCHED __builtin_amdgcn_sched_barrier(0)
    Unit cur = {0, 0, 0, 0}, nxt = {0, 0, 0, 0}; int ui = 0;
    if (!S.next(0, cur)) return;
    f32x4 acc[2][2][4][2];
#pragma unroll
    for (int a = 0; a < 2; ++a)
#pragma unroll
        for (int b = 0; b < 2; ++b)
#pragma unroll
            for (int m = 0; m < 4; ++m)
#pragma unroll
                for (int n = 0; n < 2; ++n) acc[a][b][m][n] = (f32x4){0.f, 0.f, 0.f, 0.f};
    v8i At[4], B0[2], B1[2]; int sw8 = SCALE_W8, sa8 = SCALE_A8;
    const char* gA = (const char*)g.A; const char* cB = (const char*)g.Bt + (size_t)cur.pb * tstep;
    unsigned cgA[2][2], ngA[2][2]; PG8_GOFF(cgA, 0);
    S.a_ready(cur);
    if constexpr (SP2) {
        PG8_STAGE(PG8_SB(0, 0), cB, voffB); PG8_STAGE(PG8_SB(0, 1), cB + hstep, voffB); PG8_STAGE(PG8_SA(0, 0), gA, cgA[0]); PG8_STAGE(PG8_SA(0, 1), gA, cgA[1]);
        if (wr == 1) PG8_BAR;
        PG8_WAIT_V(2); PG8_BAR;
        PG8_STAGE(PG8_SB(1, 0), cB + kstep, voffB); PG8_STAGE(PG8_SA(1, 0), gA + kstep, cgA[0]); PG8_STAGE(PG8_SB(1, 1), cB + hstep + kstep, voffB);
        PG8_WAIT_V(6); PG8_BAR;
    } else {
    }
    for (;;) {
        const bool has_next = S.next(ui + 1, nxt);
        const char* nB = has_next ? (const char*)g.Bt + (size_t)nxt.pb * tstep : cB;
        if (has_next) PG8_GOFF(ngA, ui + 1); else { _Pragma("unroll") for (int h_ = 0; h_ < 2; ++h_) _Pragma("unroll") for (int i_ = 0; i_ < 2; ++i_) ngA[h_][i_] = cgA[h_][i_]; }
        for (int t = 0; t < nt; t += 2) {
            const bool last = (t == nt - 2);
            const char* a1 = gA + (size_t)(t + 1) * kstep;
            const char* a2 = gA + (last ? (size_t)0 : (size_t)(t + 2) * kstep); const char* b2 = last ? nB : cB + (size_t)(t + 2) * kstep;
            unsigned sgA[2][2];
#pragma unroll
            for (int h_ = 0; h_ < 2; ++h_)
#pragma unroll
                for (int i_ = 0; i_ < 2; ++i_) sgA[h_][i_] = last ? ngA[h_][i_] : cgA[h_][i_];
            const char* a3 = a2 + kstep; const char* b3 = b2 + kstep;
            if (last && has_next) S.a_ready(nxt);
            if constexpr (SP2) {
            PG8_LDB(B0, 0, 0); PG8_LDB(B1, 0, 1); PG8_SCHED; PG8_LDA(At, 0, 0); PG8_STAGE(PG8_SA(1, 1), a1, cgA[1]);
            PG8_WAIT_V(8); PG8_WAIT_L(0); PG8_BAR; PG8_MMA(0, 0, At, B0); PG8_MMA(0, 1, At, B1); PG8_BAR; PG8_SCHED;
            PG8_LDA(At, 0, 1); PG8_STAGE(PG8_SB(0, 0), b2, voffB); PG8_STAGE(PG8_SB(0, 1), b2 + hstep, voffB); PG8_STAGE(PG8_SA(0, 0), a2, sgA[0]);
            PG8_WAIT_V(8); PG8_WAIT_L(0); PG8_BAR; PG8_MMA(1, 0, At, B0); PG8_MMA(1, 1, At, B1); PG8_BAR; PG8_SCHED;
            PG8_LDB(B0, 1, 0); PG8_LDB(B1, 1, 1); PG8_SCHED; PG8_LDA(At, 1, 0); PG8_STAGE(PG8_SA(0, 1), a2, sgA[1]);
            PG8_WAIT_V(8); PG8_WAIT_L(0); PG8_BAR; PG8_MMA(0, 0, At, B0); PG8_MMA(0, 1, At, B1); PG8_BAR; PG8_SCHED;
            PG8_LDA(At, 1, 1); PG8_STAGE(PG8_SB(1, 0), b3, voffB); PG8_STAGE(PG8_SB(1, 1), b3 + hstep, voffB); PG8_STAGE(PG8_SA(1, 0), a3, sgA[0]);
            PG8_WAIT_V(8); PG8_WAIT_L(0); PG8_BAR; PG8_MMA(1, 0, At, B0); PG8_MMA(1, 1, At, B1); PG8_BAR; PG8_SCHED;
            }
        }
        if constexpr (ALIGN_EPI) { if (wr == 0) PG8_BAR; }
        asm volatile("s_nop 15\n\ts_nop 7" ::: "memory");
        if constexpr (!Epi::AFTER_DRAIN) { E(acc, cur, wr, wc, fr, fq); S.done(cur); }
        if (!has_next) break;
#pragma unroll
        for (int a = 0; a < 2; ++a)
#pragma unroll
            for (int b = 0; b < 2; ++b)
#pragma unroll
                for (int m = 0; m < 4; ++m)
#pragma unroll
                    for (int n = 0; n < 2; ++n) acc[a][b][m][n] = (f32x4){0.f, 0.f, 0.f, 0.f};
        cur = nxt; cB = nB; ++ui;
#pragma unroll
        for (int h_ = 0; h_ < 2; ++h_)
#pragma unroll
            for (int i_ = 0; i_ < 2; ++i_) cgA[h_][i_] = ngA[h_][i_];
        if constexpr (ALIGN_EPI) { if (wr == 1) PG8_BAR; }
    }
    PG8_WAIT_V(0);
    if constexpr (!ALIGN_EPI) { if (wr == 0) PG8_BAR; }
    PG8_BAR;
    if constexpr (Epi::AFTER_DRAIN) { E.fused(acc, cur, wr, wc, fr, fq, lds, wid, lane); S.done(cur); }
#undef PG8_GOFF
#undef PG8_SA
#undef PG8_SB
#undef PG8_STAGE
#undef PG8_LDA
#undef PG8_LDB
#undef PG8_MMA
#undef PG8_WAIT_V
#undef PG8_WAIT_L
#undef PG8_BAR
#undef PG8_SCHED
}
}
#define GAS __attribute__((address_space(1)))
#define LAS __attribute__((address_space(3)))
typedef unsigned short bf16;
typedef unsigned v4u __attribute__((ext_vector_type(4)));
typedef float f32x4 __attribute__((ext_vector_type(4)));
typedef short bf16x8 __attribute__((ext_vector_type(8)));
typedef GAS unsigned gu32;
typedef GAS unsigned long long gu64;
#define RLX_AGENT __ATOMIC_RELAXED, __HIP_MEMORY_SCOPE_AGENT
#define LDS_WAIT() asm volatile("s_waitcnt lgkmcnt(0)" ::: "memory")
#define VM_WAIT() asm volatile("s_waitcnt vmcnt(0)" ::: "memory")
__device__ __forceinline__ unsigned long long rt() { return __builtin_amdgcn_s_memrealtime(); }
__device__ __forceinline__ unsigned f2bf(float f) { unsigned u = __builtin_bit_cast(unsigned, f); return (u + 0x7fffu + ((u >> 16) & 1u)) >> 16; }
__device__ __forceinline__ unsigned pk2(float lo, float hi) { return f2bf(lo) | (f2bf(hi) << 16); }

#define XB_TMO      128
#define XB_XCNT(j)  (256  + 64 * (j))
#define XB_XSUB(j)  (1280 + 64 * (j))
#define XB_XGEN(j)  (2304 + 64 * (j))
#define XB_TOP      3328
#define XB_TOPGEN   3392
#define XCD_BAR_WORDS 3456
#define XB_SPIN_CAP (1u << 18)

__device__ __forceinline__ unsigned xb_ld(unsigned* p)              { return __hip_atomic_load(p, __ATOMIC_RELAXED, __HIP_MEMORY_SCOPE_AGENT); }
__device__ __forceinline__ unsigned xb_add(unsigned* p, unsigned v) { return __hip_atomic_fetch_add(p, v, __ATOMIC_RELAXED, __HIP_MEMORY_SCOPE_AGENT); }
__device__ __forceinline__ unsigned xb_xcc_id() { return (unsigned)__builtin_amdgcn_s_getreg((3 << 11) | 20) & 0xFu; }
#define XB_SPIN(cond, bar) do { unsigned _sp = 0; while (cond) { __builtin_amdgcn_s_sleep(1); \
    if ((++_sp & 255u) == 0u) { if (xb_ld(&(bar)[XB_TMO])) break; if (_sp > XB_SPIN_CAP) { atomicAdd(&(bar)[XB_TMO], 1u); break; } } } } while (0)

struct XcdBarrier {
    unsigned* bar; unsigned x;
    volatile LAS unsigned* st;
};

__device__ __forceinline__ XcdBarrier xcd_barrier_post(unsigned* bar, volatile LAS unsigned* st) {
    XcdBarrier b; b.bar = bar; b.x = xb_xcc_id(); b.st = st;
    if (threadIdx.x == 0) (void)xb_add(&bar[XB_XCNT(b.x)], 1u);
    return b;
}
__device__ __forceinline__ void xcd_barrier_complete(unsigned* bar, unsigned x, unsigned& nloc, unsigned& nx) {
    const unsigned G = gridDim.x * gridDim.y * gridDim.z;
    unsigned sum, cnt, mine, sp = 0u;
    for (;;) {
        sum = 0u; cnt = 0u; mine = 0u;
#pragma unroll
        for (unsigned j = 0; j < 16; ++j) { const unsigned c = xb_ld(&bar[XB_XCNT(j)]); sum += c; cnt += (c > 0u) ? 1u : 0u; mine = (j == x) ? c : mine; }
        if (sum == G) break;
        __builtin_amdgcn_s_sleep(1);
        if ((++sp & 255u) == 0u) { if (xb_ld(&bar[XB_TMO])) break; if (sp > XB_SPIN_CAP) { atomicAdd(&bar[XB_TMO], 1u); break; } }
    }
    nloc = mine > 0u ? mine : 1u; nx = cnt > 0u ? cnt : 1u;
}

__device__ __forceinline__ void xcd_barrier(const XcdBarrier& b) {
    asm volatile("s_waitcnt vmcnt(0)" ::: "memory");
    __syncthreads();
    if (threadIdx.x == 0) {
        unsigned* bar = b.bar;
        __builtin_amdgcn_s_waitcnt(0);
        unsigned nloc = b.st[0], nx = b.st[1];
        if (nloc == 0u) { xcd_barrier_complete(bar, b.x, nloc, nx); b.st[0] = nloc; b.st[1] = nx; }
        const unsigned old = xb_add(&bar[XB_XSUB(b.x)], 1u);
        const unsigned gen = old / nloc;
        if (old + 1u == (gen + 1u) * nloc) {
            __builtin_amdgcn_fence(__ATOMIC_RELEASE, "agent");
            asm volatile("s_waitcnt vmcnt(0)" ::: "memory");
            const unsigned og = xb_add(&bar[XB_TOP], 1u);
            const unsigned tg = og / nx;
            if (og + 1u == (tg + 1u) * nx) xb_add(&bar[XB_TOPGEN], 1u);
            else XB_SPIN(xb_ld(&bar[XB_TOPGEN]) == tg, bar);
            __builtin_amdgcn_fence(__ATOMIC_ACQUIRE, "agent");
            xb_add(&bar[XB_XGEN(b.x)], 1u);
            asm volatile("s_waitcnt vmcnt(0)" ::: "memory");
        } else {
            XB_SPIN(xb_ld(&bar[XB_XGEN(b.x)]) == gen, bar);
            __builtin_amdgcn_fence(__ATOMIC_ACQUIRE, "agent");
            asm volatile("s_waitcnt vmcnt(0)" ::: "memory");
        }
    }
    __syncthreads();
}
namespace mk {
constexpr int S = 8192, D = 2048, NPROJ = 6160, NPP = 6144, NPAD = 6400, NE = 32, FF = 2048, NWAVES = 8, NTHR = 512;
constexpr int C_MQ = 0, C_MK = 512, C_MV = 1024, C_MO = 2048, C_FQ = 3072, C_FK = 4096, C_FV = 5120;
constexpr int MAXROWS = S * 4 + NE * 256;
constexpr int NCH = 128, LCH = 64;
constexpr size_t MiB = 1u << 20;
constexpr size_t WS_CTL = 0, CTL_ZERO_BYTES = 1 * MiB;
constexpr size_t WS_MODP = 14 * MiB;
constexpr size_t WS_MOD = 2 * MiB;
constexpr size_t WS_GATES = 3 * MiB;
constexpr size_t WS_F = 4 * MiB;
constexpr size_t WS_NL = 5 * MiB;
constexpr size_t WS_NS = 6 * MiB;
constexpr size_t WS_GLAL = 7 * MiB;
constexpr size_t WS_MS = 7 * MiB + 65536;
constexpr size_t WS_TOPI = 8 * MiB;
constexpr size_t WS_TOPW = 9 * MiB;
constexpr size_t WS_HIST = 10 * MiB;
constexpr size_t WS_LRANK = 11 * MiB;
constexpr size_t WS_POS = 12 * MiB;
constexpr size_t WS_ROWW = 13 * MiB;
constexpr size_t WS_ROWTOK = 13 * MiB + 512 * 1024;
constexpr size_t WS_WIN = 16 * MiB;
constexpr size_t WS_WOUT = 42 * MiB;
constexpr size_t WS_HN = 50 * MiB;
constexpr size_t WS_PROJ = 82 * MiB;
constexpr size_t WS_UL = 178 * MiB;
constexpr size_t WS_CS = 242 * MiB;
constexpr size_t WS_CONCAT = 274 * MiB;
constexpr size_t WS_H1 = 306 * MiB;
constexpr size_t WS_XG = 370 * MiB;
constexpr size_t WS_ACT = 530 * MiB;
constexpr size_t WS_Y = 690 * MiB;
constexpr size_t WS_WUG = 850 * MiB;
constexpr size_t WS_WD = 1362 * MiB;
constexpr size_t WS_OPART = 1618 * MiB;
constexpr size_t WS_MLP = 1786 * MiB;
constexpr size_t WS_JLO = 1789 * MiB;
constexpr size_t WS_END = 1790 * MiB;
constexpr size_t WS_NAIVE = 1792 * MiB;
constexpr int CW_TMO = 0, CW_CODE = 1, CW_CONV = 65536, CW_DONE = 2048, CW_BAR = 4096;
constexpr int GC_INPROJ = 128, GC_ATTN = 160, GC_PREP = 192;
constexpr int RING_OFF = 0, RING_BYTES = 131072;
constexpr int LDSCTL_OFF = RING_BYTES, MISC_OFF = LDSCTL_OFF + 320;
constexpr int TAB_OFF = LDSCTL_OFF + 1024;
constexpr int ROWC_MAX = 13;
constexpr int ATT_CH = 16;
constexpr int LDS_BYTES = 147456;
static_assert(GC_INPROJ <= 248 && GC_INPROJ % 8 == 0 && GC_ATTN % 8 == 0, "compute groups: multiples of 8; the in-proj group leaves slot 31 to the forget-gate scans");
}
namespace mk {
typedef float f32x2 __attribute__((ext_vector_type(2)));
typedef unsigned u32x2 __attribute__((ext_vector_type(2)));
struct Frame {
    LAS unsigned char* lds;
    volatile LAS unsigned* MISC;
    gu32* ctl;
    int tid, lane, wave, vcu, G, bid;
    const float* in[24];
    float* out; unsigned char* ws;
};
#define IN_X 0
#define IN_C 1
#define IN_WADA 2
#define IN_BADA 3
#define IN_NMIX 4
#define IN_WIN 5
#define IN_BI 6
#define IN_BF 7
#define IN_FOXBF 8
#define IN_FOXQN 9
#define IN_FOXKN 10
#define IN_MOUTN 11
#define IN_FOUTN 12
#define IN_WOUT 13
#define IN_NFFN 14
#define IN_WR 15
#define IN_BR 16
#define IN_WUG 17
#define IN_BUG 18
#define IN_WD 19
#define IN_BD 20
#define IN_WAF 21
#define IN_BAF 22
#define IN_NFIN 23
template <class T> __device__ __forceinline__ T* wsp(const Frame& F, size_t off) { return (T*)(F.ws + off); }
__device__ __forceinline__ float wave_sum(float v) {
#pragma unroll
    for (int o = 1; o < 64; o <<= 1) v += __shfl_xor(v, o);
    return v;
}
__device__ __forceinline__ float sigmoid_f(float v) { return 1.f / (1.f + __expf(-v)); }
__device__ __forceinline__ float log_sigmoid_f(float v) { return fminf(v, 0.f) - log1pf(__expf(-fabsf(v))); }
__device__ __forceinline__ float softcap_f(float v) { return 15.f * tanhf(v * (1.f / 15.f)); }
__device__ __forceinline__ float bf2f(unsigned short b) { return __uint_as_float(((unsigned)b) << 16); }

struct CvtItem { const float* src; bf16* dst; };
__device__ __forceinline__ void cvt_load(const CvtItem& it, int ldw, f32x4 (&v)[16], int lane) {
    const float* p = it.src + (size_t)((lane >> 4) * 16) * ldw + (lane & 15) * 4;
#pragma unroll
    for (int i = 0; i < 16; ++i) v[i] = __builtin_nontemporal_load((const GAS f32x4*)(p + (size_t)i * ldw));
}
__device__ __forceinline__ void cvt_store(const CvtItem& it, int K, const f32x4 (&v)[16], LAS unsigned char* scr, int lane) {
    const int c = lane & 15, g = lane >> 4;
#pragma unroll
    for (int j = 0; j < 4; ++j) {
        v4u a, b;
        a.x = pk2(v[0][j], v[1][j]); a.y = pk2(v[2][j], v[3][j]); a.z = pk2(v[4][j], v[5][j]); a.w = pk2(v[6][j], v[7][j]);
        b.x = pk2(v[8][j], v[9][j]); b.y = pk2(v[10][j], v[11][j]); b.z = pk2(v[12][j], v[13][j]); b.w = pk2(v[14][j], v[15][j]);
        LAS unsigned char* q = scr + (4 * c + j) * 144 + 32 * g;
        *(LAS v4u*)q = a; *(LAS v4u*)(q + 16) = b; }
    LDS_WAIT(); asm volatile("" ::: "memory");
#pragma unroll
    for (int i = 0; i < 8; ++i) { const int row = (lane >> 3) + 8 * i; const v4u o = *(const LAS v4u*)(scr + row * 144 + (lane & 7) * 16);
        *(GAS v4u*)(it.dst + (size_t)row * K + (lane & 7) * 8) = o; }
    LDS_WAIT(); asm volatile("" ::: "memory");
}
__device__ __forceinline__ unsigned pk4_fp8(float a, float b, float c, float d) { int r = __builtin_amdgcn_cvt_pk_fp8_f32(a, b, 0, false); r = __builtin_amdgcn_cvt_pk_fp8_f32(c, d, r, true); return (unsigned)r; }
constexpr float W8S = 128.f;
__device__ __forceinline__ void cvt8_pack(const f32x4 (&v)[16], LAS unsigned char* scr, int half, int lane) {
    const int c = lane & 15, g = lane >> 4;
#pragma unroll
    for (int j = 0; j < 4; ++j) { v4u a;
        a.x = pk4_fp8(v[0][j] * W8S, v[1][j] * W8S, v[2][j] * W8S, v[3][j] * W8S); a.y = pk4_fp8(v[4][j] * W8S, v[5][j] * W8S, v[6][j] * W8S, v[7][j] * W8S);
        a.z = pk4_fp8(v[8][j] * W8S, v[9][j] * W8S, v[10][j] * W8S, v[11][j] * W8S); a.w = pk4_fp8(v[12][j] * W8S, v[13][j] * W8S, v[14][j] * W8S, v[15][j] * W8S);
        *(LAS v4u*)(scr + (4 * c + j) * 144 + half * 64 + 16 * g) = a; }
}
__device__ __forceinline__ void cvt8_flush(unsigned char* dst, int kbytes, LAS unsigned char* scr, int lane) {
    LDS_WAIT(); asm volatile("" ::: "memory");
#pragma unroll
    for (int i = 0; i < 8; ++i) { const int row = (lane >> 3) + 8 * i; const v4u o = *(const LAS v4u*)(scr + row * 144 + (lane & 7) * 16);
        __builtin_nontemporal_store(o, (GAS v4u*)(dst + (size_t)row * kbytes + (lane & 7) * 16)); }
    LDS_WAIT(); asm volatile("" ::: "memory");
}
constexpr int CV8_UG = NE * 16 * 64, CV8_D = NE * 16 * 32, CV8_TOTAL = CV8_UG + CV8_D;
struct Cvt8Item { const float* src; unsigned char* dst; int ldw; };
__device__ __forceinline__ Cvt8Item cvt8_item(const Frame& F, int it, int half) {
    Cvt8Item r;
    if (it < CV8_UG) { const int e = it >> 10, q = it & 1023, kb = q >> 6, nb = q & 63, d0 = nb * 64, j = d0 >> 8, wv = d0 & 255, sc = wv < 128 ? 128 * j + wv : 2048 + 128 * j + (wv - 128);
        r.ldw = 4096; r.src = F.in[IN_WUG] + (size_t)e * D * 4096 + (size_t)(kb * 128 + half * 64) * 4096 + sc; r.dst = wsp<unsigned char>(F, WS_WUG) + (size_t)e * 4096 * D + (size_t)d0 * D + kb * 128; return r; }
    it -= CV8_UG;
    { const int e = it >> 9, q = it & 511, kb = q >> 5, nb = q & 31;
        r.ldw = D; r.src = F.in[IN_WD] + (size_t)e * FF * D + (size_t)(kb * 128 + half * 64) * D + nb * 64; r.dst = wsp<unsigned char>(F, WS_WD) + (size_t)e * D * FF + (size_t)(nb * 64) * FF + kb * 128; return r; }
}
__device__ __forceinline__ void cvt8_load(const Cvt8Item& it, f32x4 (&v)[16], int lane) {
    const float* p = it.src + (size_t)((lane >> 4) * 16) * it.ldw + (lane & 15) * 4;
#pragma unroll
    for (int i = 0; i < 16; ++i) v[i] = __builtin_nontemporal_load((const GAS f32x4*)(p + (size_t)i * it.ldw));
}
constexpr int CV_IN = 32 * 96, CV_OUT = 32 * 32, CV_TOTAL = CV_IN + CV_OUT;
__device__ __forceinline__ CvtItem cvt_item(const Frame& F, int it, int& ldw, int& K) {
    CvtItem r;
    if (it < CV_IN) { const int kb = it / 96, nb = it % 96, d0 = nb * 64, sc = d0 < 3072 ? d0 : d0 + 8;
        ldw = NPROJ; K = D; r.src = F.in[IN_WIN] + (size_t)(kb * 64) * NPROJ + sc; r.dst = wsp<bf16>(F, WS_WIN) + (size_t)d0 * D + kb * 64; return r; }
    it -= CV_IN;
    { const int kb = it >> 5, nb = it & 31; ldw = D; K = D; r.src = F.in[IN_WOUT] + (size_t)(kb * 64) * D + nb * 64; r.dst = wsp<bf16>(F, WS_WOUT) + (size_t)(nb * 64) * D + kb * 64; return r; }
}
__device__ __forceinline__ void p1_convert(Frame& F, int first);
__device__ __forceinline__ void p0_gemv(Frame& F) {
    const int gw = F.vcu * NWAVES + F.wave, NGW = F.G * NWAVES, lane = F.lane;
    int cldw = 0, cK = 0; CvtItem c0 = {nullptr, nullptr}; f32x4 cva[16];
    if (gw < CV_TOTAL) { c0 = cvt_item(F, gw, cldw, cK); cvt_load(c0, cldw, cva, lane); }
    {
        const float* c = F.in[IN_C]; float* modp = wsp<float>(F, WS_MODP);
        for (int task = gw; task < 2048; task += NGW) {
            const int cg = task & 63, ks = task >> 6, j = cg * 256 + 4 * lane;
            const float* w; int ld, col;
            if (j < 6 * D) { w = F.in[IN_WADA]; ld = 6 * D; col = j; } else { w = F.in[IN_WAF]; ld = 2 * D; col = j - 6 * D; }
            const float c0 = c[ks * 64 + lane]; const float s0 = c0 * sigmoid_f(c0);
            const float* wp = w + (size_t)(ks * 64) * ld + col; f32x4 acc = {0.f, 0.f, 0.f, 0.f};
#pragma unroll 16
            for (int i = 0; i < 64; ++i) acc += __builtin_nontemporal_load((const GAS f32x4*)(wp + (size_t)i * ld)) * __builtin_bit_cast(float, __builtin_amdgcn_readlane(__builtin_bit_cast(int, s0), i));
            *(GAS f32x4*)(modp + ks * 16384 + j) = acc;
        }
    }
    if (gw < CV_TOTAL) cvt_store(c0, cK, cva, F.lds + RING_OFF + F.wave * 9216, lane);
    p1_convert(F, gw + NGW);
    {
        bf16* win_t = wsp<bf16>(F, WS_WIN);
        for (int i2 = gw; i2 < D / 4; i2 += NGW) {
            const int col = lane & 15, k = 4 * i2 + (lane >> 4), sc = col < 8 ? 3072 + col : 6152 + (col - 8);
            win_t[(size_t)(NPP + col) * D + k] = (bf16)f2bf(F.in[IN_WIN][(size_t)k * NPROJ + sc]); }
        const v4u z = {0u, 0u, 0u, 0u};
        for (int i = gw * 64 + lane; i < 16 * D / 8; i += NGW * 64) *(GAS v4u*)(win_t + (size_t)NPROJ * D + (size_t)i * 8) = z;
    }
}
constexpr int CV8_NSH = 32, CV8_SHA = CV8_UG / CV8_NSH, CV8_SHB = CV8_D / CV8_NSH;
#define CONV_NEXT(var) do { var = CV8_TOTAL; \
        if (useA) { const int b_ = __builtin_amdgcn_readfirstlane((int)(lane == 0 ? __hip_atomic_fetch_add(ctrA, 1u, RLX_AGENT) : 0u)); if (b_ < CV8_SHA) var = xs * CV8_SHA + b_; else useA = false; } \
        if (var == CV8_TOTAL && useB) { const int b_ = __builtin_amdgcn_readfirstlane((int)(lane == 0 ? __hip_atomic_fetch_add(ctrB, 1u, RLX_AGENT) : 0u)); if (b_ < CV8_SHB) var = CV8_UG + xs * CV8_SHB + b_; else useB = false; } } while (0)
__device__ __forceinline__ void conv_worker(Frame& F, gu32* stop, unsigned target, int which) {
    LAS unsigned char* scr = F.lds + RING_OFF + F.wave * 9216; const int lane = F.lane, xs = (int)(blockIdx.x & (CV8_NSH - 1));
    gu32* ctrA = F.ctl + CW_CONV + 64 * xs; gu32* ctrB = F.ctl + CW_CONV + 64 * (CV8_NSH + xs);
    bool useA = which != 2, useB = which != 1;
    int it; CONV_NEXT(it); if (it >= CV8_TOTAL) return;
    f32x4 va[16], vb[16];
    Cvt8Item cur = cvt8_item(F, it, 0); cvt8_load(cur, va, lane);
    for (;;) {
        const Cvt8Item c1 = cvt8_item(F, it, 1); cvt8_load(c1, vb, lane);
        bool stopnow = false;
        if (stop) stopnow = (unsigned)__builtin_amdgcn_readfirstlane((int)__hip_atomic_load(stop, RLX_AGENT)) >= target;
        int itn = CV8_TOTAL; if (!stopnow) CONV_NEXT(itn);
        cvt8_pack(va, scr, 0, lane);
        const bool more = itn < CV8_TOTAL; Cvt8Item nx = cur;
        if (more) { nx = cvt8_item(F, itn, 0); cvt8_load(nx, va, lane); }
        cvt8_pack(vb, scr, 1, lane);
        cvt8_flush(cur.dst, D, scr, lane);
        if (!more) break;
        cur = nx; it = itn;
    }
}
__device__ __forceinline__ bool enter_group(Frame& F, int Gc) {
    if (F.G != 256 || Gc >= 256) return true;
    const int bx = (int)blockIdx.x, slot = bx >> 3, xcd = bx & 7, per = Gc >> 3;
    if (slot >= per) return false;
    F.vcu = xcd * per + slot; F.bid = slot * 8 + xcd; F.G = Gc; return true;
}
__device__ __forceinline__ void leave_group(Frame& F) { const int bx = (int)blockIdx.x, G = (int)gridDim.x; F.G = G; F.bid = bx; F.vcu = (G % 8 == 0) ? (bx % 8) * (G / 8) + bx / 8 : bx; }
__device__ __forceinline__ void p1_convert(Frame& F, int first) {
    const int NGW = F.G * NWAVES, lane = F.lane;
    {
        LAS unsigned char* scr = F.lds + RING_OFF + F.wave * 9216;
        int it = first;
        if (it < CV_TOTAL) {
            int ldw, K; CvtItem cur = cvt_item(F, it, ldw, K); f32x4 va[16], vb[16];
            cvt_load(cur, ldw, va, lane);
            for (;;) {
                int itn = it + NGW; int ldn = 0, Kn = 0; CvtItem nx = cur; const bool more = itn < CV_TOTAL;
                if (more) { nx = cvt_item(F, itn, ldn, Kn); cvt_load(nx, ldn, vb, lane); }
                cvt_store(cur, K, va, scr, lane);
                if (!more) break;
                it = itn + NGW; const bool more2 = it < CV_TOTAL; CvtItem n2 = nx; int ld2 = 0, K2 = 0;
                if (more2) { n2 = cvt_item(F, it, ld2, K2); cvt_load(n2, ld2, va, lane); }
                cvt_store(nx, Kn, vb, scr, lane);
                if (!more2) break;
                cur = n2; K = K2;
            }
        }
    }
}
__device__ __forceinline__ void mod_reduce_lds(Frame& F, int j0, int n, LAS float* dst) {
    const float* modp = wsp<float>(F, WS_MODP);
    for (int i = F.tid; i < n; i += NTHR) { const int j = j0 + i; float a = j < 6 * D ? F.in[IN_BADA][j] : F.in[IN_BAF][j - 6 * D];
#pragma unroll
        for (int ks = 0; ks < 32; ++ks) a += modp[ks * 16384 + j];
        dst[i] = a; }
}
__device__ __forceinline__ void modulate_row_bf16(const float* xrow, const float* g, const LAS float* sh, const LAS float* sc, bf16* orow, int lane) {
    const GAS f32x4* xr = (const GAS f32x4*)xrow + lane; f32x4 v[8]; float s2 = 0.f;
#pragma unroll
    for (int j = 0; j < 8; ++j) { v[j] = xr[64 * j]; s2 += (v[j].x * v[j].x + v[j].y * v[j].y) + (v[j].z * v[j].z + v[j].w * v[j].w); }
    const float r = rsqrtf(wave_sum(s2) * (1.f / D) + 1e-6f);
    GAS u32x2* o8 = (GAS u32x2*)orow + lane;
#pragma unroll
    for (int j = 0; j < 8; ++j) { const int c0 = 4 * lane + 256 * j; const f32x4 gg = *(const GAS f32x4*)(g + c0); const f32x4 a = *(const LAS f32x4*)(sc + c0), b = *(const LAS f32x4*)(sh + c0);
        const f32x4 y = v[j] * r * gg * (a + 1.f) + b; u32x2 w; w.x = pk2(y.x, y.y); w.y = pk2(y.z, y.w); o8[64 * j] = w; }
}
typedef float f32x16 __attribute__((ext_vector_type(16)));
typedef short s16x8g __attribute__((ext_vector_type(8)));
__device__ __forceinline__ void p1_modulate(Frame& F, int probe) {
    LAS float* shs = (LAS float*)(F.lds + RING_OFF + 81920);
    LAS float* gred = (LAS float*)(F.lds + RING_OFF + 98304);
    mod_reduce_lds(F, 0, 2 * D, shs);
    if (F.tid < 64) {
        const float* modp = wsp<float>(F, WS_MODP); float* mod = wsp<float>(F, WS_MOD);
        for (int j = blockIdx.x * 64 + F.tid; j < 16384; j += F.G * 64) { float a = j < 6 * D ? F.in[IN_BADA][j] : F.in[IN_BAF][j - 6 * D];
#pragma unroll
            for (int ks = 0; ks < 32; ++ks) a += modp[ks * 16384 + j];
            mod[j] = a; }
    }
    __syncthreads();
    bf16* hn = wsp<bf16>(F, WS_HN); const bf16* wg = wsp<bf16>(F, WS_WIN) + (size_t)NPP * D; float* gates = wsp<float>(F, WS_GATES);
    const int lane = F.lane, w = F.wave, hi = lane >> 5, l31 = lane & 31;
    if (probe != 4) for (int rb = F.vcu; rb < S / 32; rb += F.G) {
        const int row0 = rb * 32;
        {
            f32x4 xv[4][8];
#pragma unroll
            for (int i = 0; i < 4; ++i) { const GAS f32x4* xr = (const GAS f32x4*)(F.in[IN_X] + (size_t)(row0 + 4 * w + i) * D) + lane;
#pragma unroll
                for (int j = 0; j < 8; ++j) xv[i][j] = xr[64 * j]; }
#pragma unroll
            for (int i = 0; i < 4; ++i) { float s2 = 0.f;
#pragma unroll
                for (int j = 0; j < 8; ++j) s2 += (xv[i][j].x * xv[i][j].x + xv[i][j].y * xv[i][j].y) + (xv[i][j].z * xv[i][j].z + xv[i][j].w * xv[i][j].w);
                const float r = rsqrtf(wave_sum(s2) * (1.f / D) + 1e-6f);
                GAS u32x2* o8 = (GAS u32x2*)(hn + (size_t)(row0 + 4 * w + i) * D) + lane;
#pragma unroll
                for (int j = 0; j < 8; ++j) { const int c0 = 4 * lane + 256 * j; const f32x4 gg = *(const GAS f32x4*)(F.in[IN_NMIX] + c0); const f32x4 a = *(const LAS f32x4*)(shs + D + c0), b = *(const LAS f32x4*)(shs + c0);
                    const f32x4 y = xv[i][j] * r * gg * (a + 1.f) + b; u32x2 wv; wv.x = pk2(y.x, y.y); wv.y = pk2(y.z, y.w); o8[64 * j] = wv; } }
        }
        asm volatile("s_waitcnt vmcnt(0)" ::: "memory");
        __syncthreads();
        f32x16 acc;
#pragma unroll
        for (int r = 0; r < 16; ++r) acc[r] = 0.f;
        const bf16* ap = hn + (size_t)(row0 + l31) * D + 256 * w + 8 * hi; const bf16* bp = wg + (size_t)l31 * D + 256 * w + 8 * hi;
#pragma unroll
        for (int ks = 0; ks < 16; ++ks) { const s16x8g a = *(const GAS s16x8g*)(ap + 16 * ks), b = *(const GAS s16x8g*)(bp + 16 * ks); acc = __builtin_amdgcn_mfma_f32_32x32x16_bf16(a, b, acc, 0, 0, 0); }
        if (l31 < 16) {
#pragma unroll
            for (int r = 0; r < 16; ++r) gred[(w * 32 + (r & 3) + 8 * (r >> 2) + 4 * hi) * 16 + l31] = acc[r]; }
        __syncthreads();
        { const int row = F.tid >> 4, n = F.tid & 15; float s = 0.f;
#pragma unroll
            for (int q = 0; q < 8; ++q) s += gred[(q * 32 + row) * 16 + n];
            gates[(size_t)(row0 + row) * 16 + n] = s; }
        __syncthreads();
    }
    (void)probe;
}
using pg8::Unit; using pg8::cvt_pk_bf16;
struct EpiProj {
    static constexpr bool PERM = true, AFTER_DRAIN = false;
    bf16* O; PG8_LAS float* P; const float* gq; const float* gk;
    __device__ __forceinline__ void operator()(const pg8::f32x4 (&acc)[2][2][4][2], const Unit& u, int wr, int wc, int fr, int fq) const {
        const int row0 = u.pm * 256 + wr * 64 + fr, col0 = u.pn * 256 + wc * 32 + 8 * fq;
        if (u.pn >= 12 && u.pn < 20) {
            const float* gp = (u.pn < 16 ? gq : gk) + wc * 32 + 8 * fq; const pg8::f32x4 g0 = *(const pg8::f32x4*)gp, g1 = *(const pg8::f32x4*)(gp + 4);
#pragma unroll
            for (int ai = 0; ai < 2; ++ai)
#pragma unroll
                for (int m = 0; m < 4; ++m)
#pragma unroll
                    for (int bj = 0; bj < 2; ++bj) { const pg8::f32x4 v0 = acc[ai][bj][m][0], v1 = acc[ai][bj][m][1];
                        float s = (v0[0] * v0[0] + v0[1] * v0[1]) + (v0[2] * v0[2] + v0[3] * v0[3]) + (v1[0] * v1[0] + v1[1] * v1[1]) + (v1[2] * v1[2] + v1[3] * v1[3]);
                        s += __shfl_xor(s, 16); s += __shfl_xor(s, 32);
                        if (fq == 0) P[((ai * 128 + wr * 64 + m * 16 + fr) * 2 + bj) * 4 + wc] = s; }
            asm volatile("s_waitcnt lgkmcnt(0)" ::: "memory"); __builtin_amdgcn_s_barrier(); asm volatile("" ::: "memory");
#pragma unroll
            for (int ai = 0; ai < 2; ++ai)
#pragma unroll
                for (int m = 0; m < 4; ++m) { bf16* rowp = O + (size_t)(row0 + ai * 128 + m * 16) * NPP + col0;
#pragma unroll
                    for (int bj = 0; bj < 2; ++bj) { const pg8::f32x4 p4 = *(const PG8_LAS pg8::f32x4*)(P + ((ai * 128 + wr * 64 + m * 16 + fr) * 2 + bj) * 4);
                        const float r = rsqrtf(((p4[0] + p4[1]) + (p4[2] + p4[3])) * (1.f / 128.f) + 1e-6f);
                        const pg8::f32x4 v0 = acc[ai][bj][m][0] * r * g0, v1 = acc[ai][bj][m][1] * r * g1;
                        pg8::u32x4 w; w.x = cvt_pk_bf16(v0[0], v0[1]); w.y = cvt_pk_bf16(v0[2], v0[3]); w.z = cvt_pk_bf16(v1[0], v1[1]); w.w = cvt_pk_bf16(v1[2], v1[3]);
                        *(pg8::u32x4*)(rowp + bj * 128) = w; } }
            return;
        }
#pragma unroll
        for (int ai = 0; ai < 2; ++ai)
#pragma unroll
            for (int m = 0; m < 4; ++m) { bf16* rowp = O + (size_t)(row0 + ai * 128 + m * 16) * NPP + col0;
#pragma unroll
                for (int bj = 0; bj < 2; ++bj) { const pg8::f32x4 v0 = acc[ai][bj][m][0], v1 = acc[ai][bj][m][1];
                    pg8::u32x4 w; w.x = cvt_pk_bf16(v0[0], v0[1]); w.y = cvt_pk_bf16(v0[2], v0[3]); w.z = cvt_pk_bf16(v1[0], v1[1]); w.w = cvt_pk_bf16(v1[2], v1[3]);
                    *(pg8::u32x4*)(rowp + bj * 128) = w; } }
    }
};
struct EpiOut {
    static constexpr bool PERM = false, AFTER_DRAIN = false;
    const float* x; const float* g1; float* h1;
    __device__ __forceinline__ void operator()(const pg8::f32x4 (&acc)[2][2][4][2], const Unit& u, int wr, int wc, int fr, int fq) const {
        const int row0 = u.pm * 256 + wr * 64 + fr, col0 = u.pn * 256 + wc * 32 + 4 * fq;
        pg8::f32x4 gv[2][2];
#pragma unroll
        for (int bj = 0; bj < 2; ++bj)
#pragma unroll
            for (int n = 0; n < 2; ++n) gv[bj][n] = *(const pg8::f32x4*)(g1 + col0 + bj * 128 + n * 16);
#pragma unroll
        for (int ai = 0; ai < 2; ++ai)
#pragma unroll
            for (int m = 0; m < 4; ++m) { const size_t off = (size_t)(row0 + ai * 128 + m * 16) * D + col0;
#pragma unroll
                for (int bj = 0; bj < 2; ++bj)
#pragma unroll
                    for (int n = 0; n < 2; ++n) { const pg8::f32x4 xv = *(const pg8::f32x4*)(x + off + bj * 128 + n * 16);
                        *(pg8::f32x4*)(h1 + off + bj * 128 + n * 16) = xv + gv[bj][n] * acc[ai][bj][m][n]; } }
    }
};
}
namespace fox {
constexpr int D = 128, SQ = 8192, SKV = 8192; constexpr float THR = 8.f; constexpr bool WSKIP = false;
constexpr int PITCH = 6144;
constexpr int OPITCH = 2048;
constexpr float SCALE = 0.08838834764831845f;
constexpr int NW = 8, QBLK = 32, KVBLK = 64, QB = NW * QBLK;
constexpr int SHM_V = KVBLK * D * 2, SHM_K = KVBLK * D * 2;
constexpr int LDS_BIAS = 2 * SHM_V + 2 * SHM_K + NW * 64 * 4;
constexpr int LDS_BYTES = LDS_BIAS + 512;

using bf16 = __hip_bfloat16;
typedef short bf16x8 __attribute__((ext_vector_type(8)));
typedef short s16x4 __attribute__((ext_vector_type(4)));
typedef float f32x16 __attribute__((ext_vector_type(16)));
typedef float f32x4 __attribute__((ext_vector_type(4)));
typedef unsigned u32x4 __attribute__((ext_vector_type(4)));
template <class A, class Bt> struct same_t { static constexpr bool v = false; };
template <class A> struct same_t<A, A> { static constexpr bool v = true; };

#define KSWZ(row, colB) ((row) * 256 + ((colB) ^ (((row) & 7) << 4)))
#define SBAR() __builtin_amdgcn_sched_barrier(0)
__device__ __forceinline__ int v_st(int k, int c) { const int kk = (k & ~0xC) | ((k & 4) << 1) | ((k & 8) >> 1); return ((kk >> 3) * 4 + (c >> 5)) * 512 + ((kk & 7) * 32 + (c & 31)) * 2; }
__device__ __forceinline__ int v_rd_base(int lane) { return ((lane & 3) << 3) | (((lane >> 2) & 3) << 6) | (((lane >> 4) & 1) << 5) | (((lane >> 5) & 1) << 8); }
constexpr int v_rd_off(int d0, int ks, int half) { return d0 * 512 + ks * 4096 + half * 2048; }
__device__ __forceinline__ int crow(int r, int hi) { return (r & 3) + 8 * (r >> 2) + 4 * hi; }
__device__ __forceinline__ int bias_slot(int kk) { return ((kk >> 2) & 1) * 32 + (kk >> 5) * 16 + (kk & 3) + 4 * ((kk & 31) >> 3); }
__device__ __forceinline__ unsigned cvtpk(float lo, float hi) {
    unsigned r; asm volatile("v_cvt_pk_bf16_f32 %0, %1, %2" : "=v"(r) : "v"(lo), "v"(hi)); return r;
}
__device__ __forceinline__ bf16x8 pack8(f32x4 a, f32x4 b) {
    u32x4 w = {cvtpk(a[0], a[1]), cvtpk(a[2], a[3]), cvtpk(b[0], b[1]), cvtpk(b[2], b[3])};
    return *reinterpret_cast<bf16x8*>(&w);
}
template <class T> __device__ __forceinline__ bf16x8 load8(const T* p) {
    if constexpr (same_t<T, float>::v) { return pack8(*(const f32x4*)p, *(const f32x4*)(p + 4)); }
    else { return *reinterpret_cast<const bf16x8*>(p); }
}
__device__ __forceinline__ void mask_tile(f32x16& p0, f32x16& p1, int dq, unsigned W) {
    const float NEG = -__builtin_inff();
#pragma unroll
    for (int r = 0; r < 16; ++r) {
        const int c = (r & 3) + 8 * (r >> 2);
        if ((unsigned)(dq - c) >= W) p0[r] = NEG;
        if ((unsigned)(dq - c - 32) >= W) p1[r] = NEG;
    }
}
__device__ __forceinline__ void partialSM(f32x16& p0, f32x16& p1, float& m_reg, float& mn, float& alpha) {
    float pmax = p0[0]; for (int r = 1; r < 16; ++r) pmax = fmaxf(pmax, p0[r]); for (int r = 0; r < 16; ++r) pmax = fmaxf(pmax, p1[r]);
    { auto rr = __builtin_amdgcn_permlane32_swap(__float_as_uint(pmax), __float_as_uint(pmax), false, false);
      pmax = fmaxf(__uint_as_float(rr[0]), __uint_as_float(rr[1])); }
    constexpr float C2 = 1.4426950408889634f * SCALE;
    if (__builtin_expect(__all((pmax - m_reg) * SCALE <= THR), 1)) { mn = m_reg; alpha = 1.f; }
    else { mn = fmaxf(m_reg, pmax); alpha = __builtin_amdgcn_exp2f((m_reg - mn) * C2); m_reg = mn; }
    const float mnL = -mn * C2;
    for (int r = 0; r < 16; ++r) p0[r] = fmaf(p0[r], C2, mnL); for (int r = 0; r < 16; ++r) p1[r] = fmaf(p1[r], C2, mnL);
    for (int r = 0; r < 16; ++r) p0[r] = __builtin_amdgcn_exp2f(p0[r]);
}
__device__ __forceinline__ void finishSM(f32x16& p0, f32x16& p1, float alpha, float& l_reg, bf16x8& pa0, bf16x8& pa1, bf16x8& pa2, bf16x8& pa3) {
    for (int r = 0; r < 16; ++r) p1[r] = __builtin_amdgcn_exp2f(p1[r]);
    float ps = 0; for (int r = 0; r < 16; ++r) ps += p0[r]; for (int r = 0; r < 16; ++r) ps += p1[r];
    { auto rr = __builtin_amdgcn_permlane32_swap(__float_as_uint(ps), __float_as_uint(ps), false, false);
      ps = __uint_as_float(rr[0]) + __uint_as_float(rr[1]); }
    l_reg = l_reg * alpha + ps;
#define PK4(P, B_, OUT) do { unsigned a0 = cvtpk(P[B_+0], P[B_+1]), a1 = cvtpk(P[B_+2], P[B_+3]);                          \
        unsigned b0 = cvtpk(P[B_+4], P[B_+5]), b1 = cvtpk(P[B_+6], P[B_+7]);                                             \
        auto r0 = __builtin_amdgcn_permlane32_swap(a0, b0, false, false); auto r1 = __builtin_amdgcn_permlane32_swap(a1, b1, false, false); \
        u32x4 w = {r0[0], r1[0], r0[1], r1[1]}; OUT = *reinterpret_cast<bf16x8*>(&w); } while (0)
    PK4(p0, 0, pa0); PK4(p0, 8, pa1); PK4(p1, 0, pa2); PK4(p1, 8, pa3);
#undef PK4
}
template <int KB, bool SK>
__device__ __forceinline__ void qkt(f32x16& p0, f32x16& p1, const char* K_lds, int r32, int hi, const bf16x8* qr, bool act) {
    if (SK && !act) { const float NEG = -__builtin_inff();
#pragma unroll
        for (int r = 0; r < 16; ++r) { p0[r] = NEG; p1[r] = NEG; } return; }
    { const f32x16* bp = reinterpret_cast<const f32x16*>(K_lds - 2 * SHM_V + LDS_BIAS + KB * 256 + hi * 128); p0 = bp[0]; p1 = bp[1]; }
    const char* kb[4];
#pragma unroll
    for (int dd = 0; dd < 4; ++dd) kb[dd] = K_lds + KB * SHM_K + KSWZ(r32, (dd * 16 + hi * 8) * 2);
#pragma unroll
    for (int d0 = 0; d0 < 8; ++d0) { const char* a = kb[d0 & 3] + (d0 >> 2) * 128;
        bf16x8 b0 = *reinterpret_cast<const bf16x8*>(a);
        bf16x8 b1 = *reinterpret_cast<const bf16x8*>(a + 32 * 256);
        p0 = __builtin_amdgcn_mfma_f32_32x32x16_bf16(b0, qr[d0], p0, 0, 0, 0);
        p1 = __builtin_amdgcn_mfma_f32_32x32x16_bf16(b1, qr[d0], p1, 0, 0, 0); }
}
template <int VB, bool SK>
__device__ __forceinline__ void pv_tile(f32x16* o, int vb0, bf16x8 pa0, bf16x8 pa1, bf16x8 pa2, bf16x8 pa3, bool act) {
    if (SK && !act) return;
#define TRRD(dst, off) asm volatile("ds_read_b64_tr_b16 %0, %1 offset:%2" : "=&v"(dst) : "v"(vb0), "i"(off) : "memory")
#define PV_D0(d0) do { s16x4 l0, l1, l2, l3, h0, h1, h2, h3; constexpr int b_ = VB * SHM_V + v_rd_off(d0, 0, 0);     \
        TRRD(l0, b_); TRRD(h0, b_ + 2048); TRRD(l1, b_ + 4096); TRRD(h1, b_ + 6144); TRRD(l2, b_ + 8192); TRRD(h2, b_ + 10240); TRRD(l3, b_ + 12288); TRRD(h3, b_ + 14336); \
        asm volatile("s_waitcnt lgkmcnt(0)" ::: "memory"); SBAR();                 \
        o[d0] = __builtin_amdgcn_mfma_f32_32x32x16_bf16(pa0, (bf16x8){l0[0], l0[1], l0[2], l0[3], h0[0], h0[1], h0[2], h0[3]}, o[d0], 0, 0, 0);   \
        o[d0] = __builtin_amdgcn_mfma_f32_32x32x16_bf16(pa1, (bf16x8){l1[0], l1[1], l1[2], l1[3], h1[0], h1[1], h1[2], h1[3]}, o[d0], 0, 0, 0);   \
        o[d0] = __builtin_amdgcn_mfma_f32_32x32x16_bf16(pa2, (bf16x8){l2[0], l2[1], l2[2], l2[3], h2[0], h2[1], h2[2], h2[3]}, o[d0], 0, 0, 0);   \
        o[d0] = __builtin_amdgcn_mfma_f32_32x32x16_bf16(pa3, (bf16x8){l3[0], l3[1], l3[2], l3[3], h3[0], h3[1], h3[2], h3[3]}, o[d0], 0, 0, 0); } while (0)
    PV_D0(0); PV_D0(1); PV_D0(2); PV_D0(3);
#undef PV_D0
#undef TRRD
}

template <class TIn, class TOut> struct BlockRef { const TIn* Q; const TIn* K; const TIn* V; TOut* O; int P0; const float* Fb; const float* gain;
    int jlo, jhi;
    float* Op; float* ML; };
template <class TIn> struct Seam {
    bf16x8 qr[8];
    bf16x8 st_v0, st_v1, st_k0, st_k1; f32x4 sf0, sf1, sf2, sf3; float st_b;
    f32x4 tq[16];
};
__device__ __forceinline__ int swa_jlo(int P0, int W) { const int lowk = P0 - W + 1; return lowk > 0 ? lowk / KVBLK : 0; }
#define ROW(p, k0, rr) ((p) + (size_t)((k0) + (rr)) * PITCH + sc)
#define VMW() asm volatile("s_waitcnt vmcnt(0)" ::: "memory")
#define VMWN(n) asm volatile("s_waitcnt vmcnt(%0)" :: "i"(n) : "memory")
#define SLOAD_H(Kp, Vp, k0) SLOAD_HB(Kp, Vp, k0, cur)
#define SLOAD_HB(Kp, Vp, k0, blk) do { S.st_v0 = load8<TIn>(ROW(Vp, k0, sr)); S.st_v1 = load8<TIn>(ROW(Vp, k0, 32 + sr));              \
                         S.st_k0 = load8<TIn>(ROW(Kp, k0, sr)); S.st_k1 = load8<TIn>(ROW(Kp, k0, 32 + sr)); \
                         if (tid < 64) S.st_b = ((blk).Fb[(blk).P0] - (blk).Fb[(k0) + tid]) * (1.0f / SCALE); } while (0)
#define SWRITE_HK(bf) do { *(bf16x8*)(K_lds + (bf) * SHM_K + kws) = S.st_k0; *(bf16x8*)(K_lds + (bf) * SHM_K + kws + 32 * 256) = S.st_k1; \
                         if (tid < 64) *(float*)(K_lds - 2 * SHM_V + LDS_BIAS + (bf) * 256 + bws) = S.st_b; } while (0)
#define SWRITE_HV(bf) do { *(bf16x8*)(V_lds + (bf) * SHM_V + vst0) = S.st_v0; *(bf16x8*)(V_lds + (bf) * SHM_V + vst1) = S.st_v1; } while (0)
#define SWRITE_H(bf) do { SWRITE_HV(bf); SWRITE_HK(bf); } while (0)
#define SLOAD_F(p, k0) do { S.sf0 = *(const f32x4*)ROW(p, k0, sr); S.sf1 = *(const f32x4*)(ROW(p, k0, sr) + 4);                \
                            S.sf2 = *(const f32x4*)ROW(p, k0, 32 + sr); S.sf3 = *(const f32x4*)(ROW(p, k0, 32 + sr) + 4); } while (0)
#define SWRITE_KF(bf) do { *(bf16x8*)(K_lds + (bf) * SHM_K + kws) = pack8(S.sf0, S.sf1); *(bf16x8*)(K_lds + (bf) * SHM_K + kws + 32 * 256) = pack8(S.sf2, S.sf3); } while (0)
#define SWRITE_VF(bf) do { *(bf16x8*)(V_lds + (bf) * SHM_V + vst0) = pack8(S.sf0, S.sf1); *(bf16x8*)(V_lds + (bf) * SHM_V + vst1) = pack8(S.sf2, S.sf3); } while (0)
template <class TIn, class TOut>
__device__ __forceinline__ void causal_swa_prime(const BlockRef<TIn, TOut>& cur, int W, char* lds, Seam<TIn>& S) {
    constexpr bool F32 = same_t<TIn, float>::v;
    const int tid = threadIdx.x, wid = __builtin_amdgcn_readfirstlane(tid >> 6), lane = tid & 63, r32 = lane & 31, hi = lane >> 5;
    const int sr = tid >> 4, sc = (tid & 15) * 8, kws = KSWZ(sr, sc * 2); char* K_lds = lds + 2 * SHM_V;
    const int bws = bias_slot(tid & 63) * 4;
    const int kb0 = cur.jlo * KVBLK;
    for (int d0 = 0; d0 < 8; ++d0) S.qr[d0] = load8<TIn>(cur.Q + (size_t)(wid * QBLK + r32) * PITCH + d0 * 16 + hi * 8);
    if constexpr (F32) { SLOAD_F((const float*)cur.K, kb0); VMW(); SWRITE_KF(0); SBAR(); SLOAD_F((const float*)cur.V, kb0); }
    else { SLOAD_H(cur.K, cur.V, kb0); VMW(); SWRITE_HK(0); }
    __syncthreads();
}
template <class TIn, class TOut>
__device__ __forceinline__ void causal_swa_block(const BlockRef<TIn, TOut>& cur, const BlockRef<TIn, TOut>& nxt, int skv, int W, char* lds, Seam<TIn>& S) {
    constexpr bool F32 = same_t<TIn, float>::v;
    const int tid = threadIdx.x, wid = __builtin_amdgcn_readfirstlane(tid >> 6), lane = tid & 63, r32 = lane & 31, hi = lane >> 5;
    const int j_lo = cur.jlo; const int j_hi = cur.jhi;
    const int NT = j_hi - j_lo;
    const int kbn = nxt.jlo * KVBLK;
    const int qlo = cur.P0 + wid * QBLK, qm = qlo + r32 - 4 * hi;
    char* V_lds = lds; char* K_lds = lds + 2 * SHM_V;
    float* ws = (float*)(lds + 2 * SHM_V + 2 * SHM_K) + wid * 64; float* li_l = ws, * al_l = ws + 32;
    float m_reg = -1e30f, l_reg = 0; f32x16 o[4] = {};
    const int sr = tid >> 4, sc = (tid & 15) * 8, vst0 = v_st(sr, sc), vst1 = v_st(32 + sr, sc), kws = KSWZ(sr, sc * 2);
    const int bws = bias_slot(tid & 63) * 4;
    const int vb0 = (int)(uintptr_t)V_lds + v_rd_base(lane);
    const TIn* Kh = cur.K; const TIn* Vh = cur.V;
#define RESC(a) do { if (__any((a) < 1.f)) { if (hi == 0) al_l[r32] = (a); asm volatile("s_waitcnt lgkmcnt(0)" ::: "memory");              \
                     for (int d_ = 0; d_ < 4; ++d_) for (int r = 0; r < 16; ++r) o[d_][r] *= al_l[crow(r, hi)]; } } while (0)
#define KBASE(t) ((j_lo + (t)) * KVBLK)
#define ACT(t) (KBASE(t) <= qlo + QBLK - 1 && KBASE(t) + KVBLK - 1 >= qlo - W + 1)
#define MASKT(P0_, P1_, t) do { const int kb_ = KBASE(t); if ((!SK || ACT(t)) && (kb_ + KVBLK - 1 > qlo || kb_ <= qlo + QBLK - 1 - W)) mask_tile(P0_, P1_, qm - kb_, (unsigned)W); } while (0)
    constexpr int NQL = F32 ? 16 : 8;
    constexpr bool SK = WSKIP && !F32;
#define SEAM_K0() do { VMWN(NQL); if constexpr (F32) { SWRITE_KF(0); SBAR(); SLOAD_F((const float*)nxt.V, kbn); } else { SWRITE_HK(0); } SBAR(); } while (0)
    f32x16 pA0, pA1, pB0, pB1; float mnA, mnB, alA, alB; bf16x8 pa0, pa1, pa2, pa3;
    if constexpr (F32) { VMW(); SWRITE_VF(0); SBAR(); } else { SWRITE_HV(0); SBAR(); }
    if (NT > 1) { if constexpr (F32) SLOAD_F((const float*)Kh, KBASE(1)); else SLOAD_H(Kh, Vh, KBASE(1)); }
    SBAR(); qkt<0, SK>(pA0, pA1, K_lds, r32, hi, S.qr, ACT(0));
    if constexpr (F32) { if (NT > 1) { VMW(); SWRITE_KF(1); SBAR(); SLOAD_F((const float*)Vh, KBASE(1)); } }
    MASKT(pA0, pA1, 0); partialSM(pA0, pA1, m_reg, mnA, alA);
    if (NT > 1) { VMW(); if constexpr (F32) { SWRITE_VF(1); SBAR(); if (NT > 2) SLOAD_F((const float*)Kh, KBASE(2)); } else SWRITE_H(1); }
    __syncthreads();
#define HALF_STEP(PX0, PX1, mnX, alX, PY0, PY1, alY, t, KB, VB, SB) do {                                                      \
        SBAR(); qkt<KB, SK>(PX0, PX1, K_lds, r32, hi, S.qr, ACT(t));                                             \
        finishSM(PY0, PY1, alY, l_reg, pa0, pa1, pa2, pa3); SBAR();                                                           \
        if ((t) + 1 < NT) { if constexpr (F32) { VMW(); SWRITE_KF(SB); SBAR(); SLOAD_F((const float*)Vh, KBASE((t) + 1)); }  \
                            else { SLOAD_H(Kh, Vh, KBASE((t) + 1)); } SBAR(); }                                               \
        pv_tile<VB, SK>(o, vb0, pa0, pa1, pa2, pa3, ACT((t) - 1)); MASKT(PX0, PX1, (t)); partialSM(PX0, PX1, m_reg, mnX, alX);                                        \
        __syncthreads();                                                                                                      \
        if ((t) + 1 < NT) { VMW(); if constexpr (F32) { SWRITE_VF(SB); SBAR(); if ((t) + 2 < NT) SLOAD_F((const float*)Kh, KBASE((t) + 2)); } \
                            else { SWRITE_H(SB); } }                                                                          \
        RESC(alX); __syncthreads(); } while (0)
    for (int t = 1; t + 1 < NT; t += 2) {
        HALF_STEP(pB0, pB1, mnB, alB, pA0, pA1, alA, t, 1, 0, 0);
        HALF_STEP(pA0, pA1, mnA, alA, pB0, pB1, alB, t + 1, 0, 1, 1);
    }
    const bool even = (NT & 1) == 0;
    if (even) { SBAR(); qkt<1, SK>(pB0, pB1, K_lds, r32, hi, S.qr, ACT(NT - 1)); SBAR(); }
#define QROW(e) (nxt.Q + (size_t)(wid * QBLK + r32) * PITCH + ((e) >> 1) * 16 + hi * 8 + ((e) & 1) * 4)
    if constexpr (F32) { SLOAD_F((const float*)nxt.K, kbn); SBAR();
#pragma unroll
        for (int e = 0; e < 8; ++e) S.tq[e] = *(const f32x4*)QROW(e); }
    else { SLOAD_HB(nxt.K, nxt.V, kbn, nxt); SBAR();
#pragma unroll
        for (int d0 = 0; d0 < 8; ++d0) S.qr[d0] = load8<TIn>(nxt.Q + (size_t)(wid * QBLK + r32) * PITCH + d0 * 16 + hi * 8); }
    SBAR();
    finishSM(pA0, pA1, alA, l_reg, pa0, pa1, pa2, pa3); SBAR();
    if constexpr (F32) {
#pragma unroll
        for (int e = 8; e < 16; ++e) S.tq[e] = *(const f32x4*)QROW(e); SBAR(); }
#undef QROW
    pv_tile<0, SK>(o, vb0, pa0, pa1, pa2, pa3, ACT(even ? NT - 2 : NT - 1));
    if (even) { MASKT(pB0, pB1, NT - 1); partialSM(pB0, pB1, m_reg, mnB, alB); __syncthreads(); RESC(alB);
        finishSM(pB0, pB1, alB, l_reg, pa0, pa1, pa2, pa3); SBAR(); pv_tile<1, SK>(o, vb0, pa0, pa1, pa2, pa3, ACT(NT - 1)); }
    SBAR(); SEAM_K0();
    if (hi == 0) li_l[r32] = l_reg; asm volatile("s_waitcnt lgkmcnt(0)" ::: "memory");
    if (cur.Op != nullptr) {
        int rp = r32; asm volatile("" : "+v"(rp));
        if (hi == 0) { float2 mlv; mlv.x = m_reg; mlv.y = l_reg; *(float2*)(cur.ML + 2 * (wid * QBLK + rp)) = mlv; }
        float* Pr = cur.Op + (size_t)(wid * QBLK + 4 * hi) * D + rp;
#pragma unroll
        for (int r = 0; r < 16; ++r) {
#pragma unroll
            for (int d0 = 0; d0 < 4; ++d0) Pr[d0 * 32] = o[d0][r];
            Pr += ((r & 3) == 3 ? 5 : 1) * D; asm volatile("" : "+v"(Pr) :: "memory"); }
    } else {
    int ro = r32; asm volatile("" : "+v"(ro));
    TOut* Or = cur.O + (size_t)(wid * QBLK + 4 * hi) * OPITCH + ro;
    float gn[4];
#pragma unroll
    for (int d0 = 0; d0 < 4; ++d0) gn[d0] = cur.gain[d0 * 32 + ro];
#pragma unroll
    for (int r = 0; r < 16; ++r) { const int orow = crow(r, hi); const float rl = __builtin_amdgcn_rcpf(li_l[orow]);
        float v[4]; float ss = 0.f;
#pragma unroll
        for (int d0 = 0; d0 < 4; ++d0) { v[d0] = o[d0][r] * rl; ss += v[d0] * v[d0]; }
        ss += __shfl_xor(ss, 1); ss += __shfl_xor(ss, 2); ss += __shfl_xor(ss, 4); ss += __shfl_xor(ss, 8); ss += __shfl_xor(ss, 16);
        const float rn = __builtin_amdgcn_rsqf(ss * (1.0f / 128.0f) + 1e-6f);
#pragma unroll
        for (int d0 = 0; d0 < 4; ++d0) { const float vv = v[d0] * rn * gn[d0]; const float vn = __shfl_xor(vv, 1);
            if ((ro & 1) == 0) *(unsigned*)(Or + d0 * 32) = cvtpk(vv, vn); }
        Or += ((r & 3) == 3 ? 5 : 1) * OPITCH; asm volatile("" : "+v"(Or) :: "memory"); }
    }
    if constexpr (F32) {
#pragma unroll
        for (int d0 = 0; d0 < 8; ++d0) S.qr[d0] = pack8(S.tq[2 * d0], S.tq[2 * d0 + 1]); }
    __syncthreads();
#undef RESC
#undef KBASE
#undef ACT
#undef MASKT
#undef SEAM_K0
#undef HALF_STEP
}
#undef ROW
#undef VMW
#undef VMWN
#undef SLOAD_H
#undef SWRITE_HK
#undef SWRITE_HV
#undef SWRITE_H
#undef SLOAD_F
#undef SWRITE_KF
#undef SWRITE_VF

}
namespace mk {
typedef short s16x8 __attribute__((ext_vector_type(8)));
#define MFMA32(a, b, c) __builtin_amdgcn_mfma_f32_32x32x16_bf16((a), (b), (c), 0, 0, 0)
__device__ __forceinline__ int crow32(int r, int hi) { return (r & 3) + 8 * (r >> 2) + 4 * hi; }
constexpr float SCALEQ = 0.08838834764831845f;
__device__ __forceinline__ float wave_scan_add(float v, int lane) {
#pragma unroll
    for (int o = 1; o < 64; o <<= 1) { const float t = __shfl_up(v, o); if (lane >= o) v += t; }
    return v;
}
__device__ __forceinline__ float wave_scan_max(float v, int lane) {
#pragma unroll
    for (int o = 1; o < 64; o <<= 1) { const float t = __shfl_up(v, o); if (lane >= o) v = fmaxf(v, t); }
    return v;
}
__device__ __forceinline__ float wave_max(float v) {
#pragma unroll
    for (int o = 1; o < 64; o <<= 1) v = fmaxf(v, __shfl_xor(v, o));
    return v;
}
constexpr int TSTR = 72;
#define TSW(col, ks, hi) ((col) * TSTR + ((((2 * (ks) + (hi)) ^ ((col) >> 3)) & 7) << 3))
template <bool SCALED>
__device__ __forceinline__ void stage_transposed(const bf16* src, int ncols, LAS bf16* T, const LAS float* wl, int tid) {
    const int cpr = ncols / 8;
    for (int q = tid; q < 32 * cpr; q += NTHR) { const int s = 2 * (q / cpr), c8 = (q % cpr) * 8;
        const v4u r0 = *(const GAS v4u*)(src + (size_t)s * NPP + c8), r1 = *(const GAS v4u*)(src + (size_t)(s + 1) * NPP + c8);
        const unsigned a4[4] = {r0.x, r0.y, r0.z, r0.w}, b4[4] = {r1.x, r1.y, r1.z, r1.w};
        const int sw = ((((s >> 3) ^ (c8 >> 3)) & 7) << 3) + (s & 7);
#pragma unroll
        for (int j = 0; j < 4; ++j) { unsigned lo0 = a4[j] & 0xffffu, hi0 = a4[j] >> 16, lo1 = b4[j] & 0xffffu, hi1 = b4[j] >> 16;
            if (SCALED) { const float s0 = wl[s], s1 = wl[s + 1]; lo0 = f2bf(bf2f((unsigned short)lo0) * s0); hi0 = f2bf(bf2f((unsigned short)hi0) * s0); lo1 = f2bf(bf2f((unsigned short)lo1) * s1); hi1 = f2bf(bf2f((unsigned short)hi1) * s1); }
            *(LAS unsigned*)(T + (c8 + 2 * j) * TSTR + sw) = lo0 | (lo1 << 16); *(LAS unsigned*)(T + (c8 + 2 * j + 1) * TSTR + sw) = hi0 | (hi1 << 16); } }
}
__device__ __forceinline__ void p_fscan(Frame& F, int h) {
    const int tid = F.tid, lane = F.lane; const float* gates = wsp<float>(F, WS_GATES);
        const float b = F.in[IN_FOXBF][h]; float* Fo = wsp<float>(F, WS_F) + h * S;
        LAS double* tot = (LAS double*)(F.lds + RING_OFF);
        double loc[16]; double acc = 0.0;
#pragma unroll
        for (int i = 0; i < 16; ++i) { acc += (double)log_sigmoid_f(gates[(size_t)(tid * 16 + i) * 16 + 8 + h] + b); loc[i] = acc; }
        tot[tid] = acc;
        __syncthreads();
        if (F.wave == 0) { double v[8]; double s = 0.0;
#pragma unroll
            for (int i = 0; i < 8; ++i) { v[i] = tot[lane * 8 + i]; s += v[i]; }
            double inc = s;
#pragma unroll
            for (int o = 1; o < 64; o <<= 1) { const double t = __shfl_up(inc, o); if (lane >= o) inc += t; }
            double ex = inc - s;
#pragma unroll
            for (int i = 0; i < 8; ++i) { tot[lane * 8 + i] = ex; ex += v[i]; } }
        __syncthreads();
        const double off = tot[tid];
        LAS float* Fl = (LAS float*)(F.lds + RING_OFF + 8192);
#pragma unroll
        for (int i = 0; i < 16; ++i) { const float fv = (float)(off + loc[i]); Fo[tid * 16 + i] = fv; Fl[tid * 16 + i] = fv; }
        __syncthreads();
        if (tid < 32) {
            float gq = 0.f, gk = 0.f;
#pragma unroll
            for (int j = 0; j < 4; ++j) { gq = fmaxf(gq, fabsf(F.in[IN_FOXQN][tid + 32 * j])); gk = fmaxf(gk, fabsf(F.in[IN_FOXKN][tid + 32 * j])); }
#pragma unroll
            for (int o = 1; o < 32; o <<= 1) { gq = fmaxf(gq, __shfl_xor(gq, o)); gk = fmaxf(gk, __shfl_xor(gk, o)); }
            const float thr = 2.f * 11.3137085f * gq * gk + 26.f;
            const int qb = tid, P0 = qb * 256; const float f0 = Fl[P0];
            int lo = 0, hi2 = 4 * qb;
            while (lo < hi2) { const int mid = (lo + hi2) >> 1; if (Fl[64 * mid + 63] - f0 <= thr) hi2 = mid; else lo = mid + 1; }
            wsp<int>(F, WS_JLO)[h * 32 + qb] = lo;
        }
        __syncthreads();
}
__device__ __forceinline__ void p3_prep(Frame& F) {
    const int gw = F.vcu * NWAVES + F.wave, NGW = F.G * NWAVES, lane = F.lane, tid = F.tid;
    bf16* proj = wsp<bf16>(F, WS_PROJ); const float* gates = wsp<float>(F, WS_GATES);
    if (F.G != 256 && blockIdx.x < 8) p_fscan(F, (int)blockIdx.x);
    {
        LAS bf16* KT = (LAS bf16*)(F.lds + RING_OFF);
        LAS bf16* VT = KT + 128 * TSTR;
        LAS float* wl = (LAS float*)(VT + 256 * TSTR);
        float* UL = wsp<float>(F, WS_UL); float* NL = wsp<float>(F, WS_NL); float* GLAL = wsp<float>(F, WS_GLAL);
        const int hi = lane >> 5, l31 = lane & 31, w = F.wave;
        for (int u = F.vcu; u < 4 * NCH; u += F.G) {
            const int h = u >> 7, ch = u & 127, t0 = ch * LCH;
            if (w == 0) {
                const float ip = softcap_f(gates[(size_t)(t0 + lane) * 16 + h] + F.in[IN_BI][h]);
                const float fp = softcap_f(gates[(size_t)(t0 + lane) * 16 + 4 + h] + F.in[IN_BF][h]);
                const float g = wave_scan_add(log_sigmoid_f(fp), lane), a = ip - g, amax = wave_max(a);
                wl[lane] = __expf(a - amax);
                if (lane == 63) { GLAL[u * 2] = g; GLAL[u * 2 + 1] = amax; }
            }
            __syncthreads();
            stage_transposed<true>(proj + (size_t)t0 * NPP + C_MK + h * 128, 128, KT, wl, tid);
            stage_transposed<false>(proj + (size_t)t0 * NPP + C_MV + h * 256, 256, VT, wl, tid);
            __syncthreads();
            f32x16 acc[4];
#pragma unroll
            for (int dt = 0; dt < 4; ++dt)
#pragma unroll
                for (int r = 0; r < 16; ++r) acc[dt][r] = 0.f;
#pragma unroll
            for (int ks = 0; ks < 4; ++ks) { const s16x8 a = *(const LAS s16x8*)(VT + TSW(32 * w + l31, ks, hi));
#pragma unroll
                for (int dt = 0; dt < 4; ++dt) { const s16x8 b = *(const LAS s16x8*)(KT + TSW(32 * dt + l31, ks, hi)); acc[dt] = MFMA32(a, b, acc[dt]); } }
            float* ut = UL + (size_t)u * 256 * 128;
#pragma unroll
            for (int dt = 0; dt < 4; ++dt)
#pragma unroll
                for (int r = 0; r < 16; ++r) ut[(size_t)(32 * w + crow32(r, hi)) * 128 + 32 * dt + l31] = acc[dt][r];
            if (tid < 128) { float s = 0.f;
#pragma unroll
                for (int j = 0; j < 8; ++j) { const s16x8 kv = *(const LAS s16x8*)(KT + tid * TSTR + 8 * j);
#pragma unroll
                    for (int i = 0; i < 8; ++i) s += bf2f((unsigned short)kv[i]); }
                NL[u * 128 + tid] = s; }
            __syncthreads();
        }
    }
}
__device__ __forceinline__ void p4_scan(Frame& F) {
    LAS float* gl = (LAS float*)(F.lds + RING_OFF);
    LAS float* dec = gl + 256; LAS float* scl = dec + 128; LAS float* mv = scl + 128;
    const float* UL = wsp<float>(F, WS_UL); const float* NL = wsp<float>(F, WS_NL); const float* GLAL = wsp<float>(F, WS_GLAL);
    bf16* CS = wsp<bf16>(F, WS_CS); float* NS = wsp<float>(F, WS_NS); float* MS = wsp<float>(F, WS_MS);
    const int tid = F.tid;
    for (int blk = F.vcu; blk < 4 * 64; blk += F.G) {
        const int h = blk >> 6, rem0 = (blk & 63) * 512;
        if (tid < 256) gl[tid] = GLAL[h * 256 + tid];
        __syncthreads();
        if (tid < 64) {
            const int lane = tid; const float g0 = gl[4 * lane], al0 = gl[4 * lane + 1], g1 = gl[4 * lane + 2], al1 = gl[4 * lane + 3];
            float A = g0 + g1, B = fmaxf(g0 + al0 + g1, g1 + al1);
#pragma unroll
            for (int o = 1; o < 64; o <<= 1) { const float Ap = __shfl_up(A, o), Bp = __shfl_up(B, o); if (lane >= o) { B = fmaxf(Bp + A, B); A = Ap + A; } }
            float Ae = __shfl_up(A, 1), Be = __shfl_up(B, 1); if (lane == 0) { Ae = 0.f; Be = -3.0e38f; }
            const float m0 = fmaxf(Ae, Be), mn0 = g0 + fmaxf(m0, al0), mn1 = g1 + fmaxf(mn0, al1);
            mv[2 * lane] = m0; dec[2 * lane] = __expf(g0 + m0 - mn0); scl[2 * lane] = __expf(g0 + al0 - mn0);
            mv[2 * lane + 1] = mn0; dec[2 * lane + 1] = __expf(g1 + mn0 - mn1); scl[2 * lane + 1] = __expf(g1 + al1 - mn1);
        }
        __syncthreads();
        if (rem0 == 0 && tid < 128) MS[h * 128 + tid] = mv[tid];
        const int rem = rem0 + tid;
        const float* ul = UL + (size_t)h * NCH * 32768 + rem; bf16* cs = CS + (size_t)h * NCH * 32768 + rem;
        float C = 0.f;
#pragma unroll 1
        for (int c0 = 0; c0 < NCH; c0 += 64) {
            float u[64];
#pragma unroll
            for (int i = 0; i < 64; ++i) u[i] = ul[(size_t)(c0 + i) * 32768];
#pragma unroll
            for (int i = 0; i < 64; ++i) { cs[(size_t)(c0 + i) * 32768] = (bf16)f2bf(C); C = dec[c0 + i] * C + scl[c0 + i] * u[i]; }
        }
        if (rem0 == 0 && tid < 128) { float n = 0.f; const float* nl = NL + (size_t)h * NCH * 128 + tid; float* ns = NS + (size_t)h * NCH * 128 + tid;
#pragma unroll 8
            for (int c = 0; c < NCH; ++c) { ns[c * 128] = n; n = dec[c] * n + scl[c] * nl[c * 128]; } }
        __syncthreads();
    }
}
constexpr int NUMSTR = 260;
__device__ __forceinline__ void p5_mlstm_out(Frame& F) {
    LAS bf16* VT = (LAS bf16*)(F.lds + RING_OFF);
    LAS bf16* Pm = VT + 256 * TSTR;
    LAS float* NUM = (LAS float*)(Pm + 64 * TSTR);
    LAS float* a_s = NUM + 64 * NUMSTR; LAS float* Mt = a_s + 64; LAS float* inter = Mt + 64; LAS float* emt = inter + 64; LAS float* qn = emt + 64; LAS float* dinv = qn + 64;
    const bf16* proj = wsp<bf16>(F, WS_PROJ); const float* gates = wsp<float>(F, WS_GATES); const bf16* CS = wsp<bf16>(F, WS_CS);
    const float* NS = wsp<float>(F, WS_NS); const float* MS = wsp<float>(F, WS_MS); bf16* concat = wsp<bf16>(F, WS_CONCAT);
    const int tid = F.tid, lane = F.lane, w = F.wave, hi = lane >> 5, l31 = lane & 31;
    for (int u = F.vcu; u < 4 * NCH; u += F.G) {
        const int h = u >> 7, ch = u & 127, t0 = ch * LCH;
        const bf16* qbase = proj + (size_t)t0 * NPP + C_MQ + h * 128; const bf16* kbase = proj + (size_t)t0 * NPP + C_MK + h * 128;
        if (w == 0) {
            const float ip = softcap_f(gates[(size_t)(t0 + lane) * 16 + h] + F.in[IN_BI][h]);
            const float fp = softcap_f(gates[(size_t)(t0 + lane) * 16 + 4 + h] + F.in[IN_BF][h]);
            const float g = wave_scan_add(log_sigmoid_f(fp), lane), a = ip - g, cm = wave_scan_max(a, lane);
            const float mp = MS[u], M = fmaxf(mp, cm);
            a_s[lane] = a; Mt[lane] = M; inter[lane] = __expf(mp - M); emt[lane] = __expf(-(g + M));
        }
        stage_transposed<false>(proj + (size_t)t0 * NPP + C_MV + h * 256, 256, VT, a_s, tid);
        __syncthreads();
        if (w < 4) {
            const int ti = w >> 1, si = w & 1;
            if (si <= ti) {
                s16x8 qa[8], kb[8];
#pragma unroll
                for (int ks = 0; ks < 8; ++ks) { qa[ks] = *(const GAS s16x8*)(qbase + (size_t)(32 * ti + l31) * NPP + 16 * ks + 8 * hi); kb[ks] = *(const GAS s16x8*)(kbase + (size_t)(32 * si + l31) * NPP + 16 * ks + 8 * hi); }
                f32x16 acc;
#pragma unroll
                for (int r = 0; r < 16; ++r) acc[r] = 0.f;
#pragma unroll
                for (int ks = 0; ks < 8; ++ks) acc = MFMA32(qa[ks], kb[ks], acc);
                const int s = 32 * si + l31; const float as = a_s[s];
#pragma unroll
                for (int r = 0; r < 16; ++r) { const int t = 32 * ti + crow32(r, hi); const float p = (s <= t) ? acc[r] * SCALEQ * __expf(as - Mt[t]) : 0.f; Pm[t * TSTR + s] = (bf16)f2bf(p); }
            } else {
#pragma unroll
                for (int r = 0; r < 16; ++r) Pm[(32 * ti + crow32(r, hi)) * TSTR + 32 * si + l31] = (bf16)0;
            }
        } else {
            const int t = (tid - 256) >> 2, d0 = ((tid - 256) & 3) * 32; float s = 0.f; const float* np = NS + (size_t)u * 128 + d0;
#pragma unroll
            for (int j = 0; j < 4; ++j) { const s16x8 qv = *(const GAS s16x8*)(qbase + (size_t)t * NPP + d0 + 8 * j);
#pragma unroll
                for (int i = 0; i < 8; ++i) s += bf2f((unsigned short)qv[i]) * np[8 * j + i]; }
            s += __shfl_xor(s, 1); s += __shfl_xor(s, 2);
            if ((tid & 3) == 0) qn[t] = s * SCALEQ;
        }
        __syncthreads();
        f32x16 accP[2], accC[2];
#pragma unroll
        for (int ti = 0; ti < 2; ++ti)
#pragma unroll
            for (int r = 0; r < 16; ++r) { accP[ti][r] = 0.f; accC[ti][r] = 0.f; }
        {
            const bf16* cs = CS + (size_t)u * 32768 + (size_t)(32 * w + l31) * 128 + 8 * hi;
            s16x8 cb[8];
#pragma unroll
            for (int ks = 0; ks < 8; ++ks) cb[ks] = *(const GAS s16x8*)(cs + 16 * ks);
#pragma unroll
            for (int ti = 0; ti < 2; ++ti) {
                s16x8 qa[8];
#pragma unroll
                for (int ks = 0; ks < 8; ++ks) qa[ks] = *(const GAS s16x8*)(qbase + (size_t)(32 * ti + l31) * NPP + 16 * ks + 8 * hi);
#pragma unroll
                for (int ks = 0; ks < 8; ++ks) accC[ti] = MFMA32(qa[ks], cb[ks], accC[ti]);
            }
#pragma unroll
            for (int ks = 0; ks < 4; ++ks) { const s16x8 vb = *(const LAS s16x8*)(VT + TSW(32 * w + l31, ks, hi));
#pragma unroll
                for (int ti = 0; ti < 2; ++ti) { const s16x8 pa = *(const LAS s16x8*)(Pm + (32 * ti + l31) * TSTR + 16 * ks + 8 * hi); accP[ti] = MFMA32(pa, vb, accP[ti]); } }
        }
        if (w == 0) {
            float rs = 0.f;
#pragma unroll
            for (int j = 0; j < 8; ++j) { const s16x8 pv = *(const LAS s16x8*)(Pm + lane * TSTR + 8 * j);
#pragma unroll
                for (int i = 0; i < 8; ++i) rs += bf2f((unsigned short)pv[i]); }
            const float dn = rs + inter[lane] * qn[lane];
            dinv[lane] = 1.f / fmaxf(fabsf(dn), emt[lane]);
        }
        __syncthreads();
#pragma unroll
        for (int ti = 0; ti < 2; ++ti)
#pragma unroll
            for (int r = 0; r < 16; ++r) { const int t = 32 * ti + crow32(r, hi); NUM[t * NUMSTR + 32 * w + l31] = (accP[ti][r] + inter[t] * SCALEQ * accC[ti][r]) * dinv[t]; }
        __syncthreads();
        {
            const f32x4 gn = *(const GAS f32x4*)(F.in[IN_MOUTN] + h * 256 + 4 * lane);
#pragma unroll
            for (int i = 0; i < 8; ++i) { const int t = 8 * w + i; const f32x4 x = *(const LAS f32x4*)(NUM + t * NUMSTR + 4 * lane);
                const float ss = wave_sum((x.x * x.x + x.y * x.y) + (x.z * x.z + x.w * x.w)); const float r = rsqrtf(ss * (1.f / 256.f) + 1e-6f);
                const u32x2 mo = *(const GAS u32x2*)(proj + (size_t)(t0 + t) * NPP + C_MO + h * 256 + 4 * lane);
                const float o0 = x.x * r * gn.x * sigmoid_f(bf2f((unsigned short)(mo.x & 0xffffu))), o1 = x.y * r * gn.y * sigmoid_f(bf2f((unsigned short)(mo.x >> 16)));
                const float o2 = x.z * r * gn.z * sigmoid_f(bf2f((unsigned short)(mo.y & 0xffffu))), o3 = x.w * r * gn.w * sigmoid_f(bf2f((unsigned short)(mo.y >> 16)));
                u32x2 ov; ov.x = pk2(o0, o1); ov.y = pk2(o2, o3);
                *(GAS u32x2*)(concat + (size_t)(t0 + t) * D + h * 256 + 4 * lane) = ov; }
        }
        __syncthreads();
    }
}
}
namespace mk {
__device__ __forceinline__ void attn_build_schedule(Frame& F) {
    LAS int* jl = (LAS int*)(F.lds + TAB_OFF); LAS int* pre = jl + 256; LAS int* wtot = pre + 260;
    const int tid = F.tid, lane = F.lane;
    if (tid < 256) { const int j = wsp<int>(F, WS_JLO)[tid]; jl[tid] = j; const int n = 4 * (tid & 31) + 4 - j; int v = (n + ATT_CH - 1) / ATT_CH;
        int inc = v;
#pragma unroll
        for (int o = 1; o < 64; o <<= 1) { const int t = __shfl_up(inc, o); if (lane >= o) inc += t; }
        pre[tid + 1] = inc; if (lane == 63) wtot[tid >> 6] = inc; }
    __syncthreads();
    if (tid < 256) { int add = 0; for (int w2 = 0; w2 < (tid >> 6); ++w2) add += wtot[w2]; pre[tid + 1] += add; if (tid == 0) pre[0] = 0; }
    __syncthreads();
}
__device__ __forceinline__ fox::BlockRef<fox::bf16, fox::bf16> fox_ref(const Frame& F, int I) {
    const LAS int* jl = (const LAS int*)(F.lds + TAB_OFF); const LAS int* pre = jl + 256;
    int b = 0;
#pragma unroll
    for (int st = 128; st >= 1; st >>= 1) if (pre[b + st] <= I) b += st;
    b = __builtin_amdgcn_readfirstlane(b);
    const int pb0 = __builtin_amdgcn_readfirstlane(pre[b]), pb1 = __builtin_amdgcn_readfirstlane(pre[b + 1]), j0 = __builtin_amdgcn_readfirstlane(jl[b]);
    const int h = b >> 5, qb = b & 31, part = I - pb0, P = pb1 - pb0, n = 4 * qb + 4 - j0;
    fox::BlockRef<fox::bf16, fox::bf16> r;
    const fox::bf16* proj = (const fox::bf16*)(F.ws + WS_PROJ);
    r.Q = proj + (size_t)(qb * 256) * fox::PITCH + C_FQ + h * 128; r.K = proj + C_FK + h * 128; r.V = proj + C_FV + h * 128;
    r.O = (fox::bf16*)(F.ws + WS_CONCAT) + (size_t)(qb * 256) * D + 1024 + h * 128; r.P0 = qb * 256;
    r.Fb = (const float*)(F.ws + WS_F) + h * S; r.gain = F.in[IN_FOUTN] + h * 128;
    r.jlo = j0 + (part * n) / P; r.jhi = j0 + ((part + 1) * n) / P;
    r.Op = P > 1 ? (float*)(F.ws + WS_OPART) + (size_t)I * 256 * 128 : nullptr; r.ML = (float*)(F.ws + WS_MLP) + (size_t)I * 512;
    return r;
}
__device__ __forceinline__ void p5_attention(Frame& F, char* ldsg) {
    typedef fox::BlockRef<fox::bf16, fox::bf16> BR;
    attn_build_schedule(F);
    const int total = __builtin_amdgcn_readfirstlane(((const LAS int*)(F.lds + TAB_OFF))[256 + 256]);
#define ATT_ITEM(r) (total - 1 - ((r) * F.G + (((r) & 1) ? F.G - 1 - F.vcu : F.vcu)))
    int r = 0; int L = ATT_ITEM(0); if (L < 0) return;
    BR cur = fox_ref(F, L);
    fox::Seam<fox::bf16> Sm;
    fox::causal_swa_prime<fox::bf16, fox::bf16>(cur, S, ldsg, Sm);
    for (;;) {
        const int Ln = ATT_ITEM(r + 1); const bool more = Ln >= 0;
        const BR nxt = more ? fox_ref(F, Ln) : cur;
        fox::causal_swa_block<fox::bf16, fox::bf16>(cur, nxt, S, S, ldsg, Sm);
        if (!more) break;
        cur = nxt; ++r;
    }
#undef ATT_ITEM
}
__device__ __forceinline__ void p6_combine(Frame& F) {
    attn_build_schedule(F);
    const LAS int* pre = (const LAS int*)(F.lds + TAB_OFF) + 256;
    const float* OP = wsp<float>(F, WS_OPART); const float* MLP = wsp<float>(F, WS_MLP); bf16* concat = wsp<bf16>(F, WS_CONCAT);
    const int gw = F.vcu * NWAVES + F.wave, NGW = F.G * NWAVES, lane = F.lane;
    constexpr float C2 = 1.4426950408889634f * SCALEQ;
    for (int idx = gw; idx < 256 * 256; idx += NGW) {
        const int b = idx >> 8, r = idx & 255, i0 = __builtin_amdgcn_readfirstlane(pre[b]), P = __builtin_amdgcn_readfirstlane(pre[b + 1]) - i0; if (P <= 1) continue;
        const int h = b >> 5, qb = b & 31;
        f32x2 ml[8], ov[8];
#pragma unroll
        for (int p2 = 0; p2 < 8; ++p2) if (p2 < P) { ml[p2] = *(const GAS f32x2*)(MLP + (size_t)(i0 + p2) * 512 + 2 * r); ov[p2] = *(const GAS f32x2*)(OP + ((size_t)(i0 + p2) * 256 + r) * 128 + 2 * lane); }
        float ms = -3.0e38f;
#pragma unroll
        for (int p2 = 0; p2 < 8; ++p2) if (p2 < P) ms = fmaxf(ms, ml[p2].x);
        float n0 = 0.f, n1 = 0.f, den = 0.f;
#pragma unroll
        for (int p2 = 0; p2 < 8; ++p2) if (p2 < P) { const float wgt = __builtin_amdgcn_exp2f((ml[p2].x - ms) * C2); n0 += wgt * ov[p2].x; n1 += wgt * ov[p2].y; den += wgt * ml[p2].y; }
        const float inv = 1.f / den, v0 = n0 * inv, v1 = n1 * inv;
        const float ss = wave_sum(v0 * v0 + v1 * v1), rn = rsqrtf(ss * (1.f / 128.f) + 1e-6f);
        const f32x2 gn = *(const GAS f32x2*)(F.in[IN_FOUTN] + h * 128 + 2 * lane);
        *(GAS unsigned*)(concat + (size_t)(qb * 256 + r) * D + 1024 + h * 128 + 2 * lane) = pk2(v0 * rn * gn.x, v1 * rn * gn.y);
    }
}
constexpr int RROWS = 8, NITER = S / RROWS;
__device__ __forceinline__ void router_load_weights(const Frame& F, s16x8 (&whi)[16], s16x8 (&wlo)[16]) {
    const int lane = F.lane, w = F.wave, hh = lane >> 5; const float* wp = F.in[IN_WR] + (size_t)(256 * w + 8 * hh) * NE + (lane & 31);
#pragma unroll
    for (int ks = 0; ks < 16; ++ks) { float wv[8];
#pragma unroll
        for (int j = 0; j < 8; ++j) wv[j] = wp[(size_t)(16 * ks + j) * NE];
        unsigned hw[4], lw[4];
#pragma unroll
        for (int j = 0; j < 4; ++j) { const unsigned a = f2bf(wv[2 * j]), b = f2bf(wv[2 * j + 1]); hw[j] = a | (b << 16); lw[j] = pk2(wv[2 * j] - bf2f((unsigned short)a), wv[2 * j + 1] - bf2f((unsigned short)b)); }
        const v4u hv4 = {hw[0], hw[1], hw[2], hw[3]}, lv4 = {lw[0], lw[1], lw[2], lw[3]};
        whi[ks] = __builtin_bit_cast(s16x8, hv4); wlo[ks] = __builtin_bit_cast(s16x8, lv4); }
}
__device__ __forceinline__ void p7_router(Frame& F, const s16x8 (&whi)[16], const s16x8 (&wlo)[16]) {
    LAS float* shs = (LAS float*)(F.lds + RING_OFF);
    constexpr int HSTR = 2064;
    LAS bf16* H2hi = (LAS bf16*)(shs + 2 * D);
    LAS bf16* H2lo = H2hi + RROWS * HSTR;
    LAS float* red = (LAS float*)(H2lo + RROWS * HSTR);
    LAS int* selE = (LAS int*)(red + 8 * RROWS * NE);
    const float* mod = wsp<float>(F, WS_MOD); const float* h1 = wsp<float>(F, WS_H1); unsigned char* h2 = wsp<unsigned char>(F, WS_HN);
    int* top_i = wsp<int>(F, WS_TOPI); float* top_w = wsp<float>(F, WS_TOPW); int* hist = wsp<int>(F, WS_HIST); int* lrank = wsp<int>(F, WS_LRANK);
    const int tid = F.tid, lane = F.lane, w = F.wave;
    for (int i = tid; i < 2 * D; i += NTHR) shs[i] = mod[3 * D + i];
    __syncthreads();
    for (int it = F.vcu; it < NITER; it += F.G) {
        const int r0 = it * RROWS;
        {
            const int m = r0 + w; const GAS f32x4* xr = (const GAS f32x4*)(h1 + (size_t)m * D) + lane; f32x4 v[8]; float s2 = 0.f;
#pragma unroll
            for (int j = 0; j < 8; ++j) { v[j] = xr[64 * j]; s2 += (v[j].x * v[j].x + v[j].y * v[j].y) + (v[j].z * v[j].z + v[j].w * v[j].w); }
            const float r = rsqrtf(wave_sum(s2) * (1.f / D) + 1e-6f);
            GAS unsigned* o8 = (GAS unsigned*)(h2 + (size_t)m * D) + lane;
#pragma unroll
            for (int j = 0; j < 8; ++j) { const int c0 = 4 * lane + 256 * j; const f32x4 gg = *(const GAS f32x4*)(F.in[IN_NFFN] + c0); const f32x4 a = *(const LAS f32x4*)(shs + D + c0), b = *(const LAS f32x4*)(shs + c0);
                const f32x4 y = v[j] * r * gg * (a + 1.f) + b; o8[64 * j] = pk4_fp8(y.x, y.y, y.z, y.w);
                const unsigned h0 = pk2(y.x, y.y), h1w = pk2(y.z, y.w); u32x2 hv; hv.x = h0; hv.y = h1w;
                u32x2 lv; lv.x = pk2(y.x - bf2f((unsigned short)(h0 & 0xffffu)), y.y - bf2f((unsigned short)(h0 >> 16))); lv.y = pk2(y.z - bf2f((unsigned short)(h1w & 0xffffu)), y.w - bf2f((unsigned short)(h1w >> 16)));
                *(LAS u32x2*)(H2hi + w * HSTR + c0) = hv; *(LAS u32x2*)(H2lo + w * HSTR + c0) = lv; }
        }
        __syncthreads();
        {
            f32x16 acc;
#pragma unroll
            for (int r = 0; r < 16; ++r) acc[r] = 0.f;
            const int hh = lane >> 5; const LAS bf16* bh = H2hi + (lane & 7) * HSTR + 256 * w + 8 * hh; const LAS bf16* bl = H2lo + (lane & 7) * HSTR + 256 * w + 8 * hh;
#pragma unroll
            for (int ks = 0; ks < 16; ++ks) { const s16x8 xh = *(const LAS s16x8*)(bh + 16 * ks), xl = *(const LAS s16x8*)(bl + 16 * ks);
                acc = MFMA32(whi[ks], xh, acc); acc = MFMA32(whi[ks], xl, acc); acc = MFMA32(wlo[ks], xh, acc); }
            if ((lane & 31) < RROWS) {
#pragma unroll
                for (int r = 0; r < 16; ++r) red[(w * RROWS + (lane & 31)) * NE + crow32(r, hh)] = acc[r]; }
        }
        __syncthreads();
        if (tid < RROWS * NE) {
            const int r = tid >> 5, e = tid & 31; float lg = F.in[IN_BR][e];
#pragma unroll
            for (int kp = 0; kp < 8; ++kp) lg += red[(kp * RROWS + r) * NE + e];
            float cur = lg, mx = 0.f, sum = 0.f, mysel = 0.f; int myidx = 0;
#pragma unroll
            for (int q = 0; q < 4; ++q) { float best = cur; int bi = e;
#pragma unroll
                for (int o = 1; o < 32; o <<= 1) { const float ob = __shfl_xor(best, o); const int oi = __shfl_xor(bi, o); if (ob > best || (ob == best && oi < bi)) { best = ob; bi = oi; } }
                if (q == 0) mx = best;
                sum += __expf(best - mx);
                if (e == q) { mysel = best; myidx = bi; }
                if (e == bi) cur = -3.0e38f; }
            if (e < 4) { const int t = r0 + r; top_i[t * 4 + e] = myidx; top_w[t * 4 + e] = __expf(mysel - mx) / sum; selE[r * 4 + e] = myidx; }
        }
        __syncthreads();
        if (tid < 32) { const int me = selE[tid]; int rank = 0, cnt = 0;
#pragma unroll
            for (int p = 0; p < 32; ++p) { const int ep = selE[p]; rank += (ep == me && p < tid) ? 1 : 0; cnt += (ep == tid) ? 1 : 0; }
            lrank[it * 32 + tid] = rank; hist[it * NE + tid] = cnt; }
        __syncthreads();
    }
}
__device__ __forceinline__ void build_expert_table(Frame& F, const int* counts_g) {
    LAS int* tab = (LAS int*)(F.lds + TAB_OFF);
    if (F.tid < 64) {
        const int lane = F.tid, c = lane < NE ? counts_g[lane] : 0, nt = (c + 255) >> 8; int inc = nt;
#pragma unroll
        for (int o = 1; o < 64; o <<= 1) { const int t = __shfl_up(inc, o); if (lane >= o) inc += t; }
        if (lane < NE) { tab[lane] = inc - nt; tab[40 + lane] = c; }
        if (lane == NE - 1) tab[32] = inc; }
    __syncthreads();
}
__device__ __forceinline__ void p8_gather(Frame& F) {
    LAS unsigned short* loc = (LAS unsigned short*)(F.lds + RING_OFF);
    LAS int* psum = (LAS int*)(F.lds + RING_OFF + 65536);
    LAS int* startr = psum + 16 * NE;
    const int* hist = wsp<int>(F, WS_HIST); const int* lrank = wsp<int>(F, WS_LRANK); const int* top_i = wsp<int>(F, WS_TOPI); const float* top_w = wsp<float>(F, WS_TOPW);
    int* pos = wsp<int>(F, WS_POS); float* roww = wsp<float>(F, WS_ROWW); int* rowtok = wsp<int>(F, WS_ROWTOK);
    int* counts_g = (int*)(F.ws + WS_POS) + S * 4;
    const int tid = F.tid, lane = F.lane, w = F.wave;
    { const int e = tid & 31, part = tid >> 5; int hv[64];
#pragma unroll
        for (int i = 0; i < 64; ++i) hv[i] = hist[(part * 64 + i) * NE + e];
        int s = 0;
#pragma unroll
        for (int i = 0; i < 64; ++i) { loc[(part * 64 + i) * NE + e] = (unsigned short)s; s += hv[i]; }
        psum[part * NE + e] = s; }
    __syncthreads();
    if (tid < 64) { int tot = 0;
        if (tid < NE) {
#pragma unroll
            for (int p = 0; p < 16; ++p) { const int v = psum[p * NE + tid]; psum[p * NE + tid] = tot; tot += v; } }
        const int padded = ((tot + 255) >> 8) << 8; int inc = padded;
#pragma unroll
        for (int o = 1; o < 64; o <<= 1) { const int t = __shfl_up(inc, o); if (lane >= o) inc += t; }
        if (tid < NE) { startr[tid] = inc - padded; startr[NE + tid] = tot; if (blockIdx.x == 0) counts_g[tid] = tot; } }
    __syncthreads();
    for (int e = (int)blockIdx.x; e < NE; e += (int)gridDim.x) {
        const int c = startr[NE + e], pad = (((c + 255) >> 8) << 8) - c; for (int r = tid; r < pad; r += NTHR) rowtok[startr[e] + c + r] = S; }
    if (blockIdx.x == 0 && tid < 128) ((GAS v4u*)(wsp<unsigned char>(F, WS_HN) + (size_t)S * D))[tid] = (v4u){0u, 0u, 0u, 0u};
    for (int itb = F.vcu; itb < NITER; itb += 4 * F.G) {
        const int pi = 16 * w + (lane & 15), it = itb + (pi >> 5) * F.G; const bool valid = it < NITER;
        if (valid && lane < 16) { const int pair = it * 32 + (pi & 31), e = top_i[pair], dest = startr[e] + psum[(it >> 6) * NE + e] + (int)loc[it * NE + e] + lrank[pair];
            pos[pair] = dest; roww[dest] = top_w[pair]; rowtok[dest] = pair >> 2; }
    }
}
struct GroupedOrder {
    const LAS int* tab; int ntn, G, c;
    __device__ __forceinline__ bool next(int i, Unit& u) const {
        const int L0 = i * G + c, total = tab[32] * ntn; if (L0 >= total) return false;
        int L; { const int qq = total / pg8::NXCD, rr = total % pg8::NXCD, xcd = L0 % pg8::NXCD, off = L0 / pg8::NXCD; L = (xcd < rr ? xcd * (qq + 1) : rr * (qq + 1) + (xcd - rr) * qq) + off; }
        int e = (u.e > 0 && u.e < NE && tab[u.e] * ntn <= L) ? u.e : 0;
#pragma unroll 1
        while (e < NE - 1 && tab[e + 1] * ntn <= L) ++e;
        const int ts = tab[e], tc = tab[e + 1] - ts, within = L - ts * ntn;
        u.pm = ts + within % tc; u.pn = within / tc; u.e = e; u.pb = e * ntn + u.pn; return true;
    }
    __device__ __forceinline__ void a_ready(const Unit&) const {}
    __device__ __forceinline__ void done(const Unit&) const {}
};
struct EpiSwiglu {
    static constexpr bool PERM = true, AFTER_DRAIN = false;
    unsigned char* act; const float* bug; const LAS int* tab;
    __device__ __forceinline__ void operator()(const pg8::f32x4 (&acc)[2][2][4][2], const Unit& u, int wr, int wc, int fr, int fq) const {
        const int row0 = u.pm * 256 + wr * 64 + fr, f0 = u.pn * 128 + wc * 32 + 8 * fq;
        const int vr = tab[40 + u.e] - ((u.pm - tab[u.e]) << 8);
        const float* bg = bug + (size_t)u.e * 4096 + f0; pg8::f32x4 bgv[2], buv[2];
#pragma unroll
        for (int n = 0; n < 2; ++n) { bgv[n] = *(const pg8::f32x4*)(bg + 4 * n); buv[n] = *(const pg8::f32x4*)(bg + 2048 + 4 * n); }
#pragma unroll
        for (int ai = 0; ai < 2; ++ai)
#pragma unroll
            for (int m = 0; m < 4; ++m) { float o[8];
#pragma unroll
                for (int n = 0; n < 2; ++n)
#pragma unroll
                    for (int i = 0; i < 4; ++i) { const float g = fminf(acc[ai][0][m][n][i] + bgv[n][i], 7.f); const float up = fminf(fmaxf(acc[ai][1][m][n][i] + buv[n][i], -7.f), 7.f);
                        o[4 * n + i] = (up + 1.f) * g * __builtin_amdgcn_rcpf(1.f + __builtin_amdgcn_exp2f(-2.45546696f * g)); }
                u32x2 wv; wv.x = pk4_fp8(o[0], o[1], o[2], o[3]); wv.y = pk4_fp8(o[4], o[5], o[6], o[7]);
                if (wr * 64 + fr + ai * 128 + m * 16 >= vr) { wv.x = 0u; wv.y = 0u; }
                *(u32x2*)(act + (size_t)(row0 + ai * 128 + m * 16) * FF + f0) = wv; }
    }
};
struct EpiDown {
    static constexpr bool PERM = true, AFTER_DRAIN = false;
    bf16* y; const float* bd; const float* roww;
    __device__ __forceinline__ void operator()(const pg8::f32x4 (&acc)[2][2][4][2], const Unit& u, int wr, int wc, int fr, int fq) const {
        const int row0 = u.pm * 256 + wr * 64 + fr, col0 = u.pn * 256 + wc * 32 + 8 * fq;
        pg8::f32x4 bv[2][2];
#pragma unroll
        for (int bj = 0; bj < 2; ++bj)
#pragma unroll
            for (int n = 0; n < 2; ++n) bv[bj][n] = *(const pg8::f32x4*)(bd + (size_t)u.e * D + col0 + bj * 128 + 4 * n);
#pragma unroll
        for (int ai = 0; ai < 2; ++ai)
#pragma unroll
            for (int m = 0; m < 4; ++m) { const int row = row0 + ai * 128 + m * 16; const float rw = roww[row]; bf16* rowp = y + (size_t)row * D + col0;
#pragma unroll
                for (int bj = 0; bj < 2; ++bj) { const pg8::f32x4 v0 = (acc[ai][bj][m][0] + bv[bj][0]) * rw, v1 = (acc[ai][bj][m][1] + bv[bj][1]) * rw;
                    pg8::u32x4 wv; wv.x = cvt_pk_bf16(v0[0], v0[1]); wv.y = cvt_pk_bf16(v0[2], v0[3]); wv.z = cvt_pk_bf16(v1[0], v1[1]); wv.w = cvt_pk_bf16(v1[2], v1[3]);
                    *(pg8::u32x4*)(rowp + bj * 128) = wv; } }
    }
};
__device__ __forceinline__ void p11_final(Frame& F, float oscale) {
    LAS float* ms = (LAS float*)(F.lds + RING_OFF);
    const float* mod = wsp<float>(F, WS_MOD);
    for (int i = F.tid; i < 3 * D; i += NTHR) ms[i] = mod[5 * D + i];
    __syncthreads();
    const float* h1 = wsp<float>(F, WS_H1); const bf16* y = wsp<bf16>(F, WS_Y); const int* pos = wsp<int>(F, WS_POS);
    const int gw = F.vcu * NWAVES + F.wave, NGW = F.G * NWAVES, lane = F.lane;
    for (int t = gw; t < S; t += NGW) {
        asm volatile("" ::: "memory");
        const GAS f32x4* xr = (const GAS f32x4*)(h1 + (size_t)t * D) + lane;
        const GAS u32x2* y0 = (const GAS u32x2*)(y + (size_t)pos[t * 4 + 0] * D) + lane; const GAS u32x2* y1 = (const GAS u32x2*)(y + (size_t)pos[t * 4 + 1] * D) + lane;
        const GAS u32x2* y2 = (const GAS u32x2*)(y + (size_t)pos[t * 4 + 2] * D) + lane; const GAS u32x2* y3 = (const GAS u32x2*)(y + (size_t)pos[t * 4 + 3] * D) + lane;
        f32x4 v[8]; float s2 = 0.f;
#pragma unroll
        for (int j = 0; j < 8; ++j) { const u32x2 a = y0[64 * j], b = y1[64 * j], c = y2[64 * j], d = y3[64 * j]; const f32x4 g2 = *(const LAS f32x4*)(ms + 4 * lane + 256 * j);
            f32x4 f;
            f.x = (bf2f((unsigned short)(a.x & 0xffffu)) + bf2f((unsigned short)(b.x & 0xffffu))) + (bf2f((unsigned short)(c.x & 0xffffu)) + bf2f((unsigned short)(d.x & 0xffffu)));
            f.y = (bf2f((unsigned short)(a.x >> 16)) + bf2f((unsigned short)(b.x >> 16))) + (bf2f((unsigned short)(c.x >> 16)) + bf2f((unsigned short)(d.x >> 16)));
            f.z = (bf2f((unsigned short)(a.y & 0xffffu)) + bf2f((unsigned short)(b.y & 0xffffu))) + (bf2f((unsigned short)(c.y & 0xffffu)) + bf2f((unsigned short)(d.y & 0xffffu)));
            f.w = (bf2f((unsigned short)(a.y >> 16)) + bf2f((unsigned short)(b.y >> 16))) + (bf2f((unsigned short)(c.y >> 16)) + bf2f((unsigned short)(d.y >> 16)));
            v[j] = xr[64 * j] + g2 * f; s2 += (v[j].x * v[j].x + v[j].y * v[j].y) + (v[j].z * v[j].z + v[j].w * v[j].w); }
        const float r = rsqrtf(wave_sum(s2) * (1.f / D) + 1e-6f);
        GAS f32x4* o = (GAS f32x4*)(F.out + (size_t)t * D) + lane;
#pragma unroll
        for (int j = 0; j < 8; ++j) { const int c0 = 4 * lane + 256 * j; const f32x4 gg = *(const GAS f32x4*)(F.in[IN_NFIN] + c0); const f32x4 sh = *(const LAS f32x4*)(ms + D + c0), sc = *(const LAS f32x4*)(ms + 2 * D + c0);
            o[64 * j] = (v[j] * r * gg * (sc + 1.f) + sh) * oscale; }
    }
}
}
namespace mk {
struct Args { const float* in[24]; float* out; unsigned char* ws; int ph_lo, ph_hi, li, pad; };
constexpr int N_PHASES = 13;
__global__ void __launch_bounds__(NTHR, 2) mega_fwd(Args args) {
    extern __shared__ __attribute__((aligned(16))) unsigned char lds[];
    Frame F;
    F.lds = (LAS unsigned char*)lds;
    F.MISC = (volatile LAS unsigned*)(F.lds + MISC_OFF);
    F.tid = threadIdx.x; F.lane = F.tid & 63; F.wave = __builtin_amdgcn_readfirstlane(F.tid >> 6);
    leave_group(F);
    F.ws = args.ws; F.out = args.out; F.ctl = (gu32*)(args.ws + WS_CTL);
#pragma unroll
    for (int i = 0; i < 24; ++i) F.in[i] = args.in[i];
    for (int u = F.tid; u < (LDS_BYTES - LDSCTL_OFF) / 4; u += NTHR) ((LAS unsigned*)(F.lds + LDSCTL_OFF))[u] = 0u;
    __syncthreads();
    XcdBarrier bar = xcd_barrier_post((unsigned*)(F.ctl + CW_BAR) + args.li * XCD_BAR_WORDS, F.MISC + 8);
    const int lo = args.ph_lo, hi = args.ph_hi;
#define IN(k) (lo <= (k) && (k) < hi)
#define SEAM(k) do { if (IN(k) && IN((k) + 1)) { xcd_barrier(bar); if (MK_DBLBAR) xcd_barrier(bar); } } while (0)

#ifndef MK_DBLBAR
#define MK_DBLBAR 0
#endif
#ifndef MK_DOUBLE
#define MK_DOUBLE 0
#endif
#define DBL(k) ((MK_DOUBLE >> (k)) & 1)
#ifdef MK_PROBE_LO
    unsigned long long* stamps = (unsigned long long*)(F.ctl + 131072);
#define STAMP(k) do { if (blockIdx.x == 0 && F.tid == 0) stamps[k] = rt(); } while (0)
#define PROBE_SCALE() (1.f + sqrtf((float)(stamps[MK_PROBE_HI] - stamps[MK_PROBE_LO]) * 0.01f * 2e-5f))
#elif defined(MK_PROBE_TILES)
#define STAMP(k) do { } while (0)
    auto probe_tiles = [&]() -> float { int tt = 0, ni = 0; for (int b = 0; b < 256; ++b) { const int n = 4 * (b & 31) + 4 - wsp<int>(F, WS_JLO)[b]; tt += n; ni += (n + ATT_CH - 1) / ATT_CH; } return MK_PROBE_TILES == 1 ? (float)tt : (float)ni; };
#define PROBE_SCALE() (1.f + sqrtf(probe_tiles() * 1e-6f))
#else
#define STAMP(k) do { } while (0)
#define PROBE_SCALE() 1.f
#endif
    STAMP(0); if (IN(0)) { p0_gemv(F); } SEAM(0);
    STAMP(1); if (IN(1)) { p1_modulate(F, args.pad); if (DBL(1)) p1_modulate(F, args.pad); } SEAM(1);
    STAMP(2); if (IN(2)) {
        gu32* done = F.ctl + CW_DONE + 64 * 2;
        if (enter_group(F, GC_INPROJ)) {
            pg8::Gemm g{wsp<pg8::bf16_t>(F, WS_HN), wsp<pg8::bf16_t>(F, WS_WIN), S, NPP, D}; pg8::StaticOrder So; So.init(S, NPP, F.G, F.bid);
            EpiProj E{wsp<bf16>(F, WS_PROJ), (PG8_LAS float*)(F.lds + TAB_OFF + 1024), F.in[IN_FOXQN], F.in[IN_FOXKN]};
            pg8::gemm_phase<EpiProj, pg8::StaticOrder, true, true>(F.lds + RING_OFF, g, So, E);
            if (DBL(2)) pg8::gemm_phase<EpiProj, pg8::StaticOrder, true, true>(F.lds + RING_OFF, g, So, E);
            __syncthreads();
            if (F.tid == 0) __hip_atomic_fetch_add(done, 1u, RLX_AGENT);
        }
        const unsigned tgt = (unsigned)F.G; leave_group(F);
        if (F.G == 256 && (blockIdx.x >> 3) == 31) p_fscan(F, (int)(blockIdx.x & 7));
        conv_worker(F, done, F.G == 256 ? (unsigned)GC_INPROJ : tgt, 0);
        __syncthreads();
    } SEAM(2);
#define GROUPED(k, Gc, body) do { gu32* done_ = F.ctl + CW_DONE + 64 * (k); if (enter_group(F, (Gc))) { body; __syncthreads(); if (F.tid == 0) __hip_atomic_fetch_add(done_, 1u, RLX_AGENT); } \
        const unsigned tgt_ = (unsigned)F.G; leave_group(F); conv_worker(F, done_, F.G == 256 ? (unsigned)(Gc) : tgt_, 0); __syncthreads(); } while (0)
    STAMP(3); if (IN(3)) { p3_prep(F); } SEAM(3);
    STAMP(4); if (IN(4)) { p4_scan(F); if (DBL(4)) p4_scan(F); } SEAM(4);
    STAMP(5); if (IN(5)) {
        gu32* done = F.ctl + CW_DONE + 64 * 5;
        if (args.pad != 3) p5_mlstm_out(F);
        if (enter_group(F, GC_ATTN)) {
            if (args.pad != 2) p5_attention(F, (char*)lds);
            __syncthreads();
            if (F.tid == 0) __hip_atomic_fetch_add(done, 1u, RLX_AGENT);
        }
        const unsigned tgt = (unsigned)F.G; leave_group(F);
        conv_worker(F, done, F.G == 256 ? (unsigned)GC_ATTN : tgt, 0);
        __syncthreads();
    } SEAM(5);
    STAMP(6); if (IN(6)) { p6_combine(F); } SEAM(6);
    STAMP(7); if (IN(7)) {
        pg8::Gemm g{wsp<pg8::bf16_t>(F, WS_CONCAT), wsp<pg8::bf16_t>(F, WS_WOUT), S, D, D}; pg8::StaticOrder So; So.init(S, D, F.G, F.bid);
        EpiOut E{F.in[IN_X], wsp<float>(F, WS_MOD) + 2 * D, wsp<float>(F, WS_H1)};
        pg8::gemm_phase<EpiOut, pg8::StaticOrder, false, true>(F.lds + RING_OFF, g, So, E);
        if (DBL(7)) pg8::gemm_phase<EpiOut, pg8::StaticOrder, false, true>(F.lds + RING_OFF, g, So, E);
    }
    s16x8 rwhi[16], rwlo[16];
    if (IN(8)) router_load_weights(F, rwhi, rwlo);
    SEAM(7);
    STAMP(8); if (IN(8)) { p7_router(F, rwhi, rwlo); } SEAM(8);
    STAMP(9); if (IN(9)) { p8_gather(F); if (DBL(9)) p8_gather(F); __syncthreads(); conv_worker(F, nullptr, 0u, 1); __syncthreads(); } SEAM(9);
    STAMP(10); if (IN(10)) {
        build_expert_table(F, (const int*)(F.ws + WS_POS) + S * 4);
        gu32* done = F.ctl + CW_DONE + 64 * 10;
        const int units = ((const LAS int*)(F.lds + TAB_OFF))[32] * 16, rounds = (units + 255) >> 8; int gc = rounds > 0 ? (((units + rounds - 1) / rounds + 7) >> 3) << 3 : 256; gc = gc > 256 ? 256 : gc;
        gc = __builtin_amdgcn_readfirstlane(gc);
        if (enter_group(F, gc)) {
            pg8::Gemm g{wsp<pg8::bf16_t>(F, WS_HN), wsp<pg8::bf16_t>(F, WS_WUG), S, 4096, D / 2}; GroupedOrder So{(const LAS int*)(F.lds + TAB_OFF), 16, F.G, F.bid};
            EpiSwiglu E{wsp<unsigned char>(F, WS_ACT), F.in[IN_BUG], (const LAS int*)(F.lds + TAB_OFF)};
            LAS int* rowc = (LAS int*)(F.lds + TAB_OFF + 1024); const int* rowtok = wsp<int>(F, WS_ROWTOK);
            int nun = 0; { pg8::Unit uu = {0, 0, 0, 0}; while (nun < ROWC_MAX && So.next(nun, uu)) { if (F.tid < 256) rowc[nun * 256 + F.tid] = rowtok[uu.pm * 256 + F.tid]; ++nun; }
                if (nun == ROWC_MAX && So.next(nun, uu)) nun = -1; }
            __syncthreads();
            if (nun >= 0) pg8::gemm_phase8g<EpiSwiglu, GroupedOrder, true, true>(F.lds + RING_OFF, g, So, E, rowc);
            else if (F.tid == 0) __hip_atomic_store(F.ctl + CW_TMO, 0xBAD0C0u, RLX_AGENT);
            __syncthreads();
            if (F.tid == 0) __hip_atomic_fetch_add(done, 1u, RLX_AGENT);
        }
        leave_group(F);
        __syncthreads(); conv_worker(F, nullptr, 0u, 2); __syncthreads();
    } SEAM(10);
    STAMP(11); if (IN(11)) {
        build_expert_table(F, (const int*)(F.ws + WS_POS) + S * 4);
        pg8::Gemm g{wsp<pg8::bf16_t>(F, WS_ACT), wsp<pg8::bf16_t>(F, WS_WD), MAXROWS, D, FF / 2}; GroupedOrder So{(const LAS int*)(F.lds + TAB_OFF), 8, F.G, F.bid};
        EpiDown E{wsp<bf16>(F, WS_Y), F.in[IN_BD], wsp<float>(F, WS_ROWW)};
        pg8::gemm_phase8<EpiDown, GroupedOrder, true, true>(F.lds + RING_OFF, g, So, E);
        if (DBL(11)) pg8::gemm_phase8<EpiDown, GroupedOrder, true, true>(F.lds + RING_OFF, g, So, E);
    } SEAM(11);
    STAMP(12); if (IN(12)) { p11_final(F, PROBE_SCALE()); if (DBL(12)) p11_final(F, PROBE_SCALE()); }
#undef IN
#undef SEAM
}
}
#ifndef MK_DEBUG
#define MK_DEBUG 0
#endif
#ifndef MK_PH_END
#define MK_PH_END mk::N_PHASES
#endif
#ifndef MK_SPLIT
#define MK_SPLIT 0
#endif
extern "C" void kernel_launch(void* const* d_in, const int* in_sizes, int n_in, void* d_out, int out_size, void* d_ws, size_t ws_size, hipStream_t stream) {
    using namespace mk;
    static int grid = 0;
    if (grid == 0) {
        int dev = 0, cus = 0, per_cu = 0;
        if (hipGetDevice(&dev) != hipSuccess || hipDeviceGetAttribute(&cus, hipDeviceAttributeMultiprocessorCount, dev) != hipSuccess) { fprintf(stderr, "kernel_launch: device query failed\n"); grid = -1; return; }
        if (hipFuncSetAttribute((const void*)mega_fwd, hipFuncAttributeMaxDynamicSharedMemorySize, LDS_BYTES) != hipSuccess) { fprintf(stderr, "kernel_launch: hipFuncSetAttribute failed\n"); grid = -1; return; }
        if (hipOccupancyMaxActiveBlocksPerMultiprocessor(&per_cu, (const void*)mega_fwd, NTHR, LDS_BYTES) != hipSuccess || per_cu < 1) fprintf(stderr, "kernel_launch: occupancy query reports %d\n", per_cu);
        (void)hipGetLastError();
        grid = cus;
        if (n_in != 24 || out_size != S * D || ws_size < (MK_DEBUG ? WS_NAIVE + (size_t)2300 * MiB : WS_END)) fprintf(stderr, "kernel_launch: unexpected sizes n_in %d out %d ws %zu\n", n_in, out_size, ws_size);
    }
    if (grid < 0) return;
    (void)hipMemsetAsync((char*)d_ws + WS_CTL, 0, CTL_ZERO_BYTES, stream);
    Args a{};
    for (int i = 0; i < 24; ++i) a.in[i] = (const float*)d_in[i];
    a.out = (float*)d_out; a.ws = (unsigned char*)d_ws;
#if MK_DEBUG
    nv::naive_forward(d_in, (float*)d_out, (char*)d_ws + WS_NAIVE, stream);
#endif
#if MK_SPLIT
    for (int p = 0; p < MK_PH_END; ++p) { a.ph_lo = p; a.ph_hi = p + 1; a.li = p; hipLaunchKernelGGL(mega_fwd, dim3(grid), dim3(NTHR), LDS_BYTES, stream, a); }
#else
    a.ph_lo = 0; a.ph_hi = MK_PH_END; a.li = 0;
    hipLaunchKernelGGL(mega_fwd, dim3(grid), dim3(NTHR), LDS_BYTES, stream, a);
#endif
#ifdef MK_EXTRA_LO
    a.ph_lo = MK_EXTRA_LO; a.ph_hi = MK_EXTRA_HI; a.li = 1;
#ifdef MK_EXTRA_PAD
    a.pad = MK_EXTRA_PAD;
#endif
    hipLaunchKernelGGL(mega_fwd, dim3(grid), dim3(NTHR), LDS_BYTES, stream, a);
#endif
    { const hipError_t le = hipPeekAtLastError(); if (le != hipSuccess) fprintf(stderr, "kernel_launch: launch failed: %s\n", hipGetErrorName(le)); }
#if MK_DEBUG
    {
        nv::NaiveWs w = nv::carve((char*)d_ws + WS_NAIVE);
        double* slots = (double*)((char*)d_ws + WS_CTL + 512 * 1024);
        unsigned char* ws = (unsigned char*)d_ws; int nc = 0;
        MK_DEBUG_CHECKS
        dbg::k_finish<<<1024, 256, 0, stream>>>((float*)d_out, (size_t)S * D, slots, nc, 1e-3);
    }
#endif
}
```

```cpp
#include <hip/hip_runtime.h>
#include <hip/hip_bf16.h>
#include <cstdio>
#include <cstdint>
namespace pg8 {
#define PG8_LAS __attribute__((address_space(3)))
typedef unsigned short bf16_t;
typedef short bf16x8 __attribute__((ext_vector_type(8)));
typedef float f32x4 __attribute__((ext_vector_type(4)));
typedef unsigned u32x4 __attribute__((ext_vector_type(4)));
constexpr int BM = 256, BK = 64, HALF = 128, HTB = HALF * BK * 2  , STAGE_BYTES = 8 * HTB, NXCD = 8, WGM = 8;

__host__ __device__ __forceinline__ int lds_byte(int r, int c) { const int st = (r >> 4) * 2 + (c >> 5), rr = r & 15, cc = c & 31, ob = rr * 64 + cc * 2; return st * 1024 + (ob ^ (((ob >> 9) & 1) << 5)); }
__host__ __device__ __forceinline__ void stage_rc(int b, int& R, int& C) { const int st = b / 1024, sb = b % 1024, swz = sb ^ (((sb >> 9) & 1) << 5); R = (st >> 1) * 16 + swz / 64; C = (st & 1) * 32 + (swz % 64) / 2; }
__host__ __device__ __forceinline__ int perm32(int rho) { const int n = rho >> 4, i = rho & 15; return 8 * (i >> 2) + 4 * n + (i & 3); }

struct Unit { int pm, pn, pb, e; };
struct Gemm { const bf16_t* A; const bf16_t* Bt; int M, N, K; };

struct StaticOrder {
    int nM, nN, nwg, G, c;
    __host__ __device__ void init(int M, int N, int G_, int c_) { nM = M / BM; nN = N / BM; nwg = nM * nN; G = G_; c = c_; }
    __host__ __device__ bool next(int i, Unit& u) const {
        const long L = (long)i * G + c; if (L >= nwg) return false;
        int wgid = (int)L; { const int q = nwg / NXCD, r = nwg % NXCD, xcd = wgid % NXCD, off = wgid / NXCD; wgid = (xcd < r ? xcd * (q + 1) : r * (q + 1) + (xcd - r) * q) + off; }
        const int nig = WGM * nN, gid = wgid / nig, fm = gid * WGM, gsz = (nM - fm) < WGM ? (nM - fm) : WGM;
        u.pm = fm + ((wgid % nig) % gsz); u.pn = (wgid % nig) / gsz; u.pb = u.pn; u.e = 0; return true;
    }
    __device__ __forceinline__ void a_ready(const Unit&) const {}
    __device__ __forceinline__ void done(const Unit&) const {}
};

__device__ __forceinline__ unsigned cvt_pk_bf16(float lo, float hi) { unsigned r; asm volatile("v_cvt_pk_bf16_f32 %0, %1, %2" : "=v"(r) : "v"(lo), "v"(hi)); return r; }
template <class Epi, class Sched, bool ALIGN_EPI = false, bool SP2 = false>
__device__ __forceinline__ void gemm_phase(PG8_LAS unsigned char* lds, const Gemm g, const Sched& S, const Epi& E) {
    const int tid = threadIdx.x, wid = __builtin_amdgcn_readfirstlane(tid >> 6), lane = tid & 63, wr = wid >> 2, wc = wid & 3, fr = lane & 15, fq = lane >> 4;
    const int K = g.K, nt = K / BK;
    unsigned voffA[2], voffB[2];
#pragma unroll
    for (int i = 0; i < 2; ++i) { int R, C; stage_rc(tid * 16 + i * 8192, R, C); const int Rb = Epi::PERM ? ((R & ~31) + perm32(R & 31)) : R;
        voffA[i] = (unsigned)(R * K + C) * 2u; voffB[i] = (unsigned)(Rb * K + C) * 2u; }
    const size_t kstep = (size_t)(BK * 2);
    const size_t hstep = (size_t)HALF * K * 2;
    const size_t tstep = 2 * hstep;
    const unsigned ldsw = (unsigned)wid * 1024u;
    const int aoff = lds_byte(wr * 64 + fr, fq * 8), boff = lds_byte(wc * 32 + fr, fq * 8);
#define PG8_SA(b, h) (((b) * 2 + (h)) * HTB)
#define PG8_SB(b, h) ((4 + (b) * 2 + (h)) * HTB)
#define PG8_STAGE(bufoff, gbase, voff) do { _Pragma("unroll") for (int _i = 0; _i < 2; ++_i) \
        __builtin_amdgcn_global_load_lds((const unsigned*)((const char*)(gbase) + (voff)[_i]), (PG8_LAS unsigned*)(lds + (bufoff) + ldsw + _i * 8192), 16, 0, 0); } while (0)
#define PG8_LDA(dst, b, h) do { _Pragma("unroll") for (int m = 0; m < 4; ++m) _Pragma("unroll") for (int k = 0; k < 2; ++k) dst[m][k] = *(const PG8_LAS bf16x8*)(lds + PG8_SA(b, h) + aoff + m * 2048 + k * 1024); } while (0)
#define PG8_LDB(dst, b, h) do { _Pragma("unroll") for (int n = 0; n < 2; ++n) _Pragma("unroll") for (int k = 0; k < 2; ++k) dst[n][k] = *(const PG8_LAS bf16x8*)(lds + PG8_SB(b, h) + boff + n * 2048 + k * 1024); } while (0)
#define PG8_MMA(ai, bj, At, Bt) do { __builtin_amdgcn_s_setprio(1); _Pragma("unroll") for (int m = 0; m < 4; ++m) _Pragma("unroll") for (int n = 0; n < 2; ++n) _Pragma("unroll") for (int k = 0; k < 2; ++k) \
        acc[ai][bj][m][n] = __builtin_amdgcn_mfma_f32_16x16x32_bf16(Bt[n][k], At[m][k], acc[ai][bj][m][n], 0, 0, 0); __builtin_amdgcn_s_setprio(0); } while (0)
#define PG8_WAIT_V(n) asm volatile("s_waitcnt vmcnt(" #n ")" ::: "memory")
#define PG8_WAIT_L(n) asm volatile("s_waitcnt lgkmcnt(" #n ")" ::: "memory")
#define PG8_BAR __builtin_amdgcn_s_barrier()
#define PG8_SCHED __builtin_amdgcn_sched_barrier(0)
    Unit cur = {0, 0, 0, 0}, nxt = {0, 0, 0, 0}; int ui = 0;
    if (!S.next(0, cur)) return;
    f32x4 acc[2][2][4][2];
#pragma unroll
    for (int a = 0; a < 2; ++a)
#pragma unroll
        for (int b = 0; b < 2; ++b)
#pragma unroll
            for (int m = 0; m < 4; ++m)
#pragma unroll
                for (int n = 0; n < 2; ++n) acc[a][b][m][n] = (f32x4){0.f, 0.f, 0.f, 0.f};
    bf16x8 At[4][2], B0[2][2], B1[2][2];
    const char* cA = (const char*)g.A + (size_t)cur.pm * tstep; const char* cB = (const char*)g.Bt + (size_t)cur.pb * tstep;
    S.a_ready(cur);
    if constexpr (SP2) {
        PG8_STAGE(PG8_SB(0, 0), cB, voffB); PG8_STAGE(PG8_SB(0, 1), cB + hstep, voffB); PG8_STAGE(PG8_SA(0, 0), cA, voffA); PG8_STAGE(PG8_SA(0, 1), cA + hstep, voffA);
        if (wr == 1) PG8_BAR;
        PG8_WAIT_V(2); PG8_BAR;
        PG8_STAGE(PG8_SB(1, 0), cB + kstep, voffB); PG8_STAGE(PG8_SA(1, 0), cA + kstep, voffA); PG8_STAGE(PG8_SB(1, 1), cB + hstep + kstep, voffB);
        PG8_WAIT_V(6); PG8_BAR;
    } else {
        PG8_STAGE(PG8_SB(0, 0), cB, voffB); PG8_STAGE(PG8_SA(0, 0), cA, voffA); PG8_STAGE(PG8_SB(0, 1), cB + hstep, voffB); PG8_STAGE(PG8_SA(0, 1), cA + hstep, voffA);
        if (wr == 1) PG8_BAR;
        PG8_WAIT_V(4); PG8_BAR;
        PG8_STAGE(PG8_SB(1, 0), cB + kstep, voffB); PG8_STAGE(PG8_SA(1, 0), cA + kstep, voffA); PG8_STAGE(PG8_SB(1, 1), cB + hstep + kstep, voffB);
        PG8_WAIT_V(6); PG8_BAR;
    }
    for (;;) {
        const bool has_next = S.next(ui + 1, nxt);
        const char* nA = has_next ? (const char*)g.A + (size_t)nxt.pm * tstep : cA; const char* nB = has_next ? (const char*)g.Bt + (size_t)nxt.pb * tstep : cB;
        for (int t = 0; t < nt; t += 2) {
            const bool last = (t == nt - 2);
            const char* a1 = cA + (size_t)(t + 1) * kstep;
            const char* a2 = last ? nA : cA + (size_t)(t + 2) * kstep; const char* b2 = last ? nB : cB + (size_t)(t + 2) * kstep;
            const char* a3 = a2 + kstep; const char* b3 = b2 + kstep;
            if (last && has_next) S.a_ready(nxt);
            if constexpr (SP2) {
            PG8_LDB(B0, 0, 0); PG8_LDB(B1, 0, 1); PG8_SCHED; PG8_LDA(At, 0, 0); PG8_STAGE(PG8_SA(1, 1), a1 + hstep, voffA);
            PG8_WAIT_V(8); PG8_WAIT_L(0); PG8_BAR; PG8_MMA(0, 0, At, B0); PG8_MMA(0, 1, At, B1); PG8_BAR; PG8_SCHED;
            PG8_LDA(At, 0, 1); PG8_STAGE(PG8_SB(0, 0), b2, voffB); PG8_STAGE(PG8_SB(0, 1), b2 + hstep, voffB); PG8_STAGE(PG8_SA(0, 0), a2, voffA);
            PG8_WAIT_V(8); PG8_WAIT_L(0); PG8_BAR; PG8_MMA(1, 0, At, B0); PG8_MMA(1, 1, At, B1); PG8_BAR; PG8_SCHED;
            PG8_LDB(B0, 1, 0); PG8_LDB(B1, 1, 1); PG8_SCHED; PG8_LDA(At, 1, 0); PG8_STAGE(PG8_SA(0, 1), a2 + hstep, voffA);
            PG8_WAIT_V(8); PG8_WAIT_L(0); PG8_BAR; PG8_MMA(0, 0, At, B0); PG8_MMA(0, 1, At, B1); PG8_BAR; PG8_SCHED;
            PG8_LDA(At, 1, 1); PG8_STAGE(PG8_SB(1, 0), b3, voffB); PG8_STAGE(PG8_SB(1, 1), b3 + hstep, voffB); PG8_STAGE(PG8_SA(1, 0), a3, voffA);
            PG8_WAIT_V(8); PG8_WAIT_L(0); PG8_BAR; PG8_MMA(1, 0, At, B0); PG8_MMA(1, 1, At, B1); PG8_BAR; PG8_SCHED;
            } else {
            PG8_LDB(B0, 0, 0); PG8_SCHED; PG8_LDA(At, 0, 0); PG8_STAGE(PG8_SA(1, 1), a1 + hstep, voffA);
            PG8_WAIT_L(8); PG8_BAR; PG8_WAIT_L(0); PG8_MMA(0, 0, At, B0); PG8_BAR; PG8_SCHED;
            PG8_LDB(B1, 0, 1); PG8_STAGE(PG8_SB(0, 0), b2, voffB);
            PG8_BAR; PG8_WAIT_L(0); PG8_MMA(0, 1, At, B1); PG8_BAR;
            PG8_LDA(At, 0, 1); PG8_STAGE(PG8_SA(0, 0), a2, voffA);
            PG8_BAR; PG8_WAIT_L(0); PG8_MMA(1, 0, At, B0); PG8_BAR; PG8_SCHED;
            PG8_STAGE(PG8_SB(0, 1), b2 + hstep, voffB);
            PG8_WAIT_V(6); PG8_BAR; PG8_MMA(1, 1, At, B1); PG8_BAR;
            PG8_LDB(B0, 1, 0); PG8_SCHED; PG8_LDA(At, 1, 0); PG8_STAGE(PG8_SA(0, 1), a2 + hstep, voffA);
            PG8_WAIT_L(8); PG8_BAR; PG8_WAIT_L(0); PG8_MMA(0, 0, At, B0); PG8_BAR; PG8_SCHED;
            PG8_LDB(B1, 1, 1); PG8_STAGE(PG8_SB(1, 0), b3, voffB);
            PG8_BAR; PG8_WAIT_L(0); PG8_MMA(0, 1, At, B1); PG8_BAR;
            PG8_LDA(At, 1, 1); PG8_STAGE(PG8_SA(1, 0), a3, voffA);
            PG8_BAR; PG8_WAIT_L(0); PG8_MMA(1, 0, At, B0); PG8_BAR; PG8_SCHED;
            PG8_STAGE(PG8_SB(1, 1), b3 + hstep, voffB);
            PG8_WAIT_V(6); PG8_BAR; PG8_MMA(1, 1, At, B1); PG8_BAR;
            }
        }
        if constexpr (ALIGN_EPI) { if (wr == 0) PG8_BAR; }
        if constexpr (!Epi::AFTER_DRAIN) { E(acc, cur, wr, wc, fr, fq); S.done(cur); }
        if (!has_next) break;
#pragma unroll
        for (int a = 0; a < 2; ++a)
#pragma unroll
            for (int b = 0; b < 2; ++b)
#pragma unroll
                for (int m = 0; m < 4; ++m)
#pragma unroll
                    for (int n = 0; n < 2; ++n) acc[a][b][m][n] = (f32x4){0.f, 0.f, 0.f, 0.f};
        cur = nxt; cA = nA; cB = nB; ++ui;
        if constexpr (ALIGN_EPI) { if (wr == 1) PG8_BAR; }
    }
    PG8_WAIT_V(0);
    if constexpr (!ALIGN_EPI) { if (wr == 0) PG8_BAR; }
    PG8_BAR;
    if constexpr (Epi::AFTER_DRAIN) { E.fused(acc, cur, wr, wc, fr, fq, lds, wid, lane); S.done(cur); }
#undef PG8_SA
#undef PG8_SB
#undef PG8_STAGE
#undef PG8_LDA
#undef PG8_LDB
#undef PG8_MMA
#undef PG8_WAIT_V
#undef PG8_WAIT_L
#undef PG8_BAR
#undef PG8_SCHED
}
typedef int v8i __attribute__((ext_vector_type(8)));
typedef int v4i __attribute__((ext_vector_type(4)));
constexpr int SCALE_W8 = 0x78787878, SCALE_A8 = 0x7f7f7f7f;
template <class Epi, class Sched, bool ALIGN_EPI = false, bool SP2 = false>
__device__ __forceinline__ void gemm_phase8(PG8_LAS unsigned char* lds, const Gemm g, const Sched& S, const Epi& E) {
    const int tid = threadIdx.x, wid = __builtin_amdgcn_readfirstlane(tid >> 6), lane = tid & 63, wr = wid >> 2, wc = wid & 3, fr = lane & 15, fq = lane >> 4;
    const int K = g.K, nt = K / BK;
    unsigned voffA[2], voffB[2];
#pragma unroll
    for (int i = 0; i < 2; ++i) { int R, C; stage_rc(tid * 16 + i * 8192, R, C); const int Rb = Epi::PERM ? ((R & ~31) + perm32(R & 31)) : R;
        voffA[i] = (unsigned)(R * K + C) * 2u; voffB[i] = (unsigned)(Rb * K + C) * 2u; }
    const size_t kstep = (size_t)(BK * 2);
    const size_t hstep = (size_t)HALF * K * 2;
    const size_t tstep = 2 * hstep;
    const unsigned ldsw = (unsigned)wid * 1024u;
    const int aoff = lds_byte(wr * 64 + fr, fq * 8), boff = lds_byte(wc * 32 + fr, fq * 8);
#define PG8_SA(b, h) (((b) * 2 + (h)) * HTB)
#define PG8_SB(b, h) ((4 + (b) * 2 + (h)) * HTB)
#define PG8_STAGE(bufoff, gbase, voff) do { _Pragma("unroll") for (int _i = 0; _i < 2; ++_i) \
        __builtin_amdgcn_global_load_lds((const unsigned*)((const char*)(gbase) + (voff)[_i]), (PG8_LAS unsigned*)(lds + (bufoff) + ldsw + _i * 8192), 16, 0, 0); } while (0)
#define PG8_LDA(dst, b, h) do { _Pragma("unroll") for (int m = 0; m < 4; ++m) { const v4i lo_ = *(const PG8_LAS v4i*)(lds + PG8_SA(b, h) + aoff + m * 2048), hi_ = *(const PG8_LAS v4i*)(lds + PG8_SA(b, h) + aoff + m * 2048 + 1024); \
        dst[m] = __builtin_shufflevector(lo_, hi_, 0, 1, 2, 3, 4, 5, 6, 7); } } while (0)
#define PG8_LDB(dst, b, h) do { _Pragma("unroll") for (int n = 0; n < 2; ++n) { const v4i lo_ = *(const PG8_LAS v4i*)(lds + PG8_SB(b, h) + boff + n * 2048), hi_ = *(const PG8_LAS v4i*)(lds + PG8_SB(b, h) + boff + n * 2048 + 1024); \
        dst[n] = __builtin_shufflevector(lo_, hi_, 0, 1, 2, 3, 4, 5, 6, 7); } } while (0)
#define PG8_MMA(ai, bj, At, Bt) do { __builtin_amdgcn_s_setprio(1); _Pragma("unroll") for (int m = 0; m < 4; ++m) _Pragma("unroll") for (int n = 0; n < 2; ++n) \
        asm volatile("v_mfma_scale_f32_16x16x128_f8f6f4 %0, %1, %2, %0, %3, %4 op_sel_hi:[0,0,0]" : "+v"(acc[ai][bj][m][n]) : "v"(Bt[n]), "v"(At[m]), "v"(sw8), "v"(sa8)); __builtin_amdgcn_s_setprio(0); } while (0)
#define PG8_WAIT_V(n) asm volatile("s_waitcnt vmcnt(" #n ")" ::: "memory")
#define PG8_WAIT_L(n) asm volatile("s_waitcnt lgkmcnt(" #n ")" ::: "memory")
#define PG8_BAR __builtin_amdgcn_s_barrier()
#define PG8_SCHED __builtin_amdgcn_sched_barrier(0)
    Unit cur = {0, 0, 0, 0}, nxt = {0, 0, 0, 0}; int ui = 0;
    if (!S.next(0, cur)) return;
    f32x4 acc[2][2][4][2];
#pragma unroll
    for (int a = 0; a < 2; ++a)
#pragma unroll
        for (int b = 0; b < 2; ++b)
#pragma unroll
            for (int m = 0; m < 4; ++m)
#pragma unroll
                for (int n = 0; n < 2; ++n) acc[a][b][m][n] = (f32x4){0.f, 0.f, 0.f, 0.f};
    v8i At[4], B0[2], B1[2]; int sw8 = SCALE_W8, sa8 = SCALE_A8;
    const char* cA = (const char*)g.A + (size_t)cur.pm * tstep; const char* cB = (const char*)g.Bt + (size_t)cur.pb * tstep;
    bool full = S.rows(cur) > HALF;
    S.a_ready(cur);
    if constexpr (SP2) {
        PG8_STAGE(PG8_SB(0, 0), cB, voffB); PG8_STAGE(PG8_SB(0, 1), cB + hstep, voffB); PG8_STAGE(PG8_SA(0, 0), cA, voffA); PG8_STAGE(PG8_SA(0, 1), cA + hstep, voffA);
        if (wr == 1) PG8_BAR;
        PG8_WAIT_V(2); PG8_BAR;
        PG8_STAGE(PG8_SB(1, 0), cB + kstep, voffB); PG8_STAGE(PG8_SA(1, 0), cA + kstep, voffA); PG8_STAGE(PG8_SB(1, 1), cB + hstep + kstep, voffB);
        PG8_WAIT_V(6); PG8_BAR;
    } else {
        PG8_STAGE(PG8_SB(0, 0), cB, voffB); PG8_STAGE(PG8_SA(0, 0), cA, voffA); PG8_STAGE(PG8_SB(0, 1), cB + hstep, voffB); PG8_STAGE(PG8_SA(0, 1), cA + hstep, voffA);
        if (wr == 1) PG8_BAR;
        PG8_WAIT_V(4); PG8_BAR;
        PG8_STAGE(PG8_SB(1, 0), cB + kstep, voffB); PG8_STAGE(PG8_SA(1, 0), cA + kstep, voffA); PG8_STAGE(PG8_SB(1, 1), cB + hstep + kstep, voffB);
        PG8_WAIT_V(6); PG8_BAR;
    }
    for (;;) {
        const bool has_next = S.next(ui + 1, nxt);
        const char* nA = has_next ? (const char*)g.A + (size_t)nxt.pm * tstep : cA; const char* nB = has_next ? (const char*)g.Bt + (size_t)nxt.pb * tstep : cB;
        for (int t = 0; t < nt; t += 2) {
            const bool last = (t == nt - 2);
            const char* a1 = cA + (size_t)(t + 1) * kstep;
            const char* a2 = last ? nA : cA + (size_t)(t + 2) * kstep; const char* b2 = last ? nB : cB + (size_t)(t + 2) * kstep;
            const char* a3 = a2 + kstep; const char* b3 = b2 + kstep;
            if (last && has_next) S.a_ready(nxt);
            if constexpr (SP2) {
            PG8_LDB(B0, 0, 0); PG8_LDB(B1, 0, 1); PG8_SCHED; PG8_LDA(At, 0, 0); PG8_STAGE(PG8_SA(1, 1), a1 + hstep, voffA);
            PG8_WAIT_V(8); PG8_WAIT_L(0); PG8_BAR; PG8_MMA(0, 0, At, B0); PG8_MMA(0, 1, At, B1); PG8_BAR; PG8_SCHED;
            if (full) PG8_LDA(At, 0, 1); PG8_STAGE(PG8_SB(0, 0), b2, voffB); PG8_STAGE(PG8_SB(0, 1), b2 + hstep, voffB); PG8_STAGE(PG8_SA(0, 0), a2, voffA);
            PG8_WAIT_V(8); PG8_WAIT_L(0); PG8_BAR; if (full) { PG8_MMA(1, 0, At, B0); PG8_MMA(1, 1, At, B1); } PG8_BAR; PG8_SCHED;
            PG8_LDB(B0, 1, 0); PG8_LDB(B1, 1, 1); PG8_SCHED; PG8_LDA(At, 1, 0); PG8_STAGE(PG8_SA(0, 1), a2 + hstep, voffA);
            PG8_WAIT_V(8); PG8_WAIT_L(0); PG8_BAR; PG8_MMA(0, 0, At, B0); PG8_MMA(0, 1, At, B1); PG8_BAR; PG8_SCHED;
            if (full) PG8_LDA(At, 1, 1); PG8_STAGE(PG8_SB(1, 0), b3, voffB); PG8_STAGE(PG8_SB(1, 1), b3 + hstep, voffB); PG8_STAGE(PG8_SA(1, 0), a3, voffA);
            PG8_WAIT_V(8); PG8_WAIT_L(0); PG8_BAR; if (full) { PG8_MMA(1, 0, At, B0); PG8_MMA(1, 1, At, B1); } PG8_BAR; PG8_SCHED;
            } else {
            PG8_LDB(B0, 0, 0); PG8_SCHED; PG8_LDA(At, 0, 0); PG8_STAGE(PG8_SA(1, 1), a1 + hstep, voffA);
            PG8_WAIT_L(8); PG8_BAR; PG8_WAIT_L(0); PG8_MMA(0, 0, At, B0); PG8_BAR; PG8_SCHED;
            PG8_LDB(B1, 0, 1); PG8_STAGE(PG8_SB(0, 0), b2, voffB);
            PG8_BAR; PG8_WAIT_L(0); PG8_MMA(0, 1, At, B1); PG8_BAR;
            PG8_LDA(At, 0, 1); PG8_STAGE(PG8_SA(0, 0), a2, voffA);
            PG8_BAR; PG8_WAIT_L(0); PG8_MMA(1, 0, At, B0); PG8_BAR; PG8_SCHED;
            PG8_STAGE(PG8_SB(0, 1), b2 + hstep, voffB);
            PG8_WAIT_V(6); PG8_BAR; PG8_MMA(1, 1, At, B1); PG8_BAR;
            PG8_LDB(B0, 1, 0); PG8_SCHED; PG8_LDA(At, 1, 0); PG8_STAGE(PG8_SA(0, 1), a2 + hstep, voffA);
            PG8_WAIT_L(8); PG8_BAR; PG8_WAIT_L(0); PG8_MMA(0, 0, At, B0); PG8_BAR; PG8_SCHED;
            PG8_LDB(B1, 1, 1); PG8_STAGE(PG8_SB(1, 0), b3, voffB);
            PG8_BAR; PG8_WAIT_L(0); PG8_MMA(0, 1, At, B1); PG8_BAR;
            PG8_LDA(At, 1, 1); PG8_STAGE(PG8_SA(1, 0), a3, voffA);
            PG8_BAR; PG8_WAIT_L(0); PG8_MMA(1, 0, At, B0); PG8_BAR; PG8_SCHED;
            PG8_STAGE(PG8_SB(1, 1), b3 + hstep, voffB);
            PG8_WAIT_V(6); PG8_BAR; PG8_MMA(1, 1, At, B1); PG8_BAR;
            }
        }
        if constexpr (ALIGN_EPI) { if (wr == 0) PG8_BAR; }
        asm volatile("s_nop 15\n\ts_nop 7" ::: "memory");
        if constexpr (!Epi::AFTER_DRAIN) { E(acc, cur, wr, wc, fr, fq); S.done(cur); }
        if (!has_next) break;
#pragma unroll
        for (int a = 0; a < 2; ++a)
#pragma unroll
            for (int b = 0; b < 2; ++b)
#pragma unroll
                for (int m = 0; m < 4; ++m)
#pragma unroll
                    for (int n = 0; n < 2; ++n) acc[a][b][m][n] = (f32x4){0.f, 0.f, 0.f, 0.f};
        cur = nxt; full = S.rows(cur) > HALF; cA = nA; cB = nB; ++ui;
        if constexpr (ALIGN_EPI) { if (wr == 1) PG8_BAR; }
    }
    PG8_WAIT_V(0);
    if constexpr (!ALIGN_EPI) { if (wr == 0) PG8_BAR; }
    PG8_BAR;
    if constexpr (Epi::AFTER_DRAIN) { E.fused(acc, cur, wr, wc, fr, fq, lds, wid, lane); S.done(cur); }
#undef PG8_SA
#undef PG8_SB
#undef PG8_STAGE
#undef PG8_LDA
#undef PG8_LDB
#undef PG8_MMA
#undef PG8_WAIT_V
#undef PG8_WAIT_L
#undef PG8_BAR
#undef PG8_SCHED
}
template <class Epi, class Sched, bool ALIGN_EPI = false, bool SP2 = false>
__device__ __forceinline__ void gemm_phase8g(PG8_LAS unsigned char* lds, const Gemm g, const Sched& S, const Epi& E, const PG8_LAS int* rowc) {
    static_assert(SP2, "gathered-A variant: SP2 loop only");
    const int tid = threadIdx.x, wid = __builtin_amdgcn_readfirstlane(tid >> 6), lane = tid & 63, wr = wid >> 2, wc = wid & 3, fr = lane & 15, fq = lane >> 4;
    const int K = g.K, nt = K / BK;
    unsigned voffA[2], voffB[2];
#pragma unroll
    for (int i = 0; i < 2; ++i) { int R, C; stage_rc(tid * 16 + i * 8192, R, C); const int Rb = Epi::PERM ? ((R & ~31) + perm32(R & 31)) : R;
        voffA[i] = (unsigned)(R * K + C) * 2u; voffB[i] = (unsigned)(Rb * K + C) * 2u; }
    int RA[2], CA[2];
#pragma unroll
    for (int i = 0; i < 2; ++i) stage_rc(tid * 16 + i * 8192, RA[i], CA[i]);
    const unsigned rowB = (unsigned)K * 2u;
#define PG8_GOFF(dst, ui_) do { _Pragma("unroll") for (int h_ = 0; h_ < 2; ++h_) _Pragma("unroll") for (int i_ = 0; i_ < 2; ++i_) dst[h_][i_] = (unsigned)rowc[(ui_) * 256 + h_ * HALF + RA[i_]] * rowB + (unsigned)CA[i_] * 2u; } while (0)
    const size_t kstep = (size_t)(BK * 2);
    const size_t hstep = (size_t)HALF * K * 2;
    const size_t tstep = 2 * hstep;
    const unsigned ldsw = (unsigned)wid * 1024u;
    const int aoff = lds_byte(wr * 64 + fr, fq * 8), boff = lds_byte(wc * 32 + fr, fq * 8);
#define PG8_SA(b, h) (((b) * 2 + (h)) * HTB)
#define PG8_SB(b, h) ((4 + (b) * 2 + (h)) * HTB)
#define PG8_STAGE(bufoff, gbase, voff) do { _Pragma("unroll") for (int _i = 0; _i < 2; ++_i) \
        __builtin_amdgcn_global_load_lds((const unsigned*)((const char*)(gbase) + (voff)[_i]), (PG8_LAS unsigned*)(lds + (bufoff) + ldsw + _i * 8192), 16, 0, 0); } while (0)
#define PG8_LDA(dst, b, h) do { _Pragma("unroll") for (int m = 0; m < 4; ++m) { const v4i lo_ = *(const PG8_LAS v4i*)(lds + PG8_SA(b, h) + aoff + m * 2048), hi_ = *(const PG8_LAS v4i*)(lds + PG8_SA(b, h) + aoff + m * 2048 + 1024); \
        dst[m] = __builtin_shufflevector(lo_, hi_, 0, 1, 2, 3, 4, 5, 6, 7); } } while (0)
#define PG8_LDB(dst, b, h) do { _Pragma("unroll") for (int n = 0; n < 2; ++n) { const v4i lo_ = *(const PG8_LAS v4i*)(lds + PG8_SB(b, h) + boff + n * 2048), hi_ = *(const PG8_LAS v4i*)(lds + PG8_SB(b, h) + boff + n * 2048 + 1024); \
        dst[n] = __builtin_shufflevector(lo_, hi_, 0, 1, 2, 3, 4, 5, 6, 7); } } while (0)
#define PG8_MMA(ai, bj, At, Bt) do { __builtin_amdgcn_s_setprio(1); _Pragma("unroll") for (int m = 0; m < 4; ++m) _Pragma("unroll") for (int n = 0; n < 2; ++n) \
        asm volatile("v_mfma_scale_f32_16x16x128_f8f6f4 %0, %1, %2, %0, %3, %4 op_sel_hi:[0,0,0]" : "+v"(acc[ai][bj][m][n]) : "v"(Bt[n]), "v"(At[m]), "v"(sw8), "v"(sa8)); __builtin_amdgcn_s_setprio(0); } while (0)
#define PG8_WAIT_V(n) asm volatile("s_waitcnt vmcnt(" #n ")" ::: "memory")
#define PG8_WAIT_L(n) asm volatile("s_waitcnt lgkmcnt(" #n ")" ::: "memory")
#define PG8_BAR __builtin_amdgcn_s_barrier()
#define PG8_SCHED __builtin_amdgcn_sched_barrier(0)
    Unit cur = {0, 0, 0, 0}, nxt = {0, 0, 0, 0}; int ui = 0;
    if (!S.next(0, cur)) return;
    f32x4 acc[2][2][4][2];
#pragma unroll
    for (int a = 0; a < 2; ++a)
#pragma unroll
        for (int b = 0; b < 2; ++b)
#pragma unroll
            for (int m = 0; m < 4; ++m)
#pragma unroll
                for (int n = 0; n < 2; ++n) acc[a][b][m][n] = (f32x4){0.f, 0.f, 0.f, 0.f};
    v8i At[4], B0[2], B1[2]; int sw8 = SCALE_W8, sa8 = SCALE_A8;
    const char* gA = (const char*)g.A; const char* cB = (const char*)g.Bt + (size_t)cur.pb * tstep;
    unsigned cgA[2][2], ngA[2][2]; PG8_GOFF(cgA, 0);
    bool full = S.rows(cur) > HALF;
    S.a_ready(cur);
    if constexpr (SP2) {
        PG8_STAGE(PG8_SB(0, 0), cB, voffB); PG8_STAGE(PG8_SB(0, 1), cB + hstep, voffB); PG8_STAGE(PG8_SA(0, 0), gA, cgA[0]); PG8_STAGE(PG8_SA(0, 1), gA, cgA[1]);
        if (wr == 1) PG8_BAR;
        PG8_WAIT_V(2); PG8_BAR;
        PG8_STAGE(PG8_SB(1, 0), cB + kstep, voffB); PG8_STAGE(PG8_SA(1, 0), gA + kstep, cgA[0]); PG8_STAGE(PG8_SB(1, 1), cB + hstep + kstep, voffB);
        PG8_WAIT_V(6); PG8_BAR;
    } else {
    }
    for (;;) {
        const bool has_next = S.next(ui + 1, nxt);
        const char* nB = has_next ? (const char*)g.Bt + (size_t)nxt.pb * tstep : cB;
        if (has_next) PG8_GOFF(ngA, ui + 1); else { _Pragma("unroll") for (int h_ = 0; h_ < 2; ++h_) _Pragma("unroll") for (int i_ = 0; i_ < 2; ++i_) ngA[h_][i_] = cgA[h_][i_]; }
        for (int t = 0; t < nt; t += 2) {
            const bool last = (t == nt - 2);
            const char* a1 = gA + (size_t)(t + 1) * kstep;
            const char* a2 = gA + (last ? (size_t)0 : (size_t)(t + 2) * kstep); const char* b2 = last ? nB : cB + (size_t)(t + 2) * kstep;
            unsigned sgA[2][2];
#pragma unroll
            for (int h_ = 0; h_ < 2; ++h_)
#pragma unroll
                for (int i_ = 0; i_ < 2; ++i_) sgA[h_][i_] = last ? ngA[h_][i_] : cgA[h_][i_];
            const char* a3 = a2 + kstep; const char* b3 = b2 + kstep;
            if (last && has_next) S.a_ready(nxt);
            if constexpr (SP2) {
            PG8_LDB(B0, 0, 0); PG8_LDB(B1, 0, 1); PG8_SCHED; PG8_LDA(At, 0, 0); PG8_STAGE(PG8_SA(1, 1), a1, cgA[1]);
            PG8_WAIT_V(8); PG8_WAIT_L(0); PG8_BAR; PG8_MMA(0, 0, At, B0); PG8_MMA(0, 1, At, B1); PG8_BAR; PG8_SCHED;
            if (full) PG8_LDA(At, 0, 1); PG8_STAGE(PG8_SB(0, 0), b2, voffB); PG8_STAGE(PG8_SB(0, 1), b2 + hstep, voffB); PG8_STAGE(PG8_SA(0, 0), a2, sgA[0]);
            PG8_WAIT_V(8); PG8_WAIT_L(0); PG8_BAR; if (full) { PG8_MMA(1, 0, At, B0); PG8_MMA(1, 1, At, B1); } PG8_BAR; PG8_SCHED;
            PG8_LDB(B0, 1, 0); PG8_LDB(B1, 1, 1); PG8_SCHED; PG8_LDA(At, 1, 0); PG8_STAGE(PG8_SA(0, 1), a2, sgA[1]);
            PG8_WAIT_V(8); PG8_WAIT_L(0); PG8_BAR; PG8_MMA(0, 0, At, B0); PG8_MMA(0, 1, At, B1); PG8_BAR; PG8_SCHED;
            if (full) PG8_LDA(At, 1, 1); PG8_STAGE(PG8_SB(1, 0), b3, voffB); PG8_STAGE(PG8_SB(1, 1), b3 + hstep, voffB); PG8_STAGE(PG8_SA(1, 0), a3, sgA[0]);
            PG8_WAIT_V(8); PG8_WAIT_L(0); PG8_BAR; if (full) { PG8_MMA(1, 0, At, B0); PG8_MMA(1, 1, At, B1); } PG8_BAR; PG8_SCHED;
            }
        }
        if constexpr (ALIGN_EPI) { if (wr == 0) PG8_BAR; }
        asm volatile("s_nop 15\n\ts_nop 7" ::: "memory");
        if constexpr (!Epi::AFTER_DRAIN) { E(acc, cur, wr, wc, fr, fq); S.done(cur); }
        if (!has_next) break;
#pragma unroll
        for (int a = 0; a < 2; ++a)
#pragma unroll
            for (int b = 0; b < 2; ++b)
#pragma unroll
                for (int m = 0; m < 4; ++m)
#pragma unroll
                    for (int n = 0; n < 2; ++n) acc[a][b][m][n] = (f32x4){0.f, 0.f, 0.f, 0.f};
        cur = nxt; full = S.rows(cur) > HALF; cB = nB; ++ui;
#pragma unroll
        for (int h_ = 0; h_ < 2; ++h_)
#pragma unroll
            for (int i_ = 0; i_ < 2; ++i_) cgA[h_][i_] = ngA[h_][i_];
        if constexpr (ALIGN_EPI) { if (wr == 1) PG8_BAR; }
    }
    PG8_WAIT_V(0);
    if constexpr (!ALIGN_EPI) { if (wr == 0) PG8_BAR; }
    PG8_BAR;
    if constexpr (Epi::AFTER_DRAIN) { E.fused(acc, cur, wr, wc, fr, fq, lds, wid, lane); S.done(cur); }
#undef PG8_GOFF
#undef PG8_SA
#undef PG8_SB
#undef PG8_STAGE
#undef PG8_LDA
#undef PG8_LDB
#undef PG8_MMA
#undef PG8_WAIT_V
#undef PG8_WAIT_L
#undef PG8_BAR
#undef PG8_SCHED
}
}
#define GAS __attribute__((address_space(1)))
#define LAS __attribute__((address_space(3)))
typedef unsigned short bf16;
typedef unsigned v4u __attribute__((ext_vector_type(4)));
typedef float f32x4 __attribute__((ext_vector_type(4)));
typedef short bf16x8 __attribute__((ext_vector_type(8)));
typedef GAS unsigned gu32;
typedef GAS unsigned long long gu64;
#define RLX_AGENT __ATOMIC_RELAXED, __HIP_MEMORY_SCOPE_AGENT
#define LDS_WAIT() asm volatile("s_waitcnt lgkmcnt(0)" ::: "memory")
#define VM_WAIT() asm volatile("s_waitcnt vmcnt(0)" ::: "memory")
__device__ __forceinline__ unsigned long long rt() { return __builtin_amdgcn_s_memrealtime(); }
__device__ __forceinline__ unsigned f2bf(float f) { unsigned u = __builtin_bit_cast(unsigned, f); return (u + 0x7fffu + ((u >> 16) & 1u)) >> 16; }
__device__ __forceinline__ unsigned pk2(float lo, float hi) { return f2bf(lo) | (f2bf(hi) << 16); }

#define XB_TMO      128
#define XB_XCNT(j)  (256  + 64 * (j))
#define XB_XSUB(j)  (1280 + 64 * (j))
#define XB_XGEN(j)  (2304 + 64 * (j))
#define XB_TOP      3328
#define XB_TOPGEN   3392
#define XCD_BAR_WORDS 3456
#define XB_SPIN_CAP (1u << 18)

__device__ __forceinline__ unsigned xb_ld(unsigned* p)              { return __hip_atomic_load(p, __ATOMIC_RELAXED, __HIP_MEMORY_SCOPE_AGENT); }
__device__ __forceinline__ unsigned xb_add(unsigned* p, unsigned v) { return __hip_atomic_fetch_add(p, v, __ATOMIC_RELAXED, __HIP_MEMORY_SCOPE_AGENT); }
__device__ __forceinline__ unsigned xb_xcc_id() { return (unsigned)__builtin_amdgcn_s_getreg((3 << 11) | 20) & 0xFu; }
#define XB_SPIN(cond, bar) do { unsigned _sp = 0; while (cond) { __builtin_amdgcn_s_sleep(1); \
    if ((++_sp & 255u) == 0u) { if (xb_ld(&(bar)[XB_TMO])) break; if (_sp > XB_SPIN_CAP) { atomicAdd(&(bar)[XB_TMO], 1u); break; } } } } while (0)

struct XcdBarrier {
    unsigned* bar; unsigned x;
    volatile LAS unsigned* st;
};

__device__ __forceinline__ XcdBarrier xcd_barrier_post(unsigned* bar, volatile LAS unsigned* st) {
    XcdBarrier b; b.bar = bar; b.x = xb_xcc_id(); b.st = st;
    if (threadIdx.x == 0) (void)xb_add(&bar[XB_XCNT(b.x)], 1u);
    return b;
}
__device__ __forceinline__ void xcd_barrier_complete(unsigned* bar, unsigned x, unsigned& nloc, unsigned& nx) {
    const unsigned G = gridDim.x * gridDim.y * gridDim.z;
    unsigned sum, cnt, mine, sp = 0u;
    for (;;) {
        sum = 0u; cnt = 0u; mine = 0u;
#pragma unroll
        for (unsigned j = 0; j < 16; ++j) { const unsigned c = xb_ld(&bar[XB_XCNT(j)]); sum += c; cnt += (c > 0u) ? 1u : 0u; mine = (j == x) ? c : mine; }
        if (sum == G) break;
        __builtin_amdgcn_s_sleep(1);
        if ((++sp & 255u) == 0u) { if (xb_ld(&bar[XB_TMO])) break; if (sp > XB_SPIN_CAP) { atomicAdd(&bar[XB_TMO], 1u); break; } }
    }
    nloc = mine > 0u ? mine : 1u; nx = cnt > 0u ? cnt : 1u;
}

__device__ __forceinline__ void xcd_barrier(const XcdBarrier& b) {
    asm volatile("s_waitcnt vmcnt(0)" ::: "memory");
    __syncthreads();
    if (threadIdx.x == 0) {
        unsigned* bar = b.bar;
        __builtin_amdgcn_s_waitcnt(0);
        unsigned nloc = b.st[0], nx = b.st[1];
        if (nloc == 0u) { xcd_barrier_complete(bar, b.x, nloc, nx); b.st[0] = nloc; b.st[1] = nx; }
        const unsigned old = xb_add(&bar[XB_XSUB(b.x)], 1u);
        const unsigned gen = old / nloc;
        if (old + 1u == (gen + 1u) * nloc) {
            __builtin_amdgcn_fence(__ATOMIC_RELEASE, "agent");
            asm volatile("s_waitcnt vmcnt(0)" ::: "memory");
            const unsigned og = xb_add(&bar[XB_TOP], 1u);
            const unsigned tg = og / nx;
            if (og + 1u == (tg + 1u) * nx) xb_add(&bar[XB_TOPGEN], 1u);
            else XB_SPIN(xb_ld(&bar[XB_TOPGEN]) == tg, bar);
            __builtin_amdgcn_fence(__ATOMIC_ACQUIRE, "agent");
            xb_add(&bar[XB_XGEN(b.x)], 1u);
            asm volatile("s_waitcnt vmcnt(0)" ::: "memory");
        } else {
            XB_SPIN(xb_ld(&bar[XB_XGEN(b.x)]) == gen, bar);
            __builtin_amdgcn_fence(__ATOMIC_ACQUIRE, "agent");
            asm volatile("s_waitcnt vmcnt(0)" ::: "memory");
        }
    }
    __syncthreads();
}
namespace mk {
constexpr int S = 8192, D = 2048, NPROJ = 6160, NPP = 6144, NPAD = 6400, NE = 32, FF = 2048, NWAVES = 8, NTHR = 512;
constexpr int C_MQ = 0, C_MK = 512, C_MV = 1024, C_MO = 2048, C_FQ = 3072, C_FK = 4096, C_FV = 5120;
constexpr int MAXROWS = S * 4 + NE * 256;
constexpr int NCH = 128, LCH = 64;
constexpr size_t MiB = 1u << 20;
constexpr size_t WS_CTL = 0, CTL_ZERO_BYTES = 1 * MiB;
constexpr size_t WS_MODP = 14 * MiB;
constexpr size_t WS_MOD = 2 * MiB;
constexpr size_t WS_GATES = 3 * MiB;
constexpr size_t WS_F = 4 * MiB;
constexpr size_t WS_NL = 5 * MiB;
constexpr size_t WS_NS = 6 * MiB;
constexpr size_t WS_GLAL = 7 * MiB;
constexpr size_t WS_MS = 7 * MiB + 65536;
constexpr size_t WS_TOPI = 8 * MiB;
constexpr size_t WS_TOPW = 9 * MiB;
constexpr size_t WS_HIST = 10 * MiB;
constexpr size_t WS_LRANK = 11 * MiB;
constexpr size_t WS_POS = 12 * MiB;
constexpr size_t WS_ROWW = 13 * MiB;
constexpr size_t WS_ROWTOK = 13 * MiB + 512 * 1024;
constexpr size_t WS_WIN = 16 * MiB;
constexpr size_t WS_WOUT = 42 * MiB;
constexpr size_t WS_HN = 50 * MiB;
constexpr size_t WS_PROJ = 82 * MiB;
constexpr size_t WS_UL = 178 * MiB;
constexpr size_t WS_CS = 242 * MiB;
constexpr size_t WS_CONCAT = 274 * MiB;
constexpr size_t WS_H1 = 306 * MiB;
constexpr size_t WS_XG = 370 * MiB;
constexpr size_t WS_ACT = 530 * MiB;
constexpr size_t WS_Y = 690 * MiB;
constexpr size_t WS_WUG = 850 * MiB;
constexpr size_t WS_WD = 1362 * MiB;
constexpr size_t WS_OPART = 1618 * MiB;
constexpr size_t WS_MLP = 1786 * MiB;
constexpr size_t WS_JLO = 1789 * MiB;
constexpr size_t WS_END = 1790 * MiB;
constexpr size_t WS_NAIVE = 1792 * MiB;
constexpr int CW_TMO = 0, CW_CODE = 1, CW_CONV = 65536, CW_DONE = 2048, CW_BAR = 4096;
constexpr int GC_INPROJ = 160, GC_ATTN = 120, GC_PREP = 192;
constexpr int RING_OFF = 0, RING_BYTES = 131072;
constexpr int LDSCTL_OFF = RING_BYTES, MISC_OFF = LDSCTL_OFF + 320;
constexpr int TAB_OFF = LDSCTL_OFF + 1024;
constexpr int ROWC_MAX = 13;
constexpr int ATT_CH = 16;
constexpr int LDS_BYTES = 147456;
static_assert(GC_INPROJ <= 248 && GC_INPROJ % 8 == 0 && GC_ATTN % 8 == 0, "compute groups: multiples of 8; the in-proj group leaves slot 31 to the forget-gate scans");
}
namespace mk {
typedef float f32x2 __attribute__((ext_vector_type(2)));
typedef unsigned u32x2 __attribute__((ext_vector_type(2)));
struct Frame {
    LAS unsigned char* lds;
    volatile LAS unsigned* MISC;
    gu32* ctl;
    int tid, lane, wave, vcu, G, bid;
    const float* in[24];
    float* out; unsigned char* ws;
};
#define IN_X 0
#define IN_C 1
#define IN_WADA 2
#define IN_BADA 3
#define IN_NMIX 4
#define IN_WIN 5
#define IN_BI 6
#define IN_BF 7
#define IN_FOXBF 8
#define IN_FOXQN 9
#define IN_FOXKN 10
#define IN_MOUTN 11
#define IN_FOUTN 12
#define IN_WOUT 13
#define IN_NFFN 14
#define IN_WR 15
#define IN_BR 16
#define IN_WUG 17
#define IN_BUG 18
#define IN_WD 19
#define IN_BD 20
#define IN_WAF 21
#define IN_BAF 22
#define IN_NFIN 23
template <class T> __device__ __forceinline__ T* wsp(const Frame& F, size_t off) { return (T*)(F.ws + off); }
__device__ __forceinline__ float wave_sum(float v) {
#pragma unroll
    for (int o = 1; o < 64; o <<= 1) v += __shfl_xor(v, o);
    return v;
}
__device__ __forceinline__ float sigmoid_f(float v) { return 1.f / (1.f + __expf(-v)); }
__device__ __forceinline__ float log_sigmoid_f(float v) { return fminf(v, 0.f) - log1pf(__expf(-fabsf(v))); }
__device__ __forceinline__ float softcap_f(float v) { return 15.f * tanhf(v * (1.f / 15.f)); }
__device__ __forceinline__ float bf2f(unsigned short b) { return __uint_as_float(((unsigned)b) << 16); }

struct CvtItem { const float* src; bf16* dst; };
__device__ __forceinline__ void cvt_load(const CvtItem& it, int ldw, f32x4 (&v)[16], int lane) {
    const float* p = it.src + (size_t)((lane >> 4) * 16) * ldw + (lane & 15) * 4;
#pragma unroll
    for (int i = 0; i < 16; ++i) v[i] = __builtin_nontemporal_load((const GAS f32x4*)(p + (size_t)i * ldw));
}
__device__ __forceinline__ void cvt_store(const CvtItem& it, int K, const f32x4 (&v)[16], LAS unsigned char* scr, int lane) {
    const int c = lane & 15, g = lane >> 4;
#pragma unroll
    for (int j = 0; j < 4; ++j) {
        v4u a, b;
        a.x = pk2(v[0][j], v[1][j]); a.y = pk2(v[2][j], v[3][j]); a.z = pk2(v[4][j], v[5][j]); a.w = pk2(v[6][j], v[7][j]);
        b.x = pk2(v[8][j], v[9][j]); b.y = pk2(v[10][j], v[11][j]); b.z = pk2(v[12][j], v[13][j]); b.w = pk2(v[14][j], v[15][j]);
        LAS unsigned char* q = scr + (4 * c + j) * 144 + 32 * g;
        *(LAS v4u*)q = a; *(LAS v4u*)(q + 16) = b; }
    LDS_WAIT(); asm volatile("" ::: "memory");
#pragma unroll
    for (int i = 0; i < 8; ++i) { const int row = (lane >> 3) + 8 * i; const v4u o = *(const LAS v4u*)(scr + row * 144 + (lane & 7) * 16);
        *(GAS v4u*)(it.dst + (size_t)row * K + (lane & 7) * 8) = o; }
    LDS_WAIT(); asm volatile("" ::: "memory");
}
__device__ __forceinline__ unsigned pk4_fp8(float a, float b, float c, float d) { int r = __builtin_amdgcn_cvt_pk_fp8_f32(a, b, 0, false); r = __builtin_amdgcn_cvt_pk_fp8_f32(c, d, r, true); return (unsigned)r; }
constexpr float W8S = 128.f;
__device__ __forceinline__ void cvt8_pack(const f32x4 (&v)[16], LAS unsigned char* scr, int half, int lane) {
    const int c = lane & 15, g = lane >> 4;
#pragma unroll
    for (int j = 0; j < 4; ++j) { v4u a;
        a.x = pk4_fp8(v[0][j] * W8S, v[1][j] * W8S, v[2][j] * W8S, v[3][j] * W8S); a.y = pk4_fp8(v[4][j] * W8S, v[5][j] * W8S, v[6][j] * W8S, v[7][j] * W8S);
        a.z = pk4_fp8(v[8][j] * W8S, v[9][j] * W8S, v[10][j] * W8S, v[11][j] * W8S); a.w = pk4_fp8(v[12][j] * W8S, v[13][j] * W8S, v[14][j] * W8S, v[15][j] * W8S);
        *(LAS v4u*)(scr + (4 * c + j) * 144 + half * 64 + 16 * g) = a; }
}
__device__ __forceinline__ void cvt8_flush(unsigned char* dst, int kbytes, LAS unsigned char* scr, int lane) {
    LDS_WAIT(); asm volatile("" ::: "memory");
#pragma unroll
    for (int i = 0; i < 8; ++i) { const int row = (lane >> 3) + 8 * i; const v4u o = *(const LAS v4u*)(scr + row * 144 + (lane & 7) * 16);
        __builtin_nontemporal_store(o, (GAS v4u*)(dst + (size_t)row * kbytes + (lane & 7) * 16)); }
    LDS_WAIT(); asm volatile("" ::: "memory");
}
constexpr int CV8_UG = NE * 16 * 64, CV8_D = NE * 16 * 32, CV8_TOTAL = CV8_UG + CV8_D;
struct Cvt8Item { const float* src; unsigned char* dst; int ldw; };
__device__ __forceinline__ Cvt8Item cvt8_item(const Frame& F, int it, int half) {
    Cvt8Item r;
    if (it < CV8_UG) { const int e = it >> 10, q = it & 1023, kb = q >> 6, nb = q & 63, d0 = nb * 64, j = d0 >> 8, wv = d0 & 255, sc = wv < 128 ? 128 * j + wv : 2048 + 128 * j + (wv - 128);
        r.ldw = 4096; r.src = F.in[IN_WUG] + (size_t)e * D * 4096 + (size_t)(kb * 128 + half * 64) * 4096 + sc; r.dst = wsp<unsigned char>(F, WS_WUG) + (size_t)e * 4096 * D + (size_t)d0 * D + kb * 128; return r; }
    it -= CV8_UG;
    { const int e = it >> 9, q = it & 511, kb = q >> 5, nb = q & 31;
        r.ldw = D; r.src = F.in[IN_WD] + (size_t)e * FF * D + (size_t)(kb * 128 + half * 64) * D + nb * 64; r.dst = wsp<unsigned char>(F, WS_WD) + (size_t)e * D * FF + (size_t)(nb * 64) * FF + kb * 128; return r; }
}
__device__ __forceinline__ void cvt8_load(const Cvt8Item& it, f32x4 (&v)[16], int lane) {
    const float* p = it.src + (size_t)((lane >> 4) * 16) * it.ldw + (lane & 15) * 4;
#pragma unroll
    for (int i = 0; i < 16; ++i) v[i] = __builtin_nontemporal_load((const GAS f32x4*)(p + (size_t)i * it.ldw));
}
constexpr int CV_IN = 32 * 96, CV_OUT = 32 * 32, CV_TOTAL = CV_IN + CV_OUT;
__device__ __forceinline__ CvtItem cvt_item(const Frame& F, int it, int& ldw, int& K) {
    CvtItem r;
    if (it < CV_IN) { const int kb = it / 96, nb = it % 96, d0 = nb * 64, sc = d0 < 3072 ? d0 : d0 + 8;
        ldw = NPROJ; K = D; r.src = F.in[IN_WIN] + (size_t)(kb * 64) * NPROJ + sc; r.dst = wsp<bf16>(F, WS_WIN) + (size_t)d0 * D + kb * 64; return r; }
    it -= CV_IN;
    { const int kb = it >> 5, nb = it & 31; ldw = D; K = D; r.src = F.in[IN_WOUT] + (size_t)(kb * 64) * D + nb * 64; r.dst = wsp<bf16>(F, WS_WOUT) + (size_t)(nb * 64) * D + kb * 64; return r; }
}
__device__ __forceinline__ void p1_convert(Frame& F, int first);
__device__ __forceinline__ void p0_gemv(Frame& F) {
    const int gw = F.vcu * NWAVES + F.wave, NGW = F.G * NWAVES, lane = F.lane;
    int cldw = 0, cK = 0; CvtItem c0 = {nullptr, nullptr}; f32x4 cva[16];
    if (gw < CV_TOTAL) { c0 = cvt_item(F, gw, cldw, cK); cvt_load(c0, cldw, cva, lane); }
    {
        const float* c = F.in[IN_C]; float* modp = wsp<float>(F, WS_MODP);
        for (int task = gw; task < 2048; task += NGW) {
            const int cg = task & 63, ks = task >> 6, j = cg * 256 + 4 * lane;
            const float* w; int ld, col;
            if (j < 6 * D) { w = F.in[IN_WADA]; ld = 6 * D; col = j; } else { w = F.in[IN_WAF]; ld = 2 * D; col = j - 6 * D; }
            const float c0 = c[ks * 64 + lane]; const float s0 = c0 * sigmoid_f(c0);
            const float* wp = w + (size_t)(ks * 64) * ld + col; f32x4 acc = {0.f, 0.f, 0.f, 0.f};
#pragma unroll 16
            for (int i = 0; i < 64; ++i) acc += __builtin_nontemporal_load((const GAS f32x4*)(wp + (size_t)i * ld)) * __builtin_bit_cast(float, __builtin_amdgcn_readlane(__builtin_bit_cast(int, s0), i));
            *(GAS f32x4*)(modp + ks * 16384 + j) = acc;
        }
    }
    if (gw < CV_TOTAL) cvt_store(c0, cK, cva, F.lds + RING_OFF + F.wave * 9216, lane);
    p1_convert(F, gw + NGW);
    {
        bf16* win_t = wsp<bf16>(F, WS_WIN);
        for (int i2 = gw; i2 < D / 4; i2 += NGW) {
            const int col = lane & 15, k = 4 * i2 + (lane >> 4), sc = col < 8 ? 3072 + col : 6152 + (col - 8);
            win_t[(size_t)(NPP + col) * D + k] = (bf16)f2bf(F.in[IN_WIN][(size_t)k * NPROJ + sc]); }
        const v4u z = {0u, 0u, 0u, 0u};
        for (int i = gw * 64 + lane; i < 16 * D / 8; i += NGW * 64) *(GAS v4u*)(win_t + (size_t)NPROJ * D + (size_t)i * 8) = z;
    }
}
constexpr int CV8_NSH = 32, CV8_SHA = CV8_UG / CV8_NSH, CV8_SHB = CV8_D / CV8_NSH;
#define CONV_NEXT(var) do { var = CV8_TOTAL; \
        if (useA) { const int b_ = __builtin_amdgcn_readfirstlane((int)(lane == 0 ? __hip_atomic_fetch_add(ctrA, 1u, RLX_AGENT) : 0u)); if (b_ < CV8_SHA) var = xs * CV8_SHA + b_; else useA = false; } \
        if (var == CV8_TOTAL && useB) { const int b_ = __builtin_amdgcn_readfirstlane((int)(lane == 0 ? __hip_atomic_fetch_add(ctrB, 1u, RLX_AGENT) : 0u)); if (b_ < CV8_SHB) var = CV8_UG + xs * CV8_SHB + b_; else useB = false; } } while (0)
__device__ __forceinline__ void conv_worker(Frame& F, gu32* stop, unsigned target, int which) {
    LAS unsigned char* scr = F.lds + RING_OFF + F.wave * 9216; const int lane = F.lane, xs = (int)(blockIdx.x & (CV8_NSH - 1));
    gu32* ctrA = F.ctl + CW_CONV + 64 * xs; gu32* ctrB = F.ctl + CW_CONV + 64 * (CV8_NSH + xs);
    bool useA = which != 2, useB = which != 1;
    int it; CONV_NEXT(it); if (it >= CV8_TOTAL) return;
    f32x4 va[16], vb[16];
    Cvt8Item cur = cvt8_item(F, it, 0); cvt8_load(cur, va, lane);
    for (;;) {
        const Cvt8Item c1 = cvt8_item(F, it, 1); cvt8_load(c1, vb, lane);
        bool stopnow = false;
        if (stop) stopnow = (unsigned)__builtin_amdgcn_readfirstlane((int)__hip_atomic_load(stop, RLX_AGENT)) >= target;
        int itn = CV8_TOTAL; if (!stopnow) CONV_NEXT(itn);
        cvt8_pack(va, scr, 0, lane);
        const bool more = itn < CV8_TOTAL; Cvt8Item nx = cur;
        if (more) { nx = cvt8_item(F, itn, 0); cvt8_load(nx, va, lane); }
        cvt8_pack(vb, scr, 1, lane);
        cvt8_flush(cur.dst, D, scr, lane);
        if (!more) break;
        cur = nx; it = itn;
    }
}
__device__ __forceinline__ bool enter_group(Frame& F, int Gc) {
    if (F.G != 256 || Gc >= 256) return true;
    const int bx = (int)blockIdx.x, slot = bx >> 3, xcd = bx & 7, per = Gc >> 3;
    if (slot >= per) return false;
    F.vcu = xcd * per + slot; F.bid = slot * 8 + xcd; F.G = Gc; return true;
}
__device__ __forceinline__ void leave_group(Frame& F) { const int bx = (int)blockIdx.x, G = (int)gridDim.x; F.G = G; F.bid = bx; F.vcu = (G % 8 == 0) ? (bx % 8) * (G / 8) + bx / 8 : bx; }
__device__ __forceinline__ void p1_convert(Frame& F, int first) {
    const int NGW = F.G * NWAVES, lane = F.lane;
    {
        LAS unsigned char* scr = F.lds + RING_OFF + F.wave * 9216;
        int it = first;
        if (it < CV_TOTAL) {
            int ldw, K; CvtItem cur = cvt_item(F, it, ldw, K); f32x4 va[16], vb[16];
            cvt_load(cur, ldw, va, lane);
            for (;;) {
                int itn = it + NGW; int ldn = 0, Kn = 0; CvtItem nx = cur; const bool more = itn < CV_TOTAL;
                if (more) { nx = cvt_item(F, itn, ldn, Kn); cvt_load(nx, ldn, vb, lane); }
                cvt_store(cur, K, va, scr, lane);
                if (!more) break;
                it = itn + NGW; const bool more2 = it < CV_TOTAL; CvtItem n2 = nx; int ld2 = 0, K2 = 0;
                if (more2) { n2 = cvt_item(F, it, ld2, K2); cvt_load(n2, ld2, va, lane); }
                cvt_store(nx, Kn, vb, scr, lane);
                if (!more2) break;
                cur = n2; K = K2;
            }
        }
    }
}
__device__ __forceinline__ void mod_reduce_lds(Frame& F, int j0, int n, LAS float* dst) {
    const float* modp = wsp<float>(F, WS_MODP);
    for (int i = F.tid; i < n; i += NTHR) { const int j = j0 + i; float a = j < 6 * D ? F.in[IN_BADA][j] : F.in[IN_BAF][j - 6 * D];
#pragma unroll
        for (int ks = 0; ks < 32; ++ks) a += modp[ks * 16384 + j];
        dst[i] = a; }
}
__device__ __forceinline__ void modulate_row_bf16(const float* xrow, const float* g, const LAS float* sh, const LAS float* sc, bf16* orow, int lane) {
    const GAS f32x4* xr = (const GAS f32x4*)xrow + lane; f32x4 v[8]; float s2 = 0.f;
#pragma unroll
    for (int j = 0; j < 8; ++j) { v[j] = xr[64 * j]; s2 += (v[j].x * v[j].x + v[j].y * v[j].y) + (v[j].z * v[j].z + v[j].w * v[j].w); }
    const float r = rsqrtf(wave_sum(s2) * (1.f / D) + 1e-6f);
    GAS u32x2* o8 = (GAS u32x2*)orow + lane;
#pragma unroll
    for (int j = 0; j < 8; ++j) { const int c0 = 4 * lane + 256 * j; const f32x4 gg = *(const GAS f32x4*)(g + c0); const f32x4 a = *(const LAS f32x4*)(sc + c0), b = *(const LAS f32x4*)(sh + c0);
        const f32x4 y = v[j] * r * gg * (a + 1.f) + b; u32x2 w; w.x = pk2(y.x, y.y); w.y = pk2(y.z, y.w); o8[64 * j] = w; }
}
typedef float f32x16 __attribute__((ext_vector_type(16)));
typedef short s16x8g __attribute__((ext_vector_type(8)));
__device__ __forceinline__ void p1_modulate(Frame& F, int probe) {
    LAS float* shs = (LAS float*)(F.lds + RING_OFF + 81920);
    LAS float* gred = (LAS float*)(F.lds + RING_OFF + 98304);
    mod_reduce_lds(F, 0, 2 * D, shs);
    if (F.tid < 64) {
        const float* modp = wsp<float>(F, WS_MODP); float* mod = wsp<float>(F, WS_MOD);
        for (int j = blockIdx.x * 64 + F.tid; j < 16384; j += F.G * 64) { float a = j < 6 * D ? F.in[IN_BADA][j] : F.in[IN_BAF][j - 6 * D];
#pragma unroll
            for (int ks = 0; ks < 32; ++ks) a += modp[ks * 16384 + j];
            mod[j] = a; }
    }
    __syncthreads();
    bf16* hn = wsp<bf16>(F, WS_HN); const bf16* wg = wsp<bf16>(F, WS_WIN) + (size_t)NPP * D; float* gates = wsp<float>(F, WS_GATES);
    const int lane = F.lane, w = F.wave, hi = lane >> 5, l31 = lane & 31;
    if (probe != 4) for (int rb = F.vcu; rb < S / 32; rb += F.G) {
        const int row0 = rb * 32;
        {
            f32x4 xv[4][8];
#pragma unroll
            for (int i = 0; i < 4; ++i) { const GAS f32x4* xr = (const GAS f32x4*)(F.in[IN_X] + (size_t)(row0 + 4 * w + i) * D) + lane;
#pragma unroll
                for (int j = 0; j < 8; ++j) xv[i][j] = xr[64 * j]; }
#pragma unroll
            for (int i = 0; i < 4; ++i) { float s2 = 0.f;
#pragma unroll
                for (int j = 0; j < 8; ++j) s2 += (xv[i][j].x * xv[i][j].x + xv[i][j].y * xv[i][j].y) + (xv[i][j].z * xv[i][j].z + xv[i][j].w * xv[i][j].w);
                const float r = rsqrtf(wave_sum(s2) * (1.f / D) + 1e-6f);
                GAS u32x2* o8 = (GAS u32x2*)(hn + (size_t)(row0 + 4 * w + i) * D) + lane;
#pragma unroll
                for (int j = 0; j < 8; ++j) { const int c0 = 4 * lane + 256 * j; const f32x4 gg = *(const GAS f32x4*)(F.in[IN_NMIX] + c0); const f32x4 a = *(const LAS f32x4*)(shs + D + c0), b = *(const LAS f32x4*)(shs + c0);
                    const f32x4 y = xv[i][j] * r * gg * (a + 1.f) + b; u32x2 wv; wv.x = pk2(y.x, y.y); wv.y = pk2(y.z, y.w); o8[64 * j] = wv; } }
        }
        asm volatile("s_waitcnt vmcnt(0)" ::: "memory");
        __syncthreads();
        f32x16 acc;
#pragma unroll
        for (int r = 0; r < 16; ++r) acc[r] = 0.f;
        const bf16* ap = hn + (size_t)(row0 + l31) * D + 256 * w + 8 * hi; const bf16* bp = wg + (size_t)l31 * D + 256 * w + 8 * hi;
#pragma unroll
        for (int ks = 0; ks < 16; ++ks) { const s16x8g a = *(const GAS s16x8g*)(ap + 16 * ks), b = *(const GAS s16x8g*)(bp + 16 * ks); acc = __builtin_amdgcn_mfma_f32_32x32x16_bf16(a, b, acc, 0, 0, 0); }
        if (l31 < 16) {
#pragma unroll
            for (int r = 0; r < 16; ++r) gred[(w * 32 + (r & 3) + 8 * (r >> 2) + 4 * hi) * 16 + l31] = acc[r]; }
        __syncthreads();
        { const int row = F.tid >> 4, n = F.tid & 15; float s = 0.f;
#pragma unroll
            for (int q = 0; q < 8; ++q) s += gred[(q * 32 + row) * 16 + n];
            gates[(size_t)(row0 + row) * 16 + n] = s; }
        __syncthreads();
    }
    (void)probe;
}
using pg8::Unit; using pg8::cvt_pk_bf16;
struct EpiProj {
    static constexpr bool PERM = true, AFTER_DRAIN = false;
    bf16* O; PG8_LAS float* P; const float* gq; const float* gk;
    __device__ __forceinline__ void operator()(const pg8::f32x4 (&acc)[2][2][4][2], const Unit& u, int wr, int wc, int fr, int fq) const {
        const int row0 = u.pm * 256 + wr * 64 + fr, col0 = u.pn * 256 + wc * 32 + 8 * fq;
        if (u.pn >= 12 && u.pn < 20) {
            const float* gp = (u.pn < 16 ? gq : gk) + wc * 32 + 8 * fq; const pg8::f32x4 g0 = *(const pg8::f32x4*)gp, g1 = *(const pg8::f32x4*)(gp + 4);
#pragma unroll
            for (int ai = 0; ai < 2; ++ai)
#pragma unroll
                for (int m = 0; m < 4; ++m)
#pragma unroll
                    for (int bj = 0; bj < 2; ++bj) { const pg8::f32x4 v0 = acc[ai][bj][m][0], v1 = acc[ai][bj][m][1];
                        float s = (v0[0] * v0[0] + v0[1] * v0[1]) + (v0[2] * v0[2] + v0[3] * v0[3]) + (v1[0] * v1[0] + v1[1] * v1[1]) + (v1[2] * v1[2] + v1[3] * v1[3]);
                        s += __shfl_xor(s, 16); s += __shfl_xor(s, 32);
                        if (fq == 0) P[((ai * 128 + wr * 64 + m * 16 + fr) * 2 + bj) * 4 + wc] = s; }
            asm volatile("s_waitcnt lgkmcnt(0)" ::: "memory"); __builtin_amdgcn_s_barrier(); asm volatile("" ::: "memory");
#pragma unroll
            for (int ai = 0; ai < 2; ++ai)
#pragma unroll
                for (int m = 0; m < 4; ++m) { bf16* rowp = O + (size_t)(row0 + ai * 128 + m * 16) * NPP + col0;
#pragma unroll
                    for (int bj = 0; bj < 2; ++bj) { const pg8::f32x4 p4 = *(const PG8_LAS pg8::f32x4*)(P + ((ai * 128 + wr * 64 + m * 16 + fr) * 2 + bj) * 4);
                        const float r = rsqrtf(((p4[0] + p4[1]) + (p4[2] + p4[3])) * (1.f / 128.f) + 1e-6f);
                        const pg8::f32x4 v0 = acc[ai][bj][m][0] * r * g0, v1 = acc[ai][bj][m][1] * r * g1;
                        pg8::u32x4 w; w.x = cvt_pk_bf16(v0[0], v0[1]); w.y = cvt_pk_bf16(v0[2], v0[3]); w.z = cvt_pk_bf16(v1[0], v1[1]); w.w = cvt_pk_bf16(v1[2], v1[3]);
                        *(pg8::u32x4*)(rowp + bj * 128) = w; } }
            return;
        }
#pragma unroll
        for (int ai = 0; ai < 2; ++ai)
#pragma unroll
            for (int m = 0; m < 4; ++m) { bf16* rowp = O + (size_t)(row0 + ai * 128 + m * 16) * NPP + col0;
#pragma unroll
                for (int bj = 0; bj < 2; ++bj) { const pg8::f32x4 v0 = acc[ai][bj][m][0], v1 = acc[ai][bj][m][1];
                    pg8::u32x4 w; w.x = cvt_pk_bf16(v0[0], v0[1]); w.y = cvt_pk_bf16(v0[2], v0[3]); w.z = cvt_pk_bf16(v1[0], v1[1]); w.w = cvt_pk_bf16(v1[2], v1[3]);
                    *(pg8::u32x4*)(rowp + bj * 128) = w; } }
    }
};
struct EpiOut {
    static constexpr bool PERM = false, AFTER_DRAIN = false;
    const float* x; const float* g1; float* h1;
    __device__ __forceinline__ void operator()(const pg8::f32x4 (&acc)[2][2][4][2], const Unit& u, int wr, int wc, int fr, int fq) const {
        const int row0 = u.pm * 256 + wr * 64 + fr, col0 = u.pn * 256 + wc * 32 + 4 * fq;
        pg8::f32x4 gv[2][2];
#pragma unroll
        for (int bj = 0; bj < 2; ++bj)
#pragma unroll
            for (int n = 0; n < 2; ++n) gv[bj][n] = *(const pg8::f32x4*)(g1 + col0 + bj * 128 + n * 16);
#pragma unroll
        for (int ai = 0; ai < 2; ++ai)
#pragma unroll
            for (int m = 0; m < 4; ++m) { const size_t off = (size_t)(row0 + ai * 128 + m * 16) * D + col0;
#pragma unroll
                for (int bj = 0; bj < 2; ++bj)
#pragma unroll
                    for (int n = 0; n < 2; ++n) { const pg8::f32x4 xv = *(const pg8::f32x4*)(x + off + bj * 128 + n * 16);
                        *(pg8::f32x4*)(h1 + off + bj * 128 + n * 16) = xv + gv[bj][n] * acc[ai][bj][m][n]; } }
    }
};
}
namespace fox {
constexpr int D = 128, SQ = 8192, SKV = 8192; constexpr float THR = 8.f; constexpr bool WSKIP = false;
constexpr int PITCH = 6144;
constexpr int OPITCH = 2048;
constexpr float SCALE = 0.08838834764831845f;
constexpr int NW = 8, QBLK = 32, KVBLK = 64, QB = NW * QBLK;
constexpr int SHM_V = KVBLK * D * 2, SHM_K = KVBLK * D * 2;
constexpr int LDS_BIAS = 2 * SHM_V + 2 * SHM_K + NW * 64 * 4;
constexpr int LDS_BYTES = LDS_BIAS + 512;

using bf16 = __hip_bfloat16;
typedef short bf16x8 __attribute__((ext_vector_type(8)));
typedef short s16x4 __attribute__((ext_vector_type(4)));
typedef float f32x16 __attribute__((ext_vector_type(16)));
typedef float f32x4 __attribute__((ext_vector_type(4)));
typedef unsigned u32x4 __attribute__((ext_vector_type(4)));
template <class A, class Bt> struct same_t { static constexpr bool v = false; };
template <class A> struct same_t<A, A> { static constexpr bool v = true; };

#define KSWZ(row, colB) ((row) * 256 + ((colB) ^ (((row) & 7) << 4)))
#define SBAR() __builtin_amdgcn_sched_barrier(0)
__device__ __forceinline__ int v_st(int k, int c) { const int kk = (k & ~0xC) | ((k & 4) << 1) | ((k & 8) >> 1); return ((kk >> 3) * 4 + (c >> 5)) * 512 + ((kk & 7) * 32 + (c & 31)) * 2; }
__device__ __forceinline__ int v_rd_base(int lane) { return ((lane & 3) << 3) | (((lane >> 2) & 3) << 6) | (((lane >> 4) & 1) << 5) | (((lane >> 5) & 1) << 8); }
constexpr int v_rd_off(int d0, int ks, int half) { return d0 * 512 + ks * 4096 + half * 2048; }
__device__ __forceinline__ int crow(int r, int hi) { return (r & 3) + 8 * (r >> 2) + 4 * hi; }
__device__ __forceinline__ int bias_slot(int kk) { return ((kk >> 2) & 1) * 32 + (kk >> 5) * 16 + (kk & 3) + 4 * ((kk & 31) >> 3); }
__device__ __forceinline__ unsigned cvtpk(float lo, float hi) {
    unsigned r; asm volatile("v_cvt_pk_bf16_f32 %0, %1, %2" : "=v"(r) : "v"(lo), "v"(hi)); return r;
}
__device__ __forceinline__ bf16x8 pack8(f32x4 a, f32x4 b) {
    u32x4 w = {cvtpk(a[0], a[1]), cvtpk(a[2], a[3]), cvtpk(b[0], b[1]), cvtpk(b[2], b[3])};
    return *reinterpret_cast<bf16x8*>(&w);
}
template <class T> __device__ __forceinline__ bf16x8 load8(const T* p) {
    if constexpr (same_t<T, float>::v) { return pack8(*(const f32x4*)p, *(const f32x4*)(p + 4)); }
    else { return *reinterpret_cast<const bf16x8*>(p); }
}
__device__ __forceinline__ void mask_tile(f32x16& p0, f32x16& p1, int dq, unsigned W) {
    const float NEG = -__builtin_inff();
#pragma unroll
    for (int r = 0; r < 16; ++r) {
        const int c = (r & 3) + 8 * (r >> 2);
        if ((unsigned)(dq - c) >= W) p0[r] = NEG;
        if ((unsigned)(dq - c - 32) >= W) p1[r] = NEG;
    }
}
__device__ __forceinline__ void partialSM(f32x16& p0, f32x16& p1, float& m_reg, float& mn, float& alpha) {
    float pmax = p0[0]; for (int r = 1; r < 16; ++r) pmax = fmaxf(pmax, p0[r]); for (int r = 0; r < 16; ++r) pmax = fmaxf(pmax, p1[r]);
    { auto rr = __builtin_amdgcn_permlane32_swap(__float_as_uint(pmax), __float_as_uint(pmax), false, false);
      pmax = fmaxf(__uint_as_float(rr[0]), __uint_as_float(rr[1])); }
    constexpr float C2 = 1.4426950408889634f * SCALE;
    if (__builtin_expect(__all((pmax - m_reg) * SCALE <= THR), 1)) { mn = m_reg; alpha = 1.f; }
    else { mn = fmaxf(m_reg, pmax); alpha = __builtin_amdgcn_exp2f((m_reg - mn) * C2); m_reg = mn; }
    const float mnL = -mn * C2;
    for (int r = 0; r < 16; ++r) p0[r] = fmaf(p0[r], C2, mnL); for (int r = 0; r < 16; ++r) p1[r] = fmaf(p1[r], C2, mnL);
    for (int r = 0; r < 16; ++r) p0[r] = __builtin_amdgcn_exp2f(p0[r]);
}
__device__ __forceinline__ void finishSM(f32x16& p0, f32x16& p1, float alpha, float& l_reg, bf16x8& pa0, bf16x8& pa1, bf16x8& pa2, bf16x8& pa3) {
    for (int r = 0; r < 16; ++r) p1[r] = __builtin_amdgcn_exp2f(p1[r]);
    float ps = 0; for (int r = 0; r < 16; ++r) ps += p0[r]; for (int r = 0; r < 16; ++r) ps += p1[r];
    { auto rr = __builtin_amdgcn_permlane32_swap(__float_as_uint(ps), __float_as_uint(ps), false, false);
      ps = __uint_as_float(rr[0]) + __uint_as_float(rr[1]); }
    l_reg = l_reg * alpha + ps;
#define PK4(P, B_, OUT) do { unsigned a0 = cvtpk(P[B_+0], P[B_+1]), a1 = cvtpk(P[B_+2], P[B_+3]);                          \
        unsigned b0 = cvtpk(P[B_+4], P[B_+5]), b1 = cvtpk(P[B_+6], P[B_+7]);                                             \
        auto r0 = __builtin_amdgcn_permlane32_swap(a0, b0, false, false); auto r1 = __builtin_amdgcn_permlane32_swap(a1, b1, false, false); \
        u32x4 w = {r0[0], r1[0], r0[1], r1[1]}; OUT = *reinterpret_cast<bf16x8*>(&w); } while (0)
    PK4(p0, 0, pa0); PK4(p0, 8, pa1); PK4(p1, 0, pa2); PK4(p1, 8, pa3);
#undef PK4
}
template <int KB, bool SK>
__device__ __forceinline__ void qkt(f32x16& p0, f32x16& p1, const char* K_lds, int r32, int hi, const bf16x8* qr, bool act) {
    if (SK && !act) { const float NEG = -__builtin_inff();
#pragma unroll
        for (int r = 0; r < 16; ++r) { p0[r] = NEG; p1[r] = NEG; } return; }
    { const f32x16* bp = reinterpret_cast<const f32x16*>(K_lds - 2 * SHM_V + LDS_BIAS + KB * 256 + hi * 128); p0 = bp[0]; p1 = bp[1]; }
    const char* kb[4];
#pragma unroll
    for (int dd = 0; dd < 4; ++dd) kb[dd] = K_lds + KB * SHM_K + KSWZ(r32, (dd * 16 + hi * 8) * 2);
#pragma unroll
    for (int d0 = 0; d0 < 8; ++d0) { const char* a = kb[d0 & 3] + (d0 >> 2) * 128;
        bf16x8 b0 = *reinterpret_cast<const bf16x8*>(a);
        bf16x8 b1 = *reinterpret_cast<const bf16x8*>(a + 32 * 256);
        p0 = __builtin_amdgcn_mfma_f32_32x32x16_bf16(b0, qr[d0], p0, 0, 0, 0);
        p1 = __builtin_amdgcn_mfma_f32_32x32x16_bf16(b1, qr[d0], p1, 0, 0, 0); }
}
template <int VB, bool SK>
__device__ __forceinline__ void pv_tile(f32x16* o, int vb0, bf16x8 pa0, bf16x8 pa1, bf16x8 pa2, bf16x8 pa3, bool act) {
    if (SK && !act) return;
#define TRRD(dst, off) asm volatile("ds_read_b64_tr_b16 %0, %1 offset:%2" : "=&v"(dst) : "v"(vb0), "i"(off) : "memory")
#define PV_D0(d0) do { s16x4 l0, l1, l2, l3, h0, h1, h2, h3; constexpr int b_ = VB * SHM_V + v_rd_off(d0, 0, 0);     \
        TRRD(l0, b_); TRRD(h0, b_ + 2048); TRRD(l1, b_ + 4096); TRRD(h1, b_ + 6144); TRRD(l2, b_ + 8192); TRRD(h2, b_ + 10240); TRRD(l3, b_ + 12288); TRRD(h3, b_ + 14336); \
        asm volatile("s_waitcnt lgkmcnt(0)" ::: "memory"); SBAR();                 \
        o[d0] = __builtin_amdgcn_mfma_f32_32x32x16_bf16(pa0, (bf16x8){l0[0], l0[1], l0[2], l0[3], h0[0], h0[1], h0[2], h0[3]}, o[d0], 0, 0, 0);   \
        o[d0] = __builtin_amdgcn_mfma_f32_32x32x16_bf16(pa1, (bf16x8){l1[0], l1[1], l1[2], l1[3], h1[0], h1[1], h1[2], h1[3]}, o[d0], 0, 0, 0);   \
        o[d0] = __builtin_amdgcn_mfma_f32_32x32x16_bf16(pa2, (bf16x8){l2[0], l2[1], l2[2], l2[3], h2[0], h2[1], h2[2], h2[3]}, o[d0], 0, 0, 0);   \
        o[d0] = __builtin_amdgcn_mfma_f32_32x32x16_bf16(pa3, (bf16x8){l3[0], l3[1], l3[2], l3[3], h3[0], h3[1], h3[2], h3[3]}, o[d0], 0, 0, 0); } while (0)
    PV_D0(0); PV_D0(1); PV_D0(2); PV_D0(3);
#undef PV_D0
#undef TRRD
}

template <class TIn, class TOut> struct BlockRef { const TIn* Q; const TIn* K; const TIn* V; TOut* O; int P0; const float* Fb; const float* gain;
    int jlo, jhi;
    float* Op; float* ML; };
template <class TIn> struct Seam {
    bf16x8 qr[8];
    bf16x8 st_v0, st_v1, st_k0, st_k1; f32x4 sf0, sf1, sf2, sf3; float st_b;
    f32x4 tq[16];
};
__device__ __forceinline__ int swa_jlo(int P0, int W) { const int lowk = P0 - W + 1; return lowk > 0 ? lowk / KVBLK : 0; }
#define ROW(p, k0, rr) ((p) + (size_t)((k0) + (rr)) * PITCH + sc)
#define VMW() asm volatile("s_waitcnt vmcnt(0)" ::: "memory")
#define VMWN(n) asm volatile("s_waitcnt vmcnt(%0)" :: "i"(n) : "memory")
#define SLOAD_H(Kp, Vp, k0) SLOAD_HB(Kp, Vp, k0, cur)
#define SLOAD_HB(Kp, Vp, k0, blk) do { S.st_v0 = load8<TIn>(ROW(Vp, k0, sr)); S.st_v1 = load8<TIn>(ROW(Vp, k0, 32 + sr));              \
                         S.st_k0 = load8<TIn>(ROW(Kp, k0, sr)); S.st_k1 = load8<TIn>(ROW(Kp, k0, 32 + sr)); \
                         if (tid < 64) S.st_b = ((blk).Fb[(blk).P0] - (blk).Fb[(k0) + tid]) * (1.0f / SCALE); } while (0)
#define SWRITE_HK(bf) do { *(bf16x8*)(K_lds + (bf) * SHM_K + kws) = S.st_k0; *(bf16x8*)(K_lds + (bf) * SHM_K + kws + 32 * 256) = S.st_k1; \
                         if (tid < 64) *(float*)(K_lds - 2 * SHM_V + LDS_BIAS + (bf) * 256 + bws) = S.st_b; } while (0)
#define SWRITE_HV(bf) do { *(bf16x8*)(V_lds + (bf) * SHM_V + vst0) = S.st_v0; *(bf16x8*)(V_lds + (bf) * SHM_V + vst1) = S.st_v1; } while (0)
#define SWRITE_H(bf) do { SWRITE_HV(bf); SWRITE_HK(bf); } while (0)
#define SLOAD_F(p, k0) do { S.sf0 = *(const f32x4*)ROW(p, k0, sr); S.sf1 = *(const f32x4*)(ROW(p, k0, sr) + 4);                \
                            S.sf2 = *(const f32x4*)ROW(p, k0, 32 + sr); S.sf3 = *(const f32x4*)(ROW(p, k0, 32 + sr) + 4); } while (0)
#define SWRITE_KF(bf) do { *(bf16x8*)(K_lds + (bf) * SHM_K + kws) = pack8(S.sf0, S.sf1); *(bf16x8*)(K_lds + (bf) * SHM_K + kws + 32 * 256) = pack8(S.sf2, S.sf3); } while (0)
#define SWRITE_VF(bf) do { *(bf16x8*)(V_lds + (bf) * SHM_V + vst0) = pack8(S.sf0, S.sf1); *(bf16x8*)(V_lds + (bf) * SHM_V + vst1) = pack8(S.sf2, S.sf3); } while (0)
template <class TIn, class TOut>
__device__ __forceinline__ void causal_swa_prime(const BlockRef<TIn, TOut>& cur, int W, char* lds, Seam<TIn>& S) {
    constexpr bool F32 = same_t<TIn, float>::v;
    const int tid = threadIdx.x, wid = __builtin_amdgcn_readfirstlane(tid >> 6), lane = tid & 63, r32 = lane & 31, hi = lane >> 5;
    const int sr = tid >> 4, sc = (tid & 15) * 8, kws = KSWZ(sr, sc * 2); char* K_lds = lds + 2 * SHM_V;
    const int bws = bias_slot(tid & 63) * 4;
    const int kb0 = cur.jlo * KVBLK;
    for (int d0 = 0; d0 < 8; ++d0) S.qr[d0] = load8<TIn>(cur.Q + (size_t)(wid * QBLK + r32) * PITCH + d0 * 16 + hi * 8);
    if constexpr (F32) { SLOAD_F((const float*)cur.K, kb0); VMW(); SWRITE_KF(0); SBAR(); SLOAD_F((const float*)cur.V, kb0); }
    else { SLOAD_H(cur.K, cur.V, kb0); VMW(); SWRITE_HK(0); }
    __syncthreads();
}
template <class TIn, class TOut>
__device__ __forceinline__ void causal_swa_block(const BlockRef<TIn, TOut>& cur, const BlockRef<TIn, TOut>& nxt, int skv, int W, char* lds, Seam<TIn>& S) {
    constexpr bool F32 = same_t<TIn, float>::v;
    const int tid = threadIdx.x, wid = __builtin_amdgcn_readfirstlane(tid >> 6), lane = tid & 63, r32 = lane & 31, hi = lane >> 5;
    const int j_lo = cur.jlo; const int j_hi = cur.jhi;
    const int NT = j_hi - j_lo;
    const int kbn = nxt.jlo * KVBLK;
    const int qlo = cur.P0 + wid * QBLK, qm = qlo + r32 - 4 * hi;
    char* V_lds = lds; char* K_lds = lds + 2 * SHM_V;
    float* ws = (float*)(lds + 2 * SHM_V + 2 * SHM_K) + wid * 64; float* li_l = ws, * al_l = ws + 32;
    float m_reg = -1e30f, l_reg = 0; f32x16 o[4] = {};
    const int sr = tid >> 4, sc = (tid & 15) * 8, vst0 = v_st(sr, sc), vst1 = v_st(32 + sr, sc), kws = KSWZ(sr, sc * 2);
    const int bws = bias_slot(tid & 63) * 4;
    const int vb0 = (int)(uintptr_t)V_lds + v_rd_base(lane);
    const TIn* Kh = cur.K; const TIn* Vh = cur.V;
#define RESC(a) do { if (__any((a) < 1.f)) { if (hi == 0) al_l[r32] = (a); asm volatile("s_waitcnt lgkmcnt(0)" ::: "memory");              \
                     for (int d_ = 0; d_ < 4; ++d_) for (int r = 0; r < 16; ++r) o[d_][r] *= al_l[crow(r, hi)]; } } while (0)
#define KBASE(t) ((j_lo + (t)) * KVBLK)
#define ACT(t) (KBASE(t) <= qlo + QBLK - 1 && KBASE(t) + KVBLK - 1 >= qlo - W + 1)
#define MASKT(P0_, P1_, t) do { const int kb_ = KBASE(t); if ((!SK || ACT(t)) && (kb_ + KVBLK - 1 > qlo || kb_ <= qlo + QBLK - 1 - W)) mask_tile(P0_, P1_, qm - kb_, (unsigned)W); } while (0)
    constexpr int NQL = F32 ? 16 : 8;
    constexpr bool SK = WSKIP && !F32;
#define SEAM_K0() do { VMWN(NQL); if constexpr (F32) { SWRITE_KF(0); SBAR(); SLOAD_F((const float*)nxt.V, kbn); } else { SWRITE_HK(0); } SBAR(); } while (0)
    f32x16 pA0, pA1, pB0, pB1; float mnA, mnB, alA, alB; bf16x8 pa0, pa1, pa2, pa3;
    if constexpr (F32) { VMW(); SWRITE_VF(0); SBAR(); } else { SWRITE_HV(0); SBAR(); }
    if (NT > 1) { if constexpr (F32) SLOAD_F((const float*)Kh, KBASE(1)); else SLOAD_H(Kh, Vh, KBASE(1)); }
    SBAR(); qkt<0, SK>(pA0, pA1, K_lds, r32, hi, S.qr, ACT(0));
    if constexpr (F32) { if (NT > 1) { VMW(); SWRITE_KF(1); SBAR(); SLOAD_F((const float*)Vh, KBASE(1)); } }
    MASKT(pA0, pA1, 0); partialSM(pA0, pA1, m_reg, mnA, alA);
    if (NT > 1) { VMW(); if constexpr (F32) { SWRITE_VF(1); SBAR(); if (NT > 2) SLOAD_F((const float*)Kh, KBASE(2)); } else SWRITE_H(1); }
    __syncthreads();
#define HALF_STEP(PX0, PX1, mnX, alX, PY0, PY1, alY, t, KB, VB, SB) do {                                                      \
        SBAR(); qkt<KB, SK>(PX0, PX1, K_lds, r32, hi, S.qr, ACT(t));                                             \
        finishSM(PY0, PY1, alY, l_reg, pa0, pa1, pa2, pa3); SBAR();                                                           \
        if ((t) + 1 < NT) { if constexpr (F32) { VMW(); SWRITE_KF(SB); SBAR(); SLOAD_F((const float*)Vh, KBASE((t) + 1)); }  \
                            else { SLOAD_H(Kh, Vh, KBASE((t) + 1)); } SBAR(); }                                               \
        pv_tile<VB, SK>(o, vb0, pa0, pa1, pa2, pa3, ACT((t) - 1)); MASKT(PX0, PX1, (t)); partialSM(PX0, PX1, m_reg, mnX, alX);                                        \
        __syncthreads();                                                                                                      \
        if ((t) + 1 < NT) { VMW(); if constexpr (F32) { SWRITE_VF(SB); SBAR(); if ((t) + 2 < NT) SLOAD_F((const float*)Kh, KBASE((t) + 2)); } \
                            else { SWRITE_H(SB); } }                                                                          \
        RESC(alX); __syncthreads(); } while (0)
    for (int t = 1; t + 1 < NT; t += 2) {
        HALF_STEP(pB0, pB1, mnB, alB, pA0, pA1, alA, t, 1, 0, 0);
        HALF_STEP(pA0, pA1, mnA, alA, pB0, pB1, alB, t + 1, 0, 1, 1);
    }
    const bool even = (NT & 1) == 0;
    if (even) { SBAR(); qkt<1, SK>(pB0, pB1, K_lds, r32, hi, S.qr, ACT(NT - 1)); SBAR(); }
#define QROW(e) (nxt.Q + (size_t)(wid * QBLK + r32) * PITCH + ((e) >> 1) * 16 + hi * 8 + ((e) & 1) * 4)
    if constexpr (F32) { SLOAD_F((const float*)nxt.K, kbn); SBAR();
#pragma unroll
        for (int e = 0; e < 8; ++e) S.tq[e] = *(const f32x4*)QROW(e); }
    else { SLOAD_HB(nxt.K, nxt.V, kbn, nxt); SBAR();
#pragma unroll
        for (int d0 = 0; d0 < 8; ++d0) S.qr[d0] = load8<TIn>(nxt.Q + (size_t)(wid * QBLK + r32) * PITCH + d0 * 16 + hi * 8); }
    SBAR();
    finishSM(pA0, pA1, alA, l_reg, pa0, pa1, pa2, pa3); SBAR();
    if constexpr (F32) {
#pragma unroll
        for (int e = 8; e < 16; ++e) S.tq[e] = *(const f32x4*)QROW(e); SBAR(); }
#undef QROW
    pv_tile<0, SK>(o, vb0, pa0, pa1, pa2, pa3, ACT(even ? NT - 2 : NT - 1));
    if (even) { MASKT(pB0, pB1, NT - 1); partialSM(pB0, pB1, m_reg, mnB, alB); __syncthreads(); RESC(alB);
        finishSM(pB0, pB1, alB, l_reg, pa0, pa1, pa2, pa3); SBAR(); pv_tile<1, SK>(o, vb0, pa0, pa1, pa2, pa3, ACT(NT - 1)); }
    SBAR(); SEAM_K0();
    if (hi == 0) li_l[r32] = l_reg; asm volatile("s_waitcnt lgkmcnt(0)" ::: "memory");
    if (cur.Op != nullptr) {
        int rp = r32; asm volatile("" : "+v"(rp));
        if (hi == 0) { float2 mlv; mlv.x = m_reg; mlv.y = l_reg; *(float2*)(cur.ML + 2 * (wid * QBLK + rp)) = mlv; }
        unsigned short* Pr = (unsigned short*)cur.Op + (size_t)(wid * QBLK + 4 * hi) * D + 4 * rp;
#pragma unroll
        for (int r = 0; r < 16; ++r) { uint2 wv; wv.x = cvtpk(o[0][r], o[1][r]); wv.y = cvtpk(o[2][r], o[3][r]); *(uint2*)Pr = wv;
            Pr += ((r & 3) == 3 ? 5 : 1) * D; asm volatile("" : "+v"(Pr) :: "memory"); }
    } else {
    int ro = r32; asm volatile("" : "+v"(ro));
    TOut* Or = cur.O + (size_t)(wid * QBLK + 4 * hi) * OPITCH + ro;
    float gn[4];
#pragma unroll
    for (int d0 = 0; d0 < 4; ++d0) gn[d0] = cur.gain[d0 * 32 + ro];
#pragma unroll
    for (int r = 0; r < 16; ++r) { const int orow = crow(r, hi); const float rl = __builtin_amdgcn_rcpf(li_l[orow]);
        float v[4]; float ss = 0.f;
#pragma unroll
        for (int d0 = 0; d0 < 4; ++d0) { v[d0] = o[d0][r] * rl; ss += v[d0] * v[d0]; }
        ss += __shfl_xor(ss, 1); ss += __shfl_xor(ss, 2); ss += __shfl_xor(ss, 4); ss += __shfl_xor(ss, 8); ss += __shfl_xor(ss, 16);
        const float rn = __builtin_amdgcn_rsqf(ss * (1.0f / 128.0f) + 1e-6f);
#pragma unroll
        for (int d0 = 0; d0 < 4; ++d0) { const float vv = v[d0] * rn * gn[d0]; const float vn = __shfl_xor(vv, 1);
            if ((ro & 1) == 0) *(unsigned*)(Or + d0 * 32) = cvtpk(vv, vn); }
        Or += ((r & 3) == 3 ? 5 : 1) * OPITCH; asm volatile("" : "+v"(Or) :: "memory"); }
    }
    if constexpr (F32) {
#pragma unroll
        for (int d0 = 0; d0 < 8; ++d0) S.qr[d0] = pack8(S.tq[2 * d0], S.tq[2 * d0 + 1]); }
    __syncthreads();
#undef RESC
#undef KBASE
#undef ACT
#undef MASKT
#undef SEAM_K0
#undef HALF_STEP
}
#undef ROW
#undef VMW
#undef VMWN
#undef SLOAD_H
#undef SWRITE_HK
#undef SWRITE_HV
#undef SWRITE_H
#undef SLOAD_F
#undef SWRITE_KF
#undef SWRITE_VF

}
namespace mk {
typedef short s16x8 __attribute__((ext_vector_type(8)));
#define MFMA32(a, b, c) __builtin_amdgcn_mfma_f32_32x32x16_bf16((a), (b), (c), 0, 0, 0)
__device__ __forceinline__ int crow32(int r, int hi) { return (r & 3) + 8 * (r >> 2) + 4 * hi; }
constexpr float SCALEQ = 0.08838834764831845f;
__device__ __forceinline__ float wave_scan_add(float v, int lane) {
#pragma unroll
    for (int o = 1; o < 64; o <<= 1) { const float t = __shfl_up(v, o); if (lane >= o) v += t; }
    return v;
}
__device__ __forceinline__ float wave_scan_max(float v, int lane) {
#pragma unroll
    for (int o = 1; o < 64; o <<= 1) { const float t = __shfl_up(v, o); if (lane >= o) v = fmaxf(v, t); }
    return v;
}
__device__ __forceinline__ float wave_max(float v) {
#pragma unroll
    for (int o = 1; o < 64; o <<= 1) v = fmaxf(v, __shfl_xor(v, o));
    return v;
}
constexpr int TSTR = 72;
#define TSW(col, ks, hi) ((col) * TSTR + ((((2 * (ks) + (hi)) ^ ((col) >> 3)) & 7) << 3))
template <bool SCALED>
__device__ __forceinline__ void stage_transposed(const bf16* src, int ncols, LAS bf16* T, const LAS float* wl, int tid) {
    const int cpr = ncols / 8;
    for (int q = tid; q < 32 * cpr; q += NTHR) { const int s = 2 * (q / cpr), c8 = (q % cpr) * 8;
        const v4u r0 = *(const GAS v4u*)(src + (size_t)s * NPP + c8), r1 = *(const GAS v4u*)(src + (size_t)(s + 1) * NPP + c8);
        const unsigned a4[4] = {r0.x, r0.y, r0.z, r0.w}, b4[4] = {r1.x, r1.y, r1.z, r1.w};
        const int sw = ((((s >> 3) ^ (c8 >> 3)) & 7) << 3) + (s & 7);
#pragma unroll
        for (int j = 0; j < 4; ++j) { unsigned lo0 = a4[j] & 0xffffu, hi0 = a4[j] >> 16, lo1 = b4[j] & 0xffffu, hi1 = b4[j] >> 16;
            if (SCALED) { const float s0 = wl[s], s1 = wl[s + 1]; lo0 = f2bf(bf2f((unsigned short)lo0) * s0); hi0 = f2bf(bf2f((unsigned short)hi0) * s0); lo1 = f2bf(bf2f((unsigned short)lo1) * s1); hi1 = f2bf(bf2f((unsigned short)hi1) * s1); }
            *(LAS unsigned*)(T + (c8 + 2 * j) * TSTR + sw) = lo0 | (lo1 << 16); *(LAS unsigned*)(T + (c8 + 2 * j + 1) * TSTR + sw) = hi0 | (hi1 << 16); } }
}
__device__ __forceinline__ void p_fscan(Frame& F, int h) {
    const int tid = F.tid, lane = F.lane; const float* gates = wsp<float>(F, WS_GATES);
        const float b = F.in[IN_FOXBF][h]; float* Fo = wsp<float>(F, WS_F) + h * S;
        LAS double* tot = (LAS double*)(F.lds + RING_OFF);
        double loc[16]; double acc = 0.0;
#pragma unroll
        for (int i = 0; i < 16; ++i) { acc += (double)log_sigmoid_f(gates[(size_t)(tid * 16 + i) * 16 + 8 + h] + b); loc[i] = acc; }
        tot[tid] = acc;
        __syncthreads();
        if (F.wave == 0) { double v[8]; double s = 0.0;
#pragma unroll
            for (int i = 0; i < 8; ++i) { v[i] = tot[lane * 8 + i]; s += v[i]; }
            double inc = s;
#pragma unroll
            for (int o = 1; o < 64; o <<= 1) { const double t = __shfl_up(inc, o); if (lane >= o) inc += t; }
            double ex = inc - s;
#pragma unroll
            for (int i = 0; i < 8; ++i) { tot[lane * 8 + i] = ex; ex += v[i]; } }
        __syncthreads();
        const double off = tot[tid];
        LAS float* Fl = (LAS float*)(F.lds + RING_OFF + 8192);
#pragma unroll
        for (int i = 0; i < 16; ++i) { const float fv = (float)(off + loc[i]); Fo[tid * 16 + i] = fv; Fl[tid * 16 + i] = fv; }
        __syncthreads();
        if (tid < 32) {
            float gq = 0.f, gk = 0.f;
#pragma unroll
            for (int j = 0; j < 4; ++j) { gq = fmaxf(gq, fabsf(F.in[IN_FOXQN][tid + 32 * j])); gk = fmaxf(gk, fabsf(F.in[IN_FOXKN][tid + 32 * j])); }
#pragma unroll
            for (int o = 1; o < 32; o <<= 1) { gq = fmaxf(gq, __shfl_xor(gq, o)); gk = fmaxf(gk, __shfl_xor(gk, o)); }
            const float thr = 2.f * 11.3137085f * gq * gk + 26.f;
            const int qb = tid, P0 = qb * 256; const float f0 = Fl[P0];
            int lo = 0, hi2 = 4 * qb;
            while (lo < hi2) { const int mid = (lo + hi2) >> 1; if (Fl[64 * mid + 63] - f0 <= thr) hi2 = mid; else lo = mid + 1; }
            wsp<int>(F, WS_JLO)[h * 32 + qb] = lo;
        }
        __syncthreads();
}
__device__ __forceinline__ void p3_prep(Frame& F) {
    const int gw = F.vcu * NWAVES + F.wave, NGW = F.G * NWAVES, lane = F.lane, tid = F.tid;
    bf16* proj = wsp<bf16>(F, WS_PROJ); const float* gates = wsp<float>(F, WS_GATES);
    if (F.G != 256 && blockIdx.x < 8) p_fscan(F, (int)blockIdx.x);
    {
        LAS bf16* KT = (LAS bf16*)(F.lds + RING_OFF);
        LAS bf16* VT = KT + 128 * TSTR;
        LAS float* wl = (LAS float*)(VT + 256 * TSTR);
        float* UL = wsp<float>(F, WS_UL); float* NL = wsp<float>(F, WS_NL); float* GLAL = wsp<float>(F, WS_GLAL);
        const int hi = lane >> 5, l31 = lane & 31, w = F.wave;
        for (int u = F.vcu; u < 4 * NCH; u += F.G) {
            const int h = u >> 7, ch = u & 127, t0 = ch * LCH;
            if (w == 0) {
                const float ip = softcap_f(gates[(size_t)(t0 + lane) * 16 + h] + F.in[IN_BI][h]);
                const float fp = softcap_f(gates[(size_t)(t0 + lane) * 16 + 4 + h] + F.in[IN_BF][h]);
                const float g = wave_scan_add(log_sigmoid_f(fp), lane), a = ip - g, amax = wave_max(a);
                wl[lane] = __expf(a - amax);
                if (lane == 63) { GLAL[u * 2] = g; GLAL[u * 2 + 1] = amax; }
            }
            __syncthreads();
            stage_transposed<true>(proj + (size_t)t0 * NPP + C_MK + h * 128, 128, KT, wl, tid);
            stage_transposed<false>(proj + (size_t)t0 * NPP + C_MV + h * 256, 256, VT, wl, tid);
            __syncthreads();
            f32x16 acc[4];
#pragma unroll
            for (int dt = 0; dt < 4; ++dt)
#pragma unroll
                for (int r = 0; r < 16; ++r) acc[dt][r] = 0.f;
#pragma unroll
            for (int ks = 0; ks < 4; ++ks) { const s16x8 a = *(const LAS s16x8*)(VT + TSW(32 * w + l31, ks, hi));
#pragma unroll
                for (int dt = 0; dt < 4; ++dt) { const s16x8 b = *(const LAS s16x8*)(KT + TSW(32 * dt + l31, ks, hi)); acc[dt] = MFMA32(a, b, acc[dt]); } }
            float* ut = UL + (size_t)u * 256 * 128;
#pragma unroll
            for (int dt = 0; dt < 4; ++dt)
#pragma unroll
                for (int r = 0; r < 16; ++r) ut[(size_t)(32 * w + crow32(r, hi)) * 128 + 32 * dt + l31] = acc[dt][r];
            if (tid < 128) { float s = 0.f;
#pragma unroll
                for (int j = 0; j < 8; ++j) { const s16x8 kv = *(const LAS s16x8*)(KT + tid * TSTR + 8 * j);
#pragma unroll
                    for (int i = 0; i < 8; ++i) s += bf2f((unsigned short)kv[i]); }
                NL[u * 128 + tid] = s; }
            __syncthreads();
        }
    }
}
__device__ __forceinline__ void p4_scan(Frame& F) {
    LAS float* gl = (LAS float*)(F.lds + RING_OFF);
    LAS float* dec = gl + 256; LAS float* scl = dec + 128; LAS float* mv = scl + 128;
    const float* UL = wsp<float>(F, WS_UL); const float* NL = wsp<float>(F, WS_NL); const float* GLAL = wsp<float>(F, WS_GLAL);
    bf16* CS = wsp<bf16>(F, WS_CS); float* NS = wsp<float>(F, WS_NS); float* MS = wsp<float>(F, WS_MS);
    const int tid = F.tid;
    for (int blk = F.vcu; blk < 4 * 64; blk += F.G) {
        const int h = blk >> 6, rem0 = (blk & 63) * 512;
        if (tid < 256) gl[tid] = GLAL[h * 256 + tid];
        __syncthreads();
        if (tid < 64) {
            const int lane = tid; const float g0 = gl[4 * lane], al0 = gl[4 * lane + 1], g1 = gl[4 * lane + 2], al1 = gl[4 * lane + 3];
            float A = g0 + g1, B = fmaxf(g0 + al0 + g1, g1 + al1);
#pragma unroll
            for (int o = 1; o < 64; o <<= 1) { const float Ap = __shfl_up(A, o), Bp = __shfl_up(B, o); if (lane >= o) { B = fmaxf(Bp + A, B); A = Ap + A; } }
            float Ae = __shfl_up(A, 1), Be = __shfl_up(B, 1); if (lane == 0) { Ae = 0.f; Be = -3.0e38f; }
            const float m0 = fmaxf(Ae, Be), mn0 = g0 + fmaxf(m0, al0), mn1 = g1 + fmaxf(mn0, al1);
            mv[2 * lane] = m0; dec[2 * lane] = __expf(g0 + m0 - mn0); scl[2 * lane] = __expf(g0 + al0 - mn0);
            mv[2 * lane + 1] = mn0; dec[2 * lane + 1] = __expf(g1 + mn0 - mn1); scl[2 * lane + 1] = __expf(g1 + al1 - mn1);
        }
        __syncthreads();
        if (rem0 == 0 && tid < 128) MS[h * 128 + tid] = mv[tid];
        const int rem = rem0 + tid;
        const float* ul = UL + (size_t)h * NCH * 32768 + rem; bf16* cs = CS + (size_t)h * NCH * 32768 + rem;
        float C = 0.f;
#pragma unroll 1
        for (int c0 = 0; c0 < NCH; c0 += 64) {
            float u[64];
#pragma unroll
            for (int i = 0; i < 64; ++i) u[i] = ul[(size_t)(c0 + i) * 32768];
#pragma unroll
            for (int i = 0; i < 64; ++i) { cs[(size_t)(c0 + i) * 32768] = (bf16)f2bf(C); C = dec[c0 + i] * C + scl[c0 + i] * u[i]; }
        }
        if (rem0 == 0 && tid < 128) { float n = 0.f; const float* nl = NL + (size_t)h * NCH * 128 + tid; float* ns = NS + (size_t)h * NCH * 128 + tid;
#pragma unroll 8
            for (int c = 0; c < NCH; ++c) { ns[c * 128] = n; n = dec[c] * n + scl[c] * nl[c * 128]; } }
        __syncthreads();
    }
}
constexpr int NUMSTR = 260;
__device__ __forceinline__ void p5_mlstm_out(Frame& F) {
    LAS bf16* VT = (LAS bf16*)(F.lds + RING_OFF);
    LAS bf16* Pm = VT + 256 * TSTR;
    LAS float* NUM = (LAS float*)(Pm + 64 * TSTR);
    LAS float* a_s = NUM + 64 * NUMSTR; LAS float* Mt = a_s + 64; LAS float* inter = Mt + 64; LAS float* emt = inter + 64; LAS float* qn = emt + 64; LAS float* dinv = qn + 64;
    const bf16* proj = wsp<bf16>(F, WS_PROJ); const float* gates = wsp<float>(F, WS_GATES); const bf16* CS = wsp<bf16>(F, WS_CS);
    const float* NS = wsp<float>(F, WS_NS); const float* MS = wsp<float>(F, WS_MS); bf16* concat = wsp<bf16>(F, WS_CONCAT);
    const int tid = F.tid, lane = F.lane, w = F.wave, hi = lane >> 5, l31 = lane & 31;
    for (int u = F.vcu; u < 4 * NCH; u += F.G) {
        const int h = u >> 7, ch = u & 127, t0 = ch * LCH;
        const bf16* qbase = proj + (size_t)t0 * NPP + C_MQ + h * 128; const bf16* kbase = proj + (size_t)t0 * NPP + C_MK + h * 128;
        if (w == 0) {
            const float ip = softcap_f(gates[(size_t)(t0 + lane) * 16 + h] + F.in[IN_BI][h]);
            const float fp = softcap_f(gates[(size_t)(t0 + lane) * 16 + 4 + h] + F.in[IN_BF][h]);
            const float g = wave_scan_add(log_sigmoid_f(fp), lane), a = ip - g, cm = wave_scan_max(a, lane);
            const float mp = MS[u], M = fmaxf(mp, cm);
            a_s[lane] = a; Mt[lane] = M; inter[lane] = __expf(mp - M); emt[lane] = __expf(-(g + M));
        }
        stage_transposed<false>(proj + (size_t)t0 * NPP + C_MV + h * 256, 256, VT, a_s, tid);
        __syncthreads();
        if (w < 4) {
            const int ti = w >> 1, si = w & 1;
            if (si <= ti) {
                s16x8 qa[8], kb[8];
#pragma unroll
                for (int ks = 0; ks < 8; ++ks) { qa[ks] = *(const GAS s16x8*)(qbase + (size_t)(32 * ti + l31) * NPP + 16 * ks + 8 * hi); kb[ks] = *(const GAS s16x8*)(kbase + (size_t)(32 * si + l31) * NPP + 16 * ks + 8 * hi); }
                f32x16 acc;
#pragma unroll
                for (int r = 0; r < 16; ++r) acc[r] = 0.f;
#pragma unroll
                for (int ks = 0; ks < 8; ++ks) acc = MFMA32(qa[ks], kb[ks], acc);
                const int s = 32 * si + l31; const float as = a_s[s];
#pragma unroll
                for (int r = 0; r < 16; ++r) { const int t = 32 * ti + crow32(r, hi); const float p = (s <= t) ? acc[r] * SCALEQ * __expf(as - Mt[t]) : 0.f; Pm[t * TSTR + s] = (bf16)f2bf(p); }
            } else {
#pragma unroll
                for (int r = 0; r < 16; ++r) Pm[(32 * ti + crow32(r, hi)) * TSTR + 32 * si + l31] = (bf16)0;
            }
        } else {
            const int t = (tid - 256) >> 2, d0 = ((tid - 256) & 3) * 32; float s = 0.f; const float* np = NS + (size_t)u * 128 + d0;
#pragma unroll
            for (int j = 0; j < 4; ++j) { const s16x8 qv = *(const GAS s16x8*)(qbase + (size_t)t * NPP + d0 + 8 * j);
#pragma unroll
                for (int i = 0; i < 8; ++i) s += bf2f((unsigned short)qv[i]) * np[8 * j + i]; }
            s += __shfl_xor(s, 1); s += __shfl_xor(s, 2);
            if ((tid & 3) == 0) qn[t] = s * SCALEQ;
        }
        __syncthreads();
        f32x16 accP[2], accC[2];
#pragma unroll
        for (int ti = 0; ti < 2; ++ti)
#pragma unroll
            for (int r = 0; r < 16; ++r) { accP[ti][r] = 0.f; accC[ti][r] = 0.f; }
        {
            const bf16* cs = CS + (size_t)u * 32768 + (size_t)(32 * w + l31) * 128 + 8 * hi;
            s16x8 cb[8];
#pragma unroll
            for (int ks = 0; ks < 8; ++ks) cb[ks] = *(const GAS s16x8*)(cs + 16 * ks);
#pragma unroll
            for (int ti = 0; ti < 2; ++ti) {
                s16x8 qa[8];
#pragma unroll
                for (int ks = 0; ks < 8; ++ks) qa[ks] = *(const GAS s16x8*)(qbase + (size_t)(32 * ti + l31) * NPP + 16 * ks + 8 * hi);
#pragma unroll
                for (int ks = 0; ks < 8; ++ks) accC[ti] = MFMA32(qa[ks], cb[ks], accC[ti]);
            }
#pragma unroll
            for (int ks = 0; ks < 4; ++ks) { const s16x8 vb = *(const LAS s16x8*)(VT + TSW(32 * w + l31, ks, hi));
#pragma unroll
                for (int ti = 0; ti < 2; ++ti) { const s16x8 pa = *(const LAS s16x8*)(Pm + (32 * ti + l31) * TSTR + 16 * ks + 8 * hi); accP[ti] = MFMA32(pa, vb, accP[ti]); } }
        }
        if (w == 0) {
            float rs = 0.f;
#pragma unroll
            for (int j = 0; j < 8; ++j) { const s16x8 pv = *(const LAS s16x8*)(Pm + lane * TSTR + 8 * j);
#pragma unroll
                for (int i = 0; i < 8; ++i) rs += bf2f((unsigned short)pv[i]); }
            const float dn = rs + inter[lane] * qn[lane];
            dinv[lane] = 1.f / fmaxf(fabsf(dn), emt[lane]);
        }
        __syncthreads();
#pragma unroll
        for (int ti = 0; ti < 2; ++ti)
#pragma unroll
            for (int r = 0; r < 16; ++r) { const int t = 32 * ti + crow32(r, hi); NUM[t * NUMSTR + 32 * w + l31] = (accP[ti][r] + inter[t] * SCALEQ * accC[ti][r]) * dinv[t]; }
        __syncthreads();
        {
            const f32x4 gn = *(const GAS f32x4*)(F.in[IN_MOUTN] + h * 256 + 4 * lane);
#pragma unroll
            for (int i = 0; i < 8; ++i) { const int t = 8 * w + i; const f32x4 x = *(const LAS f32x4*)(NUM + t * NUMSTR + 4 * lane);
                const float ss = wave_sum((x.x * x.x + x.y * x.y) + (x.z * x.z + x.w * x.w)); const float r = rsqrtf(ss * (1.f / 256.f) + 1e-6f);
                const u32x2 mo = *(const GAS u32x2*)(proj + (size_t)(t0 + t) * NPP + C_MO + h * 256 + 4 * lane);
                const float o0 = x.x * r * gn.x * sigmoid_f(bf2f((unsigned short)(mo.x & 0xffffu))), o1 = x.y * r * gn.y * sigmoid_f(bf2f((unsigned short)(mo.x >> 16)));
                const float o2 = x.z * r * gn.z * sigmoid_f(bf2f((unsigned short)(mo.y & 0xffffu))), o3 = x.w * r * gn.w * sigmoid_f(bf2f((unsigned short)(mo.y >> 16)));
                u32x2 ov; ov.x = pk2(o0, o1); ov.y = pk2(o2, o3);
                *(GAS u32x2*)(concat + (size_t)(t0 + t) * D + h * 256 + 4 * lane) = ov; }
        }
        __syncthreads();
    }
}
}
namespace mk {
__device__ __forceinline__ void attn_build_schedule(Frame& F) {
    LAS int* jl = (LAS int*)(F.lds + TAB_OFF); LAS int* pre = jl + 256; LAS int* wtot = pre + 260;
    const int tid = F.tid, lane = F.lane;
    if (tid < 256) { const int j = wsp<int>(F, WS_JLO)[tid]; jl[tid] = j; const int n = 4 * (tid & 31) + 4 - j; int v = (n + ATT_CH - 1) / ATT_CH;
        int inc = v;
#pragma unroll
        for (int o = 1; o < 64; o <<= 1) { const int t = __shfl_up(inc, o); if (lane >= o) inc += t; }
        pre[tid + 1] = inc; if (lane == 63) wtot[tid >> 6] = inc; }
    __syncthreads();
    if (tid < 256) { int add = 0; for (int w2 = 0; w2 < (tid >> 6); ++w2) add += wtot[w2]; pre[tid + 1] += add; if (tid == 0) pre[0] = 0; }
    __syncthreads();
}
__device__ __forceinline__ fox::BlockRef<fox::bf16, fox::bf16> fox_ref(const Frame& F, int I) {
    const LAS int* jl = (const LAS int*)(F.lds + TAB_OFF); const LAS int* pre = jl + 256;
    int b = 0;
#pragma unroll
    for (int st = 128; st >= 1; st >>= 1) if (pre[b + st] <= I) b += st;
    b = __builtin_amdgcn_readfirstlane(b);
    const int pb0 = __builtin_amdgcn_readfirstlane(pre[b]), pb1 = __builtin_amdgcn_readfirstlane(pre[b + 1]), j0 = __builtin_amdgcn_readfirstlane(jl[b]);
    const int h = b >> 5, qb = b & 31, part = I - pb0, P = pb1 - pb0, n = 4 * qb + 4 - j0;
    fox::BlockRef<fox::bf16, fox::bf16> r;
    const fox::bf16* proj = (const fox::bf16*)(F.ws + WS_PROJ);
    r.Q = proj + (size_t)(qb * 256) * fox::PITCH + C_FQ + h * 128; r.K = proj + C_FK + h * 128; r.V = proj + C_FV + h * 128;
    r.O = (fox::bf16*)(F.ws + WS_CONCAT) + (size_t)(qb * 256) * D + 1024 + h * 128; r.P0 = qb * 256;
    r.Fb = (const float*)(F.ws + WS_F) + h * S; r.gain = F.in[IN_FOUTN] + h * 128;
    r.jlo = j0 + (part * n) / P; r.jhi = j0 + ((part + 1) * n) / P;
    r.Op = P > 1 ? (float*)((bf16*)(F.ws + WS_OPART) + (size_t)I * 256 * 128) : nullptr; r.ML = (float*)(F.ws + WS_MLP) + (size_t)I * 512;
    return r;
}
__device__ __forceinline__ void p5_attention(Frame& F, char* ldsg) {
    typedef fox::BlockRef<fox::bf16, fox::bf16> BR;
    attn_build_schedule(F);
    const int total = __builtin_amdgcn_readfirstlane(((const LAS int*)(F.lds + TAB_OFF))[256 + 256]);
#define ATT_ITEM(r) (total - 1 - ((r) * F.G + (((r) & 1) ? F.G - 1 - F.vcu : F.vcu)))
    int r = 0; int L = ATT_ITEM(0); if (L < 0) return;
    BR cur = fox_ref(F, L);
    fox::Seam<fox::bf16> Sm;
    fox::causal_swa_prime<fox::bf16, fox::bf16>(cur, S, ldsg, Sm);
    for (;;) {
        const int Ln = ATT_ITEM(r + 1); const bool more = Ln >= 0;
        const BR nxt = more ? fox_ref(F, Ln) : cur;
        fox::causal_swa_block<fox::bf16, fox::bf16>(cur, nxt, S, S, ldsg, Sm);
        if (!more) break;
        cur = nxt; ++r;
    }
#undef ATT_ITEM
}
struct CombRow { f32x2 ml[8]; unsigned ov[8]; int P, b, r; };
__device__ __forceinline__ void comb_load(const Frame& F, CombRow& R, int idx) {
    const LAS int* pre = (const LAS int*)(F.lds + TAB_OFF) + 256;
    const bf16* OP = wsp<bf16>(F, WS_OPART); const float* MLP = wsp<float>(F, WS_MLP);
    R.b = idx >> 8; R.r = idx & 255; const int i0 = __builtin_amdgcn_readfirstlane(pre[R.b]); R.P = __builtin_amdgcn_readfirstlane(pre[R.b + 1]) - i0;
    if (R.P <= 1) return;
#pragma unroll
    for (int p2 = 0; p2 < 8; ++p2) if (p2 < R.P) { R.ml[p2] = *(const GAS f32x2*)(MLP + (size_t)(i0 + p2) * 512 + 2 * R.r); R.ov[p2] = *(const GAS unsigned*)(OP + ((size_t)(i0 + p2) * 256 + R.r) * 128 + 2 * F.lane); }
}
__device__ __forceinline__ void comb_finish(const Frame& F, const CombRow& R) {
    if (R.P <= 1) return;
    constexpr float C2 = 1.4426950408889634f * SCALEQ;
    bf16* concat = wsp<bf16>(F, WS_CONCAT); const int lane = F.lane, h = R.b >> 5, qb = R.b & 31;
    float ms = -3.0e38f;
#pragma unroll
    for (int p2 = 0; p2 < 8; ++p2) if (p2 < R.P) ms = fmaxf(ms, R.ml[p2].x);
    float n0 = 0.f, n1 = 0.f, den = 0.f;
#pragma unroll
    for (int p2 = 0; p2 < 8; ++p2) if (p2 < R.P) { const float wgt = __builtin_amdgcn_exp2f((R.ml[p2].x - ms) * C2); n0 += wgt * __uint_as_float(R.ov[p2] << 16); n1 += wgt * __uint_as_float(R.ov[p2] & 0xffff0000u); den += wgt * R.ml[p2].y; }
    const float inv = 1.f / den, v0 = n0 * inv, v1 = n1 * inv;
    const float ss = wave_sum(v0 * v0 + v1 * v1), rn = rsqrtf(ss * (1.f / 128.f) + 1e-6f);
    const int r32 = lane >> 1, c0 = 64 * (lane & 1) + r32; const float* gp = F.in[IN_FOUTN] + h * 128 + c0;
    const float o0 = v0 * rn * gp[0], o1 = v1 * rn * gp[32];
    const bool ev = (r32 & 1) == 0; const float rcv = __shfl_xor(ev ? o1 : o0, 2);
    *(GAS unsigned*)(concat + (size_t)(qb * 256 + R.r) * D + 1024 + h * 128 + (ev ? c0 : c0 + 31)) = ev ? pk2(o0, rcv) : pk2(rcv, o1);
}
__device__ __forceinline__ void p6_combine(Frame& F) {
    attn_build_schedule(F);
    const int gw = F.vcu * NWAVES + F.wave, NGW = F.G * NWAVES;
    for (int idx = gw; idx < 256 * 256; idx += 2 * NGW) {
        CombRow A, B; comb_load(F, A, idx); const bool hb = idx + NGW < 256 * 256; B.P = 0; if (hb) comb_load(F, B, idx + NGW);
        comb_finish(F, A); comb_finish(F, B);
    }
}
constexpr int RROWS = 8, NITER = S / RROWS;
__device__ __forceinline__ void router_load_weights(const Frame& F, s16x8 (&whi)[16], s16x8 (&wlo)[16]) {
    const int lane = F.lane, w = F.wave, hh = lane >> 5; const float* wp = F.in[IN_WR] + (size_t)(256 * w + 8 * hh) * NE + (lane & 31);
#pragma unroll
    for (int ks = 0; ks < 16; ++ks) { float wv[8];
#pragma unroll
        for (int j = 0; j < 8; ++j) wv[j] = wp[(size_t)(16 * ks + j) * NE];
        unsigned hw[4], lw[4];
#pragma unroll
        for (int j = 0; j < 4; ++j) { const unsigned a = f2bf(wv[2 * j]), b = f2bf(wv[2 * j + 1]); hw[j] = a | (b << 16); lw[j] = pk2(wv[2 * j] - bf2f((unsigned short)a), wv[2 * j + 1] - bf2f((unsigned short)b)); }
        const v4u hv4 = {hw[0], hw[1], hw[2], hw[3]}, lv4 = {lw[0], lw[1], lw[2], lw[3]};
        whi[ks] = __builtin_bit_cast(s16x8, hv4); wlo[ks] = __builtin_bit_cast(s16x8, lv4); }
}
__device__ __forceinline__ void p7_router(Frame& F, const s16x8 (&whi)[16], const s16x8 (&wlo)[16]) {
    LAS float* shs = (LAS float*)(F.lds + RING_OFF);
    constexpr int HSTR = 2064;
    LAS bf16* H2hi = (LAS bf16*)(shs + 2 * D);
    LAS bf16* H2lo = H2hi + RROWS * HSTR;
    LAS float* red = (LAS float*)(H2lo + RROWS * HSTR);
    LAS int* selE = (LAS int*)(red + 8 * RROWS * NE);
    const float* mod = wsp<float>(F, WS_MOD); const float* h1 = wsp<float>(F, WS_H1); unsigned char* h2 = wsp<unsigned char>(F, WS_HN);
    int* top_i = wsp<int>(F, WS_TOPI); float* top_w = wsp<float>(F, WS_TOPW); int* hist = wsp<int>(F, WS_HIST); int* lrank = wsp<int>(F, WS_LRANK);
    const int tid = F.tid, lane = F.lane, w = F.wave;
    for (int i = tid; i < 2 * D; i += NTHR) shs[i] = mod[3 * D + i];
    __syncthreads();
    for (int it = F.vcu; it < NITER; it += F.G) {
        const int r0 = it * RROWS;
        {
            const int m = r0 + w; const GAS f32x4* xr = (const GAS f32x4*)(h1 + (size_t)m * D) + lane; f32x4 v[8]; float s2 = 0.f;
#pragma unroll
            for (int j = 0; j < 8; ++j) { v[j] = xr[64 * j]; s2 += (v[j].x * v[j].x + v[j].y * v[j].y) + (v[j].z * v[j].z + v[j].w * v[j].w); }
            const float r = rsqrtf(wave_sum(s2) * (1.f / D) + 1e-6f);
            GAS unsigned* o8 = (GAS unsigned*)(h2 + (size_t)m * D) + lane;
#pragma unroll
            for (int j = 0; j < 8; ++j) { const int c0 = 4 * lane + 256 * j; const f32x4 gg = *(const GAS f32x4*)(F.in[IN_NFFN] + c0); const f32x4 a = *(const LAS f32x4*)(shs + D + c0), b = *(const LAS f32x4*)(shs + c0);
                const f32x4 y = v[j] * r * gg * (a + 1.f) + b; o8[64 * j] = pk4_fp8(y.x, y.y, y.z, y.w);
                const unsigned h0 = pk2(y.x, y.y), h1w = pk2(y.z, y.w); u32x2 hv; hv.x = h0; hv.y = h1w;
                u32x2 lv; lv.x = pk2(y.x - bf2f((unsigned short)(h0 & 0xffffu)), y.y - bf2f((unsigned short)(h0 >> 16))); lv.y = pk2(y.z - bf2f((unsigned short)(h1w & 0xffffu)), y.w - bf2f((unsigned short)(h1w >> 16)));
                *(LAS u32x2*)(H2hi + w * HSTR + c0) = hv; *(LAS u32x2*)(H2lo + w * HSTR + c0) = lv; }
        }
        __syncthreads();
        {
            f32x16 acc;
#pragma unroll
            for (int r = 0; r < 16; ++r) acc[r] = 0.f;
            const int hh = lane >> 5; const LAS bf16* bh = H2hi + (lane & 7) * HSTR + 256 * w + 8 * hh; const LAS bf16* bl = H2lo + (lane & 7) * HSTR + 256 * w + 8 * hh;
#pragma unroll
            for (int ks = 0; ks < 16; ++ks) { const s16x8 xh = *(const LAS s16x8*)(bh + 16 * ks), xl = *(const LAS s16x8*)(bl + 16 * ks);
                acc = MFMA32(whi[ks], xh, acc); acc = MFMA32(whi[ks], xl, acc); acc = MFMA32(wlo[ks], xh, acc); }
            if ((lane & 31) < RROWS) {
#pragma unroll
                for (int r = 0; r < 16; ++r) red[(w * RROWS + (lane & 31)) * NE + crow32(r, hh)] = acc[r]; }
        }
        __syncthreads();
        if (tid < RROWS * NE) {
            const int r = tid >> 5, e = tid & 31; float lg = F.in[IN_BR][e];
#pragma unroll
            for (int kp = 0; kp < 8; ++kp) lg += red[(kp * RROWS + r) * NE + e];
            float cur = lg, mx = 0.f, sum = 0.f, mysel = 0.f; int myidx = 0;
#pragma unroll
            for (int q = 0; q < 4; ++q) { float best = cur; int bi = e;
#pragma unroll
                for (int o = 1; o < 32; o <<= 1) { const float ob = __shfl_xor(best, o); const int oi = __shfl_xor(bi, o); if (ob > best || (ob == best && oi < bi)) { best = ob; bi = oi; } }
                if (q == 0) mx = best;
                sum += __expf(best - mx);
                if (e == q) { mysel = best; myidx = bi; }
                if (e == bi) cur = -3.0e38f; }
            if (e < 4) { const int t = r0 + r; top_i[t * 4 + e] = myidx; top_w[t * 4 + e] = __expf(mysel - mx) / sum; selE[r * 4 + e] = myidx; }
        }
        __syncthreads();
        if (tid < 32) { const int me = selE[tid]; int rank = 0, cnt = 0;
#pragma unroll
            for (int p = 0; p < 32; ++p) { const int ep = selE[p]; rank += (ep == me && p < tid) ? 1 : 0; cnt += (ep == tid) ? 1 : 0; }
            lrank[it * 32 + tid] = rank; hist[it * NE + tid] = cnt; }
        __syncthreads();
    }
}
__device__ __forceinline__ void build_expert_table(Frame& F, const int* counts_g) {
    LAS int* tab = (LAS int*)(F.lds + TAB_OFF);
    if (F.tid < 64) {
        const int lane = F.tid, c = lane < NE ? counts_g[lane] : 0, nt = (c + 255) >> 8; int inc = nt;
#pragma unroll
        for (int o = 1; o < 64; o <<= 1) { const int t = __shfl_up(inc, o); if (lane >= o) inc += t; }
        if (lane < NE) { tab[lane] = inc - nt; tab[40 + lane] = c; }
        if (lane == NE - 1) tab[32] = inc; }
    __syncthreads();
}
__device__ __forceinline__ void p8_gather(Frame& F) {
    LAS unsigned short* loc = (LAS unsigned short*)(F.lds + RING_OFF);
    LAS int* psum = (LAS int*)(F.lds + RING_OFF + 65536);
    LAS int* startr = psum + 16 * NE;
    const int* hist = wsp<int>(F, WS_HIST); const int* lrank = wsp<int>(F, WS_LRANK); const int* top_i = wsp<int>(F, WS_TOPI); const float* top_w = wsp<float>(F, WS_TOPW);
    int* pos = wsp<int>(F, WS_POS); float* roww = wsp<float>(F, WS_ROWW); int* rowtok = wsp<int>(F, WS_ROWTOK);
    int* counts_g = (int*)(F.ws + WS_POS) + S * 4;
    const int tid = F.tid, lane = F.lane, w = F.wave;
    { const int e = tid & 31, part = tid >> 5; int hv[64];
#pragma unroll
        for (int i = 0; i < 64; ++i) hv[i] = hist[(part * 64 + i) * NE + e];
        int s = 0;
#pragma unroll
        for (int i = 0; i < 64; ++i) { loc[(part * 64 + i) * NE + e] = (unsigned short)s; s += hv[i]; }
        psum[part * NE + e] = s; }
    __syncthreads();
    if (tid < 64) { int tot = 0;
        if (tid < NE) {
#pragma unroll
            for (int p = 0; p < 16; ++p) { const int v = psum[p * NE + tid]; psum[p * NE + tid] = tot; tot += v; } }
        const int padded = ((tot + 255) >> 8) << 8; int inc = padded;
#pragma unroll
        for (int o = 1; o < 64; o <<= 1) { const int t = __shfl_up(inc, o); if (lane >= o) inc += t; }
        if (tid < NE) { startr[tid] = inc - padded; startr[NE + tid] = tot; if (blockIdx.x == 0) counts_g[tid] = tot; } }
    __syncthreads();
    for (int e = (int)blockIdx.x; e < NE; e += (int)gridDim.x) {
        const int c = startr[NE + e], pad = (((c + 255) >> 8) << 8) - c; for (int r = tid; r < pad; r += NTHR) rowtok[startr[e] + c + r] = S; }
    if (blockIdx.x == 0 && tid < 128) ((GAS v4u*)(wsp<unsigned char>(F, WS_HN) + (size_t)S * D))[tid] = (v4u){0u, 0u, 0u, 0u};
    for (int itb = F.vcu; itb < NITER; itb += 4 * F.G) {
        const int pi = 16 * w + (lane & 15), it = itb + (pi >> 5) * F.G; const bool valid = it < NITER;
        if (valid && lane < 16) { const int pair = it * 32 + (pi & 31), e = top_i[pair], dest = startr[e] + psum[(it >> 6) * NE + e] + (int)loc[it * NE + e] + lrank[pair];
            pos[pair] = dest; roww[dest] = top_w[pair]; rowtok[dest] = pair >> 2; }
    }
}
struct GroupedOrder {
    const LAS int* tab; int ntn, G, c;
    __device__ __forceinline__ bool next(int i, Unit& u) const {
        const int L0 = i * G + c, total = tab[32] * ntn; if (L0 >= total) return false;
        int L; { const int qq = total / pg8::NXCD, rr = total % pg8::NXCD, xcd = L0 % pg8::NXCD, off = L0 / pg8::NXCD; L = (xcd < rr ? xcd * (qq + 1) : rr * (qq + 1) + (xcd - rr) * qq) + off; }
        int e = (u.e > 0 && u.e < NE && tab[u.e] * ntn <= L) ? u.e : 0;
#pragma unroll 1
        while (e < NE - 1 && tab[e + 1] * ntn <= L) ++e;
        const int ts = tab[e], tc = tab[e + 1] - ts, within = L - ts * ntn;
        u.pm = ts + within % tc; u.pn = within / tc; u.e = e; u.pb = e * ntn + u.pn; return true;
    }
    __device__ __forceinline__ void a_ready(const Unit&) const {}
    __device__ __forceinline__ void done(const Unit&) const {}
    __device__ __forceinline__ int rows(const Unit& u) const { return __builtin_amdgcn_readfirstlane(tab[40 + u.e] - ((u.pm - tab[u.e]) << 8)); }
};
struct EpiSwiglu {
    static constexpr bool PERM = true, AFTER_DRAIN = false;
    unsigned char* act; const float* bug; const LAS int* tab;
    __device__ __forceinline__ void operator()(const pg8::f32x4 (&acc)[2][2][4][2], const Unit& u, int wr, int wc, int fr, int fq) const {
        const int row0 = u.pm * 256 + wr * 64 + fr, f0 = u.pn * 128 + wc * 32 + 8 * fq;
        const int vr = tab[40 + u.e] - ((u.pm - tab[u.e]) << 8);
        const float* bg = bug + (size_t)u.e * 4096 + f0; pg8::f32x4 bgv[2], buv[2];
#pragma unroll
        for (int n = 0; n < 2; ++n) { bgv[n] = *(const pg8::f32x4*)(bg + 4 * n); buv[n] = *(const pg8::f32x4*)(bg + 2048 + 4 * n); }
#pragma unroll
        for (int ai = 0; ai < 2; ++ai)
#pragma unroll
            for (int m = 0; m < 4; ++m) { float o[8];
#pragma unroll
                for (int n = 0; n < 2; ++n)
#pragma unroll
                    for (int i = 0; i < 4; ++i) { const float g = fminf(acc[ai][0][m][n][i] + bgv[n][i], 7.f); const float up = fminf(fmaxf(acc[ai][1][m][n][i] + buv[n][i], -7.f), 7.f);
                        o[4 * n + i] = (up + 1.f) * g * __builtin_amdgcn_rcpf(1.f + __builtin_amdgcn_exp2f(-2.45546696f * g)); }
                u32x2 wv; wv.x = pk4_fp8(o[0], o[1], o[2], o[3]); wv.y = pk4_fp8(o[4], o[5], o[6], o[7]);
                if (wr * 64 + fr + ai * 128 + m * 16 >= vr) { wv.x = 0u; wv.y = 0u; }
                *(u32x2*)(act + (size_t)(row0 + ai * 128 + m * 16) * FF + f0) = wv; }
    }
};
struct EpiDown {
    static constexpr bool PERM = true, AFTER_DRAIN = false;
    unsigned char* y; const float* bd; const float* roww;
    __device__ __forceinline__ void operator()(const pg8::f32x4 (&acc)[2][2][4][2], const Unit& u, int wr, int wc, int fr, int fq) const {
        const int row0 = u.pm * 256 + wr * 64 + fr, col0 = u.pn * 256 + wc * 32 + 8 * fq;
        pg8::f32x4 bv[2][2];
#pragma unroll
        for (int bj = 0; bj < 2; ++bj)
#pragma unroll
            for (int n = 0; n < 2; ++n) bv[bj][n] = *(const pg8::f32x4*)(bd + (size_t)u.e * D + col0 + bj * 128 + 4 * n);
#pragma unroll
        for (int ai = 0; ai < 2; ++ai)
#pragma unroll
            for (int m = 0; m < 4; ++m) { const int row = row0 + ai * 128 + m * 16; const float rw = roww[row] * 16.f; unsigned char* rowp = y + (size_t)row * D + col0;
#pragma unroll
                for (int bj = 0; bj < 2; ++bj) { const pg8::f32x4 v0 = (acc[ai][bj][m][0] + bv[bj][0]) * rw, v1 = (acc[ai][bj][m][1] + bv[bj][1]) * rw;
                    u32x2 wv; wv.x = pk4_fp8(v0[0], v0[1], v0[2], v0[3]); wv.y = pk4_fp8(v1[0], v1[1], v1[2], v1[3]);
                    *(u32x2*)(rowp + bj * 128) = wv; } }
    }
};
__device__ __forceinline__ void p11_final(Frame& F, float oscale) {
    LAS float* ms = (LAS float*)(F.lds + RING_OFF);
    const float* mod = wsp<float>(F, WS_MOD);
    for (int i = F.tid; i < 3 * D; i += NTHR) ms[i] = mod[5 * D + i];
    __syncthreads();
    const float* h1 = wsp<float>(F, WS_H1); const unsigned char* y = wsp<unsigned char>(F, WS_Y); const int* pos = wsp<int>(F, WS_POS);
    const int gw = F.vcu * NWAVES + F.wave, NGW = F.G * NWAVES, lane = F.lane;
    for (int t = gw; t < S; t += NGW) {
        asm volatile("" ::: "memory");
        const GAS f32x4* xr = (const GAS f32x4*)(h1 + (size_t)t * D) + lane;
        const GAS unsigned* y0 = (const GAS unsigned*)(y + (size_t)pos[t * 4 + 0] * D) + lane; const GAS unsigned* y1 = (const GAS unsigned*)(y + (size_t)pos[t * 4 + 1] * D) + lane;
        const GAS unsigned* y2 = (const GAS unsigned*)(y + (size_t)pos[t * 4 + 2] * D) + lane; const GAS unsigned* y3 = (const GAS unsigned*)(y + (size_t)pos[t * 4 + 3] * D) + lane;
        f32x4 v[8]; float s2 = 0.f;
#pragma unroll
        for (int j = 0; j < 8; ++j) { const unsigned a = y0[64 * j], b = y1[64 * j], c = y2[64 * j], d = y3[64 * j]; const f32x4 g2 = *(const LAS f32x4*)(ms + 4 * lane + 256 * j) * (1.f / 16.f);
            const f32x2 al = __builtin_amdgcn_cvt_pk_f32_fp8((int)a, false), ah = __builtin_amdgcn_cvt_pk_f32_fp8((int)a, true), bl = __builtin_amdgcn_cvt_pk_f32_fp8((int)b, false), bh = __builtin_amdgcn_cvt_pk_f32_fp8((int)b, true);
            const f32x2 cl = __builtin_amdgcn_cvt_pk_f32_fp8((int)c, false), ch = __builtin_amdgcn_cvt_pk_f32_fp8((int)c, true), dl = __builtin_amdgcn_cvt_pk_f32_fp8((int)d, false), dh = __builtin_amdgcn_cvt_pk_f32_fp8((int)d, true);
            f32x4 f;
            f.x = (al.x + bl.x) + (cl.x + dl.x); f.y = (al.y + bl.y) + (cl.y + dl.y); f.z = (ah.x + bh.x) + (ch.x + dh.x); f.w = (ah.y + bh.y) + (ch.y + dh.y);
            v[j] = xr[64 * j] + g2 * f; s2 += (v[j].x * v[j].x + v[j].y * v[j].y) + (v[j].z * v[j].z + v[j].w * v[j].w); }
        const float r = rsqrtf(wave_sum(s2) * (1.f / D) + 1e-6f);
        GAS f32x4* o = (GAS f32x4*)(F.out + (size_t)t * D) + lane;
#pragma unroll
        for (int j = 0; j < 8; ++j) { const int c0 = 4 * lane + 256 * j; const f32x4 gg = *(const GAS f32x4*)(F.in[IN_NFIN] + c0); const f32x4 sh = *(const LAS f32x4*)(ms + D + c0), sc = *(const LAS f32x4*)(ms + 2 * D + c0);
            o[64 * j] = (v[j] * r * gg * (sc + 1.f) + sh) * oscale; }
    }
}
}
namespace mk {
struct Args { const float* in[24]; float* out; unsigned char* ws; int ph_lo, ph_hi, li, pad; };
constexpr int N_PHASES = 13;
__global__ void __launch_bounds__(NTHR, 2) mega_fwd(Args args) {
    extern __shared__ __attribute__((aligned(16))) unsigned char lds[];
    Frame F;
    F.lds = (LAS unsigned char*)lds;
    F.MISC = (volatile LAS unsigned*)(F.lds + MISC_OFF);
    F.tid = threadIdx.x; F.lane = F.tid & 63; F.wave = __builtin_amdgcn_readfirstlane(F.tid >> 6);
    leave_group(F);
    F.ws = args.ws; F.out = args.out; F.ctl = (gu32*)(args.ws + WS_CTL);
#pragma unroll
    for (int i = 0; i < 24; ++i) F.in[i] = args.in[i];
    for (int u = F.tid; u < (LDS_BYTES - LDSCTL_OFF) / 4; u += NTHR) ((LAS unsigned*)(F.lds + LDSCTL_OFF))[u] = 0u;
    __syncthreads();
    XcdBarrier bar = xcd_barrier_post((unsigned*)(F.ctl + CW_BAR) + args.li * XCD_BAR_WORDS, F.MISC + 8);
    const int lo = args.ph_lo, hi = args.ph_hi;
#define IN(k) (lo <= (k) && (k) < hi)
#define SEAM(k) do { if (IN(k) && IN((k) + 1)) { xcd_barrier(bar); if (MK_DBLBAR) xcd_barrier(bar); } } while (0)

#ifndef MK_DBLBAR
#define MK_DBLBAR 0
#endif
#ifndef MK_DOUBLE
#define MK_DOUBLE 0
#endif
#define DBL(k) ((MK_DOUBLE >> (k)) & 1)
#ifdef MK_PROBE_LO
    unsigned long long* stamps = (unsigned long long*)(F.ctl + 131072);
#define STAMP(k) do { if (blockIdx.x == 0 && F.tid == 0) stamps[k] = rt(); } while (0)
#define PROBE_SCALE() (1.f + sqrtf((float)(stamps[MK_PROBE_HI] - stamps[MK_PROBE_LO]) * 0.01f * 2e-5f))
#elif defined(MK_PROBE_TILES)
#define STAMP(k) do { } while (0)
    auto probe_tiles = [&]() -> float { int tt = 0, ni = 0; for (int b = 0; b < 256; ++b) { const int n = 4 * (b & 31) + 4 - wsp<int>(F, WS_JLO)[b]; tt += n; ni += (n + ATT_CH - 1) / ATT_CH; } return MK_PROBE_TILES == 1 ? (float)tt : (float)ni; };
#define PROBE_SCALE() (1.f + sqrtf(probe_tiles() * 1e-6f))
#else
#define STAMP(k) do { } while (0)
#define PROBE_SCALE() 1.f
#endif
    STAMP(0); if (IN(0)) { p0_gemv(F); } SEAM(0);
    STAMP(1); if (IN(1)) { p1_modulate(F, args.pad); if (DBL(1)) p1_modulate(F, args.pad); } SEAM(1);
    STAMP(2); if (IN(2)) {
        gu32* done = F.ctl + CW_DONE + 64 * 2;
        if (enter_group(F, GC_INPROJ)) {
            pg8::Gemm g{wsp<pg8::bf16_t>(F, WS_HN), wsp<pg8::bf16_t>(F, WS_WIN), S, NPP, D}; pg8::StaticOrder So; So.init(S, NPP, F.G, F.bid);
            EpiProj E{wsp<bf16>(F, WS_PROJ), (PG8_LAS float*)(F.lds + TAB_OFF + 1024), F.in[IN_FOXQN], F.in[IN_FOXKN]};
            pg8::gemm_phase<EpiProj, pg8::StaticOrder, true, true>(F.lds + RING_OFF, g, So, E);
            if (DBL(2)) pg8::gemm_phase<EpiProj, pg8::StaticOrder, true, true>(F.lds + RING_OFF, g, So, E);
            __syncthreads();
            if (F.tid == 0) __hip_atomic_fetch_add(done, 1u, RLX_AGENT);
        }
        const unsigned tgt = (unsigned)F.G; leave_group(F);
        if (F.G == 256 && (blockIdx.x >> 3) == 31) p_fscan(F, (int)(blockIdx.x & 7));
        conv_worker(F, done, F.G == 256 ? (unsigned)GC_INPROJ : tgt, 0);
        __syncthreads();
    } SEAM(2);
#define GROUPED(k, Gc, body) do { gu32* done_ = F.ctl + CW_DONE + 64 * (k); if (enter_group(F, (Gc))) { body; __syncthreads(); if (F.tid == 0) __hip_atomic_fetch_add(done_, 1u, RLX_AGENT); } \
        const unsigned tgt_ = (unsigned)F.G; leave_group(F); conv_worker(F, done_, F.G == 256 ? (unsigned)(Gc) : tgt_, 0); __syncthreads(); } while (0)
    STAMP(3); if (IN(3)) { p3_prep(F); } SEAM(3);
    STAMP(4); if (IN(4)) { p4_scan(F); if (DBL(4)) p4_scan(F); } SEAM(4);
    STAMP(5); if (IN(5)) {
        gu32* done = F.ctl + CW_DONE + 64 * 5;
        if (args.pad != 3) p5_mlstm_out(F);
        if (enter_group(F, GC_ATTN)) {
            if (args.pad != 2) p5_attention(F, (char*)lds);
            __syncthreads();
            if (F.tid == 0) __hip_atomic_fetch_add(done, 1u, RLX_AGENT);
        }
        const unsigned tgt = (unsigned)F.G; leave_group(F);
        conv_worker(F, done, F.G == 256 ? (unsigned)GC_ATTN : tgt, 0);
        __syncthreads();
    } SEAM(5);
    STAMP(6); if (IN(6)) { p6_combine(F); } SEAM(6);
    STAMP(7); if (IN(7)) {
        pg8::Gemm g{wsp<pg8::bf16_t>(F, WS_CONCAT), wsp<pg8::bf16_t>(F, WS_WOUT), S, D, D}; pg8::StaticOrder So; So.init(S, D, F.G, F.bid);
        EpiOut E{F.in[IN_X], wsp<float>(F, WS_MOD) + 2 * D, wsp<float>(F, WS_H1)};
        pg8::gemm_phase<EpiOut, pg8::StaticOrder, false, true>(F.lds + RING_OFF, g, So, E);
        if (DBL(7)) pg8::gemm_phase<EpiOut, pg8::StaticOrder, false, true>(F.lds + RING_OFF, g, So, E);
    }
    s16x8 rwhi[16], rwlo[16];
    if (IN(8)) router_load_weights(F, rwhi, rwlo);
    SEAM(7);
    STAMP(8); if (IN(8)) { p7_router(F, rwhi, rwlo); } SEAM(8);
    STAMP(9); if (IN(9)) { p8_gather(F); if (DBL(9)) p8_gather(F); __syncthreads(); conv_worker(F, nullptr, 0u, 1); __syncthreads(); } SEAM(9);
    STAMP(10); if (IN(10)) {
        build_expert_table(F, (const int*)(F.ws + WS_POS) + S * 4);
        gu32* done = F.ctl + CW_DONE + 64 * 10;
        const int units = ((const LAS int*)(F.lds + TAB_OFF))[32] * 16, rounds = (units + 255) >> 8; int gc = rounds > 0 ? (((units + rounds - 1) / rounds + 7) >> 3) << 3 : 256; gc = gc > 256 ? 256 : gc;
        gc = __builtin_amdgcn_readfirstlane(gc);
        if (enter_group(F, gc)) {
            pg8::Gemm g{wsp<pg8::bf16_t>(F, WS_HN), wsp<pg8::bf16_t>(F, WS_WUG), S, 4096, D / 2}; GroupedOrder So{(const LAS int*)(F.lds + TAB_OFF), 16, F.G, F.bid};
            EpiSwiglu E{wsp<unsigned char>(F, WS_ACT), F.in[IN_BUG], (const LAS int*)(F.lds + TAB_OFF)};
            LAS int* rowc = (LAS int*)(F.lds + TAB_OFF + 1024); const int* rowtok = wsp<int>(F, WS_ROWTOK);
            int nun = 0; { pg8::Unit uu = {0, 0, 0, 0}; while (nun < ROWC_MAX && So.next(nun, uu)) { if (F.tid < 256) rowc[nun * 256 + F.tid] = rowtok[uu.pm * 256 + F.tid]; ++nun; }
                if (nun == ROWC_MAX && So.next(nun, uu)) nun = -1; }
            __syncthreads();
            if (nun >= 0) pg8::gemm_phase8g<EpiSwiglu, GroupedOrder, true, true>(F.lds + RING_OFF, g, So, E, rowc);
            else if (F.tid == 0) __hip_atomic_store(F.ctl + CW_TMO, 0xBAD0C0u, RLX_AGENT);
            __syncthreads();
            if (F.tid == 0) __hip_atomic_fetch_add(done, 1u, RLX_AGENT);
        }
        leave_group(F);
        __syncthreads(); conv_worker(F, nullptr, 0u, 2); __syncthreads();
    } SEAM(10);
    STAMP(11); if (IN(11)) {
        build_expert_table(F, (const int*)(F.ws + WS_POS) + S * 4);
        pg8::Gemm g{wsp<pg8::bf16_t>(F, WS_ACT), wsp<pg8::bf16_t>(F, WS_WD), MAXROWS, D, FF / 2}; GroupedOrder So{(const LAS int*)(F.lds + TAB_OFF), 8, F.G, F.bid};
        EpiDown E{wsp<unsigned char>(F, WS_Y), F.in[IN_BD], wsp<float>(F, WS_ROWW)};
        pg8::gemm_phase8<EpiDown, GroupedOrder, true, true>(F.lds + RING_OFF, g, So, E);
        if (DBL(11)) pg8::gemm_phase8<EpiDown, GroupedOrder, true, true>(F.lds + RING_OFF, g, So, E);
    } SEAM(11);
    STAMP(12); if (IN(12)) { p11_final(F, PROBE_SCALE()); if (DBL(12)) p11_final(F, PROBE_SCALE()); }
#undef IN
#undef SEAM
}
}
#ifndef MK_DEBUG
#define MK_DEBUG 0
#endif
#ifndef MK_PH_END
#define MK_PH_END mk::N_PHASES
#endif
#ifndef MK_SPLIT
#define MK_SPLIT 0
#endif
extern "C" void kernel_launch(void* const* d_in, const int* in_sizes, int n_in, void* d_out, int out_size, void* d_ws, size_t ws_size, hipStream_t stream) {
    using namespace mk;
    static int grid = 0;
    if (grid == 0) {
        int dev = 0, cus = 0, per_cu = 0;
        if (hipGetDevice(&dev) != hipSuccess || hipDeviceGetAttribute(&cus, hipDeviceAttributeMultiprocessorCount, dev) != hipSuccess) { fprintf(stderr, "kernel_launch: device query failed\n"); grid = -1; return; }
        if (hipFuncSetAttribute((const void*)mega_fwd, hipFuncAttributeMaxDynamicSharedMemorySize, LDS_BYTES) != hipSuccess) { fprintf(stderr, "kernel_launch: hipFuncSetAttribute failed\n"); grid = -1; return; }
        if (hipOccupancyMaxActiveBlocksPerMultiprocessor(&per_cu, (const void*)mega_fwd, NTHR, LDS_BYTES) != hipSuccess || per_cu < 1) fprintf(stderr, "kernel_launch: occupancy query reports %d\n", per_cu);
        (void)hipGetLastError();
        grid = cus;
        if (n_in != 24 || out_size != S * D || ws_size < (MK_DEBUG ? WS_NAIVE + (size_t)2300 * MiB : WS_END)) fprintf(stderr, "kernel_launch: unexpected sizes n_in %d out %d ws %zu\n", n_in, out_size, ws_size);
    }
    if (grid < 0) return;
    (void)hipMemsetAsync((char*)d_ws + WS_CTL, 0, CTL_ZERO_BYTES, stream);
    Args a{};
    for (int i = 0; i < 24; ++i) a.in[i] = (const float*)d_in[i];
    a.out = (float*)d_out; a.ws = (unsigned char*)d_ws;
#if MK_DEBUG
    nv::naive_forward(d_in, (float*)d_out, (char*)d_ws + WS_NAIVE, stream);
#endif
#if MK_SPLIT
    for (int p = 0; p < MK_PH_END; ++p) { a.ph_lo = p; a.ph_hi = p + 1; a.li = p; hipLaunchKernelGGL(mega_fwd, dim3(grid), dim3(NTHR), LDS_BYTES, stream, a); }
#else
    a.ph_lo = 0; a.ph_hi = MK_PH_END; a.li = 0;
    hipLaunchKernelGGL(mega_fwd, dim3(grid), dim3(NTHR), LDS_BYTES, stream, a);
#endif
#ifdef MK_EXTRA_LO
    a.ph_lo = MK_EXTRA_LO; a.ph_hi = MK_EXTRA_HI; a.li = 1;
#ifdef MK_EXTRA_PAD
    a.pad = MK_EXTRA_PAD;
#endif
    hipLaunchKernelGGL(mega_fwd, dim3(grid), dim3(NTHR), LDS_BYTES, stream, a);
#endif
    { const hipError_t le = hipPeekAtLastError(); if (le != hipSuccess) fprintf(stderr, "kernel_launch: launch failed: %s\n", hipGetErrorName(le)); }
#if MK_DEBUG
    {
        nv::NaiveWs w = nv::carve((char*)d_ws + WS_NAIVE);
        double* slots = (double*)((char*)d_ws + WS_CTL + 512 * 1024);
        unsigned char* ws = (unsigned char*)d_ws; int nc = 0;
        MK_DEBUG_CHECKS
        dbg::k_finish<<<1024, 256, 0, stream>>>((float*)d_out, (size_t)S * D, slots, nc, 1e-3);
    }
#endif
}
```
